# Optimizing an MI355X kernel written in HIP

```python
import jax, jax.numpy as jnp
from jax import lax
import numpy as np

D_MODEL = 1024
BATCH = 4
SEQ = 8192
DEPTH = 2

GRID_W = 64
CTX_LEN = 256
N_MIXERS = 2
N_EVEN = (DEPTH + 1) // 2
N_ODD = DEPTH // 2

CHUNK = 128
A_WIDTH = D_MODEL
A_GROUPS = 16
A_GROUP_CH = A_WIDTH // A_GROUPS

HEAD_DIM = 64
N_Q_HEADS = D_MODEL // HEAD_DIM
N_KV_HEADS = 4
Q_PER_KV = N_Q_HEADS // N_KV_HEADS
QKV_WIDTH = (N_Q_HEADS + 2 * N_KV_HEADS) * HEAD_DIM
WINDOW = 128
BLOCK = 128
ROPE_BASE = 10000.0

D_FF = (7 * D_MODEL) // 2
N_EXPERTS = 8
TOP_K = 2

EPS = 1e-6
NEG_INF = -1e30

kernel_name = 'hybrid_chunkmlp_swa_moe_dit'


def rms_norm(x, g):
    xf = x.astype(jnp.float32)
    y = xf * lax.rsqrt(jnp.mean(xf * xf, axis=-1, keepdims=True) + EPS)
    return (y * g.astype(jnp.float32)).astype(x.dtype)


def modulate(x, shift, scale):
    return x * (1 + scale) + shift


def rope_1d(x, pos):
    half = x.shape[-1] // 2
    inv = ROPE_BASE ** (-jnp.arange(half, dtype=jnp.float32) / half)
    ang = pos.astype(jnp.float32)[:, None] * inv[None, :]
    cos = jnp.cos(ang)[:, None, :]
    sin = jnp.sin(ang)[:, None, :]
    xf = x.astype(jnp.float32)
    x1, x2 = xf[..., :half], xf[..., half:]
    return jnp.concatenate([x1 * cos - x2 * sin, x1 * sin + x2 * cos], axis=-1).astype(x.dtype)


def axial_rope(x, row, col):
    half = x.shape[-1] // 2
    return jnp.concatenate([rope_1d(x[..., :half], row), rope_1d(x[..., half:], col)], axis=-1)


def chunk_token_mlp(x, w_in, v_g, v_b, w_s, b_s, w_out):
    B, S, _ = x.shape
    uv = jax.nn.gelu(x @ w_in)
    u, v = uv[..., :A_WIDTH], uv[..., A_WIDTH:]
    vf = v.astype(jnp.float32)
    mu = jnp.mean(vf, axis=-1, keepdims=True)
    var = jnp.mean(jnp.square(vf - mu), axis=-1, keepdims=True)
    v = ((vf - mu) * lax.rsqrt(var + EPS) * v_g.astype(jnp.float32) + v_b.astype(jnp.float32)).astype(x.dtype)
    v = v.reshape(B, S // CHUNK, CHUNK, A_GROUPS, A_GROUP_CH)
    s = jnp.einsum('gpq,bnqgc->bnpgc', w_s, v) + b_s.T[None, None, :, :, None]
    return (u * s.reshape(B, S, A_WIDTH)) @ w_out


def split_qkv(y):
    B, S, _ = y.shape
    nq = N_Q_HEADS * HEAD_DIM
    nk = N_KV_HEADS * HEAD_DIM
    q = y[..., :nq].reshape(B, S, N_Q_HEADS, HEAD_DIM)
    k = y[..., nq:nq + nk].reshape(B, S, N_KV_HEADS, HEAD_DIM)
    v = y[..., nq + nk:].reshape(B, S, N_KV_HEADS, HEAD_DIM)
    return q, k, v


def window_attention(hn, zn, w_qkv, sink, w_out, with_ctx_out):
    B, S, _ = hn.shape
    L = zn.shape[1]
    rows = S // GRID_W
    row = jnp.repeat(jnp.arange(rows, dtype=jnp.int32), GRID_W)
    col = jnp.tile(jnp.arange(GRID_W, dtype=jnp.int32), rows)
    q, k, v = split_qkv(hn @ w_qkv)
    qc, kc, vc = split_qkv(zn @ w_qkv)
    q = axial_rope(q, row, col)
    k = axial_rope(k, row, col)
    scale = HEAD_DIM ** -0.5
    nb = S // BLOCK
    kw = BLOCK + 2 * WINDOW
    kp = jnp.pad(k, ((0, 0), (WINDOW, WINDOW), (0, 0), (0, 0)))
    vp = jnp.pad(v, ((0, 0), (WINDOW, WINDOW), (0, 0), (0, 0)))
    qs = jnp.moveaxis(q.reshape(B, nb, BLOCK, N_KV_HEADS, Q_PER_KV, HEAD_DIM), 1, 0)
    sink_l = sink.astype(jnp.float32).reshape(N_KV_HEADS, Q_PER_KV)[None, :, :, None, None]
    q_idx = jnp.arange(BLOCK)[:, None]
    k_rel = jnp.arange(kw)[None, :] - WINDOW
    band = jnp.abs(q_idx - k_rel) <= WINDOW

    def attend_block(args):
        n, qb = args
        kb = lax.dynamic_slice_in_dim(kp, n * BLOCK, kw, axis=1)
        vb = lax.dynamic_slice_in_dim(vp, n * BLOCK, kw, axis=1)
        kpos = n * BLOCK + k_rel
        valid = band & (kpos >= 0) & (kpos < S)
        s_loc = jnp.einsum('bqhgd,bkhd->bhgqk', qb, kb).astype(jnp.float32) * scale
        s_loc = jnp.where(valid, s_loc, NEG_INF)
        s_ctx = jnp.einsum('bqhgd,bkhd->bhgqk', qb, kc).astype(jnp.float32) * scale
        s_sink = jnp.broadcast_to(sink_l, s_loc.shape[:-1] + (1,))
        p = jax.nn.softmax(jnp.concatenate([s_loc, s_ctx, s_sink], axis=-1), axis=-1).astype(qb.dtype)
        return (jnp.einsum('bhgqk,bkhd->bqhgd', p[..., :kw], vb)
                + jnp.einsum('bhgqk,bkhd->bqhgd', p[..., kw:kw + L], vc))

    o = lax.map(attend_block, (jnp.arange(nb, dtype=jnp.int32), qs))
    y = jnp.moveaxis(o, 0, 1).reshape(B, S, N_Q_HEADS * HEAD_DIM) @ w_out
    if not with_ctx_out:
        return y, None
    qcg = qc.reshape(B, L, N_KV_HEADS, Q_PER_KV, HEAD_DIM)
    s_c = jnp.einsum('bqhgd,bkhd->bhgqk', qcg, kc).astype(jnp.float32) * scale
    s_cs = jnp.broadcast_to(sink_l, s_c.shape[:-1] + (1,))
    p_c = jax.nn.softmax(jnp.concatenate([s_c, s_cs], axis=-1), axis=-1).astype(qc.dtype)
    o_c = jnp.einsum('bhgqk,bkhd->bqhgd', p_c[..., :L], vc)
    yc = o_c.reshape(B, L, N_Q_HEADS * HEAD_DIM) @ w_out
    return y, yc


def swiglu(x, w_gate, w_up, w_down):
    return (jax.nn.silu(x @ w_gate) * (x @ w_up)) @ w_down


def moe_swiglu(x, w_router, w_gate, w_up, w_down):
    B, S, D = x.shape
    xt = x.reshape(-1, D)
    logits = (xt @ w_router).astype(jnp.float32)
    top_v, top_i = lax.top_k(logits, TOP_K)
    top_w = jax.nn.softmax(top_v, axis=-1)
    gates = jnp.sum(jax.nn.one_hot(top_i, N_EXPERTS, dtype=jnp.float32) * top_w[..., None], axis=1)
    gates = gates.astype(x.dtype)
    y = jnp.zeros_like(xt)
    for e in range(N_EXPERTS):
        y = y + gates[:, e:e + 1] * swiglu(xt, w_gate[e], w_up[e], w_down[e])
    return y.reshape(B, S, D)


def setup_inputs(seed: int = 0) -> dict:
    key = jax.random.key(seed)
    ks = jax.random.split(key, 24)
    f32 = jnp.float32
    D = D_MODEL
    nrm = lambda k, shape, s: jax.random.normal(k, shape, f32) * s
    return {
        'x': nrm(ks[0], (BATCH, SEQ, D), 1.0),
        'c': nrm(ks[1], (BATCH, D), 1.0),
        'ctx': nrm(ks[2], (BATCH, CTX_LEN, D), 1.0),
        'c_ctx': nrm(ks[3], (D,), 1.0),
        'ada_w': nrm(ks[4], (DEPTH, D, 6 * D), 0.5 * D ** -0.5),
        'ada_b': nrm(ks[5], (DEPTH, 6 * D), 0.01),
        'norm_g': 1.0 + nrm(ks[6], (DEPTH, 2, D), 0.02),
        'final_g': 1.0 + nrm(ks[7], (D,), 0.02),
        'a_w_in': nrm(ks[8], (N_EVEN, D, 2 * A_WIDTH), D ** -0.5),
        'a_v_g': 1.0 + nrm(ks[9], (N_EVEN, A_WIDTH), 0.02),
        'a_v_b': nrm(ks[10], (N_EVEN, A_WIDTH), 0.02),
        'a_w_s': nrm(ks[11], (N_EVEN, A_GROUPS, CHUNK, CHUNK), CHUNK ** -0.5),
        'a_b_s': 1.0 + nrm(ks[12], (N_EVEN, A_GROUPS, CHUNK), 0.02),
        'a_w_out': nrm(ks[13], (N_EVEN, A_WIDTH, D), A_WIDTH ** -0.5),
        'b_w_qkv': nrm(ks[14], (N_ODD, D, QKV_WIDTH), D ** -0.5),
        'b_sink': nrm(ks[15], (N_ODD, N_Q_HEADS), 0.5),
        'b_w_out': nrm(ks[16], (N_ODD, N_Q_HEADS * HEAD_DIM, D), (N_Q_HEADS * HEAD_DIM) ** -0.5),
        'ffn_w_gate': nrm(ks[17], (N_EVEN, D, D_FF), D ** -0.5),
        'ffn_w_up': nrm(ks[18], (N_EVEN, D, D_FF), D ** -0.5),
        'ffn_w_down': nrm(ks[19], (N_EVEN, D_FF, D), D_FF ** -0.5),
        'moe_w_router': nrm(ks[20], (N_ODD, D, N_EXPERTS), D ** -0.5),
        'moe_w_gate': nrm(ks[21], (N_ODD, N_EXPERTS, D, D_FF), D ** -0.5),
        'moe_w_up': nrm(ks[22], (N_ODD, N_EXPERTS, D, D_FF), D ** -0.5),
        'moe_w_down': nrm(ks[23], (N_ODD, N_EXPERTS, D_FF, D), D_FF ** -0.5),
    }


def reference(x, c, ctx, c_ctx, ada_w, ada_b, norm_g, final_g,
              a_w_in, a_v_g, a_v_b, a_w_s, a_b_s, a_w_out,
              b_w_qkv, b_sink, b_w_out,
              ffn_w_gate, ffn_w_up, ffn_w_down,
              moe_w_router, moe_w_gate, moe_w_up, moe_w_down):
    h = x
    z = ctx
    ada_in = jax.nn.silu(c)
    ada_in_ctx = jax.nn.silu(c_ctx)[None]
    for i in range(DEPTH):
        j = i // 2
        last = i == DEPTH - 1
        mod = (ada_in @ ada_w[i] + ada_b[i])[:, None, :]
        mod_c = (ada_in_ctx @ ada_w[i] + ada_b[i])[:, None, :]
        sh1, sc1, g1, sh2, sc2, g2 = jnp.split(mod, 6, axis=-1)
        sh1c, sc1c, g1c, sh2c, sc2c, g2c = jnp.split(mod_c, 6, axis=-1)
        hn = modulate(rms_norm(h, norm_g[i, 0]), sh1, sc1)
        zn = modulate(rms_norm(z, norm_g[i, 0]), sh1c, sc1c)
        if i % N_MIXERS == 0:
            dh = chunk_token_mlp(hn, a_w_in[j], a_v_g[j], a_v_b[j], a_w_s[j], a_b_s[j], a_w_out[j])
            dz = None if last else chunk_token_mlp(zn, a_w_in[j], a_v_g[j], a_v_b[j], a_w_s[j], a_b_s[j], a_w_out[j])
        else:
            dh, dz = window_attention(hn, zn, b_w_qkv[j], b_sink[j], b_w_out[j], not last)
        if i % 2 == 0:
            channel = lambda t: swiglu(t, ffn_w_gate[j], ffn_w_up[j], ffn_w_down[j])
        else:
            channel = lambda t: moe_swiglu(t, moe_w_router[j], moe_w_gate[j], moe_w_up[j], moe_w_down[j])
        h = h + g1 * dh
        h = h + g2 * channel(modulate(rms_norm(h, norm_g[i, 1]), sh2, sc2))
        if not last:
            z = z + g1c * dz
            z = z + g2c * channel(modulate(rms_norm(z, norm_g[i, 1]), sh2c, sc2c))
    return rms_norm(h, final_g)
```

```cpp
#include <hip/hip_runtime.h>
#include <hip/hip_bf16.h>
#include <cstdio>
#include <cstdint>
#include <cmath>

constexpr int DM = 1024, NB = 4, SEQ = 8192, LCTX = 256, NLAT = NB * SEQ, NCTXR = NB * LCTX, MALL = NLAT + NCTXR;
constexpr int DFF = 3584, NEXP = 8, NQKV = 1536;
constexpr int NPL = NLAT / 256, NPA = MALL / 256;
constexpr float EPS = 1e-6f;
constexpr int MOE_CH = 88, MOE_NCH = 3, MOE_MAXP = 264;

#define LAS __attribute__((address_space(3)))
#define GAS __attribute__((address_space(1)))
typedef unsigned short bf16_t;
typedef short bf16x8 __attribute__((ext_vector_type(8)));
typedef float f32x4 __attribute__((ext_vector_type(4)));
typedef float f32x2 __attribute__((ext_vector_type(2)));
typedef float f32x16 __attribute__((ext_vector_type(16)));
typedef unsigned u32x4 __attribute__((ext_vector_type(4)));
typedef unsigned u32x2 __attribute__((ext_vector_type(2)));
typedef __bf16 bf16x2_t __attribute__((ext_vector_type(2)));
typedef GAS unsigned gu32;

__device__ __forceinline__ unsigned pkbf(float lo, float hi) { f32x2 v = {lo, hi}; bf16x2_t b = __builtin_convertvector(v, bf16x2_t); return __builtin_bit_cast(unsigned, b); }
__device__ __forceinline__ float bf2f(unsigned short h) { return __builtin_bit_cast(float, (unsigned)h << 16); }
__device__ __forceinline__ float wave_sum(float v) {
#pragma unroll
    for (int o = 1; o < 64; o <<= 1) v += __shfl_xor(v, o);
    return v;
}
__device__ __forceinline__ float gelu_tanh(float x) {
    const float t = x * (1.0f + 0.044715f * x * x);
    const float e = __builtin_amdgcn_exp2f(-2.302208198f * t);
    return x * __builtin_amdgcn_rcpf(1.0f + e);
}
__device__ __forceinline__ float silu_f(float x) { return x * __builtin_amdgcn_rcpf(1.0f + __builtin_amdgcn_exp2f(-1.4426950409f * x)); }

constexpr size_t MiB = 1u << 20;
constexpr size_t WS_CTL = 0, CTL_ZERO_BYTES = 1 * MiB;
constexpr size_t WS_MOD = 1 * MiB;
constexpr size_t WS_ROPE = 1 * MiB + 256 * 1024;
constexpr size_t WS_STATS = 2 * MiB;
constexpr size_t WS_LIST = 5 * MiB;
constexpr size_t WS_TINFO = 6 * MiB;
constexpr size_t WS_WS = 7 * MiB;
constexpr size_t WS_WIN = 8 * MiB, WS_WAO = 12 * MiB, WS_WQKV = 14 * MiB, WS_WBO = 17 * MiB, WS_WGU = 19 * MiB, WS_WD = 33 * MiB;
constexpr size_t WS_MGU = 40 * MiB, WS_MD = 152 * MiB;
constexpr size_t WS_XN = 208 * MiB;
constexpr size_t WS_ZB = 274 * MiB;
constexpr size_t WS_R = 278 * MiB;
constexpr size_t WS_UVT = WS_R, WS_A2 = WS_R + 132 * MiB, WS_H = WS_R;
constexpr size_t WS_QKV = WS_R, WS_O = WS_R + 99 * MiB;
constexpr size_t WS_Y = WS_R, WS_HC = WS_R + 132 * MiB;
constexpr size_t WS_END = WS_HC + (size_t)MOE_CH * 256 * DFF * 2;
static_assert(WS_UVT + (size_t)2048 * MALL * 2 <= WS_A2 && WS_A2 + (size_t)MALL * DM * 2 <= WS_END, "layer-0 mixer map");
static_assert(WS_H + (size_t)MALL * DFF * 2 <= WS_END && WS_QKV + (size_t)MALL * NQKV * 2 <= WS_O && WS_Y + (size_t)MOE_MAXP * 256 * DM * 2 <= WS_HC, "region map");
static_assert(WS_XN + (size_t)MALL * DM * 2 <= WS_ZB && WS_MD + (size_t)8 * DM * DFF * 2 <= WS_XN && WS_MGU + (size_t)8 * 7168 * DM * 2 <= WS_MD, "weights map");
constexpr int CW_TMO = 0, CW_CODE = 1;
constexpr int CW_CNT = 64;
constexpr int CW_BAR = 4096;

constexpr int RING_BYTES = 131072;
constexpr int GTAB_OFF = RING_BYTES;
constexpr int MOE_OFF = RING_BYTES + 1024;
constexpr int MISC_OFF = RING_BYTES + 2048;
constexpr int LDS_BYTES = 147456;

namespace pg8 {
constexpr int BM = 256, BK = 64, HALF = 128, HTB = HALF * BK * 2, STAGE_BYTES = 8 * HTB, NXCD = 8, WGM = 8;
__host__ __device__ __forceinline__ int lds_byte(int r, int c) { const int st = (r >> 4) * 2 + (c >> 5), rr = r & 15, cc = c & 31, ob = rr * 64 + cc * 2; return st * 1024 + (ob ^ (((ob >> 9) & 1) << 5)); }
__host__ __device__ __forceinline__ void stage_rc(int b, int& R, int& C) { const int st = b / 1024, sb = b % 1024, swz = sb ^ (((sb >> 9) & 1) << 5); R = (st >> 1) * 16 + swz / 64; C = (st & 1) * 32 + (swz % 64) / 2; }
__host__ __device__ __forceinline__ int perm32(int rho) { const int n = rho >> 4, i = rho & 15; return 8 * (i >> 2) + 4 * n + (i & 3); }

struct Unit { const char* a; const char* b; const int* gl; int pm, pn, om, nv; };

__device__ __forceinline__ bool tile_order(int i, int G, int c, int nM, int nN, int& pm, int& pn) {
    const int nwg = nM * nN; const long L = (long)i * G + c; if (L >= nwg) return false;
    int wgid = (int)L; { const int q = nwg / NXCD, r = nwg % NXCD, xcd = wgid % NXCD, off = wgid / NXCD; wgid = (xcd < r ? xcd * (q + 1) : r * (q + 1) + (xcd - r) * q) + off; }
    const int nig = WGM * nN, gid = wgid / nig, fm = gid * WGM, gsz = (nM - fm) < WGM ? (nM - fm) : WGM;
    pm = fm + ((wgid % nig) % gsz); pn = (wgid % nig) / gsz; return true;
}
struct DenseSched {
    const char* A; const char* B; int nM, nN, G, c; size_t tstep;
    __device__ __forceinline__ bool next(int i, Unit& u) const {
        int pm, pn; if (!tile_order(i, G, c, nM, nN, pm, pn)) return false;
        u.a = A + (size_t)pm * tstep; u.b = B + (size_t)pn * tstep; u.gl = nullptr; u.pm = pm; u.pn = pn; u.om = pm; u.nv = 256; return true;
    }
};
struct MoeSched {
    const char* A; const char* B; const int* list; const LAS int* tab; int gp0, gp1, nN, G, c; size_t bexp, btile, astep; bool gather;
    __device__ __forceinline__ bool next(int i, Unit& u) const {
        int pm, pn; if (gp1 <= gp0) return false; if (!tile_order(i, G, c, gp1 - gp0, nN, pm, pn)) return false;
        const int gp = gp0 + pm; int e = 0;
#pragma unroll
        for (int k = 1; k < 8; ++k) e += (gp >= __builtin_amdgcn_readfirstlane(tab[k])) ? 1 : 0;
        const int pbe = __builtin_amdgcn_readfirstlane(tab[e]), ce = __builtin_amdgcn_readfirstlane(tab[16 + e]);
        const int lp = gp - pbe; int nv = ce - 256 * lp; nv = nv > 256 ? 256 : nv;
        u.b = B + (size_t)e * bexp + (size_t)pn * btile; u.pm = gp; u.pn = pn; u.nv = nv;
        if (gather) { u.a = A; u.gl = list + (size_t)e * NLAT + 256 * lp; u.om = pm; }
        else { u.a = A + (size_t)pm * astep; u.gl = nullptr; u.om = gp; }
        return true;
    }
};

struct EpiGeluT {
    static constexpr bool PERM = true;
    bf16_t* O; float* stats;
    __device__ __forceinline__ void operator()(const f32x4 (&acc)[2][2][4][2], const Unit& u, int wr, int wc, int fr, int fq) const {
        const int row0 = u.pm * BM + wr * 64 + fr, col0 = u.pn * BM + wc * 32 + 8 * fq;
        const bool isv = u.pm >= 4;
        float s1[2][2][4], s2[2][2][4];
#pragma unroll
        for (int bj = 0; bj < 2; ++bj)
#pragma unroll
            for (int n = 0; n < 2; ++n)
#pragma unroll
                for (int e = 0; e < 4; ++e) { s1[bj][n][e] = 0.f; s2[bj][n][e] = 0.f; }
#pragma unroll
        for (int ai = 0; ai < 2; ++ai)
#pragma unroll
            for (int m = 0; m < 4; ++m) { bf16_t* rowp = O + (size_t)(row0 + ai * HALF + m * 16) * MALL + col0;
#pragma unroll
                for (int bj = 0; bj < 2; ++bj) { f32x4 v0 = acc[ai][bj][m][0], v1 = acc[ai][bj][m][1];
#pragma unroll
                    for (int e = 0; e < 4; ++e) { v0[e] = gelu_tanh(v0[e]); v1[e] = gelu_tanh(v1[e]); s1[bj][0][e] += v0[e]; s2[bj][0][e] += v0[e] * v0[e]; s1[bj][1][e] += v1[e]; s2[bj][1][e] += v1[e] * v1[e]; }
                    u32x4 w; w.x = pkbf(v0[0], v0[1]); w.y = pkbf(v0[2], v0[3]); w.z = pkbf(v1[0], v1[1]); w.w = pkbf(v1[2], v1[3]);
                    *(u32x4*)(rowp + bj * HALF) = w; } }
        if (isv) {
            const int slot = (u.pm - 4) * 2 + wr;
#pragma unroll
            for (int bj = 0; bj < 2; ++bj)
#pragma unroll
                for (int n = 0; n < 2; ++n)
#pragma unroll
                    for (int e = 0; e < 4; ++e) { float a = s1[bj][n][e], b = s2[bj][n][e];
#pragma unroll
                        for (int o = 1; o < 16; o <<= 1) { a += __shfl_xor(a, o); b += __shfl_xor(b, o); }
                        if (fr == 0) { const int tok = col0 + bj * HALF + 4 * n + e; *(f32x2*)(stats + (size_t)tok * 16 + slot * 2) = (f32x2){a, b}; } }
        }
    }
};
struct EpiResid {
    static constexpr bool PERM = false;
    const float* baseL; const float* baseC; float* outL; float* outC; const float* gate;
    __device__ __forceinline__ void operator()(const f32x4 (&acc)[2][2][4][2], const Unit& u, int wr, int wc, int fr, int fq) const {
        const bool lat = u.pm < NPL; const int mb = lat ? (u.pm >> 5) : 4;
        const float* base = lat ? baseL + (size_t)u.pm * BM * DM : baseC + (size_t)(u.pm - NPL) * BM * DM;
        float* out = lat ? outL + (size_t)u.pm * BM * DM : outC + (size_t)(u.pm - NPL) * BM * DM;
        const int col0 = u.pn * BM + wc * 32 + 4 * fq;
        f32x4 gv[2][2];
#pragma unroll
        for (int bj = 0; bj < 2; ++bj)
#pragma unroll
            for (int n = 0; n < 2; ++n) gv[bj][n] = *(const f32x4*)(gate + (size_t)mb * 6144 + col0 + bj * HALF + n * 16);
#pragma unroll
        for (int ai = 0; ai < 2; ++ai)
#pragma unroll
            for (int m = 0; m < 4; ++m) { const size_t off = (size_t)(wr * 64 + fr + ai * HALF + m * 16) * DM + col0;
#pragma unroll
                for (int bj = 0; bj < 2; ++bj)
#pragma unroll
                    for (int n = 0; n < 2; ++n) { const f32x4 bs = *(const f32x4*)(base + off + bj * HALF + n * 16);
                        *(f32x4*)(out + off + bj * HALF + n * 16) = bs + gv[bj][n] * acc[ai][bj][m][n]; } }
    }
};
struct EpiSwiGLU {
    static constexpr bool PERM = true;
    bf16_t* O;
    __device__ __forceinline__ void operator()(const f32x4 (&acc)[2][2][4][2], const Unit& u, int wr, int wc, int fr, int fq) const {
        bf16_t* base = O + (size_t)(u.om * BM + wr * 64 + fr) * DFF + u.pn * 128 + wc * 32 + 8 * fq;
#pragma unroll
        for (int ai = 0; ai < 2; ++ai)
#pragma unroll
            for (int m = 0; m < 4; ++m) { const f32x4 g0 = acc[ai][0][m][0], g1 = acc[ai][0][m][1], u0 = acc[ai][1][m][0], u1 = acc[ai][1][m][1];
                float o[8];
#pragma unroll
                for (int e = 0; e < 4; ++e) { o[e] = silu_f(g0[e]) * u0[e]; o[4 + e] = silu_f(g1[e]) * u1[e]; }
                u32x4 w; w.x = pkbf(o[0], o[1]); w.y = pkbf(o[2], o[3]); w.z = pkbf(o[4], o[5]); w.w = pkbf(o[6], o[7]);
                *(u32x4*)(base + (size_t)(ai * HALF + m * 16) * DFF) = w; }
    }
};
struct EpiQKV {
    static constexpr bool PERM = false;
    bf16_t* O; const float* cosT; const float* sinT; float qscale;
    __device__ __forceinline__ void operator()(const f32x4 (&acc)[2][2][4][2], const Unit& u, int wr, int wc, int fr, int fq) const {
        const bool lat = u.pm < NPL; const bool dorope = lat && u.pn < 5; const float sc = u.pn < 4 ? qscale : 1.0f;
        const int col0 = u.pn * BM + wc * 32 + 4 * fq;
#pragma unroll
        for (int ai = 0; ai < 2; ++ai)
#pragma unroll
            for (int m = 0; m < 4; ++m) { const int grow = u.pm * BM + ai * HALF + wr * 64 + m * 16 + fr; const int s = grow & (SEQ - 1); const int pos = (wc & 1) ? (s & 63) : (s >> 6);
                f32x4 cs = (f32x4){1.f, 1.f, 1.f, 1.f}, sn = (f32x4){0.f, 0.f, 0.f, 0.f};
                if (dorope) { cs = *(const f32x4*)(cosT + pos * 16 + 4 * fq); sn = *(const f32x4*)(sinT + pos * 16 + 4 * fq); }
                bf16_t* rowp = O + (size_t)grow * NQKV + col0;
#pragma unroll
                for (int bj = 0; bj < 2; ++bj) { const f32x4 x1 = acc[ai][bj][m][0], x2 = acc[ai][bj][m][1];
                    const f32x4 o1 = (x1 * cs - x2 * sn) * sc, o2 = (x1 * sn + x2 * cs) * sc;
                    u32x2 w1, w2; w1.x = pkbf(o1[0], o1[1]); w1.y = pkbf(o1[2], o1[3]); w2.x = pkbf(o2[0], o2[1]); w2.y = pkbf(o2[2], o2[3]);
                    *(u32x2*)(rowp + bj * HALF) = w1; *(u32x2*)(rowp + bj * HALF + 16) = w2; } }
    }
};
struct EpiBf16Plain {
    static constexpr bool PERM = true;
    bf16_t* O; int ldc;
    __device__ __forceinline__ void operator()(const f32x4 (&acc)[2][2][4][2], const Unit& u, int wr, int wc, int fr, int fq) const {
        bf16_t* base = O + (size_t)(u.om * BM + wr * 64 + fr) * ldc + u.pn * BM + wc * 32 + 8 * fq;
#pragma unroll
        for (int ai = 0; ai < 2; ++ai)
#pragma unroll
            for (int m = 0; m < 4; ++m)
#pragma unroll
                for (int bj = 0; bj < 2; ++bj) { const f32x4 v0 = acc[ai][bj][m][0], v1 = acc[ai][bj][m][1];
                    u32x4 w; w.x = pkbf(v0[0], v0[1]); w.y = pkbf(v0[2], v0[3]); w.z = pkbf(v1[0], v1[1]); w.w = pkbf(v1[2], v1[3]);
                    *(u32x4*)(base + (size_t)(ai * HALF + m * 16) * ldc + bj * HALF) = w; }
    }
};

template <class Epi, class Sched, bool ALIGN_EPI, bool GATHER>
__device__ __forceinline__ void gemm_phase(LAS unsigned char* lds, LAS int* gtab, const int K, const Sched& S, const Epi& E) {
    int tid_ = threadIdx.x; asm volatile("" : "+v"(tid_));
    const int tid = tid_, wid = __builtin_amdgcn_readfirstlane(tid >> 6), lane = tid & 63, wr = wid >> 2, wc = wid & 3, fr = lane & 15, fq = lane >> 4;
    const int nt = K / BK;
    const size_t kstep = (size_t)(BK * 2);
    const size_t hstep = (size_t)HALF * K * 2;
    unsigned voffB[2];
#pragma unroll
    for (int i = 0; i < 2; ++i) { int R, C; stage_rc(tid * 16 + i * 8192, R, C); const int Rb = Epi::PERM ? ((R & ~31) + perm32(R & 31)) : R;
        voffB[i] = (unsigned)(Rb * K + C) * 2u; }
    unsigned vA[2][2], vN[2][2];
    const unsigned ldsw = (unsigned)wid * 1024u;
    const int aoff = lds_byte(wr * 64 + fr, fq * 8), boff = lds_byte(wc * 32 + fr, fq * 8);
#define PG8_SA(b, h) (((b) * 2 + (h)) * HTB)
#define PG8_SB(b, h) ((4 + (b) * 2 + (h)) * HTB)
#define PG8_STAGE(bufoff, gbase, voff) do { _Pragma("unroll") for (int _i = 0; _i < 2; ++_i) \
        __builtin_amdgcn_global_load_lds((const unsigned*)((const char*)(gbase) + (voff)[_i]), (LAS unsigned*)(lds + (bufoff) + ldsw + _i * 8192), 16, 0, 0); } while (0)
#define PG8_LDA(dst, b, h) do { _Pragma("unroll") for (int m = 0; m < 4; ++m) _Pragma("unroll") for (int k = 0; k < 2; ++k) dst[m][k] = *(const LAS bf16x8*)(lds + PG8_SA(b, h) + aoff + m * 2048 + k * 1024); } while (0)
#define PG8_LDB(dst, b, h) do { _Pragma("unroll") for (int n = 0; n < 2; ++n) _Pragma("unroll") for (int k = 0; k < 2; ++k) dst[n][k] = *(const LAS bf16x8*)(lds + PG8_SB(b, h) + boff + n * 2048 + k * 1024); } while (0)
#define PG8_MMA(ai, bj, At, Bt) do { __builtin_amdgcn_s_setprio(1); _Pragma("unroll") for (int m = 0; m < 4; ++m) _Pragma("unroll") for (int n = 0; n < 2; ++n) _Pragma("unroll") for (int k = 0; k < 2; ++k) \
        acc[ai][bj][m][n] = __builtin_amdgcn_mfma_f32_16x16x32_bf16(Bt[n][k], At[m][k], acc[ai][bj][m][n], 0, 0, 0); __builtin_amdgcn_s_setprio(0); } while (0)
#define PG8_WAIT_V(n) asm volatile("s_waitcnt vmcnt(" #n ")" ::: "memory")
#define PG8_WAIT_L(n) asm volatile("s_waitcnt lgkmcnt(" #n ")" ::: "memory")
#define PG8_BAR __builtin_amdgcn_s_barrier()
#define PG8_SCHED __builtin_amdgcn_sched_barrier(0)
    Unit cur, nxt; int ui = 0;
    if (!S.next(0, cur)) return;
    f32x4 acc[2][2][4][2];
#pragma unroll
    for (int a = 0; a < 2; ++a)
#pragma unroll
        for (int b = 0; b < 2; ++b)
#pragma unroll
            for (int m = 0; m < 4; ++m)
#pragma unroll
                for (int n = 0; n < 2; ++n) acc[a][b][m][n] = (f32x4){0.f, 0.f, 0.f, 0.f};
    bf16x8 At[4][2], B0[2][2], B1[2][2];
    if constexpr (GATHER) {
#pragma unroll
        for (int h = 0; h < 2; ++h)
#pragma unroll
            for (int i = 0; i < 2; ++i) { int R, C; stage_rc(tid * 16 + i * 8192, R, C); const int row = h * HALF + R; const int tok = cur.gl[row < cur.nv ? row : 0]; vA[h][i] = (unsigned)tok * (unsigned)(K * 2) + (unsigned)C * 2u; }
    } else {
#pragma unroll
        for (int h = 0; h < 2; ++h)
#pragma unroll
            for (int i = 0; i < 2; ++i) { int R, C; stage_rc(tid * 16 + i * 8192, R, C); vA[h][i] = (unsigned)(R * K + C) * 2u + (unsigned)(h * hstep); }
    }
#pragma unroll
    for (int h = 0; h < 2; ++h)
#pragma unroll
        for (int i = 0; i < 2; ++i) vN[h][i] = vA[h][i];
    const char* cA = cur.a; const char* cB = cur.b;
    PG8_STAGE(PG8_SB(0, 0), cB, voffB); PG8_STAGE(PG8_SB(0, 1), cB + hstep, voffB); PG8_STAGE(PG8_SA(0, 0), cA, vA[0]); PG8_STAGE(PG8_SA(0, 1), cA, vA[1]);
    if (wr == 1) PG8_BAR;
    PG8_WAIT_V(2); PG8_BAR;
    PG8_STAGE(PG8_SB(1, 0), cB + kstep, voffB); PG8_STAGE(PG8_SA(1, 0), cA + kstep, vA[0]); PG8_STAGE(PG8_SB(1, 1), cB + hstep + kstep, voffB);
    PG8_WAIT_V(6); PG8_BAR;
    for (;;) {
        const bool has_next = S.next(ui + 1, nxt);
        const char* nA = has_next ? nxt.a : cA; const char* nB = has_next ? nxt.b : cB;
        if constexpr (GATHER) {
            if (has_next && wid < 4) __builtin_amdgcn_global_load_lds((const unsigned*)(nxt.gl + wid * 64 + lane), (LAS unsigned*)(gtab + wid * 64), 4, 0, 0);
        }
        for (int t = 0; t < nt; t += 2) {
            const bool last = (t == nt - 2);
            const char* a1 = cA + (size_t)(t + 1) * kstep;
            const char* a2 = last ? nA : cA + (size_t)(t + 2) * kstep; const char* b2 = last ? nB : cB + (size_t)(t + 2) * kstep;
            const char* a3 = a2 + kstep; const char* b3 = b2 + kstep;
            if constexpr (GATHER) {
                if (last && has_next) {
                    int t2 = tid; asm volatile("" : "+v"(t2));
#pragma unroll
                    for (int h = 0; h < 2; ++h)
#pragma unroll
                        for (int i = 0; i < 2; ++i) { int R, C; stage_rc(t2 * 16 + i * 8192, R, C); const int row = h * HALF + R; const int tok = gtab[row < nxt.nv ? row : 0]; vN[h][i] = (unsigned)tok * (unsigned)(K * 2) + (unsigned)C * 2u; }
                }
            }
            unsigned vS0[2], vS1[2];
#pragma unroll
            for (int i = 0; i < 2; ++i) { vS0[i] = (GATHER && last) ? vN[0][i] : vA[0][i]; vS1[i] = (GATHER && last) ? vN[1][i] : vA[1][i]; }
            PG8_LDB(B0, 0, 0); PG8_LDB(B1, 0, 1); PG8_SCHED; PG8_LDA(At, 0, 0); PG8_STAGE(PG8_SA(1, 1), a1, vA[1]);
            PG8_WAIT_V(8); PG8_WAIT_L(0); PG8_BAR; PG8_MMA(0, 0, At, B0); PG8_MMA(0, 1, At, B1); PG8_BAR; PG8_SCHED;
            PG8_LDA(At, 0, 1); PG8_STAGE(PG8_SB(0, 0), b2, voffB); PG8_STAGE(PG8_SB(0, 1), b2 + hstep, voffB); PG8_STAGE(PG8_SA(0, 0), a2, vS0);
            PG8_WAIT_V(8); PG8_WAIT_L(0); PG8_BAR; PG8_MMA(1, 0, At, B0); PG8_MMA(1, 1, At, B1); PG8_BAR; PG8_SCHED;
            PG8_LDB(B0, 1, 0); PG8_LDB(B1, 1, 1); PG8_SCHED; PG8_LDA(At, 1, 0); PG8_STAGE(PG8_SA(0, 1), a2, vS1);
            PG8_WAIT_V(8); PG8_WAIT_L(0); PG8_BAR; PG8_MMA(0, 0, At, B0); PG8_MMA(0, 1, At, B1); PG8_BAR; PG8_SCHED;
            PG8_LDA(At, 1, 1); PG8_STAGE(PG8_SB(1, 0), b3, voffB); PG8_STAGE(PG8_SB(1, 1), b3 + hstep, voffB); PG8_STAGE(PG8_SA(1, 0), a3, vS0);
            PG8_WAIT_V(8); PG8_WAIT_L(0); PG8_BAR; PG8_MMA(1, 0, At, B0); PG8_MMA(1, 1, At, B1); PG8_BAR; PG8_SCHED;
        }
        if constexpr (ALIGN_EPI) { if (wr == 0) PG8_BAR; }
        E(acc, cur, wr, wc, fr, fq);
        if (!has_next) break;
#pragma unroll
        for (int a = 0; a < 2; ++a)
#pragma unroll
            for (int b = 0; b < 2; ++b)
#pragma unroll
                for (int m = 0; m < 4; ++m)
#pragma unroll
                    for (int n = 0; n < 2; ++n) acc[a][b][m][n] = (f32x4){0.f, 0.f, 0.f, 0.f};
        cur = nxt; cA = nA; cB = nB; ++ui;
        if constexpr (GATHER) {
#pragma unroll
            for (int h = 0; h < 2; ++h)
#pragma unroll
                for (int i = 0; i < 2; ++i) vA[h][i] = vN[h][i];
        }
        if constexpr (ALIGN_EPI) { if (wr == 1) PG8_BAR; }
    }
    PG8_WAIT_V(0);
    if constexpr (!ALIGN_EPI) { if (wr == 0) PG8_BAR; }
    PG8_BAR;
#undef PG8_SA
#undef PG8_SB
#undef PG8_STAGE
#undef PG8_LDA
#undef PG8_LDB
#undef PG8_MMA
#undef PG8_WAIT_V
#undef PG8_WAIT_L
#undef PG8_BAR
#undef PG8_SCHED
}
}

namespace attn_body {
using bf16 = __hip_bfloat16;
using s16x4 = __attribute__((ext_vector_type(4))) short;
constexpr int D = 64, PITCH = NQKV, OPITCH = DM;
constexpr int NW = 8, QBLK = 32, KVBLK = 64;
__device__ __forceinline__ int crow(int r, int hi) { return (r & 3) + 8 * (r >> 2) + 4 * hi; }
#define SBAR() __builtin_amdgcn_sched_barrier(0)
__device__ __forceinline__ void bmask(f32x16& p0, f32x16& p1, int kb, int qrel, int hi) {
    const float NEG = -INFINITY; const int d0 = kb + 4 * hi - qrel;
#pragma unroll
    for (int r = 0; r < 16; ++r) { const int d = d0 + (r & 3) + 8 * (r >> 2); if (d < -128 || d > 128) p0[r] = NEG; if (d + 32 < -128 || d + 32 > 128) p1[r] = NEG; }
}
constexpr int NSLOT = 3, SLOTB = 8192;
constexpr int LDS_K = 0, LDS_V = NSLOT * SLOTB, LDS_WS = 2 * NSLOT * SLOTB, LDS_OST = LDS_WS + NW * 64 * 4, LDS_BYTES_A = LDS_OST + NW * 4096;
constexpr float C2 = 0.125f * 1.4426950408889634f;
__device__ __forceinline__ void glds16(const void* gsrc, unsigned lds_dst) { unsigned keep;
    asm volatile("s_mov_b32 %0, m0\n\ts_mov_b32 m0, %2\n\ts_nop 0\n\tglobal_load_lds_dwordx4 %1, off\n\ts_mov_b32 m0, %0" : "=&s"(keep) : "v"(gsrc), "s"(lds_dst) : "memory"); }
__device__ __forceinline__ float max3f(float a, float b, float c) { float r; asm("v_max3_f32 %0, %1, %2, %3" : "=v"(r) : "v"(a), "v"(b), "v"(c)); return r; }
__device__ __forceinline__ float max2f(float a, float b) { float r; asm("v_max_f32_e32 %0, %1, %2" : "=v"(r) : "v"(a), "v"(b)); return r; }
__device__ __forceinline__ float fadd_s(float a, float b) { float r; asm("v_add_f32_e32 %0, %1, %2" : "=v"(r) : "v"(a), "v"(b)); return r; }
__device__ __forceinline__ float fsub_s(float a, float b) { float r; asm("v_sub_f32_e32 %0, %1, %2" : "=v"(r) : "v"(a), "v"(b)); return r; }
__device__ __forceinline__ unsigned cvtpk_s(float lo, float hi) { f32x2 v = {lo, hi}; bf16x2_t b = __builtin_convertvector(v, bf16x2_t); return __builtin_bit_cast(unsigned, b); }
#define WAIT_BAR(N) asm volatile("s_waitcnt vmcnt(" #N ") lgkmcnt(0)\n\ts_barrier" ::: "memory")
__device__ __forceinline__ void qkt(f32x16& p0, f32x16& p1, const char* Kslot, const bf16x8* qr, const f32x16& negm, int r32, int hi) {
    const char* kb = Kslot + hi * 1024 + r32 * 16;
#pragma unroll
    for (int d0 = 0; d0 < 4; ++d0) {
        const bf16x8 b0 = *reinterpret_cast<const bf16x8*>(kb + d0 * 2048);
        const bf16x8 b1 = *reinterpret_cast<const bf16x8*>(kb + d0 * 2048 + 512);
        if (d0 == 0) { p0 = __builtin_amdgcn_mfma_f32_32x32x16_bf16(b0, qr[0], negm, 0, 0, 0); p1 = __builtin_amdgcn_mfma_f32_32x32x16_bf16(b1, qr[0], negm, 0, 0, 0); }
        else { p0 = __builtin_amdgcn_mfma_f32_32x32x16_bf16(b0, qr[d0], p0, 0, 0, 0); p1 = __builtin_amdgcn_mfma_f32_32x32x16_bf16(b1, qr[d0], p1, 0, 0, 0); } }
}
typedef __attribute__((address_space(3))) const char* lds_cptr;
typedef short v4i16_t __attribute__((ext_vector_type(4)));
__device__ __forceinline__ void kload8(bf16x8* kf, lds_cptr kp) {
    kf[0] = *(const __attribute__((address_space(3))) bf16x8*)(kp);        kf[1] = *(const __attribute__((address_space(3))) bf16x8*)(kp + 512);
    kf[2] = *(const __attribute__((address_space(3))) bf16x8*)(kp + 2048); kf[3] = *(const __attribute__((address_space(3))) bf16x8*)(kp + 2560);
    kf[4] = *(const __attribute__((address_space(3))) bf16x8*)(kp + 4096); kf[5] = *(const __attribute__((address_space(3))) bf16x8*)(kp + 4608);
    kf[6] = *(const __attribute__((address_space(3))) bf16x8*)(kp + 6144); kf[7] = *(const __attribute__((address_space(3))) bf16x8*)(kp + 6656);
}
__device__ __forceinline__ void kload2(bf16x8* kf, lds_cptr kp, int j) { kf[2 * j] = *(const __attribute__((address_space(3))) bf16x8*)(kp + j * 2048); kf[2 * j + 1] = *(const __attribute__((address_space(3))) bf16x8*)(kp + j * 2048 + 512); }
__device__ __forceinline__ s16x4 vtr(lds_cptr p) { return __builtin_bit_cast(s16x4, __builtin_amdgcn_ds_read_tr16_b64_v4i16((__attribute__((address_space(3))) v4i16_t*)p)); }
__device__ __forceinline__ float rowmax(const f32x16& p0, const f32x16& p1) {
    float a = max3f(p0[0], p0[1], p1[0]), b = max3f(p0[2], p0[3], p1[1]); a = max3f(a, p1[2], p1[3]);
#pragma unroll
    for (int r = 4; r < 16; r += 4) { a = max3f(a, p0[r], p0[r + 1]); b = max3f(b, p0[r + 2], p0[r + 3]); a = max3f(a, p1[r], p1[r + 1]); b = max3f(b, p1[r + 2], p1[r + 3]); }
    const float m = max2f(a, b);
    auto rr = __builtin_amdgcn_permlane32_swap(__float_as_uint(m), __float_as_uint(m), false, false);
    return max2f(__uint_as_float(rr[0]), __uint_as_float(rr[1]));
}
__device__ __forceinline__ void pv(f32x16* o, int vb, bf16x8 pa0, bf16x8 pa1, bf16x8 pa2, bf16x8 pa3) {
#pragma unroll
    for (int d0 = 0; d0 < 2; ++d0) { s16x4 lo[4], hi[4];
#pragma unroll
        for (int ks = 0; ks < 4; ++ks) {
            asm volatile("ds_read_b64_tr_b16 %0,%1 offset:%c2" : "=&v"(lo[ks]) : "v"(vb), "i"(d0 * 4096 + ks * 1024) : "memory");
            asm volatile("ds_read_b64_tr_b16 %0,%1 offset:%c2" : "=&v"(hi[ks]) : "v"(vb), "i"(d0 * 4096 + ks * 1024 + 512) : "memory"); }
        asm volatile("s_waitcnt lgkmcnt(0)" ::: "memory"); SBAR();
#define PK(k) (bf16x8){lo[k][0], lo[k][1], lo[k][2], lo[k][3], hi[k][0], hi[k][1], hi[k][2], hi[k][3]}
        o[d0] = __builtin_amdgcn_mfma_f32_32x32x16_bf16(pa0, PK(0), o[d0], 0, 0, 0);
        o[d0] = __builtin_amdgcn_mfma_f32_32x32x16_bf16(pa1, PK(1), o[d0], 0, 0, 0);
        o[d0] = __builtin_amdgcn_mfma_f32_32x32x16_bf16(pa2, PK(2), o[d0], 0, 0, 0);
        o[d0] = __builtin_amdgcn_mfma_f32_32x32x16_bf16(pa3, PK(3), o[d0], 0, 0, 0);
#undef PK
    }
}
#define ATTN_STORE16(p, v) (*(u32x4*)(p) = (v))
template <int THRL> __device__ __forceinline__ void attn_unit(int b, int hk, int n, int pr, const bf16* QKV, bf16* O, const float* sinkp, char* shm) {
    int tid_ = threadIdx.x; asm volatile("" : "+v"(tid_));
    const int tid = tid_, lane = tid & 63, r32 = lane & 31, hi = lane >> 5; const int wid = __builtin_amdgcn_readfirstlane(tid >> 6);
    const int head = 4 * hk + 2 * pr + (wid >> 2);
    const long rowblk = (long)b * SEQ + n * 128;
    const long ctxrow = (long)NLAT + b * LCTX;
    const int nlo = n > 0 ? 2 : 0, nhi = n < (SEQ / 128 - 1) ? 2 : 0;
    const int NT = 6 + nlo + nhi;
    const bf16* Qw = QKV + (rowblk + (wid & 3) * QBLK) * PITCH + head * D;
    const bf16* Kc = QKV + 1024 + hk * D; const bf16* Vc = QKV + 1280 + hk * D;
    const unsigned lds0 = (unsigned)(uintptr_t)shm;
    float* wsf = (float*)(shm + LDS_WS) + wid * 64;
    const long klane = (long)lane * PITCH + wid * 8;
    const long vlane = (long)(16 * (wid & 3) + (lane >> 2)) * PITCH + (wid >> 2) * 32 + (lane & 3) * 8;
    const unsigned kdst = lds0 + LDS_K + wid * 1024, vdst = lds0 + LDS_V + wid * 1024;
#define TROW(t) (((t) < 2) ? (rowblk + 64 * (t)) : ((t) < 6) ? (ctxrow + 64 * ((t) - 2)) : (rowblk + ((((t) - 6) < nlo) ? (-128 + 64 * ((t) - 6)) : (128 + 64 * ((t) - 6 - nlo)))))
#define TKB(t) (((t) < 6) ? 0 : ((((t) - 6) < nlo) ? (-128 + 64 * ((t) - 6)) : (128 + 64 * ((t) - 6 - nlo))))
#define DMA_K(t, slot) glds16(Kc + TROW(t) * PITCH + klane, (unsigned)__builtin_amdgcn_readfirstlane(kdst + (slot)))
#define DMA_V(t, slot) glds16(Vc + TROW(t) * PITCH + vlane, (unsigned)__builtin_amdgcn_readfirstlane(vdst + (slot)))
    const int vb0 = (int)(lds0 + LDS_V) + ((lane >> 4) & 1) * 32 + (lane & 3) * 8 + (4 * hi + ((lane & 15) >> 2)) * 64;
    const char* Kbase = shm + LDS_K; bf16x8 kf[8];
    const lds_cptr shm3 = (lds_cptr)shm; const lds_cptr kp0 = shm3 + LDS_K + hi * 1024 + r32 * 16; const lds_cptr vp0 = shm3 + LDS_V + ((lane >> 4) & 1) * 32 + (lane & 3) * 8 + (4 * hi + ((lane & 15) >> 2)) * 64;
    DMA_K(0, 0); DMA_V(0, 0); DMA_K(1, SLOTB);
    bf16x8 qr[4];
#pragma unroll
    for (int d0 = 0; d0 < 4; ++d0) qr[d0] = *reinterpret_cast<const bf16x8*>(&Qw[(long)r32 * PITCH + d0 * 16 + hi * 8]);
    float mhat = 0.f, l_reg = 0.f; f32x16 o[2]; o[0] = f32x16{}; o[1] = f32x16{}; f32x16 negm = f32x16{}; asm volatile("" : "+v"(negm));
    const int qrel = (wid & 3) * QBLK + r32;
#define CMASK(P0, P1, t) do { int jb_ = (t) - (NT - 4); if (jb_ >= 0) bmask(P0, P1, TKB(t), qrel, hi); } while (0)
    bool resc = false;
#define START(P0, P1) do { const float rm = rowmax(P0, P1); resc = false; \
    { const float dl = rm; mhat = fadd_s(mhat, dl); \
      _Pragma("unroll") for (int r = 0; r < 16; ++r) { P0[r] = fsub_s(P0[r], dl); P1[r] = fsub_s(P1[r], dl); } \
      _Pragma("unroll") for (int r = 0; r < 16; ++r) negm[r] = -mhat; asm volatile("" : "+v"(negm)); } \
    _Pragma("unroll") for (int r = 0; r < 16; ++r) P0[r] = __builtin_amdgcn_exp2f(P0[r]); } while (0)
#define RESC() do { if (resc) { asm volatile("s_waitcnt lgkmcnt(0)" ::: "memory"); \
      _Pragma("unroll") for (int d_ = 0; d_ < 2; ++d_) _Pragma("unroll") for (int r = 0; r < 16; ++r) o[d_][r] *= wsf[crow(r, hi)]; } } while (0)
    f32x16 pA0, pA1, pB0, pB1;
    int sl_prev = 0, sl_cur = 0, sl_next = SLOTB;
#define ROT() do { sl_prev = sl_cur; sl_cur = sl_next; sl_next = (sl_next == (NSLOT - 1) * SLOTB) ? 0 : sl_next + SLOTB; } while (0)
    DMA_K(2, 2 * SLOTB);
    WAIT_BAR(3);
    qkt(pA0, pA1, Kbase, qr, negm, r32, hi); asm volatile("s_nop 15\n\ts_nop 7" : "+v"(pA0), "+v"(pA1));
    START(pA0, pA1);
    _Pragma("unroll") for (int r = 0; r < 16; ++r) pA1[r] = __builtin_amdgcn_exp2f(pA1[r]);
    WAIT_BAR(0);
    DMA_K(3, 0); DMA_V(1, SLOTB);
    ROT();
    kload8(kf, kp0 + sl_cur);
    WAIT_BAR(2);
    s16x4 vlo[8], vhi[8]; u32x4 pw0, pw1, pw2, pw3;
#define PKW(P, B) cvtpk_s(P[B], P[B + 1])
#define PAF(k) __builtin_bit_cast(bf16x8, pw##k)
#define VFR(i) (bf16x8){vlo[i][0], vlo[i][1], vlo[i][2], vlo[i][3], vhi[i][0], vhi[i][1], vhi[i][2], vhi[i][3]}
#define PIN(x) asm volatile("" : "+v"(x))
#define MX3(a, b, c) __builtin_fmaxf(__builtin_fmaxf((a), (b)), (c))
#define GAPA(MF, A0, A1, A2, A3, W0, W1, PW) do { MF; sacc += A0; sacc += A1; sacc += A2; sacc += A3; PIN(sacc); W0; W1; PIN(PW); SBAR(); } while (0)
#define EX(v) __builtin_amdgcn_exp2f(v)
#define GAPB(MF, X, B) do { MF; X[B] = EX(X[B]); X[B + 1] = EX(X[B + 1]); X[B + 2] = EX(X[B + 2]); X[B + 3] = EX(X[B + 3]); PIN(X); SBAR(); } while (0)
#define VRD(i) do { vlo[i] = vtr(vp_ + (((i) >> 2) * 4096 + ((i) & 3) * 1024)); vhi[i] = vtr(vp_ + (((i) >> 2) * 4096 + ((i) & 3) * 1024 + 512)); } while (0)
#define KRD(G, j) do { if (G) { kload2(kf, kp0 + sl_next, j); SBAR(); } } while (0)
#define STEP(C0, C1, P0, P1, t, GK, GV, GL) do { SBAR(); \
    const lds_cptr vp_ = vp0 + sl_prev; \
    VRD(0); SBAR(); float sacc = (P0[0] + P0[1]); \
    GAPA(C0 = __builtin_amdgcn_mfma_f32_32x32x16_bf16(kf[0], qr[0], negm, 0, 0, 0), P0[2], P0[3], P0[4], P0[5],     pw0[0] = PKW(P0, 0), pw0[1] = PKW(P0, 2), pw0); \
    VRD(4); SBAR(); GAPA(C1 = __builtin_amdgcn_mfma_f32_32x32x16_bf16(kf[1], qr[0], negm, 0, 0, 0), P0[6], P0[7], P0[8], P0[9],     pw0[2] = PKW(P0, 4), pw0[3] = PKW(P0, 6), pw0); \
    VRD(1); SBAR(); GAPA(C0 = __builtin_amdgcn_mfma_f32_32x32x16_bf16(kf[2], qr[1], C0, 0, 0, 0),   P0[10], P0[11], P0[12], P0[13], pw1[0] = PKW(P0, 8), pw1[1] = PKW(P0, 10), pw1); \
    VRD(5); SBAR(); GAPA(C1 = __builtin_amdgcn_mfma_f32_32x32x16_bf16(kf[3], qr[1], C1, 0, 0, 0),   P0[14], P0[15], P1[0], P1[1],   pw1[2] = PKW(P0, 12), pw1[3] = PKW(P0, 14), pw1); \
    VRD(2); SBAR(); GAPA(C0 = __builtin_amdgcn_mfma_f32_32x32x16_bf16(kf[4], qr[2], C0, 0, 0, 0),   P1[2], P1[3], P1[4], P1[5],     pw2[0] = PKW(P1, 0), pw2[1] = PKW(P1, 2), pw2); \
    VRD(6); SBAR(); GAPA(C1 = __builtin_amdgcn_mfma_f32_32x32x16_bf16(kf[5], qr[2], C1, 0, 0, 0),   P1[6], P1[7], P1[8], P1[9],     pw2[2] = PKW(P1, 4), pw2[3] = PKW(P1, 6), pw2); \
    VRD(3); SBAR(); GAPA(C0 = __builtin_amdgcn_mfma_f32_32x32x16_bf16(kf[6], qr[3], C0, 0, 0, 0),   P1[10], P1[11], P1[12], P1[13], pw3[0] = PKW(P1, 8), pw3[1] = PKW(P1, 10), pw3); \
    VRD(7); SBAR(); GAPA(C1 = __builtin_amdgcn_mfma_f32_32x32x16_bf16(kf[7], qr[3], C1, 0, 0, 0),   P1[14], P1[15], 0.f, 0.f,       pw3[2] = PKW(P1, 12), pw3[3] = PKW(P1, 14), pw3); \
    l_reg += sacc; \
    if (GK) { DMA_K((t) + 3, sl_cur); } if (GV) { DMA_V((t) + 1, sl_next); } \
    CMASK(C0, C1, t); \
    { float a = MX3(C0[0], C0[1], C1[0]), b = MX3(C0[2], C0[3], C1[1]); a = MX3(a, C1[2], C1[3]); \
      _Pragma("unroll") for (int r = 4; r < 16; r += 4) { a = MX3(a, C0[r], C0[r + 1]); b = MX3(b, C0[r + 2], C0[r + 3]); a = MX3(a, C1[r], C1[r + 1]); b = MX3(b, C1[r + 2], C1[r + 3]); } \
      float rm = __builtin_fmaxf(a, b); { auto rr = __builtin_amdgcn_permlane32_swap(__float_as_uint(rm), __float_as_uint(rm), false, false); rm = __builtin_fmaxf(__uint_as_float(rr[0]), __uint_as_float(rr[1])); } \
      resc = false; \
      if (__builtin_expect(__any(rm > (float)THRL), 0)) { const float dl = __builtin_fmaxf(rm, 0.f); mhat += dl; \
        _Pragma("unroll") for (int r = 0; r < 16; ++r) { C0[r] -= dl; C1[r] -= dl; } \
        _Pragma("unroll") for (int r = 0; r < 16; ++r) negm[r] = -mhat; asm volatile("" : "+v"(negm)); \
        const float f = __builtin_amdgcn_exp2f(-dl); l_reg *= f; if (hi == 0) wsf[r32] = f; resc = true; } } \
    SBAR(); \
    GAPB(o[0] = __builtin_amdgcn_mfma_f32_32x32x16_bf16(PAF(0), VFR(0), o[0], 0, 0, 0), C0, 0); \
    GAPB(o[1] = __builtin_amdgcn_mfma_f32_32x32x16_bf16(PAF(0), VFR(4), o[1], 0, 0, 0), C0, 4); \
    KRD(GL, 0); GAPB(o[0] = __builtin_amdgcn_mfma_f32_32x32x16_bf16(PAF(1), VFR(1), o[0], 0, 0, 0), C0, 8); \
    KRD(GL, 1); GAPB(o[1] = __builtin_amdgcn_mfma_f32_32x32x16_bf16(PAF(1), VFR(5), o[1], 0, 0, 0), C0, 12); \
    KRD(GL, 2); GAPB(o[0] = __builtin_amdgcn_mfma_f32_32x32x16_bf16(PAF(2), VFR(2), o[0], 0, 0, 0), C1, 0); \
    KRD(GL, 3); GAPB(o[1] = __builtin_amdgcn_mfma_f32_32x32x16_bf16(PAF(2), VFR(6), o[1], 0, 0, 0), C1, 4); \
    GAPB(o[0] = __builtin_amdgcn_mfma_f32_32x32x16_bf16(PAF(3), VFR(3), o[0], 0, 0, 0), C1, 8); \
    GAPB(o[1] = __builtin_amdgcn_mfma_f32_32x32x16_bf16(PAF(3), VFR(7), o[1], 0, 0, 0), C1, 12); \
    } while (0)
    int t = 1;
#undef CMASK
#define CMASK(P0, P1, t) do { } while (0)
    for (; t + 5 < NT; t += 2) {
        STEP(pB0, pB1, pA0, pA1, t, true, true, true);     WAIT_BAR(2); RESC(); ROT();
        STEP(pA0, pA1, pB0, pB1, t + 1, true, true, true); WAIT_BAR(2); RESC(); ROT();
    }
#undef CMASK
#define CMASK(P0, P1, t) do { int jb_ = (t) - (NT - 4); if (jb_ >= 0) bmask(P0, P1, TKB(t), qrel, hi); } while (0)
#define ENDW(tt) do { if ((tt) + 3 < NT) { WAIT_BAR(2); } else if ((tt) + 2 < NT) { WAIT_BAR(1); } else { WAIT_BAR(0); } } while (0)
    for (; t + 1 < NT; t += 2) {
        STEP(pB0, pB1, pA0, pA1, t, (t + 3 < NT), (t + 1 < NT), (t + 1 < NT));     ENDW(t);     RESC(); ROT();
        STEP(pA0, pA1, pB0, pB1, t + 1, (t + 4 < NT), (t + 2 < NT), (t + 2 < NT)); ENDW(t + 1); RESC(); ROT();
    }
    STEP(pB0, pB1, pA0, pA1, NT - 1, false, false, false); RESC();
    { float sacc = pB0[0] + pB0[1]; _Pragma("unroll") for (int r = 2; r < 16; ++r) sacc += pB0[r]; _Pragma("unroll") for (int r = 0; r < 16; ++r) sacc += pB1[r]; l_reg += sacc;
      pw0 = (u32x4){PKW(pB0, 0), PKW(pB0, 2), PKW(pB0, 4), PKW(pB0, 6)}; pw1 = (u32x4){PKW(pB0, 8), PKW(pB0, 10), PKW(pB0, 12), PKW(pB0, 14)}; pw2 = (u32x4){PKW(pB1, 0), PKW(pB1, 2), PKW(pB1, 4), PKW(pB1, 6)}; pw3 = (u32x4){PKW(pB1, 8), PKW(pB1, 10), PKW(pB1, 12), PKW(pB1, 14)};
      SBAR(); pv(o, vb0 + sl_cur, PAF(0), PAF(1), PAF(2), PAF(3)); }
#undef PKW
#undef PAF
#undef VFR
#undef PIN
#undef MX3
#undef GAPA
#undef GAPB
#undef EX
#undef VRD
#undef KRD
#undef STEP
#undef ENDW
    { auto rr = __builtin_amdgcn_permlane32_swap(__float_as_uint(l_reg), __float_as_uint(l_reg), false, false); l_reg = __uint_as_float(rr[0]) + __uint_as_float(rr[1]); }
    l_reg += __builtin_amdgcn_exp2f(sinkp[head] * 1.4426950408889634f - mhat);
    if (hi == 0) wsf[32 + r32] = l_reg; asm volatile("s_waitcnt lgkmcnt(0)" ::: "memory");
    float rli[16];
#pragma unroll
    for (int r = 0; r < 16; ++r) rli[r] = __builtin_amdgcn_rcpf(wsf[32 + crow(r, hi)]);
    bf16* Ow = O + (rowblk + (wid & 3) * QBLK) * OPITCH + head * D;
    { bf16* stg = (bf16*)(shm + LDS_OST) + wid * 2048;
#pragma unroll
      for (int r = 0; r < 16; ++r) { const int orow = crow(r, hi);
#pragma unroll
        for (int d0 = 0; d0 < 2; ++d0) stg[orow * 64 + d0 * 32 + r32] = __float2bfloat16(o[d0][r] * rli[r]); }
      asm volatile("s_waitcnt lgkmcnt(0)" ::: "memory");
#pragma unroll
      for (int i = 0; i < 4; ++i) { const int row = i * 8 + (lane >> 3), ch = lane & 7; const u32x4 v = *(const u32x4*)(stg + row * 64 + ch * 8); ATTN_STORE16(Ow + (long)row * OPITCH + ch * 8, v); } }
    asm volatile("s_waitcnt lgkmcnt(0)\n\ts_barrier" ::: "memory");
#undef DMA_K
#undef DMA_V
#undef TROW
#undef TKB
#undef CMASK
#undef START
#undef RESC
#undef ROT
}
#undef SBAR
#undef WAIT_BAR
}

#define XB_TMO      128
#define XB_XCNT(j)  (256  + 64 * (j))
#define XB_XSUB(j)  (1280 + 64 * (j))
#define XB_XGEN(j)  (2304 + 64 * (j))
#define XB_TOP      3328
#define XB_TOPGEN   3392
#define XCD_BAR_WORDS 3456
#define XB_SPIN_CAP (1u << 18)
__device__ __forceinline__ unsigned xb_ld(unsigned* p)              { return __hip_atomic_load(p, __ATOMIC_RELAXED, __HIP_MEMORY_SCOPE_AGENT); }
__device__ __forceinline__ unsigned xb_add(unsigned* p, unsigned v) { return __hip_atomic_fetch_add(p, v, __ATOMIC_RELAXED, __HIP_MEMORY_SCOPE_AGENT); }
__device__ __forceinline__ unsigned xb_xcc_id() { return (unsigned)__builtin_amdgcn_s_getreg((3 << 11) | 20) & 0xFu; }
#define XB_SPIN(cond, bar) do { unsigned _sp = 0; while (cond) { __builtin_amdgcn_s_sleep(1); \
    if ((++_sp & 255u) == 0u) { if (xb_ld(&(bar)[XB_TMO])) break; if (_sp > XB_SPIN_CAP) { atomicAdd(&(bar)[XB_TMO], 1u); break; } } } } while (0)
struct XcdBarrier { unsigned* bar; unsigned x; volatile LAS unsigned* st; };
__device__ __forceinline__ XcdBarrier xcd_barrier_post(unsigned* bar, volatile LAS unsigned* st) {
    XcdBarrier b; b.bar = bar; b.x = xb_xcc_id(); b.st = st;
    if (threadIdx.x == 0) (void)xb_add(&bar[XB_XCNT(b.x)], 1u);
    return b;
}
__device__ __forceinline__ void xcd_barrier_complete(unsigned* bar, unsigned x, unsigned& nloc, unsigned& nx) {
    const unsigned G = gridDim.x * gridDim.y * gridDim.z;
    unsigned sum, cnt, mine, sp = 0u;
    for (;;) {
        sum = 0u; cnt = 0u; mine = 0u;
#pragma unroll
        for (unsigned j = 0; j < 16; ++j) { const unsigned c = xb_ld(&bar[XB_XCNT(j)]); sum += c; cnt += (c > 0u) ? 1u : 0u; mine = (j == x) ? c : mine; }
        if (sum == G) break;
        __builtin_amdgcn_s_sleep(1);
        if ((++sp & 255u) == 0u) { if (xb_ld(&bar[XB_TMO])) break; if (sp > XB_SPIN_CAP) { atomicAdd(&bar[XB_TMO], 1u); break; } }
    }
    nloc = mine > 0u ? mine : 1u; nx = cnt > 0u ? cnt : 1u;
}
__device__ __forceinline__ void xcd_barrier(const XcdBarrier& b) {
    asm volatile("s_waitcnt vmcnt(0)" ::: "memory");
    __syncthreads();
    if (threadIdx.x == 0) {
        unsigned* bar = b.bar;
        __builtin_amdgcn_s_waitcnt(0);
        unsigned nloc = b.st[0], nx = b.st[1];
        if (nloc == 0u) { xcd_barrier_complete(bar, b.x, nloc, nx); b.st[0] = nloc; b.st[1] = nx; }
        const unsigned old = xb_add(&bar[XB_XSUB(b.x)], 1u);
        const unsigned gen = old / nloc;
        if (old + 1u == (gen + 1u) * nloc) {
            __builtin_amdgcn_fence(__ATOMIC_RELEASE, "agent");
            asm volatile("s_waitcnt vmcnt(0)" ::: "memory");
            const unsigned og = xb_add(&bar[XB_TOP], 1u);
            const unsigned tg = og / nx;
            if (og + 1u == (tg + 1u) * nx) xb_add(&bar[XB_TOPGEN], 1u);
            else XB_SPIN(xb_ld(&bar[XB_TOPGEN]) == tg, bar);
            __builtin_amdgcn_fence(__ATOMIC_ACQUIRE, "agent");
            xb_add(&bar[XB_XGEN(b.x)], 1u);
            asm volatile("s_waitcnt vmcnt(0)" ::: "memory");
        } else {
            XB_SPIN(xb_ld(&bar[XB_XGEN(b.x)]) == gen, bar);
            __builtin_amdgcn_fence(__ATOMIC_ACQUIRE, "agent");
            asm volatile("s_waitcnt vmcnt(0)" ::: "memory");
        }
    }
    __syncthreads();
}

#define LDS_WAIT() asm volatile("s_waitcnt lgkmcnt(0)" ::: "memory")
__device__ __forceinline__ void transpose_item(const float* W, int K, int N, bf16_t* WT, int k0, int n0, int drow0, LAS float* scr, int lane) {
#pragma unroll 8
    for (int i = 0; i < 32; ++i) { const int kk = 2 * i + (lane >> 5); scr[kk * 33 + (lane & 31)] = W[(size_t)(k0 + kk) * N + n0 + (lane & 31)]; }
    LDS_WAIT(); asm volatile("" ::: "memory");
    const int c = lane & 7;
#pragma unroll
    for (int j = 0; j < 4; ++j) { const int n = (lane >> 3) + 8 * j; const LAS float* s = scr + (8 * c) * 33 + n;
        u32x4 o; o.x = pkbf(s[0 * 33], s[1 * 33]); o.y = pkbf(s[2 * 33], s[3 * 33]); o.z = pkbf(s[4 * 33], s[5 * 33]); o.w = pkbf(s[6 * 33], s[7 * 33]);
        *(GAS u32x4*)(WT + (size_t)(drow0 + n) * K + k0 + 8 * c) = o; }
    LDS_WAIT(); asm volatile("" ::: "memory");
}
__device__ __forceinline__ void sincos_d(double x, double& s, double& c) {
    const double TWO_PI = 6.283185307179586476925;
    const double k = __builtin_rint(x / TWO_PI); const double r = x - k * TWO_PI;
    const double r2 = r * r; double ts = r, tc = 1.0; s = r; c = 1.0;
    for (int i = 1; i <= 16; ++i) { tc *= -r2 / (double)((2 * i - 1) * (2 * i)); ts *= -r2 / (double)((2 * i) * (2 * i + 1)); c += tc; s += ts; }
}

struct Args { const float* in[24]; float* out; unsigned char* ws; int ph_lo, ph_hi; };
constexpr int NPH = 20;

__device__ __forceinline__ void norm_rows(const float* srcL, const float* srcC, int nrows, const float* g, const float* mod, int shc, int scc, bf16_t* XNo, int gw, int NGW, int lane) {
    for (int m = gw; m < nrows; m += NGW) {
        const float* src = m < NLAT ? srcL + (size_t)m * DM : srcC + (size_t)(m - NLAT) * DM; const int mb = m < NLAT ? (m >> 13) : 4;
        const GAS f32x4* xr = (const GAS f32x4*)src + lane;
        f32x4 v[4]; float ss = 0.f;
#pragma unroll
        for (int j = 0; j < 4; ++j) { v[j] = xr[64 * j]; ss += (v[j].x * v[j].x + v[j].y * v[j].y) + (v[j].z * v[j].z + v[j].w * v[j].w); }
        const float rstd = 1.0f / __builtin_sqrtf(wave_sum(ss) * (1.0f / DM) + EPS);
        const float* mrow = mod + (size_t)mb * 6144;
        GAS u32x2* o8 = (GAS u32x2*)(XNo + (size_t)m * DM) + lane;
#pragma unroll
        for (int j = 0; j < 4; ++j) { const f32x4 gv = *(const f32x4*)(g + 4 * lane + 256 * j), sc = *(const f32x4*)(mrow + scc * 1024 + 4 * lane + 256 * j), sh = *(const f32x4*)(mrow + shc * 1024 + 4 * lane + 256 * j);
            const f32x4 y = (v[j] * rstd) * gv * (sc + 1.0f) + sh; u32x2 w; w.x = pkbf(y.x, y.y); w.y = pkbf(y.z, y.w); o8[64 * j] = w; }
    }
}

__global__ void __launch_bounds__(512, 2) fwd(Args args) {
    extern __shared__ __attribute__((aligned(16))) unsigned char lds_raw[];
    LAS unsigned char* lds = (LAS unsigned char*)lds_raw;
    volatile LAS unsigned* MISC = (volatile LAS unsigned*)(lds + MISC_OFF);
    LAS int* gtab = (LAS int*)(lds + GTAB_OFF);
    const int G = gridDim.x; const int bx = blockIdx.x; const int vcu = (G % 8 == 0) ? (bx % 8) * (G / 8) + bx / 8 : bx;
    const int NGW = G * 8;
#define PHASE_IDS() int tid_ = threadIdx.x; asm volatile("" : "+v"(tid_)); const int tid = tid_, lane = tid & 63, wave = __builtin_amdgcn_readfirstlane(tid >> 6), gw = vcu * 8 + wave; (void)lane; (void)gw
    unsigned char* ws = args.ws;
    gu32* ctl = (gu32*)(ws + WS_CTL);
#define MOD ((float*)(ws + WS_MOD))
#define ROPE ((float*)(ws + WS_ROPE))
#define STATS ((float*)(ws + WS_STATS))
#define LIST ((int*)(ws + WS_LIST))
#define TINFO ((int*)(ws + WS_TINFO))
#define WSB ((bf16_t*)(ws + WS_WS))
#define WIN ((bf16_t*)(ws + WS_WIN))
#define WAO ((bf16_t*)(ws + WS_WAO))
#define WQKV ((bf16_t*)(ws + WS_WQKV))
#define WBO ((bf16_t*)(ws + WS_WBO))
#define WGU ((bf16_t*)(ws + WS_WGU))
#define WD ((bf16_t*)(ws + WS_WD))
#define MGU ((bf16_t*)(ws + WS_MGU))
#define MD ((bf16_t*)(ws + WS_MD))
#define XN ((bf16_t*)(ws + WS_XN))
#define ZB ((float*)(ws + WS_ZB))
#define UVT ((bf16_t*)(ws + WS_UVT))
#define A2 ((bf16_t*)(ws + WS_A2))
#define HB ((bf16_t*)(ws + WS_H))
#define QKV ((bf16_t*)(ws + WS_QKV))
#define OB ((bf16_t*)(ws + WS_O))
#define YB ((bf16_t*)(ws + WS_Y))
#define HC ((bf16_t*)(ws + WS_HC))
#define I_X (args.in[0])
#define I_C (args.in[1])
#define I_CTX (args.in[2])
#define I_CCTX (args.in[3])
#define I_ADAW (args.in[4])
#define I_ADAB (args.in[5])
#define I_NORMG (args.in[6])
#define I_FINALG (args.in[7])
#define HL (args.out)

    { PHASE_IDS(); for (int u = tid; u < (LDS_BYTES - MISC_OFF) / 4; u += 512) ((LAS unsigned*)(lds + MISC_OFF))[u] = 0u; }
    __syncthreads();
    const int lo = args.ph_lo, hi_ph = args.ph_hi;
    const bool one_launch = (hi_ph - lo) > 1;
    XcdBarrier bar; bar.bar = (unsigned*)(ctl + CW_BAR); bar.x = 0; bar.st = nullptr;
    if (one_launch) bar = xcd_barrier_post((unsigned*)(ctl + CW_BAR), MISC + 8);
#ifndef PHMASK
#define PHMASK 0xFFFFF
#endif
#define IN(k) (((PHMASK >> (k)) & 1) && lo <= (k) && (k) < hi_ph)
#define BOTH(k) (IN(k) && IN((k) + 1))
#define GRID_BAR() xcd_barrier(bar)

    if (IN(0)) {
        PHASE_IDS();
        {
            LAS float* sv = (LAS float*)lds;
            LAS float* red = (LAS float*)(lds + 5 * 1024 * 4);
            if (bx < 192) {
                for (int idx = tid; idx < 5 * 1024; idx += 512) { const int r = idx >> 10, k = idx & 1023; const float cv = r < 4 ? I_C[r * 1024 + k] : I_CCTX[k]; sv[idx] = cv / (1.0f + __expf(-cv)); }
                __syncthreads();
                for (int item = bx; item < 192; item += G) {
                    const int i = item / 96, n0 = (item % 96) * 64, nn = tid & 63, kq = tid >> 6;
                    float a0 = 0.f, a1 = 0.f, a2 = 0.f, a3 = 0.f, a4 = 0.f;
                    const float* wp = I_ADAW + ((size_t)i * 1024 + kq * 128) * 6144 + n0 + nn;
#pragma unroll 8
                    for (int k = 0; k < 128; ++k) { const float w = wp[(size_t)k * 6144]; const int kk = kq * 128 + k;
                        a0 += sv[kk] * w; a1 += sv[1024 + kk] * w; a2 += sv[2048 + kk] * w; a3 += sv[3072 + kk] * w; a4 += sv[4096 + kk] * w; }
                    red[(kq * 5 + 0) * 64 + nn] = a0; red[(kq * 5 + 1) * 64 + nn] = a1; red[(kq * 5 + 2) * 64 + nn] = a2; red[(kq * 5 + 3) * 64 + nn] = a3; red[(kq * 5 + 4) * 64 + nn] = a4;
                    __syncthreads();
                    if (tid < 320) { const int r = tid >> 6; float s = I_ADAB[i * 6144 + n0 + nn];
#pragma unroll
                        for (int q = 0; q < 8; ++q) s += red[(q * 5 + r) * 64 + nn];
                        MOD[((size_t)i * 5 + r) * 6144 + n0 + nn] = s; }
                    __syncthreads();
                }
            }
            __syncthreads();
        }
        {
            LAS float* scr = (LAS float*)(lds + wave * 16384);
            constexpr int I_IN = 16 * 64, I_AO = 16 * 32, I_QKV = 16 * 48, I_BO = 16 * 32, I_F = 16 * 112, I_FD = 56 * 32;
            constexpr int I_DENSE = I_IN + I_AO + I_QKV + I_BO + 2 * I_F + I_FD, I_MOE = 8 * (2 * I_F + I_FD), I_WS = 128, I_ROPE = 32;
            constexpr int NITEMS = I_DENSE + I_MOE + I_WS + I_ROPE;
            for (int it = gw; it < NITEMS; it += NGW) {
                int r = it;
                if (r < I_IN) { const int kb = r / 64, nb = r % 64; transpose_item(args.in[8], 1024, 2048, WIN, 64 * kb, 32 * nb, 32 * nb, scr, lane); continue; } r -= I_IN;
                if (r < I_AO) { const int kb = r / 32, nb = r % 32; transpose_item(args.in[13], 1024, 1024, WAO, 64 * kb, 32 * nb, 32 * nb, scr, lane); continue; } r -= I_AO;
                if (r < I_QKV) { const int kb = r / 48, nb = r % 48; transpose_item(args.in[14], 1024, 1536, WQKV, 64 * kb, 32 * nb, 32 * nb, scr, lane); continue; } r -= I_QKV;
                if (r < I_BO) { const int kb = r / 32, nb = r % 32; transpose_item(args.in[16], 1024, 1024, WBO, 64 * kb, 32 * nb, 32 * nb, scr, lane); continue; } r -= I_BO;
                if (r < 2 * I_F) { const int up = r / I_F; const int q = r % I_F; const int kb = q / 112, nb = q % 112, n0 = 32 * nb;
                    transpose_item(args.in[17 + up], 1024, DFF, WGU, 64 * kb, n0, 256 * (n0 >> 7) + 128 * up + (n0 & 127), scr, lane); continue; } r -= 2 * I_F;
                if (r < I_FD) { const int kb = r / 32, nb = r % 32; transpose_item(args.in[19], DFF, 1024, WD, 64 * kb, 32 * nb, 32 * nb, scr, lane); continue; } r -= I_FD;
                if (r < I_MOE) { const int e = r / (2 * I_F + I_FD); int q = r % (2 * I_F + I_FD);
                    if (q < 2 * I_F) { const int up = q / I_F; q %= I_F; const int kb = q / 112, nb = q % 112, n0 = 32 * nb;
                        transpose_item(args.in[21 + up] + (size_t)e * 1024 * DFF, 1024, DFF, MGU + (size_t)e * 7168 * 1024, 64 * kb, n0, 256 * (n0 >> 7) + 128 * up + (n0 & 127), scr, lane); }
                    else { q -= 2 * I_F; const int kb = q / 32, nb = q % 32; transpose_item(args.in[23] + (size_t)e * DFF * 1024, DFF, 1024, MD + (size_t)e * 1024 * DFF, 64 * kb, 32 * nb, 32 * nb, scr, lane); }
                    continue; } r -= I_MOE;
                if (r < I_WS) { const float* src = args.in[11] + (size_t)r * 2048;
#pragma unroll
                    for (int j = 0; j < 8; ++j) { const f32x4 v = *(const f32x4*)(src + j * 256 + lane * 4); u32x2 w; w.x = pkbf(v.x, v.y); w.y = pkbf(v.z, v.w); *(u32x2*)(WSB + (size_t)r * 2048 + j * 256 + lane * 4) = w; }
                    continue; } r -= I_WS;
                {
                    const int ent = r * 64 + lane; const int pos = ent >> 4, i = ent & 15;
                    double inv = 1.0; for (int q = 0; q < i; ++q) inv *= 0.56234132519034908;
                    const float ang = (float)pos * (float)inv; double s, c; sincos_d((double)ang, s, c);
                    ROPE[ent] = (float)c; ROPE[2048 + ent] = (float)s;
                }
            }
        }
        if (BOTH(0)) GRID_BAR();
    }
    if (IN(1)) { PHASE_IDS(); norm_rows(I_X, I_CTX, MALL, I_NORMG + 0 * 1024, MOD, 0, 1, XN, gw, NGW, lane); if (BOTH(1)) GRID_BAR(); }
    if (IN(2)) {
        pg8::DenseSched S{(const char*)WIN, (const char*)XN, 8, NPA, G, bx, (size_t)256 * 1024 * 2};
        pg8::EpiGeluT E{UVT, STATS};
        pg8::gemm_phase<pg8::EpiGeluT, pg8::DenseSched, true, false>(lds, gtab, 1024, S, E);
        if (BOTH(2)) GRID_BAR();
    }
    if (IN(3)) {
        PHASE_IDS();
        const float* vg = args.in[9]; const float* vb = args.in[10]; const float* bs = args.in[12];
        LAS float* mu_l = (LAS float*)(lds + wave * 1024); LAS float* rs_l = mu_l + 128;
        const int r32 = lane & 31, h = lane >> 5;
        for (int unit = gw; unit < (MALL / 128) * 16; unit += NGW) {
            const int ch = unit >> 4, g = unit & 15, q0 = ch * 128;
#pragma unroll
            for (int tt = 0; tt < 2; ++tt) { const int tok = q0 + lane * 2 + tt; const f32x4* sp = (const f32x4*)(STATS + (size_t)tok * 16);
                const f32x4 a = sp[0], b = sp[1], c = sp[2], d = sp[3];
                const float sum = (a.x + a.z) + (b.x + b.z) + (c.x + c.z) + (d.x + d.z), sq = (a.y + a.w) + (b.y + b.w) + (c.y + c.w) + (d.y + d.w);
                const float mean = sum * (1.0f / 1024.0f), var = sq * (1.0f / 1024.0f) - mean * mean;
                mu_l[lane * 2 + tt] = mean; rs_l[lane * 2 + tt] = 1.0f / __builtin_sqrtf(var + EPS); }
            float vgc[2], vbc[2];
#pragma unroll
            for (int ct = 0; ct < 2; ++ct) { vgc[ct] = vg[64 * g + 32 * ct + r32]; vbc[ct] = vb[64 * g + 32 * ct + r32]; }
            f32x16 acc[2][4];
#pragma unroll
            for (int ct = 0; ct < 2; ++ct)
#pragma unroll
                for (int pt = 0; pt < 4; ++pt) acc[ct][pt] = f32x16{};
#pragma unroll 2
            for (int s = 0; s < 8; ++s) {
                const int qs = 16 * s + 8 * h;
                const f32x4 m0 = *(const LAS f32x4*)(mu_l + qs), m1 = *(const LAS f32x4*)(mu_l + qs + 4), r0 = *(const LAS f32x4*)(rs_l + qs), r1 = *(const LAS f32x4*)(rs_l + qs + 4);
                bf16x8 af[2], bfr[4];
#pragma unroll
                for (int ct = 0; ct < 2; ++ct) { const bf16x8 raw = *(const bf16x8*)(UVT + (size_t)(1024 + 64 * g + 32 * ct + r32) * MALL + q0 + qs);
                    float y[8];
#pragma unroll
                    for (int j = 0; j < 4; ++j) { y[j] = (bf2f((unsigned short)raw[j]) - m0[j]) * r0[j] * vgc[ct] + vbc[ct]; y[4 + j] = (bf2f((unsigned short)raw[4 + j]) - m1[j]) * r1[j] * vgc[ct] + vbc[ct]; }
                    u32x4 w; w.x = pkbf(y[0], y[1]); w.y = pkbf(y[2], y[3]); w.z = pkbf(y[4], y[5]); w.w = pkbf(y[6], y[7]); af[ct] = __builtin_bit_cast(bf16x8, w); }
#pragma unroll
                for (int pt = 0; pt < 4; ++pt) bfr[pt] = *(const bf16x8*)(WSB + (size_t)(g * 128 + 32 * pt + r32) * 128 + qs);
#pragma unroll
                for (int ct = 0; ct < 2; ++ct)
#pragma unroll
                    for (int pt = 0; pt < 4; ++pt) acc[ct][pt] = __builtin_amdgcn_mfma_f32_32x32x16_bf16(af[ct], bfr[pt], acc[ct][pt], 0, 0, 0);
            }
#pragma unroll
            for (int pt = 0; pt < 4; ++pt) { const int p = 32 * pt + r32; const size_t tokp = (size_t)q0 + p; const float bsv = bs[g * 128 + p];
#pragma unroll
                for (int ct = 0; ct < 2; ++ct)
#pragma unroll
                    for (int rr = 0; rr < 4; ++rr) { const int c = 64 * g + 32 * ct + 8 * rr + 4 * h; float o[4];
#pragma unroll
                        for (int e = 0; e < 4; ++e) { const float uu = bf2f(UVT[(size_t)(c + e) * MALL + tokp]); o[e] = uu * (acc[ct][pt][4 * rr + e] + bsv); }
                        u32x2 w; w.x = pkbf(o[0], o[1]); w.y = pkbf(o[2], o[3]); *(u32x2*)(A2 + tokp * DM + c) = w; } }
        }
        if (BOTH(3)) GRID_BAR();
    }
    if (IN(4)) {
        pg8::DenseSched S{(const char*)A2, (const char*)WAO, NPA, 4, G, bx, (size_t)256 * 1024 * 2};
        pg8::EpiResid E{I_X, I_CTX, HL, ZB, MOD + 2 * 1024};
        pg8::gemm_phase<pg8::EpiResid, pg8::DenseSched, true, false>(lds, gtab, 1024, S, E);
        if (BOTH(4)) GRID_BAR();
    }
    if (IN(5)) { PHASE_IDS(); norm_rows(HL, ZB, MALL, I_NORMG + 1 * 1024, MOD, 3, 4, XN, gw, NGW, lane); if (BOTH(5)) GRID_BAR(); }
    if (IN(6)) {
        pg8::DenseSched S{(const char*)XN, (const char*)WGU, NPA, 28, G, bx, (size_t)256 * 1024 * 2};
        pg8::EpiSwiGLU E{HB};
        pg8::gemm_phase<pg8::EpiSwiGLU, pg8::DenseSched, true, false>(lds, gtab, 1024, S, E);
        if (BOTH(6)) GRID_BAR();
    }
    if (IN(7)) {
        pg8::DenseSched S{(const char*)HB, (const char*)WD, NPA, 4, G, bx, (size_t)256 * DFF * 2};
        pg8::EpiResid E{HL, ZB, HL, ZB, MOD + 5 * 1024};
        pg8::gemm_phase<pg8::EpiResid, pg8::DenseSched, true, false>(lds, gtab, DFF, S, E);
        if (BOTH(7)) GRID_BAR();
    }
    if (IN(8)) { PHASE_IDS(); norm_rows(HL, ZB, MALL, I_NORMG + 2 * 1024, MOD + 5 * 6144, 0, 1, XN, gw, NGW, lane); if (BOTH(8)) GRID_BAR(); }
    if (IN(9)) {
        pg8::DenseSched S{(const char*)XN, (const char*)WQKV, NPA, 6, G, bx, (size_t)256 * 1024 * 2};
        pg8::EpiQKV E{QKV, ROPE, ROPE + 2048, attn_body::C2};
        pg8::gemm_phase<pg8::EpiQKV, pg8::DenseSched, true, false>(lds, gtab, 1024, S, E);
        if (BOTH(9)) GRID_BAR();
    }
    if (IN(10)) {
        static_assert(attn_body::LDS_BYTES_A <= RING_BYTES, "attention LDS");
        const float* sinkp = args.in[15];
        for (int i = 0;; ++i) { const int uid = i * G + vcu; if (uid >= NB * 64 * 4 * 2) break;
            const int pr = uid & 1, hk = (uid >> 1) & 3, n = (uid >> 3) & 63, b = uid >> 9;
            attn_body::attn_unit<8>(b, hk, n, pr, (const attn_body::bf16*)QKV, (attn_body::bf16*)OB, sinkp, (char*)lds_raw); }
        if (BOTH(10)) GRID_BAR();
    }
    if (IN(11)) {
        pg8::DenseSched S{(const char*)OB, (const char*)WBO, NPL, 4, G, bx, (size_t)256 * 1024 * 2};
        pg8::EpiResid E{HL, ZB, HL, ZB, MOD + 5 * 6144 + 2 * 1024};
        pg8::gemm_phase<pg8::EpiResid, pg8::DenseSched, true, false>(lds, gtab, 1024, S, E);
        if (BOTH(11)) GRID_BAR();
    }
    if (IN(12)) {
        PHASE_IDS();
        const float* g = I_NORMG + 3 * 1024; const float* mod = MOD + 5 * 6144; const float* wrt = args.in[20];
        LAS int* l_e = (LAS int*)lds;
        LAS float* l_w = (LAS float*)(lds + 1024);
        LAS int* l_cnt = (LAS int*)(lds + 2048);
        LAS int* l_base = (LAS int*)(lds + 2048 + 64);
        for (int blk = bx; blk < NLAT / 128; blk += G) {
            if (tid < 8) l_cnt[tid] = 0;
            __syncthreads();
            for (int i = 0; i < 16; ++i) {
                const int tl = wave * 16 + i, m = blk * 128 + tl; const int mb = m >> 13;
                const GAS f32x4* xr = (const GAS f32x4*)(HL + (size_t)m * DM) + lane;
                f32x4 v[4]; float ss = 0.f;
#pragma unroll
                for (int j = 0; j < 4; ++j) { v[j] = xr[64 * j]; ss += (v[j].x * v[j].x + v[j].y * v[j].y) + (v[j].z * v[j].z + v[j].w * v[j].w); }
                const float rstd = 1.0f / __builtin_sqrtf(wave_sum(ss) * (1.0f / DM) + EPS);
                const float* mrow = mod + (size_t)mb * 6144;
                GAS u32x2* o8 = (GAS u32x2*)(XN + (size_t)m * DM) + lane;
                float lg[8];
#pragma unroll
                for (int e = 0; e < 8; ++e) lg[e] = 0.f;
#pragma unroll
                for (int j = 0; j < 4; ++j) { const int col = 4 * lane + 256 * j; const f32x4 gv = *(const f32x4*)(g + col), sc = *(const f32x4*)(mrow + 4 * 1024 + col), sh = *(const f32x4*)(mrow + 3 * 1024 + col);
                    const f32x4 y = (v[j] * rstd) * gv * (sc + 1.0f) + sh; u32x2 w; w.x = pkbf(y.x, y.y); w.y = pkbf(y.z, y.w); o8[64 * j] = w;
#pragma unroll
                    for (int cc = 0; cc < 4; ++cc) { const f32x4 w0 = *(const f32x4*)(wrt + (size_t)(col + cc) * 8), w1 = *(const f32x4*)(wrt + (size_t)(col + cc) * 8 + 4);
                        lg[0] += y[cc] * w0.x; lg[1] += y[cc] * w0.y; lg[2] += y[cc] * w0.z; lg[3] += y[cc] * w0.w; lg[4] += y[cc] * w1.x; lg[5] += y[cc] * w1.y; lg[6] += y[cc] * w1.z; lg[7] += y[cc] * w1.w; } }
#pragma unroll
                for (int e = 0; e < 8; ++e) lg[e] = wave_sum(lg[e]);
                int ea = 0; float va = lg[0];
#pragma unroll
                for (int e = 1; e < 8; ++e) if (lg[e] > va) { va = lg[e]; ea = e; }
                int eb = -1; float vb2 = -INFINITY;
#pragma unroll
                for (int e = 0; e < 8; ++e) if (e != ea && lg[e] > vb2) { vb2 = lg[e]; eb = e; }
                const float wb = 1.0f / (1.0f + __expf(va - vb2)), wa = 1.0f - wb;
                if (lane == 0) { l_e[tl * 2] = ea; l_e[tl * 2 + 1] = eb; l_w[tl * 2] = wa; l_w[tl * 2 + 1] = wb; }
            }
            __syncthreads();
            int ea = 0, eb = 0, pa = 0, pb = 0;
            if (tid < 128) { ea = l_e[tid * 2]; eb = l_e[tid * 2 + 1]; pa = atomicAdd((int*)&l_cnt[ea], 1); pb = atomicAdd((int*)&l_cnt[eb], 1); }
            __syncthreads();
            if (tid < 8) l_base[tid] = (int)__hip_atomic_fetch_add((unsigned*)(ctl + CW_CNT + 64 * tid), (unsigned)l_cnt[tid], __ATOMIC_RELAXED, __HIP_MEMORY_SCOPE_AGENT);
            __syncthreads();
            if (tid < 128) { const int m = blk * 128 + tid; pa += l_base[ea]; pb += l_base[eb];
                LIST[(size_t)ea * NLAT + pa] = m; LIST[(size_t)eb * NLAT + pb] = m;
                int* ti = TINFO + (size_t)m * 8; ti[0] = ea; ti[1] = pa; ti[2] = eb; ti[3] = pb; ti[4] = __float_as_int(l_w[tid * 2]); ti[5] = __float_as_int(l_w[tid * 2 + 1]); }
            __syncthreads();
        }
        if (BOTH(12)) GRID_BAR();
    }
    if (hi_ph > 13 && lo < 19) {
        PHASE_IDS();
        LAS int* mtab = (LAS int*)(lds + MOE_OFF);
        if (tid == 0) { int run = 0;
            for (int e = 0; e < 8; ++e) { const int ce = (int)__hip_atomic_load((unsigned*)(ctl + CW_CNT + 64 * e), __ATOMIC_RELAXED, __HIP_MEMORY_SCOPE_AGENT); mtab[e] = run; mtab[16 + e] = ce; run += (ce + 255) >> 8; }
            mtab[8] = run; }
        __syncthreads();
        const int ptot = __builtin_amdgcn_readfirstlane(mtab[8]);
        for (int c = 0; c < MOE_NCH; ++c) {
            const int gp0 = c * MOE_CH, gp1 = ptot < (c + 1) * MOE_CH ? ptot : (c + 1) * MOE_CH;
            if (IN(13 + 2 * c)) {
                pg8::MoeSched S; S.A = (const char*)XN; S.B = (const char*)MGU; S.list = LIST; S.tab = mtab;
                S.gp0 = gp0; S.gp1 = gp1; S.nN = 28; S.G = G; S.c = bx; S.bexp = (size_t)7168 * 1024 * 2; S.btile = (size_t)256 * 1024 * 2; S.astep = 0; S.gather = true;
                pg8::EpiSwiGLU E{HC};
                pg8::gemm_phase<pg8::EpiSwiGLU, pg8::MoeSched, true, true>(lds, gtab, 1024, S, E);
                if (BOTH(13 + 2 * c)) GRID_BAR();
            }
            if (IN(14 + 2 * c)) {
                pg8::MoeSched S; S.A = (const char*)HC; S.B = (const char*)MD; S.list = LIST; S.tab = mtab;
                S.gp0 = gp0; S.gp1 = gp1; S.nN = 4; S.G = G; S.c = bx; S.bexp = (size_t)1024 * DFF * 2; S.btile = (size_t)256 * DFF * 2; S.astep = (size_t)256 * DFF * 2; S.gather = false;
                pg8::EpiBf16Plain E{YB, DM};
                pg8::gemm_phase<pg8::EpiBf16Plain, pg8::MoeSched, true, false>(lds, gtab, DFF, S, E);
                if (BOTH(14 + 2 * c)) GRID_BAR();
            }
        }
    }
    if (IN(19)) {
        PHASE_IDS();
        LAS int* l_pb = (LAS int*)(lds + wave * 64);
        { int run = 0;
#pragma unroll
          for (int e = 0; e < 8; ++e) { if (lane == 0) l_pb[e] = run; const int ce = (int)__builtin_amdgcn_readfirstlane(__hip_atomic_load((unsigned*)(ctl + CW_CNT + 64 * e), __ATOMIC_RELAXED, __HIP_MEMORY_SCOPE_AGENT)); run += (ce + 255) >> 8; } }
        const float* g2 = MOD + 5 * 6144 + 5 * 1024;
        for (int m = gw; m < NLAT; m += NGW) {
            const int mb = m >> 13; const int* ti = TINFO + (size_t)m * 8;
            const int ea = ti[0], pa = ti[1], eb = ti[2], pb = ti[3]; const float wa = __int_as_float(ti[4]), wb = __int_as_float(ti[5]);
            const size_t sa = (size_t)l_pb[ea] * 256 + pa, sb = (size_t)l_pb[eb] * 256 + pb;
            const GAS f32x4* xr = (const GAS f32x4*)(HL + (size_t)m * DM) + lane;
            const GAS u32x2* ya = (const GAS u32x2*)(YB + sa * DM) + lane; const GAS u32x2* yb = (const GAS u32x2*)(YB + sb * DM) + lane;
            f32x4 v[4]; float ss = 0.f;
#pragma unroll
            for (int j = 0; j < 4; ++j) { const f32x4 hv = xr[64 * j]; const u32x2 a = ya[64 * j], b = yb[64 * j]; const f32x4 gv = *(const f32x4*)(g2 + (size_t)mb * 6144 + 4 * lane + 256 * j);
                f32x4 y; y.x = wa * __uint_as_float(a.x << 16) + wb * __uint_as_float(b.x << 16); y.y = wa * __uint_as_float(a.x & 0xffff0000u) + wb * __uint_as_float(b.x & 0xffff0000u);
                y.z = wa * __uint_as_float(a.y << 16) + wb * __uint_as_float(b.y << 16); y.w = wa * __uint_as_float(a.y & 0xffff0000u) + wb * __uint_as_float(b.y & 0xffff0000u);
                v[j] = hv + gv * y; ss += (v[j].x * v[j].x + v[j].y * v[j].y) + (v[j].z * v[j].z + v[j].w * v[j].w); }
            const float rstd = 1.0f / __builtin_sqrtf(wave_sum(ss) * (1.0f / DM) + EPS);
            GAS f32x4* orow = (GAS f32x4*)(args.out + (size_t)m * DM) + lane;
#pragma unroll
            for (int j = 0; j < 4; ++j) { const f32x4 fg = *(const f32x4*)(I_FINALG + 4 * lane + 256 * j); orow[64 * j] = (v[j] * rstd) * fg; }
        }
    }
#undef IN
#undef BOTH
#undef GRID_BAR
}

#ifndef MK_ONE_LAUNCH
#define MK_ONE_LAUNCH 1
#endif
extern "C" void kernel_launch(void* const* d_in, const int* in_sizes, int n_in, void* d_out, int out_size, void* d_ws, size_t ws_size, hipStream_t stream) {
    static int grid = 0;
    if (grid == 0) {
        if (n_in != 24 || out_size != NLAT * DM || ws_size < WS_END) { fprintf(stderr, "kernel_launch: unexpected problem (n_in %d, out %d, ws %zu < %zu)\n", n_in, out_size, ws_size, (size_t)WS_END); grid = -1; return; }
        int dev = 0, cus = 0, per_cu = 0;
        if (hipGetDevice(&dev) != hipSuccess || hipDeviceGetAttribute(&cus, hipDeviceAttributeMultiprocessorCount, dev) != hipSuccess) { grid = -1; return; }
        if (hipFuncSetAttribute((const void*)fwd, hipFuncAttributeMaxDynamicSharedMemorySize, LDS_BYTES) != hipSuccess) { fprintf(stderr, "kernel_launch: hipFuncSetAttribute failed\n"); grid = -1; return; }
        if (hipOccupancyMaxActiveBlocksPerMultiprocessor(&per_cu, (const void*)fwd, 512, LDS_BYTES) != hipSuccess || per_cu < 1) fprintf(stderr, "kernel_launch: occupancy query says %d\n", per_cu);
        (void)hipGetLastError();
        grid = cus;
    }
    if (grid < 0) return;
    if (hipMemsetAsync((char*)d_ws + WS_CTL, 0, CTL_ZERO_BYTES, stream) != hipSuccess) return;
    Args a{};
    for (int i = 0; i < 24; ++i) a.in[i] = (const float*)d_in[i];
    a.out = (float*)d_out; a.ws = (unsigned char*)d_ws;
#if MK_ONE_LAUNCH
    a.ph_lo = 0; a.ph_hi = NPH;
    hipLaunchKernelGGL(fwd, dim3(grid), dim3(512), LDS_BYTES, stream, a);
#else
    for (int p = 0; p < NPH; ++p) { a.ph_lo = p; a.ph_hi = p + 1; hipLaunchKernelGGL(fwd, dim3(grid), dim3(512), LDS_BYTES, stream, a); }
#endif
}
```

```cpp
#include <hip/hip_runtime.h>
#include <hip/hip_bf16.h>
#include <cstdio>
#include <cstdint>
#include <cmath>

constexpr int DM = 1024, NB = 4, SEQ = 8192, LCTX = 256, NLAT = NB * SEQ, NCTXR = NB * LCTX, MALL = NLAT + NCTXR;
constexpr int DFF = 3584, NEXP = 8, NQKV = 1536;
constexpr int NPL = NLAT / 256, NPA = MALL / 256;
constexpr float EPS = 1e-6f;
constexpr int MOE_CH = 64, MOE_NCH = 4;
constexpr int MOE_RS = 7, P3_NS = 8, P5_NS = 14;

#define LAS __attribute__((address_space(3)))
#define GAS __attribute__((address_space(1)))
typedef unsigned short bf16_t;
typedef short bf16x8 __attribute__((ext_vector_type(8)));
typedef float f32x4 __attribute__((ext_vector_type(4)));
typedef float f32x2 __attribute__((ext_vector_type(2)));
typedef float f32x16 __attribute__((ext_vector_type(16)));
typedef unsigned u32x4 __attribute__((ext_vector_type(4)));
typedef unsigned u32x2 __attribute__((ext_vector_type(2)));
typedef __bf16 bf16x2_t __attribute__((ext_vector_type(2)));
typedef GAS unsigned gu32;

__device__ __forceinline__ unsigned pkbf(float lo, float hi) { f32x2 v = {lo, hi}; bf16x2_t b = __builtin_convertvector(v, bf16x2_t); return __builtin_bit_cast(unsigned, b); }
__device__ __forceinline__ float bf2f(unsigned short h) { return __builtin_bit_cast(float, (unsigned)h << 16); }
__device__ __forceinline__ float wave_sum(float v) {
#pragma unroll
    for (int o = 1; o < 64; o <<= 1) v += __shfl_xor(v, o);
    return v;
}
__device__ __forceinline__ float gelu_tanh(float x) {
    const float t = x * (1.0f + 0.044715f * x * x);
    const float e = __builtin_amdgcn_exp2f(-2.302208198f * t);
    return x * __builtin_amdgcn_rcpf(1.0f + e);
}
__device__ __forceinline__ float silu_f(float x) { return x * __builtin_amdgcn_rcpf(1.0f + __builtin_amdgcn_exp2f(-1.4426950409f * x)); }

constexpr size_t MiB = 1u << 20;
constexpr size_t WS_CTL = 0, CTL_ZERO_BYTES = 1 * MiB;
constexpr size_t WS_MOD = 1 * MiB;
constexpr size_t WS_ROPE = 1 * MiB + 256 * 1024;
constexpr size_t WS_STATS = 2 * MiB;
constexpr size_t WS_LIST = 5 * MiB;
constexpr size_t WS_TINFO = 6 * MiB;
constexpr size_t WS_WS = 7 * MiB;
constexpr size_t WS_WIN = 8 * MiB, WS_WAO = 12 * MiB, WS_WQKV = 14 * MiB, WS_WBO = 17 * MiB, WS_WGU = 19 * MiB, WS_WD = 33 * MiB;
constexpr size_t WS_MGU = 40 * MiB, WS_MD = 152 * MiB;
constexpr size_t WS_XN = 208 * MiB;
constexpr size_t WS_ZB = 274 * MiB;
constexpr size_t WS_R = 278 * MiB;
constexpr size_t WS_UVT = WS_R, WS_A2 = WS_R + 132 * MiB, WS_PART1 = WS_R + 198 * MiB, WS_H = WS_R, WS_PART2 = WS_R + 231 * MiB;
constexpr size_t WS_QKV = WS_R, WS_O = WS_R + 99 * MiB;
constexpr size_t WS_Y = WS_R, WS_YP = WS_R + 128 * MiB, WS_HC = WS_R + 156 * MiB;
constexpr size_t WS_END = WS_R + 287 * MiB;
static_assert(WS_UVT + (size_t)2048 * MALL * 2 <= WS_A2 && WS_A2 + (size_t)MALL * DM * 2 <= WS_PART1 && WS_PART1 + (size_t)P3_NS * NCTXR * DM * 4 <= WS_END, "layer-0 mixer map");
static_assert(WS_H + (size_t)MALL * DFF * 2 <= WS_PART2 && WS_PART2 + (size_t)P5_NS * NCTXR * DM * 4 <= WS_END && WS_QKV + (size_t)MALL * NQKV * 2 <= WS_O && WS_O + (size_t)NLAT * DM * 2 <= WS_END, "region map");
static_assert(WS_Y + (size_t)256 * 256 * DM * 2 <= WS_YP && WS_YP + (size_t)MOE_RS * 8 * 256 * DM * 2 <= WS_HC && WS_HC + (size_t)MOE_CH * 256 * DFF * 2 <= WS_END, "MoE map");
static_assert(WS_XN + (size_t)MALL * DM * 2 <= WS_ZB && WS_MD + (size_t)8 * DM * DFF * 2 <= WS_XN && WS_MGU + (size_t)8 * 7168 * DM * 2 <= WS_MD, "weights map");
constexpr int CW_TMO = 0, CW_CODE = 1;
constexpr int CW_CNT = 64;
constexpr int CW_BAR = 4096;

constexpr int RING_BYTES = 131072;
constexpr int GTAB_OFF = RING_BYTES;
constexpr int MOE_OFF = RING_BYTES + 1024;
constexpr int MISC_OFF = RING_BYTES + 2048;
constexpr int LDS_BYTES = 147456;

namespace pg8 {
constexpr int BM = 256, BK = 64, HALF = 128, HTB = HALF * BK * 2, STAGE_BYTES = 8 * HTB, NXCD = 8, WGM = 8;
__host__ __device__ __forceinline__ int lds_byte(int r, int c) { const int st = (r >> 4) * 2 + (c >> 5), rr = r & 15, cc = c & 31, ob = rr * 64 + cc * 2; return st * 1024 + (ob ^ (((ob >> 9) & 1) << 5)); }
__host__ __device__ __forceinline__ void stage_rc(int b, int& R, int& C) { const int st = b / 1024, sb = b % 1024, swz = sb ^ (((sb >> 9) & 1) << 5); R = (st >> 1) * 16 + swz / 64; C = (st & 1) * 32 + (swz % 64) / 2; }
__host__ __device__ __forceinline__ int perm32(int rho) { const int n = rho >> 4, i = rho & 15; return 8 * (i >> 2) + 4 * n + (i & 3); }

struct Unit { const char* a; const char* b; const int* gl; int pm, pn, om, nv, ks; };

__device__ __forceinline__ bool tile_order(int i, int G, int c, int nM, int nN, int& pm, int& pn) {
    const int nwg = nM * nN; const long L = (long)i * G + c; if (L >= nwg) return false;
    int wgid = (int)L; { const int q = nwg / NXCD, r = nwg % NXCD, xcd = wgid % NXCD, off = wgid / NXCD; wgid = (xcd < r ? xcd * (q + 1) : r * (q + 1) + (xcd - r) * q) + off; }
    const int nig = WGM * nN, gid = wgid / nig, fm = gid * WGM, gsz = (nM - fm) < WGM ? (nM - fm) : WGM;
    pm = fm + ((wgid % nig) % gsz); pn = (wgid % nig) / gsz; return true;
}
struct DenseSched {
    const char* A; const char* B; int nM, nN, G, c; size_t tstep;
    __device__ __forceinline__ bool next(int i, Unit& u) const {
        int pm, pn; if (!tile_order(i, G, c, nM, nN, pm, pn)) return false;
        u.a = A + (size_t)pm * tstep; u.b = B + (size_t)pn * tstep; u.gl = nullptr; u.pm = pm; u.pn = pn; u.om = pm; u.nv = 256; u.ks = 0; return true;
    }
};
struct SplitSched {
    const char* A; const char* B; int nM, nN, nS, G, c, pm0; size_t tstep, kbytes;
    __device__ __forceinline__ bool next(int i, Unit& u) const {
        const int L = i * G + c; if (L >= nM * nN * nS) return false;
        const int ks = L % nS, t = L / nS, pn = t % nN, pm = t / nN;
        u.a = A + (size_t)pm * tstep + (size_t)ks * kbytes; u.b = B + (size_t)pn * tstep + (size_t)ks * kbytes; u.gl = nullptr; u.pm = pm0 + pm; u.pn = pn; u.om = pm; u.nv = 256; u.ks = ks; return true;
    }
};
struct MoeSched {
    const char* A; const char* B; const int* list; const LAS int* tab; int gp0, gp1, nN, nS, G, c, mode; size_t bexp, btile, astep, kbytes; bool gather;
    __device__ __forceinline__ bool next(int i, Unit& u) const {
        int pm, pn, ks = 0;
        if (mode == 0) { if (gp1 <= gp0) return false; if (!tile_order(i, G, c, gp1 - gp0, nN, pm, pn)) return false; }
        else { const int R = __builtin_amdgcn_readfirstlane(tab[32]); const int L = i * G + c; if (L >= R * nN * nS) return false; ks = L % nS; const int t = L / nS; pn = t % nN; pm = t / nN; }
        int e = 0, lp, nv;
        if (mode == 0) { const int gp = gp0 + pm;
#pragma unroll
            for (int k = 1; k < 8; ++k) e += (gp >= __builtin_amdgcn_readfirstlane(tab[k])) ? 1 : 0;
            lp = gp - __builtin_amdgcn_readfirstlane(tab[e]); nv = 256; u.pm = gp; }
        else { e = __builtin_amdgcn_readfirstlane(tab[24 + pm]); const int ce = __builtin_amdgcn_readfirstlane(tab[16 + e]); lp = ce >> 8; nv = ce & 255; u.pm = pm; }
        u.b = B + (size_t)e * bexp + (size_t)pn * btile + (size_t)ks * kbytes; u.pn = pn; u.nv = nv; u.ks = ks; u.om = pm;
        if (gather) { u.a = A; u.gl = list + (size_t)e * NLAT + 256 * lp; }
        else { u.a = A + (size_t)pm * astep + (size_t)ks * kbytes; u.gl = nullptr; if (mode == 0) u.om = gp0 + pm; }
        return true;
    }
};

struct EpiGeluT {
    static constexpr bool PERM = true;
    bf16_t* O; float* stats;
    __device__ __forceinline__ void operator()(const f32x4 (&acc)[2][2][4][2], const Unit& u, int wr, int wc, int fr, int fq) const {
        const int row0 = u.pm * BM + wr * 64 + fr, col0 = u.pn * BM + wc * 32 + 8 * fq;
        const bool isv = u.pm >= 4;
        float s1[2][2][4], s2[2][2][4];
#pragma unroll
        for (int bj = 0; bj < 2; ++bj)
#pragma unroll
            for (int n = 0; n < 2; ++n)
#pragma unroll
                for (int e = 0; e < 4; ++e) { s1[bj][n][e] = 0.f; s2[bj][n][e] = 0.f; }
#pragma unroll
        for (int ai = 0; ai < 2; ++ai)
#pragma unroll
            for (int m = 0; m < 4; ++m) { bf16_t* rowp = O + (size_t)(row0 + ai * HALF + m * 16) * MALL + col0;
#pragma unroll
                for (int bj = 0; bj < 2; ++bj) { f32x4 v0 = acc[ai][bj][m][0], v1 = acc[ai][bj][m][1];
#pragma unroll
                    for (int e = 0; e < 4; ++e) { v0[e] = gelu_tanh(v0[e]); v1[e] = gelu_tanh(v1[e]); s1[bj][0][e] += v0[e]; s2[bj][0][e] += v0[e] * v0[e]; s1[bj][1][e] += v1[e]; s2[bj][1][e] += v1[e] * v1[e]; }
                    u32x4 w; w.x = pkbf(v0[0], v0[1]); w.y = pkbf(v0[2], v0[3]); w.z = pkbf(v1[0], v1[1]); w.w = pkbf(v1[2], v1[3]);
                    *(u32x4*)(rowp + bj * HALF) = w; } }
        if (isv) {
            const int slot = (u.pm - 4) * 2 + wr;
#pragma unroll
            for (int bj = 0; bj < 2; ++bj)
#pragma unroll
                for (int n = 0; n < 2; ++n)
#pragma unroll
                    for (int e = 0; e < 4; ++e) { float a = s1[bj][n][e], b = s2[bj][n][e];
#pragma unroll
                        for (int o = 1; o < 16; o <<= 1) { a += __shfl_xor(a, o); b += __shfl_xor(b, o); }
                        if (fr == 0) { const int tok = col0 + bj * HALF + 4 * n + e; *(f32x2*)(stats + (size_t)tok * 16 + slot * 2) = (f32x2){a, b}; } }
        }
    }
};
struct EpiResid {
    static constexpr bool PERM = false;
    const float* baseL; const float* baseC; float* outL; float* outC; const float* gate;
    __device__ __forceinline__ void operator()(const f32x4 (&acc)[2][2][4][2], const Unit& u, int wr, int wc, int fr, int fq) const {
        const bool lat = u.pm < NPL; const int mb = lat ? (u.pm >> 5) : 4;
        const float* base = lat ? baseL + (size_t)u.pm * BM * DM : baseC + (size_t)(u.pm - NPL) * BM * DM;
        float* out = lat ? outL + (size_t)u.pm * BM * DM : outC + (size_t)(u.pm - NPL) * BM * DM;
        const int col0 = u.pn * BM + wc * 32 + 4 * fq;
        f32x4 gv[2][2];
#pragma unroll
        for (int bj = 0; bj < 2; ++bj)
#pragma unroll
            for (int n = 0; n < 2; ++n) gv[bj][n] = *(const f32x4*)(gate + (size_t)mb * 6144 + col0 + bj * HALF + n * 16);
#pragma unroll
        for (int ai = 0; ai < 2; ++ai)
#pragma unroll
            for (int m = 0; m < 4; ++m) { const size_t off = (size_t)(wr * 64 + fr + ai * HALF + m * 16) * DM + col0;
#pragma unroll
                for (int bj = 0; bj < 2; ++bj)
#pragma unroll
                    for (int n = 0; n < 2; ++n) { const f32x4 bs = *(const f32x4*)(base + off + bj * HALF + n * 16);
                        *(f32x4*)(out + off + bj * HALF + n * 16) = bs + gv[bj][n] * acc[ai][bj][m][n]; } }
    }
};
struct EpiSwiGLU {
    static constexpr bool PERM = true;
    bf16_t* O;
    __device__ __forceinline__ void operator()(const f32x4 (&acc)[2][2][4][2], const Unit& u, int wr, int wc, int fr, int fq) const {
        bf16_t* base = O + (size_t)(u.om * BM + wr * 64 + fr) * DFF + u.pn * 128 + wc * 32 + 8 * fq;
#pragma unroll
        for (int ai = 0; ai < 2; ++ai)
#pragma unroll
            for (int m = 0; m < 4; ++m) { const f32x4 g0 = acc[ai][0][m][0], g1 = acc[ai][0][m][1], u0 = acc[ai][1][m][0], u1 = acc[ai][1][m][1];
                float o[8];
#pragma unroll
                for (int e = 0; e < 4; ++e) { o[e] = silu_f(g0[e]) * u0[e]; o[4 + e] = silu_f(g1[e]) * u1[e]; }
                u32x4 w; w.x = pkbf(o[0], o[1]); w.y = pkbf(o[2], o[3]); w.z = pkbf(o[4], o[5]); w.w = pkbf(o[6], o[7]);
                *(u32x4*)(base + (size_t)(ai * HALF + m * 16) * DFF) = w; }
    }
};
struct EpiQKV {
    static constexpr bool PERM = false;
    bf16_t* O; const float* cosT; const float* sinT; float qscale;
    __device__ __forceinline__ void operator()(const f32x4 (&acc)[2][2][4][2], const Unit& u, int wr, int wc, int fr, int fq) const {
        const bool lat = u.pm < NPL; const bool dorope = lat && u.pn < 5; const float sc = u.pn < 4 ? qscale : 1.0f;
        const int col0 = u.pn * BM + wc * 32 + 4 * fq;
#pragma unroll
        for (int ai = 0; ai < 2; ++ai)
#pragma unroll
            for (int m = 0; m < 4; ++m) { const int grow = u.pm * BM + ai * HALF + wr * 64 + m * 16 + fr; const int s = grow & (SEQ - 1); const int pos = (wc & 1) ? (s & 63) : (s >> 6);
                f32x4 cs = (f32x4){1.f, 1.f, 1.f, 1.f}, sn = (f32x4){0.f, 0.f, 0.f, 0.f};
                if (dorope) { cs = *(const f32x4*)(cosT + pos * 16 + 4 * fq); sn = *(const f32x4*)(sinT + pos * 16 + 4 * fq); }
                bf16_t* rowp = O + (size_t)grow * NQKV + col0;
#pragma unroll
                for (int bj = 0; bj < 2; ++bj) { const f32x4 x1 = acc[ai][bj][m][0], x2 = acc[ai][bj][m][1];
                    const f32x4 o1 = (x1 * cs - x2 * sn) * sc, o2 = (x1 * sn + x2 * cs) * sc;
                    u32x2 w1, w2; w1.x = pkbf(o1[0], o1[1]); w1.y = pkbf(o1[2], o1[3]); w2.x = pkbf(o2[0], o2[1]); w2.y = pkbf(o2[2], o2[3]);
                    *(u32x2*)(rowp + bj * HALF) = w1; *(u32x2*)(rowp + bj * HALF + 16) = w2; } }
    }
};
struct EpiBf16Plain {
    static constexpr bool PERM = true;
    bf16_t* O; int ldc;
    __device__ __forceinline__ void operator()(const f32x4 (&acc)[2][2][4][2], const Unit& u, int wr, int wc, int fr, int fq) const {
        bf16_t* base = O + (size_t)(u.om * BM + wr * 64 + fr) * ldc + u.pn * BM + wc * 32 + 8 * fq;
#pragma unroll
        for (int ai = 0; ai < 2; ++ai)
#pragma unroll
            for (int m = 0; m < 4; ++m)
#pragma unroll
                for (int bj = 0; bj < 2; ++bj) { const f32x4 v0 = acc[ai][bj][m][0], v1 = acc[ai][bj][m][1];
                    u32x4 w; w.x = pkbf(v0[0], v0[1]); w.y = pkbf(v0[2], v0[3]); w.z = pkbf(v1[0], v1[1]); w.w = pkbf(v1[2], v1[3]);
                    *(u32x4*)(base + (size_t)(ai * HALF + m * 16) * ldc + bj * HALF) = w; }
    }
};

struct EpiPartF32 {
    static constexpr bool PERM = false;
    float* P; size_t sstride;
    __device__ __forceinline__ void operator()(const f32x4 (&acc)[2][2][4][2], const Unit& u, int wr, int wc, int fr, int fq) const {
        float* base = P + (size_t)u.ks * sstride + (size_t)(u.om * BM + wr * 64 + fr) * DM + u.pn * BM + wc * 32 + 4 * fq;
#pragma unroll
        for (int ai = 0; ai < 2; ++ai)
#pragma unroll
            for (int m = 0; m < 4; ++m)
#pragma unroll
                for (int bj = 0; bj < 2; ++bj)
#pragma unroll
                    for (int n = 0; n < 2; ++n) *(f32x4*)(base + (size_t)(ai * HALF + m * 16) * DM + bj * HALF + n * 16) = acc[ai][bj][m][n];
    }
};
struct EpiPartBf16 {
    static constexpr bool PERM = true;
    bf16_t* P; size_t sstride;
    __device__ __forceinline__ void operator()(const f32x4 (&acc)[2][2][4][2], const Unit& u, int wr, int wc, int fr, int fq) const {
        bf16_t* base = P + (size_t)u.ks * sstride + (size_t)(u.om * BM + wr * 64 + fr) * DM + u.pn * BM + wc * 32 + 8 * fq;
#pragma unroll
        for (int ai = 0; ai < 2; ++ai)
#pragma unroll
            for (int m = 0; m < 4; ++m)
#pragma unroll
                for (int bj = 0; bj < 2; ++bj) { const f32x4 v0 = acc[ai][bj][m][0], v1 = acc[ai][bj][m][1];
                    u32x4 w; w.x = pkbf(v0[0], v0[1]); w.y = pkbf(v0[2], v0[3]); w.z = pkbf(v1[0], v1[1]); w.w = pkbf(v1[2], v1[3]);
                    *(u32x4*)(base + (size_t)(ai * HALF + m * 16) * DM + bj * HALF) = w; }
    }
};

template <class Epi, class Sched, bool ALIGN_EPI, bool GATHER>
__device__ __forceinline__ void gemm_phase(LAS unsigned char* lds, LAS int* gtab, const int K  , const int nt_in  , const Sched& S, const Epi& E) {
    int nt = nt_in; asm volatile("" : "+s"(nt));
    int tid_ = threadIdx.x; asm volatile("" : "+v"(tid_));
    const int tid = tid_, wid = __builtin_amdgcn_readfirstlane(tid >> 6), lane = tid & 63, wr = wid >> 2, wc = wid & 3, fr = lane & 15, fq = lane >> 4;
    const size_t kstep = (size_t)(BK * 2);
    const size_t hstep = (size_t)HALF * K * 2;
    unsigned voffB[2];
#pragma unroll
    for (int i = 0; i < 2; ++i) { int R, C; stage_rc(tid * 16 + i * 8192, R, C); const int Rb = Epi::PERM ? ((R & ~31) + perm32(R & 31)) : R;
        voffB[i] = (unsigned)(Rb * K + C) * 2u; }
    unsigned vA[2][2], vN[2][2];
    const unsigned ldsw = (unsigned)wid * 1024u;
    const int aoff = lds_byte(wr * 64 + fr, fq * 8), boff = lds_byte(wc * 32 + fr, fq * 8);
#define PG8_SA(b, h) (((b) * 2 + (h)) * HTB)
#define PG8_SB(b, h) ((4 + (b) * 2 + (h)) * HTB)
#define PG8_STAGE(bufoff, gbase, voff) do { _Pragma("unroll") for (int _i = 0; _i < 2; ++_i) \
        __builtin_amdgcn_global_load_lds((const unsigned*)((const char*)(gbase) + (voff)[_i]), (LAS unsigned*)(lds + (bufoff) + ldsw + _i * 8192), 16, 0, 0); } while (0)
#define PG8_LDA(dst, b, h) do { _Pragma("unroll") for (int m = 0; m < 4; ++m) _Pragma("unroll") for (int k = 0; k < 2; ++k) dst[m][k] = *(const LAS bf16x8*)(lds + PG8_SA(b, h) + aoff + m * 2048 + k * 1024); } while (0)
#define PG8_LDB(dst, b, h) do { _Pragma("unroll") for (int n = 0; n < 2; ++n) _Pragma("unroll") for (int k = 0; k < 2; ++k) dst[n][k] = *(const LAS bf16x8*)(lds + PG8_SB(b, h) + boff + n * 2048 + k * 1024); } while (0)
#define PG8_MMA(ai, bj, At, Bt) do { __builtin_amdgcn_s_setprio(1); _Pragma("unroll") for (int m = 0; m < 4; ++m) _Pragma("unroll") for (int n = 0; n < 2; ++n) _Pragma("unroll") for (int k = 0; k < 2; ++k) \
        acc[ai][bj][m][n] = __builtin_amdgcn_mfma_f32_16x16x32_bf16(Bt[n][k], At[m][k], acc[ai][bj][m][n], 0, 0, 0); __builtin_amdgcn_s_setprio(0); } while (0)
#define PG8_WAIT_V(n) asm volatile("s_waitcnt vmcnt(" #n ")" ::: "memory")
#define PG8_WAIT_L(n) asm volatile("s_waitcnt lgkmcnt(" #n ")" ::: "memory")
#define PG8_BAR __builtin_amdgcn_s_barrier()
#define PG8_SCHED __builtin_amdgcn_sched_barrier(0)
    Unit cur, nxt; int ui = 0;
    if (!S.next(0, cur)) return;
    f32x4 acc[2][2][4][2];
#pragma unroll
    for (int a = 0; a < 2; ++a)
#pragma unroll
        for (int b = 0; b < 2; ++b)
#pragma unroll
            for (int m = 0; m < 4; ++m)
#pragma unroll
                for (int n = 0; n < 2; ++n) acc[a][b][m][n] = (f32x4){0.f, 0.f, 0.f, 0.f};
    bf16x8 At[4][2], B0[2][2], B1[2][2];
    if constexpr (GATHER) {
#pragma unroll
        for (int h = 0; h < 2; ++h)
#pragma unroll
            for (int i = 0; i < 2; ++i) { int R, C; stage_rc(tid * 16 + i * 8192, R, C); const int row = h * HALF + R; const int tok = cur.gl[row < cur.nv ? row : 0]; vA[h][i] = (unsigned)tok * (unsigned)(K * 2) + (unsigned)C * 2u; }
    } else {
#pragma unroll
        for (int h = 0; h < 2; ++h)
#pragma unroll
            for (int i = 0; i < 2; ++i) { int R, C; stage_rc(tid * 16 + i * 8192, R, C); vA[h][i] = (unsigned)(R * K + C) * 2u + (unsigned)(h * hstep); }
    }
#pragma unroll
    for (int h = 0; h < 2; ++h)
#pragma unroll
        for (int i = 0; i < 2; ++i) vN[h][i] = vA[h][i];
    const char* cA = cur.a; const char* cB = cur.b;
    PG8_STAGE(PG8_SB(0, 0), cB, voffB); PG8_STAGE(PG8_SB(0, 1), cB + hstep, voffB); PG8_STAGE(PG8_SA(0, 0), cA, vA[0]); PG8_STAGE(PG8_SA(0, 1), cA, vA[1]);
    if (wr == 1) PG8_BAR;
    PG8_WAIT_V(2); PG8_BAR;
    PG8_STAGE(PG8_SB(1, 0), cB + kstep, voffB); PG8_STAGE(PG8_SA(1, 0), cA + kstep, vA[0]); PG8_STAGE(PG8_SB(1, 1), cB + hstep + kstep, voffB);
    PG8_WAIT_V(6); PG8_BAR;
    for (;;) {
        const bool has_next = S.next(ui + 1, nxt);
        const char* nA = has_next ? nxt.a : cA; const char* nB = has_next ? nxt.b : cB;
        if constexpr (GATHER) {
            if (has_next && wid < 4) __builtin_amdgcn_global_load_lds((const unsigned*)(nxt.gl + wid * 64 + lane), (LAS unsigned*)(gtab + wid * 64), 4, 0, 0);
        }
        for (int t = 0; t < nt; t += 2) {
            const bool last = (t == nt - 2);
            const char* a1 = cA + (size_t)(t + 1) * kstep;
            const char* a2 = last ? nA : cA + (size_t)(t + 2) * kstep; const char* b2 = last ? nB : cB + (size_t)(t + 2) * kstep;
            const char* a3 = a2 + kstep; const char* b3 = b2 + kstep;
            if constexpr (GATHER) {
                if (last && has_next) {
                    int t2 = tid; asm volatile("" : "+v"(t2));
#pragma unroll
                    for (int h = 0; h < 2; ++h)
#pragma unroll
                        for (int i = 0; i < 2; ++i) { int R, C; stage_rc(t2 * 16 + i * 8192, R, C); const int row = h * HALF + R; const int tok = gtab[row < nxt.nv ? row : 0]; vN[h][i] = (unsigned)tok * (unsigned)(K * 2) + (unsigned)C * 2u; }
                }
            }
            unsigned vS0[2], vS1[2];
#pragma unroll
            for (int i = 0; i < 2; ++i) { vS0[i] = (GATHER && last) ? vN[0][i] : vA[0][i]; vS1[i] = (GATHER && last) ? vN[1][i] : vA[1][i]; }
            PG8_LDB(B0, 0, 0); PG8_LDB(B1, 0, 1); PG8_SCHED; PG8_LDA(At, 0, 0); PG8_STAGE(PG8_SA(1, 1), a1, vA[1]);
            PG8_WAIT_V(8); PG8_WAIT_L(0); PG8_BAR; PG8_MMA(0, 0, At, B0); PG8_MMA(0, 1, At, B1); PG8_BAR; PG8_SCHED;
            PG8_LDA(At, 0, 1); PG8_STAGE(PG8_SB(0, 0), b2, voffB); PG8_STAGE(PG8_SB(0, 1), b2 + hstep, voffB); PG8_STAGE(PG8_SA(0, 0), a2, vS0);
            PG8_WAIT_V(8); PG8_WAIT_L(0); PG8_BAR; PG8_MMA(1, 0, At, B0); PG8_MMA(1, 1, At, B1); PG8_BAR; PG8_SCHED;
            PG8_LDB(B0, 1, 0); PG8_LDB(B1, 1, 1); PG8_SCHED; PG8_LDA(At, 1, 0); PG8_STAGE(PG8_SA(0, 1), a2, vS1);
            PG8_WAIT_V(8); PG8_WAIT_L(0); PG8_BAR; PG8_MMA(0, 0, At, B0); PG8_MMA(0, 1, At, B1); PG8_BAR; PG8_SCHED;
            PG8_LDA(At, 1, 1); PG8_STAGE(PG8_SB(1, 0), b3, voffB); PG8_STAGE(PG8_SB(1, 1), b3 + hstep, voffB); PG8_STAGE(PG8_SA(1, 0), a3, vS0);
            PG8_WAIT_V(8); PG8_WAIT_L(0); PG8_BAR; PG8_MMA(1, 0, At, B0); PG8_MMA(1, 1, At, B1); PG8_BAR; PG8_SCHED;
        }
        if constexpr (ALIGN_EPI) { if (wr == 0) PG8_BAR; }
        E(acc, cur, wr, wc, fr, fq);
        if (!has_next) break;
#pragma unroll
        for (int a = 0; a < 2; ++a)
#pragma unroll
            for (int b = 0; b < 2; ++b)
#pragma unroll
                for (int m = 0; m < 4; ++m)
#pragma unroll
                    for (int n = 0; n < 2; ++n) acc[a][b][m][n] = (f32x4){0.f, 0.f, 0.f, 0.f};
        cur = nxt; cA = nA; cB = nB; ++ui;
        if constexpr (GATHER) {
#pragma unroll
            for (int h = 0; h < 2; ++h)
#pragma unroll
                for (int i = 0; i < 2; ++i) vA[h][i] = vN[h][i];
        }
        if constexpr (ALIGN_EPI) { if (wr == 1) PG8_BAR; }
    }
    PG8_WAIT_V(0);
    if constexpr (!ALIGN_EPI) { if (wr == 0) PG8_BAR; }
    PG8_BAR;
#undef PG8_SA
#undef PG8_SB
#undef PG8_STAGE
#undef PG8_LDA
#undef PG8_LDB
#undef PG8_MMA
#undef PG8_WAIT_V
#undef PG8_WAIT_L
#undef PG8_BAR
#undef PG8_SCHED
}
}

namespace attn_body {
using bf16 = __hip_bfloat16;
using s16x4 = __attribute__((ext_vector_type(4))) short;
constexpr int D = 64, PITCH = NQKV, OPITCH = DM;
constexpr int NW = 8, QBLK = 32, KVBLK = 64;
__device__ __forceinline__ int crow(int r, int hi) { return (r & 3) + 8 * (r >> 2) + 4 * hi; }
#define SBAR() __builtin_amdgcn_sched_barrier(0)
__device__ __forceinline__ void bmask(f32x16& p0, f32x16& p1, int kb, int qrel, int hi) {
    const float NEG = -INFINITY; const int d0 = kb + 4 * hi - qrel;
#pragma unroll
    for (int r = 0; r < 16; ++r) { const int d = d0 + (r & 3) + 8 * (r >> 2); if (d < -128 || d > 128) p0[r] = NEG; if (d + 32 < -128 || d + 32 > 128) p1[r] = NEG; }
}
constexpr int NSLOT = 3, SLOTB = 8192;
constexpr int LDS_K = 0, LDS_V = NSLOT * SLOTB, LDS_WS = 2 * NSLOT * SLOTB, LDS_OST = LDS_WS + NW * 64 * 4, LDS_BYTES_A = LDS_OST + NW * 4096;
constexpr float C2 = 0.125f * 1.4426950408889634f;
__device__ __forceinline__ void glds16(const void* gsrc, unsigned lds_dst) { unsigned keep;
    asm volatile("s_mov_b32 %0, m0\n\ts_mov_b32 m0, %2\n\ts_nop 0\n\tglobal_load_lds_dwordx4 %1, off\n\ts_mov_b32 m0, %0" : "=&s"(keep) : "v"(gsrc), "s"(lds_dst) : "memory"); }
__device__ __forceinline__ float max3f(float a, float b, float c) { float r; asm("v_max3_f32 %0, %1, %2, %3" : "=v"(r) : "v"(a), "v"(b), "v"(c)); return r; }
__device__ __forceinline__ float max2f(float a, float b) { float r; asm("v_max_f32_e32 %0, %1, %2" : "=v"(r) : "v"(a), "v"(b)); return r; }
__device__ __forceinline__ float fadd_s(float a, float b) { float r; asm("v_add_f32_e32 %0, %1, %2" : "=v"(r) : "v"(a), "v"(b)); return r; }
__device__ __forceinline__ float fsub_s(float a, float b) { float r; asm("v_sub_f32_e32 %0, %1, %2" : "=v"(r) : "v"(a), "v"(b)); return r; }
__device__ __forceinline__ unsigned cvtpk_s(float lo, float hi) { f32x2 v = {lo, hi}; bf16x2_t b = __builtin_convertvector(v, bf16x2_t); return __builtin_bit_cast(unsigned, b); }
#define WAIT_BAR(N) asm volatile("s_waitcnt vmcnt(" #N ") lgkmcnt(0)\n\ts_barrier" ::: "memory")
__device__ __forceinline__ void qkt(f32x16& p0, f32x16& p1, const char* Kslot, const bf16x8* qr, const f32x16& negm, int r32, int hi) {
    const char* kb = Kslot + hi * 1024 + r32 * 16;
#pragma unroll
    for (int d0 = 0; d0 < 4; ++d0) {
        const bf16x8 b0 = *reinterpret_cast<const bf16x8*>(kb + d0 * 2048);
        const bf16x8 b1 = *reinterpret_cast<const bf16x8*>(kb + d0 * 2048 + 512);
        if (d0 == 0) { p0 = __builtin_amdgcn_mfma_f32_32x32x16_bf16(b0, qr[0], negm, 0, 0, 0); p1 = __builtin_amdgcn_mfma_f32_32x32x16_bf16(b1, qr[0], negm, 0, 0, 0); }
        else { p0 = __builtin_amdgcn_mfma_f32_32x32x16_bf16(b0, qr[d0], p0, 0, 0, 0); p1 = __builtin_amdgcn_mfma_f32_32x32x16_bf16(b1, qr[d0], p1, 0, 0, 0); } }
}
typedef __attribute__((address_space(3))) const char* lds_cptr;
typedef short v4i16_t __attribute__((ext_vector_type(4)));
__device__ __forceinline__ void kload8(bf16x8* kf, lds_cptr kp) {
    kf[0] = *(const __attribute__((address_space(3))) bf16x8*)(kp);        kf[1] = *(const __attribute__((address_space(3))) bf16x8*)(kp + 512);
    kf[2] = *(const __attribute__((address_space(3))) bf16x8*)(kp + 2048); kf[3] = *(const __attribute__((address_space(3))) bf16x8*)(kp + 2560);
    kf[4] = *(const __attribute__((address_space(3))) bf16x8*)(kp + 4096); kf[5] = *(const __attribute__((address_space(3))) bf16x8*)(kp + 4608);
    kf[6] = *(const __attribute__((address_space(3))) bf16x8*)(kp + 6144); kf[7] = *(const __attribute__((address_space(3))) bf16x8*)(kp + 6656);
}
__device__ __forceinline__ void kload2(bf16x8* kf, lds_cptr kp, int j) { kf[2 * j] = *(const __attribute__((address_space(3))) bf16x8*)(kp + j * 2048); kf[2 * j + 1] = *(const __attribute__((address_space(3))) bf16x8*)(kp + j * 2048 + 512); }
__device__ __forceinline__ s16x4 vtr(lds_cptr p) { return __builtin_bit_cast(s16x4, __builtin_amdgcn_ds_read_tr16_b64_v4i16((__attribute__((address_space(3))) v4i16_t*)p)); }
__device__ __forceinline__ float rowmax(const f32x16& p0, const f32x16& p1) {
    float a = max3f(p0[0], p0[1], p1[0]), b = max3f(p0[2], p0[3], p1[1]); a = max3f(a, p1[2], p1[3]);
#pragma unroll
    for (int r = 4; r < 16; r += 4) { a = max3f(a, p0[r], p0[r + 1]); b = max3f(b, p0[r + 2], p0[r + 3]); a = max3f(a, p1[r], p1[r + 1]); b = max3f(b, p1[r + 2], p1[r + 3]); }
    const float m = max2f(a, b);
    auto rr = __builtin_amdgcn_permlane32_swap(__float_as_uint(m), __float_as_uint(m), false, false);
    return max2f(__uint_as_float(rr[0]), __uint_as_float(rr[1]));
}
__device__ __forceinline__ void pv(f32x16* o, int vb, bf16x8 pa0, bf16x8 pa1, bf16x8 pa2, bf16x8 pa3) {
#pragma unroll
    for (int d0 = 0; d0 < 2; ++d0) { s16x4 lo[4], hi[4];
#pragma unroll
        for (int ks = 0; ks < 4; ++ks) {
            asm volatile("ds_read_b64_tr_b16 %0,%1 offset:%c2" : "=&v"(lo[ks]) : "v"(vb), "i"(d0 * 4096 + ks * 1024) : "memory");
            asm volatile("ds_read_b64_tr_b16 %0,%1 offset:%c2" : "=&v"(hi[ks]) : "v"(vb), "i"(d0 * 4096 + ks * 1024 + 512) : "memory"); }
        asm volatile("s_waitcnt lgkmcnt(0)" ::: "memory"); SBAR();
#define PK(k) (bf16x8){lo[k][0], lo[k][1], lo[k][2], lo[k][3], hi[k][0], hi[k][1], hi[k][2], hi[k][3]}
        o[d0] = __builtin_amdgcn_mfma_f32_32x32x16_bf16(pa0, PK(0), o[d0], 0, 0, 0);
        o[d0] = __builtin_amdgcn_mfma_f32_32x32x16_bf16(pa1, PK(1), o[d0], 0, 0, 0);
        o[d0] = __builtin_amdgcn_mfma_f32_32x32x16_bf16(pa2, PK(2), o[d0], 0, 0, 0);
        o[d0] = __builtin_amdgcn_mfma_f32_32x32x16_bf16(pa3, PK(3), o[d0], 0, 0, 0);
#undef PK
    }
}
#define ATTN_STORE16(p, v) (*(u32x4*)(p) = (v))
template <int THRL> __device__ __forceinline__ void attn_unit(int b, int hk, int n, int pr, const bf16* QKV, bf16* O, const float* sinkp, char* shm) {
    int tid_ = threadIdx.x; asm volatile("" : "+v"(tid_));
    const int tid = tid_, lane = tid & 63, r32 = lane & 31, hi = lane >> 5; const int wid = __builtin_amdgcn_readfirstlane(tid >> 6);
    const int head = 4 * hk + 2 * pr + (wid >> 2);
    const long rowblk = (long)b * SEQ + n * 128;
    const long ctxrow = (long)NLAT + b * LCTX;
    const int nlo = n > 0 ? 2 : 0, nhi = n < (SEQ / 128 - 1) ? 2 : 0;
    const int NT = 6 + nlo + nhi;
    const bf16* Qw = QKV + (rowblk + (wid & 3) * QBLK) * PITCH + head * D;
    const bf16* Kc = QKV + 1024 + hk * D; const bf16* Vc = QKV + 1280 + hk * D;
    const unsigned lds0 = (unsigned)(uintptr_t)shm;
    float* wsf = (float*)(shm + LDS_WS) + wid * 64;
    const long klane = (long)lane * PITCH + wid * 8;
    const long vlane = (long)(16 * (wid & 3) + (lane >> 2)) * PITCH + (wid >> 2) * 32 + (lane & 3) * 8;
    const unsigned kdst = lds0 + LDS_K + wid * 1024, vdst = lds0 + LDS_V + wid * 1024;
#define TROW(t) (((t) < 2) ? (rowblk + 64 * (t)) : ((t) < 6) ? (ctxrow + 64 * ((t) - 2)) : (rowblk + ((((t) - 6) < nlo) ? (-128 + 64 * ((t) - 6)) : (128 + 64 * ((t) - 6 - nlo)))))
#define TKB(t) (((t) < 6) ? 0 : ((((t) - 6) < nlo) ? (-128 + 64 * ((t) - 6)) : (128 + 64 * ((t) - 6 - nlo))))
#define DMA_K(t, slot) glds16(Kc + TROW(t) * PITCH + klane, (unsigned)__builtin_amdgcn_readfirstlane(kdst + (slot)))
#define DMA_V(t, slot) glds16(Vc + TROW(t) * PITCH + vlane, (unsigned)__builtin_amdgcn_readfirstlane(vdst + (slot)))
    const int vb0 = (int)(lds0 + LDS_V) + ((lane >> 4) & 1) * 32 + (lane & 3) * 8 + (4 * hi + ((lane & 15) >> 2)) * 64;
    const char* Kbase = shm + LDS_K; bf16x8 kf[8];
    const lds_cptr shm3 = (lds_cptr)shm; const lds_cptr kp0 = shm3 + LDS_K + hi * 1024 + r32 * 16; const lds_cptr vp0 = shm3 + LDS_V + ((lane >> 4) & 1) * 32 + (lane & 3) * 8 + (4 * hi + ((lane & 15) >> 2)) * 64;
    DMA_K(0, 0); DMA_V(0, 0); DMA_K(1, SLOTB);
    bf16x8 qr[4];
#pragma unroll
    for (int d0 = 0; d0 < 4; ++d0) qr[d0] = *reinterpret_cast<const bf16x8*>(&Qw[(long)r32 * PITCH + d0 * 16 + hi * 8]);
    float mhat = 0.f, l_reg = 0.f; f32x16 o[2]; o[0] = f32x16{}; o[1] = f32x16{}; f32x16 negm = f32x16{}; asm volatile("" : "+v"(negm));
    const int qrel = (wid & 3) * QBLK + r32;
#define CMASK(P0, P1, t) do { int jb_ = (t) - (NT - 4); if (jb_ >= 0) bmask(P0, P1, TKB(t), qrel, hi); } while (0)
    bool resc = false;
#define START(P0, P1) do { const float rm = rowmax(P0, P1); resc = false; \
    { const float dl = rm; mhat = fadd_s(mhat, dl); \
      _Pragma("unroll") for (int r = 0; r < 16; ++r) { P0[r] = fsub_s(P0[r], dl); P1[r] = fsub_s(P1[r], dl); } \
      _Pragma("unroll") for (int r = 0; r < 16; ++r) negm[r] = -mhat; asm volatile("" : "+v"(negm)); } \
    _Pragma("unroll") for (int r = 0; r < 16; ++r) P0[r] = __builtin_amdgcn_exp2f(P0[r]); } while (0)
#define RESC() do { if (resc) { asm volatile("s_waitcnt lgkmcnt(0)" ::: "memory"); \
      _Pragma("unroll") for (int d_ = 0; d_ < 2; ++d_) _Pragma("unroll") for (int r = 0; r < 16; ++r) o[d_][r] *= wsf[crow(r, hi)]; } } while (0)
    f32x16 pA0, pA1, pB0, pB1;
    int sl_prev = 0, sl_cur = 0, sl_next = SLOTB;
#define ROT() do { sl_prev = sl_cur; sl_cur = sl_next; sl_next = (sl_next == (NSLOT - 1) * SLOTB) ? 0 : sl_next + SLOTB; } while (0)
    DMA_K(2, 2 * SLOTB);
    WAIT_BAR(3);
    qkt(pA0, pA1, Kbase, qr, negm, r32, hi); asm volatile("s_nop 15\n\ts_nop 7" : "+v"(pA0), "+v"(pA1));
    START(pA0, pA1);
    _Pragma("unroll") for (int r = 0; r < 16; ++r) pA1[r] = __builtin_amdgcn_exp2f(pA1[r]);
    WAIT_BAR(0);
    DMA_K(3, 0); DMA_V(1, SLOTB);
    ROT();
    kload8(kf, kp0 + sl_cur);
    WAIT_BAR(2);
    s16x4 vlo[8], vhi[8]; u32x4 pw0, pw1, pw2, pw3;
#define PKW(P, B) cvtpk_s(P[B], P[B + 1])
#define PAF(k) __builtin_bit_cast(bf16x8, pw##k)
#define VFR(i) (bf16x8){vlo[i][0], vlo[i][1], vlo[i][2], vlo[i][3], vhi[i][0], vhi[i][1], vhi[i][2], vhi[i][3]}
#define PIN(x) asm volatile("" : "+v"(x))
#define MX3(a, b, c) __builtin_fmaxf(__builtin_fmaxf((a), (b)), (c))
#define GAPA(MF, A0, A1, A2, A3, W0, W1, PW) do { MF; sacc += A0; sacc += A1; sacc += A2; sacc += A3; PIN(sacc); W0; W1; PIN(PW); SBAR(); } while (0)
#define EX(v) __builtin_amdgcn_exp2f(v)
#define GAPB(MF, X, B) do { MF; X[B] = EX(X[B]); X[B + 1] = EX(X[B + 1]); X[B + 2] = EX(X[B + 2]); X[B + 3] = EX(X[B + 3]); PIN(X); SBAR(); } while (0)
#define VRD(i) do { vlo[i] = vtr(vp_ + (((i) >> 2) * 4096 + ((i) & 3) * 1024)); vhi[i] = vtr(vp_ + (((i) >> 2) * 4096 + ((i) & 3) * 1024 + 512)); } while (0)
#define KRD(G, j) do { if (G) { kload2(kf, kp0 + sl_next, j); SBAR(); } } while (0)
#define STEP(C0, C1, P0, P1, t, GK, GV, GL) do { SBAR(); \
    const lds_cptr vp_ = vp0 + sl_prev; \
    VRD(0); SBAR(); float sacc = (P0[0] + P0[1]); \
    GAPA(C0 = __builtin_amdgcn_mfma_f32_32x32x16_bf16(kf[0], qr[0], negm, 0, 0, 0), P0[2], P0[3], P0[4], P0[5],     pw0[0] = PKW(P0, 0), pw0[1] = PKW(P0, 2), pw0); \
    VRD(4); SBAR(); GAPA(C1 = __builtin_amdgcn_mfma_f32_32x32x16_bf16(kf[1], qr[0], negm, 0, 0, 0), P0[6], P0[7], P0[8], P0[9],     pw0[2] = PKW(P0, 4), pw0[3] = PKW(P0, 6), pw0); \
    VRD(1); SBAR(); GAPA(C0 = __builtin_amdgcn_mfma_f32_32x32x16_bf16(kf[2], qr[1], C0, 0, 0, 0),   P0[10], P0[11], P0[12], P0[13], pw1[0] = PKW(P0, 8), pw1[1] = PKW(P0, 10), pw1); \
    VRD(5); SBAR(); GAPA(C1 = __builtin_amdgcn_mfma_f32_32x32x16_bf16(kf[3], qr[1], C1, 0, 0, 0),   P0[14], P0[15], P1[0], P1[1],   pw1[2] = PKW(P0, 12), pw1[3] = PKW(P0, 14), pw1); \
    VRD(2); SBAR(); GAPA(C0 = __builtin_amdgcn_mfma_f32_32x32x16_bf16(kf[4], qr[2], C0, 0, 0, 0),   P1[2], P1[3], P1[4], P1[5],     pw2[0] = PKW(P1, 0), pw2[1] = PKW(P1, 2), pw2); \
    VRD(6); SBAR(); GAPA(C1 = __builtin_amdgcn_mfma_f32_32x32x16_bf16(kf[5], qr[2], C1, 0, 0, 0),   P1[6], P1[7], P1[8], P1[9],     pw2[2] = PKW(P1, 4), pw2[3] = PKW(P1, 6), pw2); \
    VRD(3); SBAR(); GAPA(C0 = __builtin_amdgcn_mfma_f32_32x32x16_bf16(kf[6], qr[3], C0, 0, 0, 0),   P1[10], P1[11], P1[12], P1[13], pw3[0] = PKW(P1, 8), pw3[1] = PKW(P1, 10), pw3); \
    VRD(7); SBAR(); GAPA(C1 = __builtin_amdgcn_mfma_f32_32x32x16_bf16(kf[7], qr[3], C1, 0, 0, 0),   P1[14], P1[15], 0.f, 0.f,       pw3[2] = PKW(P1, 12), pw3[3] = PKW(P1, 14), pw3); \
    l_reg += sacc; \
    if (GK) { DMA_K((t) + 3, sl_cur); } if (GV) { DMA_V((t) + 1, sl_next); } \
    CMASK(C0, C1, t); \
    { float a = MX3(C0[0], C0[1], C1[0]), b = MX3(C0[2], C0[3], C1[1]); a = MX3(a, C1[2], C1[3]); \
      _Pragma("unroll") for (int r = 4; r < 16; r += 4) { a = MX3(a, C0[r], C0[r + 1]); b = MX3(b, C0[r + 2], C0[r + 3]); a = MX3(a, C1[r], C1[r + 1]); b = MX3(b, C1[r + 2], C1[r + 3]); } \
      float rm = __builtin_fmaxf(a, b); { auto rr = __builtin_amdgcn_permlane32_swap(__float_as_uint(rm), __float_as_uint(rm), false, false); rm = __builtin_fmaxf(__uint_as_float(rr[0]), __uint_as_float(rr[1])); } \
      resc = false; \
      if (__builtin_expect(__any(rm > (float)THRL), 0)) { const float dl = __builtin_fmaxf(rm, 0.f); mhat += dl; \
        _Pragma("unroll") for (int r = 0; r < 16; ++r) { C0[r] -= dl; C1[r] -= dl; } \
        _Pragma("unroll") for (int r = 0; r < 16; ++r) negm[r] = -mhat; asm volatile("" : "+v"(negm)); \
        const float f = __builtin_amdgcn_exp2f(-dl); l_reg *= f; if (hi == 0) wsf[r32] = f; resc = true; } } \
    SBAR(); \
    GAPB(o[0] = __builtin_amdgcn_mfma_f32_32x32x16_bf16(PAF(0), VFR(0), o[0], 0, 0, 0), C0, 0); \
    GAPB(o[1] = __builtin_amdgcn_mfma_f32_32x32x16_bf16(PAF(0), VFR(4), o[1], 0, 0, 0), C0, 4); \
    KRD(GL, 0); GAPB(o[0] = __builtin_amdgcn_mfma_f32_32x32x16_bf16(PAF(1), VFR(1), o[0], 0, 0, 0), C0, 8); \
    KRD(GL, 1); GAPB(o[1] = __builtin_amdgcn_mfma_f32_32x32x16_bf16(PAF(1), VFR(5), o[1], 0, 0, 0), C0, 12); \
    KRD(GL, 2); GAPB(o[0] = __builtin_amdgcn_mfma_f32_32x32x16_bf16(PAF(2), VFR(2), o[0], 0, 0, 0), C1, 0); \
    KRD(GL, 3); GAPB(o[1] = __builtin_amdgcn_mfma_f32_32x32x16_bf16(PAF(2), VFR(6), o[1], 0, 0, 0), C1, 4); \
    GAPB(o[0] = __builtin_amdgcn_mfma_f32_32x32x16_bf16(PAF(3), VFR(3), o[0], 0, 0, 0), C1, 8); \
    GAPB(o[1] = __builtin_amdgcn_mfma_f32_32x32x16_bf16(PAF(3), VFR(7), o[1], 0, 0, 0), C1, 12); \
    } while (0)
    int t = 1;
#undef CMASK
#define CMASK(P0, P1, t) do { } while (0)
    for (; t + 5 < NT; t += 2) {
        STEP(pB0, pB1, pA0, pA1, t, true, true, true);     WAIT_BAR(2); RESC(); ROT();
        STEP(pA0, pA1, pB0, pB1, t + 1, true, true, true); WAIT_BAR(2); RESC(); ROT();
    }
#undef CMASK
#define CMASK(P0, P1, t) do { int jb_ = (t) - (NT - 4); if (jb_ >= 0) bmask(P0, P1, TKB(t), qrel, hi); } while (0)
#define ENDW(tt) do { if ((tt) + 3 < NT) { WAIT_BAR(2); } else if ((tt) + 2 < NT) { WAIT_BAR(1); } else { WAIT_BAR(0); } } while (0)
    for (; t + 1 < NT; t += 2) {
        STEP(pB0, pB1, pA0, pA1, t, (t + 3 < NT), (t + 1 < NT), (t + 1 < NT));     ENDW(t);     RESC(); ROT();
        STEP(pA0, pA1, pB0, pB1, t + 1, (t + 4 < NT), (t + 2 < NT), (t + 2 < NT)); ENDW(t + 1); RESC(); ROT();
    }
    STEP(pB0, pB1, pA0, pA1, NT - 1, false, false, false); RESC();
    { float sacc = pB0[0] + pB0[1]; _Pragma("unroll") for (int r = 2; r < 16; ++r) sacc += pB0[r]; _Pragma("unroll") for (int r = 0; r < 16; ++r) sacc += pB1[r]; l_reg += sacc;
      pw0 = (u32x4){PKW(pB0, 0), PKW(pB0, 2), PKW(pB0, 4), PKW(pB0, 6)}; pw1 = (u32x4){PKW(pB0, 8), PKW(pB0, 10), PKW(pB0, 12), PKW(pB0, 14)}; pw2 = (u32x4){PKW(pB1, 0), PKW(pB1, 2), PKW(pB1, 4), PKW(pB1, 6)}; pw3 = (u32x4){PKW(pB1, 8), PKW(pB1, 10), PKW(pB1, 12), PKW(pB1, 14)};
      SBAR(); pv(o, vb0 + sl_cur, PAF(0), PAF(1), PAF(2), PAF(3)); }
#undef PKW
#undef PAF
#undef VFR
#undef PIN
#undef MX3
#undef GAPA
#undef GAPB
#undef EX
#undef VRD
#undef KRD
#undef STEP
#undef ENDW
    { auto rr = __builtin_amdgcn_permlane32_swap(__float_as_uint(l_reg), __float_as_uint(l_reg), false, false); l_reg = __uint_as_float(rr[0]) + __uint_as_float(rr[1]); }
    l_reg += __builtin_amdgcn_exp2f(sinkp[head] * 1.4426950408889634f - mhat);
    if (hi == 0) wsf[32 + r32] = l_reg; asm volatile("s_waitcnt lgkmcnt(0)" ::: "memory");
    float rli[16];
#pragma unroll
    for (int r = 0; r < 16; ++r) rli[r] = __builtin_amdgcn_rcpf(wsf[32 + crow(r, hi)]);
    bf16* Ow = O + (rowblk + (wid & 3) * QBLK) * OPITCH + head * D;
    { bf16* stg = (bf16*)(shm + LDS_OST) + wid * 2048;
#pragma unroll
      for (int r = 0; r < 16; ++r) { const int orow = crow(r, hi);
#pragma unroll
        for (int d0 = 0; d0 < 2; ++d0) stg[orow * 64 + d0 * 32 + r32] = __float2bfloat16(o[d0][r] * rli[r]); }
      asm volatile("s_waitcnt lgkmcnt(0)" ::: "memory");
#pragma unroll
      for (int i = 0; i < 4; ++i) { const int row = i * 8 + (lane >> 3), ch = lane & 7; const u32x4 v = *(const u32x4*)(stg + row * 64 + ch * 8); ATTN_STORE16(Ow + (long)row * OPITCH + ch * 8, v); } }
    asm volatile("s_waitcnt lgkmcnt(0)\n\ts_barrier" ::: "memory");
#undef DMA_K
#undef DMA_V
#undef TROW
#undef TKB
#undef CMASK
#undef START
#undef RESC
#undef ROT
}
#undef SBAR
#undef WAIT_BAR
}

#define XB_TMO      128
#define XB_XCNT(j)  (256  + 64 * (j))
#define XB_XSUB(j)  (1280 + 64 * (j))
#define XB_XGEN(j)  (2304 + 64 * (j))
#define XB_TOP      3328
#define XB_TOPGEN   3392
#define XCD_BAR_WORDS 3456
#define XB_SPIN_CAP (1u << 18)
__device__ __forceinline__ unsigned xb_ld(unsigned* p)              { return __hip_atomic_load(p, __ATOMIC_RELAXED, __HIP_MEMORY_SCOPE_AGENT); }
__device__ __forceinline__ unsigned xb_add(unsigned* p, unsigned v) { return __hip_atomic_fetch_add(p, v, __ATOMIC_RELAXED, __HIP_MEMORY_SCOPE_AGENT); }
__device__ __forceinline__ unsigned xb_xcc_id() { return (unsigned)__builtin_amdgcn_s_getreg((3 << 11) | 20) & 0xFu; }
#define XB_SPIN(cond, bar) do { unsigned _sp = 0; while (cond) { __builtin_amdgcn_s_sleep(1); \
    if ((++_sp & 255u) == 0u) { if (xb_ld(&(bar)[XB_TMO])) break; if (_sp > XB_SPIN_CAP) { atomicAdd(&(bar)[XB_TMO], 1u); break; } } } } while (0)
struct XcdBarrier { unsigned* bar; unsigned x; volatile LAS unsigned* st; };
__device__ __forceinline__ XcdBarrier xcd_barrier_post(unsigned* bar, volatile LAS unsigned* st) {
    XcdBarrier b; b.bar = bar; b.x = xb_xcc_id(); b.st = st;
    if (threadIdx.x == 0) (void)xb_add(&bar[XB_XCNT(b.x)], 1u);
    return b;
}
__device__ __forceinline__ void xcd_barrier_complete(unsigned* bar, unsigned x, unsigned& nloc, unsigned& nx) {
    const unsigned G = gridDim.x * gridDim.y * gridDim.z;
    unsigned sum, cnt, mine, sp = 0u;
    for (;;) {
        sum = 0u; cnt = 0u; mine = 0u;
#pragma unroll
        for (unsigned j = 0; j < 16; ++j) { const unsigned c = xb_ld(&bar[XB_XCNT(j)]); sum += c; cnt += (c > 0u) ? 1u : 0u; mine = (j == x) ? c : mine; }
        if (sum == G) break;
        __builtin_amdgcn_s_sleep(1);
        if ((++sp & 255u) == 0u) { if (xb_ld(&bar[XB_TMO])) break; if (sp > XB_SPIN_CAP) { atomicAdd(&bar[XB_TMO], 1u); break; } }
    }
    nloc = mine > 0u ? mine : 1u; nx = cnt > 0u ? cnt : 1u;
}
__device__ __forceinline__ void xcd_barrier(const XcdBarrier& b) {
    asm volatile("s_waitcnt vmcnt(0)" ::: "memory");
    __syncthreads();
    if (threadIdx.x == 0) {
        unsigned* bar = b.bar;
        __builtin_amdgcn_s_waitcnt(0);
        unsigned nloc = b.st[0], nx = b.st[1];
        if (nloc == 0u) { xcd_barrier_complete(bar, b.x, nloc, nx); b.st[0] = nloc; b.st[1] = nx; }
        const unsigned old = xb_add(&bar[XB_XSUB(b.x)], 1u);
        const unsigned gen = old / nloc;
        if (old + 1u == (gen + 1u) * nloc) {
            __builtin_amdgcn_fence(__ATOMIC_RELEASE, "agent");
            asm volatile("s_waitcnt vmcnt(0)" ::: "memory");
            const unsigned og = xb_add(&bar[XB_TOP], 1u);
            const unsigned tg = og / nx;
            if (og + 1u == (tg + 1u) * nx) xb_add(&bar[XB_TOPGEN], 1u);
            else XB_SPIN(xb_ld(&bar[XB_TOPGEN]) == tg, bar);
            __builtin_amdgcn_fence(__ATOMIC_ACQUIRE, "agent");
            xb_add(&bar[XB_XGEN(b.x)], 1u);
            asm volatile("s_waitcnt vmcnt(0)" ::: "memory");
        } else {
            XB_SPIN(xb_ld(&bar[XB_XGEN(b.x)]) == gen, bar);
            __builtin_amdgcn_fence(__ATOMIC_ACQUIRE, "agent");
            asm volatile("s_waitcnt vmcnt(0)" ::: "memory");
        }
    }
    __syncthreads();
}

#define LDS_WAIT() asm volatile("s_waitcnt lgkmcnt(0)" ::: "memory")
__device__ __forceinline__ void transpose_item(const float* W, int K, int N, bf16_t* WT, int k0, int n0, int drow0, LAS float* scr, int lane) {
#pragma unroll 8
    for (int i = 0; i < 32; ++i) { const int kk = 2 * i + (lane >> 5); scr[kk * 33 + (lane & 31)] = W[(size_t)(k0 + kk) * N + n0 + (lane & 31)]; }
    LDS_WAIT(); asm volatile("" ::: "memory");
    const int c = lane & 7;
#pragma unroll
    for (int j = 0; j < 4; ++j) { const int n = (lane >> 3) + 8 * j; const LAS float* s = scr + (8 * c) * 33 + n;
        u32x4 o; o.x = pkbf(s[0 * 33], s[1 * 33]); o.y = pkbf(s[2 * 33], s[3 * 33]); o.z = pkbf(s[4 * 33], s[5 * 33]); o.w = pkbf(s[6 * 33], s[7 * 33]);
        *(GAS u32x4*)(WT + (size_t)(drow0 + n) * K + k0 + 8 * c) = o; }
    LDS_WAIT(); asm volatile("" ::: "memory");
}
__device__ __forceinline__ void sincos_d(double x, double& s, double& c) {
    const double TWO_PI = 6.283185307179586476925;
    const double k = __builtin_rint(x / TWO_PI); const double r = x - k * TWO_PI;
    const double r2 = r * r; double ts = r, tc = 1.0; s = r; c = 1.0;
    for (int i = 1; i <= 16; ++i) { tc *= -r2 / (double)((2 * i - 1) * (2 * i)); ts *= -r2 / (double)((2 * i) * (2 * i + 1)); c += tc; s += ts; }
}

struct Args { const float* in[24]; float* out; unsigned char* ws; int ph_lo, ph_hi; };
constexpr int NPH = 24;

__device__ __forceinline__ void norm_rows(const float* srcL, const float* srcC, int nrows, const float* g, const float* mod, int shc, int scc, bf16_t* XNo, int gw, int NGW, int lane,
                                          const float* part, int nS, const float* gatec, float* zout) {
    for (int m = gw; m < nrows; m += NGW) {
        const bool lat = m < NLAT;
        const float* src = lat ? srcL + (size_t)m * DM : srcC + (size_t)(m - NLAT) * DM; const int mb = lat ? (m >> 13) : 4;
        const GAS f32x4* xr = (const GAS f32x4*)src + lane;
        f32x4 v[4]; float ss = 0.f;
#pragma unroll
        for (int j = 0; j < 4; ++j) v[j] = xr[64 * j];
        if (!lat && part != nullptr) {
            f32x4 a[4];
#pragma unroll
            for (int j = 0; j < 4; ++j) a[j] = (f32x4){0.f, 0.f, 0.f, 0.f};
            for (int s2 = 0; s2 < nS; ++s2) { const GAS f32x4* pr = (const GAS f32x4*)(part + ((size_t)s2 * NCTXR + (m - NLAT)) * DM) + lane;
#pragma unroll
                for (int j = 0; j < 4; ++j) a[j] += pr[64 * j]; }
#pragma unroll
            for (int j = 0; j < 4; ++j) v[j] += *(const f32x4*)(gatec + 4 * lane + 256 * j) * a[j];
            if (zout != nullptr) { GAS f32x4* zr = (GAS f32x4*)(zout + (size_t)(m - NLAT) * DM) + lane;
#pragma unroll
                for (int j = 0; j < 4; ++j) zr[64 * j] = v[j]; }
        }
#pragma unroll
        for (int j = 0; j < 4; ++j) ss += (v[j].x * v[j].x + v[j].y * v[j].y) + (v[j].z * v[j].z + v[j].w * v[j].w);
        const float rstd = 1.0f / __builtin_sqrtf(wave_sum(ss) * (1.0f / DM) + EPS);
        const float* mrow = mod + (size_t)mb * 6144;
        GAS u32x2* o8 = (GAS u32x2*)(XNo + (size_t)m * DM) + lane;
#pragma unroll
        for (int j = 0; j < 4; ++j) { const f32x4 gv = *(const f32x4*)(g + 4 * lane + 256 * j), sc = *(const f32x4*)(mrow + scc * 1024 + 4 * lane + 256 * j), sh = *(const f32x4*)(mrow + shc * 1024 + 4 * lane + 256 * j);
            const f32x4 y = (v[j] * rstd) * gv * (sc + 1.0f) + sh; u32x2 w; w.x = pkbf(y.x, y.y); w.y = pkbf(y.z, y.w); o8[64 * j] = w; }
    }
}

__global__ void __launch_bounds__(512, 2) fwd(Args args) {
    extern __shared__ __attribute__((aligned(16))) unsigned char lds_raw[];
    LAS unsigned char* lds = (LAS unsigned char*)lds_raw;
    volatile LAS unsigned* MISC = (volatile LAS unsigned*)(lds + MISC_OFF);
    LAS int* gtab = (LAS int*)(lds + GTAB_OFF);
    const int G = gridDim.x; const int bx = blockIdx.x; const int vcu = (G % 8 == 0) ? (bx % 8) * (G / 8) + bx / 8 : bx;
    const int NGW = G * 8;
#define PHASE_IDS() int tid_ = threadIdx.x; asm volatile("" : "+v"(tid_)); const int tid = tid_, lane = tid & 63, wave = __builtin_amdgcn_readfirstlane(tid >> 6), gw = vcu * 8 + wave; (void)lane; (void)gw
    unsigned char* ws = args.ws;
    gu32* ctl = (gu32*)(ws + WS_CTL);
#define MOD ((float*)(ws + WS_MOD))
#define ROPE ((float*)(ws + WS_ROPE))
#define STATS ((float*)(ws + WS_STATS))
#define LIST ((int*)(ws + WS_LIST))
#define TINFO ((int*)(ws + WS_TINFO))
#define WSB ((bf16_t*)(ws + WS_WS))
#define WIN ((bf16_t*)(ws + WS_WIN))
#define WAO ((bf16_t*)(ws + WS_WAO))
#define WQKV ((bf16_t*)(ws + WS_WQKV))
#define WBO ((bf16_t*)(ws + WS_WBO))
#define WGU ((bf16_t*)(ws + WS_WGU))
#define WD ((bf16_t*)(ws + WS_WD))
#define MGU ((bf16_t*)(ws + WS_MGU))
#define MD ((bf16_t*)(ws + WS_MD))
#define XN ((bf16_t*)(ws + WS_XN))
#define ZB ((float*)(ws + WS_ZB))
#define UVT ((bf16_t*)(ws + WS_UVT))
#define A2 ((bf16_t*)(ws + WS_A2))
#define HB ((bf16_t*)(ws + WS_H))
#define QKV ((bf16_t*)(ws + WS_QKV))
#define OB ((bf16_t*)(ws + WS_O))
#define YB ((bf16_t*)(ws + WS_Y))
#define HC ((bf16_t*)(ws + WS_HC))
#define YP ((bf16_t*)(ws + WS_YP))
#define PART1 ((float*)(ws + WS_PART1))
#define PART2 ((float*)(ws + WS_PART2))
#define I_X (args.in[0])
#define I_C (args.in[1])
#define I_CTX (args.in[2])
#define I_CCTX (args.in[3])
#define I_ADAW (args.in[4])
#define I_ADAB (args.in[5])
#define I_NORMG (args.in[6])
#define I_FINALG (args.in[7])
#define HL (args.out)

    { PHASE_IDS(); for (int u = tid; u < (LDS_BYTES - MISC_OFF) / 4; u += 512) ((LAS unsigned*)(lds + MISC_OFF))[u] = 0u; }
    __syncthreads();
    const int lo = args.ph_lo, hi_ph = args.ph_hi;
    const bool one_launch = (hi_ph - lo) > 1;
    XcdBarrier bar; bar.bar = (unsigned*)(ctl + CW_BAR); bar.x = 0; bar.st = nullptr;
    if (one_launch) bar = xcd_barrier_post((unsigned*)(ctl + CW_BAR), MISC + 8);
#ifndef PHMASK
#define PHMASK 0xFFFFFFFFu
#endif
#define IN(k) (((PHMASK >> (k)) & 1) && lo <= (k) && (k) < hi_ph)
#define BOTH(k) (IN(k) && IN((k) + 1))
#define GRID_BAR() xcd_barrier(bar)

    if (IN(0)) {
        PHASE_IDS();
        {
            LAS float* sv = (LAS float*)lds;
            LAS float* red = (LAS float*)(lds + 5 * 1024 * 4);
            if (bx < 192) {
                for (int idx = tid; idx < 5 * 1024; idx += 512) { const int r = idx >> 10, k = idx & 1023; const float cv = r < 4 ? I_C[r * 1024 + k] : I_CCTX[k]; sv[idx] = cv / (1.0f + __expf(-cv)); }
                __syncthreads();
                for (int item = bx; item < 192; item += G) {
                    const int i = item / 96, n0 = (item % 96) * 64, nn = tid & 63, kq = tid >> 6;
                    float a0 = 0.f, a1 = 0.f, a2 = 0.f, a3 = 0.f, a4 = 0.f;
                    const float* wp = I_ADAW + ((size_t)i * 1024 + kq * 128) * 6144 + n0 + nn;
#pragma unroll 8
                    for (int k = 0; k < 128; ++k) { const float w = wp[(size_t)k * 6144]; const int kk = kq * 128 + k;
                        a0 += sv[kk] * w; a1 += sv[1024 + kk] * w; a2 += sv[2048 + kk] * w; a3 += sv[3072 + kk] * w; a4 += sv[4096 + kk] * w; }
                    red[(kq * 5 + 0) * 64 + nn] = a0; red[(kq * 5 + 1) * 64 + nn] = a1; red[(kq * 5 + 2) * 64 + nn] = a2; red[(kq * 5 + 3) * 64 + nn] = a3; red[(kq * 5 + 4) * 64 + nn] = a4;
                    __syncthreads();
                    if (tid < 320) { const int r = tid >> 6; float s = I_ADAB[i * 6144 + n0 + nn];
#pragma unroll
                        for (int q = 0; q < 8; ++q) s += red[(q * 5 + r) * 64 + nn];
                        MOD[((size_t)i * 5 + r) * 6144 + n0 + nn] = s; }
                    __syncthreads();
                }
            }
            __syncthreads();
        }
        {
            LAS float* scr = (LAS float*)(lds + wave * 16384);
            constexpr int I_IN = 16 * 64, I_AO = 16 * 32, I_QKV = 16 * 48, I_BO = 16 * 32, I_F = 16 * 112, I_FD = 56 * 32;
            constexpr int I_DENSE = I_IN + I_AO + I_QKV + I_BO + 2 * I_F + I_FD, I_MOE = 8 * (2 * I_F + I_FD), I_WS = 128, I_ROPE = 32;
            constexpr int NITEMS = I_DENSE + I_MOE + I_WS + I_ROPE;
            for (int it = gw; it < NITEMS; it += NGW) {
                int r = it;
                if (r < I_IN) { const int kb = r / 64, nb = r % 64; transpose_item(args.in[8], 1024, 2048, WIN, 64 * kb, 32 * nb, 32 * nb, scr, lane); continue; } r -= I_IN;
                if (r < I_AO) { const int kb = r / 32, nb = r % 32; transpose_item(args.in[13], 1024, 1024, WAO, 64 * kb, 32 * nb, 32 * nb, scr, lane); continue; } r -= I_AO;
                if (r < I_QKV) { const int kb = r / 48, nb = r % 48; transpose_item(args.in[14], 1024, 1536, WQKV, 64 * kb, 32 * nb, 32 * nb, scr, lane); continue; } r -= I_QKV;
                if (r < I_BO) { const int kb = r / 32, nb = r % 32; transpose_item(args.in[16], 1024, 1024, WBO, 64 * kb, 32 * nb, 32 * nb, scr, lane); continue; } r -= I_BO;
                if (r < 2 * I_F) { const int up = r / I_F; const int q = r % I_F; const int kb = q / 112, nb = q % 112, n0 = 32 * nb;
                    transpose_item(args.in[17 + up], 1024, DFF, WGU, 64 * kb, n0, 256 * (n0 >> 7) + 128 * up + (n0 & 127), scr, lane); continue; } r -= 2 * I_F;
                if (r < I_FD) { const int kb = r / 32, nb = r % 32; transpose_item(args.in[19], DFF, 1024, WD, 64 * kb, 32 * nb, 32 * nb, scr, lane); continue; } r -= I_FD;
                if (r < I_MOE) { const int e = r / (2 * I_F + I_FD); int q = r % (2 * I_F + I_FD);
                    if (q < 2 * I_F) { const int up = q / I_F; q %= I_F; const int kb = q / 112, nb = q % 112, n0 = 32 * nb;
                        transpose_item(args.in[21 + up] + (size_t)e * 1024 * DFF, 1024, DFF, MGU + (size_t)e * 7168 * 1024, 64 * kb, n0, 256 * (n0 >> 7) + 128 * up + (n0 & 127), scr, lane); }
                    else { q -= 2 * I_F; const int kb = q / 32, nb = q % 32; transpose_item(args.in[23] + (size_t)e * DFF * 1024, DFF, 1024, MD + (size_t)e * 1024 * DFF, 64 * kb, 32 * nb, 32 * nb, scr, lane); }
                    continue; } r -= I_MOE;
                if (r < I_WS) { const float* src = args.in[11] + (size_t)r * 2048;
#pragma unroll
                    for (int j = 0; j < 8; ++j) { const f32x4 v = *(const f32x4*)(src + j * 256 + lane * 4); u32x2 w; w.x = pkbf(v.x, v.y); w.y = pkbf(v.z, v.w); *(u32x2*)(WSB + (size_t)r * 2048 + j * 256 + lane * 4) = w; }
                    continue; } r -= I_WS;
                {
                    const int ent = r * 64 + lane; const int pos = ent >> 4, i = ent & 15;
                    double inv = 1.0; for (int q = 0; q < i; ++q) inv *= 0.56234132519034908;
                    const float ang = (float)pos * (float)inv; double s, c; sincos_d((double)ang, s, c);
                    ROPE[ent] = (float)c; ROPE[2048 + ent] = (float)s;
                }
            }
        }
        if (BOTH(0)) GRID_BAR();
    }
    if (IN(1)) { PHASE_IDS(); norm_rows(I_X, I_CTX, MALL, I_NORMG + 0 * 1024, MOD, 0, 1, XN, gw, NGW, lane, nullptr, 0, nullptr, nullptr); if (BOTH(1)) GRID_BAR(); }
    if (IN(2)) {
        pg8::DenseSched S{(const char*)WIN, (const char*)XN, 8, NPA, G, bx, (size_t)256 * 1024 * 2};
        pg8::EpiGeluT E{UVT, STATS};
        pg8::gemm_phase<pg8::EpiGeluT, pg8::DenseSched, true, false>(lds, gtab, 1024, 16, S, E);
        if (BOTH(2)) GRID_BAR();
    }
    if (IN(3)) {
        PHASE_IDS();
        const float* vg = args.in[9]; const float* vb = args.in[10]; const float* bs = args.in[12];
        LAS float* mu_l = (LAS float*)(lds + wave * 1024); LAS float* rs_l = mu_l + 128;
        const int r32 = lane & 31, h = lane >> 5;
        for (int unit = gw; unit < (MALL / 128) * 16; unit += NGW) {
            const int ch = unit >> 4, g = unit & 15, q0 = ch * 128;
#pragma unroll
            for (int tt = 0; tt < 2; ++tt) { const int tok = q0 + lane * 2 + tt; const f32x4* sp = (const f32x4*)(STATS + (size_t)tok * 16);
                const f32x4 a = sp[0], b = sp[1], c = sp[2], d = sp[3];
                const float sum = (a.x + a.z) + (b.x + b.z) + (c.x + c.z) + (d.x + d.z), sq = (a.y + a.w) + (b.y + b.w) + (c.y + c.w) + (d.y + d.w);
                const float mean = sum * (1.0f / 1024.0f), var = sq * (1.0f / 1024.0f) - mean * mean;
                mu_l[lane * 2 + tt] = mean; rs_l[lane * 2 + tt] = 1.0f / __builtin_sqrtf(var + EPS); }
            float vgc[2], vbc[2];
#pragma unroll
            for (int ct = 0; ct < 2; ++ct) { vgc[ct] = vg[64 * g + 32 * ct + r32]; vbc[ct] = vb[64 * g + 32 * ct + r32]; }
            f32x16 acc[2][4];
#pragma unroll
            for (int ct = 0; ct < 2; ++ct)
#pragma unroll
                for (int pt = 0; pt < 4; ++pt) acc[ct][pt] = f32x16{};
#pragma unroll 2
            for (int s = 0; s < 8; ++s) {
                const int qs = 16 * s + 8 * h;
                const f32x4 m0 = *(const LAS f32x4*)(mu_l + qs), m1 = *(const LAS f32x4*)(mu_l + qs + 4), r0 = *(const LAS f32x4*)(rs_l + qs), r1 = *(const LAS f32x4*)(rs_l + qs + 4);
                bf16x8 af[2], bfr[4];
#pragma unroll
                for (int ct = 0; ct < 2; ++ct) { const bf16x8 raw = *(const bf16x8*)(UVT + (size_t)(1024 + 64 * g + 32 * ct + r32) * MALL + q0 + qs);
                    float y[8];
#pragma unroll
                    for (int j = 0; j < 4; ++j) { y[j] = (bf2f((unsigned short)raw[j]) - m0[j]) * r0[j] * vgc[ct] + vbc[ct]; y[4 + j] = (bf2f((unsigned short)raw[4 + j]) - m1[j]) * r1[j] * vgc[ct] + vbc[ct]; }
                    u32x4 w; w.x = pkbf(y[0], y[1]); w.y = pkbf(y[2], y[3]); w.z = pkbf(y[4], y[5]); w.w = pkbf(y[6], y[7]); af[ct] = __builtin_bit_cast(bf16x8, w); }
#pragma unroll
                for (int pt = 0; pt < 4; ++pt) bfr[pt] = *(const bf16x8*)(WSB + (size_t)(g * 128 + 32 * pt + r32) * 128 + qs);
#pragma unroll
                for (int ct = 0; ct < 2; ++ct)
#pragma unroll
                    for (int pt = 0; pt < 4; ++pt) acc[ct][pt] = __builtin_amdgcn_mfma_f32_32x32x16_bf16(af[ct], bfr[pt], acc[ct][pt], 0, 0, 0);
            }
#pragma unroll
            for (int pt = 0; pt < 4; ++pt) { const int p = 32 * pt + r32; const size_t tokp = (size_t)q0 + p; const float bsv = bs[g * 128 + p];
#pragma unroll
                for (int ct = 0; ct < 2; ++ct)
#pragma unroll
                    for (int rr = 0; rr < 4; ++rr) { const int c = 64 * g + 32 * ct + 8 * rr + 4 * h; float o[4];
#pragma unroll
                        for (int e = 0; e < 4; ++e) { const float uu = bf2f(UVT[(size_t)(c + e) * MALL + tokp]); o[e] = uu * (acc[ct][pt][4 * rr + e] + bsv); }
                        u32x2 w; w.x = pkbf(o[0], o[1]); w.y = pkbf(o[2], o[3]); *(u32x2*)(A2 + tokp * DM + c) = w; } }
        }
        if (BOTH(3)) GRID_BAR();
    }
    if (IN(4)) {
        { pg8::DenseSched S{(const char*)A2, (const char*)WAO, NPL, 4, G, bx, (size_t)256 * 1024 * 2};
          pg8::EpiResid E{I_X, I_CTX, HL, ZB, MOD + 2 * 1024};
          pg8::gemm_phase<pg8::EpiResid, pg8::DenseSched, true, false>(lds, gtab, 1024, 16, S, E); }
        { pg8::SplitSched S{(const char*)(A2 + (size_t)NLAT * DM), (const char*)WAO, 4, 4, P3_NS, G, bx, NPL, (size_t)256 * 1024 * 2, (size_t)(1024 / P3_NS) * 2};
          pg8::EpiPartF32 E{PART1, (size_t)NCTXR * DM};
          pg8::gemm_phase<pg8::EpiPartF32, pg8::SplitSched, true, false>(lds, gtab, 1024, 1024 / P3_NS / 64, S, E); }
        if (BOTH(4)) GRID_BAR();
    }
    if (IN(5)) { PHASE_IDS(); norm_rows(HL, I_CTX, MALL, I_NORMG + 1 * 1024, MOD, 3, 4, XN, gw, NGW, lane, PART1, P3_NS, MOD + 4 * 6144 + 2 * 1024, ZB); if (BOTH(5)) GRID_BAR(); }
    if (IN(6)) {
        pg8::DenseSched S{(const char*)XN, (const char*)WGU, NPA, 28, G, bx, (size_t)256 * 1024 * 2};
        pg8::EpiSwiGLU E{HB};
        pg8::gemm_phase<pg8::EpiSwiGLU, pg8::DenseSched, true, false>(lds, gtab, 1024, 16, S, E);
        if (BOTH(6)) GRID_BAR();
    }
    if (IN(7)) {
        { pg8::DenseSched S{(const char*)HB, (const char*)WD, NPL, 4, G, bx, (size_t)256 * DFF * 2};
          pg8::EpiResid E{HL, ZB, HL, ZB, MOD + 5 * 1024};
          pg8::gemm_phase<pg8::EpiResid, pg8::DenseSched, true, false>(lds, gtab, DFF, 56, S, E); }
        { pg8::SplitSched S{(const char*)(HB + (size_t)NLAT * DFF), (const char*)WD, 4, 4, P5_NS, G, bx, NPL, (size_t)256 * DFF * 2, (size_t)(DFF / P5_NS) * 2};
          pg8::EpiPartF32 E{PART2, (size_t)NCTXR * DM};
          pg8::gemm_phase<pg8::EpiPartF32, pg8::SplitSched, true, false>(lds, gtab, DFF, DFF / P5_NS / 64, S, E); }
        if (BOTH(7)) GRID_BAR();
    }
    if (IN(8)) { PHASE_IDS(); norm_rows(HL, ZB, MALL, I_NORMG + 2 * 1024, MOD + 5 * 6144, 0, 1, XN, gw, NGW, lane, PART2, P5_NS, MOD + 4 * 6144 + 5 * 1024, nullptr); if (BOTH(8)) GRID_BAR(); }
    if (IN(9)) {
        pg8::DenseSched S{(const char*)XN, (const char*)WQKV, NPA, 6, G, bx, (size_t)256 * 1024 * 2};
        pg8::EpiQKV E{QKV, ROPE, ROPE + 2048, attn_body::C2};
        pg8::gemm_phase<pg8::EpiQKV, pg8::DenseSched, true, false>(lds, gtab, 1024, 16, S, E);
        if (BOTH(9)) GRID_BAR();
    }
    if (IN(10)) {
        static_assert(attn_body::LDS_BYTES_A <= RING_BYTES, "attention LDS");
        const float* sinkp = args.in[15];
        for (int i = 0;; ++i) { const int uid = i * G + vcu; if (uid >= NB * 64 * 4 * 2) break;
            const int pr = uid & 1, hk = (uid >> 1) & 3, n = (uid >> 3) & 63, b = uid >> 9;
            attn_body::attn_unit<8>(b, hk, n, pr, (const attn_body::bf16*)QKV, (attn_body::bf16*)OB, sinkp, (char*)lds_raw); }
        if (BOTH(10)) GRID_BAR();
    }
    if (IN(11)) {
        pg8::DenseSched S{(const char*)OB, (const char*)WBO, NPL, 4, G, bx, (size_t)256 * 1024 * 2};
        pg8::EpiResid E{HL, ZB, HL, ZB, MOD + 5 * 6144 + 2 * 1024};
        pg8::gemm_phase<pg8::EpiResid, pg8::DenseSched, true, false>(lds, gtab, 1024, 16, S, E);
        if (BOTH(11)) GRID_BAR();
    }
    if (IN(12)) {
        PHASE_IDS();
        const float* g = I_NORMG + 3 * 1024; const float* mod = MOD + 5 * 6144; const float* wrt = args.in[20];
        LAS int* l_e = (LAS int*)lds;
        LAS float* l_w = (LAS float*)(lds + 1024);
        LAS int* l_cnt = (LAS int*)(lds + 2048);
        LAS int* l_base = (LAS int*)(lds + 2048 + 64);
        for (int blk = bx; blk < NLAT / 128; blk += G) {
            if (tid < 8) l_cnt[tid] = 0;
            __syncthreads();
            for (int i = 0; i < 16; ++i) {
                const int tl = wave * 16 + i, m = blk * 128 + tl; const int mb = m >> 13;
                const GAS f32x4* xr = (const GAS f32x4*)(HL + (size_t)m * DM) + lane;
                f32x4 v[4]; float ss = 0.f;
#pragma unroll
                for (int j = 0; j < 4; ++j) { v[j] = xr[64 * j]; ss += (v[j].x * v[j].x + v[j].y * v[j].y) + (v[j].z * v[j].z + v[j].w * v[j].w); }
                const float rstd = 1.0f / __builtin_sqrtf(wave_sum(ss) * (1.0f / DM) + EPS);
                const float* mrow = mod + (size_t)mb * 6144;
                GAS u32x2* o8 = (GAS u32x2*)(XN + (size_t)m * DM) + lane;
                float lg[8];
#pragma unroll
                for (int e = 0; e < 8; ++e) lg[e] = 0.f;
#pragma unroll
                for (int j = 0; j < 4; ++j) { const int col = 4 * lane + 256 * j; const f32x4 gv = *(const f32x4*)(g + col), sc = *(const f32x4*)(mrow + 4 * 1024 + col), sh = *(const f32x4*)(mrow + 3 * 1024 + col);
                    const f32x4 y = (v[j] * rstd) * gv * (sc + 1.0f) + sh; u32x2 w; w.x = pkbf(y.x, y.y); w.y = pkbf(y.z, y.w); o8[64 * j] = w;
#pragma unroll
                    for (int cc = 0; cc < 4; ++cc) { const f32x4 w0 = *(const f32x4*)(wrt + (size_t)(col + cc) * 8), w1 = *(const f32x4*)(wrt + (size_t)(col + cc) * 8 + 4);
                        lg[0] += y[cc] * w0.x; lg[1] += y[cc] * w0.y; lg[2] += y[cc] * w0.z; lg[3] += y[cc] * w0.w; lg[4] += y[cc] * w1.x; lg[5] += y[cc] * w1.y; lg[6] += y[cc] * w1.z; lg[7] += y[cc] * w1.w; } }
#pragma unroll
                for (int e = 0; e < 8; ++e) lg[e] = wave_sum(lg[e]);
                int ea = 0; float va = lg[0];
#pragma unroll
                for (int e = 1; e < 8; ++e) if (lg[e] > va) { va = lg[e]; ea = e; }
                int eb = -1; float vb2 = -INFINITY;
#pragma unroll
                for (int e = 0; e < 8; ++e) if (e != ea && lg[e] > vb2) { vb2 = lg[e]; eb = e; }
                const float wb = 1.0f / (1.0f + __expf(va - vb2)), wa = 1.0f - wb;
                if (lane == 0) { l_e[tl * 2] = ea; l_e[tl * 2 + 1] = eb; l_w[tl * 2] = wa; l_w[tl * 2 + 1] = wb; }
            }
            __syncthreads();
            int ea = 0, eb = 0, pa = 0, pb = 0;
            if (tid < 128) { ea = l_e[tid * 2]; eb = l_e[tid * 2 + 1]; pa = atomicAdd((int*)&l_cnt[ea], 1); pb = atomicAdd((int*)&l_cnt[eb], 1); }
            __syncthreads();
            if (tid < 8) l_base[tid] = (int)__hip_atomic_fetch_add((unsigned*)(ctl + CW_CNT + 64 * tid), (unsigned)l_cnt[tid], __ATOMIC_RELAXED, __HIP_MEMORY_SCOPE_AGENT);
            __syncthreads();
            if (tid < 128) { const int m = blk * 128 + tid; pa += l_base[ea]; pb += l_base[eb];
                LIST[(size_t)ea * NLAT + pa] = m; LIST[(size_t)eb * NLAT + pb] = m;
                int* ti = TINFO + (size_t)m * 8; ti[0] = ea; ti[1] = pa; ti[2] = eb; ti[3] = pb; ti[4] = __float_as_int(l_w[tid * 2]); ti[5] = __float_as_int(l_w[tid * 2 + 1]); }
            __syncthreads();
        }
        if (BOTH(12)) GRID_BAR();
    }
    if (hi_ph > 13 && lo < 23) {
        PHASE_IDS();
        LAS int* mtab = (LAS int*)(lds + MOE_OFF);
        if (tid == 0) { int run = 0, R = 0;
            for (int e = 0; e < 8; ++e) { const int ce = (int)__hip_atomic_load((unsigned*)(ctl + CW_CNT + 64 * e), __ATOMIC_RELAXED, __HIP_MEMORY_SCOPE_AGENT); mtab[e] = run; mtab[16 + e] = ce; run += ce >> 8; if (ce & 255) { mtab[24 + R] = e; ++R; } }
            mtab[8] = run; mtab[32] = R; }
        __syncthreads();
        const int nfull = __builtin_amdgcn_readfirstlane(mtab[8]);
        for (int c = 0; c < MOE_NCH; ++c) {
            const int gp0 = c * MOE_CH, gp1 = nfull < (c + 1) * MOE_CH ? nfull : (c + 1) * MOE_CH;
            if (IN(13 + 2 * c)) {
                pg8::MoeSched S; S.A = (const char*)XN; S.B = (const char*)MGU; S.list = LIST; S.tab = mtab; S.mode = 0; S.nS = 1; S.kbytes = 0;
                S.gp0 = gp0; S.gp1 = gp1; S.nN = 28; S.G = G; S.c = bx; S.bexp = (size_t)7168 * 1024 * 2; S.btile = (size_t)256 * 1024 * 2; S.astep = 0; S.gather = true;
                pg8::EpiSwiGLU E{HC};
                pg8::gemm_phase<pg8::EpiSwiGLU, pg8::MoeSched, true, true>(lds, gtab, 1024, 16, S, E);
                if (BOTH(13 + 2 * c)) GRID_BAR();
            }
            if (IN(14 + 2 * c)) {
                pg8::MoeSched S; S.A = (const char*)HC; S.B = (const char*)MD; S.list = LIST; S.tab = mtab; S.mode = 0; S.nS = 1; S.kbytes = 0;
                S.gp0 = gp0; S.gp1 = gp1; S.nN = 4; S.G = G; S.c = bx; S.bexp = (size_t)1024 * DFF * 2; S.btile = (size_t)256 * DFF * 2; S.astep = (size_t)256 * DFF * 2; S.gather = false;
                pg8::EpiBf16Plain E{YB, DM};
                pg8::gemm_phase<pg8::EpiBf16Plain, pg8::MoeSched, true, false>(lds, gtab, DFF, 56, S, E);
                if (BOTH(14 + 2 * c)) GRID_BAR();
            }
        }
        if (IN(21)) {
            pg8::MoeSched S; S.A = (const char*)XN; S.B = (const char*)MGU; S.list = LIST; S.tab = mtab; S.mode = 1; S.nS = 1; S.kbytes = 0;
            S.gp0 = 0; S.gp1 = 0; S.nN = 28; S.G = G; S.c = bx; S.bexp = (size_t)7168 * 1024 * 2; S.btile = (size_t)256 * 1024 * 2; S.astep = 0; S.gather = true;
            pg8::EpiSwiGLU E{HC};
            pg8::gemm_phase<pg8::EpiSwiGLU, pg8::MoeSched, true, true>(lds, gtab, 1024, 16, S, E);
            if (BOTH(21)) GRID_BAR();
        }
        if (IN(22)) {
            pg8::MoeSched S; S.A = (const char*)HC; S.B = (const char*)MD; S.list = LIST; S.tab = mtab; S.mode = 2; S.nS = MOE_RS; S.kbytes = (size_t)(DFF / MOE_RS) * 2;
            S.gp0 = 0; S.gp1 = 0; S.nN = 4; S.G = G; S.c = bx; S.bexp = (size_t)1024 * DFF * 2; S.btile = (size_t)256 * DFF * 2; S.astep = (size_t)256 * DFF * 2; S.gather = false;
            pg8::EpiPartBf16 E{YP, (size_t)8 * 256 * DM};
            pg8::gemm_phase<pg8::EpiPartBf16, pg8::MoeSched, true, false>(lds, gtab, DFF, DFF / MOE_RS / 64, S, E);
            if (BOTH(22)) GRID_BAR();
        }
    }
    if (IN(23)) {
        PHASE_IDS();
        LAS int* l_pb = (LAS int*)(lds + wave * 128);
        if (lane == 0) { int run = 0, R = 0;
            for (int e = 0; e < 8; ++e) { const int ce = (int)__hip_atomic_load((unsigned*)(ctl + CW_CNT + 64 * e), __ATOMIC_RELAXED, __HIP_MEMORY_SCOPE_AGENT); l_pb[e] = run; l_pb[8 + e] = ce >> 8; l_pb[16 + e] = R; run += ce >> 8; if (ce & 255) ++R; } }
        const float* g2 = MOD + 5 * 6144 + 5 * 1024;
        for (int m = gw; m < NLAT; m += NGW) {
            const int mb = m >> 13; const int* ti = TINFO + (size_t)m * 8;
            const int ea = ti[0], pa = ti[1], eb = ti[2], pb = ti[3]; const float wa = __int_as_float(ti[4]), wb = __int_as_float(ti[5]);
            const bool ma = (pa >> 8) < l_pb[8 + ea], mbm = (pb >> 8) < l_pb[8 + eb];
            const size_t sa = ma ? (size_t)(l_pb[ea] + (pa >> 8)) * 256 + (pa & 255) : (size_t)l_pb[16 + ea] * 256 + (pa & 255);
            const size_t sb = mbm ? (size_t)(l_pb[eb] + (pb >> 8)) * 256 + (pb & 255) : (size_t)l_pb[16 + eb] * 256 + (pb & 255);
            const GAS f32x4* xr = (const GAS f32x4*)(HL + (size_t)m * DM) + lane;
            f32x4 ya[4], yb[4];
#pragma unroll
            for (int j = 0; j < 4; ++j) { ya[j] = (f32x4){0.f, 0.f, 0.f, 0.f}; yb[j] = (f32x4){0.f, 0.f, 0.f, 0.f}; }
            { const int ns = ma ? 1 : MOE_RS; const bf16_t* yp = ma ? YB : YP;
              for (int s2 = 0; s2 < ns; ++s2) { const GAS u32x2* yr = (const GAS u32x2*)(yp + ((size_t)s2 * 8 * 256 + sa) * DM) + lane;
#pragma unroll
                for (int j = 0; j < 4; ++j) { const u32x2 a = yr[64 * j]; ya[j].x += __uint_as_float(a.x << 16); ya[j].y += __uint_as_float(a.x & 0xffff0000u); ya[j].z += __uint_as_float(a.y << 16); ya[j].w += __uint_as_float(a.y & 0xffff0000u); } } }
            { const int ns = mbm ? 1 : MOE_RS; const bf16_t* yp = mbm ? YB : YP;
              for (int s2 = 0; s2 < ns; ++s2) { const GAS u32x2* yr = (const GAS u32x2*)(yp + ((size_t)s2 * 8 * 256 + sb) * DM) + lane;
#pragma unroll
                for (int j = 0; j < 4; ++j) { const u32x2 a = yr[64 * j]; yb[j].x += __uint_as_float(a.x << 16); yb[j].y += __uint_as_float(a.x & 0xffff0000u); yb[j].z += __uint_as_float(a.y << 16); yb[j].w += __uint_as_float(a.y & 0xffff0000u); } } }
            f32x4 v[4]; float ss = 0.f;
#pragma unroll
            for (int j = 0; j < 4; ++j) { const f32x4 hv = xr[64 * j]; const f32x4 gv = *(const f32x4*)(g2 + (size_t)mb * 6144 + 4 * lane + 256 * j);
                v[j] = hv + gv * (ya[j] * wa + yb[j] * wb); ss += (v[j].x * v[j].x + v[j].y * v[j].y) + (v[j].z * v[j].z + v[j].w * v[j].w); }
            const float rstd = 1.0f / __builtin_sqrtf(wave_sum(ss) * (1.0f / DM) + EPS);
            GAS f32x4* orow = (GAS f32x4*)(args.out + (size_t)m * DM) + lane;
#pragma unroll
            for (int j = 0; j < 4; ++j) { const f32x4 fg = *(const f32x4*)(I_FINALG + 4 * lane + 256 * j); orow[64 * j] = (v[j] * rstd) * fg; }
        }
    }
#undef IN
#undef BOTH
#undef GRID_BAR
}

#ifndef MK_ONE_LAUNCH
#define MK_ONE_LAUNCH 1
#endif
extern "C" void kernel_launch(void* const* d_in, const int* in_sizes, int n_in, void* d_out, int out_size, void* d_ws, size_t ws_size, hipStream_t stream) {
    static int grid = 0;
    if (grid == 0) {
        if (n_in != 24 || out_size != NLAT * DM || ws_size < WS_END) { fprintf(stderr, "kernel_launch: unexpected problem (n_in %d, out %d, ws %zu < %zu)\n", n_in, out_size, ws_size, (size_t)WS_END); grid = -1; return; }
        int dev = 0, cus = 0, per_cu = 0;
        if (hipGetDevice(&dev) != hipSuccess || hipDeviceGetAttribute(&cus, hipDeviceAttributeMultiprocessorCount, dev) != hipSuccess) { grid = -1; return; }
        if (hipFuncSetAttribute((const void*)fwd, hipFuncAttributeMaxDynamicSharedMemorySize, LDS_BYTES) != hipSuccess) { fprintf(stderr, "kernel_launch: hipFuncSetAttribute failed\n"); grid = -1; return; }
        if (hipOccupancyMaxActiveBlocksPerMultiprocessor(&per_cu, (const void*)fwd, 512, LDS_BYTES) != hipSuccess || per_cu < 1) fprintf(stderr, "kernel_launch: occupancy query says %d\n", per_cu);
        (void)hipGetLastError();
        grid = cus;
    }
    if (grid < 0) return;
    if (hipMemsetAsync((char*)d_ws + WS_CTL, 0, CTL_ZERO_BYTES, stream) != hipSuccess) return;
    Args a{};
    for (int i = 0; i < 24; ++i) a.in[i] = (const float*)d_in[i];
    a.out = (float*)d_out; a.ws = (unsigned char*)d_ws;
#if MK_ONE_LAUNCH
    a.ph_lo = 0; a.ph_hi = NPH;
    hipLaunchKernelGGL(fwd, dim3(grid), dim3(512), LDS_BYTES, stream, a);
#else
    for (int p = 0; p < NPH; ++p) { a.ph_lo = p; a.ph_hi = p + 1; hipLaunchKernelGGL(fwd, dim3(grid), dim3(512), LDS_BYTES, stream, a); }
#endif
}
```

```cpp
#include <hip/hip_runtime.h>
#include <hip/hip_bf16.h>
#include <cstdio>
#include <cstdint>
#include <cmath>

constexpr int DM = 1024, NB = 4, SEQ = 8192, LCTX = 256, NLAT = NB * SEQ, NCTXR = NB * LCTX, MALL = NLAT + NCTXR;
constexpr int DFF = 3584, NEXP = 8, NQKV = 1536;
constexpr int NPL = NLAT / 256, NPA = MALL / 256;
constexpr float EPS = 1e-6f;
constexpr int MOE_CH = 64, MOE_NCH = 4;
constexpr int MOE_RS = 7, P3_NS = 8, P5_NS = 14;

#define LAS __attribute__((address_space(3)))
#define GAS __attribute__((address_space(1)))
typedef unsigned short bf16_t;
typedef short bf16x8 __attribute__((ext_vector_type(8)));
typedef float f32x4 __attribute__((ext_vector_type(4)));
typedef float f32x2 __attribute__((ext_vector_type(2)));
typedef float f32x16 __attribute__((ext_vector_type(16)));
typedef unsigned u32x4 __attribute__((ext_vector_type(4)));
typedef unsigned u32x2 __attribute__((ext_vector_type(2)));
typedef __bf16 bf16x2_t __attribute__((ext_vector_type(2)));
typedef GAS unsigned gu32;

__device__ __forceinline__ unsigned pkbf(float lo, float hi) { f32x2 v = {lo, hi}; bf16x2_t b = __builtin_convertvector(v, bf16x2_t); return __builtin_bit_cast(unsigned, b); }
__device__ __forceinline__ float bf2f(unsigned short h) { return __builtin_bit_cast(float, (unsigned)h << 16); }
__device__ __forceinline__ float wave_sum(float v) {
#pragma unroll
    for (int o = 1; o < 64; o <<= 1) v += __shfl_xor(v, o);
    return v;
}
__device__ __forceinline__ float gelu_tanh(float x) {
    const float t = x * (1.0f + 0.044715f * x * x);
    const float e = __builtin_amdgcn_exp2f(-2.302208198f * t);
    return x * __builtin_amdgcn_rcpf(1.0f + e);
}
__device__ __forceinline__ float silu_f(float x) { return x * __builtin_amdgcn_rcpf(1.0f + __builtin_amdgcn_exp2f(-1.4426950409f * x)); }

constexpr size_t MiB = 1u << 20;
constexpr size_t WS_CTL = 0, CTL_ZERO_BYTES = 1 * MiB;
constexpr size_t WS_MOD = 1 * MiB;
constexpr size_t WS_ROPE = 1 * MiB + 256 * 1024;
constexpr size_t WS_STATS = 2 * MiB;
constexpr size_t WS_LIST = 5 * MiB;
constexpr size_t WS_TINFO = 6 * MiB;
constexpr size_t WS_WS = 7 * MiB;
constexpr size_t WS_WIN = 8 * MiB, WS_WAO = 12 * MiB, WS_WQKV = 14 * MiB, WS_WBO = 17 * MiB, WS_WGU = 19 * MiB, WS_WD = 33 * MiB;
constexpr size_t WS_MGU = 40 * MiB, WS_MD = 152 * MiB;
constexpr size_t WS_XN = 208 * MiB;
constexpr size_t WS_ZB = 274 * MiB;
constexpr size_t WS_R = 278 * MiB;
constexpr size_t WS_UVT = WS_R, WS_A2 = WS_R + 132 * MiB, WS_PART1 = WS_R + 198 * MiB, WS_H = WS_R, WS_PART2 = WS_R + 231 * MiB;
constexpr size_t WS_QKV = WS_R, WS_O = WS_R + 99 * MiB;
constexpr size_t WS_Y = WS_R, WS_YP = WS_R + 128 * MiB, WS_HC = WS_R + 156 * MiB;
constexpr size_t WS_END = WS_R + 287 * MiB;
static_assert(WS_UVT + (size_t)2048 * MALL * 2 <= WS_A2 && WS_A2 + (size_t)MALL * DM * 2 <= WS_PART1 && WS_PART1 + (size_t)P3_NS * NCTXR * DM * 4 <= WS_END, "layer-0 mixer map");
static_assert(WS_H + (size_t)MALL * DFF * 2 <= WS_PART2 && WS_PART2 + (size_t)P5_NS * NCTXR * DM * 4 <= WS_END && WS_QKV + (size_t)MALL * NQKV * 2 <= WS_O && WS_O + (size_t)NLAT * DM * 2 <= WS_END, "region map");
static_assert(WS_Y + (size_t)256 * 256 * DM * 2 <= WS_YP && WS_YP + (size_t)MOE_RS * 8 * 256 * DM * 2 <= WS_HC && WS_HC + (size_t)MOE_CH * 256 * DFF * 2 <= WS_END, "MoE map");
static_assert(WS_XN + (size_t)MALL * DM * 2 <= WS_ZB && WS_MD + (size_t)8 * DM * DFF * 2 <= WS_XN && WS_MGU + (size_t)8 * 7168 * DM * 2 <= WS_MD, "weights map");
constexpr int CW_TMO = 0, CW_CODE = 1;
constexpr int CW_CNT = 64;
constexpr int CW_BAR = 4096;

constexpr int RING_BYTES = 131072;
constexpr int GTAB_OFF = RING_BYTES;
constexpr int MOE_OFF = RING_BYTES + 1024;
constexpr int MISC_OFF = RING_BYTES + 2048;
constexpr int LDS_BYTES = 147456;

namespace pg8 {
constexpr int BM = 256, BK = 64, HALF = 128, HTB = HALF * BK * 2, STAGE_BYTES = 8 * HTB, NXCD = 8, WGM = 8;
__host__ __device__ __forceinline__ int lds_byte(int r, int c) { const int st = (r >> 4) * 2 + (c >> 5), rr = r & 15, cc = c & 31, ob = rr * 64 + cc * 2; return st * 1024 + (ob ^ (((ob >> 9) & 1) << 5)); }
__host__ __device__ __forceinline__ void stage_rc(int b, int& R, int& C) { const int st = b / 1024, sb = b % 1024, swz = sb ^ (((sb >> 9) & 1) << 5); R = (st >> 1) * 16 + swz / 64; C = (st & 1) * 32 + (swz % 64) / 2; }
__host__ __device__ __forceinline__ int perm32(int rho) { const int n = rho >> 4, i = rho & 15; return 8 * (i >> 2) + 4 * n + (i & 3); }

struct Unit { const char* a; const char* b; const int* gl; int pm, pn, om, nv, ks; };

__device__ __forceinline__ bool tile_order(int i, int G, int c, int nM, int nN, int& pm, int& pn) {
    const int nwg = nM * nN; const long L = (long)i * G + c; if (L >= nwg) return false;
    int wgid = (int)L; { const int q = nwg / NXCD, r = nwg % NXCD, xcd = wgid % NXCD, off = wgid / NXCD; wgid = (xcd < r ? xcd * (q + 1) : r * (q + 1) + (xcd - r) * q) + off; }
    const int nig = WGM * nN, gid = wgid / nig, fm = gid * WGM, gsz = (nM - fm) < WGM ? (nM - fm) : WGM;
    pm = fm + ((wgid % nig) % gsz); pn = (wgid % nig) / gsz; return true;
}
struct DenseSched {
    const char* A; const char* B; int nM, nN, G, c; size_t tstep;
    __device__ __forceinline__ bool next(int i, Unit& u) const {
        int pm, pn; if (!tile_order(i, G, c, nM, nN, pm, pn)) return false;
        u.a = A + (size_t)pm * tstep; u.b = B + (size_t)pn * tstep; u.gl = nullptr; u.pm = pm; u.pn = pn; u.om = pm; u.nv = 256; u.ks = 0; return true;
    }
};
struct SplitSched {
    const char* A; const char* B; int nM, nN, nS, G, c, pm0; size_t tstep, kbytes;
    __device__ __forceinline__ bool next(int i, Unit& u) const {
        const int L = i * G + c; if (L >= nM * nN * nS) return false;
        const int ks = L % nS, t = L / nS, pn = t % nN, pm = t / nN;
        u.a = A + (size_t)pm * tstep + (size_t)ks * kbytes; u.b = B + (size_t)pn * tstep + (size_t)ks * kbytes; u.gl = nullptr; u.pm = pm0 + pm; u.pn = pn; u.om = pm; u.nv = 256; u.ks = ks; return true;
    }
};
struct MoeSched {
    const char* A; const char* B; const int* list; const LAS int* tab; int gp0, gp1, nN, nS, G, c, mode; size_t bexp, btile, astep, kbytes; bool gather;
    __device__ __forceinline__ bool next(int i, Unit& u) const {
        int pm, pn, ks = 0;
        if (mode == 0) { if (gp1 <= gp0) return false; if (!tile_order(i, G, c, gp1 - gp0, nN, pm, pn)) return false; }
        else { const int R = __builtin_amdgcn_readfirstlane(tab[32]); const int L = i * G + c; if (L >= R * nN * nS) return false; ks = L % nS; const int t = L / nS; pn = t % nN; pm = t / nN; }
        int e = 0, lp, nv;
        if (mode == 0) { const int gp = gp0 + pm;
#pragma unroll
            for (int k = 1; k < 8; ++k) e += (gp >= __builtin_amdgcn_readfirstlane(tab[k])) ? 1 : 0;
            lp = gp - __builtin_amdgcn_readfirstlane(tab[e]); nv = 256; u.pm = gp; }
        else { e = __builtin_amdgcn_readfirstlane(tab[24 + pm]); const int ce = __builtin_amdgcn_readfirstlane(tab[16 + e]); lp = ce >> 8; nv = ce & 255; u.pm = pm; }
        u.b = B + (size_t)e * bexp + (size_t)pn * btile + (size_t)ks * kbytes; u.pn = pn; u.nv = nv; u.ks = ks; u.om = pm;
        if (gather) { u.a = A; u.gl = list + (size_t)e * NLAT + 256 * lp; }
        else { u.a = A + (size_t)pm * astep + (size_t)ks * kbytes; u.gl = nullptr; if (mode == 0) u.om = gp0 + pm; }
        return true;
    }
};

struct EpiGeluT {
    static constexpr bool PERM = true;
    bf16_t* O; float* stats;
    __device__ __forceinline__ void operator()(const f32x4 (&acc)[2][2][4][2], const Unit& u, int wr, int wc, int fr, int fq) const {
        const int row0 = u.pm * BM + wr * 64 + fr, col0 = u.pn * BM + wc * 32 + 8 * fq;
        const bool isv = u.pm >= 4;
        float s1[2][2][4], s2[2][2][4];
#pragma unroll
        for (int bj = 0; bj < 2; ++bj)
#pragma unroll
            for (int n = 0; n < 2; ++n)
#pragma unroll
                for (int e = 0; e < 4; ++e) { s1[bj][n][e] = 0.f; s2[bj][n][e] = 0.f; }
#pragma unroll
        for (int ai = 0; ai < 2; ++ai)
#pragma unroll
            for (int m = 0; m < 4; ++m) { bf16_t* rowp = O + (size_t)(row0 + ai * HALF + m * 16) * MALL + col0;
#pragma unroll
                for (int bj = 0; bj < 2; ++bj) { f32x4 v0 = acc[ai][bj][m][0], v1 = acc[ai][bj][m][1];
#pragma unroll
                    for (int e = 0; e < 4; ++e) { v0[e] = gelu_tanh(v0[e]); v1[e] = gelu_tanh(v1[e]); s1[bj][0][e] += v0[e]; s2[bj][0][e] += v0[e] * v0[e]; s1[bj][1][e] += v1[e]; s2[bj][1][e] += v1[e] * v1[e]; }
                    u32x4 w; w.x = pkbf(v0[0], v0[1]); w.y = pkbf(v0[2], v0[3]); w.z = pkbf(v1[0], v1[1]); w.w = pkbf(v1[2], v1[3]);
                    *(u32x4*)(rowp + bj * HALF) = w; } }
        if (isv) {
            const int slot = (u.pm - 4) * 2 + wr;
#pragma unroll
            for (int bj = 0; bj < 2; ++bj)
#pragma unroll
                for (int n = 0; n < 2; ++n)
#pragma unroll
                    for (int e = 0; e < 4; ++e) { float a = s1[bj][n][e], b = s2[bj][n][e];
#pragma unroll
                        for (int o = 1; o < 16; o <<= 1) { a += __shfl_xor(a, o); b += __shfl_xor(b, o); }
                        if (fr == 0) { const int tok = col0 + bj * HALF + 4 * n + e; *(f32x2*)(stats + (size_t)tok * 16 + slot * 2) = (f32x2){a, b}; } }
        }
    }
};
struct EpiResid {
    static constexpr bool PERM = false;
    const float* baseL; const float* baseC; float* outL; float* outC; const float* gate;
    __device__ __forceinline__ void operator()(const f32x4 (&acc)[2][2][4][2], const Unit& u, int wr, int wc, int fr, int fq) const {
        const bool lat = u.pm < NPL; const int mb = lat ? (u.pm >> 5) : 4;
        const float* base = lat ? baseL + (size_t)u.pm * BM * DM : baseC + (size_t)(u.pm - NPL) * BM * DM;
        float* out = lat ? outL + (size_t)u.pm * BM * DM : outC + (size_t)(u.pm - NPL) * BM * DM;
        const int col0 = u.pn * BM + wc * 32 + 4 * fq;
        f32x4 gv[2][2];
#pragma unroll
        for (int bj = 0; bj < 2; ++bj)
#pragma unroll
            for (int n = 0; n < 2; ++n) gv[bj][n] = *(const f32x4*)(gate + (size_t)mb * 6144 + col0 + bj * HALF + n * 16);
#pragma unroll
        for (int ai = 0; ai < 2; ++ai)
#pragma unroll
            for (int m = 0; m < 4; ++m) { const size_t off = (size_t)(wr * 64 + fr + ai * HALF + m * 16) * DM + col0;
#pragma unroll
                for (int bj = 0; bj < 2; ++bj)
#pragma unroll
                    for (int n = 0; n < 2; ++n) { const f32x4 bs = *(const f32x4*)(base + off + bj * HALF + n * 16);
                        *(f32x4*)(out + off + bj * HALF + n * 16) = bs + gv[bj][n] * acc[ai][bj][m][n]; } }
    }
};
struct EpiSwiGLU {
    static constexpr bool PERM = true;
    bf16_t* O;
    __device__ __forceinline__ void operator()(const f32x4 (&acc)[2][2][4][2], const Unit& u, int wr, int wc, int fr, int fq) const {
        bf16_t* base = O + (size_t)(u.om * BM + wr * 64 + fr) * DFF + u.pn * 128 + wc * 32 + 8 * fq;
#pragma unroll
        for (int ai = 0; ai < 2; ++ai)
#pragma unroll
            for (int m = 0; m < 4; ++m) { const f32x4 g0 = acc[ai][0][m][0], g1 = acc[ai][0][m][1], u0 = acc[ai][1][m][0], u1 = acc[ai][1][m][1];
                float o[8];
#pragma unroll
                for (int e = 0; e < 4; ++e) { o[e] = silu_f(g0[e]) * u0[e]; o[4 + e] = silu_f(g1[e]) * u1[e]; }
                u32x4 w; w.x = pkbf(o[0], o[1]); w.y = pkbf(o[2], o[3]); w.z = pkbf(o[4], o[5]); w.w = pkbf(o[6], o[7]);
                *(u32x4*)(base + (size_t)(ai * HALF + m * 16) * DFF) = w; }
    }
};
struct EpiQKV {
    static constexpr bool PERM = false;
    bf16_t* O; const float* cosT; const float* sinT; float qscale;
    __device__ __forceinline__ void operator()(const f32x4 (&acc)[2][2][4][2], const Unit& u, int wr, int wc, int fr, int fq) const {
        const bool lat = u.pm < NPL; const bool dorope = lat && u.pn < 5; const float sc = u.pn < 4 ? qscale : 1.0f;
        const int col0 = u.pn * BM + wc * 32 + 4 * fq;
#pragma unroll
        for (int ai = 0; ai < 2; ++ai)
#pragma unroll
            for (int m = 0; m < 4; ++m) { const int grow = u.pm * BM + ai * HALF + wr * 64 + m * 16 + fr; const int s = grow & (SEQ - 1); const int pos = (wc & 1) ? (s & 63) : (s >> 6);
                f32x4 cs = (f32x4){1.f, 1.f, 1.f, 1.f}, sn = (f32x4){0.f, 0.f, 0.f, 0.f};
                if (dorope) { cs = *(const f32x4*)(cosT + pos * 16 + 4 * fq); sn = *(const f32x4*)(sinT + pos * 16 + 4 * fq); }
                bf16_t* rowp = O + (size_t)grow * NQKV + col0;
#pragma unroll
                for (int bj = 0; bj < 2; ++bj) { const f32x4 x1 = acc[ai][bj][m][0], x2 = acc[ai][bj][m][1];
                    const f32x4 o1 = (x1 * cs - x2 * sn) * sc, o2 = (x1 * sn + x2 * cs) * sc;
                    u32x2 w1, w2; w1.x = pkbf(o1[0], o1[1]); w1.y = pkbf(o1[2], o1[3]); w2.x = pkbf(o2[0], o2[1]); w2.y = pkbf(o2[2], o2[3]);
                    *(u32x2*)(rowp + bj * HALF) = w1; *(u32x2*)(rowp + bj * HALF + 16) = w2; } }
    }
};
struct EpiBf16Plain {
    static constexpr bool PERM = true;
    bf16_t* O; int ldc;
    __device__ __forceinline__ void operator()(const f32x4 (&acc)[2][2][4][2], const Unit& u, int wr, int wc, int fr, int fq) const {
        bf16_t* base = O + (size_t)(u.om * BM + wr * 64 + fr) * ldc + u.pn * BM + wc * 32 + 8 * fq;
#pragma unroll
        for (int ai = 0; ai < 2; ++ai)
#pragma unroll
            for (int m = 0; m < 4; ++m)
#pragma unroll
                for (int bj = 0; bj < 2; ++bj) { const f32x4 v0 = acc[ai][bj][m][0], v1 = acc[ai][bj][m][1];
                    u32x4 w; w.x = pkbf(v0[0], v0[1]); w.y = pkbf(v0[2], v0[3]); w.z = pkbf(v1[0], v1[1]); w.w = pkbf(v1[2], v1[3]);
                    *(u32x4*)(base + (size_t)(ai * HALF + m * 16) * ldc + bj * HALF) = w; }
    }
};

struct EpiPartF32 {
    static constexpr bool PERM = false;
    float* P; size_t sstride;
    __device__ __forceinline__ void operator()(const f32x4 (&acc)[2][2][4][2], const Unit& u, int wr, int wc, int fr, int fq) const {
        float* base = P + (size_t)u.ks * sstride + (size_t)(u.om * BM + wr * 64 + fr) * DM + u.pn * BM + wc * 32 + 4 * fq;
#pragma unroll
        for (int ai = 0; ai < 2; ++ai)
#pragma unroll
            for (int m = 0; m < 4; ++m)
#pragma unroll
                for (int bj = 0; bj < 2; ++bj)
#pragma unroll
                    for (int n = 0; n < 2; ++n) *(f32x4*)(base + (size_t)(ai * HALF + m * 16) * DM + bj * HALF + n * 16) = acc[ai][bj][m][n];
    }
};
struct EpiPartBf16 {
    static constexpr bool PERM = true;
    bf16_t* P; size_t sstride;
    __device__ __forceinline__ void operator()(const f32x4 (&acc)[2][2][4][2], const Unit& u, int wr, int wc, int fr, int fq) const {
        bf16_t* base = P + (size_t)u.ks * sstride + (size_t)(u.om * BM + wr * 64 + fr) * DM + u.pn * BM + wc * 32 + 8 * fq;
#pragma unroll
        for (int ai = 0; ai < 2; ++ai)
#pragma unroll
            for (int m = 0; m < 4; ++m)
#pragma unroll
                for (int bj = 0; bj < 2; ++bj) { const f32x4 v0 = acc[ai][bj][m][0], v1 = acc[ai][bj][m][1];
                    u32x4 w; w.x = pkbf(v0[0], v0[1]); w.y = pkbf(v0[2], v0[3]); w.z = pkbf(v1[0], v1[1]); w.w = pkbf(v1[2], v1[3]);
                    *(u32x4*)(base + (size_t)(ai * HALF + m * 16) * DM + bj * HALF) = w; }
    }
};

template <class Epi, class Sched, bool ALIGN_EPI, bool GATHER>
__device__ __forceinline__ void gemm_phase(LAS unsigned char* lds, LAS int* gtab, const int K  , const int nt_in  , const Sched& S, const Epi& E) {
    int nt = nt_in; asm volatile("" : "+s"(nt));
    int tid_ = threadIdx.x; asm volatile("" : "+v"(tid_));
    const int tid = tid_, wid = __builtin_amdgcn_readfirstlane(tid >> 6), lane = tid & 63, wr = wid >> 2, wc = wid & 3, fr = lane & 15, fq = lane >> 4;
    const size_t kstep = (size_t)(BK * 2);
    const size_t hstep = (size_t)HALF * K * 2;
    unsigned voffB[2];
#pragma unroll
    for (int i = 0; i < 2; ++i) { int R, C; stage_rc(tid * 16 + i * 8192, R, C); const int Rb = Epi::PERM ? ((R & ~31) + perm32(R & 31)) : R;
        voffB[i] = (unsigned)(Rb * K + C) * 2u; }
    unsigned vA[2][2], vN[2][2];
    const unsigned ldsw = (unsigned)wid * 1024u;
    const int aoff = lds_byte(wr * 64 + fr, fq * 8), boff = lds_byte(wc * 32 + fr, fq * 8);
#define PG8_SA(b, h) (((b) * 2 + (h)) * HTB)
#define PG8_SB(b, h) ((4 + (b) * 2 + (h)) * HTB)
#define PG8_STAGE(bufoff, gbase, voff) do { _Pragma("unroll") for (int _i = 0; _i < 2; ++_i) \
        __builtin_amdgcn_global_load_lds((const unsigned*)((const char*)(gbase) + (voff)[_i]), (LAS unsigned*)(lds + (bufoff) + ldsw + _i * 8192), 16, 0, 0); } while (0)
#define PG8_LDA(dst, b, h) do { _Pragma("unroll") for (int m = 0; m < 4; ++m) _Pragma("unroll") for (int k = 0; k < 2; ++k) dst[m][k] = *(const LAS bf16x8*)(lds + PG8_SA(b, h) + aoff + m * 2048 + k * 1024); } while (0)
#define PG8_LDB(dst, b, h) do { _Pragma("unroll") for (int n = 0; n < 2; ++n) _Pragma("unroll") for (int k = 0; k < 2; ++k) dst[n][k] = *(const LAS bf16x8*)(lds + PG8_SB(b, h) + boff + n * 2048 + k * 1024); } while (0)
#define PG8_MMA(ai, bj, At, Bt) do { __builtin_amdgcn_s_setprio(1); _Pragma("unroll") for (int m = 0; m < 4; ++m) _Pragma("unroll") for (int n = 0; n < 2; ++n) _Pragma("unroll") for (int k = 0; k < 2; ++k) \
        acc[ai][bj][m][n] = __builtin_amdgcn_mfma_f32_16x16x32_bf16(Bt[n][k], At[m][k], acc[ai][bj][m][n], 0, 0, 0); __builtin_amdgcn_s_setprio(0); } while (0)
#define PG8_WAIT_V(n) asm volatile("s_waitcnt vmcnt(" #n ")" ::: "memory")
#define PG8_WAIT_L(n) asm volatile("s_waitcnt lgkmcnt(" #n ")" ::: "memory")
#define PG8_BAR __builtin_amdgcn_s_barrier()
#define PG8_SCHED __builtin_amdgcn_sched_barrier(0)
    Unit cur, nxt; int ui = 0;
    if (!S.next(0, cur)) return;
    f32x4 acc[2][2][4][2];
#pragma unroll
    for (int a = 0; a < 2; ++a)
#pragma unroll
        for (int b = 0; b < 2; ++b)
#pragma unroll
            for (int m = 0; m < 4; ++m)
#pragma unroll
                for (int n = 0; n < 2; ++n) acc[a][b][m][n] = (f32x4){0.f, 0.f, 0.f, 0.f};
    bf16x8 At[4][2], B0[2][2], B1[2][2];
    if constexpr (GATHER) {
#pragma unroll
        for (int h = 0; h < 2; ++h)
#pragma unroll
            for (int i = 0; i < 2; ++i) { int R, C; stage_rc(tid * 16 + i * 8192, R, C); const int row = h * HALF + R; const int tok = cur.gl[row < cur.nv ? row : 0]; vA[h][i] = (unsigned)tok * (unsigned)(K * 2) + (unsigned)C * 2u; }
    } else {
#pragma unroll
        for (int h = 0; h < 2; ++h)
#pragma unroll
            for (int i = 0; i < 2; ++i) { int R, C; stage_rc(tid * 16 + i * 8192, R, C); vA[h][i] = (unsigned)(R * K + C) * 2u + (unsigned)(h * hstep); }
    }
#pragma unroll
    for (int h = 0; h < 2; ++h)
#pragma unroll
        for (int i = 0; i < 2; ++i) vN[h][i] = vA[h][i];
    const char* cA = cur.a; const char* cB = cur.b;
    PG8_STAGE(PG8_SB(0, 0), cB, voffB); PG8_STAGE(PG8_SB(0, 1), cB + hstep, voffB); PG8_STAGE(PG8_SA(0, 0), cA, vA[0]); PG8_STAGE(PG8_SA(0, 1), cA, vA[1]);
    if (wr == 1) PG8_BAR;
    PG8_WAIT_V(2); PG8_BAR;
    PG8_STAGE(PG8_SB(1, 0), cB + kstep, voffB); PG8_STAGE(PG8_SA(1, 0), cA + kstep, vA[0]); PG8_STAGE(PG8_SB(1, 1), cB + hstep + kstep, voffB);
    PG8_WAIT_V(6); PG8_BAR;
    for (;;) {
        const bool has_next = S.next(ui + 1, nxt);
        const char* nA = has_next ? nxt.a : cA; const char* nB = has_next ? nxt.b : cB;
        if constexpr (GATHER) {
            if (has_next && wid < 4) __builtin_amdgcn_global_load_lds((const unsigned*)(nxt.gl + wid * 64 + lane), (LAS unsigned*)(gtab + wid * 64), 4, 0, 0);
        }
        for (int t = 0; t < nt; t += 2) {
            const bool last = (t == nt - 2);
            const char* a1 = cA + (size_t)(t + 1) * kstep;
            const char* a2 = last ? nA : cA + (size_t)(t + 2) * kstep; const char* b2 = last ? nB : cB + (size_t)(t + 2) * kstep;
            const char* a3 = a2 + kstep; const char* b3 = b2 + kstep;
            if constexpr (GATHER) {
                if (last && has_next) {
                    int t2 = tid; asm volatile("" : "+v"(t2));
#pragma unroll
                    for (int h = 0; h < 2; ++h)
#pragma unroll
                        for (int i = 0; i < 2; ++i) { int R, C; stage_rc(t2 * 16 + i * 8192, R, C); const int row = h * HALF + R; const int tok = gtab[row < nxt.nv ? row : 0]; vN[h][i] = (unsigned)tok * (unsigned)(K * 2) + (unsigned)C * 2u; }
                }
            }
            unsigned vS0[2], vS1[2];
#pragma unroll
            for (int i = 0; i < 2; ++i) { vS0[i] = (GATHER && last) ? vN[0][i] : vA[0][i]; vS1[i] = (GATHER && last) ? vN[1][i] : vA[1][i]; }
            PG8_LDB(B0, 0, 0); PG8_LDB(B1, 0, 1); PG8_SCHED; PG8_LDA(At, 0, 0); PG8_STAGE(PG8_SA(1, 1), a1, vA[1]);
            PG8_WAIT_V(8); PG8_WAIT_L(0); PG8_BAR; PG8_MMA(0, 0, At, B0); PG8_MMA(0, 1, At, B1); PG8_BAR; PG8_SCHED;
            PG8_LDA(At, 0, 1); PG8_STAGE(PG8_SB(0, 0), b2, voffB); PG8_STAGE(PG8_SB(0, 1), b2 + hstep, voffB); PG8_STAGE(PG8_SA(0, 0), a2, vS0);
            PG8_WAIT_V(8); PG8_WAIT_L(0); PG8_BAR; PG8_MMA(1, 0, At, B0); PG8_MMA(1, 1, At, B1); PG8_BAR; PG8_SCHED;
            PG8_LDB(B0, 1, 0); PG8_LDB(B1, 1, 1); PG8_SCHED; PG8_LDA(At, 1, 0); PG8_STAGE(PG8_SA(0, 1), a2, vS1);
            PG8_WAIT_V(8); PG8_WAIT_L(0); PG8_BAR; PG8_MMA(0, 0, At, B0); PG8_MMA(0, 1, At, B1); PG8_BAR; PG8_SCHED;
            PG8_LDA(At, 1, 1); PG8_STAGE(PG8_SB(1, 0), b3, voffB); PG8_STAGE(PG8_SB(1, 1), b3 + hstep, voffB); PG8_STAGE(PG8_SA(1, 0), a3, vS0);
            PG8_WAIT_V(8); PG8_WAIT_L(0); PG8_BAR; PG8_MMA(1, 0, At, B0); PG8_MMA(1, 1, At, B1); PG8_BAR; PG8_SCHED;
        }
        if constexpr (ALIGN_EPI) { if (wr == 0) PG8_BAR; }
        E(acc, cur, wr, wc, fr, fq);
        if (!has_next) break;
#pragma unroll
        for (int a = 0; a < 2; ++a)
#pragma unroll
            for (int b = 0; b < 2; ++b)
#pragma unroll
                for (int m = 0; m < 4; ++m)
#pragma unroll
                    for (int n = 0; n < 2; ++n) acc[a][b][m][n] = (f32x4){0.f, 0.f, 0.f, 0.f};
        cur = nxt; cA = nA; cB = nB; ++ui;
        if constexpr (GATHER) {
#pragma unroll
            for (int h = 0; h < 2; ++h)
#pragma unroll
                for (int i = 0; i < 2; ++i) vA[h][i] = vN[h][i];
        }
        if constexpr (ALIGN_EPI) { if (wr == 1) PG8_BAR; }
    }
    PG8_WAIT_V(0);
    if constexpr (!ALIGN_EPI) { if (wr == 0) PG8_BAR; }
    PG8_BAR;
#undef PG8_SA
#undef PG8_SB
#undef PG8_STAGE
#undef PG8_LDA
#undef PG8_LDB
#undef PG8_MMA
#undef PG8_WAIT_V
#undef PG8_WAIT_L
#undef PG8_BAR
#undef PG8_SCHED
}
}

namespace attn_body {
using bf16 = __hip_bfloat16;
using s16x4 = __attribute__((ext_vector_type(4))) short;
constexpr int D = 64, PITCH = NQKV, OPITCH = DM;
constexpr int NW = 8, QBLK = 32, KVBLK = 64;
__device__ __forceinline__ int crow(int r, int hi) { return (r & 3) + 8 * (r >> 2) + 4 * hi; }
#define SBAR() __builtin_amdgcn_sched_barrier(0)
__device__ __forceinline__ void bmask(f32x16& p0, f32x16& p1, int kb, int qrel, int hi) {
    const float NEG = -INFINITY; const int d0 = kb + 4 * hi - qrel;
#pragma unroll
    for (int r = 0; r < 16; ++r) { const int d = d0 + (r & 3) + 8 * (r >> 2); if (d < -128 || d > 128) p0[r] = NEG; if (d + 32 < -128 || d + 32 > 128) p1[r] = NEG; }
}
constexpr int NSLOT = 3, SLOTB = 8192;
constexpr int LDS_K = 0, LDS_V = NSLOT * SLOTB, LDS_WS = 2 * NSLOT * SLOTB, LDS_OST = LDS_WS + NW * 64 * 4, LDS_BYTES_A = LDS_OST + NW * 4096;
constexpr float C2 = 0.125f * 1.4426950408889634f;
__device__ __forceinline__ void glds16(const void* gsrc, unsigned lds_dst) { unsigned keep;
    asm volatile("s_mov_b32 %0, m0\n\ts_mov_b32 m0, %2\n\ts_nop 0\n\tglobal_load_lds_dwordx4 %1, off\n\ts_mov_b32 m0, %0" : "=&s"(keep) : "v"(gsrc), "s"(lds_dst) : "memory"); }
__device__ __forceinline__ float max3f(float a, float b, float c) { float r; asm("v_max3_f32 %0, %1, %2, %3" : "=v"(r) : "v"(a), "v"(b), "v"(c)); return r; }
__device__ __forceinline__ float max2f(float a, float b) { float r; asm("v_max_f32_e32 %0, %1, %2" : "=v"(r) : "v"(a), "v"(b)); return r; }
__device__ __forceinline__ float fadd_s(float a, float b) { float r; asm("v_add_f32_e32 %0, %1, %2" : "=v"(r) : "v"(a), "v"(b)); return r; }
__device__ __forceinline__ float fsub_s(float a, float b) { float r; asm("v_sub_f32_e32 %0, %1, %2" : "=v"(r) : "v"(a), "v"(b)); return r; }
__device__ __forceinline__ unsigned cvtpk_s(float lo, float hi) { f32x2 v = {lo, hi}; bf16x2_t b = __builtin_convertvector(v, bf16x2_t); return __builtin_bit_cast(unsigned, b); }
#define WAIT_BAR(N) asm volatile("s_waitcnt vmcnt(" #N ") lgkmcnt(0)\n\ts_barrier" ::: "memory")
__device__ __forceinline__ void qkt(f32x16& p0, f32x16& p1, const char* Kslot, const bf16x8* qr, const f32x16& negm, int r32, int hi) {
    const char* kb = Kslot + hi * 1024 + r32 * 16;
#pragma unroll
    for (int d0 = 0; d0 < 4; ++d0) {
        const bf16x8 b0 = *reinterpret_cast<const bf16x8*>(kb + d0 * 2048);
        const bf16x8 b1 = *reinterpret_cast<const bf16x8*>(kb + d0 * 2048 + 512);
        if (d0 == 0) { p0 = __builtin_amdgcn_mfma_f32_32x32x16_bf16(b0, qr[0], negm, 0, 0, 0); p1 = __builtin_amdgcn_mfma_f32_32x32x16_bf16(b1, qr[0], negm, 0, 0, 0); }
        else { p0 = __builtin_amdgcn_mfma_f32_32x32x16_bf16(b0, qr[d0], p0, 0, 0, 0); p1 = __builtin_amdgcn_mfma_f32_32x32x16_bf16(b1, qr[d0], p1, 0, 0, 0); } }
}
typedef __attribute__((address_space(3))) const char* lds_cptr;
typedef short v4i16_t __attribute__((ext_vector_type(4)));
__device__ __forceinline__ void kload8(bf16x8* kf, lds_cptr kp) {
    kf[0] = *(const __attribute__((address_space(3))) bf16x8*)(kp);        kf[1] = *(const __attribute__((address_space(3))) bf16x8*)(kp + 512);
    kf[2] = *(const __attribute__((address_space(3))) bf16x8*)(kp + 2048); kf[3] = *(const __attribute__((address_space(3))) bf16x8*)(kp + 2560);
    kf[4] = *(const __attribute__((address_space(3))) bf16x8*)(kp + 4096); kf[5] = *(const __attribute__((address_space(3))) bf16x8*)(kp + 4608);
    kf[6] = *(const __attribute__((address_space(3))) bf16x8*)(kp + 6144); kf[7] = *(const __attribute__((address_space(3))) bf16x8*)(kp + 6656);
}
__device__ __forceinline__ void kload2(bf16x8* kf, lds_cptr kp, int j) { kf[2 * j] = *(const __attribute__((address_space(3))) bf16x8*)(kp + j * 2048); kf[2 * j + 1] = *(const __attribute__((address_space(3))) bf16x8*)(kp + j * 2048 + 512); }
__device__ __forceinline__ s16x4 vtr(lds_cptr p) { return __builtin_bit_cast(s16x4, __builtin_amdgcn_ds_read_tr16_b64_v4i16((__attribute__((address_space(3))) v4i16_t*)p)); }
__device__ __forceinline__ float rowmax(const f32x16& p0, const f32x16& p1) {
    float a = max3f(p0[0], p0[1], p1[0]), b = max3f(p0[2], p0[3], p1[1]); a = max3f(a, p1[2], p1[3]);
#pragma unroll
    for (int r = 4; r < 16; r += 4) { a = max3f(a, p0[r], p0[r + 1]); b = max3f(b, p0[r + 2], p0[r + 3]); a = max3f(a, p1[r], p1[r + 1]); b = max3f(b, p1[r + 2], p1[r + 3]); }
    const float m = max2f(a, b);
    auto rr = __builtin_amdgcn_permlane32_swap(__float_as_uint(m), __float_as_uint(m), false, false);
    return max2f(__uint_as_float(rr[0]), __uint_as_float(rr[1]));
}
__device__ __forceinline__ void pv(f32x16* o, int vb, bf16x8 pa0, bf16x8 pa1, bf16x8 pa2, bf16x8 pa3) {
#pragma unroll
    for (int d0 = 0; d0 < 2; ++d0) { s16x4 lo[4], hi[4];
#pragma unroll
        for (int ks = 0; ks < 4; ++ks) {
            asm volatile("ds_read_b64_tr_b16 %0,%1 offset:%c2" : "=&v"(lo[ks]) : "v"(vb), "i"(d0 * 4096 + ks * 1024) : "memory");
            asm volatile("ds_read_b64_tr_b16 %0,%1 offset:%c2" : "=&v"(hi[ks]) : "v"(vb), "i"(d0 * 4096 + ks * 1024 + 512) : "memory"); }
        asm volatile("s_waitcnt lgkmcnt(0)" ::: "memory"); SBAR();
#define PK(k) (bf16x8){lo[k][0], lo[k][1], lo[k][2], lo[k][3], hi[k][0], hi[k][1], hi[k][2], hi[k][3]}
        o[d0] = __builtin_amdgcn_mfma_f32_32x32x16_bf16(pa0, PK(0), o[d0], 0, 0, 0);
        o[d0] = __builtin_amdgcn_mfma_f32_32x32x16_bf16(pa1, PK(1), o[d0], 0, 0, 0);
        o[d0] = __builtin_amdgcn_mfma_f32_32x32x16_bf16(pa2, PK(2), o[d0], 0, 0, 0);
        o[d0] = __builtin_amdgcn_mfma_f32_32x32x16_bf16(pa3, PK(3), o[d0], 0, 0, 0);
#undef PK
    }
}
#define ATTN_STORE16(p, v) (*(u32x4*)(p) = (v))
template <int THRL> __device__ __forceinline__ void attn_unit(int b, int hk, int n, int pr, const bf16* QKV, bf16* O, const float* sinkp, char* shm) {
    int tid_ = threadIdx.x; asm volatile("" : "+v"(tid_));
    const int tid = tid_, lane = tid & 63, r32 = lane & 31, hi = lane >> 5; const int wid = __builtin_amdgcn_readfirstlane(tid >> 6);
    const int head = 4 * hk + 2 * pr + (wid >> 2);
    const long rowblk = (long)b * SEQ + n * 128;
    const long ctxrow = (long)NLAT + b * LCTX;
    const int nlo = n > 0 ? 2 : 0, nhi = n < (SEQ / 128 - 1) ? 2 : 0;
    const int NT = 6 + nlo + nhi;
    const bf16* Qw = QKV + (rowblk + (wid & 3) * QBLK) * PITCH + head * D;
    const bf16* Kc = QKV + 1024 + hk * D; const bf16* Vc = QKV + 1280 + hk * D;
    const unsigned lds0 = (unsigned)(uintptr_t)shm;
    float* wsf = (float*)(shm + LDS_WS) + wid * 64;
    const long klane = (long)lane * PITCH + wid * 8;
    const long vlane = (long)(16 * (wid & 3) + (lane >> 2)) * PITCH + (wid >> 2) * 32 + (lane & 3) * 8;
    const unsigned kdst = lds0 + LDS_K + wid * 1024, vdst = lds0 + LDS_V + wid * 1024;
#define TROW(t) (((t) < 2) ? (rowblk + 64 * (t)) : ((t) < 6) ? (ctxrow + 64 * ((t) - 2)) : (rowblk + ((((t) - 6) < nlo) ? (-128 + 64 * ((t) - 6)) : (128 + 64 * ((t) - 6 - nlo)))))
#define TKB(t) (((t) < 6) ? 0 : ((((t) - 6) < nlo) ? (-128 + 64 * ((t) - 6)) : (128 + 64 * ((t) - 6 - nlo))))
#define DMA_K(t, slot) glds16(Kc + TROW(t) * PITCH + klane, (unsigned)__builtin_amdgcn_readfirstlane(kdst + (slot)))
#define DMA_V(t, slot) glds16(Vc + TROW(t) * PITCH + vlane, (unsigned)__builtin_amdgcn_readfirstlane(vdst + (slot)))
    const int vb0 = (int)(lds0 + LDS_V) + ((lane >> 4) & 1) * 32 + (lane & 3) * 8 + (4 * hi + ((lane & 15) >> 2)) * 64;
    const char* Kbase = shm + LDS_K; bf16x8 kf[8];
    const lds_cptr shm3 = (lds_cptr)shm; const lds_cptr kp0 = shm3 + LDS_K + hi * 1024 + r32 * 16; const lds_cptr vp0 = shm3 + LDS_V + ((lane >> 4) & 1) * 32 + (lane & 3) * 8 + (4 * hi + ((lane & 15) >> 2)) * 64;
    DMA_K(0, 0); DMA_V(0, 0); DMA_K(1, SLOTB);
    bf16x8 qr[4];
#pragma unroll
    for (int d0 = 0; d0 < 4; ++d0) qr[d0] = *reinterpret_cast<const bf16x8*>(&Qw[(long)r32 * PITCH + d0 * 16 + hi * 8]);
    float mhat = 0.f, l_reg = 0.f; f32x16 o[2]; o[0] = f32x16{}; o[1] = f32x16{}; f32x16 negm = f32x16{}; asm volatile("" : "+v"(negm));
    const int qrel = (wid & 3) * QBLK + r32;
#define CMASK(P0, P1, t) do { int jb_ = (t) - (NT - 4); if (jb_ >= 0) bmask(P0, P1, TKB(t), qrel, hi); } while (0)
    bool resc = false;
#define START(P0, P1) do { const float rm = rowmax(P0, P1); resc = false; \
    { const float dl = rm; mhat = fadd_s(mhat, dl); \
      _Pragma("unroll") for (int r = 0; r < 16; ++r) { P0[r] = fsub_s(P0[r], dl); P1[r] = fsub_s(P1[r], dl); } \
      _Pragma("unroll") for (int r = 0; r < 16; ++r) negm[r] = -mhat; asm volatile("" : "+v"(negm)); } \
    _Pragma("unroll") for (int r = 0; r < 16; ++r) P0[r] = __builtin_amdgcn_exp2f(P0[r]); } while (0)
#define RESC() do { if (resc) { asm volatile("s_waitcnt lgkmcnt(0)" ::: "memory"); \
      _Pragma("unroll") for (int d_ = 0; d_ < 2; ++d_) _Pragma("unroll") for (int r = 0; r < 16; ++r) o[d_][r] *= wsf[crow(r, hi)]; } } while (0)
    f32x16 pA0, pA1, pB0, pB1;
    int sl_prev = 0, sl_cur = 0, sl_next = SLOTB;
#define ROT() do { sl_prev = sl_cur; sl_cur = sl_next; sl_next = (sl_next == (NSLOT - 1) * SLOTB) ? 0 : sl_next + SLOTB; } while (0)
    DMA_K(2, 2 * SLOTB);
    WAIT_BAR(3);
    qkt(pA0, pA1, Kbase, qr, negm, r32, hi); asm volatile("s_nop 15\n\ts_nop 7" : "+v"(pA0), "+v"(pA1));
    START(pA0, pA1);
    _Pragma("unroll") for (int r = 0; r < 16; ++r) pA1[r] = __builtin_amdgcn_exp2f(pA1[r]);
    WAIT_BAR(0);
    DMA_K(3, 0); DMA_V(1, SLOTB);
    ROT();
    kload8(kf, kp0 + sl_cur);
    WAIT_BAR(2);
    s16x4 vlo[8], vhi[8]; u32x4 pw0, pw1, pw2, pw3;
#define PKW(P, B) cvtpk_s(P[B], P[B + 1])
#define PAF(k) __builtin_bit_cast(bf16x8, pw##k)
#define VFR(i) (bf16x8){vlo[i][0], vlo[i][1], vlo[i][2], vlo[i][3], vhi[i][0], vhi[i][1], vhi[i][2], vhi[i][3]}
#define PIN(x) asm volatile("" : "+v"(x))
#define MX3(a, b, c) __builtin_fmaxf(__builtin_fmaxf((a), (b)), (c))
#define GAPA(MF, A0, A1, A2, A3, W0, W1, PW) do { MF; sacc += A0; sacc += A1; sacc += A2; sacc += A3; PIN(sacc); W0; W1; PIN(PW); SBAR(); } while (0)
#define EX(v) __builtin_amdgcn_exp2f(v)
#define GAPB(MF, X, B) do { MF; X[B] = EX(X[B]); X[B + 1] = EX(X[B + 1]); X[B + 2] = EX(X[B + 2]); X[B + 3] = EX(X[B + 3]); PIN(X); SBAR(); } while (0)
#define VRD(i) do { vlo[i] = vtr(vp_ + (((i) >> 2) * 4096 + ((i) & 3) * 1024)); vhi[i] = vtr(vp_ + (((i) >> 2) * 4096 + ((i) & 3) * 1024 + 512)); } while (0)
#define KRD(G, j) do { if (G) { kload2(kf, kp0 + sl_next, j); SBAR(); } } while (0)
#define STEP(C0, C1, P0, P1, t, GK, GV, GL) do { SBAR(); \
    const lds_cptr vp_ = vp0 + sl_prev; \
    VRD(0); SBAR(); float sacc = (P0[0] + P0[1]); \
    GAPA(C0 = __builtin_amdgcn_mfma_f32_32x32x16_bf16(kf[0], qr[0], negm, 0, 0, 0), P0[2], P0[3], P0[4], P0[5],     pw0[0] = PKW(P0, 0), pw0[1] = PKW(P0, 2), pw0); \
    VRD(4); SBAR(); GAPA(C1 = __builtin_amdgcn_mfma_f32_32x32x16_bf16(kf[1], qr[0], negm, 0, 0, 0), P0[6], P0[7], P0[8], P0[9],     pw0[2] = PKW(P0, 4), pw0[3] = PKW(P0, 6), pw0); \
    VRD(1); SBAR(); GAPA(C0 = __builtin_amdgcn_mfma_f32_32x32x16_bf16(kf[2], qr[1], C0, 0, 0, 0),   P0[10], P0[11], P0[12], P0[13], pw1[0] = PKW(P0, 8), pw1[1] = PKW(P0, 10), pw1); \
    VRD(5); SBAR(); GAPA(C1 = __builtin_amdgcn_mfma_f32_32x32x16_bf16(kf[3], qr[1], C1, 0, 0, 0),   P0[14], P0[15], P1[0], P1[1],   pw1[2] = PKW(P0, 12), pw1[3] = PKW(P0, 14), pw1); \
    VRD(2); SBAR(); GAPA(C0 = __builtin_amdgcn_mfma_f32_32x32x16_bf16(kf[4], qr[2], C0, 0, 0, 0),   P1[2], P1[3], P1[4], P1[5],     pw2[0] = PKW(P1, 0), pw2[1] = PKW(P1, 2), pw2); \
    VRD(6); SBAR(); GAPA(C1 = __builtin_amdgcn_mfma_f32_32x32x16_bf16(kf[5], qr[2], C1, 0, 0, 0),   P1[6], P1[7], P1[8], P1[9],     pw2[2] = PKW(P1, 4), pw2[3] = PKW(P1, 6), pw2); \
    VRD(3); SBAR(); GAPA(C0 = __builtin_amdgcn_mfma_f32_32x32x16_bf16(kf[6], qr[3], C0, 0, 0, 0),   P1[10], P1[11], P1[12], P1[13], pw3[0] = PKW(P1, 8), pw3[1] = PKW(P1, 10), pw3); \
    VRD(7); SBAR(); GAPA(C1 = __builtin_amdgcn_mfma_f32_32x32x16_bf16(kf[7], qr[3], C1, 0, 0, 0),   P1[14], P1[15], 0.f, 0.f,       pw3[2] = PKW(P1, 12), pw3[3] = PKW(P1, 14), pw3); \
    l_reg += sacc; \
    if (GK) { DMA_K((t) + 3, sl_cur); } if (GV) { DMA_V((t) + 1, sl_next); } \
    CMASK(C0, C1, t); \
    { float a = MX3(C0[0], C0[1], C1[0]), b = MX3(C0[2], C0[3], C1[1]); a = MX3(a, C1[2], C1[3]); \
      _Pragma("unroll") for (int r = 4; r < 16; r += 4) { a = MX3(a, C0[r], C0[r + 1]); b = MX3(b, C0[r + 2], C0[r + 3]); a = MX3(a, C1[r], C1[r + 1]); b = MX3(b, C1[r + 2], C1[r + 3]); } \
      float rm = __builtin_fmaxf(a, b); { auto rr = __builtin_amdgcn_permlane32_swap(__float_as_uint(rm), __float_as_uint(rm), false, false); rm = __builtin_fmaxf(__uint_as_float(rr[0]), __uint_as_float(rr[1])); } \
      resc = false; \
      if (__builtin_expect(__any(rm > (float)THRL), 0)) { const float dl = __builtin_fmaxf(rm, 0.f); mhat += dl; \
        _Pragma("unroll") for (int r = 0; r < 16; ++r) { C0[r] -= dl; C1[r] -= dl; } \
        _Pragma("unroll") for (int r = 0; r < 16; ++r) negm[r] = -mhat; asm volatile("" : "+v"(negm)); \
        const float f = __builtin_amdgcn_exp2f(-dl); l_reg *= f; if (hi == 0) wsf[r32] = f; resc = true; } } \
    SBAR(); \
    GAPB(o[0] = __builtin_amdgcn_mfma_f32_32x32x16_bf16(PAF(0), VFR(0), o[0], 0, 0, 0), C0, 0); \
    GAPB(o[1] = __builtin_amdgcn_mfma_f32_32x32x16_bf16(PAF(0), VFR(4), o[1], 0, 0, 0), C0, 4); \
    KRD(GL, 0); GAPB(o[0] = __builtin_amdgcn_mfma_f32_32x32x16_bf16(PAF(1), VFR(1), o[0], 0, 0, 0), C0, 8); \
    KRD(GL, 1); GAPB(o[1] = __builtin_amdgcn_mfma_f32_32x32x16_bf16(PAF(1), VFR(5), o[1], 0, 0, 0), C0, 12); \
    KRD(GL, 2); GAPB(o[0] = __builtin_amdgcn_mfma_f32_32x32x16_bf16(PAF(2), VFR(2), o[0], 0, 0, 0), C1, 0); \
    KRD(GL, 3); GAPB(o[1] = __builtin_amdgcn_mfma_f32_32x32x16_bf16(PAF(2), VFR(6), o[1], 0, 0, 0), C1, 4); \
    GAPB(o[0] = __builtin_amdgcn_mfma_f32_32x32x16_bf16(PAF(3), VFR(3), o[0], 0, 0, 0), C1, 8); \
    GAPB(o[1] = __builtin_amdgcn_mfma_f32_32x32x16_bf16(PAF(3), VFR(7), o[1], 0, 0, 0), C1, 12); \
    } while (0)
    int t = 1;
#undef CMASK
#define CMASK(P0, P1, t) do { } while (0)
    for (; t + 5 < NT; t += 2) {
        STEP(pB0, pB1, pA0, pA1, t, true, true, true);     WAIT_BAR(2); RESC(); ROT();
        STEP(pA0, pA1, pB0, pB1, t + 1, true, true, true); WAIT_BAR(2); RESC(); ROT();
    }
#undef CMASK
#define CMASK(P0, P1, t) do { int jb_ = (t) - (NT - 4); if (jb_ >= 0) bmask(P0, P1, TKB(t), qrel, hi); } while (0)
#define ENDW(tt) do { if ((tt) + 3 < NT) { WAIT_BAR(2); } else if ((tt) + 2 < NT) { WAIT_BAR(1); } else { WAIT_BAR(0); } } while (0)
    for (; t + 1 < NT; t += 2) {
        STEP(pB0, pB1, pA0, pA1, t, (t + 3 < NT), (t + 1 < NT), (t + 1 < NT));     ENDW(t);     RESC(); ROT();
        STEP(pA0, pA1, pB0, pB1, t + 1, (t + 4 < NT), (t + 2 < NT), (t + 2 < NT)); ENDW(t + 1); RESC(); ROT();
    }
    STEP(pB0, pB1, pA0, pA1, NT - 1, false, false, false); RESC();
    { float sacc = pB0[0] + pB0[1]; _Pragma("unroll") for (int r = 2; r < 16; ++r) sacc += pB0[r]; _Pragma("unroll") for (int r = 0; r < 16; ++r) sacc += pB1[r]; l_reg += sacc;
      pw0 = (u32x4){PKW(pB0, 0), PKW(pB0, 2), PKW(pB0, 4), PKW(pB0, 6)}; pw1 = (u32x4){PKW(pB0, 8), PKW(pB0, 10), PKW(pB0, 12), PKW(pB0, 14)}; pw2 = (u32x4){PKW(pB1, 0), PKW(pB1, 2), PKW(pB1, 4), PKW(pB1, 6)}; pw3 = (u32x4){PKW(pB1, 8), PKW(pB1, 10), PKW(pB1, 12), PKW(pB1, 14)};
      SBAR(); pv(o, vb0 + sl_cur, PAF(0), PAF(1), PAF(2), PAF(3)); }
#undef PKW
#undef PAF
#undef VFR
#undef PIN
#undef MX3
#undef GAPA
#undef GAPB
#undef EX
#undef VRD
#undef KRD
#undef STEP
#undef ENDW
    { auto rr = __builtin_amdgcn_permlane32_swap(__float_as_uint(l_reg), __float_as_uint(l_reg), false, false); l_reg = __uint_as_float(rr[0]) + __uint_as_float(rr[1]); }
    l_reg += __builtin_amdgcn_exp2f(sinkp[head] * 1.4426950408889634f - mhat);
    if (hi == 0) wsf[32 + r32] = l_reg; asm volatile("s_waitcnt lgkmcnt(0)" ::: "memory");
    float rli[16];
#pragma unroll
    for (int r = 0; r < 16; ++r) rli[r] = __builtin_amdgcn_rcpf(wsf[32 + crow(r, hi)]);
    bf16* Ow = O + (rowblk + (wid & 3) * QBLK) * OPITCH + head * D;
    { bf16* stg = (bf16*)(shm + LDS_OST) + wid * 2048;
#pragma unroll
      for (int r = 0; r < 16; ++r) { const int orow = crow(r, hi);
#pragma unroll
        for (int d0 = 0; d0 < 2; ++d0) stg[orow * 64 + d0 * 32 + r32] = __float2bfloat16(o[d0][r] * rli[r]); }
      asm volatile("s_waitcnt lgkmcnt(0)" ::: "memory");
#pragma unroll
      for (int i = 0; i < 4; ++i) { const int row = i * 8 + (lane >> 3), ch = lane & 7; const u32x4 v = *(const u32x4*)(stg + row * 64 + ch * 8); ATTN_STORE16(Ow + (long)row * OPITCH + ch * 8, v); } }
    asm volatile("s_waitcnt lgkmcnt(0)\n\ts_barrier" ::: "memory");
#undef DMA_K
#undef DMA_V
#undef TROW
#undef TKB
#undef CMASK
#undef START
#undef RESC
#undef ROT
}
#undef SBAR
#undef WAIT_BAR
}

#define XB_TMO      128
#define XB_XCNT(j)  (256  + 64 * (j))
#define XB_XSUB(j)  (1280 + 64 * (j))
#define XB_XGEN(j)  (2304 + 64 * (j))
#define XB_TOP      3328
#define XB_TOPGEN   3392
#define XCD_BAR_WORDS 3456
#define XB_SPIN_CAP (1u << 18)
__device__ __forceinline__ unsigned xb_ld(unsigned* p)              { return __hip_atomic_load(p, __ATOMIC_RELAXED, __HIP_MEMORY_SCOPE_AGENT); }
__device__ __forceinline__ unsigned xb_add(unsigned* p, unsigned v) { return __hip_atomic_fetch_add(p, v, __ATOMIC_RELAXED, __HIP_MEMORY_SCOPE_AGENT); }
__device__ __forceinline__ unsigned xb_xcc_id() { return (unsigned)__builtin_amdgcn_s_getreg((3 << 11) | 20) & 0xFu; }
#define XB_SPIN(cond, bar) do { unsigned _sp = 0; while (cond) { __builtin_amdgcn_s_sleep(1); \
    if ((++_sp & 255u) == 0u) { if (xb_ld(&(bar)[XB_TMO])) break; if (_sp > XB_SPIN_CAP) { atomicAdd(&(bar)[XB_TMO], 1u); break; } } } } while (0)
struct XcdBarrier { unsigned* bar; unsigned x; volatile LAS unsigned* st; };
__device__ __forceinline__ XcdBarrier xcd_barrier_post(unsigned* bar, volatile LAS unsigned* st) {
    XcdBarrier b; b.bar = bar; b.x = xb_xcc_id(); b.st = st;
    if (threadIdx.x == 0) (void)xb_add(&bar[XB_XCNT(b.x)], 1u);
    return b;
}
__device__ __forceinline__ void xcd_barrier_complete(unsigned* bar, unsigned x, unsigned& nloc, unsigned& nx) {
    const unsigned G = gridDim.x * gridDim.y * gridDim.z;
    unsigned sum, cnt, mine, sp = 0u;
    for (;;) {
        sum = 0u; cnt = 0u; mine = 0u;
#pragma unroll
        for (unsigned j = 0; j < 16; ++j) { const unsigned c = xb_ld(&bar[XB_XCNT(j)]); sum += c; cnt += (c > 0u) ? 1u : 0u; mine = (j == x) ? c : mine; }
        if (sum == G) break;
        __builtin_amdgcn_s_sleep(1);
        if ((++sp & 255u) == 0u) { if (xb_ld(&bar[XB_TMO])) break; if (sp > XB_SPIN_CAP) { atomicAdd(&bar[XB_TMO], 1u); break; } }
    }
    nloc = mine > 0u ? mine : 1u; nx = cnt > 0u ? cnt : 1u;
}
__device__ __forceinline__ void xcd_barrier(const XcdBarrier& b) {
    asm volatile("s_waitcnt vmcnt(0)" ::: "memory");
    __syncthreads();
    if (threadIdx.x == 0) {
        unsigned* bar = b.bar;
        __builtin_amdgcn_s_waitcnt(0);
        unsigned nloc = b.st[0], nx = b.st[1];
        if (nloc == 0u) { xcd_barrier_complete(bar, b.x, nloc, nx); b.st[0] = nloc; b.st[1] = nx; }
        const unsigned old = xb_add(&bar[XB_XSUB(b.x)], 1u);
        const unsigned gen = old / nloc;
        if (old + 1u == (gen + 1u) * nloc) {
            __builtin_amdgcn_fence(__ATOMIC_RELEASE, "agent");
            asm volatile("s_waitcnt vmcnt(0)" ::: "memory");
            const unsigned og = xb_add(&bar[XB_TOP], 1u);
            const unsigned tg = og / nx;
            if (og + 1u == (tg + 1u) * nx) xb_add(&bar[XB_TOPGEN], 1u);
            else XB_SPIN(xb_ld(&bar[XB_TOPGEN]) == tg, bar);
            __builtin_amdgcn_fence(__ATOMIC_ACQUIRE, "agent");
            xb_add(&bar[XB_XGEN(b.x)], 1u);
            asm volatile("s_waitcnt vmcnt(0)" ::: "memory");
        } else {
            XB_SPIN(xb_ld(&bar[XB_XGEN(b.x)]) == gen, bar);
            __builtin_amdgcn_fence(__ATOMIC_ACQUIRE, "agent");
            asm volatile("s_waitcnt vmcnt(0)" ::: "memory");
        }
    }
    __syncthreads();
}

#define LDS_WAIT() asm volatile("s_waitcnt lgkmcnt(0)" ::: "memory")
__device__ __forceinline__ void transpose_item(const float* W, int K, int N, bf16_t* WT, int k0, int n0, int drow0, LAS float* scr, int lane) {
#pragma unroll 8
    for (int i = 0; i < 32; ++i) { const int kk = 2 * i + (lane >> 5); scr[kk * 33 + (lane & 31)] = W[(size_t)(k0 + kk) * N + n0 + (lane & 31)]; }
    LDS_WAIT(); asm volatile("" ::: "memory");
    const int c = lane & 7;
#pragma unroll
    for (int j = 0; j < 4; ++j) { const int n = (lane >> 3) + 8 * j; const LAS float* s = scr + (8 * c) * 33 + n;
        u32x4 o; o.x = pkbf(s[0 * 33], s[1 * 33]); o.y = pkbf(s[2 * 33], s[3 * 33]); o.z = pkbf(s[4 * 33], s[5 * 33]); o.w = pkbf(s[6 * 33], s[7 * 33]);
        *(GAS u32x4*)(WT + (size_t)(drow0 + n) * K + k0 + 8 * c) = o; }
    LDS_WAIT(); asm volatile("" ::: "memory");
}
__device__ __forceinline__ void sincos_d(double x, double& s, double& c) {
    const double TWO_PI = 6.283185307179586476925;
    const double k = __builtin_rint(x / TWO_PI); const double r = x - k * TWO_PI;
    const double r2 = r * r; double ts = r, tc = 1.0; s = r; c = 1.0;
    for (int i = 1; i <= 16; ++i) { tc *= -r2 / (double)((2 * i - 1) * (2 * i)); ts *= -r2 / (double)((2 * i) * (2 * i + 1)); c += tc; s += ts; }
}

struct Args { const float* in[24]; float* out; unsigned char* ws; int ph_lo, ph_hi, li, pad; };
constexpr int NPH = 24;

__device__ __forceinline__ void norm_rows(const float* srcL, const float* srcC, int nrows, const float* g, const float* mod, int shc, int scc, bf16_t* XNo, int gw, int NGW, int lane,
                                          const float* part, int nS, const float* gatec, float* zout) {
    for (int m0 = gw * 4; m0 < nrows; m0 += NGW * 4) {
        const bool lat = m0 < NLAT;
        const float* src = lat ? srcL + (size_t)m0 * DM : srcC + (size_t)(m0 - NLAT) * DM; const int mb = lat ? (m0 >> 13) : 4;
        const GAS f32x4* xr = (const GAS f32x4*)src + lane;
        f32x4 v[4][4];
#pragma unroll
        for (int r = 0; r < 4; ++r)
#pragma unroll
            for (int j = 0; j < 4; ++j) v[r][j] = __builtin_nontemporal_load(xr + r * 256 + 64 * j);
        if (!lat && part != nullptr) {
#pragma unroll
            for (int r = 0; r < 4; ++r) {
                f32x4 a[4];
#pragma unroll
                for (int j = 0; j < 4; ++j) a[j] = (f32x4){0.f, 0.f, 0.f, 0.f};
                for (int s2 = 0; s2 < nS; ++s2) { const GAS f32x4* pr = (const GAS f32x4*)(part + ((size_t)s2 * NCTXR + (m0 + r - NLAT)) * DM) + lane;
#pragma unroll
                    for (int j = 0; j < 4; ++j) a[j] += pr[64 * j]; }
#pragma unroll
                for (int j = 0; j < 4; ++j) v[r][j] += *(const f32x4*)(gatec + 4 * lane + 256 * j) * a[j];
                if (zout != nullptr) { GAS f32x4* zr = (GAS f32x4*)(zout + (size_t)(m0 + r - NLAT) * DM) + lane;
#pragma unroll
                    for (int j = 0; j < 4; ++j) zr[64 * j] = v[r][j]; }
            }
        }
        float ss[4];
#pragma unroll
        for (int r = 0; r < 4; ++r) { ss[r] = 0.f;
#pragma unroll
            for (int j = 0; j < 4; ++j) ss[r] += (v[r][j].x * v[r][j].x + v[r][j].y * v[r][j].y) + (v[r][j].z * v[r][j].z + v[r][j].w * v[r][j].w); }
#pragma unroll
        for (int o = 1; o < 64; o <<= 1) {
#pragma unroll
            for (int r = 0; r < 4; ++r) ss[r] += __shfl_xor(ss[r], o); }
        const float* mrow = mod + (size_t)mb * 6144;
#pragma unroll
        for (int j = 0; j < 4; ++j) { const f32x4 gv = *(const f32x4*)(g + 4 * lane + 256 * j), sc = *(const f32x4*)(mrow + scc * 1024 + 4 * lane + 256 * j), sh = *(const f32x4*)(mrow + shc * 1024 + 4 * lane + 256 * j);
            const f32x4 gm = gv * (sc + 1.0f);
#pragma unroll
            for (int r = 0; r < 4; ++r) { const float rstd = 1.0f / __builtin_sqrtf(ss[r] * (1.0f / DM) + EPS);
                const f32x4 y = (v[r][j] * rstd) * gm + sh; u32x2 w; w.x = pkbf(y.x, y.y); w.y = pkbf(y.z, y.w);
                *((GAS u32x2*)(XNo + (size_t)(m0 + r) * DM) + lane + 64 * j) = w; } }
    }
}

__global__ void __launch_bounds__(512, 2) fwd(Args args) {
    extern __shared__ __attribute__((aligned(16))) unsigned char lds_raw[];
    LAS unsigned char* lds = (LAS unsigned char*)lds_raw;
    volatile LAS unsigned* MISC = (volatile LAS unsigned*)(lds + MISC_OFF);
    LAS int* gtab = (LAS int*)(lds + GTAB_OFF);
    const int G = gridDim.x; const int bx = blockIdx.x; const int vcu = (G % 8 == 0) ? (bx % 8) * (G / 8) + bx / 8 : bx;
    const int NGW = G * 8;
#define PHASE_IDS() int tid_ = threadIdx.x; asm volatile("" : "+v"(tid_)); const int tid = tid_, lane = tid & 63, wave = __builtin_amdgcn_readfirstlane(tid >> 6), gw = vcu * 8 + wave; (void)lane; (void)gw
    unsigned char* ws = args.ws;
    gu32* ctl = (gu32*)(ws + WS_CTL);
#define MOD ((float*)(ws + WS_MOD))
#define ROPE ((float*)(ws + WS_ROPE))
#define STATS ((float*)(ws + WS_STATS))
#define LIST ((int*)(ws + WS_LIST))
#define TINFO ((int*)(ws + WS_TINFO))
#define WSB ((bf16_t*)(ws + WS_WS))
#define WIN ((bf16_t*)(ws + WS_WIN))
#define WAO ((bf16_t*)(ws + WS_WAO))
#define WQKV ((bf16_t*)(ws + WS_WQKV))
#define WBO ((bf16_t*)(ws + WS_WBO))
#define WGU ((bf16_t*)(ws + WS_WGU))
#define WD ((bf16_t*)(ws + WS_WD))
#define MGU ((bf16_t*)(ws + WS_MGU))
#define MD ((bf16_t*)(ws + WS_MD))
#define XN ((bf16_t*)(ws + WS_XN))
#define ZB ((float*)(ws + WS_ZB))
#define UVT ((bf16_t*)(ws + WS_UVT))
#define A2 ((bf16_t*)(ws + WS_A2))
#define HB ((bf16_t*)(ws + WS_H))
#define QKV ((bf16_t*)(ws + WS_QKV))
#define OB ((bf16_t*)(ws + WS_O))
#define YB ((bf16_t*)(ws + WS_Y))
#define HC ((bf16_t*)(ws + WS_HC))
#define YP ((bf16_t*)(ws + WS_YP))
#define PART1 ((float*)(ws + WS_PART1))
#define PART2 ((float*)(ws + WS_PART2))
#define I_X (args.in[0])
#define I_C (args.in[1])
#define I_CTX (args.in[2])
#define I_CCTX (args.in[3])
#define I_ADAW (args.in[4])
#define I_ADAB (args.in[5])
#define I_NORMG (args.in[6])
#define I_FINALG (args.in[7])
#define HL (args.out)

    { PHASE_IDS(); for (int u = tid; u < (LDS_BYTES - MISC_OFF) / 4; u += 512) ((LAS unsigned*)(lds + MISC_OFF))[u] = 0u; }
    __syncthreads();
    const int lo = args.ph_lo, hi_ph = args.ph_hi;
    const bool one_launch = (hi_ph - lo) > 1;
    XcdBarrier bar; bar.bar = (unsigned*)(ctl + CW_BAR) + args.li * XCD_BAR_WORDS; bar.x = 0; bar.st = nullptr;
    if (one_launch) bar = xcd_barrier_post((unsigned*)(ctl + CW_BAR) + args.li * XCD_BAR_WORDS, MISC + 8);
#ifndef PHMASK
#define PHMASK 0xFFFFFFFFu
#endif
#define IN(k) (((PHMASK >> (k)) & 1) && lo <= (k) && (k) < hi_ph)
#define BOTH(k) (IN(k) && IN((k) + 1))
#define GRID_BAR() xcd_barrier(bar)
#if defined(PROBE_LO)
    unsigned long long tpA = __builtin_amdgcn_s_memrealtime(), tpB = 0;
#define PROBE_MARK(k) do { if ((k) == PROBE_LO - 1) tpA = __builtin_amdgcn_s_memrealtime(); if ((k) == PROBE_HI) tpB = __builtin_amdgcn_s_memrealtime(); } while (0)
#else
#define PROBE_MARK(k) do { } while (0)
#endif

    if (IN(0)) {
        PHASE_IDS();
        {
            LAS float* sv = (LAS float*)lds;
            LAS float* red = (LAS float*)(lds + 5 * 1024 * 4);
            if (bx < 192) {
                for (int idx = tid; idx < 5 * 1024; idx += 512) { const int r = idx >> 10, k = idx & 1023; const float cv = r < 4 ? I_C[r * 1024 + k] : I_CCTX[k]; sv[idx] = cv / (1.0f + __expf(-cv)); }
                __syncthreads();
                for (int item = bx; item < 192; item += G) {
                    const int i = item / 96, n0 = (item % 96) * 64, nn = tid & 63, kq = tid >> 6;
                    float a0 = 0.f, a1 = 0.f, a2 = 0.f, a3 = 0.f, a4 = 0.f;
                    const float* wp = I_ADAW + ((size_t)i * 1024 + kq * 128) * 6144 + n0 + nn;
#pragma unroll 8
                    for (int k = 0; k < 128; ++k) { const float w = wp[(size_t)k * 6144]; const int kk = kq * 128 + k;
                        a0 += sv[kk] * w; a1 += sv[1024 + kk] * w; a2 += sv[2048 + kk] * w; a3 += sv[3072 + kk] * w; a4 += sv[4096 + kk] * w; }
                    red[(kq * 5 + 0) * 64 + nn] = a0; red[(kq * 5 + 1) * 64 + nn] = a1; red[(kq * 5 + 2) * 64 + nn] = a2; red[(kq * 5 + 3) * 64 + nn] = a3; red[(kq * 5 + 4) * 64 + nn] = a4;
                    __syncthreads();
                    if (tid < 320) { const int r = tid >> 6; float s = I_ADAB[i * 6144 + n0 + nn];
#pragma unroll
                        for (int q = 0; q < 8; ++q) s += red[(q * 5 + r) * 64 + nn];
                        MOD[((size_t)i * 5 + r) * 6144 + n0 + nn] = s; }
                    __syncthreads();
                }
            }
            __syncthreads();
        }
        {
            LAS float* scr = (LAS float*)(lds + wave * 16384);
            constexpr int I_IN = 16 * 64, I_AO = 16 * 32, I_QKV = 16 * 48, I_BO = 16 * 32, I_F = 16 * 112, I_FD = 56 * 32;
            constexpr int I_DENSE = I_IN + I_AO + I_QKV + I_BO + 2 * I_F + I_FD, I_MOE = 8 * (2 * I_F + I_FD), I_WS = 128, I_ROPE = 32;
            constexpr int NITEMS = I_DENSE + I_MOE + I_WS + I_ROPE;
            for (int it = gw; it < NITEMS; it += NGW) {
                int r = it;
                if (r < I_IN) { const int kb = r / 64, nb = r % 64; transpose_item(args.in[8], 1024, 2048, WIN, 64 * kb, 32 * nb, 32 * nb, scr, lane); continue; } r -= I_IN;
                if (r < I_AO) { const int kb = r / 32, nb = r % 32; transpose_item(args.in[13], 1024, 1024, WAO, 64 * kb, 32 * nb, 32 * nb, scr, lane); continue; } r -= I_AO;
                if (r < I_QKV) { const int kb = r / 48, nb = r % 48; transpose_item(args.in[14], 1024, 1536, WQKV, 64 * kb, 32 * nb, 32 * nb, scr, lane); continue; } r -= I_QKV;
                if (r < I_BO) { const int kb = r / 32, nb = r % 32; transpose_item(args.in[16], 1024, 1024, WBO, 64 * kb, 32 * nb, 32 * nb, scr, lane); continue; } r -= I_BO;
                if (r < 2 * I_F) { const int up = r / I_F; const int q = r % I_F; const int kb = q / 112, nb = q % 112, n0 = 32 * nb;
                    transpose_item(args.in[17 + up], 1024, DFF, WGU, 64 * kb, n0, 256 * (n0 >> 7) + 128 * up + (n0 & 127), scr, lane); continue; } r -= 2 * I_F;
                if (r < I_FD) { const int kb = r / 32, nb = r % 32; transpose_item(args.in[19], DFF, 1024, WD, 64 * kb, 32 * nb, 32 * nb, scr, lane); continue; } r -= I_FD;
                if (r < I_MOE) { const int e = r / (2 * I_F + I_FD); int q = r % (2 * I_F + I_FD);
                    if (q < 2 * I_F) { const int up = q / I_F; q %= I_F; const int kb = q / 112, nb = q % 112, n0 = 32 * nb;
                        transpose_item(args.in[21 + up] + (size_t)e * 1024 * DFF, 1024, DFF, MGU + (size_t)e * 7168 * 1024, 64 * kb, n0, 256 * (n0 >> 7) + 128 * up + (n0 & 127), scr, lane); }
                    else { q -= 2 * I_F; const int kb = q / 32, nb = q % 32; transpose_item(args.in[23] + (size_t)e * DFF * 1024, DFF, 1024, MD + (size_t)e * 1024 * DFF, 64 * kb, 32 * nb, 32 * nb, scr, lane); }
                    continue; } r -= I_MOE;
                if (r < I_WS) { const float* src = args.in[11] + (size_t)r * 2048;
#pragma unroll
                    for (int j = 0; j < 8; ++j) { const f32x4 v = *(const f32x4*)(src + j * 256 + lane * 4); u32x2 w; w.x = pkbf(v.x, v.y); w.y = pkbf(v.z, v.w); *(u32x2*)(WSB + (size_t)r * 2048 + j * 256 + lane * 4) = w; }
                    continue; } r -= I_WS;
                {
                    const int ent = r * 64 + lane; const int pos = ent >> 4, i = ent & 15;
                    double inv = 1.0; for (int q = 0; q < i; ++q) inv *= 0.56234132519034908;
                    const float ang = (float)pos * (float)inv; double s, c; sincos_d((double)ang, s, c);
                    ROPE[ent] = (float)c; ROPE[2048 + ent] = (float)s;
                }
            }
        }
        if (BOTH(0)) GRID_BAR(); PROBE_MARK(0);
    }
    if (IN(1)) { PHASE_IDS(); norm_rows(I_X, I_CTX, MALL, I_NORMG + 0 * 1024, MOD, 0, 1, XN, gw, NGW, lane, nullptr, 0, nullptr, nullptr); if (BOTH(1)) GRID_BAR(); PROBE_MARK(1); }
    if (IN(2)) {
        pg8::DenseSched S{(const char*)WIN, (const char*)XN, 8, NPA, G, bx, (size_t)256 * 1024 * 2};
        pg8::EpiGeluT E{UVT, STATS};
        pg8::gemm_phase<pg8::EpiGeluT, pg8::DenseSched, true, false>(lds, gtab, 1024, 16, S, E);
        if (BOTH(2)) GRID_BAR(); PROBE_MARK(2);
    }
    if (IN(3)) {
        PHASE_IDS();
        const float* vg = args.in[9]; const float* vb = args.in[10]; const float* bs = args.in[12];
        LAS float* mu_l = (LAS float*)(lds + wave * 1024); LAS float* rs_l = mu_l + 128;
        const int r32 = lane & 31, h = lane >> 5;
        for (int unit = gw; unit < (MALL / 128) * 16; unit += NGW) {
            const int ch = unit >> 4, g = unit & 15, q0 = ch * 128;
#pragma unroll
            for (int tt = 0; tt < 2; ++tt) { const int tok = q0 + lane * 2 + tt; const f32x4* sp = (const f32x4*)(STATS + (size_t)tok * 16);
                const f32x4 a = sp[0], b = sp[1], c = sp[2], d = sp[3];
                const float sum = (a.x + a.z) + (b.x + b.z) + (c.x + c.z) + (d.x + d.z), sq = (a.y + a.w) + (b.y + b.w) + (c.y + c.w) + (d.y + d.w);
                const float mean = sum * (1.0f / 1024.0f), var = sq * (1.0f / 1024.0f) - mean * mean;
                mu_l[lane * 2 + tt] = mean; rs_l[lane * 2 + tt] = 1.0f / __builtin_sqrtf(var + EPS); }
            float vgc[2], vbc[2];
#pragma unroll
            for (int ct = 0; ct < 2; ++ct) { vgc[ct] = vg[64 * g + 32 * ct + r32]; vbc[ct] = vb[64 * g + 32 * ct + r32]; }
            f32x16 acc[2][4];
#pragma unroll
            for (int ct = 0; ct < 2; ++ct)
#pragma unroll
                for (int pt = 0; pt < 4; ++pt) acc[ct][pt] = f32x16{};
#pragma unroll 2
            for (int s = 0; s < 8; ++s) {
                const int qs = 16 * s + 8 * h;
                const f32x4 m0 = *(const LAS f32x4*)(mu_l + qs), m1 = *(const LAS f32x4*)(mu_l + qs + 4), r0 = *(const LAS f32x4*)(rs_l + qs), r1 = *(const LAS f32x4*)(rs_l + qs + 4);
                bf16x8 af[2], bfr[4];
#pragma unroll
                for (int ct = 0; ct < 2; ++ct) { const bf16x8 raw = *(const bf16x8*)(UVT + (size_t)(1024 + 64 * g + 32 * ct + r32) * MALL + q0 + qs);
                    float y[8];
#pragma unroll
                    for (int j = 0; j < 4; ++j) { y[j] = (bf2f((unsigned short)raw[j]) - m0[j]) * r0[j] * vgc[ct] + vbc[ct]; y[4 + j] = (bf2f((unsigned short)raw[4 + j]) - m1[j]) * r1[j] * vgc[ct] + vbc[ct]; }
                    u32x4 w; w.x = pkbf(y[0], y[1]); w.y = pkbf(y[2], y[3]); w.z = pkbf(y[4], y[5]); w.w = pkbf(y[6], y[7]); af[ct] = __builtin_bit_cast(bf16x8, w); }
#pragma unroll
                for (int pt = 0; pt < 4; ++pt) bfr[pt] = *(const bf16x8*)(WSB + (size_t)(g * 128 + 32 * pt + r32) * 128 + qs);
#pragma unroll
                for (int ct = 0; ct < 2; ++ct)
#pragma unroll
                    for (int pt = 0; pt < 4; ++pt) acc[ct][pt] = __builtin_amdgcn_mfma_f32_32x32x16_bf16(af[ct], bfr[pt], acc[ct][pt], 0, 0, 0);
            }
#pragma unroll
            for (int pt = 0; pt < 4; ++pt) { const int p = 32 * pt + r32; const size_t tokp = (size_t)q0 + p; const float bsv = bs[g * 128 + p];
#pragma unroll
                for (int ct = 0; ct < 2; ++ct)
#pragma unroll
                    for (int rr = 0; rr < 4; ++rr) { const int c = 64 * g + 32 * ct + 8 * rr + 4 * h; float o[4];
#pragma unroll
                        for (int e = 0; e < 4; ++e) { const float uu = bf2f(UVT[(size_t)(c + e) * MALL + tokp]); o[e] = uu * (acc[ct][pt][4 * rr + e] + bsv); }
                        u32x2 w; w.x = pkbf(o[0], o[1]); w.y = pkbf(o[2], o[3]); *(u32x2*)(A2 + tokp * DM + c) = w; } }
        }
        if (BOTH(3)) GRID_BAR(); PROBE_MARK(3);
    }
    if (IN(4)) {
        { pg8::DenseSched S{(const char*)A2, (const char*)WAO, NPL, 4, G, bx, (size_t)256 * 1024 * 2};
          pg8::EpiResid E{I_X, I_CTX, HL, ZB, MOD + 2 * 1024};
          pg8::gemm_phase<pg8::EpiResid, pg8::DenseSched, true, false>(lds, gtab, 1024, 16, S, E); }
        { pg8::SplitSched S{(const char*)(A2 + (size_t)NLAT * DM), (const char*)WAO, 4, 4, P3_NS, G, bx, NPL, (size_t)256 * 1024 * 2, (size_t)(1024 / P3_NS) * 2};
          pg8::EpiPartF32 E{PART1, (size_t)NCTXR * DM};
          pg8::gemm_phase<pg8::EpiPartF32, pg8::SplitSched, true, false>(lds, gtab, 1024, 1024 / P3_NS / 64, S, E); }
        if (BOTH(4)) GRID_BAR(); PROBE_MARK(4);
    }
    if (IN(5)) { PHASE_IDS(); norm_rows(HL, I_CTX, MALL, I_NORMG + 1 * 1024, MOD, 3, 4, XN, gw, NGW, lane, PART1, P3_NS, MOD + 4 * 6144 + 2 * 1024, ZB); if (BOTH(5)) GRID_BAR(); PROBE_MARK(5); }
    if (IN(6)) {
        pg8::DenseSched S{(const char*)XN, (const char*)WGU, NPA, 28, G, bx, (size_t)256 * 1024 * 2};
        pg8::EpiSwiGLU E{HB};
        pg8::gemm_phase<pg8::EpiSwiGLU, pg8::DenseSched, true, false>(lds, gtab, 1024, 16, S, E);
        if (BOTH(6)) GRID_BAR(); PROBE_MARK(6);
    }
    if (IN(7)) {
        { pg8::DenseSched S{(const char*)HB, (const char*)WD, NPL, 4, G, bx, (size_t)256 * DFF * 2};
          pg8::EpiResid E{HL, ZB, HL, ZB, MOD + 5 * 1024};
          pg8::gemm_phase<pg8::EpiResid, pg8::DenseSched, true, false>(lds, gtab, DFF, 56, S, E); }
        { pg8::SplitSched S{(const char*)(HB + (size_t)NLAT * DFF), (const char*)WD, 4, 4, P5_NS, G, bx, NPL, (size_t)256 * DFF * 2, (size_t)(DFF / P5_NS) * 2};
          pg8::EpiPartF32 E{PART2, (size_t)NCTXR * DM};
          pg8::gemm_phase<pg8::EpiPartF32, pg8::SplitSched, true, false>(lds, gtab, DFF, DFF / P5_NS / 64, S, E); }
        if (BOTH(7)) GRID_BAR(); PROBE_MARK(7);
    }
    if (IN(8)) { PHASE_IDS(); norm_rows(HL, ZB, MALL, I_NORMG + 2 * 1024, MOD + 5 * 6144, 0, 1, XN, gw, NGW, lane, PART2, P5_NS, MOD + 4 * 6144 + 5 * 1024, nullptr); if (BOTH(8)) GRID_BAR(); PROBE_MARK(8); }
    if (IN(9)) {
        pg8::DenseSched S{(const char*)XN, (const char*)WQKV, NPA, 6, G, bx, (size_t)256 * 1024 * 2};
        pg8::EpiQKV E{QKV, ROPE, ROPE + 2048, attn_body::C2};
        pg8::gemm_phase<pg8::EpiQKV, pg8::DenseSched, true, false>(lds, gtab, 1024, 16, S, E);
        if (BOTH(9)) GRID_BAR(); PROBE_MARK(9);
    }
    if (IN(10)) {
        static_assert(attn_body::LDS_BYTES_A <= RING_BYTES, "attention LDS");
        const float* sinkp = args.in[15];
        for (int i = 0;; ++i) { const int uid = i * G + vcu; if (uid >= NB * 64 * 4 * 2) break;
            const int pr = uid & 1, hk = (uid >> 1) & 3, n = (uid >> 3) & 63, b = uid >> 9;
            attn_body::attn_unit<8>(b, hk, n, pr, (const attn_body::bf16*)QKV, (attn_body::bf16*)OB, sinkp, (char*)lds_raw); }
        if (BOTH(10)) GRID_BAR(); PROBE_MARK(10);
    }
    if (IN(11)) {
        pg8::DenseSched S{(const char*)OB, (const char*)WBO, NPL, 4, G, bx, (size_t)256 * 1024 * 2};
        pg8::EpiResid E{HL, ZB, HL, ZB, MOD + 5 * 6144 + 2 * 1024};
        pg8::gemm_phase<pg8::EpiResid, pg8::DenseSched, true, false>(lds, gtab, 1024, 16, S, E);
        if (BOTH(11)) GRID_BAR(); PROBE_MARK(11);
    }
    if (IN(12)) {
        PHASE_IDS();
        const float* g = I_NORMG + 3 * 1024; const float* mod = MOD + 5 * 6144; const float* wrt = args.in[20];
        LAS int* l_e = (LAS int*)lds;
        LAS float* l_w = (LAS float*)(lds + 1024);
        LAS int* l_cnt = (LAS int*)(lds + 2048);
        LAS int* l_base = (LAS int*)(lds + 2048 + 64);
        for (int blk = bx; blk < NLAT / 128; blk += G) {
            if (tid < 8) l_cnt[tid] = 0;
            __syncthreads();
            const int mb = (blk * 128) >> 13; const float* mrow = mod + (size_t)mb * 6144;
            for (int i4 = 0; i4 < 8; ++i4) {
                const int tl0 = wave * 16 + i4 * 2, m0 = blk * 128 + tl0;
                const GAS f32x4* xr = (const GAS f32x4*)(HL + (size_t)m0 * DM) + lane;
                f32x4 v[2][4]; float ss[2];
#pragma unroll
                for (int r = 0; r < 2; ++r)
#pragma unroll
                    for (int j = 0; j < 4; ++j) v[r][j] = xr[r * 256 + 64 * j];
#pragma unroll
                for (int r = 0; r < 2; ++r) { ss[r] = 0.f;
#pragma unroll
                    for (int j = 0; j < 4; ++j) ss[r] += (v[r][j].x * v[r][j].x + v[r][j].y * v[r][j].y) + (v[r][j].z * v[r][j].z + v[r][j].w * v[r][j].w); }
#pragma unroll
                for (int o = 1; o < 64; o <<= 1) {
#pragma unroll
                    for (int r = 0; r < 2; ++r) ss[r] += __shfl_xor(ss[r], o); }
                float lg[2][8];
#pragma unroll
                for (int r = 0; r < 2; ++r)
#pragma unroll
                    for (int e = 0; e < 8; ++e) lg[r][e] = 0.f;
#pragma unroll
                for (int j = 0; j < 4; ++j) { const int col = 4 * lane + 256 * j; const f32x4 gv = *(const f32x4*)(g + col), sc = *(const f32x4*)(mrow + 4 * 1024 + col), sh = *(const f32x4*)(mrow + 3 * 1024 + col);
                    const f32x4 gm = gv * (sc + 1.0f);
                    f32x4 y[2];
#pragma unroll
                    for (int r = 0; r < 2; ++r) { const float rstd = 1.0f / __builtin_sqrtf(ss[r] * (1.0f / DM) + EPS); y[r] = (v[r][j] * rstd) * gm + sh;
                        u32x2 w; w.x = pkbf(y[r].x, y[r].y); w.y = pkbf(y[r].z, y[r].w); *((GAS u32x2*)(XN + (size_t)(m0 + r) * DM) + lane + 64 * j) = w; }
#pragma unroll
                    for (int cc = 0; cc < 4; ++cc) { const f32x4 w0 = *(const f32x4*)(wrt + (size_t)(col + cc) * 8), w1 = *(const f32x4*)(wrt + (size_t)(col + cc) * 8 + 4);
#pragma unroll
                        for (int r = 0; r < 2; ++r) { const float yv = y[r][cc];
                            lg[r][0] += yv * w0.x; lg[r][1] += yv * w0.y; lg[r][2] += yv * w0.z; lg[r][3] += yv * w0.w; lg[r][4] += yv * w1.x; lg[r][5] += yv * w1.y; lg[r][6] += yv * w1.z; lg[r][7] += yv * w1.w; } } }
#pragma unroll
                for (int o = 1; o < 64; o <<= 1) {
#pragma unroll
                    for (int r = 0; r < 2; ++r)
#pragma unroll
                        for (int e = 0; e < 8; ++e) lg[r][e] += __shfl_xor(lg[r][e], o); }
#pragma unroll
                for (int r = 0; r < 2; ++r) {
                    int ea = 0; float va = lg[r][0];
#pragma unroll
                    for (int e = 1; e < 8; ++e) if (lg[r][e] > va) { va = lg[r][e]; ea = e; }
                    int eb = -1; float vb2 = -INFINITY;
#pragma unroll
                    for (int e = 0; e < 8; ++e) if (e != ea && lg[r][e] > vb2) { vb2 = lg[r][e]; eb = e; }
                    const float wb = 1.0f / (1.0f + __expf(va - vb2)), wa = 1.0f - wb;
                    if (lane == 0) { const int tl = tl0 + r; l_e[tl * 2] = ea; l_e[tl * 2 + 1] = eb; l_w[tl * 2] = wa; l_w[tl * 2 + 1] = wb; } }
            }
            __syncthreads();
            int ea = 0, eb = 0, pa = 0, pb = 0;
            if (tid < 128) { ea = l_e[tid * 2]; eb = l_e[tid * 2 + 1]; pa = atomicAdd((int*)&l_cnt[ea], 1); pb = atomicAdd((int*)&l_cnt[eb], 1); }
            __syncthreads();
            if (tid < 8) l_base[tid] = (int)__hip_atomic_fetch_add((unsigned*)(ctl + CW_CNT + 64 * tid), (unsigned)l_cnt[tid], __ATOMIC_RELAXED, __HIP_MEMORY_SCOPE_AGENT);
            __syncthreads();
            if (tid < 128) { const int m = blk * 128 + tid; pa += l_base[ea]; pb += l_base[eb];
                LIST[(size_t)ea * NLAT + pa] = m; LIST[(size_t)eb * NLAT + pb] = m;
                int* ti = TINFO + (size_t)m * 8; ti[0] = ea; ti[1] = pa; ti[2] = eb; ti[3] = pb; ti[4] = __float_as_int(l_w[tid * 2]); ti[5] = __float_as_int(l_w[tid * 2 + 1]); }
            __syncthreads();
        }
        if (BOTH(12)) GRID_BAR(); PROBE_MARK(12);
    }
    if (hi_ph > 13 && lo < 23) {
        PHASE_IDS();
        LAS int* mtab = (LAS int*)(lds + MOE_OFF);
        if (tid == 0) { int run = 0, R = 0;
            for (int e = 0; e < 8; ++e) { const int ce = (int)__hip_atomic_load((unsigned*)(ctl + CW_CNT + 64 * e), __ATOMIC_RELAXED, __HIP_MEMORY_SCOPE_AGENT); mtab[e] = run; mtab[16 + e] = ce; run += ce >> 8; if (ce & 255) { mtab[24 + R] = e; ++R; } }
            mtab[8] = run; mtab[32] = R; }
        __syncthreads();
        const int nfull = __builtin_amdgcn_readfirstlane(mtab[8]);
        for (int c = 0; c < MOE_NCH; ++c) {
            const int gp0 = c * MOE_CH, gp1 = nfull < (c + 1) * MOE_CH ? nfull : (c + 1) * MOE_CH;
            if (IN(13 + 2 * c)) {
                pg8::MoeSched S; S.A = (const char*)XN; S.B = (const char*)MGU; S.list = LIST; S.tab = mtab; S.mode = 0; S.nS = 1; S.kbytes = 0;
                S.gp0 = gp0; S.gp1 = gp1; S.nN = 28; S.G = G; S.c = bx; S.bexp = (size_t)7168 * 1024 * 2; S.btile = (size_t)256 * 1024 * 2; S.astep = 0; S.gather = true;
                pg8::EpiSwiGLU E{HC};
                pg8::gemm_phase<pg8::EpiSwiGLU, pg8::MoeSched, true, true>(lds, gtab, 1024, 16, S, E);
                if (BOTH(13 + 2 * c)) GRID_BAR(); PROBE_MARK(13 + 2 * c);
            }
            if (IN(14 + 2 * c)) {
                pg8::MoeSched S; S.A = (const char*)HC; S.B = (const char*)MD; S.list = LIST; S.tab = mtab; S.mode = 0; S.nS = 1; S.kbytes = 0;
                S.gp0 = gp0; S.gp1 = gp1; S.nN = 4; S.G = G; S.c = bx; S.bexp = (size_t)1024 * DFF * 2; S.btile = (size_t)256 * DFF * 2; S.astep = (size_t)256 * DFF * 2; S.gather = false;
                pg8::EpiBf16Plain E{YB, DM};
                pg8::gemm_phase<pg8::EpiBf16Plain, pg8::MoeSched, true, false>(lds, gtab, DFF, 56, S, E);
                if (BOTH(14 + 2 * c)) GRID_BAR(); PROBE_MARK(14 + 2 * c);
            }
        }
        if (IN(21)) {
            pg8::MoeSched S; S.A = (const char*)XN; S.B = (const char*)MGU; S.list = LIST; S.tab = mtab; S.mode = 1; S.nS = 1; S.kbytes = 0;
            S.gp0 = 0; S.gp1 = 0; S.nN = 28; S.G = G; S.c = bx; S.bexp = (size_t)7168 * 1024 * 2; S.btile = (size_t)256 * 1024 * 2; S.astep = 0; S.gather = true;
            pg8::EpiSwiGLU E{HC};
            pg8::gemm_phase<pg8::EpiSwiGLU, pg8::MoeSched, true, true>(lds, gtab, 1024, 16, S, E);
            if (BOTH(21)) GRID_BAR(); PROBE_MARK(21);
        }
        if (IN(22)) {
            pg8::MoeSched S; S.A = (const char*)HC; S.B = (const char*)MD; S.list = LIST; S.tab = mtab; S.mode = 2; S.nS = MOE_RS; S.kbytes = (size_t)(DFF / MOE_RS) * 2;
            S.gp0 = 0; S.gp1 = 0; S.nN = 4; S.G = G; S.c = bx; S.bexp = (size_t)1024 * DFF * 2; S.btile = (size_t)256 * DFF * 2; S.astep = (size_t)256 * DFF * 2; S.gather = false;
            pg8::EpiPartBf16 E{YP, (size_t)8 * 256 * DM};
            pg8::gemm_phase<pg8::EpiPartBf16, pg8::MoeSched, true, false>(lds, gtab, DFF, DFF / MOE_RS / 64, S, E);
            if (BOTH(22)) GRID_BAR(); PROBE_MARK(22);
        }
    }
    if (IN(23)) {
        PHASE_IDS();
        LAS int* l_pb = (LAS int*)(lds + wave * 128);
        if (lane == 0) { int run = 0, R = 0;
            for (int e = 0; e < 8; ++e) { const int ce = (int)__hip_atomic_load((unsigned*)(ctl + CW_CNT + 64 * e), __ATOMIC_RELAXED, __HIP_MEMORY_SCOPE_AGENT); l_pb[e] = run; l_pb[8 + e] = ce >> 8; l_pb[16 + e] = R; run += ce >> 8; if (ce & 255) ++R; } }
        const float* g2 = MOD + 5 * 6144 + 5 * 1024;
        for (int m0 = gw * 2; m0 < NLAT; m0 += NGW * 2) {
            const int mb = m0 >> 13;
            f32x4 hv[2][4], ya[2][4], yb[2][4]; float wa[2], wb[2];
#pragma unroll
            for (int r = 0; r < 2; ++r) {
                const int m = m0 + r; const int* ti = TINFO + (size_t)m * 8;
                const int ea = ti[0], pa = ti[1], eb = ti[2], pb = ti[3]; wa[r] = __int_as_float(ti[4]); wb[r] = __int_as_float(ti[5]);
                const bool ma = (pa >> 8) < l_pb[8 + ea], mbm = (pb >> 8) < l_pb[8 + eb];
                const size_t sa = ma ? (size_t)(l_pb[ea] + (pa >> 8)) * 256 + (pa & 255) : (size_t)l_pb[16 + ea] * 256 + (pa & 255);
                const size_t sb = mbm ? (size_t)(l_pb[eb] + (pb >> 8)) * 256 + (pb & 255) : (size_t)l_pb[16 + eb] * 256 + (pb & 255);
                const GAS f32x4* xr = (const GAS f32x4*)(HL + (size_t)m * DM) + lane;
#pragma unroll
                for (int j = 0; j < 4; ++j) hv[r][j] = xr[64 * j];
                { const GAS u32x2* yr = (const GAS u32x2*)((ma ? YB : YP) + sa * DM) + lane;
#pragma unroll
                  for (int j = 0; j < 4; ++j) { const u32x2 a = yr[64 * j]; ya[r][j] = (f32x4){__uint_as_float(a.x << 16), __uint_as_float(a.x & 0xffff0000u), __uint_as_float(a.y << 16), __uint_as_float(a.y & 0xffff0000u)}; }
                  if (!ma) for (int s2 = 1; s2 < MOE_RS; ++s2) { const GAS u32x2* y2 = (const GAS u32x2*)(YP + ((size_t)s2 * 8 * 256 + sa) * DM) + lane;
#pragma unroll
                      for (int j = 0; j < 4; ++j) { const u32x2 a = y2[64 * j]; ya[r][j] += (f32x4){__uint_as_float(a.x << 16), __uint_as_float(a.x & 0xffff0000u), __uint_as_float(a.y << 16), __uint_as_float(a.y & 0xffff0000u)}; } } }
                { const GAS u32x2* yr = (const GAS u32x2*)((mbm ? YB : YP) + sb * DM) + lane;
#pragma unroll
                  for (int j = 0; j < 4; ++j) { const u32x2 a = yr[64 * j]; yb[r][j] = (f32x4){__uint_as_float(a.x << 16), __uint_as_float(a.x & 0xffff0000u), __uint_as_float(a.y << 16), __uint_as_float(a.y & 0xffff0000u)}; }
                  if (!mbm) for (int s2 = 1; s2 < MOE_RS; ++s2) { const GAS u32x2* y2 = (const GAS u32x2*)(YP + ((size_t)s2 * 8 * 256 + sb) * DM) + lane;
#pragma unroll
                      for (int j = 0; j < 4; ++j) { const u32x2 a = y2[64 * j]; yb[r][j] += (f32x4){__uint_as_float(a.x << 16), __uint_as_float(a.x & 0xffff0000u), __uint_as_float(a.y << 16), __uint_as_float(a.y & 0xffff0000u)}; } } }
            }
            float ss[2];
#pragma unroll
            for (int r = 0; r < 2; ++r) { ss[r] = 0.f;
#pragma unroll
                for (int j = 0; j < 4; ++j) { const f32x4 gv = *(const f32x4*)(g2 + (size_t)mb * 6144 + 4 * lane + 256 * j);
                    hv[r][j] = hv[r][j] + gv * (ya[r][j] * wa[r] + yb[r][j] * wb[r]); ss[r] += (hv[r][j].x * hv[r][j].x + hv[r][j].y * hv[r][j].y) + (hv[r][j].z * hv[r][j].z + hv[r][j].w * hv[r][j].w); } }
#pragma unroll
            for (int o = 1; o < 64; o <<= 1) {
#pragma unroll
                for (int r = 0; r < 2; ++r) ss[r] += __shfl_xor(ss[r], o); }
#pragma unroll
            for (int r = 0; r < 2; ++r) { const float rstd = 1.0f / __builtin_sqrtf(ss[r] * (1.0f / DM) + EPS);
                GAS f32x4* orow = (GAS f32x4*)(args.out + (size_t)(m0 + r) * DM) + lane;
#pragma unroll
                for (int j = 0; j < 4; ++j) { const f32x4 fg = *(const f32x4*)(I_FINALG + 4 * lane + 256 * j); __builtin_nontemporal_store((hv[r][j] * rstd) * fg, orow + 64 * j); } }
        }
    }
    PROBE_MARK(23);
#if defined(PROBE_LO)
    { PHASE_IDS(); const float T = (float)(tpB - tpA) * 0.01f; const float cval = __builtin_sqrtf(T / (float)(PROBE_UNIT));
      for (int m = gw; m < NLAT; m += NGW) { GAS f32x4* orow = (GAS f32x4*)(args.out + (size_t)m * DM) + lane;
#pragma unroll
        for (int j = 0; j < 4; ++j) orow[64 * j] = (f32x4){cval, cval, cval, cval}; } }
#endif
#undef IN
#undef BOTH
#undef GRID_BAR
}

#ifndef MK_ONE_LAUNCH
#define MK_ONE_LAUNCH 1
#endif
extern "C" void kernel_launch(void* const* d_in, const int* in_sizes, int n_in, void* d_out, int out_size, void* d_ws, size_t ws_size, hipStream_t stream) {
    static int grid = 0;
    if (grid == 0) {
        if (n_in != 24 || out_size != NLAT * DM || ws_size < WS_END) { fprintf(stderr, "kernel_launch: unexpected problem (n_in %d, out %d, ws %zu < %zu)\n", n_in, out_size, ws_size, (size_t)WS_END); grid = -1; return; }
        int dev = 0, cus = 0, per_cu = 0;
        if (hipGetDevice(&dev) != hipSuccess || hipDeviceGetAttribute(&cus, hipDeviceAttributeMultiprocessorCount, dev) != hipSuccess) { grid = -1; return; }
        if (hipFuncSetAttribute((const void*)fwd, hipFuncAttributeMaxDynamicSharedMemorySize, LDS_BYTES) != hipSuccess) { fprintf(stderr, "kernel_launch: hipFuncSetAttribute failed\n"); grid = -1; return; }
        if (hipOccupancyMaxActiveBlocksPerMultiprocessor(&per_cu, (const void*)fwd, 512, LDS_BYTES) != hipSuccess || per_cu < 1) fprintf(stderr, "kernel_launch: occupancy query says %d\n", per_cu);
        (void)hipGetLastError();
        grid = cus;
    }
    if (grid < 0) return;
    if (hipMemsetAsync((char*)d_ws + WS_CTL, 0, CTL_ZERO_BYTES, stream) != hipSuccess) return;
    Args a{};
    for (int i = 0; i < 24; ++i) a.in[i] = (const float*)d_in[i];
    a.out = (float*)d_out; a.ws = (unsigned char*)d_ws;
#if defined(SPLITAT)
    a.ph_lo = 0; a.ph_hi = SPLITAT; a.li = 0;
    hipLaunchKernelGGL(fwd, dim3(grid), dim3(512), LDS_BYTES, stream, a);
    a.ph_lo = SPLITAT; a.ph_hi = NPH; a.li = 1;
    hipLaunchKernelGGL(fwd, dim3(grid), dim3(512), LDS_BYTES, stream, a);
#elif defined(DUPK)
    a.ph_lo = 0; a.ph_hi = DUPK + 1; a.li = 0;
    hipLaunchKernelGGL(fwd, dim3(grid), dim3(512), LDS_BYTES, stream, a);
    a.ph_lo = DUPK; a.ph_hi = NPH; a.li = 1;
    hipLaunchKernelGGL(fwd, dim3(grid), dim3(512), LDS_BYTES, stream, a);
#elif MK_ONE_LAUNCH
    a.ph_lo = 0; a.ph_hi = NPH;
    hipLaunchKernelGGL(fwd, dim3(grid), dim3(512), LDS_BYTES, stream, a);
#else
    for (int p = 0; p < NPH; ++p) { a.ph_lo = p; a.ph_hi = p + 1; hipLaunchKernelGGL(fwd, dim3(grid), dim3(512), LDS_BYTES, stream, a); }
#endif
}
```

```cpp
#include <hip/hip_runtime.h>
#include <hip/hip_bf16.h>
#include <cstdio>
#include <cstdint>
#include <cmath>

constexpr int DM = 1024, NB = 4, SEQ = 8192, LCTX = 256, NLAT = NB * SEQ, NCTXR = NB * LCTX, MALL = NLAT + NCTXR;
constexpr int DFF = 3584, NEXP = 8, NQKV = 1536;
constexpr int NPL = NLAT / 256, NPA = MALL / 256;
constexpr float EPS = 1e-6f;
constexpr int MOE_CH = 64, MOE_NCH = 4;
constexpr float MOE_SGU = 32.0f, MOE_SD = 64.0f;
constexpr int MOE_RS = 7, P3_NS = 8, P5_NS = 14;

#define LAS __attribute__((address_space(3)))
#define GAS __attribute__((address_space(1)))
typedef unsigned short bf16_t;
typedef short bf16x8 __attribute__((ext_vector_type(8)));
typedef float f32x4 __attribute__((ext_vector_type(4)));
typedef float f32x2 __attribute__((ext_vector_type(2)));
typedef float f32x16 __attribute__((ext_vector_type(16)));
typedef unsigned u32x4 __attribute__((ext_vector_type(4)));
typedef unsigned u32x2 __attribute__((ext_vector_type(2)));
typedef __bf16 bf16x2_t __attribute__((ext_vector_type(2)));
typedef GAS unsigned gu32;

__device__ __forceinline__ unsigned pkbf(float lo, float hi) { f32x2 v = {lo, hi}; bf16x2_t b = __builtin_convertvector(v, bf16x2_t); return __builtin_bit_cast(unsigned, b); }
__device__ __forceinline__ unsigned pk4f8(float a, float b, float c, float d) { unsigned w = 0; w = __builtin_amdgcn_cvt_pk_fp8_f32(a, b, w, false); w = __builtin_amdgcn_cvt_pk_fp8_f32(c, d, w, true); return w; }
__device__ __forceinline__ float bf2f(unsigned short h) { return __builtin_bit_cast(float, (unsigned)h << 16); }
__device__ __forceinline__ float wave_sum(float v) {
#pragma unroll
    for (int o = 1; o < 64; o <<= 1) v += __shfl_xor(v, o);
    return v;
}
__device__ __forceinline__ float gelu_tanh(float x) {
    const float t = x * (1.0f + 0.044715f * x * x);
    const float e = __builtin_amdgcn_exp2f(-2.302208198f * t);
    return x * __builtin_amdgcn_rcpf(1.0f + e);
}
__device__ __forceinline__ float silu_f(float x) { return x * __builtin_amdgcn_rcpf(1.0f + __builtin_amdgcn_exp2f(-1.4426950409f * x)); }

constexpr size_t MiB = 1u << 20;
constexpr size_t WS_CTL = 0, CTL_ZERO_BYTES = 1 * MiB;
constexpr size_t WS_MOD = 1 * MiB;
constexpr size_t WS_ROPE = 1 * MiB + 256 * 1024;
constexpr size_t WS_STATS = 2 * MiB;
constexpr size_t WS_LIST = 5 * MiB;
constexpr size_t WS_TINFO = 6 * MiB;
constexpr size_t WS_WS = 7 * MiB;
constexpr size_t WS_WIN = 8 * MiB, WS_WAO = 12 * MiB, WS_WQKV = 14 * MiB, WS_WBO = 17 * MiB, WS_WGU = 19 * MiB, WS_WD = 33 * MiB;
constexpr size_t WS_MGU = 40 * MiB, WS_MD = 96 * MiB;
constexpr size_t WS_XN = 208 * MiB;
constexpr size_t WS_ZB = 274 * MiB;
constexpr size_t WS_R = 278 * MiB;
constexpr size_t WS_UVT = WS_R, WS_A2 = WS_R + 132 * MiB, WS_PART1 = WS_R + 198 * MiB, WS_H = WS_R, WS_PART2 = WS_R + 231 * MiB;
constexpr size_t WS_QKV = WS_R, WS_O = WS_R + 99 * MiB;
constexpr size_t WS_Y = WS_R, WS_YP = WS_R + 128 * MiB, WS_HC = WS_R + 156 * MiB;
constexpr size_t WS_END = WS_R + 287 * MiB;
static_assert(WS_UVT + (size_t)2048 * MALL * 2 <= WS_A2 && WS_A2 + (size_t)MALL * DM * 2 <= WS_PART1 && WS_PART1 + (size_t)P3_NS * NCTXR * DM * 4 <= WS_END, "layer-0 mixer map");
static_assert(WS_H + (size_t)MALL * DFF * 2 <= WS_PART2 && WS_PART2 + (size_t)P5_NS * NCTXR * DM * 4 <= WS_END && WS_QKV + (size_t)MALL * NQKV * 2 <= WS_O && WS_O + (size_t)NLAT * DM * 2 <= WS_END, "region map");
static_assert(WS_Y + (size_t)256 * 256 * DM * 2 <= WS_YP && WS_YP + (size_t)MOE_RS * 8 * 256 * DM * 2 <= WS_HC && WS_HC + (size_t)MOE_CH * 256 * DFF <= WS_END, "MoE map");
static_assert(WS_XN + (size_t)MALL * DM * 2 <= WS_ZB && WS_MD + (size_t)8 * DM * DFF <= WS_XN && WS_MGU + (size_t)8 * 7168 * DM <= WS_MD, "weights map");
constexpr int CW_TMO = 0, CW_CODE = 1;
constexpr int CW_CNT = 64;
constexpr int CW_BAR = 4096;

constexpr int RING_BYTES = 131072;
constexpr int GTAB_OFF = RING_BYTES;
constexpr int MOE_OFF = RING_BYTES + 1024;
constexpr int MISC_OFF = RING_BYTES + 2048;
constexpr int LDS_BYTES = 147456;

namespace pg8 {
constexpr int BM = 256, BK = 64, HALF = 128, HTB = HALF * BK * 2, STAGE_BYTES = 8 * HTB, NXCD = 8, WGM = 8;
__host__ __device__ __forceinline__ int lds_byte(int r, int c) { const int st = (r >> 4) * 2 + (c >> 5), rr = r & 15, cc = c & 31, ob = rr * 64 + cc * 2; return st * 1024 + (ob ^ (((ob >> 9) & 1) << 5)); }
__host__ __device__ __forceinline__ void stage_rc(int b, int& R, int& C) { const int st = b / 1024, sb = b % 1024, swz = sb ^ (((sb >> 9) & 1) << 5); R = (st >> 1) * 16 + swz / 64; C = (st & 1) * 32 + (swz % 64) / 2; }
__host__ __device__ __forceinline__ int perm32(int rho) { const int n = rho >> 4, i = rho & 15; return 8 * (i >> 2) + 4 * n + (i & 3); }

struct Unit { const char* a; const char* b; const int* gl; int pm, pn, om, nv, ks; };

__device__ __forceinline__ bool tile_order(int i, int G, int c, int nM, int nN, int& pm, int& pn) {
    const int nwg = nM * nN; const long L = (long)i * G + c; if (L >= nwg) return false;
    int wgid = (int)L; { const int q = nwg / NXCD, r = nwg % NXCD, xcd = wgid % NXCD, off = wgid / NXCD; wgid = (xcd < r ? xcd * (q + 1) : r * (q + 1) + (xcd - r) * q) + off; }
    const int nig = WGM * nN, gid = wgid / nig, fm = gid * WGM, gsz = (nM - fm) < WGM ? (nM - fm) : WGM;
    pm = fm + ((wgid % nig) % gsz); pn = (wgid % nig) / gsz; return true;
}
struct DenseSched {
    const char* A; const char* B; int nM, nN, G, c; size_t tstep;
    __device__ __forceinline__ bool next(int i, Unit& u) const {
        int pm, pn; if (!tile_order(i, G, c, nM, nN, pm, pn)) return false;
        u.a = A + (size_t)pm * tstep; u.b = B + (size_t)pn * tstep; u.gl = nullptr; u.pm = pm; u.pn = pn; u.om = pm; u.nv = 256; u.ks = 0; return true;
    }
};
typedef int v8i_t __attribute__((ext_vector_type(8)));
typedef int v4i_t __attribute__((ext_vector_type(4)));
__device__ __forceinline__ v8i_t cat8(bf16x8 lo, bf16x8 hi) { const v4i_t a = __builtin_bit_cast(v4i_t, lo), b = __builtin_bit_cast(v4i_t, hi); return __builtin_shufflevector(a, b, 0, 1, 2, 3, 4, 5, 6, 7); }
struct SplitSched {
    const char* A; const char* B; int nM, nN, nS, G, c, pm0; size_t tstep, kbytes;
    __device__ __forceinline__ bool next(int i, Unit& u) const {
        const int L = i * G + c; if (L >= nM * nN * nS) return false;
        const int ks = L % nS, t = L / nS, pn = t % nN, pm = t / nN;
        u.a = A + (size_t)pm * tstep + (size_t)ks * kbytes; u.b = B + (size_t)pn * tstep + (size_t)ks * kbytes; u.gl = nullptr; u.pm = pm0 + pm; u.pn = pn; u.om = pm; u.nv = 256; u.ks = ks; return true;
    }
};
struct MoeSched {
    const char* A; const char* B; const int* list; const LAS int* tab; int gp0, gp1, nN, nS, G, c, mode; size_t bexp, btile, astep, kbytes; bool gather;
    __device__ __forceinline__ bool next(int i, Unit& u) const {
        int pm, pn, ks = 0;
        if (mode == 0) { if (gp1 <= gp0) return false; if (!tile_order(i, G, c, gp1 - gp0, nN, pm, pn)) return false; }
        else { const int R = __builtin_amdgcn_readfirstlane(tab[32]); const int L = i * G + c; if (L >= R * nN * nS) return false; ks = L % nS; const int t = L / nS; pn = t % nN; pm = t / nN; }
        int e = 0, lp, nv;
        if (mode == 0) { const int gp = gp0 + pm;
#pragma unroll
            for (int k = 1; k < 8; ++k) e += (gp >= __builtin_amdgcn_readfirstlane(tab[k])) ? 1 : 0;
            lp = gp - __builtin_amdgcn_readfirstlane(tab[e]); nv = 256; u.pm = gp; }
        else { e = __builtin_amdgcn_readfirstlane(tab[24 + pm]); const int ce = __builtin_amdgcn_readfirstlane(tab[16 + e]); lp = ce >> 8; nv = ce & 255; u.pm = pm; }
        u.b = B + (size_t)e * bexp + (size_t)pn * btile + (size_t)ks * kbytes; u.pn = pn; u.nv = nv; u.ks = ks; u.om = pm;
        if (gather) { u.a = A; u.gl = list + (size_t)e * NLAT + 256 * lp; }
        else { u.a = A + (size_t)pm * astep + (size_t)ks * kbytes; u.gl = nullptr; if (mode == 0) u.om = gp0 + pm; }
        return true;
    }
};

struct EpiGeluT {
    static constexpr bool PERM = true;
    bf16_t* O; float* stats;
    __device__ __forceinline__ void operator()(const f32x4 (&acc)[2][2][4][2], const Unit& u, int wr, int wc, int fr, int fq) const {
        const int row0 = u.pm * BM + wr * 64 + fr, col0 = u.pn * BM + wc * 32 + 8 * fq;
        const bool isv = u.pm >= 4;
        float s1[2][2][4], s2[2][2][4];
#pragma unroll
        for (int bj = 0; bj < 2; ++bj)
#pragma unroll
            for (int n = 0; n < 2; ++n)
#pragma unroll
                for (int e = 0; e < 4; ++e) { s1[bj][n][e] = 0.f; s2[bj][n][e] = 0.f; }
#pragma unroll
        for (int ai = 0; ai < 2; ++ai)
#pragma unroll
            for (int m = 0; m < 4; ++m) { bf16_t* rowp = O + (size_t)(row0 + ai * HALF + m * 16) * MALL + col0;
#pragma unroll
                for (int bj = 0; bj < 2; ++bj) { f32x4 v0 = acc[ai][bj][m][0], v1 = acc[ai][bj][m][1];
#pragma unroll
                    for (int e = 0; e < 4; ++e) { v0[e] = gelu_tanh(v0[e]); v1[e] = gelu_tanh(v1[e]); s1[bj][0][e] += v0[e]; s2[bj][0][e] += v0[e] * v0[e]; s1[bj][1][e] += v1[e]; s2[bj][1][e] += v1[e] * v1[e]; }
                    u32x4 w; w.x = pkbf(v0[0], v0[1]); w.y = pkbf(v0[2], v0[3]); w.z = pkbf(v1[0], v1[1]); w.w = pkbf(v1[2], v1[3]);
                    *(u32x4*)(rowp + bj * HALF) = w; } }
        if (isv) {
            const int slot = (u.pm - 4) * 2 + wr;
#pragma unroll
            for (int bj = 0; bj < 2; ++bj)
#pragma unroll
                for (int n = 0; n < 2; ++n)
#pragma unroll
                    for (int e = 0; e < 4; ++e) { float a = s1[bj][n][e], b = s2[bj][n][e];
#pragma unroll
                        for (int o = 1; o < 16; o <<= 1) { a += __shfl_xor(a, o); b += __shfl_xor(b, o); }
                        if (fr == 0) { const int tok = col0 + bj * HALF + 4 * n + e; *(f32x2*)(stats + (size_t)tok * 16 + slot * 2) = (f32x2){a, b}; } }
        }
    }
};
struct EpiResid {
    static constexpr bool PERM = false;
    const float* baseL; const float* baseC; float* outL; float* outC; const float* gate;
    __device__ __forceinline__ void operator()(const f32x4 (&acc)[2][2][4][2], const Unit& u, int wr, int wc, int fr, int fq) const {
        const bool lat = u.pm < NPL; const int mb = lat ? (u.pm >> 5) : 4;
        const float* base = lat ? baseL + (size_t)u.pm * BM * DM : baseC + (size_t)(u.pm - NPL) * BM * DM;
        float* out = lat ? outL + (size_t)u.pm * BM * DM : outC + (size_t)(u.pm - NPL) * BM * DM;
        const int col0 = u.pn * BM + wc * 32 + 4 * fq;
        f32x4 gv[2][2];
#pragma unroll
        for (int bj = 0; bj < 2; ++bj)
#pragma unroll
            for (int n = 0; n < 2; ++n) gv[bj][n] = *(const f32x4*)(gate + (size_t)mb * 6144 + col0 + bj * HALF + n * 16);
#pragma unroll
        for (int ai = 0; ai < 2; ++ai)
#pragma unroll
            for (int m = 0; m < 4; ++m) { const size_t off = (size_t)(wr * 64 + fr + ai * HALF + m * 16) * DM + col0;
#pragma unroll
                for (int bj = 0; bj < 2; ++bj)
#pragma unroll
                    for (int n = 0; n < 2; ++n) { const f32x4 bs = *(const f32x4*)(base + off + bj * HALF + n * 16);
                        *(f32x4*)(out + off + bj * HALF + n * 16) = bs + gv[bj][n] * acc[ai][bj][m][n]; } }
    }
};
struct EpiSwiGLU {
    static constexpr bool PERM = true;
    bf16_t* O;
    __device__ __forceinline__ void operator()(const f32x4 (&acc)[2][2][4][2], const Unit& u, int wr, int wc, int fr, int fq) const {
        bf16_t* base = O + (size_t)(u.om * BM + wr * 64 + fr) * DFF + u.pn * 128 + wc * 32 + 8 * fq;
#pragma unroll
        for (int ai = 0; ai < 2; ++ai)
#pragma unroll
            for (int m = 0; m < 4; ++m) { const f32x4 g0 = acc[ai][0][m][0], g1 = acc[ai][0][m][1], u0 = acc[ai][1][m][0], u1 = acc[ai][1][m][1];
                float o[8];
#pragma unroll
                for (int e = 0; e < 4; ++e) { o[e] = silu_f(g0[e]) * u0[e]; o[4 + e] = silu_f(g1[e]) * u1[e]; }
                u32x4 w; w.x = pkbf(o[0], o[1]); w.y = pkbf(o[2], o[3]); w.z = pkbf(o[4], o[5]); w.w = pkbf(o[6], o[7]);
                *(u32x4*)(base + (size_t)(ai * HALF + m * 16) * DFF) = w; }
    }
};
struct EpiQKV {
    static constexpr bool PERM = false;
    bf16_t* O; const float* cosT; const float* sinT; float qscale;
    __device__ __forceinline__ void operator()(const f32x4 (&acc)[2][2][4][2], const Unit& u, int wr, int wc, int fr, int fq) const {
        const bool lat = u.pm < NPL; const bool dorope = lat && u.pn < 5; const float sc = u.pn < 4 ? qscale : 1.0f;
        const int col0 = u.pn * BM + wc * 32 + 4 * fq;
#pragma unroll
        for (int ai = 0; ai < 2; ++ai)
#pragma unroll
            for (int m = 0; m < 4; ++m) { const int grow = u.pm * BM + ai * HALF + wr * 64 + m * 16 + fr; const int s = grow & (SEQ - 1); const int pos = (wc & 1) ? (s & 63) : (s >> 6);
                f32x4 cs = (f32x4){1.f, 1.f, 1.f, 1.f}, sn = (f32x4){0.f, 0.f, 0.f, 0.f};
                if (dorope) { cs = *(const f32x4*)(cosT + pos * 16 + 4 * fq); sn = *(const f32x4*)(sinT + pos * 16 + 4 * fq); }
                bf16_t* rowp = O + (size_t)grow * NQKV + col0;
#pragma unroll
                for (int bj = 0; bj < 2; ++bj) { const f32x4 x1 = acc[ai][bj][m][0], x2 = acc[ai][bj][m][1];
                    const f32x4 o1 = (x1 * cs - x2 * sn) * sc, o2 = (x1 * sn + x2 * cs) * sc;
                    u32x2 w1, w2; w1.x = pkbf(o1[0], o1[1]); w1.y = pkbf(o1[2], o1[3]); w2.x = pkbf(o2[0], o2[1]); w2.y = pkbf(o2[2], o2[3]);
                    *(u32x2*)(rowp + bj * HALF) = w1; *(u32x2*)(rowp + bj * HALF + 16) = w2; } }
    }
};
struct EpiSwiGLU8 {
    static constexpr bool PERM = true;
    unsigned char* O; float s;
    __device__ __forceinline__ void operator()(const f32x4 (&acc)[2][2][4][2], const Unit& u, int wr, int wc, int fr, int fq) const {
        unsigned char* base = O + (size_t)(u.om * BM + wr * 64 + fr) * DFF + u.pn * 128 + wc * 32 + 8 * fq;
#pragma unroll
        for (int ai = 0; ai < 2; ++ai)
#pragma unroll
            for (int m = 0; m < 4; ++m) { const f32x4 g0 = acc[ai][0][m][0] * s, g1 = acc[ai][0][m][1] * s, u0 = acc[ai][1][m][0] * s, u1 = acc[ai][1][m][1] * s;
                float o[8];
#pragma unroll
                for (int e = 0; e < 4; ++e) { o[e] = silu_f(g0[e]) * u0[e]; o[4 + e] = silu_f(g1[e]) * u1[e]; }
                u32x2 w; w.x = pk4f8(o[0], o[1], o[2], o[3]); w.y = pk4f8(o[4], o[5], o[6], o[7]);
                *(u32x2*)(base + (size_t)(ai * HALF + m * 16) * DFF) = w; }
    }
};
struct EpiBf16Plain {
    static constexpr bool PERM = true;
    bf16_t* O; int ldc; float s;
    __device__ __forceinline__ void operator()(const f32x4 (&acc)[2][2][4][2], const Unit& u, int wr, int wc, int fr, int fq) const {
        bf16_t* base = O + (size_t)(u.om * BM + wr * 64 + fr) * ldc + u.pn * BM + wc * 32 + 8 * fq;
#pragma unroll
        for (int ai = 0; ai < 2; ++ai)
#pragma unroll
            for (int m = 0; m < 4; ++m)
#pragma unroll
                for (int bj = 0; bj < 2; ++bj) { const f32x4 v0 = acc[ai][bj][m][0] * s, v1 = acc[ai][bj][m][1] * s;
                    u32x4 w; w.x = pkbf(v0[0], v0[1]); w.y = pkbf(v0[2], v0[3]); w.z = pkbf(v1[0], v1[1]); w.w = pkbf(v1[2], v1[3]);
                    *(u32x4*)(base + (size_t)(ai * HALF + m * 16) * ldc + bj * HALF) = w; }
    }
};

struct EpiPartF32 {
    static constexpr bool PERM = false;
    float* P; size_t sstride;
    __device__ __forceinline__ void operator()(const f32x4 (&acc)[2][2][4][2], const Unit& u, int wr, int wc, int fr, int fq) const {
        float* base = P + (size_t)u.ks * sstride + (size_t)(u.om * BM + wr * 64 + fr) * DM + u.pn * BM + wc * 32 + 4 * fq;
#pragma unroll
        for (int ai = 0; ai < 2; ++ai)
#pragma unroll
            for (int m = 0; m < 4; ++m)
#pragma unroll
                for (int bj = 0; bj < 2; ++bj)
#pragma unroll
                    for (int n = 0; n < 2; ++n) *(f32x4*)(base + (size_t)(ai * HALF + m * 16) * DM + bj * HALF + n * 16) = acc[ai][bj][m][n];
    }
};
struct EpiPartBf16 {
    static constexpr bool PERM = true;
    bf16_t* P; size_t sstride; float s;
    __device__ __forceinline__ void operator()(const f32x4 (&acc)[2][2][4][2], const Unit& u, int wr, int wc, int fr, int fq) const {
        bf16_t* base = P + (size_t)u.ks * sstride + (size_t)(u.om * BM + wr * 64 + fr) * DM + u.pn * BM + wc * 32 + 8 * fq;
#pragma unroll
        for (int ai = 0; ai < 2; ++ai)
#pragma unroll
            for (int m = 0; m < 4; ++m)
#pragma unroll
                for (int bj = 0; bj < 2; ++bj) { const f32x4 v0 = acc[ai][bj][m][0] * s, v1 = acc[ai][bj][m][1] * s;
                    u32x4 w; w.x = pkbf(v0[0], v0[1]); w.y = pkbf(v0[2], v0[3]); w.z = pkbf(v1[0], v1[1]); w.w = pkbf(v1[2], v1[3]);
                    *(u32x4*)(base + (size_t)(ai * HALF + m * 16) * DM + bj * HALF) = w; }
    }
};

template <class Epi, class Sched, bool ALIGN_EPI, bool GATHER, bool FP8 = false>
__device__ __forceinline__ void gemm_phase(LAS unsigned char* lds, LAS int* gtab, const int K  , const int nt_in  , const Sched& S, const Epi& E) {
    int nt = nt_in; asm volatile("" : "+s"(nt));
    int tid_ = threadIdx.x; asm volatile("" : "+v"(tid_));
    const int tid = tid_, wid = __builtin_amdgcn_readfirstlane(tid >> 6), lane = tid & 63, wr = wid >> 2, wc = wid & 3, fr = lane & 15, fq = lane >> 4;
    const size_t kstep = (size_t)(BK * 2);
    const size_t hstep = (size_t)HALF * K * 2;
    unsigned voffB[2];
#pragma unroll
    for (int i = 0; i < 2; ++i) { int R, C; stage_rc(tid * 16 + i * 8192, R, C); const int Rb = Epi::PERM ? ((R & ~31) + perm32(R & 31)) : R;
        voffB[i] = (unsigned)(Rb * K + C) * 2u; }
    unsigned vA[2][2], vN[2][2];
    const unsigned ldsw = (unsigned)wid * 1024u;
    const int aoff = lds_byte(wr * 64 + fr, fq * 8), boff = lds_byte(wc * 32 + fr, fq * 8);
    const LAS unsigned char* aB = lds + aoff; const LAS unsigned char* bB = lds + 65536 + boff;
    asm volatile("" : "+v"(aB), "+v"(bB));
#define PG8_SA(b, h) (((b) * 2 + (h)) * HTB)
#define PG8_SB(b, h) ((4 + (b) * 2 + (h)) * HTB)
#define PG8_STAGE(bufoff, gbase, voff) do { _Pragma("unroll") for (int _i = 0; _i < 2; ++_i) \
        __builtin_amdgcn_global_load_lds((const unsigned*)((const char*)(gbase) + (voff)[_i]), (LAS unsigned*)(lds + (bufoff) + ldsw + _i * 8192), 16, 0, 0); } while (0)
#define PG8_LDA(dst, b, h) do { _Pragma("unroll") for (int m = 0; m < 4; ++m) { if constexpr (FP8) dst##8[m] = cat8(*(const LAS bf16x8*)(aB + PG8_SA(b, h) + m * 2048), *(const LAS bf16x8*)(aB + PG8_SA(b, h) + m * 2048 + 1024)); \
        else { _Pragma("unroll") for (int k = 0; k < 2; ++k) dst[m][k] = *(const LAS bf16x8*)(aB + PG8_SA(b, h) + m * 2048 + k * 1024); } } } while (0)
#define PG8_LDB(dst, b, h) do { _Pragma("unroll") for (int n = 0; n < 2; ++n) { if constexpr (FP8) dst##8[n] = cat8(*(const LAS bf16x8*)(bB + (PG8_SB(b, h) - 65536) + n * 2048), *(const LAS bf16x8*)(bB + (PG8_SB(b, h) - 65536) + n * 2048 + 1024)); \
        else { _Pragma("unroll") for (int k = 0; k < 2; ++k) dst[n][k] = *(const LAS bf16x8*)(bB + (PG8_SB(b, h) - 65536) + n * 2048 + k * 1024); } } } while (0)
#define PG8_MMA(ai, bj, At, Bt) do { __builtin_amdgcn_s_setprio(1); \
    if constexpr (FP8) { _Pragma("unroll") for (int m = 0; m < 4; ++m) _Pragma("unroll") for (int n = 0; n < 2; ++n) \
        asm volatile("v_mfma_f32_16x16x128_f8f6f4 %0, %1, %2, %0" : "+v"(acc[ai][bj][m][n]) : "v"(Bt##8[n]), "v"(At##8[m])); } \
    else { _Pragma("unroll") for (int m = 0; m < 4; ++m) _Pragma("unroll") for (int n = 0; n < 2; ++n) _Pragma("unroll") for (int k = 0; k < 2; ++k) \
        acc[ai][bj][m][n] = __builtin_amdgcn_mfma_f32_16x16x32_bf16(Bt[n][k], At[m][k], acc[ai][bj][m][n], 0, 0, 0); } \
    __builtin_amdgcn_s_setprio(0); } while (0)
#define PG8_WAIT_V(n) asm volatile("s_waitcnt vmcnt(" #n ")" ::: "memory")
#define PG8_WAIT_L(n) asm volatile("s_waitcnt lgkmcnt(" #n ")" ::: "memory")
#define PG8_BAR __builtin_amdgcn_s_barrier()
#define PG8_SCHED __builtin_amdgcn_sched_barrier(0)
    Unit cur, nxt; int ui = 0;
    if (!S.next(0, cur)) return;
    f32x4 acc[2][2][4][2];
#pragma unroll
    for (int a = 0; a < 2; ++a)
#pragma unroll
        for (int b = 0; b < 2; ++b)
#pragma unroll
            for (int m = 0; m < 4; ++m)
#pragma unroll
                for (int n = 0; n < 2; ++n) acc[a][b][m][n] = (f32x4){0.f, 0.f, 0.f, 0.f};
    bf16x8 At[4][2], B0[2][2], B1[2][2]; v8i_t At8[4], B08[2], B18[2];
    if constexpr (GATHER) {
#pragma unroll
        for (int h = 0; h < 2; ++h)
#pragma unroll
            for (int i = 0; i < 2; ++i) { int R, C; stage_rc(tid * 16 + i * 8192, R, C); const int row = h * HALF + R; const int tok = cur.gl[row < cur.nv ? row : 0]; vA[h][i] = (unsigned)tok * (unsigned)(K * 2) + (unsigned)C * 2u; }
    } else {
#pragma unroll
        for (int h = 0; h < 2; ++h)
#pragma unroll
            for (int i = 0; i < 2; ++i) { int R, C; stage_rc(tid * 16 + i * 8192, R, C); vA[h][i] = (unsigned)(R * K + C) * 2u + (unsigned)(h * hstep); }
    }
#pragma unroll
    for (int h = 0; h < 2; ++h)
#pragma unroll
        for (int i = 0; i < 2; ++i) vN[h][i] = vA[h][i];
    const char* cA = cur.a; const char* cB = cur.b;
    PG8_STAGE(PG8_SB(0, 0), cB, voffB); PG8_STAGE(PG8_SB(0, 1), cB + hstep, voffB); PG8_STAGE(PG8_SA(0, 0), cA, vA[0]); PG8_STAGE(PG8_SA(0, 1), cA, vA[1]);
    if (wr == 1) PG8_BAR;
    PG8_WAIT_V(2); PG8_BAR;
    PG8_STAGE(PG8_SB(1, 0), cB + kstep, voffB); PG8_STAGE(PG8_SA(1, 0), cA + kstep, vA[0]); PG8_STAGE(PG8_SB(1, 1), cB + hstep + kstep, voffB);
    PG8_WAIT_V(6); PG8_BAR;
    for (;;) {
        const bool has_next = S.next(ui + 1, nxt);
        const char* nA = has_next ? nxt.a : cA; const char* nB = has_next ? nxt.b : cB;
        if constexpr (GATHER) {
            if (has_next && wid < 4) __builtin_amdgcn_global_load_lds((const unsigned*)(nxt.gl + wid * 64 + lane), (LAS unsigned*)(gtab + wid * 64), 4, 0, 0);
        }
        for (int t = 0; t < nt; t += 2) {
            const bool last = (t == nt - 2);
            const char* a1 = cA + (size_t)(t + 1) * kstep;
            const char* a2 = last ? nA : cA + (size_t)(t + 2) * kstep; const char* b2 = last ? nB : cB + (size_t)(t + 2) * kstep;
            const char* a3 = a2 + kstep; const char* b3 = b2 + kstep;
            if constexpr (GATHER) {
                if (last && has_next) {
                    int t2 = tid; asm volatile("" : "+v"(t2));
#pragma unroll
                    for (int h = 0; h < 2; ++h)
#pragma unroll
                        for (int i = 0; i < 2; ++i) { int R, C; stage_rc(t2 * 16 + i * 8192, R, C); const int row = h * HALF + R; const int tok = gtab[row < nxt.nv ? row : 0]; vN[h][i] = (unsigned)tok * (unsigned)(K * 2) + (unsigned)C * 2u; }
                }
            }
            unsigned vS0[2], vS1[2];
#pragma unroll
            for (int i = 0; i < 2; ++i) { vS0[i] = (GATHER && last) ? vN[0][i] : vA[0][i]; vS1[i] = (GATHER && last) ? vN[1][i] : vA[1][i]; }
            PG8_LDB(B0, 0, 0); PG8_LDB(B1, 0, 1); PG8_SCHED; PG8_LDA(At, 0, 0); PG8_STAGE(PG8_SA(1, 1), a1, vA[1]);
            PG8_WAIT_V(8); PG8_WAIT_L(0); PG8_BAR; PG8_MMA(0, 0, At, B0); PG8_MMA(0, 1, At, B1); PG8_BAR; PG8_SCHED;
            PG8_LDA(At, 0, 1); PG8_STAGE(PG8_SB(0, 0), b2, voffB); PG8_STAGE(PG8_SB(0, 1), b2 + hstep, voffB); PG8_STAGE(PG8_SA(0, 0), a2, vS0);
            PG8_WAIT_V(8); PG8_WAIT_L(0); PG8_BAR; PG8_MMA(1, 0, At, B0); PG8_MMA(1, 1, At, B1); PG8_BAR; PG8_SCHED;
            PG8_LDB(B0, 1, 0); PG8_LDB(B1, 1, 1); PG8_SCHED; PG8_LDA(At, 1, 0); PG8_STAGE(PG8_SA(0, 1), a2, vS1);
            PG8_WAIT_V(8); PG8_WAIT_L(0); PG8_BAR; PG8_MMA(0, 0, At, B0); PG8_MMA(0, 1, At, B1); PG8_BAR; PG8_SCHED;
            PG8_LDA(At, 1, 1); PG8_STAGE(PG8_SB(1, 0), b3, voffB); PG8_STAGE(PG8_SB(1, 1), b3 + hstep, voffB); PG8_STAGE(PG8_SA(1, 0), a3, vS0);
            PG8_WAIT_V(8); PG8_WAIT_L(0); PG8_BAR; PG8_MMA(1, 0, At, B0); PG8_MMA(1, 1, At, B1); PG8_BAR; PG8_SCHED;
        }
        if constexpr (ALIGN_EPI) { if (wr == 0) PG8_BAR; }
        if constexpr (FP8) asm volatile("s_nop 15\n\ts_nop 15" ::: "memory");
        E(acc, cur, wr, wc, fr, fq);
        if (!has_next) break;
#pragma unroll
        for (int a = 0; a < 2; ++a)
#pragma unroll
            for (int b = 0; b < 2; ++b)
#pragma unroll
                for (int m = 0; m < 4; ++m)
#pragma unroll
                    for (int n = 0; n < 2; ++n) acc[a][b][m][n] = (f32x4){0.f, 0.f, 0.f, 0.f};
        cur = nxt; cA = nA; cB = nB; ++ui;
        if constexpr (GATHER) {
#pragma unroll
            for (int h = 0; h < 2; ++h)
#pragma unroll
                for (int i = 0; i < 2; ++i) vA[h][i] = vN[h][i];
        }
        if constexpr (ALIGN_EPI) { if (wr == 1) PG8_BAR; }
    }
    PG8_WAIT_V(0);
    if constexpr (!ALIGN_EPI) { if (wr == 0) PG8_BAR; }
    PG8_BAR;
#undef PG8_SA
#undef PG8_SB
#undef PG8_STAGE
#undef PG8_LDA
#undef PG8_LDB
#undef PG8_MMA
#undef PG8_WAIT_V
#undef PG8_WAIT_L
#undef PG8_BAR
#undef PG8_SCHED
}
}

namespace attn_body {
using bf16 = __hip_bfloat16;
using s16x4 = __attribute__((ext_vector_type(4))) short;
constexpr int D = 64, PITCH = NQKV, OPITCH = DM;
constexpr int NW = 8, QBLK = 32, KVBLK = 64;
__device__ __forceinline__ int crow(int r, int hi) { return (r & 3) + 8 * (r >> 2) + 4 * hi; }
#define SBAR() __builtin_amdgcn_sched_barrier(0)
__device__ __forceinline__ void bmask(f32x16& p0, f32x16& p1, int kb, int qrel, int hi) {
    const float NEG = -INFINITY; const int d0 = kb + 4 * hi - qrel;
#pragma unroll
    for (int r = 0; r < 16; ++r) { const int d = d0 + (r & 3) + 8 * (r >> 2); if (d < -128 || d > 128) p0[r] = NEG; if (d + 32 < -128 || d + 32 > 128) p1[r] = NEG; }
}
constexpr int NSLOT = 3, SLOTB = 8192;
constexpr int LDS_K = 0, LDS_V = NSLOT * SLOTB, LDS_WS = 2 * NSLOT * SLOTB, LDS_OST = LDS_WS + NW * 64 * 4, LDS_BYTES_A = LDS_OST + NW * 4096;
constexpr float C2 = 0.125f * 1.4426950408889634f;
__device__ __forceinline__ void glds16(const void* gsrc, unsigned lds_dst) { unsigned keep;
    asm volatile("s_mov_b32 %0, m0\n\ts_mov_b32 m0, %2\n\ts_nop 0\n\tglobal_load_lds_dwordx4 %1, off\n\ts_mov_b32 m0, %0" : "=&s"(keep) : "v"(gsrc), "s"(lds_dst) : "memory"); }
__device__ __forceinline__ float max3f(float a, float b, float c) { float r; asm("v_max3_f32 %0, %1, %2, %3" : "=v"(r) : "v"(a), "v"(b), "v"(c)); return r; }
__device__ __forceinline__ float max2f(float a, float b) { float r; asm("v_max_f32_e32 %0, %1, %2" : "=v"(r) : "v"(a), "v"(b)); return r; }
__device__ __forceinline__ float fadd_s(float a, float b) { float r; asm("v_add_f32_e32 %0, %1, %2" : "=v"(r) : "v"(a), "v"(b)); return r; }
__device__ __forceinline__ float fsub_s(float a, float b) { float r; asm("v_sub_f32_e32 %0, %1, %2" : "=v"(r) : "v"(a), "v"(b)); return r; }
__device__ __forceinline__ unsigned cvtpk_s(float lo, float hi) { f32x2 v = {lo, hi}; bf16x2_t b = __builtin_convertvector(v, bf16x2_t); return __builtin_bit_cast(unsigned, b); }
#define WAIT_BAR(N) asm volatile("s_waitcnt vmcnt(" #N ") lgkmcnt(0)\n\ts_barrier" ::: "memory")
__device__ __forceinline__ void qkt(f32x16& p0, f32x16& p1, const char* Kslot, const bf16x8* qr, const f32x16& negm, int r32, int hi) {
    const char* kb = Kslot + hi * 1024 + r32 * 16;
#pragma unroll
    for (int d0 = 0; d0 < 4; ++d0) {
        const bf16x8 b0 = *reinterpret_cast<const bf16x8*>(kb + d0 * 2048);
        const bf16x8 b1 = *reinterpret_cast<const bf16x8*>(kb + d0 * 2048 + 512);
        if (d0 == 0) { p0 = __builtin_amdgcn_mfma_f32_32x32x16_bf16(b0, qr[0], negm, 0, 0, 0); p1 = __builtin_amdgcn_mfma_f32_32x32x16_bf16(b1, qr[0], negm, 0, 0, 0); }
        else { p0 = __builtin_amdgcn_mfma_f32_32x32x16_bf16(b0, qr[d0], p0, 0, 0, 0); p1 = __builtin_amdgcn_mfma_f32_32x32x16_bf16(b1, qr[d0], p1, 0, 0, 0); } }
}
typedef __attribute__((address_space(3))) const char* lds_cptr;
typedef short v4i16_t __attribute__((ext_vector_type(4)));
__device__ __forceinline__ void kload8(bf16x8* kf, lds_cptr kp) {
    kf[0] = *(const __attribute__((address_space(3))) bf16x8*)(kp);        kf[1] = *(const __attribute__((address_space(3))) bf16x8*)(kp + 512);
    kf[2] = *(const __attribute__((address_space(3))) bf16x8*)(kp + 2048); kf[3] = *(const __attribute__((address_space(3))) bf16x8*)(kp + 2560);
    kf[4] = *(const __attribute__((address_space(3))) bf16x8*)(kp + 4096); kf[5] = *(const __attribute__((address_space(3))) bf16x8*)(kp + 4608);
    kf[6] = *(const __attribute__((address_space(3))) bf16x8*)(kp + 6144); kf[7] = *(const __attribute__((address_space(3))) bf16x8*)(kp + 6656);
}
__device__ __forceinline__ void kload2(bf16x8* kf, lds_cptr kp, int j) { kf[2 * j] = *(const __attribute__((address_space(3))) bf16x8*)(kp + j * 2048); kf[2 * j + 1] = *(const __attribute__((address_space(3))) bf16x8*)(kp + j * 2048 + 512); }
__device__ __forceinline__ s16x4 vtr(lds_cptr p) { return __builtin_bit_cast(s16x4, __builtin_amdgcn_ds_read_tr16_b64_v4i16((__attribute__((address_space(3))) v4i16_t*)p)); }
__device__ __forceinline__ float rowmax(const f32x16& p0, const f32x16& p1) {
    float a = max3f(p0[0], p0[1], p1[0]), b = max3f(p0[2], p0[3], p1[1]); a = max3f(a, p1[2], p1[3]);
#pragma unroll
    for (int r = 4; r < 16; r += 4) { a = max3f(a, p0[r], p0[r + 1]); b = max3f(b, p0[r + 2], p0[r + 3]); a = max3f(a, p1[r], p1[r + 1]); b = max3f(b, p1[r + 2], p1[r + 3]); }
    const float m = max2f(a, b);
    auto rr = __builtin_amdgcn_permlane32_swap(__float_as_uint(m), __float_as_uint(m), false, false);
    return max2f(__uint_as_float(rr[0]), __uint_as_float(rr[1]));
}
__device__ __forceinline__ void pv(f32x16* o, int vb, bf16x8 pa0, bf16x8 pa1, bf16x8 pa2, bf16x8 pa3) {
#pragma unroll
    for (int d0 = 0; d0 < 2; ++d0) { s16x4 lo[4], hi[4];
#pragma unroll
        for (int ks = 0; ks < 4; ++ks) {
            asm volatile("ds_read_b64_tr_b16 %0,%1 offset:%c2" : "=&v"(lo[ks]) : "v"(vb), "i"(d0 * 4096 + ks * 1024) : "memory");
            asm volatile("ds_read_b64_tr_b16 %0,%1 offset:%c2" : "=&v"(hi[ks]) : "v"(vb), "i"(d0 * 4096 + ks * 1024 + 512) : "memory"); }
        asm volatile("s_waitcnt lgkmcnt(0)" ::: "memory"); SBAR();
#define PK(k) (bf16x8){lo[k][0], lo[k][1], lo[k][2], lo[k][3], hi[k][0], hi[k][1], hi[k][2], hi[k][3]}
        o[d0] = __builtin_amdgcn_mfma_f32_32x32x16_bf16(pa0, PK(0), o[d0], 0, 0, 0);
        o[d0] = __builtin_amdgcn_mfma_f32_32x32x16_bf16(pa1, PK(1), o[d0], 0, 0, 0);
        o[d0] = __builtin_amdgcn_mfma_f32_32x32x16_bf16(pa2, PK(2), o[d0], 0, 0, 0);
        o[d0] = __builtin_amdgcn_mfma_f32_32x32x16_bf16(pa3, PK(3), o[d0], 0, 0, 0);
#undef PK
    }
}
#define ATTN_STORE16(p, v) (*(u32x4*)(p) = (v))
template <int THRL> __device__ __forceinline__ void attn_unit(int b, int hk, int n, int pr, const bf16* QKV, bf16* O, const float* sinkp, char* shm) {
    int tid_ = threadIdx.x; asm volatile("" : "+v"(tid_));
    const int tid = tid_, lane = tid & 63, r32 = lane & 31, hi = lane >> 5; const int wid = __builtin_amdgcn_readfirstlane(tid >> 6);
    const int head = 4 * hk + 2 * pr + (wid >> 2);
    const long rowblk = (long)b * SEQ + n * 128;
    const long ctxrow = (long)NLAT + b * LCTX;
    const int nlo = n > 0 ? 2 : 0, nhi = n < (SEQ / 128 - 1) ? 2 : 0;
    const int NT = 6 + nlo + nhi;
    const bf16* Qw = QKV + (rowblk + (wid & 3) * QBLK) * PITCH + head * D;
    const bf16* Kc = QKV + 1024 + hk * D; const bf16* Vc = QKV + 1280 + hk * D;
    const unsigned lds0 = (unsigned)(uintptr_t)shm;
    float* wsf = (float*)(shm + LDS_WS) + wid * 64;
    const long klane = (long)lane * PITCH + wid * 8;
    const long vlane = (long)(16 * (wid & 3) + (lane >> 2)) * PITCH + (wid >> 2) * 32 + (lane & 3) * 8;
    const unsigned kdst = lds0 + LDS_K + wid * 1024, vdst = lds0 + LDS_V + wid * 1024;
#define TROW(t) (((t) < 2) ? (rowblk + 64 * (t)) : ((t) < 6) ? (ctxrow + 64 * ((t) - 2)) : (rowblk + ((((t) - 6) < nlo) ? (-128 + 64 * ((t) - 6)) : (128 + 64 * ((t) - 6 - nlo)))))
#define TKB(t) (((t) < 6) ? 0 : ((((t) - 6) < nlo) ? (-128 + 64 * ((t) - 6)) : (128 + 64 * ((t) - 6 - nlo))))
#define DMA_K(t, slot) glds16(Kc + TROW(t) * PITCH + klane, (unsigned)__builtin_amdgcn_readfirstlane(kdst + (slot)))
#define DMA_V(t, slot) glds16(Vc + TROW(t) * PITCH + vlane, (unsigned)__builtin_amdgcn_readfirstlane(vdst + (slot)))
    const int vb0 = (int)(lds0 + LDS_V) + ((lane >> 4) & 1) * 32 + (lane & 3) * 8 + (4 * hi + ((lane & 15) >> 2)) * 64;
    const char* Kbase = shm + LDS_K; bf16x8 kf[8];
    const lds_cptr shm3 = (lds_cptr)shm; const lds_cptr kp0 = shm3 + LDS_K + hi * 1024 + r32 * 16; const lds_cptr vp0 = shm3 + LDS_V + ((lane >> 4) & 1) * 32 + (lane & 3) * 8 + (4 * hi + ((lane & 15) >> 2)) * 64;
    DMA_K(0, 0); DMA_V(0, 0); DMA_K(1, SLOTB);
    bf16x8 qr[4];
#pragma unroll
    for (int d0 = 0; d0 < 4; ++d0) qr[d0] = *reinterpret_cast<const bf16x8*>(&Qw[(long)r32 * PITCH + d0 * 16 + hi * 8]);
    float mhat = 0.f, l_reg = 0.f; f32x16 o[2]; o[0] = f32x16{}; o[1] = f32x16{}; f32x16 negm = f32x16{}; asm volatile("" : "+v"(negm));
    const int qrel = (wid & 3) * QBLK + r32;
#define CMASK(P0, P1, t) do { int jb_ = (t) - (NT - 4); if (jb_ >= 0) bmask(P0, P1, TKB(t), qrel, hi); } while (0)
    bool resc = false;
#define START(P0, P1) do { const float rm = rowmax(P0, P1); resc = false; \
    { const float dl = rm; mhat = fadd_s(mhat, dl); \
      _Pragma("unroll") for (int r = 0; r < 16; ++r) { P0[r] = fsub_s(P0[r], dl); P1[r] = fsub_s(P1[r], dl); } \
      _Pragma("unroll") for (int r = 0; r < 16; ++r) negm[r] = -mhat; asm volatile("" : "+v"(negm)); } \
    _Pragma("unroll") for (int r = 0; r < 16; ++r) P0[r] = __builtin_amdgcn_exp2f(P0[r]); } while (0)
#define RESC() do { if (resc) { asm volatile("s_waitcnt lgkmcnt(0)" ::: "memory"); \
      _Pragma("unroll") for (int d_ = 0; d_ < 2; ++d_) _Pragma("unroll") for (int r = 0; r < 16; ++r) o[d_][r] *= wsf[crow(r, hi)]; } } while (0)
    f32x16 pA0, pA1, pB0, pB1;
    int sl_prev = 0, sl_cur = 0, sl_next = SLOTB;
#define ROT() do { sl_prev = sl_cur; sl_cur = sl_next; sl_next = (sl_next == (NSLOT - 1) * SLOTB) ? 0 : sl_next + SLOTB; } while (0)
    DMA_K(2, 2 * SLOTB);
    WAIT_BAR(3);
    qkt(pA0, pA1, Kbase, qr, negm, r32, hi); asm volatile("s_nop 15\n\ts_nop 7" : "+v"(pA0), "+v"(pA1));
    START(pA0, pA1);
    _Pragma("unroll") for (int r = 0; r < 16; ++r) pA1[r] = __builtin_amdgcn_exp2f(pA1[r]);
    WAIT_BAR(0);
    DMA_K(3, 0); DMA_V(1, SLOTB);
    ROT();
    kload8(kf, kp0 + sl_cur);
    WAIT_BAR(2);
    s16x4 vlo[8], vhi[8]; u32x4 pw0, pw1, pw2, pw3;
#define PKW(P, B) cvtpk_s(P[B], P[B + 1])
#define PAF(k) __builtin_bit_cast(bf16x8, pw##k)
#define VFR(i) (bf16x8){vlo[i][0], vlo[i][1], vlo[i][2], vlo[i][3], vhi[i][0], vhi[i][1], vhi[i][2], vhi[i][3]}
#define PIN(x) asm volatile("" : "+v"(x))
#define MX3(a, b, c) __builtin_fmaxf(__builtin_fmaxf((a), (b)), (c))
#define GAPA(MF, A0, A1, A2, A3, W0, W1, PW) do { MF; sacc += A0; sacc += A1; sacc += A2; sacc += A3; PIN(sacc); W0; W1; PIN(PW); SBAR(); } while (0)
#define EX(v) __builtin_amdgcn_exp2f(v)
#define GAPB(MF, X, B) do { MF; X[B] = EX(X[B]); X[B + 1] = EX(X[B + 1]); X[B + 2] = EX(X[B + 2]); X[B + 3] = EX(X[B + 3]); PIN(X); SBAR(); } while (0)
#define VRD(i) do { vlo[i] = vtr(vp_ + (((i) >> 2) * 4096 + ((i) & 3) * 1024)); vhi[i] = vtr(vp_ + (((i) >> 2) * 4096 + ((i) & 3) * 1024 + 512)); } while (0)
#define KRD(G, j) do { if (G) { kload2(kf, kp0 + sl_next, j); SBAR(); } } while (0)
#define STEP(C0, C1, P0, P1, t, GK, GV, GL) do { SBAR(); \
    const lds_cptr vp_ = vp0 + sl_prev; \
    VRD(0); SBAR(); float sacc = (P0[0] + P0[1]); \
    GAPA(C0 = __builtin_amdgcn_mfma_f32_32x32x16_bf16(kf[0], qr[0], negm, 0, 0, 0), P0[2], P0[3], P0[4], P0[5],     pw0[0] = PKW(P0, 0), pw0[1] = PKW(P0, 2), pw0); \
    VRD(4); SBAR(); GAPA(C1 = __builtin_amdgcn_mfma_f32_32x32x16_bf16(kf[1], qr[0], negm, 0, 0, 0), P0[6], P0[7], P0[8], P0[9],     pw0[2] = PKW(P0, 4), pw0[3] = PKW(P0, 6), pw0); \
    VRD(1); SBAR(); GAPA(C0 = __builtin_amdgcn_mfma_f32_32x32x16_bf16(kf[2], qr[1], C0, 0, 0, 0),   P0[10], P0[11], P0[12], P0[13], pw1[0] = PKW(P0, 8), pw1[1] = PKW(P0, 10), pw1); \
    VRD(5); SBAR(); GAPA(C1 = __builtin_amdgcn_mfma_f32_32x32x16_bf16(kf[3], qr[1], C1, 0, 0, 0),   P0[14], P0[15], P1[0], P1[1],   pw1[2] = PKW(P0, 12), pw1[3] = PKW(P0, 14), pw1); \
    VRD(2); SBAR(); GAPA(C0 = __builtin_amdgcn_mfma_f32_32x32x16_bf16(kf[4], qr[2], C0, 0, 0, 0),   P1[2], P1[3], P1[4], P1[5],     pw2[0] = PKW(P1, 0), pw2[1] = PKW(P1, 2), pw2); \
    VRD(6); SBAR(); GAPA(C1 = __builtin_amdgcn_mfma_f32_32x32x16_bf16(kf[5], qr[2], C1, 0, 0, 0),   P1[6], P1[7], P1[8], P1[9],     pw2[2] = PKW(P1, 4), pw2[3] = PKW(P1, 6), pw2); \
    VRD(3); SBAR(); GAPA(C0 = __builtin_amdgcn_mfma_f32_32x32x16_bf16(kf[6], qr[3], C0, 0, 0, 0),   P1[10], P1[11], P1[12], P1[13], pw3[0] = PKW(P1, 8), pw3[1] = PKW(P1, 10), pw3); \
    VRD(7); SBAR(); GAPA(C1 = __builtin_amdgcn_mfma_f32_32x32x16_bf16(kf[7], qr[3], C1, 0, 0, 0),   P1[14], P1[15], 0.f, 0.f,       pw3[2] = PKW(P1, 12), pw3[3] = PKW(P1, 14), pw3); \
    l_reg += sacc; \
    if (GK) { DMA_K((t) + 3, sl_cur); } if (GV) { DMA_V((t) + 1, sl_next); } \
    CMASK(C0, C1, t); \
    { float a = MX3(C0[0], C0[1], C1[0]), b = MX3(C0[2], C0[3], C1[1]); a = MX3(a, C1[2], C1[3]); \
      _Pragma("unroll") for (int r = 4; r < 16; r += 4) { a = MX3(a, C0[r], C0[r + 1]); b = MX3(b, C0[r + 2], C0[r + 3]); a = MX3(a, C1[r], C1[r + 1]); b = MX3(b, C1[r + 2], C1[r + 3]); } \
      float rm = __builtin_fmaxf(a, b); { auto rr = __builtin_amdgcn_permlane32_swap(__float_as_uint(rm), __float_as_uint(rm), false, false); rm = __builtin_fmaxf(__uint_as_float(rr[0]), __uint_as_float(rr[1])); } \
      resc = false; \
      if (__builtin_expect(__any(rm > (float)THRL), 0)) { const float dl = __builtin_fmaxf(rm, 0.f); mhat += dl; \
        _Pragma("unroll") for (int r = 0; r < 16; ++r) { C0[r] -= dl; C1[r] -= dl; } \
        _Pragma("unroll") for (int r = 0; r < 16; ++r) negm[r] = -mhat; asm volatile("" : "+v"(negm)); \
        const float f = __builtin_amdgcn_exp2f(-dl); l_reg *= f; if (hi == 0) wsf[r32] = f; resc = true; } } \
    SBAR(); \
    GAPB(o[0] = __builtin_amdgcn_mfma_f32_32x32x16_bf16(PAF(0), VFR(0), o[0], 0, 0, 0), C0, 0); \
    GAPB(o[1] = __builtin_amdgcn_mfma_f32_32x32x16_bf16(PAF(0), VFR(4), o[1], 0, 0, 0), C0, 4); \
    KRD(GL, 0); GAPB(o[0] = __builtin_amdgcn_mfma_f32_32x32x16_bf16(PAF(1), VFR(1), o[0], 0, 0, 0), C0, 8); \
    KRD(GL, 1); GAPB(o[1] = __builtin_amdgcn_mfma_f32_32x32x16_bf16(PAF(1), VFR(5), o[1], 0, 0, 0), C0, 12); \
    KRD(GL, 2); GAPB(o[0] = __builtin_amdgcn_mfma_f32_32x32x16_bf16(PAF(2), VFR(2), o[0], 0, 0, 0), C1, 0); \
    KRD(GL, 3); GAPB(o[1] = __builtin_amdgcn_mfma_f32_32x32x16_bf16(PAF(2), VFR(6), o[1], 0, 0, 0), C1, 4); \
    GAPB(o[0] = __builtin_amdgcn_mfma_f32_32x32x16_bf16(PAF(3), VFR(3), o[0], 0, 0, 0), C1, 8); \
    GAPB(o[1] = __builtin_amdgcn_mfma_f32_32x32x16_bf16(PAF(3), VFR(7), o[1], 0, 0, 0), C1, 12); \
    } while (0)
    int t = 1;
#undef CMASK
#define CMASK(P0, P1, t) do { } while (0)
    for (; t + 5 < NT; t += 2) {
        STEP(pB0, pB1, pA0, pA1, t, true, true, true);     WAIT_BAR(2); RESC(); ROT();
        STEP(pA0, pA1, pB0, pB1, t + 1, true, true, true); WAIT_BAR(2); RESC(); ROT();
    }
#undef CMASK
#define CMASK(P0, P1, t) do { int jb_ = (t) - (NT - 4); if (jb_ >= 0) bmask(P0, P1, TKB(t), qrel, hi); } while (0)
#define ENDW(tt) do { if ((tt) + 3 < NT) { WAIT_BAR(2); } else if ((tt) + 2 < NT) { WAIT_BAR(1); } else { WAIT_BAR(0); } } while (0)
    for (; t + 1 < NT; t += 2) {
        STEP(pB0, pB1, pA0, pA1, t, (t + 3 < NT), (t + 1 < NT), (t + 1 < NT));     ENDW(t);     RESC(); ROT();
        STEP(pA0, pA1, pB0, pB1, t + 1, (t + 4 < NT), (t + 2 < NT), (t + 2 < NT)); ENDW(t + 1); RESC(); ROT();
    }
    STEP(pB0, pB1, pA0, pA1, NT - 1, false, false, false); RESC();
    { float sacc = pB0[0] + pB0[1]; _Pragma("unroll") for (int r = 2; r < 16; ++r) sacc += pB0[r]; _Pragma("unroll") for (int r = 0; r < 16; ++r) sacc += pB1[r]; l_reg += sacc;
      pw0 = (u32x4){PKW(pB0, 0), PKW(pB0, 2), PKW(pB0, 4), PKW(pB0, 6)}; pw1 = (u32x4){PKW(pB0, 8), PKW(pB0, 10), PKW(pB0, 12), PKW(pB0, 14)}; pw2 = (u32x4){PKW(pB1, 0), PKW(pB1, 2), PKW(pB1, 4), PKW(pB1, 6)}; pw3 = (u32x4){PKW(pB1, 8), PKW(pB1, 10), PKW(pB1, 12), PKW(pB1, 14)};
      SBAR(); pv(o, vb0 + sl_cur, PAF(0), PAF(1), PAF(2), PAF(3)); }
#undef PKW
#undef PAF
#undef VFR
#undef PIN
#undef MX3
#undef GAPA
#undef GAPB
#undef EX
#undef VRD
#undef KRD
#undef STEP
#undef ENDW
    { auto rr = __builtin_amdgcn_permlane32_swap(__float_as_uint(l_reg), __float_as_uint(l_reg), false, false); l_reg = __uint_as_float(rr[0]) + __uint_as_float(rr[1]); }
    l_reg += __builtin_amdgcn_exp2f(sinkp[head] * 1.4426950408889634f - mhat);
    if (hi == 0) wsf[32 + r32] = l_reg; asm volatile("s_waitcnt lgkmcnt(0)" ::: "memory");
    float rli[16];
#pragma unroll
    for (int r = 0; r < 16; ++r) rli[r] = __builtin_amdgcn_rcpf(wsf[32 + crow(r, hi)]);
    bf16* Ow = O + (rowblk + (wid & 3) * QBLK) * OPITCH + head * D;
    { bf16* stg = (bf16*)(shm + LDS_OST) + wid * 2048;
#pragma unroll
      for (int r = 0; r < 16; ++r) { const int orow = crow(r, hi);
#pragma unroll
        for (int d0 = 0; d0 < 2; ++d0) stg[orow * 64 + d0 * 32 + r32] = __float2bfloat16(o[d0][r] * rli[r]); }
      asm volatile("s_waitcnt lgkmcnt(0)" ::: "memory");
#pragma unroll
      for (int i = 0; i < 4; ++i) { const int row = i * 8 + (lane >> 3), ch = lane & 7; const u32x4 v = *(const u32x4*)(stg + row * 64 + ch * 8); ATTN_STORE16(Ow + (long)row * OPITCH + ch * 8, v); } }
    asm volatile("s_waitcnt lgkmcnt(0)\n\ts_barrier" ::: "memory");
#undef DMA_K
#undef DMA_V
#undef TROW
#undef TKB
#undef CMASK
#undef START
#undef RESC
#undef ROT
}
#undef SBAR
#undef WAIT_BAR
}

#define XB_TMO      128
#define XB_XCNT(j)  (256  + 64 * (j))
#define XB_XSUB(j)  (1280 + 64 * (j))
#define XB_XGEN(j)  (2304 + 64 * (j))
#define XB_TOP      3328
#define XB_TOPGEN   3392
#define XCD_BAR_WORDS 3456
#define XB_SPIN_CAP (1u << 18)
__device__ __forceinline__ unsigned xb_ld(unsigned* p)              { return __hip_atomic_load(p, __ATOMIC_RELAXED, __HIP_MEMORY_SCOPE_AGENT); }
__device__ __forceinline__ unsigned xb_add(unsigned* p, unsigned v) { return __hip_atomic_fetch_add(p, v, __ATOMIC_RELAXED, __HIP_MEMORY_SCOPE_AGENT); }
__device__ __forceinline__ unsigned xb_xcc_id() { return (unsigned)__builtin_amdgcn_s_getreg((3 << 11) | 20) & 0xFu; }
#define XB_SPIN(cond, bar) do { unsigned _sp = 0; while (cond) { __builtin_amdgcn_s_sleep(1); \
    if ((++_sp & 255u) == 0u) { if (xb_ld(&(bar)[XB_TMO])) break; if (_sp > XB_SPIN_CAP) { atomicAdd(&(bar)[XB_TMO], 1u); break; } } } } while (0)
struct XcdBarrier { unsigned* bar; unsigned x; volatile LAS unsigned* st; };
__device__ __forceinline__ XcdBarrier xcd_barrier_post(unsigned* bar, volatile LAS unsigned* st) {
    XcdBarrier b; b.bar = bar; b.x = xb_xcc_id(); b.st = st;
    if (threadIdx.x == 0) (void)xb_add(&bar[XB_XCNT(b.x)], 1u);
    return b;
}
__device__ __forceinline__ void xcd_barrier_complete(unsigned* bar, unsigned x, unsigned& nloc, unsigned& nx) {
    const unsigned G = gridDim.x * gridDim.y * gridDim.z;
    unsigned sum, cnt, mine, sp = 0u;
    for (;;) {
        sum = 0u; cnt = 0u; mine = 0u;
#pragma unroll
        for (unsigned j = 0; j < 16; ++j) { const unsigned c = xb_ld(&bar[XB_XCNT(j)]); sum += c; cnt += (c > 0u) ? 1u : 0u; mine = (j == x) ? c : mine; }
        if (sum == G) break;
        __builtin_amdgcn_s_sleep(1);
        if ((++sp & 255u) == 0u) { if (xb_ld(&bar[XB_TMO])) break; if (sp > XB_SPIN_CAP) { atomicAdd(&bar[XB_TMO], 1u); break; } }
    }
    nloc = mine > 0u ? mine : 1u; nx = cnt > 0u ? cnt : 1u;
}
__device__ __forceinline__ void xcd_barrier(const XcdBarrier& b) {
    asm volatile("s_waitcnt vmcnt(0)" ::: "memory");
    __syncthreads();
    if (threadIdx.x == 0) {
        unsigned* bar = b.bar;
        __builtin_amdgcn_s_waitcnt(0);
        unsigned nloc = b.st[0], nx = b.st[1];
        if (nloc == 0u) { xcd_barrier_complete(bar, b.x, nloc, nx); b.st[0] = nloc; b.st[1] = nx; }
        const unsigned old = xb_add(&bar[XB_XSUB(b.x)], 1u);
        const unsigned gen = old / nloc;
        if (old + 1u == (gen + 1u) * nloc) {
            __builtin_amdgcn_fence(__ATOMIC_RELEASE, "agent");
            asm volatile("s_waitcnt vmcnt(0)" ::: "memory");
            const unsigned og = xb_add(&bar[XB_TOP], 1u);
            const unsigned tg = og / nx;
            if (og + 1u == (tg + 1u) * nx) xb_add(&bar[XB_TOPGEN], 1u);
            else XB_SPIN(xb_ld(&bar[XB_TOPGEN]) == tg, bar);
            __builtin_amdgcn_fence(__ATOMIC_ACQUIRE, "agent");
            xb_add(&bar[XB_XGEN(b.x)], 1u);
            asm volatile("s_waitcnt vmcnt(0)" ::: "memory");
        } else {
            XB_SPIN(xb_ld(&bar[XB_XGEN(b.x)]) == gen, bar);
            __builtin_amdgcn_fence(__ATOMIC_ACQUIRE, "agent");
            asm volatile("s_waitcnt vmcnt(0)" ::: "memory");
        }
    }
    __syncthreads();
}

#define LDS_WAIT() asm volatile("s_waitcnt lgkmcnt(0)" ::: "memory")
__device__ __forceinline__ void transpose_item(const float* W, int K, int N, bf16_t* WT, int k0, int n0, int drow0, LAS float* scr, int lane) {
#pragma unroll 8
    for (int i = 0; i < 32; ++i) { const int kk = 2 * i + (lane >> 5); scr[kk * 33 + (lane & 31)] = W[(size_t)(k0 + kk) * N + n0 + (lane & 31)]; }
    LDS_WAIT(); asm volatile("" ::: "memory");
    const int c = lane & 7;
#pragma unroll
    for (int j = 0; j < 4; ++j) { const int n = (lane >> 3) + 8 * j; const LAS float* s = scr + (8 * c) * 33 + n;
        u32x4 o; o.x = pkbf(s[0 * 33], s[1 * 33]); o.y = pkbf(s[2 * 33], s[3 * 33]); o.z = pkbf(s[4 * 33], s[5 * 33]); o.w = pkbf(s[6 * 33], s[7 * 33]);
        *(GAS u32x4*)(WT + (size_t)(drow0 + n) * K + k0 + 8 * c) = o; }
    LDS_WAIT(); asm volatile("" ::: "memory");
}
__device__ __forceinline__ void transpose_item_f8(const float* W, int K, int N, unsigned char* WT, int k0, int n0, int drow0, float scale, LAS float* scr, int lane) {
#pragma unroll 8
    for (int i = 0; i < 32; ++i) { const int kk = 2 * i + (lane >> 5); scr[kk * 33 + (lane & 31)] = W[(size_t)(k0 + kk) * N + n0 + (lane & 31)]; }
    LDS_WAIT(); asm volatile("" ::: "memory");
    const int n = lane >> 1, hf = lane & 1; const LAS float* sp = scr + (32 * hf) * 33 + n;
    u32x4 o0, o1;
    o0.x = pk4f8(sp[0 * 33] * scale, sp[1 * 33] * scale, sp[2 * 33] * scale, sp[3 * 33] * scale);     o0.y = pk4f8(sp[4 * 33] * scale, sp[5 * 33] * scale, sp[6 * 33] * scale, sp[7 * 33] * scale);
    o0.z = pk4f8(sp[8 * 33] * scale, sp[9 * 33] * scale, sp[10 * 33] * scale, sp[11 * 33] * scale);   o0.w = pk4f8(sp[12 * 33] * scale, sp[13 * 33] * scale, sp[14 * 33] * scale, sp[15 * 33] * scale);
    o1.x = pk4f8(sp[16 * 33] * scale, sp[17 * 33] * scale, sp[18 * 33] * scale, sp[19 * 33] * scale); o1.y = pk4f8(sp[20 * 33] * scale, sp[21 * 33] * scale, sp[22 * 33] * scale, sp[23 * 33] * scale);
    o1.z = pk4f8(sp[24 * 33] * scale, sp[25 * 33] * scale, sp[26 * 33] * scale, sp[27 * 33] * scale); o1.w = pk4f8(sp[28 * 33] * scale, sp[29 * 33] * scale, sp[30 * 33] * scale, sp[31 * 33] * scale);
    GAS u32x4* dst = (GAS u32x4*)(WT + (size_t)(drow0 + n) * K + k0 + 32 * hf);
    dst[0] = o0; dst[1] = o1;
    LDS_WAIT(); asm volatile("" ::: "memory");
}
__device__ __forceinline__ void sincos_d(double x, double& s, double& c) {
    const double TWO_PI = 6.283185307179586476925;
    const double k = __builtin_rint(x / TWO_PI); const double r = x - k * TWO_PI;
    const double r2 = r * r; double ts = r, tc = 1.0; s = r; c = 1.0;
    for (int i = 1; i <= 16; ++i) { tc *= -r2 / (double)((2 * i - 1) * (2 * i)); ts *= -r2 / (double)((2 * i) * (2 * i + 1)); c += tc; s += ts; }
}

struct Args { const float* in[24]; float* out; unsigned char* ws; int ph_lo, ph_hi, li, pad; };
constexpr int NPH = 24;

__device__ __forceinline__ void norm_rows(const float* srcL, const float* srcC, int nrows, const float* g, const float* mod, int shc, int scc, bf16_t* XNo, int gw, int NGW, int lane,
                                          const float* part, int nS, const float* gatec, float* zout) {
    for (int m0 = gw * 4; m0 < nrows; m0 += NGW * 4) {
        const bool lat = m0 < NLAT;
        const float* src = lat ? srcL + (size_t)m0 * DM : srcC + (size_t)(m0 - NLAT) * DM; const int mb = lat ? (m0 >> 13) : 4;
        const GAS f32x4* xr = (const GAS f32x4*)src + lane;
        f32x4 v[4][4];
#pragma unroll
        for (int r = 0; r < 4; ++r)
#pragma unroll
            for (int j = 0; j < 4; ++j) v[r][j] = __builtin_nontemporal_load(xr + r * 256 + 64 * j);
        if (!lat && part != nullptr) {
#pragma unroll
            for (int r = 0; r < 4; ++r) {
                f32x4 a[4];
#pragma unroll
                for (int j = 0; j < 4; ++j) a[j] = (f32x4){0.f, 0.f, 0.f, 0.f};
                for (int s2 = 0; s2 < nS; ++s2) { const GAS f32x4* pr = (const GAS f32x4*)(part + ((size_t)s2 * NCTXR + (m0 + r - NLAT)) * DM) + lane;
#pragma unroll
                    for (int j = 0; j < 4; ++j) a[j] += pr[64 * j]; }
#pragma unroll
                for (int j = 0; j < 4; ++j) v[r][j] += *(const f32x4*)(gatec + 4 * lane + 256 * j) * a[j];
                if (zout != nullptr) { GAS f32x4* zr = (GAS f32x4*)(zout + (size_t)(m0 + r - NLAT) * DM) + lane;
#pragma unroll
                    for (int j = 0; j < 4; ++j) zr[64 * j] = v[r][j]; }
            }
        }
        float ss[4];
#pragma unroll
        for (int r = 0; r < 4; ++r) { ss[r] = 0.f;
#pragma unroll
            for (int j = 0; j < 4; ++j) ss[r] += (v[r][j].x * v[r][j].x + v[r][j].y * v[r][j].y) + (v[r][j].z * v[r][j].z + v[r][j].w * v[r][j].w); }
#pragma unroll
        for (int o = 1; o < 64; o <<= 1) {
#pragma unroll
            for (int r = 0; r < 4; ++r) ss[r] += __shfl_xor(ss[r], o); }
        const float* mrow = mod + (size_t)mb * 6144;
#pragma unroll
        for (int j = 0; j < 4; ++j) { const f32x4 gv = *(const f32x4*)(g + 4 * lane + 256 * j), sc = *(const f32x4*)(mrow + scc * 1024 + 4 * lane + 256 * j), sh = *(const f32x4*)(mrow + shc * 1024 + 4 * lane + 256 * j);
            const f32x4 gm = gv * (sc + 1.0f);
#pragma unroll
            for (int r = 0; r < 4; ++r) { const float rstd = 1.0f / __builtin_sqrtf(ss[r] * (1.0f / DM) + EPS);
                const f32x4 y = (v[r][j] * rstd) * gm + sh; u32x2 w; w.x = pkbf(y.x, y.y); w.y = pkbf(y.z, y.w);
                *((GAS u32x2*)(XNo + (size_t)(m0 + r) * DM) + lane + 64 * j) = w; } }
    }
}

__global__ void __launch_bounds__(512, 2) fwd(Args args) {
    extern __shared__ __attribute__((aligned(16))) unsigned char lds_raw[];
    LAS unsigned char* lds = (LAS unsigned char*)lds_raw;
    volatile LAS unsigned* MISC = (volatile LAS unsigned*)(lds + MISC_OFF);
    LAS int* gtab = (LAS int*)(lds + GTAB_OFF);
    const int G = gridDim.x; const int bx = blockIdx.x; const int vcu = (G % 8 == 0) ? (bx % 8) * (G / 8) + bx / 8 : bx;
    const int NGW = G * 8;
#define PHASE_IDS() int tid_ = threadIdx.x; asm volatile("" : "+v"(tid_)); const int tid = tid_, lane = tid & 63, wave = __builtin_amdgcn_readfirstlane(tid >> 6), gw = vcu * 8 + wave; (void)lane; (void)gw
    unsigned char* ws = args.ws;
    gu32* ctl = (gu32*)(ws + WS_CTL);
#define MOD ((float*)(ws + WS_MOD))
#define ROPE ((float*)(ws + WS_ROPE))
#define STATS ((float*)(ws + WS_STATS))
#define LIST ((int*)(ws + WS_LIST))
#define TINFO ((int*)(ws + WS_TINFO))
#define WSB ((bf16_t*)(ws + WS_WS))
#define WIN ((bf16_t*)(ws + WS_WIN))
#define WAO ((bf16_t*)(ws + WS_WAO))
#define WQKV ((bf16_t*)(ws + WS_WQKV))
#define WBO ((bf16_t*)(ws + WS_WBO))
#define WGU ((bf16_t*)(ws + WS_WGU))
#define WD ((bf16_t*)(ws + WS_WD))
#define MGU ((unsigned char*)(ws + WS_MGU))
#define MD ((unsigned char*)(ws + WS_MD))
#define XN8 ((unsigned char*)(ws + WS_XN))
#define XN ((bf16_t*)(ws + WS_XN))
#define ZB ((float*)(ws + WS_ZB))
#define UVT ((bf16_t*)(ws + WS_UVT))
#define A2 ((bf16_t*)(ws + WS_A2))
#define HB ((bf16_t*)(ws + WS_H))
#define QKV ((bf16_t*)(ws + WS_QKV))
#define OB ((bf16_t*)(ws + WS_O))
#define YB ((bf16_t*)(ws + WS_Y))
#define HC ((unsigned char*)(ws + WS_HC))
#define YP ((bf16_t*)(ws + WS_YP))
#define PART1 ((float*)(ws + WS_PART1))
#define PART2 ((float*)(ws + WS_PART2))
#define I_X (args.in[0])
#define I_C (args.in[1])
#define I_CTX (args.in[2])
#define I_CCTX (args.in[3])
#define I_ADAW (args.in[4])
#define I_ADAB (args.in[5])
#define I_NORMG (args.in[6])
#define I_FINALG (args.in[7])
#define HL (args.out)

    { PHASE_IDS(); for (int u = tid; u < (LDS_BYTES - MISC_OFF) / 4; u += 512) ((LAS unsigned*)(lds + MISC_OFF))[u] = 0u; }
    __syncthreads();
    const int lo = args.ph_lo, hi_ph = args.ph_hi;
    const bool one_launch = (hi_ph - lo) > 1;
    XcdBarrier bar; bar.bar = (unsigned*)(ctl + CW_BAR) + args.li * XCD_BAR_WORDS; bar.x = 0; bar.st = nullptr;
    if (one_launch) bar = xcd_barrier_post((unsigned*)(ctl + CW_BAR) + args.li * XCD_BAR_WORDS, MISC + 8);
#ifndef PHMASK
#define PHMASK 0xFFFFFFFFu
#endif
#define IN(k) (((PHMASK >> (k)) & 1) && lo <= (k) && (k) < hi_ph)
#define BOTH(k) (IN(k) && IN((k) + 1))
#define GRID_BAR() xcd_barrier(bar)
#if defined(PROBE_LO)
    unsigned long long tpA = __builtin_amdgcn_s_memrealtime(), tpB = 0;
#define PROBE_MARK(k) do { if ((k) == PROBE_LO - 1) tpA = __builtin_amdgcn_s_memrealtime(); if ((k) == PROBE_HI) tpB = __builtin_amdgcn_s_memrealtime(); } while (0)
#else
#define PROBE_MARK(k) do { } while (0)
#endif

    if (IN(0)) {
        PHASE_IDS();
        {
            LAS float* sv = (LAS float*)lds;
            LAS float* red = (LAS float*)(lds + 5 * 1024 * 4);
            if (bx < 192) {
                for (int idx = tid; idx < 5 * 1024; idx += 512) { const int r = idx >> 10, k = idx & 1023; const float cv = r < 4 ? I_C[r * 1024 + k] : I_CCTX[k]; sv[idx] = cv / (1.0f + __expf(-cv)); }
                __syncthreads();
                for (int item = bx; item < 192; item += G) {
                    const int i = item / 96, n0 = (item % 96) * 64, nn = tid & 63, kq = tid >> 6;
                    float a0 = 0.f, a1 = 0.f, a2 = 0.f, a3 = 0.f, a4 = 0.f;
                    const float* wp = I_ADAW + ((size_t)i * 1024 + kq * 128) * 6144 + n0 + nn;
#pragma unroll 8
                    for (int k = 0; k < 128; ++k) { const float w = wp[(size_t)k * 6144]; const int kk = kq * 128 + k;
                        a0 += sv[kk] * w; a1 += sv[1024 + kk] * w; a2 += sv[2048 + kk] * w; a3 += sv[3072 + kk] * w; a4 += sv[4096 + kk] * w; }
                    red[(kq * 5 + 0) * 64 + nn] = a0; red[(kq * 5 + 1) * 64 + nn] = a1; red[(kq * 5 + 2) * 64 + nn] = a2; red[(kq * 5 + 3) * 64 + nn] = a3; red[(kq * 5 + 4) * 64 + nn] = a4;
                    __syncthreads();
                    if (tid < 320) { const int r = tid >> 6; float s = I_ADAB[i * 6144 + n0 + nn];
#pragma unroll
                        for (int q = 0; q < 8; ++q) s += red[(q * 5 + r) * 64 + nn];
                        MOD[((size_t)i * 5 + r) * 6144 + n0 + nn] = s; }
                    __syncthreads();
                }
            }
            __syncthreads();
        }
        {
            LAS float* scr = (LAS float*)(lds + wave * 16384);
            constexpr int I_IN = 16 * 64, I_AO = 16 * 32, I_QKV = 16 * 48, I_BO = 16 * 32, I_F = 16 * 112, I_FD = 56 * 32;
            constexpr int I_DENSE = I_IN + I_AO + I_QKV + I_BO + 2 * I_F + I_FD, I_MOE = 8 * (2 * I_F + I_FD), I_WS = 128, I_ROPE = 32;
            constexpr int NITEMS = I_DENSE + I_MOE + I_WS + I_ROPE;
            for (int it = gw; it < NITEMS; it += NGW) {
                int r = it;
                if (r < I_IN) { const int kb = r / 64, nb = r % 64; transpose_item(args.in[8], 1024, 2048, WIN, 64 * kb, 32 * nb, 32 * nb, scr, lane); continue; } r -= I_IN;
                if (r < I_AO) { const int kb = r / 32, nb = r % 32; transpose_item(args.in[13], 1024, 1024, WAO, 64 * kb, 32 * nb, 32 * nb, scr, lane); continue; } r -= I_AO;
                if (r < I_QKV) { const int kb = r / 48, nb = r % 48; transpose_item(args.in[14], 1024, 1536, WQKV, 64 * kb, 32 * nb, 32 * nb, scr, lane); continue; } r -= I_QKV;
                if (r < I_BO) { const int kb = r / 32, nb = r % 32; transpose_item(args.in[16], 1024, 1024, WBO, 64 * kb, 32 * nb, 32 * nb, scr, lane); continue; } r -= I_BO;
                if (r < 2 * I_F) { const int up = r / I_F; const int q = r % I_F; const int kb = q / 112, nb = q % 112, n0 = 32 * nb;
                    transpose_item(args.in[17 + up], 1024, DFF, WGU, 64 * kb, n0, 256 * (n0 >> 7) + 128 * up + (n0 & 127), scr, lane); continue; } r -= 2 * I_F;
                if (r < I_FD) { const int kb = r / 32, nb = r % 32; transpose_item(args.in[19], DFF, 1024, WD, 64 * kb, 32 * nb, 32 * nb, scr, lane); continue; } r -= I_FD;
                if (r < I_MOE) { const int e = r / (2 * I_F + I_FD); int q = r % (2 * I_F + I_FD);
                    if (q < 2 * I_F) { const int up = q / I_F; q %= I_F; const int kb = q / 112, nb = q % 112, n0 = 32 * nb;
                        transpose_item_f8(args.in[21 + up] + (size_t)e * 1024 * DFF, 1024, DFF, MGU + (size_t)e * 7168 * 1024, 64 * kb, n0, 256 * (n0 >> 7) + 128 * up + (n0 & 127), MOE_SGU, scr, lane); }
                    else { q -= 2 * I_F; const int kb = q / 32, nb = q % 32; transpose_item_f8(args.in[23] + (size_t)e * DFF * 1024, DFF, 1024, MD + (size_t)e * 1024 * DFF, 64 * kb, 32 * nb, 32 * nb, MOE_SD, scr, lane); }
                    continue; } r -= I_MOE;
                if (r < I_WS) { const float* src = args.in[11] + (size_t)r * 2048;
#pragma unroll
                    for (int j = 0; j < 8; ++j) { const f32x4 v = *(const f32x4*)(src + j * 256 + lane * 4); u32x2 w; w.x = pkbf(v.x, v.y); w.y = pkbf(v.z, v.w); *(u32x2*)(WSB + (size_t)r * 2048 + j * 256 + lane * 4) = w; }
                    continue; } r -= I_WS;
                {
                    const int ent = r * 64 + lane; const int pos = ent >> 4, i = ent & 15;
                    double inv = 1.0; for (int q = 0; q < i; ++q) inv *= 0.56234132519034908;
                    const float ang = (float)pos * (float)inv; double s, c; sincos_d((double)ang, s, c);
                    ROPE[ent] = (float)c; ROPE[2048 + ent] = (float)s;
                }
            }
        }
        if (BOTH(0)) GRID_BAR(); PROBE_MARK(0);
    }
    if (IN(1)) { PHASE_IDS(); norm_rows(I_X, I_CTX, MALL, I_NORMG + 0 * 1024, MOD, 0, 1, XN, gw, NGW, lane, nullptr, 0, nullptr, nullptr); if (BOTH(1)) GRID_BAR(); PROBE_MARK(1); }
    if (IN(2)) {
        pg8::DenseSched S{(const char*)WIN, (const char*)XN, 8, NPA, G, bx, (size_t)256 * 1024 * 2};
        pg8::EpiGeluT E{UVT, STATS};
        pg8::gemm_phase<pg8::EpiGeluT, pg8::DenseSched, true, false>(lds, gtab, 1024, 16, S, E);
        if (BOTH(2)) GRID_BAR(); PROBE_MARK(2);
    }
    if (IN(3)) {
        PHASE_IDS();
        const float* vg = args.in[9]; const float* vb = args.in[10]; const float* bs = args.in[12];
        LAS float* mu_l = (LAS float*)(lds + wave * 1024); LAS float* rs_l = mu_l + 128;
        const int r32 = lane & 31, h = lane >> 5;
        for (int unit = gw; unit < (MALL / 128) * 16; unit += NGW) {
            const int ch = unit >> 4, g = unit & 15, q0 = ch * 128;
#pragma unroll
            for (int tt = 0; tt < 2; ++tt) { const int tok = q0 + lane * 2 + tt; const f32x4* sp = (const f32x4*)(STATS + (size_t)tok * 16);
                const f32x4 a = sp[0], b = sp[1], c = sp[2], d = sp[3];
                const float sum = (a.x + a.z) + (b.x + b.z) + (c.x + c.z) + (d.x + d.z), sq = (a.y + a.w) + (b.y + b.w) + (c.y + c.w) + (d.y + d.w);
                const float mean = sum * (1.0f / 1024.0f), var = sq * (1.0f / 1024.0f) - mean * mean;
                mu_l[lane * 2 + tt] = mean; rs_l[lane * 2 + tt] = 1.0f / __builtin_sqrtf(var + EPS); }
            float vgc[2], vbc[2];
#pragma unroll
            for (int ct = 0; ct < 2; ++ct) { vgc[ct] = vg[64 * g + 32 * ct + r32]; vbc[ct] = vb[64 * g + 32 * ct + r32]; }
            f32x16 acc[2][4];
#pragma unroll
            for (int ct = 0; ct < 2; ++ct)
#pragma unroll
                for (int pt = 0; pt < 4; ++pt) acc[ct][pt] = f32x16{};
#pragma unroll 2
            for (int s = 0; s < 8; ++s) {
                const int qs = 16 * s + 8 * h;
                const f32x4 m0 = *(const LAS f32x4*)(mu_l + qs), m1 = *(const LAS f32x4*)(mu_l + qs + 4), r0 = *(const LAS f32x4*)(rs_l + qs), r1 = *(const LAS f32x4*)(rs_l + qs + 4);
                bf16x8 af[2], bfr[4];
#pragma unroll
                for (int ct = 0; ct < 2; ++ct) { const bf16x8 raw = *(const bf16x8*)(UVT + (size_t)(1024 + 64 * g + 32 * ct + r32) * MALL + q0 + qs);
                    float y[8];
#pragma unroll
                    for (int j = 0; j < 4; ++j) { y[j] = (bf2f((unsigned short)raw[j]) - m0[j]) * r0[j] * vgc[ct] + vbc[ct]; y[4 + j] = (bf2f((unsigned short)raw[4 + j]) - m1[j]) * r1[j] * vgc[ct] + vbc[ct]; }
                    u32x4 w; w.x = pkbf(y[0], y[1]); w.y = pkbf(y[2], y[3]); w.z = pkbf(y[4], y[5]); w.w = pkbf(y[6], y[7]); af[ct] = __builtin_bit_cast(bf16x8, w); }
#pragma unroll
                for (int pt = 0; pt < 4; ++pt) bfr[pt] = *(const bf16x8*)(WSB + (size_t)(g * 128 + 32 * pt + r32) * 128 + qs);
#pragma unroll
                for (int ct = 0; ct < 2; ++ct)
#pragma unroll
                    for (int pt = 0; pt < 4; ++pt) acc[ct][pt] = __builtin_amdgcn_mfma_f32_32x32x16_bf16(af[ct], bfr[pt], acc[ct][pt], 0, 0, 0);
            }
#pragma unroll
            for (int pt = 0; pt < 4; ++pt) { const int p = 32 * pt + r32; const size_t tokp = (size_t)q0 + p; const float bsv = bs[g * 128 + p];
#pragma unroll
                for (int ct = 0; ct < 2; ++ct)
#pragma unroll
                    for (int rr = 0; rr < 4; ++rr) { const int c = 64 * g + 32 * ct + 8 * rr + 4 * h; float o[4];
#pragma unroll
                        for (int e = 0; e < 4; ++e) { const float uu = bf2f(UVT[(size_t)(c + e) * MALL + tokp]); o[e] = uu * (acc[ct][pt][4 * rr + e] + bsv); }
                        u32x2 w; w.x = pkbf(o[0], o[1]); w.y = pkbf(o[2], o[3]); *(u32x2*)(A2 + tokp * DM + c) = w; } }
        }
        if (BOTH(3)) GRID_BAR(); PROBE_MARK(3);
    }
    if (IN(4)) {
        { pg8::DenseSched S{(const char*)A2, (const char*)WAO, NPL, 4, G, bx, (size_t)256 * 1024 * 2};
          pg8::EpiResid E{I_X, I_CTX, HL, ZB, MOD + 2 * 1024};
          pg8::gemm_phase<pg8::EpiResid, pg8::DenseSched, true, false>(lds, gtab, 1024, 16, S, E); }
        { pg8::SplitSched S{(const char*)(A2 + (size_t)NLAT * DM), (const char*)WAO, 4, 4, P3_NS, G, bx, NPL, (size_t)256 * 1024 * 2, (size_t)(1024 / P3_NS) * 2};
          pg8::EpiPartF32 E{PART1, (size_t)NCTXR * DM};
          pg8::gemm_phase<pg8::EpiPartF32, pg8::SplitSched, true, false>(lds, gtab, 1024, 1024 / P3_NS / 64, S, E); }
        if (BOTH(4)) GRID_BAR(); PROBE_MARK(4);
    }
    if (IN(5)) { PHASE_IDS(); norm_rows(HL, I_CTX, MALL, I_NORMG + 1 * 1024, MOD, 3, 4, XN, gw, NGW, lane, PART1, P3_NS, MOD + 4 * 6144 + 2 * 1024, ZB); if (BOTH(5)) GRID_BAR(); PROBE_MARK(5); }
    if (IN(6)) {
        pg8::DenseSched S{(const char*)XN, (const char*)WGU, NPA, 28, G, bx, (size_t)256 * 1024 * 2};
        pg8::EpiSwiGLU E{HB};
        pg8::gemm_phase<pg8::EpiSwiGLU, pg8::DenseSched, true, false>(lds, gtab, 1024, 16, S, E);
        if (BOTH(6)) GRID_BAR(); PROBE_MARK(6);
    }
    if (IN(7)) {
        { pg8::DenseSched S{(const char*)HB, (const char*)WD, NPL, 4, G, bx, (size_t)256 * DFF * 2};
          pg8::EpiResid E{HL, ZB, HL, ZB, MOD + 5 * 1024};
          pg8::gemm_phase<pg8::EpiResid, pg8::DenseSched, true, false>(lds, gtab, DFF, 56, S, E); }
        { pg8::SplitSched S{(const char*)(HB + (size_t)NLAT * DFF), (const char*)WD, 4, 4, P5_NS, G, bx, NPL, (size_t)256 * DFF * 2, (size_t)(DFF / P5_NS) * 2};
          pg8::EpiPartF32 E{PART2, (size_t)NCTXR * DM};
          pg8::gemm_phase<pg8::EpiPartF32, pg8::SplitSched, true, false>(lds, gtab, DFF, DFF / P5_NS / 64, S, E); }
        if (BOTH(7)) GRID_BAR(); PROBE_MARK(7);
    }
    if (IN(8)) { PHASE_IDS(); norm_rows(HL, ZB, MALL, I_NORMG + 2 * 1024, MOD + 5 * 6144, 0, 1, XN, gw, NGW, lane, PART2, P5_NS, MOD + 4 * 6144 + 5 * 1024, nullptr); if (BOTH(8)) GRID_BAR(); PROBE_MARK(8); }
    if (IN(9)) {
        pg8::DenseSched S{(const char*)XN, (const char*)WQKV, NPA, 6, G, bx, (size_t)256 * 1024 * 2};
        pg8::EpiQKV E{QKV, ROPE, ROPE + 2048, attn_body::C2};
        pg8::gemm_phase<pg8::EpiQKV, pg8::DenseSched, true, false>(lds, gtab, 1024, 16, S, E);
        if (BOTH(9)) GRID_BAR(); PROBE_MARK(9);
    }
    if (IN(10)) {
        static_assert(attn_body::LDS_BYTES_A <= RING_BYTES, "attention LDS");
        const float* sinkp = args.in[15];
        for (int i = 0;; ++i) { const int uid = i * G + vcu; if (uid >= NB * 64 * 4 * 2) break;
            const int pr = uid & 1, hk = (uid >> 1) & 3, n = (uid >> 3) & 63, b = uid >> 9;
            attn_body::attn_unit<8>(b, hk, n, pr, (const attn_body::bf16*)QKV, (attn_body::bf16*)OB, sinkp, (char*)lds_raw); }
        if (BOTH(10)) GRID_BAR(); PROBE_MARK(10);
    }
    if (IN(11)) {
        pg8::DenseSched S{(const char*)OB, (const char*)WBO, NPL, 4, G, bx, (size_t)256 * 1024 * 2};
        pg8::EpiResid E{HL, ZB, HL, ZB, MOD + 5 * 6144 + 2 * 1024};
        pg8::gemm_phase<pg8::EpiResid, pg8::DenseSched, true, false>(lds, gtab, 1024, 16, S, E);
        if (BOTH(11)) GRID_BAR(); PROBE_MARK(11);
    }
    if (IN(12)) {
        PHASE_IDS();
        const float* g = I_NORMG + 3 * 1024; const float* mod = MOD + 5 * 6144; const float* wrt = args.in[20];
        LAS int* l_e = (LAS int*)lds;
        LAS float* l_w = (LAS float*)(lds + 1024);
        LAS int* l_cnt = (LAS int*)(lds + 2048);
        LAS int* l_base = (LAS int*)(lds + 2048 + 64);
        for (int blk = bx; blk < NLAT / 128; blk += G) {
            if (tid < 8) l_cnt[tid] = 0;
            __syncthreads();
            const int mb = (blk * 128) >> 13; const float* mrow = mod + (size_t)mb * 6144;
            for (int i4 = 0; i4 < 8; ++i4) {
                const int tl0 = wave * 16 + i4 * 2, m0 = blk * 128 + tl0;
                const GAS f32x4* xr = (const GAS f32x4*)(HL + (size_t)m0 * DM) + lane;
                f32x4 v[2][4]; float ss[2];
#pragma unroll
                for (int r = 0; r < 2; ++r)
#pragma unroll
                    for (int j = 0; j < 4; ++j) v[r][j] = xr[r * 256 + 64 * j];
#pragma unroll
                for (int r = 0; r < 2; ++r) { ss[r] = 0.f;
#pragma unroll
                    for (int j = 0; j < 4; ++j) ss[r] += (v[r][j].x * v[r][j].x + v[r][j].y * v[r][j].y) + (v[r][j].z * v[r][j].z + v[r][j].w * v[r][j].w); }
#pragma unroll
                for (int o = 1; o < 64; o <<= 1) {
#pragma unroll
                    for (int r = 0; r < 2; ++r) ss[r] += __shfl_xor(ss[r], o); }
                float lg[2][8];
#pragma unroll
                for (int r = 0; r < 2; ++r)
#pragma unroll
                    for (int e = 0; e < 8; ++e) lg[r][e] = 0.f;
#pragma unroll
                for (int j = 0; j < 4; ++j) { const int col = 4 * lane + 256 * j; const f32x4 gv = *(const f32x4*)(g + col), sc = *(const f32x4*)(mrow + 4 * 1024 + col), sh = *(const f32x4*)(mrow + 3 * 1024 + col);
                    const f32x4 gm = gv * (sc + 1.0f);
                    f32x4 y[2];
#pragma unroll
                    for (int r = 0; r < 2; ++r) { const float rstd = 1.0f / __builtin_sqrtf(ss[r] * (1.0f / DM) + EPS); y[r] = (v[r][j] * rstd) * gm + sh;
                        *((GAS unsigned*)(XN8 + (size_t)(m0 + r) * DM) + lane + 64 * j) = pk4f8(y[r].x, y[r].y, y[r].z, y[r].w); }
#pragma unroll
                    for (int cc = 0; cc < 4; ++cc) { const f32x4 w0 = *(const f32x4*)(wrt + (size_t)(col + cc) * 8), w1 = *(const f32x4*)(wrt + (size_t)(col + cc) * 8 + 4);
#pragma unroll
                        for (int r = 0; r < 2; ++r) { const float yv = y[r][cc];
                            lg[r][0] += yv * w0.x; lg[r][1] += yv * w0.y; lg[r][2] += yv * w0.z; lg[r][3] += yv * w0.w; lg[r][4] += yv * w1.x; lg[r][5] += yv * w1.y; lg[r][6] += yv * w1.z; lg[r][7] += yv * w1.w; } } }
#pragma unroll
                for (int o = 1; o < 64; o <<= 1) {
#pragma unroll
                    for (int r = 0; r < 2; ++r)
#pragma unroll
                        for (int e = 0; e < 8; ++e) lg[r][e] += __shfl_xor(lg[r][e], o); }
#pragma unroll
                for (int r = 0; r < 2; ++r) {
                    int ea = 0; float va = lg[r][0];
#pragma unroll
                    for (int e = 1; e < 8; ++e) if (lg[r][e] > va) { va = lg[r][e]; ea = e; }
                    int eb = -1; float vb2 = -INFINITY;
#pragma unroll
                    for (int e = 0; e < 8; ++e) if (e != ea && lg[r][e] > vb2) { vb2 = lg[r][e]; eb = e; }
                    const float wb = 1.0f / (1.0f + __expf(va - vb2)), wa = 1.0f - wb;
                    if (lane == 0) { const int tl = tl0 + r; l_e[tl * 2] = ea; l_e[tl * 2 + 1] = eb; l_w[tl * 2] = wa; l_w[tl * 2 + 1] = wb; } }
            }
            __syncthreads();
            int ea = 0, eb = 0, pa = 0, pb = 0;
            if (tid < 128) { ea = l_e[tid * 2]; eb = l_e[tid * 2 + 1]; pa = atomicAdd((int*)&l_cnt[ea], 1); pb = atomicAdd((int*)&l_cnt[eb], 1); }
            __syncthreads();
            if (tid < 8) l_base[tid] = (int)__hip_atomic_fetch_add((unsigned*)(ctl + CW_CNT + 64 * tid), (unsigned)l_cnt[tid], __ATOMIC_RELAXED, __HIP_MEMORY_SCOPE_AGENT);
            __syncthreads();
            if (tid < 128) { const int m = blk * 128 + tid; pa += l_base[ea]; pb += l_base[eb];
                LIST[(size_t)ea * NLAT + pa] = m; LIST[(size_t)eb * NLAT + pb] = m;
                int* ti = TINFO + (size_t)m * 8; ti[0] = ea; ti[1] = pa; ti[2] = eb; ti[3] = pb; ti[4] = __float_as_int(l_w[tid * 2]); ti[5] = __float_as_int(l_w[tid * 2 + 1]); }
            __syncthreads();
        }
        if (BOTH(12)) GRID_BAR(); PROBE_MARK(12);
    }
    if (hi_ph > 13 && lo < 23) {
        PHASE_IDS();
        LAS int* mtab = (LAS int*)(lds + MOE_OFF);
        if (tid == 0) { int run = 0, R = 0;
            for (int e = 0; e < 8; ++e) { const int ce = (int)__hip_atomic_load((unsigned*)(ctl + CW_CNT + 64 * e), __ATOMIC_RELAXED, __HIP_MEMORY_SCOPE_AGENT); mtab[e] = run; mtab[16 + e] = ce; run += ce >> 8; if (ce & 255) { mtab[24 + R] = e; ++R; } }
            mtab[8] = run; mtab[32] = R; }
        __syncthreads();
        const int nfull = __builtin_amdgcn_readfirstlane(mtab[8]);
        for (int c = 0; c < MOE_NCH; ++c) {
            const int gp0 = c * MOE_CH, gp1 = nfull < (c + 1) * MOE_CH ? nfull : (c + 1) * MOE_CH;
            if (IN(13 + 2 * c)) {
                pg8::MoeSched S; S.A = (const char*)XN8; S.B = (const char*)MGU; S.list = LIST; S.tab = mtab; S.mode = 0; S.nS = 1; S.kbytes = 0;
                S.gp0 = gp0; S.gp1 = gp1; S.nN = 28; S.G = G; S.c = bx; S.bexp = (size_t)7168 * 1024; S.btile = (size_t)256 * 1024; S.astep = 0; S.gather = true;
                pg8::EpiSwiGLU8 E{HC, 1.0f / MOE_SGU};
                pg8::gemm_phase<pg8::EpiSwiGLU8, pg8::MoeSched, true, true, true>(lds, gtab, 512, 8, S, E);
                if (BOTH(13 + 2 * c)) GRID_BAR(); PROBE_MARK(13 + 2 * c);
            }
            if (IN(14 + 2 * c)) {
                pg8::MoeSched S; S.A = (const char*)HC; S.B = (const char*)MD; S.list = LIST; S.tab = mtab; S.mode = 0; S.nS = 1; S.kbytes = 0;
                S.gp0 = gp0; S.gp1 = gp1; S.nN = 4; S.G = G; S.c = bx; S.bexp = (size_t)1024 * DFF; S.btile = (size_t)256 * DFF; S.astep = (size_t)256 * DFF; S.gather = false;
                pg8::EpiBf16Plain E{YB, DM, 1.0f / MOE_SD};
                pg8::gemm_phase<pg8::EpiBf16Plain, pg8::MoeSched, true, false, true>(lds, gtab, DFF / 2, 28, S, E);
                if (BOTH(14 + 2 * c)) GRID_BAR(); PROBE_MARK(14 + 2 * c);
            }
        }
        if (IN(21)) {
            pg8::MoeSched S; S.A = (const char*)XN8; S.B = (const char*)MGU; S.list = LIST; S.tab = mtab; S.mode = 1; S.nS = 1; S.kbytes = 0;
            S.gp0 = 0; S.gp1 = 0; S.nN = 28; S.G = G; S.c = bx; S.bexp = (size_t)7168 * 1024; S.btile = (size_t)256 * 1024; S.astep = 0; S.gather = true;
            pg8::EpiSwiGLU8 E{HC, 1.0f / MOE_SGU};
            pg8::gemm_phase<pg8::EpiSwiGLU8, pg8::MoeSched, true, true, true>(lds, gtab, 512, 8, S, E);
            if (BOTH(21)) GRID_BAR(); PROBE_MARK(21);
        }
        if (IN(22)) {
            pg8::MoeSched S; S.A = (const char*)HC; S.B = (const char*)MD; S.list = LIST; S.tab = mtab; S.mode = 2; S.nS = MOE_RS; S.kbytes = (size_t)(DFF / MOE_RS);
            S.gp0 = 0; S.gp1 = 0; S.nN = 4; S.G = G; S.c = bx; S.bexp = (size_t)1024 * DFF; S.btile = (size_t)256 * DFF; S.astep = (size_t)256 * DFF; S.gather = false;
            pg8::EpiPartBf16 E{YP, (size_t)8 * 256 * DM, 1.0f / MOE_SD};
            pg8::gemm_phase<pg8::EpiPartBf16, pg8::MoeSched, true, false, true>(lds, gtab, DFF / 2, DFF / MOE_RS / 128, S, E);
            if (BOTH(22)) GRID_BAR(); PROBE_MARK(22);
        }
    }
    if (IN(23)) {
        PHASE_IDS();
        LAS int* l_pb = (LAS int*)(lds + wave * 128);
        if (lane == 0) { int run = 0, R = 0;
            for (int e = 0; e < 8; ++e) { const int ce = (int)__hip_atomic_load((unsigned*)(ctl + CW_CNT + 64 * e), __ATOMIC_RELAXED, __HIP_MEMORY_SCOPE_AGENT); l_pb[e] = run; l_pb[8 + e] = ce >> 8; l_pb[16 + e] = R; run += ce >> 8; if (ce & 255) ++R; } }
        const float* g2 = MOD + 5 * 6144 + 5 * 1024;
        for (int m0 = gw * 2; m0 < NLAT; m0 += NGW * 2) {
            const int mb = m0 >> 13;
            f32x4 hv[2][4], ya[2][4], yb[2][4]; float wa[2], wb[2];
#pragma unroll
            for (int r = 0; r < 2; ++r) {
                const int m = m0 + r; const int* ti = TINFO + (size_t)m * 8;
                const int ea = ti[0], pa = ti[1], eb = ti[2], pb = ti[3]; wa[r] = __int_as_float(ti[4]); wb[r] = __int_as_float(ti[5]);
                const bool ma = (pa >> 8) < l_pb[8 + ea], mbm = (pb >> 8) < l_pb[8 + eb];
                const size_t sa = ma ? (size_t)(l_pb[ea] + (pa >> 8)) * 256 + (pa & 255) : (size_t)l_pb[16 + ea] * 256 + (pa & 255);
                const size_t sb = mbm ? (size_t)(l_pb[eb] + (pb >> 8)) * 256 + (pb & 255) : (size_t)l_pb[16 + eb] * 256 + (pb & 255);
                const GAS f32x4* xr = (const GAS f32x4*)(HL + (size_t)m * DM) + lane;
#pragma unroll
                for (int j = 0; j < 4; ++j) hv[r][j] = xr[64 * j];
                { const GAS u32x2* yr = (const GAS u32x2*)((ma ? YB : YP) + sa * DM) + lane;
#pragma unroll
                  for (int j = 0; j < 4; ++j) { const u32x2 a = yr[64 * j]; ya[r][j] = (f32x4){__uint_as_float(a.x << 16), __uint_as_float(a.x & 0xffff0000u), __uint_as_float(a.y << 16), __uint_as_float(a.y & 0xffff0000u)}; }
                  if (!ma) for (int s2 = 1; s2 < MOE_RS; ++s2) { const GAS u32x2* y2 = (const GAS u32x2*)(YP + ((size_t)s2 * 8 * 256 + sa) * DM) + lane;
#pragma unroll
                      for (int j = 0; j < 4; ++j) { const u32x2 a = y2[64 * j]; ya[r][j] += (f32x4){__uint_as_float(a.x << 16), __uint_as_float(a.x & 0xffff0000u), __uint_as_float(a.y << 16), __uint_as_float(a.y & 0xffff0000u)}; } } }
                { const GAS u32x2* yr = (const GAS u32x2*)((mbm ? YB : YP) + sb * DM) + lane;
#pragma unroll
                  for (int j = 0; j < 4; ++j) { const u32x2 a = yr[64 * j]; yb[r][j] = (f32x4){__uint_as_float(a.x << 16), __uint_as_float(a.x & 0xffff0000u), __uint_as_float(a.y << 16), __uint_as_float(a.y & 0xffff0000u)}; }
                  if (!mbm) for (int s2 = 1; s2 < MOE_RS; ++s2) { const GAS u32x2* y2 = (const GAS u32x2*)(YP + ((size_t)s2 * 8 * 256 + sb) * DM) + lane;
#pragma unroll
                      for (int j = 0; j < 4; ++j) { const u32x2 a = y2[64 * j]; yb[r][j] += (f32x4){__uint_as_float(a.x << 16), __uint_as_float(a.x & 0xffff0000u), __uint_as_float(a.y << 16), __uint_as_float(a.y & 0xffff0000u)}; } } }
            }
            float ss[2];
#pragma unroll
            for (int r = 0; r < 2; ++r) { ss[r] = 0.f;
#pragma unroll
                for (int j = 0; j < 4; ++j) { const f32x4 gv = *(const f32x4*)(g2 + (size_t)mb * 6144 + 4 * lane + 256 * j);
                    hv[r][j] = hv[r][j] + gv * (ya[r][j] * wa[r] + yb[r][j] * wb[r]); ss[r] += (hv[r][j].x * hv[r][j].x + hv[r][j].y * hv[r][j].y) + (hv[r][j].z * hv[r][j].z + hv[r][j].w * hv[r][j].w); } }
#pragma unroll
            for (int o = 1; o < 64; o <<= 1) {
#pragma unroll
                for (int r = 0; r < 2; ++r) ss[r] += __shfl_xor(ss[r], o); }
#pragma unroll
            for (int r = 0; r < 2; ++r) { const float rstd = 1.0f / __builtin_sqrtf(ss[r] * (1.0f / DM) + EPS);
                GAS f32x4* orow = (GAS f32x4*)(args.out + (size_t)(m0 + r) * DM) + lane;
#pragma unroll
                for (int j = 0; j < 4; ++j) { const f32x4 fg = *(const f32x4*)(I_FINALG + 4 * lane + 256 * j); __builtin_nontemporal_store((hv[r][j] * rstd) * fg, orow + 64 * j); } }
        }
    }
    PROBE_MARK(23);
#if defined(PROBE_LO)
    { PHASE_IDS(); const float T = (float)(tpB - tpA) * 0.01f; const float cval = __builtin_sqrtf(T / (float)(PROBE_UNIT));
      for (int m = gw; m < NLAT; m += NGW) { GAS f32x4* orow = (GAS f32x4*)(args.out + (size_t)m * DM) + lane;
#pragma unroll
        for (int j = 0; j < 4; ++j) orow[64 * j] = (f32x4){cval, cval, cval, cval}; } }
#endif
#undef IN
#undef BOTH
#undef GRID_BAR
}

#ifndef MK_ONE_LAUNCH
#define MK_ONE_LAUNCH 1
#endif
extern "C" void kernel_launch(void* const* d_in, const int* in_sizes, int n_in, void* d_out, int out_size, void* d_ws, size_t ws_size, hipStream_t stream) {
    static int grid = 0;
    if (grid == 0) {
        if (n_in != 24 || out_size != NLAT * DM || ws_size < WS_END) { fprintf(stderr, "kernel_launch: unexpected problem (n_in %d, out %d, ws %zu < %zu)\n", n_in, out_size, ws_size, (size_t)WS_END); grid = -1; return; }
        int dev = 0, cus = 0, per_cu = 0;
        if (hipGetDevice(&dev) != hipSuccess || hipDeviceGetAttribute(&cus, hipDeviceAttributeMultiprocessorCount, dev) != hipSuccess) { grid = -1; return; }
        if (hipFuncSetAttribute((const void*)fwd, hipFuncAttributeMaxDynamicSharedMemorySize, LDS_BYTES) != hipSuccess) { fprintf(stderr, "kernel_launch: hipFuncSetAttribute failed\n"); grid = -1; return; }
        if (hipOccupancyMaxActiveBlocksPerMultiprocessor(&per_cu, (const void*)fwd, 512, LDS_BYTES) != hipSuccess || per_cu < 1) fprintf(stderr, "kernel_launch: occupancy query says %d\n", per_cu);
        (void)hipGetLastError();
        grid = cus;
    }
    if (grid < 0) return;
    if (hipMemsetAsync((char*)d_ws + WS_CTL, 0, CTL_ZERO_BYTES, stream) != hipSuccess) return;
    Args a{};
    for (int i = 0; i < 24; ++i) a.in[i] = (const float*)d_in[i];
    a.out = (float*)d_out; a.ws = (unsigned char*)d_ws;
#if defined(SPLITAT)
    a.ph_lo = 0; a.ph_hi = SPLITAT; a.li = 0;
    hipLaunchKernelGGL(fwd, dim3(grid), dim3(512), LDS_BYTES, stream, a);
    a.ph_lo = SPLITAT; a.ph_hi = NPH; a.li = 1;
    hipLaunchKernelGGL(fwd, dim3(grid), dim3(512), LDS_BYTES, stream, a);
#elif defined(DUPK)
    a.ph_lo = 0; a.ph_hi = DUPK + 1; a.li = 0;
    hipLaunchKernelGGL(fwd, dim3(grid), dim3(512), LDS_BYTES, stream, a);
    a.ph_lo = DUPK; a.ph_hi = NPH; a.li = 1;
    hipLaunchKernelGGL(fwd, dim3(grid), dim3(512), LDS_BYTES, stream, a);
#elif MK_ONE_LAUNCH
    a.ph_lo = 0; a.ph_hi = NPH;
    hipLaunchKernelGGL(fwd, dim3(grid), dim3(512), LDS_BYTES, stream, a);
#else
    for (int p = 0; p < NPH; ++p) { a.ph_lo = p; a.ph_hi = p + 1; hipLaunchKernelGGL(fwd, dim3(grid), dim3(512), LDS_BYTES, stream, a); }
#endif
}
```

```cpp
#include <hip/hip_runtime.h>
#include <hip/hip_bf16.h>
#include <cstdio>
#include <cstdint>
#include <cmath>

constexpr int DM = 1024, NB = 4, SEQ = 8192, LCTX = 256, NLAT = NB * SEQ, NCTXR = NB * LCTX, MALL = NLAT + NCTXR;
constexpr int DFF = 3584, NEXP = 8, NQKV = 1536;
constexpr int NPL = NLAT / 256, NPA = MALL / 256;
constexpr float EPS = 1e-6f;
constexpr int MOE_CH = 64, MOE_NCH = 4;
constexpr float MOE_SGU = 32.0f, MOE_SD = 64.0f;
constexpr int MOE_RS = 7, P3_NS = 8, P5_NS = 14;

#define LAS __attribute__((address_space(3)))
#define GAS __attribute__((address_space(1)))
typedef unsigned short bf16_t;
typedef short bf16x8 __attribute__((ext_vector_type(8)));
typedef float f32x4 __attribute__((ext_vector_type(4)));
typedef float f32x2 __attribute__((ext_vector_type(2)));
typedef float f32x16 __attribute__((ext_vector_type(16)));
typedef unsigned u32x4 __attribute__((ext_vector_type(4)));
typedef unsigned u32x2 __attribute__((ext_vector_type(2)));
typedef __bf16 bf16x2_t __attribute__((ext_vector_type(2)));
typedef GAS unsigned gu32;

__device__ __forceinline__ unsigned pkbf(float lo, float hi) { f32x2 v = {lo, hi}; bf16x2_t b = __builtin_convertvector(v, bf16x2_t); return __builtin_bit_cast(unsigned, b); }
__device__ __forceinline__ unsigned pk4f8(float a, float b, float c, float d) { unsigned w = 0; w = __builtin_amdgcn_cvt_pk_fp8_f32(a, b, w, false); w = __builtin_amdgcn_cvt_pk_fp8_f32(c, d, w, true); return w; }
__device__ __forceinline__ float bf2f(unsigned short h) { return __builtin_bit_cast(float, (unsigned)h << 16); }
__device__ __forceinline__ float wave_sum(float v) {
#pragma unroll
    for (int o = 1; o < 64; o <<= 1) v += __shfl_xor(v, o);
    return v;
}
__device__ __forceinline__ float gelu_tanh(float x) {
    const float t = x * (1.0f + 0.044715f * x * x);
    const float e = __builtin_amdgcn_exp2f(-2.302208198f * t);
    return x * __builtin_amdgcn_rcpf(1.0f + e);
}
__device__ __forceinline__ float silu_f(float x) { return x * __builtin_amdgcn_rcpf(1.0f + __builtin_amdgcn_exp2f(-1.4426950409f * x)); }

constexpr size_t MiB = 1u << 20;
constexpr size_t WS_CTL = 0, CTL_ZERO_BYTES = 1 * MiB;
constexpr size_t WS_MOD = 1 * MiB;
constexpr size_t WS_ROPE = 1 * MiB + 256 * 1024;
constexpr size_t WS_STATS = 2 * MiB;
constexpr size_t WS_LIST = 5 * MiB;
constexpr size_t WS_TINFO = 6 * MiB;
constexpr size_t WS_WS = 7 * MiB;
constexpr size_t WS_WIN = 8 * MiB, WS_WAO = 12 * MiB, WS_WQKV = 14 * MiB, WS_WBO = 17 * MiB, WS_WGU = 19 * MiB, WS_WD = 33 * MiB;
constexpr size_t WS_MGU = 40 * MiB, WS_MD = 96 * MiB;
constexpr size_t WS_XN = 208 * MiB;
constexpr size_t WS_ZB = 274 * MiB;
constexpr size_t WS_R = 278 * MiB;
constexpr size_t WS_UVT = WS_R, WS_A2 = WS_R + 132 * MiB, WS_PART1 = WS_R + 198 * MiB, WS_H = WS_R, WS_PART2 = WS_R + 231 * MiB;
constexpr size_t WS_QKV = WS_R, WS_O = WS_R + 99 * MiB;
constexpr size_t WS_Y = WS_R, WS_YP = WS_R + 128 * MiB, WS_HC = WS_R + 156 * MiB;
constexpr size_t WS_END = WS_R + 287 * MiB;
static_assert(WS_UVT + (size_t)2048 * MALL * 2 <= WS_A2 && WS_A2 + (size_t)MALL * DM * 2 <= WS_PART1 && WS_PART1 + (size_t)P3_NS * NCTXR * DM * 4 <= WS_END, "layer-0 mixer map");
static_assert(WS_H + (size_t)MALL * DFF * 2 <= WS_PART2 && WS_PART2 + (size_t)P5_NS * NCTXR * DM * 4 <= WS_END && WS_QKV + (size_t)MALL * NQKV * 2 <= WS_O && WS_O + (size_t)NLAT * DM * 2 <= WS_END, "region map");
static_assert(WS_Y + (size_t)256 * 256 * DM * 2 <= WS_YP && WS_YP + (size_t)MOE_RS * 8 * 256 * DM * 2 <= WS_HC && WS_HC + (size_t)MOE_CH * 256 * DFF <= WS_END, "MoE map");
static_assert(WS_XN + (size_t)MALL * DM * 2 <= WS_ZB && WS_MD + (size_t)8 * DM * DFF <= WS_XN && WS_MGU + (size_t)8 * 7168 * DM <= WS_MD, "weights map");
constexpr int CW_TMO = 0, CW_CODE = 1;
constexpr int CW_CNT = 64;
constexpr int CW_BAR = 4096;

constexpr int RING_BYTES = 131072;
constexpr int GTAB_OFF = RING_BYTES;
constexpr int MOE_OFF = RING_BYTES + 1024;
constexpr int MISC_OFF = RING_BYTES + 2048;
constexpr int LDS_BYTES = 147456;

namespace pg8 {
constexpr int BM = 256, BK = 64, HALF = 128, HTB = HALF * BK * 2, STAGE_BYTES = 8 * HTB, NXCD = 8, WGM = 8;
__host__ __device__ __forceinline__ int lds_byte(int r, int c) { const int st = (r >> 4) * 2 + (c >> 5), rr = r & 15, cc = c & 31, ob = rr * 64 + cc * 2; return st * 1024 + (ob ^ (((ob >> 9) & 1) << 5)); }
__host__ __device__ __forceinline__ void stage_rc(int b, int& R, int& C) { const int st = b / 1024, sb = b % 1024, swz = sb ^ (((sb >> 9) & 1) << 5); R = (st >> 1) * 16 + swz / 64; C = (st & 1) * 32 + (swz % 64) / 2; }
__host__ __device__ __forceinline__ int perm32(int rho) { const int n = rho >> 4, i = rho & 15; return 8 * (i >> 2) + 4 * n + (i & 3); }

struct Unit { const char* a; const char* b; const int* gl; int pm, pn, om, nv, ks; };

__device__ __forceinline__ bool tile_order(int i, int G, int c, int nM, int nN, int& pm, int& pn) {
    const int nwg = nM * nN; const long L = (long)i * G + c; if (L >= nwg) return false;
    int wgid = (int)L; { const int q = nwg / NXCD, r = nwg % NXCD, xcd = wgid % NXCD, off = wgid / NXCD; wgid = (xcd < r ? xcd * (q + 1) : r * (q + 1) + (xcd - r) * q) + off; }
    const int nig = WGM * nN, gid = wgid / nig, fm = gid * WGM, gsz = (nM - fm) < WGM ? (nM - fm) : WGM;
    pm = fm + ((wgid % nig) % gsz); pn = (wgid % nig) / gsz; return true;
}
struct DenseSched {
    const char* A; const char* B; int nM, nN, G, c; size_t tstep;
    __device__ __forceinline__ bool next(int i, Unit& u) const {
        int pm, pn; if (!tile_order(i, G, c, nM, nN, pm, pn)) return false;
        u.a = A + (size_t)pm * tstep; u.b = B + (size_t)pn * tstep; u.gl = nullptr; u.pm = pm; u.pn = pn; u.om = pm; u.nv = 256; u.ks = 0; return true;
    }
};
typedef int v8i_t __attribute__((ext_vector_type(8)));
typedef int v4i_t __attribute__((ext_vector_type(4)));
__device__ __forceinline__ v8i_t cat8(bf16x8 lo, bf16x8 hi) { const v4i_t a = __builtin_bit_cast(v4i_t, lo), b = __builtin_bit_cast(v4i_t, hi); return __builtin_shufflevector(a, b, 0, 1, 2, 3, 4, 5, 6, 7); }
struct SplitSched {
    const char* A; const char* B; int nM, nN, nS, G, c, pm0; size_t tstep, kbytes;
    __device__ __forceinline__ bool next(int i, Unit& u) const {
        const int L = i * G + c; if (L >= nM * nN * nS) return false;
        const int ks = L % nS, t = L / nS, pn = t % nN, pm = t / nN;
        u.a = A + (size_t)pm * tstep + (size_t)ks * kbytes; u.b = B + (size_t)pn * tstep + (size_t)ks * kbytes; u.gl = nullptr; u.pm = pm0 + pm; u.pn = pn; u.om = pm; u.nv = 256; u.ks = ks; return true;
    }
};
struct MoeSched {
    const char* A; const char* B; const int* list; const LAS int* tab; int gp0, gp1, nN, nS, G, c, mode; size_t bexp, btile, astep, kbytes; bool gather;
    __device__ __forceinline__ bool next(int i, Unit& u) const {
        int pm, pn, ks = 0;
        if (mode == 0) { if (gp1 <= gp0) return false; if (!tile_order(i, G, c, gp1 - gp0, nN, pm, pn)) return false; }
        else { const int R = __builtin_amdgcn_readfirstlane(tab[32]); const int L = i * G + c; if (L >= R * nN * nS) return false; ks = L % nS; const int t = L / nS; pn = t % nN; pm = t / nN; }
        int e = 0, lp, nv;
        if (mode == 0) { const int gp = gp0 + pm;
#pragma unroll
            for (int k = 1; k < 8; ++k) e += (gp >= __builtin_amdgcn_readfirstlane(tab[k])) ? 1 : 0;
            lp = gp - __builtin_amdgcn_readfirstlane(tab[e]); nv = 256; u.pm = gp; }
        else { e = __builtin_amdgcn_readfirstlane(tab[24 + pm]); const int ce = __builtin_amdgcn_readfirstlane(tab[16 + e]); lp = ce >> 8; nv = ce & 255; u.pm = pm; }
        u.b = B + (size_t)e * bexp + (size_t)pn * btile + (size_t)ks * kbytes; u.pn = pn; u.nv = nv; u.ks = ks; u.om = pm;
        if (gather) { u.a = A; u.gl = list + (size_t)e * NLAT + 256 * lp; }
        else { u.a = A + (size_t)pm * astep + (size_t)ks * kbytes; u.gl = nullptr; if (mode == 0) u.om = gp0 + pm; }
        return true;
    }
};

struct EpiGeluT {
    static constexpr bool PERM = true;
    bf16_t* O; float* stats;
    __device__ __forceinline__ void operator()(const f32x4 (&acc)[2][2][4][2], const Unit& u, int wr, int wc, int fr, int fq) const {
        const int row0 = u.pm * BM + wr * 64 + fr, col0 = u.pn * BM + wc * 32 + 8 * fq;
        const bool isv = u.pm >= 4;
        float s1[2][2][4], s2[2][2][4];
#pragma unroll
        for (int bj = 0; bj < 2; ++bj)
#pragma unroll
            for (int n = 0; n < 2; ++n)
#pragma unroll
                for (int e = 0; e < 4; ++e) { s1[bj][n][e] = 0.f; s2[bj][n][e] = 0.f; }
#pragma unroll
        for (int ai = 0; ai < 2; ++ai)
#pragma unroll
            for (int m = 0; m < 4; ++m) { bf16_t* rowp = O + (size_t)(row0 + ai * HALF + m * 16) * MALL + col0;
#pragma unroll
                for (int bj = 0; bj < 2; ++bj) { f32x4 v0 = acc[ai][bj][m][0], v1 = acc[ai][bj][m][1];
#pragma unroll
                    for (int e = 0; e < 4; ++e) { v0[e] = gelu_tanh(v0[e]); v1[e] = gelu_tanh(v1[e]); s1[bj][0][e] += v0[e]; s2[bj][0][e] += v0[e] * v0[e]; s1[bj][1][e] += v1[e]; s2[bj][1][e] += v1[e] * v1[e]; }
                    u32x4 w; w.x = pkbf(v0[0], v0[1]); w.y = pkbf(v0[2], v0[3]); w.z = pkbf(v1[0], v1[1]); w.w = pkbf(v1[2], v1[3]);
                    *(u32x4*)(rowp + bj * HALF) = w; } }
        if (isv) {
            const int slot = (u.pm - 4) * 2 + wr;
#pragma unroll
            for (int bj = 0; bj < 2; ++bj)
#pragma unroll
                for (int n = 0; n < 2; ++n)
#pragma unroll
                    for (int e = 0; e < 4; ++e) { float a = s1[bj][n][e], b = s2[bj][n][e];
#pragma unroll
                        for (int o = 1; o < 16; o <<= 1) { a += __shfl_xor(a, o); b += __shfl_xor(b, o); }
                        if (fr == 0) { const int tok = col0 + bj * HALF + 4 * n + e; *(f32x2*)(stats + (size_t)tok * 16 + slot * 2) = (f32x2){a, b}; } }
        }
    }
};
struct EpiResid {
    static constexpr bool PERM = true;
    const float* baseL; const float* baseC; float* outL; float* outC; const float* gate;
    __device__ __forceinline__ void operator()(const f32x4 (&acc)[2][2][4][2], const Unit& u, int wr, int wc, int fr, int fq) const {
        const bool lat = u.pm < NPL; const int mb = lat ? (u.pm >> 5) : 4;
        const float* base = lat ? baseL + (size_t)u.pm * BM * DM : baseC + (size_t)(u.pm - NPL) * BM * DM;
        float* out = lat ? outL + (size_t)u.pm * BM * DM : outC + (size_t)(u.pm - NPL) * BM * DM;
        const int col0 = u.pn * BM + wc * 32 + 8 * fq;
        f32x4 gv[2][2];
#pragma unroll
        for (int bj = 0; bj < 2; ++bj)
#pragma unroll
            for (int n = 0; n < 2; ++n) gv[bj][n] = *(const f32x4*)(gate + (size_t)mb * 6144 + col0 + bj * HALF + n * 4);
#pragma unroll
        for (int ai = 0; ai < 2; ++ai)
#pragma unroll
            for (int m = 0; m < 4; ++m) { const size_t off = (size_t)(wr * 64 + fr + ai * HALF + m * 16) * DM + col0;
#pragma unroll
                for (int bj = 0; bj < 2; ++bj)
#pragma unroll
                    for (int n = 0; n < 2; ++n) { const f32x4 bs = *(const f32x4*)(base + off + bj * HALF + n * 4);
                        *(f32x4*)(out + off + bj * HALF + n * 4) = bs + gv[bj][n] * acc[ai][bj][m][n]; } }
    }
};
struct EpiSwiGLU {
    static constexpr bool PERM = true;
    bf16_t* O;
    __device__ __forceinline__ void operator()(const f32x4 (&acc)[2][2][4][2], const Unit& u, int wr, int wc, int fr, int fq) const {
        bf16_t* base = O + (size_t)(u.om * BM + wr * 64 + fr) * DFF + u.pn * 128 + wc * 32 + 8 * fq;
#pragma unroll
        for (int ai = 0; ai < 2; ++ai)
#pragma unroll
            for (int m = 0; m < 4; ++m) { const f32x4 g0 = acc[ai][0][m][0], g1 = acc[ai][0][m][1], u0 = acc[ai][1][m][0], u1 = acc[ai][1][m][1];
                float o[8];
#pragma unroll
                for (int e = 0; e < 4; ++e) { o[e] = silu_f(g0[e]) * u0[e]; o[4 + e] = silu_f(g1[e]) * u1[e]; }
                u32x4 w; w.x = pkbf(o[0], o[1]); w.y = pkbf(o[2], o[3]); w.z = pkbf(o[4], o[5]); w.w = pkbf(o[6], o[7]);
                *(u32x4*)(base + (size_t)(ai * HALF + m * 16) * DFF) = w; }
    }
};
struct EpiQKV {
    static constexpr bool PERM = false;
    bf16_t* O; const float* cosT; const float* sinT; float qscale;
    __device__ __forceinline__ void operator()(const f32x4 (&acc)[2][2][4][2], const Unit& u, int wr, int wc, int fr, int fq) const {
        const bool lat = u.pm < NPL; const bool dorope = lat && u.pn < 5; const float sc = u.pn < 4 ? qscale : 1.0f;
        const int col0 = u.pn * BM + wc * 32 + 4 * fq;
#pragma unroll
        for (int ai = 0; ai < 2; ++ai)
#pragma unroll
            for (int m = 0; m < 4; ++m) { const int grow = u.pm * BM + ai * HALF + wr * 64 + m * 16 + fr; const int s = grow & (SEQ - 1); const int pos = (wc & 1) ? (s & 63) : (s >> 6);
                f32x4 cs = (f32x4){1.f, 1.f, 1.f, 1.f}, sn = (f32x4){0.f, 0.f, 0.f, 0.f};
                if (dorope) { cs = *(const f32x4*)(cosT + pos * 16 + 4 * fq); sn = *(const f32x4*)(sinT + pos * 16 + 4 * fq); }
                bf16_t* rowp = O + (size_t)grow * NQKV + col0;
#pragma unroll
                for (int bj = 0; bj < 2; ++bj) { const f32x4 x1 = acc[ai][bj][m][0], x2 = acc[ai][bj][m][1];
                    const f32x4 o1 = (x1 * cs - x2 * sn) * sc, o2 = (x1 * sn + x2 * cs) * sc;
                    u32x2 w1, w2; w1.x = pkbf(o1[0], o1[1]); w1.y = pkbf(o1[2], o1[3]); w2.x = pkbf(o2[0], o2[1]); w2.y = pkbf(o2[2], o2[3]);
                    *(u32x2*)(rowp + bj * HALF) = w1; *(u32x2*)(rowp + bj * HALF + 16) = w2; } }
    }
};
struct EpiSwiGLU8 {
    static constexpr bool PERM = true;
    unsigned char* O; float s;
    __device__ __forceinline__ void operator()(const f32x4 (&acc)[2][2][4][2], const Unit& u, int wr, int wc, int fr, int fq) const {
        unsigned char* base = O + (size_t)(u.om * BM + wr * 64 + fr) * DFF + u.pn * 128 + wc * 32 + 8 * fq;
#pragma unroll
        for (int ai = 0; ai < 2; ++ai)
#pragma unroll
            for (int m = 0; m < 4; ++m) { const f32x4 g0 = acc[ai][0][m][0] * s, g1 = acc[ai][0][m][1] * s, u0 = acc[ai][1][m][0] * s, u1 = acc[ai][1][m][1] * s;
                float o[8];
#pragma unroll
                for (int e = 0; e < 4; ++e) { o[e] = silu_f(g0[e]) * u0[e]; o[4 + e] = silu_f(g1[e]) * u1[e]; }
                u32x2 w; w.x = pk4f8(o[0], o[1], o[2], o[3]); w.y = pk4f8(o[4], o[5], o[6], o[7]);
                *(u32x2*)(base + (size_t)(ai * HALF + m * 16) * DFF) = w; }
    }
};
struct EpiBf16Plain {
    static constexpr bool PERM = true;
    bf16_t* O; int ldc; float s;
    __device__ __forceinline__ void operator()(const f32x4 (&acc)[2][2][4][2], const Unit& u, int wr, int wc, int fr, int fq) const {
        bf16_t* base = O + (size_t)(u.om * BM + wr * 64 + fr) * ldc + u.pn * BM + wc * 32 + 8 * fq;
#pragma unroll
        for (int ai = 0; ai < 2; ++ai)
#pragma unroll
            for (int m = 0; m < 4; ++m)
#pragma unroll
                for (int bj = 0; bj < 2; ++bj) { const f32x4 v0 = acc[ai][bj][m][0] * s, v1 = acc[ai][bj][m][1] * s;
                    u32x4 w; w.x = pkbf(v0[0], v0[1]); w.y = pkbf(v0[2], v0[3]); w.z = pkbf(v1[0], v1[1]); w.w = pkbf(v1[2], v1[3]);
                    *(u32x4*)(base + (size_t)(ai * HALF + m * 16) * ldc + bj * HALF) = w; }
    }
};

struct EpiPartF32 {
    static constexpr bool PERM = true;
    float* P; size_t sstride;
    __device__ __forceinline__ void operator()(const f32x4 (&acc)[2][2][4][2], const Unit& u, int wr, int wc, int fr, int fq) const {
        float* base = P + (size_t)u.ks * sstride + (size_t)(u.om * BM + wr * 64 + fr) * DM + u.pn * BM + wc * 32 + 8 * fq;
#pragma unroll
        for (int ai = 0; ai < 2; ++ai)
#pragma unroll
            for (int m = 0; m < 4; ++m)
#pragma unroll
                for (int bj = 0; bj < 2; ++bj)
#pragma unroll
                    for (int n = 0; n < 2; ++n) *(f32x4*)(base + (size_t)(ai * HALF + m * 16) * DM + bj * HALF + n * 4) = acc[ai][bj][m][n];
    }
};
struct EpiPartBf16 {
    static constexpr bool PERM = true;
    bf16_t* P; size_t sstride; float s;
    __device__ __forceinline__ void operator()(const f32x4 (&acc)[2][2][4][2], const Unit& u, int wr, int wc, int fr, int fq) const {
        bf16_t* base = P + (size_t)u.ks * sstride + (size_t)(u.om * BM + wr * 64 + fr) * DM + u.pn * BM + wc * 32 + 8 * fq;
#pragma unroll
        for (int ai = 0; ai < 2; ++ai)
#pragma unroll
            for (int m = 0; m < 4; ++m)
#pragma unroll
                for (int bj = 0; bj < 2; ++bj) { const f32x4 v0 = acc[ai][bj][m][0] * s, v1 = acc[ai][bj][m][1] * s;
                    u32x4 w; w.x = pkbf(v0[0], v0[1]); w.y = pkbf(v0[2], v0[3]); w.z = pkbf(v1[0], v1[1]); w.w = pkbf(v1[2], v1[3]);
                    *(u32x4*)(base + (size_t)(ai * HALF + m * 16) * DM + bj * HALF) = w; }
    }
};

template <class Epi, class Sched, bool ALIGN_EPI, bool GATHER, bool FP8 = false>
__device__ __forceinline__ void gemm_phase(LAS unsigned char* lds, LAS int* gtab, const int K  , const int nt_in  , const Sched& S, const Epi& E) {
    int nt = nt_in; asm volatile("" : "+s"(nt));
    int tid_ = threadIdx.x; asm volatile("" : "+v"(tid_));
    const int tid = tid_, wid = __builtin_amdgcn_readfirstlane(tid >> 6), lane = tid & 63, wr = wid >> 2, wc = wid & 3, fr = lane & 15, fq = lane >> 4;
    const size_t kstep = (size_t)(BK * 2);
    const size_t hstep = (size_t)HALF * K * 2;
    unsigned voffB[2];
#pragma unroll
    for (int i = 0; i < 2; ++i) { int R, C; stage_rc(tid * 16 + i * 8192, R, C); const int Rb = Epi::PERM ? ((R & ~31) + perm32(R & 31)) : R;
        voffB[i] = (unsigned)(Rb * K + C) * 2u; }
    unsigned vA[2][2], vN[2][2];
    const unsigned ldsw = (unsigned)wid * 1024u;
    const int aoff = lds_byte(wr * 64 + fr, fq * 8), boff = lds_byte(wc * 32 + fr, fq * 8);
    const LAS unsigned char* aB = lds + aoff; const LAS unsigned char* bB = lds + 65536 + boff;
    asm volatile("" : "+v"(aB), "+v"(bB));
#define PG8_SA(b, h) (((b) * 2 + (h)) * HTB)
#define PG8_SB(b, h) ((4 + (b) * 2 + (h)) * HTB)
#define PG8_STAGE(bufoff, gbase, voff) do { _Pragma("unroll") for (int _i = 0; _i < 2; ++_i) \
        __builtin_amdgcn_global_load_lds((const unsigned*)((const char*)(gbase) + (voff)[_i]), (LAS unsigned*)(lds + (bufoff) + ldsw + _i * 8192), 16, 0, 0); } while (0)
#define PG8_LDA(dst, b, h) do { _Pragma("unroll") for (int m = 0; m < 4; ++m) { if constexpr (FP8) dst##8[m] = cat8(*(const LAS bf16x8*)(aB + PG8_SA(b, h) + m * 2048), *(const LAS bf16x8*)(aB + PG8_SA(b, h) + m * 2048 + 1024)); \
        else { _Pragma("unroll") for (int k = 0; k < 2; ++k) dst[m][k] = *(const LAS bf16x8*)(aB + PG8_SA(b, h) + m * 2048 + k * 1024); } } } while (0)
#define PG8_LDB(dst, b, h) do { _Pragma("unroll") for (int n = 0; n < 2; ++n) { if constexpr (FP8) dst##8[n] = cat8(*(const LAS bf16x8*)(bB + (PG8_SB(b, h) - 65536) + n * 2048), *(const LAS bf16x8*)(bB + (PG8_SB(b, h) - 65536) + n * 2048 + 1024)); \
        else { _Pragma("unroll") for (int k = 0; k < 2; ++k) dst[n][k] = *(const LAS bf16x8*)(bB + (PG8_SB(b, h) - 65536) + n * 2048 + k * 1024); } } } while (0)
#define PG8_MMA(ai, bj, At, Bt) do { __builtin_amdgcn_s_setprio(1); \
    if constexpr (FP8) { _Pragma("unroll") for (int m = 0; m < 4; ++m) _Pragma("unroll") for (int n = 0; n < 2; ++n) \
        asm volatile("v_mfma_f32_16x16x128_f8f6f4 %0, %1, %2, %0" : "+v"(acc[ai][bj][m][n]) : "v"(Bt##8[n]), "v"(At##8[m])); } \
    else { _Pragma("unroll") for (int m = 0; m < 4; ++m) _Pragma("unroll") for (int n = 0; n < 2; ++n) _Pragma("unroll") for (int k = 0; k < 2; ++k) \
        acc[ai][bj][m][n] = __builtin_amdgcn_mfma_f32_16x16x32_bf16(Bt[n][k], At[m][k], acc[ai][bj][m][n], 0, 0, 0); } \
    __builtin_amdgcn_s_setprio(0); } while (0)
#define PG8_WAIT_V(n) asm volatile("s_waitcnt vmcnt(" #n ")" ::: "memory")
#define PG8_WAIT_L(n) asm volatile("s_waitcnt lgkmcnt(" #n ")" ::: "memory")
#define PG8_BAR __builtin_amdgcn_s_barrier()
#define PG8_SCHED __builtin_amdgcn_sched_barrier(0)
    Unit cur, nxt; int ui = 0;
    if (!S.next(0, cur)) return;
    f32x4 acc[2][2][4][2];
#pragma unroll
    for (int a = 0; a < 2; ++a)
#pragma unroll
        for (int b = 0; b < 2; ++b)
#pragma unroll
            for (int m = 0; m < 4; ++m)
#pragma unroll
                for (int n = 0; n < 2; ++n) acc[a][b][m][n] = (f32x4){0.f, 0.f, 0.f, 0.f};
    bf16x8 At[4][2], B0[2][2], B1[2][2]; v8i_t At8[4], B08[2], B18[2];
    if constexpr (GATHER) {
#pragma unroll
        for (int h = 0; h < 2; ++h)
#pragma unroll
            for (int i = 0; i < 2; ++i) { int R, C; stage_rc(tid * 16 + i * 8192, R, C); const int row = h * HALF + R; const int tok = cur.gl[row < cur.nv ? row : 0]; vA[h][i] = (unsigned)tok * (unsigned)(K * 2) + (unsigned)C * 2u; }
    } else {
#pragma unroll
        for (int h = 0; h < 2; ++h)
#pragma unroll
            for (int i = 0; i < 2; ++i) { int R, C; stage_rc(tid * 16 + i * 8192, R, C); vA[h][i] = (unsigned)(R * K + C) * 2u + (unsigned)(h * hstep); }
    }
#pragma unroll
    for (int h = 0; h < 2; ++h)
#pragma unroll
        for (int i = 0; i < 2; ++i) vN[h][i] = vA[h][i];
    const char* cA = cur.a; const char* cB = cur.b;
    PG8_STAGE(PG8_SB(0, 0), cB, voffB); PG8_STAGE(PG8_SB(0, 1), cB + hstep, voffB); PG8_STAGE(PG8_SA(0, 0), cA, vA[0]); PG8_STAGE(PG8_SA(0, 1), cA, vA[1]);
    if (wr == 1) PG8_BAR;
    PG8_WAIT_V(2); PG8_BAR;
    PG8_STAGE(PG8_SB(1, 0), cB + kstep, voffB); PG8_STAGE(PG8_SA(1, 0), cA + kstep, vA[0]); PG8_STAGE(PG8_SB(1, 1), cB + hstep + kstep, voffB);
    PG8_WAIT_V(6); PG8_BAR;
    for (;;) {
        const bool has_next = S.next(ui + 1, nxt);
        const char* nA = has_next ? nxt.a : cA; const char* nB = has_next ? nxt.b : cB;
        if constexpr (GATHER) {
            if (has_next && wid < 4) __builtin_amdgcn_global_load_lds((const unsigned*)(nxt.gl + wid * 64 + lane), (LAS unsigned*)(gtab + wid * 64), 4, 0, 0);
        }
        for (int t = 0; t < nt; t += 2) {
            const bool last = (t == nt - 2);
            const char* a1 = cA + (size_t)(t + 1) * kstep;
            const char* a2 = last ? nA : cA + (size_t)(t + 2) * kstep; const char* b2 = last ? nB : cB + (size_t)(t + 2) * kstep;
            const char* a3 = a2 + kstep; const char* b3 = b2 + kstep;
            if constexpr (GATHER) {
                if (last && has_next) {
                    int t2 = tid; asm volatile("" : "+v"(t2));
#pragma unroll
                    for (int h = 0; h < 2; ++h)
#pragma unroll
                        for (int i = 0; i < 2; ++i) { int R, C; stage_rc(t2 * 16 + i * 8192, R, C); const int row = h * HALF + R; const int tok = gtab[row < nxt.nv ? row : 0]; vN[h][i] = (unsigned)tok * (unsigned)(K * 2) + (unsigned)C * 2u; }
                }
            }
            unsigned vS0[2], vS1[2];
#pragma unroll
            for (int i = 0; i < 2; ++i) { vS0[i] = (GATHER && last) ? vN[0][i] : vA[0][i]; vS1[i] = (GATHER && last) ? vN[1][i] : vA[1][i]; }
            PG8_LDB(B0, 0, 0); PG8_LDB(B1, 0, 1); PG8_SCHED; PG8_LDA(At, 0, 0); PG8_STAGE(PG8_SA(1, 1), a1, vA[1]);
            PG8_WAIT_V(8); PG8_WAIT_L(0); PG8_BAR; PG8_MMA(0, 0, At, B0); PG8_MMA(0, 1, At, B1); PG8_BAR; PG8_SCHED;
            PG8_LDA(At, 0, 1); PG8_STAGE(PG8_SB(0, 0), b2, voffB); PG8_STAGE(PG8_SB(0, 1), b2 + hstep, voffB); PG8_STAGE(PG8_SA(0, 0), a2, vS0);
            PG8_WAIT_V(8); PG8_WAIT_L(0); PG8_BAR; PG8_MMA(1, 0, At, B0); PG8_MMA(1, 1, At, B1); PG8_BAR; PG8_SCHED;
            PG8_LDB(B0, 1, 0); PG8_LDB(B1, 1, 1); PG8_SCHED; PG8_LDA(At, 1, 0); PG8_STAGE(PG8_SA(0, 1), a2, vS1);
            PG8_WAIT_V(8); PG8_WAIT_L(0); PG8_BAR; PG8_MMA(0, 0, At, B0); PG8_MMA(0, 1, At, B1); PG8_BAR; PG8_SCHED;
            PG8_LDA(At, 1, 1); PG8_STAGE(PG8_SB(1, 0), b3, voffB); PG8_STAGE(PG8_SB(1, 1), b3 + hstep, voffB); PG8_STAGE(PG8_SA(1, 0), a3, vS0);
            PG8_WAIT_V(8); PG8_WAIT_L(0); PG8_BAR; PG8_MMA(1, 0, At, B0); PG8_MMA(1, 1, At, B1); PG8_BAR; PG8_SCHED;
        }
        if constexpr (ALIGN_EPI) { if (wr == 0) PG8_BAR; }
        if constexpr (FP8) asm volatile("s_nop 15\n\ts_nop 15" ::: "memory");
        E(acc, cur, wr, wc, fr, fq);
        if (!has_next) break;
#pragma unroll
        for (int a = 0; a < 2; ++a)
#pragma unroll
            for (int b = 0; b < 2; ++b)
#pragma unroll
                for (int m = 0; m < 4; ++m)
#pragma unroll
                    for (int n = 0; n < 2; ++n) acc[a][b][m][n] = (f32x4){0.f, 0.f, 0.f, 0.f};
        cur = nxt; cA = nA; cB = nB; ++ui;
        if constexpr (GATHER) {
#pragma unroll
            for (int h = 0; h < 2; ++h)
#pragma unroll
                for (int i = 0; i < 2; ++i) vA[h][i] = vN[h][i];
        }
        if constexpr (ALIGN_EPI) { if (wr == 1) PG8_BAR; }
    }
    PG8_WAIT_V(0);
    if constexpr (!ALIGN_EPI) { if (wr == 0) PG8_BAR; }
    PG8_BAR;
#undef PG8_SA
#undef PG8_SB
#undef PG8_STAGE
#undef PG8_LDA
#undef PG8_LDB
#undef PG8_MMA
#undef PG8_WAIT_V
#undef PG8_WAIT_L
#undef PG8_BAR
#undef PG8_SCHED
}
}

namespace attn_body {
using bf16 = __hip_bfloat16;
using s16x4 = __attribute__((ext_vector_type(4))) short;
constexpr int D = 64, PITCH = NQKV, OPITCH = DM;
constexpr int NW = 8, QBLK = 32, KVBLK = 64;
__device__ __forceinline__ int crow(int r, int hi) { return (r & 3) + 8 * (r >> 2) + 4 * hi; }
#define SBAR() __builtin_amdgcn_sched_barrier(0)
__device__ __forceinline__ void bmask(f32x16& p0, f32x16& p1, int kb, int qrel, int hi) {
    const float NEG = -INFINITY; const int d0 = kb + 4 * hi - qrel;
#pragma unroll
    for (int r = 0; r < 16; ++r) { const int d = d0 + (r & 3) + 8 * (r >> 2); if (d < -128 || d > 128) p0[r] = NEG; if (d + 32 < -128 || d + 32 > 128) p1[r] = NEG; }
}
constexpr int NSLOT = 3, SLOTB = 8192;
constexpr int LDS_K = 0, LDS_V = NSLOT * SLOTB, LDS_WS = 2 * NSLOT * SLOTB, LDS_OST = LDS_WS + NW * 64 * 4, LDS_BYTES_A = LDS_OST + NW * 4096;
constexpr float C2 = 0.125f * 1.4426950408889634f;
__device__ __forceinline__ void glds16(const void* gsrc, unsigned lds_dst) { unsigned keep;
    asm volatile("s_mov_b32 %0, m0\n\ts_mov_b32 m0, %2\n\ts_nop 0\n\tglobal_load_lds_dwordx4 %1, off\n\ts_mov_b32 m0, %0" : "=&s"(keep) : "v"(gsrc), "s"(lds_dst) : "memory"); }
__device__ __forceinline__ float max3f(float a, float b, float c) { float r; asm("v_max3_f32 %0, %1, %2, %3" : "=v"(r) : "v"(a), "v"(b), "v"(c)); return r; }
__device__ __forceinline__ float max2f(float a, float b) { float r; asm("v_max_f32_e32 %0, %1, %2" : "=v"(r) : "v"(a), "v"(b)); return r; }
__device__ __forceinline__ float fadd_s(float a, float b) { float r; asm("v_add_f32_e32 %0, %1, %2" : "=v"(r) : "v"(a), "v"(b)); return r; }
__device__ __forceinline__ float fsub_s(float a, float b) { float r; asm("v_sub_f32_e32 %0, %1, %2" : "=v"(r) : "v"(a), "v"(b)); return r; }
__device__ __forceinline__ unsigned cvtpk_s(float lo, float hi) { f32x2 v = {lo, hi}; bf16x2_t b = __builtin_convertvector(v, bf16x2_t); return __builtin_bit_cast(unsigned, b); }
#define WAIT_BAR(N) asm volatile("s_waitcnt vmcnt(" #N ") lgkmcnt(0)\n\ts_barrier" ::: "memory")
__device__ __forceinline__ void qkt(f32x16& p0, f32x16& p1, const char* Kslot, const bf16x8* qr, const f32x16& negm, int r32, int hi) {
    const char* kb = Kslot + hi * 1024 + r32 * 16;
#pragma unroll
    for (int d0 = 0; d0 < 4; ++d0) {
        const bf16x8 b0 = *reinterpret_cast<const bf16x8*>(kb + d0 * 2048);
        const bf16x8 b1 = *reinterpret_cast<const bf16x8*>(kb + d0 * 2048 + 512);
        if (d0 == 0) { p0 = __builtin_amdgcn_mfma_f32_32x32x16_bf16(b0, qr[0], negm, 0, 0, 0); p1 = __builtin_amdgcn_mfma_f32_32x32x16_bf16(b1, qr[0], negm, 0, 0, 0); }
        else { p0 = __builtin_amdgcn_mfma_f32_32x32x16_bf16(b0, qr[d0], p0, 0, 0, 0); p1 = __builtin_amdgcn_mfma_f32_32x32x16_bf16(b1, qr[d0], p1, 0, 0, 0); } }
}
typedef __attribute__((address_space(3))) const char* lds_cptr;
typedef short v4i16_t __attribute__((ext_vector_type(4)));
__device__ __forceinline__ void kload8(bf16x8* kf, lds_cptr kp) {
    kf[0] = *(const __attribute__((address_space(3))) bf16x8*)(kp);        kf[1] = *(const __attribute__((address_space(3))) bf16x8*)(kp + 512);
    kf[2] = *(const __attribute__((address_space(3))) bf16x8*)(kp + 2048); kf[3] = *(const __attribute__((address_space(3))) bf16x8*)(kp + 2560);
    kf[4] = *(const __attribute__((address_space(3))) bf16x8*)(kp + 4096); kf[5] = *(const __attribute__((address_space(3))) bf16x8*)(kp + 4608);
    kf[6] = *(const __attribute__((address_space(3))) bf16x8*)(kp + 6144); kf[7] = *(const __attribute__((address_space(3))) bf16x8*)(kp + 6656);
}
__device__ __forceinline__ void kload2(bf16x8* kf, lds_cptr kp, int j) { kf[2 * j] = *(const __attribute__((address_space(3))) bf16x8*)(kp + j * 2048); kf[2 * j + 1] = *(const __attribute__((address_space(3))) bf16x8*)(kp + j * 2048 + 512); }
__device__ __forceinline__ s16x4 vtr(lds_cptr p) { return __builtin_bit_cast(s16x4, __builtin_amdgcn_ds_read_tr16_b64_v4i16((__attribute__((address_space(3))) v4i16_t*)p)); }
__device__ __forceinline__ float rowmax(const f32x16& p0, const f32x16& p1) {
    float a = max3f(p0[0], p0[1], p1[0]), b = max3f(p0[2], p0[3], p1[1]); a = max3f(a, p1[2], p1[3]);
#pragma unroll
    for (int r = 4; r < 16; r += 4) { a = max3f(a, p0[r], p0[r + 1]); b = max3f(b, p0[r + 2], p0[r + 3]); a = max3f(a, p1[r], p1[r + 1]); b = max3f(b, p1[r + 2], p1[r + 3]); }
    const float m = max2f(a, b);
    auto rr = __builtin_amdgcn_permlane32_swap(__float_as_uint(m), __float_as_uint(m), false, false);
    return max2f(__uint_as_float(rr[0]), __uint_as_float(rr[1]));
}
__device__ __forceinline__ void pv(f32x16* o, int vb, bf16x8 pa0, bf16x8 pa1, bf16x8 pa2, bf16x8 pa3) {
#pragma unroll
    for (int d0 = 0; d0 < 2; ++d0) { s16x4 lo[4], hi[4];
#pragma unroll
        for (int ks = 0; ks < 4; ++ks) {
            asm volatile("ds_read_b64_tr_b16 %0,%1 offset:%c2" : "=&v"(lo[ks]) : "v"(vb), "i"(d0 * 4096 + ks * 1024) : "memory");
            asm volatile("ds_read_b64_tr_b16 %0,%1 offset:%c2" : "=&v"(hi[ks]) : "v"(vb), "i"(d0 * 4096 + ks * 1024 + 512) : "memory"); }
        asm volatile("s_waitcnt lgkmcnt(0)" ::: "memory"); SBAR();
#define PK(k) (bf16x8){lo[k][0], lo[k][1], lo[k][2], lo[k][3], hi[k][0], hi[k][1], hi[k][2], hi[k][3]}
        o[d0] = __builtin_amdgcn_mfma_f32_32x32x16_bf16(pa0, PK(0), o[d0], 0, 0, 0);
        o[d0] = __builtin_amdgcn_mfma_f32_32x32x16_bf16(pa1, PK(1), o[d0], 0, 0, 0);
        o[d0] = __builtin_amdgcn_mfma_f32_32x32x16_bf16(pa2, PK(2), o[d0], 0, 0, 0);
        o[d0] = __builtin_amdgcn_mfma_f32_32x32x16_bf16(pa3, PK(3), o[d0], 0, 0, 0);
#undef PK
    }
}
#define ATTN_STORE16(p, v) (*(u32x4*)(p) = (v))
template <int THRL> __device__ __forceinline__ void attn_unit(int b, int hk, int n, int pr, const bf16* QKV, bf16* O, const float* sinkp, char* shm) {
    int tid_ = threadIdx.x; asm volatile("" : "+v"(tid_));
    const int tid = tid_, lane = tid & 63, r32 = lane & 31, hi = lane >> 5; const int wid = __builtin_amdgcn_readfirstlane(tid >> 6);
    const int head = 4 * hk + 2 * pr + (wid >> 2);
    const long rowblk = (long)b * SEQ + n * 128;
    const long ctxrow = (long)NLAT + b * LCTX;
    const int nlo = n > 0 ? 2 : 0, nhi = n < (SEQ / 128 - 1) ? 2 : 0;
    const int NT = 6 + nlo + nhi;
    const bf16* Qw = QKV + (rowblk + (wid & 3) * QBLK) * PITCH + head * D;
    const bf16* Kc = QKV + 1024 + hk * D; const bf16* Vc = QKV + 1280 + hk * D;
    const unsigned lds0 = (unsigned)(uintptr_t)shm;
    float* wsf = (float*)(shm + LDS_WS) + wid * 64;
    const long klane = (long)lane * PITCH + wid * 8;
    const long vlane = (long)(16 * (wid & 3) + (lane >> 2)) * PITCH + (wid >> 2) * 32 + (lane & 3) * 8;
    const unsigned kdst = lds0 + LDS_K + wid * 1024, vdst = lds0 + LDS_V + wid * 1024;
#define TROW(t) (((t) < 2) ? (rowblk + 64 * (t)) : ((t) < 6) ? (ctxrow + 64 * ((t) - 2)) : (rowblk + ((((t) - 6) < nlo) ? (-128 + 64 * ((t) - 6)) : (128 + 64 * ((t) - 6 - nlo)))))
#define TKB(t) (((t) < 6) ? 0 : ((((t) - 6) < nlo) ? (-128 + 64 * ((t) - 6)) : (128 + 64 * ((t) - 6 - nlo))))
#define DMA_K(t, slot) glds16(Kc + TROW(t) * PITCH + klane, (unsigned)__builtin_amdgcn_readfirstlane(kdst + (slot)))
#define DMA_V(t, slot) glds16(Vc + TROW(t) * PITCH + vlane, (unsigned)__builtin_amdgcn_readfirstlane(vdst + (slot)))
    const int vb0 = (int)(lds0 + LDS_V) + ((lane >> 4) & 1) * 32 + (lane & 3) * 8 + (4 * hi + ((lane & 15) >> 2)) * 64;
    const char* Kbase = shm + LDS_K; bf16x8 kf[8];
    const lds_cptr shm3 = (lds_cptr)shm; const lds_cptr kp0 = shm3 + LDS_K + hi * 1024 + r32 * 16; const lds_cptr vp0 = shm3 + LDS_V + ((lane >> 4) & 1) * 32 + (lane & 3) * 8 + (4 * hi + ((lane & 15) >> 2)) * 64;
    DMA_K(0, 0); DMA_V(0, 0); DMA_K(1, SLOTB);
    bf16x8 qr[4];
#pragma unroll
    for (int d0 = 0; d0 < 4; ++d0) qr[d0] = *reinterpret_cast<const bf16x8*>(&Qw[(long)r32 * PITCH + d0 * 16 + hi * 8]);
    float mhat = 0.f, l_reg = 0.f; f32x16 o[2]; o[0] = f32x16{}; o[1] = f32x16{}; f32x16 negm = f32x16{}; asm volatile("" : "+v"(negm));
    const int qrel = (wid & 3) * QBLK + r32;
#define CMASK(P0, P1, t) do { int jb_ = (t) - (NT - 4); if (jb_ >= 0) bmask(P0, P1, TKB(t), qrel, hi); } while (0)
    bool resc = false;
#define START(P0, P1) do { const float rm = rowmax(P0, P1); resc = false; \
    { const float dl = rm; mhat = fadd_s(mhat, dl); \
      _Pragma("unroll") for (int r = 0; r < 16; ++r) { P0[r] = fsub_s(P0[r], dl); P1[r] = fsub_s(P1[r], dl); } \
      _Pragma("unroll") for (int r = 0; r < 16; ++r) negm[r] = -mhat; asm volatile("" : "+v"(negm)); } \
    _Pragma("unroll") for (int r = 0; r < 16; ++r) P0[r] = __builtin_amdgcn_exp2f(P0[r]); } while (0)
#define RESC() do { if (resc) { asm volatile("s_waitcnt lgkmcnt(0)" ::: "memory"); \
      _Pragma("unroll") for (int d_ = 0; d_ < 2; ++d_) _Pragma("unroll") for (int r = 0; r < 16; ++r) o[d_][r] *= wsf[crow(r, hi)]; } } while (0)
    f32x16 pA0, pA1, pB0, pB1;
    int sl_prev = 0, sl_cur = 0, sl_next = SLOTB;
#define ROT() do { sl_prev = sl_cur; sl_cur = sl_next; sl_next = (sl_next == (NSLOT - 1) * SLOTB) ? 0 : sl_next + SLOTB; } while (0)
    DMA_K(2, 2 * SLOTB);
    WAIT_BAR(3);
    qkt(pA0, pA1, Kbase, qr, negm, r32, hi); asm volatile("s_nop 15\n\ts_nop 7" : "+v"(pA0), "+v"(pA1));
    START(pA0, pA1);
    _Pragma("unroll") for (int r = 0; r < 16; ++r) pA1[r] = __builtin_amdgcn_exp2f(pA1[r]);
    WAIT_BAR(0);
    DMA_K(3, 0); DMA_V(1, SLOTB);
    ROT();
    kload8(kf, kp0 + sl_cur);
    WAIT_BAR(2);
    s16x4 vlo[8], vhi[8]; u32x4 pw0, pw1, pw2, pw3;
#define PKW(P, B) cvtpk_s(P[B], P[B + 1])
#define PAF(k) __builtin_bit_cast(bf16x8, pw##k)
#define VFR(i) (bf16x8){vlo[i][0], vlo[i][1], vlo[i][2], vlo[i][3], vhi[i][0], vhi[i][1], vhi[i][2], vhi[i][3]}
#define PIN(x) asm volatile("" : "+v"(x))
#define MX3(a, b, c) __builtin_fmaxf(__builtin_fmaxf((a), (b)), (c))
#define GAPA(MF, A0, A1, A2, A3, W0, W1, PW) do { MF; sacc += A0; sacc += A1; sacc += A2; sacc += A3; PIN(sacc); W0; W1; PIN(PW); SBAR(); } while (0)
#define EX(v) __builtin_amdgcn_exp2f(v)
#define GAPB(MF, X, B) do { MF; X[B] = EX(X[B]); X[B + 1] = EX(X[B + 1]); X[B + 2] = EX(X[B + 2]); X[B + 3] = EX(X[B + 3]); PIN(X); SBAR(); } while (0)
#define VRD(i) do { vlo[i] = vtr(vp_ + (((i) >> 2) * 4096 + ((i) & 3) * 1024)); vhi[i] = vtr(vp_ + (((i) >> 2) * 4096 + ((i) & 3) * 1024 + 512)); } while (0)
#define KRD(G, j) do { if (G) { kload2(kf, kp0 + sl_next, j); SBAR(); } } while (0)
#define STEP(C0, C1, P0, P1, t, GK, GV, GL) do { SBAR(); \
    const lds_cptr vp_ = vp0 + sl_prev; \
    VRD(0); SBAR(); float sacc = (P0[0] + P0[1]); \
    GAPA(C0 = __builtin_amdgcn_mfma_f32_32x32x16_bf16(kf[0], qr[0], negm, 0, 0, 0), P0[2], P0[3], P0[4], P0[5],     pw0[0] = PKW(P0, 0), pw0[1] = PKW(P0, 2), pw0); \
    VRD(4); SBAR(); GAPA(C1 = __builtin_amdgcn_mfma_f32_32x32x16_bf16(kf[1], qr[0], negm, 0, 0, 0), P0[6], P0[7], P0[8], P0[9],     pw0[2] = PKW(P0, 4), pw0[3] = PKW(P0, 6), pw0); \
    VRD(1); SBAR(); GAPA(C0 = __builtin_amdgcn_mfma_f32_32x32x16_bf16(kf[2], qr[1], C0, 0, 0, 0),   P0[10], P0[11], P0[12], P0[13], pw1[0] = PKW(P0, 8), pw1[1] = PKW(P0, 10), pw1); \
    VRD(5); SBAR(); GAPA(C1 = __builtin_amdgcn_mfma_f32_32x32x16_bf16(kf[3], qr[1], C1, 0, 0, 0),   P0[14], P0[15], P1[0], P1[1],   pw1[2] = PKW(P0, 12), pw1[3] = PKW(P0, 14), pw1); \
    VRD(2); SBAR(); GAPA(C0 = __builtin_amdgcn_mfma_f32_32x32x16_bf16(kf[4], qr[2], C0, 0, 0, 0),   P1[2], P1[3], P1[4], P1[5],     pw2[0] = PKW(P1, 0), pw2[1] = PKW(P1, 2), pw2); \
    VRD(6); SBAR(); GAPA(C1 = __builtin_amdgcn_mfma_f32_32x32x16_bf16(kf[5], qr[2], C1, 0, 0, 0),   P1[6], P1[7], P1[8], P1[9],     pw2[2] = PKW(P1, 4), pw2[3] = PKW(P1, 6), pw2); \
    VRD(3); SBAR(); GAPA(C0 = __builtin_amdgcn_mfma_f32_32x32x16_bf16(kf[6], qr[3], C0, 0, 0, 0),   P1[10], P1[11], P1[12], P1[13], pw3[0] = PKW(P1, 8), pw3[1] = PKW(P1, 10), pw3); \
    VRD(7); SBAR(); GAPA(C1 = __builtin_amdgcn_mfma_f32_32x32x16_bf16(kf[7], qr[3], C1, 0, 0, 0),   P1[14], P1[15], 0.f, 0.f,       pw3[2] = PKW(P1, 12), pw3[3] = PKW(P1, 14), pw3); \
    l_reg += sacc; \
    if (GK) { DMA_K((t) + 3, sl_cur); } if (GV) { DMA_V((t) + 1, sl_next); } \
    CMASK(C0, C1, t); \
    { float a = MX3(C0[0], C0[1], C1[0]), b = MX3(C0[2], C0[3], C1[1]); a = MX3(a, C1[2], C1[3]); \
      _Pragma("unroll") for (int r = 4; r < 16; r += 4) { a = MX3(a, C0[r], C0[r + 1]); b = MX3(b, C0[r + 2], C0[r + 3]); a = MX3(a, C1[r], C1[r + 1]); b = MX3(b, C1[r + 2], C1[r + 3]); } \
      float rm = __builtin_fmaxf(a, b); { auto rr = __builtin_amdgcn_permlane32_swap(__float_as_uint(rm), __float_as_uint(rm), false, false); rm = __builtin_fmaxf(__uint_as_float(rr[0]), __uint_as_float(rr[1])); } \
      resc = false; \
      if (__builtin_expect(__any(rm > (float)THRL), 0)) { const float dl = __builtin_fmaxf(rm, 0.f); mhat += dl; \
        _Pragma("unroll") for (int r = 0; r < 16; ++r) { C0[r] -= dl; C1[r] -= dl; } \
        _Pragma("unroll") for (int r = 0; r < 16; ++r) negm[r] = -mhat; asm volatile("" : "+v"(negm)); \
        const float f = __builtin_amdgcn_exp2f(-dl); l_reg *= f; if (hi == 0) wsf[r32] = f; resc = true; } } \
    SBAR(); \
    GAPB(o[0] = __builtin_amdgcn_mfma_f32_32x32x16_bf16(PAF(0), VFR(0), o[0], 0, 0, 0), C0, 0); \
    GAPB(o[1] = __builtin_amdgcn_mfma_f32_32x32x16_bf16(PAF(0), VFR(4), o[1], 0, 0, 0), C0, 4); \
    KRD(GL, 0); GAPB(o[0] = __builtin_amdgcn_mfma_f32_32x32x16_bf16(PAF(1), VFR(1), o[0], 0, 0, 0), C0, 8); \
    KRD(GL, 1); GAPB(o[1] = __builtin_amdgcn_mfma_f32_32x32x16_bf16(PAF(1), VFR(5), o[1], 0, 0, 0), C0, 12); \
    KRD(GL, 2); GAPB(o[0] = __builtin_amdgcn_mfma_f32_32x32x16_bf16(PAF(2), VFR(2), o[0], 0, 0, 0), C1, 0); \
    KRD(GL, 3); GAPB(o[1] = __builtin_amdgcn_mfma_f32_32x32x16_bf16(PAF(2), VFR(6), o[1], 0, 0, 0), C1, 4); \
    GAPB(o[0] = __builtin_amdgcn_mfma_f32_32x32x16_bf16(PAF(3), VFR(3), o[0], 0, 0, 0), C1, 8); \
    GAPB(o[1] = __builtin_amdgcn_mfma_f32_32x32x16_bf16(PAF(3), VFR(7), o[1], 0, 0, 0), C1, 12); \
    } while (0)
    int t = 1;
#undef CMASK
#define CMASK(P0, P1, t) do { } while (0)
    for (; t + 5 < NT; t += 2) {
        STEP(pB0, pB1, pA0, pA1, t, true, true, true);     WAIT_BAR(2); RESC(); ROT();
        STEP(pA0, pA1, pB0, pB1, t + 1, true, true, true); WAIT_BAR(2); RESC(); ROT();
    }
#undef CMASK
#define CMASK(P0, P1, t) do { int jb_ = (t) - (NT - 4); if (jb_ >= 0) bmask(P0, P1, TKB(t), qrel, hi); } while (0)
#define ENDW(tt) do { if ((tt) + 3 < NT) { WAIT_BAR(2); } else if ((tt) + 2 < NT) { WAIT_BAR(1); } else { WAIT_BAR(0); } } while (0)
    for (; t + 1 < NT; t += 2) {
        STEP(pB0, pB1, pA0, pA1, t, (t + 3 < NT), (t + 1 < NT), (t + 1 < NT));     ENDW(t);     RESC(); ROT();
        STEP(pA0, pA1, pB0, pB1, t + 1, (t + 4 < NT), (t + 2 < NT), (t + 2 < NT)); ENDW(t + 1); RESC(); ROT();
    }
    STEP(pB0, pB1, pA0, pA1, NT - 1, false, false, false); RESC();
    { float sacc = pB0[0] + pB0[1]; _Pragma("unroll") for (int r = 2; r < 16; ++r) sacc += pB0[r]; _Pragma("unroll") for (int r = 0; r < 16; ++r) sacc += pB1[r]; l_reg += sacc;
      pw0 = (u32x4){PKW(pB0, 0), PKW(pB0, 2), PKW(pB0, 4), PKW(pB0, 6)}; pw1 = (u32x4){PKW(pB0, 8), PKW(pB0, 10), PKW(pB0, 12), PKW(pB0, 14)}; pw2 = (u32x4){PKW(pB1, 0), PKW(pB1, 2), PKW(pB1, 4), PKW(pB1, 6)}; pw3 = (u32x4){PKW(pB1, 8), PKW(pB1, 10), PKW(pB1, 12), PKW(pB1, 14)};
      SBAR(); pv(o, vb0 + sl_cur, PAF(0), PAF(1), PAF(2), PAF(3)); }
#undef PKW
#undef PAF
#undef VFR
#undef PIN
#undef MX3
#undef GAPA
#undef GAPB
#undef EX
#undef VRD
#undef KRD
#undef STEP
#undef ENDW
    { auto rr = __builtin_amdgcn_permlane32_swap(__float_as_uint(l_reg), __float_as_uint(l_reg), false, false); l_reg = __uint_as_float(rr[0]) + __uint_as_float(rr[1]); }
    l_reg += __builtin_amdgcn_exp2f(sinkp[head] * 1.4426950408889634f - mhat);
    if (hi == 0) wsf[32 + r32] = l_reg; asm volatile("s_waitcnt lgkmcnt(0)" ::: "memory");
    float rli[16];
#pragma unroll
    for (int r = 0; r < 16; ++r) rli[r] = __builtin_amdgcn_rcpf(wsf[32 + crow(r, hi)]);
    bf16* Ow = O + (rowblk + (wid & 3) * QBLK) * OPITCH + head * D;
    { bf16* stg = (bf16*)(shm + LDS_OST) + wid * 2048;
#pragma unroll
      for (int r = 0; r < 16; ++r) { const int orow = crow(r, hi);
#pragma unroll
        for (int d0 = 0; d0 < 2; ++d0) stg[orow * 64 + d0 * 32 + r32] = __float2bfloat16(o[d0][r] * rli[r]); }
      asm volatile("s_waitcnt lgkmcnt(0)" ::: "memory");
#pragma unroll
      for (int i = 0; i < 4; ++i) { const int row = i * 8 + (lane >> 3), ch = lane & 7; const u32x4 v = *(const u32x4*)(stg + row * 64 + ch * 8); ATTN_STORE16(Ow + (long)row * OPITCH + ch * 8, v); } }
    asm volatile("s_waitcnt lgkmcnt(0)\n\ts_barrier" ::: "memory");
#undef DMA_K
#undef DMA_V
#undef TROW
#undef TKB
#undef CMASK
#undef START
#undef RESC
#undef ROT
}
#undef SBAR
#undef WAIT_BAR
}

#define XB_TMO      128
#define XB_XCNT(j)  (256  + 64 * (j))
#define XB_XSUB(j)  (1280 + 64 * (j))
#define XB_XGEN(j)  (2304 + 64 * (j))
#define XB_TOP      3328
#define XB_TOPGEN   3392
#define XCD_BAR_WORDS 3456
#define XB_SPIN_CAP (1u << 18)
__device__ __forceinline__ unsigned xb_ld(unsigned* p)              { return __hip_atomic_load(p, __ATOMIC_RELAXED, __HIP_MEMORY_SCOPE_AGENT); }
__device__ __forceinline__ unsigned xb_add(unsigned* p, unsigned v) { return __hip_atomic_fetch_add(p, v, __ATOMIC_RELAXED, __HIP_MEMORY_SCOPE_AGENT); }
__device__ __forceinline__ unsigned xb_xcc_id() { return (unsigned)__builtin_amdgcn_s_getreg((3 << 11) | 20) & 0xFu; }
#define XB_SPIN(cond, bar) do { unsigned _sp = 0; while (cond) { __builtin_amdgcn_s_sleep(1); \
    if ((++_sp & 255u) == 0u) { if (xb_ld(&(bar)[XB_TMO])) break; if (_sp > XB_SPIN_CAP) { atomicAdd(&(bar)[XB_TMO], 1u); break; } } } } while (0)
struct XcdBarrier { unsigned* bar; unsigned x; volatile LAS unsigned* st; };
__device__ __forceinline__ XcdBarrier xcd_barrier_post(unsigned* bar, volatile LAS unsigned* st) {
    XcdBarrier b; b.bar = bar; b.x = xb_xcc_id(); b.st = st;
    if (threadIdx.x == 0) (void)xb_add(&bar[XB_XCNT(b.x)], 1u);
    return b;
}
__device__ __forceinline__ void xcd_barrier_complete(unsigned* bar, unsigned x, unsigned& nloc, unsigned& nx) {
    const unsigned G = gridDim.x * gridDim.y * gridDim.z;
    unsigned sum, cnt, mine, sp = 0u;
    for (;;) {
        sum = 0u; cnt = 0u; mine = 0u;
#pragma unroll
        for (unsigned j = 0; j < 16; ++j) { const unsigned c = xb_ld(&bar[XB_XCNT(j)]); sum += c; cnt += (c > 0u) ? 1u : 0u; mine = (j == x) ? c : mine; }
        if (sum == G) break;
        __builtin_amdgcn_s_sleep(1);
        if ((++sp & 255u) == 0u) { if (xb_ld(&bar[XB_TMO])) break; if (sp > XB_SPIN_CAP) { atomicAdd(&bar[XB_TMO], 1u); break; } }
    }
    nloc = mine > 0u ? mine : 1u; nx = cnt > 0u ? cnt : 1u;
}
__device__ __forceinline__ void xcd_barrier(const XcdBarrier& b) {
    asm volatile("s_waitcnt vmcnt(0)" ::: "memory");
    __syncthreads();
    if (threadIdx.x == 0) {
        unsigned* bar = b.bar;
        __builtin_amdgcn_s_waitcnt(0);
        unsigned nloc = b.st[0], nx = b.st[1];
        if (nloc == 0u) { xcd_barrier_complete(bar, b.x, nloc, nx); b.st[0] = nloc; b.st[1] = nx; }
        const unsigned old = xb_add(&bar[XB_XSUB(b.x)], 1u);
        const unsigned gen = old / nloc;
        if (old + 1u == (gen + 1u) * nloc) {
            __builtin_amdgcn_fence(__ATOMIC_RELEASE, "agent");
            asm volatile("s_waitcnt vmcnt(0)" ::: "memory");
            const unsigned og = xb_add(&bar[XB_TOP], 1u);
            const unsigned tg = og / nx;
            if (og + 1u == (tg + 1u) * nx) xb_add(&bar[XB_TOPGEN], 1u);
            else XB_SPIN(xb_ld(&bar[XB_TOPGEN]) == tg, bar);
            __builtin_amdgcn_fence(__ATOMIC_ACQUIRE, "agent");
            xb_add(&bar[XB_XGEN(b.x)], 1u);
            asm volatile("s_waitcnt vmcnt(0)" ::: "memory");
        } else {
            XB_SPIN(xb_ld(&bar[XB_XGEN(b.x)]) == gen, bar);
            __builtin_amdgcn_fence(__ATOMIC_ACQUIRE, "agent");
            asm volatile("s_waitcnt vmcnt(0)" ::: "memory");
        }
    }
    __syncthreads();
}

#define LDS_WAIT() asm volatile("s_waitcnt lgkmcnt(0)" ::: "memory")
__device__ __forceinline__ void transpose_item(const float* W, int K, int N, bf16_t* WT, int k0, int n0, int drow0, LAS float* scr, int lane) {
    float t[32];
#pragma unroll
    for (int i = 0; i < 32; ++i) t[i] = __builtin_nontemporal_load(W + (size_t)(k0 + 2 * i + (lane >> 5)) * N + n0 + (lane & 31));
#pragma unroll
    for (int i = 0; i < 32; ++i) scr[(2 * i + (lane >> 5)) * 33 + (lane & 31)] = t[i];
    LDS_WAIT(); asm volatile("" ::: "memory");
    const int c = lane & 7;
#pragma unroll
    for (int j = 0; j < 4; ++j) { const int n = (lane >> 3) + 8 * j; const LAS float* s = scr + (8 * c) * 33 + n;
        u32x4 o; o.x = pkbf(s[0 * 33], s[1 * 33]); o.y = pkbf(s[2 * 33], s[3 * 33]); o.z = pkbf(s[4 * 33], s[5 * 33]); o.w = pkbf(s[6 * 33], s[7 * 33]);
        *(GAS u32x4*)(WT + (size_t)(drow0 + n) * K + k0 + 8 * c) = o; }
    LDS_WAIT(); asm volatile("" ::: "memory");
}
__device__ __forceinline__ void transpose_item_f8(const float* W, int K, int N, unsigned char* WT, int k0, int n0, int drow0, float scale, LAS float* scr, int lane) {
    float t[32];
#pragma unroll
    for (int i = 0; i < 32; ++i) t[i] = __builtin_nontemporal_load(W + (size_t)(k0 + 2 * i + (lane >> 5)) * N + n0 + (lane & 31));
#pragma unroll
    for (int i = 0; i < 32; ++i) scr[(2 * i + (lane >> 5)) * 33 + (lane & 31)] = t[i];
    LDS_WAIT(); asm volatile("" ::: "memory");
    const int n = lane >> 1, hf = lane & 1; const LAS float* sp = scr + (32 * hf) * 33 + n;
    u32x4 o0, o1;
    o0.x = pk4f8(sp[0 * 33] * scale, sp[1 * 33] * scale, sp[2 * 33] * scale, sp[3 * 33] * scale);     o0.y = pk4f8(sp[4 * 33] * scale, sp[5 * 33] * scale, sp[6 * 33] * scale, sp[7 * 33] * scale);
    o0.z = pk4f8(sp[8 * 33] * scale, sp[9 * 33] * scale, sp[10 * 33] * scale, sp[11 * 33] * scale);   o0.w = pk4f8(sp[12 * 33] * scale, sp[13 * 33] * scale, sp[14 * 33] * scale, sp[15 * 33] * scale);
    o1.x = pk4f8(sp[16 * 33] * scale, sp[17 * 33] * scale, sp[18 * 33] * scale, sp[19 * 33] * scale); o1.y = pk4f8(sp[20 * 33] * scale, sp[21 * 33] * scale, sp[22 * 33] * scale, sp[23 * 33] * scale);
    o1.z = pk4f8(sp[24 * 33] * scale, sp[25 * 33] * scale, sp[26 * 33] * scale, sp[27 * 33] * scale); o1.w = pk4f8(sp[28 * 33] * scale, sp[29 * 33] * scale, sp[30 * 33] * scale, sp[31 * 33] * scale);
    GAS u32x4* dst = (GAS u32x4*)(WT + (size_t)(drow0 + n) * K + k0 + 32 * hf);
    dst[0] = o0; dst[1] = o1;
    LDS_WAIT(); asm volatile("" ::: "memory");
}
__device__ __forceinline__ void sincos_d(double x, double& s, double& c) {
    const double TWO_PI = 6.283185307179586476925;
    const double k = __builtin_rint(x / TWO_PI); const double r = x - k * TWO_PI;
    const double r2 = r * r; double ts = r, tc = 1.0; s = r; c = 1.0;
    for (int i = 1; i <= 16; ++i) { tc *= -r2 / (double)((2 * i - 1) * (2 * i)); ts *= -r2 / (double)((2 * i) * (2 * i + 1)); c += tc; s += ts; }
}

struct Args { const float* in[24]; float* out; unsigned char* ws; int ph_lo, ph_hi, li, pad; };
constexpr int NPH = 24;

__device__ __forceinline__ void norm_store(const f32x4 (&v)[4], float ssum, const float* g, const float* mrow, int shc, int scc, bf16_t* XNo, size_t m, int lane) {
    const float rstd = 1.0f / __builtin_sqrtf(ssum * (1.0f / DM) + EPS);
#pragma unroll
    for (int j = 0; j < 4; ++j) { const f32x4 gv = *(const f32x4*)(g + 4 * lane + 256 * j), sc = *(const f32x4*)(mrow + scc * 1024 + 4 * lane + 256 * j), sh = *(const f32x4*)(mrow + shc * 1024 + 4 * lane + 256 * j);
        const f32x4 y = (v[j] * rstd) * gv * (sc + 1.0f) + sh; u32x2 w; w.x = pkbf(y.x, y.y); w.y = pkbf(y.z, y.w); *((GAS u32x2*)(XNo + m * DM) + lane + 64 * j) = w; }
}
__device__ __forceinline__ void norm_rows(const float* srcL, const float* srcC, int nrows, const float* g, const float* mod, int shc, int scc, bf16_t* XNo, int gw, int NGW, int lane,
                                          const float* part, int nS, const float* gatec, float* zout) {
    if (nrows > NLAT) {
        for (int rc = gw; rc < NCTXR; rc += NGW) {
            const GAS f32x4* xr = (const GAS f32x4*)(srcC + (size_t)rc * DM) + lane;
            f32x4 v[4];
#pragma unroll
            for (int j = 0; j < 4; ++j) v[j] = xr[64 * j];
            if (part != nullptr) {
                f32x4 a[4];
#pragma unroll
                for (int j = 0; j < 4; ++j) a[j] = (f32x4){0.f, 0.f, 0.f, 0.f};
                for (int s0 = 0; s0 < nS; s0 += 7) {
                    f32x4 t[7][4];
#pragma unroll
                    for (int q = 0; q < 7; ++q) { const int s2 = (s0 + q < nS) ? s0 + q : s0; const GAS f32x4* pr = (const GAS f32x4*)(part + ((size_t)s2 * NCTXR + rc) * DM) + lane;
#pragma unroll
                        for (int j = 0; j < 4; ++j) t[q][j] = pr[64 * j]; }
#pragma unroll
                    for (int q = 0; q < 7; ++q) if (s0 + q < nS) {
#pragma unroll
                        for (int j = 0; j < 4; ++j) a[j] += t[q][j]; }
                }
#pragma unroll
                for (int j = 0; j < 4; ++j) v[j] += *(const f32x4*)(gatec + 4 * lane + 256 * j) * a[j];
                if (zout != nullptr) { GAS f32x4* zr = (GAS f32x4*)(zout + (size_t)rc * DM) + lane;
#pragma unroll
                    for (int j = 0; j < 4; ++j) zr[64 * j] = v[j]; }
            }
            float ss = 0.f;
#pragma unroll
            for (int j = 0; j < 4; ++j) ss += (v[j].x * v[j].x + v[j].y * v[j].y) + (v[j].z * v[j].z + v[j].w * v[j].w);
            norm_store(v, wave_sum(ss), g, mod + (size_t)4 * 6144, shc, scc, XNo, (size_t)NLAT + rc, lane);
        }
    }
    for (int m0 = gw * 4; m0 < NLAT; m0 += NGW * 4) {
        const int mb = m0 >> 13;
        const GAS f32x4* xr = (const GAS f32x4*)(srcL + (size_t)m0 * DM) + lane;
        f32x4 v[4][4];
#pragma unroll
        for (int r = 0; r < 4; ++r)
#pragma unroll
            for (int j = 0; j < 4; ++j) v[r][j] = xr[r * 256 + 64 * j];
        float ss[4];
#pragma unroll
        for (int r = 0; r < 4; ++r) { ss[r] = 0.f;
#pragma unroll
            for (int j = 0; j < 4; ++j) ss[r] += (v[r][j].x * v[r][j].x + v[r][j].y * v[r][j].y) + (v[r][j].z * v[r][j].z + v[r][j].w * v[r][j].w); }
#pragma unroll
        for (int o = 1; o < 64; o <<= 1) {
#pragma unroll
            for (int r = 0; r < 4; ++r) ss[r] += __shfl_xor(ss[r], o); }
#pragma unroll
        for (int r = 0; r < 4; ++r) norm_store(v[r], ss[r], g, mod + (size_t)mb * 6144, shc, scc, XNo, (size_t)(m0 + r), lane);
    }
}

__global__ void __launch_bounds__(512, 2) fwd(Args args) {
    extern __shared__ __attribute__((aligned(16))) unsigned char lds_raw[];
    LAS unsigned char* lds = (LAS unsigned char*)lds_raw;
    volatile LAS unsigned* MISC = (volatile LAS unsigned*)(lds + MISC_OFF);
    LAS int* gtab = (LAS int*)(lds + GTAB_OFF);
    const int G = gridDim.x; const int bx = blockIdx.x; const int vcu = (G % 8 == 0) ? (bx % 8) * (G / 8) + bx / 8 : bx;
    const int NGW = G * 8;
#define PHASE_IDS() int tid_ = threadIdx.x; asm volatile("" : "+v"(tid_)); const int tid = tid_, lane = tid & 63, wave = __builtin_amdgcn_readfirstlane(tid >> 6), gw = vcu * 8 + wave; (void)lane; (void)gw
    unsigned char* ws = args.ws;
    gu32* ctl = (gu32*)(ws + WS_CTL);
#define MOD ((float*)(ws + WS_MOD))
#define ROPE ((float*)(ws + WS_ROPE))
#define STATS ((float*)(ws + WS_STATS))
#define LIST ((int*)(ws + WS_LIST))
#define TINFO ((int*)(ws + WS_TINFO))
#define WSB ((bf16_t*)(ws + WS_WS))
#define WIN ((bf16_t*)(ws + WS_WIN))
#define WAO ((bf16_t*)(ws + WS_WAO))
#define WQKV ((bf16_t*)(ws + WS_WQKV))
#define WBO ((bf16_t*)(ws + WS_WBO))
#define WGU ((bf16_t*)(ws + WS_WGU))
#define WD ((bf16_t*)(ws + WS_WD))
#define MGU ((unsigned char*)(ws + WS_MGU))
#define MD ((unsigned char*)(ws + WS_MD))
#define XN8 ((unsigned char*)(ws + WS_XN))
#define XN ((bf16_t*)(ws + WS_XN))
#define ZB ((float*)(ws + WS_ZB))
#define UVT ((bf16_t*)(ws + WS_UVT))
#define A2 ((bf16_t*)(ws + WS_A2))
#define HB ((bf16_t*)(ws + WS_H))
#define QKV ((bf16_t*)(ws + WS_QKV))
#define OB ((bf16_t*)(ws + WS_O))
#define YB ((bf16_t*)(ws + WS_Y))
#define HC ((unsigned char*)(ws + WS_HC))
#define YP ((bf16_t*)(ws + WS_YP))
#define PART1 ((float*)(ws + WS_PART1))
#define PART2 ((float*)(ws + WS_PART2))
#define I_X (args.in[0])
#define I_C (args.in[1])
#define I_CTX (args.in[2])
#define I_CCTX (args.in[3])
#define I_ADAW (args.in[4])
#define I_ADAB (args.in[5])
#define I_NORMG (args.in[6])
#define I_FINALG (args.in[7])
#define HL (args.out)

    { PHASE_IDS(); for (int u = tid; u < (LDS_BYTES - MISC_OFF) / 4; u += 512) ((LAS unsigned*)(lds + MISC_OFF))[u] = 0u; }
    __syncthreads();
    const int lo = args.ph_lo, hi_ph = args.ph_hi;
    const bool one_launch = (hi_ph - lo) > 1;
    XcdBarrier bar; bar.bar = (unsigned*)(ctl + CW_BAR) + args.li * XCD_BAR_WORDS; bar.x = 0; bar.st = nullptr;
    if (one_launch) bar = xcd_barrier_post((unsigned*)(ctl + CW_BAR) + args.li * XCD_BAR_WORDS, MISC + 8);
#ifndef PHMASK
#define PHMASK 0xFFFFFFFFu
#endif
#define IN(k) (((PHMASK >> (k)) & 1) && lo <= (k) && (k) < hi_ph)
#define BOTH(k) (IN(k) && IN((k) + 1))
#define GRID_BAR() xcd_barrier(bar)
#if defined(PROBE_LO)
    unsigned long long tpA = __builtin_amdgcn_s_memrealtime(), tpB = 0;
#define PROBE_MARK(k) do { if ((k) == PROBE_LO - 1) tpA = __builtin_amdgcn_s_memrealtime(); if ((k) == PROBE_HI) tpB = __builtin_amdgcn_s_memrealtime(); } while (0)
#else
#define PROBE_MARK(k) do { } while (0)
#endif

    if (IN(0)) {
        PHASE_IDS();
        {
            LAS float* sv = (LAS float*)lds;
            LAS float* red = (LAS float*)(lds + 5 * 1024 * 4);
            if (bx < 192) {
                for (int idx = tid; idx < 5 * 1024; idx += 512) { const int r = idx >> 10, k = idx & 1023; const float cv = r < 4 ? I_C[r * 1024 + k] : I_CCTX[k]; sv[idx] = cv / (1.0f + __expf(-cv)); }
                __syncthreads();
                for (int item = bx; item < 192; item += G) {
                    const int i = item / 96, n0 = (item % 96) * 64, nn = tid & 63, kq = tid >> 6;
                    float a0 = 0.f, a1 = 0.f, a2 = 0.f, a3 = 0.f, a4 = 0.f;
                    const float* wp = I_ADAW + ((size_t)i * 1024 + kq * 128) * 6144 + n0 + nn;
#pragma unroll 8
                    for (int k = 0; k < 128; ++k) { const float w = wp[(size_t)k * 6144]; const int kk = kq * 128 + k;
                        a0 += sv[kk] * w; a1 += sv[1024 + kk] * w; a2 += sv[2048 + kk] * w; a3 += sv[3072 + kk] * w; a4 += sv[4096 + kk] * w; }
                    red[(kq * 5 + 0) * 64 + nn] = a0; red[(kq * 5 + 1) * 64 + nn] = a1; red[(kq * 5 + 2) * 64 + nn] = a2; red[(kq * 5 + 3) * 64 + nn] = a3; red[(kq * 5 + 4) * 64 + nn] = a4;
                    __syncthreads();
                    if (tid < 320) { const int r = tid >> 6; float s = I_ADAB[i * 6144 + n0 + nn];
#pragma unroll
                        for (int q = 0; q < 8; ++q) s += red[(q * 5 + r) * 64 + nn];
                        MOD[((size_t)i * 5 + r) * 6144 + n0 + nn] = s; }
                    __syncthreads();
                }
            }
            __syncthreads();
        }
        {
            LAS float* scr = (LAS float*)(lds + wave * 16384);
            constexpr int I_IN = 16 * 64, I_AO = 16 * 32, I_QKV = 16 * 48, I_BO = 16 * 32, I_F = 16 * 112, I_FD = 56 * 32;
            constexpr int I_DENSE = I_IN + I_AO + I_QKV + I_BO + 2 * I_F + I_FD, I_MOE = 8 * (2 * I_F + I_FD), I_WS = 128, I_ROPE = 32;
            constexpr int NITEMS = I_DENSE + I_MOE + I_WS + I_ROPE;
            for (int it = gw; it < NITEMS; it += NGW) {
                int r = it;
                if (r < I_IN) { const int kb = r / 64, nb = r % 64; transpose_item(args.in[8], 1024, 2048, WIN, 64 * kb, 32 * nb, 32 * nb, scr, lane); continue; } r -= I_IN;
                if (r < I_AO) { const int kb = r / 32, nb = r % 32; transpose_item(args.in[13], 1024, 1024, WAO, 64 * kb, 32 * nb, 32 * nb, scr, lane); continue; } r -= I_AO;
                if (r < I_QKV) { const int kb = r / 48, nb = r % 48; transpose_item(args.in[14], 1024, 1536, WQKV, 64 * kb, 32 * nb, 32 * nb, scr, lane); continue; } r -= I_QKV;
                if (r < I_BO) { const int kb = r / 32, nb = r % 32; transpose_item(args.in[16], 1024, 1024, WBO, 64 * kb, 32 * nb, 32 * nb, scr, lane); continue; } r -= I_BO;
                if (r < 2 * I_F) { const int up = r / I_F; const int q = r % I_F; const int kb = q / 112, nb = q % 112, n0 = 32 * nb;
                    transpose_item(args.in[17 + up], 1024, DFF, WGU, 64 * kb, n0, 256 * (n0 >> 7) + 128 * up + (n0 & 127), scr, lane); continue; } r -= 2 * I_F;
                if (r < I_FD) { const int kb = r / 32, nb = r % 32; transpose_item(args.in[19], DFF, 1024, WD, 64 * kb, 32 * nb, 32 * nb, scr, lane); continue; } r -= I_FD;
                if (r < I_MOE) { const int e = r / (2 * I_F + I_FD); int q = r % (2 * I_F + I_FD);
                    if (q < 2 * I_F) { const int up = q / I_F; q %= I_F; const int kb = q / 112, nb = q % 112, n0 = 32 * nb;
                        transpose_item_f8(args.in[21 + up] + (size_t)e * 1024 * DFF, 1024, DFF, MGU + (size_t)e * 7168 * 1024, 64 * kb, n0, 256 * (n0 >> 7) + 128 * up + (n0 & 127), MOE_SGU, scr, lane); }
                    else { q -= 2 * I_F; const int kb = q / 32, nb = q % 32; transpose_item_f8(args.in[23] + (size_t)e * DFF * 1024, DFF, 1024, MD + (size_t)e * 1024 * DFF, 64 * kb, 32 * nb, 32 * nb, MOE_SD, scr, lane); }
                    continue; } r -= I_MOE;
                if (r < I_WS) { const float* src = args.in[11] + (size_t)r * 2048;
#pragma unroll
                    for (int j = 0; j < 8; ++j) { const f32x4 v = *(const f32x4*)(src + j * 256 + lane * 4); u32x2 w; w.x = pkbf(v.x, v.y); w.y = pkbf(v.z, v.w); *(u32x2*)(WSB + (size_t)r * 2048 + j * 256 + lane * 4) = w; }
                    continue; } r -= I_WS;
                {
                    const int ent = r * 64 + lane; const int pos = ent >> 4, i = ent & 15;
                    double inv = 1.0; for (int q = 0; q < i; ++q) inv *= 0.56234132519034908;
                    const float ang = (float)pos * (float)inv; double s, c; sincos_d((double)ang, s, c);
                    ROPE[ent] = (float)c; ROPE[2048 + ent] = (float)s;
                }
            }
        }
        if (BOTH(0)) GRID_BAR(); PROBE_MARK(0);
    }
    if (IN(1)) { PHASE_IDS(); norm_rows(I_X, I_CTX, MALL, I_NORMG + 0 * 1024, MOD, 0, 1, XN, gw, NGW, lane, nullptr, 0, nullptr, nullptr); if (BOTH(1)) GRID_BAR(); PROBE_MARK(1); }
    if (IN(2)) {
        pg8::DenseSched S{(const char*)WIN, (const char*)XN, 8, NPA, G, bx, (size_t)256 * 1024 * 2};
        pg8::EpiGeluT E{UVT, STATS};
        pg8::gemm_phase<pg8::EpiGeluT, pg8::DenseSched, true, false>(lds, gtab, 1024, 16, S, E);
        if (BOTH(2)) GRID_BAR(); PROBE_MARK(2);
    }
    if (IN(3)) {
        PHASE_IDS();
        const float* vg = args.in[9]; const float* vb = args.in[10]; const float* bs = args.in[12];
        LAS float* mu_l = (LAS float*)(lds + wave * 1024); LAS float* rs_l = mu_l + 128;
        const int r32 = lane & 31, h = lane >> 5;
        for (int unit = gw; unit < (MALL / 128) * 16; unit += NGW) {
            const int ch = unit >> 4, g = unit & 15, q0 = ch * 128;
#pragma unroll
            for (int tt = 0; tt < 2; ++tt) { const int tok = q0 + lane * 2 + tt; const f32x4* sp = (const f32x4*)(STATS + (size_t)tok * 16);
                const f32x4 a = sp[0], b = sp[1], c = sp[2], d = sp[3];
                const float sum = (a.x + a.z) + (b.x + b.z) + (c.x + c.z) + (d.x + d.z), sq = (a.y + a.w) + (b.y + b.w) + (c.y + c.w) + (d.y + d.w);
                const float mean = sum * (1.0f / 1024.0f), var = sq * (1.0f / 1024.0f) - mean * mean;
                mu_l[lane * 2 + tt] = mean; rs_l[lane * 2 + tt] = 1.0f / __builtin_sqrtf(var + EPS); }
            float vgc[2], vbc[2];
#pragma unroll
            for (int ct = 0; ct < 2; ++ct) { vgc[ct] = vg[64 * g + 32 * ct + r32]; vbc[ct] = vb[64 * g + 32 * ct + r32]; }
            f32x16 acc[2][4];
#pragma unroll
            for (int ct = 0; ct < 2; ++ct)
#pragma unroll
                for (int pt = 0; pt < 4; ++pt) acc[ct][pt] = f32x16{};
#pragma unroll 2
            for (int s = 0; s < 8; ++s) {
                const int qs = 16 * s + 8 * h;
                const f32x4 m0 = *(const LAS f32x4*)(mu_l + qs), m1 = *(const LAS f32x4*)(mu_l + qs + 4), r0 = *(const LAS f32x4*)(rs_l + qs), r1 = *(const LAS f32x4*)(rs_l + qs + 4);
                bf16x8 af[2], bfr[4];
#pragma unroll
                for (int ct = 0; ct < 2; ++ct) { const bf16x8 raw = *(const bf16x8*)(UVT + (size_t)(1024 + 64 * g + 32 * ct + r32) * MALL + q0 + qs);
                    float y[8];
#pragma unroll
                    for (int j = 0; j < 4; ++j) { y[j] = (bf2f((unsigned short)raw[j]) - m0[j]) * r0[j] * vgc[ct] + vbc[ct]; y[4 + j] = (bf2f((unsigned short)raw[4 + j]) - m1[j]) * r1[j] * vgc[ct] + vbc[ct]; }
                    u32x4 w; w.x = pkbf(y[0], y[1]); w.y = pkbf(y[2], y[3]); w.z = pkbf(y[4], y[5]); w.w = pkbf(y[6], y[7]); af[ct] = __builtin_bit_cast(bf16x8, w); }
#pragma unroll
                for (int pt = 0; pt < 4; ++pt) bfr[pt] = *(const bf16x8*)(WSB + (size_t)(g * 128 + 32 * pt + r32) * 128 + qs);
#pragma unroll
                for (int ct = 0; ct < 2; ++ct)
#pragma unroll
                    for (int pt = 0; pt < 4; ++pt) acc[ct][pt] = __builtin_amdgcn_mfma_f32_32x32x16_bf16(af[ct], bfr[pt], acc[ct][pt], 0, 0, 0);
            }
#pragma unroll
            for (int pt = 0; pt < 4; ++pt) { const int p = 32 * pt + r32; const size_t tokp = (size_t)q0 + p; const float bsv = bs[g * 128 + p];
#pragma unroll
                for (int ct = 0; ct < 2; ++ct)
#pragma unroll
                    for (int rr = 0; rr < 4; ++rr) { const int c = 64 * g + 32 * ct + 8 * rr + 4 * h; float o[4];
#pragma unroll
                        for (int e = 0; e < 4; ++e) { const float uu = bf2f(UVT[(size_t)(c + e) * MALL + tokp]); o[e] = uu * (acc[ct][pt][4 * rr + e] + bsv); }
                        u32x2 w; w.x = pkbf(o[0], o[1]); w.y = pkbf(o[2], o[3]); *(u32x2*)(A2 + tokp * DM + c) = w; } }
        }
        if (BOTH(3)) GRID_BAR(); PROBE_MARK(3);
    }
    if (IN(4)) {
        { pg8::DenseSched S{(const char*)A2, (const char*)WAO, NPL, 4, G, bx, (size_t)256 * 1024 * 2};
          pg8::EpiResid E{I_X, I_CTX, HL, ZB, MOD + 2 * 1024};
          pg8::gemm_phase<pg8::EpiResid, pg8::DenseSched, true, false>(lds, gtab, 1024, 16, S, E); }
        { pg8::SplitSched S{(const char*)(A2 + (size_t)NLAT * DM), (const char*)WAO, 4, 4, P3_NS, G, bx, NPL, (size_t)256 * 1024 * 2, (size_t)(1024 / P3_NS) * 2};
          pg8::EpiPartF32 E{PART1, (size_t)NCTXR * DM};
          pg8::gemm_phase<pg8::EpiPartF32, pg8::SplitSched, true, false>(lds, gtab, 1024, 1024 / P3_NS / 64, S, E); }
        if (BOTH(4)) GRID_BAR(); PROBE_MARK(4);
    }
    if (IN(5)) { PHASE_IDS(); norm_rows(HL, I_CTX, MALL, I_NORMG + 1 * 1024, MOD, 3, 4, XN, gw, NGW, lane, PART1, P3_NS, MOD + 4 * 6144 + 2 * 1024, ZB); if (BOTH(5)) GRID_BAR(); PROBE_MARK(5); }
    if (IN(6)) {
        pg8::DenseSched S{(const char*)XN, (const char*)WGU, NPA, 28, G, bx, (size_t)256 * 1024 * 2};
        pg8::EpiSwiGLU E{HB};
        pg8::gemm_phase<pg8::EpiSwiGLU, pg8::DenseSched, true, false>(lds, gtab, 1024, 16, S, E);
        if (BOTH(6)) GRID_BAR(); PROBE_MARK(6);
    }
    if (IN(7)) {
        { pg8::DenseSched S{(const char*)HB, (const char*)WD, NPL, 4, G, bx, (size_t)256 * DFF * 2};
          pg8::EpiResid E{HL, ZB, HL, ZB, MOD + 5 * 1024};
          pg8::gemm_phase<pg8::EpiResid, pg8::DenseSched, true, false>(lds, gtab, DFF, 56, S, E); }
        { pg8::SplitSched S{(const char*)(HB + (size_t)NLAT * DFF), (const char*)WD, 4, 4, P5_NS, G, bx, NPL, (size_t)256 * DFF * 2, (size_t)(DFF / P5_NS) * 2};
          pg8::EpiPartF32 E{PART2, (size_t)NCTXR * DM};
          pg8::gemm_phase<pg8::EpiPartF32, pg8::SplitSched, true, false>(lds, gtab, DFF, DFF / P5_NS / 64, S, E); }
        if (BOTH(7)) GRID_BAR(); PROBE_MARK(7);
    }
    if (IN(8)) { PHASE_IDS(); norm_rows(HL, ZB, MALL, I_NORMG + 2 * 1024, MOD + 5 * 6144, 0, 1, XN, gw, NGW, lane, PART2, P5_NS, MOD + 4 * 6144 + 5 * 1024, nullptr); if (BOTH(8)) GRID_BAR(); PROBE_MARK(8); }
    if (IN(9)) {
        pg8::DenseSched S{(const char*)XN, (const char*)WQKV, NPA, 6, G, bx, (size_t)256 * 1024 * 2};
        pg8::EpiQKV E{QKV, ROPE, ROPE + 2048, attn_body::C2};
        pg8::gemm_phase<pg8::EpiQKV, pg8::DenseSched, true, false>(lds, gtab, 1024, 16, S, E);
        if (BOTH(9)) GRID_BAR(); PROBE_MARK(9);
    }
    if (IN(10)) {
        static_assert(attn_body::LDS_BYTES_A <= RING_BYTES, "attention LDS");
        const float* sinkp = args.in[15];
        for (int i = 0;; ++i) { const int uid = i * G + vcu; if (uid >= NB * 64 * 4 * 2) break;
            const int pr = uid & 1, hk = (uid >> 1) & 3, n = (uid >> 3) & 63, b = uid >> 9;
            attn_body::attn_unit<8>(b, hk, n, pr, (const attn_body::bf16*)QKV, (attn_body::bf16*)OB, sinkp, (char*)lds_raw); }
        if (BOTH(10)) GRID_BAR(); PROBE_MARK(10);
    }
    if (IN(11)) {
        pg8::DenseSched S{(const char*)OB, (const char*)WBO, NPL, 4, G, bx, (size_t)256 * 1024 * 2};
        pg8::EpiResid E{HL, ZB, HL, ZB, MOD + 5 * 6144 + 2 * 1024};
        pg8::gemm_phase<pg8::EpiResid, pg8::DenseSched, true, false>(lds, gtab, 1024, 16, S, E);
        if (BOTH(11)) GRID_BAR(); PROBE_MARK(11);
    }
    if (IN(12)) {
        PHASE_IDS();
        const float* g = I_NORMG + 3 * 1024; const float* mod = MOD + 5 * 6144; const float* wrt = args.in[20];
        LAS int* l_e = (LAS int*)lds;
        LAS float* l_w = (LAS float*)(lds + 1024);
        LAS int* l_cnt = (LAS int*)(lds + 2048);
        LAS int* l_base = (LAS int*)(lds + 2048 + 64);
        for (int blk = bx; blk < NLAT / 128; blk += G) {
            if (tid < 8) l_cnt[tid] = 0;
            __syncthreads();
            const int mb = (blk * 128) >> 13; const float* mrow = mod + (size_t)mb * 6144;
            for (int i4 = 0; i4 < 8; ++i4) {
                const int tl0 = wave * 16 + i4 * 2, m0 = blk * 128 + tl0;
                const GAS f32x4* xr = (const GAS f32x4*)(HL + (size_t)m0 * DM) + lane;
                f32x4 v[2][4]; float ss[2];
#pragma unroll
                for (int r = 0; r < 2; ++r)
#pragma unroll
                    for (int j = 0; j < 4; ++j) v[r][j] = xr[r * 256 + 64 * j];
#pragma unroll
                for (int r = 0; r < 2; ++r) { ss[r] = 0.f;
#pragma unroll
                    for (int j = 0; j < 4; ++j) ss[r] += (v[r][j].x * v[r][j].x + v[r][j].y * v[r][j].y) + (v[r][j].z * v[r][j].z + v[r][j].w * v[r][j].w); }
#pragma unroll
                for (int o = 1; o < 64; o <<= 1) {
#pragma unroll
                    for (int r = 0; r < 2; ++r) ss[r] += __shfl_xor(ss[r], o); }
                float lg[2][8];
#pragma unroll
                for (int r = 0; r < 2; ++r)
#pragma unroll
                    for (int e = 0; e < 8; ++e) lg[r][e] = 0.f;
#pragma unroll
                for (int j = 0; j < 4; ++j) { const int col = 4 * lane + 256 * j; const f32x4 gv = *(const f32x4*)(g + col), sc = *(const f32x4*)(mrow + 4 * 1024 + col), sh = *(const f32x4*)(mrow + 3 * 1024 + col);
                    const f32x4 gm = gv * (sc + 1.0f);
                    f32x4 y[2];
#pragma unroll
                    for (int r = 0; r < 2; ++r) { const float rstd = 1.0f / __builtin_sqrtf(ss[r] * (1.0f / DM) + EPS); y[r] = (v[r][j] * rstd) * gm + sh;
                        *((GAS unsigned*)(XN8 + (size_t)(m0 + r) * DM) + lane + 64 * j) = pk4f8(y[r].x, y[r].y, y[r].z, y[r].w); }
#pragma unroll
                    for (int cc = 0; cc < 4; ++cc) { const f32x4 w0 = *(const f32x4*)(wrt + (size_t)(col + cc) * 8), w1 = *(const f32x4*)(wrt + (size_t)(col + cc) * 8 + 4);
#pragma unroll
                        for (int r = 0; r < 2; ++r) { const float yv = y[r][cc];
                            lg[r][0] += yv * w0.x; lg[r][1] += yv * w0.y; lg[r][2] += yv * w0.z; lg[r][3] += yv * w0.w; lg[r][4] += yv * w1.x; lg[r][5] += yv * w1.y; lg[r][6] += yv * w1.z; lg[r][7] += yv * w1.w; } } }
#pragma unroll
                for (int o = 1; o < 64; o <<= 1) {
#pragma unroll
                    for (int r = 0; r < 2; ++r)
#pragma unroll
                        for (int e = 0; e < 8; ++e) lg[r][e] += __shfl_xor(lg[r][e], o); }
#pragma unroll
                for (int r = 0; r < 2; ++r) {
                    int ea = 0; float va = lg[r][0];
#pragma unroll
                    for (int e = 1; e < 8; ++e) if (lg[r][e] > va) { va = lg[r][e]; ea = e; }
                    int eb = -1; float vb2 = -INFINITY;
#pragma unroll
                    for (int e = 0; e < 8; ++e) if (e != ea && lg[r][e] > vb2) { vb2 = lg[r][e]; eb = e; }
                    const float wb = 1.0f / (1.0f + __expf(va - vb2)), wa = 1.0f - wb;
                    if (lane == 0) { const int tl = tl0 + r; l_e[tl * 2] = ea; l_e[tl * 2 + 1] = eb; l_w[tl * 2] = wa; l_w[tl * 2 + 1] = wb; } }
            }
            __syncthreads();
            int ea = 0, eb = 0, pa = 0, pb = 0;
            if (tid < 128) { ea = l_e[tid * 2]; eb = l_e[tid * 2 + 1]; pa = atomicAdd((int*)&l_cnt[ea], 1); pb = atomicAdd((int*)&l_cnt[eb], 1); }
            __syncthreads();
            if (tid < 8) l_base[tid] = (int)__hip_atomic_fetch_add((unsigned*)(ctl + CW_CNT + 64 * tid), (unsigned)l_cnt[tid], __ATOMIC_RELAXED, __HIP_MEMORY_SCOPE_AGENT);
            __syncthreads();
            if (tid < 128) { const int m = blk * 128 + tid; pa += l_base[ea]; pb += l_base[eb];
                LIST[(size_t)ea * NLAT + pa] = m; LIST[(size_t)eb * NLAT + pb] = m;
                int* ti = TINFO + (size_t)m * 8; ti[0] = ea; ti[1] = pa; ti[2] = eb; ti[3] = pb; ti[4] = __float_as_int(l_w[tid * 2]); ti[5] = __float_as_int(l_w[tid * 2 + 1]); }
            __syncthreads();
        }
        if (BOTH(12)) GRID_BAR(); PROBE_MARK(12);
    }
    if (hi_ph > 13 && lo < 23) {
        PHASE_IDS();
        LAS int* mtab = (LAS int*)(lds + MOE_OFF);
        if (tid == 0) { int run = 0, R = 0;
            for (int e = 0; e < 8; ++e) { const int ce = (int)__hip_atomic_load((unsigned*)(ctl + CW_CNT + 64 * e), __ATOMIC_RELAXED, __HIP_MEMORY_SCOPE_AGENT); mtab[e] = run; mtab[16 + e] = ce; run += ce >> 8; if (ce & 255) { mtab[24 + R] = e; ++R; } }
            mtab[8] = run; mtab[32] = R; }
        __syncthreads();
        const int nfull = __builtin_amdgcn_readfirstlane(mtab[8]);
        for (int c = 0; c < MOE_NCH; ++c) {
            const int gp0 = c * MOE_CH, gp1 = nfull < (c + 1) * MOE_CH ? nfull : (c + 1) * MOE_CH;
            if (IN(13 + 2 * c)) {
                pg8::MoeSched S; S.A = (const char*)XN8; S.B = (const char*)MGU; S.list = LIST; S.tab = mtab; S.mode = 0; S.nS = 1; S.kbytes = 0;
                S.gp0 = gp0; S.gp1 = gp1; S.nN = 28; S.G = G; S.c = bx; S.bexp = (size_t)7168 * 1024; S.btile = (size_t)256 * 1024; S.astep = 0; S.gather = true;
                pg8::EpiSwiGLU8 E{HC, 1.0f / MOE_SGU};
                pg8::gemm_phase<pg8::EpiSwiGLU8, pg8::MoeSched, true, true, true>(lds, gtab, 512, 8, S, E);
                if (BOTH(13 + 2 * c)) GRID_BAR(); PROBE_MARK(13 + 2 * c);
            }
            if (IN(14 + 2 * c)) {
                pg8::MoeSched S; S.A = (const char*)HC; S.B = (const char*)MD; S.list = LIST; S.tab = mtab; S.mode = 0; S.nS = 1; S.kbytes = 0;
                S.gp0 = gp0; S.gp1 = gp1; S.nN = 4; S.G = G; S.c = bx; S.bexp = (size_t)1024 * DFF; S.btile = (size_t)256 * DFF; S.astep = (size_t)256 * DFF; S.gather = false;
                pg8::EpiBf16Plain E{YB, DM, 1.0f / MOE_SD};
                pg8::gemm_phase<pg8::EpiBf16Plain, pg8::MoeSched, true, false, true>(lds, gtab, DFF / 2, 28, S, E);
                if (BOTH(14 + 2 * c)) GRID_BAR(); PROBE_MARK(14 + 2 * c);
            }
        }
        if (IN(21)) {
            pg8::MoeSched S; S.A = (const char*)XN8; S.B = (const char*)MGU; S.list = LIST; S.tab = mtab; S.mode = 1; S.nS = 1; S.kbytes = 0;
            S.gp0 = 0; S.gp1 = 0; S.nN = 28; S.G = G; S.c = bx; S.bexp = (size_t)7168 * 1024; S.btile = (size_t)256 * 1024; S.astep = 0; S.gather = true;
            pg8::EpiSwiGLU8 E{HC, 1.0f / MOE_SGU};
            pg8::gemm_phase<pg8::EpiSwiGLU8, pg8::MoeSched, true, true, true>(lds, gtab, 512, 8, S, E);
            if (BOTH(21)) GRID_BAR(); PROBE_MARK(21);
        }
        if (IN(22)) {
            pg8::MoeSched S; S.A = (const char*)HC; S.B = (const char*)MD; S.list = LIST; S.tab = mtab; S.mode = 2; S.nS = MOE_RS; S.kbytes = (size_t)(DFF / MOE_RS);
            S.gp0 = 0; S.gp1 = 0; S.nN = 4; S.G = G; S.c = bx; S.bexp = (size_t)1024 * DFF; S.btile = (size_t)256 * DFF; S.astep = (size_t)256 * DFF; S.gather = false;
            pg8::EpiPartBf16 E{YP, (size_t)8 * 256 * DM, 1.0f / MOE_SD};
            pg8::gemm_phase<pg8::EpiPartBf16, pg8::MoeSched, true, false, true>(lds, gtab, DFF / 2, DFF / MOE_RS / 128, S, E);
            if (BOTH(22)) GRID_BAR(); PROBE_MARK(22);
        }
    }
    if (IN(23)) {
        PHASE_IDS();
        LAS int* l_pb = (LAS int*)(lds + wave * 128);
        if (lane == 0) { int run = 0, R = 0;
            for (int e = 0; e < 8; ++e) { const int ce = (int)__hip_atomic_load((unsigned*)(ctl + CW_CNT + 64 * e), __ATOMIC_RELAXED, __HIP_MEMORY_SCOPE_AGENT); l_pb[e] = run; l_pb[8 + e] = ce >> 8; l_pb[16 + e] = R; run += ce >> 8; if (ce & 255) ++R; } }
        const float* g2 = MOD + 5 * 6144 + 5 * 1024;
        for (int m0 = gw * 2; m0 < NLAT; m0 += NGW * 2) {
            const int mb = m0 >> 13;
            f32x4 hv[2][4], ya[2][4], yb[2][4]; float wa[2], wb[2];
#pragma unroll
            for (int r = 0; r < 2; ++r) {
                const int m = m0 + r; const int* ti = TINFO + (size_t)m * 8;
                const int ea = ti[0], pa = ti[1], eb = ti[2], pb = ti[3]; wa[r] = __int_as_float(ti[4]); wb[r] = __int_as_float(ti[5]);
                const bool ma = (pa >> 8) < l_pb[8 + ea], mbm = (pb >> 8) < l_pb[8 + eb];
                const size_t sa = ma ? (size_t)(l_pb[ea] + (pa >> 8)) * 256 + (pa & 255) : (size_t)l_pb[16 + ea] * 256 + (pa & 255);
                const size_t sb = mbm ? (size_t)(l_pb[eb] + (pb >> 8)) * 256 + (pb & 255) : (size_t)l_pb[16 + eb] * 256 + (pb & 255);
                const GAS f32x4* xr = (const GAS f32x4*)(HL + (size_t)m * DM) + lane;
#pragma unroll
                for (int j = 0; j < 4; ++j) hv[r][j] = xr[64 * j];
                { const GAS u32x2* yr = (const GAS u32x2*)((ma ? YB : YP) + sa * DM) + lane;
#pragma unroll
                  for (int j = 0; j < 4; ++j) { const u32x2 a = yr[64 * j]; ya[r][j] = (f32x4){__uint_as_float(a.x << 16), __uint_as_float(a.x & 0xffff0000u), __uint_as_float(a.y << 16), __uint_as_float(a.y & 0xffff0000u)}; }
                  if (!ma) for (int s2 = 1; s2 < MOE_RS; ++s2) { const GAS u32x2* y2 = (const GAS u32x2*)(YP + ((size_t)s2 * 8 * 256 + sa) * DM) + lane;
#pragma unroll
                      for (int j = 0; j < 4; ++j) { const u32x2 a = y2[64 * j]; ya[r][j] += (f32x4){__uint_as_float(a.x << 16), __uint_as_float(a.x & 0xffff0000u), __uint_as_float(a.y << 16), __uint_as_float(a.y & 0xffff0000u)}; } } }
                { const GAS u32x2* yr = (const GAS u32x2*)((mbm ? YB : YP) + sb * DM) + lane;
#pragma unroll
                  for (int j = 0; j < 4; ++j) { const u32x2 a = yr[64 * j]; yb[r][j] = (f32x4){__uint_as_float(a.x << 16), __uint_as_float(a.x & 0xffff0000u), __uint_as_float(a.y << 16), __uint_as_float(a.y & 0xffff0000u)}; }
                  if (!mbm) for (int s2 = 1; s2 < MOE_RS; ++s2) { const GAS u32x2* y2 = (const GAS u32x2*)(YP + ((size_t)s2 * 8 * 256 + sb) * DM) + lane;
#pragma unroll
                      for (int j = 0; j < 4; ++j) { const u32x2 a = y2[64 * j]; yb[r][j] += (f32x4){__uint_as_float(a.x << 16), __uint_as_float(a.x & 0xffff0000u), __uint_as_float(a.y << 16), __uint_as_float(a.y & 0xffff0000u)}; } } }
            }
            float ss[2];
#pragma unroll
            for (int r = 0; r < 2; ++r) { ss[r] = 0.f;
#pragma unroll
                for (int j = 0; j < 4; ++j) { const f32x4 gv = *(const f32x4*)(g2 + (size_t)mb * 6144 + 4 * lane + 256 * j);
                    hv[r][j] = hv[r][j] + gv * (ya[r][j] * wa[r] + yb[r][j] * wb[r]); ss[r] += (hv[r][j].x * hv[r][j].x + hv[r][j].y * hv[r][j].y) + (hv[r][j].z * hv[r][j].z + hv[r][j].w * hv[r][j].w); } }
#pragma unroll
            for (int o = 1; o < 64; o <<= 1) {
#pragma unroll
                for (int r = 0; r < 2; ++r) ss[r] += __shfl_xor(ss[r], o); }
#pragma unroll
            for (int r = 0; r < 2; ++r) { const float rstd = 1.0f / __builtin_sqrtf(ss[r] * (1.0f / DM) + EPS);
                GAS f32x4* orow = (GAS f32x4*)(args.out + (size_t)(m0 + r) * DM) + lane;
#pragma unroll
                for (int j = 0; j < 4; ++j) { const f32x4 fg = *(const f32x4*)(I_FINALG + 4 * lane + 256 * j); __builtin_nontemporal_store((hv[r][j] * rstd) * fg, orow + 64 * j); } }
        }
    }
    PROBE_MARK(23);
#if defined(PROBE_LO)
    { PHASE_IDS(); const float T = (float)(tpB - tpA) * 0.01f; const float cval = __builtin_sqrtf(T / (float)(PROBE_UNIT));
      for (int m = gw; m < NLAT; m += NGW) { GAS f32x4* orow = (GAS f32x4*)(args.out + (size_t)m * DM) + lane;
#pragma unroll
        for (int j = 0; j < 4; ++j) orow[64 * j] = (f32x4){cval, cval, cval, cval}; } }
#endif
#undef IN
#undef BOTH
#undef GRID_BAR
}

#ifndef MK_ONE_LAUNCH
#define MK_ONE_LAUNCH 1
#endif
extern "C" void kernel_launch(void* const* d_in, const int* in_sizes, int n_in, void* d_out, int out_size, void* d_ws, size_t ws_size, hipStream_t stream) {
    static int grid = 0;
    if (grid == 0) {
        if (n_in != 24 || out_size != NLAT * DM || ws_size < WS_END) { fprintf(stderr, "kernel_launch: unexpected problem (n_in %d, out %d, ws %zu < %zu)\n", n_in, out_size, ws_size, (size_t)WS_END); grid = -1; return; }
        int dev = 0, cus = 0, per_cu = 0;
        if (hipGetDevice(&dev) != hipSuccess || hipDeviceGetAttribute(&cus, hipDeviceAttributeMultiprocessorCount, dev) != hipSuccess) { grid = -1; return; }
        if (hipFuncSetAttribute((const void*)fwd, hipFuncAttributeMaxDynamicSharedMemorySize, LDS_BYTES) != hipSuccess) { fprintf(stderr, "kernel_launch: hipFuncSetAttribute failed\n"); grid = -1; return; }
        if (hipOccupancyMaxActiveBlocksPerMultiprocessor(&per_cu, (const void*)fwd, 512, LDS_BYTES) != hipSuccess || per_cu < 1) fprintf(stderr, "kernel_launch: occupancy query says %d\n", per_cu);
        (void)hipGetLastError();
        grid = cus;
    }
    if (grid < 0) return;
    if (hipMemsetAsync((char*)d_ws + WS_CTL, 0, CTL_ZERO_BYTES, stream) != hipSuccess) return;
    Args a{};
    for (int i = 0; i < 24; ++i) a.in[i] = (const float*)d_in[i];
    a.out = (float*)d_out; a.ws = (unsigned char*)d_ws;
#if defined(SPLITAT)
    a.ph_lo = 0; a.ph_hi = SPLITAT; a.li = 0;
    hipLaunchKernelGGL(fwd, dim3(grid), dim3(512), LDS_BYTES, stream, a);
    a.ph_lo = SPLITAT; a.ph_hi = NPH; a.li = 1;
    hipLaunchKernelGGL(fwd, dim3(grid), dim3(512), LDS_BYTES, stream, a);
#elif defined(DUPK)
    a.ph_lo = 0; a.ph_hi = DUPK + 1; a.li = 0;
    hipLaunchKernelGGL(fwd, dim3(grid), dim3(512), LDS_BYTES, stream, a);
#ifdef DUPN
    for (int rep = 0; rep < DUPN; ++rep) { a.ph_lo = DUPK; a.ph_hi = DUPK + 1; a.li = 2; hipLaunchKernelGGL(fwd, dim3(grid), dim3(512), LDS_BYTES, stream, a); }
#endif
    a.ph_lo = DUPK; a.ph_hi = NPH; a.li = 1;
    hipLaunchKernelGGL(fwd, dim3(grid), dim3(512), LDS_BYTES, stream, a);
#elif MK_ONE_LAUNCH
    a.ph_lo = 0; a.ph_hi = NPH;
    hipLaunchKernelGGL(fwd, dim3(grid), dim3(512), LDS_BYTES, stream, a);
#else
    for (int p = 0; p < NPH; ++p) { a.ph_lo = p; a.ph_hi = p + 1; hipLaunchKernelGGL(fwd, dim3(grid), dim3(512), LDS_BYTES, stream, a); }
#endif
}
```

```cpp
#include <hip/hip_runtime.h>
#include <hip/hip_bf16.h>
#include <cstdio>
#include <cstdint>
#include <cmath>

constexpr int DM = 1024, NB = 4, SEQ = 8192, LCTX = 256, NLAT = NB * SEQ, NCTXR = NB * LCTX, MALL = NLAT + NCTXR;
constexpr int DFF = 3584, NEXP = 8, NQKV = 1536;
constexpr int NPL = NLAT / 256, NPA = MALL / 256;
constexpr float EPS = 1e-6f;
constexpr int MOE_CH = 64, MOE_NCH = 4;
constexpr float MOE_SGU = 32.0f, MOE_SD = 64.0f;
constexpr int MOE_RS = 7, P3_NS = 8, P5_NS = 14;

#define LAS __attribute__((address_space(3)))
#define GAS __attribute__((address_space(1)))
typedef unsigned short bf16_t;
typedef short bf16x8 __attribute__((ext_vector_type(8)));
typedef float f32x4 __attribute__((ext_vector_type(4)));
typedef float f32x2 __attribute__((ext_vector_type(2)));
typedef float f32x16 __attribute__((ext_vector_type(16)));
typedef unsigned u32x4 __attribute__((ext_vector_type(4)));
typedef unsigned u32x2 __attribute__((ext_vector_type(2)));
typedef __bf16 bf16x2_t __attribute__((ext_vector_type(2)));
typedef GAS unsigned gu32;

__device__ __forceinline__ unsigned pkbf(float lo, float hi) { f32x2 v = {lo, hi}; bf16x2_t b = __builtin_convertvector(v, bf16x2_t); return __builtin_bit_cast(unsigned, b); }
__device__ __forceinline__ unsigned pk4f8(float a, float b, float c, float d) { unsigned w = 0; w = __builtin_amdgcn_cvt_pk_fp8_f32(a, b, w, false); w = __builtin_amdgcn_cvt_pk_fp8_f32(c, d, w, true); return w; }
__device__ __forceinline__ float bf2f(unsigned short h) { return __builtin_bit_cast(float, (unsigned)h << 16); }
__device__ __forceinline__ float wave_sum(float v) {
#pragma unroll
    for (int o = 1; o < 64; o <<= 1) v += __shfl_xor(v, o);
    return v;
}
__device__ __forceinline__ float gelu_tanh(float x) {
    const float t = x * (1.0f + 0.044715f * x * x);
    const float e = __builtin_amdgcn_exp2f(-2.302208198f * t);
    return x * __builtin_amdgcn_rcpf(1.0f + e);
}
__device__ __forceinline__ float silu_f(float x) { return x * __builtin_amdgcn_rcpf(1.0f + __builtin_amdgcn_exp2f(-1.4426950409f * x)); }

constexpr size_t MiB = 1u << 20;
constexpr size_t WS_CTL = 0, CTL_ZERO_BYTES = 1 * MiB;
constexpr size_t WS_MOD = 1 * MiB;
constexpr size_t WS_ROPE = 1 * MiB + 256 * 1024;
constexpr size_t WS_STATS = 2 * MiB;
constexpr size_t WS_LIST = 5 * MiB;
constexpr size_t WS_TINFO = 6 * MiB;
constexpr size_t WS_WS = 7 * MiB;
constexpr size_t WS_WIN = 8 * MiB, WS_WAO = 12 * MiB, WS_WQKV = 14 * MiB, WS_WBO = 17 * MiB, WS_WGU = 19 * MiB, WS_WD = 33 * MiB;
constexpr size_t WS_MGU = 40 * MiB, WS_MD = 96 * MiB;
constexpr size_t WS_HLB = 124 * MiB;
constexpr size_t WS_XN = 208 * MiB;
constexpr size_t WS_ZB = 274 * MiB;
constexpr size_t WS_R = 278 * MiB;
constexpr size_t WS_UVT = WS_R, WS_A2 = WS_R + 132 * MiB, WS_PART1 = WS_R + 198 * MiB, WS_H = WS_R, WS_PART2 = WS_R + 231 * MiB;
constexpr size_t WS_QKV = WS_R, WS_O = WS_R + 99 * MiB;
constexpr size_t WS_Y = WS_R, WS_YP = WS_R + 128 * MiB, WS_HC = WS_R + 156 * MiB;
constexpr size_t WS_END = WS_R + 287 * MiB;
static_assert(WS_UVT + (size_t)2048 * MALL * 2 <= WS_A2 && WS_A2 + (size_t)MALL * DM * 2 <= WS_PART1 && WS_PART1 + (size_t)P3_NS * NCTXR * DM * 4 <= WS_END, "layer-0 mixer map");
static_assert(WS_H + (size_t)MALL * DFF * 2 <= WS_PART2 && WS_PART2 + (size_t)P5_NS * NCTXR * DM * 4 <= WS_END && WS_QKV + (size_t)MALL * NQKV * 2 <= WS_O && WS_O + (size_t)NLAT * DM * 2 <= WS_END, "region map");
static_assert(WS_Y + (size_t)256 * 256 * DM * 2 <= WS_YP && WS_YP + (size_t)MOE_RS * 8 * 256 * DM * 2 <= WS_HC && WS_HC + (size_t)MOE_CH * 256 * DFF <= WS_END, "MoE map");
static_assert(WS_MD + (size_t)8 * DM * DFF <= WS_HLB && WS_HLB + (size_t)NLAT * DM * 2 <= WS_XN && WS_XN + (size_t)MALL * DM * 2 <= WS_ZB && WS_MD + (size_t)8 * DM * DFF <= WS_XN && WS_MGU + (size_t)8 * 7168 * DM <= WS_MD, "weights map");
constexpr int CW_TMO = 0, CW_CODE = 1;
constexpr int CW_CNT = 64;
constexpr int CW_BAR = 4096;

constexpr int RING_BYTES = 131072;
constexpr int GTAB_OFF = RING_BYTES;
constexpr int MOE_OFF = RING_BYTES + 1024;
constexpr int MISC_OFF = RING_BYTES + 2048;
constexpr int LDS_BYTES = 147456;

namespace pg8 {
constexpr int BM = 256, BK = 64, HALF = 128, HTB = HALF * BK * 2, STAGE_BYTES = 8 * HTB, NXCD = 8, WGM = 8;
__host__ __device__ __forceinline__ int lds_byte(int r, int c) { const int st = (r >> 4) * 2 + (c >> 5), rr = r & 15, cc = c & 31, ob = rr * 64 + cc * 2; return st * 1024 + (ob ^ (((ob >> 9) & 1) << 5)); }
__host__ __device__ __forceinline__ void stage_rc(int b, int& R, int& C) { const int st = b / 1024, sb = b % 1024, swz = sb ^ (((sb >> 9) & 1) << 5); R = (st >> 1) * 16 + swz / 64; C = (st & 1) * 32 + (swz % 64) / 2; }
__host__ __device__ __forceinline__ int perm32(int rho) { const int n = rho >> 4, i = rho & 15; return 8 * (i >> 2) + 4 * n + (i & 3); }

struct Unit { const char* a; const char* b; const int* gl; int pm, pn, om, nv, ks; };

__device__ __forceinline__ bool tile_order(int i, int G, int c, int nM, int nN, int& pm, int& pn) {
    const int nwg = nM * nN; const long L = (long)i * G + c; if (L >= nwg) return false;
    int wgid = (int)L; { const int q = nwg / NXCD, r = nwg % NXCD, xcd = wgid % NXCD, off = wgid / NXCD; wgid = (xcd < r ? xcd * (q + 1) : r * (q + 1) + (xcd - r) * q) + off; }
    const int nig = WGM * nN, gid = wgid / nig, fm = gid * WGM, gsz = (nM - fm) < WGM ? (nM - fm) : WGM;
    pm = fm + ((wgid % nig) % gsz); pn = (wgid % nig) / gsz; return true;
}
struct DenseSched {
    const char* A; const char* B; int nM, nN, G, c; size_t tstep;
    __device__ __forceinline__ bool next(int i, Unit& u) const {
        int pm, pn; if (!tile_order(i, G, c, nM, nN, pm, pn)) return false;
        u.a = A + (size_t)pm * tstep; u.b = B + (size_t)pn * tstep; u.gl = nullptr; u.pm = pm; u.pn = pn; u.om = pm; u.nv = 256; u.ks = 0; return true;
    }
};
typedef int v8i_t __attribute__((ext_vector_type(8)));
typedef int v4i_t __attribute__((ext_vector_type(4)));
__device__ __forceinline__ v8i_t cat8(bf16x8 lo, bf16x8 hi) { const v4i_t a = __builtin_bit_cast(v4i_t, lo), b = __builtin_bit_cast(v4i_t, hi); return __builtin_shufflevector(a, b, 0, 1, 2, 3, 4, 5, 6, 7); }
struct SplitSched {
    const char* A; const char* B; int nM, nN, nS, G, c, pm0; size_t tstep, kbytes;
    __device__ __forceinline__ bool next(int i, Unit& u) const {
        const int L = i * G + c; if (L >= nM * nN * nS) return false;
        const int ks = L % nS, t = L / nS, pn = t % nN, pm = t / nN;
        u.a = A + (size_t)pm * tstep + (size_t)ks * kbytes; u.b = B + (size_t)pn * tstep + (size_t)ks * kbytes; u.gl = nullptr; u.pm = pm0 + pm; u.pn = pn; u.om = pm; u.nv = 256; u.ks = ks; return true;
    }
};
struct MoeSched {
    const char* A; const char* B; const int* list; const LAS int* tab; int gp0, gp1, nN, nS, G, c, mode; size_t bexp, btile, astep, kbytes; bool gather;
    __device__ __forceinline__ bool next(int i, Unit& u) const {
        int pm, pn, ks = 0;
        if (mode == 0) { if (gp1 <= gp0) return false; if (!tile_order(i, G, c, gp1 - gp0, nN, pm, pn)) return false; }
        else { const int R = __builtin_amdgcn_readfirstlane(tab[32]); const int L = i * G + c; if (L >= R * nN * nS) return false; ks = L % nS; const int t = L / nS; pn = t % nN; pm = t / nN; }
        int e = 0, lp, nv;
        if (mode == 0) { const int gp = gp0 + pm;
#pragma unroll
            for (int k = 1; k < 8; ++k) e += (gp >= __builtin_amdgcn_readfirstlane(tab[k])) ? 1 : 0;
            lp = gp - __builtin_amdgcn_readfirstlane(tab[e]); nv = 256; u.pm = gp; }
        else { e = __builtin_amdgcn_readfirstlane(tab[24 + pm]); const int ce = __builtin_amdgcn_readfirstlane(tab[16 + e]); lp = ce >> 8; nv = ce & 255; u.pm = pm; }
        u.b = B + (size_t)e * bexp + (size_t)pn * btile + (size_t)ks * kbytes; u.pn = pn; u.nv = nv; u.ks = ks; u.om = pm;
        if (gather) { u.a = A; u.gl = list + (size_t)e * NLAT + 256 * lp; }
        else { u.a = A + (size_t)pm * astep + (size_t)ks * kbytes; u.gl = nullptr; if (mode == 0) u.om = gp0 + pm; }
        return true;
    }
};

struct EpiGeluT {
    static constexpr bool PERM = true;
    bf16_t* O; float* stats;
    __device__ __forceinline__ void operator()(const f32x4 (&acc)[2][2][4][2], const Unit& u, int wr, int wc, int fr, int fq) const {
        const int row0 = u.pm * BM + wr * 64 + fr, col0 = u.pn * BM + wc * 32 + 8 * fq;
        const bool isv = u.pm >= 4;
        float s1[2][2][4], s2[2][2][4];
#pragma unroll
        for (int bj = 0; bj < 2; ++bj)
#pragma unroll
            for (int n = 0; n < 2; ++n)
#pragma unroll
                for (int e = 0; e < 4; ++e) { s1[bj][n][e] = 0.f; s2[bj][n][e] = 0.f; }
#pragma unroll
        for (int ai = 0; ai < 2; ++ai)
#pragma unroll
            for (int m = 0; m < 4; ++m) { bf16_t* rowp = O + (size_t)(row0 + ai * HALF + m * 16) * MALL + col0;
#pragma unroll
                for (int bj = 0; bj < 2; ++bj) { f32x4 v0 = acc[ai][bj][m][0], v1 = acc[ai][bj][m][1];
#pragma unroll
                    for (int e = 0; e < 4; ++e) { v0[e] = gelu_tanh(v0[e]); v1[e] = gelu_tanh(v1[e]); s1[bj][0][e] += v0[e]; s2[bj][0][e] += v0[e] * v0[e]; s1[bj][1][e] += v1[e]; s2[bj][1][e] += v1[e] * v1[e]; }
                    u32x4 w; w.x = pkbf(v0[0], v0[1]); w.y = pkbf(v0[2], v0[3]); w.z = pkbf(v1[0], v1[1]); w.w = pkbf(v1[2], v1[3]);
                    *(u32x4*)(rowp + bj * HALF) = w; } }
        if (isv) {
            const int slot = (u.pm - 4) * 2 + wr;
#pragma unroll
            for (int bj = 0; bj < 2; ++bj)
#pragma unroll
                for (int n = 0; n < 2; ++n)
#pragma unroll
                    for (int e = 0; e < 4; ++e) { float a = s1[bj][n][e], b = s2[bj][n][e];
#pragma unroll
                        for (int o = 1; o < 16; o <<= 1) { a += __shfl_xor(a, o); b += __shfl_xor(b, o); }
                        if (fr == 0) { const int tok = col0 + bj * HALF + 4 * n + e; *(f32x2*)(stats + (size_t)tok * 16 + slot * 2) = (f32x2){a, b}; } }
        }
    }
};
template <bool BASE_F32> struct EpiResid {
    static constexpr bool PERM = true;
    const float* basef; const bf16_t* baseb; bf16_t* out; const float* gate;
    __device__ __forceinline__ void operator()(const f32x4 (&acc)[2][2][4][2], const Unit& u, int wr, int wc, int fr, int fq) const {
        const int mb = u.pm >> 5; const int col0 = u.pn * BM + wc * 32 + 8 * fq;
        f32x4 gv[2][2];
#pragma unroll
        for (int bj = 0; bj < 2; ++bj)
#pragma unroll
            for (int n = 0; n < 2; ++n) gv[bj][n] = *(const f32x4*)(gate + (size_t)mb * 6144 + col0 + bj * HALF + n * 4);
#pragma unroll
        for (int ai = 0; ai < 2; ++ai)
#pragma unroll
            for (int m = 0; m < 4; ++m) { const size_t off = (size_t)(u.pm * BM + wr * 64 + fr + ai * HALF + m * 16) * DM + col0;
#pragma unroll
                for (int bj = 0; bj < 2; ++bj) { f32x4 b0, b1;
                    if constexpr (BASE_F32) { b0 = *(const f32x4*)(basef + off + bj * HALF); b1 = *(const f32x4*)(basef + off + bj * HALF + 4); }
                    else { const u32x4 w = *(const u32x4*)(baseb + off + bj * HALF);
                        b0 = (f32x4){__uint_as_float(w.x << 16), __uint_as_float(w.x & 0xffff0000u), __uint_as_float(w.y << 16), __uint_as_float(w.y & 0xffff0000u)};
                        b1 = (f32x4){__uint_as_float(w.z << 16), __uint_as_float(w.z & 0xffff0000u), __uint_as_float(w.w << 16), __uint_as_float(w.w & 0xffff0000u)}; }
                    const f32x4 o0 = b0 + gv[bj][0] * acc[ai][bj][m][0], o1 = b1 + gv[bj][1] * acc[ai][bj][m][1];
                    u32x4 w; w.x = pkbf(o0[0], o0[1]); w.y = pkbf(o0[2], o0[3]); w.z = pkbf(o1[0], o1[1]); w.w = pkbf(o1[2], o1[3]);
                    *(u32x4*)(out + off + bj * HALF) = w; } }
    }
};
struct EpiSwiGLU {
    static constexpr bool PERM = true;
    bf16_t* O;
    __device__ __forceinline__ void operator()(const f32x4 (&acc)[2][2][4][2], const Unit& u, int wr, int wc, int fr, int fq) const {
        bf16_t* base = O + (size_t)(u.om * BM + wr * 64 + fr) * DFF + u.pn * 128 + wc * 32 + 8 * fq;
#pragma unroll
        for (int ai = 0; ai < 2; ++ai)
#pragma unroll
            for (int m = 0; m < 4; ++m) { const f32x4 g0 = acc[ai][0][m][0], g1 = acc[ai][0][m][1], u0 = acc[ai][1][m][0], u1 = acc[ai][1][m][1];
                float o[8];
#pragma unroll
                for (int e = 0; e < 4; ++e) { o[e] = silu_f(g0[e]) * u0[e]; o[4 + e] = silu_f(g1[e]) * u1[e]; }
                u32x4 w; w.x = pkbf(o[0], o[1]); w.y = pkbf(o[2], o[3]); w.z = pkbf(o[4], o[5]); w.w = pkbf(o[6], o[7]);
                *(u32x4*)(base + (size_t)(ai * HALF + m * 16) * DFF) = w; }
    }
};
struct EpiQKV {
    static constexpr bool PERM = false;
    bf16_t* O; const float* cosT; const float* sinT; float qscale;
    __device__ __forceinline__ void operator()(const f32x4 (&acc)[2][2][4][2], const Unit& u, int wr, int wc, int fr, int fq) const {
        const bool lat = u.pm < NPL; const bool dorope = lat && u.pn < 5; const float sc = u.pn < 4 ? qscale : 1.0f;
        const int col0 = u.pn * BM + wc * 32 + 4 * fq;
#pragma unroll
        for (int ai = 0; ai < 2; ++ai)
#pragma unroll
            for (int m = 0; m < 4; ++m) { const int grow = u.pm * BM + ai * HALF + wr * 64 + m * 16 + fr; const int s = grow & (SEQ - 1); const int pos = (wc & 1) ? (s & 63) : (s >> 6);
                f32x4 cs = (f32x4){1.f, 1.f, 1.f, 1.f}, sn = (f32x4){0.f, 0.f, 0.f, 0.f};
                if (dorope) { cs = *(const f32x4*)(cosT + pos * 16 + 4 * fq); sn = *(const f32x4*)(sinT + pos * 16 + 4 * fq); }
                bf16_t* rowp = O + (size_t)grow * NQKV + col0;
#pragma unroll
                for (int bj = 0; bj < 2; ++bj) { const f32x4 x1 = acc[ai][bj][m][0], x2 = acc[ai][bj][m][1];
                    const f32x4 o1 = (x1 * cs - x2 * sn) * sc, o2 = (x1 * sn + x2 * cs) * sc;
                    u32x2 w1, w2; w1.x = pkbf(o1[0], o1[1]); w1.y = pkbf(o1[2], o1[3]); w2.x = pkbf(o2[0], o2[1]); w2.y = pkbf(o2[2], o2[3]);
                    *(u32x2*)(rowp + bj * HALF) = w1; *(u32x2*)(rowp + bj * HALF + 16) = w2; } }
    }
};
struct EpiSwiGLU8 {
    static constexpr bool PERM = true;
    unsigned char* O; float s;
    __device__ __forceinline__ void operator()(const f32x4 (&acc)[2][2][4][2], const Unit& u, int wr, int wc, int fr, int fq) const {
        unsigned char* base = O + (size_t)(u.om * BM + wr * 64 + fr) * DFF + u.pn * 128 + wc * 32 + 8 * fq;
#pragma unroll
        for (int ai = 0; ai < 2; ++ai)
#pragma unroll
            for (int m = 0; m < 4; ++m) { const f32x4 g0 = acc[ai][0][m][0] * s, g1 = acc[ai][0][m][1] * s, u0 = acc[ai][1][m][0] * s, u1 = acc[ai][1][m][1] * s;
                float o[8];
#pragma unroll
                for (int e = 0; e < 4; ++e) { o[e] = silu_f(g0[e]) * u0[e]; o[4 + e] = silu_f(g1[e]) * u1[e]; }
                u32x2 w; w.x = pk4f8(o[0], o[1], o[2], o[3]); w.y = pk4f8(o[4], o[5], o[6], o[7]);
                *(u32x2*)(base + (size_t)(ai * HALF + m * 16) * DFF) = w; }
    }
};
struct EpiBf16Plain {
    static constexpr bool PERM = true;
    bf16_t* O; int ldc; float s;
    __device__ __forceinline__ void operator()(const f32x4 (&acc)[2][2][4][2], const Unit& u, int wr, int wc, int fr, int fq) const {
        bf16_t* base = O + (size_t)(u.om * BM + wr * 64 + fr) * ldc + u.pn * BM + wc * 32 + 8 * fq;
#pragma unroll
        for (int ai = 0; ai < 2; ++ai)
#pragma unroll
            for (int m = 0; m < 4; ++m)
#pragma unroll
                for (int bj = 0; bj < 2; ++bj) { const f32x4 v0 = acc[ai][bj][m][0] * s, v1 = acc[ai][bj][m][1] * s;
                    u32x4 w; w.x = pkbf(v0[0], v0[1]); w.y = pkbf(v0[2], v0[3]); w.z = pkbf(v1[0], v1[1]); w.w = pkbf(v1[2], v1[3]);
                    *(u32x4*)(base + (size_t)(ai * HALF + m * 16) * ldc + bj * HALF) = w; }
    }
};

struct EpiPartF32 {
    static constexpr bool PERM = true;
    float* P; size_t sstride;
    __device__ __forceinline__ void operator()(const f32x4 (&acc)[2][2][4][2], const Unit& u, int wr, int wc, int fr, int fq) const {
        float* base = P + (size_t)u.ks * sstride + (size_t)(u.om * BM + wr * 64 + fr) * DM + u.pn * BM + wc * 32 + 8 * fq;
#pragma unroll
        for (int ai = 0; ai < 2; ++ai)
#pragma unroll
            for (int m = 0; m < 4; ++m)
#pragma unroll
                for (int bj = 0; bj < 2; ++bj)
#pragma unroll
                    for (int n = 0; n < 2; ++n) *(f32x4*)(base + (size_t)(ai * HALF + m * 16) * DM + bj * HALF + n * 4) = acc[ai][bj][m][n];
    }
};
struct EpiPartBf16 {
    static constexpr bool PERM = true;
    bf16_t* P; size_t sstride; float s;
    __device__ __forceinline__ void operator()(const f32x4 (&acc)[2][2][4][2], const Unit& u, int wr, int wc, int fr, int fq) const {
        bf16_t* base = P + (size_t)u.ks * sstride + (size_t)(u.om * BM + wr * 64 + fr) * DM + u.pn * BM + wc * 32 + 8 * fq;
#pragma unroll
        for (int ai = 0; ai < 2; ++ai)
#pragma unroll
            for (int m = 0; m < 4; ++m)
#pragma unroll
                for (int bj = 0; bj < 2; ++bj) { const f32x4 v0 = acc[ai][bj][m][0] * s, v1 = acc[ai][bj][m][1] * s;
                    u32x4 w; w.x = pkbf(v0[0], v0[1]); w.y = pkbf(v0[2], v0[3]); w.z = pkbf(v1[0], v1[1]); w.w = pkbf(v1[2], v1[3]);
                    *(u32x4*)(base + (size_t)(ai * HALF + m * 16) * DM + bj * HALF) = w; }
    }
};

template <class Epi, class Sched, bool ALIGN_EPI, bool GATHER, bool FP8 = false>
__device__ __forceinline__ void gemm_phase(LAS unsigned char* lds, LAS int* gtab, const int K  , const int nt_in  , const Sched& S, const Epi& E) {
    int nt = nt_in; asm volatile("" : "+s"(nt));
    int tid_ = threadIdx.x; asm volatile("" : "+v"(tid_));
    const int tid = tid_, wid = __builtin_amdgcn_readfirstlane(tid >> 6), lane = tid & 63, wr = wid >> 2, wc = wid & 3, fr = lane & 15, fq = lane >> 4;
    const size_t kstep = (size_t)(BK * 2);
    const size_t hstep = (size_t)HALF * K * 2;
    unsigned voffB[2];
#pragma unroll
    for (int i = 0; i < 2; ++i) { int R, C; stage_rc(tid * 16 + i * 8192, R, C); const int Rb = Epi::PERM ? ((R & ~31) + perm32(R & 31)) : R;
        voffB[i] = (unsigned)(Rb * K + C) * 2u; }
    unsigned vA[2][2], vN[2][2];
    const unsigned ldsw = (unsigned)wid * 1024u;
    const int aoff = lds_byte(wr * 64 + fr, fq * 8), boff = lds_byte(wc * 32 + fr, fq * 8);
    const LAS unsigned char* aB = lds + aoff; const LAS unsigned char* bB = lds + 65536 + boff;
    asm volatile("" : "+v"(aB), "+v"(bB));
#define PG8_SA(b, h) (((b) * 2 + (h)) * HTB)
#define PG8_SB(b, h) ((4 + (b) * 2 + (h)) * HTB)
#define PG8_STAGE(bufoff, gbase, voff) do { _Pragma("unroll") for (int _i = 0; _i < 2; ++_i) \
        __builtin_amdgcn_global_load_lds((const unsigned*)((const char*)(gbase) + (voff)[_i]), (LAS unsigned*)(lds + (bufoff) + ldsw + _i * 8192), 16, 0, 0); } while (0)
#define PG8_LDA(dst, b, h) do { _Pragma("unroll") for (int m = 0; m < 4; ++m) { if constexpr (FP8) dst##8[m] = cat8(*(const LAS bf16x8*)(aB + PG8_SA(b, h) + m * 2048), *(const LAS bf16x8*)(aB + PG8_SA(b, h) + m * 2048 + 1024)); \
        else { _Pragma("unroll") for (int k = 0; k < 2; ++k) dst[m][k] = *(const LAS bf16x8*)(aB + PG8_SA(b, h) + m * 2048 + k * 1024); } } } while (0)
#define PG8_LDB(dst, b, h) do { _Pragma("unroll") for (int n = 0; n < 2; ++n) { if constexpr (FP8) dst##8[n] = cat8(*(const LAS bf16x8*)(bB + (PG8_SB(b, h) - 65536) + n * 2048), *(const LAS bf16x8*)(bB + (PG8_SB(b, h) - 65536) + n * 2048 + 1024)); \
        else { _Pragma("unroll") for (int k = 0; k < 2; ++k) dst[n][k] = *(const LAS bf16x8*)(bB + (PG8_SB(b, h) - 65536) + n * 2048 + k * 1024); } } } while (0)
#define PG8_MMA(ai, bj, At, Bt) do { __builtin_amdgcn_s_setprio(1); \
    if constexpr (FP8) { _Pragma("unroll") for (int m = 0; m < 4; ++m) _Pragma("unroll") for (int n = 0; n < 2; ++n) \
        asm volatile("v_mfma_f32_16x16x128_f8f6f4 %0, %1, %2, %0" : "+v"(acc[ai][bj][m][n]) : "v"(Bt##8[n]), "v"(At##8[m])); } \
    else { _Pragma("unroll") for (int m = 0; m < 4; ++m) _Pragma("unroll") for (int n = 0; n < 2; ++n) _Pragma("unroll") for (int k = 0; k < 2; ++k) \
        acc[ai][bj][m][n] = __builtin_amdgcn_mfma_f32_16x16x32_bf16(Bt[n][k], At[m][k], acc[ai][bj][m][n], 0, 0, 0); } \
    __builtin_amdgcn_s_setprio(0); } while (0)
#define PG8_WAIT_V(n) asm volatile("s_waitcnt vmcnt(" #n ")" ::: "memory")
#define PG8_WAIT_L(n) asm volatile("s_waitcnt lgkmcnt(" #n ")" ::: "memory")
#define PG8_BAR __builtin_amdgcn_s_barrier()
#define PG8_SCHED __builtin_amdgcn_sched_barrier(0)
    Unit cur, nxt; int ui = 0;
    if (!S.next(0, cur)) return;
    f32x4 acc[2][2][4][2];
#pragma unroll
    for (int a = 0; a < 2; ++a)
#pragma unroll
        for (int b = 0; b < 2; ++b)
#pragma unroll
            for (int m = 0; m < 4; ++m)
#pragma unroll
                for (int n = 0; n < 2; ++n) acc[a][b][m][n] = (f32x4){0.f, 0.f, 0.f, 0.f};
    bf16x8 At[4][2], B0[2][2], B1[2][2]; v8i_t At8[4], B08[2], B18[2];
    if constexpr (GATHER) {
#pragma unroll
        for (int h = 0; h < 2; ++h)
#pragma unroll
            for (int i = 0; i < 2; ++i) { int R, C; stage_rc(tid * 16 + i * 8192, R, C); const int row = h * HALF + R; const int tok = cur.gl[row < cur.nv ? row : 0]; vA[h][i] = (unsigned)tok * (unsigned)(K * 2) + (unsigned)C * 2u; }
    } else {
#pragma unroll
        for (int h = 0; h < 2; ++h)
#pragma unroll
            for (int i = 0; i < 2; ++i) { int R, C; stage_rc(tid * 16 + i * 8192, R, C); vA[h][i] = (unsigned)(R * K + C) * 2u + (unsigned)(h * hstep); }
    }
#pragma unroll
    for (int h = 0; h < 2; ++h)
#pragma unroll
        for (int i = 0; i < 2; ++i) vN[h][i] = vA[h][i];
    const char* cA = cur.a; const char* cB = cur.b;
    PG8_STAGE(PG8_SB(0, 0), cB, voffB); PG8_STAGE(PG8_SB(0, 1), cB + hstep, voffB); PG8_STAGE(PG8_SA(0, 0), cA, vA[0]); PG8_STAGE(PG8_SA(0, 1), cA, vA[1]);
    if (wr == 1) PG8_BAR;
    PG8_WAIT_V(2); PG8_BAR;
    PG8_STAGE(PG8_SB(1, 0), cB + kstep, voffB); PG8_STAGE(PG8_SA(1, 0), cA + kstep, vA[0]); PG8_STAGE(PG8_SB(1, 1), cB + hstep + kstep, voffB);
    PG8_WAIT_V(6); PG8_BAR;
    for (;;) {
        const bool has_next = S.next(ui + 1, nxt);
        const char* nA = has_next ? nxt.a : cA; const char* nB = has_next ? nxt.b : cB;
        if constexpr (GATHER) {
            if (has_next && wid < 4) __builtin_amdgcn_global_load_lds((const unsigned*)(nxt.gl + wid * 64 + lane), (LAS unsigned*)(gtab + wid * 64), 4, 0, 0);
        }
        for (int t = 0; t < nt; t += 2) {
            const bool last = (t == nt - 2);
            const char* a1 = cA + (size_t)(t + 1) * kstep;
            const char* a2 = last ? nA : cA + (size_t)(t + 2) * kstep; const char* b2 = last ? nB : cB + (size_t)(t + 2) * kstep;
            const char* a3 = a2 + kstep; const char* b3 = b2 + kstep;
            if constexpr (GATHER) {
                if (last && has_next) {
                    int t2 = tid; asm volatile("" : "+v"(t2));
#pragma unroll
                    for (int h = 0; h < 2; ++h)
#pragma unroll
                        for (int i = 0; i < 2; ++i) { int R, C; stage_rc(t2 * 16 + i * 8192, R, C); const int row = h * HALF + R; const int tok = gtab[row < nxt.nv ? row : 0]; vN[h][i] = (unsigned)tok * (unsigned)(K * 2) + (unsigned)C * 2u; }
                }
            }
            unsigned vS0[2], vS1[2];
#pragma unroll
            for (int i = 0; i < 2; ++i) { vS0[i] = (GATHER && last) ? vN[0][i] : vA[0][i]; vS1[i] = (GATHER && last) ? vN[1][i] : vA[1][i]; }
            PG8_LDB(B0, 0, 0); PG8_LDB(B1, 0, 1); PG8_SCHED; PG8_LDA(At, 0, 0); PG8_STAGE(PG8_SA(1, 1), a1, vA[1]);
            PG8_WAIT_V(8); PG8_WAIT_L(0); PG8_BAR; PG8_MMA(0, 0, At, B0); PG8_MMA(0, 1, At, B1); PG8_BAR; PG8_SCHED;
            PG8_LDA(At, 0, 1); PG8_STAGE(PG8_SB(0, 0), b2, voffB); PG8_STAGE(PG8_SB(0, 1), b2 + hstep, voffB); PG8_STAGE(PG8_SA(0, 0), a2, vS0);
            PG8_WAIT_V(8); PG8_WAIT_L(0); PG8_BAR; PG8_MMA(1, 0, At, B0); PG8_MMA(1, 1, At, B1); PG8_BAR; PG8_SCHED;
            PG8_LDB(B0, 1, 0); PG8_LDB(B1, 1, 1); PG8_SCHED; PG8_LDA(At, 1, 0); PG8_STAGE(PG8_SA(0, 1), a2, vS1);
            PG8_WAIT_V(8); PG8_WAIT_L(0); PG8_BAR; PG8_MMA(0, 0, At, B0); PG8_MMA(0, 1, At, B1); PG8_BAR; PG8_SCHED;
            PG8_LDA(At, 1, 1); PG8_STAGE(PG8_SB(1, 0), b3, voffB); PG8_STAGE(PG8_SB(1, 1), b3 + hstep, voffB); PG8_STAGE(PG8_SA(1, 0), a3, vS0);
            PG8_WAIT_V(8); PG8_WAIT_L(0); PG8_BAR; PG8_MMA(1, 0, At, B0); PG8_MMA(1, 1, At, B1); PG8_BAR; PG8_SCHED;
        }
        if constexpr (ALIGN_EPI) { if (wr == 0) PG8_BAR; }
        if constexpr (FP8) asm volatile("s_nop 15\n\ts_nop 15" ::: "memory");
        E(acc, cur, wr, wc, fr, fq);
        if (!has_next) break;
#pragma unroll
        for (int a = 0; a < 2; ++a)
#pragma unroll
            for (int b = 0; b < 2; ++b)
#pragma unroll
                for (int m = 0; m < 4; ++m)
#pragma unroll
                    for (int n = 0; n < 2; ++n) acc[a][b][m][n] = (f32x4){0.f, 0.f, 0.f, 0.f};
        cur = nxt; cA = nA; cB = nB; ++ui;
        if constexpr (GATHER) {
#pragma unroll
            for (int h = 0; h < 2; ++h)
#pragma unroll
                for (int i = 0; i < 2; ++i) vA[h][i] = vN[h][i];
        }
        if constexpr (ALIGN_EPI) { if (wr == 1) PG8_BAR; }
    }
    PG8_WAIT_V(0);
    if constexpr (!ALIGN_EPI) { if (wr == 0) PG8_BAR; }
    PG8_BAR;
#undef PG8_SA
#undef PG8_SB
#undef PG8_STAGE
#undef PG8_LDA
#undef PG8_LDB
#undef PG8_MMA
#undef PG8_WAIT_V
#undef PG8_WAIT_L
#undef PG8_BAR
#undef PG8_SCHED
}
}

namespace attn_body {
using bf16 = __hip_bfloat16;
using s16x4 = __attribute__((ext_vector_type(4))) short;
constexpr int D = 64, PITCH = NQKV, OPITCH = DM;
constexpr int NW = 8, QBLK = 32, KVBLK = 64;
__device__ __forceinline__ int crow(int r, int hi) { return (r & 3) + 8 * (r >> 2) + 4 * hi; }
#define SBAR() __builtin_amdgcn_sched_barrier(0)
__device__ __forceinline__ void bmask(f32x16& p0, f32x16& p1, int kb, int qrel, int hi) {
    const float NEG = -INFINITY; const int d0 = kb + 4 * hi - qrel;
#pragma unroll
    for (int r = 0; r < 16; ++r) { const int d = d0 + (r & 3) + 8 * (r >> 2); if (d < -128 || d > 128) p0[r] = NEG; if (d + 32 < -128 || d + 32 > 128) p1[r] = NEG; }
}
constexpr int NSLOT = 3, SLOTB = 8192;
constexpr int LDS_K = 0, LDS_V = NSLOT * SLOTB, LDS_WS = 2 * NSLOT * SLOTB, LDS_OST = LDS_WS + NW * 64 * 4, LDS_BYTES_A = LDS_OST + NW * 4096;
constexpr float C2 = 0.125f * 1.4426950408889634f;
__device__ __forceinline__ void glds16(const void* gsrc, unsigned lds_dst) { unsigned keep;
    asm volatile("s_mov_b32 %0, m0\n\ts_mov_b32 m0, %2\n\ts_nop 0\n\tglobal_load_lds_dwordx4 %1, off\n\ts_mov_b32 m0, %0" : "=&s"(keep) : "v"(gsrc), "s"(lds_dst) : "memory"); }
__device__ __forceinline__ float max3f(float a, float b, float c) { float r; asm("v_max3_f32 %0, %1, %2, %3" : "=v"(r) : "v"(a), "v"(b), "v"(c)); return r; }
__device__ __forceinline__ float max2f(float a, float b) { float r; asm("v_max_f32_e32 %0, %1, %2" : "=v"(r) : "v"(a), "v"(b)); return r; }
__device__ __forceinline__ float fadd_s(float a, float b) { float r; asm("v_add_f32_e32 %0, %1, %2" : "=v"(r) : "v"(a), "v"(b)); return r; }
__device__ __forceinline__ float fsub_s(float a, float b) { float r; asm("v_sub_f32_e32 %0, %1, %2" : "=v"(r) : "v"(a), "v"(b)); return r; }
__device__ __forceinline__ unsigned cvtpk_s(float lo, float hi) { f32x2 v = {lo, hi}; bf16x2_t b = __builtin_convertvector(v, bf16x2_t); return __builtin_bit_cast(unsigned, b); }
#define WAIT_BAR(N) asm volatile("s_waitcnt vmcnt(" #N ") lgkmcnt(0)\n\ts_barrier" ::: "memory")
__device__ __forceinline__ void qkt(f32x16& p0, f32x16& p1, const char* Kslot, const bf16x8* qr, const f32x16& negm, int r32, int hi) {
    const char* kb = Kslot + hi * 1024 + r32 * 16;
#pragma unroll
    for (int d0 = 0; d0 < 4; ++d0) {
        const bf16x8 b0 = *reinterpret_cast<const bf16x8*>(kb + d0 * 2048);
        const bf16x8 b1 = *reinterpret_cast<const bf16x8*>(kb + d0 * 2048 + 512);
        if (d0 == 0) { p0 = __builtin_amdgcn_mfma_f32_32x32x16_bf16(b0, qr[0], negm, 0, 0, 0); p1 = __builtin_amdgcn_mfma_f32_32x32x16_bf16(b1, qr[0], negm, 0, 0, 0); }
        else { p0 = __builtin_amdgcn_mfma_f32_32x32x16_bf16(b0, qr[d0], p0, 0, 0, 0); p1 = __builtin_amdgcn_mfma_f32_32x32x16_bf16(b1, qr[d0], p1, 0, 0, 0); } }
}
typedef __attribute__((address_space(3))) const char* lds_cptr;
typedef short v4i16_t __attribute__((ext_vector_type(4)));
__device__ __forceinline__ void kload8(bf16x8* kf, lds_cptr kp) {
    kf[0] = *(const __attribute__((address_space(3))) bf16x8*)(kp);        kf[1] = *(const __attribute__((address_space(3))) bf16x8*)(kp + 512);
    kf[2] = *(const __attribute__((address_space(3))) bf16x8*)(kp + 2048); kf[3] = *(const __attribute__((address_space(3))) bf16x8*)(kp + 2560);
    kf[4] = *(const __attribute__((address_space(3))) bf16x8*)(kp + 4096); kf[5] = *(const __attribute__((address_space(3))) bf16x8*)(kp + 4608);
    kf[6] = *(const __attribute__((address_space(3))) bf16x8*)(kp + 6144); kf[7] = *(const __attribute__((address_space(3))) bf16x8*)(kp + 6656);
}
__device__ __forceinline__ void kload2(bf16x8* kf, lds_cptr kp, int j) { kf[2 * j] = *(const __attribute__((address_space(3))) bf16x8*)(kp + j * 2048); kf[2 * j + 1] = *(const __attribute__((address_space(3))) bf16x8*)(kp + j * 2048 + 512); }
__device__ __forceinline__ s16x4 vtr(lds_cptr p) { return __builtin_bit_cast(s16x4, __builtin_amdgcn_ds_read_tr16_b64_v4i16((__attribute__((address_space(3))) v4i16_t*)p)); }
__device__ __forceinline__ float rowmax(const f32x16& p0, const f32x16& p1) {
    float a = max3f(p0[0], p0[1], p1[0]), b = max3f(p0[2], p0[3], p1[1]); a = max3f(a, p1[2], p1[3]);
#pragma unroll
    for (int r = 4; r < 16; r += 4) { a = max3f(a, p0[r], p0[r + 1]); b = max3f(b, p0[r + 2], p0[r + 3]); a = max3f(a, p1[r], p1[r + 1]); b = max3f(b, p1[r + 2], p1[r + 3]); }
    const float m = max2f(a, b);
    auto rr = __builtin_amdgcn_permlane32_swap(__float_as_uint(m), __float_as_uint(m), false, false);
    return max2f(__uint_as_float(rr[0]), __uint_as_float(rr[1]));
}
__device__ __forceinline__ void pv(f32x16* o, int vb, bf16x8 pa0, bf16x8 pa1, bf16x8 pa2, bf16x8 pa3) {
#pragma unroll
    for (int d0 = 0; d0 < 2; ++d0) { s16x4 lo[4], hi[4];
#pragma unroll
        for (int ks = 0; ks < 4; ++ks) {
            asm volatile("ds_read_b64_tr_b16 %0,%1 offset:%c2" : "=&v"(lo[ks]) : "v"(vb), "i"(d0 * 4096 + ks * 1024) : "memory");
            asm volatile("ds_read_b64_tr_b16 %0,%1 offset:%c2" : "=&v"(hi[ks]) : "v"(vb), "i"(d0 * 4096 + ks * 1024 + 512) : "memory"); }
        asm volatile("s_waitcnt lgkmcnt(0)" ::: "memory"); SBAR();
#define PK(k) (bf16x8){lo[k][0], lo[k][1], lo[k][2], lo[k][3], hi[k][0], hi[k][1], hi[k][2], hi[k][3]}
        o[d0] = __builtin_amdgcn_mfma_f32_32x32x16_bf16(pa0, PK(0), o[d0], 0, 0, 0);
        o[d0] = __builtin_amdgcn_mfma_f32_32x32x16_bf16(pa1, PK(1), o[d0], 0, 0, 0);
        o[d0] = __builtin_amdgcn_mfma_f32_32x32x16_bf16(pa2, PK(2), o[d0], 0, 0, 0);
        o[d0] = __builtin_amdgcn_mfma_f32_32x32x16_bf16(pa3, PK(3), o[d0], 0, 0, 0);
#undef PK
    }
}
#define ATTN_STORE16(p, v) (*(u32x4*)(p) = (v))
template <int THRL> __device__ __forceinline__ void attn_unit(int b, int hk, int n, int pr, const bf16* QKV, bf16* O, const float* sinkp, char* shm) {
    int tid_ = threadIdx.x; asm volatile("" : "+v"(tid_));
    const int tid = tid_, lane = tid & 63, r32 = lane & 31, hi = lane >> 5; const int wid = __builtin_amdgcn_readfirstlane(tid >> 6);
    const int head = 4 * hk + 2 * pr + (wid >> 2);
    const long rowblk = (long)b * SEQ + n * 128;
    const long ctxrow = (long)NLAT + b * LCTX;
    const int nlo = n > 0 ? 2 : 0, nhi = n < (SEQ / 128 - 1) ? 2 : 0;
    const int NT = 6 + nlo + nhi;
    const bf16* Qw = QKV + (rowblk + (wid & 3) * QBLK) * PITCH + head * D;
    const bf16* Kc = QKV + 1024 + hk * D; const bf16* Vc = QKV + 1280 + hk * D;
    const unsigned lds0 = (unsigned)(uintptr_t)shm;
    float* wsf = (float*)(shm + LDS_WS) + wid * 64;
    const long klane = (long)lane * PITCH + wid * 8;
    const long vlane = (long)(16 * (wid & 3) + (lane >> 2)) * PITCH + (wid >> 2) * 32 + (lane & 3) * 8;
    const unsigned kdst = lds0 + LDS_K + wid * 1024, vdst = lds0 + LDS_V + wid * 1024;
#define TROW(t) (((t) < 2) ? (rowblk + 64 * (t)) : ((t) < 6) ? (ctxrow + 64 * ((t) - 2)) : (rowblk + ((((t) - 6) < nlo) ? (-128 + 64 * ((t) - 6)) : (128 + 64 * ((t) - 6 - nlo)))))
#define TKB(t) (((t) < 6) ? 0 : ((((t) - 6) < nlo) ? (-128 + 64 * ((t) - 6)) : (128 + 64 * ((t) - 6 - nlo))))
#define DMA_K(t, slot) glds16(Kc + TROW(t) * PITCH + klane, (unsigned)__builtin_amdgcn_readfirstlane(kdst + (slot)))
#define DMA_V(t, slot) glds16(Vc + TROW(t) * PITCH + vlane, (unsigned)__builtin_amdgcn_readfirstlane(vdst + (slot)))
    const int vb0 = (int)(lds0 + LDS_V) + ((lane >> 4) & 1) * 32 + (lane & 3) * 8 + (4 * hi + ((lane & 15) >> 2)) * 64;
    const char* Kbase = shm + LDS_K; bf16x8 kf[8];
    const lds_cptr shm3 = (lds_cptr)shm; const lds_cptr kp0 = shm3 + LDS_K + hi * 1024 + r32 * 16; const lds_cptr vp0 = shm3 + LDS_V + ((lane >> 4) & 1) * 32 + (lane & 3) * 8 + (4 * hi + ((lane & 15) >> 2)) * 64;
    DMA_K(0, 0); DMA_V(0, 0); DMA_K(1, SLOTB);
    bf16x8 qr[4];
#pragma unroll
    for (int d0 = 0; d0 < 4; ++d0) qr[d0] = *reinterpret_cast<const bf16x8*>(&Qw[(long)r32 * PITCH + d0 * 16 + hi * 8]);
    float mhat = 0.f, l_reg = 0.f; f32x16 o[2]; o[0] = f32x16{}; o[1] = f32x16{}; f32x16 negm = f32x16{}; asm volatile("" : "+v"(negm));
    const int qrel = (wid & 3) * QBLK + r32;
#define CMASK(P0, P1, t) do { int jb_ = (t) - (NT - 4); if (jb_ >= 0) bmask(P0, P1, TKB(t), qrel, hi); } while (0)
    bool resc = false;
#define START(P0, P1) do { const float rm = rowmax(P0, P1); resc = false; \
    { const float dl = rm; mhat = fadd_s(mhat, dl); \
      _Pragma("unroll") for (int r = 0; r < 16; ++r) { P0[r] = fsub_s(P0[r], dl); P1[r] = fsub_s(P1[r], dl); } \
      _Pragma("unroll") for (int r = 0; r < 16; ++r) negm[r] = -mhat; asm volatile("" : "+v"(negm)); } \
    _Pragma("unroll") for (int r = 0; r < 16; ++r) P0[r] = __builtin_amdgcn_exp2f(P0[r]); } while (0)
#define RESC() do { if (resc) { asm volatile("s_waitcnt lgkmcnt(0)" ::: "memory"); \
      _Pragma("unroll") for (int d_ = 0; d_ < 2; ++d_) _Pragma("unroll") for (int r = 0; r < 16; ++r) o[d_][r] *= wsf[crow(r, hi)]; } } while (0)
    f32x16 pA0, pA1, pB0, pB1;
    int sl_prev = 0, sl_cur = 0, sl_next = SLOTB;
#define ROT() do { sl_prev = sl_cur; sl_cur = sl_next; sl_next = (sl_next == (NSLOT - 1) * SLOTB) ? 0 : sl_next + SLOTB; } while (0)
    DMA_K(2, 2 * SLOTB);
    WAIT_BAR(3);
    qkt(pA0, pA1, Kbase, qr, negm, r32, hi); asm volatile("s_nop 15\n\ts_nop 7" : "+v"(pA0), "+v"(pA1));
    START(pA0, pA1);
    _Pragma("unroll") for (int r = 0; r < 16; ++r) pA1[r] = __builtin_amdgcn_exp2f(pA1[r]);
    WAIT_BAR(0);
    DMA_K(3, 0); DMA_V(1, SLOTB);
    ROT();
    kload8(kf, kp0 + sl_cur);
    WAIT_BAR(2);
    s16x4 vlo[8], vhi[8]; u32x4 pw0, pw1, pw2, pw3;
#define PKW(P, B) cvtpk_s(P[B], P[B + 1])
#define PAF(k) __builtin_bit_cast(bf16x8, pw##k)
#define VFR(i) (bf16x8){vlo[i][0], vlo[i][1], vlo[i][2], vlo[i][3], vhi[i][0], vhi[i][1], vhi[i][2], vhi[i][3]}
#define PIN(x) asm volatile("" : "+v"(x))
#define MX3(a, b, c) __builtin_fmaxf(__builtin_fmaxf((a), (b)), (c))
#define GAPA(MF, A0, A1, A2, A3, W0, W1, PW) do { MF; sacc += A0; sacc += A1; sacc += A2; sacc += A3; PIN(sacc); W0; W1; PIN(PW); SBAR(); } while (0)
#define EX(v) __builtin_amdgcn_exp2f(v)
#define GAPB(MF, X, B) do { MF; X[B] = EX(X[B]); X[B + 1] = EX(X[B + 1]); X[B + 2] = EX(X[B + 2]); X[B + 3] = EX(X[B + 3]); PIN(X); SBAR(); } while (0)
#define VRD(i) do { vlo[i] = vtr(vp_ + (((i) >> 2) * 4096 + ((i) & 3) * 1024)); vhi[i] = vtr(vp_ + (((i) >> 2) * 4096 + ((i) & 3) * 1024 + 512)); } while (0)
#define KRD(G, j) do { if (G) { kload2(kf, kp0 + sl_next, j); SBAR(); } } while (0)
#define STEP(C0, C1, P0, P1, t, GK, GV, GL) do { SBAR(); \
    const lds_cptr vp_ = vp0 + sl_prev; \
    VRD(0); SBAR(); float sacc = (P0[0] + P0[1]); \
    GAPA(C0 = __builtin_amdgcn_mfma_f32_32x32x16_bf16(kf[0], qr[0], negm, 0, 0, 0), P0[2], P0[3], P0[4], P0[5],     pw0[0] = PKW(P0, 0), pw0[1] = PKW(P0, 2), pw0); \
    VRD(4); SBAR(); GAPA(C1 = __builtin_amdgcn_mfma_f32_32x32x16_bf16(kf[1], qr[0], negm, 0, 0, 0), P0[6], P0[7], P0[8], P0[9],     pw0[2] = PKW(P0, 4), pw0[3] = PKW(P0, 6), pw0); \
    VRD(1); SBAR(); GAPA(C0 = __builtin_amdgcn_mfma_f32_32x32x16_bf16(kf[2], qr[1], C0, 0, 0, 0),   P0[10], P0[11], P0[12], P0[13], pw1[0] = PKW(P0, 8), pw1[1] = PKW(P0, 10), pw1); \
    VRD(5); SBAR(); GAPA(C1 = __builtin_amdgcn_mfma_f32_32x32x16_bf16(kf[3], qr[1], C1, 0, 0, 0),   P0[14], P0[15], P1[0], P1[1],   pw1[2] = PKW(P0, 12), pw1[3] = PKW(P0, 14), pw1); \
    VRD(2); SBAR(); GAPA(C0 = __builtin_amdgcn_mfma_f32_32x32x16_bf16(kf[4], qr[2], C0, 0, 0, 0),   P1[2], P1[3], P1[4], P1[5],     pw2[0] = PKW(P1, 0), pw2[1] = PKW(P1, 2), pw2); \
    VRD(6); SBAR(); GAPA(C1 = __builtin_amdgcn_mfma_f32_32x32x16_bf16(kf[5], qr[2], C1, 0, 0, 0),   P1[6], P1[7], P1[8], P1[9],     pw2[2] = PKW(P1, 4), pw2[3] = PKW(P1, 6), pw2); \
    VRD(3); SBAR(); GAPA(C0 = __builtin_amdgcn_mfma_f32_32x32x16_bf16(kf[6], qr[3], C0, 0, 0, 0),   P1[10], P1[11], P1[12], P1[13], pw3[0] = PKW(P1, 8), pw3[1] = PKW(P1, 10), pw3); \
    VRD(7); SBAR(); GAPA(C1 = __builtin_amdgcn_mfma_f32_32x32x16_bf16(kf[7], qr[3], C1, 0, 0, 0),   P1[14], P1[15], 0.f, 0.f,       pw3[2] = PKW(P1, 12), pw3[3] = PKW(P1, 14), pw3); \
    l_reg += sacc; \
    if (GK) { DMA_K((t) + 3, sl_cur); } if (GV) { DMA_V((t) + 1, sl_next); } \
    CMASK(C0, C1, t); \
    { float a = MX3(C0[0], C0[1], C1[0]), b = MX3(C0[2], C0[3], C1[1]); a = MX3(a, C1[2], C1[3]); \
      _Pragma("unroll") for (int r = 4; r < 16; r += 4) { a = MX3(a, C0[r], C0[r + 1]); b = MX3(b, C0[r + 2], C0[r + 3]); a = MX3(a, C1[r], C1[r + 1]); b = MX3(b, C1[r + 2], C1[r + 3]); } \
      float rm = __builtin_fmaxf(a, b); { auto rr = __builtin_amdgcn_permlane32_swap(__float_as_uint(rm), __float_as_uint(rm), false, false); rm = __builtin_fmaxf(__uint_as_float(rr[0]), __uint_as_float(rr[1])); } \
      resc = false; \
      if (__builtin_expect(__any(rm > (float)THRL), 0)) { const float dl = __builtin_fmaxf(rm, 0.f); mhat += dl; \
        _Pragma("unroll") for (int r = 0; r < 16; ++r) { C0[r] -= dl; C1[r] -= dl; } \
        _Pragma("unroll") for (int r = 0; r < 16; ++r) negm[r] = -mhat; asm volatile("" : "+v"(negm)); \
        const float f = __builtin_amdgcn_exp2f(-dl); l_reg *= f; if (hi == 0) wsf[r32] = f; resc = true; } } \
    SBAR(); \
    GAPB(o[0] = __builtin_amdgcn_mfma_f32_32x32x16_bf16(PAF(0), VFR(0), o[0], 0, 0, 0), C0, 0); \
    GAPB(o[1] = __builtin_amdgcn_mfma_f32_32x32x16_bf16(PAF(0), VFR(4), o[1], 0, 0, 0), C0, 4); \
    KRD(GL, 0); GAPB(o[0] = __builtin_amdgcn_mfma_f32_32x32x16_bf16(PAF(1), VFR(1), o[0], 0, 0, 0), C0, 8); \
    KRD(GL, 1); GAPB(o[1] = __builtin_amdgcn_mfma_f32_32x32x16_bf16(PAF(1), VFR(5), o[1], 0, 0, 0), C0, 12); \
    KRD(GL, 2); GAPB(o[0] = __builtin_amdgcn_mfma_f32_32x32x16_bf16(PAF(2), VFR(2), o[0], 0, 0, 0), C1, 0); \
    KRD(GL, 3); GAPB(o[1] = __builtin_amdgcn_mfma_f32_32x32x16_bf16(PAF(2), VFR(6), o[1], 0, 0, 0), C1, 4); \
    GAPB(o[0] = __builtin_amdgcn_mfma_f32_32x32x16_bf16(PAF(3), VFR(3), o[0], 0, 0, 0), C1, 8); \
    GAPB(o[1] = __builtin_amdgcn_mfma_f32_32x32x16_bf16(PAF(3), VFR(7), o[1], 0, 0, 0), C1, 12); \
    } while (0)
    int t = 1;
#undef CMASK
#define CMASK(P0, P1, t) do { } while (0)
    for (; t + 5 < NT; t += 2) {
        STEP(pB0, pB1, pA0, pA1, t, true, true, true);     WAIT_BAR(2); RESC(); ROT();
        STEP(pA0, pA1, pB0, pB1, t + 1, true, true, true); WAIT_BAR(2); RESC(); ROT();
    }
#undef CMASK
#define CMASK(P0, P1, t) do { int jb_ = (t) - (NT - 4); if (jb_ >= 0) bmask(P0, P1, TKB(t), qrel, hi); } while (0)
#define ENDW(tt) do { if ((tt) + 3 < NT) { WAIT_BAR(2); } else if ((tt) + 2 < NT) { WAIT_BAR(1); } else { WAIT_BAR(0); } } while (0)
    for (; t + 1 < NT; t += 2) {
        STEP(pB0, pB1, pA0, pA1, t, (t + 3 < NT), (t + 1 < NT), (t + 1 < NT));     ENDW(t);     RESC(); ROT();
        STEP(pA0, pA1, pB0, pB1, t + 1, (t + 4 < NT), (t + 2 < NT), (t + 2 < NT)); ENDW(t + 1); RESC(); ROT();
    }
    STEP(pB0, pB1, pA0, pA1, NT - 1, false, false, false); RESC();
    { float sacc = pB0[0] + pB0[1]; _Pragma("unroll") for (int r = 2; r < 16; ++r) sacc += pB0[r]; _Pragma("unroll") for (int r = 0; r < 16; ++r) sacc += pB1[r]; l_reg += sacc;
      pw0 = (u32x4){PKW(pB0, 0), PKW(pB0, 2), PKW(pB0, 4), PKW(pB0, 6)}; pw1 = (u32x4){PKW(pB0, 8), PKW(pB0, 10), PKW(pB0, 12), PKW(pB0, 14)}; pw2 = (u32x4){PKW(pB1, 0), PKW(pB1, 2), PKW(pB1, 4), PKW(pB1, 6)}; pw3 = (u32x4){PKW(pB1, 8), PKW(pB1, 10), PKW(pB1, 12), PKW(pB1, 14)};
      SBAR(); pv(o, vb0 + sl_cur, PAF(0), PAF(1), PAF(2), PAF(3)); }
#undef PKW
#undef PAF
#undef VFR
#undef PIN
#undef MX3
#undef GAPA
#undef GAPB
#undef EX
#undef VRD
#undef KRD
#undef STEP
#undef ENDW
    { auto rr = __builtin_amdgcn_permlane32_swap(__float_as_uint(l_reg), __float_as_uint(l_reg), false, false); l_reg = __uint_as_float(rr[0]) + __uint_as_float(rr[1]); }
    l_reg += __builtin_amdgcn_exp2f(sinkp[head] * 1.4426950408889634f - mhat);
    if (hi == 0) wsf[32 + r32] = l_reg; asm volatile("s_waitcnt lgkmcnt(0)" ::: "memory");
    float rli[16];
#pragma unroll
    for (int r = 0; r < 16; ++r) rli[r] = __builtin_amdgcn_rcpf(wsf[32 + crow(r, hi)]);
    bf16* Ow = O + (rowblk + (wid & 3) * QBLK) * OPITCH + head * D;
    { bf16* stg = (bf16*)(shm + LDS_OST) + wid * 2048;
#pragma unroll
      for (int r = 0; r < 16; ++r) { const int orow = crow(r, hi);
#pragma unroll
        for (int d0 = 0; d0 < 2; ++d0) stg[orow * 64 + d0 * 32 + r32] = __float2bfloat16(o[d0][r] * rli[r]); }
      asm volatile("s_waitcnt lgkmcnt(0)" ::: "memory");
#pragma unroll
      for (int i = 0; i < 4; ++i) { const int row = i * 8 + (lane >> 3), ch = lane & 7; const u32x4 v = *(const u32x4*)(stg + row * 64 + ch * 8); ATTN_STORE16(Ow + (long)row * OPITCH + ch * 8, v); } }
    asm volatile("s_waitcnt lgkmcnt(0)\n\ts_barrier" ::: "memory");
#undef DMA_K
#undef DMA_V
#undef TROW
#undef TKB
#undef CMASK
#undef START
#undef RESC
#undef ROT
}
#undef SBAR
#undef WAIT_BAR
}

#define XB_TMO      128
#define XB_XCNT(j)  (256  + 64 * (j))
#define XB_XSUB(j)  (1280 + 64 * (j))
#define XB_XGEN(j)  (2304 + 64 * (j))
#define XB_TOP      3328
#define XB_TOPGEN   3392
#define XCD_BAR_WORDS 3456
#define XB_SPIN_CAP (1u << 18)
__device__ __forceinline__ unsigned xb_ld(unsigned* p)              { return __hip_atomic_load(p, __ATOMIC_RELAXED, __HIP_MEMORY_SCOPE_AGENT); }
__device__ __forceinline__ unsigned xb_add(unsigned* p, unsigned v) { return __hip_atomic_fetch_add(p, v, __ATOMIC_RELAXED, __HIP_MEMORY_SCOPE_AGENT); }
__device__ __forceinline__ unsigned xb_xcc_id() { return (unsigned)__builtin_amdgcn_s_getreg((3 << 11) | 20) & 0xFu; }
#define XB_SPIN(cond, bar) do { unsigned _sp = 0; while (cond) { __builtin_amdgcn_s_sleep(1); \
    if ((++_sp & 255u) == 0u) { if (xb_ld(&(bar)[XB_TMO])) break; if (_sp > XB_SPIN_CAP) { atomicAdd(&(bar)[XB_TMO], 1u); break; } } } } while (0)
struct XcdBarrier { unsigned* bar; unsigned x; volatile LAS unsigned* st; };
__device__ __forceinline__ XcdBarrier xcd_barrier_post(unsigned* bar, volatile LAS unsigned* st) {
    XcdBarrier b; b.bar = bar; b.x = xb_xcc_id(); b.st = st;
    if (threadIdx.x == 0) (void)xb_add(&bar[XB_XCNT(b.x)], 1u);
    return b;
}
__device__ __forceinline__ void xcd_barrier_complete(unsigned* bar, unsigned x, unsigned& nloc, unsigned& nx) {
    const unsigned G = gridDim.x * gridDim.y * gridDim.z;
    unsigned sum, cnt, mine, sp = 0u;
    for (;;) {
        sum = 0u; cnt = 0u; mine = 0u;
#pragma unroll
        for (unsigned j = 0; j < 16; ++j) { const unsigned c = xb_ld(&bar[XB_XCNT(j)]); sum += c; cnt += (c > 0u) ? 1u : 0u; mine = (j == x) ? c : mine; }
        if (sum == G) break;
        __builtin_amdgcn_s_sleep(1);
        if ((++sp & 255u) == 0u) { if (xb_ld(&bar[XB_TMO])) break; if (sp > XB_SPIN_CAP) { atomicAdd(&bar[XB_TMO], 1u); break; } }
    }
    nloc = mine > 0u ? mine : 1u; nx = cnt > 0u ? cnt : 1u;
}
__device__ __forceinline__ void xcd_barrier(const XcdBarrier& b) {
    asm volatile("s_waitcnt vmcnt(0)" ::: "memory");
    __syncthreads();
    if (threadIdx.x == 0) {
        unsigned* bar = b.bar;
        __builtin_amdgcn_s_waitcnt(0);
        unsigned nloc = b.st[0], nx = b.st[1];
        if (nloc == 0u) { xcd_barrier_complete(bar, b.x, nloc, nx); b.st[0] = nloc; b.st[1] = nx; }
        const unsigned old = xb_add(&bar[XB_XSUB(b.x)], 1u);
        const unsigned gen = old / nloc;
        if (old + 1u == (gen + 1u) * nloc) {
            __builtin_amdgcn_fence(__ATOMIC_RELEASE, "agent");
            asm volatile("s_waitcnt vmcnt(0)" ::: "memory");
            const unsigned og = xb_add(&bar[XB_TOP], 1u);
            const unsigned tg = og / nx;
            if (og + 1u == (tg + 1u) * nx) xb_add(&bar[XB_TOPGEN], 1u);
            else XB_SPIN(xb_ld(&bar[XB_TOPGEN]) == tg, bar);
            __builtin_amdgcn_fence(__ATOMIC_ACQUIRE, "agent");
            xb_add(&bar[XB_XGEN(b.x)], 1u);
            asm volatile("s_waitcnt vmcnt(0)" ::: "memory");
        } else {
            XB_SPIN(xb_ld(&bar[XB_XGEN(b.x)]) == gen, bar);
            __builtin_amdgcn_fence(__ATOMIC_ACQUIRE, "agent");
            asm volatile("s_waitcnt vmcnt(0)" ::: "memory");
        }
    }
    __syncthreads();
}

#define LDS_WAIT() asm volatile("s_waitcnt lgkmcnt(0)" ::: "memory")
__device__ __forceinline__ void transpose_item(const float* W, int K, int N, bf16_t* WT, int k0, int n0, int drow0, LAS float* scr, int lane) {
    float t[32];
#pragma unroll
    for (int i = 0; i < 32; ++i) t[i] = __builtin_nontemporal_load(W + (size_t)(k0 + 2 * i + (lane >> 5)) * N + n0 + (lane & 31));
#pragma unroll
    for (int i = 0; i < 32; ++i) scr[(2 * i + (lane >> 5)) * 33 + (lane & 31)] = t[i];
    LDS_WAIT(); asm volatile("" ::: "memory");
    const int c = lane & 7;
#pragma unroll
    for (int j = 0; j < 4; ++j) { const int n = (lane >> 3) + 8 * j; const LAS float* s = scr + (8 * c) * 33 + n;
        u32x4 o; o.x = pkbf(s[0 * 33], s[1 * 33]); o.y = pkbf(s[2 * 33], s[3 * 33]); o.z = pkbf(s[4 * 33], s[5 * 33]); o.w = pkbf(s[6 * 33], s[7 * 33]);
        *(GAS u32x4*)(WT + (size_t)(drow0 + n) * K + k0 + 8 * c) = o; }
    LDS_WAIT(); asm volatile("" ::: "memory");
}
__device__ __forceinline__ void transpose_item_f8(const float* W, int K, int N, unsigned char* WT, int k0, int n0, int drow0, float scale, LAS float* scr, int lane) {
    float t[32];
#pragma unroll
    for (int i = 0; i < 32; ++i) t[i] = __builtin_nontemporal_load(W + (size_t)(k0 + 2 * i + (lane >> 5)) * N + n0 + (lane & 31));
#pragma unroll
    for (int i = 0; i < 32; ++i) scr[(2 * i + (lane >> 5)) * 33 + (lane & 31)] = t[i];
    LDS_WAIT(); asm volatile("" ::: "memory");
    const int n = lane >> 1, hf = lane & 1; const LAS float* sp = scr + (32 * hf) * 33 + n;
    u32x4 o0, o1;
    o0.x = pk4f8(sp[0 * 33] * scale, sp[1 * 33] * scale, sp[2 * 33] * scale, sp[3 * 33] * scale);     o0.y = pk4f8(sp[4 * 33] * scale, sp[5 * 33] * scale, sp[6 * 33] * scale, sp[7 * 33] * scale);
    o0.z = pk4f8(sp[8 * 33] * scale, sp[9 * 33] * scale, sp[10 * 33] * scale, sp[11 * 33] * scale);   o0.w = pk4f8(sp[12 * 33] * scale, sp[13 * 33] * scale, sp[14 * 33] * scale, sp[15 * 33] * scale);
    o1.x = pk4f8(sp[16 * 33] * scale, sp[17 * 33] * scale, sp[18 * 33] * scale, sp[19 * 33] * scale); o1.y = pk4f8(sp[20 * 33] * scale, sp[21 * 33] * scale, sp[22 * 33] * scale, sp[23 * 33] * scale);
    o1.z = pk4f8(sp[24 * 33] * scale, sp[25 * 33] * scale, sp[26 * 33] * scale, sp[27 * 33] * scale); o1.w = pk4f8(sp[28 * 33] * scale, sp[29 * 33] * scale, sp[30 * 33] * scale, sp[31 * 33] * scale);
    GAS u32x4* dst = (GAS u32x4*)(WT + (size_t)(drow0 + n) * K + k0 + 32 * hf);
    dst[0] = o0; dst[1] = o1;
    LDS_WAIT(); asm volatile("" ::: "memory");
}
__device__ __forceinline__ void sincos_d(double x, double& s, double& c) {
    const double TWO_PI = 6.283185307179586476925;
    const double k = __builtin_rint(x / TWO_PI); const double r = x - k * TWO_PI;
    const double r2 = r * r; double ts = r, tc = 1.0; s = r; c = 1.0;
    for (int i = 1; i <= 16; ++i) { tc *= -r2 / (double)((2 * i - 1) * (2 * i)); ts *= -r2 / (double)((2 * i) * (2 * i + 1)); c += tc; s += ts; }
}

struct Args { const float* in[24]; float* out; unsigned char* ws; int ph_lo, ph_hi, li, pad; };
constexpr int NPH = 24;

__device__ __forceinline__ void norm_store(const f32x4 (&v)[4], float ssum, const float* g, const float* mrow, int shc, int scc, bf16_t* XNo, size_t m, int lane) {
    const float rstd = 1.0f / __builtin_sqrtf(ssum * (1.0f / DM) + EPS);
#pragma unroll
    for (int j = 0; j < 4; ++j) { const f32x4 gv = *(const f32x4*)(g + 4 * lane + 256 * j), sc = *(const f32x4*)(mrow + scc * 1024 + 4 * lane + 256 * j), sh = *(const f32x4*)(mrow + shc * 1024 + 4 * lane + 256 * j);
        const f32x4 y = (v[j] * rstd) * gv * (sc + 1.0f) + sh; u32x2 w; w.x = pkbf(y.x, y.y); w.y = pkbf(y.z, y.w); *((GAS u32x2*)(XNo + m * DM) + lane + 64 * j) = w; }
}
template <bool SRC_BF16> __device__ __forceinline__ void norm_rows(const void* srcLv, const float* srcC, int nrows, const float* g, const float* mod, int shc, int scc, bf16_t* XNo, int gw, int NGW, int lane,
                                          const float* part, int nS, const float* gatec, float* zout) {
    if (nrows > NLAT) {
        for (int rc = gw; rc < NCTXR; rc += NGW) {
            const GAS f32x4* xr = (const GAS f32x4*)(srcC + (size_t)rc * DM) + lane;
            f32x4 v[4];
#pragma unroll
            for (int j = 0; j < 4; ++j) v[j] = xr[64 * j];
            if (part != nullptr) {
                f32x4 a[4];
#pragma unroll
                for (int j = 0; j < 4; ++j) a[j] = (f32x4){0.f, 0.f, 0.f, 0.f};
                for (int s0 = 0; s0 < nS; s0 += 7) {
                    f32x4 t[7][4];
#pragma unroll
                    for (int q = 0; q < 7; ++q) { const int s2 = (s0 + q < nS) ? s0 + q : s0; const GAS f32x4* pr = (const GAS f32x4*)(part + ((size_t)s2 * NCTXR + rc) * DM) + lane;
#pragma unroll
                        for (int j = 0; j < 4; ++j) t[q][j] = pr[64 * j]; }
#pragma unroll
                    for (int q = 0; q < 7; ++q) if (s0 + q < nS) {
#pragma unroll
                        for (int j = 0; j < 4; ++j) a[j] += t[q][j]; }
                }
#pragma unroll
                for (int j = 0; j < 4; ++j) v[j] += *(const f32x4*)(gatec + 4 * lane + 256 * j) * a[j];
                if (zout != nullptr) { GAS f32x4* zr = (GAS f32x4*)(zout + (size_t)rc * DM) + lane;
#pragma unroll
                    for (int j = 0; j < 4; ++j) zr[64 * j] = v[j]; }
            }
            float ss = 0.f;
#pragma unroll
            for (int j = 0; j < 4; ++j) ss += (v[j].x * v[j].x + v[j].y * v[j].y) + (v[j].z * v[j].z + v[j].w * v[j].w);
            norm_store(v, wave_sum(ss), g, mod + (size_t)4 * 6144, shc, scc, XNo, (size_t)NLAT + rc, lane);
        }
    }
    for (int m0 = gw * 4; m0 < NLAT; m0 += NGW * 4) {
        const int mb = m0 >> 13;
        f32x4 v[4][4];
        if constexpr (SRC_BF16) { const GAS u32x2* xr = (const GAS u32x2*)((const bf16_t*)srcLv + (size_t)m0 * DM) + lane;
#pragma unroll
            for (int r = 0; r < 4; ++r)
#pragma unroll
                for (int j = 0; j < 4; ++j) { const u32x2 w = xr[r * 256 + 64 * j]; v[r][j] = (f32x4){__uint_as_float(w.x << 16), __uint_as_float(w.x & 0xffff0000u), __uint_as_float(w.y << 16), __uint_as_float(w.y & 0xffff0000u)}; } }
        else { const GAS f32x4* xr = (const GAS f32x4*)((const float*)srcLv + (size_t)m0 * DM) + lane;
#pragma unroll
            for (int r = 0; r < 4; ++r)
#pragma unroll
                for (int j = 0; j < 4; ++j) v[r][j] = xr[r * 256 + 64 * j]; }
        float ss[4];
#pragma unroll
        for (int r = 0; r < 4; ++r) { ss[r] = 0.f;
#pragma unroll
            for (int j = 0; j < 4; ++j) ss[r] += (v[r][j].x * v[r][j].x + v[r][j].y * v[r][j].y) + (v[r][j].z * v[r][j].z + v[r][j].w * v[r][j].w); }
#pragma unroll
        for (int o = 1; o < 64; o <<= 1) {
#pragma unroll
            for (int r = 0; r < 4; ++r) ss[r] += __shfl_xor(ss[r], o); }
#pragma unroll
        for (int r = 0; r < 4; ++r) norm_store(v[r], ss[r], g, mod + (size_t)mb * 6144, shc, scc, XNo, (size_t)(m0 + r), lane);
    }
}

__global__ void __launch_bounds__(512, 2) fwd(Args args) {
    extern __shared__ __attribute__((aligned(16))) unsigned char lds_raw[];
    LAS unsigned char* lds = (LAS unsigned char*)lds_raw;
    volatile LAS unsigned* MISC = (volatile LAS unsigned*)(lds + MISC_OFF);
    LAS int* gtab = (LAS int*)(lds + GTAB_OFF);
    const int G = gridDim.x; const int bx = blockIdx.x; const int vcu = (G % 8 == 0) ? (bx % 8) * (G / 8) + bx / 8 : bx;
    const int NGW = G * 8;
#define PHASE_IDS() int tid_ = threadIdx.x; asm volatile("" : "+v"(tid_)); const int tid = tid_, lane = tid & 63, wave = __builtin_amdgcn_readfirstlane(tid >> 6), gw = vcu * 8 + wave; (void)lane; (void)gw
    unsigned char* ws = args.ws;
    gu32* ctl = (gu32*)(ws + WS_CTL);
#define MOD ((float*)(ws + WS_MOD))
#define ROPE ((float*)(ws + WS_ROPE))
#define STATS ((float*)(ws + WS_STATS))
#define LIST ((int*)(ws + WS_LIST))
#define TINFO ((int*)(ws + WS_TINFO))
#define WSB ((bf16_t*)(ws + WS_WS))
#define WIN ((bf16_t*)(ws + WS_WIN))
#define WAO ((bf16_t*)(ws + WS_WAO))
#define WQKV ((bf16_t*)(ws + WS_WQKV))
#define WBO ((bf16_t*)(ws + WS_WBO))
#define WGU ((bf16_t*)(ws + WS_WGU))
#define WD ((bf16_t*)(ws + WS_WD))
#define MGU ((unsigned char*)(ws + WS_MGU))
#define MD ((unsigned char*)(ws + WS_MD))
#define XN8 ((unsigned char*)(ws + WS_XN))
#define XN ((bf16_t*)(ws + WS_XN))
#define ZB ((float*)(ws + WS_ZB))
#define UVT ((bf16_t*)(ws + WS_UVT))
#define A2 ((bf16_t*)(ws + WS_A2))
#define HB ((bf16_t*)(ws + WS_H))
#define QKV ((bf16_t*)(ws + WS_QKV))
#define OB ((bf16_t*)(ws + WS_O))
#define YB ((bf16_t*)(ws + WS_Y))
#define HC ((unsigned char*)(ws + WS_HC))
#define YP ((bf16_t*)(ws + WS_YP))
#define PART1 ((float*)(ws + WS_PART1))
#define PART2 ((float*)(ws + WS_PART2))
#define I_X (args.in[0])
#define I_C (args.in[1])
#define I_CTX (args.in[2])
#define I_CCTX (args.in[3])
#define I_ADAW (args.in[4])
#define I_ADAB (args.in[5])
#define I_NORMG (args.in[6])
#define I_FINALG (args.in[7])
#define HL ((bf16_t*)(ws + WS_HLB))

    { PHASE_IDS(); for (int u = tid; u < (LDS_BYTES - MISC_OFF) / 4; u += 512) ((LAS unsigned*)(lds + MISC_OFF))[u] = 0u; }
    __syncthreads();
    const int lo = args.ph_lo, hi_ph = args.ph_hi;
    const bool one_launch = (hi_ph - lo) > 1;
    XcdBarrier bar; bar.bar = (unsigned*)(ctl + CW_BAR) + args.li * XCD_BAR_WORDS; bar.x = 0; bar.st = nullptr;
    if (one_launch) bar = xcd_barrier_post((unsigned*)(ctl + CW_BAR) + args.li * XCD_BAR_WORDS, MISC + 8);
#ifndef PHMASK
#define PHMASK 0xFFFFFFFFu
#endif
#define IN(k) (((PHMASK >> (k)) & 1) && lo <= (k) && (k) < hi_ph)
#define BOTH(k) (IN(k) && IN((k) + 1))
#define GRID_BAR() xcd_barrier(bar)
#if defined(PROBE_LO)
    unsigned long long tpA = __builtin_amdgcn_s_memrealtime(), tpB = 0;
#define PROBE_MARK(k) do { if ((k) == PROBE_LO - 1) tpA = __builtin_amdgcn_s_memrealtime(); if ((k) == PROBE_HI) tpB = __builtin_amdgcn_s_memrealtime(); } while (0)
#else
#define PROBE_MARK(k) do { } while (0)
#endif

    if (IN(0)) {
        PHASE_IDS();
        {
            LAS float* sv = (LAS float*)lds;
            LAS float* red = (LAS float*)(lds + 5 * 1024 * 4);
            if (bx < 192) {
                for (int idx = tid; idx < 5 * 1024; idx += 512) { const int r = idx >> 10, k = idx & 1023; const float cv = r < 4 ? I_C[r * 1024 + k] : I_CCTX[k]; sv[idx] = cv / (1.0f + __expf(-cv)); }
                __syncthreads();
                for (int item = bx; item < 192; item += G) {
                    const int i = item / 96, n0 = (item % 96) * 64, nn = tid & 63, kq = tid >> 6;
                    float a0 = 0.f, a1 = 0.f, a2 = 0.f, a3 = 0.f, a4 = 0.f;
                    const float* wp = I_ADAW + ((size_t)i * 1024 + kq * 128) * 6144 + n0 + nn;
#pragma unroll 8
                    for (int k = 0; k < 128; ++k) { const float w = wp[(size_t)k * 6144]; const int kk = kq * 128 + k;
                        a0 += sv[kk] * w; a1 += sv[1024 + kk] * w; a2 += sv[2048 + kk] * w; a3 += sv[3072 + kk] * w; a4 += sv[4096 + kk] * w; }
                    red[(kq * 5 + 0) * 64 + nn] = a0; red[(kq * 5 + 1) * 64 + nn] = a1; red[(kq * 5 + 2) * 64 + nn] = a2; red[(kq * 5 + 3) * 64 + nn] = a3; red[(kq * 5 + 4) * 64 + nn] = a4;
                    __syncthreads();
                    if (tid < 320) { const int r = tid >> 6; float s = I_ADAB[i * 6144 + n0 + nn];
#pragma unroll
                        for (int q = 0; q < 8; ++q) s += red[(q * 5 + r) * 64 + nn];
                        MOD[((size_t)i * 5 + r) * 6144 + n0 + nn] = s; }
                    __syncthreads();
                }
            }
            __syncthreads();
        }
        {
            LAS float* scr = (LAS float*)(lds + wave * 16384);
            constexpr int I_IN = 16 * 64, I_AO = 16 * 32, I_QKV = 16 * 48, I_BO = 16 * 32, I_F = 16 * 112, I_FD = 56 * 32;
            constexpr int I_DENSE = I_IN + I_AO + I_QKV + I_BO + 2 * I_F + I_FD, I_MOE = 8 * (2 * I_F + I_FD), I_WS = 128, I_ROPE = 32;
            constexpr int NITEMS = I_DENSE + I_MOE + I_WS + I_ROPE;
            for (int it = gw; it < NITEMS; it += NGW) {
                int r = it;
                if (r < I_IN) { const int kb = r / 64, nb = r % 64; transpose_item(args.in[8], 1024, 2048, WIN, 64 * kb, 32 * nb, 32 * nb, scr, lane); continue; } r -= I_IN;
                if (r < I_AO) { const int kb = r / 32, nb = r % 32; transpose_item(args.in[13], 1024, 1024, WAO, 64 * kb, 32 * nb, 32 * nb, scr, lane); continue; } r -= I_AO;
                if (r < I_QKV) { const int kb = r / 48, nb = r % 48; transpose_item(args.in[14], 1024, 1536, WQKV, 64 * kb, 32 * nb, 32 * nb, scr, lane); continue; } r -= I_QKV;
                if (r < I_BO) { const int kb = r / 32, nb = r % 32; transpose_item(args.in[16], 1024, 1024, WBO, 64 * kb, 32 * nb, 32 * nb, scr, lane); continue; } r -= I_BO;
                if (r < 2 * I_F) { const int up = r / I_F; const int q = r % I_F; const int kb = q / 112, nb = q % 112, n0 = 32 * nb;
                    transpose_item(args.in[17 + up], 1024, DFF, WGU, 64 * kb, n0, 256 * (n0 >> 7) + 128 * up + (n0 & 127), scr, lane); continue; } r -= 2 * I_F;
                if (r < I_FD) { const int kb = r / 32, nb = r % 32; transpose_item(args.in[19], DFF, 1024, WD, 64 * kb, 32 * nb, 32 * nb, scr, lane); continue; } r -= I_FD;
                if (r < I_MOE) { const int e = r / (2 * I_F + I_FD); int q = r % (2 * I_F + I_FD);
                    if (q < 2 * I_F) { const int up = q / I_F; q %= I_F; const int kb = q / 112, nb = q % 112, n0 = 32 * nb;
                        transpose_item_f8(args.in[21 + up] + (size_t)e * 1024 * DFF, 1024, DFF, MGU + (size_t)e * 7168 * 1024, 64 * kb, n0, 256 * (n0 >> 7) + 128 * up + (n0 & 127), MOE_SGU, scr, lane); }
                    else { q -= 2 * I_F; const int kb = q / 32, nb = q % 32; transpose_item_f8(args.in[23] + (size_t)e * DFF * 1024, DFF, 1024, MD + (size_t)e * 1024 * DFF, 64 * kb, 32 * nb, 32 * nb, MOE_SD, scr, lane); }
                    continue; } r -= I_MOE;
                if (r < I_WS) { const float* src = args.in[11] + (size_t)r * 2048;
#pragma unroll
                    for (int j = 0; j < 8; ++j) { const f32x4 v = *(const f32x4*)(src + j * 256 + lane * 4); u32x2 w; w.x = pkbf(v.x, v.y); w.y = pkbf(v.z, v.w); *(u32x2*)(WSB + (size_t)r * 2048 + j * 256 + lane * 4) = w; }
                    continue; } r -= I_WS;
                {
                    const int ent = r * 64 + lane; const int pos = ent >> 4, i = ent & 15;
                    double inv = 1.0; for (int q = 0; q < i; ++q) inv *= 0.56234132519034908;
                    const float ang = (float)pos * (float)inv; double s, c; sincos_d((double)ang, s, c);
                    ROPE[ent] = (float)c; ROPE[2048 + ent] = (float)s;
                }
            }
        }
        if (BOTH(0)) GRID_BAR(); PROBE_MARK(0);
    }
    if (IN(1)) { PHASE_IDS(); norm_rows<false>(I_X, I_CTX, MALL, I_NORMG + 0 * 1024, MOD, 0, 1, XN, gw, NGW, lane, nullptr, 0, nullptr, nullptr); if (BOTH(1)) GRID_BAR(); PROBE_MARK(1); }
    if (IN(2)) {
        pg8::DenseSched S{(const char*)WIN, (const char*)XN, 8, NPA, G, bx, (size_t)256 * 1024 * 2};
        pg8::EpiGeluT E{UVT, STATS};
        pg8::gemm_phase<pg8::EpiGeluT, pg8::DenseSched, true, false>(lds, gtab, 1024, 16, S, E);
        if (BOTH(2)) GRID_BAR(); PROBE_MARK(2);
    }
    if (IN(3)) {
        PHASE_IDS();
        const float* vg = args.in[9]; const float* vb = args.in[10]; const float* bs = args.in[12];
        LAS float* mu_l = (LAS float*)(lds + wave * 1024); LAS float* rs_l = mu_l + 128;
        const int r32 = lane & 31, h = lane >> 5;
        for (int unit = gw; unit < (MALL / 128) * 16; unit += NGW) {
            const int ch = unit >> 4, g = unit & 15, q0 = ch * 128;
#pragma unroll
            for (int tt = 0; tt < 2; ++tt) { const int tok = q0 + lane * 2 + tt; const f32x4* sp = (const f32x4*)(STATS + (size_t)tok * 16);
                const f32x4 a = sp[0], b = sp[1], c = sp[2], d = sp[3];
                const float sum = (a.x + a.z) + (b.x + b.z) + (c.x + c.z) + (d.x + d.z), sq = (a.y + a.w) + (b.y + b.w) + (c.y + c.w) + (d.y + d.w);
                const float mean = sum * (1.0f / 1024.0f), var = sq * (1.0f / 1024.0f) - mean * mean;
                mu_l[lane * 2 + tt] = mean; rs_l[lane * 2 + tt] = 1.0f / __builtin_sqrtf(var + EPS); }
            float vgc[2], vbc[2];
#pragma unroll
            for (int ct = 0; ct < 2; ++ct) { vgc[ct] = vg[64 * g + 32 * ct + r32]; vbc[ct] = vb[64 * g + 32 * ct + r32]; }
            f32x16 acc[2][4];
#pragma unroll
            for (int ct = 0; ct < 2; ++ct)
#pragma unroll
                for (int pt = 0; pt < 4; ++pt) acc[ct][pt] = f32x16{};
#pragma unroll 2
            for (int s = 0; s < 8; ++s) {
                const int qs = 16 * s + 8 * h;
                const f32x4 m0 = *(const LAS f32x4*)(mu_l + qs), m1 = *(const LAS f32x4*)(mu_l + qs + 4), r0 = *(const LAS f32x4*)(rs_l + qs), r1 = *(const LAS f32x4*)(rs_l + qs + 4);
                bf16x8 af[2], bfr[4];
#pragma unroll
                for (int ct = 0; ct < 2; ++ct) { const bf16x8 raw = *(const bf16x8*)(UVT + (size_t)(1024 + 64 * g + 32 * ct + r32) * MALL + q0 + qs);
                    float y[8];
#pragma unroll
                    for (int j = 0; j < 4; ++j) { y[j] = (bf2f((unsigned short)raw[j]) - m0[j]) * r0[j] * vgc[ct] + vbc[ct]; y[4 + j] = (bf2f((unsigned short)raw[4 + j]) - m1[j]) * r1[j] * vgc[ct] + vbc[ct]; }
                    u32x4 w; w.x = pkbf(y[0], y[1]); w.y = pkbf(y[2], y[3]); w.z = pkbf(y[4], y[5]); w.w = pkbf(y[6], y[7]); af[ct] = __builtin_bit_cast(bf16x8, w); }
#pragma unroll
                for (int pt = 0; pt < 4; ++pt) bfr[pt] = *(const bf16x8*)(WSB + (size_t)(g * 128 + 32 * pt + r32) * 128 + qs);
#pragma unroll
                for (int ct = 0; ct < 2; ++ct)
#pragma unroll
                    for (int pt = 0; pt < 4; ++pt) acc[ct][pt] = __builtin_amdgcn_mfma_f32_32x32x16_bf16(af[ct], bfr[pt], acc[ct][pt], 0, 0, 0);
            }
#pragma unroll
            for (int pt = 0; pt < 4; ++pt) { const int p = 32 * pt + r32; const size_t tokp = (size_t)q0 + p; const float bsv = bs[g * 128 + p];
#pragma unroll
                for (int ct = 0; ct < 2; ++ct)
#pragma unroll
                    for (int rr = 0; rr < 4; ++rr) { const int c = 64 * g + 32 * ct + 8 * rr + 4 * h; float o[4];
#pragma unroll
                        for (int e = 0; e < 4; ++e) { const float uu = bf2f(UVT[(size_t)(c + e) * MALL + tokp]); o[e] = uu * (acc[ct][pt][4 * rr + e] + bsv); }
                        u32x2 w; w.x = pkbf(o[0], o[1]); w.y = pkbf(o[2], o[3]); *(u32x2*)(A2 + tokp * DM + c) = w; } }
        }
        if (BOTH(3)) GRID_BAR(); PROBE_MARK(3);
    }
    if (IN(4)) {
        { pg8::DenseSched S{(const char*)A2, (const char*)WAO, NPL, 4, G, bx, (size_t)256 * 1024 * 2};
          pg8::EpiResid<true> E{I_X, nullptr, HL, MOD + 2 * 1024};
          pg8::gemm_phase<pg8::EpiResid<true>, pg8::DenseSched, true, false>(lds, gtab, 1024, 16, S, E); }
        { pg8::SplitSched S{(const char*)(A2 + (size_t)NLAT * DM), (const char*)WAO, 4, 4, P3_NS, G, bx, NPL, (size_t)256 * 1024 * 2, (size_t)(1024 / P3_NS) * 2};
          pg8::EpiPartF32 E{PART1, (size_t)NCTXR * DM};
          pg8::gemm_phase<pg8::EpiPartF32, pg8::SplitSched, true, false>(lds, gtab, 1024, 1024 / P3_NS / 64, S, E); }
        if (BOTH(4)) GRID_BAR(); PROBE_MARK(4);
    }
    if (IN(5)) { PHASE_IDS(); norm_rows<true>(HL, I_CTX, MALL, I_NORMG + 1 * 1024, MOD, 3, 4, XN, gw, NGW, lane, PART1, P3_NS, MOD + 4 * 6144 + 2 * 1024, ZB); if (BOTH(5)) GRID_BAR(); PROBE_MARK(5); }
    if (IN(6)) {
        pg8::DenseSched S{(const char*)XN, (const char*)WGU, NPA, 28, G, bx, (size_t)256 * 1024 * 2};
        pg8::EpiSwiGLU E{HB};
        pg8::gemm_phase<pg8::EpiSwiGLU, pg8::DenseSched, true, false>(lds, gtab, 1024, 16, S, E);
        if (BOTH(6)) GRID_BAR(); PROBE_MARK(6);
    }
    if (IN(7)) {
        { pg8::DenseSched S{(const char*)HB, (const char*)WD, NPL, 4, G, bx, (size_t)256 * DFF * 2};
          pg8::EpiResid<false> E{nullptr, HL, HL, MOD + 5 * 1024};
          pg8::gemm_phase<pg8::EpiResid<false>, pg8::DenseSched, true, false>(lds, gtab, DFF, 56, S, E); }
        { pg8::SplitSched S{(const char*)(HB + (size_t)NLAT * DFF), (const char*)WD, 4, 4, P5_NS, G, bx, NPL, (size_t)256 * DFF * 2, (size_t)(DFF / P5_NS) * 2};
          pg8::EpiPartF32 E{PART2, (size_t)NCTXR * DM};
          pg8::gemm_phase<pg8::EpiPartF32, pg8::SplitSched, true, false>(lds, gtab, DFF, DFF / P5_NS / 64, S, E); }
        if (BOTH(7)) GRID_BAR(); PROBE_MARK(7);
    }
    if (IN(8)) { PHASE_IDS(); norm_rows<true>(HL, ZB, MALL, I_NORMG + 2 * 1024, MOD + 5 * 6144, 0, 1, XN, gw, NGW, lane, PART2, P5_NS, MOD + 4 * 6144 + 5 * 1024, nullptr); if (BOTH(8)) GRID_BAR(); PROBE_MARK(8); }
    if (IN(9)) {
        pg8::DenseSched S{(const char*)XN, (const char*)WQKV, NPA, 6, G, bx, (size_t)256 * 1024 * 2};
        pg8::EpiQKV E{QKV, ROPE, ROPE + 2048, attn_body::C2};
        pg8::gemm_phase<pg8::EpiQKV, pg8::DenseSched, true, false>(lds, gtab, 1024, 16, S, E);
        if (BOTH(9)) GRID_BAR(); PROBE_MARK(9);
    }
    if (IN(10)) {
        static_assert(attn_body::LDS_BYTES_A <= RING_BYTES, "attention LDS");
        const float* sinkp = args.in[15];
        for (int i = 0;; ++i) { const int uid = i * G + vcu; if (uid >= NB * 64 * 4 * 2) break;
            const int pr = uid & 1, hk = (uid >> 1) & 3, n = (uid >> 3) & 63, b = uid >> 9;
            attn_body::attn_unit<8>(b, hk, n, pr, (const attn_body::bf16*)QKV, (attn_body::bf16*)OB, sinkp, (char*)lds_raw); }
        if (BOTH(10)) GRID_BAR(); PROBE_MARK(10);
    }
    if (IN(11)) {
        pg8::DenseSched S{(const char*)OB, (const char*)WBO, NPL, 4, G, bx, (size_t)256 * 1024 * 2};
        pg8::EpiResid<false> E{nullptr, HL, HL, MOD + 5 * 6144 + 2 * 1024};
        pg8::gemm_phase<pg8::EpiResid<false>, pg8::DenseSched, true, false>(lds, gtab, 1024, 16, S, E);
        if (BOTH(11)) GRID_BAR(); PROBE_MARK(11);
    }
    if (IN(12)) {
        PHASE_IDS();
        const float* g = I_NORMG + 3 * 1024; const float* mod = MOD + 5 * 6144; const float* wrt = args.in[20];
        LAS int* l_e = (LAS int*)lds;
        LAS float* l_w = (LAS float*)(lds + 1024);
        LAS int* l_cnt = (LAS int*)(lds + 2048);
        LAS int* l_base = (LAS int*)(lds + 2048 + 64);
        for (int blk = bx; blk < NLAT / 128; blk += G) {
            if (tid < 8) l_cnt[tid] = 0;
            __syncthreads();
            const int mb = (blk * 128) >> 13; const float* mrow = mod + (size_t)mb * 6144;
            for (int i4 = 0; i4 < 8; ++i4) {
                const int tl0 = wave * 16 + i4 * 2, m0 = blk * 128 + tl0;
                const GAS u32x2* xr = (const GAS u32x2*)(HL + (size_t)m0 * DM) + lane;
                f32x4 v[2][4]; float ss[2];
#pragma unroll
                for (int r = 0; r < 2; ++r)
#pragma unroll
                    for (int j = 0; j < 4; ++j) { const u32x2 w = xr[r * 256 + 64 * j]; v[r][j] = (f32x4){__uint_as_float(w.x << 16), __uint_as_float(w.x & 0xffff0000u), __uint_as_float(w.y << 16), __uint_as_float(w.y & 0xffff0000u)}; }
#pragma unroll
                for (int r = 0; r < 2; ++r) { ss[r] = 0.f;
#pragma unroll
                    for (int j = 0; j < 4; ++j) ss[r] += (v[r][j].x * v[r][j].x + v[r][j].y * v[r][j].y) + (v[r][j].z * v[r][j].z + v[r][j].w * v[r][j].w); }
#pragma unroll
                for (int o = 1; o < 64; o <<= 1) {
#pragma unroll
                    for (int r = 0; r < 2; ++r) ss[r] += __shfl_xor(ss[r], o); }
                float lg[2][8];
#pragma unroll
                for (int r = 0; r < 2; ++r)
#pragma unroll
                    for (int e = 0; e < 8; ++e) lg[r][e] = 0.f;
#pragma unroll
                for (int j = 0; j < 4; ++j) { const int col = 4 * lane + 256 * j; const f32x4 gv = *(const f32x4*)(g + col), sc = *(const f32x4*)(mrow + 4 * 1024 + col), sh = *(const f32x4*)(mrow + 3 * 1024 + col);
                    const f32x4 gm = gv * (sc + 1.0f);
                    f32x4 y[2];
#pragma unroll
                    for (int r = 0; r < 2; ++r) { const float rstd = 1.0f / __builtin_sqrtf(ss[r] * (1.0f / DM) + EPS); y[r] = (v[r][j] * rstd) * gm + sh;
                        *((GAS unsigned*)(XN8 + (size_t)(m0 + r) * DM) + lane + 64 * j) = pk4f8(y[r].x, y[r].y, y[r].z, y[r].w); }
#pragma unroll
                    for (int cc = 0; cc < 4; ++cc) { const f32x4 w0 = *(const f32x4*)(wrt + (size_t)(col + cc) * 8), w1 = *(const f32x4*)(wrt + (size_t)(col + cc) * 8 + 4);
#pragma unroll
                        for (int r = 0; r < 2; ++r) { const float yv = y[r][cc];
                            lg[r][0] += yv * w0.x; lg[r][1] += yv * w0.y; lg[r][2] += yv * w0.z; lg[r][3] += yv * w0.w; lg[r][4] += yv * w1.x; lg[r][5] += yv * w1.y; lg[r][6] += yv * w1.z; lg[r][7] += yv * w1.w; } } }
#pragma unroll
                for (int o = 1; o < 64; o <<= 1) {
#pragma unroll
                    for (int r = 0; r < 2; ++r)
#pragma unroll
                        for (int e = 0; e < 8; ++e) lg[r][e] += __shfl_xor(lg[r][e], o); }
#pragma unroll
                for (int r = 0; r < 2; ++r) {
                    int ea = 0; float va = lg[r][0];
#pragma unroll
                    for (int e = 1; e < 8; ++e) if (lg[r][e] > va) { va = lg[r][e]; ea = e; }
                    int eb = -1; float vb2 = -INFINITY;
#pragma unroll
                    for (int e = 0; e < 8; ++e) if (e != ea && lg[r][e] > vb2) { vb2 = lg[r][e]; eb = e; }
                    const float wb = 1.0f / (1.0f + __expf(va - vb2)), wa = 1.0f - wb;
                    if (lane == 0) { const int tl = tl0 + r; l_e[tl * 2] = ea; l_e[tl * 2 + 1] = eb; l_w[tl * 2] = wa; l_w[tl * 2 + 1] = wb; } }
            }
            __syncthreads();
            int ea = 0, eb = 0, pa = 0, pb = 0;
            if (tid < 128) { ea = l_e[tid * 2]; eb = l_e[tid * 2 + 1]; pa = atomicAdd((int*)&l_cnt[ea], 1); pb = atomicAdd((int*)&l_cnt[eb], 1); }
            __syncthreads();
            if (tid < 8) l_base[tid] = (int)__hip_atomic_fetch_add((unsigned*)(ctl + CW_CNT + 64 * tid), (unsigned)l_cnt[tid], __ATOMIC_RELAXED, __HIP_MEMORY_SCOPE_AGENT);
            __syncthreads();
            if (tid < 128) { const int m = blk * 128 + tid; pa += l_base[ea]; pb += l_base[eb];
                LIST[(size_t)ea * NLAT + pa] = m; LIST[(size_t)eb * NLAT + pb] = m;
                int* ti = TINFO + (size_t)m * 8; ti[0] = ea; ti[1] = pa; ti[2] = eb; ti[3] = pb; ti[4] = __float_as_int(l_w[tid * 2]); ti[5] = __float_as_int(l_w[tid * 2 + 1]); }
            __syncthreads();
        }
        if (BOTH(12)) GRID_BAR(); PROBE_MARK(12);
    }
    if (hi_ph > 13 && lo < 23) {
        PHASE_IDS();
        LAS int* mtab = (LAS int*)(lds + MOE_OFF);
        if (tid == 0) { int run = 0, R = 0;
            for (int e = 0; e < 8; ++e) { const int ce = (int)__hip_atomic_load((unsigned*)(ctl + CW_CNT + 64 * e), __ATOMIC_RELAXED, __HIP_MEMORY_SCOPE_AGENT); mtab[e] = run; mtab[16 + e] = ce; run += ce >> 8; if (ce & 255) { mtab[24 + R] = e; ++R; } }
            mtab[8] = run; mtab[32] = R; }
        __syncthreads();
        const int nfull = __builtin_amdgcn_readfirstlane(mtab[8]);
        for (int c = 0; c < MOE_NCH; ++c) {
            const int gp0 = c * MOE_CH, gp1 = nfull < (c + 1) * MOE_CH ? nfull : (c + 1) * MOE_CH;
            if (IN(13 + 2 * c)) {
                pg8::MoeSched S; S.A = (const char*)XN8; S.B = (const char*)MGU; S.list = LIST; S.tab = mtab; S.mode = 0; S.nS = 1; S.kbytes = 0;
                S.gp0 = gp0; S.gp1 = gp1; S.nN = 28; S.G = G; S.c = bx; S.bexp = (size_t)7168 * 1024; S.btile = (size_t)256 * 1024; S.astep = 0; S.gather = true;
                pg8::EpiSwiGLU8 E{HC, 1.0f / MOE_SGU};
                pg8::gemm_phase<pg8::EpiSwiGLU8, pg8::MoeSched, true, true, true>(lds, gtab, 512, 8, S, E);
                if (BOTH(13 + 2 * c)) GRID_BAR(); PROBE_MARK(13 + 2 * c);
            }
            if (IN(14 + 2 * c)) {
                pg8::MoeSched S; S.A = (const char*)HC; S.B = (const char*)MD; S.list = LIST; S.tab = mtab; S.mode = 0; S.nS = 1; S.kbytes = 0;
                S.gp0 = gp0; S.gp1 = gp1; S.nN = 4; S.G = G; S.c = bx; S.bexp = (size_t)1024 * DFF; S.btile = (size_t)256 * DFF; S.astep = (size_t)256 * DFF; S.gather = false;
                pg8::EpiBf16Plain E{YB, DM, 1.0f / MOE_SD};
                pg8::gemm_phase<pg8::EpiBf16Plain, pg8::MoeSched, true, false, true>(lds, gtab, DFF / 2, 28, S, E);
                if (BOTH(14 + 2 * c)) GRID_BAR(); PROBE_MARK(14 + 2 * c);
            }
        }
        if (IN(21)) {
            pg8::MoeSched S; S.A = (const char*)XN8; S.B = (const char*)MGU; S.list = LIST; S.tab = mtab; S.mode = 1; S.nS = 1; S.kbytes = 0;
            S.gp0 = 0; S.gp1 = 0; S.nN = 28; S.G = G; S.c = bx; S.bexp = (size_t)7168 * 1024; S.btile = (size_t)256 * 1024; S.astep = 0; S.gather = true;
            pg8::EpiSwiGLU8 E{HC, 1.0f / MOE_SGU};
            pg8::gemm_phase<pg8::EpiSwiGLU8, pg8::MoeSched, true, true, true>(lds, gtab, 512, 8, S, E);
            if (BOTH(21)) GRID_BAR(); PROBE_MARK(21);
        }
        if (IN(22)) {
            pg8::MoeSched S; S.A = (const char*)HC; S.B = (const char*)MD; S.list = LIST; S.tab = mtab; S.mode = 2; S.nS = MOE_RS; S.kbytes = (size_t)(DFF / MOE_RS);
            S.gp0 = 0; S.gp1 = 0; S.nN = 4; S.G = G; S.c = bx; S.bexp = (size_t)1024 * DFF; S.btile = (size_t)256 * DFF; S.astep = (size_t)256 * DFF; S.gather = false;
            pg8::EpiPartBf16 E{YP, (size_t)8 * 256 * DM, 1.0f / MOE_SD};
            pg8::gemm_phase<pg8::EpiPartBf16, pg8::MoeSched, true, false, true>(lds, gtab, DFF / 2, DFF / MOE_RS / 128, S, E);
            if (BOTH(22)) GRID_BAR(); PROBE_MARK(22);
        }
    }
    if (IN(23)) {
        PHASE_IDS();
        LAS int* l_pb = (LAS int*)(lds + wave * 128);
        if (lane == 0) { int run = 0, R = 0;
            for (int e = 0; e < 8; ++e) { const int ce = (int)__hip_atomic_load((unsigned*)(ctl + CW_CNT + 64 * e), __ATOMIC_RELAXED, __HIP_MEMORY_SCOPE_AGENT); l_pb[e] = run; l_pb[8 + e] = ce >> 8; l_pb[16 + e] = R; run += ce >> 8; if (ce & 255) ++R; } }
        const float* g2 = MOD + 5 * 6144 + 5 * 1024;
        for (int m0 = gw * 2; m0 < NLAT; m0 += NGW * 2) {
            const int mb = m0 >> 13;
            f32x4 hv[2][4], ya[2][4], yb[2][4]; float wa[2], wb[2];
#pragma unroll
            for (int r = 0; r < 2; ++r) {
                const int m = m0 + r; const int* ti = TINFO + (size_t)m * 8;
                const int ea = ti[0], pa = ti[1], eb = ti[2], pb = ti[3]; wa[r] = __int_as_float(ti[4]); wb[r] = __int_as_float(ti[5]);
                const bool ma = (pa >> 8) < l_pb[8 + ea], mbm = (pb >> 8) < l_pb[8 + eb];
                const size_t sa = ma ? (size_t)(l_pb[ea] + (pa >> 8)) * 256 + (pa & 255) : (size_t)l_pb[16 + ea] * 256 + (pa & 255);
                const size_t sb = mbm ? (size_t)(l_pb[eb] + (pb >> 8)) * 256 + (pb & 255) : (size_t)l_pb[16 + eb] * 256 + (pb & 255);
                const GAS u32x2* xr = (const GAS u32x2*)(HL + (size_t)m * DM) + lane;
#pragma unroll
                for (int j = 0; j < 4; ++j) { const u32x2 w = xr[64 * j]; hv[r][j] = (f32x4){__uint_as_float(w.x << 16), __uint_as_float(w.x & 0xffff0000u), __uint_as_float(w.y << 16), __uint_as_float(w.y & 0xffff0000u)}; }
                { const GAS u32x2* yr = (const GAS u32x2*)((ma ? YB : YP) + sa * DM) + lane;
#pragma unroll
                  for (int j = 0; j < 4; ++j) { const u32x2 a = yr[64 * j]; ya[r][j] = (f32x4){__uint_as_float(a.x << 16), __uint_as_float(a.x & 0xffff0000u), __uint_as_float(a.y << 16), __uint_as_float(a.y & 0xffff0000u)}; }
                  if (!ma) for (int s2 = 1; s2 < MOE_RS; ++s2) { const GAS u32x2* y2 = (const GAS u32x2*)(YP + ((size_t)s2 * 8 * 256 + sa) * DM) + lane;
#pragma unroll
                      for (int j = 0; j < 4; ++j) { const u32x2 a = y2[64 * j]; ya[r][j] += (f32x4){__uint_as_float(a.x << 16), __uint_as_float(a.x & 0xffff0000u), __uint_as_float(a.y << 16), __uint_as_float(a.y & 0xffff0000u)}; } } }
                { const GAS u32x2* yr = (const GAS u32x2*)((mbm ? YB : YP) + sb * DM) + lane;
#pragma unroll
                  for (int j = 0; j < 4; ++j) { const u32x2 a = yr[64 * j]; yb[r][j] = (f32x4){__uint_as_float(a.x << 16), __uint_as_float(a.x & 0xffff0000u), __uint_as_float(a.y << 16), __uint_as_float(a.y & 0xffff0000u)}; }
                  if (!mbm) for (int s2 = 1; s2 < MOE_RS; ++s2) { const GAS u32x2* y2 = (const GAS u32x2*)(YP + ((size_t)s2 * 8 * 256 + sb) * DM) + lane;
#pragma unroll
                      for (int j = 0; j < 4; ++j) { const u32x2 a = y2[64 * j]; yb[r][j] += (f32x4){__uint_as_float(a.x << 16), __uint_as_float(a.x & 0xffff0000u), __uint_as_float(a.y << 16), __uint_as_float(a.y & 0xffff0000u)}; } } }
            }
            float ss[2];
#pragma unroll
            for (int r = 0; r < 2; ++r) { ss[r] = 0.f;
#pragma unroll
                for (int j = 0; j < 4; ++j) { const f32x4 gv = *(const f32x4*)(g2 + (size_t)mb * 6144 + 4 * lane + 256 * j);
                    hv[r][j] = hv[r][j] + gv * (ya[r][j] * wa[r] + yb[r][j] * wb[r]); ss[r] += (hv[r][j].x * hv[r][j].x + hv[r][j].y * hv[r][j].y) + (hv[r][j].z * hv[r][j].z + hv[r][j].w * hv[r][j].w); } }
#pragma unroll
            for (int o = 1; o < 64; o <<= 1) {
#pragma unroll
                for (int r = 0; r < 2; ++r) ss[r] += __shfl_xor(ss[r], o); }
#pragma unroll
            for (int r = 0; r < 2; ++r) { const float rstd = 1.0f / __builtin_sqrtf(ss[r] * (1.0f / DM) + EPS);
                GAS f32x4* orow = (GAS f32x4*)(args.out + (size_t)(m0 + r) * DM) + lane;
#pragma unroll
                for (int j = 0; j < 4; ++j) { const f32x4 fg = *(const f32x4*)(I_FINALG + 4 * lane + 256 * j); __builtin_nontemporal_store((hv[r][j] * rstd) * fg, orow + 64 * j); } }
        }
    }
    PROBE_MARK(23);
#if defined(PROBE_LO)
    { PHASE_IDS(); const float T = (float)(tpB - tpA) * 0.01f; const float cval = __builtin_sqrtf(T / (float)(PROBE_UNIT));
      for (int m = gw; m < NLAT; m += NGW) { GAS f32x4* orow = (GAS f32x4*)(args.out + (size_t)m * DM) + lane;
#pragma unroll
        for (int j = 0; j < 4; ++j) orow[64 * j] = (f32x4){cval, cval, cval, cval}; } }
#endif
#undef IN
#undef BOTH
#undef GRID_BAR
}

#ifndef MK_ONE_LAUNCH
#define MK_ONE_LAUNCH 1
#endif
extern "C" void kernel_launch(void* const* d_in, const int* in_sizes, int n_in, void* d_out, int out_size, void* d_ws, size_t ws_size, hipStream_t stream) {
    static int grid = 0;
    if (grid == 0) {
        if (n_in != 24 || out_size != NLAT * DM || ws_size < WS_END) { fprintf(stderr, "kernel_launch: unexpected problem (n_in %d, out %d, ws %zu < %zu)\n", n_in, out_size, ws_size, (size_t)WS_END); grid = -1; return; }
        int dev = 0, cus = 0, per_cu = 0;
        if (hipGetDevice(&dev) != hipSuccess || hipDeviceGetAttribute(&cus, hipDeviceAttributeMultiprocessorCount, dev) != hipSuccess) { grid = -1; return; }
        if (hipFuncSetAttribute((const void*)fwd, hipFuncAttributeMaxDynamicSharedMemorySize, LDS_BYTES) != hipSuccess) { fprintf(stderr, "kernel_launch: hipFuncSetAttribute failed\n"); grid = -1; return; }
        if (hipOccupancyMaxActiveBlocksPerMultiprocessor(&per_cu, (const void*)fwd, 512, LDS_BYTES) != hipSuccess || per_cu < 1) fprintf(stderr, "kernel_launch: occupancy query says %d\n", per_cu);
        (void)hipGetLastError();
        grid = cus;
    }
    if (grid < 0) return;
    if (hipMemsetAsync((char*)d_ws + WS_CTL, 0, CTL_ZERO_BYTES, stream) != hipSuccess) return;
    Args a{};
    for (int i = 0; i < 24; ++i) a.in[i] = (const float*)d_in[i];
    a.out = (float*)d_out; a.ws = (unsigned char*)d_ws;
#if defined(SPLITAT)
    a.ph_lo = 0; a.ph_hi = SPLITAT; a.li = 0;
    hipLaunchKernelGGL(fwd, dim3(grid), dim3(512), LDS_BYTES, stream, a);
    a.ph_lo = SPLITAT; a.ph_hi = NPH; a.li = 1;
    hipLaunchKernelGGL(fwd, dim3(grid), dim3(512), LDS_BYTES, stream, a);
#elif defined(DUPK)
    a.ph_lo = 0; a.ph_hi = DUPK + 1; a.li = 0;
    hipLaunchKernelGGL(fwd, dim3(grid), dim3(512), LDS_BYTES, stream, a);
#ifdef DUPN
    for (int rep = 0; rep < DUPN; ++rep) { a.ph_lo = DUPK; a.ph_hi = DUPK + 1; a.li = 2; hipLaunchKernelGGL(fwd, dim3(grid), dim3(512), LDS_BYTES, stream, a); }
#endif
    a.ph_lo = DUPK; a.ph_hi = NPH; a.li = 1;
    hipLaunchKernelGGL(fwd, dim3(grid), dim3(512), LDS_BYTES, stream, a);
#elif MK_ONE_LAUNCH
    a.ph_lo = 0; a.ph_hi = NPH;
    hipLaunchKernelGGL(fwd, dim3(grid), dim3(512), LDS_BYTES, stream, a);
#else
    for (int p = 0; p < NPH; ++p) { a.ph_lo = p; a.ph_hi = p + 1; hipLaunchKernelGGL(fwd, dim3(grid), dim3(512), LDS_BYTES, stream, a); }
#endif
}
```

```cpp
#include <hip/hip_runtime.h>
#include <hip/hip_bf16.h>
#include <cstdio>
#include <cstdint>
#include <cmath>

constexpr int DM = 1024, NB = 4, SEQ = 8192, LCTX = 256, NLAT = NB * SEQ, NCTXR = NB * LCTX, MALL = NLAT + NCTXR;
constexpr int DFF = 3584, NEXP = 8, NQKV = 1536;
constexpr int NPL = NLAT / 256, NPA = MALL / 256;
constexpr float EPS = 1e-6f;
constexpr int MOE_CH = 128, MOE_NCH = 2;
constexpr float MOE_SGU = 32.0f, MOE_SD = 64.0f;
constexpr int MOE_RS = 7, P3_NS = 8, P5_NS = 14;

#define LAS __attribute__((address_space(3)))
#define GAS __attribute__((address_space(1)))
typedef unsigned short bf16_t;
typedef short bf16x8 __attribute__((ext_vector_type(8)));
typedef float f32x4 __attribute__((ext_vector_type(4)));
typedef float f32x2 __attribute__((ext_vector_type(2)));
typedef float f32x16 __attribute__((ext_vector_type(16)));
typedef unsigned u32x4 __attribute__((ext_vector_type(4)));
typedef unsigned u32x2 __attribute__((ext_vector_type(2)));
typedef __bf16 bf16x2_t __attribute__((ext_vector_type(2)));
typedef GAS unsigned gu32;

__device__ __forceinline__ unsigned pkbf(float lo, float hi) { f32x2 v = {lo, hi}; bf16x2_t b = __builtin_convertvector(v, bf16x2_t); return __builtin_bit_cast(unsigned, b); }
__device__ __forceinline__ unsigned pk4f8(float a, float b, float c, float d) { unsigned w = 0; w = __builtin_amdgcn_cvt_pk_fp8_f32(a, b, w, false); w = __builtin_amdgcn_cvt_pk_fp8_f32(c, d, w, true); return w; }
__device__ __forceinline__ float bf2f(unsigned short h) { return __builtin_bit_cast(float, (unsigned)h << 16); }
__device__ __forceinline__ float wave_sum(float v) {
#pragma unroll
    for (int o = 1; o < 64; o <<= 1) v += __shfl_xor(v, o);
    return v;
}
__device__ __forceinline__ float gelu_tanh(float x) {
    const float t = x * (1.0f + 0.044715f * x * x);
    const float e = __builtin_amdgcn_exp2f(-2.302208198f * t);
    return x * __builtin_amdgcn_rcpf(1.0f + e);
}
__device__ __forceinline__ float silu_f(float x) { return x * __builtin_amdgcn_rcpf(1.0f + __builtin_amdgcn_exp2f(-1.4426950409f * x)); }

constexpr size_t MiB = 1u << 20;
constexpr size_t WS_CTL = 0, CTL_ZERO_BYTES = 1 * MiB;
constexpr size_t WS_MOD = 1 * MiB;
constexpr size_t WS_ROPE = 1 * MiB + 256 * 1024;
constexpr size_t WS_STATS = 2 * MiB;
constexpr size_t WS_LIST = 5 * MiB;
constexpr size_t WS_TINFO = 6 * MiB;
constexpr size_t WS_WS = 7 * MiB;
constexpr size_t WS_WIN = 8 * MiB, WS_WAO = 12 * MiB, WS_WQKV = 14 * MiB, WS_WBO = 17 * MiB, WS_WGU = 19 * MiB, WS_WD = 33 * MiB;
constexpr size_t WS_MGU = 40 * MiB, WS_MD = 96 * MiB;
constexpr size_t WS_HLB = 124 * MiB;
constexpr size_t WS_XN = 208 * MiB;
constexpr size_t WS_ZB = 274 * MiB;
constexpr size_t WS_R = 278 * MiB;
constexpr size_t WS_UVT = WS_R, WS_A2 = WS_R + 132 * MiB, WS_PART1 = WS_R + 198 * MiB, WS_H = WS_R, WS_PART2 = WS_R + 231 * MiB;
constexpr size_t WS_QKV = WS_R, WS_O = WS_R + 99 * MiB;
constexpr size_t WS_Y = WS_R, WS_YP = WS_R + 128 * MiB, WS_HC = WS_R + 156 * MiB;
constexpr size_t WS_END = WS_R + 287 * MiB;
static_assert(WS_UVT + (size_t)2048 * MALL * 2 <= WS_A2 && WS_A2 + (size_t)MALL * DM * 2 <= WS_PART1 && WS_PART1 + (size_t)P3_NS * NCTXR * DM * 4 <= WS_END, "layer-0 mixer map");
static_assert(WS_H + (size_t)MALL * DFF * 2 <= WS_PART2 && WS_PART2 + (size_t)P5_NS * NCTXR * DM * 4 <= WS_END && WS_QKV + (size_t)MALL * NQKV * 2 <= WS_O && WS_O + (size_t)NLAT * DM * 2 <= WS_END, "region map");
static_assert(WS_Y + (size_t)256 * 256 * DM * 2 <= WS_YP && WS_YP + (size_t)MOE_RS * 8 * 256 * DM * 2 <= WS_HC && WS_HC + (size_t)(MOE_CH + 8) * 256 * DFF <= WS_END, "MoE map");
static_assert(WS_MD + (size_t)8 * DM * DFF <= WS_HLB && WS_HLB + (size_t)NLAT * DM * 2 <= WS_XN && WS_XN + (size_t)MALL * DM * 2 <= WS_ZB && WS_MD + (size_t)8 * DM * DFF <= WS_XN && WS_MGU + (size_t)8 * 7168 * DM <= WS_MD, "weights map");
constexpr int CW_TMO = 0, CW_CODE = 1;
constexpr int CW_CNT = 64;
constexpr int CW_BAR = 4096;

constexpr int RING_BYTES = 131072;
constexpr int GTAB_OFF = RING_BYTES;
constexpr int MOE_OFF = RING_BYTES + 1024;
constexpr int MISC_OFF = RING_BYTES + 2048;
constexpr int LDS_BYTES = 147456;

namespace pg8 {
constexpr int BM = 256, BK = 64, HALF = 128, HTB = HALF * BK * 2, STAGE_BYTES = 8 * HTB, NXCD = 8, WGM = 8;
__host__ __device__ __forceinline__ int lds_byte(int r, int c) { const int st = (r >> 4) * 2 + (c >> 5), rr = r & 15, cc = c & 31, ob = rr * 64 + cc * 2; return st * 1024 + (ob ^ (((ob >> 9) & 1) << 5)); }
__host__ __device__ __forceinline__ void stage_rc(int b, int& R, int& C) { const int st = b / 1024, sb = b % 1024, swz = sb ^ (((sb >> 9) & 1) << 5); R = (st >> 1) * 16 + swz / 64; C = (st & 1) * 32 + (swz % 64) / 2; }
__host__ __device__ __forceinline__ int perm32(int rho) { const int n = rho >> 4, i = rho & 15; return 8 * (i >> 2) + 4 * n + (i & 3); }

struct Unit { const char* a; const char* b; const int* gl; int pm, pn, om, nv, ks; };

__device__ __forceinline__ bool tile_order(int i, int G, int c, int nM, int nN, int& pm, int& pn) {
    const int nwg = nM * nN; const long L = (long)i * G + c; if (L >= nwg) return false;
    int wgid = (int)L; { const int q = nwg / NXCD, r = nwg % NXCD, xcd = wgid % NXCD, off = wgid / NXCD; wgid = (xcd < r ? xcd * (q + 1) : r * (q + 1) + (xcd - r) * q) + off; }
    const int nig = WGM * nN, gid = wgid / nig, fm = gid * WGM, gsz = (nM - fm) < WGM ? (nM - fm) : WGM;
    pm = fm + ((wgid % nig) % gsz); pn = (wgid % nig) / gsz; return true;
}
struct DenseSched {
    const char* A; const char* B; int nM, nN, G, c; size_t tstep;
    __device__ __forceinline__ bool next(int i, Unit& u) const {
        int pm, pn; if (!tile_order(i, G, c, nM, nN, pm, pn)) return false;
        u.a = A + (size_t)pm * tstep; u.b = B + (size_t)pn * tstep; u.gl = nullptr; u.pm = pm; u.pn = pn; u.om = pm; u.nv = 256; u.ks = 0; return true;
    }
};
typedef int v8i_t __attribute__((ext_vector_type(8)));
typedef int v4i_t __attribute__((ext_vector_type(4)));
__device__ __forceinline__ v8i_t cat8(bf16x8 lo, bf16x8 hi) { const v4i_t a = __builtin_bit_cast(v4i_t, lo), b = __builtin_bit_cast(v4i_t, hi); return __builtin_shufflevector(a, b, 0, 1, 2, 3, 4, 5, 6, 7); }
struct SplitSched {
    const char* A; const char* B; int nM, nN, nS, G, c, pm0; size_t tstep, kbytes;
    __device__ __forceinline__ bool next(int i, Unit& u) const {
        const int L = i * G + c; if (L >= nM * nN * nS) return false;
        const int ks = L % nS, t = L / nS, pn = t % nN, pm = t / nN;
        u.a = A + (size_t)pm * tstep + (size_t)ks * kbytes; u.b = B + (size_t)pn * tstep + (size_t)ks * kbytes; u.gl = nullptr; u.pm = pm0 + pm; u.pn = pn; u.om = pm; u.nv = 256; u.ks = ks; return true;
    }
};
struct MoeSched {
    const char* A; const char* B; const int* list; const LAS int* tab; int gp0, gp1, nN, nS, G, c, mode, omoff; size_t bexp, btile, astep, kbytes; bool gather;
    __device__ __forceinline__ bool next(int i, Unit& u) const {
        int pm, pn, ks = 0;
        if (mode == 0) { if (gp1 <= gp0) return false; if (!tile_order(i, G, c, gp1 - gp0, nN, pm, pn)) return false; }
        else { const int R = __builtin_amdgcn_readfirstlane(tab[32]); const int L = i * G + c; if (L >= R * nN * nS) return false; ks = L % nS; const int t = L / nS; pn = t % nN; pm = t / nN; }
        int e = 0, lp, nv;
        if (mode == 0) { const int gp = gp0 + pm;
#pragma unroll
            for (int k = 1; k < 8; ++k) e += (gp >= __builtin_amdgcn_readfirstlane(tab[k])) ? 1 : 0;
            lp = gp - __builtin_amdgcn_readfirstlane(tab[e]); nv = 256; u.pm = gp; }
        else { e = __builtin_amdgcn_readfirstlane(tab[24 + pm]); const int ce = __builtin_amdgcn_readfirstlane(tab[16 + e]); lp = ce >> 8; nv = ce & 255; u.pm = pm; }
        u.b = B + (size_t)e * bexp + (size_t)pn * btile + (size_t)ks * kbytes; u.pn = pn; u.nv = nv; u.ks = ks; u.om = pm;
        if (gather) { u.a = A; u.gl = list + (size_t)e * NLAT + 256 * lp; u.om = pm + omoff; }
        else { u.a = A + (size_t)pm * astep + (size_t)ks * kbytes; u.gl = nullptr; if (mode == 0) u.om = gp0 + pm; }
        return true;
    }
};

struct EpiGeluT {
    static constexpr bool PERM = true;
    bf16_t* O; float* stats;
    __device__ __forceinline__ void operator()(const f32x4 (&acc)[2][2][4][2], const Unit& u, int wr, int wc, int fr, int fq) const {
        const int row0 = u.pm * BM + wr * 64 + fr, col0 = u.pn * BM + wc * 32 + 8 * fq;
        const bool isv = u.pm >= 4;
        float s1[2][2][4], s2[2][2][4];
#pragma unroll
        for (int bj = 0; bj < 2; ++bj)
#pragma unroll
            for (int n = 0; n < 2; ++n)
#pragma unroll
                for (int e = 0; e < 4; ++e) { s1[bj][n][e] = 0.f; s2[bj][n][e] = 0.f; }
#pragma unroll
        for (int ai = 0; ai < 2; ++ai)
#pragma unroll
            for (int m = 0; m < 4; ++m) { bf16_t* rowp = O + (size_t)(row0 + ai * HALF + m * 16) * MALL + col0;
#pragma unroll
                for (int bj = 0; bj < 2; ++bj) { f32x4 v0 = acc[ai][bj][m][0], v1 = acc[ai][bj][m][1];
#pragma unroll
                    for (int e = 0; e < 4; ++e) { v0[e] = gelu_tanh(v0[e]); v1[e] = gelu_tanh(v1[e]); s1[bj][0][e] += v0[e]; s2[bj][0][e] += v0[e] * v0[e]; s1[bj][1][e] += v1[e]; s2[bj][1][e] += v1[e] * v1[e]; }
                    u32x4 w; w.x = pkbf(v0[0], v0[1]); w.y = pkbf(v0[2], v0[3]); w.z = pkbf(v1[0], v1[1]); w.w = pkbf(v1[2], v1[3]);
                    *(u32x4*)(rowp + bj * HALF) = w; } }
        if (isv) {
            const int slot = (u.pm - 4) * 2 + wr;
#pragma unroll
            for (int bj = 0; bj < 2; ++bj)
#pragma unroll
                for (int n = 0; n < 2; ++n)
#pragma unroll
                    for (int e = 0; e < 4; ++e) { float a = s1[bj][n][e], b = s2[bj][n][e];
#pragma unroll
                        for (int o = 1; o < 16; o <<= 1) { a += __shfl_xor(a, o); b += __shfl_xor(b, o); }
                        if (fr == 0) { const int tok = col0 + bj * HALF + 4 * n + e; *(f32x2*)(stats + (size_t)tok * 16 + slot * 2) = (f32x2){a, b}; } }
        }
    }
};
template <bool BASE_F32> struct EpiResid {
    static constexpr bool PERM = true;
    const float* basef; const bf16_t* baseb; bf16_t* out; const float* gate;
    __device__ __forceinline__ void operator()(const f32x4 (&acc)[2][2][4][2], const Unit& u, int wr, int wc, int fr, int fq) const {
        const int mb = u.pm >> 5; const int col0 = u.pn * BM + wc * 32 + 8 * fq;
        f32x4 gv[2][2];
#pragma unroll
        for (int bj = 0; bj < 2; ++bj)
#pragma unroll
            for (int n = 0; n < 2; ++n) gv[bj][n] = *(const f32x4*)(gate + (size_t)mb * 6144 + col0 + bj * HALF + n * 4);
#pragma unroll
        for (int ai = 0; ai < 2; ++ai)
#pragma unroll
            for (int m = 0; m < 4; ++m) { const size_t off = (size_t)(u.pm * BM + wr * 64 + fr + ai * HALF + m * 16) * DM + col0;
#pragma unroll
                for (int bj = 0; bj < 2; ++bj) { f32x4 b0, b1;
                    if constexpr (BASE_F32) { b0 = *(const f32x4*)(basef + off + bj * HALF); b1 = *(const f32x4*)(basef + off + bj * HALF + 4); }
                    else { const u32x4 w = *(const u32x4*)(baseb + off + bj * HALF);
                        b0 = (f32x4){__uint_as_float(w.x << 16), __uint_as_float(w.x & 0xffff0000u), __uint_as_float(w.y << 16), __uint_as_float(w.y & 0xffff0000u)};
                        b1 = (f32x4){__uint_as_float(w.z << 16), __uint_as_float(w.z & 0xffff0000u), __uint_as_float(w.w << 16), __uint_as_float(w.w & 0xffff0000u)}; }
                    const f32x4 o0 = b0 + gv[bj][0] * acc[ai][bj][m][0], o1 = b1 + gv[bj][1] * acc[ai][bj][m][1];
                    u32x4 w; w.x = pkbf(o0[0], o0[1]); w.y = pkbf(o0[2], o0[3]); w.z = pkbf(o1[0], o1[1]); w.w = pkbf(o1[2], o1[3]);
                    *(u32x4*)(out + off + bj * HALF) = w; } }
    }
};
struct EpiSwiGLU {
    static constexpr bool PERM = true;
    bf16_t* O;
    __device__ __forceinline__ void operator()(const f32x4 (&acc)[2][2][4][2], const Unit& u, int wr, int wc, int fr, int fq) const {
        bf16_t* base = O + (size_t)(u.om * BM + wr * 64 + fr) * DFF + u.pn * 128 + wc * 32 + 8 * fq;
#pragma unroll
        for (int ai = 0; ai < 2; ++ai)
#pragma unroll
            for (int m = 0; m < 4; ++m) { const f32x4 g0 = acc[ai][0][m][0], g1 = acc[ai][0][m][1], u0 = acc[ai][1][m][0], u1 = acc[ai][1][m][1];
                float o[8];
#pragma unroll
                for (int e = 0; e < 4; ++e) { o[e] = silu_f(g0[e]) * u0[e]; o[4 + e] = silu_f(g1[e]) * u1[e]; }
                u32x4 w; w.x = pkbf(o[0], o[1]); w.y = pkbf(o[2], o[3]); w.z = pkbf(o[4], o[5]); w.w = pkbf(o[6], o[7]);
                *(u32x4*)(base + (size_t)(ai * HALF + m * 16) * DFF) = w; }
    }
};
struct EpiQKV {
    static constexpr bool PERM = false;
    bf16_t* O; const float* cosT; const float* sinT; float qscale;
    __device__ __forceinline__ void operator()(const f32x4 (&acc)[2][2][4][2], const Unit& u, int wr, int wc, int fr, int fq) const {
        const bool lat = u.pm < NPL; const bool dorope = lat && u.pn < 5; const float sc = u.pn < 4 ? qscale : 1.0f;
        const int col0 = u.pn * BM + wc * 32 + 4 * fq;
#pragma unroll
        for (int ai = 0; ai < 2; ++ai)
#pragma unroll
            for (int m = 0; m < 4; ++m) { const int grow = u.pm * BM + ai * HALF + wr * 64 + m * 16 + fr; const int s = grow & (SEQ - 1); const int pos = (wc & 1) ? (s & 63) : (s >> 6);
                f32x4 cs = (f32x4){1.f, 1.f, 1.f, 1.f}, sn = (f32x4){0.f, 0.f, 0.f, 0.f};
                if (dorope) { cs = *(const f32x4*)(cosT + pos * 16 + 4 * fq); sn = *(const f32x4*)(sinT + pos * 16 + 4 * fq); }
                bf16_t* rowp = O + (size_t)grow * NQKV + col0;
#pragma unroll
                for (int bj = 0; bj < 2; ++bj) { const f32x4 x1 = acc[ai][bj][m][0], x2 = acc[ai][bj][m][1];
                    const f32x4 o1 = (x1 * cs - x2 * sn) * sc, o2 = (x1 * sn + x2 * cs) * sc;
                    u32x2 w1, w2; w1.x = pkbf(o1[0], o1[1]); w1.y = pkbf(o1[2], o1[3]); w2.x = pkbf(o2[0], o2[1]); w2.y = pkbf(o2[2], o2[3]);
                    *(u32x2*)(rowp + bj * HALF) = w1; *(u32x2*)(rowp + bj * HALF + 16) = w2; } }
    }
};
struct EpiSwiGLU8 {
    static constexpr bool PERM = true;
    unsigned char* O; float s;
    __device__ __forceinline__ void operator()(const f32x4 (&acc)[2][2][4][2], const Unit& u, int wr, int wc, int fr, int fq) const {
        unsigned char* base = O + (size_t)(u.om * BM + wr * 64 + fr) * DFF + u.pn * 128 + wc * 32 + 8 * fq;
#pragma unroll
        for (int ai = 0; ai < 2; ++ai)
#pragma unroll
            for (int m = 0; m < 4; ++m) { const f32x4 g0 = acc[ai][0][m][0] * s, g1 = acc[ai][0][m][1] * s, u0 = acc[ai][1][m][0] * s, u1 = acc[ai][1][m][1] * s;
                float o[8];
#pragma unroll
                for (int e = 0; e < 4; ++e) { o[e] = silu_f(g0[e]) * u0[e]; o[4 + e] = silu_f(g1[e]) * u1[e]; }
                u32x2 w; w.x = pk4f8(o[0], o[1], o[2], o[3]); w.y = pk4f8(o[4], o[5], o[6], o[7]);
                *(u32x2*)(base + (size_t)(ai * HALF + m * 16) * DFF) = w; }
    }
};
struct EpiBf16Plain {
    static constexpr bool PERM = true;
    bf16_t* O; int ldc; float s;
    __device__ __forceinline__ void operator()(const f32x4 (&acc)[2][2][4][2], const Unit& u, int wr, int wc, int fr, int fq) const {
        bf16_t* base = O + (size_t)(u.om * BM + wr * 64 + fr) * ldc + u.pn * BM + wc * 32 + 8 * fq;
#pragma unroll
        for (int ai = 0; ai < 2; ++ai)
#pragma unroll
            for (int m = 0; m < 4; ++m)
#pragma unroll
                for (int bj = 0; bj < 2; ++bj) { const f32x4 v0 = acc[ai][bj][m][0] * s, v1 = acc[ai][bj][m][1] * s;
                    u32x4 w; w.x = pkbf(v0[0], v0[1]); w.y = pkbf(v0[2], v0[3]); w.z = pkbf(v1[0], v1[1]); w.w = pkbf(v1[2], v1[3]);
                    *(u32x4*)(base + (size_t)(ai * HALF + m * 16) * ldc + bj * HALF) = w; }
    }
};

struct EpiPartF32 {
    static constexpr bool PERM = true;
    float* P; size_t sstride;
    __device__ __forceinline__ void operator()(const f32x4 (&acc)[2][2][4][2], const Unit& u, int wr, int wc, int fr, int fq) const {
        float* base = P + (size_t)u.ks * sstride + (size_t)(u.om * BM + wr * 64 + fr) * DM + u.pn * BM + wc * 32 + 8 * fq;
#pragma unroll
        for (int ai = 0; ai < 2; ++ai)
#pragma unroll
            for (int m = 0; m < 4; ++m)
#pragma unroll
                for (int bj = 0; bj < 2; ++bj)
#pragma unroll
                    for (int n = 0; n < 2; ++n) *(f32x4*)(base + (size_t)(ai * HALF + m * 16) * DM + bj * HALF + n * 4) = acc[ai][bj][m][n];
    }
};
struct EpiPartBf16 {
    static constexpr bool PERM = true;
    bf16_t* P; size_t sstride; float s;
    __device__ __forceinline__ void operator()(const f32x4 (&acc)[2][2][4][2], const Unit& u, int wr, int wc, int fr, int fq) const {
        bf16_t* base = P + (size_t)u.ks * sstride + (size_t)(u.om * BM + wr * 64 + fr) * DM + u.pn * BM + wc * 32 + 8 * fq;
#pragma unroll
        for (int ai = 0; ai < 2; ++ai)
#pragma unroll
            for (int m = 0; m < 4; ++m)
#pragma unroll
                for (int bj = 0; bj < 2; ++bj) { const f32x4 v0 = acc[ai][bj][m][0] * s, v1 = acc[ai][bj][m][1] * s;
                    u32x4 w; w.x = pkbf(v0[0], v0[1]); w.y = pkbf(v0[2], v0[3]); w.z = pkbf(v1[0], v1[1]); w.w = pkbf(v1[2], v1[3]);
                    *(u32x4*)(base + (size_t)(ai * HALF + m * 16) * DM + bj * HALF) = w; }
    }
};

template <class Epi, class Sched, bool ALIGN_EPI, bool GATHER, bool FP8 = false>
__device__ __forceinline__ void gemm_phase(LAS unsigned char* lds, LAS int* gtab, const int K  , const int nt_in  , const Sched& S, const Epi& E) {
    int nt = nt_in; asm volatile("" : "+s"(nt));
    int tid_ = threadIdx.x; asm volatile("" : "+v"(tid_));
    const int tid = tid_, wid = __builtin_amdgcn_readfirstlane(tid >> 6), lane = tid & 63, wr = wid >> 2, wc = wid & 3, fr = lane & 15, fq = lane >> 4;
    const size_t kstep = (size_t)(BK * 2);
    const size_t hstep = (size_t)HALF * K * 2;
    unsigned voffB[2];
#pragma unroll
    for (int i = 0; i < 2; ++i) { int R, C; stage_rc(tid * 16 + i * 8192, R, C); const int Rb = Epi::PERM ? ((R & ~31) + perm32(R & 31)) : R;
        voffB[i] = (unsigned)(Rb * K + C) * 2u; }
    unsigned vA[2][2], vN[2][2];
    const unsigned ldsw = (unsigned)wid * 1024u;
    const int aoff = lds_byte(wr * 64 + fr, fq * 8), boff = lds_byte(wc * 32 + fr, fq * 8);
    const LAS unsigned char* aB = lds + aoff; const LAS unsigned char* bB = lds + 65536 + boff;
    asm volatile("" : "+v"(aB), "+v"(bB));
#define PG8_SA(b, h) (((b) * 2 + (h)) * HTB)
#define PG8_SB(b, h) ((4 + (b) * 2 + (h)) * HTB)
#define PG8_STAGE(bufoff, gbase, voff) do { _Pragma("unroll") for (int _i = 0; _i < 2; ++_i) \
        __builtin_amdgcn_global_load_lds((const unsigned*)((const char*)(gbase) + (voff)[_i]), (LAS unsigned*)(lds + (bufoff) + ldsw + _i * 8192), 16, 0, 0); } while (0)
#define PG8_LDA(dst, b, h) do { _Pragma("unroll") for (int m = 0; m < 4; ++m) { if constexpr (FP8) dst##8[m] = cat8(*(const LAS bf16x8*)(aB + PG8_SA(b, h) + m * 2048), *(const LAS bf16x8*)(aB + PG8_SA(b, h) + m * 2048 + 1024)); \
        else { _Pragma("unroll") for (int k = 0; k < 2; ++k) dst[m][k] = *(const LAS bf16x8*)(aB + PG8_SA(b, h) + m * 2048 + k * 1024); } } } while (0)
#define PG8_LDB(dst, b, h) do { _Pragma("unroll") for (int n = 0; n < 2; ++n) { if constexpr (FP8) dst##8[n] = cat8(*(const LAS bf16x8*)(bB + (PG8_SB(b, h) - 65536) + n * 2048), *(const LAS bf16x8*)(bB + (PG8_SB(b, h) - 65536) + n * 2048 + 1024)); \
        else { _Pragma("unroll") for (int k = 0; k < 2; ++k) dst[n][k] = *(const LAS bf16x8*)(bB + (PG8_SB(b, h) - 65536) + n * 2048 + k * 1024); } } } while (0)
#define PG8_MMA(ai, bj, At, Bt) do { __builtin_amdgcn_s_setprio(1); \
    if constexpr (FP8) { _Pragma("unroll") for (int m = 0; m < 4; ++m) _Pragma("unroll") for (int n = 0; n < 2; ++n) \
        asm volatile("v_mfma_f32_16x16x128_f8f6f4 %0, %1, %2, %0" : "+v"(acc[ai][bj][m][n]) : "v"(Bt##8[n]), "v"(At##8[m])); } \
    else { _Pragma("unroll") for (int m = 0; m < 4; ++m) _Pragma("unroll") for (int n = 0; n < 2; ++n) _Pragma("unroll") for (int k = 0; k < 2; ++k) \
        acc[ai][bj][m][n] = __builtin_amdgcn_mfma_f32_16x16x32_bf16(Bt[n][k], At[m][k], acc[ai][bj][m][n], 0, 0, 0); } \
    __builtin_amdgcn_s_setprio(0); } while (0)
#define PG8_WAIT_V(n) asm volatile("s_waitcnt vmcnt(" #n ")" ::: "memory")
#define PG8_WAIT_L(n) asm volatile("s_waitcnt lgkmcnt(" #n ")" ::: "memory")
#define PG8_BAR __builtin_amdgcn_s_barrier()
#define PG8_SCHED __builtin_amdgcn_sched_barrier(0)
    Unit cur, nxt; int ui = 0;
    if (!S.next(0, cur)) return;
    f32x4 acc[2][2][4][2];
#pragma unroll
    for (int a = 0; a < 2; ++a)
#pragma unroll
        for (int b = 0; b < 2; ++b)
#pragma unroll
            for (int m = 0; m < 4; ++m)
#pragma unroll
                for (int n = 0; n < 2; ++n) acc[a][b][m][n] = (f32x4){0.f, 0.f, 0.f, 0.f};
    bf16x8 At[4][2], B0[2][2], B1[2][2]; v8i_t At8[4], B08[2], B18[2];
    if constexpr (GATHER) {
#pragma unroll
        for (int h = 0; h < 2; ++h)
#pragma unroll
            for (int i = 0; i < 2; ++i) { int R, C; stage_rc(tid * 16 + i * 8192, R, C); const int row = h * HALF + R; const int tok = cur.gl[row < cur.nv ? row : 0]; vA[h][i] = (unsigned)tok * (unsigned)(K * 2) + (unsigned)C * 2u; }
    } else {
#pragma unroll
        for (int h = 0; h < 2; ++h)
#pragma unroll
            for (int i = 0; i < 2; ++i) { int R, C; stage_rc(tid * 16 + i * 8192, R, C); vA[h][i] = (unsigned)(R * K + C) * 2u + (unsigned)(h * hstep); }
    }
#pragma unroll
    for (int h = 0; h < 2; ++h)
#pragma unroll
        for (int i = 0; i < 2; ++i) vN[h][i] = vA[h][i];
    const char* cA = cur.a; const char* cB = cur.b;
    PG8_STAGE(PG8_SB(0, 0), cB, voffB); PG8_STAGE(PG8_SB(0, 1), cB + hstep, voffB); PG8_STAGE(PG8_SA(0, 0), cA, vA[0]); PG8_STAGE(PG8_SA(0, 1), cA, vA[1]);
    if (wr == 1) PG8_BAR;
    PG8_WAIT_V(2); PG8_BAR;
    PG8_STAGE(PG8_SB(1, 0), cB + kstep, voffB); PG8_STAGE(PG8_SA(1, 0), cA + kstep, vA[0]); PG8_STAGE(PG8_SB(1, 1), cB + hstep + kstep, voffB);
    PG8_WAIT_V(6); PG8_BAR;
    for (;;) {
        const bool has_next = S.next(ui + 1, nxt);
        const char* nA = has_next ? nxt.a : cA; const char* nB = has_next ? nxt.b : cB;
        if constexpr (GATHER) {
            if (has_next && wid < 4) __builtin_amdgcn_global_load_lds((const unsigned*)(nxt.gl + wid * 64 + lane), (LAS unsigned*)(gtab + wid * 64), 4, 0, 0);
        }
        for (int t = 0; t < nt; t += 2) {
            const bool last = (t == nt - 2);
            const char* a1 = cA + (size_t)(t + 1) * kstep;
            const char* a2 = last ? nA : cA + (size_t)(t + 2) * kstep; const char* b2 = last ? nB : cB + (size_t)(t + 2) * kstep;
            const char* a3 = a2 + kstep; const char* b3 = b2 + kstep;
            if constexpr (GATHER) {
                if (last && has_next) {
                    int t2 = tid; asm volatile("" : "+v"(t2));
#pragma unroll
                    for (int h = 0; h < 2; ++h)
#pragma unroll
                        for (int i = 0; i < 2; ++i) { int R, C; stage_rc(t2 * 16 + i * 8192, R, C); const int row = h * HALF + R; const int tok = gtab[row < nxt.nv ? row : 0]; vN[h][i] = (unsigned)tok * (unsigned)(K * 2) + (unsigned)C * 2u; }
                }
            }
            unsigned vS0[2], vS1[2];
#pragma unroll
            for (int i = 0; i < 2; ++i) { vS0[i] = (GATHER && last) ? vN[0][i] : vA[0][i]; vS1[i] = (GATHER && last) ? vN[1][i] : vA[1][i]; }
            PG8_LDB(B0, 0, 0); PG8_LDB(B1, 0, 1); PG8_SCHED; PG8_LDA(At, 0, 0); PG8_STAGE(PG8_SA(1, 1), a1, vA[1]);
            PG8_WAIT_V(8); PG8_WAIT_L(0); PG8_BAR; PG8_MMA(0, 0, At, B0); PG8_MMA(0, 1, At, B1); PG8_BAR; PG8_SCHED;
            PG8_LDA(At, 0, 1); PG8_STAGE(PG8_SB(0, 0), b2, voffB); PG8_STAGE(PG8_SB(0, 1), b2 + hstep, voffB); PG8_STAGE(PG8_SA(0, 0), a2, vS0);
            PG8_WAIT_V(8); PG8_WAIT_L(0); PG8_BAR; PG8_MMA(1, 0, At, B0); PG8_MMA(1, 1, At, B1); PG8_BAR; PG8_SCHED;
            PG8_LDB(B0, 1, 0); PG8_LDB(B1, 1, 1); PG8_SCHED; PG8_LDA(At, 1, 0); PG8_STAGE(PG8_SA(0, 1), a2, vS1);
            PG8_WAIT_V(8); PG8_WAIT_L(0); PG8_BAR; PG8_MMA(0, 0, At, B0); PG8_MMA(0, 1, At, B1); PG8_BAR; PG8_SCHED;
            PG8_LDA(At, 1, 1); PG8_STAGE(PG8_SB(1, 0), b3, voffB); PG8_STAGE(PG8_SB(1, 1), b3 + hstep, voffB); PG8_STAGE(PG8_SA(1, 0), a3, vS0);
            PG8_WAIT_V(8); PG8_WAIT_L(0); PG8_BAR; PG8_MMA(1, 0, At, B0); PG8_MMA(1, 1, At, B1); PG8_BAR; PG8_SCHED;
        }
        if constexpr (ALIGN_EPI) { if (wr == 0) PG8_BAR; }
        if constexpr (FP8) asm volatile("s_nop 15\n\ts_nop 15" ::: "memory");
        E(acc, cur, wr, wc, fr, fq);
        if (!has_next) break;
#pragma unroll
        for (int a = 0; a < 2; ++a)
#pragma unroll
            for (int b = 0; b < 2; ++b)
#pragma unroll
                for (int m = 0; m < 4; ++m)
#pragma unroll
                    for (int n = 0; n < 2; ++n) acc[a][b][m][n] = (f32x4){0.f, 0.f, 0.f, 0.f};
        cur = nxt; cA = nA; cB = nB; ++ui;
        if constexpr (GATHER) {
#pragma unroll
            for (int h = 0; h < 2; ++h)
#pragma unroll
                for (int i = 0; i < 2; ++i) vA[h][i] = vN[h][i];
        }
        if constexpr (ALIGN_EPI) { if (wr == 1) PG8_BAR; }
    }
    PG8_WAIT_V(0);
    if constexpr (!ALIGN_EPI) { if (wr == 0) PG8_BAR; }
    PG8_BAR;
#undef PG8_SA
#undef PG8_SB
#undef PG8_STAGE
#undef PG8_LDA
#undef PG8_LDB
#undef PG8_MMA
#undef PG8_WAIT_V
#undef PG8_WAIT_L
#undef PG8_BAR
#undef PG8_SCHED
}
}

namespace attn_body {
using bf16 = __hip_bfloat16;
using s16x4 = __attribute__((ext_vector_type(4))) short;
constexpr int D = 64, PITCH = NQKV, OPITCH = DM;
constexpr int NW = 8, QBLK = 32, KVBLK = 64;
__device__ __forceinline__ int crow(int r, int hi) { return (r & 3) + 8 * (r >> 2) + 4 * hi; }
#define SBAR() __builtin_amdgcn_sched_barrier(0)
__device__ __forceinline__ void bmask(f32x16& p0, f32x16& p1, int kb, int qrel, int hi) {
    const float NEG = -INFINITY; const int d0 = kb + 4 * hi - qrel;
#pragma unroll
    for (int r = 0; r < 16; ++r) { const int d = d0 + (r & 3) + 8 * (r >> 2); if (d < -128 || d > 128) p0[r] = NEG; if (d + 32 < -128 || d + 32 > 128) p1[r] = NEG; }
}
constexpr int NSLOT = 3, SLOTB = 8192;
constexpr int LDS_K = 0, LDS_V = NSLOT * SLOTB, LDS_WS = 2 * NSLOT * SLOTB, LDS_OST = LDS_WS + NW * 64 * 4, LDS_BYTES_A = LDS_OST + NW * 4096;
constexpr float C2 = 0.125f * 1.4426950408889634f;
__device__ __forceinline__ void glds16(const void* gsrc, unsigned lds_dst) { unsigned keep;
    asm volatile("s_mov_b32 %0, m0\n\ts_mov_b32 m0, %2\n\ts_nop 0\n\tglobal_load_lds_dwordx4 %1, off\n\ts_mov_b32 m0, %0" : "=&s"(keep) : "v"(gsrc), "s"(lds_dst) : "memory"); }
__device__ __forceinline__ float max3f(float a, float b, float c) { float r; asm("v_max3_f32 %0, %1, %2, %3" : "=v"(r) : "v"(a), "v"(b), "v"(c)); return r; }
__device__ __forceinline__ float max2f(float a, float b) { float r; asm("v_max_f32_e32 %0, %1, %2" : "=v"(r) : "v"(a), "v"(b)); return r; }
__device__ __forceinline__ float fadd_s(float a, float b) { float r; asm("v_add_f32_e32 %0, %1, %2" : "=v"(r) : "v"(a), "v"(b)); return r; }
__device__ __forceinline__ float fsub_s(float a, float b) { float r; asm("v_sub_f32_e32 %0, %1, %2" : "=v"(r) : "v"(a), "v"(b)); return r; }
__device__ __forceinline__ unsigned cvtpk_s(float lo, float hi) { f32x2 v = {lo, hi}; bf16x2_t b = __builtin_convertvector(v, bf16x2_t); return __builtin_bit_cast(unsigned, b); }
#define WAIT_BAR(N) asm volatile("s_waitcnt vmcnt(" #N ") lgkmcnt(0)\n\ts_barrier" ::: "memory")
__device__ __forceinline__ void qkt(f32x16& p0, f32x16& p1, const char* Kslot, const bf16x8* qr, const f32x16& negm, int r32, int hi) {
    const char* kb = Kslot + hi * 1024 + r32 * 16;
#pragma unroll
    for (int d0 = 0; d0 < 4; ++d0) {
        const bf16x8 b0 = *reinterpret_cast<const bf16x8*>(kb + d0 * 2048);
        const bf16x8 b1 = *reinterpret_cast<const bf16x8*>(kb + d0 * 2048 + 512);
        if (d0 == 0) { p0 = __builtin_amdgcn_mfma_f32_32x32x16_bf16(b0, qr[0], negm, 0, 0, 0); p1 = __builtin_amdgcn_mfma_f32_32x32x16_bf16(b1, qr[0], negm, 0, 0, 0); }
        else { p0 = __builtin_amdgcn_mfma_f32_32x32x16_bf16(b0, qr[d0], p0, 0, 0, 0); p1 = __builtin_amdgcn_mfma_f32_32x32x16_bf16(b1, qr[d0], p1, 0, 0, 0); } }
}
typedef __attribute__((address_space(3))) const char* lds_cptr;
typedef short v4i16_t __attribute__((ext_vector_type(4)));
__device__ __forceinline__ void kload8(bf16x8* kf, lds_cptr kp) {
    kf[0] = *(const __attribute__((address_space(3))) bf16x8*)(kp);        kf[1] = *(const __attribute__((address_space(3))) bf16x8*)(kp + 512);
    kf[2] = *(const __attribute__((address_space(3))) bf16x8*)(kp + 2048); kf[3] = *(const __attribute__((address_space(3))) bf16x8*)(kp + 2560);
    kf[4] = *(const __attribute__((address_space(3))) bf16x8*)(kp + 4096); kf[5] = *(const __attribute__((address_space(3))) bf16x8*)(kp + 4608);
    kf[6] = *(const __attribute__((address_space(3))) bf16x8*)(kp + 6144); kf[7] = *(const __attribute__((address_space(3))) bf16x8*)(kp + 6656);
}
__device__ __forceinline__ void kload2(bf16x8* kf, lds_cptr kp, int j) { kf[2 * j] = *(const __attribute__((address_space(3))) bf16x8*)(kp + j * 2048); kf[2 * j + 1] = *(const __attribute__((address_space(3))) bf16x8*)(kp + j * 2048 + 512); }
__device__ __forceinline__ s16x4 vtr(lds_cptr p) { return __builtin_bit_cast(s16x4, __builtin_amdgcn_ds_read_tr16_b64_v4i16((__attribute__((address_space(3))) v4i16_t*)p)); }
__device__ __forceinline__ float rowmax(const f32x16& p0, const f32x16& p1) {
    float a = max3f(p0[0], p0[1], p1[0]), b = max3f(p0[2], p0[3], p1[1]); a = max3f(a, p1[2], p1[3]);
#pragma unroll
    for (int r = 4; r < 16; r += 4) { a = max3f(a, p0[r], p0[r + 1]); b = max3f(b, p0[r + 2], p0[r + 3]); a = max3f(a, p1[r], p1[r + 1]); b = max3f(b, p1[r + 2], p1[r + 3]); }
    const float m = max2f(a, b);
    auto rr = __builtin_amdgcn_permlane32_swap(__float_as_uint(m), __float_as_uint(m), false, false);
    return max2f(__uint_as_float(rr[0]), __uint_as_float(rr[1]));
}
__device__ __forceinline__ void pv(f32x16* o, int vb, bf16x8 pa0, bf16x8 pa1, bf16x8 pa2, bf16x8 pa3) {
#pragma unroll
    for (int d0 = 0; d0 < 2; ++d0) { s16x4 lo[4], hi[4];
#pragma unroll
        for (int ks = 0; ks < 4; ++ks) {
            asm volatile("ds_read_b64_tr_b16 %0,%1 offset:%c2" : "=&v"(lo[ks]) : "v"(vb), "i"(d0 * 4096 + ks * 1024) : "memory");
            asm volatile("ds_read_b64_tr_b16 %0,%1 offset:%c2" : "=&v"(hi[ks]) : "v"(vb), "i"(d0 * 4096 + ks * 1024 + 512) : "memory"); }
        asm volatile("s_waitcnt lgkmcnt(0)" ::: "memory"); SBAR();
#define PK(k) (bf16x8){lo[k][0], lo[k][1], lo[k][2], lo[k][3], hi[k][0], hi[k][1], hi[k][2], hi[k][3]}
        o[d0] = __builtin_amdgcn_mfma_f32_32x32x16_bf16(pa0, PK(0), o[d0], 0, 0, 0);
        o[d0] = __builtin_amdgcn_mfma_f32_32x32x16_bf16(pa1, PK(1), o[d0], 0, 0, 0);
        o[d0] = __builtin_amdgcn_mfma_f32_32x32x16_bf16(pa2, PK(2), o[d0], 0, 0, 0);
        o[d0] = __builtin_amdgcn_mfma_f32_32x32x16_bf16(pa3, PK(3), o[d0], 0, 0, 0);
#undef PK
    }
}
#define ATTN_STORE16(p, v) (*(u32x4*)(p) = (v))
template <int THRL> __device__ __forceinline__ void attn_unit(int b, int hk, int n, int pr, const bf16* QKV, bf16* O, const float* sinkp, char* shm) {
    int tid_ = threadIdx.x; asm volatile("" : "+v"(tid_));
    const int tid = tid_, lane = tid & 63, r32 = lane & 31, hi = lane >> 5; const int wid = __builtin_amdgcn_readfirstlane(tid >> 6);
    const int head = 4 * hk + 2 * pr + (wid >> 2);
    const long rowblk = (long)b * SEQ + n * 128;
    const long ctxrow = (long)NLAT + b * LCTX;
    const int nlo = n > 0 ? 2 : 0, nhi = n < (SEQ / 128 - 1) ? 2 : 0;
    const int NT = 6 + nlo + nhi;
    const bf16* Qw = QKV + (rowblk + (wid & 3) * QBLK) * PITCH + head * D;
    const bf16* Kc = QKV + 1024 + hk * D; const bf16* Vc = QKV + 1280 + hk * D;
    const unsigned lds0 = (unsigned)(uintptr_t)shm;
    float* wsf = (float*)(shm + LDS_WS) + wid * 64;
    const long klane = (long)lane * PITCH + wid * 8;
    const long vlane = (long)(16 * (wid & 3) + (lane >> 2)) * PITCH + (wid >> 2) * 32 + (lane & 3) * 8;
    const unsigned kdst = lds0 + LDS_K + wid * 1024, vdst = lds0 + LDS_V + wid * 1024;
#define TROW(t) (((t) < 2) ? (rowblk + 64 * (t)) : ((t) < 6) ? (ctxrow + 64 * ((t) - 2)) : (rowblk + ((((t) - 6) < nlo) ? (-128 + 64 * ((t) - 6)) : (128 + 64 * ((t) - 6 - nlo)))))
#define TKB(t) (((t) < 6) ? 0 : ((((t) - 6) < nlo) ? (-128 + 64 * ((t) - 6)) : (128 + 64 * ((t) - 6 - nlo))))
#define DMA_K(t, slot) glds16(Kc + TROW(t) * PITCH + klane, (unsigned)__builtin_amdgcn_readfirstlane(kdst + (slot)))
#define DMA_V(t, slot) glds16(Vc + TROW(t) * PITCH + vlane, (unsigned)__builtin_amdgcn_readfirstlane(vdst + (slot)))
    const int vb0 = (int)(lds0 + LDS_V) + ((lane >> 4) & 1) * 32 + (lane & 3) * 8 + (4 * hi + ((lane & 15) >> 2)) * 64;
    const char* Kbase = shm + LDS_K; bf16x8 kf[8];
    const lds_cptr shm3 = (lds_cptr)shm; const lds_cptr kp0 = shm3 + LDS_K + hi * 1024 + r32 * 16; const lds_cptr vp0 = shm3 + LDS_V + ((lane >> 4) & 1) * 32 + (lane & 3) * 8 + (4 * hi + ((lane & 15) >> 2)) * 64;
    DMA_K(0, 0); DMA_V(0, 0); DMA_K(1, SLOTB);
    bf16x8 qr[4];
#pragma unroll
    for (int d0 = 0; d0 < 4; ++d0) qr[d0] = *reinterpret_cast<const bf16x8*>(&Qw[(long)r32 * PITCH + d0 * 16 + hi * 8]);
    float mhat = 0.f, l_reg = 0.f; f32x16 o[2]; o[0] = f32x16{}; o[1] = f32x16{}; f32x16 negm = f32x16{}; asm volatile("" : "+v"(negm));
    const int qrel = (wid & 3) * QBLK + r32;
#define CMASK(P0, P1, t) do { int jb_ = (t) - (NT - 4); if (jb_ >= 0) bmask(P0, P1, TKB(t), qrel, hi); } while (0)
    bool resc = false;
#define START(P0, P1) do { const float rm = rowmax(P0, P1); resc = false; \
    { const float dl = rm; mhat = fadd_s(mhat, dl); \
      _Pragma("unroll") for (int r = 0; r < 16; ++r) { P0[r] = fsub_s(P0[r], dl); P1[r] = fsub_s(P1[r], dl); } \
      _Pragma("unroll") for (int r = 0; r < 16; ++r) negm[r] = -mhat; asm volatile("" : "+v"(negm)); } \
    _Pragma("unroll") for (int r = 0; r < 16; ++r) P0[r] = __builtin_amdgcn_exp2f(P0[r]); } while (0)
#define RESC() do { if (resc) { asm volatile("s_waitcnt lgkmcnt(0)" ::: "memory"); \
      _Pragma("unroll") for (int d_ = 0; d_ < 2; ++d_) _Pragma("unroll") for (int r = 0; r < 16; ++r) o[d_][r] *= wsf[crow(r, hi)]; } } while (0)
    f32x16 pA0, pA1, pB0, pB1;
    int sl_prev = 0, sl_cur = 0, sl_next = SLOTB;
#define ROT() do { sl_prev = sl_cur; sl_cur = sl_next; sl_next = (sl_next == (NSLOT - 1) * SLOTB) ? 0 : sl_next + SLOTB; } while (0)
    DMA_K(2, 2 * SLOTB);
    WAIT_BAR(3);
    qkt(pA0, pA1, Kbase, qr, negm, r32, hi); asm volatile("s_nop 15\n\ts_nop 7" : "+v"(pA0), "+v"(pA1));
    START(pA0, pA1);
    _Pragma("unroll") for (int r = 0; r < 16; ++r) pA1[r] = __builtin_amdgcn_exp2f(pA1[r]);
    WAIT_BAR(0);
    DMA_K(3, 0); DMA_V(1, SLOTB);
    ROT();
    kload8(kf, kp0 + sl_cur);
    WAIT_BAR(2);
    s16x4 vlo[8], vhi[8]; u32x4 pw0, pw1, pw2, pw3;
#define PKW(P, B) cvtpk_s(P[B], P[B + 1])
#define PAF(k) __builtin_bit_cast(bf16x8, pw##k)
#define VFR(i) (bf16x8){vlo[i][0], vlo[i][1], vlo[i][2], vlo[i][3], vhi[i][0], vhi[i][1], vhi[i][2], vhi[i][3]}
#define PIN(x) asm volatile("" : "+v"(x))
#define MX3(a, b, c) __builtin_fmaxf(__builtin_fmaxf((a), (b)), (c))
#define GAPA(MF, A0, A1, A2, A3, W0, W1, PW) do { MF; sacc += A0; sacc += A1; sacc += A2; sacc += A3; PIN(sacc); W0; W1; PIN(PW); SBAR(); } while (0)
#define EX(v) __builtin_amdgcn_exp2f(v)
#define GAPB(MF, X, B) do { MF; X[B] = EX(X[B]); X[B + 1] = EX(X[B + 1]); X[B + 2] = EX(X[B + 2]); X[B + 3] = EX(X[B + 3]); PIN(X); SBAR(); } while (0)
#define VRD(i) do { vlo[i] = vtr(vp_ + (((i) >> 2) * 4096 + ((i) & 3) * 1024)); vhi[i] = vtr(vp_ + (((i) >> 2) * 4096 + ((i) & 3) * 1024 + 512)); } while (0)
#define KRD(G, j) do { if (G) { kload2(kf, kp0 + sl_next, j); SBAR(); } } while (0)
#define STEP(C0, C1, P0, P1, t, GK, GV, GL) do { SBAR(); \
    const lds_cptr vp_ = vp0 + sl_prev; \
    VRD(0); SBAR(); float sacc = (P0[0] + P0[1]); \
    GAPA(C0 = __builtin_amdgcn_mfma_f32_32x32x16_bf16(kf[0], qr[0], negm, 0, 0, 0), P0[2], P0[3], P0[4], P0[5],     pw0[0] = PKW(P0, 0), pw0[1] = PKW(P0, 2), pw0); \
    VRD(4); SBAR(); GAPA(C1 = __builtin_amdgcn_mfma_f32_32x32x16_bf16(kf[1], qr[0], negm, 0, 0, 0), P0[6], P0[7], P0[8], P0[9],     pw0[2] = PKW(P0, 4), pw0[3] = PKW(P0, 6), pw0); \
    VRD(1); SBAR(); GAPA(C0 = __builtin_amdgcn_mfma_f32_32x32x16_bf16(kf[2], qr[1], C0, 0, 0, 0),   P0[10], P0[11], P0[12], P0[13], pw1[0] = PKW(P0, 8), pw1[1] = PKW(P0, 10), pw1); \
    VRD(5); SBAR(); GAPA(C1 = __builtin_amdgcn_mfma_f32_32x32x16_bf16(kf[3], qr[1], C1, 0, 0, 0),   P0[14], P0[15], P1[0], P1[1],   pw1[2] = PKW(P0, 12), pw1[3] = PKW(P0, 14), pw1); \
    VRD(2); SBAR(); GAPA(C0 = __builtin_amdgcn_mfma_f32_32x32x16_bf16(kf[4], qr[2], C0, 0, 0, 0),   P1[2], P1[3], P1[4], P1[5],     pw2[0] = PKW(P1, 0), pw2[1] = PKW(P1, 2), pw2); \
    VRD(6); SBAR(); GAPA(C1 = __builtin_amdgcn_mfma_f32_32x32x16_bf16(kf[5], qr[2], C1, 0, 0, 0),   P1[6], P1[7], P1[8], P1[9],     pw2[2] = PKW(P1, 4), pw2[3] = PKW(P1, 6), pw2); \
    VRD(3); SBAR(); GAPA(C0 = __builtin_amdgcn_mfma_f32_32x32x16_bf16(kf[6], qr[3], C0, 0, 0, 0),   P1[10], P1[11], P1[12], P1[13], pw3[0] = PKW(P1, 8), pw3[1] = PKW(P1, 10), pw3); \
    VRD(7); SBAR(); GAPA(C1 = __builtin_amdgcn_mfma_f32_32x32x16_bf16(kf[7], qr[3], C1, 0, 0, 0),   P1[14], P1[15], 0.f, 0.f,       pw3[2] = PKW(P1, 12), pw3[3] = PKW(P1, 14), pw3); \
    l_reg += sacc; \
    if (GK) { DMA_K((t) + 3, sl_cur); } if (GV) { DMA_V((t) + 1, sl_next); } \
    CMASK(C0, C1, t); \
    { float a = MX3(C0[0], C0[1], C1[0]), b = MX3(C0[2], C0[3], C1[1]); a = MX3(a, C1[2], C1[3]); \
      _Pragma("unroll") for (int r = 4; r < 16; r += 4) { a = MX3(a, C0[r], C0[r + 1]); b = MX3(b, C0[r + 2], C0[r + 3]); a = MX3(a, C1[r], C1[r + 1]); b = MX3(b, C1[r + 2], C1[r + 3]); } \
      float rm = __builtin_fmaxf(a, b); { auto rr = __builtin_amdgcn_permlane32_swap(__float_as_uint(rm), __float_as_uint(rm), false, false); rm = __builtin_fmaxf(__uint_as_float(rr[0]), __uint_as_float(rr[1])); } \
      resc = false; \
      if (__builtin_expect(__any(rm > (float)THRL), 0)) { const float dl = __builtin_fmaxf(rm, 0.f); mhat += dl; \
        _Pragma("unroll") for (int r = 0; r < 16; ++r) { C0[r] -= dl; C1[r] -= dl; } \
        _Pragma("unroll") for (int r = 0; r < 16; ++r) negm[r] = -mhat; asm volatile("" : "+v"(negm)); \
        const float f = __builtin_amdgcn_exp2f(-dl); l_reg *= f; if (hi == 0) wsf[r32] = f; resc = true; } } \
    SBAR(); \
    GAPB(o[0] = __builtin_amdgcn_mfma_f32_32x32x16_bf16(PAF(0), VFR(0), o[0], 0, 0, 0), C0, 0); \
    GAPB(o[1] = __builtin_amdgcn_mfma_f32_32x32x16_bf16(PAF(0), VFR(4), o[1], 0, 0, 0), C0, 4); \
    KRD(GL, 0); GAPB(o[0] = __builtin_amdgcn_mfma_f32_32x32x16_bf16(PAF(1), VFR(1), o[0], 0, 0, 0), C0, 8); \
    KRD(GL, 1); GAPB(o[1] = __builtin_amdgcn_mfma_f32_32x32x16_bf16(PAF(1), VFR(5), o[1], 0, 0, 0), C0, 12); \
    KRD(GL, 2); GAPB(o[0] = __builtin_amdgcn_mfma_f32_32x32x16_bf16(PAF(2), VFR(2), o[0], 0, 0, 0), C1, 0); \
    KRD(GL, 3); GAPB(o[1] = __builtin_amdgcn_mfma_f32_32x32x16_bf16(PAF(2), VFR(6), o[1], 0, 0, 0), C1, 4); \
    GAPB(o[0] = __builtin_amdgcn_mfma_f32_32x32x16_bf16(PAF(3), VFR(3), o[0], 0, 0, 0), C1, 8); \
    GAPB(o[1] = __builtin_amdgcn_mfma_f32_32x32x16_bf16(PAF(3), VFR(7), o[1], 0, 0, 0), C1, 12); \
    } while (0)
    int t = 1;
#undef CMASK
#define CMASK(P0, P1, t) do { } while (0)
    for (; t + 5 < NT; t += 2) {
        STEP(pB0, pB1, pA0, pA1, t, true, true, true);     WAIT_BAR(2); RESC(); ROT();
        STEP(pA0, pA1, pB0, pB1, t + 1, true, true, true); WAIT_BAR(2); RESC(); ROT();
    }
#undef CMASK
#define CMASK(P0, P1, t) do { int jb_ = (t) - (NT - 4); if (jb_ >= 0) bmask(P0, P1, TKB(t), qrel, hi); } while (0)
#define ENDW(tt) do { if ((tt) + 3 < NT) { WAIT_BAR(2); } else if ((tt) + 2 < NT) { WAIT_BAR(1); } else { WAIT_BAR(0); } } while (0)
    for (; t + 1 < NT; t += 2) {
        STEP(pB0, pB1, pA0, pA1, t, (t + 3 < NT), (t + 1 < NT), (t + 1 < NT));     ENDW(t);     RESC(); ROT();
        STEP(pA0, pA1, pB0, pB1, t + 1, (t + 4 < NT), (t + 2 < NT), (t + 2 < NT)); ENDW(t + 1); RESC(); ROT();
    }
    STEP(pB0, pB1, pA0, pA1, NT - 1, false, false, false); RESC();
    { float sacc = pB0[0] + pB0[1]; _Pragma("unroll") for (int r = 2; r < 16; ++r) sacc += pB0[r]; _Pragma("unroll") for (int r = 0; r < 16; ++r) sacc += pB1[r]; l_reg += sacc;
      pw0 = (u32x4){PKW(pB0, 0), PKW(pB0, 2), PKW(pB0, 4), PKW(pB0, 6)}; pw1 = (u32x4){PKW(pB0, 8), PKW(pB0, 10), PKW(pB0, 12), PKW(pB0, 14)}; pw2 = (u32x4){PKW(pB1, 0), PKW(pB1, 2), PKW(pB1, 4), PKW(pB1, 6)}; pw3 = (u32x4){PKW(pB1, 8), PKW(pB1, 10), PKW(pB1, 12), PKW(pB1, 14)};
      SBAR(); pv(o, vb0 + sl_cur, PAF(0), PAF(1), PAF(2), PAF(3)); }
#undef PKW
#undef PAF
#undef VFR
#undef PIN
#undef MX3
#undef GAPA
#undef GAPB
#undef EX
#undef VRD
#undef KRD
#undef STEP
#undef ENDW
    { auto rr = __builtin_amdgcn_permlane32_swap(__float_as_uint(l_reg), __float_as_uint(l_reg), false, false); l_reg = __uint_as_float(rr[0]) + __uint_as_float(rr[1]); }
    l_reg += __builtin_amdgcn_exp2f(sinkp[head] * 1.4426950408889634f - mhat);
    if (hi == 0) wsf[32 + r32] = l_reg; asm volatile("s_waitcnt lgkmcnt(0)" ::: "memory");
    float rli[16];
#pragma unroll
    for (int r = 0; r < 16; ++r) rli[r] = __builtin_amdgcn_rcpf(wsf[32 + crow(r, hi)]);
    bf16* Ow = O + (rowblk + (wid & 3) * QBLK) * OPITCH + head * D;
    { bf16* stg = (bf16*)(shm + LDS_OST) + wid * 2048;
#pragma unroll
      for (int r = 0; r < 16; ++r) { const int orow = crow(r, hi);
#pragma unroll
        for (int d0 = 0; d0 < 2; ++d0) stg[orow * 64 + d0 * 32 + r32] = __float2bfloat16(o[d0][r] * rli[r]); }
      asm volatile("s_waitcnt lgkmcnt(0)" ::: "memory");
#pragma unroll
      for (int i = 0; i < 4; ++i) { const int row = i * 8 + (lane >> 3), ch = lane & 7; const u32x4 v = *(const u32x4*)(stg + row * 64 + ch * 8); ATTN_STORE16(Ow + (long)row * OPITCH + ch * 8, v); } }
    asm volatile("s_waitcnt lgkmcnt(0)\n\ts_barrier" ::: "memory");
#undef DMA_K
#undef DMA_V
#undef TROW
#undef TKB
#undef CMASK
#undef START
#undef RESC
#undef ROT
}
#undef SBAR
#undef WAIT_BAR
}

#define XB_TMO      128
#define XB_XCNT(j)  (256  + 64 * (j))
#define XB_XSUB(j)  (1280 + 64 * (j))
#define XB_XGEN(j)  (2304 + 64 * (j))
#define XB_TOP      3328
#define XB_TOPGEN   3392
#define XCD_BAR_WORDS 3456
#define XB_SPIN_CAP (1u << 18)
__device__ __forceinline__ unsigned xb_ld(unsigned* p)              { return __hip_atomic_load(p, __ATOMIC_RELAXED, __HIP_MEMORY_SCOPE_AGENT); }
__device__ __forceinline__ unsigned xb_add(unsigned* p, unsigned v) { return __hip_atomic_fetch_add(p, v, __ATOMIC_RELAXED, __HIP_MEMORY_SCOPE_AGENT); }
__device__ __forceinline__ unsigned xb_xcc_id() { return (unsigned)__builtin_amdgcn_s_getreg((3 << 11) | 20) & 0xFu; }
#define XB_SPIN(cond, bar) do { unsigned _sp = 0; while (cond) { __builtin_amdgcn_s_sleep(1); \
    if ((++_sp & 255u) == 0u) { if (xb_ld(&(bar)[XB_TMO])) break; if (_sp > XB_SPIN_CAP) { atomicAdd(&(bar)[XB_TMO], 1u); break; } } } } while (0)
struct XcdBarrier { unsigned* bar; unsigned x; volatile LAS unsigned* st; };
__device__ __forceinline__ XcdBarrier xcd_barrier_post(unsigned* bar, volatile LAS unsigned* st) {
    XcdBarrier b; b.bar = bar; b.x = xb_xcc_id(); b.st = st;
    if (threadIdx.x == 0) (void)xb_add(&bar[XB_XCNT(b.x)], 1u);
    return b;
}
__device__ __forceinline__ void xcd_barrier_complete(unsigned* bar, unsigned x, unsigned& nloc, unsigned& nx) {
    const unsigned G = gridDim.x * gridDim.y * gridDim.z;
    unsigned sum, cnt, mine, sp = 0u;
    for (;;) {
        sum = 0u; cnt = 0u; mine = 0u;
#pragma unroll
        for (unsigned j = 0; j < 16; ++j) { const unsigned c = xb_ld(&bar[XB_XCNT(j)]); sum += c; cnt += (c > 0u) ? 1u : 0u; mine = (j == x) ? c : mine; }
        if (sum == G) break;
        __builtin_amdgcn_s_sleep(1);
        if ((++sp & 255u) == 0u) { if (xb_ld(&bar[XB_TMO])) break; if (sp > XB_SPIN_CAP) { atomicAdd(&bar[XB_TMO], 1u); break; } }
    }
    nloc = mine > 0u ? mine : 1u; nx = cnt > 0u ? cnt : 1u;
}
__device__ __forceinline__ void xcd_barrier(const XcdBarrier& b) {
    asm volatile("s_waitcnt vmcnt(0)" ::: "memory");
    __syncthreads();
    if (threadIdx.x == 0) {
        unsigned* bar = b.bar;
        __builtin_amdgcn_s_waitcnt(0);
        unsigned nloc = b.st[0], nx = b.st[1];
        if (nloc == 0u) { xcd_barrier_complete(bar, b.x, nloc, nx); b.st[0] = nloc; b.st[1] = nx; }
        const unsigned old = xb_add(&bar[XB_XSUB(b.x)], 1u);
        const unsigned gen = old / nloc;
        if (old + 1u == (gen + 1u) * nloc) {
            __builtin_amdgcn_fence(__ATOMIC_RELEASE, "agent");
            asm volatile("s_waitcnt vmcnt(0)" ::: "memory");
            const unsigned og = xb_add(&bar[XB_TOP], 1u);
            const unsigned tg = og / nx;
            if (og + 1u == (tg + 1u) * nx) xb_add(&bar[XB_TOPGEN], 1u);
            else XB_SPIN(xb_ld(&bar[XB_TOPGEN]) == tg, bar);
            __builtin_amdgcn_fence(__ATOMIC_ACQUIRE, "agent");
            xb_add(&bar[XB_XGEN(b.x)], 1u);
            asm volatile("s_waitcnt vmcnt(0)" ::: "memory");
        } else {
            XB_SPIN(xb_ld(&bar[XB_XGEN(b.x)]) == gen, bar);
            __builtin_amdgcn_fence(__ATOMIC_ACQUIRE, "agent");
            asm volatile("s_waitcnt vmcnt(0)" ::: "memory");
        }
    }
    __syncthreads();
}

#define LDS_WAIT() asm volatile("s_waitcnt lgkmcnt(0)" ::: "memory")
__device__ __forceinline__ void transpose_item(const float* W, int K, int N, bf16_t* WT, int k0, int n0, int drow0, LAS float* scr, int lane) {
    float t[32];
#pragma unroll
    for (int i = 0; i < 32; ++i) t[i] = __builtin_nontemporal_load(W + (size_t)(k0 + 2 * i + (lane >> 5)) * N + n0 + (lane & 31));
#pragma unroll
    for (int i = 0; i < 32; ++i) scr[(2 * i + (lane >> 5)) * 33 + (lane & 31)] = t[i];
    LDS_WAIT(); asm volatile("" ::: "memory");
    const int c = lane & 7;
#pragma unroll
    for (int j = 0; j < 4; ++j) { const int n = (lane >> 3) + 8 * j; const LAS float* s = scr + (8 * c) * 33 + n;
        u32x4 o; o.x = pkbf(s[0 * 33], s[1 * 33]); o.y = pkbf(s[2 * 33], s[3 * 33]); o.z = pkbf(s[4 * 33], s[5 * 33]); o.w = pkbf(s[6 * 33], s[7 * 33]);
        *(GAS u32x4*)(WT + (size_t)(drow0 + n) * K + k0 + 8 * c) = o; }
    LDS_WAIT(); asm volatile("" ::: "memory");
}
__device__ __forceinline__ void transpose_item_f8(const float* W, int K, int N, unsigned char* WT, int k0, int n0, int drow0, float scale, LAS float* scr, int lane) {
    float t[32];
#pragma unroll
    for (int i = 0; i < 32; ++i) t[i] = __builtin_nontemporal_load(W + (size_t)(k0 + 2 * i + (lane >> 5)) * N + n0 + (lane & 31));
#pragma unroll
    for (int i = 0; i < 32; ++i) scr[(2 * i + (lane >> 5)) * 33 + (lane & 31)] = t[i];
    LDS_WAIT(); asm volatile("" ::: "memory");
    const int n = lane >> 1, hf = lane & 1; const LAS float* sp = scr + (32 * hf) * 33 + n;
    u32x4 o0, o1;
    o0.x = pk4f8(sp[0 * 33] * scale, sp[1 * 33] * scale, sp[2 * 33] * scale, sp[3 * 33] * scale);     o0.y = pk4f8(sp[4 * 33] * scale, sp[5 * 33] * scale, sp[6 * 33] * scale, sp[7 * 33] * scale);
    o0.z = pk4f8(sp[8 * 33] * scale, sp[9 * 33] * scale, sp[10 * 33] * scale, sp[11 * 33] * scale);   o0.w = pk4f8(sp[12 * 33] * scale, sp[13 * 33] * scale, sp[14 * 33] * scale, sp[15 * 33] * scale);
    o1.x = pk4f8(sp[16 * 33] * scale, sp[17 * 33] * scale, sp[18 * 33] * scale, sp[19 * 33] * scale); o1.y = pk4f8(sp[20 * 33] * scale, sp[21 * 33] * scale, sp[22 * 33] * scale, sp[23 * 33] * scale);
    o1.z = pk4f8(sp[24 * 33] * scale, sp[25 * 33] * scale, sp[26 * 33] * scale, sp[27 * 33] * scale); o1.w = pk4f8(sp[28 * 33] * scale, sp[29 * 33] * scale, sp[30 * 33] * scale, sp[31 * 33] * scale);
    GAS u32x4* dst = (GAS u32x4*)(WT + (size_t)(drow0 + n) * K + k0 + 32 * hf);
    dst[0] = o0; dst[1] = o1;
    LDS_WAIT(); asm volatile("" ::: "memory");
}
__device__ __forceinline__ void sincos_d(double x, double& s, double& c) {
    const double TWO_PI = 6.283185307179586476925;
    const double k = __builtin_rint(x / TWO_PI); const double r = x - k * TWO_PI;
    const double r2 = r * r; double ts = r, tc = 1.0; s = r; c = 1.0;
    for (int i = 1; i <= 16; ++i) { tc *= -r2 / (double)((2 * i - 1) * (2 * i)); ts *= -r2 / (double)((2 * i) * (2 * i + 1)); c += tc; s += ts; }
}

constexpr int CI_F = 16 * 112, CI_FD = 56 * 32, MOE_ITEMS = 8 * (2 * CI_F + CI_FD);
constexpr int MOE_TAIL_A = 12000, MOE_TAIL_B = 7000, MOE_TAIL_C = 12000, MOE_TAIL_TOTAL = MOE_TAIL_A + MOE_TAIL_B + MOE_TAIL_C;
__device__ __forceinline__ void moe_convert_item(int r, const float* wg, const float* wu, const float* wd, unsigned char* mgu, unsigned char* md, LAS float* scr, int lane) {
    const int e = r / (2 * CI_F + CI_FD); int q = r % (2 * CI_F + CI_FD);
    if (q < 2 * CI_F) { const int up = q / CI_F; q %= CI_F; const int kb = q / 112, nb = q % 112, n0 = 32 * nb;
        transpose_item_f8((up ? wu : wg) + (size_t)e * 1024 * DFF, 1024, DFF, mgu + (size_t)e * 7168 * 1024, 64 * kb, n0, 256 * (n0 >> 7) + 128 * up + (n0 & 127), MOE_SGU, scr, lane); }
    else { q -= 2 * CI_F; const int kb = q / 32, nb = q % 32; transpose_item_f8(wd + (size_t)e * DFF * 1024, DFF, 1024, md + (size_t)e * 1024 * DFF, 64 * kb, 32 * nb, 32 * nb, MOE_SD, scr, lane); }
}
__device__ __forceinline__ void moe_convert_tail(int nunits, int G, int bx, int first, int count, const float* wg, const float* wu, const float* wd, unsigned char* mgu, unsigned char* md, LAS unsigned char* lds) {
    const int busy = nunits % G; if (busy == 0 || bx < busy) return;
    int tid_ = threadIdx.x; asm volatile("" : "+v"(tid_)); const int lane = tid_ & 63, wave = __builtin_amdgcn_readfirstlane(tid_ >> 6);
    LAS float* scr = (LAS float*)(lds + wave * 16384);
    const int nw = (G - busy) * 8, w = (bx - busy) * 8 + wave;
    for (int it = w; it < count; it += nw) moe_convert_item(first + it, wg, wu, wd, mgu, md, scr, lane);
}

struct Args { const float* in[24]; float* out; unsigned char* ws; int ph_lo, ph_hi, li, pad; };
constexpr int NPH = 18;

__device__ __forceinline__ void norm_store(const f32x4 (&v)[4], float ssum, const float* g, const float* mrow, int shc, int scc, bf16_t* XNo, size_t m, int lane) {
    const float rstd = 1.0f / __builtin_sqrtf(ssum * (1.0f / DM) + EPS);
#pragma unroll
    for (int j = 0; j < 4; ++j) { const f32x4 gv = *(const f32x4*)(g + 4 * lane + 256 * j), sc = *(const f32x4*)(mrow + scc * 1024 + 4 * lane + 256 * j), sh = *(const f32x4*)(mrow + shc * 1024 + 4 * lane + 256 * j);
        const f32x4 y = (v[j] * rstd) * gv * (sc + 1.0f) + sh; u32x2 w; w.x = pkbf(y.x, y.y); w.y = pkbf(y.z, y.w); *((GAS u32x2*)(XNo + m * DM) + lane + 64 * j) = w; }
}
template <bool SRC_BF16> __device__ __forceinline__ void norm_rows(const void* srcLv, const float* srcC, int nrows, const float* g, const float* mod, int shc, int scc, bf16_t* XNo, int gw, int NGW, int lane,
                                          const float* part, int nS, const float* gatec, float* zout) {
    if (nrows > NLAT) {
        for (int rc = gw; rc < NCTXR; rc += NGW) {
            const GAS f32x4* xr = (const GAS f32x4*)(srcC + (size_t)rc * DM) + lane;
            f32x4 v[4];
#pragma unroll
            for (int j = 0; j < 4; ++j) v[j] = xr[64 * j];
            if (part != nullptr) {
                f32x4 a[4];
#pragma unroll
                for (int j = 0; j < 4; ++j) a[j] = (f32x4){0.f, 0.f, 0.f, 0.f};
                for (int s0 = 0; s0 < nS; s0 += 7) {
                    f32x4 t[7][4];
#pragma unroll
                    for (int q = 0; q < 7; ++q) { const int s2 = (s0 + q < nS) ? s0 + q : s0; const GAS f32x4* pr = (const GAS f32x4*)(part + ((size_t)s2 * NCTXR + rc) * DM) + lane;
#pragma unroll
                        for (int j = 0; j < 4; ++j) t[q][j] = pr[64 * j]; }
#pragma unroll
                    for (int q = 0; q < 7; ++q) if (s0 + q < nS) {
#pragma unroll
                        for (int j = 0; j < 4; ++j) a[j] += t[q][j]; }
                }
#pragma unroll
                for (int j = 0; j < 4; ++j) v[j] += *(const f32x4*)(gatec + 4 * lane + 256 * j) * a[j];
                if (zout != nullptr) { GAS f32x4* zr = (GAS f32x4*)(zout + (size_t)rc * DM) + lane;
#pragma unroll
                    for (int j = 0; j < 4; ++j) zr[64 * j] = v[j]; }
            }
            float ss = 0.f;
#pragma unroll
            for (int j = 0; j < 4; ++j) ss += (v[j].x * v[j].x + v[j].y * v[j].y) + (v[j].z * v[j].z + v[j].w * v[j].w);
            norm_store(v, wave_sum(ss), g, mod + (size_t)4 * 6144, shc, scc, XNo, (size_t)NLAT + rc, lane);
        }
    }
    for (int m0 = gw * 4; m0 < NLAT; m0 += NGW * 4) {
        const int mb = m0 >> 13;
        f32x4 v[4][4];
        if constexpr (SRC_BF16) { const GAS u32x2* xr = (const GAS u32x2*)((const bf16_t*)srcLv + (size_t)m0 * DM) + lane;
#pragma unroll
            for (int r = 0; r < 4; ++r)
#pragma unroll
                for (int j = 0; j < 4; ++j) { const u32x2 w = xr[r * 256 + 64 * j]; v[r][j] = (f32x4){__uint_as_float(w.x << 16), __uint_as_float(w.x & 0xffff0000u), __uint_as_float(w.y << 16), __uint_as_float(w.y & 0xffff0000u)}; } }
        else { const GAS f32x4* xr = (const GAS f32x4*)((const float*)srcLv + (size_t)m0 * DM) + lane;
#pragma unroll
            for (int r = 0; r < 4; ++r)
#pragma unroll
                for (int j = 0; j < 4; ++j) v[r][j] = xr[r * 256 + 64 * j]; }
        float ss[4];
#pragma unroll
        for (int r = 0; r < 4; ++r) { ss[r] = 0.f;
#pragma unroll
            for (int j = 0; j < 4; ++j) ss[r] += (v[r][j].x * v[r][j].x + v[r][j].y * v[r][j].y) + (v[r][j].z * v[r][j].z + v[r][j].w * v[r][j].w); }
#pragma unroll
        for (int o = 1; o < 64; o <<= 1) {
#pragma unroll
            for (int r = 0; r < 4; ++r) ss[r] += __shfl_xor(ss[r], o); }
#pragma unroll
        for (int r = 0; r < 4; ++r) norm_store(v[r], ss[r], g, mod + (size_t)mb * 6144, shc, scc, XNo, (size_t)(m0 + r), lane);
    }
}

__global__ void __launch_bounds__(512, 2) fwd(Args args) {
    extern __shared__ __attribute__((aligned(16))) unsigned char lds_raw[];
    LAS unsigned char* lds = (LAS unsigned char*)lds_raw;
    volatile LAS unsigned* MISC = (volatile LAS unsigned*)(lds + MISC_OFF);
    LAS int* gtab = (LAS int*)(lds + GTAB_OFF);
    const int G = gridDim.x; const int bx = blockIdx.x; const int vcu = (G % 8 == 0) ? (bx % 8) * (G / 8) + bx / 8 : bx;
    const int NGW = G * 8;
#define PHASE_IDS() int tid_ = threadIdx.x; asm volatile("" : "+v"(tid_)); const int tid = tid_, lane = tid & 63, wave = __builtin_amdgcn_readfirstlane(tid >> 6), gw = vcu * 8 + wave; (void)lane; (void)gw
    unsigned char* ws = args.ws;
    gu32* ctl = (gu32*)(ws + WS_CTL);
#define MOD ((float*)(ws + WS_MOD))
#define ROPE ((float*)(ws + WS_ROPE))
#define STATS ((float*)(ws + WS_STATS))
#define LIST ((int*)(ws + WS_LIST))
#define TINFO ((int*)(ws + WS_TINFO))
#define WSB ((bf16_t*)(ws + WS_WS))
#define WIN ((bf16_t*)(ws + WS_WIN))
#define WAO ((bf16_t*)(ws + WS_WAO))
#define WQKV ((bf16_t*)(ws + WS_WQKV))
#define WBO ((bf16_t*)(ws + WS_WBO))
#define WGU ((bf16_t*)(ws + WS_WGU))
#define WD ((bf16_t*)(ws + WS_WD))
#define MGU ((unsigned char*)(ws + WS_MGU))
#define MD ((unsigned char*)(ws + WS_MD))
#define XN8 ((unsigned char*)(ws + WS_XN))
#define XN ((bf16_t*)(ws + WS_XN))
#define ZB ((float*)(ws + WS_ZB))
#define UVT ((bf16_t*)(ws + WS_UVT))
#define A2 ((bf16_t*)(ws + WS_A2))
#define HB ((bf16_t*)(ws + WS_H))
#define QKV ((bf16_t*)(ws + WS_QKV))
#define OB ((bf16_t*)(ws + WS_O))
#define YB ((bf16_t*)(ws + WS_Y))
#define HC ((unsigned char*)(ws + WS_HC))
#define YP ((bf16_t*)(ws + WS_YP))
#define PART1 ((float*)(ws + WS_PART1))
#define PART2 ((float*)(ws + WS_PART2))
#define I_X (args.in[0])
#define I_C (args.in[1])
#define I_CTX (args.in[2])
#define I_CCTX (args.in[3])
#define I_ADAW (args.in[4])
#define I_ADAB (args.in[5])
#define I_NORMG (args.in[6])
#define I_FINALG (args.in[7])
#define HL ((bf16_t*)(ws + WS_HLB))

    { PHASE_IDS(); for (int u = tid; u < (LDS_BYTES - MISC_OFF) / 4; u += 512) ((LAS unsigned*)(lds + MISC_OFF))[u] = 0u; }
    __syncthreads();
    const int lo = args.ph_lo, hi_ph = args.ph_hi;
    const bool one_launch = (hi_ph - lo) > 1;
    XcdBarrier bar; bar.bar = (unsigned*)(ctl + CW_BAR) + args.li * XCD_BAR_WORDS; bar.x = 0; bar.st = nullptr;
    if (one_launch) bar = xcd_barrier_post((unsigned*)(ctl + CW_BAR) + args.li * XCD_BAR_WORDS, MISC + 8);
#ifndef PHMASK
#define PHMASK 0xFFFFFFFFu
#endif
#define IN(k) (((PHMASK >> (k)) & 1) && lo <= (k) && (k) < hi_ph)
#define BOTH(k) (IN(k) && IN((k) + 1))
#define GRID_BAR() xcd_barrier(bar)
#if defined(PROBE_LO)
    unsigned long long tpA = __builtin_amdgcn_s_memrealtime(), tpB = 0;
#define PROBE_MARK(k) do { if ((k) == PROBE_LO - 1) tpA = __builtin_amdgcn_s_memrealtime(); if ((k) == PROBE_HI) tpB = __builtin_amdgcn_s_memrealtime(); } while (0)
#else
#define PROBE_MARK(k) do { } while (0)
#endif

    if (IN(0)) {
        PHASE_IDS();
        {
            LAS float* sv = (LAS float*)lds;
            LAS float* red = (LAS float*)(lds + 5 * 1024 * 4);
            if (bx < 192) {
                for (int idx = tid; idx < 5 * 1024; idx += 512) { const int r = idx >> 10, k = idx & 1023; const float cv = r < 4 ? I_C[r * 1024 + k] : I_CCTX[k]; sv[idx] = cv / (1.0f + __expf(-cv)); }
                __syncthreads();
                for (int item = bx; item < 192; item += G) {
                    const int i = item / 96, n0 = (item % 96) * 64, nn = tid & 63, kq = tid >> 6;
                    float a0 = 0.f, a1 = 0.f, a2 = 0.f, a3 = 0.f, a4 = 0.f;
                    const float* wp = I_ADAW + ((size_t)i * 1024 + kq * 128) * 6144 + n0 + nn;
#pragma unroll 8
                    for (int k = 0; k < 128; ++k) { const float w = wp[(size_t)k * 6144]; const int kk = kq * 128 + k;
                        a0 += sv[kk] * w; a1 += sv[1024 + kk] * w; a2 += sv[2048 + kk] * w; a3 += sv[3072 + kk] * w; a4 += sv[4096 + kk] * w; }
                    red[(kq * 5 + 0) * 64 + nn] = a0; red[(kq * 5 + 1) * 64 + nn] = a1; red[(kq * 5 + 2) * 64 + nn] = a2; red[(kq * 5 + 3) * 64 + nn] = a3; red[(kq * 5 + 4) * 64 + nn] = a4;
                    __syncthreads();
                    if (tid < 320) { const int r = tid >> 6; float s = I_ADAB[i * 6144 + n0 + nn];
#pragma unroll
                        for (int q = 0; q < 8; ++q) s += red[(q * 5 + r) * 64 + nn];
                        MOD[((size_t)i * 5 + r) * 6144 + n0 + nn] = s; }
                    __syncthreads();
                }
            }
            __syncthreads();
        }
        {
            LAS float* scr = (LAS float*)(lds + wave * 16384);
            constexpr int I_IN = 16 * 64, I_AO = 16 * 32, I_QKV = 16 * 48, I_BO = 16 * 32, I_F = 16 * 112, I_FD = 56 * 32;
            constexpr int I_DENSE = I_IN + I_AO + I_QKV + I_BO + 2 * I_F + I_FD, I_MOE = MOE_ITEMS, I_WS = 128, I_ROPE = 32;
            constexpr int NITEMS = I_DENSE + I_MOE + I_WS + I_ROPE;
            for (int it = gw; it < NITEMS; it += NGW) {
                int r = it;
                if (r < I_IN) { const int kb = r / 64, nb = r % 64; transpose_item(args.in[8], 1024, 2048, WIN, 64 * kb, 32 * nb, 32 * nb, scr, lane); continue; } r -= I_IN;
                if (r < I_AO) { const int kb = r / 32, nb = r % 32; transpose_item(args.in[13], 1024, 1024, WAO, 64 * kb, 32 * nb, 32 * nb, scr, lane); continue; } r -= I_AO;
                if (r < I_QKV) { const int kb = r / 48, nb = r % 48; transpose_item(args.in[14], 1024, 1536, WQKV, 64 * kb, 32 * nb, 32 * nb, scr, lane); continue; } r -= I_QKV;
                if (r < I_BO) { const int kb = r / 32, nb = r % 32; transpose_item(args.in[16], 1024, 1024, WBO, 64 * kb, 32 * nb, 32 * nb, scr, lane); continue; } r -= I_BO;
                if (r < 2 * I_F) { const int up = r / I_F; const int q = r % I_F; const int kb = q / 112, nb = q % 112, n0 = 32 * nb;
                    transpose_item(args.in[17 + up], 1024, DFF, WGU, 64 * kb, n0, 256 * (n0 >> 7) + 128 * up + (n0 & 127), scr, lane); continue; } r -= 2 * I_F;
                if (r < I_FD) { const int kb = r / 32, nb = r % 32; transpose_item(args.in[19], DFF, 1024, WD, 64 * kb, 32 * nb, 32 * nb, scr, lane); continue; } r -= I_FD;
                if (r < I_MOE) { if (r >= MOE_TAIL_TOTAL) moe_convert_item(r, args.in[21], args.in[22], args.in[23], MGU, MD, scr, lane); continue; } r -= I_MOE;
                if (r < I_WS) { const float* src = args.in[11] + (size_t)r * 2048;
#pragma unroll
                    for (int j = 0; j < 8; ++j) { const f32x4 v = *(const f32x4*)(src + j * 256 + lane * 4); u32x2 w; w.x = pkbf(v.x, v.y); w.y = pkbf(v.z, v.w); *(u32x2*)(WSB + (size_t)r * 2048 + j * 256 + lane * 4) = w; }
                    continue; } r -= I_WS;
                {
                    const int ent = r * 64 + lane; const int pos = ent >> 4, i = ent & 15;
                    double inv = 1.0; for (int q = 0; q < i; ++q) inv *= 0.56234132519034908;
                    const float ang = (float)pos * (float)inv; double s, c; sincos_d((double)ang, s, c);
                    ROPE[ent] = (float)c; ROPE[2048 + ent] = (float)s;
                }
            }
        }
        if (BOTH(0)) GRID_BAR(); PROBE_MARK(0);
    }
    if (IN(1)) { PHASE_IDS(); norm_rows<false>(I_X, I_CTX, MALL, I_NORMG + 0 * 1024, MOD, 0, 1, XN, gw, NGW, lane, nullptr, 0, nullptr, nullptr); if (BOTH(1)) GRID_BAR(); PROBE_MARK(1); }
    if (IN(2)) {
        pg8::DenseSched S{(const char*)WIN, (const char*)XN, 8, NPA, G, bx, (size_t)256 * 1024 * 2};
        pg8::EpiGeluT E{UVT, STATS};
        pg8::gemm_phase<pg8::EpiGeluT, pg8::DenseSched, true, false>(lds, gtab, 1024, 16, S, E);
        moe_convert_tail(8 * NPA, G, bx, 0, MOE_TAIL_A, args.in[21], args.in[22], args.in[23], MGU, MD, lds);
        if (BOTH(2)) GRID_BAR(); PROBE_MARK(2);
    }
    if (IN(3)) {
        PHASE_IDS();
        const float* vg = args.in[9]; const float* vb = args.in[10]; const float* bs = args.in[12];
        LAS float* mu_l = (LAS float*)(lds + wave * 1024); LAS float* rs_l = mu_l + 128;
        const int r32 = lane & 31, h = lane >> 5;
        for (int unit = gw; unit < (MALL / 128) * 16; unit += NGW) {
            const int ch = unit >> 4, g = unit & 15, q0 = ch * 128;
#pragma unroll
            for (int tt = 0; tt < 2; ++tt) { const int tok = q0 + lane * 2 + tt; const f32x4* sp = (const f32x4*)(STATS + (size_t)tok * 16);
                const f32x4 a = sp[0], b = sp[1], c = sp[2], d = sp[3];
                const float sum = (a.x + a.z) + (b.x + b.z) + (c.x + c.z) + (d.x + d.z), sq = (a.y + a.w) + (b.y + b.w) + (c.y + c.w) + (d.y + d.w);
                const float mean = sum * (1.0f / 1024.0f), var = sq * (1.0f / 1024.0f) - mean * mean;
                mu_l[lane * 2 + tt] = mean; rs_l[lane * 2 + tt] = 1.0f / __builtin_sqrtf(var + EPS); }
            float vgc[2], vbc[2];
#pragma unroll
            for (int ct = 0; ct < 2; ++ct) { vgc[ct] = vg[64 * g + 32 * ct + r32]; vbc[ct] = vb[64 * g + 32 * ct + r32]; }
            f32x16 acc[2][4];
#pragma unroll
            for (int ct = 0; ct < 2; ++ct)
#pragma unroll
                for (int pt = 0; pt < 4; ++pt) acc[ct][pt] = f32x16{};
#pragma unroll 2
            for (int s = 0; s < 8; ++s) {
                const int qs = 16 * s + 8 * h;
                const f32x4 m0 = *(const LAS f32x4*)(mu_l + qs), m1 = *(const LAS f32x4*)(mu_l + qs + 4), r0 = *(const LAS f32x4*)(rs_l + qs), r1 = *(const LAS f32x4*)(rs_l + qs + 4);
                bf16x8 af[2], bfr[4];
#pragma unroll
                for (int ct = 0; ct < 2; ++ct) { const bf16x8 raw = *(const bf16x8*)(UVT + (size_t)(1024 + 64 * g + 32 * ct + r32) * MALL + q0 + qs);
                    float y[8];
#pragma unroll
                    for (int j = 0; j < 4; ++j) { y[j] = (bf2f((unsigned short)raw[j]) - m0[j]) * r0[j] * vgc[ct] + vbc[ct]; y[4 + j] = (bf2f((unsigned short)raw[4 + j]) - m1[j]) * r1[j] * vgc[ct] + vbc[ct]; }
                    u32x4 w; w.x = pkbf(y[0], y[1]); w.y = pkbf(y[2], y[3]); w.z = pkbf(y[4], y[5]); w.w = pkbf(y[6], y[7]); af[ct] = __builtin_bit_cast(bf16x8, w); }
#pragma unroll
                for (int pt = 0; pt < 4; ++pt) bfr[pt] = *(const bf16x8*)(WSB + (size_t)(g * 128 + 32 * pt + r32) * 128 + qs);
#pragma unroll
                for (int ct = 0; ct < 2; ++ct)
#pragma unroll
                    for (int pt = 0; pt < 4; ++pt) acc[ct][pt] = __builtin_amdgcn_mfma_f32_32x32x16_bf16(af[ct], bfr[pt], acc[ct][pt], 0, 0, 0);
            }
#pragma unroll
            for (int pt = 0; pt < 4; ++pt) { const int p = 32 * pt + r32; const size_t tokp = (size_t)q0 + p; const float bsv = bs[g * 128 + p];
#pragma unroll
                for (int ct = 0; ct < 2; ++ct)
#pragma unroll
                    for (int rr = 0; rr < 4; ++rr) { const int c = 64 * g + 32 * ct + 8 * rr + 4 * h; float o[4];
#pragma unroll
                        for (int e = 0; e < 4; ++e) { const float uu = bf2f(UVT[(size_t)(c + e) * MALL + tokp]); o[e] = uu * (acc[ct][pt][4 * rr + e] + bsv); }
                        u32x2 w; w.x = pkbf(o[0], o[1]); w.y = pkbf(o[2], o[3]); *(u32x2*)(A2 + tokp * DM + c) = w; } }
        }
        if (BOTH(3)) GRID_BAR(); PROBE_MARK(3);
    }
    if (IN(4)) {
        { pg8::DenseSched S{(const char*)A2, (const char*)WAO, NPL, 4, G, bx, (size_t)256 * 1024 * 2};
          pg8::EpiResid<true> E{I_X, nullptr, HL, MOD + 2 * 1024};
          pg8::gemm_phase<pg8::EpiResid<true>, pg8::DenseSched, true, false>(lds, gtab, 1024, 16, S, E); }
        { pg8::SplitSched S{(const char*)(A2 + (size_t)NLAT * DM), (const char*)WAO, 4, 4, P3_NS, G, bx, NPL, (size_t)256 * 1024 * 2, (size_t)(1024 / P3_NS) * 2};
          pg8::EpiPartF32 E{PART1, (size_t)NCTXR * DM};
          pg8::gemm_phase<pg8::EpiPartF32, pg8::SplitSched, true, false>(lds, gtab, 1024, 1024 / P3_NS / 64, S, E); }
        if (BOTH(4)) GRID_BAR(); PROBE_MARK(4);
    }
    if (IN(5)) { PHASE_IDS(); norm_rows<true>(HL, I_CTX, MALL, I_NORMG + 1 * 1024, MOD, 3, 4, XN, gw, NGW, lane, PART1, P3_NS, MOD + 4 * 6144 + 2 * 1024, ZB); if (BOTH(5)) GRID_BAR(); PROBE_MARK(5); }
    if (IN(6)) {
        pg8::DenseSched S{(const char*)XN, (const char*)WGU, NPA, 28, G, bx, (size_t)256 * 1024 * 2};
        pg8::EpiSwiGLU E{HB};
        pg8::gemm_phase<pg8::EpiSwiGLU, pg8::DenseSched, true, false>(lds, gtab, 1024, 16, S, E);
        moe_convert_tail(NPA * 28, G, bx, MOE_TAIL_A, MOE_TAIL_B, args.in[21], args.in[22], args.in[23], MGU, MD, lds);
        if (BOTH(6)) GRID_BAR(); PROBE_MARK(6);
    }
    if (IN(7)) {
        { pg8::DenseSched S{(const char*)HB, (const char*)WD, NPL, 4, G, bx, (size_t)256 * DFF * 2};
          pg8::EpiResid<false> E{nullptr, HL, HL, MOD + 5 * 1024};
          pg8::gemm_phase<pg8::EpiResid<false>, pg8::DenseSched, true, false>(lds, gtab, DFF, 56, S, E); }
        { pg8::SplitSched S{(const char*)(HB + (size_t)NLAT * DFF), (const char*)WD, 4, 4, P5_NS, G, bx, NPL, (size_t)256 * DFF * 2, (size_t)(DFF / P5_NS) * 2};
          pg8::EpiPartF32 E{PART2, (size_t)NCTXR * DM};
          pg8::gemm_phase<pg8::EpiPartF32, pg8::SplitSched, true, false>(lds, gtab, DFF, DFF / P5_NS / 64, S, E); }
        if (BOTH(7)) GRID_BAR(); PROBE_MARK(7);
    }
    if (IN(8)) { PHASE_IDS(); norm_rows<true>(HL, ZB, MALL, I_NORMG + 2 * 1024, MOD + 5 * 6144, 0, 1, XN, gw, NGW, lane, PART2, P5_NS, MOD + 4 * 6144 + 5 * 1024, nullptr); if (BOTH(8)) GRID_BAR(); PROBE_MARK(8); }
    if (IN(9)) {
        pg8::DenseSched S{(const char*)XN, (const char*)WQKV, NPA, 6, G, bx, (size_t)256 * 1024 * 2};
        pg8::EpiQKV E{QKV, ROPE, ROPE + 2048, attn_body::C2};
        pg8::gemm_phase<pg8::EpiQKV, pg8::DenseSched, true, false>(lds, gtab, 1024, 16, S, E);
        moe_convert_tail(NPA * 6, G, bx, MOE_TAIL_A + MOE_TAIL_B, MOE_TAIL_C, args.in[21], args.in[22], args.in[23], MGU, MD, lds);
        if (BOTH(9)) GRID_BAR(); PROBE_MARK(9);
    }
    if (IN(10)) {
        static_assert(attn_body::LDS_BYTES_A <= RING_BYTES, "attention LDS");
        const float* sinkp = args.in[15];
        for (int i = 0;; ++i) { const int uid = i * G + vcu; if (uid >= NB * 64 * 4 * 2) break;
            const int pr = uid & 1, hk = (uid >> 1) & 3, n = (uid >> 3) & 63, b = uid >> 9;
            attn_body::attn_unit<8>(b, hk, n, pr, (const attn_body::bf16*)QKV, (attn_body::bf16*)OB, sinkp, (char*)lds_raw); }
        if (BOTH(10)) GRID_BAR(); PROBE_MARK(10);
    }
    if (IN(11)) {
        pg8::DenseSched S{(const char*)OB, (const char*)WBO, NPL, 4, G, bx, (size_t)256 * 1024 * 2};
        pg8::EpiResid<false> E{nullptr, HL, HL, MOD + 5 * 6144 + 2 * 1024};
        pg8::gemm_phase<pg8::EpiResid<false>, pg8::DenseSched, true, false>(lds, gtab, 1024, 16, S, E);
        if (BOTH(11)) GRID_BAR(); PROBE_MARK(11);
    }
    if (IN(12)) {
        PHASE_IDS();
        const float* g = I_NORMG + 3 * 1024; const float* mod = MOD + 5 * 6144; const float* wrt = args.in[20];
        LAS int* l_e = (LAS int*)lds;
        LAS float* l_w = (LAS float*)(lds + 1024);
        LAS int* l_cnt = (LAS int*)(lds + 2048);
        LAS int* l_base = (LAS int*)(lds + 2048 + 64);
        for (int blk = bx; blk < NLAT / 128; blk += G) {
            if (tid < 8) l_cnt[tid] = 0;
            __syncthreads();
            const int mb = (blk * 128) >> 13; const float* mrow = mod + (size_t)mb * 6144;
            for (int i4 = 0; i4 < 8; ++i4) {
                const int tl0 = wave * 16 + i4 * 2, m0 = blk * 128 + tl0;
                const GAS u32x2* xr = (const GAS u32x2*)(HL + (size_t)m0 * DM) + lane;
                f32x4 v[2][4]; float ss[2];
#pragma unroll
                for (int r = 0; r < 2; ++r)
#pragma unroll
                    for (int j = 0; j < 4; ++j) { const u32x2 w = xr[r * 256 + 64 * j]; v[r][j] = (f32x4){__uint_as_float(w.x << 16), __uint_as_float(w.x & 0xffff0000u), __uint_as_float(w.y << 16), __uint_as_float(w.y & 0xffff0000u)}; }
#pragma unroll
                for (int r = 0; r < 2; ++r) { ss[r] = 0.f;
#pragma unroll
                    for (int j = 0; j < 4; ++j) ss[r] += (v[r][j].x * v[r][j].x + v[r][j].y * v[r][j].y) + (v[r][j].z * v[r][j].z + v[r][j].w * v[r][j].w); }
#pragma unroll
                for (int o = 1; o < 64; o <<= 1) {
#pragma unroll
                    for (int r = 0; r < 2; ++r) ss[r] += __shfl_xor(ss[r], o); }
                float lg[2][8];
#pragma unroll
                for (int r = 0; r < 2; ++r)
#pragma unroll
                    for (int e = 0; e < 8; ++e) lg[r][e] = 0.f;
#pragma unroll
                for (int j = 0; j < 4; ++j) { const int col = 4 * lane + 256 * j; const f32x4 gv = *(const f32x4*)(g + col), sc = *(const f32x4*)(mrow + 4 * 1024 + col), sh = *(const f32x4*)(mrow + 3 * 1024 + col);
                    const f32x4 gm = gv * (sc + 1.0f);
                    f32x4 y[2];
#pragma unroll
                    for (int r = 0; r < 2; ++r) { const float rstd = 1.0f / __builtin_sqrtf(ss[r] * (1.0f / DM) + EPS); y[r] = (v[r][j] * rstd) * gm + sh;
                        *((GAS unsigned*)(XN8 + (size_t)(m0 + r) * DM) + lane + 64 * j) = pk4f8(y[r].x, y[r].y, y[r].z, y[r].w); }
#pragma unroll
                    for (int cc = 0; cc < 4; ++cc) { const f32x4 w0 = *(const f32x4*)(wrt + (size_t)(col + cc) * 8), w1 = *(const f32x4*)(wrt + (size_t)(col + cc) * 8 + 4);
#pragma unroll
                        for (int r = 0; r < 2; ++r) { const float yv = y[r][cc];
                            lg[r][0] += yv * w0.x; lg[r][1] += yv * w0.y; lg[r][2] += yv * w0.z; lg[r][3] += yv * w0.w; lg[r][4] += yv * w1.x; lg[r][5] += yv * w1.y; lg[r][6] += yv * w1.z; lg[r][7] += yv * w1.w; } } }
#pragma unroll
                for (int o = 1; o < 64; o <<= 1) {
#pragma unroll
                    for (int r = 0; r < 2; ++r)
#pragma unroll
                        for (int e = 0; e < 8; ++e) lg[r][e] += __shfl_xor(lg[r][e], o); }
#pragma unroll
                for (int r = 0; r < 2; ++r) {
                    int ea = 0; float va = lg[r][0];
#pragma unroll
                    for (int e = 1; e < 8; ++e) if (lg[r][e] > va) { va = lg[r][e]; ea = e; }
                    int eb = -1; float vb2 = -INFINITY;
#pragma unroll
                    for (int e = 0; e < 8; ++e) if (e != ea && lg[r][e] > vb2) { vb2 = lg[r][e]; eb = e; }
                    const float wb = 1.0f / (1.0f + __expf(va - vb2)), wa = 1.0f - wb;
                    if (lane == 0) { const int tl = tl0 + r; l_e[tl * 2] = ea; l_e[tl * 2 + 1] = eb; l_w[tl * 2] = wa; l_w[tl * 2 + 1] = wb; } }
            }
            __syncthreads();
            int ea = 0, eb = 0, pa = 0, pb = 0;
            if (tid < 128) { ea = l_e[tid * 2]; eb = l_e[tid * 2 + 1]; pa = atomicAdd((int*)&l_cnt[ea], 1); pb = atomicAdd((int*)&l_cnt[eb], 1); }
            __syncthreads();
            if (tid < 8) l_base[tid] = (int)__hip_atomic_fetch_add((unsigned*)(ctl + CW_CNT + 64 * tid), (unsigned)l_cnt[tid], __ATOMIC_RELAXED, __HIP_MEMORY_SCOPE_AGENT);
            __syncthreads();
            if (tid < 128) { const int m = blk * 128 + tid; pa += l_base[ea]; pb += l_base[eb];
                LIST[(size_t)ea * NLAT + pa] = m; LIST[(size_t)eb * NLAT + pb] = m;
                int* ti = TINFO + (size_t)m * 8; ti[0] = ea; ti[1] = pa; ti[2] = eb; ti[3] = pb; ti[4] = __float_as_int(l_w[tid * 2]); ti[5] = __float_as_int(l_w[tid * 2 + 1]); }
            __syncthreads();
        }
        if (BOTH(12)) GRID_BAR(); PROBE_MARK(12);
    }
    if (hi_ph > 13 && lo < 17) {
        PHASE_IDS();
        LAS int* mtab = (LAS int*)(lds + MOE_OFF);
        if (tid == 0) { int run = 0, R = 0;
            for (int e = 0; e < 8; ++e) { const int ce = (int)__hip_atomic_load((unsigned*)(ctl + CW_CNT + 64 * e), __ATOMIC_RELAXED, __HIP_MEMORY_SCOPE_AGENT); mtab[e] = run; mtab[16 + e] = ce; run += ce >> 8; if (ce & 255) { mtab[24 + R] = e; ++R; } }
            mtab[8] = run; mtab[32] = R; }
        __syncthreads();
        const int nfull = __builtin_amdgcn_readfirstlane(mtab[8]);
        for (int c = 0; c < MOE_NCH; ++c) {
            const int gp0 = c * MOE_CH, gp1 = nfull < (c + 1) * MOE_CH ? nfull : (c + 1) * MOE_CH;
            if (IN(13 + 2 * c)) {
                { pg8::MoeSched S; S.A = (const char*)XN8; S.B = (const char*)MGU; S.list = LIST; S.tab = mtab; S.mode = 0; S.nS = 1; S.kbytes = 0; S.omoff = 0;
                  S.gp0 = gp0; S.gp1 = gp1; S.nN = 28; S.G = G; S.c = bx; S.bexp = (size_t)7168 * 1024; S.btile = (size_t)256 * 1024; S.astep = 0; S.gather = true;
                  pg8::EpiSwiGLU8 E{HC, 1.0f / MOE_SGU};
                  pg8::gemm_phase<pg8::EpiSwiGLU8, pg8::MoeSched, true, true, true>(lds, gtab, 512, 8, S, E); }
                if (c == 0) { pg8::MoeSched S; S.A = (const char*)XN8; S.B = (const char*)MGU; S.list = LIST; S.tab = mtab; S.mode = 1; S.nS = 1; S.kbytes = 0; S.omoff = MOE_CH;
                  S.gp0 = 0; S.gp1 = 0; S.nN = 28; S.G = G; S.c = bx; S.bexp = (size_t)7168 * 1024; S.btile = (size_t)256 * 1024; S.astep = 0; S.gather = true;
                  pg8::EpiSwiGLU8 E{HC, 1.0f / MOE_SGU};
                  pg8::gemm_phase<pg8::EpiSwiGLU8, pg8::MoeSched, true, true, true>(lds, gtab, 512, 8, S, E); }
                if (BOTH(13 + 2 * c)) GRID_BAR(); PROBE_MARK(13 + 2 * c);
            }
            if (IN(14 + 2 * c)) {
                { pg8::MoeSched S; S.A = (const char*)HC; S.B = (const char*)MD; S.list = LIST; S.tab = mtab; S.mode = 0; S.nS = 1; S.kbytes = 0; S.omoff = 0;
                  S.gp0 = gp0; S.gp1 = gp1; S.nN = 4; S.G = G; S.c = bx; S.bexp = (size_t)1024 * DFF; S.btile = (size_t)256 * DFF; S.astep = (size_t)256 * DFF; S.gather = false;
                  pg8::EpiBf16Plain E{YB, DM, 1.0f / MOE_SD};
                  pg8::gemm_phase<pg8::EpiBf16Plain, pg8::MoeSched, true, false, true>(lds, gtab, DFF / 2, 28, S, E); }
                if (c == 0) { pg8::MoeSched S; S.A = (const char*)(HC + (size_t)MOE_CH * 256 * DFF); S.B = (const char*)MD; S.list = LIST; S.tab = mtab; S.mode = 2; S.nS = MOE_RS; S.kbytes = (size_t)(DFF / MOE_RS); S.omoff = 0;
                  S.gp0 = 0; S.gp1 = 0; S.nN = 4; S.G = G; S.c = bx; S.bexp = (size_t)1024 * DFF; S.btile = (size_t)256 * DFF; S.astep = (size_t)256 * DFF; S.gather = false;
                  pg8::EpiPartBf16 E{YP, (size_t)8 * 256 * DM, 1.0f / MOE_SD};
                  pg8::gemm_phase<pg8::EpiPartBf16, pg8::MoeSched, true, false, true>(lds, gtab, DFF / 2, DFF / MOE_RS / 128, S, E); }
                if (BOTH(14 + 2 * c)) GRID_BAR(); PROBE_MARK(14 + 2 * c);
            }
        }
    }
    if (IN(17)) {
        PHASE_IDS();
        LAS int* l_pb = (LAS int*)(lds + wave * 128);
        if (lane == 0) { int run = 0, R = 0;
            for (int e = 0; e < 8; ++e) { const int ce = (int)__hip_atomic_load((unsigned*)(ctl + CW_CNT + 64 * e), __ATOMIC_RELAXED, __HIP_MEMORY_SCOPE_AGENT); l_pb[e] = run; l_pb[8 + e] = ce >> 8; l_pb[16 + e] = R; run += ce >> 8; if (ce & 255) ++R; } }
        const float* g2 = MOD + 5 * 6144 + 5 * 1024;
        for (int m0 = gw * 2; m0 < NLAT; m0 += NGW * 2) {
            const int mb = m0 >> 13;
            f32x4 hv[2][4], ya[2][4], yb[2][4]; float wa[2], wb[2];
#pragma unroll
            for (int r = 0; r < 2; ++r) {
                const int m = m0 + r; const int* ti = TINFO + (size_t)m * 8;
                const int ea = ti[0], pa = ti[1], eb = ti[2], pb = ti[3]; wa[r] = __int_as_float(ti[4]); wb[r] = __int_as_float(ti[5]);
                const bool ma = (pa >> 8) < l_pb[8 + ea], mbm = (pb >> 8) < l_pb[8 + eb];
                const size_t sa = ma ? (size_t)(l_pb[ea] + (pa >> 8)) * 256 + (pa & 255) : (size_t)l_pb[16 + ea] * 256 + (pa & 255);
                const size_t sb = mbm ? (size_t)(l_pb[eb] + (pb >> 8)) * 256 + (pb & 255) : (size_t)l_pb[16 + eb] * 256 + (pb & 255);
                const GAS u32x2* xr = (const GAS u32x2*)(HL + (size_t)m * DM) + lane;
#pragma unroll
                for (int j = 0; j < 4; ++j) { const u32x2 w = xr[64 * j]; hv[r][j] = (f32x4){__uint_as_float(w.x << 16), __uint_as_float(w.x & 0xffff0000u), __uint_as_float(w.y << 16), __uint_as_float(w.y & 0xffff0000u)}; }
                { const GAS u32x2* yr = (const GAS u32x2*)((ma ? YB : YP) + sa * DM) + lane;
#pragma unroll
                  for (int j = 0; j < 4; ++j) { const u32x2 a = yr[64 * j]; ya[r][j] = (f32x4){__uint_as_float(a.x << 16), __uint_as_float(a.x & 0xffff0000u), __uint_as_float(a.y << 16), __uint_as_float(a.y & 0xffff0000u)}; }
                  if (!ma) for (int s2 = 1; s2 < MOE_RS; ++s2) { const GAS u32x2* y2 = (const GAS u32x2*)(YP + ((size_t)s2 * 8 * 256 + sa) * DM) + lane;
#pragma unroll
                      for (int j = 0; j < 4; ++j) { const u32x2 a = y2[64 * j]; ya[r][j] += (f32x4){__uint_as_float(a.x << 16), __uint_as_float(a.x & 0xffff0000u), __uint_as_float(a.y << 16), __uint_as_float(a.y & 0xffff0000u)}; } } }
                { const GAS u32x2* yr = (const GAS u32x2*)((mbm ? YB : YP) + sb * DM) + lane;
#pragma unroll
                  for (int j = 0; j < 4; ++j) { const u32x2 a = yr[64 * j]; yb[r][j] = (f32x4){__uint_as_float(a.x << 16), __uint_as_float(a.x & 0xffff0000u), __uint_as_float(a.y << 16), __uint_as_float(a.y & 0xffff0000u)}; }
                  if (!mbm) for (int s2 = 1; s2 < MOE_RS; ++s2) { const GAS u32x2* y2 = (const GAS u32x2*)(YP + ((size_t)s2 * 8 * 256 + sb) * DM) + lane;
#pragma unroll
                      for (int j = 0; j < 4; ++j) { const u32x2 a = y2[64 * j]; yb[r][j] += (f32x4){__uint_as_float(a.x << 16), __uint_as_float(a.x & 0xffff0000u), __uint_as_float(a.y << 16), __uint_as_float(a.y & 0xffff0000u)}; } } }
            }
            float ss[2];
#pragma unroll
            for (int r = 0; r < 2; ++r) { ss[r] = 0.f;
#pragma unroll
                for (int j = 0; j < 4; ++j) { const f32x4 gv = *(const f32x4*)(g2 + (size_t)mb * 6144 + 4 * lane + 256 * j);
                    hv[r][j] = hv[r][j] + gv * (ya[r][j] * wa[r] + yb[r][j] * wb[r]); ss[r] += (hv[r][j].x * hv[r][j].x + hv[r][j].y * hv[r][j].y) + (hv[r][j].z * hv[r][j].z + hv[r][j].w * hv[r][j].w); } }
#pragma unroll
            for (int o = 1; o < 64; o <<= 1) {
#pragma unroll
                for (int r = 0; r < 2; ++r) ss[r] += __shfl_xor(ss[r], o); }
#pragma unroll
            for (int r = 0; r < 2; ++r) { const float rstd = 1.0f / __builtin_sqrtf(ss[r] * (1.0f / DM) + EPS);
                GAS f32x4* orow = (GAS f32x4*)(args.out + (size_t)(m0 + r) * DM) + lane;
#pragma unroll
                for (int j = 0; j < 4; ++j) { const f32x4 fg = *(const f32x4*)(I_FINALG + 4 * lane + 256 * j); __builtin_nontemporal_store((hv[r][j] * rstd) * fg, orow + 64 * j); } }
        }
    }
    PROBE_MARK(17);
#if defined(PROBE_LO)
    { PHASE_IDS(); const float T = (float)(tpB - tpA) * 0.01f; const float cval = __builtin_sqrtf(T / (float)(PROBE_UNIT));
      for (int m = gw; m < NLAT; m += NGW) { GAS f32x4* orow = (GAS f32x4*)(args.out + (size_t)m * DM) + lane;
#pragma unroll
        for (int j = 0; j < 4; ++j) orow[64 * j] = (f32x4){cval, cval, cval, cval}; } }
#endif
#undef IN
#undef BOTH
#undef GRID_BAR
}

#ifndef MK_ONE_LAUNCH
#define MK_ONE_LAUNCH 1
#endif
extern "C" void kernel_launch(void* const* d_in, const int* in_sizes, int n_in, void* d_out, int out_size, void* d_ws, size_t ws_size, hipStream_t stream) {
    static int grid = 0;
    if (grid == 0) {
        if (n_in != 24 || out_size != NLAT * DM || ws_size < WS_END) { fprintf(stderr, "kernel_launch: unexpected problem (n_in %d, out %d, ws %zu < %zu)\n", n_in, out_size, ws_size, (size_t)WS_END); grid = -1; return; }
        int dev = 0, cus = 0, per_cu = 0;
        if (hipGetDevice(&dev) != hipSuccess || hipDeviceGetAttribute(&cus, hipDeviceAttributeMultiprocessorCount, dev) != hipSuccess) { grid = -1; return; }
        if (hipFuncSetAttribute((const void*)fwd, hipFuncAttributeMaxDynamicSharedMemorySize, LDS_BYTES) != hipSuccess) { fprintf(stderr, "kernel_launch: hipFuncSetAttribute failed\n"); grid = -1; return; }
        if (hipOccupancyMaxActiveBlocksPerMultiprocessor(&per_cu, (const void*)fwd, 512, LDS_BYTES) != hipSuccess || per_cu < 1) fprintf(stderr, "kernel_launch: occupancy query says %d\n", per_cu);
        (void)hipGetLastError();
        grid = cus;
    }
    if (grid < 0) return;
    if (hipMemsetAsync((char*)d_ws + WS_CTL, 0, CTL_ZERO_BYTES, stream) != hipSuccess) return;
    Args a{};
    for (int i = 0; i < 24; ++i) a.in[i] = (const float*)d_in[i];
    a.out = (float*)d_out; a.ws = (unsigned char*)d_ws;
#if defined(SPLITAT)
    a.ph_lo = 0; a.ph_hi = SPLITAT; a.li = 0;
    hipLaunchKernelGGL(fwd, dim3(grid), dim3(512), LDS_BYTES, stream, a);
    a.ph_lo = SPLITAT; a.ph_hi = NPH; a.li = 1;
    hipLaunchKernelGGL(fwd, dim3(grid), dim3(512), LDS_BYTES, stream, a);
#elif defined(DUPK)
    a.ph_lo = 0; a.ph_hi = DUPK + 1; a.li = 0;
    hipLaunchKernelGGL(fwd, dim3(grid), dim3(512), LDS_BYTES, stream, a);
#ifdef DUPN
    for (int rep = 0; rep < DUPN; ++rep) { a.ph_lo = DUPK; a.ph_hi = DUPK + 1; a.li = 2; hipLaunchKernelGGL(fwd, dim3(grid), dim3(512), LDS_BYTES, stream, a); }
#endif
    a.ph_lo = DUPK; a.ph_hi = NPH; a.li = 1;
    hipLaunchKernelGGL(fwd, dim3(grid), dim3(512), LDS_BYTES, stream, a);
#elif MK_ONE_LAUNCH
    a.ph_lo = 0; a.ph_hi = NPH;
    hipLaunchKernelGGL(fwd, dim3(grid), dim3(512), LDS_BYTES, stream, a);
#else
    for (int p = 0; p < NPH; ++p) { a.ph_lo = p; a.ph_hi = p + 1; hipLaunchKernelGGL(fwd, dim3(grid), dim3(512), LDS_BYTES, stream, a); }
#endif
}
```

```cpp
#include <hip/hip_runtime.h>
#include <hip/hip_bf16.h>
#include <cstdio>
#include <cstdint>
#include <cmath>

constexpr int DM = 1024, NB = 4, SEQ = 8192, LCTX = 256, NLAT = NB * SEQ, NCTXR = NB * LCTX, MALL = NLAT + NCTXR;
constexpr int DFF = 3584, NEXP = 8, NQKV = 1536;
constexpr int NPL = NLAT / 256, NPA = MALL / 256;
constexpr float EPS = 1e-6f;
constexpr int MOE_CH = 128, MOE_NCH = 2;
constexpr float MOE_SGU = 32.0f, MOE_SD = 64.0f;
constexpr int MOE_RS = 7, P3_NS = 8, P5_NS = 14;

#define LAS __attribute__((address_space(3)))
#define GAS __attribute__((address_space(1)))
typedef unsigned short bf16_t;
typedef short bf16x8 __attribute__((ext_vector_type(8)));
typedef float f32x4 __attribute__((ext_vector_type(4)));
typedef float f32x2 __attribute__((ext_vector_type(2)));
typedef float f32x16 __attribute__((ext_vector_type(16)));
typedef unsigned u32x4 __attribute__((ext_vector_type(4)));
typedef unsigned u32x2 __attribute__((ext_vector_type(2)));
typedef __bf16 bf16x2_t __attribute__((ext_vector_type(2)));
typedef GAS unsigned gu32;

__device__ __forceinline__ unsigned pkbf(float lo, float hi) { f32x2 v = {lo, hi}; bf16x2_t b = __builtin_convertvector(v, bf16x2_t); return __builtin_bit_cast(unsigned, b); }
__device__ __forceinline__ unsigned pk4f8(float a, float b, float c, float d) { unsigned w = 0; w = __builtin_amdgcn_cvt_pk_fp8_f32(a, b, w, false); w = __builtin_amdgcn_cvt_pk_fp8_f32(c, d, w, true); return w; }
__device__ __forceinline__ float bf2f(unsigned short h) { return __builtin_bit_cast(float, (unsigned)h << 16); }
__device__ __forceinline__ float wave_sum(float v) {
#pragma unroll
    for (int o = 1; o < 64; o <<= 1) v += __shfl_xor(v, o);
    return v;
}
__device__ __forceinline__ float gelu_tanh(float x) {
    const float t = x * (1.0f + 0.044715f * x * x);
    const float e = __builtin_amdgcn_exp2f(-2.302208198f * t);
    return x * __builtin_amdgcn_rcpf(1.0f + e);
}
__device__ __forceinline__ float silu_f(float x) { return x * __builtin_amdgcn_rcpf(1.0f + __builtin_amdgcn_exp2f(-1.4426950409f * x)); }

constexpr size_t MiB = 1u << 20;
constexpr size_t WS_CTL = 0, CTL_ZERO_BYTES = 1 * MiB;
constexpr size_t WS_MOD = 1 * MiB;
constexpr size_t WS_ROPE = 1 * MiB + 256 * 1024;
constexpr size_t WS_STATS = 2 * MiB;
constexpr size_t WS_LIST = 5 * MiB;
constexpr size_t WS_TINFO = 6 * MiB;
constexpr size_t WS_WS = 7 * MiB;
constexpr size_t WS_WIN = 8 * MiB, WS_WAO = 12 * MiB, WS_WQKV = 14 * MiB, WS_WBO = 17 * MiB, WS_WGU = 19 * MiB, WS_WD = 33 * MiB;
constexpr size_t WS_MGU = 40 * MiB, WS_MD = 96 * MiB;
constexpr size_t WS_HLB = 124 * MiB;
constexpr size_t WS_XN = 208 * MiB;
constexpr size_t WS_ZB = 274 * MiB;
constexpr size_t WS_R = 278 * MiB;
constexpr size_t WS_UVT = WS_R, WS_A2 = WS_R + 132 * MiB, WS_PART1 = WS_R + 198 * MiB, WS_H = WS_R, WS_PART2 = WS_R + 231 * MiB;
constexpr size_t WS_QKV = WS_R, WS_O = WS_R + 99 * MiB;
constexpr size_t WS_Y = WS_R, WS_YP = WS_R + 128 * MiB, WS_HC = WS_R + 156 * MiB;
constexpr size_t WS_END = WS_R + 287 * MiB;
static_assert(WS_UVT + (size_t)2048 * MALL * 2 <= WS_A2 && WS_A2 + (size_t)MALL * DM * 2 <= WS_PART1 && WS_PART1 + (size_t)P3_NS * NCTXR * DM * 4 <= WS_END, "layer-0 mixer map");
static_assert(WS_H + (size_t)MALL * DFF * 2 <= WS_PART2 && WS_PART2 + (size_t)P5_NS * NCTXR * DM * 4 <= WS_END && WS_QKV + (size_t)MALL * NQKV * 2 <= WS_O && WS_O + (size_t)NLAT * DM * 2 <= WS_END, "region map");
static_assert(WS_Y + (size_t)256 * 256 * DM * 2 <= WS_YP && WS_YP + (size_t)MOE_RS * 8 * 256 * DM * 2 <= WS_HC && WS_HC + (size_t)(MOE_CH + 8) * 256 * DFF <= WS_END, "MoE map");
static_assert(WS_MD + (size_t)8 * DM * DFF <= WS_HLB && WS_HLB + (size_t)NLAT * DM * 2 <= WS_XN && WS_XN + (size_t)MALL * DM * 2 <= WS_ZB && WS_MD + (size_t)8 * DM * DFF <= WS_XN && WS_MGU + (size_t)8 * 7168 * DM <= WS_MD, "weights map");
constexpr int CW_TMO = 0, CW_CODE = 1;
constexpr int CW_CNT = 64;
constexpr int CW_BAR = 4096;

constexpr int RING_BYTES = 131072;
constexpr int GTAB_OFF = RING_BYTES;
constexpr int MOE_OFF = RING_BYTES + 1024;
constexpr int MISC_OFF = RING_BYTES + 2048;
constexpr int LDS_BYTES = 147456;

namespace pg8 {
constexpr int BM = 256, BK = 64, HALF = 128, HTB = HALF * BK * 2, STAGE_BYTES = 8 * HTB, NXCD = 8, WGM = 8;
__host__ __device__ __forceinline__ int lds_byte(int r, int c) { const int st = (r >> 4) * 2 + (c >> 5), rr = r & 15, cc = c & 31, ob = rr * 64 + cc * 2; return st * 1024 + (ob ^ (((ob >> 9) & 1) << 5)); }
__host__ __device__ __forceinline__ void stage_rc(int b, int& R, int& C) { const int st = b / 1024, sb = b % 1024, swz = sb ^ (((sb >> 9) & 1) << 5); R = (st >> 1) * 16 + swz / 64; C = (st & 1) * 32 + (swz % 64) / 2; }
__host__ __device__ __forceinline__ int perm32(int rho) { const int n = rho >> 4, i = rho & 15; return 8 * (i >> 2) + 4 * n + (i & 3); }

struct Unit { const char* a; const char* b; const int* gl; int pm, pn, om, nv, ks; };

__device__ __forceinline__ bool tile_order(int i, int G, int c, int nM, int nN, int& pm, int& pn) {
    const int nwg = nM * nN; const long L = (long)i * G + c; if (L >= nwg) return false;
    int wgid = (int)L; { const int q = nwg / NXCD, r = nwg % NXCD, xcd = wgid % NXCD, off = wgid / NXCD; wgid = (xcd < r ? xcd * (q + 1) : r * (q + 1) + (xcd - r) * q) + off; }
    const int nig = WGM * nN, gid = wgid / nig, fm = gid * WGM, gsz = (nM - fm) < WGM ? (nM - fm) : WGM;
    pm = fm + ((wgid % nig) % gsz); pn = (wgid % nig) / gsz; return true;
}
struct DenseSched {
    const char* A; const char* B; int nM, nN, G, c; size_t tstep;
    __device__ __forceinline__ bool next(int i, Unit& u) const {
        int pm, pn; if (!tile_order(i, G, c, nM, nN, pm, pn)) return false;
        u.a = A + (size_t)pm * tstep; u.b = B + (size_t)pn * tstep; u.gl = nullptr; u.pm = pm; u.pn = pn; u.om = pm; u.nv = 256; u.ks = 0; return true;
    }
};
typedef int v8i_t __attribute__((ext_vector_type(8)));
typedef int v4i_t __attribute__((ext_vector_type(4)));
__device__ __forceinline__ v8i_t cat8(bf16x8 lo, bf16x8 hi) { const v4i_t a = __builtin_bit_cast(v4i_t, lo), b = __builtin_bit_cast(v4i_t, hi); return __builtin_shufflevector(a, b, 0, 1, 2, 3, 4, 5, 6, 7); }
struct SplitSched {
    const char* A; const char* B; int nM, nN, nS, G, c, pm0; size_t tstep, kbytes;
    __device__ __forceinline__ bool next(int i, Unit& u) const {
        const int L = i * G + c; if (L >= nM * nN * nS) return false;
        const int ks = L % nS, t = L / nS, pn = t % nN, pm = t / nN;
        u.a = A + (size_t)pm * tstep + (size_t)ks * kbytes; u.b = B + (size_t)pn * tstep + (size_t)ks * kbytes; u.gl = nullptr; u.pm = pm0 + pm; u.pn = pn; u.om = pm; u.nv = 256; u.ks = ks; return true;
    }
};
struct MoeSched {
    const char* A; const char* B; const int* list; const LAS int* tab; int gp0, gp1, nN, nS, G, c, mode, omoff; size_t bexp, btile, astep, kbytes; bool gather;
    __device__ __forceinline__ bool next(int i, Unit& u) const {
        int pm, pn, ks = 0;
        if (mode == 0) { if (gp1 <= gp0) return false; if (!tile_order(i, G, c, gp1 - gp0, nN, pm, pn)) return false; }
        else { const int R = __builtin_amdgcn_readfirstlane(tab[32]); const int L = i * G + c; if (L >= R * nN * nS) return false; ks = L % nS; const int t = L / nS; pn = t % nN; pm = t / nN; }
        int e = 0, lp, nv;
        if (mode == 0) { const int gp = gp0 + pm;
#pragma unroll
            for (int k = 1; k < 8; ++k) e += (gp >= __builtin_amdgcn_readfirstlane(tab[k])) ? 1 : 0;
            lp = gp - __builtin_amdgcn_readfirstlane(tab[e]); nv = 256; u.pm = gp; }
        else { e = __builtin_amdgcn_readfirstlane(tab[24 + pm]); const int ce = __builtin_amdgcn_readfirstlane(tab[16 + e]); lp = ce >> 8; nv = ce & 255; u.pm = pm; }
        u.b = B + (size_t)e * bexp + (size_t)pn * btile + (size_t)ks * kbytes; u.pn = pn; u.nv = nv; u.ks = ks; u.om = pm;
        if (gather) { u.a = A; u.gl = list + (size_t)e * NLAT + 256 * lp; u.om = pm + omoff; }
        else { u.a = A + (size_t)pm * astep + (size_t)ks * kbytes; u.gl = nullptr; if (mode == 0) u.om = gp0 + pm; }
        return true;
    }
};

struct EpiGeluT {
    static constexpr bool PERM = true;
    bf16_t* O; float* stats;
    __device__ __forceinline__ void operator()(const f32x4 (&acc)[2][2][4][2], const Unit& u, int wr, int wc, int fr, int fq) const {
        const int row0 = u.pm * BM + wr * 64 + fr, col0 = u.pn * BM + wc * 32 + 8 * fq;
        const bool isv = u.pm >= 4;
        float s1[2][2][4], s2[2][2][4];
#pragma unroll
        for (int bj = 0; bj < 2; ++bj)
#pragma unroll
            for (int n = 0; n < 2; ++n)
#pragma unroll
                for (int e = 0; e < 4; ++e) { s1[bj][n][e] = 0.f; s2[bj][n][e] = 0.f; }
#pragma unroll
        for (int ai = 0; ai < 2; ++ai)
#pragma unroll
            for (int m = 0; m < 4; ++m) { bf16_t* rowp = O + (size_t)(row0 + ai * HALF + m * 16) * MALL + col0;
#pragma unroll
                for (int bj = 0; bj < 2; ++bj) { f32x4 v0 = acc[ai][bj][m][0], v1 = acc[ai][bj][m][1];
#pragma unroll
                    for (int e = 0; e < 4; ++e) { v0[e] = gelu_tanh(v0[e]); v1[e] = gelu_tanh(v1[e]); s1[bj][0][e] += v0[e]; s2[bj][0][e] += v0[e] * v0[e]; s1[bj][1][e] += v1[e]; s2[bj][1][e] += v1[e] * v1[e]; }
                    u32x4 w; w.x = pkbf(v0[0], v0[1]); w.y = pkbf(v0[2], v0[3]); w.z = pkbf(v1[0], v1[1]); w.w = pkbf(v1[2], v1[3]);
                    *(u32x4*)(rowp + bj * HALF) = w; } }
        if (isv) {
            const int slot = (u.pm - 4) * 2 + wr;
#pragma unroll
            for (int bj = 0; bj < 2; ++bj)
#pragma unroll
                for (int n = 0; n < 2; ++n)
#pragma unroll
                    for (int e = 0; e < 4; ++e) { float a = s1[bj][n][e], b = s2[bj][n][e];
#pragma unroll
                        for (int o = 1; o < 16; o <<= 1) { a += __shfl_xor(a, o); b += __shfl_xor(b, o); }
                        if (fr == 0) { const int tok = col0 + bj * HALF + 4 * n + e; *(f32x2*)(stats + (size_t)tok * 16 + slot * 2) = (f32x2){a, b}; } }
        }
    }
};
template <bool BASE_F32> struct EpiResid {
    static constexpr bool PERM = true;
    const float* basef; const bf16_t* baseb; bf16_t* out; const float* gate;
    __device__ __forceinline__ void operator()(const f32x4 (&acc)[2][2][4][2], const Unit& u, int wr, int wc, int fr, int fq) const {
        const int mb = u.pm >> 5; const int col0 = u.pn * BM + wc * 32 + 8 * fq;
        f32x4 gv[2][2];
#pragma unroll
        for (int bj = 0; bj < 2; ++bj)
#pragma unroll
            for (int n = 0; n < 2; ++n) gv[bj][n] = *(const f32x4*)(gate + (size_t)mb * 6144 + col0 + bj * HALF + n * 4);
#pragma unroll
        for (int ai = 0; ai < 2; ++ai)
#pragma unroll
            for (int m = 0; m < 4; ++m) { const size_t off = (size_t)(u.pm * BM + wr * 64 + fr + ai * HALF + m * 16) * DM + col0;
#pragma unroll
                for (int bj = 0; bj < 2; ++bj) { f32x4 b0, b1;
                    if constexpr (BASE_F32) { b0 = *(const f32x4*)(basef + off + bj * HALF); b1 = *(const f32x4*)(basef + off + bj * HALF + 4); }
                    else { const u32x4 w = *(const u32x4*)(baseb + off + bj * HALF);
                        b0 = (f32x4){__uint_as_float(w.x << 16), __uint_as_float(w.x & 0xffff0000u), __uint_as_float(w.y << 16), __uint_as_float(w.y & 0xffff0000u)};
                        b1 = (f32x4){__uint_as_float(w.z << 16), __uint_as_float(w.z & 0xffff0000u), __uint_as_float(w.w << 16), __uint_as_float(w.w & 0xffff0000u)}; }
                    const f32x4 o0 = b0 + gv[bj][0] * acc[ai][bj][m][0], o1 = b1 + gv[bj][1] * acc[ai][bj][m][1];
                    u32x4 w; w.x = pkbf(o0[0], o0[1]); w.y = pkbf(o0[2], o0[3]); w.z = pkbf(o1[0], o1[1]); w.w = pkbf(o1[2], o1[3]);
                    *(u32x4*)(out + off + bj * HALF) = w; } }
    }
};
struct EpiSwiGLU {
    static constexpr bool PERM = true;
    bf16_t* O;
    __device__ __forceinline__ void operator()(const f32x4 (&acc)[2][2][4][2], const Unit& u, int wr, int wc, int fr, int fq) const {
        bf16_t* base = O + (size_t)(u.om * BM + wr * 64 + fr) * DFF + u.pn * 128 + wc * 32 + 8 * fq;
#pragma unroll
        for (int ai = 0; ai < 2; ++ai)
#pragma unroll
            for (int m = 0; m < 4; ++m) { const f32x4 g0 = acc[ai][0][m][0], g1 = acc[ai][0][m][1], u0 = acc[ai][1][m][0], u1 = acc[ai][1][m][1];
                float o[8];
#pragma unroll
                for (int e = 0; e < 4; ++e) { o[e] = silu_f(g0[e]) * u0[e]; o[4 + e] = silu_f(g1[e]) * u1[e]; }
                u32x4 w; w.x = pkbf(o[0], o[1]); w.y = pkbf(o[2], o[3]); w.z = pkbf(o[4], o[5]); w.w = pkbf(o[6], o[7]);
                *(u32x4*)(base + (size_t)(ai * HALF + m * 16) * DFF) = w; }
    }
};
struct EpiQKV {
    static constexpr bool PERM = false;
    bf16_t* O; const float* cosT; const float* sinT; float qscale;
    __device__ __forceinline__ void operator()(const f32x4 (&acc)[2][2][4][2], const Unit& u, int wr, int wc, int fr, int fq) const {
        const bool lat = u.pm < NPL; const bool dorope = lat && u.pn < 5; const float sc = u.pn < 4 ? qscale : 1.0f;
        const int col0 = u.pn * BM + wc * 32 + 4 * fq;
#pragma unroll
        for (int ai = 0; ai < 2; ++ai)
#pragma unroll
            for (int m = 0; m < 4; ++m) { const int grow = u.pm * BM + ai * HALF + wr * 64 + m * 16 + fr; const int s = grow & (SEQ - 1); const int pos = (wc & 1) ? (s & 63) : (s >> 6);
                f32x4 cs = (f32x4){1.f, 1.f, 1.f, 1.f}, sn = (f32x4){0.f, 0.f, 0.f, 0.f};
                if (dorope) { cs = *(const f32x4*)(cosT + pos * 16 + 4 * fq); sn = *(const f32x4*)(sinT + pos * 16 + 4 * fq); }
                bf16_t* rowp = O + (size_t)grow * NQKV + col0;
#pragma unroll
                for (int bj = 0; bj < 2; ++bj) { const f32x4 x1 = acc[ai][bj][m][0], x2 = acc[ai][bj][m][1];
                    const f32x4 o1 = (x1 * cs - x2 * sn) * sc, o2 = (x1 * sn + x2 * cs) * sc;
                    u32x2 w1, w2; w1.x = pkbf(o1[0], o1[1]); w1.y = pkbf(o1[2], o1[3]); w2.x = pkbf(o2[0], o2[1]); w2.y = pkbf(o2[2], o2[3]);
                    *(u32x2*)(rowp + bj * HALF) = w1; *(u32x2*)(rowp + bj * HALF + 16) = w2; } }
    }
};
struct EpiSwiGLU8 {
    static constexpr bool PERM = true;
    unsigned char* O; float s;
    __device__ __forceinline__ void operator()(const f32x4 (&acc)[2][2][4][2], const Unit& u, int wr, int wc, int fr, int fq) const {
        unsigned char* base = O + (size_t)(u.om * BM + wr * 64 + fr) * DFF + u.pn * 128 + wc * 32 + 8 * fq;
#pragma unroll
        for (int ai = 0; ai < 2; ++ai)
#pragma unroll
            for (int m = 0; m < 4; ++m) { const f32x4 g0 = acc[ai][0][m][0] * s, g1 = acc[ai][0][m][1] * s, u0 = acc[ai][1][m][0] * s, u1 = acc[ai][1][m][1] * s;
                float o[8];
#pragma unroll
                for (int e = 0; e < 4; ++e) { o[e] = silu_f(g0[e]) * u0[e]; o[4 + e] = silu_f(g1[e]) * u1[e]; }
                u32x2 w; w.x = pk4f8(o[0], o[1], o[2], o[3]); w.y = pk4f8(o[4], o[5], o[6], o[7]);
                *(u32x2*)(base + (size_t)(ai * HALF + m * 16) * DFF) = w; }
    }
};
struct EpiBf16Plain {
    static constexpr bool PERM = true;
    bf16_t* O; int ldc; float s;
    __device__ __forceinline__ void operator()(const f32x4 (&acc)[2][2][4][2], const Unit& u, int wr, int wc, int fr, int fq) const {
        bf16_t* base = O + (size_t)(u.om * BM + wr * 64 + fr) * ldc + u.pn * BM + wc * 32 + 8 * fq;
#pragma unroll
        for (int ai = 0; ai < 2; ++ai)
#pragma unroll
            for (int m = 0; m < 4; ++m)
#pragma unroll
                for (int bj = 0; bj < 2; ++bj) { const f32x4 v0 = acc[ai][bj][m][0] * s, v1 = acc[ai][bj][m][1] * s;
                    u32x4 w; w.x = pkbf(v0[0], v0[1]); w.y = pkbf(v0[2], v0[3]); w.z = pkbf(v1[0], v1[1]); w.w = pkbf(v1[2], v1[3]);
                    *(u32x4*)(base + (size_t)(ai * HALF + m * 16) * ldc + bj * HALF) = w; }
    }
};

struct EpiPartF32 {
    static constexpr bool PERM = true;
    float* P; size_t sstride;
    __device__ __forceinline__ void operator()(const f32x4 (&acc)[2][2][4][2], const Unit& u, int wr, int wc, int fr, int fq) const {
        float* base = P + (size_t)u.ks * sstride + (size_t)(u.om * BM + wr * 64 + fr) * DM + u.pn * BM + wc * 32 + 8 * fq;
#pragma unroll
        for (int ai = 0; ai < 2; ++ai)
#pragma unroll
            for (int m = 0; m < 4; ++m)
#pragma unroll
                for (int bj = 0; bj < 2; ++bj)
#pragma unroll
                    for (int n = 0; n < 2; ++n) *(f32x4*)(base + (size_t)(ai * HALF + m * 16) * DM + bj * HALF + n * 4) = acc[ai][bj][m][n];
    }
};
struct EpiPartBf16 {
    static constexpr bool PERM = true;
    bf16_t* P; size_t sstride; float s;
    __device__ __forceinline__ void operator()(const f32x4 (&acc)[2][2][4][2], const Unit& u, int wr, int wc, int fr, int fq) const {
        bf16_t* base = P + (size_t)u.ks * sstride + (size_t)(u.om * BM + wr * 64 + fr) * DM + u.pn * BM + wc * 32 + 8 * fq;
#pragma unroll
        for (int ai = 0; ai < 2; ++ai)
#pragma unroll
            for (int m = 0; m < 4; ++m)
#pragma unroll
                for (int bj = 0; bj < 2; ++bj) { const f32x4 v0 = acc[ai][bj][m][0] * s, v1 = acc[ai][bj][m][1] * s;
                    u32x4 w; w.x = pkbf(v0[0], v0[1]); w.y = pkbf(v0[2], v0[3]); w.z = pkbf(v1[0], v1[1]); w.w = pkbf(v1[2], v1[3]);
                    *(u32x4*)(base + (size_t)(ai * HALF + m * 16) * DM + bj * HALF) = w; }
    }
};

template <class Epi, class Sched, bool ALIGN_EPI, bool GATHER, bool FP8 = false>
__device__ __forceinline__ void gemm_phase(LAS unsigned char* lds, LAS int* gtab, const int K  , const int nt_in  , const Sched& S, const Epi& E) {
    int nt = nt_in; asm volatile("" : "+s"(nt));
    int tid_ = threadIdx.x; asm volatile("" : "+v"(tid_));
    const int tid = tid_, wid = __builtin_amdgcn_readfirstlane(tid >> 6), lane = tid & 63, wr = wid >> 2, wc = wid & 3, fr = lane & 15, fq = lane >> 4;
    const size_t kstep = (size_t)(BK * 2);
    const size_t hstep = (size_t)HALF * K * 2;
    unsigned voffB[2];
#pragma unroll
    for (int i = 0; i < 2; ++i) { int R, C; stage_rc(tid * 16 + i * 8192, R, C); const int Rb = Epi::PERM ? ((R & ~31) + perm32(R & 31)) : R;
        voffB[i] = (unsigned)(Rb * K + C) * 2u; }
    unsigned vA[2][2], vN[2][2];
    const unsigned ldsw = (unsigned)wid * 1024u;
    const int aoff = lds_byte(wr * 64 + fr, fq * 8), boff = lds_byte(wc * 32 + fr, fq * 8);
    const LAS unsigned char* aB = lds + aoff; const LAS unsigned char* bB = lds + 65536 + boff;
    asm volatile("" : "+v"(aB), "+v"(bB));
#define PG8_SA(b, h) (((b) * 2 + (h)) * HTB)
#define PG8_SB(b, h) ((4 + (b) * 2 + (h)) * HTB)
#define PG8_STAGE(bufoff, gbase, voff) do { _Pragma("unroll") for (int _i = 0; _i < 2; ++_i) \
        __builtin_amdgcn_global_load_lds((const unsigned*)((const char*)(gbase) + (voff)[_i]), (LAS unsigned*)(lds + (bufoff) + ldsw + _i * 8192), 16, 0, 0); } while (0)
#define PG8_LDA(dst, b, h) do { _Pragma("unroll") for (int m = 0; m < 4; ++m) { if constexpr (FP8) dst##8[m] = cat8(*(const LAS bf16x8*)(aB + PG8_SA(b, h) + m * 2048), *(const LAS bf16x8*)(aB + PG8_SA(b, h) + m * 2048 + 1024)); \
        else { _Pragma("unroll") for (int k = 0; k < 2; ++k) dst[m][k] = *(const LAS bf16x8*)(aB + PG8_SA(b, h) + m * 2048 + k * 1024); } } } while (0)
#define PG8_LDB(dst, b, h) do { _Pragma("unroll") for (int n = 0; n < 2; ++n) { if constexpr (FP8) dst##8[n] = cat8(*(const LAS bf16x8*)(bB + (PG8_SB(b, h) - 65536) + n * 2048), *(const LAS bf16x8*)(bB + (PG8_SB(b, h) - 65536) + n * 2048 + 1024)); \
        else { _Pragma("unroll") for (int k = 0; k < 2; ++k) dst[n][k] = *(const LAS bf16x8*)(bB + (PG8_SB(b, h) - 65536) + n * 2048 + k * 1024); } } } while (0)
#define PG8_MMA(ai, bj, At, Bt) do { __builtin_amdgcn_s_setprio(1); \
    if constexpr (FP8) { _Pragma("unroll") for (int m = 0; m < 4; ++m) _Pragma("unroll") for (int n = 0; n < 2; ++n) \
        asm volatile("v_mfma_f32_16x16x128_f8f6f4 %0, %1, %2, %0" : "+v"(acc[ai][bj][m][n]) : "v"(Bt##8[n]), "v"(At##8[m])); } \
    else { _Pragma("unroll") for (int m = 0; m < 4; ++m) _Pragma("unroll") for (int n = 0; n < 2; ++n) _Pragma("unroll") for (int k = 0; k < 2; ++k) \
        acc[ai][bj][m][n] = __builtin_amdgcn_mfma_f32_16x16x32_bf16(Bt[n][k], At[m][k], acc[ai][bj][m][n], 0, 0, 0); } \
    __builtin_amdgcn_s_setprio(0); } while (0)
#define PG8_WAIT_V(n) asm volatile("s_waitcnt vmcnt(" #n ")" ::: "memory")
#define PG8_WAIT_L(n) asm volatile("s_waitcnt lgkmcnt(" #n ")" ::: "memory")
#define PG8_BAR __builtin_amdgcn_s_barrier()
#define PG8_SCHED __builtin_amdgcn_sched_barrier(0)
    Unit cur, nxt; int ui = 0;
    if (!S.next(0, cur)) return;
    f32x4 acc[2][2][4][2];
#pragma unroll
    for (int a = 0; a < 2; ++a)
#pragma unroll
        for (int b = 0; b < 2; ++b)
#pragma unroll
            for (int m = 0; m < 4; ++m)
#pragma unroll
                for (int n = 0; n < 2; ++n) acc[a][b][m][n] = (f32x4){0.f, 0.f, 0.f, 0.f};
    bf16x8 At[4][2], B0[2][2], B1[2][2]; v8i_t At8[4], B08[2], B18[2];
    if constexpr (GATHER) {
#pragma unroll
        for (int h = 0; h < 2; ++h)
#pragma unroll
            for (int i = 0; i < 2; ++i) { int R, C; stage_rc(tid * 16 + i * 8192, R, C); const int row = h * HALF + R; const int tok = cur.gl[row < cur.nv ? row : 0]; vA[h][i] = (unsigned)tok * (unsigned)(K * 2) + (unsigned)C * 2u; }
    } else {
#pragma unroll
        for (int h = 0; h < 2; ++h)
#pragma unroll
            for (int i = 0; i < 2; ++i) { int R, C; stage_rc(tid * 16 + i * 8192, R, C); vA[h][i] = (unsigned)(R * K + C) * 2u + (unsigned)(h * hstep); }
    }
#pragma unroll
    for (int h = 0; h < 2; ++h)
#pragma unroll
        for (int i = 0; i < 2; ++i) vN[h][i] = vA[h][i];
    const char* cA = cur.a; const char* cB = cur.b;
    PG8_STAGE(PG8_SB(0, 0), cB, voffB); PG8_STAGE(PG8_SB(0, 1), cB + hstep, voffB); PG8_STAGE(PG8_SA(0, 0), cA, vA[0]); PG8_STAGE(PG8_SA(0, 1), cA, vA[1]);
    if (wr == 1) PG8_BAR;
    PG8_WAIT_V(2); PG8_BAR;
    PG8_STAGE(PG8_SB(1, 0), cB + kstep, voffB); PG8_STAGE(PG8_SA(1, 0), cA + kstep, vA[0]); PG8_STAGE(PG8_SB(1, 1), cB + hstep + kstep, voffB);
    PG8_WAIT_V(6); PG8_BAR;
    for (;;) {
        const bool has_next = S.next(ui + 1, nxt);
        const char* nA = has_next ? nxt.a : cA; const char* nB = has_next ? nxt.b : cB;
        if constexpr (GATHER) {
            if (has_next && wid < 4) __builtin_amdgcn_global_load_lds((const unsigned*)(nxt.gl + wid * 64 + lane), (LAS unsigned*)(gtab + wid * 64), 4, 0, 0);
        }
        for (int t = 0; t < nt; t += 2) {
            const bool last = (t == nt - 2);
            const char* a1 = cA + (size_t)(t + 1) * kstep;
            const char* a2 = last ? nA : cA + (size_t)(t + 2) * kstep; const char* b2 = last ? nB : cB + (size_t)(t + 2) * kstep;
            const char* a3 = a2 + kstep; const char* b3 = b2 + kstep;
            if constexpr (GATHER) {
                if (last && has_next) {
                    int t2 = tid; asm volatile("" : "+v"(t2));
#pragma unroll
                    for (int h = 0; h < 2; ++h)
#pragma unroll
                        for (int i = 0; i < 2; ++i) { int R, C; stage_rc(t2 * 16 + i * 8192, R, C); const int row = h * HALF + R; const int tok = gtab[row < nxt.nv ? row : 0]; vN[h][i] = (unsigned)tok * (unsigned)(K * 2) + (unsigned)C * 2u; }
                }
            }
            unsigned vS0[2], vS1[2];
#pragma unroll
            for (int i = 0; i < 2; ++i) { vS0[i] = (GATHER && last) ? vN[0][i] : vA[0][i]; vS1[i] = (GATHER && last) ? vN[1][i] : vA[1][i]; }
            PG8_LDB(B0, 0, 0); PG8_LDB(B1, 0, 1); PG8_SCHED; PG8_LDA(At, 0, 0); PG8_STAGE(PG8_SA(1, 1), a1, vA[1]);
            PG8_WAIT_V(8); PG8_WAIT_L(0); PG8_BAR; PG8_MMA(0, 0, At, B0); PG8_MMA(0, 1, At, B1); PG8_BAR; PG8_SCHED;
            PG8_LDA(At, 0, 1); PG8_STAGE(PG8_SB(0, 0), b2, voffB); PG8_STAGE(PG8_SB(0, 1), b2 + hstep, voffB); PG8_STAGE(PG8_SA(0, 0), a2, vS0);
            PG8_WAIT_V(8); PG8_WAIT_L(0); PG8_BAR; PG8_MMA(1, 0, At, B0); PG8_MMA(1, 1, At, B1); PG8_BAR; PG8_SCHED;
            PG8_LDB(B0, 1, 0); PG8_LDB(B1, 1, 1); PG8_SCHED; PG8_LDA(At, 1, 0); PG8_STAGE(PG8_SA(0, 1), a2, vS1);
            PG8_WAIT_V(8); PG8_WAIT_L(0); PG8_BAR; PG8_MMA(0, 0, At, B0); PG8_MMA(0, 1, At, B1); PG8_BAR; PG8_SCHED;
            PG8_LDA(At, 1, 1); PG8_STAGE(PG8_SB(1, 0), b3, voffB); PG8_STAGE(PG8_SB(1, 1), b3 + hstep, voffB); PG8_STAGE(PG8_SA(1, 0), a3, vS0);
            PG8_WAIT_V(8); PG8_WAIT_L(0); PG8_BAR; PG8_MMA(1, 0, At, B0); PG8_MMA(1, 1, At, B1); PG8_BAR; PG8_SCHED;
        }
        if constexpr (ALIGN_EPI) { if (wr == 0) PG8_BAR; }
        if constexpr (FP8) asm volatile("s_nop 15\n\ts_nop 15" ::: "memory");
        E(acc, cur, wr, wc, fr, fq);
        if (!has_next) break;
#pragma unroll
        for (int a = 0; a < 2; ++a)
#pragma unroll
            for (int b = 0; b < 2; ++b)
#pragma unroll
                for (int m = 0; m < 4; ++m)
#pragma unroll
                    for (int n = 0; n < 2; ++n) acc[a][b][m][n] = (f32x4){0.f, 0.f, 0.f, 0.f};
        cur = nxt; cA = nA; cB = nB; ++ui;
        if constexpr (GATHER) {
#pragma unroll
            for (int h = 0; h < 2; ++h)
#pragma unroll
                for (int i = 0; i < 2; ++i) vA[h][i] = vN[h][i];
        }
        if constexpr (ALIGN_EPI) { if (wr == 1) PG8_BAR; }
    }
    PG8_WAIT_V(0);
    if constexpr (!ALIGN_EPI) { if (wr == 0) PG8_BAR; }
    PG8_BAR;
#undef PG8_SA
#undef PG8_SB
#undef PG8_STAGE
#undef PG8_LDA
#undef PG8_LDB
#undef PG8_MMA
#undef PG8_WAIT_V
#undef PG8_WAIT_L
#undef PG8_BAR
#undef PG8_SCHED
}
}

namespace attn_body {
using bf16 = __hip_bfloat16;
using s16x4 = __attribute__((ext_vector_type(4))) short;
constexpr int D = 64, PITCH = NQKV, OPITCH = DM;
constexpr int NW = 8, QBLK = 32, KVBLK = 64;
__device__ __forceinline__ int crow(int r, int hi) { return (r & 3) + 8 * (r >> 2) + 4 * hi; }
#define SBAR() __builtin_amdgcn_sched_barrier(0)
__device__ __forceinline__ void bmask(f32x16& p0, f32x16& p1, int kb, int qrel, int hi) {
    const float NEG = -INFINITY; const int d0 = kb + 4 * hi - qrel;
#pragma unroll
    for (int r = 0; r < 16; ++r) { const int d = d0 + (r & 3) + 8 * (r >> 2); if (d < -128 || d > 128) p0[r] = NEG; if (d + 32 < -128 || d + 32 > 128) p1[r] = NEG; }
}
constexpr int NSLOT = 3, SLOTB = 8192;
constexpr int LDS_K = 0, LDS_V = NSLOT * SLOTB, LDS_WS = 2 * NSLOT * SLOTB, LDS_OST = LDS_WS + NW * 64 * 4, LDS_BYTES_A = LDS_OST + NW * 4096;
constexpr float C2 = 0.125f * 1.4426950408889634f;
__device__ __forceinline__ void glds16(const void* gsrc, unsigned lds_dst) { unsigned keep;
    asm volatile("s_mov_b32 %0, m0\n\ts_mov_b32 m0, %2\n\ts_nop 0\n\tglobal_load_lds_dwordx4 %1, off\n\ts_mov_b32 m0, %0" : "=&s"(keep) : "v"(gsrc), "s"(lds_dst) : "memory"); }
__device__ __forceinline__ float max3f(float a, float b, float c) { float r; asm("v_max3_f32 %0, %1, %2, %3" : "=v"(r) : "v"(a), "v"(b), "v"(c)); return r; }
__device__ __forceinline__ float max2f(float a, float b) { float r; asm("v_max_f32_e32 %0, %1, %2" : "=v"(r) : "v"(a), "v"(b)); return r; }
__device__ __forceinline__ float fadd_s(float a, float b) { float r; asm("v_add_f32_e32 %0, %1, %2" : "=v"(r) : "v"(a), "v"(b)); return r; }
__device__ __forceinline__ float fsub_s(float a, float b) { float r; asm("v_sub_f32_e32 %0, %1, %2" : "=v"(r) : "v"(a), "v"(b)); return r; }
__device__ __forceinline__ unsigned cvtpk_s(float lo, float hi) { f32x2 v = {lo, hi}; bf16x2_t b = __builtin_convertvector(v, bf16x2_t); return __builtin_bit_cast(unsigned, b); }
#define WAIT_BAR(N) asm volatile("s_waitcnt vmcnt(" #N ") lgkmcnt(0)\n\ts_barrier" ::: "memory")
__device__ __forceinline__ void qkt(f32x16& p0, f32x16& p1, const char* Kslot, const bf16x8* qr, const f32x16& negm, int r32, int hi) {
    const char* kb = Kslot + hi * 1024 + r32 * 16;
#pragma unroll
    for (int d0 = 0; d0 < 4; ++d0) {
        const bf16x8 b0 = *reinterpret_cast<const bf16x8*>(kb + d0 * 2048);
        const bf16x8 b1 = *reinterpret_cast<const bf16x8*>(kb + d0 * 2048 + 512);
        if (d0 == 0) { p0 = __builtin_amdgcn_mfma_f32_32x32x16_bf16(b0, qr[0], negm, 0, 0, 0); p1 = __builtin_amdgcn_mfma_f32_32x32x16_bf16(b1, qr[0], negm, 0, 0, 0); }
        else { p0 = __builtin_amdgcn_mfma_f32_32x32x16_bf16(b0, qr[d0], p0, 0, 0, 0); p1 = __builtin_amdgcn_mfma_f32_32x32x16_bf16(b1, qr[d0], p1, 0, 0, 0); } }
}
typedef __attribute__((address_space(3))) const char* lds_cptr;
typedef short v4i16_t __attribute__((ext_vector_type(4)));
__device__ __forceinline__ void kload8(bf16x8* kf, lds_cptr kp) {
    kf[0] = *(const __attribute__((address_space(3))) bf16x8*)(kp);        kf[1] = *(const __attribute__((address_space(3))) bf16x8*)(kp + 512);
    kf[2] = *(const __attribute__((address_space(3))) bf16x8*)(kp + 2048); kf[3] = *(const __attribute__((address_space(3))) bf16x8*)(kp + 2560);
    kf[4] = *(const __attribute__((address_space(3))) bf16x8*)(kp + 4096); kf[5] = *(const __attribute__((address_space(3))) bf16x8*)(kp + 4608);
    kf[6] = *(const __attribute__((address_space(3))) bf16x8*)(kp + 6144); kf[7] = *(const __attribute__((address_space(3))) bf16x8*)(kp + 6656);
}
__device__ __forceinline__ void kload2(bf16x8* kf, lds_cptr kp, int j) { kf[2 * j] = *(const __attribute__((address_space(3))) bf16x8*)(kp + j * 2048); kf[2 * j + 1] = *(const __attribute__((address_space(3))) bf16x8*)(kp + j * 2048 + 512); }
__device__ __forceinline__ s16x4 vtr(lds_cptr p) { return __builtin_bit_cast(s16x4, __builtin_amdgcn_ds_read_tr16_b64_v4i16((__attribute__((address_space(3))) v4i16_t*)p)); }
__device__ __forceinline__ float rowmax(const f32x16& p0, const f32x16& p1) {
    float a = max3f(p0[0], p0[1], p1[0]), b = max3f(p0[2], p0[3], p1[1]); a = max3f(a, p1[2], p1[3]);
#pragma unroll
    for (int r = 4; r < 16; r += 4) { a = max3f(a, p0[r], p0[r + 1]); b = max3f(b, p0[r + 2], p0[r + 3]); a = max3f(a, p1[r], p1[r + 1]); b = max3f(b, p1[r + 2], p1[r + 3]); }
    const float m = max2f(a, b);
    auto rr = __builtin_amdgcn_permlane32_swap(__float_as_uint(m), __float_as_uint(m), false, false);
    return max2f(__uint_as_float(rr[0]), __uint_as_float(rr[1]));
}
__device__ __forceinline__ void pv(f32x16* o, int vb, bf16x8 pa0, bf16x8 pa1, bf16x8 pa2, bf16x8 pa3) {
#pragma unroll
    for (int d0 = 0; d0 < 2; ++d0) { s16x4 lo[4], hi[4];
#pragma unroll
        for (int ks = 0; ks < 4; ++ks) {
            asm volatile("ds_read_b64_tr_b16 %0,%1 offset:%c2" : "=&v"(lo[ks]) : "v"(vb), "i"(d0 * 4096 + ks * 1024) : "memory");
            asm volatile("ds_read_b64_tr_b16 %0,%1 offset:%c2" : "=&v"(hi[ks]) : "v"(vb), "i"(d0 * 4096 + ks * 1024 + 512) : "memory"); }
        asm volatile("s_waitcnt lgkmcnt(0)" ::: "memory"); SBAR();
#define PK(k) (bf16x8){lo[k][0], lo[k][1], lo[k][2], lo[k][3], hi[k][0], hi[k][1], hi[k][2], hi[k][3]}
        o[d0] = __builtin_amdgcn_mfma_f32_32x32x16_bf16(pa0, PK(0), o[d0], 0, 0, 0);
        o[d0] = __builtin_amdgcn_mfma_f32_32x32x16_bf16(pa1, PK(1), o[d0], 0, 0, 0);
        o[d0] = __builtin_amdgcn_mfma_f32_32x32x16_bf16(pa2, PK(2), o[d0], 0, 0, 0);
        o[d0] = __builtin_amdgcn_mfma_f32_32x32x16_bf16(pa3, PK(3), o[d0], 0, 0, 0);
#undef PK
    }
}
#define ATTN_STORE16(p, v) (*(u32x4*)(p) = (v))
template <int THRL> __device__ __forceinline__ void attn_unit(int b, int hk, int n, int pr, const bf16* QKV, bf16* O, const float* sinkp, char* shm) {
    int tid_ = threadIdx.x; asm volatile("" : "+v"(tid_));
    const int tid = tid_, lane = tid & 63, r32 = lane & 31, hi = lane >> 5; const int wid = __builtin_amdgcn_readfirstlane(tid >> 6);
    const int head = 4 * hk + 2 * pr + (wid >> 2);
    const long rowblk = (long)b * SEQ + n * 128;
    const long ctxrow = (long)NLAT + b * LCTX;
    const int nlo = n > 0 ? 2 : 0, nhi = n < (SEQ / 128 - 1) ? 2 : 0;
    const int NT = 6 + nlo + nhi;
    const bf16* Qw = QKV + (rowblk + (wid & 3) * QBLK) * PITCH + head * D;
    const bf16* Kc = QKV + 1024 + hk * D; const bf16* Vc = QKV + 1280 + hk * D;
    const unsigned lds0 = (unsigned)(uintptr_t)shm;
    float* wsf = (float*)(shm + LDS_WS) + wid * 64;
    const long klane = (long)lane * PITCH + wid * 8;
    const long vlane = (long)(16 * (wid & 3) + (lane >> 2)) * PITCH + (wid >> 2) * 32 + (lane & 3) * 8;
    const unsigned kdst = lds0 + LDS_K + wid * 1024, vdst = lds0 + LDS_V + wid * 1024;
#define TROW(t) (((t) < 2) ? (rowblk + 64 * (t)) : ((t) < 6) ? (ctxrow + 64 * ((t) - 2)) : (rowblk + ((((t) - 6) < nlo) ? (-128 + 64 * ((t) - 6)) : (128 + 64 * ((t) - 6 - nlo)))))
#define TKB(t) (((t) < 6) ? 0 : ((((t) - 6) < nlo) ? (-128 + 64 * ((t) - 6)) : (128 + 64 * ((t) - 6 - nlo))))
#define DMA_K(t, slot) glds16(Kc + TROW(t) * PITCH + klane, (unsigned)__builtin_amdgcn_readfirstlane(kdst + (slot)))
#define DMA_V(t, slot) glds16(Vc + TROW(t) * PITCH + vlane, (unsigned)__builtin_amdgcn_readfirstlane(vdst + (slot)))
    const int vb0 = (int)(lds0 + LDS_V) + ((lane >> 4) & 1) * 32 + (lane & 3) * 8 + (4 * hi + ((lane & 15) >> 2)) * 64;
    const char* Kbase = shm + LDS_K; bf16x8 kf[8];
    const lds_cptr shm3 = (lds_cptr)shm; const lds_cptr kp0 = shm3 + LDS_K + hi * 1024 + r32 * 16; const lds_cptr vp0 = shm3 + LDS_V + ((lane >> 4) & 1) * 32 + (lane & 3) * 8 + (4 * hi + ((lane & 15) >> 2)) * 64;
    DMA_K(0, 0); DMA_V(0, 0); DMA_K(1, SLOTB);
    bf16x8 qr[4];
#pragma unroll
    for (int d0 = 0; d0 < 4; ++d0) qr[d0] = *reinterpret_cast<const bf16x8*>(&Qw[(long)r32 * PITCH + d0 * 16 + hi * 8]);
    float mhat = 0.f, l_reg = 0.f; f32x16 o[2]; o[0] = f32x16{}; o[1] = f32x16{}; f32x16 negm = f32x16{}; asm volatile("" : "+v"(negm));
    const int qrel = (wid & 3) * QBLK + r32;
#define CMASK(P0, P1, t) do { int jb_ = (t) - (NT - 4); if (jb_ >= 0) bmask(P0, P1, TKB(t), qrel, hi); } while (0)
    bool resc = false;
#define START(P0, P1) do { const float rm = rowmax(P0, P1); resc = false; \
    { const float dl = rm; mhat = fadd_s(mhat, dl); \
      _Pragma("unroll") for (int r = 0; r < 16; ++r) { P0[r] = fsub_s(P0[r], dl); P1[r] = fsub_s(P1[r], dl); } \
      _Pragma("unroll") for (int r = 0; r < 16; ++r) negm[r] = -mhat; asm volatile("" : "+v"(negm)); } \
    _Pragma("unroll") for (int r = 0; r < 16; ++r) P0[r] = __builtin_amdgcn_exp2f(P0[r]); } while (0)
#define RESC() do { if (resc) { asm volatile("s_waitcnt lgkmcnt(0)" ::: "memory"); \
      _Pragma("unroll") for (int d_ = 0; d_ < 2; ++d_) _Pragma("unroll") for (int r = 0; r < 16; ++r) o[d_][r] *= wsf[crow(r, hi)]; } } while (0)
    f32x16 pA0, pA1, pB0, pB1;
    int sl_prev = 0, sl_cur = 0, sl_next = SLOTB;
#define ROT() do { sl_prev = sl_cur; sl_cur = sl_next; sl_next = (sl_next == (NSLOT - 1) * SLOTB) ? 0 : sl_next + SLOTB; } while (0)
    DMA_K(2, 2 * SLOTB);
    WAIT_BAR(3);
    qkt(pA0, pA1, Kbase, qr, negm, r32, hi); asm volatile("s_nop 15\n\ts_nop 7" : "+v"(pA0), "+v"(pA1));
    START(pA0, pA1);
    _Pragma("unroll") for (int r = 0; r < 16; ++r) pA1[r] = __builtin_amdgcn_exp2f(pA1[r]);
    WAIT_BAR(0);
    DMA_K(3, 0); DMA_V(1, SLOTB);
    ROT();
    kload8(kf, kp0 + sl_cur);
    WAIT_BAR(2);
    s16x4 vlo[8], vhi[8]; u32x4 pw0, pw1, pw2, pw3;
#define PKW(P, B) cvtpk_s(P[B], P[B + 1])
#define PAF(k) __builtin_bit_cast(bf16x8, pw##k)
#define VFR(i) (bf16x8){vlo[i][0], vlo[i][1], vlo[i][2], vlo[i][3], vhi[i][0], vhi[i][1], vhi[i][2], vhi[i][3]}
#define PIN(x) asm volatile("" : "+v"(x))
#define MX3(a, b, c) __builtin_fmaxf(__builtin_fmaxf((a), (b)), (c))
#define GAPA(MF, A0, A1, A2, A3, W0, W1, PW) do { MF; sacc += A0; sacc += A1; sacc += A2; sacc += A3; PIN(sacc); W0; W1; PIN(PW); SBAR(); } while (0)
#define EX(v) __builtin_amdgcn_exp2f(v)
#define GAPB(MF, X, B) do { MF; X[B] = EX(X[B]); X[B + 1] = EX(X[B + 1]); X[B + 2] = EX(X[B + 2]); X[B + 3] = EX(X[B + 3]); PIN(X); SBAR(); } while (0)
#define VRD(i) do { vlo[i] = vtr(vp_ + (((i) >> 2) * 4096 + ((i) & 3) * 1024)); vhi[i] = vtr(vp_ + (((i) >> 2) * 4096 + ((i) & 3) * 1024 + 512)); } while (0)
#define KRD(G, j) do { if (G) { kload2(kf, kp0 + sl_next, j); SBAR(); } } while (0)
#define STEP(C0, C1, P0, P1, t, GK, GV, GL) do { SBAR(); \
    const lds_cptr vp_ = vp0 + sl_prev; \
    VRD(0); SBAR(); float sacc = (P0[0] + P0[1]); \
    GAPA(C0 = __builtin_amdgcn_mfma_f32_32x32x16_bf16(kf[0], qr[0], negm, 0, 0, 0), P0[2], P0[3], P0[4], P0[5],     pw0[0] = PKW(P0, 0), pw0[1] = PKW(P0, 2), pw0); \
    VRD(4); SBAR(); GAPA(C1 = __builtin_amdgcn_mfma_f32_32x32x16_bf16(kf[1], qr[0], negm, 0, 0, 0), P0[6], P0[7], P0[8], P0[9],     pw0[2] = PKW(P0, 4), pw0[3] = PKW(P0, 6), pw0); \
    VRD(1); SBAR(); GAPA(C0 = __builtin_amdgcn_mfma_f32_32x32x16_bf16(kf[2], qr[1], C0, 0, 0, 0),   P0[10], P0[11], P0[12], P0[13], pw1[0] = PKW(P0, 8), pw1[1] = PKW(P0, 10), pw1); \
    VRD(5); SBAR(); GAPA(C1 = __builtin_amdgcn_mfma_f32_32x32x16_bf16(kf[3], qr[1], C1, 0, 0, 0),   P0[14], P0[15], P1[0], P1[1],   pw1[2] = PKW(P0, 12), pw1[3] = PKW(P0, 14), pw1); \
    VRD(2); SBAR(); GAPA(C0 = __builtin_amdgcn_mfma_f32_32x32x16_bf16(kf[4], qr[2], C0, 0, 0, 0),   P1[2], P1[3], P1[4], P1[5],     pw2[0] = PKW(P1, 0), pw2[1] = PKW(P1, 2), pw2); \
    VRD(6); SBAR(); GAPA(C1 = __builtin_amdgcn_mfma_f32_32x32x16_bf16(kf[5], qr[2], C1, 0, 0, 0),   P1[6], P1[7], P1[8], P1[9],     pw2[2] = PKW(P1, 4), pw2[3] = PKW(P1, 6), pw2); \
    VRD(3); SBAR(); GAPA(C0 = __builtin_amdgcn_mfma_f32_32x32x16_bf16(kf[6], qr[3], C0, 0, 0, 0),   P1[10], P1[11], P1[12], P1[13], pw3[0] = PKW(P1, 8), pw3[1] = PKW(P1, 10), pw3); \
    VRD(7); SBAR(); GAPA(C1 = __builtin_amdgcn_mfma_f32_32x32x16_bf16(kf[7], qr[3], C1, 0, 0, 0),   P1[14], P1[15], 0.f, 0.f,       pw3[2] = PKW(P1, 12), pw3[3] = PKW(P1, 14), pw3); \
    l_reg += sacc; \
    if (GK) { DMA_K((t) + 3, sl_cur); } if (GV) { DMA_V((t) + 1, sl_next); } \
    CMASK(C0, C1, t); \
    { float a = MX3(C0[0], C0[1], C1[0]), b = MX3(C0[2], C0[3], C1[1]); a = MX3(a, C1[2], C1[3]); \
      _Pragma("unroll") for (int r = 4; r < 16; r += 4) { a = MX3(a, C0[r], C0[r + 1]); b = MX3(b, C0[r + 2], C0[r + 3]); a = MX3(a, C1[r], C1[r + 1]); b = MX3(b, C1[r + 2], C1[r + 3]); } \
      float rm = __builtin_fmaxf(a, b); { auto rr = __builtin_amdgcn_permlane32_swap(__float_as_uint(rm), __float_as_uint(rm), false, false); rm = __builtin_fmaxf(__uint_as_float(rr[0]), __uint_as_float(rr[1])); } \
      resc = false; \
      if (__builtin_expect(__any(rm > (float)THRL), 0)) { const float dl = __builtin_fmaxf(rm, 0.f); mhat += dl; \
        _Pragma("unroll") for (int r = 0; r < 16; ++r) { C0[r] -= dl; C1[r] -= dl; } \
        _Pragma("unroll") for (int r = 0; r < 16; ++r) negm[r] = -mhat; asm volatile("" : "+v"(negm)); \
        const float f = __builtin_amdgcn_exp2f(-dl); l_reg *= f; if (hi == 0) wsf[r32] = f; resc = true; } } \
    SBAR(); \
    GAPB(o[0] = __builtin_amdgcn_mfma_f32_32x32x16_bf16(PAF(0), VFR(0), o[0], 0, 0, 0), C0, 0); \
    GAPB(o[1] = __builtin_amdgcn_mfma_f32_32x32x16_bf16(PAF(0), VFR(4), o[1], 0, 0, 0), C0, 4); \
    KRD(GL, 0); GAPB(o[0] = __builtin_amdgcn_mfma_f32_32x32x16_bf16(PAF(1), VFR(1), o[0], 0, 0, 0), C0, 8); \
    KRD(GL, 1); GAPB(o[1] = __builtin_amdgcn_mfma_f32_32x32x16_bf16(PAF(1), VFR(5), o[1], 0, 0, 0), C0, 12); \
    KRD(GL, 2); GAPB(o[0] = __builtin_amdgcn_mfma_f32_32x32x16_bf16(PAF(2), VFR(2), o[0], 0, 0, 0), C1, 0); \
    KRD(GL, 3); GAPB(o[1] = __builtin_amdgcn_mfma_f32_32x32x16_bf16(PAF(2), VFR(6), o[1], 0, 0, 0), C1, 4); \
    GAPB(o[0] = __builtin_amdgcn_mfma_f32_32x32x16_bf16(PAF(3), VFR(3), o[0], 0, 0, 0), C1, 8); \
    GAPB(o[1] = __builtin_amdgcn_mfma_f32_32x32x16_bf16(PAF(3), VFR(7), o[1], 0, 0, 0), C1, 12); \
    } while (0)
    int t = 1;
#undef CMASK
#define CMASK(P0, P1, t) do { } while (0)
    for (; t + 5 < NT; t += 2) {
        STEP(pB0, pB1, pA0, pA1, t, true, true, true);     WAIT_BAR(2); RESC(); ROT();
        STEP(pA0, pA1, pB0, pB1, t + 1, true, true, true); WAIT_BAR(2); RESC(); ROT();
    }
#undef CMASK
#define CMASK(P0, P1, t) do { int jb_ = (t) - (NT - 4); if (jb_ >= 0) bmask(P0, P1, TKB(t), qrel, hi); } while (0)
#define ENDW(tt) do { if ((tt) + 3 < NT) { WAIT_BAR(2); } else if ((tt) + 2 < NT) { WAIT_BAR(1); } else { WAIT_BAR(0); } } while (0)
    for (; t + 1 < NT; t += 2) {
        STEP(pB0, pB1, pA0, pA1, t, (t + 3 < NT), (t + 1 < NT), (t + 1 < NT));     ENDW(t);     RESC(); ROT();
        STEP(pA0, pA1, pB0, pB1, t + 1, (t + 4 < NT), (t + 2 < NT), (t + 2 < NT)); ENDW(t + 1); RESC(); ROT();
    }
    STEP(pB0, pB1, pA0, pA1, NT - 1, false, false, false); RESC();
    { float sacc = pB0[0] + pB0[1]; _Pragma("unroll") for (int r = 2; r < 16; ++r) sacc += pB0[r]; _Pragma("unroll") for (int r = 0; r < 16; ++r) sacc += pB1[r]; l_reg += sacc;
      pw0 = (u32x4){PKW(pB0, 0), PKW(pB0, 2), PKW(pB0, 4), PKW(pB0, 6)}; pw1 = (u32x4){PKW(pB0, 8), PKW(pB0, 10), PKW(pB0, 12), PKW(pB0, 14)}; pw2 = (u32x4){PKW(pB1, 0), PKW(pB1, 2), PKW(pB1, 4), PKW(pB1, 6)}; pw3 = (u32x4){PKW(pB1, 8), PKW(pB1, 10), PKW(pB1, 12), PKW(pB1, 14)};
      SBAR(); pv(o, vb0 + sl_cur, PAF(0), PAF(1), PAF(2), PAF(3)); }
#undef PKW
#undef PAF
#undef VFR
#undef PIN
#undef MX3
#undef GAPA
#undef GAPB
#undef EX
#undef VRD
#undef KRD
#undef STEP
#undef ENDW
    { auto rr = __builtin_amdgcn_permlane32_swap(__float_as_uint(l_reg), __float_as_uint(l_reg), false, false); l_reg = __uint_as_float(rr[0]) + __uint_as_float(rr[1]); }
    l_reg += __builtin_amdgcn_exp2f(sinkp[head] * 1.4426950408889634f - mhat);
    if (hi == 0) wsf[32 + r32] = l_reg; asm volatile("s_waitcnt lgkmcnt(0)" ::: "memory");
    float rli[16];
#pragma unroll
    for (int r = 0; r < 16; ++r) rli[r] = __builtin_amdgcn_rcpf(wsf[32 + crow(r, hi)]);
    bf16* Ow = O + (rowblk + (wid & 3) * QBLK) * OPITCH + head * D;
    { bf16* stg = (bf16*)(shm + LDS_OST) + wid * 2048;
#pragma unroll
      for (int r = 0; r < 16; ++r) { const int orow = crow(r, hi);
#pragma unroll
        for (int d0 = 0; d0 < 2; ++d0) stg[orow * 64 + d0 * 32 + r32] = __float2bfloat16(o[d0][r] * rli[r]); }
      asm volatile("s_waitcnt lgkmcnt(0)" ::: "memory");
#pragma unroll
      for (int i = 0; i < 4; ++i) { const int row = i * 8 + (lane >> 3), ch = lane & 7; const u32x4 v = *(const u32x4*)(stg + row * 64 + ch * 8); ATTN_STORE16(Ow + (long)row * OPITCH + ch * 8, v); } }
    asm volatile("s_waitcnt lgkmcnt(0)\n\ts_barrier" ::: "memory");
#undef DMA_K
#undef DMA_V
#undef TROW
#undef TKB
#undef CMASK
#undef START
#undef RESC
#undef ROT
}
#undef SBAR
#undef WAIT_BAR
}

#define XB_TMO      128
#define XB_XCNT(j)  (256  + 64 * (j))
#define XB_XSUB(j)  (1280 + 64 * (j))
#define XB_XGEN(j)  (2304 + 64 * (j))
#define XB_TOP      3328
#define XB_TOPGEN   3392
#define XCD_BAR_WORDS 3456
#define XB_SPIN_CAP (1u << 18)
__device__ __forceinline__ unsigned xb_ld(unsigned* p)              { return __hip_atomic_load(p, __ATOMIC_RELAXED, __HIP_MEMORY_SCOPE_AGENT); }
__device__ __forceinline__ unsigned xb_add(unsigned* p, unsigned v) { return __hip_atomic_fetch_add(p, v, __ATOMIC_RELAXED, __HIP_MEMORY_SCOPE_AGENT); }
__device__ __forceinline__ unsigned xb_xcc_id() { return (unsigned)__builtin_amdgcn_s_getreg((3 << 11) | 20) & 0xFu; }
#define XB_SPIN(cond, bar) do { unsigned _sp = 0; while (cond) { __builtin_amdgcn_s_sleep(1); \
    if ((++_sp & 255u) == 0u) { if (xb_ld(&(bar)[XB_TMO])) break; if (_sp > XB_SPIN_CAP) { atomicAdd(&(bar)[XB_TMO], 1u); break; } } } } while (0)
struct XcdBarrier { unsigned* bar; unsigned x; volatile LAS unsigned* st; };
__device__ __forceinline__ XcdBarrier xcd_barrier_post(unsigned* bar, volatile LAS unsigned* st) {
    XcdBarrier b; b.bar = bar; b.x = xb_xcc_id(); b.st = st;
    if (threadIdx.x == 0) (void)xb_add(&bar[XB_XCNT(b.x)], 1u);
    return b;
}
__device__ __forceinline__ void xcd_barrier_complete(unsigned* bar, unsigned x, unsigned& nloc, unsigned& nx) {
    const unsigned G = gridDim.x * gridDim.y * gridDim.z;
    unsigned sum, cnt, mine, sp = 0u;
    for (;;) {
        sum = 0u; cnt = 0u; mine = 0u;
#pragma unroll
        for (unsigned j = 0; j < 16; ++j) { const unsigned c = xb_ld(&bar[XB_XCNT(j)]); sum += c; cnt += (c > 0u) ? 1u : 0u; mine = (j == x) ? c : mine; }
        if (sum == G) break;
        __builtin_amdgcn_s_sleep(1);
        if ((++sp & 255u) == 0u) { if (xb_ld(&bar[XB_TMO])) break; if (sp > XB_SPIN_CAP) { atomicAdd(&bar[XB_TMO], 1u); break; } }
    }
    nloc = mine > 0u ? mine : 1u; nx = cnt > 0u ? cnt : 1u;
}
__device__ __forceinline__ void xcd_barrier(const XcdBarrier& b) {
    asm volatile("s_waitcnt vmcnt(0)" ::: "memory");
    __syncthreads();
    if (threadIdx.x == 0) {
        unsigned* bar = b.bar;
        __builtin_amdgcn_s_waitcnt(0);
        unsigned nloc = b.st[0], nx = b.st[1];
        if (nloc == 0u) { xcd_barrier_complete(bar, b.x, nloc, nx); b.st[0] = nloc; b.st[1] = nx; }
        const unsigned old = xb_add(&bar[XB_XSUB(b.x)], 1u);
        const unsigned gen = old / nloc;
        if (old + 1u == (gen + 1u) * nloc) {
            __builtin_amdgcn_fence(__ATOMIC_RELEASE, "agent");
            asm volatile("s_waitcnt vmcnt(0)" ::: "memory");
            const unsigned og = xb_add(&bar[XB_TOP], 1u);
            const unsigned tg = og / nx;
            if (og + 1u == (tg + 1u) * nx) xb_add(&bar[XB_TOPGEN], 1u);
            else XB_SPIN(xb_ld(&bar[XB_TOPGEN]) == tg, bar);
            __builtin_amdgcn_fence(__ATOMIC_ACQUIRE, "agent");
            xb_add(&bar[XB_XGEN(b.x)], 1u);
            asm volatile("s_waitcnt vmcnt(0)" ::: "memory");
        } else {
            XB_SPIN(xb_ld(&bar[XB_XGEN(b.x)]) == gen, bar);
            __builtin_amdgcn_fence(__ATOMIC_ACQUIRE, "agent");
            asm volatile("s_waitcnt vmcnt(0)" ::: "memory");
        }
    }
    __syncthreads();
}

#define LDS_WAIT() asm volatile("s_waitcnt lgkmcnt(0)" ::: "memory")
__device__ __forceinline__ void transpose_item(const float* W, int K, int N, bf16_t* WT, int k0, int n0, int drow0, LAS float* scr, int lane) {
    float t[32];
#pragma unroll
    for (int i = 0; i < 32; ++i) t[i] = __builtin_nontemporal_load(W + (size_t)(k0 + 2 * i + (lane >> 5)) * N + n0 + (lane & 31));
#pragma unroll
    for (int i = 0; i < 32; ++i) scr[(2 * i + (lane >> 5)) * 33 + (lane & 31)] = t[i];
    LDS_WAIT(); asm volatile("" ::: "memory");
    const int c = lane & 7;
#pragma unroll
    for (int j = 0; j < 4; ++j) { const int n = (lane >> 3) + 8 * j; const LAS float* s = scr + (8 * c) * 33 + n;
        u32x4 o; o.x = pkbf(s[0 * 33], s[1 * 33]); o.y = pkbf(s[2 * 33], s[3 * 33]); o.z = pkbf(s[4 * 33], s[5 * 33]); o.w = pkbf(s[6 * 33], s[7 * 33]);
        *(GAS u32x4*)(WT + (size_t)(drow0 + n) * K + k0 + 8 * c) = o; }
    LDS_WAIT(); asm volatile("" ::: "memory");
}
__device__ __forceinline__ void transpose_item_f8(const float* W, int K, int N, unsigned char* WT, int k0, int n0, int drow0, float scale, LAS float* scr, int lane) {
    float t[32];
#pragma unroll
    for (int i = 0; i < 32; ++i) t[i] = __builtin_nontemporal_load(W + (size_t)(k0 + 2 * i + (lane >> 5)) * N + n0 + (lane & 31));
#pragma unroll
    for (int i = 0; i < 32; ++i) scr[(2 * i + (lane >> 5)) * 33 + (lane & 31)] = t[i];
    LDS_WAIT(); asm volatile("" ::: "memory");
    const int n = lane >> 1, hf = lane & 1; const LAS float* sp = scr + (32 * hf) * 33 + n;
    u32x4 o0, o1;
    o0.x = pk4f8(sp[0 * 33] * scale, sp[1 * 33] * scale, sp[2 * 33] * scale, sp[3 * 33] * scale);     o0.y = pk4f8(sp[4 * 33] * scale, sp[5 * 33] * scale, sp[6 * 33] * scale, sp[7 * 33] * scale);
    o0.z = pk4f8(sp[8 * 33] * scale, sp[9 * 33] * scale, sp[10 * 33] * scale, sp[11 * 33] * scale);   o0.w = pk4f8(sp[12 * 33] * scale, sp[13 * 33] * scale, sp[14 * 33] * scale, sp[15 * 33] * scale);
    o1.x = pk4f8(sp[16 * 33] * scale, sp[17 * 33] * scale, sp[18 * 33] * scale, sp[19 * 33] * scale); o1.y = pk4f8(sp[20 * 33] * scale, sp[21 * 33] * scale, sp[22 * 33] * scale, sp[23 * 33] * scale);
    o1.z = pk4f8(sp[24 * 33] * scale, sp[25 * 33] * scale, sp[26 * 33] * scale, sp[27 * 33] * scale); o1.w = pk4f8(sp[28 * 33] * scale, sp[29 * 33] * scale, sp[30 * 33] * scale, sp[31 * 33] * scale);
    GAS u32x4* dst = (GAS u32x4*)(WT + (size_t)(drow0 + n) * K + k0 + 32 * hf);
    dst[0] = o0; dst[1] = o1;
    LDS_WAIT(); asm volatile("" ::: "memory");
}
__device__ __forceinline__ void sincos_d(double x, double& s, double& c) {
    const double TWO_PI = 6.283185307179586476925;
    const double k = __builtin_rint(x / TWO_PI); const double r = x - k * TWO_PI;
    const double r2 = r * r; double ts = r, tc = 1.0; s = r; c = 1.0;
    for (int i = 1; i <= 16; ++i) { tc *= -r2 / (double)((2 * i - 1) * (2 * i)); ts *= -r2 / (double)((2 * i) * (2 * i + 1)); c += tc; s += ts; }
}

constexpr int CI_F = 16 * 112, CI_FD = 56 * 32, MOE_ITEMS = 8 * (2 * CI_F + CI_FD);
constexpr int MOE_TAIL_A = 12000, MOE_TAIL_B = 7000, MOE_TAIL_C = 12000, MOE_TAIL_TOTAL = MOE_TAIL_A + MOE_TAIL_B + MOE_TAIL_C;
__device__ __forceinline__ void moe_convert_item(int r, const float* wg, const float* wu, const float* wd, unsigned char* mgu, unsigned char* md, LAS float* scr, int lane) {
    const int e = r / (2 * CI_F + CI_FD); int q = r % (2 * CI_F + CI_FD);
    if (q < 2 * CI_F) { const int up = q / CI_F; q %= CI_F; const int kb = q / 112, nb = q % 112, n0 = 32 * nb;
        transpose_item_f8((up ? wu : wg) + (size_t)e * 1024 * DFF, 1024, DFF, mgu + (size_t)e * 7168 * 1024, 64 * kb, n0, 256 * (n0 >> 7) + 128 * up + (n0 & 127), MOE_SGU, scr, lane); }
    else { q -= 2 * CI_F; const int kb = q / 32, nb = q % 32; transpose_item_f8(wd + (size_t)e * DFF * 1024, DFF, 1024, md + (size_t)e * 1024 * DFF, 64 * kb, 32 * nb, 32 * nb, MOE_SD, scr, lane); }
}
__device__ __forceinline__ void moe_convert_tail(int nunits, int G, int bx, int first, int count, const float* wg, const float* wu, const float* wd, unsigned char* mgu, unsigned char* md, LAS unsigned char* lds) {
    const int busy = nunits % G; if (busy == 0 || bx < busy) return;
    int tid_ = threadIdx.x; asm volatile("" : "+v"(tid_)); const int lane = tid_ & 63, wave = __builtin_amdgcn_readfirstlane(tid_ >> 6);
    LAS float* scr = (LAS float*)(lds + wave * 16384);
    const int nw = (G - busy) * 8, w = (bx - busy) * 8 + wave;
    for (int it = w; it < count; it += nw) moe_convert_item(first + it, wg, wu, wd, mgu, md, scr, lane);
}

struct Args { const float* in[24]; float* out; unsigned char* ws; int ph_lo, ph_hi, li, pad; };
constexpr int NPH = 18;

__device__ __forceinline__ void norm_store(const f32x4 (&v)[4], float ssum, const float* g, const float* mrow, int shc, int scc, bf16_t* XNo, size_t m, int lane) {
    const float rstd = 1.0f / __builtin_sqrtf(ssum * (1.0f / DM) + EPS);
#pragma unroll
    for (int j = 0; j < 4; ++j) { const f32x4 gv = *(const f32x4*)(g + 4 * lane + 256 * j), sc = *(const f32x4*)(mrow + scc * 1024 + 4 * lane + 256 * j), sh = *(const f32x4*)(mrow + shc * 1024 + 4 * lane + 256 * j);
        const f32x4 y = (v[j] * rstd) * gv * (sc + 1.0f) + sh; u32x2 w; w.x = pkbf(y.x, y.y); w.y = pkbf(y.z, y.w); *((GAS u32x2*)(XNo + m * DM) + lane + 64 * j) = w; }
}
template <bool SRC_BF16> __device__ __forceinline__ void norm_rows(const void* srcLv, const float* srcC, int nrows, const float* g, const float* mod, int shc, int scc, bf16_t* XNo, int gw, int NGW, int lane,
                                          const float* part, int nS, const float* gatec, float* zout) {
    if (nrows > NLAT) {
        for (int rc = gw; rc < NCTXR; rc += NGW) {
            const GAS f32x4* xr = (const GAS f32x4*)(srcC + (size_t)rc * DM) + lane;
            f32x4 v[4];
#pragma unroll
            for (int j = 0; j < 4; ++j) v[j] = xr[64 * j];
            if (part != nullptr) {
                f32x4 a[4];
#pragma unroll
                for (int j = 0; j < 4; ++j) a[j] = (f32x4){0.f, 0.f, 0.f, 0.f};
                for (int s0 = 0; s0 < nS; s0 += 7) {
                    f32x4 t[7][4];
#pragma unroll
                    for (int q = 0; q < 7; ++q) { const int s2 = (s0 + q < nS) ? s0 + q : s0; const GAS f32x4* pr = (const GAS f32x4*)(part + ((size_t)s2 * NCTXR + rc) * DM) + lane;
#pragma unroll
                        for (int j = 0; j < 4; ++j) t[q][j] = pr[64 * j]; }
#pragma unroll
                    for (int q = 0; q < 7; ++q) if (s0 + q < nS) {
#pragma unroll
                        for (int j = 0; j < 4; ++j) a[j] += t[q][j]; }
                }
#pragma unroll
                for (int j = 0; j < 4; ++j) v[j] += *(const f32x4*)(gatec + 4 * lane + 256 * j) * a[j];
                if (zout != nullptr) { GAS f32x4* zr = (GAS f32x4*)(zout + (size_t)rc * DM) + lane;
#pragma unroll
                    for (int j = 0; j < 4; ++j) zr[64 * j] = v[j]; }
            }
            float ss = 0.f;
#pragma unroll
            for (int j = 0; j < 4; ++j) ss += (v[j].x * v[j].x + v[j].y * v[j].y) + (v[j].z * v[j].z + v[j].w * v[j].w);
            norm_store(v, wave_sum(ss), g, mod + (size_t)4 * 6144, shc, scc, XNo, (size_t)NLAT + rc, lane);
        }
    }
    for (int m0 = gw * 4; m0 < NLAT; m0 += NGW * 4) {
        const int mb = m0 >> 13;
        f32x4 v[4][4];
        if constexpr (SRC_BF16) { const GAS u32x2* xr = (const GAS u32x2*)((const bf16_t*)srcLv + (size_t)m0 * DM) + lane;
#pragma unroll
            for (int r = 0; r < 4; ++r)
#pragma unroll
                for (int j = 0; j < 4; ++j) { const u32x2 w = xr[r * 256 + 64 * j]; v[r][j] = (f32x4){__uint_as_float(w.x << 16), __uint_as_float(w.x & 0xffff0000u), __uint_as_float(w.y << 16), __uint_as_float(w.y & 0xffff0000u)}; } }
        else { const GAS f32x4* xr = (const GAS f32x4*)((const float*)srcLv + (size_t)m0 * DM) + lane;
#pragma unroll
            for (int r = 0; r < 4; ++r)
#pragma unroll
                for (int j = 0; j < 4; ++j) v[r][j] = xr[r * 256 + 64 * j]; }
        float ss[4];
#pragma unroll
        for (int r = 0; r < 4; ++r) { ss[r] = 0.f;
#pragma unroll
            for (int j = 0; j < 4; ++j) ss[r] += (v[r][j].x * v[r][j].x + v[r][j].y * v[r][j].y) + (v[r][j].z * v[r][j].z + v[r][j].w * v[r][j].w); }
#pragma unroll
        for (int o = 1; o < 64; o <<= 1) {
#pragma unroll
            for (int r = 0; r < 4; ++r) ss[r] += __shfl_xor(ss[r], o); }
#pragma unroll
        for (int r = 0; r < 4; ++r) norm_store(v[r], ss[r], g, mod + (size_t)mb * 6144, shc, scc, XNo, (size_t)(m0 + r), lane);
    }
}

__global__ void __launch_bounds__(512, 2) fwd(Args args) {
    extern __shared__ __attribute__((aligned(16))) unsigned char lds_raw[];
    LAS unsigned char* lds = (LAS unsigned char*)lds_raw;
    volatile LAS unsigned* MISC = (volatile LAS unsigned*)(lds + MISC_OFF);
    LAS int* gtab = (LAS int*)(lds + GTAB_OFF);
    const int G = gridDim.x; const int bx = blockIdx.x; const int vcu = (G % 8 == 0) ? (bx % 8) * (G / 8) + bx / 8 : bx;
    const int NGW = G * 8;
#define PHASE_IDS() int tid_ = threadIdx.x; asm volatile("" : "+v"(tid_)); const int tid = tid_, lane = tid & 63, wave = __builtin_amdgcn_readfirstlane(tid >> 6), gw = vcu * 8 + wave; (void)lane; (void)gw
    unsigned char* ws = args.ws;
    gu32* ctl = (gu32*)(ws + WS_CTL);
#define MOD ((float*)(ws + WS_MOD))
#define ROPE ((float*)(ws + WS_ROPE))
#define STATS ((float*)(ws + WS_STATS))
#define LIST ((int*)(ws + WS_LIST))
#define TINFO ((int*)(ws + WS_TINFO))
#define WSB ((bf16_t*)(ws + WS_WS))
#define WIN ((bf16_t*)(ws + WS_WIN))
#define WAO ((bf16_t*)(ws + WS_WAO))
#define WQKV ((bf16_t*)(ws + WS_WQKV))
#define WBO ((bf16_t*)(ws + WS_WBO))
#define WGU ((bf16_t*)(ws + WS_WGU))
#define WD ((bf16_t*)(ws + WS_WD))
#define MGU ((unsigned char*)(ws + WS_MGU))
#define MD ((unsigned char*)(ws + WS_MD))
#define XN8 ((unsigned char*)(ws + WS_XN))
#define XN ((bf16_t*)(ws + WS_XN))
#define ZB ((float*)(ws + WS_ZB))
#define UVT ((bf16_t*)(ws + WS_UVT))
#define A2 ((bf16_t*)(ws + WS_A2))
#define HB ((bf16_t*)(ws + WS_H))
#define QKV ((bf16_t*)(ws + WS_QKV))
#define OB ((bf16_t*)(ws + WS_O))
#define YB ((bf16_t*)(ws + WS_Y))
#define HC ((unsigned char*)(ws + WS_HC))
#define YP ((bf16_t*)(ws + WS_YP))
#define PART1 ((float*)(ws + WS_PART1))
#define PART2 ((float*)(ws + WS_PART2))
#define I_X (args.in[0])
#define I_C (args.in[1])
#define I_CTX (args.in[2])
#define I_CCTX (args.in[3])
#define I_ADAW (args.in[4])
#define I_ADAB (args.in[5])
#define I_NORMG (args.in[6])
#define I_FINALG (args.in[7])
#define HL ((bf16_t*)(ws + WS_HLB))

    { PHASE_IDS(); for (int u = tid; u < (LDS_BYTES - MISC_OFF) / 4; u += 512) ((LAS unsigned*)(lds + MISC_OFF))[u] = 0u; }
    __syncthreads();
    const int lo = args.ph_lo, hi_ph = args.ph_hi;
    const bool one_launch = (hi_ph - lo) > 1;
    XcdBarrier bar; bar.bar = (unsigned*)(ctl + CW_BAR) + args.li * XCD_BAR_WORDS; bar.x = 0; bar.st = nullptr;
    if (one_launch) bar = xcd_barrier_post((unsigned*)(ctl + CW_BAR) + args.li * XCD_BAR_WORDS, MISC + 8);
#ifndef PHMASK
#define PHMASK 0xFFFFFFFFu
#endif
#define IN(k) (((PHMASK >> (k)) & 1) && lo <= (k) && (k) < hi_ph)
#define BOTH(k) (IN(k) && IN((k) + 1))
#define GRID_BAR() xcd_barrier(bar)
#if defined(PROBE_LO)
    unsigned long long tpA = __builtin_amdgcn_s_memrealtime(), tpB = 0;
#define PROBE_MARK(k) do { if ((k) == PROBE_LO - 1) tpA = __builtin_amdgcn_s_memrealtime(); if ((k) == PROBE_HI) tpB = __builtin_amdgcn_s_memrealtime(); } while (0)
#else
#define PROBE_MARK(k) do { } while (0)
#endif

    if (IN(0)) {
        PHASE_IDS();
        {
            LAS float* sv = (LAS float*)lds;
            LAS float* red = (LAS float*)(lds + 5 * 1024 * 4);
            if (bx < 192) {
                for (int idx = tid; idx < 5 * 1024; idx += 512) { const int r = idx >> 10, k = idx & 1023; const float cv = r < 4 ? I_C[r * 1024 + k] : I_CCTX[k]; sv[idx] = cv / (1.0f + __expf(-cv)); }
                __syncthreads();
                for (int item = bx; item < 192; item += G) {
                    const int i = item / 96, n0 = (item % 96) * 64, nn = tid & 63, kq = tid >> 6;
                    float a0 = 0.f, a1 = 0.f, a2 = 0.f, a3 = 0.f, a4 = 0.f;
                    const float* wp = I_ADAW + ((size_t)i * 1024 + kq * 128) * 6144 + n0 + nn;
#pragma unroll 8
                    for (int k = 0; k < 128; ++k) { const float w = wp[(size_t)k * 6144]; const int kk = kq * 128 + k;
                        a0 += sv[kk] * w; a1 += sv[1024 + kk] * w; a2 += sv[2048 + kk] * w; a3 += sv[3072 + kk] * w; a4 += sv[4096 + kk] * w; }
                    red[(kq * 5 + 0) * 64 + nn] = a0; red[(kq * 5 + 1) * 64 + nn] = a1; red[(kq * 5 + 2) * 64 + nn] = a2; red[(kq * 5 + 3) * 64 + nn] = a3; red[(kq * 5 + 4) * 64 + nn] = a4;
                    __syncthreads();
                    if (tid < 320) { const int r = tid >> 6; float s = I_ADAB[i * 6144 + n0 + nn];
#pragma unroll
                        for (int q = 0; q < 8; ++q) s += red[(q * 5 + r) * 64 + nn];
                        MOD[((size_t)i * 5 + r) * 6144 + n0 + nn] = s; }
                    __syncthreads();
                }
            }
            __syncthreads();
        }
        {
            LAS float* scr = (LAS float*)(lds + wave * 16384);
            constexpr int I_IN = 16 * 64, I_AO = 16 * 32, I_QKV = 16 * 48, I_BO = 16 * 32, I_F = 16 * 112, I_FD = 56 * 32;
            constexpr int I_DENSE = I_IN + I_AO + I_QKV + I_BO + 2 * I_F + I_FD, I_MOE = MOE_ITEMS, I_WS = 128, I_ROPE = 32;
            constexpr int NITEMS = I_DENSE + I_MOE + I_WS + I_ROPE;
            for (int it = gw; it < NITEMS; it += NGW) {
                int r = it;
                if (r < I_IN) { const int kb = r / 64, nb = r % 64; transpose_item(args.in[8], 1024, 2048, WIN, 64 * kb, 32 * nb, 32 * nb, scr, lane); continue; } r -= I_IN;
                if (r < I_AO) { const int kb = r / 32, nb = r % 32; transpose_item(args.in[13], 1024, 1024, WAO, 64 * kb, 32 * nb, 32 * nb, scr, lane); continue; } r -= I_AO;
                if (r < I_QKV) { const int kb = r / 48, nb = r % 48; transpose_item(args.in[14], 1024, 1536, WQKV, 64 * kb, 32 * nb, 32 * nb, scr, lane); continue; } r -= I_QKV;
                if (r < I_BO) { const int kb = r / 32, nb = r % 32; transpose_item(args.in[16], 1024, 1024, WBO, 64 * kb, 32 * nb, 32 * nb, scr, lane); continue; } r -= I_BO;
                if (r < 2 * I_F) { const int up = r / I_F; const int q = r % I_F; const int kb = q / 112, nb = q % 112, n0 = 32 * nb;
                    transpose_item(args.in[17 + up], 1024, DFF, WGU, 64 * kb, n0, 256 * (n0 >> 7) + 128 * up + (n0 & 127), scr, lane); continue; } r -= 2 * I_F;
                if (r < I_FD) { const int kb = r / 32, nb = r % 32; transpose_item(args.in[19], DFF, 1024, WD, 64 * kb, 32 * nb, 32 * nb, scr, lane); continue; } r -= I_FD;
                if (r < I_MOE) { if (r >= MOE_TAIL_TOTAL) moe_convert_item(r, args.in[21], args.in[22], args.in[23], MGU, MD, scr, lane); continue; } r -= I_MOE;
                if (r < I_WS) { const float* src = args.in[11] + (size_t)r * 2048;
#pragma unroll
                    for (int j = 0; j < 8; ++j) { const f32x4 v = *(const f32x4*)(src + j * 256 + lane * 4); u32x2 w; w.x = pkbf(v.x, v.y); w.y = pkbf(v.z, v.w); *(u32x2*)(WSB + (size_t)r * 2048 + j * 256 + lane * 4) = w; }
                    continue; } r -= I_WS;
                {
                    const int ent = r * 64 + lane; const int pos = ent >> 4, i = ent & 15;
                    double inv = 1.0; for (int q = 0; q < i; ++q) inv *= 0.56234132519034908;
                    const float ang = (float)pos * (float)inv; double s, c; sincos_d((double)ang, s, c);
                    ROPE[ent] = (float)c; ROPE[2048 + ent] = (float)s;
                }
            }
        }
        if (BOTH(0)) GRID_BAR(); PROBE_MARK(0);
    }
    if (IN(1)) { PHASE_IDS(); norm_rows<false>(I_X, I_CTX, MALL, I_NORMG + 0 * 1024, MOD, 0, 1, XN, gw, NGW, lane, nullptr, 0, nullptr, nullptr); if (BOTH(1)) GRID_BAR(); PROBE_MARK(1); }
    if (IN(2)) {
        pg8::DenseSched S{(const char*)WIN, (const char*)XN, 8, NPA, G, bx, (size_t)256 * 1024 * 2};
        pg8::EpiGeluT E{UVT, STATS};
        pg8::gemm_phase<pg8::EpiGeluT, pg8::DenseSched, true, false>(lds, gtab, 1024, 16, S, E);
        moe_convert_tail(8 * NPA, G, bx, 0, MOE_TAIL_A, args.in[21], args.in[22], args.in[23], MGU, MD, lds);
        if (BOTH(2)) GRID_BAR(); PROBE_MARK(2);
    }
    if (IN(3)) {
        PHASE_IDS();
        const float* vg = args.in[9]; const float* vb = args.in[10]; const float* bs = args.in[12];
        LAS unsigned char* buf = lds + wave * 16384;
        LAS float* mu_l = (LAS float*)(lds + RING_BYTES + 4096 + wave * 1024); LAS float* rs_l = mu_l + 128;
        const int r32 = lane & 31, h = lane >> 5;
        for (int unit = gw; unit < (MALL / 128) * 32; unit += NGW) {
            const int ph = unit & 1, g = (unit >> 1) & 15, ch = unit >> 5, q0 = ch * 128;
#pragma unroll
            for (int tt = 0; tt < 2; ++tt) { const int tok = q0 + lane * 2 + tt; const f32x4* sp = (const f32x4*)(STATS + (size_t)tok * 16);
                const f32x4 a = sp[0], b = sp[1], c = sp[2], d = sp[3];
                const float sum = (a.x + a.z) + (b.x + b.z) + (c.x + c.z) + (d.x + d.z), sq = (a.y + a.w) + (b.y + b.w) + (c.y + c.w) + (d.y + d.w);
                const float mean = sum * (1.0f / 1024.0f), var = sq * (1.0f / 1024.0f) - mean * mean;
                mu_l[lane * 2 + tt] = mean; rs_l[lane * 2 + tt] = 1.0f / __builtin_sqrtf(var + EPS); }
            {
                u32x4 t[16]; const int rw = lane >> 4, ck = lane & 15;
                const bf16_t* vp = UVT + (size_t)(1024 + 64 * g + rw) * MALL + q0 + ck * 8;
#pragma unroll
                for (int i = 0; i < 16; ++i) { t[i] = *(const u32x4*)vp; vp += (size_t)4 * MALL; asm volatile("" : "+v"(vp)); }
#pragma unroll
                for (int i = 0; i < 16; ++i) { const int row = 4 * i + rw; *(LAS u32x4*)(buf + row * 256 + ((ck ^ (row & 15)) << 4)) = t[i]; }
            }
            bf16x8 af[2][8];
#pragma unroll
            for (int ct = 0; ct < 2; ++ct) { const int row = 32 * ct + r32; const float vgc = vg[64 * g + row], vbc = vb[64 * g + row];
#pragma unroll
                for (int s2 = 0; s2 < 8; ++s2) { const int qs = 16 * s2 + 8 * h, ck = 2 * s2 + h;
                    const f32x4 m0 = *(const LAS f32x4*)(mu_l + qs), m1 = *(const LAS f32x4*)(mu_l + qs + 4), r0 = *(const LAS f32x4*)(rs_l + qs), r1 = *(const LAS f32x4*)(rs_l + qs + 4);
                    const bf16x8 raw = *(const LAS bf16x8*)(buf + row * 256 + ((ck ^ (row & 15)) << 4));
                    float y[8];
#pragma unroll
                    for (int j = 0; j < 4; ++j) { y[j] = (bf2f((unsigned short)raw[j]) - m0[j]) * r0[j] * vgc + vbc; y[4 + j] = (bf2f((unsigned short)raw[4 + j]) - m1[j]) * r1[j] * vgc + vbc; }
                    u32x4 w; w.x = pkbf(y[0], y[1]); w.y = pkbf(y[2], y[3]); w.z = pkbf(y[4], y[5]); w.w = pkbf(y[6], y[7]); af[ct][s2] = __builtin_bit_cast(bf16x8, w); } }
            {
                u32x4 t[8]; const int rw = lane >> 3, ck = lane & 7;
                const bf16_t* up = UVT + (size_t)(64 * g + rw) * MALL + q0 + 64 * ph + ck * 8;
#pragma unroll
                for (int i = 0; i < 8; ++i) { t[i] = *(const u32x4*)up; up += (size_t)8 * MALL; asm volatile("" : "+v"(up)); }
#pragma unroll
                for (int i = 0; i < 8; ++i) { const int row = 8 * i + rw; *(LAS u32x4*)(buf + row * 128 + ((ck ^ (row & 7)) << 4)) = t[i]; }
            }
#pragma unroll
            for (int ptl = 0; ptl < 2; ++ptl) {
                const int pl = 32 * ptl + r32, p = 64 * ph + pl; const float bsv = bs[g * 128 + p];
                bf16x8 bfr[8];
#pragma unroll
                for (int s2 = 0; s2 < 8; ++s2) bfr[s2] = *(const bf16x8*)(WSB + (size_t)(g * 128 + p) * 128 + 16 * s2 + 8 * h);
                f32x16 acc[2]; acc[0] = f32x16{}; acc[1] = f32x16{};
#pragma unroll
                for (int s2 = 0; s2 < 8; ++s2)
#pragma unroll
                    for (int ct = 0; ct < 2; ++ct) acc[ct] = __builtin_amdgcn_mfma_f32_32x32x16_bf16(af[ct][s2], bfr[s2], acc[ct], 0, 0, 0);
#pragma unroll
                for (int ct = 0; ct < 2; ++ct)
#pragma unroll
                    for (int rr = 0; rr < 4; ++rr) { const int c = 32 * ct + 8 * rr + 4 * h; float o[4];
#pragma unroll
                        for (int e = 0; e < 4; ++e) { const int cc = c + e; const float uu = bf2f(*(const LAS unsigned short*)(buf + cc * 128 + (((pl >> 3) ^ (cc & 7)) << 4) + (pl & 7) * 2)); o[e] = uu * (acc[ct][4 * rr + e] + bsv); }
                        u32x2 w; w.x = pkbf(o[0], o[1]); w.y = pkbf(o[2], o[3]);
                        *(LAS u32x2*)(buf + 8192 + pl * 128 + (((c >> 3) ^ (pl & 7)) << 4) + (c & 7) * 2) = w; }
            }
            {
                const int rw = lane >> 3, ck = lane & 7;
#pragma unroll
                for (int i = 0; i < 8; ++i) { const int row = 8 * i + rw; const u32x4 v = *(const LAS u32x4*)(buf + 8192 + row * 128 + ((ck ^ (row & 7)) << 4));
                    *(u32x4*)(A2 + (size_t)(q0 + 64 * ph + row) * DM + 64 * g + ck * 8) = v; }
            }
        }
        if (BOTH(3)) GRID_BAR(); PROBE_MARK(3);
    }
    if (IN(4)) {
        { pg8::DenseSched S{(const char*)A2, (const char*)WAO, NPL, 4, G, bx, (size_t)256 * 1024 * 2};
          pg8::EpiResid<true> E{I_X, nullptr, HL, MOD + 2 * 1024};
          pg8::gemm_phase<pg8::EpiResid<true>, pg8::DenseSched, true, false>(lds, gtab, 1024, 16, S, E); }
        { pg8::SplitSched S{(const char*)(A2 + (size_t)NLAT * DM), (const char*)WAO, 4, 4, P3_NS, G, bx, NPL, (size_t)256 * 1024 * 2, (size_t)(1024 / P3_NS) * 2};
          pg8::EpiPartF32 E{PART1, (size_t)NCTXR * DM};
          pg8::gemm_phase<pg8::EpiPartF32, pg8::SplitSched, true, false>(lds, gtab, 1024, 1024 / P3_NS / 64, S, E); }
        if (BOTH(4)) GRID_BAR(); PROBE_MARK(4);
    }
    if (IN(5)) { PHASE_IDS(); norm_rows<true>(HL, I_CTX, MALL, I_NORMG + 1 * 1024, MOD, 3, 4, XN, gw, NGW, lane, PART1, P3_NS, MOD + 4 * 6144 + 2 * 1024, ZB); if (BOTH(5)) GRID_BAR(); PROBE_MARK(5); }
    if (IN(6)) {
        pg8::DenseSched S{(const char*)XN, (const char*)WGU, NPA, 28, G, bx, (size_t)256 * 1024 * 2};
        pg8::EpiSwiGLU E{HB};
        pg8::gemm_phase<pg8::EpiSwiGLU, pg8::DenseSched, true, false>(lds, gtab, 1024, 16, S, E);
        moe_convert_tail(NPA * 28, G, bx, MOE_TAIL_A, MOE_TAIL_B, args.in[21], args.in[22], args.in[23], MGU, MD, lds);
        if (BOTH(6)) GRID_BAR(); PROBE_MARK(6);
    }
    if (IN(7)) {
        { pg8::DenseSched S{(const char*)HB, (const char*)WD, NPL, 4, G, bx, (size_t)256 * DFF * 2};
          pg8::EpiResid<false> E{nullptr, HL, HL, MOD + 5 * 1024};
          pg8::gemm_phase<pg8::EpiResid<false>, pg8::DenseSched, true, false>(lds, gtab, DFF, 56, S, E); }
        { pg8::SplitSched S{(const char*)(HB + (size_t)NLAT * DFF), (const char*)WD, 4, 4, P5_NS, G, bx, NPL, (size_t)256 * DFF * 2, (size_t)(DFF / P5_NS) * 2};
          pg8::EpiPartF32 E{PART2, (size_t)NCTXR * DM};
          pg8::gemm_phase<pg8::EpiPartF32, pg8::SplitSched, true, false>(lds, gtab, DFF, DFF / P5_NS / 64, S, E); }
        if (BOTH(7)) GRID_BAR(); PROBE_MARK(7);
    }
    if (IN(8)) { PHASE_IDS(); norm_rows<true>(HL, ZB, MALL, I_NORMG + 2 * 1024, MOD + 5 * 6144, 0, 1, XN, gw, NGW, lane, PART2, P5_NS, MOD + 4 * 6144 + 5 * 1024, nullptr); if (BOTH(8)) GRID_BAR(); PROBE_MARK(8); }
    if (IN(9)) {
        pg8::DenseSched S{(const char*)XN, (const char*)WQKV, NPA, 6, G, bx, (size_t)256 * 1024 * 2};
        pg8::EpiQKV E{QKV, ROPE, ROPE + 2048, attn_body::C2};
        pg8::gemm_phase<pg8::EpiQKV, pg8::DenseSched, true, false>(lds, gtab, 1024, 16, S, E);
        moe_convert_tail(NPA * 6, G, bx, MOE_TAIL_A + MOE_TAIL_B, MOE_TAIL_C, args.in[21], args.in[22], args.in[23], MGU, MD, lds);
        if (BOTH(9)) GRID_BAR(); PROBE_MARK(9);
    }
    if (IN(10)) {
        static_assert(attn_body::LDS_BYTES_A <= RING_BYTES, "attention LDS");
        const float* sinkp = args.in[15];
        for (int i = 0;; ++i) { const int uid = i * G + vcu; if (uid >= NB * 64 * 4 * 2) break;
            const int pr = uid & 1, hk = (uid >> 1) & 3, n = (uid >> 3) & 63, b = uid >> 9;
            attn_body::attn_unit<8>(b, hk, n, pr, (const attn_body::bf16*)QKV, (attn_body::bf16*)OB, sinkp, (char*)lds_raw); }
        if (BOTH(10)) GRID_BAR(); PROBE_MARK(10);
    }
    if (IN(11)) {
        pg8::DenseSched S{(const char*)OB, (const char*)WBO, NPL, 4, G, bx, (size_t)256 * 1024 * 2};
        pg8::EpiResid<false> E{nullptr, HL, HL, MOD + 5 * 6144 + 2 * 1024};
        pg8::gemm_phase<pg8::EpiResid<false>, pg8::DenseSched, true, false>(lds, gtab, 1024, 16, S, E);
        if (BOTH(11)) GRID_BAR(); PROBE_MARK(11);
    }
    if (IN(12)) {
        PHASE_IDS();
        const float* g = I_NORMG + 3 * 1024; const float* mod = MOD + 5 * 6144; const float* wrt = args.in[20];
        LAS int* l_e = (LAS int*)lds;
        LAS float* l_w = (LAS float*)(lds + 1024);
        LAS int* l_cnt = (LAS int*)(lds + 2048);
        LAS int* l_base = (LAS int*)(lds + 2048 + 64);
        for (int blk = bx; blk < NLAT / 128; blk += G) {
            if (tid < 8) l_cnt[tid] = 0;
            __syncthreads();
            const int mb = (blk * 128) >> 13; const float* mrow = mod + (size_t)mb * 6144;
            for (int i4 = 0; i4 < 8; ++i4) {
                const int tl0 = wave * 16 + i4 * 2, m0 = blk * 128 + tl0;
                const GAS u32x2* xr = (const GAS u32x2*)(HL + (size_t)m0 * DM) + lane;
                f32x4 v[2][4]; float ss[2];
#pragma unroll
                for (int r = 0; r < 2; ++r)
#pragma unroll
                    for (int j = 0; j < 4; ++j) { const u32x2 w = xr[r * 256 + 64 * j]; v[r][j] = (f32x4){__uint_as_float(w.x << 16), __uint_as_float(w.x & 0xffff0000u), __uint_as_float(w.y << 16), __uint_as_float(w.y & 0xffff0000u)}; }
#pragma unroll
                for (int r = 0; r < 2; ++r) { ss[r] = 0.f;
#pragma unroll
                    for (int j = 0; j < 4; ++j) ss[r] += (v[r][j].x * v[r][j].x + v[r][j].y * v[r][j].y) + (v[r][j].z * v[r][j].z + v[r][j].w * v[r][j].w); }
#pragma unroll
                for (int o = 1; o < 64; o <<= 1) {
#pragma unroll
                    for (int r = 0; r < 2; ++r) ss[r] += __shfl_xor(ss[r], o); }
                float lg[2][8];
#pragma unroll
                for (int r = 0; r < 2; ++r)
#pragma unroll
                    for (int e = 0; e < 8; ++e) lg[r][e] = 0.f;
#pragma unroll
                for (int j = 0; j < 4; ++j) { const int col = 4 * lane + 256 * j; const f32x4 gv = *(const f32x4*)(g + col), sc = *(const f32x4*)(mrow + 4 * 1024 + col), sh = *(const f32x4*)(mrow + 3 * 1024 + col);
                    const f32x4 gm = gv * (sc + 1.0f);
                    f32x4 y[2];
#pragma unroll
                    for (int r = 0; r < 2; ++r) { const float rstd = 1.0f / __builtin_sqrtf(ss[r] * (1.0f / DM) + EPS); y[r] = (v[r][j] * rstd) * gm + sh;
                        *((GAS unsigned*)(XN8 + (size_t)(m0 + r) * DM) + lane + 64 * j) = pk4f8(y[r].x, y[r].y, y[r].z, y[r].w); }
#pragma unroll
                    for (int cc = 0; cc < 4; ++cc) { const f32x4 w0 = *(const f32x4*)(wrt + (size_t)(col + cc) * 8), w1 = *(const f32x4*)(wrt + (size_t)(col + cc) * 8 + 4);
#pragma unroll
                        for (int r = 0; r < 2; ++r) { const float yv = y[r][cc];
                            lg[r][0] += yv * w0.x; lg[r][1] += yv * w0.y; lg[r][2] += yv * w0.z; lg[r][3] += yv * w0.w; lg[r][4] += yv * w1.x; lg[r][5] += yv * w1.y; lg[r][6] += yv * w1.z; lg[r][7] += yv * w1.w; } } }
#pragma unroll
                for (int o = 1; o < 64; o <<= 1) {
#pragma unroll
                    for (int r = 0; r < 2; ++r)
#pragma unroll
                        for (int e = 0; e < 8; ++e) lg[r][e] += __shfl_xor(lg[r][e], o); }
#pragma unroll
                for (int r = 0; r < 2; ++r) {
                    int ea = 0; float va = lg[r][0];
#pragma unroll
                    for (int e = 1; e < 8; ++e) if (lg[r][e] > va) { va = lg[r][e]; ea = e; }
                    int eb = -1; float vb2 = -INFINITY;
#pragma unroll
                    for (int e = 0; e < 8; ++e) if (e != ea && lg[r][e] > vb2) { vb2 = lg[r][e]; eb = e; }
                    const float wb = 1.0f / (1.0f + __expf(va - vb2)), wa = 1.0f - wb;
                    if (lane == 0) { const int tl = tl0 + r; l_e[tl * 2] = ea; l_e[tl * 2 + 1] = eb; l_w[tl * 2] = wa; l_w[tl * 2 + 1] = wb; } }
            }
            __syncthreads();
            int ea = 0, eb = 0, pa = 0, pb = 0;
            if (tid < 128) { ea = l_e[tid * 2]; eb = l_e[tid * 2 + 1]; pa = atomicAdd((int*)&l_cnt[ea], 1); pb = atomicAdd((int*)&l_cnt[eb], 1); }
            __syncthreads();
            if (tid < 8) l_base[tid] = (int)__hip_atomic_fetch_add((unsigned*)(ctl + CW_CNT + 64 * tid), (unsigned)l_cnt[tid], __ATOMIC_RELAXED, __HIP_MEMORY_SCOPE_AGENT);
            __syncthreads();
            if (tid < 128) { const int m = blk * 128 + tid; pa += l_base[ea]; pb += l_base[eb];
                LIST[(size_t)ea * NLAT + pa] = m; LIST[(size_t)eb * NLAT + pb] = m;
                int* ti = TINFO + (size_t)m * 8; ti[0] = ea; ti[1] = pa; ti[2] = eb; ti[3] = pb; ti[4] = __float_as_int(l_w[tid * 2]); ti[5] = __float_as_int(l_w[tid * 2 + 1]); }
            __syncthreads();
        }
        if (BOTH(12)) GRID_BAR(); PROBE_MARK(12);
    }
    if (hi_ph > 13 && lo < 17) {
        PHASE_IDS();
        LAS int* mtab = (LAS int*)(lds + MOE_OFF);
        if (tid == 0) { int run = 0, R = 0;
            for (int e = 0; e < 8; ++e) { const int ce = (int)__hip_atomic_load((unsigned*)(ctl + CW_CNT + 64 * e), __ATOMIC_RELAXED, __HIP_MEMORY_SCOPE_AGENT); mtab[e] = run; mtab[16 + e] = ce; run += ce >> 8; if (ce & 255) { mtab[24 + R] = e; ++R; } }
            mtab[8] = run; mtab[32] = R; }
        __syncthreads();
        const int nfull = __builtin_amdgcn_readfirstlane(mtab[8]);
        for (int c = 0; c < MOE_NCH; ++c) {
            const int gp0 = c * MOE_CH, gp1 = nfull < (c + 1) * MOE_CH ? nfull : (c + 1) * MOE_CH;
            if (IN(13 + 2 * c)) {
                { pg8::MoeSched S; S.A = (const char*)XN8; S.B = (const char*)MGU; S.list = LIST; S.tab = mtab; S.mode = 0; S.nS = 1; S.kbytes = 0; S.omoff = 0;
                  S.gp0 = gp0; S.gp1 = gp1; S.nN = 28; S.G = G; S.c = bx; S.bexp = (size_t)7168 * 1024; S.btile = (size_t)256 * 1024; S.astep = 0; S.gather = true;
                  pg8::EpiSwiGLU8 E{HC, 1.0f / MOE_SGU};
                  pg8::gemm_phase<pg8::EpiSwiGLU8, pg8::MoeSched, true, true, true>(lds, gtab, 512, 8, S, E); }
                if (c == 0) { pg8::MoeSched S; S.A = (const char*)XN8; S.B = (const char*)MGU; S.list = LIST; S.tab = mtab; S.mode = 1; S.nS = 1; S.kbytes = 0; S.omoff = MOE_CH;
                  S.gp0 = 0; S.gp1 = 0; S.nN = 28; S.G = G; S.c = bx; S.bexp = (size_t)7168 * 1024; S.btile = (size_t)256 * 1024; S.astep = 0; S.gather = true;
                  pg8::EpiSwiGLU8 E{HC, 1.0f / MOE_SGU};
                  pg8::gemm_phase<pg8::EpiSwiGLU8, pg8::MoeSched, true, true, true>(lds, gtab, 512, 8, S, E); }
                if (BOTH(13 + 2 * c)) GRID_BAR(); PROBE_MARK(13 + 2 * c);
            }
            if (IN(14 + 2 * c)) {
                { pg8::MoeSched S; S.A = (const char*)HC; S.B = (const char*)MD; S.list = LIST; S.tab = mtab; S.mode = 0; S.nS = 1; S.kbytes = 0; S.omoff = 0;
                  S.gp0 = gp0; S.gp1 = gp1; S.nN = 4; S.G = G; S.c = bx; S.bexp = (size_t)1024 * DFF; S.btile = (size_t)256 * DFF; S.astep = (size_t)256 * DFF; S.gather = false;
                  pg8::EpiBf16Plain E{YB, DM, 1.0f / MOE_SD};
                  pg8::gemm_phase<pg8::EpiBf16Plain, pg8::MoeSched, true, false, true>(lds, gtab, DFF / 2, 28, S, E); }
                if (c == 0) { pg8::MoeSched S; S.A = (const char*)(HC + (size_t)MOE_CH * 256 * DFF); S.B = (const char*)MD; S.list = LIST; S.tab = mtab; S.mode = 2; S.nS = MOE_RS; S.kbytes = (size_t)(DFF / MOE_RS); S.omoff = 0;
                  S.gp0 = 0; S.gp1 = 0; S.nN = 4; S.G = G; S.c = bx; S.bexp = (size_t)1024 * DFF; S.btile = (size_t)256 * DFF; S.astep = (size_t)256 * DFF; S.gather = false;
                  pg8::EpiPartBf16 E{YP, (size_t)8 * 256 * DM, 1.0f / MOE_SD};
                  pg8::gemm_phase<pg8::EpiPartBf16, pg8::MoeSched, true, false, true>(lds, gtab, DFF / 2, DFF / MOE_RS / 128, S, E); }
                if (BOTH(14 + 2 * c)) GRID_BAR(); PROBE_MARK(14 + 2 * c);
            }
        }
    }
    if (IN(17)) {
        PHASE_IDS();
        LAS int* l_pb = (LAS int*)(lds + wave * 128);
        if (lane == 0) { int run = 0, R = 0;
            for (int e = 0; e < 8; ++e) { const int ce = (int)__hip_atomic_load((unsigned*)(ctl + CW_CNT + 64 * e), __ATOMIC_RELAXED, __HIP_MEMORY_SCOPE_AGENT); l_pb[e] = run; l_pb[8 + e] = ce >> 8; l_pb[16 + e] = R; run += ce >> 8; if (ce & 255) ++R; } }
        const float* g2 = MOD + 5 * 6144 + 5 * 1024;
        for (int m0 = gw * 2; m0 < NLAT; m0 += NGW * 2) {
            const int mb = m0 >> 13;
            f32x4 hv[2][4], ya[2][4], yb[2][4]; float wa[2], wb[2];
#pragma unroll
            for (int r = 0; r < 2; ++r) {
                const int m = m0 + r; const int* ti = TINFO + (size_t)m * 8;
                const int ea = ti[0], pa = ti[1], eb = ti[2], pb = ti[3]; wa[r] = __int_as_float(ti[4]); wb[r] = __int_as_float(ti[5]);
                const bool ma = (pa >> 8) < l_pb[8 + ea], mbm = (pb >> 8) < l_pb[8 + eb];
                const size_t sa = ma ? (size_t)(l_pb[ea] + (pa >> 8)) * 256 + (pa & 255) : (size_t)l_pb[16 + ea] * 256 + (pa & 255);
                const size_t sb = mbm ? (size_t)(l_pb[eb] + (pb >> 8)) * 256 + (pb & 255) : (size_t)l_pb[16 + eb] * 256 + (pb & 255);
                const GAS u32x2* xr = (const GAS u32x2*)(HL + (size_t)m * DM) + lane;
#pragma unroll
                for (int j = 0; j < 4; ++j) { const u32x2 w = xr[64 * j]; hv[r][j] = (f32x4){__uint_as_float(w.x << 16), __uint_as_float(w.x & 0xffff0000u), __uint_as_float(w.y << 16), __uint_as_float(w.y & 0xffff0000u)}; }
                { const GAS u32x2* yr = (const GAS u32x2*)((ma ? YB : YP) + sa * DM) + lane;
#pragma unroll
                  for (int j = 0; j < 4; ++j) { const u32x2 a = yr[64 * j]; ya[r][j] = (f32x4){__uint_as_float(a.x << 16), __uint_as_float(a.x & 0xffff0000u), __uint_as_float(a.y << 16), __uint_as_float(a.y & 0xffff0000u)}; }
                  if (!ma) for (int s2 = 1; s2 < MOE_RS; ++s2) { const GAS u32x2* y2 = (const GAS u32x2*)(YP + ((size_t)s2 * 8 * 256 + sa) * DM) + lane;
#pragma unroll
                      for (int j = 0; j < 4; ++j) { const u32x2 a = y2[64 * j]; ya[r][j] += (f32x4){__uint_as_float(a.x << 16), __uint_as_float(a.x & 0xffff0000u), __uint_as_float(a.y << 16), __uint_as_float(a.y & 0xffff0000u)}; } } }
                { const GAS u32x2* yr = (const GAS u32x2*)((mbm ? YB : YP) + sb * DM) + lane;
#pragma unroll
                  for (int j = 0; j < 4; ++j) { const u32x2 a = yr[64 * j]; yb[r][j] = (f32x4){__uint_as_float(a.x << 16), __uint_as_float(a.x & 0xffff0000u), __uint_as_float(a.y << 16), __uint_as_float(a.y & 0xffff0000u)}; }
                  if (!mbm) for (int s2 = 1; s2 < MOE_RS; ++s2) { const GAS u32x2* y2 = (const GAS u32x2*)(YP + ((size_t)s2 * 8 * 256 + sb) * DM) + lane;
#pragma unroll
                      for (int j = 0; j < 4; ++j) { const u32x2 a = y2[64 * j]; yb[r][j] += (f32x4){__uint_as_float(a.x << 16), __uint_as_float(a.x & 0xffff0000u), __uint_as_float(a.y << 16), __uint_as_float(a.y & 0xffff0000u)}; } } }
            }
            float ss[2];
#pragma unroll
            for (int r = 0; r < 2; ++r) { ss[r] = 0.f;
#pragma unroll
                for (int j = 0; j < 4; ++j) { const f32x4 gv = *(const f32x4*)(g2 + (size_t)mb * 6144 + 4 * lane + 256 * j);
                    hv[r][j] = hv[r][j] + gv * (ya[r][j] * wa[r] + yb[r][j] * wb[r]); ss[r] += (hv[r][j].x * hv[r][j].x + hv[r][j].y * hv[r][j].y) + (hv[r][j].z * hv[r][j].z + hv[r][j].w * hv[r][j].w); } }
#pragma unroll
            for (int o = 1; o < 64; o <<= 1) {
#pragma unroll
                for (int r = 0; r < 2; ++r) ss[r] += __shfl_xor(ss[r], o); }
#pragma unroll
            for (int r = 0; r < 2; ++r) { const float rstd = 1.0f / __builtin_sqrtf(ss[r] * (1.0f / DM) + EPS);
                GAS f32x4* orow = (GAS f32x4*)(args.out + (size_t)(m0 + r) * DM) + lane;
#pragma unroll
                for (int j = 0; j < 4; ++j) { const f32x4 fg = *(const f32x4*)(I_FINALG + 4 * lane + 256 * j); __builtin_nontemporal_store((hv[r][j] * rstd) * fg, orow + 64 * j); } }
        }
    }
    PROBE_MARK(17);
#if defined(PROBE_LO)
    { PHASE_IDS(); const float T = (float)(tpB - tpA) * 0.01f; const float cval = __builtin_sqrtf(T / (float)(PROBE_UNIT));
      for (int m = gw; m < NLAT; m += NGW) { GAS f32x4* orow = (GAS f32x4*)(args.out + (size_t)m * DM) + lane;
#pragma unroll
        for (int j = 0; j < 4; ++j) orow[64 * j] = (f32x4){cval, cval, cval, cval}; } }
#endif
#undef IN
#undef BOTH
#undef GRID_BAR
}

#ifndef MK_ONE_LAUNCH
#define MK_ONE_LAUNCH 1
#endif
extern "C" void kernel_launch(void* const* d_in, const int* in_sizes, int n_in, void* d_out, int out_size, void* d_ws, size_t ws_size, hipStream_t stream) {
    static int grid = 0;
    if (grid == 0) {
        if (n_in != 24 || out_size != NLAT * DM || ws_size < WS_END) { fprintf(stderr, "kernel_launch: unexpected problem (n_in %d, out %d, ws %zu < %zu)\n", n_in, out_size, ws_size, (size_t)WS_END); grid = -1; return; }
        int dev = 0, cus = 0, per_cu = 0;
        if (hipGetDevice(&dev) != hipSuccess || hipDeviceGetAttribute(&cus, hipDeviceAttributeMultiprocessorCount, dev) != hipSuccess) { grid = -1; return; }
        if (hipFuncSetAttribute((const void*)fwd, hipFuncAttributeMaxDynamicSharedMemorySize, LDS_BYTES) != hipSuccess) { fprintf(stderr, "kernel_launch: hipFuncSetAttribute failed\n"); grid = -1; return; }
        if (hipOccupancyMaxActiveBlocksPerMultiprocessor(&per_cu, (const void*)fwd, 512, LDS_BYTES) != hipSuccess || per_cu < 1) fprintf(stderr, "kernel_launch: occupancy query says %d\n", per_cu);
        (void)hipGetLastError();
        grid = cus;
    }
    if (grid < 0) return;
    if (hipMemsetAsync((char*)d_ws + WS_CTL, 0, CTL_ZERO_BYTES, stream) != hipSuccess) return;
    Args a{};
    for (int i = 0; i < 24; ++i) a.in[i] = (const float*)d_in[i];
    a.out = (float*)d_out; a.ws = (unsigned char*)d_ws;
#if defined(SPLITAT)
    a.ph_lo = 0; a.ph_hi = SPLITAT; a.li = 0;
    hipLaunchKernelGGL(fwd, dim3(grid), dim3(512), LDS_BYTES, stream, a);
    a.ph_lo = SPLITAT; a.ph_hi = NPH; a.li = 1;
    hipLaunchKernelGGL(fwd, dim3(grid), dim3(512), LDS_BYTES, stream, a);
#elif defined(DUPK)
    a.ph_lo = 0; a.ph_hi = DUPK + 1; a.li = 0;
    hipLaunchKernelGGL(fwd, dim3(grid), dim3(512), LDS_BYTES, stream, a);
#ifdef DUPN
    for (int rep = 0; rep < DUPN; ++rep) { a.ph_lo = DUPK; a.ph_hi = DUPK + 1; a.li = 2; hipLaunchKernelGGL(fwd, dim3(grid), dim3(512), LDS_BYTES, stream, a); }
#endif
    a.ph_lo = DUPK; a.ph_hi = NPH; a.li = 1;
    hipLaunchKernelGGL(fwd, dim3(grid), dim3(512), LDS_BYTES, stream, a);
#elif MK_ONE_LAUNCH
    a.ph_lo = 0; a.ph_hi = NPH;
    hipLaunchKernelGGL(fwd, dim3(grid), dim3(512), LDS_BYTES, stream, a);
#else
    for (int p = 0; p < NPH; ++p) { a.ph_lo = p; a.ph_hi = p + 1; hipLaunchKernelGGL(fwd, dim3(grid), dim3(512), LDS_BYTES, stream, a); }
#endif
}
```

```cpp
#include <hip/hip_runtime.h>
#include <hip/hip_bf16.h>
#include <cstdio>
#include <cstdint>
#include <cmath>

constexpr int DM = 1024, NB = 4, SEQ = 8192, LCTX = 256, NLAT = NB * SEQ, NCTXR = NB * LCTX, MALL = NLAT + NCTXR;
constexpr int DFF = 3584, NEXP = 8, NQKV = 1536;
constexpr int NPL = NLAT / 256, NPA = MALL / 256;
constexpr float EPS = 1e-6f;
constexpr int MOE_CH = 128, MOE_NCH = 2;
constexpr float MOE_SGU = 32.0f, MOE_SD = 64.0f;
constexpr int MOE_RS = 7, P3_NS = 8, P5_NS = 14;

#define LAS __attribute__((address_space(3)))
#define GAS __attribute__((address_space(1)))
typedef unsigned short bf16_t;
typedef short bf16x8 __attribute__((ext_vector_type(8)));
typedef float f32x4 __attribute__((ext_vector_type(4)));
typedef float f32x2 __attribute__((ext_vector_type(2)));
typedef float f32x16 __attribute__((ext_vector_type(16)));
typedef unsigned u32x4 __attribute__((ext_vector_type(4)));
typedef unsigned u32x2 __attribute__((ext_vector_type(2)));
typedef __bf16 bf16x2_t __attribute__((ext_vector_type(2)));
typedef GAS unsigned gu32;

__device__ __forceinline__ unsigned pkbf(float lo, float hi) { f32x2 v = {lo, hi}; bf16x2_t b = __builtin_convertvector(v, bf16x2_t); return __builtin_bit_cast(unsigned, b); }
__device__ __forceinline__ unsigned pk4f8(float a, float b, float c, float d) { unsigned w = 0; w = __builtin_amdgcn_cvt_pk_fp8_f32(a, b, w, false); w = __builtin_amdgcn_cvt_pk_fp8_f32(c, d, w, true); return w; }
__device__ __forceinline__ float bf2f(unsigned short h) { return __builtin_bit_cast(float, (unsigned)h << 16); }
__device__ __forceinline__ float wave_sum(float v) {
#pragma unroll
    for (int o = 1; o < 64; o <<= 1) v += __shfl_xor(v, o);
    return v;
}
__device__ __forceinline__ float gelu_tanh(float x) {
    const float t = x * (1.0f + 0.044715f * x * x);
    const float e = __builtin_amdgcn_exp2f(-2.302208198f * t);
    return x * __builtin_amdgcn_rcpf(1.0f + e);
}
__device__ __forceinline__ float silu_f(float x) { return x * __builtin_amdgcn_rcpf(1.0f + __builtin_amdgcn_exp2f(-1.4426950409f * x)); }

constexpr size_t MiB = 1u << 20;
constexpr size_t WS_CTL = 0, CTL_ZERO_BYTES = 1 * MiB;
constexpr size_t WS_MOD = 1 * MiB;
constexpr size_t WS_ROPE = 1 * MiB + 256 * 1024;
constexpr size_t WS_STATS = 2 * MiB;
constexpr size_t WS_RSC = 4 * MiB + 512 * 1024;
constexpr size_t WS_LIST = 5 * MiB;
constexpr size_t WS_TINFO = 6 * MiB;
constexpr size_t WS_WS = 7 * MiB;
constexpr size_t WS_WIN = 8 * MiB, WS_WAO = 12 * MiB, WS_WQKV = 14 * MiB, WS_WBO = 17 * MiB, WS_WGU = 19 * MiB, WS_WD = 33 * MiB;
constexpr size_t WS_MGU = 40 * MiB, WS_MD = 96 * MiB;
constexpr size_t WS_HLB = 124 * MiB;
constexpr size_t WS_XN = 208 * MiB;
constexpr size_t WS_ZB = 274 * MiB;
constexpr size_t WS_R = 278 * MiB;
constexpr size_t WS_UVT = WS_R, WS_A2 = WS_R + 132 * MiB, WS_PART1 = WS_R + 198 * MiB, WS_H = WS_R, WS_PART2 = WS_R + 231 * MiB;
constexpr size_t WS_QKV = WS_R, WS_O = WS_R + 99 * MiB;
constexpr size_t WS_Y = WS_R, WS_YP = WS_R + 128 * MiB, WS_HC = WS_R + 156 * MiB;
constexpr size_t WS_END = WS_R + 287 * MiB;
static_assert(WS_UVT + (size_t)2048 * MALL * 2 <= WS_A2 && WS_A2 + (size_t)MALL * DM * 2 <= WS_PART1 && WS_PART1 + (size_t)P3_NS * NCTXR * DM * 4 <= WS_END, "layer-0 mixer map");
static_assert(WS_H + (size_t)MALL * DFF * 2 <= WS_PART2 && WS_PART2 + (size_t)P5_NS * NCTXR * DM * 4 <= WS_END && WS_QKV + (size_t)MALL * NQKV * 2 <= WS_O && WS_O + (size_t)NLAT * DM * 2 <= WS_END, "region map");
static_assert(WS_Y + (size_t)256 * 256 * DM * 2 <= WS_YP && WS_YP + (size_t)MOE_RS * 8 * 256 * DM * 2 <= WS_HC && WS_HC + (size_t)(MOE_CH + 8) * 256 * DFF <= WS_END, "MoE map");
static_assert(WS_MD + (size_t)8 * DM * DFF <= WS_HLB && WS_HLB + (size_t)NLAT * DM * 2 <= WS_XN && WS_XN + (size_t)MALL * DM * 2 <= WS_ZB && WS_MD + (size_t)8 * DM * DFF <= WS_XN && WS_MGU + (size_t)8 * 7168 * DM <= WS_MD, "weights map");
constexpr int CW_TMO = 0, CW_CODE = 1;
constexpr int CW_CNT = 64;
constexpr int CW_WAMAX = 1024;
constexpr int CW_BAR = 4096;

constexpr int RING_BYTES = 131072;
constexpr int GTAB_OFF = RING_BYTES;
constexpr int MOE_OFF = RING_BYTES + 1024;
constexpr int MISC_OFF = RING_BYTES + 2048;
constexpr int LDS_BYTES = 147456;

namespace pg8 {
constexpr int BM = 256, BK = 64, HALF = 128, HTB = HALF * BK * 2, STAGE_BYTES = 8 * HTB, NXCD = 8, WGM = 8;
__host__ __device__ __forceinline__ int lds_byte(int r, int c) { const int st = (r >> 4) * 2 + (c >> 5), rr = r & 15, cc = c & 31, ob = rr * 64 + cc * 2; return st * 1024 + (ob ^ (((ob >> 9) & 1) << 5)); }
__host__ __device__ __forceinline__ void stage_rc(int b, int& R, int& C) { const int st = b / 1024, sb = b % 1024, swz = sb ^ (((sb >> 9) & 1) << 5); R = (st >> 1) * 16 + swz / 64; C = (st & 1) * 32 + (swz % 64) / 2; }
__host__ __device__ __forceinline__ int perm32(int rho) { const int n = rho >> 4, i = rho & 15; return 8 * (i >> 2) + 4 * n + (i & 3); }

struct Unit { const char* a; const char* b; const int* gl; int pm, pn, om, nv, ks; };

__device__ __forceinline__ bool tile_order(int i, int G, int c, int nM, int nN, int& pm, int& pn) {
    const int nwg = nM * nN; const long L = (long)i * G + c; if (L >= nwg) return false;
    int wgid = (int)L; { const int q = nwg / NXCD, r = nwg % NXCD, xcd = wgid % NXCD, off = wgid / NXCD; wgid = (xcd < r ? xcd * (q + 1) : r * (q + 1) + (xcd - r) * q) + off; }
    const int nig = WGM * nN, gid = wgid / nig, fm = gid * WGM, gsz = (nM - fm) < WGM ? (nM - fm) : WGM;
    pm = fm + ((wgid % nig) % gsz); pn = (wgid % nig) / gsz; return true;
}
struct DenseSched {
    const char* A; const char* B; int nM, nN, G, c; size_t tstep;
    __device__ __forceinline__ bool next(int i, Unit& u) const {
        int pm, pn; if (!tile_order(i, G, c, nM, nN, pm, pn)) return false;
        u.a = A + (size_t)pm * tstep; u.b = B + (size_t)pn * tstep; u.gl = nullptr; u.pm = pm; u.pn = pn; u.om = pm; u.nv = 256; u.ks = 0; return true;
    }
};
typedef int v8i_t __attribute__((ext_vector_type(8)));
typedef int v4i_t __attribute__((ext_vector_type(4)));
__device__ __forceinline__ v8i_t cat8(bf16x8 lo, bf16x8 hi) { const v4i_t a = __builtin_bit_cast(v4i_t, lo), b = __builtin_bit_cast(v4i_t, hi); return __builtin_shufflevector(a, b, 0, 1, 2, 3, 4, 5, 6, 7); }
struct SplitSched {
    const char* A; const char* B; int nM, nN, nS, G, c, pm0; size_t tstep, kbytes;
    __device__ __forceinline__ bool next(int i, Unit& u) const {
        const int L = i * G + c; if (L >= nM * nN * nS) return false;
        const int ks = L % nS, t = L / nS, pn = t % nN, pm = t / nN;
        u.a = A + (size_t)pm * tstep + (size_t)ks * kbytes; u.b = B + (size_t)pn * tstep + (size_t)ks * kbytes; u.gl = nullptr; u.pm = pm0 + pm; u.pn = pn; u.om = pm; u.nv = 256; u.ks = ks; return true;
    }
};
struct MoeSched {
    const char* A; const char* B; const int* list; const LAS int* tab; int gp0, gp1, nN, nS, G, c, mode, omoff; size_t bexp, btile, astep, kbytes; bool gather;
    __device__ __forceinline__ bool next(int i, Unit& u) const {
        int pm, pn, ks = 0;
        if (mode == 0) { if (gp1 <= gp0) return false; if (!tile_order(i, G, c, gp1 - gp0, nN, pm, pn)) return false; }
        else { const int R = __builtin_amdgcn_readfirstlane(tab[32]); const int L = i * G + c; if (L >= R * nN * nS) return false; ks = L % nS; const int t = L / nS; pn = t % nN; pm = t / nN; }
        int e = 0, lp, nv;
        if (mode == 0) { const int gp = gp0 + pm;
#pragma unroll
            for (int k = 1; k < 8; ++k) e += (gp >= __builtin_amdgcn_readfirstlane(tab[k])) ? 1 : 0;
            lp = gp - __builtin_amdgcn_readfirstlane(tab[e]); nv = 256; u.pm = gp; }
        else { e = __builtin_amdgcn_readfirstlane(tab[24 + pm]); const int ce = __builtin_amdgcn_readfirstlane(tab[16 + e]); lp = ce >> 8; nv = ce & 255; u.pm = pm; }
        u.b = B + (size_t)e * bexp + (size_t)pn * btile + (size_t)ks * kbytes; u.pn = pn; u.nv = nv; u.ks = ks; u.om = pm;
        if (gather) { u.a = A; u.gl = list + (size_t)e * NLAT + 256 * lp; u.om = pm + omoff; }
        else { u.a = A + (size_t)pm * astep + (size_t)ks * kbytes; u.gl = nullptr; if (mode == 0) u.om = gp0 + pm; }
        return true;
    }
};

struct EpiGeluT {
    static constexpr bool PERM = true;
    bf16_t* O; float* stats;
    __device__ __forceinline__ void operator()(const f32x4 (&acc)[2][2][4][2], const Unit& u, int wr, int wc, int fr, int fq) const {
        const int row0 = u.pm * BM + wr * 64 + fr, col0 = u.pn * BM + wc * 32 + 8 * fq;
        const bool isv = u.pm >= 4;
        float s1[2][2][4], s2[2][2][4];
#pragma unroll
        for (int bj = 0; bj < 2; ++bj)
#pragma unroll
            for (int n = 0; n < 2; ++n)
#pragma unroll
                for (int e = 0; e < 4; ++e) { s1[bj][n][e] = 0.f; s2[bj][n][e] = 0.f; }
#pragma unroll
        for (int ai = 0; ai < 2; ++ai)
#pragma unroll
            for (int m = 0; m < 4; ++m) { bf16_t* rowp = O + (size_t)(row0 + ai * HALF + m * 16) * MALL + col0;
#pragma unroll
                for (int bj = 0; bj < 2; ++bj) { f32x4 v0 = acc[ai][bj][m][0], v1 = acc[ai][bj][m][1];
#pragma unroll
                    for (int e = 0; e < 4; ++e) { v0[e] = gelu_tanh(v0[e]); v1[e] = gelu_tanh(v1[e]); s1[bj][0][e] += v0[e]; s2[bj][0][e] += v0[e] * v0[e]; s1[bj][1][e] += v1[e]; s2[bj][1][e] += v1[e] * v1[e]; }
                    u32x4 w; w.x = pkbf(v0[0], v0[1]); w.y = pkbf(v0[2], v0[3]); w.z = pkbf(v1[0], v1[1]); w.w = pkbf(v1[2], v1[3]);
                    *(u32x4*)(rowp + bj * HALF) = w; } }
        if (isv) {
            const int slot = (u.pm - 4) * 2 + wr;
#pragma unroll
            for (int bj = 0; bj < 2; ++bj)
#pragma unroll
                for (int n = 0; n < 2; ++n)
#pragma unroll
                    for (int e = 0; e < 4; ++e) { float a = s1[bj][n][e], b = s2[bj][n][e];
#pragma unroll
                        for (int o = 1; o < 16; o <<= 1) { a += __shfl_xor(a, o); b += __shfl_xor(b, o); }
                        if (fr == 0) { const int tok = col0 + bj * HALF + 4 * n + e; *(f32x2*)(stats + (size_t)tok * 16 + slot * 2) = (f32x2){a, b}; } }
        }
    }
};
template <bool BASE_F32> struct EpiResid {
    static constexpr bool PERM = true;
    const float* basef; const bf16_t* baseb; bf16_t* out; const float* gate;
    __device__ __forceinline__ void operator()(const f32x4 (&acc)[2][2][4][2], const Unit& u, int wr, int wc, int fr, int fq) const {
        const int mb = u.pm >> 5; const int col0 = u.pn * BM + wc * 32 + 8 * fq;
        f32x4 gv[2][2];
#pragma unroll
        for (int bj = 0; bj < 2; ++bj)
#pragma unroll
            for (int n = 0; n < 2; ++n) gv[bj][n] = *(const f32x4*)(gate + (size_t)mb * 6144 + col0 + bj * HALF + n * 4);
#pragma unroll
        for (int ai = 0; ai < 2; ++ai)
#pragma unroll
            for (int m = 0; m < 4; ++m) { const size_t off = (size_t)(u.pm * BM + wr * 64 + fr + ai * HALF + m * 16) * DM + col0;
#pragma unroll
                for (int bj = 0; bj < 2; ++bj) { f32x4 b0, b1;
                    if constexpr (BASE_F32) { b0 = *(const f32x4*)(basef + off + bj * HALF); b1 = *(const f32x4*)(basef + off + bj * HALF + 4); }
                    else { const u32x4 w = *(const u32x4*)(baseb + off + bj * HALF);
                        b0 = (f32x4){__uint_as_float(w.x << 16), __uint_as_float(w.x & 0xffff0000u), __uint_as_float(w.y << 16), __uint_as_float(w.y & 0xffff0000u)};
                        b1 = (f32x4){__uint_as_float(w.z << 16), __uint_as_float(w.z & 0xffff0000u), __uint_as_float(w.w << 16), __uint_as_float(w.w & 0xffff0000u)}; }
                    const f32x4 o0 = b0 + gv[bj][0] * acc[ai][bj][m][0], o1 = b1 + gv[bj][1] * acc[ai][bj][m][1];
                    u32x4 w; w.x = pkbf(o0[0], o0[1]); w.y = pkbf(o0[2], o0[3]); w.z = pkbf(o1[0], o1[1]); w.w = pkbf(o1[2], o1[3]);
                    *(u32x4*)(out + off + bj * HALF) = w; } }
    }
};
struct EpiSwiGLU {
    static constexpr bool PERM = true;
    bf16_t* O;
    __device__ __forceinline__ void operator()(const f32x4 (&acc)[2][2][4][2], const Unit& u, int wr, int wc, int fr, int fq) const {
        bf16_t* base = O + (size_t)(u.om * BM + wr * 64 + fr) * DFF + u.pn * 128 + wc * 32 + 8 * fq;
#pragma unroll
        for (int ai = 0; ai < 2; ++ai)
#pragma unroll
            for (int m = 0; m < 4; ++m) { const f32x4 g0 = acc[ai][0][m][0], g1 = acc[ai][0][m][1], u0 = acc[ai][1][m][0], u1 = acc[ai][1][m][1];
                float o[8];
#pragma unroll
                for (int e = 0; e < 4; ++e) { o[e] = silu_f(g0[e]) * u0[e]; o[4 + e] = silu_f(g1[e]) * u1[e]; }
                u32x4 w; w.x = pkbf(o[0], o[1]); w.y = pkbf(o[2], o[3]); w.z = pkbf(o[4], o[5]); w.w = pkbf(o[6], o[7]);
                *(u32x4*)(base + (size_t)(ai * HALF + m * 16) * DFF) = w; }
    }
};
struct EpiQKV {
    static constexpr bool PERM = false;
    bf16_t* O; const float* cosT; const float* sinT; float qscale;
    __device__ __forceinline__ void operator()(const f32x4 (&acc)[2][2][4][2], const Unit& u, int wr, int wc, int fr, int fq) const {
        const bool lat = u.pm < NPL; const bool dorope = lat && u.pn < 5; const float sc = u.pn < 4 ? qscale : 1.0f;
        const int col0 = u.pn * BM + wc * 32 + 4 * fq;
#pragma unroll
        for (int ai = 0; ai < 2; ++ai)
#pragma unroll
            for (int m = 0; m < 4; ++m) { const int grow = u.pm * BM + ai * HALF + wr * 64 + m * 16 + fr; const int s = grow & (SEQ - 1); const int pos = (wc & 1) ? (s & 63) : (s >> 6);
                f32x4 cs = (f32x4){1.f, 1.f, 1.f, 1.f}, sn = (f32x4){0.f, 0.f, 0.f, 0.f};
                if (dorope) { cs = *(const f32x4*)(cosT + pos * 16 + 4 * fq); sn = *(const f32x4*)(sinT + pos * 16 + 4 * fq); }
                bf16_t* rowp = O + (size_t)grow * NQKV + col0;
#pragma unroll
                for (int bj = 0; bj < 2; ++bj) { const f32x4 x1 = acc[ai][bj][m][0], x2 = acc[ai][bj][m][1];
                    const f32x4 o1 = (x1 * cs - x2 * sn) * sc, o2 = (x1 * sn + x2 * cs) * sc;
                    u32x2 w1, w2; w1.x = pkbf(o1[0], o1[1]); w1.y = pkbf(o1[2], o1[3]); w2.x = pkbf(o2[0], o2[1]); w2.y = pkbf(o2[2], o2[3]);
                    *(u32x2*)(rowp + bj * HALF) = w1; *(u32x2*)(rowp + bj * HALF + 16) = w2; } }
    }
};
struct EpiSwiGLUI8 {
    static constexpr bool PERM = true;
    bf16_t* O; const float* rscale; const float* ws;
    __device__ __forceinline__ void operator()(const f32x4 (&acc)[2][2][4][2], const Unit& u, int wr, int wc, int fr, int fq) const {
        bf16_t* base = O + (size_t)(u.om * BM + wr * 64 + fr) * DFF + u.pn * 128 + wc * 32 + 8 * fq;
        const float wsg = ws[0], wsu = ws[1];
#pragma unroll
        for (int ai = 0; ai < 2; ++ai)
#pragma unroll
            for (int m = 0; m < 4; ++m) { const float rs = rscale[u.pm * BM + wr * 64 + fr + ai * HALF + m * 16]; const float sg = rs * wsg, su = rs * wsu;
                const v4i_t g0 = __builtin_bit_cast(v4i_t, acc[ai][0][m][0]), g1 = __builtin_bit_cast(v4i_t, acc[ai][0][m][1]), u0 = __builtin_bit_cast(v4i_t, acc[ai][1][m][0]), u1 = __builtin_bit_cast(v4i_t, acc[ai][1][m][1]);
                float o[8];
#pragma unroll
                for (int e = 0; e < 4; ++e) { o[e] = silu_f((float)g0[e] * sg) * ((float)u0[e] * su); o[4 + e] = silu_f((float)g1[e] * sg) * ((float)u1[e] * su); }
                u32x4 w; w.x = pkbf(o[0], o[1]); w.y = pkbf(o[2], o[3]); w.z = pkbf(o[4], o[5]); w.w = pkbf(o[6], o[7]);
                *(u32x4*)(base + (size_t)(ai * HALF + m * 16) * DFF) = w; }
    }
};
struct EpiSwiGLU8 {
    static constexpr bool PERM = true;
    unsigned char* O; float s;
    __device__ __forceinline__ void operator()(const f32x4 (&acc)[2][2][4][2], const Unit& u, int wr, int wc, int fr, int fq) const {
        unsigned char* base = O + (size_t)(u.om * BM + wr * 64 + fr) * DFF + u.pn * 128 + wc * 32 + 8 * fq;
#pragma unroll
        for (int ai = 0; ai < 2; ++ai)
#pragma unroll
            for (int m = 0; m < 4; ++m) { const f32x4 g0 = acc[ai][0][m][0] * s, g1 = acc[ai][0][m][1] * s, u0 = acc[ai][1][m][0] * s, u1 = acc[ai][1][m][1] * s;
                float o[8];
#pragma unroll
                for (int e = 0; e < 4; ++e) { o[e] = silu_f(g0[e]) * u0[e]; o[4 + e] = silu_f(g1[e]) * u1[e]; }
                u32x2 w; w.x = pk4f8(o[0], o[1], o[2], o[3]); w.y = pk4f8(o[4], o[5], o[6], o[7]);
                *(u32x2*)(base + (size_t)(ai * HALF + m * 16) * DFF) = w; }
    }
};
struct EpiBf16Plain {
    static constexpr bool PERM = true;
    bf16_t* O; int ldc; float s;
    __device__ __forceinline__ void operator()(const f32x4 (&acc)[2][2][4][2], const Unit& u, int wr, int wc, int fr, int fq) const {
        bf16_t* base = O + (size_t)(u.om * BM + wr * 64 + fr) * ldc + u.pn * BM + wc * 32 + 8 * fq;
#pragma unroll
        for (int ai = 0; ai < 2; ++ai)
#pragma unroll
            for (int m = 0; m < 4; ++m)
#pragma unroll
                for (int bj = 0; bj < 2; ++bj) { const f32x4 v0 = acc[ai][bj][m][0] * s, v1 = acc[ai][bj][m][1] * s;
                    u32x4 w; w.x = pkbf(v0[0], v0[1]); w.y = pkbf(v0[2], v0[3]); w.z = pkbf(v1[0], v1[1]); w.w = pkbf(v1[2], v1[3]);
                    *(u32x4*)(base + (size_t)(ai * HALF + m * 16) * ldc + bj * HALF) = w; }
    }
};

struct EpiPartF32 {
    static constexpr bool PERM = true;
    float* P; size_t sstride;
    __device__ __forceinline__ void operator()(const f32x4 (&acc)[2][2][4][2], const Unit& u, int wr, int wc, int fr, int fq) const {
        float* base = P + (size_t)u.ks * sstride + (size_t)(u.om * BM + wr * 64 + fr) * DM + u.pn * BM + wc * 32 + 8 * fq;
#pragma unroll
        for (int ai = 0; ai < 2; ++ai)
#pragma unroll
            for (int m = 0; m < 4; ++m)
#pragma unroll
                for (int bj = 0; bj < 2; ++bj)
#pragma unroll
                    for (int n = 0; n < 2; ++n) *(f32x4*)(base + (size_t)(ai * HALF + m * 16) * DM + bj * HALF + n * 4) = acc[ai][bj][m][n];
    }
};
struct EpiPartBf16 {
    static constexpr bool PERM = true;
    bf16_t* P; size_t sstride; float s;
    __device__ __forceinline__ void operator()(const f32x4 (&acc)[2][2][4][2], const Unit& u, int wr, int wc, int fr, int fq) const {
        bf16_t* base = P + (size_t)u.ks * sstride + (size_t)(u.om * BM + wr * 64 + fr) * DM + u.pn * BM + wc * 32 + 8 * fq;
#pragma unroll
        for (int ai = 0; ai < 2; ++ai)
#pragma unroll
            for (int m = 0; m < 4; ++m)
#pragma unroll
                for (int bj = 0; bj < 2; ++bj) { const f32x4 v0 = acc[ai][bj][m][0] * s, v1 = acc[ai][bj][m][1] * s;
                    u32x4 w; w.x = pkbf(v0[0], v0[1]); w.y = pkbf(v0[2], v0[3]); w.z = pkbf(v1[0], v1[1]); w.w = pkbf(v1[2], v1[3]);
                    *(u32x4*)(base + (size_t)(ai * HALF + m * 16) * DM + bj * HALF) = w; }
    }
};

template <class Epi, class Sched, bool ALIGN_EPI, bool GATHER, bool FP8 = false, bool I8 = false>
__device__ __forceinline__ void gemm_phase(LAS unsigned char* lds, LAS int* gtab, const int K  , const int nt_in  , const Sched& S, const Epi& E) {
    int nt = nt_in; asm volatile("" : "+s"(nt));
    int tid_ = threadIdx.x; asm volatile("" : "+v"(tid_));
    const int tid = tid_, wid = __builtin_amdgcn_readfirstlane(tid >> 6), lane = tid & 63, wr = wid >> 2, wc = wid & 3, fr = lane & 15, fq = lane >> 4;
    const size_t kstep = (size_t)(BK * 2);
    const size_t hstep = (size_t)HALF * K * 2;
    unsigned voffB[2];
#pragma unroll
    for (int i = 0; i < 2; ++i) { int R, C; stage_rc(tid * 16 + i * 8192, R, C); const int Rb = Epi::PERM ? ((R & ~31) + perm32(R & 31)) : R;
        voffB[i] = (unsigned)(Rb * K + C) * 2u; }
    unsigned vA[2][2], vN[2][2];
    const unsigned ldsw = (unsigned)wid * 1024u;
    const int aoff = lds_byte(wr * 64 + fr, fq * 8), boff = lds_byte(wc * 32 + fr, fq * 8);
    const LAS unsigned char* aB = lds + aoff; const LAS unsigned char* bB = lds + 65536 + boff;
    asm volatile("" : "+v"(aB), "+v"(bB));
#define PG8_SA(b, h) (((b) * 2 + (h)) * HTB)
#define PG8_SB(b, h) ((4 + (b) * 2 + (h)) * HTB)
#define PG8_STAGE(bufoff, gbase, voff) do { _Pragma("unroll") for (int _i = 0; _i < 2; ++_i) \
        __builtin_amdgcn_global_load_lds((const unsigned*)((const char*)(gbase) + (voff)[_i]), (LAS unsigned*)(lds + (bufoff) + ldsw + _i * 8192), 16, 0, 0); } while (0)
#define PG8_LDA(dst, b, h) do { _Pragma("unroll") for (int m = 0; m < 4; ++m) { if constexpr (FP8) dst##8[m] = cat8(*(const LAS bf16x8*)(aB + PG8_SA(b, h) + m * 2048), *(const LAS bf16x8*)(aB + PG8_SA(b, h) + m * 2048 + 1024)); \
        else { _Pragma("unroll") for (int k = 0; k < 2; ++k) dst[m][k] = *(const LAS bf16x8*)(aB + PG8_SA(b, h) + m * 2048 + k * 1024); } } } while (0)
#define PG8_LDB(dst, b, h) do { _Pragma("unroll") for (int n = 0; n < 2; ++n) { if constexpr (FP8) dst##8[n] = cat8(*(const LAS bf16x8*)(bB + (PG8_SB(b, h) - 65536) + n * 2048), *(const LAS bf16x8*)(bB + (PG8_SB(b, h) - 65536) + n * 2048 + 1024)); \
        else { _Pragma("unroll") for (int k = 0; k < 2; ++k) dst[n][k] = *(const LAS bf16x8*)(bB + (PG8_SB(b, h) - 65536) + n * 2048 + k * 1024); } } } while (0)
#define PG8_MMA(ai, bj, At, Bt) do { __builtin_amdgcn_s_setprio(1); \
    if constexpr (FP8) { _Pragma("unroll") for (int m = 0; m < 4; ++m) _Pragma("unroll") for (int n = 0; n < 2; ++n) \
        asm volatile("v_mfma_f32_16x16x128_f8f6f4 %0, %1, %2, %0" : "+v"(acc[ai][bj][m][n]) : "v"(Bt##8[n]), "v"(At##8[m])); } \
    else if constexpr (I8) { _Pragma("unroll") for (int m = 0; m < 4; ++m) _Pragma("unroll") for (int n = 0; n < 2; ++n) _Pragma("unroll") for (int k = 0; k < 2; ++k) \
        acc[ai][bj][m][n] = __builtin_bit_cast(f32x4, __builtin_amdgcn_mfma_i32_16x16x64_i8(__builtin_bit_cast(v4i_t, Bt[n][k]), __builtin_bit_cast(v4i_t, At[m][k]), __builtin_bit_cast(v4i_t, acc[ai][bj][m][n]), 0, 0, 0)); } \
    else { _Pragma("unroll") for (int m = 0; m < 4; ++m) _Pragma("unroll") for (int n = 0; n < 2; ++n) _Pragma("unroll") for (int k = 0; k < 2; ++k) \
        acc[ai][bj][m][n] = __builtin_amdgcn_mfma_f32_16x16x32_bf16(Bt[n][k], At[m][k], acc[ai][bj][m][n], 0, 0, 0); } \
    __builtin_amdgcn_s_setprio(0); } while (0)
#define PG8_WAIT_V(n) asm volatile("s_waitcnt vmcnt(" #n ")" ::: "memory")
#define PG8_WAIT_L(n) asm volatile("s_waitcnt lgkmcnt(" #n ")" ::: "memory")
#define PG8_BAR __builtin_amdgcn_s_barrier()
#define PG8_SCHED __builtin_amdgcn_sched_barrier(0)
    Unit cur, nxt; int ui = 0;
    if (!S.next(0, cur)) return;
    f32x4 acc[2][2][4][2];
#pragma unroll
    for (int a = 0; a < 2; ++a)
#pragma unroll
        for (int b = 0; b < 2; ++b)
#pragma unroll
            for (int m = 0; m < 4; ++m)
#pragma unroll
                for (int n = 0; n < 2; ++n) acc[a][b][m][n] = (f32x4){0.f, 0.f, 0.f, 0.f};
    bf16x8 At[4][2], B0[2][2], B1[2][2]; v8i_t At8[4], B08[2], B18[2];
    if constexpr (GATHER) {
#pragma unroll
        for (int h = 0; h < 2; ++h)
#pragma unroll
            for (int i = 0; i < 2; ++i) { int R, C; stage_rc(tid * 16 + i * 8192, R, C); const int row = h * HALF + R; const int tok = cur.gl[row < cur.nv ? row : 0]; vA[h][i] = (unsigned)tok * (unsigned)(K * 2) + (unsigned)C * 2u; }
    } else {
#pragma unroll
        for (int h = 0; h < 2; ++h)
#pragma unroll
            for (int i = 0; i < 2; ++i) { int R, C; stage_rc(tid * 16 + i * 8192, R, C); vA[h][i] = (unsigned)(R * K + C) * 2u + (unsigned)(h * hstep); }
    }
#pragma unroll
    for (int h = 0; h < 2; ++h)
#pragma unroll
        for (int i = 0; i < 2; ++i) vN[h][i] = vA[h][i];
    const char* cA = cur.a; const char* cB = cur.b;
    PG8_STAGE(PG8_SB(0, 0), cB, voffB); PG8_STAGE(PG8_SB(0, 1), cB + hstep, voffB); PG8_STAGE(PG8_SA(0, 0), cA, vA[0]); PG8_STAGE(PG8_SA(0, 1), cA, vA[1]);
    if (wr == 1) PG8_BAR;
    PG8_WAIT_V(2); PG8_BAR;
    PG8_STAGE(PG8_SB(1, 0), cB + kstep, voffB); PG8_STAGE(PG8_SA(1, 0), cA + kstep, vA[0]); PG8_STAGE(PG8_SB(1, 1), cB + hstep + kstep, voffB);
    PG8_WAIT_V(6); PG8_BAR;
    for (;;) {
        const bool has_next = S.next(ui + 1, nxt);
        const char* nA = has_next ? nxt.a : cA; const char* nB = has_next ? nxt.b : cB;
        if constexpr (GATHER) {
            if (has_next && wid < 4) __builtin_amdgcn_global_load_lds((const unsigned*)(nxt.gl + wid * 64 + lane), (LAS unsigned*)(gtab + wid * 64), 4, 0, 0);
        }
        for (int t = 0; t < nt; t += 2) {
            const bool last = (t == nt - 2);
            const char* a1 = cA + (size_t)(t + 1) * kstep;
            const char* a2 = last ? nA : cA + (size_t)(t + 2) * kstep; const char* b2 = last ? nB : cB + (size_t)(t + 2) * kstep;
            const char* a3 = a2 + kstep; const char* b3 = b2 + kstep;
            if constexpr (GATHER) {
                if (last && has_next) {
                    int t2 = tid; asm volatile("" : "+v"(t2));
#pragma unroll
                    for (int h = 0; h < 2; ++h)
#pragma unroll
                        for (int i = 0; i < 2; ++i) { int R, C; stage_rc(t2 * 16 + i * 8192, R, C); const int row = h * HALF + R; const int tok = gtab[row < nxt.nv ? row : 0]; vN[h][i] = (unsigned)tok * (unsigned)(K * 2) + (unsigned)C * 2u; }
                }
            }
            unsigned vS0[2], vS1[2];
#pragma unroll
            for (int i = 0; i < 2; ++i) { vS0[i] = (GATHER && last) ? vN[0][i] : vA[0][i]; vS1[i] = (GATHER && last) ? vN[1][i] : vA[1][i]; }
            PG8_LDB(B0, 0, 0); PG8_LDB(B1, 0, 1); PG8_SCHED; PG8_LDA(At, 0, 0); PG8_STAGE(PG8_SA(1, 1), a1, vA[1]);
            PG8_WAIT_V(8); PG8_WAIT_L(0); PG8_BAR; PG8_MMA(0, 0, At, B0); PG8_MMA(0, 1, At, B1); PG8_BAR; PG8_SCHED;
            PG8_LDA(At, 0, 1); PG8_STAGE(PG8_SB(0, 0), b2, voffB); PG8_STAGE(PG8_SB(0, 1), b2 + hstep, voffB); PG8_STAGE(PG8_SA(0, 0), a2, vS0);
            PG8_WAIT_V(8); PG8_WAIT_L(0); PG8_BAR; PG8_MMA(1, 0, At, B0); PG8_MMA(1, 1, At, B1); PG8_BAR; PG8_SCHED;
            PG8_LDB(B0, 1, 0); PG8_LDB(B1, 1, 1); PG8_SCHED; PG8_LDA(At, 1, 0); PG8_STAGE(PG8_SA(0, 1), a2, vS1);
            PG8_WAIT_V(8); PG8_WAIT_L(0); PG8_BAR; PG8_MMA(0, 0, At, B0); PG8_MMA(0, 1, At, B1); PG8_BAR; PG8_SCHED;
            PG8_LDA(At, 1, 1); PG8_STAGE(PG8_SB(1, 0), b3, voffB); PG8_STAGE(PG8_SB(1, 1), b3 + hstep, voffB); PG8_STAGE(PG8_SA(1, 0), a3, vS0);
            PG8_WAIT_V(8); PG8_WAIT_L(0); PG8_BAR; PG8_MMA(1, 0, At, B0); PG8_MMA(1, 1, At, B1); PG8_BAR; PG8_SCHED;
        }
        if constexpr (ALIGN_EPI) { if (wr == 0) PG8_BAR; }
        if constexpr (FP8) asm volatile("s_nop 15\n\ts_nop 15" ::: "memory");
        E(acc, cur, wr, wc, fr, fq);
        if (!has_next) break;
#pragma unroll
        for (int a = 0; a < 2; ++a)
#pragma unroll
            for (int b = 0; b < 2; ++b)
#pragma unroll
                for (int m = 0; m < 4; ++m)
#pragma unroll
                    for (int n = 0; n < 2; ++n) acc[a][b][m][n] = (f32x4){0.f, 0.f, 0.f, 0.f};
        cur = nxt; cA = nA; cB = nB; ++ui;
        if constexpr (GATHER) {
#pragma unroll
            for (int h = 0; h < 2; ++h)
#pragma unroll
                for (int i = 0; i < 2; ++i) vA[h][i] = vN[h][i];
        }
        if constexpr (ALIGN_EPI) { if (wr == 1) PG8_BAR; }
    }
    PG8_WAIT_V(0);
    if constexpr (!ALIGN_EPI) { if (wr == 0) PG8_BAR; }
    PG8_BAR;
#undef PG8_SA
#undef PG8_SB
#undef PG8_STAGE
#undef PG8_LDA
#undef PG8_LDB
#undef PG8_MMA
#undef PG8_WAIT_V
#undef PG8_WAIT_L
#undef PG8_BAR
#undef PG8_SCHED
}
}

namespace attn_body {
using bf16 = __hip_bfloat16;
using s16x4 = __attribute__((ext_vector_type(4))) short;
constexpr int D = 64, PITCH = NQKV, OPITCH = DM;
constexpr int NW = 8, QBLK = 32, KVBLK = 64;
__device__ __forceinline__ int crow(int r, int hi) { return (r & 3) + 8 * (r >> 2) + 4 * hi; }
#define SBAR() __builtin_amdgcn_sched_barrier(0)
__device__ __forceinline__ void bmask(f32x16& p0, f32x16& p1, int kb, int qrel, int hi) {
    const float NEG = -INFINITY; const int d0 = kb + 4 * hi - qrel;
#pragma unroll
    for (int r = 0; r < 16; ++r) { const int d = d0 + (r & 3) + 8 * (r >> 2); if (d < -128 || d > 128) p0[r] = NEG; if (d + 32 < -128 || d + 32 > 128) p1[r] = NEG; }
}
constexpr int NSLOT = 3, SLOTB = 8192;
constexpr int LDS_K = 0, LDS_V = NSLOT * SLOTB, LDS_WS = 2 * NSLOT * SLOTB, LDS_OST = LDS_WS + NW * 64 * 4, LDS_BYTES_A = LDS_OST + NW * 4096;
constexpr float C2 = 0.125f * 1.4426950408889634f;
__device__ __forceinline__ void glds16(const void* gsrc, unsigned lds_dst) { unsigned keep;
    asm volatile("s_mov_b32 %0, m0\n\ts_mov_b32 m0, %2\n\ts_nop 0\n\tglobal_load_lds_dwordx4 %1, off\n\ts_mov_b32 m0, %0" : "=&s"(keep) : "v"(gsrc), "s"(lds_dst) : "memory"); }
__device__ __forceinline__ float max3f(float a, float b, float c) { float r; asm("v_max3_f32 %0, %1, %2, %3" : "=v"(r) : "v"(a), "v"(b), "v"(c)); return r; }
__device__ __forceinline__ float max2f(float a, float b) { float r; asm("v_max_f32_e32 %0, %1, %2" : "=v"(r) : "v"(a), "v"(b)); return r; }
__device__ __forceinline__ float fadd_s(float a, float b) { float r; asm("v_add_f32_e32 %0, %1, %2" : "=v"(r) : "v"(a), "v"(b)); return r; }
__device__ __forceinline__ float fsub_s(float a, float b) { float r; asm("v_sub_f32_e32 %0, %1, %2" : "=v"(r) : "v"(a), "v"(b)); return r; }
__device__ __forceinline__ unsigned cvtpk_s(float lo, float hi) { f32x2 v = {lo, hi}; bf16x2_t b = __builtin_convertvector(v, bf16x2_t); return __builtin_bit_cast(unsigned, b); }
#define WAIT_BAR(N) asm volatile("s_waitcnt vmcnt(" #N ") lgkmcnt(0)\n\ts_barrier" ::: "memory")
__device__ __forceinline__ void qkt(f32x16& p0, f32x16& p1, const char* Kslot, const bf16x8* qr, const f32x16& negm, int r32, int hi) {
    const char* kb = Kslot + hi * 1024 + r32 * 16;
#pragma unroll
    for (int d0 = 0; d0 < 4; ++d0) {
        const bf16x8 b0 = *reinterpret_cast<const bf16x8*>(kb + d0 * 2048);
        const bf16x8 b1 = *reinterpret_cast<const bf16x8*>(kb + d0 * 2048 + 512);
        if (d0 == 0) { p0 = __builtin_amdgcn_mfma_f32_32x32x16_bf16(b0, qr[0], negm, 0, 0, 0); p1 = __builtin_amdgcn_mfma_f32_32x32x16_bf16(b1, qr[0], negm, 0, 0, 0); }
        else { p0 = __builtin_amdgcn_mfma_f32_32x32x16_bf16(b0, qr[d0], p0, 0, 0, 0); p1 = __builtin_amdgcn_mfma_f32_32x32x16_bf16(b1, qr[d0], p1, 0, 0, 0); } }
}
typedef __attribute__((address_space(3))) const char* lds_cptr;
typedef short v4i16_t __attribute__((ext_vector_type(4)));
__device__ __forceinline__ void kload8(bf16x8* kf, lds_cptr kp) {
    kf[0] = *(const __attribute__((address_space(3))) bf16x8*)(kp);        kf[1] = *(const __attribute__((address_space(3))) bf16x8*)(kp + 512);
    kf[2] = *(const __attribute__((address_space(3))) bf16x8*)(kp + 2048); kf[3] = *(const __attribute__((address_space(3))) bf16x8*)(kp + 2560);
    kf[4] = *(const __attribute__((address_space(3))) bf16x8*)(kp + 4096); kf[5] = *(const __attribute__((address_space(3))) bf16x8*)(kp + 4608);
    kf[6] = *(const __attribute__((address_space(3))) bf16x8*)(kp + 6144); kf[7] = *(const __attribute__((address_space(3))) bf16x8*)(kp + 6656);
}
__device__ __forceinline__ void kload2(bf16x8* kf, lds_cptr kp, int j) { kf[2 * j] = *(const __attribute__((address_space(3))) bf16x8*)(kp + j * 2048); kf[2 * j + 1] = *(const __attribute__((address_space(3))) bf16x8*)(kp + j * 2048 + 512); }
__device__ __forceinline__ s16x4 vtr(lds_cptr p) { return __builtin_bit_cast(s16x4, __builtin_amdgcn_ds_read_tr16_b64_v4i16((__attribute__((address_space(3))) v4i16_t*)p)); }
__device__ __forceinline__ float rowmax(const f32x16& p0, const f32x16& p1) {
    float a = max3f(p0[0], p0[1], p1[0]), b = max3f(p0[2], p0[3], p1[1]); a = max3f(a, p1[2], p1[3]);
#pragma unroll
    for (int r = 4; r < 16; r += 4) { a = max3f(a, p0[r], p0[r + 1]); b = max3f(b, p0[r + 2], p0[r + 3]); a = max3f(a, p1[r], p1[r + 1]); b = max3f(b, p1[r + 2], p1[r + 3]); }
    const float m = max2f(a, b);
    auto rr = __builtin_amdgcn_permlane32_swap(__float_as_uint(m), __float_as_uint(m), false, false);
    return max2f(__uint_as_float(rr[0]), __uint_as_float(rr[1]));
}
__device__ __forceinline__ void pv(f32x16* o, int vb, bf16x8 pa0, bf16x8 pa1, bf16x8 pa2, bf16x8 pa3) {
#pragma unroll
    for (int d0 = 0; d0 < 2; ++d0) { s16x4 lo[4], hi[4];
#pragma unroll
        for (int ks = 0; ks < 4; ++ks) {
            asm volatile("ds_read_b64_tr_b16 %0,%1 offset:%c2" : "=&v"(lo[ks]) : "v"(vb), "i"(d0 * 4096 + ks * 1024) : "memory");
            asm volatile("ds_read_b64_tr_b16 %0,%1 offset:%c2" : "=&v"(hi[ks]) : "v"(vb), "i"(d0 * 4096 + ks * 1024 + 512) : "memory"); }
        asm volatile("s_waitcnt lgkmcnt(0)" ::: "memory"); SBAR();
#define PK(k) (bf16x8){lo[k][0], lo[k][1], lo[k][2], lo[k][3], hi[k][0], hi[k][1], hi[k][2], hi[k][3]}
        o[d0] = __builtin_amdgcn_mfma_f32_32x32x16_bf16(pa0, PK(0), o[d0], 0, 0, 0);
        o[d0] = __builtin_amdgcn_mfma_f32_32x32x16_bf16(pa1, PK(1), o[d0], 0, 0, 0);
        o[d0] = __builtin_amdgcn_mfma_f32_32x32x16_bf16(pa2, PK(2), o[d0], 0, 0, 0);
        o[d0] = __builtin_amdgcn_mfma_f32_32x32x16_bf16(pa3, PK(3), o[d0], 0, 0, 0);
#undef PK
    }
}
#define ATTN_STORE16(p, v) (*(u32x4*)(p) = (v))
template <int THRL> __device__ __forceinline__ void attn_unit(int b, int hk, int n, int pr, const bf16* QKV, bf16* O, const float* sinkp, char* shm) {
    int tid_ = threadIdx.x; asm volatile("" : "+v"(tid_));
    const int tid = tid_, lane = tid & 63, r32 = lane & 31, hi = lane >> 5; const int wid = __builtin_amdgcn_readfirstlane(tid >> 6);
    const int head = 4 * hk + 2 * pr + (wid >> 2);
    const long rowblk = (long)b * SEQ + n * 128;
    const long ctxrow = (long)NLAT + b * LCTX;
    const int nlo = n > 0 ? 2 : 0, nhi = n < (SEQ / 128 - 1) ? 2 : 0;
    const int NT = 6 + nlo + nhi;
    const bf16* Qw = QKV + (rowblk + (wid & 3) * QBLK) * PITCH + head * D;
    const bf16* Kc = QKV + 1024 + hk * D; const bf16* Vc = QKV + 1280 + hk * D;
    const unsigned lds0 = (unsigned)(uintptr_t)shm;
    float* wsf = (float*)(shm + LDS_WS) + wid * 64;
    const long klane = (long)lane * PITCH + wid * 8;
    const long vlane = (long)(16 * (wid & 3) + (lane >> 2)) * PITCH + (wid >> 2) * 32 + (lane & 3) * 8;
    const unsigned kdst = lds0 + LDS_K + wid * 1024, vdst = lds0 + LDS_V + wid * 1024;
#define TROW(t) (((t) < 2) ? (rowblk + 64 * (t)) : ((t) < 6) ? (ctxrow + 64 * ((t) - 2)) : (rowblk + ((((t) - 6) < nlo) ? (-128 + 64 * ((t) - 6)) : (128 + 64 * ((t) - 6 - nlo)))))
#define TKB(t) (((t) < 6) ? 0 : ((((t) - 6) < nlo) ? (-128 + 64 * ((t) - 6)) : (128 + 64 * ((t) - 6 - nlo))))
#define DMA_K(t, slot) glds16(Kc + TROW(t) * PITCH + klane, (unsigned)__builtin_amdgcn_readfirstlane(kdst + (slot)))
#define DMA_V(t, slot) glds16(Vc + TROW(t) * PITCH + vlane, (unsigned)__builtin_amdgcn_readfirstlane(vdst + (slot)))
    const int vb0 = (int)(lds0 + LDS_V) + ((lane >> 4) & 1) * 32 + (lane & 3) * 8 + (4 * hi + ((lane & 15) >> 2)) * 64;
    const char* Kbase = shm + LDS_K; bf16x8 kf[8];
    const lds_cptr shm3 = (lds_cptr)shm; const lds_cptr kp0 = shm3 + LDS_K + hi * 1024 + r32 * 16; const lds_cptr vp0 = shm3 + LDS_V + ((lane >> 4) & 1) * 32 + (lane & 3) * 8 + (4 * hi + ((lane & 15) >> 2)) * 64;
    DMA_K(0, 0); DMA_V(0, 0); DMA_K(1, SLOTB);
    bf16x8 qr[4];
#pragma unroll
    for (int d0 = 0; d0 < 4; ++d0) qr[d0] = *reinterpret_cast<const bf16x8*>(&Qw[(long)r32 * PITCH + d0 * 16 + hi * 8]);
    float mhat = 0.f, l_reg = 0.f; f32x16 o[2]; o[0] = f32x16{}; o[1] = f32x16{}; f32x16 negm = f32x16{}; asm volatile("" : "+v"(negm));
    const int qrel = (wid & 3) * QBLK + r32;
#define CMASK(P0, P1, t) do { int jb_ = (t) - (NT - 4); if (jb_ >= 0) bmask(P0, P1, TKB(t), qrel, hi); } while (0)
    bool resc = false;
#define START(P0, P1) do { const float rm = rowmax(P0, P1); resc = false; \
    { const float dl = rm; mhat = fadd_s(mhat, dl); \
      _Pragma("unroll") for (int r = 0; r < 16; ++r) { P0[r] = fsub_s(P0[r], dl); P1[r] = fsub_s(P1[r], dl); } \
      _Pragma("unroll") for (int r = 0; r < 16; ++r) negm[r] = -mhat; asm volatile("" : "+v"(negm)); } \
    _Pragma("unroll") for (int r = 0; r < 16; ++r) P0[r] = __builtin_amdgcn_exp2f(P0[r]); } while (0)
#define RESC() do { if (resc) { asm volatile("s_waitcnt lgkmcnt(0)" ::: "memory"); \
      _Pragma("unroll") for (int d_ = 0; d_ < 2; ++d_) _Pragma("unroll") for (int r = 0; r < 16; ++r) o[d_][r] *= wsf[crow(r, hi)]; } } while (0)
    f32x16 pA0, pA1, pB0, pB1;
    int sl_prev = 0, sl_cur = 0, sl_next = SLOTB;
#define ROT() do { sl_prev = sl_cur; sl_cur = sl_next; sl_next = (sl_next == (NSLOT - 1) * SLOTB) ? 0 : sl_next + SLOTB; } while (0)
    DMA_K(2, 2 * SLOTB);
    WAIT_BAR(3);
    qkt(pA0, pA1, Kbase, qr, negm, r32, hi); asm volatile("s_nop 15\n\ts_nop 7" : "+v"(pA0), "+v"(pA1));
    START(pA0, pA1);
    _Pragma("unroll") for (int r = 0; r < 16; ++r) pA1[r] = __builtin_amdgcn_exp2f(pA1[r]);
    WAIT_BAR(0);
    DMA_K(3, 0); DMA_V(1, SLOTB);
    ROT();
    kload8(kf, kp0 + sl_cur);
    WAIT_BAR(2);
    s16x4 vlo[8], vhi[8]; u32x4 pw0, pw1, pw2, pw3;
#define PKW(P, B) cvtpk_s(P[B], P[B + 1])
#define PAF(k) __builtin_bit_cast(bf16x8, pw##k)
#define VFR(i) (bf16x8){vlo[i][0], vlo[i][1], vlo[i][2], vlo[i][3], vhi[i][0], vhi[i][1], vhi[i][2], vhi[i][3]}
#define PIN(x) asm volatile("" : "+v"(x))
#define MX3(a, b, c) __builtin_fmaxf(__builtin_fmaxf((a), (b)), (c))
#define GAPA(MF, A0, A1, A2, A3, W0, W1, PW) do { MF; sacc += A0; sacc += A1; sacc += A2; sacc += A3; PIN(sacc); W0; W1; PIN(PW); SBAR(); } while (0)
#define EX(v) __builtin_amdgcn_exp2f(v)
#define GAPB(MF, X, B) do { MF; X[B] = EX(X[B]); X[B + 1] = EX(X[B + 1]); X[B + 2] = EX(X[B + 2]); X[B + 3] = EX(X[B + 3]); PIN(X); SBAR(); } while (0)
#define VRD(i) do { vlo[i] = vtr(vp_ + (((i) >> 2) * 4096 + ((i) & 3) * 1024)); vhi[i] = vtr(vp_ + (((i) >> 2) * 4096 + ((i) & 3) * 1024 + 512)); } while (0)
#define KRD(G, j) do { if (G) { kload2(kf, kp0 + sl_next, j); SBAR(); } } while (0)
#define STEP(C0, C1, P0, P1, t, GK, GV, GL) do { SBAR(); \
    const lds_cptr vp_ = vp0 + sl_prev; \
    VRD(0); SBAR(); float sacc = (P0[0] + P0[1]); \
    GAPA(C0 = __builtin_amdgcn_mfma_f32_32x32x16_bf16(kf[0], qr[0], negm, 0, 0, 0), P0[2], P0[3], P0[4], P0[5],     pw0[0] = PKW(P0, 0), pw0[1] = PKW(P0, 2), pw0); \
    VRD(4); SBAR(); GAPA(C1 = __builtin_amdgcn_mfma_f32_32x32x16_bf16(kf[1], qr[0], negm, 0, 0, 0), P0[6], P0[7], P0[8], P0[9],     pw0[2] = PKW(P0, 4), pw0[3] = PKW(P0, 6), pw0); \
    VRD(1); SBAR(); GAPA(C0 = __builtin_amdgcn_mfma_f32_32x32x16_bf16(kf[2], qr[1], C0, 0, 0, 0),   P0[10], P0[11], P0[12], P0[13], pw1[0] = PKW(P0, 8), pw1[1] = PKW(P0, 10), pw1); \
    VRD(5); SBAR(); GAPA(C1 = __builtin_amdgcn_mfma_f32_32x32x16_bf16(kf[3], qr[1], C1, 0, 0, 0),   P0[14], P0[15], P1[0], P1[1],   pw1[2] = PKW(P0, 12), pw1[3] = PKW(P0, 14), pw1); \
    VRD(2); SBAR(); GAPA(C0 = __builtin_amdgcn_mfma_f32_32x32x16_bf16(kf[4], qr[2], C0, 0, 0, 0),   P1[2], P1[3], P1[4], P1[5],     pw2[0] = PKW(P1, 0), pw2[1] = PKW(P1, 2), pw2); \
    VRD(6); SBAR(); GAPA(C1 = __builtin_amdgcn_mfma_f32_32x32x16_bf16(kf[5], qr[2], C1, 0, 0, 0),   P1[6], P1[7], P1[8], P1[9],     pw2[2] = PKW(P1, 4), pw2[3] = PKW(P1, 6), pw2); \
    VRD(3); SBAR(); GAPA(C0 = __builtin_amdgcn_mfma_f32_32x32x16_bf16(kf[6], qr[3], C0, 0, 0, 0),   P1[10], P1[11], P1[12], P1[13], pw3[0] = PKW(P1, 8), pw3[1] = PKW(P1, 10), pw3); \
    VRD(7); SBAR(); GAPA(C1 = __builtin_amdgcn_mfma_f32_32x32x16_bf16(kf[7], qr[3], C1, 0, 0, 0),   P1[14], P1[15], 0.f, 0.f,       pw3[2] = PKW(P1, 12), pw3[3] = PKW(P1, 14), pw3); \
    l_reg += sacc; \
    if (GK) { DMA_K((t) + 3, sl_cur); } if (GV) { DMA_V((t) + 1, sl_next); } \
    CMASK(C0, C1, t); \
    { float a = MX3(C0[0], C0[1], C1[0]), b = MX3(C0[2], C0[3], C1[1]); a = MX3(a, C1[2], C1[3]); \
      _Pragma("unroll") for (int r = 4; r < 16; r += 4) { a = MX3(a, C0[r], C0[r + 1]); b = MX3(b, C0[r + 2], C0[r + 3]); a = MX3(a, C1[r], C1[r + 1]); b = MX3(b, C1[r + 2], C1[r + 3]); } \
      float rm = __builtin_fmaxf(a, b); { auto rr = __builtin_amdgcn_permlane32_swap(__float_as_uint(rm), __float_as_uint(rm), false, false); rm = __builtin_fmaxf(__uint_as_float(rr[0]), __uint_as_float(rr[1])); } \
      resc = false; \
      if (__builtin_expect(__any(rm > (float)THRL), 0)) { const float dl = __builtin_fmaxf(rm, 0.f); mhat += dl; \
        _Pragma("unroll") for (int r = 0; r < 16; ++r) { C0[r] -= dl; C1[r] -= dl; } \
        _Pragma("unroll") for (int r = 0; r < 16; ++r) negm[r] = -mhat; asm volatile("" : "+v"(negm)); \
        const float f = __builtin_amdgcn_exp2f(-dl); l_reg *= f; if (hi == 0) wsf[r32] = f; resc = true; } } \
    SBAR(); \
    GAPB(o[0] = __builtin_amdgcn_mfma_f32_32x32x16_bf16(PAF(0), VFR(0), o[0], 0, 0, 0), C0, 0); \
    GAPB(o[1] = __builtin_amdgcn_mfma_f32_32x32x16_bf16(PAF(0), VFR(4), o[1], 0, 0, 0), C0, 4); \
    KRD(GL, 0); GAPB(o[0] = __builtin_amdgcn_mfma_f32_32x32x16_bf16(PAF(1), VFR(1), o[0], 0, 0, 0), C0, 8); \
    KRD(GL, 1); GAPB(o[1] = __builtin_amdgcn_mfma_f32_32x32x16_bf16(PAF(1), VFR(5), o[1], 0, 0, 0), C0, 12); \
    KRD(GL, 2); GAPB(o[0] = __builtin_amdgcn_mfma_f32_32x32x16_bf16(PAF(2), VFR(2), o[0], 0, 0, 0), C1, 0); \
    KRD(GL, 3); GAPB(o[1] = __builtin_amdgcn_mfma_f32_32x32x16_bf16(PAF(2), VFR(6), o[1], 0, 0, 0), C1, 4); \
    GAPB(o[0] = __builtin_amdgcn_mfma_f32_32x32x16_bf16(PAF(3), VFR(3), o[0], 0, 0, 0), C1, 8); \
    GAPB(o[1] = __builtin_amdgcn_mfma_f32_32x32x16_bf16(PAF(3), VFR(7), o[1], 0, 0, 0), C1, 12); \
    } while (0)
    int t = 1;
#undef CMASK
#define CMASK(P0, P1, t) do { } while (0)
    for (; t + 5 < NT; t += 2) {
        STEP(pB0, pB1, pA0, pA1, t, true, true, true);     WAIT_BAR(2); RESC(); ROT();
        STEP(pA0, pA1, pB0, pB1, t + 1, true, true, true); WAIT_BAR(2); RESC(); ROT();
    }
#undef CMASK
#define CMASK(P0, P1, t) do { int jb_ = (t) - (NT - 4); if (jb_ >= 0) bmask(P0, P1, TKB(t), qrel, hi); } while (0)
#define ENDW(tt) do { if ((tt) + 3 < NT) { WAIT_BAR(2); } else if ((tt) + 2 < NT) { WAIT_BAR(1); } else { WAIT_BAR(0); } } while (0)
    for (; t + 1 < NT; t += 2) {
        STEP(pB0, pB1, pA0, pA1, t, (t + 3 < NT), (t + 1 < NT), (t + 1 < NT));     ENDW(t);     RESC(); ROT();
        STEP(pA0, pA1, pB0, pB1, t + 1, (t + 4 < NT), (t + 2 < NT), (t + 2 < NT)); ENDW(t + 1); RESC(); ROT();
    }
    STEP(pB0, pB1, pA0, pA1, NT - 1, false, false, false); RESC();
    { float sacc = pB0[0] + pB0[1]; _Pragma("unroll") for (int r = 2; r < 16; ++r) sacc += pB0[r]; _Pragma("unroll") for (int r = 0; r < 16; ++r) sacc += pB1[r]; l_reg += sacc;
      pw0 = (u32x4){PKW(pB0, 0), PKW(pB0, 2), PKW(pB0, 4), PKW(pB0, 6)}; pw1 = (u32x4){PKW(pB0, 8), PKW(pB0, 10), PKW(pB0, 12), PKW(pB0, 14)}; pw2 = (u32x4){PKW(pB1, 0), PKW(pB1, 2), PKW(pB1, 4), PKW(pB1, 6)}; pw3 = (u32x4){PKW(pB1, 8), PKW(pB1, 10), PKW(pB1, 12), PKW(pB1, 14)};
      SBAR(); pv(o, vb0 + sl_cur, PAF(0), PAF(1), PAF(2), PAF(3)); }
#undef PKW
#undef PAF
#undef VFR
#undef PIN
#undef MX3
#undef GAPA
#undef GAPB
#undef EX
#undef VRD
#undef KRD
#undef STEP
#undef ENDW
    { auto rr = __builtin_amdgcn_permlane32_swap(__float_as_uint(l_reg), __float_as_uint(l_reg), false, false); l_reg = __uint_as_float(rr[0]) + __uint_as_float(rr[1]); }
    l_reg += __builtin_amdgcn_exp2f(sinkp[head] * 1.4426950408889634f - mhat);
    if (hi == 0) wsf[32 + r32] = l_reg; asm volatile("s_waitcnt lgkmcnt(0)" ::: "memory");
    float rli[16];
#pragma unroll
    for (int r = 0; r < 16; ++r) rli[r] = __builtin_amdgcn_rcpf(wsf[32 + crow(r, hi)]);
    bf16* Ow = O + (rowblk + (wid & 3) * QBLK) * OPITCH + head * D;
    { bf16* stg = (bf16*)(shm + LDS_OST) + wid * 2048;
#pragma unroll
      for (int r = 0; r < 16; ++r) { const int orow = crow(r, hi);
#pragma unroll
        for (int d0 = 0; d0 < 2; ++d0) stg[orow * 64 + d0 * 32 + r32] = __float2bfloat16(o[d0][r] * rli[r]); }
      asm volatile("s_waitcnt lgkmcnt(0)" ::: "memory");
#pragma unroll
      for (int i = 0; i < 4; ++i) { const int row = i * 8 + (lane >> 3), ch = lane & 7; const u32x4 v = *(const u32x4*)(stg + row * 64 + ch * 8); ATTN_STORE16(Ow + (long)row * OPITCH + ch * 8, v); } }
    asm volatile("s_waitcnt lgkmcnt(0)\n\ts_barrier" ::: "memory");
#undef DMA_K
#undef DMA_V
#undef TROW
#undef TKB
#undef CMASK
#undef START
#undef RESC
#undef ROT
}
#undef SBAR
#undef WAIT_BAR
}

#define XB_TMO      128
#define XB_XCNT(j)  (256  + 64 * (j))
#define XB_XSUB(j)  (1280 + 64 * (j))
#define XB_XGEN(j)  (2304 + 64 * (j))
#define XB_TOP      3328
#define XB_TOPGEN   3392
#define XCD_BAR_WORDS 3456
#define XB_SPIN_CAP (1u << 18)
__device__ __forceinline__ unsigned xb_ld(unsigned* p)              { return __hip_atomic_load(p, __ATOMIC_RELAXED, __HIP_MEMORY_SCOPE_AGENT); }
__device__ __forceinline__ unsigned xb_add(unsigned* p, unsigned v) { return __hip_atomic_fetch_add(p, v, __ATOMIC_RELAXED, __HIP_MEMORY_SCOPE_AGENT); }
__device__ __forceinline__ unsigned xb_xcc_id() { return (unsigned)__builtin_amdgcn_s_getreg((3 << 11) | 20) & 0xFu; }
#define XB_SPIN(cond, bar) do { unsigned _sp = 0; while (cond) { __builtin_amdgcn_s_sleep(1); \
    if ((++_sp & 255u) == 0u) { if (xb_ld(&(bar)[XB_TMO])) break; if (_sp > XB_SPIN_CAP) { atomicAdd(&(bar)[XB_TMO], 1u); break; } } } } while (0)
struct XcdBarrier { unsigned* bar; unsigned x; volatile LAS unsigned* st; };
__device__ __forceinline__ XcdBarrier xcd_barrier_post(unsigned* bar, volatile LAS unsigned* st) {
    XcdBarrier b; b.bar = bar; b.x = xb_xcc_id(); b.st = st;
    if (threadIdx.x == 0) (void)xb_add(&bar[XB_XCNT(b.x)], 1u);
    return b;
}
__device__ __forceinline__ void xcd_barrier_complete(unsigned* bar, unsigned x, unsigned& nloc, unsigned& nx) {
    const unsigned G = gridDim.x * gridDim.y * gridDim.z;
    unsigned sum, cnt, mine, sp = 0u;
    for (;;) {
        sum = 0u; cnt = 0u; mine = 0u;
#pragma unroll
        for (unsigned j = 0; j < 16; ++j) { const unsigned c = xb_ld(&bar[XB_XCNT(j)]); sum += c; cnt += (c > 0u) ? 1u : 0u; mine = (j == x) ? c : mine; }
        if (sum == G) break;
        __builtin_amdgcn_s_sleep(1);
        if ((++sp & 255u) == 0u) { if (xb_ld(&bar[XB_TMO])) break; if (sp > XB_SPIN_CAP) { atomicAdd(&bar[XB_TMO], 1u); break; } }
    }
    nloc = mine > 0u ? mine : 1u; nx = cnt > 0u ? cnt : 1u;
}
__device__ __forceinline__ void xcd_barrier(const XcdBarrier& b) {
    asm volatile("s_waitcnt vmcnt(0)" ::: "memory");
    __syncthreads();
    if (threadIdx.x == 0) {
        unsigned* bar = b.bar;
        __builtin_amdgcn_s_waitcnt(0);
        unsigned nloc = b.st[0], nx = b.st[1];
        if (nloc == 0u) { xcd_barrier_complete(bar, b.x, nloc, nx); b.st[0] = nloc; b.st[1] = nx; }
        const unsigned old = xb_add(&bar[XB_XSUB(b.x)], 1u);
        const unsigned gen = old / nloc;
        if (old + 1u == (gen + 1u) * nloc) {
            __builtin_amdgcn_fence(__ATOMIC_RELEASE, "agent");
            asm volatile("s_waitcnt vmcnt(0)" ::: "memory");
            const unsigned og = xb_add(&bar[XB_TOP], 1u);
            const unsigned tg = og / nx;
            if (og + 1u == (tg + 1u) * nx) xb_add(&bar[XB_TOPGEN], 1u);
            else XB_SPIN(xb_ld(&bar[XB_TOPGEN]) == tg, bar);
            __builtin_amdgcn_fence(__ATOMIC_ACQUIRE, "agent");
            xb_add(&bar[XB_XGEN(b.x)], 1u);
            asm volatile("s_waitcnt vmcnt(0)" ::: "memory");
        } else {
            XB_SPIN(xb_ld(&bar[XB_XGEN(b.x)]) == gen, bar);
            __builtin_amdgcn_fence(__ATOMIC_ACQUIRE, "agent");
            asm volatile("s_waitcnt vmcnt(0)" ::: "memory");
        }
    }
    __syncthreads();
}

#define LDS_WAIT() asm volatile("s_waitcnt lgkmcnt(0)" ::: "memory")
__device__ __forceinline__ void transpose_item(const float* W, int K, int N, bf16_t* WT, int k0, int n0, int drow0, LAS float* scr, int lane) {
    float t[32];
#pragma unroll
    for (int i = 0; i < 32; ++i) t[i] = __builtin_nontemporal_load(W + (size_t)(k0 + 2 * i + (lane >> 5)) * N + n0 + (lane & 31));
#pragma unroll
    for (int i = 0; i < 32; ++i) scr[(2 * i + (lane >> 5)) * 33 + (lane & 31)] = t[i];
    LDS_WAIT(); asm volatile("" ::: "memory");
    const int c = lane & 7;
#pragma unroll
    for (int j = 0; j < 4; ++j) { const int n = (lane >> 3) + 8 * j; const LAS float* s = scr + (8 * c) * 33 + n;
        u32x4 o; o.x = pkbf(s[0 * 33], s[1 * 33]); o.y = pkbf(s[2 * 33], s[3 * 33]); o.z = pkbf(s[4 * 33], s[5 * 33]); o.w = pkbf(s[6 * 33], s[7 * 33]);
        *(GAS u32x4*)(WT + (size_t)(drow0 + n) * K + k0 + 8 * c) = o; }
    LDS_WAIT(); asm volatile("" ::: "memory");
}
__device__ __forceinline__ void transpose_item_f8(const float* W, int K, int N, unsigned char* WT, int k0, int n0, int drow0, float scale, LAS float* scr, int lane) {
    float t[32];
#pragma unroll
    for (int i = 0; i < 32; ++i) t[i] = __builtin_nontemporal_load(W + (size_t)(k0 + 2 * i + (lane >> 5)) * N + n0 + (lane & 31));
#pragma unroll
    for (int i = 0; i < 32; ++i) scr[(2 * i + (lane >> 5)) * 33 + (lane & 31)] = t[i];
    LDS_WAIT(); asm volatile("" ::: "memory");
    const int n = lane >> 1, hf = lane & 1; const LAS float* sp = scr + (32 * hf) * 33 + n;
    u32x4 o0, o1;
    o0.x = pk4f8(sp[0 * 33] * scale, sp[1 * 33] * scale, sp[2 * 33] * scale, sp[3 * 33] * scale);     o0.y = pk4f8(sp[4 * 33] * scale, sp[5 * 33] * scale, sp[6 * 33] * scale, sp[7 * 33] * scale);
    o0.z = pk4f8(sp[8 * 33] * scale, sp[9 * 33] * scale, sp[10 * 33] * scale, sp[11 * 33] * scale);   o0.w = pk4f8(sp[12 * 33] * scale, sp[13 * 33] * scale, sp[14 * 33] * scale, sp[15 * 33] * scale);
    o1.x = pk4f8(sp[16 * 33] * scale, sp[17 * 33] * scale, sp[18 * 33] * scale, sp[19 * 33] * scale); o1.y = pk4f8(sp[20 * 33] * scale, sp[21 * 33] * scale, sp[22 * 33] * scale, sp[23 * 33] * scale);
    o1.z = pk4f8(sp[24 * 33] * scale, sp[25 * 33] * scale, sp[26 * 33] * scale, sp[27 * 33] * scale); o1.w = pk4f8(sp[28 * 33] * scale, sp[29 * 33] * scale, sp[30 * 33] * scale, sp[31 * 33] * scale);
    GAS u32x4* dst = (GAS u32x4*)(WT + (size_t)(drow0 + n) * K + k0 + 32 * hf);
    dst[0] = o0; dst[1] = o1;
    LDS_WAIT(); asm volatile("" ::: "memory");
}
__device__ __forceinline__ unsigned pk4i8(float a, float b, float c, float d) {
    const int ia = (int)__builtin_rintf(a), ib = (int)__builtin_rintf(b), ic = (int)__builtin_rintf(c), id = (int)__builtin_rintf(d);
    return (unsigned)(ia & 255) | ((unsigned)(ib & 255) << 8) | ((unsigned)(ic & 255) << 16) | ((unsigned)(id & 255) << 24); }
__device__ __forceinline__ void transpose_item_i8(const float* W, int K, int N, unsigned char* WT, int k0, int n0, int drow0, float scale, LAS float* scr, int lane) {
    float t[32];
#pragma unroll
    for (int i = 0; i < 32; ++i) t[i] = W[(size_t)(k0 + 2 * i + (lane >> 5)) * N + n0 + (lane & 31)];
#pragma unroll
    for (int i = 0; i < 32; ++i) scr[(2 * i + (lane >> 5)) * 33 + (lane & 31)] = t[i];
    LDS_WAIT(); asm volatile("" ::: "memory");
    const int n = lane >> 1, hf = lane & 1; const LAS float* sp = scr + (32 * hf) * 33 + n;
    u32x4 o0, o1;
    o0.x = pk4i8(sp[0 * 33] * scale, sp[1 * 33] * scale, sp[2 * 33] * scale, sp[3 * 33] * scale);     o0.y = pk4i8(sp[4 * 33] * scale, sp[5 * 33] * scale, sp[6 * 33] * scale, sp[7 * 33] * scale);
    o0.z = pk4i8(sp[8 * 33] * scale, sp[9 * 33] * scale, sp[10 * 33] * scale, sp[11 * 33] * scale);   o0.w = pk4i8(sp[12 * 33] * scale, sp[13 * 33] * scale, sp[14 * 33] * scale, sp[15 * 33] * scale);
    o1.x = pk4i8(sp[16 * 33] * scale, sp[17 * 33] * scale, sp[18 * 33] * scale, sp[19 * 33] * scale); o1.y = pk4i8(sp[20 * 33] * scale, sp[21 * 33] * scale, sp[22 * 33] * scale, sp[23 * 33] * scale);
    o1.z = pk4i8(sp[24 * 33] * scale, sp[25 * 33] * scale, sp[26 * 33] * scale, sp[27 * 33] * scale); o1.w = pk4i8(sp[28 * 33] * scale, sp[29 * 33] * scale, sp[30 * 33] * scale, sp[31 * 33] * scale);
    GAS u32x4* dst = (GAS u32x4*)(WT + (size_t)(drow0 + n) * K + k0 + 32 * hf);
    dst[0] = o0; dst[1] = o1;
    LDS_WAIT(); asm volatile("" ::: "memory");
}
__device__ __forceinline__ void sincos_d(double x, double& s, double& c) {
    const double TWO_PI = 6.283185307179586476925;
    const double k = __builtin_rint(x / TWO_PI); const double r = x - k * TWO_PI;
    const double r2 = r * r; double ts = r, tc = 1.0; s = r; c = 1.0;
    for (int i = 1; i <= 16; ++i) { tc *= -r2 / (double)((2 * i - 1) * (2 * i)); ts *= -r2 / (double)((2 * i) * (2 * i + 1)); c += tc; s += ts; }
}

constexpr int CI_F = 16 * 112, CI_FD = 56 * 32, MOE_ITEMS = 8 * (2 * CI_F + CI_FD);
constexpr int MOE_TAIL_A = 12000, MOE_TAIL_B = 7000, MOE_TAIL_C = 12000, MOE_TAIL_TOTAL = MOE_TAIL_A + MOE_TAIL_B + MOE_TAIL_C;
__device__ __forceinline__ void moe_convert_item(int r, const float* wg, const float* wu, const float* wd, unsigned char* mgu, unsigned char* md, LAS float* scr, int lane) {
    const int e = r / (2 * CI_F + CI_FD); int q = r % (2 * CI_F + CI_FD);
    if (q < 2 * CI_F) { const int up = q / CI_F; q %= CI_F; const int kb = q / 112, nb = q % 112, n0 = 32 * nb;
        transpose_item_f8((up ? wu : wg) + (size_t)e * 1024 * DFF, 1024, DFF, mgu + (size_t)e * 7168 * 1024, 64 * kb, n0, 256 * (n0 >> 7) + 128 * up + (n0 & 127), MOE_SGU, scr, lane); }
    else { q -= 2 * CI_F; const int kb = q / 32, nb = q % 32; transpose_item_f8(wd + (size_t)e * DFF * 1024, DFF, 1024, md + (size_t)e * 1024 * DFF, 64 * kb, 32 * nb, 32 * nb, MOE_SD, scr, lane); }
}
__device__ __forceinline__ void moe_convert_tail(int nunits, int G, int bx, int first, int count, const float* wg, const float* wu, const float* wd, unsigned char* mgu, unsigned char* md, LAS unsigned char* lds) {
    const int busy = nunits % G; if (busy == 0 || bx < busy) return;
    int tid_ = threadIdx.x; asm volatile("" : "+v"(tid_)); const int lane = tid_ & 63, wave = __builtin_amdgcn_readfirstlane(tid_ >> 6);
    LAS float* scr = (LAS float*)(lds + wave * 16384);
    const int nw = (G - busy) * 8, w = (bx - busy) * 8 + wave;
    for (int it = w; it < count; it += nw) moe_convert_item(first + it, wg, wu, wd, mgu, md, scr, lane);
}

struct Args { const float* in[24]; float* out; unsigned char* ws; int ph_lo, ph_hi, li, pad; };
constexpr int NPH = 18;

__device__ __forceinline__ void norm_store(const f32x4 (&v)[4], float ssum, const float* g, const float* mrow, int shc, int scc, bf16_t* XNo, size_t m, int lane, float* rsc) {
    const float rstd = 1.0f / __builtin_sqrtf(ssum * (1.0f / DM) + EPS);
    f32x4 y[4];
#pragma unroll
    for (int j = 0; j < 4; ++j) { const f32x4 gv = *(const f32x4*)(g + 4 * lane + 256 * j), sc = *(const f32x4*)(mrow + scc * 1024 + 4 * lane + 256 * j), sh = *(const f32x4*)(mrow + shc * 1024 + 4 * lane + 256 * j);
        y[j] = (v[j] * rstd) * gv * (sc + 1.0f) + sh; }
    if (rsc == nullptr) {
#pragma unroll
        for (int j = 0; j < 4; ++j) { u32x2 w; w.x = pkbf(y[j].x, y[j].y); w.y = pkbf(y[j].z, y[j].w); *((GAS u32x2*)(XNo + m * DM) + lane + 64 * j) = w; }
    } else {
        float mx = 0.f;
#pragma unroll
        for (int j = 0; j < 4; ++j) mx = __builtin_fmaxf(__builtin_fmaxf(mx, __builtin_fmaxf(__builtin_fabsf(y[j].x), __builtin_fabsf(y[j].y))), __builtin_fmaxf(__builtin_fabsf(y[j].z), __builtin_fabsf(y[j].w)));
#pragma unroll
        for (int o = 1; o < 64; o <<= 1) mx = __builtin_fmaxf(mx, __shfl_xor(mx, o));
        mx = __builtin_fmaxf(mx, 1e-20f); const float qs = 127.0f / mx;
#pragma unroll
        for (int j = 0; j < 4; ++j) *((GAS unsigned*)((unsigned char*)XNo + m * DM) + lane + 64 * j) = pk4i8(y[j].x * qs, y[j].y * qs, y[j].z * qs, y[j].w * qs);
        if (lane == 0) rsc[m] = mx * (1.0f / 127.0f);
    }
}
template <bool SRC_BF16> __device__ __forceinline__ void norm_rows(const void* srcLv, const float* srcC, int nrows, const float* g, const float* mod, int shc, int scc, bf16_t* XNo, int gw, int NGW, int lane,
                                          const float* part, int nS, const float* gatec, float* zout, float* rsc = nullptr) {
    if (nrows > NLAT) {
        for (int rc = gw; rc < NCTXR; rc += NGW) {
            const GAS f32x4* xr = (const GAS f32x4*)(srcC + (size_t)rc * DM) + lane;
            f32x4 v[4];
#pragma unroll
            for (int j = 0; j < 4; ++j) v[j] = xr[64 * j];
            if (part != nullptr) {
                f32x4 a[4];
#pragma unroll
                for (int j = 0; j < 4; ++j) a[j] = (f32x4){0.f, 0.f, 0.f, 0.f};
                for (int s0 = 0; s0 < nS; s0 += 7) {
                    f32x4 t[7][4];
#pragma unroll
                    for (int q = 0; q < 7; ++q) { const int s2 = (s0 + q < nS) ? s0 + q : s0; const GAS f32x4* pr = (const GAS f32x4*)(part + ((size_t)s2 * NCTXR + rc) * DM) + lane;
#pragma unroll
                        for (int j = 0; j < 4; ++j) t[q][j] = pr[64 * j]; }
#pragma unroll
                    for (int q = 0; q < 7; ++q) if (s0 + q < nS) {
#pragma unroll
                        for (int j = 0; j < 4; ++j) a[j] += t[q][j]; }
                }
#pragma unroll
                for (int j = 0; j < 4; ++j) v[j] += *(const f32x4*)(gatec + 4 * lane + 256 * j) * a[j];
                if (zout != nullptr) { GAS f32x4* zr = (GAS f32x4*)(zout + (size_t)rc * DM) + lane;
#pragma unroll
                    for (int j = 0; j < 4; ++j) zr[64 * j] = v[j]; }
            }
            float ss = 0.f;
#pragma unroll
            for (int j = 0; j < 4; ++j) ss += (v[j].x * v[j].x + v[j].y * v[j].y) + (v[j].z * v[j].z + v[j].w * v[j].w);
            norm_store(v, wave_sum(ss), g, mod + (size_t)4 * 6144, shc, scc, XNo, (size_t)NLAT + rc, lane, rsc);
        }
    }
    for (int m0 = gw * 4; m0 < NLAT; m0 += NGW * 4) {
        const int mb = m0 >> 13;
        f32x4 v[4][4];
        if constexpr (SRC_BF16) { const GAS u32x2* xr = (const GAS u32x2*)((const bf16_t*)srcLv + (size_t)m0 * DM) + lane;
#pragma unroll
            for (int r = 0; r < 4; ++r)
#pragma unroll
                for (int j = 0; j < 4; ++j) { const u32x2 w = xr[r * 256 + 64 * j]; v[r][j] = (f32x4){__uint_as_float(w.x << 16), __uint_as_float(w.x & 0xffff0000u), __uint_as_float(w.y << 16), __uint_as_float(w.y & 0xffff0000u)}; } }
        else { const GAS f32x4* xr = (const GAS f32x4*)((const float*)srcLv + (size_t)m0 * DM) + lane;
#pragma unroll
            for (int r = 0; r < 4; ++r)
#pragma unroll
                for (int j = 0; j < 4; ++j) v[r][j] = xr[r * 256 + 64 * j]; }
        float ss[4];
#pragma unroll
        for (int r = 0; r < 4; ++r) { ss[r] = 0.f;
#pragma unroll
            for (int j = 0; j < 4; ++j) ss[r] += (v[r][j].x * v[r][j].x + v[r][j].y * v[r][j].y) + (v[r][j].z * v[r][j].z + v[r][j].w * v[r][j].w); }
#pragma unroll
        for (int o = 1; o < 64; o <<= 1) {
#pragma unroll
            for (int r = 0; r < 4; ++r) ss[r] += __shfl_xor(ss[r], o); }
#pragma unroll
        for (int r = 0; r < 4; ++r) norm_store(v[r], ss[r], g, mod + (size_t)mb * 6144, shc, scc, XNo, (size_t)(m0 + r), lane, rsc);
    }
}

__global__ void __launch_bounds__(512, 2) fwd(Args args) {
    extern __shared__ __attribute__((aligned(16))) unsigned char lds_raw[];
    LAS unsigned char* lds = (LAS unsigned char*)lds_raw;
    volatile LAS unsigned* MISC = (volatile LAS unsigned*)(lds + MISC_OFF);
    LAS int* gtab = (LAS int*)(lds + GTAB_OFF);
    const int G = gridDim.x; const int bx = blockIdx.x; const int vcu = (G % 8 == 0) ? (bx % 8) * (G / 8) + bx / 8 : bx;
    const int NGW = G * 8;
#define PHASE_IDS() int tid_ = threadIdx.x; asm volatile("" : "+v"(tid_)); const int tid = tid_, lane = tid & 63, wave = __builtin_amdgcn_readfirstlane(tid >> 6), gw = vcu * 8 + wave; (void)lane; (void)gw
    unsigned char* ws = args.ws;
    gu32* ctl = (gu32*)(ws + WS_CTL);
#define MOD ((float*)(ws + WS_MOD))
#define ROPE ((float*)(ws + WS_ROPE))
#define STATS ((float*)(ws + WS_STATS))
#define RSC ((float*)(ws + WS_RSC))
#define LIST ((int*)(ws + WS_LIST))
#define TINFO ((int*)(ws + WS_TINFO))
#define WSB ((bf16_t*)(ws + WS_WS))
#define WIN ((bf16_t*)(ws + WS_WIN))
#define WAO ((bf16_t*)(ws + WS_WAO))
#define WQKV ((bf16_t*)(ws + WS_WQKV))
#define WBO ((bf16_t*)(ws + WS_WBO))
#define WGU ((unsigned char*)(ws + WS_WGU))
#define WD ((bf16_t*)(ws + WS_WD))
#define MGU ((unsigned char*)(ws + WS_MGU))
#define MD ((unsigned char*)(ws + WS_MD))
#define XN8 ((unsigned char*)(ws + WS_XN))
#define XN ((bf16_t*)(ws + WS_XN))
#define ZB ((float*)(ws + WS_ZB))
#define UVT ((bf16_t*)(ws + WS_UVT))
#define A2 ((bf16_t*)(ws + WS_A2))
#define HB ((bf16_t*)(ws + WS_H))
#define QKV ((bf16_t*)(ws + WS_QKV))
#define OB ((bf16_t*)(ws + WS_O))
#define YB ((bf16_t*)(ws + WS_Y))
#define HC ((unsigned char*)(ws + WS_HC))
#define YP ((bf16_t*)(ws + WS_YP))
#define PART1 ((float*)(ws + WS_PART1))
#define PART2 ((float*)(ws + WS_PART2))
#define I_X (args.in[0])
#define I_C (args.in[1])
#define I_CTX (args.in[2])
#define I_CCTX (args.in[3])
#define I_ADAW (args.in[4])
#define I_ADAB (args.in[5])
#define I_NORMG (args.in[6])
#define I_FINALG (args.in[7])
#define HL ((bf16_t*)(ws + WS_HLB))

    { PHASE_IDS(); for (int u = tid; u < (LDS_BYTES - MISC_OFF) / 4; u += 512) ((LAS unsigned*)(lds + MISC_OFF))[u] = 0u; }
    __syncthreads();
    const int lo = args.ph_lo, hi_ph = args.ph_hi;
    const bool one_launch = (hi_ph - lo) > 1;
    XcdBarrier bar; bar.bar = (unsigned*)(ctl + CW_BAR) + args.li * XCD_BAR_WORDS; bar.x = 0; bar.st = nullptr;
    if (one_launch) bar = xcd_barrier_post((unsigned*)(ctl + CW_BAR) + args.li * XCD_BAR_WORDS, MISC + 8);
#ifndef PHMASK
#define PHMASK 0xFFFFFFFFu
#endif
#define IN(k) (((PHMASK >> (k)) & 1) && lo <= (k) && (k) < hi_ph)
#define BOTH(k) (IN(k) && IN((k) + 1))
#define GRID_BAR() xcd_barrier(bar)
#if defined(PROBE_LO)
    unsigned long long tpA = __builtin_amdgcn_s_memrealtime(), tpB = 0;
#define PROBE_MARK(k) do { if ((k) == PROBE_LO - 1) tpA = __builtin_amdgcn_s_memrealtime(); if ((k) == PROBE_HI) tpB = __builtin_amdgcn_s_memrealtime(); } while (0)
#else
#define PROBE_MARK(k) do { } while (0)
#endif

    if (IN(0)) {
        PHASE_IDS();
        {
            LAS float* sv = (LAS float*)lds;
            LAS float* red = (LAS float*)(lds + 5 * 1024 * 4);
            if (bx < 192) {
                for (int idx = tid; idx < 5 * 1024; idx += 512) { const int r = idx >> 10, k = idx & 1023; const float cv = r < 4 ? I_C[r * 1024 + k] : I_CCTX[k]; sv[idx] = cv / (1.0f + __expf(-cv)); }
                __syncthreads();
                for (int item = bx; item < 192; item += G) {
                    const int i = item / 96, n0 = (item % 96) * 64, nn = tid & 63, kq = tid >> 6;
                    float a0 = 0.f, a1 = 0.f, a2 = 0.f, a3 = 0.f, a4 = 0.f;
                    const float* wp = I_ADAW + ((size_t)i * 1024 + kq * 128) * 6144 + n0 + nn;
#pragma unroll 8
                    for (int k = 0; k < 128; ++k) { const float w = wp[(size_t)k * 6144]; const int kk = kq * 128 + k;
                        a0 += sv[kk] * w; a1 += sv[1024 + kk] * w; a2 += sv[2048 + kk] * w; a3 += sv[3072 + kk] * w; a4 += sv[4096 + kk] * w; }
                    red[(kq * 5 + 0) * 64 + nn] = a0; red[(kq * 5 + 1) * 64 + nn] = a1; red[(kq * 5 + 2) * 64 + nn] = a2; red[(kq * 5 + 3) * 64 + nn] = a3; red[(kq * 5 + 4) * 64 + nn] = a4;
                    __syncthreads();
                    if (tid < 320) { const int r = tid >> 6; float s = I_ADAB[i * 6144 + n0 + nn];
#pragma unroll
                        for (int q = 0; q < 8; ++q) s += red[(q * 5 + r) * 64 + nn];
                        MOD[((size_t)i * 5 + r) * 6144 + n0 + nn] = s; }
                    __syncthreads();
                }
            }
            __syncthreads();
        }
        {
            LAS float* scr = (LAS float*)(lds + wave * 16384);
            constexpr int I_IN = 16 * 64, I_AO = 16 * 32, I_QKV = 16 * 48, I_BO = 16 * 32, I_F = 16 * 112, I_FD = 56 * 32;
            constexpr int I_DENSE = I_IN + I_AO + I_QKV + I_BO + 2 * I_F + I_FD, I_MOE = MOE_ITEMS, I_WS = 128, I_ROPE = 32;
            constexpr int NITEMS = I_DENSE + I_MOE + I_WS + I_ROPE;
            for (int it = gw; it < NITEMS; it += NGW) {
                int r = it;
                if (r < I_IN) { const int kb = r / 64, nb = r % 64; transpose_item(args.in[8], 1024, 2048, WIN, 64 * kb, 32 * nb, 32 * nb, scr, lane); continue; } r -= I_IN;
                if (r < I_AO) { const int kb = r / 32, nb = r % 32; transpose_item(args.in[13], 1024, 1024, WAO, 64 * kb, 32 * nb, 32 * nb, scr, lane); continue; } r -= I_AO;
                if (r < I_QKV) { const int kb = r / 48, nb = r % 48; transpose_item(args.in[14], 1024, 1536, WQKV, 64 * kb, 32 * nb, 32 * nb, scr, lane); continue; } r -= I_QKV;
                if (r < I_BO) { const int kb = r / 32, nb = r % 32; transpose_item(args.in[16], 1024, 1024, WBO, 64 * kb, 32 * nb, 32 * nb, scr, lane); continue; } r -= I_BO;
                if (r < 2 * I_F) { const int up = r / I_F; const int q = r % I_F; const int kb = q / 112, nb = q % 112;
                    const float* W = args.in[17 + up]; float mx = 0.f;
#pragma unroll
                    for (int i = 0; i < 32; ++i) mx = __builtin_fmaxf(mx, __builtin_fabsf(W[(size_t)(64 * kb + 2 * i + (lane >> 5)) * DFF + 32 * nb + (lane & 31)]));
#pragma unroll
                    for (int o = 1; o < 64; o <<= 1) mx = __builtin_fmaxf(mx, __shfl_xor(mx, o));
                    if (lane == 0) __hip_atomic_fetch_max((unsigned*)(ctl + CW_WAMAX + 64 * up), __float_as_uint(mx), __ATOMIC_RELAXED, __HIP_MEMORY_SCOPE_AGENT);
                    continue; } r -= 2 * I_F;
                if (r < I_FD) { const int kb = r / 32, nb = r % 32; transpose_item(args.in[19], DFF, 1024, WD, 64 * kb, 32 * nb, 32 * nb, scr, lane); continue; } r -= I_FD;
                if (r < I_MOE) { if (r >= MOE_TAIL_TOTAL) moe_convert_item(r, args.in[21], args.in[22], args.in[23], MGU, MD, scr, lane); continue; } r -= I_MOE;
                if (r < I_WS) { const float* src = args.in[11] + (size_t)r * 2048;
#pragma unroll
                    for (int j = 0; j < 8; ++j) { const f32x4 v = *(const f32x4*)(src + j * 256 + lane * 4); u32x2 w; w.x = pkbf(v.x, v.y); w.y = pkbf(v.z, v.w); *(u32x2*)(WSB + (size_t)r * 2048 + j * 256 + lane * 4) = w; }
                    continue; } r -= I_WS;
                {
                    const int ent = r * 64 + lane; const int pos = ent >> 4, i = ent & 15;
                    double inv = 1.0; for (int q = 0; q < i; ++q) inv *= 0.56234132519034908;
                    const float ang = (float)pos * (float)inv; double s, c; sincos_d((double)ang, s, c);
                    ROPE[ent] = (float)c; ROPE[2048 + ent] = (float)s;
                }
            }
        }
        if (BOTH(0)) GRID_BAR(); PROBE_MARK(0);
    }
    if (IN(1)) { PHASE_IDS();
        {
            LAS float* scr = (LAS float*)(lds + wave * 16384);
            const float ag = __uint_as_float(__hip_atomic_load((unsigned*)(ctl + CW_WAMAX), __ATOMIC_RELAXED, __HIP_MEMORY_SCOPE_AGENT)), au = __uint_as_float(__hip_atomic_load((unsigned*)(ctl + CW_WAMAX + 64), __ATOMIC_RELAXED, __HIP_MEMORY_SCOPE_AGENT));
            if (gw == 0 && lane == 0) { RSC[MALL] = ag * (1.0f / 127.0f); RSC[MALL + 1] = au * (1.0f / 127.0f); }
            for (int it = gw; it < 2 * 16 * 112; it += NGW) { const int up = it / (16 * 112), q = it % (16 * 112), kb = q / 112, nb = q % 112, n0 = 32 * nb;
                transpose_item_i8(args.in[17 + up], 1024, DFF, WGU, 64 * kb, n0, 256 * (n0 >> 7) + 128 * up + (n0 & 127), 127.0f / (up ? au : ag), scr, lane); }
        }
        norm_rows<false>(I_X, I_CTX, MALL, I_NORMG + 0 * 1024, MOD, 0, 1, XN, gw, NGW, lane, nullptr, 0, nullptr, nullptr); if (BOTH(1)) GRID_BAR(); PROBE_MARK(1); }
    if (IN(2)) {
        pg8::DenseSched S{(const char*)WIN, (const char*)XN, 8, NPA, G, bx, (size_t)256 * 1024 * 2};
        pg8::EpiGeluT E{UVT, STATS};
        pg8::gemm_phase<pg8::EpiGeluT, pg8::DenseSched, true, false>(lds, gtab, 1024, 16, S, E);
        moe_convert_tail(8 * NPA, G, bx, 0, MOE_TAIL_A, args.in[21], args.in[22], args.in[23], MGU, MD, lds);
        if (BOTH(2)) GRID_BAR(); PROBE_MARK(2);
    }
    if (IN(3)) {
        PHASE_IDS();
        const float* vg = args.in[9]; const float* vb = args.in[10]; const float* bs = args.in[12];
        LAS unsigned char* buf = lds + wave * 16384;
        LAS float* mu_l = (LAS float*)(lds + RING_BYTES + 4096 + wave * 1024); LAS float* rs_l = mu_l + 128;
        const int r32 = lane & 31, h = lane >> 5;
        for (int unit = gw; unit < (MALL / 128) * 32; unit += NGW) {
            const int ph = unit & 1, g = (unit >> 1) & 15, ch = unit >> 5, q0 = ch * 128;
#pragma unroll
            for (int tt = 0; tt < 2; ++tt) { const int tok = q0 + lane * 2 + tt; const f32x4* sp = (const f32x4*)(STATS + (size_t)tok * 16);
                const f32x4 a = sp[0], b = sp[1], c = sp[2], d = sp[3];
                const float sum = (a.x + a.z) + (b.x + b.z) + (c.x + c.z) + (d.x + d.z), sq = (a.y + a.w) + (b.y + b.w) + (c.y + c.w) + (d.y + d.w);
                const float mean = sum * (1.0f / 1024.0f), var = sq * (1.0f / 1024.0f) - mean * mean;
                mu_l[lane * 2 + tt] = mean; rs_l[lane * 2 + tt] = 1.0f / __builtin_sqrtf(var + EPS); }
            {
                u32x4 t[16]; const int rw = lane >> 4, ck = lane & 15;
                const bf16_t* vp = UVT + (size_t)(1024 + 64 * g + rw) * MALL + q0 + ck * 8;
#pragma unroll
                for (int i = 0; i < 16; ++i) { t[i] = *(const u32x4*)vp; vp += (size_t)4 * MALL; asm volatile("" : "+v"(vp)); }
#pragma unroll
                for (int i = 0; i < 16; ++i) { const int row = 4 * i + rw; *(LAS u32x4*)(buf + row * 256 + ((ck ^ (row & 15)) << 4)) = t[i]; }
            }
            bf16x8 af[2][8];
#pragma unroll
            for (int ct = 0; ct < 2; ++ct) { const int row = 32 * ct + r32; const float vgc = vg[64 * g + row], vbc = vb[64 * g + row];
#pragma unroll
                for (int s2 = 0; s2 < 8; ++s2) { const int qs = 16 * s2 + 8 * h, ck = 2 * s2 + h;
                    const f32x4 m0 = *(const LAS f32x4*)(mu_l + qs), m1 = *(const LAS f32x4*)(mu_l + qs + 4), r0 = *(const LAS f32x4*)(rs_l + qs), r1 = *(const LAS f32x4*)(rs_l + qs + 4);
                    const bf16x8 raw = *(const LAS bf16x8*)(buf + row * 256 + ((ck ^ (row & 15)) << 4));
                    float y[8];
#pragma unroll
                    for (int j = 0; j < 4; ++j) { y[j] = (bf2f((unsigned short)raw[j]) - m0[j]) * r0[j] * vgc + vbc; y[4 + j] = (bf2f((unsigned short)raw[4 + j]) - m1[j]) * r1[j] * vgc + vbc; }
                    u32x4 w; w.x = pkbf(y[0], y[1]); w.y = pkbf(y[2], y[3]); w.z = pkbf(y[4], y[5]); w.w = pkbf(y[6], y[7]); af[ct][s2] = __builtin_bit_cast(bf16x8, w); } }
            {
                u32x4 t[8]; const int rw = lane >> 3, ck = lane & 7;
                const bf16_t* up = UVT + (size_t)(64 * g + rw) * MALL + q0 + 64 * ph + ck * 8;
#pragma unroll
                for (int i = 0; i < 8; ++i) { t[i] = *(const u32x4*)up; up += (size_t)8 * MALL; asm volatile("" : "+v"(up)); }
#pragma unroll
                for (int i = 0; i < 8; ++i) { const int row = 8 * i + rw; *(LAS u32x4*)(buf + row * 128 + ((ck ^ (row & 7)) << 4)) = t[i]; }
            }
#pragma unroll
            for (int ptl = 0; ptl < 2; ++ptl) {
                const int pl = 32 * ptl + r32, p = 64 * ph + pl; const float bsv = bs[g * 128 + p];
                bf16x8 bfr[8];
#pragma unroll
                for (int s2 = 0; s2 < 8; ++s2) bfr[s2] = *(const bf16x8*)(WSB + (size_t)(g * 128 + p) * 128 + 16 * s2 + 8 * h);
                f32x16 acc[2]; acc[0] = f32x16{}; acc[1] = f32x16{};
#pragma unroll
                for (int s2 = 0; s2 < 8; ++s2)
#pragma unroll
                    for (int ct = 0; ct < 2; ++ct) acc[ct] = __builtin_amdgcn_mfma_f32_32x32x16_bf16(af[ct][s2], bfr[s2], acc[ct], 0, 0, 0);
#pragma unroll
                for (int ct = 0; ct < 2; ++ct)
#pragma unroll
                    for (int rr = 0; rr < 4; ++rr) { const int c = 32 * ct + 8 * rr + 4 * h; float o[4];
#pragma unroll
                        for (int e = 0; e < 4; ++e) { const int cc = c + e; const float uu = bf2f(*(const LAS unsigned short*)(buf + cc * 128 + (((pl >> 3) ^ (cc & 7)) << 4) + (pl & 7) * 2)); o[e] = uu * (acc[ct][4 * rr + e] + bsv); }
                        u32x2 w; w.x = pkbf(o[0], o[1]); w.y = pkbf(o[2], o[3]);
                        *(LAS u32x2*)(buf + 8192 + pl * 128 + (((c >> 3) ^ (pl & 7)) << 4) + (c & 7) * 2) = w; }
            }
            {
                const int rw = lane >> 3, ck = lane & 7;
#pragma unroll
                for (int i = 0; i < 8; ++i) { const int row = 8 * i + rw; const u32x4 v = *(const LAS u32x4*)(buf + 8192 + row * 128 + ((ck ^ (row & 7)) << 4));
                    *(u32x4*)(A2 + (size_t)(q0 + 64 * ph + row) * DM + 64 * g + ck * 8) = v; }
            }
        }
        if (BOTH(3)) GRID_BAR(); PROBE_MARK(3);
    }
    if (IN(4)) {
        { pg8::DenseSched S{(const char*)A2, (const char*)WAO, NPL, 4, G, bx, (size_t)256 * 1024 * 2};
          pg8::EpiResid<true> E{I_X, nullptr, HL, MOD + 2 * 1024};
          pg8::gemm_phase<pg8::EpiResid<true>, pg8::DenseSched, true, false>(lds, gtab, 1024, 16, S, E); }
        { pg8::SplitSched S{(const char*)(A2 + (size_t)NLAT * DM), (const char*)WAO, 4, 4, P3_NS, G, bx, NPL, (size_t)256 * 1024 * 2, (size_t)(1024 / P3_NS) * 2};
          pg8::EpiPartF32 E{PART1, (size_t)NCTXR * DM};
          pg8::gemm_phase<pg8::EpiPartF32, pg8::SplitSched, true, false>(lds, gtab, 1024, 1024 / P3_NS / 64, S, E); }
        if (BOTH(4)) GRID_BAR(); PROBE_MARK(4);
    }
    if (IN(5)) { PHASE_IDS(); norm_rows<true>(HL, I_CTX, MALL, I_NORMG + 1 * 1024, MOD, 3, 4, XN, gw, NGW, lane, PART1, P3_NS, MOD + 4 * 6144 + 2 * 1024, ZB, RSC); if (BOTH(5)) GRID_BAR(); PROBE_MARK(5); }
    if (IN(6)) {
        pg8::DenseSched S{(const char*)XN8, (const char*)WGU, NPA, 28, G, bx, (size_t)256 * 1024};
        pg8::EpiSwiGLUI8 E{HB, RSC, RSC + MALL};
        pg8::gemm_phase<pg8::EpiSwiGLUI8, pg8::DenseSched, true, false, false, true>(lds, gtab, 512, 8, S, E);
        moe_convert_tail(NPA * 28, G, bx, MOE_TAIL_A, MOE_TAIL_B, args.in[21], args.in[22], args.in[23], MGU, MD, lds);
        if (BOTH(6)) GRID_BAR(); PROBE_MARK(6);
    }
    if (IN(7)) {
        { pg8::DenseSched S{(const char*)HB, (const char*)WD, NPL, 4, G, bx, (size_t)256 * DFF * 2};
          pg8::EpiResid<false> E{nullptr, HL, HL, MOD + 5 * 1024};
          pg8::gemm_phase<pg8::EpiResid<false>, pg8::DenseSched, true, false>(lds, gtab, DFF, 56, S, E); }
        { pg8::SplitSched S{(const char*)(HB + (size_t)NLAT * DFF), (const char*)WD, 4, 4, P5_NS, G, bx, NPL, (size_t)256 * DFF * 2, (size_t)(DFF / P5_NS) * 2};
          pg8::EpiPartF32 E{PART2, (size_t)NCTXR * DM};
          pg8::gemm_phase<pg8::EpiPartF32, pg8::SplitSched, true, false>(lds, gtab, DFF, DFF / P5_NS / 64, S, E); }
        if (BOTH(7)) GRID_BAR(); PROBE_MARK(7);
    }
    if (IN(8)) { PHASE_IDS(); norm_rows<true>(HL, ZB, MALL, I_NORMG + 2 * 1024, MOD + 5 * 6144, 0, 1, XN, gw, NGW, lane, PART2, P5_NS, MOD + 4 * 6144 + 5 * 1024, nullptr); if (BOTH(8)) GRID_BAR(); PROBE_MARK(8); }
    if (IN(9)) {
        pg8::DenseSched S{(const char*)XN, (const char*)WQKV, NPA, 6, G, bx, (size_t)256 * 1024 * 2};
        pg8::EpiQKV E{QKV, ROPE, ROPE + 2048, attn_body::C2};
        pg8::gemm_phase<pg8::EpiQKV, pg8::DenseSched, true, false>(lds, gtab, 1024, 16, S, E);
        moe_convert_tail(NPA * 6, G, bx, MOE_TAIL_A + MOE_TAIL_B, MOE_TAIL_C, args.in[21], args.in[22], args.in[23], MGU, MD, lds);
        if (BOTH(9)) GRID_BAR(); PROBE_MARK(9);
    }
    if (IN(10)) {
        static_assert(attn_body::LDS_BYTES_A <= RING_BYTES, "attention LDS");
        const float* sinkp = args.in[15];
        for (int i = 0;; ++i) { const int uid = i * G + vcu; if (uid >= NB * 64 * 4 * 2) break;
            const int pr = uid & 1, hk = (uid >> 1) & 3, n = (uid >> 3) & 63, b = uid >> 9;
            attn_body::attn_unit<8>(b, hk, n, pr, (const attn_body::bf16*)QKV, (attn_body::bf16*)OB, sinkp, (char*)lds_raw); }
        if (BOTH(10)) GRID_BAR(); PROBE_MARK(10);
    }
    if (IN(11)) {
        pg8::DenseSched S{(const char*)OB, (const char*)WBO, NPL, 4, G, bx, (size_t)256 * 1024 * 2};
        pg8::EpiResid<false> E{nullptr, HL, HL, MOD + 5 * 6144 + 2 * 1024};
        pg8::gemm_phase<pg8::EpiResid<false>, pg8::DenseSched, true, false>(lds, gtab, 1024, 16, S, E);
        if (BOTH(11)) GRID_BAR(); PROBE_MARK(11);
    }
    if (IN(12)) {
        PHASE_IDS();
        const float* g = I_NORMG + 3 * 1024; const float* mod = MOD + 5 * 6144; const float* wrt = args.in[20];
        LAS int* l_e = (LAS int*)lds;
        LAS float* l_w = (LAS float*)(lds + 1024);
        LAS int* l_cnt = (LAS int*)(lds + 2048);
        LAS int* l_base = (LAS int*)(lds + 2048 + 64);
        for (int blk = bx; blk < NLAT / 128; blk += G) {
            if (tid < 8) l_cnt[tid] = 0;
            __syncthreads();
            const int mb = (blk * 128) >> 13; const float* mrow = mod + (size_t)mb * 6144;
            for (int i4 = 0; i4 < 8; ++i4) {
                const int tl0 = wave * 16 + i4 * 2, m0 = blk * 128 + tl0;
                const GAS u32x2* xr = (const GAS u32x2*)(HL + (size_t)m0 * DM) + lane;
                f32x4 v[2][4]; float ss[2];
#pragma unroll
                for (int r = 0; r < 2; ++r)
#pragma unroll
                    for (int j = 0; j < 4; ++j) { const u32x2 w = xr[r * 256 + 64 * j]; v[r][j] = (f32x4){__uint_as_float(w.x << 16), __uint_as_float(w.x & 0xffff0000u), __uint_as_float(w.y << 16), __uint_as_float(w.y & 0xffff0000u)}; }
#pragma unroll
                for (int r = 0; r < 2; ++r) { ss[r] = 0.f;
#pragma unroll
                    for (int j = 0; j < 4; ++j) ss[r] += (v[r][j].x * v[r][j].x + v[r][j].y * v[r][j].y) + (v[r][j].z * v[r][j].z + v[r][j].w * v[r][j].w); }
#pragma unroll
                for (int o = 1; o < 64; o <<= 1) {
#pragma unroll
                    for (int r = 0; r < 2; ++r) ss[r] += __shfl_xor(ss[r], o); }
                float lg[2][8];
#pragma unroll
                for (int r = 0; r < 2; ++r)
#pragma unroll
                    for (int e = 0; e < 8; ++e) lg[r][e] = 0.f;
#pragma unroll
                for (int j = 0; j < 4; ++j) { const int col = 4 * lane + 256 * j; const f32x4 gv = *(const f32x4*)(g + col), sc = *(const f32x4*)(mrow + 4 * 1024 + col), sh = *(const f32x4*)(mrow + 3 * 1024 + col);
                    const f32x4 gm = gv * (sc + 1.0f);
                    f32x4 y[2];
#pragma unroll
                    for (int r = 0; r < 2; ++r) { const float rstd = 1.0f / __builtin_sqrtf(ss[r] * (1.0f / DM) + EPS); y[r] = (v[r][j] * rstd) * gm + sh;
                        *((GAS unsigned*)(XN8 + (size_t)(m0 + r) * DM) + lane + 64 * j) = pk4f8(y[r].x, y[r].y, y[r].z, y[r].w); }
#pragma unroll
                    for (int cc = 0; cc < 4; ++cc) { const f32x4 w0 = *(const f32x4*)(wrt + (size_t)(col + cc) * 8), w1 = *(const f32x4*)(wrt + (size_t)(col + cc) * 8 + 4);
#pragma unroll
                        for (int r = 0; r < 2; ++r) { const float yv = y[r][cc];
                            lg[r][0] += yv * w0.x; lg[r][1] += yv * w0.y; lg[r][2] += yv * w0.z; lg[r][3] += yv * w0.w; lg[r][4] += yv * w1.x; lg[r][5] += yv * w1.y; lg[r][6] += yv * w1.z; lg[r][7] += yv * w1.w; } } }
#pragma unroll
                for (int o = 1; o < 64; o <<= 1) {
#pragma unroll
                    for (int r = 0; r < 2; ++r)
#pragma unroll
                        for (int e = 0; e < 8; ++e) lg[r][e] += __shfl_xor(lg[r][e], o); }
#pragma unroll
                for (int r = 0; r < 2; ++r) {
                    int ea = 0; float va = lg[r][0];
#pragma unroll
                    for (int e = 1; e < 8; ++e) if (lg[r][e] > va) { va = lg[r][e]; ea = e; }
                    int eb = -1; float vb2 = -INFINITY;
#pragma unroll
                    for (int e = 0; e < 8; ++e) if (e != ea && lg[r][e] > vb2) { vb2 = lg[r][e]; eb = e; }
                    const float wb = 1.0f / (1.0f + __expf(va - vb2)), wa = 1.0f - wb;
                    if (lane == 0) { const int tl = tl0 + r; l_e[tl * 2] = ea; l_e[tl * 2 + 1] = eb; l_w[tl * 2] = wa; l_w[tl * 2 + 1] = wb; } }
            }
            __syncthreads();
            int ea = 0, eb = 0, pa = 0, pb = 0;
            if (tid < 128) { ea = l_e[tid * 2]; eb = l_e[tid * 2 + 1]; pa = atomicAdd((int*)&l_cnt[ea], 1); pb = atomicAdd((int*)&l_cnt[eb], 1); }
            __syncthreads();
            if (tid < 8) l_base[tid] = (int)__hip_atomic_fetch_add((unsigned*)(ctl + CW_CNT + 64 * tid), (unsigned)l_cnt[tid], __ATOMIC_RELAXED, __HIP_MEMORY_SCOPE_AGENT);
            __syncthreads();
            if (tid < 128) { const int m = blk * 128 + tid; pa += l_base[ea]; pb += l_base[eb];
                LIST[(size_t)ea * NLAT + pa] = m; LIST[(size_t)eb * NLAT + pb] = m;
                int* ti = TINFO + (size_t)m * 8; ti[0] = ea; ti[1] = pa; ti[2] = eb; ti[3] = pb; ti[4] = __float_as_int(l_w[tid * 2]); ti[5] = __float_as_int(l_w[tid * 2 + 1]); }
            __syncthreads();
        }
        if (BOTH(12)) GRID_BAR(); PROBE_MARK(12);
    }
    if (hi_ph > 13 && lo < 17) {
        PHASE_IDS();
        LAS int* mtab = (LAS int*)(lds + MOE_OFF);
        if (tid == 0) { int run = 0, R = 0;
            for (int e = 0; e < 8; ++e) { const int ce = (int)__hip_atomic_load((unsigned*)(ctl + CW_CNT + 64 * e), __ATOMIC_RELAXED, __HIP_MEMORY_SCOPE_AGENT); mtab[e] = run; mtab[16 + e] = ce; run += ce >> 8; if (ce & 255) { mtab[24 + R] = e; ++R; } }
            mtab[8] = run; mtab[32] = R; }
        __syncthreads();
        const int nfull = __builtin_amdgcn_readfirstlane(mtab[8]);
        for (int c = 0; c < MOE_NCH; ++c) {
            const int gp0 = c * MOE_CH, gp1 = nfull < (c + 1) * MOE_CH ? nfull : (c + 1) * MOE_CH;
            if (IN(13 + 2 * c)) {
                { pg8::MoeSched S; S.A = (const char*)XN8; S.B = (const char*)MGU; S.list = LIST; S.tab = mtab; S.mode = 0; S.nS = 1; S.kbytes = 0; S.omoff = 0;
                  S.gp0 = gp0; S.gp1 = gp1; S.nN = 28; S.G = G; S.c = bx; S.bexp = (size_t)7168 * 1024; S.btile = (size_t)256 * 1024; S.astep = 0; S.gather = true;
                  pg8::EpiSwiGLU8 E{HC, 1.0f / MOE_SGU};
                  pg8::gemm_phase<pg8::EpiSwiGLU8, pg8::MoeSched, true, true, true>(lds, gtab, 512, 8, S, E); }
                if (c == 0) { pg8::MoeSched S; S.A = (const char*)XN8; S.B = (const char*)MGU; S.list = LIST; S.tab = mtab; S.mode = 1; S.nS = 1; S.kbytes = 0; S.omoff = MOE_CH;
                  S.gp0 = 0; S.gp1 = 0; S.nN = 28; S.G = G; S.c = bx; S.bexp = (size_t)7168 * 1024; S.btile = (size_t)256 * 1024; S.astep = 0; S.gather = true;
                  pg8::EpiSwiGLU8 E{HC, 1.0f / MOE_SGU};
                  pg8::gemm_phase<pg8::EpiSwiGLU8, pg8::MoeSched, true, true, true>(lds, gtab, 512, 8, S, E); }
                if (BOTH(13 + 2 * c)) GRID_BAR(); PROBE_MARK(13 + 2 * c);
            }
            if (IN(14 + 2 * c)) {
                { pg8::MoeSched S; S.A = (const char*)HC; S.B = (const char*)MD; S.list = LIST; S.tab = mtab; S.mode = 0; S.nS = 1; S.kbytes = 0; S.omoff = 0;
                  S.gp0 = gp0; S.gp1 = gp1; S.nN = 4; S.G = G; S.c = bx; S.bexp = (size_t)1024 * DFF; S.btile = (size_t)256 * DFF; S.astep = (size_t)256 * DFF; S.gather = false;
                  pg8::EpiBf16Plain E{YB, DM, 1.0f / MOE_SD};
                  pg8::gemm_phase<pg8::EpiBf16Plain, pg8::MoeSched, true, false, true>(lds, gtab, DFF / 2, 28, S, E); }
                if (c == 0) { pg8::MoeSched S; S.A = (const char*)(HC + (size_t)MOE_CH * 256 * DFF); S.B = (const char*)MD; S.list = LIST; S.tab = mtab; S.mode = 2; S.nS = MOE_RS; S.kbytes = (size_t)(DFF / MOE_RS); S.omoff = 0;
                  S.gp0 = 0; S.gp1 = 0; S.nN = 4; S.G = G; S.c = bx; S.bexp = (size_t)1024 * DFF; S.btile = (size_t)256 * DFF; S.astep = (size_t)256 * DFF; S.gather = false;
                  pg8::EpiPartBf16 E{YP, (size_t)8 * 256 * DM, 1.0f / MOE_SD};
                  pg8::gemm_phase<pg8::EpiPartBf16, pg8::MoeSched, true, false, true>(lds, gtab, DFF / 2, DFF / MOE_RS / 128, S, E); }
                if (BOTH(14 + 2 * c)) GRID_BAR(); PROBE_MARK(14 + 2 * c);
            }
        }
    }
    if (IN(17)) {
        PHASE_IDS();
        LAS int* l_pb = (LAS int*)(lds + wave * 128);
        if (lane == 0) { int run = 0, R = 0;
            for (int e = 0; e < 8; ++e) { const int ce = (int)__hip_atomic_load((unsigned*)(ctl + CW_CNT + 64 * e), __ATOMIC_RELAXED, __HIP_MEMORY_SCOPE_AGENT); l_pb[e] = run; l_pb[8 + e] = ce >> 8; l_pb[16 + e] = R; run += ce >> 8; if (ce & 255) ++R; } }
        const float* g2 = MOD + 5 * 6144 + 5 * 1024;
        for (int m0 = gw * 2; m0 < NLAT; m0 += NGW * 2) {
            const int mb = m0 >> 13;
            f32x4 hv[2][4], ya[2][4], yb[2][4]; float wa[2], wb[2];
#pragma unroll
            for (int r = 0; r < 2; ++r) {
                const int m = m0 + r; const int* ti = TINFO + (size_t)m * 8;
                const int ea = ti[0], pa = ti[1], eb = ti[2], pb = ti[3]; wa[r] = __int_as_float(ti[4]); wb[r] = __int_as_float(ti[5]);
                const bool ma = (pa >> 8) < l_pb[8 + ea], mbm = (pb >> 8) < l_pb[8 + eb];
                const size_t sa = ma ? (size_t)(l_pb[ea] + (pa >> 8)) * 256 + (pa & 255) : (size_t)l_pb[16 + ea] * 256 + (pa & 255);
                const size_t sb = mbm ? (size_t)(l_pb[eb] + (pb >> 8)) * 256 + (pb & 255) : (size_t)l_pb[16 + eb] * 256 + (pb & 255);
                const GAS u32x2* xr = (const GAS u32x2*)(HL + (size_t)m * DM) + lane;
#pragma unroll
                for (int j = 0; j < 4; ++j) { const u32x2 w = xr[64 * j]; hv[r][j] = (f32x4){__uint_as_float(w.x << 16), __uint_as_float(w.x & 0xffff0000u), __uint_as_float(w.y << 16), __uint_as_float(w.y & 0xffff0000u)}; }
                { const GAS u32x2* yr = (const GAS u32x2*)((ma ? YB : YP) + sa * DM) + lane;
#pragma unroll
                  for (int j = 0; j < 4; ++j) { const u32x2 a = yr[64 * j]; ya[r][j] = (f32x4){__uint_as_float(a.x << 16), __uint_as_float(a.x & 0xffff0000u), __uint_as_float(a.y << 16), __uint_as_float(a.y & 0xffff0000u)}; }
                  if (!ma) for (int s2 = 1; s2 < MOE_RS; ++s2) { const GAS u32x2* y2 = (const GAS u32x2*)(YP + ((size_t)s2 * 8 * 256 + sa) * DM) + lane;
#pragma unroll
                      for (int j = 0; j < 4; ++j) { const u32x2 a = y2[64 * j]; ya[r][j] += (f32x4){__uint_as_float(a.x << 16), __uint_as_float(a.x & 0xffff0000u), __uint_as_float(a.y << 16), __uint_as_float(a.y & 0xffff0000u)}; } } }
                { const GAS u32x2* yr = (const GAS u32x2*)((mbm ? YB : YP) + sb * DM) + lane;
#pragma unroll
                  for (int j = 0; j < 4; ++j) { const u32x2 a = yr[64 * j]; yb[r][j] = (f32x4){__uint_as_float(a.x << 16), __uint_as_float(a.x & 0xffff0000u), __uint_as_float(a.y << 16), __uint_as_float(a.y & 0xffff0000u)}; }
                  if (!mbm) for (int s2 = 1; s2 < MOE_RS; ++s2) { const GAS u32x2* y2 = (const GAS u32x2*)(YP + ((size_t)s2 * 8 * 256 + sb) * DM) + lane;
#pragma unroll
                      for (int j = 0; j < 4; ++j) { const u32x2 a = y2[64 * j]; yb[r][j] += (f32x4){__uint_as_float(a.x << 16), __uint_as_float(a.x & 0xffff0000u), __uint_as_float(a.y << 16), __uint_as_float(a.y & 0xffff0000u)}; } } }
            }
            float ss[2];
#pragma unroll
            for (int r = 0; r < 2; ++r) { ss[r] = 0.f;
#pragma unroll
                for (int j = 0; j < 4; ++j) { const f32x4 gv = *(const f32x4*)(g2 + (size_t)mb * 6144 + 4 * lane + 256 * j);
                    hv[r][j] = hv[r][j] + gv * (ya[r][j] * wa[r] + yb[r][j] * wb[r]); ss[r] += (hv[r][j].x * hv[r][j].x + hv[r][j].y * hv[r][j].y) + (hv[r][j].z * hv[r][j].z + hv[r][j].w * hv[r][j].w); } }
#pragma unroll
            for (int o = 1; o < 64; o <<= 1) {
#pragma unroll
                for (int r = 0; r < 2; ++r) ss[r] += __shfl_xor(ss[r], o); }
#pragma unroll
            for (int r = 0; r < 2; ++r) { const float rstd = 1.0f / __builtin_sqrtf(ss[r] * (1.0f / DM) + EPS);
                GAS f32x4* orow = (GAS f32x4*)(args.out + (size_t)(m0 + r) * DM) + lane;
#pragma unroll
                for (int j = 0; j < 4; ++j) { const f32x4 fg = *(const f32x4*)(I_FINALG + 4 * lane + 256 * j); __builtin_nontemporal_store((hv[r][j] * rstd) * fg, orow + 64 * j); } }
        }
    }
    PROBE_MARK(17);
#if defined(PROBE_LO)
    { PHASE_IDS(); const float T = (float)(tpB - tpA) * 0.01f; const float cval = __builtin_sqrtf(T / (float)(PROBE_UNIT));
      for (int m = gw; m < NLAT; m += NGW) { GAS f32x4* orow = (GAS f32x4*)(args.out + (size_t)m * DM) + lane;
#pragma unroll
        for (int j = 0; j < 4; ++j) orow[64 * j] = (f32x4){cval, cval, cval, cval}; } }
#endif
#undef IN
#undef BOTH
#undef GRID_BAR
}

#ifndef MK_ONE_LAUNCH
#define MK_ONE_LAUNCH 1
#endif
extern "C" void kernel_launch(void* const* d_in, const int* in_sizes, int n_in, void* d_out, int out_size, void* d_ws, size_t ws_size, hipStream_t stream) {
    static int grid = 0;
    if (grid == 0) {
        if (n_in != 24 || out_size != NLAT * DM || ws_size < WS_END) { fprintf(stderr, "kernel_launch: unexpected problem (n_in %d, out %d, ws %zu < %zu)\n", n_in, out_size, ws_size, (size_t)WS_END); grid = -1; return; }
        int dev = 0, cus = 0, per_cu = 0;
        if (hipGetDevice(&dev) != hipSuccess || hipDeviceGetAttribute(&cus, hipDeviceAttributeMultiprocessorCount, dev) != hipSuccess) { grid = -1; return; }
        if (hipFuncSetAttribute((const void*)fwd, hipFuncAttributeMaxDynamicSharedMemorySize, LDS_BYTES) != hipSuccess) { fprintf(stderr, "kernel_launch: hipFuncSetAttribute failed\n"); grid = -1; return; }
        if (hipOccupancyMaxActiveBlocksPerMultiprocessor(&per_cu, (const void*)fwd, 512, LDS_BYTES) != hipSuccess || per_cu < 1) fprintf(stderr, "kernel_launch: occupancy query says %d\n", per_cu);
        (void)hipGetLastError();
        grid = cus;
    }
    if (grid < 0) return;
    if (hipMemsetAsync((char*)d_ws + WS_CTL, 0, CTL_ZERO_BYTES, stream) != hipSuccess) return;
    Args a{};
    for (int i = 0; i < 24; ++i) a.in[i] = (const float*)d_in[i];
    a.out = (float*)d_out; a.ws = (unsigned char*)d_ws;
#if defined(SPLITAT)
    a.ph_lo = 0; a.ph_hi = SPLITAT; a.li = 0;
    hipLaunchKernelGGL(fwd, dim3(grid), dim3(512), LDS_BYTES, stream, a);
    a.ph_lo = SPLITAT; a.ph_hi = NPH; a.li = 1;
    hipLaunchKernelGGL(fwd, dim3(grid), dim3(512), LDS_BYTES, stream, a);
#elif defined(DUPK)
    a.ph_lo = 0; a.ph_hi = DUPK + 1; a.li = 0;
    hipLaunchKernelGGL(fwd, dim3(grid), dim3(512), LDS_BYTES, stream, a);
#ifdef DUPN
    for (int rep = 0; rep < DUPN; ++rep) { a.ph_lo = DUPK; a.ph_hi = DUPK + 1; a.li = 2; hipLaunchKernelGGL(fwd, dim3(grid), dim3(512), LDS_BYTES, stream, a); }
#endif
    a.ph_lo = DUPK; a.ph_hi = NPH; a.li = 1;
    hipLaunchKernelGGL(fwd, dim3(grid), dim3(512), LDS_BYTES, stream, a);
#elif MK_ONE_LAUNCH
    a.ph_lo = 0; a.ph_hi = NPH;
    hipLaunchKernelGGL(fwd, dim3(grid), dim3(512), LDS_BYTES, stream, a);
#else
    for (int p = 0; p < NPH; ++p) { a.ph_lo = p; a.ph_hi = p + 1; hipLaunchKernelGGL(fwd, dim3(grid), dim3(512), LDS_BYTES, stream, a); }
#endif
}
```

```cpp
#include <hip/hip_runtime.h>
#include <hip/hip_bf16.h>
#include <cstdio>
#include <cstdint>
#include <cmath>

constexpr int DM = 1024, NB = 4, SEQ = 8192, LCTX = 256, NLAT = NB * SEQ, NCTXR = NB * LCTX, MALL = NLAT + NCTXR;
constexpr int DFF = 3584, NEXP = 8, NQKV = 1536;
constexpr int NPL = NLAT / 256, NPA = MALL / 256;
constexpr float EPS = 1e-6f;
constexpr int MOE_CH = 128, MOE_NCH = 2;
constexpr float MOE_SGU = 32.0f, MOE_SD = 64.0f;
constexpr int MOE_RS = 7, P3_NS = 8, P5_NS = 14;

#define LAS __attribute__((address_space(3)))
#define GAS __attribute__((address_space(1)))
typedef unsigned short bf16_t;
typedef short bf16x8 __attribute__((ext_vector_type(8)));
typedef float f32x4 __attribute__((ext_vector_type(4)));
typedef float f32x2 __attribute__((ext_vector_type(2)));
typedef float f32x16 __attribute__((ext_vector_type(16)));
typedef unsigned u32x4 __attribute__((ext_vector_type(4)));
typedef unsigned u32x2 __attribute__((ext_vector_type(2)));
typedef __bf16 bf16x2_t __attribute__((ext_vector_type(2)));
typedef GAS unsigned gu32;

__device__ __forceinline__ unsigned pkbf(float lo, float hi) { f32x2 v = {lo, hi}; bf16x2_t b = __builtin_convertvector(v, bf16x2_t); return __builtin_bit_cast(unsigned, b); }
__device__ __forceinline__ unsigned pk4f8(float a, float b, float c, float d) { unsigned w = 0; w = __builtin_amdgcn_cvt_pk_fp8_f32(a, b, w, false); w = __builtin_amdgcn_cvt_pk_fp8_f32(c, d, w, true); return w; }
__device__ __forceinline__ float bf2f(unsigned short h) { return __builtin_bit_cast(float, (unsigned)h << 16); }
__device__ __forceinline__ float wave_sum(float v) {
#pragma unroll
    for (int o = 1; o < 64; o <<= 1) v += __shfl_xor(v, o);
    return v;
}
__device__ __forceinline__ float gelu_tanh(float x) {
    const float t = x * (1.0f + 0.044715f * x * x);
    const float e = __builtin_amdgcn_exp2f(-2.302208198f * t);
    return x * __builtin_amdgcn_rcpf(1.0f + e);
}
__device__ __forceinline__ float silu_f(float x) { return x * __builtin_amdgcn_rcpf(1.0f + __builtin_amdgcn_exp2f(-1.4426950409f * x)); }

constexpr size_t MiB = 1u << 20;
constexpr size_t WS_CTL = 0, CTL_ZERO_BYTES = 1 * MiB;
constexpr size_t WS_MOD = 1 * MiB;
constexpr size_t WS_ROPE = 1 * MiB + 256 * 1024;
constexpr size_t WS_STATS = 2 * MiB;
constexpr size_t WS_RSC = 4 * MiB + 512 * 1024;
constexpr size_t WS_LIST = 5 * MiB;
constexpr size_t WS_TINFO = 6 * MiB;
constexpr size_t WS_WS = 7 * MiB;
constexpr size_t WS_WIN = 8 * MiB, WS_WAO = 12 * MiB, WS_WQKV = 14 * MiB, WS_WBO = 17 * MiB, WS_WGU = 19 * MiB, WS_WD = 33 * MiB;
constexpr size_t WS_MGU = 40 * MiB, WS_MD = 96 * MiB;
constexpr size_t WS_HLB = 124 * MiB;
constexpr size_t WS_XN = 208 * MiB;
constexpr size_t WS_ZB = 274 * MiB;
constexpr size_t WS_R = 278 * MiB;
constexpr size_t WS_UVT = WS_R, WS_A2 = WS_R + 132 * MiB, WS_PART1 = WS_R + 198 * MiB, WS_H = WS_R, WS_PART2 = WS_R + 231 * MiB;
constexpr size_t WS_QKV = WS_R, WS_O = WS_R + 99 * MiB;
constexpr size_t WS_Y = WS_R, WS_YP = WS_R + 128 * MiB, WS_HC = WS_R + 156 * MiB;
constexpr size_t WS_END = WS_R + 287 * MiB;
static_assert(WS_UVT + (size_t)2048 * MALL * 2 <= WS_A2 && WS_A2 + (size_t)MALL * DM * 2 <= WS_PART1 && WS_PART1 + (size_t)P3_NS * NCTXR * DM * 4 <= WS_END, "layer-0 mixer map");
static_assert(WS_H + (size_t)MALL * DFF * 2 <= WS_PART2 && WS_PART2 + (size_t)P5_NS * NCTXR * DM * 4 <= WS_END && WS_QKV + (size_t)MALL * NQKV * 2 <= WS_O && WS_O + (size_t)NLAT * DM * 2 <= WS_END, "region map");
static_assert(WS_Y + (size_t)256 * 256 * DM * 2 <= WS_YP && WS_YP + (size_t)MOE_RS * 8 * 256 * DM * 2 <= WS_HC && WS_HC + (size_t)(MOE_CH + 8) * 256 * DFF <= WS_END, "MoE map");
static_assert(WS_MD + (size_t)8 * DM * DFF <= WS_HLB && WS_HLB + (size_t)NLAT * DM * 2 <= WS_XN && WS_XN + (size_t)MALL * DM * 2 <= WS_ZB && WS_MD + (size_t)8 * DM * DFF <= WS_XN && WS_MGU + (size_t)8 * 7168 * DM <= WS_MD, "weights map");
constexpr int CW_TMO = 0, CW_CODE = 1;
constexpr int CW_CNT = 64;
constexpr int CW_WAMAX = 1024;
constexpr int CW_BAR = 4096;

constexpr int RING_BYTES = 131072;
constexpr int GTAB_OFF = RING_BYTES;
constexpr int MOE_OFF = RING_BYTES + 1024;
constexpr int MISC_OFF = RING_BYTES + 2048;
constexpr int LDS_BYTES = 147456;

namespace pg8 {
constexpr int BM = 256, BK = 64, HALF = 128, HTB = HALF * BK * 2, STAGE_BYTES = 8 * HTB, NXCD = 8, WGM = 8;
__host__ __device__ __forceinline__ int lds_byte(int r, int c) { const int st = (r >> 4) * 2 + (c >> 5), rr = r & 15, cc = c & 31, ob = rr * 64 + cc * 2; return st * 1024 + (ob ^ (((ob >> 9) & 1) << 5)); }
__host__ __device__ __forceinline__ void stage_rc(int b, int& R, int& C) { const int st = b / 1024, sb = b % 1024, swz = sb ^ (((sb >> 9) & 1) << 5); R = (st >> 1) * 16 + swz / 64; C = (st & 1) * 32 + (swz % 64) / 2; }
__host__ __device__ __forceinline__ int perm32(int rho) { const int n = rho >> 4, i = rho & 15; return 8 * (i >> 2) + 4 * n + (i & 3); }

struct Unit { const char* a; const char* b; const int* gl; int pm, pn, om, nv, ks; };

__device__ __forceinline__ bool tile_order(int i, int G, int c, int nM, int nN, int& pm, int& pn) {
    const int nwg = nM * nN; const long L = (long)i * G + c; if (L >= nwg) return false;
    int wgid = (int)L; { const int q = nwg / NXCD, r = nwg % NXCD, xcd = wgid % NXCD, off = wgid / NXCD; wgid = (xcd < r ? xcd * (q + 1) : r * (q + 1) + (xcd - r) * q) + off; }
    const int nig = WGM * nN, gid = wgid / nig, fm = gid * WGM, gsz = (nM - fm) < WGM ? (nM - fm) : WGM;
    pm = fm + ((wgid % nig) % gsz); pn = (wgid % nig) / gsz; return true;
}
struct DenseSched {
    const char* A; const char* B; int nM, nN, G, c; size_t tstep;
    __device__ __forceinline__ bool next(int i, Unit& u) const {
        int pm, pn; if (!tile_order(i, G, c, nM, nN, pm, pn)) return false;
        u.a = A + (size_t)pm * tstep; u.b = B + (size_t)pn * tstep; u.gl = nullptr; u.pm = pm; u.pn = pn; u.om = pm; u.nv = 256; u.ks = 0; return true;
    }
};
typedef int v8i_t __attribute__((ext_vector_type(8)));
typedef int v4i_t __attribute__((ext_vector_type(4)));
__device__ __forceinline__ v8i_t cat8(bf16x8 lo, bf16x8 hi) { const v4i_t a = __builtin_bit_cast(v4i_t, lo), b = __builtin_bit_cast(v4i_t, hi); return __builtin_shufflevector(a, b, 0, 1, 2, 3, 4, 5, 6, 7); }
struct SplitSched {
    const char* A; const char* B; int nM, nN, nS, G, c, pm0; size_t tstep, kbytes;
    __device__ __forceinline__ bool next(int i, Unit& u) const {
        const int L = i * G + c; if (L >= nM * nN * nS) return false;
        const int ks = L % nS, t = L / nS, pn = t % nN, pm = t / nN;
        u.a = A + (size_t)pm * tstep + (size_t)ks * kbytes; u.b = B + (size_t)pn * tstep + (size_t)ks * kbytes; u.gl = nullptr; u.pm = pm0 + pm; u.pn = pn; u.om = pm; u.nv = 256; u.ks = ks; return true;
    }
};
struct MoeSched {
    const char* A; const char* B; const int* list; const LAS int* tab; int gp0, gp1, nN, nS, G, c, mode, omoff; size_t bexp, btile, astep, kbytes; bool gather;
    __device__ __forceinline__ bool next(int i, Unit& u) const {
        int pm, pn, ks = 0;
        if (mode == 0) { if (gp1 <= gp0) return false; if (!tile_order(i, G, c, gp1 - gp0, nN, pm, pn)) return false; }
        else { const int R = __builtin_amdgcn_readfirstlane(tab[32]); const int L = i * G + c; if (L >= R * nN * nS) return false; ks = L % nS; const int t = L / nS; pn = t % nN; pm = t / nN; }
        int e = 0, lp, nv;
        if (mode == 0) { const int gp = gp0 + pm;
#pragma unroll
            for (int k = 1; k < 8; ++k) e += (gp >= __builtin_amdgcn_readfirstlane(tab[k])) ? 1 : 0;
            lp = gp - __builtin_amdgcn_readfirstlane(tab[e]); nv = 256; u.pm = gp; }
        else { e = __builtin_amdgcn_readfirstlane(tab[24 + pm]); const int ce = __builtin_amdgcn_readfirstlane(tab[16 + e]); lp = ce >> 8; nv = ce & 255; u.pm = pm; }
        u.b = B + (size_t)e * bexp + (size_t)pn * btile + (size_t)ks * kbytes; u.pn = pn; u.nv = nv; u.ks = ks; u.om = pm;
        if (gather) { u.a = A; u.gl = list + (size_t)e * NLAT + 256 * lp; u.om = pm + omoff; }
        else { u.a = A + (size_t)pm * astep + (size_t)ks * kbytes; u.gl = nullptr; if (mode == 0) u.om = gp0 + pm; }
        return true;
    }
};

struct EpiGeluT {
    static constexpr bool PERM = true;
    bf16_t* O; float* stats;
    __device__ __forceinline__ void operator()(const f32x4 (&acc)[2][2][4][2], const Unit& u, int wr, int wc, int fr, int fq) const {
        const int row0 = u.pm * BM + wr * 64 + fr, col0 = u.pn * BM + wc * 32 + 8 * fq;
        const bool isv = u.pm >= 4;
        float s1[2][2][4], s2[2][2][4];
#pragma unroll
        for (int bj = 0; bj < 2; ++bj)
#pragma unroll
            for (int n = 0; n < 2; ++n)
#pragma unroll
                for (int e = 0; e < 4; ++e) { s1[bj][n][e] = 0.f; s2[bj][n][e] = 0.f; }
#pragma unroll
        for (int ai = 0; ai < 2; ++ai)
#pragma unroll
            for (int m = 0; m < 4; ++m) { bf16_t* rowp = O + (size_t)(row0 + ai * HALF + m * 16) * MALL + col0;
#pragma unroll
                for (int bj = 0; bj < 2; ++bj) { f32x4 v0 = acc[ai][bj][m][0], v1 = acc[ai][bj][m][1];
#pragma unroll
                    for (int e = 0; e < 4; ++e) { v0[e] = gelu_tanh(v0[e]); v1[e] = gelu_tanh(v1[e]); s1[bj][0][e] += v0[e]; s2[bj][0][e] += v0[e] * v0[e]; s1[bj][1][e] += v1[e]; s2[bj][1][e] += v1[e] * v1[e]; }
                    u32x4 w; w.x = pkbf(v0[0], v0[1]); w.y = pkbf(v0[2], v0[3]); w.z = pkbf(v1[0], v1[1]); w.w = pkbf(v1[2], v1[3]);
                    *(u32x4*)(rowp + bj * HALF) = w; } }
        if (isv) {
            const int slot = (u.pm - 4) * 2 + wr;
#pragma unroll
            for (int bj = 0; bj < 2; ++bj)
#pragma unroll
                for (int n = 0; n < 2; ++n)
#pragma unroll
                    for (int e = 0; e < 4; ++e) { float a = s1[bj][n][e], b = s2[bj][n][e];
#pragma unroll
                        for (int o = 1; o < 16; o <<= 1) { a += __shfl_xor(a, o); b += __shfl_xor(b, o); }
                        if (fr == 0) { const int tok = col0 + bj * HALF + 4 * n + e; *(f32x2*)(stats + (size_t)tok * 16 + slot * 2) = (f32x2){a, b}; } }
        }
    }
};
template <bool BASE_F32> struct EpiResid {
    static constexpr bool PERM = true;
    const float* basef; const bf16_t* baseb; bf16_t* out; const float* gate;
    __device__ __forceinline__ void operator()(const f32x4 (&acc)[2][2][4][2], const Unit& u, int wr, int wc, int fr, int fq) const {
        const int mb = u.pm >> 5; const int col0 = u.pn * BM + wc * 32 + 8 * fq;
        f32x4 gv[2][2];
#pragma unroll
        for (int bj = 0; bj < 2; ++bj)
#pragma unroll
            for (int n = 0; n < 2; ++n) gv[bj][n] = *(const f32x4*)(gate + (size_t)mb * 6144 + col0 + bj * HALF + n * 4);
#pragma unroll
        for (int ai = 0; ai < 2; ++ai)
#pragma unroll
            for (int m = 0; m < 4; ++m) { const size_t off = (size_t)(u.pm * BM + wr * 64 + fr + ai * HALF + m * 16) * DM + col0;
#pragma unroll
                for (int bj = 0; bj < 2; ++bj) { f32x4 b0, b1;
                    if constexpr (BASE_F32) { b0 = *(const f32x4*)(basef + off + bj * HALF); b1 = *(const f32x4*)(basef + off + bj * HALF + 4); }
                    else { const u32x4 w = *(const u32x4*)(baseb + off + bj * HALF);
                        b0 = (f32x4){__uint_as_float(w.x << 16), __uint_as_float(w.x & 0xffff0000u), __uint_as_float(w.y << 16), __uint_as_float(w.y & 0xffff0000u)};
                        b1 = (f32x4){__uint_as_float(w.z << 16), __uint_as_float(w.z & 0xffff0000u), __uint_as_float(w.w << 16), __uint_as_float(w.w & 0xffff0000u)}; }
                    const f32x4 o0 = b0 + gv[bj][0] * acc[ai][bj][m][0], o1 = b1 + gv[bj][1] * acc[ai][bj][m][1];
                    u32x4 w; w.x = pkbf(o0[0], o0[1]); w.y = pkbf(o0[2], o0[3]); w.z = pkbf(o1[0], o1[1]); w.w = pkbf(o1[2], o1[3]);
                    *(u32x4*)(out + off + bj * HALF) = w; } }
    }
};
struct EpiSwiGLU {
    static constexpr bool PERM = true;
    bf16_t* O;
    __device__ __forceinline__ void operator()(const f32x4 (&acc)[2][2][4][2], const Unit& u, int wr, int wc, int fr, int fq) const {
        bf16_t* base = O + (size_t)(u.om * BM + wr * 64 + fr) * DFF + u.pn * 128 + wc * 32 + 8 * fq;
#pragma unroll
        for (int ai = 0; ai < 2; ++ai)
#pragma unroll
            for (int m = 0; m < 4; ++m) { const f32x4 g0 = acc[ai][0][m][0], g1 = acc[ai][0][m][1], u0 = acc[ai][1][m][0], u1 = acc[ai][1][m][1];
                float o[8];
#pragma unroll
                for (int e = 0; e < 4; ++e) { o[e] = silu_f(g0[e]) * u0[e]; o[4 + e] = silu_f(g1[e]) * u1[e]; }
                u32x4 w; w.x = pkbf(o[0], o[1]); w.y = pkbf(o[2], o[3]); w.z = pkbf(o[4], o[5]); w.w = pkbf(o[6], o[7]);
                *(u32x4*)(base + (size_t)(ai * HALF + m * 16) * DFF) = w; }
    }
};
struct EpiQKV {
    static constexpr bool PERM = false;
    bf16_t* O; const float* cosT; const float* sinT; float qscale; const float* rscale; const float* wsc;
    __device__ __forceinline__ void operator()(const f32x4 (&acc)[2][2][4][2], const Unit& u, int wr, int wc, int fr, int fq) const {
        const bool lat = u.pm < NPL; const bool dorope = lat && u.pn < 5; const float sc = (u.pn < 4 ? qscale : 1.0f) * wsc[0];
        const int col0 = u.pn * BM + wc * 32 + 4 * fq;
#pragma unroll
        for (int ai = 0; ai < 2; ++ai)
#pragma unroll
            for (int m = 0; m < 4; ++m) { const int grow = u.pm * BM + ai * HALF + wr * 64 + m * 16 + fr; const int s = grow & (SEQ - 1); const int pos = (wc & 1) ? (s & 63) : (s >> 6);
                f32x4 cs = (f32x4){1.f, 1.f, 1.f, 1.f}, sn = (f32x4){0.f, 0.f, 0.f, 0.f};
                if (dorope) { cs = *(const f32x4*)(cosT + pos * 16 + 4 * fq); sn = *(const f32x4*)(sinT + pos * 16 + 4 * fq); }
                bf16_t* rowp = O + (size_t)grow * NQKV + col0;
                const float rsx = rscale[grow] * sc;
#pragma unroll
                for (int bj = 0; bj < 2; ++bj) { const v4i_t i1 = __builtin_bit_cast(v4i_t, acc[ai][bj][m][0]), i2 = __builtin_bit_cast(v4i_t, acc[ai][bj][m][1]);
                    const f32x4 x1 = (f32x4){(float)i1[0], (float)i1[1], (float)i1[2], (float)i1[3]}, x2 = (f32x4){(float)i2[0], (float)i2[1], (float)i2[2], (float)i2[3]};
                    const f32x4 o1 = (x1 * cs - x2 * sn) * rsx, o2 = (x1 * sn + x2 * cs) * rsx;
                    u32x2 w1, w2; w1.x = pkbf(o1[0], o1[1]); w1.y = pkbf(o1[2], o1[3]); w2.x = pkbf(o2[0], o2[1]); w2.y = pkbf(o2[2], o2[3]);
                    *(u32x2*)(rowp + bj * HALF) = w1; *(u32x2*)(rowp + bj * HALF + 16) = w2; } }
    }
};
struct EpiSwiGLUI8 {
    static constexpr bool PERM = true;
    bf16_t* O; const float* rscale; const float* ws;
    __device__ __forceinline__ void operator()(const f32x4 (&acc)[2][2][4][2], const Unit& u, int wr, int wc, int fr, int fq) const {
        bf16_t* base = O + (size_t)(u.om * BM + wr * 64 + fr) * DFF + u.pn * 128 + wc * 32 + 8 * fq;
        const float wsg = ws[0], wsu = ws[1];
#pragma unroll
        for (int ai = 0; ai < 2; ++ai)
#pragma unroll
            for (int m = 0; m < 4; ++m) { const float rs = rscale[u.pm * BM + wr * 64 + fr + ai * HALF + m * 16]; const float sg = rs * wsg, su = rs * wsu;
                const v4i_t g0 = __builtin_bit_cast(v4i_t, acc[ai][0][m][0]), g1 = __builtin_bit_cast(v4i_t, acc[ai][0][m][1]), u0 = __builtin_bit_cast(v4i_t, acc[ai][1][m][0]), u1 = __builtin_bit_cast(v4i_t, acc[ai][1][m][1]);
                float o[8];
#pragma unroll
                for (int e = 0; e < 4; ++e) { o[e] = silu_f((float)g0[e] * sg) * ((float)u0[e] * su); o[4 + e] = silu_f((float)g1[e] * sg) * ((float)u1[e] * su); }
                u32x4 w; w.x = pkbf(o[0], o[1]); w.y = pkbf(o[2], o[3]); w.z = pkbf(o[4], o[5]); w.w = pkbf(o[6], o[7]);
                *(u32x4*)(base + (size_t)(ai * HALF + m * 16) * DFF) = w; }
    }
};
struct EpiSwiGLU8 {
    static constexpr bool PERM = true;
    unsigned char* O; float s;
    __device__ __forceinline__ void operator()(const f32x4 (&acc)[2][2][4][2], const Unit& u, int wr, int wc, int fr, int fq) const {
        unsigned char* base = O + (size_t)(u.om * BM + wr * 64 + fr) * DFF + u.pn * 128 + wc * 32 + 8 * fq;
#pragma unroll
        for (int ai = 0; ai < 2; ++ai)
#pragma unroll
            for (int m = 0; m < 4; ++m) { const f32x4 g0 = acc[ai][0][m][0] * s, g1 = acc[ai][0][m][1] * s, u0 = acc[ai][1][m][0] * s, u1 = acc[ai][1][m][1] * s;
                float o[8];
#pragma unroll
                for (int e = 0; e < 4; ++e) { o[e] = silu_f(g0[e]) * u0[e]; o[4 + e] = silu_f(g1[e]) * u1[e]; }
                u32x2 w; w.x = pk4f8(o[0], o[1], o[2], o[3]); w.y = pk4f8(o[4], o[5], o[6], o[7]);
                *(u32x2*)(base + (size_t)(ai * HALF + m * 16) * DFF) = w; }
    }
};
struct EpiBf16Plain {
    static constexpr bool PERM = true;
    bf16_t* O; int ldc; float s;
    __device__ __forceinline__ void operator()(const f32x4 (&acc)[2][2][4][2], const Unit& u, int wr, int wc, int fr, int fq) const {
        bf16_t* base = O + (size_t)(u.om * BM + wr * 64 + fr) * ldc + u.pn * BM + wc * 32 + 8 * fq;
#pragma unroll
        for (int ai = 0; ai < 2; ++ai)
#pragma unroll
            for (int m = 0; m < 4; ++m)
#pragma unroll
                for (int bj = 0; bj < 2; ++bj) { const f32x4 v0 = acc[ai][bj][m][0] * s, v1 = acc[ai][bj][m][1] * s;
                    u32x4 w; w.x = pkbf(v0[0], v0[1]); w.y = pkbf(v0[2], v0[3]); w.z = pkbf(v1[0], v1[1]); w.w = pkbf(v1[2], v1[3]);
                    *(u32x4*)(base + (size_t)(ai * HALF + m * 16) * ldc + bj * HALF) = w; }
    }
};

struct EpiPartF32 {
    static constexpr bool PERM = true;
    float* P; size_t sstride;
    __device__ __forceinline__ void operator()(const f32x4 (&acc)[2][2][4][2], const Unit& u, int wr, int wc, int fr, int fq) const {
        float* base = P + (size_t)u.ks * sstride + (size_t)(u.om * BM + wr * 64 + fr) * DM + u.pn * BM + wc * 32 + 8 * fq;
#pragma unroll
        for (int ai = 0; ai < 2; ++ai)
#pragma unroll
            for (int m = 0; m < 4; ++m)
#pragma unroll
                for (int bj = 0; bj < 2; ++bj)
#pragma unroll
                    for (int n = 0; n < 2; ++n) *(f32x4*)(base + (size_t)(ai * HALF + m * 16) * DM + bj * HALF + n * 4) = acc[ai][bj][m][n];
    }
};
struct EpiPartBf16 {
    static constexpr bool PERM = true;
    bf16_t* P; size_t sstride; float s;
    __device__ __forceinline__ void operator()(const f32x4 (&acc)[2][2][4][2], const Unit& u, int wr, int wc, int fr, int fq) const {
        bf16_t* base = P + (size_t)u.ks * sstride + (size_t)(u.om * BM + wr * 64 + fr) * DM + u.pn * BM + wc * 32 + 8 * fq;
#pragma unroll
        for (int ai = 0; ai < 2; ++ai)
#pragma unroll
            for (int m = 0; m < 4; ++m)
#pragma unroll
                for (int bj = 0; bj < 2; ++bj) { const f32x4 v0 = acc[ai][bj][m][0] * s, v1 = acc[ai][bj][m][1] * s;
                    u32x4 w; w.x = pkbf(v0[0], v0[1]); w.y = pkbf(v0[2], v0[3]); w.z = pkbf(v1[0], v1[1]); w.w = pkbf(v1[2], v1[3]);
                    *(u32x4*)(base + (size_t)(ai * HALF + m * 16) * DM + bj * HALF) = w; }
    }
};

template <class Epi, class Sched, bool ALIGN_EPI, bool GATHER, bool FP8 = false, bool I8 = false>
__device__ __forceinline__ void gemm_phase(LAS unsigned char* lds, LAS int* gtab, const int K  , const int nt_in  , const Sched& S, const Epi& E) {
    int nt = nt_in; asm volatile("" : "+s"(nt));
    int tid_ = threadIdx.x; asm volatile("" : "+v"(tid_));
    const int tid = tid_, wid = __builtin_amdgcn_readfirstlane(tid >> 6), lane = tid & 63, wr = wid >> 2, wc = wid & 3, fr = lane & 15, fq = lane >> 4;
    const size_t kstep = (size_t)(BK * 2);
    const size_t hstep = (size_t)HALF * K * 2;
    unsigned voffB[2];
#pragma unroll
    for (int i = 0; i < 2; ++i) { int R, C; stage_rc(tid * 16 + i * 8192, R, C); const int Rb = Epi::PERM ? ((R & ~31) + perm32(R & 31)) : R;
        voffB[i] = (unsigned)(Rb * K + C) * 2u; }
    unsigned vA[2][2], vN[2][2];
    const unsigned ldsw = (unsigned)wid * 1024u;
    const int aoff = lds_byte(wr * 64 + fr, fq * 8), boff = lds_byte(wc * 32 + fr, fq * 8);
    const LAS unsigned char* aB = lds + aoff; const LAS unsigned char* bB = lds + 65536 + boff;
    asm volatile("" : "+v"(aB), "+v"(bB));
#define PG8_SA(b, h) (((b) * 2 + (h)) * HTB)
#define PG8_SB(b, h) ((4 + (b) * 2 + (h)) * HTB)
#define PG8_STAGE(bufoff, gbase, voff) do { _Pragma("unroll") for (int _i = 0; _i < 2; ++_i) \
        __builtin_amdgcn_global_load_lds((const unsigned*)((const char*)(gbase) + (voff)[_i]), (LAS unsigned*)(lds + (bufoff) + ldsw + _i * 8192), 16, 0, 0); } while (0)
#define PG8_LDA(dst, b, h) do { _Pragma("unroll") for (int m = 0; m < 4; ++m) { if constexpr (FP8) dst##8[m] = cat8(*(const LAS bf16x8*)(aB + PG8_SA(b, h) + m * 2048), *(const LAS bf16x8*)(aB + PG8_SA(b, h) + m * 2048 + 1024)); \
        else { _Pragma("unroll") for (int k = 0; k < 2; ++k) dst[m][k] = *(const LAS bf16x8*)(aB + PG8_SA(b, h) + m * 2048 + k * 1024); } } } while (0)
#define PG8_LDB(dst, b, h) do { _Pragma("unroll") for (int n = 0; n < 2; ++n) { if constexpr (FP8) dst##8[n] = cat8(*(const LAS bf16x8*)(bB + (PG8_SB(b, h) - 65536) + n * 2048), *(const LAS bf16x8*)(bB + (PG8_SB(b, h) - 65536) + n * 2048 + 1024)); \
        else { _Pragma("unroll") for (int k = 0; k < 2; ++k) dst[n][k] = *(const LAS bf16x8*)(bB + (PG8_SB(b, h) - 65536) + n * 2048 + k * 1024); } } } while (0)
#define PG8_MMA(ai, bj, At, Bt) do { __builtin_amdgcn_s_setprio(1); \
    if constexpr (FP8) { _Pragma("unroll") for (int m = 0; m < 4; ++m) _Pragma("unroll") for (int n = 0; n < 2; ++n) \
        asm volatile("v_mfma_f32_16x16x128_f8f6f4 %0, %1, %2, %0" : "+v"(acc[ai][bj][m][n]) : "v"(Bt##8[n]), "v"(At##8[m])); } \
    else if constexpr (I8) { _Pragma("unroll") for (int m = 0; m < 4; ++m) _Pragma("unroll") for (int n = 0; n < 2; ++n) _Pragma("unroll") for (int k = 0; k < 2; ++k) \
        acc[ai][bj][m][n] = __builtin_bit_cast(f32x4, __builtin_amdgcn_mfma_i32_16x16x64_i8(__builtin_bit_cast(v4i_t, Bt[n][k]), __builtin_bit_cast(v4i_t, At[m][k]), __builtin_bit_cast(v4i_t, acc[ai][bj][m][n]), 0, 0, 0)); } \
    else { _Pragma("unroll") for (int m = 0; m < 4; ++m) _Pragma("unroll") for (int n = 0; n < 2; ++n) _Pragma("unroll") for (int k = 0; k < 2; ++k) \
        acc[ai][bj][m][n] = __builtin_amdgcn_mfma_f32_16x16x32_bf16(Bt[n][k], At[m][k], acc[ai][bj][m][n], 0, 0, 0); } \
    __builtin_amdgcn_s_setprio(0); } while (0)
#define PG8_WAIT_V(n) asm volatile("s_waitcnt vmcnt(" #n ")" ::: "memory")
#define PG8_WAIT_L(n) asm volatile("s_waitcnt lgkmcnt(" #n ")" ::: "memory")
#define PG8_BAR __builtin_amdgcn_s_barrier()
#define PG8_SCHED __builtin_amdgcn_sched_barrier(0)
    Unit cur, nxt; int ui = 0;
    if (!S.next(0, cur)) return;
    f32x4 acc[2][2][4][2];
#pragma unroll
    for (int a = 0; a < 2; ++a)
#pragma unroll
        for (int b = 0; b < 2; ++b)
#pragma unroll
            for (int m = 0; m < 4; ++m)
#pragma unroll
                for (int n = 0; n < 2; ++n) acc[a][b][m][n] = (f32x4){0.f, 0.f, 0.f, 0.f};
    bf16x8 At[4][2], B0[2][2], B1[2][2]; v8i_t At8[4], B08[2], B18[2];
    if constexpr (GATHER) {
#pragma unroll
        for (int h = 0; h < 2; ++h)
#pragma unroll
            for (int i = 0; i < 2; ++i) { int R, C; stage_rc(tid * 16 + i * 8192, R, C); const int row = h * HALF + R; const int tok = cur.gl[row < cur.nv ? row : 0]; vA[h][i] = (unsigned)tok * (unsigned)(K * 2) + (unsigned)C * 2u; }
    } else {
#pragma unroll
        for (int h = 0; h < 2; ++h)
#pragma unroll
            for (int i = 0; i < 2; ++i) { int R, C; stage_rc(tid * 16 + i * 8192, R, C); vA[h][i] = (unsigned)(R * K + C) * 2u + (unsigned)(h * hstep); }
    }
#pragma unroll
    for (int h = 0; h < 2; ++h)
#pragma unroll
        for (int i = 0; i < 2; ++i) vN[h][i] = vA[h][i];
    const char* cA = cur.a; const char* cB = cur.b;
    PG8_STAGE(PG8_SB(0, 0), cB, voffB); PG8_STAGE(PG8_SB(0, 1), cB + hstep, voffB); PG8_STAGE(PG8_SA(0, 0), cA, vA[0]); PG8_STAGE(PG8_SA(0, 1), cA, vA[1]);
    if (wr == 1) PG8_BAR;
    PG8_WAIT_V(2); PG8_BAR;
    PG8_STAGE(PG8_SB(1, 0), cB + kstep, voffB); PG8_STAGE(PG8_SA(1, 0), cA + kstep, vA[0]); PG8_STAGE(PG8_SB(1, 1), cB + hstep + kstep, voffB);
    PG8_WAIT_V(6); PG8_BAR;
    for (;;) {
        const bool has_next = S.next(ui + 1, nxt);
        const char* nA = has_next ? nxt.a : cA; const char* nB = has_next ? nxt.b : cB;
        if constexpr (GATHER) {
            if (has_next && wid < 4) __builtin_amdgcn_global_load_lds((const unsigned*)(nxt.gl + wid * 64 + lane), (LAS unsigned*)(gtab + wid * 64), 4, 0, 0);
        }
        for (int t = 0; t < nt; t += 2) {
            const bool last = (t == nt - 2);
            const char* a1 = cA + (size_t)(t + 1) * kstep;
            const char* a2 = last ? nA : cA + (size_t)(t + 2) * kstep; const char* b2 = last ? nB : cB + (size_t)(t + 2) * kstep;
            const char* a3 = a2 + kstep; const char* b3 = b2 + kstep;
            if constexpr (GATHER) {
                if (last && has_next) {
                    int t2 = tid; asm volatile("" : "+v"(t2));
#pragma unroll
                    for (int h = 0; h < 2; ++h)
#pragma unroll
                        for (int i = 0; i < 2; ++i) { int R, C; stage_rc(t2 * 16 + i * 8192, R, C); const int row = h * HALF + R; const int tok = gtab[row < nxt.nv ? row : 0]; vN[h][i] = (unsigned)tok * (unsigned)(K * 2) + (unsigned)C * 2u; }
                }
            }
            unsigned vS0[2], vS1[2];
#pragma unroll
            for (int i = 0; i < 2; ++i) { vS0[i] = (GATHER && last) ? vN[0][i] : vA[0][i]; vS1[i] = (GATHER && last) ? vN[1][i] : vA[1][i]; }
            PG8_LDB(B0, 0, 0); PG8_LDB(B1, 0, 1); PG8_SCHED; PG8_LDA(At, 0, 0); PG8_STAGE(PG8_SA(1, 1), a1, vA[1]);
            PG8_WAIT_V(8); PG8_WAIT_L(0); PG8_BAR; PG8_MMA(0, 0, At, B0); PG8_MMA(0, 1, At, B1); PG8_BAR; PG8_SCHED;
            PG8_LDA(At, 0, 1); PG8_STAGE(PG8_SB(0, 0), b2, voffB); PG8_STAGE(PG8_SB(0, 1), b2 + hstep, voffB); PG8_STAGE(PG8_SA(0, 0), a2, vS0);
            PG8_WAIT_V(8); PG8_WAIT_L(0); PG8_BAR; PG8_MMA(1, 0, At, B0); PG8_MMA(1, 1, At, B1); PG8_BAR; PG8_SCHED;
            PG8_LDB(B0, 1, 0); PG8_LDB(B1, 1, 1); PG8_SCHED; PG8_LDA(At, 1, 0); PG8_STAGE(PG8_SA(0, 1), a2, vS1);
            PG8_WAIT_V(8); PG8_WAIT_L(0); PG8_BAR; PG8_MMA(0, 0, At, B0); PG8_MMA(0, 1, At, B1); PG8_BAR; PG8_SCHED;
            PG8_LDA(At, 1, 1); PG8_STAGE(PG8_SB(1, 0), b3, voffB); PG8_STAGE(PG8_SB(1, 1), b3 + hstep, voffB); PG8_STAGE(PG8_SA(1, 0), a3, vS0);
            PG8_WAIT_V(8); PG8_WAIT_L(0); PG8_BAR; PG8_MMA(1, 0, At, B0); PG8_MMA(1, 1, At, B1); PG8_BAR; PG8_SCHED;
        }
        if constexpr (ALIGN_EPI) { if (wr == 0) PG8_BAR; }
        if constexpr (FP8) asm volatile("s_nop 15\n\ts_nop 15" ::: "memory");
        E(acc, cur, wr, wc, fr, fq);
        if (!has_next) break;
#pragma unroll
        for (int a = 0; a < 2; ++a)
#pragma unroll
            for (int b = 0; b < 2; ++b)
#pragma unroll
                for (int m = 0; m < 4; ++m)
#pragma unroll
                    for (int n = 0; n < 2; ++n) acc[a][b][m][n] = (f32x4){0.f, 0.f, 0.f, 0.f};
        cur = nxt; cA = nA; cB = nB; ++ui;
        if constexpr (GATHER) {
#pragma unroll
            for (int h = 0; h < 2; ++h)
#pragma unroll
                for (int i = 0; i < 2; ++i) vA[h][i] = vN[h][i];
        }
        if constexpr (ALIGN_EPI) { if (wr == 1) PG8_BAR; }
    }
    PG8_WAIT_V(0);
    if constexpr (!ALIGN_EPI) { if (wr == 0) PG8_BAR; }
    PG8_BAR;
#undef PG8_SA
#undef PG8_SB
#undef PG8_STAGE
#undef PG8_LDA
#undef PG8_LDB
#undef PG8_MMA
#undef PG8_WAIT_V
#undef PG8_WAIT_L
#undef PG8_BAR
#undef PG8_SCHED
}
}

namespace attn_body {
using bf16 = __hip_bfloat16;
using s16x4 = __attribute__((ext_vector_type(4))) short;
constexpr int D = 64, PITCH = NQKV, OPITCH = DM;
constexpr int NW = 8, QBLK = 32, KVBLK = 64;
__device__ __forceinline__ int crow(int r, int hi) { return (r & 3) + 8 * (r >> 2) + 4 * hi; }
#define SBAR() __builtin_amdgcn_sched_barrier(0)
__device__ __forceinline__ void bmask(f32x16& p0, f32x16& p1, int kb, int qrel, int hi) {
    const float NEG = -INFINITY; const int d0 = kb + 4 * hi - qrel;
#pragma unroll
    for (int r = 0; r < 16; ++r) { const int d = d0 + (r & 3) + 8 * (r >> 2); if (d < -128 || d > 128) p0[r] = NEG; if (d + 32 < -128 || d + 32 > 128) p1[r] = NEG; }
}
constexpr int NSLOT = 3, SLOTB = 8192;
constexpr int LDS_K = 0, LDS_V = NSLOT * SLOTB, LDS_WS = 2 * NSLOT * SLOTB, LDS_OST = LDS_WS + NW * 64 * 4, LDS_BYTES_A = LDS_OST + NW * 4096;
constexpr float C2 = 0.125f * 1.4426950408889634f;
__device__ __forceinline__ void glds16(const void* gsrc, unsigned lds_dst) { unsigned keep;
    asm volatile("s_mov_b32 %0, m0\n\ts_mov_b32 m0, %2\n\ts_nop 0\n\tglobal_load_lds_dwordx4 %1, off\n\ts_mov_b32 m0, %0" : "=&s"(keep) : "v"(gsrc), "s"(lds_dst) : "memory"); }
__device__ __forceinline__ float max3f(float a, float b, float c) { float r; asm("v_max3_f32 %0, %1, %2, %3" : "=v"(r) : "v"(a), "v"(b), "v"(c)); return r; }
__device__ __forceinline__ float max2f(float a, float b) { float r; asm("v_max_f32_e32 %0, %1, %2" : "=v"(r) : "v"(a), "v"(b)); return r; }
__device__ __forceinline__ float fadd_s(float a, float b) { float r; asm("v_add_f32_e32 %0, %1, %2" : "=v"(r) : "v"(a), "v"(b)); return r; }
__device__ __forceinline__ float fsub_s(float a, float b) { float r; asm("v_sub_f32_e32 %0, %1, %2" : "=v"(r) : "v"(a), "v"(b)); return r; }
__device__ __forceinline__ unsigned cvtpk_s(float lo, float hi) { f32x2 v = {lo, hi}; bf16x2_t b = __builtin_convertvector(v, bf16x2_t); return __builtin_bit_cast(unsigned, b); }
#define WAIT_BAR(N) asm volatile("s_waitcnt vmcnt(" #N ") lgkmcnt(0)\n\ts_barrier" ::: "memory")
__device__ __forceinline__ void qkt(f32x16& p0, f32x16& p1, const char* Kslot, const bf16x8* qr, const f32x16& negm, int r32, int hi) {
    const char* kb = Kslot + hi * 1024 + r32 * 16;
#pragma unroll
    for (int d0 = 0; d0 < 4; ++d0) {
        const bf16x8 b0 = *reinterpret_cast<const bf16x8*>(kb + d0 * 2048);
        const bf16x8 b1 = *reinterpret_cast<const bf16x8*>(kb + d0 * 2048 + 512);
        if (d0 == 0) { p0 = __builtin_amdgcn_mfma_f32_32x32x16_bf16(b0, qr[0], negm, 0, 0, 0); p1 = __builtin_amdgcn_mfma_f32_32x32x16_bf16(b1, qr[0], negm, 0, 0, 0); }
        else { p0 = __builtin_amdgcn_mfma_f32_32x32x16_bf16(b0, qr[d0], p0, 0, 0, 0); p1 = __builtin_amdgcn_mfma_f32_32x32x16_bf16(b1, qr[d0], p1, 0, 0, 0); } }
}
typedef __attribute__((address_space(3))) const char* lds_cptr;
typedef short v4i16_t __attribute__((ext_vector_type(4)));
__device__ __forceinline__ void kload8(bf16x8* kf, lds_cptr kp) {
    kf[0] = *(const __attribute__((address_space(3))) bf16x8*)(kp);        kf[1] = *(const __attribute__((address_space(3))) bf16x8*)(kp + 512);
    kf[2] = *(const __attribute__((address_space(3))) bf16x8*)(kp + 2048); kf[3] = *(const __attribute__((address_space(3))) bf16x8*)(kp + 2560);
    kf[4] = *(const __attribute__((address_space(3))) bf16x8*)(kp + 4096); kf[5] = *(const __attribute__((address_space(3))) bf16x8*)(kp + 4608);
    kf[6] = *(const __attribute__((address_space(3))) bf16x8*)(kp + 6144); kf[7] = *(const __attribute__((address_space(3))) bf16x8*)(kp + 6656);
}
__device__ __forceinline__ void kload2(bf16x8* kf, lds_cptr kp, int j) { kf[2 * j] = *(const __attribute__((address_space(3))) bf16x8*)(kp + j * 2048); kf[2 * j + 1] = *(const __attribute__((address_space(3))) bf16x8*)(kp + j * 2048 + 512); }
__device__ __forceinline__ s16x4 vtr(lds_cptr p) { return __builtin_bit_cast(s16x4, __builtin_amdgcn_ds_read_tr16_b64_v4i16((__attribute__((address_space(3))) v4i16_t*)p)); }
__device__ __forceinline__ float rowmax(const f32x16& p0, const f32x16& p1) {
    float a = max3f(p0[0], p0[1], p1[0]), b = max3f(p0[2], p0[3], p1[1]); a = max3f(a, p1[2], p1[3]);
#pragma unroll
    for (int r = 4; r < 16; r += 4) { a = max3f(a, p0[r], p0[r + 1]); b = max3f(b, p0[r + 2], p0[r + 3]); a = max3f(a, p1[r], p1[r + 1]); b = max3f(b, p1[r + 2], p1[r + 3]); }
    const float m = max2f(a, b);
    auto rr = __builtin_amdgcn_permlane32_swap(__float_as_uint(m), __float_as_uint(m), false, false);
    return max2f(__uint_as_float(rr[0]), __uint_as_float(rr[1]));
}
__device__ __forceinline__ void pv(f32x16* o, int vb, bf16x8 pa0, bf16x8 pa1, bf16x8 pa2, bf16x8 pa3) {
#pragma unroll
    for (int d0 = 0; d0 < 2; ++d0) { s16x4 lo[4], hi[4];
#pragma unroll
        for (int ks = 0; ks < 4; ++ks) {
            asm volatile("ds_read_b64_tr_b16 %0,%1 offset:%c2" : "=&v"(lo[ks]) : "v"(vb), "i"(d0 * 4096 + ks * 1024) : "memory");
            asm volatile("ds_read_b64_tr_b16 %0,%1 offset:%c2" : "=&v"(hi[ks]) : "v"(vb), "i"(d0 * 4096 + ks * 1024 + 512) : "memory"); }
        asm volatile("s_waitcnt lgkmcnt(0)" ::: "memory"); SBAR();
#define PK(k) (bf16x8){lo[k][0], lo[k][1], lo[k][2], lo[k][3], hi[k][0], hi[k][1], hi[k][2], hi[k][3]}
        o[d0] = __builtin_amdgcn_mfma_f32_32x32x16_bf16(pa0, PK(0), o[d0], 0, 0, 0);
        o[d0] = __builtin_amdgcn_mfma_f32_32x32x16_bf16(pa1, PK(1), o[d0], 0, 0, 0);
        o[d0] = __builtin_amdgcn_mfma_f32_32x32x16_bf16(pa2, PK(2), o[d0], 0, 0, 0);
        o[d0] = __builtin_amdgcn_mfma_f32_32x32x16_bf16(pa3, PK(3), o[d0], 0, 0, 0);
#undef PK
    }
}
#define ATTN_STORE16(p, v) (*(u32x4*)(p) = (v))
template <int THRL> __device__ __forceinline__ void attn_unit(int b, int hk, int n, int pr, const bf16* QKV, bf16* O, const float* sinkp, char* shm) {
    int tid_ = threadIdx.x; asm volatile("" : "+v"(tid_));
    const int tid = tid_, lane = tid & 63, r32 = lane & 31, hi = lane >> 5; const int wid = __builtin_amdgcn_readfirstlane(tid >> 6);
    const int head = 4 * hk + 2 * pr + (wid >> 2);
    const long rowblk = (long)b * SEQ + n * 128;
    const long ctxrow = (long)NLAT + b * LCTX;
    const int nlo = n > 0 ? 2 : 0, nhi = n < (SEQ / 128 - 1) ? 2 : 0;
    const int NT = 6 + nlo + nhi;
    const bf16* Qw = QKV + (rowblk + (wid & 3) * QBLK) * PITCH + head * D;
    const bf16* Kc = QKV + 1024 + hk * D; const bf16* Vc = QKV + 1280 + hk * D;
    const unsigned lds0 = (unsigned)(uintptr_t)shm;
    float* wsf = (float*)(shm + LDS_WS) + wid * 64;
    const long klane = (long)lane * PITCH + wid * 8;
    const long vlane = (long)(16 * (wid & 3) + (lane >> 2)) * PITCH + (wid >> 2) * 32 + (lane & 3) * 8;
    const unsigned kdst = lds0 + LDS_K + wid * 1024, vdst = lds0 + LDS_V + wid * 1024;
#define TROW(t) (((t) < 2) ? (rowblk + 64 * (t)) : ((t) < 6) ? (ctxrow + 64 * ((t) - 2)) : (rowblk + ((((t) - 6) < nlo) ? (-128 + 64 * ((t) - 6)) : (128 + 64 * ((t) - 6 - nlo)))))
#define TKB(t) (((t) < 6) ? 0 : ((((t) - 6) < nlo) ? (-128 + 64 * ((t) - 6)) : (128 + 64 * ((t) - 6 - nlo))))
#define DMA_K(t, slot) glds16(Kc + TROW(t) * PITCH + klane, (unsigned)__builtin_amdgcn_readfirstlane(kdst + (slot)))
#define DMA_V(t, slot) glds16(Vc + TROW(t) * PITCH + vlane, (unsigned)__builtin_amdgcn_readfirstlane(vdst + (slot)))
    const int vb0 = (int)(lds0 + LDS_V) + ((lane >> 4) & 1) * 32 + (lane & 3) * 8 + (4 * hi + ((lane & 15) >> 2)) * 64;
    const char* Kbase = shm + LDS_K; bf16x8 kf[8];
    const lds_cptr shm3 = (lds_cptr)shm; const lds_cptr kp0 = shm3 + LDS_K + hi * 1024 + r32 * 16; const lds_cptr vp0 = shm3 + LDS_V + ((lane >> 4) & 1) * 32 + (lane & 3) * 8 + (4 * hi + ((lane & 15) >> 2)) * 64;
    DMA_K(0, 0); DMA_V(0, 0); DMA_K(1, SLOTB);
    bf16x8 qr[4];
#pragma unroll
    for (int d0 = 0; d0 < 4; ++d0) qr[d0] = *reinterpret_cast<const bf16x8*>(&Qw[(long)r32 * PITCH + d0 * 16 + hi * 8]);
    float mhat = 0.f, l_reg = 0.f; f32x16 o[2]; o[0] = f32x16{}; o[1] = f32x16{}; f32x16 negm = f32x16{}; asm volatile("" : "+v"(negm));
    const int qrel = (wid & 3) * QBLK + r32;
#define CMASK(P0, P1, t) do { int jb_ = (t) - (NT - 4); if (jb_ >= 0) bmask(P0, P1, TKB(t), qrel, hi); } while (0)
    bool resc = false;
#define START(P0, P1) do { const float rm = rowmax(P0, P1); resc = false; \
    { const float dl = rm; mhat = fadd_s(mhat, dl); \
      _Pragma("unroll") for (int r = 0; r < 16; ++r) { P0[r] = fsub_s(P0[r], dl); P1[r] = fsub_s(P1[r], dl); } \
      _Pragma("unroll") for (int r = 0; r < 16; ++r) negm[r] = -mhat; asm volatile("" : "+v"(negm)); } \
    _Pragma("unroll") for (int r = 0; r < 16; ++r) P0[r] = __builtin_amdgcn_exp2f(P0[r]); } while (0)
#define RESC() do { if (resc) { asm volatile("s_waitcnt lgkmcnt(0)" ::: "memory"); \
      _Pragma("unroll") for (int d_ = 0; d_ < 2; ++d_) _Pragma("unroll") for (int r = 0; r < 16; ++r) o[d_][r] *= wsf[crow(r, hi)]; } } while (0)
    f32x16 pA0, pA1, pB0, pB1;
    int sl_prev = 0, sl_cur = 0, sl_next = SLOTB;
#define ROT() do { sl_prev = sl_cur; sl_cur = sl_next; sl_next = (sl_next == (NSLOT - 1) * SLOTB) ? 0 : sl_next + SLOTB; } while (0)
    DMA_K(2, 2 * SLOTB);
    WAIT_BAR(3);
    qkt(pA0, pA1, Kbase, qr, negm, r32, hi); asm volatile("s_nop 15\n\ts_nop 7" : "+v"(pA0), "+v"(pA1));
    START(pA0, pA1);
    _Pragma("unroll") for (int r = 0; r < 16; ++r) pA1[r] = __builtin_amdgcn_exp2f(pA1[r]);
    WAIT_BAR(0);
    DMA_K(3, 0); DMA_V(1, SLOTB);
    ROT();
    kload8(kf, kp0 + sl_cur);
    WAIT_BAR(2);
    s16x4 vlo[8], vhi[8]; u32x4 pw0, pw1, pw2, pw3;
#define PKW(P, B) cvtpk_s(P[B], P[B + 1])
#define PAF(k) __builtin_bit_cast(bf16x8, pw##k)
#define VFR(i) (bf16x8){vlo[i][0], vlo[i][1], vlo[i][2], vlo[i][3], vhi[i][0], vhi[i][1], vhi[i][2], vhi[i][3]}
#define PIN(x) asm volatile("" : "+v"(x))
#define MX3(a, b, c) __builtin_fmaxf(__builtin_fmaxf((a), (b)), (c))
#define GAPA(MF, A0, A1, A2, A3, W0, W1, PW) do { MF; sacc += A0; sacc += A1; sacc += A2; sacc += A3; PIN(sacc); W0; W1; PIN(PW); SBAR(); } while (0)
#define EX(v) __builtin_amdgcn_exp2f(v)
#define GAPB(MF, X, B) do { MF; X[B] = EX(X[B]); X[B + 1] = EX(X[B + 1]); X[B + 2] = EX(X[B + 2]); X[B + 3] = EX(X[B + 3]); PIN(X); SBAR(); } while (0)
#define VRD(i) do { vlo[i] = vtr(vp_ + (((i) >> 2) * 4096 + ((i) & 3) * 1024)); vhi[i] = vtr(vp_ + (((i) >> 2) * 4096 + ((i) & 3) * 1024 + 512)); } while (0)
#define KRD(G, j) do { if (G) { kload2(kf, kp0 + sl_next, j); SBAR(); } } while (0)
#define STEP(C0, C1, P0, P1, t, GK, GV, GL) do { SBAR(); \
    const lds_cptr vp_ = vp0 + sl_prev; \
    VRD(0); SBAR(); float sacc = (P0[0] + P0[1]); \
    GAPA(C0 = __builtin_amdgcn_mfma_f32_32x32x16_bf16(kf[0], qr[0], negm, 0, 0, 0), P0[2], P0[3], P0[4], P0[5],     pw0[0] = PKW(P0, 0), pw0[1] = PKW(P0, 2), pw0); \
    VRD(4); SBAR(); GAPA(C1 = __builtin_amdgcn_mfma_f32_32x32x16_bf16(kf[1], qr[0], negm, 0, 0, 0), P0[6], P0[7], P0[8], P0[9],     pw0[2] = PKW(P0, 4), pw0[3] = PKW(P0, 6), pw0); \
    VRD(1); SBAR(); GAPA(C0 = __builtin_amdgcn_mfma_f32_32x32x16_bf16(kf[2], qr[1], C0, 0, 0, 0),   P0[10], P0[11], P0[12], P0[13], pw1[0] = PKW(P0, 8), pw1[1] = PKW(P0, 10), pw1); \
    VRD(5); SBAR(); GAPA(C1 = __builtin_amdgcn_mfma_f32_32x32x16_bf16(kf[3], qr[1], C1, 0, 0, 0),   P0[14], P0[15], P1[0], P1[1],   pw1[2] = PKW(P0, 12), pw1[3] = PKW(P0, 14), pw1); \
    VRD(2); SBAR(); GAPA(C0 = __builtin_amdgcn_mfma_f32_32x32x16_bf16(kf[4], qr[2], C0, 0, 0, 0),   P1[2], P1[3], P1[4], P1[5],     pw2[0] = PKW(P1, 0), pw2[1] = PKW(P1, 2), pw2); \
    VRD(6); SBAR(); GAPA(C1 = __builtin_amdgcn_mfma_f32_32x32x16_bf16(kf[5], qr[2], C1, 0, 0, 0),   P1[6], P1[7], P1[8], P1[9],     pw2[2] = PKW(P1, 4), pw2[3] = PKW(P1, 6), pw2); \
    VRD(3); SBAR(); GAPA(C0 = __builtin_amdgcn_mfma_f32_32x32x16_bf16(kf[6], qr[3], C0, 0, 0, 0),   P1[10], P1[11], P1[12], P1[13], pw3[0] = PKW(P1, 8), pw3[1] = PKW(P1, 10), pw3); \
    VRD(7); SBAR(); GAPA(C1 = __builtin_amdgcn_mfma_f32_32x32x16_bf16(kf[7], qr[3], C1, 0, 0, 0),   P1[14], P1[15], 0.f, 0.f,       pw3[2] = PKW(P1, 12), pw3[3] = PKW(P1, 14), pw3); \
    l_reg += sacc; \
    if (GK) { DMA_K((t) + 3, sl_cur); } if (GV) { DMA_V((t) + 1, sl_next); } \
    CMASK(C0, C1, t); \
    { float a = MX3(C0[0], C0[1], C1[0]), b = MX3(C0[2], C0[3], C1[1]); a = MX3(a, C1[2], C1[3]); \
      _Pragma("unroll") for (int r = 4; r < 16; r += 4) { a = MX3(a, C0[r], C0[r + 1]); b = MX3(b, C0[r + 2], C0[r + 3]); a = MX3(a, C1[r], C1[r + 1]); b = MX3(b, C1[r + 2], C1[r + 3]); } \
      float rm = __builtin_fmaxf(a, b); { auto rr = __builtin_amdgcn_permlane32_swap(__float_as_uint(rm), __float_as_uint(rm), false, false); rm = __builtin_fmaxf(__uint_as_float(rr[0]), __uint_as_float(rr[1])); } \
      resc = false; \
      if (__builtin_expect(__any(rm > (float)THRL), 0)) { const float dl = __builtin_fmaxf(rm, 0.f); mhat += dl; \
        _Pragma("unroll") for (int r = 0; r < 16; ++r) { C0[r] -= dl; C1[r] -= dl; } \
        _Pragma("unroll") for (int r = 0; r < 16; ++r) negm[r] = -mhat; asm volatile("" : "+v"(negm)); \
        const float f = __builtin_amdgcn_exp2f(-dl); l_reg *= f; if (hi == 0) wsf[r32] = f; resc = true; } } \
    SBAR(); \
    GAPB(o[0] = __builtin_amdgcn_mfma_f32_32x32x16_bf16(PAF(0), VFR(0), o[0], 0, 0, 0), C0, 0); \
    GAPB(o[1] = __builtin_amdgcn_mfma_f32_32x32x16_bf16(PAF(0), VFR(4), o[1], 0, 0, 0), C0, 4); \
    KRD(GL, 0); GAPB(o[0] = __builtin_amdgcn_mfma_f32_32x32x16_bf16(PAF(1), VFR(1), o[0], 0, 0, 0), C0, 8); \
    KRD(GL, 1); GAPB(o[1] = __builtin_amdgcn_mfma_f32_32x32x16_bf16(PAF(1), VFR(5), o[1], 0, 0, 0), C0, 12); \
    KRD(GL, 2); GAPB(o[0] = __builtin_amdgcn_mfma_f32_32x32x16_bf16(PAF(2), VFR(2), o[0], 0, 0, 0), C1, 0); \
    KRD(GL, 3); GAPB(o[1] = __builtin_amdgcn_mfma_f32_32x32x16_bf16(PAF(2), VFR(6), o[1], 0, 0, 0), C1, 4); \
    GAPB(o[0] = __builtin_amdgcn_mfma_f32_32x32x16_bf16(PAF(3), VFR(3), o[0], 0, 0, 0), C1, 8); \
    GAPB(o[1] = __builtin_amdgcn_mfma_f32_32x32x16_bf16(PAF(3), VFR(7), o[1], 0, 0, 0), C1, 12); \
    } while (0)
    int t = 1;
#undef CMASK
#define CMASK(P0, P1, t) do { } while (0)
    for (; t + 5 < NT; t += 2) {
        STEP(pB0, pB1, pA0, pA1, t, true, true, true);     WAIT_BAR(2); RESC(); ROT();
        STEP(pA0, pA1, pB0, pB1, t + 1, true, true, true); WAIT_BAR(2); RESC(); ROT();
    }
#undef CMASK
#define CMASK(P0, P1, t) do { int jb_ = (t) - (NT - 4); if (jb_ >= 0) bmask(P0, P1, TKB(t), qrel, hi); } while (0)
#define ENDW(tt) do { if ((tt) + 3 < NT) { WAIT_BAR(2); } else if ((tt) + 2 < NT) { WAIT_BAR(1); } else { WAIT_BAR(0); } } while (0)
    for (; t + 1 < NT; t += 2) {
        STEP(pB0, pB1, pA0, pA1, t, (t + 3 < NT), (t + 1 < NT), (t + 1 < NT));     ENDW(t);     RESC(); ROT();
        STEP(pA0, pA1, pB0, pB1, t + 1, (t + 4 < NT), (t + 2 < NT), (t + 2 < NT)); ENDW(t + 1); RESC(); ROT();
    }
    STEP(pB0, pB1, pA0, pA1, NT - 1, false, false, false); RESC();
    { float sacc = pB0[0] + pB0[1]; _Pragma("unroll") for (int r = 2; r < 16; ++r) sacc += pB0[r]; _Pragma("unroll") for (int r = 0; r < 16; ++r) sacc += pB1[r]; l_reg += sacc;
      pw0 = (u32x4){PKW(pB0, 0), PKW(pB0, 2), PKW(pB0, 4), PKW(pB0, 6)}; pw1 = (u32x4){PKW(pB0, 8), PKW(pB0, 10), PKW(pB0, 12), PKW(pB0, 14)}; pw2 = (u32x4){PKW(pB1, 0), PKW(pB1, 2), PKW(pB1, 4), PKW(pB1, 6)}; pw3 = (u32x4){PKW(pB1, 8), PKW(pB1, 10), PKW(pB1, 12), PKW(pB1, 14)};
      SBAR(); pv(o, vb0 + sl_cur, PAF(0), PAF(1), PAF(2), PAF(3)); }
#undef PKW
#undef PAF
#undef VFR
#undef PIN
#undef MX3
#undef GAPA
#undef GAPB
#undef EX
#undef VRD
#undef KRD
#undef STEP
#undef ENDW
    { auto rr = __builtin_amdgcn_permlane32_swap(__float_as_uint(l_reg), __float_as_uint(l_reg), false, false); l_reg = __uint_as_float(rr[0]) + __uint_as_float(rr[1]); }
    l_reg += __builtin_amdgcn_exp2f(sinkp[head] * 1.4426950408889634f - mhat);
    if (hi == 0) wsf[32 + r32] = l_reg; asm volatile("s_waitcnt lgkmcnt(0)" ::: "memory");
    float rli[16];
#pragma unroll
    for (int r = 0; r < 16; ++r) rli[r] = __builtin_amdgcn_rcpf(wsf[32 + crow(r, hi)]);
    bf16* Ow = O + (rowblk + (wid & 3) * QBLK) * OPITCH + head * D;
    { bf16* stg = (bf16*)(shm + LDS_OST) + wid * 2048;
#pragma unroll
      for (int r = 0; r < 16; ++r) { const int orow = crow(r, hi);
#pragma unroll
        for (int d0 = 0; d0 < 2; ++d0) stg[orow * 64 + d0 * 32 + r32] = __float2bfloat16(o[d0][r] * rli[r]); }
      asm volatile("s_waitcnt lgkmcnt(0)" ::: "memory");
#pragma unroll
      for (int i = 0; i < 4; ++i) { const int row = i * 8 + (lane >> 3), ch = lane & 7; const u32x4 v = *(const u32x4*)(stg + row * 64 + ch * 8); ATTN_STORE16(Ow + (long)row * OPITCH + ch * 8, v); } }
    asm volatile("s_waitcnt lgkmcnt(0)\n\ts_barrier" ::: "memory");
#undef DMA_K
#undef DMA_V
#undef TROW
#undef TKB
#undef CMASK
#undef START
#undef RESC
#undef ROT
}
#undef SBAR
#undef WAIT_BAR
}

#define XB_TMO      128
#define XB_XCNT(j)  (256  + 64 * (j))
#define XB_XSUB(j)  (1280 + 64 * (j))
#define XB_XGEN(j)  (2304 + 64 * (j))
#define XB_TOP      3328
#define XB_TOPGEN   3392
#define XCD_BAR_WORDS 3456
#define XB_SPIN_CAP (1u << 18)
__device__ __forceinline__ unsigned xb_ld(unsigned* p)              { return __hip_atomic_load(p, __ATOMIC_RELAXED, __HIP_MEMORY_SCOPE_AGENT); }
__device__ __forceinline__ unsigned xb_add(unsigned* p, unsigned v) { return __hip_atomic_fetch_add(p, v, __ATOMIC_RELAXED, __HIP_MEMORY_SCOPE_AGENT); }
__device__ __forceinline__ unsigned xb_xcc_id() { return (unsigned)__builtin_amdgcn_s_getreg((3 << 11) | 20) & 0xFu; }
#define XB_SPIN(cond, bar) do { unsigned _sp = 0; while (cond) { __builtin_amdgcn_s_sleep(1); \
    if ((++_sp & 255u) == 0u) { if (xb_ld(&(bar)[XB_TMO])) break; if (_sp > XB_SPIN_CAP) { atomicAdd(&(bar)[XB_TMO], 1u); break; } } } } while (0)
struct XcdBarrier { unsigned* bar; unsigned x; volatile LAS unsigned* st; };
__device__ __forceinline__ XcdBarrier xcd_barrier_post(unsigned* bar, volatile LAS unsigned* st) {
    XcdBarrier b; b.bar = bar; b.x = xb_xcc_id(); b.st = st;
    if (threadIdx.x == 0) (void)xb_add(&bar[XB_XCNT(b.x)], 1u);
    return b;
}
__device__ __forceinline__ void xcd_barrier_complete(unsigned* bar, unsigned x, unsigned& nloc, unsigned& nx) {
    const unsigned G = gridDim.x * gridDim.y * gridDim.z;
    unsigned sum, cnt, mine, sp = 0u;
    for (;;) {
        sum = 0u; cnt = 0u; mine = 0u;
#pragma unroll
        for (unsigned j = 0; j < 16; ++j) { const unsigned c = xb_ld(&bar[XB_XCNT(j)]); sum += c; cnt += (c > 0u) ? 1u : 0u; mine = (j == x) ? c : mine; }
        if (sum == G) break;
        __builtin_amdgcn_s_sleep(1);
        if ((++sp & 255u) == 0u) { if (xb_ld(&bar[XB_TMO])) break; if (sp > XB_SPIN_CAP) { atomicAdd(&bar[XB_TMO], 1u); break; } }
    }
    nloc = mine > 0u ? mine : 1u; nx = cnt > 0u ? cnt : 1u;
}
__device__ __forceinline__ void xcd_barrier(const XcdBarrier& b) {
    asm volatile("s_waitcnt vmcnt(0)" ::: "memory");
    __syncthreads();
    if (threadIdx.x == 0) {
        unsigned* bar = b.bar;
        __builtin_amdgcn_s_waitcnt(0);
        unsigned nloc = b.st[0], nx = b.st[1];
        if (nloc == 0u) { xcd_barrier_complete(bar, b.x, nloc, nx); b.st[0] = nloc; b.st[1] = nx; }
        const unsigned old = xb_add(&bar[XB_XSUB(b.x)], 1u);
        const unsigned gen = old / nloc;
        if (old + 1u == (gen + 1u) * nloc) {
            __builtin_amdgcn_fence(__ATOMIC_RELEASE, "agent");
            asm volatile("s_waitcnt vmcnt(0)" ::: "memory");
            const unsigned og = xb_add(&bar[XB_TOP], 1u);
            const unsigned tg = og / nx;
            if (og + 1u == (tg + 1u) * nx) xb_add(&bar[XB_TOPGEN], 1u);
            else XB_SPIN(xb_ld(&bar[XB_TOPGEN]) == tg, bar);
            __builtin_amdgcn_fence(__ATOMIC_ACQUIRE, "agent");
            xb_add(&bar[XB_XGEN(b.x)], 1u);
            asm volatile("s_waitcnt vmcnt(0)" ::: "memory");
        } else {
            XB_SPIN(xb_ld(&bar[XB_XGEN(b.x)]) == gen, bar);
            __builtin_amdgcn_fence(__ATOMIC_ACQUIRE, "agent");
            asm volatile("s_waitcnt vmcnt(0)" ::: "memory");
        }
    }
    __syncthreads();
}

#define LDS_WAIT() asm volatile("s_waitcnt lgkmcnt(0)" ::: "memory")
__device__ __forceinline__ void transpose_item(const float* W, int K, int N, bf16_t* WT, int k0, int n0, int drow0, LAS float* scr, int lane) {
    float t[32];
#pragma unroll
    for (int i = 0; i < 32; ++i) t[i] = __builtin_nontemporal_load(W + (size_t)(k0 + 2 * i + (lane >> 5)) * N + n0 + (lane & 31));
#pragma unroll
    for (int i = 0; i < 32; ++i) scr[(2 * i + (lane >> 5)) * 33 + (lane & 31)] = t[i];
    LDS_WAIT(); asm volatile("" ::: "memory");
    const int c = lane & 7;
#pragma unroll
    for (int j = 0; j < 4; ++j) { const int n = (lane >> 3) + 8 * j; const LAS float* s = scr + (8 * c) * 33 + n;
        u32x4 o; o.x = pkbf(s[0 * 33], s[1 * 33]); o.y = pkbf(s[2 * 33], s[3 * 33]); o.z = pkbf(s[4 * 33], s[5 * 33]); o.w = pkbf(s[6 * 33], s[7 * 33]);
        *(GAS u32x4*)(WT + (size_t)(drow0 + n) * K + k0 + 8 * c) = o; }
    LDS_WAIT(); asm volatile("" ::: "memory");
}
__device__ __forceinline__ void transpose_item_f8(const float* W, int K, int N, unsigned char* WT, int k0, int n0, int drow0, float scale, LAS float* scr, int lane) {
    float t[32];
#pragma unroll
    for (int i = 0; i < 32; ++i) t[i] = __builtin_nontemporal_load(W + (size_t)(k0 + 2 * i + (lane >> 5)) * N + n0 + (lane & 31));
#pragma unroll
    for (int i = 0; i < 32; ++i) scr[(2 * i + (lane >> 5)) * 33 + (lane & 31)] = t[i];
    LDS_WAIT(); asm volatile("" ::: "memory");
    const int n = lane >> 1, hf = lane & 1; const LAS float* sp = scr + (32 * hf) * 33 + n;
    u32x4 o0, o1;
    o0.x = pk4f8(sp[0 * 33] * scale, sp[1 * 33] * scale, sp[2 * 33] * scale, sp[3 * 33] * scale);     o0.y = pk4f8(sp[4 * 33] * scale, sp[5 * 33] * scale, sp[6 * 33] * scale, sp[7 * 33] * scale);
    o0.z = pk4f8(sp[8 * 33] * scale, sp[9 * 33] * scale, sp[10 * 33] * scale, sp[11 * 33] * scale);   o0.w = pk4f8(sp[12 * 33] * scale, sp[13 * 33] * scale, sp[14 * 33] * scale, sp[15 * 33] * scale);
    o1.x = pk4f8(sp[16 * 33] * scale, sp[17 * 33] * scale, sp[18 * 33] * scale, sp[19 * 33] * scale); o1.y = pk4f8(sp[20 * 33] * scale, sp[21 * 33] * scale, sp[22 * 33] * scale, sp[23 * 33] * scale);
    o1.z = pk4f8(sp[24 * 33] * scale, sp[25 * 33] * scale, sp[26 * 33] * scale, sp[27 * 33] * scale); o1.w = pk4f8(sp[28 * 33] * scale, sp[29 * 33] * scale, sp[30 * 33] * scale, sp[31 * 33] * scale);
    GAS u32x4* dst = (GAS u32x4*)(WT + (size_t)(drow0 + n) * K + k0 + 32 * hf);
    dst[0] = o0; dst[1] = o1;
    LDS_WAIT(); asm volatile("" ::: "memory");
}
__device__ __forceinline__ unsigned pk4i8(float a, float b, float c, float d) {
    const int ia = (int)__builtin_rintf(a), ib = (int)__builtin_rintf(b), ic = (int)__builtin_rintf(c), id = (int)__builtin_rintf(d);
    return (unsigned)(ia & 255) | ((unsigned)(ib & 255) << 8) | ((unsigned)(ic & 255) << 16) | ((unsigned)(id & 255) << 24); }
__device__ __forceinline__ void transpose_item_i8(const float* W, int K, int N, unsigned char* WT, int k0, int n0, int drow0, float scale, LAS float* scr, int lane) {
    float t[32];
#pragma unroll
    for (int i = 0; i < 32; ++i) t[i] = W[(size_t)(k0 + 2 * i + (lane >> 5)) * N + n0 + (lane & 31)];
#pragma unroll
    for (int i = 0; i < 32; ++i) scr[(2 * i + (lane >> 5)) * 33 + (lane & 31)] = t[i];
    LDS_WAIT(); asm volatile("" ::: "memory");
    const int n = lane >> 1, hf = lane & 1; const LAS float* sp = scr + (32 * hf) * 33 + n;
    u32x4 o0, o1;
    o0.x = pk4i8(sp[0 * 33] * scale, sp[1 * 33] * scale, sp[2 * 33] * scale, sp[3 * 33] * scale);     o0.y = pk4i8(sp[4 * 33] * scale, sp[5 * 33] * scale, sp[6 * 33] * scale, sp[7 * 33] * scale);
    o0.z = pk4i8(sp[8 * 33] * scale, sp[9 * 33] * scale, sp[10 * 33] * scale, sp[11 * 33] * scale);   o0.w = pk4i8(sp[12 * 33] * scale, sp[13 * 33] * scale, sp[14 * 33] * scale, sp[15 * 33] * scale);
    o1.x = pk4i8(sp[16 * 33] * scale, sp[17 * 33] * scale, sp[18 * 33] * scale, sp[19 * 33] * scale); o1.y = pk4i8(sp[20 * 33] * scale, sp[21 * 33] * scale, sp[22 * 33] * scale, sp[23 * 33] * scale);
    o1.z = pk4i8(sp[24 * 33] * scale, sp[25 * 33] * scale, sp[26 * 33] * scale, sp[27 * 33] * scale); o1.w = pk4i8(sp[28 * 33] * scale, sp[29 * 33] * scale, sp[30 * 33] * scale, sp[31 * 33] * scale);
    GAS u32x4* dst = (GAS u32x4*)(WT + (size_t)(drow0 + n) * K + k0 + 32 * hf);
    dst[0] = o0; dst[1] = o1;
    LDS_WAIT(); asm volatile("" ::: "memory");
}
__device__ __forceinline__ void sincos_d(double x, double& s, double& c) {
    const double TWO_PI = 6.283185307179586476925;
    const double k = __builtin_rint(x / TWO_PI); const double r = x - k * TWO_PI;
    const double r2 = r * r; double ts = r, tc = 1.0; s = r; c = 1.0;
    for (int i = 1; i <= 16; ++i) { tc *= -r2 / (double)((2 * i - 1) * (2 * i)); ts *= -r2 / (double)((2 * i) * (2 * i + 1)); c += tc; s += ts; }
}

constexpr int CI_F = 16 * 112, CI_FD = 56 * 32, MOE_ITEMS = 8 * (2 * CI_F + CI_FD);
constexpr int MOE_TAIL_A = 12000, MOE_TAIL_B = 7000, MOE_TAIL_C = 12000, MOE_TAIL_TOTAL = MOE_TAIL_A + MOE_TAIL_B + MOE_TAIL_C;
__device__ __forceinline__ void moe_convert_item(int r, const float* wg, const float* wu, const float* wd, unsigned char* mgu, unsigned char* md, LAS float* scr, int lane) {
    const int e = r / (2 * CI_F + CI_FD); int q = r % (2 * CI_F + CI_FD);
    if (q < 2 * CI_F) { const int up = q / CI_F; q %= CI_F; const int kb = q / 112, nb = q % 112, n0 = 32 * nb;
        transpose_item_f8((up ? wu : wg) + (size_t)e * 1024 * DFF, 1024, DFF, mgu + (size_t)e * 7168 * 1024, 64 * kb, n0, 256 * (n0 >> 7) + 128 * up + (n0 & 127), MOE_SGU, scr, lane); }
    else { q -= 2 * CI_F; const int kb = q / 32, nb = q % 32; transpose_item_f8(wd + (size_t)e * DFF * 1024, DFF, 1024, md + (size_t)e * 1024 * DFF, 64 * kb, 32 * nb, 32 * nb, MOE_SD, scr, lane); }
}
__device__ __forceinline__ void moe_convert_tail(int nunits, int G, int bx, int first, int count, const float* wg, const float* wu, const float* wd, unsigned char* mgu, unsigned char* md, LAS unsigned char* lds) {
    const int busy = nunits % G; if (busy == 0 || bx < busy) return;
    int tid_ = threadIdx.x; asm volatile("" : "+v"(tid_)); const int lane = tid_ & 63, wave = __builtin_amdgcn_readfirstlane(tid_ >> 6);
    LAS float* scr = (LAS float*)(lds + wave * 16384);
    const int nw = (G - busy) * 8, w = (bx - busy) * 8 + wave;
    for (int it = w; it < count; it += nw) moe_convert_item(first + it, wg, wu, wd, mgu, md, scr, lane);
}

struct Args { const float* in[24]; float* out; unsigned char* ws; int ph_lo, ph_hi, li, pad; };
constexpr int NPH = 18;

__device__ __forceinline__ void norm_store(const f32x4 (&v)[4], float ssum, const float* g, const float* mrow, int shc, int scc, bf16_t* XNo, size_t m, int lane, float* rsc) {
    const float rstd = 1.0f / __builtin_sqrtf(ssum * (1.0f / DM) + EPS);
    f32x4 y[4];
#pragma unroll
    for (int j = 0; j < 4; ++j) { const f32x4 gv = *(const f32x4*)(g + 4 * lane + 256 * j), sc = *(const f32x4*)(mrow + scc * 1024 + 4 * lane + 256 * j), sh = *(const f32x4*)(mrow + shc * 1024 + 4 * lane + 256 * j);
        y[j] = (v[j] * rstd) * gv * (sc + 1.0f) + sh; }
    if (rsc == nullptr) {
#pragma unroll
        for (int j = 0; j < 4; ++j) { u32x2 w; w.x = pkbf(y[j].x, y[j].y); w.y = pkbf(y[j].z, y[j].w); *((GAS u32x2*)(XNo + m * DM) + lane + 64 * j) = w; }
    } else {
        float mx = 0.f;
#pragma unroll
        for (int j = 0; j < 4; ++j) mx = __builtin_fmaxf(__builtin_fmaxf(mx, __builtin_fmaxf(__builtin_fabsf(y[j].x), __builtin_fabsf(y[j].y))), __builtin_fmaxf(__builtin_fabsf(y[j].z), __builtin_fabsf(y[j].w)));
#pragma unroll
        for (int o = 1; o < 64; o <<= 1) mx = __builtin_fmaxf(mx, __shfl_xor(mx, o));
        mx = __builtin_fmaxf(mx, 1e-20f); const float qs = 127.0f / mx;
#pragma unroll
        for (int j = 0; j < 4; ++j) *((GAS unsigned*)((unsigned char*)XNo + m * DM) + lane + 64 * j) = pk4i8(y[j].x * qs, y[j].y * qs, y[j].z * qs, y[j].w * qs);
        if (lane == 0) rsc[m] = mx * (1.0f / 127.0f);
    }
}
template <bool SRC_BF16> __device__ __forceinline__ void norm_rows(const void* srcLv, const float* srcC, int nrows, const float* g, const float* mod, int shc, int scc, bf16_t* XNo, int gw, int NGW, int lane,
                                          const float* part, int nS, const float* gatec, float* zout, float* rsc = nullptr) {
    if (nrows > NLAT) {
        for (int rc = gw; rc < NCTXR; rc += NGW) {
            const GAS f32x4* xr = (const GAS f32x4*)(srcC + (size_t)rc * DM) + lane;
            f32x4 v[4];
#pragma unroll
            for (int j = 0; j < 4; ++j) v[j] = xr[64 * j];
            if (part != nullptr) {
                f32x4 a[4];
#pragma unroll
                for (int j = 0; j < 4; ++j) a[j] = (f32x4){0.f, 0.f, 0.f, 0.f};
                for (int s0 = 0; s0 < nS; s0 += 7) {
                    f32x4 t[7][4];
#pragma unroll
                    for (int q = 0; q < 7; ++q) { const int s2 = (s0 + q < nS) ? s0 + q : s0; const GAS f32x4* pr = (const GAS f32x4*)(part + ((size_t)s2 * NCTXR + rc) * DM) + lane;
#pragma unroll
                        for (int j = 0; j < 4; ++j) t[q][j] = pr[64 * j]; }
#pragma unroll
                    for (int q = 0; q < 7; ++q) if (s0 + q < nS) {
#pragma unroll
                        for (int j = 0; j < 4; ++j) a[j] += t[q][j]; }
                }
#pragma unroll
                for (int j = 0; j < 4; ++j) v[j] += *(const f32x4*)(gatec + 4 * lane + 256 * j) * a[j];
                if (zout != nullptr) { GAS f32x4* zr = (GAS f32x4*)(zout + (size_t)rc * DM) + lane;
#pragma unroll
                    for (int j = 0; j < 4; ++j) zr[64 * j] = v[j]; }
            }
            float ss = 0.f;
#pragma unroll
            for (int j = 0; j < 4; ++j) ss += (v[j].x * v[j].x + v[j].y * v[j].y) + (v[j].z * v[j].z + v[j].w * v[j].w);
            norm_store(v, wave_sum(ss), g, mod + (size_t)4 * 6144, shc, scc, XNo, (size_t)NLAT + rc, lane, rsc);
        }
    }
    for (int m0 = gw * 4; m0 < NLAT; m0 += NGW * 4) {
        const int mb = m0 >> 13;
        f32x4 v[4][4];
        if constexpr (SRC_BF16) { const GAS u32x2* xr = (const GAS u32x2*)((const bf16_t*)srcLv + (size_t)m0 * DM) + lane;
#pragma unroll
            for (int r = 0; r < 4; ++r)
#pragma unroll
                for (int j = 0; j < 4; ++j) { const u32x2 w = xr[r * 256 + 64 * j]; v[r][j] = (f32x4){__uint_as_float(w.x << 16), __uint_as_float(w.x & 0xffff0000u), __uint_as_float(w.y << 16), __uint_as_float(w.y & 0xffff0000u)}; } }
        else { const GAS f32x4* xr = (const GAS f32x4*)((const float*)srcLv + (size_t)m0 * DM) + lane;
#pragma unroll
            for (int r = 0; r < 4; ++r)
#pragma unroll
                for (int j = 0; j < 4; ++j) v[r][j] = xr[r * 256 + 64 * j]; }
        float ss[4];
#pragma unroll
        for (int r = 0; r < 4; ++r) { ss[r] = 0.f;
#pragma unroll
            for (int j = 0; j < 4; ++j) ss[r] += (v[r][j].x * v[r][j].x + v[r][j].y * v[r][j].y) + (v[r][j].z * v[r][j].z + v[r][j].w * v[r][j].w); }
#pragma unroll
        for (int o = 1; o < 64; o <<= 1) {
#pragma unroll
            for (int r = 0; r < 4; ++r) ss[r] += __shfl_xor(ss[r], o); }
#pragma unroll
        for (int r = 0; r < 4; ++r) norm_store(v[r], ss[r], g, mod + (size_t)mb * 6144, shc, scc, XNo, (size_t)(m0 + r), lane, rsc);
    }
}

__global__ void __launch_bounds__(512, 2) fwd(Args args) {
    extern __shared__ __attribute__((aligned(16))) unsigned char lds_raw[];
    LAS unsigned char* lds = (LAS unsigned char*)lds_raw;
    volatile LAS unsigned* MISC = (volatile LAS unsigned*)(lds + MISC_OFF);
    LAS int* gtab = (LAS int*)(lds + GTAB_OFF);
    const int G = gridDim.x; const int bx = blockIdx.x; const int vcu = (G % 8 == 0) ? (bx % 8) * (G / 8) + bx / 8 : bx;
    const int NGW = G * 8;
#define PHASE_IDS() int tid_ = threadIdx.x; asm volatile("" : "+v"(tid_)); const int tid = tid_, lane = tid & 63, wave = __builtin_amdgcn_readfirstlane(tid >> 6), gw = vcu * 8 + wave; (void)lane; (void)gw
    unsigned char* ws = args.ws;
    gu32* ctl = (gu32*)(ws + WS_CTL);
#define MOD ((float*)(ws + WS_MOD))
#define ROPE ((float*)(ws + WS_ROPE))
#define STATS ((float*)(ws + WS_STATS))
#define RSC ((float*)(ws + WS_RSC))
#define LIST ((int*)(ws + WS_LIST))
#define TINFO ((int*)(ws + WS_TINFO))
#define WSB ((bf16_t*)(ws + WS_WS))
#define WIN ((bf16_t*)(ws + WS_WIN))
#define WAO ((bf16_t*)(ws + WS_WAO))
#define WQKV ((unsigned char*)(ws + WS_WQKV))
#define WBO ((bf16_t*)(ws + WS_WBO))
#define WGU ((unsigned char*)(ws + WS_WGU))
#define WD ((bf16_t*)(ws + WS_WD))
#define MGU ((unsigned char*)(ws + WS_MGU))
#define MD ((unsigned char*)(ws + WS_MD))
#define XN8 ((unsigned char*)(ws + WS_XN))
#define XN ((bf16_t*)(ws + WS_XN))
#define ZB ((float*)(ws + WS_ZB))
#define UVT ((bf16_t*)(ws + WS_UVT))
#define A2 ((bf16_t*)(ws + WS_A2))
#define HB ((bf16_t*)(ws + WS_H))
#define QKV ((bf16_t*)(ws + WS_QKV))
#define OB ((bf16_t*)(ws + WS_O))
#define YB ((bf16_t*)(ws + WS_Y))
#define HC ((unsigned char*)(ws + WS_HC))
#define YP ((bf16_t*)(ws + WS_YP))
#define PART1 ((float*)(ws + WS_PART1))
#define PART2 ((float*)(ws + WS_PART2))
#define I_X (args.in[0])
#define I_C (args.in[1])
#define I_CTX (args.in[2])
#define I_CCTX (args.in[3])
#define I_ADAW (args.in[4])
#define I_ADAB (args.in[5])
#define I_NORMG (args.in[6])
#define I_FINALG (args.in[7])
#define HL ((bf16_t*)(ws + WS_HLB))

    { PHASE_IDS(); for (int u = tid; u < (LDS_BYTES - MISC_OFF) / 4; u += 512) ((LAS unsigned*)(lds + MISC_OFF))[u] = 0u; }
    __syncthreads();
    const int lo = args.ph_lo, hi_ph = args.ph_hi;
    const bool one_launch = (hi_ph - lo) > 1;
    XcdBarrier bar; bar.bar = (unsigned*)(ctl + CW_BAR) + args.li * XCD_BAR_WORDS; bar.x = 0; bar.st = nullptr;
    if (one_launch) bar = xcd_barrier_post((unsigned*)(ctl + CW_BAR) + args.li * XCD_BAR_WORDS, MISC + 8);
#ifndef PHMASK
#define PHMASK 0xFFFFFFFFu
#endif
#define IN(k) (((PHMASK >> (k)) & 1) && lo <= (k) && (k) < hi_ph)
#define BOTH(k) (IN(k) && IN((k) + 1))
#define GRID_BAR() xcd_barrier(bar)
#if defined(PROBE_LO)
    unsigned long long tpA = __builtin_amdgcn_s_memrealtime(), tpB = 0;
#define PROBE_MARK(k) do { if ((k) == PROBE_LO - 1) tpA = __builtin_amdgcn_s_memrealtime(); if ((k) == PROBE_HI) tpB = __builtin_amdgcn_s_memrealtime(); } while (0)
#else
#define PROBE_MARK(k) do { } while (0)
#endif

    if (IN(0)) {
        PHASE_IDS();
        {
            LAS float* sv = (LAS float*)lds;
            LAS float* red = (LAS float*)(lds + 5 * 1024 * 4);
            if (bx < 192) {
                for (int idx = tid; idx < 5 * 1024; idx += 512) { const int r = idx >> 10, k = idx & 1023; const float cv = r < 4 ? I_C[r * 1024 + k] : I_CCTX[k]; sv[idx] = cv / (1.0f + __expf(-cv)); }
                __syncthreads();
                for (int item = bx; item < 192; item += G) {
                    const int i = item / 96, n0 = (item % 96) * 64, nn = tid & 63, kq = tid >> 6;
                    float a0 = 0.f, a1 = 0.f, a2 = 0.f, a3 = 0.f, a4 = 0.f;
                    const float* wp = I_ADAW + ((size_t)i * 1024 + kq * 128) * 6144 + n0 + nn;
#pragma unroll 8
                    for (int k = 0; k < 128; ++k) { const float w = wp[(size_t)k * 6144]; const int kk = kq * 128 + k;
                        a0 += sv[kk] * w; a1 += sv[1024 + kk] * w; a2 += sv[2048 + kk] * w; a3 += sv[3072 + kk] * w; a4 += sv[4096 + kk] * w; }
                    red[(kq * 5 + 0) * 64 + nn] = a0; red[(kq * 5 + 1) * 64 + nn] = a1; red[(kq * 5 + 2) * 64 + nn] = a2; red[(kq * 5 + 3) * 64 + nn] = a3; red[(kq * 5 + 4) * 64 + nn] = a4;
                    __syncthreads();
                    if (tid < 320) { const int r = tid >> 6; float s = I_ADAB[i * 6144 + n0 + nn];
#pragma unroll
                        for (int q = 0; q < 8; ++q) s += red[(q * 5 + r) * 64 + nn];
                        MOD[((size_t)i * 5 + r) * 6144 + n0 + nn] = s; }
                    __syncthreads();
                }
            }
            __syncthreads();
        }
        {
            LAS float* scr = (LAS float*)(lds + wave * 16384);
            constexpr int I_IN = 16 * 64, I_AO = 16 * 32, I_QKV = 16 * 48, I_BO = 16 * 32, I_F = 16 * 112, I_FD = 56 * 32;
            constexpr int I_DENSE = I_IN + I_AO + I_QKV + I_BO + 2 * I_F + I_FD, I_MOE = MOE_ITEMS, I_WS = 128, I_ROPE = 32;
            constexpr int NITEMS = I_DENSE + I_MOE + I_WS + I_ROPE;
            for (int it = gw; it < NITEMS; it += NGW) {
                int r = it;
                if (r < I_IN) { const int kb = r / 64, nb = r % 64; transpose_item(args.in[8], 1024, 2048, WIN, 64 * kb, 32 * nb, 32 * nb, scr, lane); continue; } r -= I_IN;
                if (r < I_AO) { const int kb = r / 32, nb = r % 32; transpose_item(args.in[13], 1024, 1024, WAO, 64 * kb, 32 * nb, 32 * nb, scr, lane); continue; } r -= I_AO;
                if (r < I_QKV) { const int kb = r / 48, nb = r % 48; const float* W = args.in[14]; float mx = 0.f;
#pragma unroll
                    for (int i = 0; i < 32; ++i) mx = __builtin_fmaxf(mx, __builtin_fabsf(W[(size_t)(64 * kb + 2 * i + (lane >> 5)) * NQKV + 32 * nb + (lane & 31)]));
#pragma unroll
                    for (int o = 1; o < 64; o <<= 1) mx = __builtin_fmaxf(mx, __shfl_xor(mx, o));
                    if (lane == 0) __hip_atomic_fetch_max((unsigned*)(ctl + CW_WAMAX + 128), __float_as_uint(mx), __ATOMIC_RELAXED, __HIP_MEMORY_SCOPE_AGENT);
                    continue; } r -= I_QKV;
                if (r < I_BO) { const int kb = r / 32, nb = r % 32; transpose_item(args.in[16], 1024, 1024, WBO, 64 * kb, 32 * nb, 32 * nb, scr, lane); continue; } r -= I_BO;
                if (r < 2 * I_F) { const int up = r / I_F; const int q = r % I_F; const int kb = q / 112, nb = q % 112;
                    const float* W = args.in[17 + up]; float mx = 0.f;
#pragma unroll
                    for (int i = 0; i < 32; ++i) mx = __builtin_fmaxf(mx, __builtin_fabsf(W[(size_t)(64 * kb + 2 * i + (lane >> 5)) * DFF + 32 * nb + (lane & 31)]));
#pragma unroll
                    for (int o = 1; o < 64; o <<= 1) mx = __builtin_fmaxf(mx, __shfl_xor(mx, o));
                    if (lane == 0) __hip_atomic_fetch_max((unsigned*)(ctl + CW_WAMAX + 64 * up), __float_as_uint(mx), __ATOMIC_RELAXED, __HIP_MEMORY_SCOPE_AGENT);
                    continue; } r -= 2 * I_F;
                if (r < I_FD) { const int kb = r / 32, nb = r % 32; transpose_item(args.in[19], DFF, 1024, WD, 64 * kb, 32 * nb, 32 * nb, scr, lane); continue; } r -= I_FD;
                if (r < I_MOE) { if (r >= MOE_TAIL_TOTAL) moe_convert_item(r, args.in[21], args.in[22], args.in[23], MGU, MD, scr, lane); continue; } r -= I_MOE;
                if (r < I_WS) { const float* src = args.in[11] + (size_t)r * 2048;
#pragma unroll
                    for (int j = 0; j < 8; ++j) { const f32x4 v = *(const f32x4*)(src + j * 256 + lane * 4); u32x2 w; w.x = pkbf(v.x, v.y); w.y = pkbf(v.z, v.w); *(u32x2*)(WSB + (size_t)r * 2048 + j * 256 + lane * 4) = w; }
                    continue; } r -= I_WS;
                {
                    const int ent = r * 64 + lane; const int pos = ent >> 4, i = ent & 15;
                    double inv = 1.0; for (int q = 0; q < i; ++q) inv *= 0.56234132519034908;
                    const float ang = (float)pos * (float)inv; double s, c; sincos_d((double)ang, s, c);
                    ROPE[ent] = (float)c; ROPE[2048 + ent] = (float)s;
                }
            }
        }
        if (BOTH(0)) GRID_BAR(); PROBE_MARK(0);
    }
    if (IN(1)) { PHASE_IDS();
        {
            LAS float* scr = (LAS float*)(lds + wave * 16384);
            const float ag = __uint_as_float(__hip_atomic_load((unsigned*)(ctl + CW_WAMAX), __ATOMIC_RELAXED, __HIP_MEMORY_SCOPE_AGENT)), au = __uint_as_float(__hip_atomic_load((unsigned*)(ctl + CW_WAMAX + 64), __ATOMIC_RELAXED, __HIP_MEMORY_SCOPE_AGENT));
            if (gw == 0 && lane == 0) { RSC[MALL] = ag * (1.0f / 127.0f); RSC[MALL + 1] = au * (1.0f / 127.0f); }
            const float aq = __uint_as_float(__hip_atomic_load((unsigned*)(ctl + CW_WAMAX + 128), __ATOMIC_RELAXED, __HIP_MEMORY_SCOPE_AGENT));
            if (gw == 0 && lane == 0) RSC[MALL + 2] = aq * (1.0f / 127.0f);
            for (int it = gw; it < 16 * 48; it += NGW) { const int kb = it / 48, nb = it % 48; transpose_item_i8(args.in[14], 1024, NQKV, WQKV, 64 * kb, 32 * nb, 32 * nb, 127.0f / aq, scr, lane); }
            for (int it = gw; it < 2 * 16 * 112; it += NGW) { const int up = it / (16 * 112), q = it % (16 * 112), kb = q / 112, nb = q % 112, n0 = 32 * nb;
                transpose_item_i8(args.in[17 + up], 1024, DFF, WGU, 64 * kb, n0, 256 * (n0 >> 7) + 128 * up + (n0 & 127), 127.0f / (up ? au : ag), scr, lane); }
        }
        norm_rows<false>(I_X, I_CTX, MALL, I_NORMG + 0 * 1024, MOD, 0, 1, XN, gw, NGW, lane, nullptr, 0, nullptr, nullptr); if (BOTH(1)) GRID_BAR(); PROBE_MARK(1); }
    if (IN(2)) {
        pg8::DenseSched S{(const char*)WIN, (const char*)XN, 8, NPA, G, bx, (size_t)256 * 1024 * 2};
        pg8::EpiGeluT E{UVT, STATS};
        pg8::gemm_phase<pg8::EpiGeluT, pg8::DenseSched, true, false>(lds, gtab, 1024, 16, S, E);
        moe_convert_tail(8 * NPA, G, bx, 0, MOE_TAIL_A, args.in[21], args.in[22], args.in[23], MGU, MD, lds);
        if (BOTH(2)) GRID_BAR(); PROBE_MARK(2);
    }
    if (IN(3)) {
        PHASE_IDS();
        const float* vg = args.in[9]; const float* vb = args.in[10]; const float* bs = args.in[12];
        LAS unsigned char* buf = lds + wave * 16384;
        LAS float* mu_l = (LAS float*)(lds + RING_BYTES + 4096 + wave * 1024); LAS float* rs_l = mu_l + 128;
        const int r32 = lane & 31, h = lane >> 5;
        for (int unit = gw; unit < (MALL / 128) * 32; unit += NGW) {
            const int ph = unit & 1, g = (unit >> 1) & 15, ch = unit >> 5, q0 = ch * 128;
#pragma unroll
            for (int tt = 0; tt < 2; ++tt) { const int tok = q0 + lane * 2 + tt; const f32x4* sp = (const f32x4*)(STATS + (size_t)tok * 16);
                const f32x4 a = sp[0], b = sp[1], c = sp[2], d = sp[3];
                const float sum = (a.x + a.z) + (b.x + b.z) + (c.x + c.z) + (d.x + d.z), sq = (a.y + a.w) + (b.y + b.w) + (c.y + c.w) + (d.y + d.w);
                const float mean = sum * (1.0f / 1024.0f), var = sq * (1.0f / 1024.0f) - mean * mean;
                mu_l[lane * 2 + tt] = mean; rs_l[lane * 2 + tt] = 1.0f / __builtin_sqrtf(var + EPS); }
            {
                u32x4 t[16]; const int rw = lane >> 4, ck = lane & 15;
                const bf16_t* vp = UVT + (size_t)(1024 + 64 * g + rw) * MALL + q0 + ck * 8;
#pragma unroll
                for (int i = 0; i < 16; ++i) { t[i] = *(const u32x4*)vp; vp += (size_t)4 * MALL; asm volatile("" : "+v"(vp)); }
#pragma unroll
                for (int i = 0; i < 16; ++i) { const int row = 4 * i + rw; *(LAS u32x4*)(buf + row * 256 + ((ck ^ (row & 15)) << 4)) = t[i]; }
            }
            bf16x8 af[2][8];
#pragma unroll
            for (int ct = 0; ct < 2; ++ct) { const int row = 32 * ct + r32; const float vgc = vg[64 * g + row], vbc = vb[64 * g + row];
#pragma unroll
                for (int s2 = 0; s2 < 8; ++s2) { const int qs = 16 * s2 + 8 * h, ck = 2 * s2 + h;
                    const f32x4 m0 = *(const LAS f32x4*)(mu_l + qs), m1 = *(const LAS f32x4*)(mu_l + qs + 4), r0 = *(const LAS f32x4*)(rs_l + qs), r1 = *(const LAS f32x4*)(rs_l + qs + 4);
                    const bf16x8 raw = *(const LAS bf16x8*)(buf + row * 256 + ((ck ^ (row & 15)) << 4));
                    float y[8];
#pragma unroll
                    for (int j = 0; j < 4; ++j) { y[j] = (bf2f((unsigned short)raw[j]) - m0[j]) * r0[j] * vgc + vbc; y[4 + j] = (bf2f((unsigned short)raw[4 + j]) - m1[j]) * r1[j] * vgc + vbc; }
                    u32x4 w; w.x = pkbf(y[0], y[1]); w.y = pkbf(y[2], y[3]); w.z = pkbf(y[4], y[5]); w.w = pkbf(y[6], y[7]); af[ct][s2] = __builtin_bit_cast(bf16x8, w); } }
            {
                u32x4 t[8]; const int rw = lane >> 3, ck = lane & 7;
                const bf16_t* up = UVT + (size_t)(64 * g + rw) * MALL + q0 + 64 * ph + ck * 8;
#pragma unroll
                for (int i = 0; i < 8; ++i) { t[i] = *(const u32x4*)up; up += (size_t)8 * MALL; asm volatile("" : "+v"(up)); }
#pragma unroll
                for (int i = 0; i < 8; ++i) { const int row = 8 * i + rw; *(LAS u32x4*)(buf + row * 128 + ((ck ^ (row & 7)) << 4)) = t[i]; }
            }
#pragma unroll
            for (int ptl = 0; ptl < 2; ++ptl) {
                const int pl = 32 * ptl + r32, p = 64 * ph + pl; const float bsv = bs[g * 128 + p];
                bf16x8 bfr[8];
#pragma unroll
                for (int s2 = 0; s2 < 8; ++s2) bfr[s2] = *(const bf16x8*)(WSB + (size_t)(g * 128 + p) * 128 + 16 * s2 + 8 * h);
                f32x16 acc[2]; acc[0] = f32x16{}; acc[1] = f32x16{};
#pragma unroll
                for (int s2 = 0; s2 < 8; ++s2)
#pragma unroll
                    for (int ct = 0; ct < 2; ++ct) acc[ct] = __builtin_amdgcn_mfma_f32_32x32x16_bf16(af[ct][s2], bfr[s2], acc[ct], 0, 0, 0);
#pragma unroll
                for (int ct = 0; ct < 2; ++ct)
#pragma unroll
                    for (int rr = 0; rr < 4; ++rr) { const int c = 32 * ct + 8 * rr + 4 * h; float o[4];
#pragma unroll
                        for (int e = 0; e < 4; ++e) { const int cc = c + e; const float uu = bf2f(*(const LAS unsigned short*)(buf + cc * 128 + (((pl >> 3) ^ (cc & 7)) << 4) + (pl & 7) * 2)); o[e] = uu * (acc[ct][4 * rr + e] + bsv); }
                        u32x2 w; w.x = pkbf(o[0], o[1]); w.y = pkbf(o[2], o[3]);
                        *(LAS u32x2*)(buf + 8192 + pl * 128 + (((c >> 3) ^ (pl & 7)) << 4) + (c & 7) * 2) = w; }
            }
            {
                const int rw = lane >> 3, ck = lane & 7;
#pragma unroll
                for (int i = 0; i < 8; ++i) { const int row = 8 * i + rw; const u32x4 v = *(const LAS u32x4*)(buf + 8192 + row * 128 + ((ck ^ (row & 7)) << 4));
                    *(u32x4*)(A2 + (size_t)(q0 + 64 * ph + row) * DM + 64 * g + ck * 8) = v; }
            }
        }
        if (BOTH(3)) GRID_BAR(); PROBE_MARK(3);
    }
    if (IN(4)) {
        { pg8::DenseSched S{(const char*)A2, (const char*)WAO, NPL, 4, G, bx, (size_t)256 * 1024 * 2};
          pg8::EpiResid<true> E{I_X, nullptr, HL, MOD + 2 * 1024};
          pg8::gemm_phase<pg8::EpiResid<true>, pg8::DenseSched, true, false>(lds, gtab, 1024, 16, S, E); }
        { pg8::SplitSched S{(const char*)(A2 + (size_t)NLAT * DM), (const char*)WAO, 4, 4, P3_NS, G, bx, NPL, (size_t)256 * 1024 * 2, (size_t)(1024 / P3_NS) * 2};
          pg8::EpiPartF32 E{PART1, (size_t)NCTXR * DM};
          pg8::gemm_phase<pg8::EpiPartF32, pg8::SplitSched, true, false>(lds, gtab, 1024, 1024 / P3_NS / 64, S, E); }
        if (BOTH(4)) GRID_BAR(); PROBE_MARK(4);
    }
    if (IN(5)) { PHASE_IDS(); norm_rows<true>(HL, I_CTX, MALL, I_NORMG + 1 * 1024, MOD, 3, 4, XN, gw, NGW, lane, PART1, P3_NS, MOD + 4 * 6144 + 2 * 1024, ZB, RSC); if (BOTH(5)) GRID_BAR(); PROBE_MARK(5); }
    if (IN(6)) {
        pg8::DenseSched S{(const char*)XN8, (const char*)WGU, NPA, 28, G, bx, (size_t)256 * 1024};
        pg8::EpiSwiGLUI8 E{HB, RSC, RSC + MALL};
        pg8::gemm_phase<pg8::EpiSwiGLUI8, pg8::DenseSched, true, false, false, true>(lds, gtab, 512, 8, S, E);
        moe_convert_tail(NPA * 28, G, bx, MOE_TAIL_A, MOE_TAIL_B, args.in[21], args.in[22], args.in[23], MGU, MD, lds);
        if (BOTH(6)) GRID_BAR(); PROBE_MARK(6);
    }
    if (IN(7)) {
        { pg8::DenseSched S{(const char*)HB, (const char*)WD, NPL, 4, G, bx, (size_t)256 * DFF * 2};
          pg8::EpiResid<false> E{nullptr, HL, HL, MOD + 5 * 1024};
          pg8::gemm_phase<pg8::EpiResid<false>, pg8::DenseSched, true, false>(lds, gtab, DFF, 56, S, E); }
        { pg8::SplitSched S{(const char*)(HB + (size_t)NLAT * DFF), (const char*)WD, 4, 4, P5_NS, G, bx, NPL, (size_t)256 * DFF * 2, (size_t)(DFF / P5_NS) * 2};
          pg8::EpiPartF32 E{PART2, (size_t)NCTXR * DM};
          pg8::gemm_phase<pg8::EpiPartF32, pg8::SplitSched, true, false>(lds, gtab, DFF, DFF / P5_NS / 64, S, E); }
        if (BOTH(7)) GRID_BAR(); PROBE_MARK(7);
    }
    if (IN(8)) { PHASE_IDS(); norm_rows<true>(HL, ZB, MALL, I_NORMG + 2 * 1024, MOD + 5 * 6144, 0, 1, XN, gw, NGW, lane, PART2, P5_NS, MOD + 4 * 6144 + 5 * 1024, nullptr, RSC); if (BOTH(8)) GRID_BAR(); PROBE_MARK(8); }
    if (IN(9)) {
        pg8::DenseSched S{(const char*)XN8, (const char*)WQKV, NPA, 6, G, bx, (size_t)256 * 1024};
        pg8::EpiQKV E{QKV, ROPE, ROPE + 2048, attn_body::C2, RSC, RSC + MALL + 2};
        pg8::gemm_phase<pg8::EpiQKV, pg8::DenseSched, true, false, false, true>(lds, gtab, 512, 8, S, E);
        moe_convert_tail(NPA * 6, G, bx, MOE_TAIL_A + MOE_TAIL_B, MOE_TAIL_C, args.in[21], args.in[22], args.in[23], MGU, MD, lds);
        if (BOTH(9)) GRID_BAR(); PROBE_MARK(9);
    }
    if (IN(10)) {
        static_assert(attn_body::LDS_BYTES_A <= RING_BYTES, "attention LDS");
        const float* sinkp = args.in[15];
        for (int i = 0;; ++i) { const int uid = i * G + vcu; if (uid >= NB * 64 * 4 * 2) break;
            const int pr = uid & 1, hk = (uid >> 1) & 3, n = (uid >> 3) & 63, b = uid >> 9;
            attn_body::attn_unit<8>(b, hk, n, pr, (const attn_body::bf16*)QKV, (attn_body::bf16*)OB, sinkp, (char*)lds_raw); }
        if (BOTH(10)) GRID_BAR(); PROBE_MARK(10);
    }
    if (IN(11)) {
        pg8::DenseSched S{(const char*)OB, (const char*)WBO, NPL, 4, G, bx, (size_t)256 * 1024 * 2};
        pg8::EpiResid<false> E{nullptr, HL, HL, MOD + 5 * 6144 + 2 * 1024};
        pg8::gemm_phase<pg8::EpiResid<false>, pg8::DenseSched, true, false>(lds, gtab, 1024, 16, S, E);
        if (BOTH(11)) GRID_BAR(); PROBE_MARK(11);
    }
    if (IN(12)) {
        PHASE_IDS();
        const float* g = I_NORMG + 3 * 1024; const float* mod = MOD + 5 * 6144; const float* wrt = args.in[20];
        LAS int* l_e = (LAS int*)lds;
        LAS float* l_w = (LAS float*)(lds + 1024);
        LAS int* l_cnt = (LAS int*)(lds + 2048);
        LAS int* l_base = (LAS int*)(lds + 2048 + 64);
        for (int blk = bx; blk < NLAT / 128; blk += G) {
            if (tid < 8) l_cnt[tid] = 0;
            __syncthreads();
            const int mb = (blk * 128) >> 13; const float* mrow = mod + (size_t)mb * 6144;
            for (int i4 = 0; i4 < 8; ++i4) {
                const int tl0 = wave * 16 + i4 * 2, m0 = blk * 128 + tl0;
                const GAS u32x2* xr = (const GAS u32x2*)(HL + (size_t)m0 * DM) + lane;
                f32x4 v[2][4]; float ss[2];
#pragma unroll
                for (int r = 0; r < 2; ++r)
#pragma unroll
                    for (int j = 0; j < 4; ++j) { const u32x2 w = xr[r * 256 + 64 * j]; v[r][j] = (f32x4){__uint_as_float(w.x << 16), __uint_as_float(w.x & 0xffff0000u), __uint_as_float(w.y << 16), __uint_as_float(w.y & 0xffff0000u)}; }
#pragma unroll
                for (int r = 0; r < 2; ++r) { ss[r] = 0.f;
#pragma unroll
                    for (int j = 0; j < 4; ++j) ss[r] += (v[r][j].x * v[r][j].x + v[r][j].y * v[r][j].y) + (v[r][j].z * v[r][j].z + v[r][j].w * v[r][j].w); }
#pragma unroll
                for (int o = 1; o < 64; o <<= 1) {
#pragma unroll
                    for (int r = 0; r < 2; ++r) ss[r] += __shfl_xor(ss[r], o); }
                float lg[2][8];
#pragma unroll
                for (int r = 0; r < 2; ++r)
#pragma unroll
                    for (int e = 0; e < 8; ++e) lg[r][e] = 0.f;
#pragma unroll
                for (int j = 0; j < 4; ++j) { const int col = 4 * lane + 256 * j; const f32x4 gv = *(const f32x4*)(g + col), sc = *(const f32x4*)(mrow + 4 * 1024 + col), sh = *(const f32x4*)(mrow + 3 * 1024 + col);
                    const f32x4 gm = gv * (sc + 1.0f);
                    f32x4 y[2];
#pragma unroll
                    for (int r = 0; r < 2; ++r) { const float rstd = 1.0f / __builtin_sqrtf(ss[r] * (1.0f / DM) + EPS); y[r] = (v[r][j] * rstd) * gm + sh;
                        *((GAS unsigned*)(XN8 + (size_t)(m0 + r) * DM) + lane + 64 * j) = pk4f8(y[r].x, y[r].y, y[r].z, y[r].w); }
#pragma unroll
                    for (int cc = 0; cc < 4; ++cc) { const f32x4 w0 = *(const f32x4*)(wrt + (size_t)(col + cc) * 8), w1 = *(const f32x4*)(wrt + (size_t)(col + cc) * 8 + 4);
#pragma unroll
                        for (int r = 0; r < 2; ++r) { const float yv = y[r][cc];
                            lg[r][0] += yv * w0.x; lg[r][1] += yv * w0.y; lg[r][2] += yv * w0.z; lg[r][3] += yv * w0.w; lg[r][4] += yv * w1.x; lg[r][5] += yv * w1.y; lg[r][6] += yv * w1.z; lg[r][7] += yv * w1.w; } } }
#pragma unroll
                for (int o = 1; o < 64; o <<= 1) {
#pragma unroll
                    for (int r = 0; r < 2; ++r)
#pragma unroll
                        for (int e = 0; e < 8; ++e) lg[r][e] += __shfl_xor(lg[r][e], o); }
#pragma unroll
                for (int r = 0; r < 2; ++r) {
                    int ea = 0; float va = lg[r][0];
#pragma unroll
                    for (int e = 1; e < 8; ++e) if (lg[r][e] > va) { va = lg[r][e]; ea = e; }
                    int eb = -1; float vb2 = -INFINITY;
#pragma unroll
                    for (int e = 0; e < 8; ++e) if (e != ea && lg[r][e] > vb2) { vb2 = lg[r][e]; eb = e; }
                    const float wb = 1.0f / (1.0f + __expf(va - vb2)), wa = 1.0f - wb;
                    if (lane == 0) { const int tl = tl0 + r; l_e[tl * 2] = ea; l_e[tl * 2 + 1] = eb; l_w[tl * 2] = wa; l_w[tl * 2 + 1] = wb; } }
            }
            __syncthreads();
            int ea = 0, eb = 0, pa = 0, pb = 0;
            if (tid < 128) { ea = l_e[tid * 2]; eb = l_e[tid * 2 + 1]; pa = atomicAdd((int*)&l_cnt[ea], 1); pb = atomicAdd((int*)&l_cnt[eb], 1); }
            __syncthreads();
            if (tid < 8) l_base[tid] = (int)__hip_atomic_fetch_add((unsigned*)(ctl + CW_CNT + 64 * tid), (unsigned)l_cnt[tid], __ATOMIC_RELAXED, __HIP_MEMORY_SCOPE_AGENT);
            __syncthreads();
            if (tid < 128) { const int m = blk * 128 + tid; pa += l_base[ea]; pb += l_base[eb];
                LIST[(size_t)ea * NLAT + pa] = m; LIST[(size_t)eb * NLAT + pb] = m;
                int* ti = TINFO + (size_t)m * 8; ti[0] = ea; ti[1] = pa; ti[2] = eb; ti[3] = pb; ti[4] = __float_as_int(l_w[tid * 2]); ti[5] = __float_as_int(l_w[tid * 2 + 1]); }
            __syncthreads();
        }
        if (BOTH(12)) GRID_BAR(); PROBE_MARK(12);
    }
    if (hi_ph > 13 && lo < 17) {
        PHASE_IDS();
        LAS int* mtab = (LAS int*)(lds + MOE_OFF);
        if (tid == 0) { int run = 0, R = 0;
            for (int e = 0; e < 8; ++e) { const int ce = (int)__hip_atomic_load((unsigned*)(ctl + CW_CNT + 64 * e), __ATOMIC_RELAXED, __HIP_MEMORY_SCOPE_AGENT); mtab[e] = run; mtab[16 + e] = ce; run += ce >> 8; if (ce & 255) { mtab[24 + R] = e; ++R; } }
            mtab[8] = run; mtab[32] = R; }
        __syncthreads();
        const int nfull = __builtin_amdgcn_readfirstlane(mtab[8]);
        for (int c = 0; c < MOE_NCH; ++c) {
            const int gp0 = c * MOE_CH, gp1 = nfull < (c + 1) * MOE_CH ? nfull : (c + 1) * MOE_CH;
            if (IN(13 + 2 * c)) {
                { pg8::MoeSched S; S.A = (const char*)XN8; S.B = (const char*)MGU; S.list = LIST; S.tab = mtab; S.mode = 0; S.nS = 1; S.kbytes = 0; S.omoff = 0;
                  S.gp0 = gp0; S.gp1 = gp1; S.nN = 28; S.G = G; S.c = bx; S.bexp = (size_t)7168 * 1024; S.btile = (size_t)256 * 1024; S.astep = 0; S.gather = true;
                  pg8::EpiSwiGLU8 E{HC, 1.0f / MOE_SGU};
                  pg8::gemm_phase<pg8::EpiSwiGLU8, pg8::MoeSched, true, true, true>(lds, gtab, 512, 8, S, E); }
                if (c == 0) { pg8::MoeSched S; S.A = (const char*)XN8; S.B = (const char*)MGU; S.list = LIST; S.tab = mtab; S.mode = 1; S.nS = 1; S.kbytes = 0; S.omoff = MOE_CH;
                  S.gp0 = 0; S.gp1 = 0; S.nN = 28; S.G = G; S.c = bx; S.bexp = (size_t)7168 * 1024; S.btile = (size_t)256 * 1024; S.astep = 0; S.gather = true;
                  pg8::EpiSwiGLU8 E{HC, 1.0f / MOE_SGU};
                  pg8::gemm_phase<pg8::EpiSwiGLU8, pg8::MoeSched, true, true, true>(lds, gtab, 512, 8, S, E); }
                if (BOTH(13 + 2 * c)) GRID_BAR(); PROBE_MARK(13 + 2 * c);
            }
            if (IN(14 + 2 * c)) {
                { pg8::MoeSched S; S.A = (const char*)HC; S.B = (const char*)MD; S.list = LIST; S.tab = mtab; S.mode = 0; S.nS = 1; S.kbytes = 0; S.omoff = 0;
                  S.gp0 = gp0; S.gp1 = gp1; S.nN = 4; S.G = G; S.c = bx; S.bexp = (size_t)1024 * DFF; S.btile = (size_t)256 * DFF; S.astep = (size_t)256 * DFF; S.gather = false;
                  pg8::EpiBf16Plain E{YB, DM, 1.0f / MOE_SD};
                  pg8::gemm_phase<pg8::EpiBf16Plain, pg8::MoeSched, true, false, true>(lds, gtab, DFF / 2, 28, S, E); }
                if (c == 0) { pg8::MoeSched S; S.A = (const char*)(HC + (size_t)MOE_CH * 256 * DFF); S.B = (const char*)MD; S.list = LIST; S.tab = mtab; S.mode = 2; S.nS = MOE_RS; S.kbytes = (size_t)(DFF / MOE_RS); S.omoff = 0;
                  S.gp0 = 0; S.gp1 = 0; S.nN = 4; S.G = G; S.c = bx; S.bexp = (size_t)1024 * DFF; S.btile = (size_t)256 * DFF; S.astep = (size_t)256 * DFF; S.gather = false;
                  pg8::EpiPartBf16 E{YP, (size_t)8 * 256 * DM, 1.0f / MOE_SD};
                  pg8::gemm_phase<pg8::EpiPartBf16, pg8::MoeSched, true, false, true>(lds, gtab, DFF / 2, DFF / MOE_RS / 128, S, E); }
                if (BOTH(14 + 2 * c)) GRID_BAR(); PROBE_MARK(14 + 2 * c);
            }
        }
    }
    if (IN(17)) {
        PHASE_IDS();
        LAS int* l_pb = (LAS int*)(lds + wave * 128);
        if (lane == 0) { int run = 0, R = 0;
            for (int e = 0; e < 8; ++e) { const int ce = (int)__hip_atomic_load((unsigned*)(ctl + CW_CNT + 64 * e), __ATOMIC_RELAXED, __HIP_MEMORY_SCOPE_AGENT); l_pb[e] = run; l_pb[8 + e] = ce >> 8; l_pb[16 + e] = R; run += ce >> 8; if (ce & 255) ++R; } }
        const float* g2 = MOD + 5 * 6144 + 5 * 1024;
        for (int m0 = gw * 2; m0 < NLAT; m0 += NGW * 2) {
            const int mb = m0 >> 13;
            f32x4 hv[2][4], ya[2][4], yb[2][4]; float wa[2], wb[2];
#pragma unroll
            for (int r = 0; r < 2; ++r) {
                const int m = m0 + r; const int* ti = TINFO + (size_t)m * 8;
                const int ea = ti[0], pa = ti[1], eb = ti[2], pb = ti[3]; wa[r] = __int_as_float(ti[4]); wb[r] = __int_as_float(ti[5]);
                const bool ma = (pa >> 8) < l_pb[8 + ea], mbm = (pb >> 8) < l_pb[8 + eb];
                const size_t sa = ma ? (size_t)(l_pb[ea] + (pa >> 8)) * 256 + (pa & 255) : (size_t)l_pb[16 + ea] * 256 + (pa & 255);
                const size_t sb = mbm ? (size_t)(l_pb[eb] + (pb >> 8)) * 256 + (pb & 255) : (size_t)l_pb[16 + eb] * 256 + (pb & 255);
                const GAS u32x2* xr = (const GAS u32x2*)(HL + (size_t)m * DM) + lane;
#pragma unroll
                for (int j = 0; j < 4; ++j) { const u32x2 w = xr[64 * j]; hv[r][j] = (f32x4){__uint_as_float(w.x << 16), __uint_as_float(w.x & 0xffff0000u), __uint_as_float(w.y << 16), __uint_as_float(w.y & 0xffff0000u)}; }
                { const GAS u32x2* yr = (const GAS u32x2*)((ma ? YB : YP) + sa * DM) + lane;
#pragma unroll
                  for (int j = 0; j < 4; ++j) { const u32x2 a = yr[64 * j]; ya[r][j] = (f32x4){__uint_as_float(a.x << 16), __uint_as_float(a.x & 0xffff0000u), __uint_as_float(a.y << 16), __uint_as_float(a.y & 0xffff0000u)}; }
                  if (!ma) for (int s2 = 1; s2 < MOE_RS; ++s2) { const GAS u32x2* y2 = (const GAS u32x2*)(YP + ((size_t)s2 * 8 * 256 + sa) * DM) + lane;
#pragma unroll
                      for (int j = 0; j < 4; ++j) { const u32x2 a = y2[64 * j]; ya[r][j] += (f32x4){__uint_as_float(a.x << 16), __uint_as_float(a.x & 0xffff0000u), __uint_as_float(a.y << 16), __uint_as_float(a.y & 0xffff0000u)}; } } }
                { const GAS u32x2* yr = (const GAS u32x2*)((mbm ? YB : YP) + sb * DM) + lane;
#pragma unroll
                  for (int j = 0; j < 4; ++j) { const u32x2 a = yr[64 * j]; yb[r][j] = (f32x4){__uint_as_float(a.x << 16), __uint_as_float(a.x & 0xffff0000u), __uint_as_float(a.y << 16), __uint_as_float(a.y & 0xffff0000u)}; }
                  if (!mbm) for (int s2 = 1; s2 < MOE_RS; ++s2) { const GAS u32x2* y2 = (const GAS u32x2*)(YP + ((size_t)s2 * 8 * 256 + sb) * DM) + lane;
#pragma unroll
                      for (int j = 0; j < 4; ++j) { const u32x2 a = y2[64 * j]; yb[r][j] += (f32x4){__uint_as_float(a.x << 16), __uint_as_float(a.x & 0xffff0000u), __uint_as_float(a.y << 16), __uint_as_float(a.y & 0xffff0000u)}; } } }
            }
            float ss[2];
#pragma unroll
            for (int r = 0; r < 2; ++r) { ss[r] = 0.f;
#pragma unroll
                for (int j = 0; j < 4; ++j) { const f32x4 gv = *(const f32x4*)(g2 + (size_t)mb * 6144 + 4 * lane + 256 * j);
                    hv[r][j] = hv[r][j] + gv * (ya[r][j] * wa[r] + yb[r][j] * wb[r]); ss[r] += (hv[r][j].x * hv[r][j].x + hv[r][j].y * hv[r][j].y) + (hv[r][j].z * hv[r][j].z + hv[r][j].w * hv[r][j].w); } }
#pragma unroll
            for (int o = 1; o < 64; o <<= 1) {
#pragma unroll
                for (int r = 0; r < 2; ++r) ss[r] += __shfl_xor(ss[r], o); }
#pragma unroll
            for (int r = 0; r < 2; ++r) { const float rstd = 1.0f / __builtin_sqrtf(ss[r] * (1.0f / DM) + EPS);
                GAS f32x4* orow = (GAS f32x4*)(args.out + (size_t)(m0 + r) * DM) + lane;
#pragma unroll
                for (int j = 0; j < 4; ++j) { const f32x4 fg = *(const f32x4*)(I_FINALG + 4 * lane + 256 * j); __builtin_nontemporal_store((hv[r][j] * rstd) * fg, orow + 64 * j); } }
        }
    }
    PROBE_MARK(17);
#if defined(PROBE_LO)
    { PHASE_IDS(); const float T = (float)(tpB - tpA) * 0.01f; const float cval = __builtin_sqrtf(T / (float)(PROBE_UNIT));
      for (int m = gw; m < NLAT; m += NGW) { GAS f32x4* orow = (GAS f32x4*)(args.out + (size_t)m * DM) + lane;
#pragma unroll
        for (int j = 0; j < 4; ++j) orow[64 * j] = (f32x4){cval, cval, cval, cval}; } }
#endif
#undef IN
#undef BOTH
#undef GRID_BAR
}

#ifndef MK_ONE_LAUNCH
#define MK_ONE_LAUNCH 1
#endif
extern "C" void kernel_launch(void* const* d_in, const int* in_sizes, int n_in, void* d_out, int out_size, void* d_ws, size_t ws_size, hipStream_t stream) {
    static int grid = 0;
    if (grid == 0) {
        if (n_in != 24 || out_size != NLAT * DM || ws_size < WS_END) { fprintf(stderr, "kernel_launch: unexpected problem (n_in %d, out %d, ws %zu < %zu)\n", n_in, out_size, ws_size, (size_t)WS_END); grid = -1; return; }
        int dev = 0, cus = 0, per_cu = 0;
        if (hipGetDevice(&dev) != hipSuccess || hipDeviceGetAttribute(&cus, hipDeviceAttributeMultiprocessorCount, dev) != hipSuccess) { grid = -1; return; }
        if (hipFuncSetAttribute((const void*)fwd, hipFuncAttributeMaxDynamicSharedMemorySize, LDS_BYTES) != hipSuccess) { fprintf(stderr, "kernel_launch: hipFuncSetAttribute failed\n"); grid = -1; return; }
        if (hipOccupancyMaxActiveBlocksPerMultiprocessor(&per_cu, (const void*)fwd, 512, LDS_BYTES) != hipSuccess || per_cu < 1) fprintf(stderr, "kernel_launch: occupancy query says %d\n", per_cu);
        (void)hipGetLastError();
        grid = cus;
    }
    if (grid < 0) return;
    if (hipMemsetAsync((char*)d_ws + WS_CTL, 0, CTL_ZERO_BYTES, stream) != hipSuccess) return;
    Args a{};
    for (int i = 0; i < 24; ++i) a.in[i] = (const float*)d_in[i];
    a.out = (float*)d_out; a.ws = (unsigned char*)d_ws;
#if defined(SPLITAT)
    a.ph_lo = 0; a.ph_hi = SPLITAT; a.li = 0;
    hipLaunchKernelGGL(fwd, dim3(grid), dim3(512), LDS_BYTES, stream, a);
    a.ph_lo = SPLITAT; a.ph_hi = NPH; a.li = 1;
    hipLaunchKernelGGL(fwd, dim3(grid), dim3(512), LDS_BYTES, stream, a);
#elif defined(DUPK)
    a.ph_lo = 0; a.ph_hi = DUPK + 1; a.li = 0;
    hipLaunchKernelGGL(fwd, dim3(grid), dim3(512), LDS_BYTES, stream, a);
#ifdef DUPN
    for (int rep = 0; rep < DUPN; ++rep) { a.ph_lo = DUPK; a.ph_hi = DUPK + 1; a.li = 2; hipLaunchKernelGGL(fwd, dim3(grid), dim3(512), LDS_BYTES, stream, a); }
#endif
    a.ph_lo = DUPK; a.ph_hi = NPH; a.li = 1;
    hipLaunchKernelGGL(fwd, dim3(grid), dim3(512), LDS_BYTES, stream, a);
#elif MK_ONE_LAUNCH
    a.ph_lo = 0; a.ph_hi = NPH;
    hipLaunchKernelGGL(fwd, dim3(grid), dim3(512), LDS_BYTES, stream, a);
#else
    for (int p = 0; p < NPH; ++p) { a.ph_lo = p; a.ph_hi = p + 1; hipLaunchKernelGGL(fwd, dim3(grid), dim3(512), LDS_BYTES, stream, a); }
#endif
}
```

```cpp
#include <hip/hip_runtime.h>
#include <hip/hip_bf16.h>
#include <cstdio>
#include <cstdint>
#include <cmath>

constexpr int DM = 1024, NB = 4, SEQ = 8192, LCTX = 256, NLAT = NB * SEQ, NCTXR = NB * LCTX, MALL = NLAT + NCTXR;
constexpr int DFF = 3584, NEXP = 8, NQKV = 1536;
constexpr int NPL = NLAT / 256, NPA = MALL / 256;
constexpr float EPS = 1e-6f;
constexpr int MOE_CH = 128, MOE_NCH = 2;
constexpr float MOE_SGU = 32.0f, MOE_SD = 64.0f;
constexpr int MOE_RS = 7, P3_NS = 8, P5_NS = 14;

#define LAS __attribute__((address_space(3)))
#define GAS __attribute__((address_space(1)))
typedef unsigned short bf16_t;
typedef short bf16x8 __attribute__((ext_vector_type(8)));
typedef float f32x4 __attribute__((ext_vector_type(4)));
typedef float f32x2 __attribute__((ext_vector_type(2)));
typedef float f32x16 __attribute__((ext_vector_type(16)));
typedef unsigned u32x4 __attribute__((ext_vector_type(4)));
typedef unsigned u32x2 __attribute__((ext_vector_type(2)));
typedef __bf16 bf16x2_t __attribute__((ext_vector_type(2)));
typedef GAS unsigned gu32;

__device__ __forceinline__ unsigned pkbf(float lo, float hi) { f32x2 v = {lo, hi}; bf16x2_t b = __builtin_convertvector(v, bf16x2_t); return __builtin_bit_cast(unsigned, b); }
__device__ __forceinline__ unsigned pk4f8(float a, float b, float c, float d) { unsigned w = 0; w = __builtin_amdgcn_cvt_pk_fp8_f32(a, b, w, false); w = __builtin_amdgcn_cvt_pk_fp8_f32(c, d, w, true); return w; }
__device__ __forceinline__ float bf2f(unsigned short h) { return __builtin_bit_cast(float, (unsigned)h << 16); }
__device__ __forceinline__ float wave_sum(float v) {
#pragma unroll
    for (int o = 1; o < 64; o <<= 1) v += __shfl_xor(v, o);
    return v;
}
__device__ __forceinline__ float gelu_tanh(float x) {
    const float t = x * (1.0f + 0.044715f * x * x);
    const float e = __builtin_amdgcn_exp2f(-2.302208198f * t);
    return x * __builtin_amdgcn_rcpf(1.0f + e);
}
__device__ __forceinline__ float silu_f(float x) { return x * __builtin_amdgcn_rcpf(1.0f + __builtin_amdgcn_exp2f(-1.4426950409f * x)); }

constexpr size_t MiB = 1u << 20;
constexpr size_t WS_CTL = 0, CTL_ZERO_BYTES = 1 * MiB;
constexpr size_t WS_MOD = 1 * MiB;
constexpr size_t WS_ROPE = 1 * MiB + 256 * 1024;
constexpr size_t WS_STATS = 2 * MiB;
constexpr size_t WS_RSC = 4 * MiB + 512 * 1024;
constexpr size_t WS_LIST = 5 * MiB;
constexpr size_t WS_TINFO = 6 * MiB;
constexpr size_t WS_WS = 7 * MiB;
constexpr size_t WS_WIN = 8 * MiB, WS_WAO = 12 * MiB, WS_WQKV = 14 * MiB, WS_WBO = 17 * MiB, WS_WGU = 19 * MiB, WS_WD = 33 * MiB;
constexpr size_t WS_MGU = 40 * MiB, WS_MD = 96 * MiB;
constexpr size_t WS_HLB = 124 * MiB;
constexpr size_t WS_XN = 208 * MiB;
constexpr size_t WS_ZB = 274 * MiB;
constexpr size_t WS_R = 278 * MiB;
constexpr size_t WS_UVT = WS_R, WS_A2 = WS_R + 132 * MiB, WS_PART1 = WS_R + 198 * MiB, WS_H = WS_R, WS_PART2 = WS_R + 231 * MiB;
constexpr size_t WS_QKV = WS_R, WS_O = WS_R + 99 * MiB;
constexpr size_t WS_Y = WS_R, WS_YP = WS_R + 128 * MiB, WS_HC = WS_R + 156 * MiB;
constexpr size_t WS_END = WS_R + 287 * MiB;
static_assert(WS_UVT + (size_t)2048 * MALL * 2 <= WS_A2 && WS_A2 + (size_t)MALL * DM * 2 <= WS_PART1 && WS_PART1 + (size_t)P3_NS * NCTXR * DM * 4 <= WS_END, "layer-0 mixer map");
static_assert(WS_H + (size_t)MALL * DFF * 2 <= WS_PART2 && WS_PART2 + (size_t)P5_NS * NCTXR * DM * 4 <= WS_END && WS_QKV + (size_t)MALL * NQKV * 2 <= WS_O && WS_O + (size_t)NLAT * DM * 2 <= WS_END, "region map");
static_assert(WS_Y + (size_t)256 * 256 * DM * 2 <= WS_YP && WS_YP + (size_t)MOE_RS * 8 * 256 * DM * 2 <= WS_HC && WS_HC + (size_t)(MOE_CH + 8) * 256 * DFF <= WS_END, "MoE map");
static_assert(WS_MD + (size_t)8 * DM * DFF <= WS_HLB && WS_HLB + (size_t)NLAT * DM * 2 <= WS_XN && WS_XN + (size_t)MALL * DM * 2 <= WS_ZB && WS_MD + (size_t)8 * DM * DFF <= WS_XN && WS_MGU + (size_t)8 * 7168 * DM <= WS_MD, "weights map");
constexpr int CW_TMO = 0, CW_CODE = 1;
constexpr int CW_CNT = 64;
constexpr int CW_WAMAX = 1024;
constexpr int CW_BAR = 4096;

constexpr int RING_BYTES = 131072;
constexpr int GTAB_OFF = RING_BYTES;
constexpr int MOE_OFF = RING_BYTES + 1024;
constexpr int MISC_OFF = RING_BYTES + 2048;
constexpr int LDS_BYTES = 147456;

namespace pg8 {
constexpr int BM = 256, BK = 64, HALF = 128, HTB = HALF * BK * 2, STAGE_BYTES = 8 * HTB, NXCD = 8, WGM = 8;
__host__ __device__ __forceinline__ int lds_byte(int r, int c) { const int st = (r >> 4) * 2 + (c >> 5), rr = r & 15, cc = c & 31, ob = rr * 64 + cc * 2; return st * 1024 + (ob ^ (((ob >> 9) & 1) << 5)); }
__host__ __device__ __forceinline__ void stage_rc(int b, int& R, int& C) { const int st = b / 1024, sb = b % 1024, swz = sb ^ (((sb >> 9) & 1) << 5); R = (st >> 1) * 16 + swz / 64; C = (st & 1) * 32 + (swz % 64) / 2; }
__host__ __device__ __forceinline__ int perm32(int rho) { const int n = rho >> 4, i = rho & 15; return 8 * (i >> 2) + 4 * n + (i & 3); }

struct Unit { const char* a; const char* b; const int* gl; int pm, pn, om, nv, ks; };

__device__ __forceinline__ bool tile_order(int i, int G, int c, int nM, int nN, int& pm, int& pn) {
    const int nwg = nM * nN; const long L = (long)i * G + c; if (L >= nwg) return false;
    int wgid = (int)L; { const int q = nwg / NXCD, r = nwg % NXCD, xcd = wgid % NXCD, off = wgid / NXCD; wgid = (xcd < r ? xcd * (q + 1) : r * (q + 1) + (xcd - r) * q) + off; }
    const int nig = WGM * nN, gid = wgid / nig, fm = gid * WGM, gsz = (nM - fm) < WGM ? (nM - fm) : WGM;
    pm = fm + ((wgid % nig) % gsz); pn = (wgid % nig) / gsz; return true;
}
struct DenseSched {
    const char* A; const char* B; int nM, nN, G, c; size_t tstep;
    __device__ __forceinline__ bool next(int i, Unit& u) const {
        int pm, pn; if (!tile_order(i, G, c, nM, nN, pm, pn)) return false;
        u.a = A + (size_t)pm * tstep; u.b = B + (size_t)pn * tstep; u.gl = nullptr; u.pm = pm; u.pn = pn; u.om = pm; u.nv = 256; u.ks = 0; return true;
    }
};
typedef int v8i_t __attribute__((ext_vector_type(8)));
typedef int v4i_t __attribute__((ext_vector_type(4)));
__device__ __forceinline__ v8i_t cat8(bf16x8 lo, bf16x8 hi) { const v4i_t a = __builtin_bit_cast(v4i_t, lo), b = __builtin_bit_cast(v4i_t, hi); return __builtin_shufflevector(a, b, 0, 1, 2, 3, 4, 5, 6, 7); }
struct SplitSched {
    const char* A; const char* B; int nM, nN, nS, G, c, pm0; size_t tstep, kbytes;
    __device__ __forceinline__ bool next(int i, Unit& u) const {
        const int L = i * G + c; if (L >= nM * nN * nS) return false;
        const int ks = L % nS, t = L / nS, pn = t % nN, pm = t / nN;
        u.a = A + (size_t)pm * tstep + (size_t)ks * kbytes; u.b = B + (size_t)pn * tstep + (size_t)ks * kbytes; u.gl = nullptr; u.pm = pm0 + pm; u.pn = pn; u.om = pm; u.nv = 256; u.ks = ks; return true;
    }
};
struct MoeSched {
    const char* A; const char* B; const int* list; const LAS int* tab; int gp0, gp1, nN, nS, G, c, mode, omoff; size_t bexp, btile, astep, kbytes; bool gather;
    __device__ __forceinline__ bool next(int i, Unit& u) const {
        int pm, pn, ks = 0;
        if (mode == 0) { if (gp1 <= gp0) return false; if (!tile_order(i, G, c, gp1 - gp0, nN, pm, pn)) return false; }
        else { const int R = __builtin_amdgcn_readfirstlane(tab[32]); const int L = i * G + c; if (L >= R * nN * nS) return false; ks = L % nS; const int t = L / nS; pn = t % nN; pm = t / nN; }
        int e = 0, lp, nv;
        if (mode == 0) { const int gp = gp0 + pm;
#pragma unroll
            for (int k = 1; k < 8; ++k) e += (gp >= __builtin_amdgcn_readfirstlane(tab[k])) ? 1 : 0;
            lp = gp - __builtin_amdgcn_readfirstlane(tab[e]); nv = 256; u.pm = gp; }
        else { e = __builtin_amdgcn_readfirstlane(tab[24 + pm]); const int ce = __builtin_amdgcn_readfirstlane(tab[16 + e]); lp = ce >> 8; nv = ce & 255; u.pm = pm; }
        u.b = B + (size_t)e * bexp + (size_t)pn * btile + (size_t)ks * kbytes; u.pn = pn; u.nv = nv; u.ks = ks; u.om = pm;
        if (gather) { u.a = A; u.gl = list + (size_t)e * NLAT + 256 * lp; u.om = pm + omoff; }
        else { u.a = A + (size_t)pm * astep + (size_t)ks * kbytes; u.gl = nullptr; if (mode == 0) u.om = gp0 + pm; }
        return true;
    }
};

struct EpiGeluT {
    static constexpr bool PERM = true;
    bf16_t* O; float* stats; const float* cscale; const float* wsc;
    __device__ __forceinline__ void operator()(const f32x4 (&acc)[2][2][4][2], const Unit& u, int wr, int wc, int fr, int fq) const {
        const int row0 = u.pm * BM + wr * 64 + fr, col0 = u.pn * BM + wc * 32 + 8 * fq;
        const bool isv = u.pm >= 4; const float wq = wsc[0];
        f32x4 csv[2][2];
#pragma unroll
        for (int bj = 0; bj < 2; ++bj)
#pragma unroll
            for (int n = 0; n < 2; ++n) csv[bj][n] = *(const f32x4*)(cscale + col0 + bj * HALF + 4 * n) * wq;
        float s1[2][2][4], s2[2][2][4];
#pragma unroll
        for (int bj = 0; bj < 2; ++bj)
#pragma unroll
            for (int n = 0; n < 2; ++n)
#pragma unroll
                for (int e = 0; e < 4; ++e) { s1[bj][n][e] = 0.f; s2[bj][n][e] = 0.f; }
#pragma unroll
        for (int ai = 0; ai < 2; ++ai)
#pragma unroll
            for (int m = 0; m < 4; ++m) { bf16_t* rowp = O + (size_t)(row0 + ai * HALF + m * 16) * MALL + col0;
#pragma unroll
                for (int bj = 0; bj < 2; ++bj) { const v4i_t i0 = __builtin_bit_cast(v4i_t, acc[ai][bj][m][0]), i1 = __builtin_bit_cast(v4i_t, acc[ai][bj][m][1]);
                    f32x4 v0 = (f32x4){(float)i0[0], (float)i0[1], (float)i0[2], (float)i0[3]} * csv[bj][0], v1 = (f32x4){(float)i1[0], (float)i1[1], (float)i1[2], (float)i1[3]} * csv[bj][1];
#pragma unroll
                    for (int e = 0; e < 4; ++e) { v0[e] = gelu_tanh(v0[e]); v1[e] = gelu_tanh(v1[e]); s1[bj][0][e] += v0[e]; s2[bj][0][e] += v0[e] * v0[e]; s1[bj][1][e] += v1[e]; s2[bj][1][e] += v1[e] * v1[e]; }
                    u32x4 w; w.x = pkbf(v0[0], v0[1]); w.y = pkbf(v0[2], v0[3]); w.z = pkbf(v1[0], v1[1]); w.w = pkbf(v1[2], v1[3]);
                    *(u32x4*)(rowp + bj * HALF) = w; } }
        if (isv) {
            const int slot = (u.pm - 4) * 2 + wr;
#pragma unroll
            for (int bj = 0; bj < 2; ++bj)
#pragma unroll
                for (int n = 0; n < 2; ++n)
#pragma unroll
                    for (int e = 0; e < 4; ++e) { float a = s1[bj][n][e], b = s2[bj][n][e];
#pragma unroll
                        for (int o = 1; o < 16; o <<= 1) { a += __shfl_xor(a, o); b += __shfl_xor(b, o); }
                        if (fr == 0) { const int tok = col0 + bj * HALF + 4 * n + e; *(f32x2*)(stats + (size_t)tok * 16 + slot * 2) = (f32x2){a, b}; } }
        }
    }
};
template <bool BASE_F32> struct EpiResid {
    static constexpr bool PERM = true;
    const float* basef; const bf16_t* baseb; bf16_t* out; const float* gate;
    __device__ __forceinline__ void operator()(const f32x4 (&acc)[2][2][4][2], const Unit& u, int wr, int wc, int fr, int fq) const {
        const int mb = u.pm >> 5; const int col0 = u.pn * BM + wc * 32 + 8 * fq;
        f32x4 gv[2][2];
#pragma unroll
        for (int bj = 0; bj < 2; ++bj)
#pragma unroll
            for (int n = 0; n < 2; ++n) gv[bj][n] = *(const f32x4*)(gate + (size_t)mb * 6144 + col0 + bj * HALF + n * 4);
#pragma unroll
        for (int ai = 0; ai < 2; ++ai)
#pragma unroll
            for (int m = 0; m < 4; ++m) { const size_t off = (size_t)(u.pm * BM + wr * 64 + fr + ai * HALF + m * 16) * DM + col0;
#pragma unroll
                for (int bj = 0; bj < 2; ++bj) { f32x4 b0, b1;
                    if constexpr (BASE_F32) { b0 = *(const f32x4*)(basef + off + bj * HALF); b1 = *(const f32x4*)(basef + off + bj * HALF + 4); }
                    else { const u32x4 w = *(const u32x4*)(baseb + off + bj * HALF);
                        b0 = (f32x4){__uint_as_float(w.x << 16), __uint_as_float(w.x & 0xffff0000u), __uint_as_float(w.y << 16), __uint_as_float(w.y & 0xffff0000u)};
                        b1 = (f32x4){__uint_as_float(w.z << 16), __uint_as_float(w.z & 0xffff0000u), __uint_as_float(w.w << 16), __uint_as_float(w.w & 0xffff0000u)}; }
                    const f32x4 o0 = b0 + gv[bj][0] * acc[ai][bj][m][0], o1 = b1 + gv[bj][1] * acc[ai][bj][m][1];
                    u32x4 w; w.x = pkbf(o0[0], o0[1]); w.y = pkbf(o0[2], o0[3]); w.z = pkbf(o1[0], o1[1]); w.w = pkbf(o1[2], o1[3]);
                    *(u32x4*)(out + off + bj * HALF) = w; } }
    }
};
struct EpiSwiGLU {
    static constexpr bool PERM = true;
    bf16_t* O;
    __device__ __forceinline__ void operator()(const f32x4 (&acc)[2][2][4][2], const Unit& u, int wr, int wc, int fr, int fq) const {
        bf16_t* base = O + (size_t)(u.om * BM + wr * 64 + fr) * DFF + u.pn * 128 + wc * 32 + 8 * fq;
#pragma unroll
        for (int ai = 0; ai < 2; ++ai)
#pragma unroll
            for (int m = 0; m < 4; ++m) { const f32x4 g0 = acc[ai][0][m][0], g1 = acc[ai][0][m][1], u0 = acc[ai][1][m][0], u1 = acc[ai][1][m][1];
                float o[8];
#pragma unroll
                for (int e = 0; e < 4; ++e) { o[e] = silu_f(g0[e]) * u0[e]; o[4 + e] = silu_f(g1[e]) * u1[e]; }
                u32x4 w; w.x = pkbf(o[0], o[1]); w.y = pkbf(o[2], o[3]); w.z = pkbf(o[4], o[5]); w.w = pkbf(o[6], o[7]);
                *(u32x4*)(base + (size_t)(ai * HALF + m * 16) * DFF) = w; }
    }
};
struct EpiQKV {
    static constexpr bool PERM = false;
    bf16_t* O; const float* cosT; const float* sinT; float qscale; const float* rscale; const float* wsc;
    __device__ __forceinline__ void operator()(const f32x4 (&acc)[2][2][4][2], const Unit& u, int wr, int wc, int fr, int fq) const {
        const bool lat = u.pm < NPL; const bool dorope = lat && u.pn < 5; const float sc = (u.pn < 4 ? qscale : 1.0f) * wsc[0];
        const int col0 = u.pn * BM + wc * 32 + 4 * fq;
#pragma unroll
        for (int ai = 0; ai < 2; ++ai)
#pragma unroll
            for (int m = 0; m < 4; ++m) { const int grow = u.pm * BM + ai * HALF + wr * 64 + m * 16 + fr; const int s = grow & (SEQ - 1); const int pos = (wc & 1) ? (s & 63) : (s >> 6);
                f32x4 cs = (f32x4){1.f, 1.f, 1.f, 1.f}, sn = (f32x4){0.f, 0.f, 0.f, 0.f};
                if (dorope) { cs = *(const f32x4*)(cosT + pos * 16 + 4 * fq); sn = *(const f32x4*)(sinT + pos * 16 + 4 * fq); }
                bf16_t* rowp = O + (size_t)grow * NQKV + col0;
                const float rsx = rscale[grow] * sc;
#pragma unroll
                for (int bj = 0; bj < 2; ++bj) { const v4i_t i1 = __builtin_bit_cast(v4i_t, acc[ai][bj][m][0]), i2 = __builtin_bit_cast(v4i_t, acc[ai][bj][m][1]);
                    const f32x4 x1 = (f32x4){(float)i1[0], (float)i1[1], (float)i1[2], (float)i1[3]}, x2 = (f32x4){(float)i2[0], (float)i2[1], (float)i2[2], (float)i2[3]};
                    const f32x4 o1 = (x1 * cs - x2 * sn) * rsx, o2 = (x1 * sn + x2 * cs) * rsx;
                    u32x2 w1, w2; w1.x = pkbf(o1[0], o1[1]); w1.y = pkbf(o1[2], o1[3]); w2.x = pkbf(o2[0], o2[1]); w2.y = pkbf(o2[2], o2[3]);
                    *(u32x2*)(rowp + bj * HALF) = w1; *(u32x2*)(rowp + bj * HALF + 16) = w2; } }
    }
};
struct EpiSwiGLUI8 {
    static constexpr bool PERM = true;
    bf16_t* O; const float* rscale; const float* ws;
    __device__ __forceinline__ void operator()(const f32x4 (&acc)[2][2][4][2], const Unit& u, int wr, int wc, int fr, int fq) const {
        bf16_t* base = O + (size_t)(u.om * BM + wr * 64 + fr) * DFF + u.pn * 128 + wc * 32 + 8 * fq;
        const float wsg = ws[0], wsu = ws[1];
#pragma unroll
        for (int ai = 0; ai < 2; ++ai)
#pragma unroll
            for (int m = 0; m < 4; ++m) { const float rs = rscale[u.pm * BM + wr * 64 + fr + ai * HALF + m * 16]; const float sg = rs * wsg, su = rs * wsu;
                const v4i_t g0 = __builtin_bit_cast(v4i_t, acc[ai][0][m][0]), g1 = __builtin_bit_cast(v4i_t, acc[ai][0][m][1]), u0 = __builtin_bit_cast(v4i_t, acc[ai][1][m][0]), u1 = __builtin_bit_cast(v4i_t, acc[ai][1][m][1]);
                float o[8];
#pragma unroll
                for (int e = 0; e < 4; ++e) { o[e] = silu_f((float)g0[e] * sg) * ((float)u0[e] * su); o[4 + e] = silu_f((float)g1[e] * sg) * ((float)u1[e] * su); }
                u32x4 w; w.x = pkbf(o[0], o[1]); w.y = pkbf(o[2], o[3]); w.z = pkbf(o[4], o[5]); w.w = pkbf(o[6], o[7]);
                *(u32x4*)(base + (size_t)(ai * HALF + m * 16) * DFF) = w; }
    }
};
struct EpiSwiGLU8 {
    static constexpr bool PERM = true;
    unsigned char* O; float s;
    __device__ __forceinline__ void operator()(const f32x4 (&acc)[2][2][4][2], const Unit& u, int wr, int wc, int fr, int fq) const {
        unsigned char* base = O + (size_t)(u.om * BM + wr * 64 + fr) * DFF + u.pn * 128 + wc * 32 + 8 * fq;
#pragma unroll
        for (int ai = 0; ai < 2; ++ai)
#pragma unroll
            for (int m = 0; m < 4; ++m) { const f32x4 g0 = acc[ai][0][m][0] * s, g1 = acc[ai][0][m][1] * s, u0 = acc[ai][1][m][0] * s, u1 = acc[ai][1][m][1] * s;
                float o[8];
#pragma unroll
                for (int e = 0; e < 4; ++e) { o[e] = silu_f(g0[e]) * u0[e]; o[4 + e] = silu_f(g1[e]) * u1[e]; }
                u32x2 w; w.x = pk4f8(o[0], o[1], o[2], o[3]); w.y = pk4f8(o[4], o[5], o[6], o[7]);
                *(u32x2*)(base + (size_t)(ai * HALF + m * 16) * DFF) = w; }
    }
};
struct EpiBf16Plain {
    static constexpr bool PERM = true;
    bf16_t* O; int ldc; float s;
    __device__ __forceinline__ void operator()(const f32x4 (&acc)[2][2][4][2], const Unit& u, int wr, int wc, int fr, int fq) const {
        bf16_t* base = O + (size_t)(u.om * BM + wr * 64 + fr) * ldc + u.pn * BM + wc * 32 + 8 * fq;
#pragma unroll
        for (int ai = 0; ai < 2; ++ai)
#pragma unroll
            for (int m = 0; m < 4; ++m)
#pragma unroll
                for (int bj = 0; bj < 2; ++bj) { const f32x4 v0 = acc[ai][bj][m][0] * s, v1 = acc[ai][bj][m][1] * s;
                    u32x4 w; w.x = pkbf(v0[0], v0[1]); w.y = pkbf(v0[2], v0[3]); w.z = pkbf(v1[0], v1[1]); w.w = pkbf(v1[2], v1[3]);
                    *(u32x4*)(base + (size_t)(ai * HALF + m * 16) * ldc + bj * HALF) = w; }
    }
};

struct EpiPartF32 {
    static constexpr bool PERM = true;
    float* P; size_t sstride;
    __device__ __forceinline__ void operator()(const f32x4 (&acc)[2][2][4][2], const Unit& u, int wr, int wc, int fr, int fq) const {
        float* base = P + (size_t)u.ks * sstride + (size_t)(u.om * BM + wr * 64 + fr) * DM + u.pn * BM + wc * 32 + 8 * fq;
#pragma unroll
        for (int ai = 0; ai < 2; ++ai)
#pragma unroll
            for (int m = 0; m < 4; ++m)
#pragma unroll
                for (int bj = 0; bj < 2; ++bj)
#pragma unroll
                    for (int n = 0; n < 2; ++n) *(f32x4*)(base + (size_t)(ai * HALF + m * 16) * DM + bj * HALF + n * 4) = acc[ai][bj][m][n];
    }
};
struct EpiPartBf16 {
    static constexpr bool PERM = true;
    bf16_t* P; size_t sstride; float s;
    __device__ __forceinline__ void operator()(const f32x4 (&acc)[2][2][4][2], const Unit& u, int wr, int wc, int fr, int fq) const {
        bf16_t* base = P + (size_t)u.ks * sstride + (size_t)(u.om * BM + wr * 64 + fr) * DM + u.pn * BM + wc * 32 + 8 * fq;
#pragma unroll
        for (int ai = 0; ai < 2; ++ai)
#pragma unroll
            for (int m = 0; m < 4; ++m)
#pragma unroll
                for (int bj = 0; bj < 2; ++bj) { const f32x4 v0 = acc[ai][bj][m][0] * s, v1 = acc[ai][bj][m][1] * s;
                    u32x4 w; w.x = pkbf(v0[0], v0[1]); w.y = pkbf(v0[2], v0[3]); w.z = pkbf(v1[0], v1[1]); w.w = pkbf(v1[2], v1[3]);
                    *(u32x4*)(base + (size_t)(ai * HALF + m * 16) * DM + bj * HALF) = w; }
    }
};

template <class Epi, class Sched, bool ALIGN_EPI, bool GATHER, bool FP8 = false, bool I8 = false>
__device__ __forceinline__ void gemm_phase(LAS unsigned char* lds, LAS int* gtab, const int K  , const int nt_in  , const Sched& S, const Epi& E) {
    int nt = nt_in; asm volatile("" : "+s"(nt));
    int tid_ = threadIdx.x; asm volatile("" : "+v"(tid_));
    const int tid = tid_, wid = __builtin_amdgcn_readfirstlane(tid >> 6), lane = tid & 63, wr = wid >> 2, wc = wid & 3, fr = lane & 15, fq = lane >> 4;
    const size_t kstep = (size_t)(BK * 2);
    const size_t hstep = (size_t)HALF * K * 2;
    unsigned voffB[2];
#pragma unroll
    for (int i = 0; i < 2; ++i) { int R, C; stage_rc(tid * 16 + i * 8192, R, C); const int Rb = Epi::PERM ? ((R & ~31) + perm32(R & 31)) : R;
        voffB[i] = (unsigned)(Rb * K + C) * 2u; }
    unsigned vA[2][2], vN[2][2];
    const unsigned ldsw = (unsigned)wid * 1024u;
    const int aoff = lds_byte(wr * 64 + fr, fq * 8), boff = lds_byte(wc * 32 + fr, fq * 8);
    const LAS unsigned char* aB = lds + aoff; const LAS unsigned char* bB = lds + 65536 + boff;
    asm volatile("" : "+v"(aB), "+v"(bB));
#define PG8_SA(b, h) (((b) * 2 + (h)) * HTB)
#define PG8_SB(b, h) ((4 + (b) * 2 + (h)) * HTB)
#define PG8_STAGE(bufoff, gbase, voff) do { _Pragma("unroll") for (int _i = 0; _i < 2; ++_i) \
        __builtin_amdgcn_global_load_lds((const unsigned*)((const char*)(gbase) + (voff)[_i]), (LAS unsigned*)(lds + (bufoff) + ldsw + _i * 8192), 16, 0, 0); } while (0)
#define PG8_LDA(dst, b, h) do { _Pragma("unroll") for (int m = 0; m < 4; ++m) { if constexpr (FP8) dst##8[m] = cat8(*(const LAS bf16x8*)(aB + PG8_SA(b, h) + m * 2048), *(const LAS bf16x8*)(aB + PG8_SA(b, h) + m * 2048 + 1024)); \
        else { _Pragma("unroll") for (int k = 0; k < 2; ++k) dst[m][k] = *(const LAS bf16x8*)(aB + PG8_SA(b, h) + m * 2048 + k * 1024); } } } while (0)
#define PG8_LDB(dst, b, h) do { _Pragma("unroll") for (int n = 0; n < 2; ++n) { if constexpr (FP8) dst##8[n] = cat8(*(const LAS bf16x8*)(bB + (PG8_SB(b, h) - 65536) + n * 2048), *(const LAS bf16x8*)(bB + (PG8_SB(b, h) - 65536) + n * 2048 + 1024)); \
        else { _Pragma("unroll") for (int k = 0; k < 2; ++k) dst[n][k] = *(const LAS bf16x8*)(bB + (PG8_SB(b, h) - 65536) + n * 2048 + k * 1024); } } } while (0)
#define PG8_MMA(ai, bj, At, Bt) do { __builtin_amdgcn_s_setprio(1); \
    if constexpr (FP8) { _Pragma("unroll") for (int m = 0; m < 4; ++m) _Pragma("unroll") for (int n = 0; n < 2; ++n) \
        asm volatile("v_mfma_f32_16x16x128_f8f6f4 %0, %1, %2, %0" : "+v"(acc[ai][bj][m][n]) : "v"(Bt##8[n]), "v"(At##8[m])); } \
    else if constexpr (I8) { _Pragma("unroll") for (int m = 0; m < 4; ++m) _Pragma("unroll") for (int n = 0; n < 2; ++n) _Pragma("unroll") for (int k = 0; k < 2; ++k) \
        acc[ai][bj][m][n] = __builtin_bit_cast(f32x4, __builtin_amdgcn_mfma_i32_16x16x64_i8(__builtin_bit_cast(v4i_t, Bt[n][k]), __builtin_bit_cast(v4i_t, At[m][k]), __builtin_bit_cast(v4i_t, acc[ai][bj][m][n]), 0, 0, 0)); } \
    else { _Pragma("unroll") for (int m = 0; m < 4; ++m) _Pragma("unroll") for (int n = 0; n < 2; ++n) _Pragma("unroll") for (int k = 0; k < 2; ++k) \
        acc[ai][bj][m][n] = __builtin_amdgcn_mfma_f32_16x16x32_bf16(Bt[n][k], At[m][k], acc[ai][bj][m][n], 0, 0, 0); } \
    __builtin_amdgcn_s_setprio(0); } while (0)
#define PG8_WAIT_V(n) asm volatile("s_waitcnt vmcnt(" #n ")" ::: "memory")
#define PG8_WAIT_L(n) asm volatile("s_waitcnt lgkmcnt(" #n ")" ::: "memory")
#define PG8_BAR __builtin_amdgcn_s_barrier()
#define PG8_SCHED __builtin_amdgcn_sched_barrier(0)
    Unit cur, nxt; int ui = 0;
    if (!S.next(0, cur)) return;
    f32x4 acc[2][2][4][2];
#pragma unroll
    for (int a = 0; a < 2; ++a)
#pragma unroll
        for (int b = 0; b < 2; ++b)
#pragma unroll
            for (int m = 0; m < 4; ++m)
#pragma unroll
                for (int n = 0; n < 2; ++n) acc[a][b][m][n] = (f32x4){0.f, 0.f, 0.f, 0.f};
    bf16x8 At[4][2], B0[2][2], B1[2][2]; v8i_t At8[4], B08[2], B18[2];
    if constexpr (GATHER) {
#pragma unroll
        for (int h = 0; h < 2; ++h)
#pragma unroll
            for (int i = 0; i < 2; ++i) { int R, C; stage_rc(tid * 16 + i * 8192, R, C); const int row = h * HALF + R; const int tok = cur.gl[row < cur.nv ? row : 0]; vA[h][i] = (unsigned)tok * (unsigned)(K * 2) + (unsigned)C * 2u; }
    } else {
#pragma unroll
        for (int h = 0; h < 2; ++h)
#pragma unroll
            for (int i = 0; i < 2; ++i) { int R, C; stage_rc(tid * 16 + i * 8192, R, C); vA[h][i] = (unsigned)(R * K + C) * 2u + (unsigned)(h * hstep); }
    }
#pragma unroll
    for (int h = 0; h < 2; ++h)
#pragma unroll
        for (int i = 0; i < 2; ++i) vN[h][i] = vA[h][i];
    const char* cA = cur.a; const char* cB = cur.b;
    PG8_STAGE(PG8_SB(0, 0), cB, voffB); PG8_STAGE(PG8_SB(0, 1), cB + hstep, voffB); PG8_STAGE(PG8_SA(0, 0), cA, vA[0]); PG8_STAGE(PG8_SA(0, 1), cA, vA[1]);
    if (wr == 1) PG8_BAR;
    PG8_WAIT_V(2); PG8_BAR;
    PG8_STAGE(PG8_SB(1, 0), cB + kstep, voffB); PG8_STAGE(PG8_SA(1, 0), cA + kstep, vA[0]); PG8_STAGE(PG8_SB(1, 1), cB + hstep + kstep, voffB);
    PG8_WAIT_V(6); PG8_BAR;
    for (;;) {
        const bool has_next = S.next(ui + 1, nxt);
        const char* nA = has_next ? nxt.a : cA; const char* nB = has_next ? nxt.b : cB;
        if constexpr (GATHER) {
            if (has_next && wid < 4) __builtin_amdgcn_global_load_lds((const unsigned*)(nxt.gl + wid * 64 + lane), (LAS unsigned*)(gtab + wid * 64), 4, 0, 0);
        }
        for (int t = 0; t < nt; t += 2) {
            const bool last = (t == nt - 2);
            const char* a1 = cA + (size_t)(t + 1) * kstep;
            const char* a2 = last ? nA : cA + (size_t)(t + 2) * kstep; const char* b2 = last ? nB : cB + (size_t)(t + 2) * kstep;
            const char* a3 = a2 + kstep; const char* b3 = b2 + kstep;
            if constexpr (GATHER) {
                if (last && has_next) {
                    int t2 = tid; asm volatile("" : "+v"(t2));
#pragma unroll
                    for (int h = 0; h < 2; ++h)
#pragma unroll
                        for (int i = 0; i < 2; ++i) { int R, C; stage_rc(t2 * 16 + i * 8192, R, C); const int row = h * HALF + R; const int tok = gtab[row < nxt.nv ? row : 0]; vN[h][i] = (unsigned)tok * (unsigned)(K * 2) + (unsigned)C * 2u; }
                }
            }
            unsigned vS0[2], vS1[2];
#pragma unroll
            for (int i = 0; i < 2; ++i) { vS0[i] = (GATHER && last) ? vN[0][i] : vA[0][i]; vS1[i] = (GATHER && last) ? vN[1][i] : vA[1][i]; }
            PG8_LDB(B0, 0, 0); PG8_LDB(B1, 0, 1); PG8_SCHED; PG8_LDA(At, 0, 0); PG8_STAGE(PG8_SA(1, 1), a1, vA[1]);
            PG8_WAIT_V(8); PG8_WAIT_L(0); PG8_BAR; PG8_MMA(0, 0, At, B0); PG8_MMA(0, 1, At, B1); PG8_BAR; PG8_SCHED;
            PG8_LDA(At, 0, 1); PG8_STAGE(PG8_SB(0, 0), b2, voffB); PG8_STAGE(PG8_SB(0, 1), b2 + hstep, voffB); PG8_STAGE(PG8_SA(0, 0), a2, vS0);
            PG8_WAIT_V(8); PG8_WAIT_L(0); PG8_BAR; PG8_MMA(1, 0, At, B0); PG8_MMA(1, 1, At, B1); PG8_BAR; PG8_SCHED;
            PG8_LDB(B0, 1, 0); PG8_LDB(B1, 1, 1); PG8_SCHED; PG8_LDA(At, 1, 0); PG8_STAGE(PG8_SA(0, 1), a2, vS1);
            PG8_WAIT_V(8); PG8_WAIT_L(0); PG8_BAR; PG8_MMA(0, 0, At, B0); PG8_MMA(0, 1, At, B1); PG8_BAR; PG8_SCHED;
            PG8_LDA(At, 1, 1); PG8_STAGE(PG8_SB(1, 0), b3, voffB); PG8_STAGE(PG8_SB(1, 1), b3 + hstep, voffB); PG8_STAGE(PG8_SA(1, 0), a3, vS0);
            PG8_WAIT_V(8); PG8_WAIT_L(0); PG8_BAR; PG8_MMA(1, 0, At, B0); PG8_MMA(1, 1, At, B1); PG8_BAR; PG8_SCHED;
        }
        if constexpr (ALIGN_EPI) { if (wr == 0) PG8_BAR; }
        if constexpr (FP8) asm volatile("s_nop 15\n\ts_nop 15" ::: "memory");
        E(acc, cur, wr, wc, fr, fq);
        if (!has_next) break;
#pragma unroll
        for (int a = 0; a < 2; ++a)
#pragma unroll
            for (int b = 0; b < 2; ++b)
#pragma unroll
                for (int m = 0; m < 4; ++m)
#pragma unroll
                    for (int n = 0; n < 2; ++n) acc[a][b][m][n] = (f32x4){0.f, 0.f, 0.f, 0.f};
        cur = nxt; cA = nA; cB = nB; ++ui;
        if constexpr (GATHER) {
#pragma unroll
            for (int h = 0; h < 2; ++h)
#pragma unroll
                for (int i = 0; i < 2; ++i) vA[h][i] = vN[h][i];
        }
        if constexpr (ALIGN_EPI) { if (wr == 1) PG8_BAR; }
    }
    PG8_WAIT_V(0);
    if constexpr (!ALIGN_EPI) { if (wr == 0) PG8_BAR; }
    PG8_BAR;
#undef PG8_SA
#undef PG8_SB
#undef PG8_STAGE
#undef PG8_LDA
#undef PG8_LDB
#undef PG8_MMA
#undef PG8_WAIT_V
#undef PG8_WAIT_L
#undef PG8_BAR
#undef PG8_SCHED
}
}

namespace attn_body {
using bf16 = __hip_bfloat16;
using s16x4 = __attribute__((ext_vector_type(4))) short;
constexpr int D = 64, PITCH = NQKV, OPITCH = DM;
constexpr int NW = 8, QBLK = 32, KVBLK = 64;
__device__ __forceinline__ int crow(int r, int hi) { return (r & 3) + 8 * (r >> 2) + 4 * hi; }
#define SBAR() __builtin_amdgcn_sched_barrier(0)
__device__ __forceinline__ void bmask(f32x16& p0, f32x16& p1, int kb, int qrel, int hi) {
    const float NEG = -INFINITY; const int d0 = kb + 4 * hi - qrel;
#pragma unroll
    for (int r = 0; r < 16; ++r) { const int d = d0 + (r & 3) + 8 * (r >> 2); if (d < -128 || d > 128) p0[r] = NEG; if (d + 32 < -128 || d + 32 > 128) p1[r] = NEG; }
}
constexpr int NSLOT = 3, SLOTB = 8192;
constexpr int LDS_K = 0, LDS_V = NSLOT * SLOTB, LDS_WS = 2 * NSLOT * SLOTB, LDS_OST = LDS_WS + NW * 64 * 4, LDS_BYTES_A = LDS_OST + NW * 4096;
constexpr float C2 = 0.125f * 1.4426950408889634f;
__device__ __forceinline__ void glds16(const void* gsrc, unsigned lds_dst) { unsigned keep;
    asm volatile("s_mov_b32 %0, m0\n\ts_mov_b32 m0, %2\n\ts_nop 0\n\tglobal_load_lds_dwordx4 %1, off\n\ts_mov_b32 m0, %0" : "=&s"(keep) : "v"(gsrc), "s"(lds_dst) : "memory"); }
__device__ __forceinline__ float max3f(float a, float b, float c) { float r; asm("v_max3_f32 %0, %1, %2, %3" : "=v"(r) : "v"(a), "v"(b), "v"(c)); return r; }
__device__ __forceinline__ float max2f(float a, float b) { float r; asm("v_max_f32_e32 %0, %1, %2" : "=v"(r) : "v"(a), "v"(b)); return r; }
__device__ __forceinline__ float fadd_s(float a, float b) { float r; asm("v_add_f32_e32 %0, %1, %2" : "=v"(r) : "v"(a), "v"(b)); return r; }
__device__ __forceinline__ float fsub_s(float a, float b) { float r; asm("v_sub_f32_e32 %0, %1, %2" : "=v"(r) : "v"(a), "v"(b)); return r; }
__device__ __forceinline__ unsigned cvtpk_s(float lo, float hi) { f32x2 v = {lo, hi}; bf16x2_t b = __builtin_convertvector(v, bf16x2_t); return __builtin_bit_cast(unsigned, b); }
#define WAIT_BAR(N) asm volatile("s_waitcnt vmcnt(" #N ") lgkmcnt(0)\n\ts_barrier" ::: "memory")
__device__ __forceinline__ void qkt(f32x16& p0, f32x16& p1, const char* Kslot, const bf16x8* qr, const f32x16& negm, int r32, int hi) {
    const char* kb = Kslot + hi * 1024 + r32 * 16;
#pragma unroll
    for (int d0 = 0; d0 < 4; ++d0) {
        const bf16x8 b0 = *reinterpret_cast<const bf16x8*>(kb + d0 * 2048);
        const bf16x8 b1 = *reinterpret_cast<const bf16x8*>(kb + d0 * 2048 + 512);
        if (d0 == 0) { p0 = __builtin_amdgcn_mfma_f32_32x32x16_bf16(b0, qr[0], negm, 0, 0, 0); p1 = __builtin_amdgcn_mfma_f32_32x32x16_bf16(b1, qr[0], negm, 0, 0, 0); }
        else { p0 = __builtin_amdgcn_mfma_f32_32x32x16_bf16(b0, qr[d0], p0, 0, 0, 0); p1 = __builtin_amdgcn_mfma_f32_32x32x16_bf16(b1, qr[d0], p1, 0, 0, 0); } }
}
typedef __attribute__((address_space(3))) const char* lds_cptr;
typedef short v4i16_t __attribute__((ext_vector_type(4)));
__device__ __forceinline__ void kload8(bf16x8* kf, lds_cptr kp) {
    kf[0] = *(const __attribute__((address_space(3))) bf16x8*)(kp);        kf[1] = *(const __attribute__((address_space(3))) bf16x8*)(kp + 512);
    kf[2] = *(const __attribute__((address_space(3))) bf16x8*)(kp + 2048); kf[3] = *(const __attribute__((address_space(3))) bf16x8*)(kp + 2560);
    kf[4] = *(const __attribute__((address_space(3))) bf16x8*)(kp + 4096); kf[5] = *(const __attribute__((address_space(3))) bf16x8*)(kp + 4608);
    kf[6] = *(const __attribute__((address_space(3))) bf16x8*)(kp + 6144); kf[7] = *(const __attribute__((address_space(3))) bf16x8*)(kp + 6656);
}
__device__ __forceinline__ void kload2(bf16x8* kf, lds_cptr kp, int j) { kf[2 * j] = *(const __attribute__((address_space(3))) bf16x8*)(kp + j * 2048); kf[2 * j + 1] = *(const __attribute__((address_space(3))) bf16x8*)(kp + j * 2048 + 512); }
__device__ __forceinline__ s16x4 vtr(lds_cptr p) { return __builtin_bit_cast(s16x4, __builtin_amdgcn_ds_read_tr16_b64_v4i16((__attribute__((address_space(3))) v4i16_t*)p)); }
__device__ __forceinline__ float rowmax(const f32x16& p0, const f32x16& p1) {
    float a = max3f(p0[0], p0[1], p1[0]), b = max3f(p0[2], p0[3], p1[1]); a = max3f(a, p1[2], p1[3]);
#pragma unroll
    for (int r = 4; r < 16; r += 4) { a = max3f(a, p0[r], p0[r + 1]); b = max3f(b, p0[r + 2], p0[r + 3]); a = max3f(a, p1[r], p1[r + 1]); b = max3f(b, p1[r + 2], p1[r + 3]); }
    const float m = max2f(a, b);
    auto rr = __builtin_amdgcn_permlane32_swap(__float_as_uint(m), __float_as_uint(m), false, false);
    return max2f(__uint_as_float(rr[0]), __uint_as_float(rr[1]));
}
__device__ __forceinline__ void pv(f32x16* o, int vb, bf16x8 pa0, bf16x8 pa1, bf16x8 pa2, bf16x8 pa3) {
#pragma unroll
    for (int d0 = 0; d0 < 2; ++d0) { s16x4 lo[4], hi[4];
#pragma unroll
        for (int ks = 0; ks < 4; ++ks) {
            asm volatile("ds_read_b64_tr_b16 %0,%1 offset:%c2" : "=&v"(lo[ks]) : "v"(vb), "i"(d0 * 4096 + ks * 1024) : "memory");
            asm volatile("ds_read_b64_tr_b16 %0,%1 offset:%c2" : "=&v"(hi[ks]) : "v"(vb), "i"(d0 * 4096 + ks * 1024 + 512) : "memory"); }
        asm volatile("s_waitcnt lgkmcnt(0)" ::: "memory"); SBAR();
#define PK(k) (bf16x8){lo[k][0], lo[k][1], lo[k][2], lo[k][3], hi[k][0], hi[k][1], hi[k][2], hi[k][3]}
        o[d0] = __builtin_amdgcn_mfma_f32_32x32x16_bf16(pa0, PK(0), o[d0], 0, 0, 0);
        o[d0] = __builtin_amdgcn_mfma_f32_32x32x16_bf16(pa1, PK(1), o[d0], 0, 0, 0);
        o[d0] = __builtin_amdgcn_mfma_f32_32x32x16_bf16(pa2, PK(2), o[d0], 0, 0, 0);
        o[d0] = __builtin_amdgcn_mfma_f32_32x32x16_bf16(pa3, PK(3), o[d0], 0, 0, 0);
#undef PK
    }
}
#define ATTN_STORE16(p, v) (*(u32x4*)(p) = (v))
template <int THRL> __device__ __forceinline__ void attn_unit(int b, int hk, int n, int pr, const bf16* QKV, bf16* O, const float* sinkp, char* shm) {
    int tid_ = threadIdx.x; asm volatile("" : "+v"(tid_));
    const int tid = tid_, lane = tid & 63, r32 = lane & 31, hi = lane >> 5; const int wid = __builtin_amdgcn_readfirstlane(tid >> 6);
    const int head = 4 * hk + 2 * pr + (wid >> 2);
    const long rowblk = (long)b * SEQ + n * 128;
    const long ctxrow = (long)NLAT + b * LCTX;
    const int nlo = n > 0 ? 2 : 0, nhi = n < (SEQ / 128 - 1) ? 2 : 0;
    const int NT = 6 + nlo + nhi;
    const bf16* Qw = QKV + (rowblk + (wid & 3) * QBLK) * PITCH + head * D;
    const bf16* Kc = QKV + 1024 + hk * D; const bf16* Vc = QKV + 1280 + hk * D;
    const unsigned lds0 = (unsigned)(uintptr_t)shm;
    float* wsf = (float*)(shm + LDS_WS) + wid * 64;
    const long klane = (long)lane * PITCH + wid * 8;
    const long vlane = (long)(16 * (wid & 3) + (lane >> 2)) * PITCH + (wid >> 2) * 32 + (lane & 3) * 8;
    const unsigned kdst = lds0 + LDS_K + wid * 1024, vdst = lds0 + LDS_V + wid * 1024;
#define TROW(t) (((t) < 2) ? (rowblk + 64 * (t)) : ((t) < 6) ? (ctxrow + 64 * ((t) - 2)) : (rowblk + ((((t) - 6) < nlo) ? (-128 + 64 * ((t) - 6)) : (128 + 64 * ((t) - 6 - nlo)))))
#define TKB(t) (((t) < 6) ? 0 : ((((t) - 6) < nlo) ? (-128 + 64 * ((t) - 6)) : (128 + 64 * ((t) - 6 - nlo))))
#define DMA_K(t, slot) glds16(Kc + TROW(t) * PITCH + klane, (unsigned)__builtin_amdgcn_readfirstlane(kdst + (slot)))
#define DMA_V(t, slot) glds16(Vc + TROW(t) * PITCH + vlane, (unsigned)__builtin_amdgcn_readfirstlane(vdst + (slot)))
    const int vb0 = (int)(lds0 + LDS_V) + ((lane >> 4) & 1) * 32 + (lane & 3) * 8 + (4 * hi + ((lane & 15) >> 2)) * 64;
    const char* Kbase = shm + LDS_K; bf16x8 kf[8];
    const lds_cptr shm3 = (lds_cptr)shm; const lds_cptr kp0 = shm3 + LDS_K + hi * 1024 + r32 * 16; const lds_cptr vp0 = shm3 + LDS_V + ((lane >> 4) & 1) * 32 + (lane & 3) * 8 + (4 * hi + ((lane & 15) >> 2)) * 64;
    DMA_K(0, 0); DMA_V(0, 0); DMA_K(1, SLOTB);
    bf16x8 qr[4];
#pragma unroll
    for (int d0 = 0; d0 < 4; ++d0) qr[d0] = *reinterpret_cast<const bf16x8*>(&Qw[(long)r32 * PITCH + d0 * 16 + hi * 8]);
    float mhat = 0.f, l_reg = 0.f; f32x16 o[2]; o[0] = f32x16{}; o[1] = f32x16{}; f32x16 negm = f32x16{}; asm volatile("" : "+v"(negm));
    const int qrel = (wid & 3) * QBLK + r32;
#define CMASK(P0, P1, t) do { int jb_ = (t) - (NT - 4); if (jb_ >= 0) bmask(P0, P1, TKB(t), qrel, hi); } while (0)
    bool resc = false;
#define START(P0, P1) do { const float rm = rowmax(P0, P1); resc = false; \
    { const float dl = rm; mhat = fadd_s(mhat, dl); \
      _Pragma("unroll") for (int r = 0; r < 16; ++r) { P0[r] = fsub_s(P0[r], dl); P1[r] = fsub_s(P1[r], dl); } \
      _Pragma("unroll") for (int r = 0; r < 16; ++r) negm[r] = -mhat; asm volatile("" : "+v"(negm)); } \
    _Pragma("unroll") for (int r = 0; r < 16; ++r) P0[r] = __builtin_amdgcn_exp2f(P0[r]); } while (0)
#define RESC() do { if (resc) { asm volatile("s_waitcnt lgkmcnt(0)" ::: "memory"); \
      _Pragma("unroll") for (int d_ = 0; d_ < 2; ++d_) _Pragma("unroll") for (int r = 0; r < 16; ++r) o[d_][r] *= wsf[crow(r, hi)]; } } while (0)
    f32x16 pA0, pA1, pB0, pB1;
    int sl_prev = 0, sl_cur = 0, sl_next = SLOTB;
#define ROT() do { sl_prev = sl_cur; sl_cur = sl_next; sl_next = (sl_next == (NSLOT - 1) * SLOTB) ? 0 : sl_next + SLOTB; } while (0)
    DMA_K(2, 2 * SLOTB);
    WAIT_BAR(3);
    qkt(pA0, pA1, Kbase, qr, negm, r32, hi); asm volatile("s_nop 15\n\ts_nop 7" : "+v"(pA0), "+v"(pA1));
    START(pA0, pA1);
    _Pragma("unroll") for (int r = 0; r < 16; ++r) pA1[r] = __builtin_amdgcn_exp2f(pA1[r]);
    WAIT_BAR(0);
    DMA_K(3, 0); DMA_V(1, SLOTB);
    ROT();
    kload8(kf, kp0 + sl_cur);
    WAIT_BAR(2);
    s16x4 vlo[8], vhi[8]; u32x4 pw0, pw1, pw2, pw3;
#define PKW(P, B) cvtpk_s(P[B], P[B + 1])
#define PAF(k) __builtin_bit_cast(bf16x8, pw##k)
#define VFR(i) (bf16x8){vlo[i][0], vlo[i][1], vlo[i][2], vlo[i][3], vhi[i][0], vhi[i][1], vhi[i][2], vhi[i][3]}
#define PIN(x) asm volatile("" : "+v"(x))
#define MX3(a, b, c) __builtin_fmaxf(__builtin_fmaxf((a), (b)), (c))
#define GAPA(MF, A0, A1, A2, A3, W0, W1, PW) do { MF; sacc += A0; sacc += A1; sacc += A2; sacc += A3; PIN(sacc); W0; W1; PIN(PW); SBAR(); } while (0)
#define EX(v) __builtin_amdgcn_exp2f(v)
#define GAPB(MF, X, B) do { MF; X[B] = EX(X[B]); X[B + 1] = EX(X[B + 1]); X[B + 2] = EX(X[B + 2]); X[B + 3] = EX(X[B + 3]); PIN(X); SBAR(); } while (0)
#define VRD(i) do { vlo[i] = vtr(vp_ + (((i) >> 2) * 4096 + ((i) & 3) * 1024)); vhi[i] = vtr(vp_ + (((i) >> 2) * 4096 + ((i) & 3) * 1024 + 512)); } while (0)
#define KRD(G, j) do { if (G) { kload2(kf, kp0 + sl_next, j); SBAR(); } } while (0)
#define STEP(C0, C1, P0, P1, t, GK, GV, GL) do { SBAR(); \
    const lds_cptr vp_ = vp0 + sl_prev; \
    VRD(0); SBAR(); float sacc = (P0[0] + P0[1]); \
    GAPA(C0 = __builtin_amdgcn_mfma_f32_32x32x16_bf16(kf[0], qr[0], negm, 0, 0, 0), P0[2], P0[3], P0[4], P0[5],     pw0[0] = PKW(P0, 0), pw0[1] = PKW(P0, 2), pw0); \
    VRD(4); SBAR(); GAPA(C1 = __builtin_amdgcn_mfma_f32_32x32x16_bf16(kf[1], qr[0], negm, 0, 0, 0), P0[6], P0[7], P0[8], P0[9],     pw0[2] = PKW(P0, 4), pw0[3] = PKW(P0, 6), pw0); \
    VRD(1); SBAR(); GAPA(C0 = __builtin_amdgcn_mfma_f32_32x32x16_bf16(kf[2], qr[1], C0, 0, 0, 0),   P0[10], P0[11], P0[12], P0[13], pw1[0] = PKW(P0, 8), pw1[1] = PKW(P0, 10), pw1); \
    VRD(5); SBAR(); GAPA(C1 = __builtin_amdgcn_mfma_f32_32x32x16_bf16(kf[3], qr[1], C1, 0, 0, 0),   P0[14], P0[15], P1[0], P1[1],   pw1[2] = PKW(P0, 12), pw1[3] = PKW(P0, 14), pw1); \
    VRD(2); SBAR(); GAPA(C0 = __builtin_amdgcn_mfma_f32_32x32x16_bf16(kf[4], qr[2], C0, 0, 0, 0),   P1[2], P1[3], P1[4], P1[5],     pw2[0] = PKW(P1, 0), pw2[1] = PKW(P1, 2), pw2); \
    VRD(6); SBAR(); GAPA(C1 = __builtin_amdgcn_mfma_f32_32x32x16_bf16(kf[5], qr[2], C1, 0, 0, 0),   P1[6], P1[7], P1[8], P1[9],     pw2[2] = PKW(P1, 4), pw2[3] = PKW(P1, 6), pw2); \
    VRD(3); SBAR(); GAPA(C0 = __builtin_amdgcn_mfma_f32_32x32x16_bf16(kf[6], qr[3], C0, 0, 0, 0),   P1[10], P1[11], P1[12], P1[13], pw3[0] = PKW(P1, 8), pw3[1] = PKW(P1, 10), pw3); \
    VRD(7); SBAR(); GAPA(C1 = __builtin_amdgcn_mfma_f32_32x32x16_bf16(kf[7], qr[3], C1, 0, 0, 0),   P1[14], P1[15], 0.f, 0.f,       pw3[2] = PKW(P1, 12), pw3[3] = PKW(P1, 14), pw3); \
    l_reg += sacc; \
    if (GK) { DMA_K((t) + 3, sl_cur); } if (GV) { DMA_V((t) + 1, sl_next); } \
    CMASK(C0, C1, t); \
    { float a = MX3(C0[0], C0[1], C1[0]), b = MX3(C0[2], C0[3], C1[1]); a = MX3(a, C1[2], C1[3]); \
      _Pragma("unroll") for (int r = 4; r < 16; r += 4) { a = MX3(a, C0[r], C0[r + 1]); b = MX3(b, C0[r + 2], C0[r + 3]); a = MX3(a, C1[r], C1[r + 1]); b = MX3(b, C1[r + 2], C1[r + 3]); } \
      float rm = __builtin_fmaxf(a, b); { auto rr = __builtin_amdgcn_permlane32_swap(__float_as_uint(rm), __float_as_uint(rm), false, false); rm = __builtin_fmaxf(__uint_as_float(rr[0]), __uint_as_float(rr[1])); } \
      resc = false; \
      if (__builtin_expect(__any(rm > (float)THRL), 0)) { const float dl = __builtin_fmaxf(rm, 0.f); mhat += dl; \
        _Pragma("unroll") for (int r = 0; r < 16; ++r) { C0[r] -= dl; C1[r] -= dl; } \
        _Pragma("unroll") for (int r = 0; r < 16; ++r) negm[r] = -mhat; asm volatile("" : "+v"(negm)); \
        const float f = __builtin_amdgcn_exp2f(-dl); l_reg *= f; if (hi == 0) wsf[r32] = f; resc = true; } } \
    SBAR(); \
    GAPB(o[0] = __builtin_amdgcn_mfma_f32_32x32x16_bf16(PAF(0), VFR(0), o[0], 0, 0, 0), C0, 0); \
    GAPB(o[1] = __builtin_amdgcn_mfma_f32_32x32x16_bf16(PAF(0), VFR(4), o[1], 0, 0, 0), C0, 4); \
    KRD(GL, 0); GAPB(o[0] = __builtin_amdgcn_mfma_f32_32x32x16_bf16(PAF(1), VFR(1), o[0], 0, 0, 0), C0, 8); \
    KRD(GL, 1); GAPB(o[1] = __builtin_amdgcn_mfma_f32_32x32x16_bf16(PAF(1), VFR(5), o[1], 0, 0, 0), C0, 12); \
    KRD(GL, 2); GAPB(o[0] = __builtin_amdgcn_mfma_f32_32x32x16_bf16(PAF(2), VFR(2), o[0], 0, 0, 0), C1, 0); \
    KRD(GL, 3); GAPB(o[1] = __builtin_amdgcn_mfma_f32_32x32x16_bf16(PAF(2), VFR(6), o[1], 0, 0, 0), C1, 4); \
    GAPB(o[0] = __builtin_amdgcn_mfma_f32_32x32x16_bf16(PAF(3), VFR(3), o[0], 0, 0, 0), C1, 8); \
    GAPB(o[1] = __builtin_amdgcn_mfma_f32_32x32x16_bf16(PAF(3), VFR(7), o[1], 0, 0, 0), C1, 12); \
    } while (0)
    int t = 1;
#undef CMASK
#define CMASK(P0, P1, t) do { } while (0)
    for (; t + 5 < NT; t += 2) {
        STEP(pB0, pB1, pA0, pA1, t, true, true, true);     WAIT_BAR(2); RESC(); ROT();
        STEP(pA0, pA1, pB0, pB1, t + 1, true, true, true); WAIT_BAR(2); RESC(); ROT();
    }
#undef CMASK
#define CMASK(P0, P1, t) do { int jb_ = (t) - (NT - 4); if (jb_ >= 0) bmask(P0, P1, TKB(t), qrel, hi); } while (0)
#define ENDW(tt) do { if ((tt) + 3 < NT) { WAIT_BAR(2); } else if ((tt) + 2 < NT) { WAIT_BAR(1); } else { WAIT_BAR(0); } } while (0)
    for (; t + 1 < NT; t += 2) {
        STEP(pB0, pB1, pA0, pA1, t, (t + 3 < NT), (t + 1 < NT), (t + 1 < NT));     ENDW(t);     RESC(); ROT();
        STEP(pA0, pA1, pB0, pB1, t + 1, (t + 4 < NT), (t + 2 < NT), (t + 2 < NT)); ENDW(t + 1); RESC(); ROT();
    }
    STEP(pB0, pB1, pA0, pA1, NT - 1, false, false, false); RESC();
    { float sacc = pB0[0] + pB0[1]; _Pragma("unroll") for (int r = 2; r < 16; ++r) sacc += pB0[r]; _Pragma("unroll") for (int r = 0; r < 16; ++r) sacc += pB1[r]; l_reg += sacc;
      pw0 = (u32x4){PKW(pB0, 0), PKW(pB0, 2), PKW(pB0, 4), PKW(pB0, 6)}; pw1 = (u32x4){PKW(pB0, 8), PKW(pB0, 10), PKW(pB0, 12), PKW(pB0, 14)}; pw2 = (u32x4){PKW(pB1, 0), PKW(pB1, 2), PKW(pB1, 4), PKW(pB1, 6)}; pw3 = (u32x4){PKW(pB1, 8), PKW(pB1, 10), PKW(pB1, 12), PKW(pB1, 14)};
      SBAR(); pv(o, vb0 + sl_cur, PAF(0), PAF(1), PAF(2), PAF(3)); }
#undef PKW
#undef PAF
#undef VFR
#undef PIN
#undef MX3
#undef GAPA
#undef GAPB
#undef EX
#undef VRD
#undef KRD
#undef STEP
#undef ENDW
    { auto rr = __builtin_amdgcn_permlane32_swap(__float_as_uint(l_reg), __float_as_uint(l_reg), false, false); l_reg = __uint_as_float(rr[0]) + __uint_as_float(rr[1]); }
    l_reg += __builtin_amdgcn_exp2f(sinkp[head] * 1.4426950408889634f - mhat);
    if (hi == 0) wsf[32 + r32] = l_reg; asm volatile("s_waitcnt lgkmcnt(0)" ::: "memory");
    float rli[16];
#pragma unroll
    for (int r = 0; r < 16; ++r) rli[r] = __builtin_amdgcn_rcpf(wsf[32 + crow(r, hi)]);
    bf16* Ow = O + (rowblk + (wid & 3) * QBLK) * OPITCH + head * D;
    { bf16* stg = (bf16*)(shm + LDS_OST) + wid * 2048;
#pragma unroll
      for (int r = 0; r < 16; ++r) { const int orow = crow(r, hi);
#pragma unroll
        for (int d0 = 0; d0 < 2; ++d0) stg[orow * 64 + d0 * 32 + r32] = __float2bfloat16(o[d0][r] * rli[r]); }
      asm volatile("s_waitcnt lgkmcnt(0)" ::: "memory");
#pragma unroll
      for (int i = 0; i < 4; ++i) { const int row = i * 8 + (lane >> 3), ch = lane & 7; const u32x4 v = *(const u32x4*)(stg + row * 64 + ch * 8); ATTN_STORE16(Ow + (long)row * OPITCH + ch * 8, v); } }
    asm volatile("s_waitcnt lgkmcnt(0)\n\ts_barrier" ::: "memory");
#undef DMA_K
#undef DMA_V
#undef TROW
#undef TKB
#undef CMASK
#undef START
#undef RESC
#undef ROT
}
#undef SBAR
#undef WAIT_BAR
}

#define XB_TMO      128
#define XB_XCNT(j)  (256  + 64 * (j))
#define XB_XSUB(j)  (1280 + 64 * (j))
#define XB_XGEN(j)  (2304 + 64 * (j))
#define XB_TOP      3328
#define XB_TOPGEN   3392
#define XCD_BAR_WORDS 3456
#define XB_SPIN_CAP (1u << 18)
__device__ __forceinline__ unsigned xb_ld(unsigned* p)              { return __hip_atomic_load(p, __ATOMIC_RELAXED, __HIP_MEMORY_SCOPE_AGENT); }
__device__ __forceinline__ unsigned xb_add(unsigned* p, unsigned v) { return __hip_atomic_fetch_add(p, v, __ATOMIC_RELAXED, __HIP_MEMORY_SCOPE_AGENT); }
__device__ __forceinline__ unsigned xb_xcc_id() { return (unsigned)__builtin_amdgcn_s_getreg((3 << 11) | 20) & 0xFu; }
#define XB_SPIN(cond, bar) do { unsigned _sp = 0; while (cond) { __builtin_amdgcn_s_sleep(1); \
    if ((++_sp & 255u) == 0u) { if (xb_ld(&(bar)[XB_TMO])) break; if (_sp > XB_SPIN_CAP) { atomicAdd(&(bar)[XB_TMO], 1u); break; } } } } while (0)
struct XcdBarrier { unsigned* bar; unsigned x; volatile LAS unsigned* st; };
__device__ __forceinline__ XcdBarrier xcd_barrier_post(unsigned* bar, volatile LAS unsigned* st) {
    XcdBarrier b; b.bar = bar; b.x = xb_xcc_id(); b.st = st;
    if (threadIdx.x == 0) (void)xb_add(&bar[XB_XCNT(b.x)], 1u);
    return b;
}
__device__ __forceinline__ void xcd_barrier_complete(unsigned* bar, unsigned x, unsigned& nloc, unsigned& nx) {
    const unsigned G = gridDim.x * gridDim.y * gridDim.z;
    unsigned sum, cnt, mine, sp = 0u;
    for (;;) {
        sum = 0u; cnt = 0u; mine = 0u;
#pragma unroll
        for (unsigned j = 0; j < 16; ++j) { const unsigned c = xb_ld(&bar[XB_XCNT(j)]); sum += c; cnt += (c > 0u) ? 1u : 0u; mine = (j == x) ? c : mine; }
        if (sum == G) break;
        __builtin_amdgcn_s_sleep(1);
        if ((++sp & 255u) == 0u) { if (xb_ld(&bar[XB_TMO])) break; if (sp > XB_SPIN_CAP) { atomicAdd(&bar[XB_TMO], 1u); break; } }
    }
    nloc = mine > 0u ? mine : 1u; nx = cnt > 0u ? cnt : 1u;
}
__device__ __forceinline__ void xcd_barrier(const XcdBarrier& b) {
    asm volatile("s_waitcnt vmcnt(0)" ::: "memory");
    __syncthreads();
    if (threadIdx.x == 0) {
        unsigned* bar = b.bar;
        __builtin_amdgcn_s_waitcnt(0);
        unsigned nloc = b.st[0], nx = b.st[1];
        if (nloc == 0u) { xcd_barrier_complete(bar, b.x, nloc, nx); b.st[0] = nloc; b.st[1] = nx; }
        const unsigned old = xb_add(&bar[XB_XSUB(b.x)], 1u);
        const unsigned gen = old / nloc;
        if (old + 1u == (gen + 1u) * nloc) {
            __builtin_amdgcn_fence(__ATOMIC_RELEASE, "agent");
            asm volatile("s_waitcnt vmcnt(0)" ::: "memory");
            const unsigned og = xb_add(&bar[XB_TOP], 1u);
            const unsigned tg = og / nx;
            if (og + 1u == (tg + 1u) * nx) xb_add(&bar[XB_TOPGEN], 1u);
            else XB_SPIN(xb_ld(&bar[XB_TOPGEN]) == tg, bar);
            __builtin_amdgcn_fence(__ATOMIC_ACQUIRE, "agent");
            xb_add(&bar[XB_XGEN(b.x)], 1u);
            asm volatile("s_waitcnt vmcnt(0)" ::: "memory");
        } else {
            XB_SPIN(xb_ld(&bar[XB_XGEN(b.x)]) == gen, bar);
            __builtin_amdgcn_fence(__ATOMIC_ACQUIRE, "agent");
            asm volatile("s_waitcnt vmcnt(0)" ::: "memory");
        }
    }
    __syncthreads();
}

#define LDS_WAIT() asm volatile("s_waitcnt lgkmcnt(0)" ::: "memory")
__device__ __forceinline__ void transpose_item(const float* W, int K, int N, bf16_t* WT, int k0, int n0, int drow0, LAS float* scr, int lane) {
    float t[32];
#pragma unroll
    for (int i = 0; i < 32; ++i) t[i] = __builtin_nontemporal_load(W + (size_t)(k0 + 2 * i + (lane >> 5)) * N + n0 + (lane & 31));
#pragma unroll
    for (int i = 0; i < 32; ++i) scr[(2 * i + (lane >> 5)) * 33 + (lane & 31)] = t[i];
    LDS_WAIT(); asm volatile("" ::: "memory");
    const int c = lane & 7;
#pragma unroll
    for (int j = 0; j < 4; ++j) { const int n = (lane >> 3) + 8 * j; const LAS float* s = scr + (8 * c) * 33 + n;
        u32x4 o; o.x = pkbf(s[0 * 33], s[1 * 33]); o.y = pkbf(s[2 * 33], s[3 * 33]); o.z = pkbf(s[4 * 33], s[5 * 33]); o.w = pkbf(s[6 * 33], s[7 * 33]);
        *(GAS u32x4*)(WT + (size_t)(drow0 + n) * K + k0 + 8 * c) = o; }
    LDS_WAIT(); asm volatile("" ::: "memory");
}
__device__ __forceinline__ void transpose_item_f8(const float* W, int K, int N, unsigned char* WT, int k0, int n0, int drow0, float scale, LAS float* scr, int lane) {
    float t[32];
#pragma unroll
    for (int i = 0; i < 32; ++i) t[i] = __builtin_nontemporal_load(W + (size_t)(k0 + 2 * i + (lane >> 5)) * N + n0 + (lane & 31));
#pragma unroll
    for (int i = 0; i < 32; ++i) scr[(2 * i + (lane >> 5)) * 33 + (lane & 31)] = t[i];
    LDS_WAIT(); asm volatile("" ::: "memory");
    const int n = lane >> 1, hf = lane & 1; const LAS float* sp = scr + (32 * hf) * 33 + n;
    u32x4 o0, o1;
    o0.x = pk4f8(sp[0 * 33] * scale, sp[1 * 33] * scale, sp[2 * 33] * scale, sp[3 * 33] * scale);     o0.y = pk4f8(sp[4 * 33] * scale, sp[5 * 33] * scale, sp[6 * 33] * scale, sp[7 * 33] * scale);
    o0.z = pk4f8(sp[8 * 33] * scale, sp[9 * 33] * scale, sp[10 * 33] * scale, sp[11 * 33] * scale);   o0.w = pk4f8(sp[12 * 33] * scale, sp[13 * 33] * scale, sp[14 * 33] * scale, sp[15 * 33] * scale);
    o1.x = pk4f8(sp[16 * 33] * scale, sp[17 * 33] * scale, sp[18 * 33] * scale, sp[19 * 33] * scale); o1.y = pk4f8(sp[20 * 33] * scale, sp[21 * 33] * scale, sp[22 * 33] * scale, sp[23 * 33] * scale);
    o1.z = pk4f8(sp[24 * 33] * scale, sp[25 * 33] * scale, sp[26 * 33] * scale, sp[27 * 33] * scale); o1.w = pk4f8(sp[28 * 33] * scale, sp[29 * 33] * scale, sp[30 * 33] * scale, sp[31 * 33] * scale);
    GAS u32x4* dst = (GAS u32x4*)(WT + (size_t)(drow0 + n) * K + k0 + 32 * hf);
    dst[0] = o0; dst[1] = o1;
    LDS_WAIT(); asm volatile("" ::: "memory");
}
__device__ __forceinline__ unsigned pk4i8(float a, float b, float c, float d) {
    const int ia = (int)__builtin_rintf(a), ib = (int)__builtin_rintf(b), ic = (int)__builtin_rintf(c), id = (int)__builtin_rintf(d);
    return (unsigned)(ia & 255) | ((unsigned)(ib & 255) << 8) | ((unsigned)(ic & 255) << 16) | ((unsigned)(id & 255) << 24); }
__device__ __forceinline__ void transpose_item_i8(const float* W, int K, int N, unsigned char* WT, int k0, int n0, int drow0, float scale, LAS float* scr, int lane) {
    float t[32];
#pragma unroll
    for (int i = 0; i < 32; ++i) t[i] = W[(size_t)(k0 + 2 * i + (lane >> 5)) * N + n0 + (lane & 31)];
#pragma unroll
    for (int i = 0; i < 32; ++i) scr[(2 * i + (lane >> 5)) * 33 + (lane & 31)] = t[i];
    LDS_WAIT(); asm volatile("" ::: "memory");
    const int n = lane >> 1, hf = lane & 1; const LAS float* sp = scr + (32 * hf) * 33 + n;
    u32x4 o0, o1;
    o0.x = pk4i8(sp[0 * 33] * scale, sp[1 * 33] * scale, sp[2 * 33] * scale, sp[3 * 33] * scale);     o0.y = pk4i8(sp[4 * 33] * scale, sp[5 * 33] * scale, sp[6 * 33] * scale, sp[7 * 33] * scale);
    o0.z = pk4i8(sp[8 * 33] * scale, sp[9 * 33] * scale, sp[10 * 33] * scale, sp[11 * 33] * scale);   o0.w = pk4i8(sp[12 * 33] * scale, sp[13 * 33] * scale, sp[14 * 33] * scale, sp[15 * 33] * scale);
    o1.x = pk4i8(sp[16 * 33] * scale, sp[17 * 33] * scale, sp[18 * 33] * scale, sp[19 * 33] * scale); o1.y = pk4i8(sp[20 * 33] * scale, sp[21 * 33] * scale, sp[22 * 33] * scale, sp[23 * 33] * scale);
    o1.z = pk4i8(sp[24 * 33] * scale, sp[25 * 33] * scale, sp[26 * 33] * scale, sp[27 * 33] * scale); o1.w = pk4i8(sp[28 * 33] * scale, sp[29 * 33] * scale, sp[30 * 33] * scale, sp[31 * 33] * scale);
    GAS u32x4* dst = (GAS u32x4*)(WT + (size_t)(drow0 + n) * K + k0 + 32 * hf);
    dst[0] = o0; dst[1] = o1;
    LDS_WAIT(); asm volatile("" ::: "memory");
}
__device__ __forceinline__ void sincos_d(double x, double& s, double& c) {
    const double TWO_PI = 6.283185307179586476925;
    const double k = __builtin_rint(x / TWO_PI); const double r = x - k * TWO_PI;
    const double r2 = r * r; double ts = r, tc = 1.0; s = r; c = 1.0;
    for (int i = 1; i <= 16; ++i) { tc *= -r2 / (double)((2 * i - 1) * (2 * i)); ts *= -r2 / (double)((2 * i) * (2 * i + 1)); c += tc; s += ts; }
}

constexpr int CI_F = 16 * 112, CI_FD = 56 * 32, MOE_ITEMS = 8 * (2 * CI_F + CI_FD);
constexpr int MOE_TAIL_A = 12000, MOE_TAIL_B = 7000, MOE_TAIL_C = 12000, MOE_TAIL_TOTAL = MOE_TAIL_A + MOE_TAIL_B + MOE_TAIL_C;
__device__ __forceinline__ void moe_convert_item(int r, const float* wg, const float* wu, const float* wd, unsigned char* mgu, unsigned char* md, LAS float* scr, int lane) {
    const int e = r / (2 * CI_F + CI_FD); int q = r % (2 * CI_F + CI_FD);
    if (q < 2 * CI_F) { const int up = q / CI_F; q %= CI_F; const int kb = q / 112, nb = q % 112, n0 = 32 * nb;
        transpose_item_f8((up ? wu : wg) + (size_t)e * 1024 * DFF, 1024, DFF, mgu + (size_t)e * 7168 * 1024, 64 * kb, n0, 256 * (n0 >> 7) + 128 * up + (n0 & 127), MOE_SGU, scr, lane); }
    else { q -= 2 * CI_F; const int kb = q / 32, nb = q % 32; transpose_item_f8(wd + (size_t)e * DFF * 1024, DFF, 1024, md + (size_t)e * 1024 * DFF, 64 * kb, 32 * nb, 32 * nb, MOE_SD, scr, lane); }
}
__device__ __forceinline__ void moe_convert_tail(int nunits, int G, int bx, int first, int count, const float* wg, const float* wu, const float* wd, unsigned char* mgu, unsigned char* md, LAS unsigned char* lds) {
    const int busy = nunits % G; if (busy == 0 || bx < busy) return;
    int tid_ = threadIdx.x; asm volatile("" : "+v"(tid_)); const int lane = tid_ & 63, wave = __builtin_amdgcn_readfirstlane(tid_ >> 6);
    LAS float* scr = (LAS float*)(lds + wave * 16384);
    const int nw = (G - busy) * 8, w = (bx - busy) * 8 + wave;
    for (int it = w; it < count; it += nw) moe_convert_item(first + it, wg, wu, wd, mgu, md, scr, lane);
}

struct Args { const float* in[24]; float* out; unsigned char* ws; int ph_lo, ph_hi, li, pad; };
constexpr int NPH = 18;

__device__ __forceinline__ void norm_store(const f32x4 (&v)[4], float ssum, const float* g, const float* mrow, int shc, int scc, bf16_t* XNo, size_t m, int lane, float* rsc) {
    const float rstd = 1.0f / __builtin_sqrtf(ssum * (1.0f / DM) + EPS);
    f32x4 y[4];
#pragma unroll
    for (int j = 0; j < 4; ++j) { const f32x4 gv = *(const f32x4*)(g + 4 * lane + 256 * j), sc = *(const f32x4*)(mrow + scc * 1024 + 4 * lane + 256 * j), sh = *(const f32x4*)(mrow + shc * 1024 + 4 * lane + 256 * j);
        y[j] = (v[j] * rstd) * gv * (sc + 1.0f) + sh; }
    if (rsc == nullptr) {
#pragma unroll
        for (int j = 0; j < 4; ++j) { u32x2 w; w.x = pkbf(y[j].x, y[j].y); w.y = pkbf(y[j].z, y[j].w); *((GAS u32x2*)(XNo + m * DM) + lane + 64 * j) = w; }
    } else {
        float mx = 0.f;
#pragma unroll
        for (int j = 0; j < 4; ++j) mx = __builtin_fmaxf(__builtin_fmaxf(mx, __builtin_fmaxf(__builtin_fabsf(y[j].x), __builtin_fabsf(y[j].y))), __builtin_fmaxf(__builtin_fabsf(y[j].z), __builtin_fabsf(y[j].w)));
#pragma unroll
        for (int o = 1; o < 64; o <<= 1) mx = __builtin_fmaxf(mx, __shfl_xor(mx, o));
        mx = __builtin_fmaxf(mx, 1e-20f); const float qs = 127.0f / mx;
#pragma unroll
        for (int j = 0; j < 4; ++j) *((GAS unsigned*)((unsigned char*)XNo + m * DM) + lane + 64 * j) = pk4i8(y[j].x * qs, y[j].y * qs, y[j].z * qs, y[j].w * qs);
        if (lane == 0) rsc[m] = mx * (1.0f / 127.0f);
    }
}
template <bool SRC_BF16> __device__ __forceinline__ void norm_rows(const void* srcLv, const float* srcC, int nrows, const float* g, const float* mod, int shc, int scc, bf16_t* XNo, int gw, int NGW, int lane,
                                          const float* part, int nS, const float* gatec, float* zout, float* rsc = nullptr) {
    if (nrows > NLAT) {
        for (int rc = gw; rc < NCTXR; rc += NGW) {
            const GAS f32x4* xr = (const GAS f32x4*)(srcC + (size_t)rc * DM) + lane;
            f32x4 v[4];
#pragma unroll
            for (int j = 0; j < 4; ++j) v[j] = xr[64 * j];
            if (part != nullptr) {
                f32x4 a[4];
#pragma unroll
                for (int j = 0; j < 4; ++j) a[j] = (f32x4){0.f, 0.f, 0.f, 0.f};
                for (int s0 = 0; s0 < nS; s0 += 7) {
                    f32x4 t[7][4];
#pragma unroll
                    for (int q = 0; q < 7; ++q) { const int s2 = (s0 + q < nS) ? s0 + q : s0; const GAS f32x4* pr = (const GAS f32x4*)(part + ((size_t)s2 * NCTXR + rc) * DM) + lane;
#pragma unroll
                        for (int j = 0; j < 4; ++j) t[q][j] = pr[64 * j]; }
#pragma unroll
                    for (int q = 0; q < 7; ++q) if (s0 + q < nS) {
#pragma unroll
                        for (int j = 0; j < 4; ++j) a[j] += t[q][j]; }
                }
#pragma unroll
                for (int j = 0; j < 4; ++j) v[j] += *(const f32x4*)(gatec + 4 * lane + 256 * j) * a[j];
                if (zout != nullptr) { GAS f32x4* zr = (GAS f32x4*)(zout + (size_t)rc * DM) + lane;
#pragma unroll
                    for (int j = 0; j < 4; ++j) zr[64 * j] = v[j]; }
            }
            float ss = 0.f;
#pragma unroll
            for (int j = 0; j < 4; ++j) ss += (v[j].x * v[j].x + v[j].y * v[j].y) + (v[j].z * v[j].z + v[j].w * v[j].w);
            norm_store(v, wave_sum(ss), g, mod + (size_t)4 * 6144, shc, scc, XNo, (size_t)NLAT + rc, lane, rsc);
        }
    }
    const bool bal = (NGW == 2048) && (nrows > NLAT);
    for (int k = 0;; ++k) {
        int grp;
        if (bal) { if (k < 3) grp = gw + 2048 * k; else if (gw >= 1024 && k < 5) grp = 6144 + 2 * (gw - 1024) + (k - 3); else break; }
        else { grp = gw + k * NGW; if (grp >= NLAT / 4) break; }
        const int m0 = grp * 4;
        const int mb = m0 >> 13;
        f32x4 v[4][4];
        if constexpr (SRC_BF16) { const GAS u32x2* xr = (const GAS u32x2*)((const bf16_t*)srcLv + (size_t)m0 * DM) + lane;
#pragma unroll
            for (int r = 0; r < 4; ++r)
#pragma unroll
                for (int j = 0; j < 4; ++j) { const u32x2 w = xr[r * 256 + 64 * j]; v[r][j] = (f32x4){__uint_as_float(w.x << 16), __uint_as_float(w.x & 0xffff0000u), __uint_as_float(w.y << 16), __uint_as_float(w.y & 0xffff0000u)}; } }
        else { const GAS f32x4* xr = (const GAS f32x4*)((const float*)srcLv + (size_t)m0 * DM) + lane;
#pragma unroll
            for (int r = 0; r < 4; ++r)
#pragma unroll
                for (int j = 0; j < 4; ++j) v[r][j] = xr[r * 256 + 64 * j]; }
        float ss[4];
#pragma unroll
        for (int r = 0; r < 4; ++r) { ss[r] = 0.f;
#pragma unroll
            for (int j = 0; j < 4; ++j) ss[r] += (v[r][j].x * v[r][j].x + v[r][j].y * v[r][j].y) + (v[r][j].z * v[r][j].z + v[r][j].w * v[r][j].w); }
#pragma unroll
        for (int o = 1; o < 64; o <<= 1) {
#pragma unroll
            for (int r = 0; r < 4; ++r) ss[r] += __shfl_xor(ss[r], o); }
#pragma unroll
        for (int r = 0; r < 4; ++r) norm_store(v[r], ss[r], g, mod + (size_t)mb * 6144, shc, scc, XNo, (size_t)(m0 + r), lane, rsc);
    }
}

__global__ void __launch_bounds__(512, 2) fwd(Args args) {
    extern __shared__ __attribute__((aligned(16))) unsigned char lds_raw[];
    LAS unsigned char* lds = (LAS unsigned char*)lds_raw;
    volatile LAS unsigned* MISC = (volatile LAS unsigned*)(lds + MISC_OFF);
    LAS int* gtab = (LAS int*)(lds + GTAB_OFF);
    const int G = gridDim.x; const int bx = blockIdx.x; const int vcu = (G % 8 == 0) ? (bx % 8) * (G / 8) + bx / 8 : bx;
    const int NGW = G * 8;
#define PHASE_IDS() int tid_ = threadIdx.x; asm volatile("" : "+v"(tid_)); const int tid = tid_, lane = tid & 63, wave = __builtin_amdgcn_readfirstlane(tid >> 6), gw = vcu * 8 + wave; (void)lane; (void)gw
    unsigned char* ws = args.ws;
    gu32* ctl = (gu32*)(ws + WS_CTL);
#define MOD ((float*)(ws + WS_MOD))
#define ROPE ((float*)(ws + WS_ROPE))
#define STATS ((float*)(ws + WS_STATS))
#define RSC ((float*)(ws + WS_RSC))
#define LIST ((int*)(ws + WS_LIST))
#define TINFO ((int*)(ws + WS_TINFO))
#define WSB ((bf16_t*)(ws + WS_WS))
#define WIN ((unsigned char*)(ws + WS_WIN))
#define WAO ((bf16_t*)(ws + WS_WAO))
#define WQKV ((unsigned char*)(ws + WS_WQKV))
#define WBO ((bf16_t*)(ws + WS_WBO))
#define WGU ((unsigned char*)(ws + WS_WGU))
#define WD ((bf16_t*)(ws + WS_WD))
#define MGU ((unsigned char*)(ws + WS_MGU))
#define MD ((unsigned char*)(ws + WS_MD))
#define XN8 ((unsigned char*)(ws + WS_XN))
#define XN ((bf16_t*)(ws + WS_XN))
#define ZB ((float*)(ws + WS_ZB))
#define UVT ((bf16_t*)(ws + WS_UVT))
#define A2 ((bf16_t*)(ws + WS_A2))
#define HB ((bf16_t*)(ws + WS_H))
#define QKV ((bf16_t*)(ws + WS_QKV))
#define OB ((bf16_t*)(ws + WS_O))
#define YB ((bf16_t*)(ws + WS_Y))
#define HC ((unsigned char*)(ws + WS_HC))
#define YP ((bf16_t*)(ws + WS_YP))
#define PART1 ((float*)(ws + WS_PART1))
#define PART2 ((float*)(ws + WS_PART2))
#define I_X (args.in[0])
#define I_C (args.in[1])
#define I_CTX (args.in[2])
#define I_CCTX (args.in[3])
#define I_ADAW (args.in[4])
#define I_ADAB (args.in[5])
#define I_NORMG (args.in[6])
#define I_FINALG (args.in[7])
#define HL ((bf16_t*)(ws + WS_HLB))

    { PHASE_IDS(); for (int u = tid; u < (LDS_BYTES - MISC_OFF) / 4; u += 512) ((LAS unsigned*)(lds + MISC_OFF))[u] = 0u; }
    __syncthreads();
    const int lo = args.ph_lo, hi_ph = args.ph_hi;
    const bool one_launch = (hi_ph - lo) > 1;
    XcdBarrier bar; bar.bar = (unsigned*)(ctl + CW_BAR) + args.li * XCD_BAR_WORDS; bar.x = 0; bar.st = nullptr;
    if (one_launch) bar = xcd_barrier_post((unsigned*)(ctl + CW_BAR) + args.li * XCD_BAR_WORDS, MISC + 8);
#ifndef PHMASK
#define PHMASK 0xFFFFFFFFu
#endif
#define IN(k) (((PHMASK >> (k)) & 1) && lo <= (k) && (k) < hi_ph)
#define BOTH(k) (IN(k) && IN((k) + 1))
#define GRID_BAR() xcd_barrier(bar)
#if defined(PROBE_LO)
    unsigned long long tpA = __builtin_amdgcn_s_memrealtime(), tpB = 0;
#define PROBE_MARK(k) do { if ((k) == PROBE_LO - 1) tpA = __builtin_amdgcn_s_memrealtime(); if ((k) == PROBE_HI) tpB = __builtin_amdgcn_s_memrealtime(); } while (0)
#else
#define PROBE_MARK(k) do { } while (0)
#endif

    if (IN(0)) {
        PHASE_IDS();
        {
            LAS float* sv = (LAS float*)lds;
            LAS float* red = (LAS float*)(lds + 5 * 1024 * 4);
            if (bx < 192) {
                for (int idx = tid; idx < 5 * 1024; idx += 512) { const int r = idx >> 10, k = idx & 1023; const float cv = r < 4 ? I_C[r * 1024 + k] : I_CCTX[k]; sv[idx] = cv / (1.0f + __expf(-cv)); }
                __syncthreads();
                for (int item = bx; item < 192; item += G) {
                    const int i = item / 96, n0 = (item % 96) * 64, nn = tid & 63, kq = tid >> 6;
                    float a0 = 0.f, a1 = 0.f, a2 = 0.f, a3 = 0.f, a4 = 0.f;
                    const float* wp = I_ADAW + ((size_t)i * 1024 + kq * 128) * 6144 + n0 + nn;
#pragma unroll 8
                    for (int k = 0; k < 128; ++k) { const float w = wp[(size_t)k * 6144]; const int kk = kq * 128 + k;
                        a0 += sv[kk] * w; a1 += sv[1024 + kk] * w; a2 += sv[2048 + kk] * w; a3 += sv[3072 + kk] * w; a4 += sv[4096 + kk] * w; }
                    red[(kq * 5 + 0) * 64 + nn] = a0; red[(kq * 5 + 1) * 64 + nn] = a1; red[(kq * 5 + 2) * 64 + nn] = a2; red[(kq * 5 + 3) * 64 + nn] = a3; red[(kq * 5 + 4) * 64 + nn] = a4;
                    __syncthreads();
                    if (tid < 320) { const int r = tid >> 6; float s = I_ADAB[i * 6144 + n0 + nn];
#pragma unroll
                        for (int q = 0; q < 8; ++q) s += red[(q * 5 + r) * 64 + nn];
                        MOD[((size_t)i * 5 + r) * 6144 + n0 + nn] = s; }
                    __syncthreads();
                }
            }
            __syncthreads();
        }
        {
            LAS float* scr = (LAS float*)(lds + wave * 16384);
            constexpr int I_IN = 16 * 64, I_AO = 16 * 32, I_QKV = 16 * 48, I_BO = 16 * 32, I_F = 16 * 112, I_FD = 56 * 32;
            constexpr int I_DENSE = I_IN + I_AO + I_QKV + I_BO + 2 * I_F + I_FD, I_MOE = MOE_ITEMS, I_WS = 128, I_ROPE = 32;
            constexpr int NITEMS = I_DENSE + I_MOE + I_WS + I_ROPE;
            for (int it = gw; it < NITEMS; it += NGW) {
                int r = it;
                if (r < I_IN) { const int kb = r / 64, nb = r % 64; const float* W = args.in[8]; float mx = 0.f;
#pragma unroll
                    for (int i = 0; i < 32; ++i) mx = __builtin_fmaxf(mx, __builtin_fabsf(W[(size_t)(64 * kb + 2 * i + (lane >> 5)) * 2048 + 32 * nb + (lane & 31)]));
#pragma unroll
                    for (int o = 1; o < 64; o <<= 1) mx = __builtin_fmaxf(mx, __shfl_xor(mx, o));
                    if (lane == 0) __hip_atomic_fetch_max((unsigned*)(ctl + CW_WAMAX + 192), __float_as_uint(mx), __ATOMIC_RELAXED, __HIP_MEMORY_SCOPE_AGENT);
                    continue; } r -= I_IN;
                if (r < I_AO) { const int kb = r / 32, nb = r % 32; transpose_item(args.in[13], 1024, 1024, WAO, 64 * kb, 32 * nb, 32 * nb, scr, lane); continue; } r -= I_AO;
                if (r < I_QKV) { const int kb = r / 48, nb = r % 48; const float* W = args.in[14]; float mx = 0.f;
#pragma unroll
                    for (int i = 0; i < 32; ++i) mx = __builtin_fmaxf(mx, __builtin_fabsf(W[(size_t)(64 * kb + 2 * i + (lane >> 5)) * NQKV + 32 * nb + (lane & 31)]));
#pragma unroll
                    for (int o = 1; o < 64; o <<= 1) mx = __builtin_fmaxf(mx, __shfl_xor(mx, o));
                    if (lane == 0) __hip_atomic_fetch_max((unsigned*)(ctl + CW_WAMAX + 128), __float_as_uint(mx), __ATOMIC_RELAXED, __HIP_MEMORY_SCOPE_AGENT);
                    continue; } r -= I_QKV;
                if (r < I_BO) { const int kb = r / 32, nb = r % 32; transpose_item(args.in[16], 1024, 1024, WBO, 64 * kb, 32 * nb, 32 * nb, scr, lane); continue; } r -= I_BO;
                if (r < 2 * I_F) { const int up = r / I_F; const int q = r % I_F; const int kb = q / 112, nb = q % 112;
                    const float* W = args.in[17 + up]; float mx = 0.f;
#pragma unroll
                    for (int i = 0; i < 32; ++i) mx = __builtin_fmaxf(mx, __builtin_fabsf(W[(size_t)(64 * kb + 2 * i + (lane >> 5)) * DFF + 32 * nb + (lane & 31)]));
#pragma unroll
                    for (int o = 1; o < 64; o <<= 1) mx = __builtin_fmaxf(mx, __shfl_xor(mx, o));
                    if (lane == 0) __hip_atomic_fetch_max((unsigned*)(ctl + CW_WAMAX + 64 * up), __float_as_uint(mx), __ATOMIC_RELAXED, __HIP_MEMORY_SCOPE_AGENT);
                    continue; } r -= 2 * I_F;
                if (r < I_FD) { const int kb = r / 32, nb = r % 32; transpose_item(args.in[19], DFF, 1024, WD, 64 * kb, 32 * nb, 32 * nb, scr, lane); continue; } r -= I_FD;
                if (r < I_MOE) { if (r >= MOE_TAIL_TOTAL) moe_convert_item(r, args.in[21], args.in[22], args.in[23], MGU, MD, scr, lane); continue; } r -= I_MOE;
                if (r < I_WS) { const float* src = args.in[11] + (size_t)r * 2048;
#pragma unroll
                    for (int j = 0; j < 8; ++j) { const f32x4 v = *(const f32x4*)(src + j * 256 + lane * 4); u32x2 w; w.x = pkbf(v.x, v.y); w.y = pkbf(v.z, v.w); *(u32x2*)(WSB + (size_t)r * 2048 + j * 256 + lane * 4) = w; }
                    continue; } r -= I_WS;
                {
                    const int ent = r * 64 + lane; const int pos = ent >> 4, i = ent & 15;
                    double inv = 1.0; for (int q = 0; q < i; ++q) inv *= 0.56234132519034908;
                    const float ang = (float)pos * (float)inv; double s, c; sincos_d((double)ang, s, c);
                    ROPE[ent] = (float)c; ROPE[2048 + ent] = (float)s;
                }
            }
        }
        if (BOTH(0)) GRID_BAR(); PROBE_MARK(0);
    }
    if (IN(1)) { PHASE_IDS();
        {
            LAS float* scr = (LAS float*)(lds + wave * 16384);
            const float ag = __uint_as_float(__hip_atomic_load((unsigned*)(ctl + CW_WAMAX), __ATOMIC_RELAXED, __HIP_MEMORY_SCOPE_AGENT)), au = __uint_as_float(__hip_atomic_load((unsigned*)(ctl + CW_WAMAX + 64), __ATOMIC_RELAXED, __HIP_MEMORY_SCOPE_AGENT));
            if (gw == 0 && lane == 0) { RSC[MALL] = ag * (1.0f / 127.0f); RSC[MALL + 1] = au * (1.0f / 127.0f); }
            const float ai_ = __uint_as_float(__hip_atomic_load((unsigned*)(ctl + CW_WAMAX + 192), __ATOMIC_RELAXED, __HIP_MEMORY_SCOPE_AGENT));
            if (gw == 0 && lane == 0) RSC[MALL + 3] = ai_ * (1.0f / 127.0f);
            for (int it = gw; it < 16 * 64; it += NGW) { const int kb = it / 64, nb = it % 64; transpose_item_i8(args.in[8], 1024, 2048, WIN, 64 * kb, 32 * nb, 32 * nb, 127.0f / ai_, scr, lane); }
            const float aq = __uint_as_float(__hip_atomic_load((unsigned*)(ctl + CW_WAMAX + 128), __ATOMIC_RELAXED, __HIP_MEMORY_SCOPE_AGENT));
            if (gw == 0 && lane == 0) RSC[MALL + 2] = aq * (1.0f / 127.0f);
            for (int it = gw; it < 16 * 48; it += NGW) { const int kb = it / 48, nb = it % 48; transpose_item_i8(args.in[14], 1024, NQKV, WQKV, 64 * kb, 32 * nb, 32 * nb, 127.0f / aq, scr, lane); }
            for (int it = gw; it < 2 * 16 * 112; it += NGW) { const int up = it / (16 * 112), q = it % (16 * 112), kb = q / 112, nb = q % 112, n0 = 32 * nb;
                transpose_item_i8(args.in[17 + up], 1024, DFF, WGU, 64 * kb, n0, 256 * (n0 >> 7) + 128 * up + (n0 & 127), 127.0f / (up ? au : ag), scr, lane); }
        }
        norm_rows<false>(I_X, I_CTX, MALL, I_NORMG + 0 * 1024, MOD, 0, 1, XN, gw, NGW, lane, nullptr, 0, nullptr, nullptr, RSC); if (BOTH(1)) GRID_BAR(); PROBE_MARK(1); }
    if (IN(2)) {
        pg8::DenseSched S{(const char*)WIN, (const char*)XN8, 8, NPA, G, bx, (size_t)256 * 1024};
        pg8::EpiGeluT E{UVT, STATS, RSC, RSC + MALL + 3};
        pg8::gemm_phase<pg8::EpiGeluT, pg8::DenseSched, true, false, false, true>(lds, gtab, 512, 8, S, E);
        moe_convert_tail(8 * NPA, G, bx, 0, MOE_TAIL_A, args.in[21], args.in[22], args.in[23], MGU, MD, lds);
        if (BOTH(2)) GRID_BAR(); PROBE_MARK(2);
    }
    if (IN(3)) {
        PHASE_IDS();
        const float* vg = args.in[9]; const float* vb = args.in[10]; const float* bs = args.in[12];
        LAS unsigned char* buf = lds + wave * 16384;
        LAS float* mu_l = (LAS float*)(lds + RING_BYTES + 4096 + wave * 1024); LAS float* rs_l = mu_l + 128;
        const int r32 = lane & 31, h = lane >> 5;
        for (int unit = gw; unit < (MALL / 128) * 32; unit += NGW) {
            const int ph = unit & 1, g = (unit >> 1) & 15, ch = unit >> 5, q0 = ch * 128;
#pragma unroll
            for (int tt = 0; tt < 2; ++tt) { const int tok = q0 + lane * 2 + tt; const f32x4* sp = (const f32x4*)(STATS + (size_t)tok * 16);
                const f32x4 a = sp[0], b = sp[1], c = sp[2], d = sp[3];
                const float sum = (a.x + a.z) + (b.x + b.z) + (c.x + c.z) + (d.x + d.z), sq = (a.y + a.w) + (b.y + b.w) + (c.y + c.w) + (d.y + d.w);
                const float mean = sum * (1.0f / 1024.0f), var = sq * (1.0f / 1024.0f) - mean * mean;
                mu_l[lane * 2 + tt] = mean; rs_l[lane * 2 + tt] = 1.0f / __builtin_sqrtf(var + EPS); }
            {
                u32x4 t[16]; const int rw = lane >> 4, ck = lane & 15;
                const bf16_t* vp = UVT + (size_t)(1024 + 64 * g + rw) * MALL + q0 + ck * 8;
#pragma unroll
                for (int i = 0; i < 16; ++i) { t[i] = *(const u32x4*)vp; vp += (size_t)4 * MALL; asm volatile("" : "+v"(vp)); }
#pragma unroll
                for (int i = 0; i < 16; ++i) { const int row = 4 * i + rw; *(LAS u32x4*)(buf + row * 256 + ((ck ^ (row & 15)) << 4)) = t[i]; }
            }
            bf16x8 af[2][8];
#pragma unroll
            for (int ct = 0; ct < 2; ++ct) { const int row = 32 * ct + r32; const float vgc = vg[64 * g + row], vbc = vb[64 * g + row];
#pragma unroll
                for (int s2 = 0; s2 < 8; ++s2) { const int qs = 16 * s2 + 8 * h, ck = 2 * s2 + h;
                    const f32x4 m0 = *(const LAS f32x4*)(mu_l + qs), m1 = *(const LAS f32x4*)(mu_l + qs + 4), r0 = *(const LAS f32x4*)(rs_l + qs), r1 = *(const LAS f32x4*)(rs_l + qs + 4);
                    const bf16x8 raw = *(const LAS bf16x8*)(buf + row * 256 + ((ck ^ (row & 15)) << 4));
                    float y[8];
#pragma unroll
                    for (int j = 0; j < 4; ++j) { y[j] = (bf2f((unsigned short)raw[j]) - m0[j]) * r0[j] * vgc + vbc; y[4 + j] = (bf2f((unsigned short)raw[4 + j]) - m1[j]) * r1[j] * vgc + vbc; }
                    u32x4 w; w.x = pkbf(y[0], y[1]); w.y = pkbf(y[2], y[3]); w.z = pkbf(y[4], y[5]); w.w = pkbf(y[6], y[7]); af[ct][s2] = __builtin_bit_cast(bf16x8, w); } }
            {
                u32x4 t[8]; const int rw = lane >> 3, ck = lane & 7;
                const bf16_t* up = UVT + (size_t)(64 * g + rw) * MALL + q0 + 64 * ph + ck * 8;
#pragma unroll
                for (int i = 0; i < 8; ++i) { t[i] = *(const u32x4*)up; up += (size_t)8 * MALL; asm volatile("" : "+v"(up)); }
#pragma unroll
                for (int i = 0; i < 8; ++i) { const int row = 8 * i + rw; *(LAS u32x4*)(buf + row * 128 + ((ck ^ (row & 7)) << 4)) = t[i]; }
            }
#pragma unroll
            for (int ptl = 0; ptl < 2; ++ptl) {
                const int pl = 32 * ptl + r32, p = 64 * ph + pl; const float bsv = bs[g * 128 + p];
                bf16x8 bfr[8];
#pragma unroll
                for (int s2 = 0; s2 < 8; ++s2) bfr[s2] = *(const bf16x8*)(WSB + (size_t)(g * 128 + p) * 128 + 16 * s2 + 8 * h);
                f32x16 acc[2]; acc[0] = f32x16{}; acc[1] = f32x16{};
#pragma unroll
                for (int s2 = 0; s2 < 8; ++s2)
#pragma unroll
                    for (int ct = 0; ct < 2; ++ct) acc[ct] = __builtin_amdgcn_mfma_f32_32x32x16_bf16(af[ct][s2], bfr[s2], acc[ct], 0, 0, 0);
#pragma unroll
                for (int ct = 0; ct < 2; ++ct)
#pragma unroll
                    for (int rr = 0; rr < 4; ++rr) { const int c = 32 * ct + 8 * rr + 4 * h; float o[4];
#pragma unroll
                        for (int e = 0; e < 4; ++e) { const int cc = c + e; const float uu = bf2f(*(const LAS unsigned short*)(buf + cc * 128 + (((pl >> 3) ^ (cc & 7)) << 4) + (pl & 7) * 2)); o[e] = uu * (acc[ct][4 * rr + e] + bsv); }
                        u32x2 w; w.x = pkbf(o[0], o[1]); w.y = pkbf(o[2], o[3]);
                        *(LAS u32x2*)(buf + 8192 + pl * 128 + (((c >> 3) ^ (pl & 7)) << 4) + (c & 7) * 2) = w; }
            }
            {
                const int rw = lane >> 3, ck = lane & 7;
#pragma unroll
                for (int i = 0; i < 8; ++i) { const int row = 8 * i + rw; const u32x4 v = *(const LAS u32x4*)(buf + 8192 + row * 128 + ((ck ^ (row & 7)) << 4));
                    *(u32x4*)(A2 + (size_t)(q0 + 64 * ph + row) * DM + 64 * g + ck * 8) = v; }
            }
        }
        if (BOTH(3)) GRID_BAR(); PROBE_MARK(3);
    }
    if (IN(4)) {
        { pg8::DenseSched S{(const char*)A2, (const char*)WAO, NPL, 4, G, bx, (size_t)256 * 1024 * 2};
          pg8::EpiResid<true> E{I_X, nullptr, HL, MOD + 2 * 1024};
          pg8::gemm_phase<pg8::EpiResid<true>, pg8::DenseSched, true, false>(lds, gtab, 1024, 16, S, E); }
        { pg8::SplitSched S{(const char*)(A2 + (size_t)NLAT * DM), (const char*)WAO, 4, 4, P3_NS, G, bx, NPL, (size_t)256 * 1024 * 2, (size_t)(1024 / P3_NS) * 2};
          pg8::EpiPartF32 E{PART1, (size_t)NCTXR * DM};
          pg8::gemm_phase<pg8::EpiPartF32, pg8::SplitSched, true, false>(lds, gtab, 1024, 1024 / P3_NS / 64, S, E); }
        if (BOTH(4)) GRID_BAR(); PROBE_MARK(4);
    }
    if (IN(5)) { PHASE_IDS(); norm_rows<true>(HL, I_CTX, MALL, I_NORMG + 1 * 1024, MOD, 3, 4, XN, gw, NGW, lane, PART1, P3_NS, MOD + 4 * 6144 + 2 * 1024, ZB, RSC); if (BOTH(5)) GRID_BAR(); PROBE_MARK(5); }
    if (IN(6)) {
        pg8::DenseSched S{(const char*)XN8, (const char*)WGU, NPA, 28, G, bx, (size_t)256 * 1024};
        pg8::EpiSwiGLUI8 E{HB, RSC, RSC + MALL};
        pg8::gemm_phase<pg8::EpiSwiGLUI8, pg8::DenseSched, true, false, false, true>(lds, gtab, 512, 8, S, E);
        moe_convert_tail(NPA * 28, G, bx, MOE_TAIL_A, MOE_TAIL_B, args.in[21], args.in[22], args.in[23], MGU, MD, lds);
        if (BOTH(6)) GRID_BAR(); PROBE_MARK(6);
    }
    if (IN(7)) {
        { pg8::DenseSched S{(const char*)HB, (const char*)WD, NPL, 4, G, bx, (size_t)256 * DFF * 2};
          pg8::EpiResid<false> E{nullptr, HL, HL, MOD + 5 * 1024};
          pg8::gemm_phase<pg8::EpiResid<false>, pg8::DenseSched, true, false>(lds, gtab, DFF, 56, S, E); }
        { pg8::SplitSched S{(const char*)(HB + (size_t)NLAT * DFF), (const char*)WD, 4, 4, P5_NS, G, bx, NPL, (size_t)256 * DFF * 2, (size_t)(DFF / P5_NS) * 2};
          pg8::EpiPartF32 E{PART2, (size_t)NCTXR * DM};
          pg8::gemm_phase<pg8::EpiPartF32, pg8::SplitSched, true, false>(lds, gtab, DFF, DFF / P5_NS / 64, S, E); }
        if (BOTH(7)) GRID_BAR(); PROBE_MARK(7);
    }
    if (IN(8)) { PHASE_IDS(); norm_rows<true>(HL, ZB, MALL, I_NORMG + 2 * 1024, MOD + 5 * 6144, 0, 1, XN, gw, NGW, lane, PART2, P5_NS, MOD + 4 * 6144 + 5 * 1024, nullptr, RSC); if (BOTH(8)) GRID_BAR(); PROBE_MARK(8); }
    if (IN(9)) {
        pg8::DenseSched S{(const char*)XN8, (const char*)WQKV, NPA, 6, G, bx, (size_t)256 * 1024};
        pg8::EpiQKV E{QKV, ROPE, ROPE + 2048, attn_body::C2, RSC, RSC + MALL + 2};
        pg8::gemm_phase<pg8::EpiQKV, pg8::DenseSched, true, false, false, true>(lds, gtab, 512, 8, S, E);
        moe_convert_tail(NPA * 6, G, bx, MOE_TAIL_A + MOE_TAIL_B, MOE_TAIL_C, args.in[21], args.in[22], args.in[23], MGU, MD, lds);
        if (BOTH(9)) GRID_BAR(); PROBE_MARK(9);
    }
    if (IN(10)) {
        static_assert(attn_body::LDS_BYTES_A <= RING_BYTES, "attention LDS");
        const float* sinkp = args.in[15];
        for (int i = 0;; ++i) { const int uid = i * G + vcu; if (uid >= NB * 64 * 4 * 2) break;
            const int pr = uid & 1, hk = (uid >> 1) & 3, n = (uid >> 3) & 63, b = uid >> 9;
            attn_body::attn_unit<8>(b, hk, n, pr, (const attn_body::bf16*)QKV, (attn_body::bf16*)OB, sinkp, (char*)lds_raw); }
        if (BOTH(10)) GRID_BAR(); PROBE_MARK(10);
    }
    if (IN(11)) {
        pg8::DenseSched S{(const char*)OB, (const char*)WBO, NPL, 4, G, bx, (size_t)256 * 1024 * 2};
        pg8::EpiResid<false> E{nullptr, HL, HL, MOD + 5 * 6144 + 2 * 1024};
        pg8::gemm_phase<pg8::EpiResid<false>, pg8::DenseSched, true, false>(lds, gtab, 1024, 16, S, E);
        if (BOTH(11)) GRID_BAR(); PROBE_MARK(11);
    }
    if (IN(12)) {
        PHASE_IDS();
        const float* g = I_NORMG + 3 * 1024; const float* mod = MOD + 5 * 6144; const float* wrt = args.in[20];
        LAS int* l_e = (LAS int*)lds;
        LAS float* l_w = (LAS float*)(lds + 1024);
        LAS int* l_cnt = (LAS int*)(lds + 2048);
        LAS int* l_base = (LAS int*)(lds + 2048 + 64);
        for (int blk = bx; blk < NLAT / 128; blk += G) {
            if (tid < 8) l_cnt[tid] = 0;
            __syncthreads();
            const int mb = (blk * 128) >> 13; const float* mrow = mod + (size_t)mb * 6144;
            for (int i4 = 0; i4 < 8; ++i4) {
                const int tl0 = wave * 16 + i4 * 2, m0 = blk * 128 + tl0;
                const GAS u32x2* xr = (const GAS u32x2*)(HL + (size_t)m0 * DM) + lane;
                f32x4 v[2][4]; float ss[2];
#pragma unroll
                for (int r = 0; r < 2; ++r)
#pragma unroll
                    for (int j = 0; j < 4; ++j) { const u32x2 w = xr[r * 256 + 64 * j]; v[r][j] = (f32x4){__uint_as_float(w.x << 16), __uint_as_float(w.x & 0xffff0000u), __uint_as_float(w.y << 16), __uint_as_float(w.y & 0xffff0000u)}; }
#pragma unroll
                for (int r = 0; r < 2; ++r) { ss[r] = 0.f;
#pragma unroll
                    for (int j = 0; j < 4; ++j) ss[r] += (v[r][j].x * v[r][j].x + v[r][j].y * v[r][j].y) + (v[r][j].z * v[r][j].z + v[r][j].w * v[r][j].w); }
#pragma unroll
                for (int o = 1; o < 64; o <<= 1) {
#pragma unroll
                    for (int r = 0; r < 2; ++r) ss[r] += __shfl_xor(ss[r], o); }
                float lg[2][8];
#pragma unroll
                for (int r = 0; r < 2; ++r)
#pragma unroll
                    for (int e = 0; e < 8; ++e) lg[r][e] = 0.f;
#pragma unroll
                for (int j = 0; j < 4; ++j) { const int col = 4 * lane + 256 * j; const f32x4 gv = *(const f32x4*)(g + col), sc = *(const f32x4*)(mrow + 4 * 1024 + col), sh = *(const f32x4*)(mrow + 3 * 1024 + col);
                    const f32x4 gm = gv * (sc + 1.0f);
                    f32x4 y[2];
#pragma unroll
                    for (int r = 0; r < 2; ++r) { const float rstd = 1.0f / __builtin_sqrtf(ss[r] * (1.0f / DM) + EPS); y[r] = (v[r][j] * rstd) * gm + sh;
                        *((GAS unsigned*)(XN8 + (size_t)(m0 + r) * DM) + lane + 64 * j) = pk4f8(y[r].x, y[r].y, y[r].z, y[r].w); }
#pragma unroll
                    for (int cc = 0; cc < 4; ++cc) { const f32x4 w0 = *(const f32x4*)(wrt + (size_t)(col + cc) * 8), w1 = *(const f32x4*)(wrt + (size_t)(col + cc) * 8 + 4);
#pragma unroll
                        for (int r = 0; r < 2; ++r) { const float yv = y[r][cc];
                            lg[r][0] += yv * w0.x; lg[r][1] += yv * w0.y; lg[r][2] += yv * w0.z; lg[r][3] += yv * w0.w; lg[r][4] += yv * w1.x; lg[r][5] += yv * w1.y; lg[r][6] += yv * w1.z; lg[r][7] += yv * w1.w; } } }
#pragma unroll
                for (int o = 1; o < 64; o <<= 1) {
#pragma unroll
                    for (int r = 0; r < 2; ++r)
#pragma unroll
                        for (int e = 0; e < 8; ++e) lg[r][e] += __shfl_xor(lg[r][e], o); }
#pragma unroll
                for (int r = 0; r < 2; ++r) {
                    int ea = 0; float va = lg[r][0];
#pragma unroll
                    for (int e = 1; e < 8; ++e) if (lg[r][e] > va) { va = lg[r][e]; ea = e; }
                    int eb = -1; float vb2 = -INFINITY;
#pragma unroll
                    for (int e = 0; e < 8; ++e) if (e != ea && lg[r][e] > vb2) { vb2 = lg[r][e]; eb = e; }
                    const float wb = 1.0f / (1.0f + __expf(va - vb2)), wa = 1.0f - wb;
                    if (lane == 0) { const int tl = tl0 + r; l_e[tl * 2] = ea; l_e[tl * 2 + 1] = eb; l_w[tl * 2] = wa; l_w[tl * 2 + 1] = wb; } }
            }
            __syncthreads();
            int ea = 0, eb = 0, pa = 0, pb = 0;
            if (tid < 128) { ea = l_e[tid * 2]; eb = l_e[tid * 2 + 1]; pa = atomicAdd((int*)&l_cnt[ea], 1); pb = atomicAdd((int*)&l_cnt[eb], 1); }
            __syncthreads();
            if (tid < 8) l_base[tid] = (int)__hip_atomic_fetch_add((unsigned*)(ctl + CW_CNT + 64 * tid), (unsigned)l_cnt[tid], __ATOMIC_RELAXED, __HIP_MEMORY_SCOPE_AGENT);
            __syncthreads();
            if (tid < 128) { const int m = blk * 128 + tid; pa += l_base[ea]; pb += l_base[eb];
                LIST[(size_t)ea * NLAT + pa] = m; LIST[(size_t)eb * NLAT + pb] = m;
                int* ti = TINFO + (size_t)m * 8; ti[0] = ea; ti[1] = pa; ti[2] = eb; ti[3] = pb; ti[4] = __float_as_int(l_w[tid * 2]); ti[5] = __float_as_int(l_w[tid * 2 + 1]); }
            __syncthreads();
        }
        if (BOTH(12)) GRID_BAR(); PROBE_MARK(12);
    }
    if (hi_ph > 13 && lo < 17) {
        PHASE_IDS();
        LAS int* mtab = (LAS int*)(lds + MOE_OFF);
        if (tid == 0) { int run = 0, R = 0;
            for (int e = 0; e < 8; ++e) { const int ce = (int)__hip_atomic_load((unsigned*)(ctl + CW_CNT + 64 * e), __ATOMIC_RELAXED, __HIP_MEMORY_SCOPE_AGENT); mtab[e] = run; mtab[16 + e] = ce; run += ce >> 8; if (ce & 255) { mtab[24 + R] = e; ++R; } }
            mtab[8] = run; mtab[32] = R; }
        __syncthreads();
        const int nfull = __builtin_amdgcn_readfirstlane(mtab[8]);
        for (int c = 0; c < MOE_NCH; ++c) {
            const int gp0 = c * MOE_CH, gp1 = nfull < (c + 1) * MOE_CH ? nfull : (c + 1) * MOE_CH;
            if (IN(13 + 2 * c)) {
                { pg8::MoeSched S; S.A = (const char*)XN8; S.B = (const char*)MGU; S.list = LIST; S.tab = mtab; S.mode = 0; S.nS = 1; S.kbytes = 0; S.omoff = 0;
                  S.gp0 = gp0; S.gp1 = gp1; S.nN = 28; S.G = G; S.c = bx; S.bexp = (size_t)7168 * 1024; S.btile = (size_t)256 * 1024; S.astep = 0; S.gather = true;
                  pg8::EpiSwiGLU8 E{HC, 1.0f / MOE_SGU};
                  pg8::gemm_phase<pg8::EpiSwiGLU8, pg8::MoeSched, true, true, true>(lds, gtab, 512, 8, S, E); }
                if (c == 0) { pg8::MoeSched S; S.A = (const char*)XN8; S.B = (const char*)MGU; S.list = LIST; S.tab = mtab; S.mode = 1; S.nS = 1; S.kbytes = 0; S.omoff = MOE_CH;
                  S.gp0 = 0; S.gp1 = 0; S.nN = 28; S.G = G; S.c = bx; S.bexp = (size_t)7168 * 1024; S.btile = (size_t)256 * 1024; S.astep = 0; S.gather = true;
                  pg8::EpiSwiGLU8 E{HC, 1.0f / MOE_SGU};
                  pg8::gemm_phase<pg8::EpiSwiGLU8, pg8::MoeSched, true, true, true>(lds, gtab, 512, 8, S, E); }
                if (BOTH(13 + 2 * c)) GRID_BAR(); PROBE_MARK(13 + 2 * c);
            }
            if (IN(14 + 2 * c)) {
                { pg8::MoeSched S; S.A = (const char*)HC; S.B = (const char*)MD; S.list = LIST; S.tab = mtab; S.mode = 0; S.nS = 1; S.kbytes = 0; S.omoff = 0;
                  S.gp0 = gp0; S.gp1 = gp1; S.nN = 4; S.G = G; S.c = bx; S.bexp = (size_t)1024 * DFF; S.btile = (size_t)256 * DFF; S.astep = (size_t)256 * DFF; S.gather = false;
                  pg8::EpiBf16Plain E{YB, DM, 1.0f / MOE_SD};
                  pg8::gemm_phase<pg8::EpiBf16Plain, pg8::MoeSched, true, false, true>(lds, gtab, DFF / 2, 28, S, E); }
                if (c == 0) { pg8::MoeSched S; S.A = (const char*)(HC + (size_t)MOE_CH * 256 * DFF); S.B = (const char*)MD; S.list = LIST; S.tab = mtab; S.mode = 2; S.nS = MOE_RS; S.kbytes = (size_t)(DFF / MOE_RS); S.omoff = 0;
                  S.gp0 = 0; S.gp1 = 0; S.nN = 4; S.G = G; S.c = bx; S.bexp = (size_t)1024 * DFF; S.btile = (size_t)256 * DFF; S.astep = (size_t)256 * DFF; S.gather = false;
                  pg8::EpiPartBf16 E{YP, (size_t)8 * 256 * DM, 1.0f / MOE_SD};
                  pg8::gemm_phase<pg8::EpiPartBf16, pg8::MoeSched, true, false, true>(lds, gtab, DFF / 2, DFF / MOE_RS / 128, S, E); }
                if (BOTH(14 + 2 * c)) GRID_BAR(); PROBE_MARK(14 + 2 * c);
            }
        }
    }
    if (IN(17)) {
        PHASE_IDS();
        LAS int* l_pb = (LAS int*)(lds + wave * 128);
        if (lane == 0) { int run = 0, R = 0;
            for (int e = 0; e < 8; ++e) { const int ce = (int)__hip_atomic_load((unsigned*)(ctl + CW_CNT + 64 * e), __ATOMIC_RELAXED, __HIP_MEMORY_SCOPE_AGENT); l_pb[e] = run; l_pb[8 + e] = ce >> 8; l_pb[16 + e] = R; run += ce >> 8; if (ce & 255) ++R; } }
        const float* g2 = MOD + 5 * 6144 + 5 * 1024;
        for (int m0 = gw * 2; m0 < NLAT; m0 += NGW * 2) {
            const int mb = m0 >> 13;
            f32x4 hv[2][4], ya[2][4], yb[2][4]; float wa[2], wb[2];
#pragma unroll
            for (int r = 0; r < 2; ++r) {
                const int m = m0 + r; const int* ti = TINFO + (size_t)m * 8;
                const int ea = ti[0], pa = ti[1], eb = ti[2], pb = ti[3]; wa[r] = __int_as_float(ti[4]); wb[r] = __int_as_float(ti[5]);
                const bool ma = (pa >> 8) < l_pb[8 + ea], mbm = (pb >> 8) < l_pb[8 + eb];
                const size_t sa = ma ? (size_t)(l_pb[ea] + (pa >> 8)) * 256 + (pa & 255) : (size_t)l_pb[16 + ea] * 256 + (pa & 255);
                const size_t sb = mbm ? (size_t)(l_pb[eb] + (pb >> 8)) * 256 + (pb & 255) : (size_t)l_pb[16 + eb] * 256 + (pb & 255);
                const GAS u32x2* xr = (const GAS u32x2*)(HL + (size_t)m * DM) + lane;
#pragma unroll
                for (int j = 0; j < 4; ++j) { const u32x2 w = xr[64 * j]; hv[r][j] = (f32x4){__uint_as_float(w.x << 16), __uint_as_float(w.x & 0xffff0000u), __uint_as_float(w.y << 16), __uint_as_float(w.y & 0xffff0000u)}; }
                { const GAS u32x2* yr = (const GAS u32x2*)((ma ? YB : YP) + sa * DM) + lane;
#pragma unroll
                  for (int j = 0; j < 4; ++j) { const u32x2 a = yr[64 * j]; ya[r][j] = (f32x4){__uint_as_float(a.x << 16), __uint_as_float(a.x & 0xffff0000u), __uint_as_float(a.y << 16), __uint_as_float(a.y & 0xffff0000u)}; }
                  if (!ma) for (int s2 = 1; s2 < MOE_RS; ++s2) { const GAS u32x2* y2 = (const GAS u32x2*)(YP + ((size_t)s2 * 8 * 256 + sa) * DM) + lane;
#pragma unroll
                      for (int j = 0; j < 4; ++j) { const u32x2 a = y2[64 * j]; ya[r][j] += (f32x4){__uint_as_float(a.x << 16), __uint_as_float(a.x & 0xffff0000u), __uint_as_float(a.y << 16), __uint_as_float(a.y & 0xffff0000u)}; } } }
                { const GAS u32x2* yr = (const GAS u32x2*)((mbm ? YB : YP) + sb * DM) + lane;
#pragma unroll
                  for (int j = 0; j < 4; ++j) { const u32x2 a = yr[64 * j]; yb[r][j] = (f32x4){__uint_as_float(a.x << 16), __uint_as_float(a.x & 0xffff0000u), __uint_as_float(a.y << 16), __uint_as_float(a.y & 0xffff0000u)}; }
                  if (!mbm) for (int s2 = 1; s2 < MOE_RS; ++s2) { const GAS u32x2* y2 = (const GAS u32x2*)(YP + ((size_t)s2 * 8 * 256 + sb) * DM) + lane;
#pragma unroll
                      for (int j = 0; j < 4; ++j) { const u32x2 a = y2[64 * j]; yb[r][j] += (f32x4){__uint_as_float(a.x << 16), __uint_as_float(a.x & 0xffff0000u), __uint_as_float(a.y << 16), __uint_as_float(a.y & 0xffff0000u)}; } } }
            }
            float ss[2];
#pragma unroll
            for (int r = 0; r < 2; ++r) { ss[r] = 0.f;
#pragma unroll
                for (int j = 0; j < 4; ++j) { const f32x4 gv = *(const f32x4*)(g2 + (size_t)mb * 6144 + 4 * lane + 256 * j);
                    hv[r][j] = hv[r][j] + gv * (ya[r][j] * wa[r] + yb[r][j] * wb[r]); ss[r] += (hv[r][j].x * hv[r][j].x + hv[r][j].y * hv[r][j].y) + (hv[r][j].z * hv[r][j].z + hv[r][j].w * hv[r][j].w); } }
#pragma unroll
            for (int o = 1; o < 64; o <<= 1) {
#pragma unroll
                for (int r = 0; r < 2; ++r) ss[r] += __shfl_xor(ss[r], o); }
#pragma unroll
            for (int r = 0; r < 2; ++r) { const float rstd = 1.0f / __builtin_sqrtf(ss[r] * (1.0f / DM) + EPS);
                GAS f32x4* orow = (GAS f32x4*)(args.out + (size_t)(m0 + r) * DM) + lane;
#pragma unroll
                for (int j = 0; j < 4; ++j) { const f32x4 fg = *(const f32x4*)(I_FINALG + 4 * lane + 256 * j); __builtin_nontemporal_store((hv[r][j] * rstd) * fg, orow + 64 * j); } }
        }
    }
    PROBE_MARK(17);
#if defined(PROBE_LO)
    { PHASE_IDS(); const float T = (float)(tpB - tpA) * 0.01f; const float cval = __builtin_sqrtf(T / (float)(PROBE_UNIT));
      for (int m = gw; m < NLAT; m += NGW) { GAS f32x4* orow = (GAS f32x4*)(args.out + (size_t)m * DM) + lane;
#pragma unroll
        for (int j = 0; j < 4; ++j) orow[64 * j] = (f32x4){cval, cval, cval, cval}; } }
#endif
#undef IN
#undef BOTH
#undef GRID_BAR
}

#ifndef MK_ONE_LAUNCH
#define MK_ONE_LAUNCH 1
#endif
extern "C" void kernel_launch(void* const* d_in, const int* in_sizes, int n_in, void* d_out, int out_size, void* d_ws, size_t ws_size, hipStream_t stream) {
    static int grid = 0;
    if (grid == 0) {
        if (n_in != 24 || out_size != NLAT * DM || ws_size < WS_END) { fprintf(stderr, "kernel_launch: unexpected problem (n_in %d, out %d, ws %zu < %zu)\n", n_in, out_size, ws_size, (size_t)WS_END); grid = -1; return; }
        int dev = 0, cus = 0, per_cu = 0;
        if (hipGetDevice(&dev) != hipSuccess || hipDeviceGetAttribute(&cus, hipDeviceAttributeMultiprocessorCount, dev) != hipSuccess) { grid = -1; return; }
        if (hipFuncSetAttribute((const void*)fwd, hipFuncAttributeMaxDynamicSharedMemorySize, LDS_BYTES) != hipSuccess) { fprintf(stderr, "kernel_launch: hipFuncSetAttribute failed\n"); grid = -1; return; }
        if (hipOccupancyMaxActiveBlocksPerMultiprocessor(&per_cu, (const void*)fwd, 512, LDS_BYTES) != hipSuccess || per_cu < 1) fprintf(stderr, "kernel_launch: occupancy query says %d\n", per_cu);
        (void)hipGetLastError();
        grid = cus;
    }
    if (grid < 0) return;
    if (hipMemsetAsync((char*)d_ws + WS_CTL, 0, CTL_ZERO_BYTES, stream) != hipSuccess) return;
    Args a{};
    for (int i = 0; i < 24; ++i) a.in[i] = (const float*)d_in[i];
    a.out = (float*)d_out; a.ws = (unsigned char*)d_ws;
#if defined(SPLITAT)
    a.ph_lo = 0; a.ph_hi = SPLITAT; a.li = 0;
    hipLaunchKernelGGL(fwd, dim3(grid), dim3(512), LDS_BYTES, stream, a);
    a.ph_lo = SPLITAT; a.ph_hi = NPH; a.li = 1;
    hipLaunchKernelGGL(fwd, dim3(grid), dim3(512), LDS_BYTES, stream, a);
#elif defined(DUPK)
    a.ph_lo = 0; a.ph_hi = DUPK + 1; a.li = 0;
    hipLaunchKernelGGL(fwd, dim3(grid), dim3(512), LDS_BYTES, stream, a);
#ifdef DUPN
    for (int rep = 0; rep < DUPN; ++rep) { a.ph_lo = DUPK; a.ph_hi = DUPK + 1; a.li = 2; hipLaunchKernelGGL(fwd, dim3(grid), dim3(512), LDS_BYTES, stream, a); }
#endif
    a.ph_lo = DUPK; a.ph_hi = NPH; a.li = 1;
    hipLaunchKernelGGL(fwd, dim3(grid), dim3(512), LDS_BYTES, stream, a);
#elif MK_ONE_LAUNCH
    a.ph_lo = 0; a.ph_hi = NPH;
    hipLaunchKernelGGL(fwd, dim3(grid), dim3(512), LDS_BYTES, stream, a);
#else
    for (int p = 0; p < NPH; ++p) { a.ph_lo = p; a.ph_hi = p + 1; hipLaunchKernelGGL(fwd, dim3(grid), dim3(512), LDS_BYTES, stream, a); }
#endif
}
```

```cpp
#include <hip/hip_runtime.h>
#include <hip/hip_bf16.h>
#include <cstdio>
#include <cstdint>
#include <cmath>

constexpr int DM = 1024, NB = 4, SEQ = 8192, LCTX = 256, NLAT = NB * SEQ, NCTXR = NB * LCTX, MALL = NLAT + NCTXR;
constexpr int DFF = 3584, NEXP = 8, NQKV = 1536;
constexpr int NPL = NLAT / 256, NPA = MALL / 256;
constexpr float EPS = 1e-6f;
constexpr int MOE_CH = 128, MOE_NCH = 2;
constexpr float MOE_SGU = 32.0f, MOE_SD = 64.0f;
constexpr int MOE_RS = 7, P3_NS = 8, P5_NS = 14;

#define LAS __attribute__((address_space(3)))
#define GAS __attribute__((address_space(1)))
typedef unsigned short bf16_t;
typedef short bf16x8 __attribute__((ext_vector_type(8)));
typedef float f32x4 __attribute__((ext_vector_type(4)));
typedef float f32x2 __attribute__((ext_vector_type(2)));
typedef float f32x16 __attribute__((ext_vector_type(16)));
typedef unsigned u32x4 __attribute__((ext_vector_type(4)));
typedef unsigned u32x2 __attribute__((ext_vector_type(2)));
typedef __bf16 bf16x2_t __attribute__((ext_vector_type(2)));
typedef GAS unsigned gu32;

__device__ __forceinline__ unsigned pkbf(float lo, float hi) { f32x2 v = {lo, hi}; bf16x2_t b = __builtin_convertvector(v, bf16x2_t); return __builtin_bit_cast(unsigned, b); }
__device__ __forceinline__ unsigned pk4f8(float a, float b, float c, float d) { unsigned w = 0; w = __builtin_amdgcn_cvt_pk_fp8_f32(a, b, w, false); w = __builtin_amdgcn_cvt_pk_fp8_f32(c, d, w, true); return w; }
__device__ __forceinline__ float bf2f(unsigned short h) { return __builtin_bit_cast(float, (unsigned)h << 16); }
__device__ __forceinline__ float wave_sum(float v) {
#pragma unroll
    for (int o = 1; o < 64; o <<= 1) v += __shfl_xor(v, o);
    return v;
}
__device__ __forceinline__ float gelu_tanh(float x) {
    const float t = x * (1.0f + 0.044715f * x * x);
    const float e = __builtin_amdgcn_exp2f(-2.302208198f * t);
    return x * __builtin_amdgcn_rcpf(1.0f + e);
}
__device__ __forceinline__ float silu_f(float x) { return x * __builtin_amdgcn_rcpf(1.0f + __builtin_amdgcn_exp2f(-1.4426950409f * x)); }

constexpr size_t MiB = 1u << 20;
constexpr size_t WS_CTL = 0, CTL_ZERO_BYTES = 1 * MiB;
constexpr size_t WS_MOD = 1 * MiB;
constexpr size_t WS_ROPE = 1 * MiB + 256 * 1024;
constexpr size_t WS_STATS = 2 * MiB;
constexpr size_t WS_RSC = 4 * MiB + 512 * 1024;
constexpr size_t WS_LIST = 5 * MiB;
constexpr size_t WS_TINFO = 6 * MiB;
constexpr size_t WS_WS = 7 * MiB;
constexpr size_t WS_WIN = 8 * MiB, WS_WAO = 12 * MiB, WS_WQKV = 14 * MiB, WS_WBO = 17 * MiB, WS_WGU = 19 * MiB, WS_WD = 33 * MiB;
constexpr size_t WS_MGU = 40 * MiB, WS_MD = 96 * MiB;
constexpr size_t WS_HLB = 124 * MiB;
constexpr size_t WS_XN = 208 * MiB;
constexpr size_t WS_ZB = 274 * MiB;
constexpr size_t WS_R = 278 * MiB;
constexpr size_t WS_UVT = WS_R, WS_A2 = WS_R + 132 * MiB, WS_PART1 = WS_R + 198 * MiB, WS_H = WS_R, WS_PART2 = WS_R + 231 * MiB;
constexpr size_t WS_QKV = WS_R, WS_O = WS_R + 99 * MiB;
constexpr size_t WS_Y = WS_R, WS_YP = WS_R + 128 * MiB, WS_HC = WS_R + 156 * MiB;
constexpr size_t WS_END = WS_R + 287 * MiB;
static_assert(WS_UVT + (size_t)2048 * MALL * 2 <= WS_A2 && WS_A2 + (size_t)MALL * DM * 2 <= WS_PART1 && WS_PART1 + (size_t)P3_NS * NCTXR * DM * 4 <= WS_END, "layer-0 mixer map");
static_assert(WS_H + (size_t)MALL * DFF * 2 <= WS_PART2 && WS_PART2 + (size_t)P5_NS * NCTXR * DM * 4 <= WS_END && WS_QKV + (size_t)MALL * NQKV * 2 <= WS_O && WS_O + (size_t)NLAT * DM * 2 <= WS_END, "region map");
static_assert(WS_Y + (size_t)256 * 256 * DM * 2 <= WS_YP && WS_YP + (size_t)MOE_RS * 8 * 256 * DM * 2 <= WS_HC && WS_HC + (size_t)(MOE_CH + 8) * 256 * DFF <= WS_END, "MoE map");
static_assert(WS_MD + (size_t)8 * DM * DFF <= WS_HLB && WS_HLB + (size_t)NLAT * DM * 2 <= WS_XN && WS_XN + (size_t)MALL * DM * 2 <= WS_ZB && WS_MD + (size_t)8 * DM * DFF <= WS_XN && WS_MGU + (size_t)8 * 7168 * DM <= WS_MD, "weights map");
constexpr int CW_TMO = 0, CW_CODE = 1;
constexpr int CW_CNT = 64;
constexpr int CW_WAMAX = 1024;
constexpr int CW_BAR = 4096;

constexpr int RING_BYTES = 131072;
constexpr int GTAB_OFF = RING_BYTES;
constexpr int MOE_OFF = RING_BYTES + 1024;
constexpr int MISC_OFF = RING_BYTES + 2048;
constexpr int STAB_OFF = RING_BYTES + 3072;
constexpr int LDS_BYTES = 147456;

namespace pg8 {
constexpr int BM = 256, BK = 64, HALF = 128, HTB = HALF * BK * 2, STAGE_BYTES = 8 * HTB, NXCD = 8, WGM = 8;
__host__ __device__ __forceinline__ int lds_byte(int r, int c) { const int st = (r >> 4) * 2 + (c >> 5), rr = r & 15, cc = c & 31, ob = rr * 64 + cc * 2; return st * 1024 + (ob ^ (((ob >> 9) & 1) << 5)); }
__host__ __device__ __forceinline__ void stage_rc(int b, int& R, int& C) { const int st = b / 1024, sb = b % 1024, swz = sb ^ (((sb >> 9) & 1) << 5); R = (st >> 1) * 16 + swz / 64; C = (st & 1) * 32 + (swz % 64) / 2; }
__host__ __device__ __forceinline__ int perm32(int rho) { const int n = rho >> 4, i = rho & 15; return 8 * (i >> 2) + 4 * n + (i & 3); }

struct Unit { const char* a; const char* b; const int* gl; int pm, pn, om, nv, ks; };

__device__ __forceinline__ bool tile_order(int i, int G, int c, int nM, int nN, int& pm, int& pn) {
    const int nwg = nM * nN; const long L = (long)i * G + c; if (L >= nwg) return false;
    int wgid = (int)L; { const int q = nwg / NXCD, r = nwg % NXCD, xcd = wgid % NXCD, off = wgid / NXCD; wgid = (xcd < r ? xcd * (q + 1) : r * (q + 1) + (xcd - r) * q) + off; }
    const int nig = WGM * nN, gid = wgid / nig, fm = gid * WGM, gsz = (nM - fm) < WGM ? (nM - fm) : WGM;
    pm = fm + ((wgid % nig) % gsz); pn = (wgid % nig) / gsz; return true;
}
struct DenseSched {
    const char* A; const char* B; int nM, nN, G, c; size_t tstep;
    __device__ __forceinline__ bool next(int i, Unit& u) const {
        int pm, pn; if (!tile_order(i, G, c, nM, nN, pm, pn)) return false;
        u.a = A + (size_t)pm * tstep; u.b = B + (size_t)pn * tstep; u.gl = nullptr; u.pm = pm; u.pn = pn; u.om = pm; u.nv = 256; u.ks = 0; return true;
    }
};
typedef int v8i_t __attribute__((ext_vector_type(8)));
typedef int v4i_t __attribute__((ext_vector_type(4)));
__device__ __forceinline__ v8i_t cat8(bf16x8 lo, bf16x8 hi) { const v4i_t a = __builtin_bit_cast(v4i_t, lo), b = __builtin_bit_cast(v4i_t, hi); return __builtin_shufflevector(a, b, 0, 1, 2, 3, 4, 5, 6, 7); }
struct SplitSched {
    const char* A; const char* B; int nM, nN, nS, G, c, pm0; size_t tstep, kbytes;
    __device__ __forceinline__ bool next(int i, Unit& u) const {
        const int L = i * G + c; if (L >= nM * nN * nS) return false;
        const int ks = L % nS, t = L / nS, pn = t % nN, pm = t / nN;
        u.a = A + (size_t)pm * tstep + (size_t)ks * kbytes; u.b = B + (size_t)pn * tstep + (size_t)ks * kbytes; u.gl = nullptr; u.pm = pm0 + pm; u.pn = pn; u.om = pm; u.nv = 256; u.ks = ks; return true;
    }
};
struct MoeSched {
    const char* A; const char* B; const int* list; const LAS int* tab; int gp0, gp1, nN, nS, G, c, mode, omoff; size_t bexp, btile, astep, kbytes; bool gather;
    __device__ __forceinline__ bool next(int i, Unit& u) const {
        int pm, pn, ks = 0;
        if (mode == 0) { if (gp1 <= gp0) return false; if (!tile_order(i, G, c, gp1 - gp0, nN, pm, pn)) return false; }
        else { const int R = __builtin_amdgcn_readfirstlane(tab[32]); const int L = i * G + c; if (L >= R * nN * nS) return false; ks = L % nS; const int t = L / nS; pn = t % nN; pm = t / nN; }
        int e = 0, lp, nv;
        if (mode == 0) { const int gp = gp0 + pm;
#pragma unroll
            for (int k = 1; k < 8; ++k) e += (gp >= __builtin_amdgcn_readfirstlane(tab[k])) ? 1 : 0;
            lp = gp - __builtin_amdgcn_readfirstlane(tab[e]); nv = 256; u.pm = gp; }
        else { e = __builtin_amdgcn_readfirstlane(tab[24 + pm]); const int ce = __builtin_amdgcn_readfirstlane(tab[16 + e]); lp = ce >> 8; nv = ce & 255; u.pm = pm; }
        u.b = B + (size_t)e * bexp + (size_t)pn * btile + (size_t)ks * kbytes; u.pn = pn; u.nv = nv; u.ks = ks; u.om = pm;
        if (gather) { u.a = A; u.gl = list + (size_t)e * NLAT + 256 * lp; u.om = pm + omoff; }
        else { u.a = A + (size_t)pm * astep + (size_t)ks * kbytes; u.gl = nullptr; if (mode == 0) u.om = gp0 + pm; }
        return true;
    }
};

struct EpiGeluT {
    static constexpr bool PERM = true, ROWSCALE = true;
    __device__ __forceinline__ const float* scale_src(const Unit& u) const { return cscale + u.pn * BM; }
    bf16_t* O; float* stats; const float* cscale; const float* wsc;
    __device__ __forceinline__ void operator()(const f32x4 (&acc)[2][2][4][2], const Unit& u, int wr, int wc, int fr, int fq, const LAS float* tab) const {
        const int row0 = u.pm * BM + wr * 64 + fr, col0 = u.pn * BM + wc * 32 + 8 * fq;
        const bool isv = u.pm >= 4; const float wq = wsc[0];
        f32x4 csv[2][2];
#pragma unroll
        for (int bj = 0; bj < 2; ++bj)
#pragma unroll
            for (int n = 0; n < 2; ++n) csv[bj][n] = *(const LAS f32x4*)(tab + wc * 32 + 8 * fq + bj * HALF + 4 * n) * wq;
        float s1[2][2][4], s2[2][2][4];
#pragma unroll
        for (int bj = 0; bj < 2; ++bj)
#pragma unroll
            for (int n = 0; n < 2; ++n)
#pragma unroll
                for (int e = 0; e < 4; ++e) { s1[bj][n][e] = 0.f; s2[bj][n][e] = 0.f; }
#pragma unroll
        for (int ai = 0; ai < 2; ++ai)
#pragma unroll
            for (int m = 0; m < 4; ++m) { bf16_t* rowp = O + (size_t)(row0 + ai * HALF + m * 16) * MALL + col0;
#pragma unroll
                for (int bj = 0; bj < 2; ++bj) { const v4i_t i0 = __builtin_bit_cast(v4i_t, acc[ai][bj][m][0]), i1 = __builtin_bit_cast(v4i_t, acc[ai][bj][m][1]);
                    f32x4 v0 = (f32x4){(float)i0[0], (float)i0[1], (float)i0[2], (float)i0[3]} * csv[bj][0], v1 = (f32x4){(float)i1[0], (float)i1[1], (float)i1[2], (float)i1[3]} * csv[bj][1];
#pragma unroll
                    for (int e = 0; e < 4; ++e) { v0[e] = gelu_tanh(v0[e]); v1[e] = gelu_tanh(v1[e]); s1[bj][0][e] += v0[e]; s2[bj][0][e] += v0[e] * v0[e]; s1[bj][1][e] += v1[e]; s2[bj][1][e] += v1[e] * v1[e]; }
                    u32x4 w; w.x = pkbf(v0[0], v0[1]); w.y = pkbf(v0[2], v0[3]); w.z = pkbf(v1[0], v1[1]); w.w = pkbf(v1[2], v1[3]);
                    *(u32x4*)(rowp + bj * HALF) = w; } }
        if (isv) {
            const int slot = (u.pm - 4) * 2 + wr;
#pragma unroll
            for (int bj = 0; bj < 2; ++bj)
#pragma unroll
                for (int n = 0; n < 2; ++n)
#pragma unroll
                    for (int e = 0; e < 4; ++e) { float a = s1[bj][n][e], b = s2[bj][n][e];
#pragma unroll
                        for (int o = 1; o < 16; o <<= 1) { a += __shfl_xor(a, o); b += __shfl_xor(b, o); }
                        if (fr == 0) { const int tok = col0 + bj * HALF + 4 * n + e; *(f32x2*)(stats + (size_t)tok * 16 + slot * 2) = (f32x2){a, b}; } }
        }
    }
};
template <bool BASE_F32> struct EpiResid {
    static constexpr bool PERM = true, ROWSCALE = false;
    const float* basef; const bf16_t* baseb; bf16_t* out; const float* gate;
    __device__ __forceinline__ void operator()(const f32x4 (&acc)[2][2][4][2], const Unit& u, int wr, int wc, int fr, int fq, const LAS float* tab) const {
        const int mb = u.pm >> 5; const int col0 = u.pn * BM + wc * 32 + 8 * fq;
        f32x4 gv[2][2];
#pragma unroll
        for (int bj = 0; bj < 2; ++bj)
#pragma unroll
            for (int n = 0; n < 2; ++n) gv[bj][n] = *(const f32x4*)(gate + (size_t)mb * 6144 + col0 + bj * HALF + n * 4);
#pragma unroll
        for (int ai = 0; ai < 2; ++ai)
#pragma unroll
            for (int m = 0; m < 4; ++m) { const size_t off = (size_t)(u.pm * BM + wr * 64 + fr + ai * HALF + m * 16) * DM + col0;
#pragma unroll
                for (int bj = 0; bj < 2; ++bj) { f32x4 b0, b1;
                    if constexpr (BASE_F32) { b0 = *(const f32x4*)(basef + off + bj * HALF); b1 = *(const f32x4*)(basef + off + bj * HALF + 4); }
                    else { const u32x4 w = *(const u32x4*)(baseb + off + bj * HALF);
                        b0 = (f32x4){__uint_as_float(w.x << 16), __uint_as_float(w.x & 0xffff0000u), __uint_as_float(w.y << 16), __uint_as_float(w.y & 0xffff0000u)};
                        b1 = (f32x4){__uint_as_float(w.z << 16), __uint_as_float(w.z & 0xffff0000u), __uint_as_float(w.w << 16), __uint_as_float(w.w & 0xffff0000u)}; }
                    const f32x4 o0 = b0 + gv[bj][0] * acc[ai][bj][m][0], o1 = b1 + gv[bj][1] * acc[ai][bj][m][1];
                    u32x4 w; w.x = pkbf(o0[0], o0[1]); w.y = pkbf(o0[2], o0[3]); w.z = pkbf(o1[0], o1[1]); w.w = pkbf(o1[2], o1[3]);
                    *(u32x4*)(out + off + bj * HALF) = w; } }
    }
};
struct EpiSwiGLU {
    static constexpr bool PERM = true, ROWSCALE = false;
    bf16_t* O;
    __device__ __forceinline__ void operator()(const f32x4 (&acc)[2][2][4][2], const Unit& u, int wr, int wc, int fr, int fq, const LAS float* tab) const {
        bf16_t* base = O + (size_t)(u.om * BM + wr * 64 + fr) * DFF + u.pn * 128 + wc * 32 + 8 * fq;
#pragma unroll
        for (int ai = 0; ai < 2; ++ai)
#pragma unroll
            for (int m = 0; m < 4; ++m) { const f32x4 g0 = acc[ai][0][m][0], g1 = acc[ai][0][m][1], u0 = acc[ai][1][m][0], u1 = acc[ai][1][m][1];
                float o[8];
#pragma unroll
                for (int e = 0; e < 4; ++e) { o[e] = silu_f(g0[e]) * u0[e]; o[4 + e] = silu_f(g1[e]) * u1[e]; }
                u32x4 w; w.x = pkbf(o[0], o[1]); w.y = pkbf(o[2], o[3]); w.z = pkbf(o[4], o[5]); w.w = pkbf(o[6], o[7]);
                *(u32x4*)(base + (size_t)(ai * HALF + m * 16) * DFF) = w; }
    }
};
struct EpiQKV {
    static constexpr bool PERM = false, ROWSCALE = true;
    __device__ __forceinline__ const float* scale_src(const Unit& u) const { return rscale + u.pm * BM; }
    bf16_t* O; const float* cosT; const float* sinT; float qscale; const float* rscale; const float* wsc;
    __device__ __forceinline__ void operator()(const f32x4 (&acc)[2][2][4][2], const Unit& u, int wr, int wc, int fr, int fq, const LAS float* tab) const {
        const bool lat = u.pm < NPL; const bool dorope = lat && u.pn < 5; const float sc = (u.pn < 4 ? qscale : 1.0f) * wsc[0];
        const int col0 = u.pn * BM + wc * 32 + 4 * fq;
#pragma unroll
        for (int ai = 0; ai < 2; ++ai)
#pragma unroll
            for (int m = 0; m < 4; ++m) { const int grow = u.pm * BM + ai * HALF + wr * 64 + m * 16 + fr; const int s = grow & (SEQ - 1); const int pos = (wc & 1) ? (s & 63) : (s >> 6);
                f32x4 cs = (f32x4){1.f, 1.f, 1.f, 1.f}, sn = (f32x4){0.f, 0.f, 0.f, 0.f};
                if (dorope) { cs = *(const f32x4*)(cosT + pos * 16 + 4 * fq); sn = *(const f32x4*)(sinT + pos * 16 + 4 * fq); }
                bf16_t* rowp = O + (size_t)grow * NQKV + col0;
                const float rsx = tab[ai * HALF + wr * 64 + m * 16 + fr] * sc;
#pragma unroll
                for (int bj = 0; bj < 2; ++bj) { const v4i_t i1 = __builtin_bit_cast(v4i_t, acc[ai][bj][m][0]), i2 = __builtin_bit_cast(v4i_t, acc[ai][bj][m][1]);
                    const f32x4 x1 = (f32x4){(float)i1[0], (float)i1[1], (float)i1[2], (float)i1[3]}, x2 = (f32x4){(float)i2[0], (float)i2[1], (float)i2[2], (float)i2[3]};
                    const f32x4 o1 = (x1 * cs - x2 * sn) * rsx, o2 = (x1 * sn + x2 * cs) * rsx;
                    u32x2 w1, w2; w1.x = pkbf(o1[0], o1[1]); w1.y = pkbf(o1[2], o1[3]); w2.x = pkbf(o2[0], o2[1]); w2.y = pkbf(o2[2], o2[3]);
                    *(u32x2*)(rowp + bj * HALF) = w1; *(u32x2*)(rowp + bj * HALF + 16) = w2; } }
    }
};
struct EpiSwiGLUI8 {
    static constexpr bool PERM = true, ROWSCALE = true;
    __device__ __forceinline__ const float* scale_src(const Unit& u) const { return rscale + u.pm * BM; }
    bf16_t* O; const float* rscale; const float* ws;
    __device__ __forceinline__ void operator()(const f32x4 (&acc)[2][2][4][2], const Unit& u, int wr, int wc, int fr, int fq, const LAS float* tab) const {
        bf16_t* base = O + (size_t)(u.om * BM + wr * 64 + fr) * DFF + u.pn * 128 + wc * 32 + 8 * fq;
        const float wsg = ws[0], wsu = ws[1];
#pragma unroll
        for (int ai = 0; ai < 2; ++ai)
#pragma unroll
            for (int m = 0; m < 4; ++m) { const float rs = tab[wr * 64 + fr + ai * HALF + m * 16]; const float sg = rs * wsg, su = rs * wsu;
                const v4i_t g0 = __builtin_bit_cast(v4i_t, acc[ai][0][m][0]), g1 = __builtin_bit_cast(v4i_t, acc[ai][0][m][1]), u0 = __builtin_bit_cast(v4i_t, acc[ai][1][m][0]), u1 = __builtin_bit_cast(v4i_t, acc[ai][1][m][1]);
                float o[8];
#pragma unroll
                for (int e = 0; e < 4; ++e) { o[e] = silu_f((float)g0[e] * sg) * ((float)u0[e] * su); o[4 + e] = silu_f((float)g1[e] * sg) * ((float)u1[e] * su); }
                u32x4 w; w.x = pkbf(o[0], o[1]); w.y = pkbf(o[2], o[3]); w.z = pkbf(o[4], o[5]); w.w = pkbf(o[6], o[7]);
                *(u32x4*)(base + (size_t)(ai * HALF + m * 16) * DFF) = w; }
    }
};
struct EpiSwiGLU8 {
    static constexpr bool PERM = true, ROWSCALE = false;
    unsigned char* O; float s;
    __device__ __forceinline__ void operator()(const f32x4 (&acc)[2][2][4][2], const Unit& u, int wr, int wc, int fr, int fq, const LAS float* tab) const {
        unsigned char* base = O + (size_t)(u.om * BM + wr * 64 + fr) * DFF + u.pn * 128 + wc * 32 + 8 * fq;
#pragma unroll
        for (int ai = 0; ai < 2; ++ai)
#pragma unroll
            for (int m = 0; m < 4; ++m) { const f32x4 g0 = acc[ai][0][m][0] * s, g1 = acc[ai][0][m][1] * s, u0 = acc[ai][1][m][0] * s, u1 = acc[ai][1][m][1] * s;
                float o[8];
#pragma unroll
                for (int e = 0; e < 4; ++e) { o[e] = silu_f(g0[e]) * u0[e]; o[4 + e] = silu_f(g1[e]) * u1[e]; }
                u32x2 w; w.x = pk4f8(o[0], o[1], o[2], o[3]); w.y = pk4f8(o[4], o[5], o[6], o[7]);
                *(u32x2*)(base + (size_t)(ai * HALF + m * 16) * DFF) = w; }
    }
};
struct EpiBf16Plain {
    static constexpr bool PERM = true, ROWSCALE = false;
    bf16_t* O; int ldc; float s;
    __device__ __forceinline__ void operator()(const f32x4 (&acc)[2][2][4][2], const Unit& u, int wr, int wc, int fr, int fq, const LAS float* tab) const {
        bf16_t* base = O + (size_t)(u.om * BM + wr * 64 + fr) * ldc + u.pn * BM + wc * 32 + 8 * fq;
#pragma unroll
        for (int ai = 0; ai < 2; ++ai)
#pragma unroll
            for (int m = 0; m < 4; ++m)
#pragma unroll
                for (int bj = 0; bj < 2; ++bj) { const f32x4 v0 = acc[ai][bj][m][0] * s, v1 = acc[ai][bj][m][1] * s;
                    u32x4 w; w.x = pkbf(v0[0], v0[1]); w.y = pkbf(v0[2], v0[3]); w.z = pkbf(v1[0], v1[1]); w.w = pkbf(v1[2], v1[3]);
                    *(u32x4*)(base + (size_t)(ai * HALF + m * 16) * ldc + bj * HALF) = w; }
    }
};

struct EpiPartF32 {
    static constexpr bool PERM = true, ROWSCALE = false;
    float* P; size_t sstride;
    __device__ __forceinline__ void operator()(const f32x4 (&acc)[2][2][4][2], const Unit& u, int wr, int wc, int fr, int fq, const LAS float* tab) const {
        float* base = P + (size_t)u.ks * sstride + (size_t)(u.om * BM + wr * 64 + fr) * DM + u.pn * BM + wc * 32 + 8 * fq;
#pragma unroll
        for (int ai = 0; ai < 2; ++ai)
#pragma unroll
            for (int m = 0; m < 4; ++m)
#pragma unroll
                for (int bj = 0; bj < 2; ++bj)
#pragma unroll
                    for (int n = 0; n < 2; ++n) *(f32x4*)(base + (size_t)(ai * HALF + m * 16) * DM + bj * HALF + n * 4) = acc[ai][bj][m][n];
    }
};
struct EpiPartBf16 {
    static constexpr bool PERM = true, ROWSCALE = false;
    bf16_t* P; size_t sstride; float s;
    __device__ __forceinline__ void operator()(const f32x4 (&acc)[2][2][4][2], const Unit& u, int wr, int wc, int fr, int fq, const LAS float* tab) const {
        bf16_t* base = P + (size_t)u.ks * sstride + (size_t)(u.om * BM + wr * 64 + fr) * DM + u.pn * BM + wc * 32 + 8 * fq;
#pragma unroll
        for (int ai = 0; ai < 2; ++ai)
#pragma unroll
            for (int m = 0; m < 4; ++m)
#pragma unroll
                for (int bj = 0; bj < 2; ++bj) { const f32x4 v0 = acc[ai][bj][m][0] * s, v1 = acc[ai][bj][m][1] * s;
                    u32x4 w; w.x = pkbf(v0[0], v0[1]); w.y = pkbf(v0[2], v0[3]); w.z = pkbf(v1[0], v1[1]); w.w = pkbf(v1[2], v1[3]);
                    *(u32x4*)(base + (size_t)(ai * HALF + m * 16) * DM + bj * HALF) = w; }
    }
};

template <class Epi, class Sched, bool ALIGN_EPI, bool GATHER, bool FP8 = false, bool I8 = false>
__device__ __forceinline__ void gemm_phase(LAS unsigned char* lds, LAS int* gtab, const int K  , const int nt_in  , const Sched& S, const Epi& E) {
    int nt = nt_in; asm volatile("" : "+s"(nt));
    int tid_ = threadIdx.x; asm volatile("" : "+v"(tid_));
    const int tid = tid_, wid = __builtin_amdgcn_readfirstlane(tid >> 6), lane = tid & 63, wr = wid >> 2, wc = wid & 3, fr = lane & 15, fq = lane >> 4;
    const size_t kstep = (size_t)(BK * 2);
    const size_t hstep = (size_t)HALF * K * 2;
    unsigned voffB[2];
#pragma unroll
    for (int i = 0; i < 2; ++i) { int R, C; stage_rc(tid * 16 + i * 8192, R, C); const int Rb = Epi::PERM ? ((R & ~31) + perm32(R & 31)) : R;
        voffB[i] = (unsigned)(Rb * K + C) * 2u; }
    unsigned vA[2][2], vN[2][2];
    const unsigned ldsw = (unsigned)wid * 1024u;
    const int aoff = lds_byte(wr * 64 + fr, fq * 8), boff = lds_byte(wc * 32 + fr, fq * 8);
    const LAS unsigned char* aB = lds + aoff; const LAS unsigned char* bB = lds + 65536 + boff;
    asm volatile("" : "+v"(aB), "+v"(bB));
#define PG8_SA(b, h) (((b) * 2 + (h)) * HTB)
#define PG8_SB(b, h) ((4 + (b) * 2 + (h)) * HTB)
#define PG8_STAGE(bufoff, gbase, voff) do { _Pragma("unroll") for (int _i = 0; _i < 2; ++_i) \
        __builtin_amdgcn_global_load_lds((const unsigned*)((const char*)(gbase) + (voff)[_i]), (LAS unsigned*)(lds + (bufoff) + ldsw + _i * 8192), 16, 0, 0); } while (0)
#define PG8_LDA(dst, b, h) do { _Pragma("unroll") for (int m = 0; m < 4; ++m) { if constexpr (FP8) dst##8[m] = cat8(*(const LAS bf16x8*)(aB + PG8_SA(b, h) + m * 2048), *(const LAS bf16x8*)(aB + PG8_SA(b, h) + m * 2048 + 1024)); \
        else { _Pragma("unroll") for (int k = 0; k < 2; ++k) dst[m][k] = *(const LAS bf16x8*)(aB + PG8_SA(b, h) + m * 2048 + k * 1024); } } } while (0)
#define PG8_LDB(dst, b, h) do { _Pragma("unroll") for (int n = 0; n < 2; ++n) { if constexpr (FP8) dst##8[n] = cat8(*(const LAS bf16x8*)(bB + (PG8_SB(b, h) - 65536) + n * 2048), *(const LAS bf16x8*)(bB + (PG8_SB(b, h) - 65536) + n * 2048 + 1024)); \
        else { _Pragma("unroll") for (int k = 0; k < 2; ++k) dst[n][k] = *(const LAS bf16x8*)(bB + (PG8_SB(b, h) - 65536) + n * 2048 + k * 1024); } } } while (0)
#define PG8_MMA(ai, bj, At, Bt) do { __builtin_amdgcn_s_setprio(1); \
    if constexpr (FP8) { _Pragma("unroll") for (int m = 0; m < 4; ++m) _Pragma("unroll") for (int n = 0; n < 2; ++n) \
        asm volatile("v_mfma_f32_16x16x128_f8f6f4 %0, %1, %2, %0" : "+v"(acc[ai][bj][m][n]) : "v"(Bt##8[n]), "v"(At##8[m])); } \
    else if constexpr (I8) { _Pragma("unroll") for (int m = 0; m < 4; ++m) _Pragma("unroll") for (int n = 0; n < 2; ++n) _Pragma("unroll") for (int k = 0; k < 2; ++k) \
        asm volatile("v_mfma_i32_16x16x64_i8 %0, %1, %2, %0" : "+v"(acc[ai][bj][m][n]) : "v"(Bt[n][k]), "v"(At[m][k])); } \
    else { _Pragma("unroll") for (int m = 0; m < 4; ++m) _Pragma("unroll") for (int n = 0; n < 2; ++n) _Pragma("unroll") for (int k = 0; k < 2; ++k) \
        acc[ai][bj][m][n] = __builtin_amdgcn_mfma_f32_16x16x32_bf16(Bt[n][k], At[m][k], acc[ai][bj][m][n], 0, 0, 0); } \
    __builtin_amdgcn_s_setprio(0); } while (0)
#define PG8_WAIT_V(n) asm volatile("s_waitcnt vmcnt(" #n ")" ::: "memory")
#define PG8_WAIT_L(n) asm volatile("s_waitcnt lgkmcnt(" #n ")" ::: "memory")
#define PG8_BAR __builtin_amdgcn_s_barrier()
#define PG8_SCHED __builtin_amdgcn_sched_barrier(0)
    Unit cur, nxt; int ui = 0;
    if (!S.next(0, cur)) return;
    f32x4 acc[2][2][4][2];
#pragma unroll
    for (int a = 0; a < 2; ++a)
#pragma unroll
        for (int b = 0; b < 2; ++b)
#pragma unroll
            for (int m = 0; m < 4; ++m)
#pragma unroll
                for (int n = 0; n < 2; ++n) acc[a][b][m][n] = (f32x4){0.f, 0.f, 0.f, 0.f};
    bf16x8 At[4][2], B0[2][2], B1[2][2]; v8i_t At8[4], B08[2], B18[2];
    if constexpr (GATHER) {
#pragma unroll
        for (int h = 0; h < 2; ++h)
#pragma unroll
            for (int i = 0; i < 2; ++i) { int R, C; stage_rc(tid * 16 + i * 8192, R, C); const int row = h * HALF + R; const int tok = cur.gl[row < cur.nv ? row : 0]; vA[h][i] = (unsigned)tok * (unsigned)(K * 2) + (unsigned)C * 2u; }
    } else {
#pragma unroll
        for (int h = 0; h < 2; ++h)
#pragma unroll
            for (int i = 0; i < 2; ++i) { int R, C; stage_rc(tid * 16 + i * 8192, R, C); vA[h][i] = (unsigned)(R * K + C) * 2u + (unsigned)(h * hstep); }
    }
#pragma unroll
    for (int h = 0; h < 2; ++h)
#pragma unroll
        for (int i = 0; i < 2; ++i) vN[h][i] = vA[h][i];
    const char* cA = cur.a; const char* cB = cur.b;
    PG8_STAGE(PG8_SB(0, 0), cB, voffB); PG8_STAGE(PG8_SB(0, 1), cB + hstep, voffB); PG8_STAGE(PG8_SA(0, 0), cA, vA[0]); PG8_STAGE(PG8_SA(0, 1), cA, vA[1]);
    if (wr == 1) PG8_BAR;
    PG8_WAIT_V(2); PG8_BAR;
    PG8_STAGE(PG8_SB(1, 0), cB + kstep, voffB); PG8_STAGE(PG8_SA(1, 0), cA + kstep, vA[0]); PG8_STAGE(PG8_SB(1, 1), cB + hstep + kstep, voffB);
    PG8_WAIT_V(6); PG8_BAR;
    for (;;) {
        const bool has_next = S.next(ui + 1, nxt);
        if constexpr (Epi::ROWSCALE) {
            if (wid < 4) __builtin_amdgcn_global_load_lds((const unsigned*)(E.scale_src(cur) + wid * 64 + lane), (LAS unsigned*)(lds + STAB_OFF + (ui & 1) * 1024 + wid * 256), 4, 0, 0);
        }
        const char* nA = has_next ? nxt.a : cA; const char* nB = has_next ? nxt.b : cB;
        if constexpr (GATHER) {
            if (has_next && wid < 4) __builtin_amdgcn_global_load_lds((const unsigned*)(nxt.gl + wid * 64 + lane), (LAS unsigned*)(gtab + wid * 64), 4, 0, 0);
        }
        for (int t = 0; t < nt; t += 2) {
            const bool last = (t == nt - 2);
            const char* a1 = cA + (size_t)(t + 1) * kstep;
            const char* a2 = last ? nA : cA + (size_t)(t + 2) * kstep; const char* b2 = last ? nB : cB + (size_t)(t + 2) * kstep;
            const char* a3 = a2 + kstep; const char* b3 = b2 + kstep;
            if constexpr (GATHER) {
                if (last && has_next) {
                    int t2 = tid; asm volatile("" : "+v"(t2));
#pragma unroll
                    for (int h = 0; h < 2; ++h)
#pragma unroll
                        for (int i = 0; i < 2; ++i) { int R, C; stage_rc(t2 * 16 + i * 8192, R, C); const int row = h * HALF + R; const int tok = gtab[row < nxt.nv ? row : 0]; vN[h][i] = (unsigned)tok * (unsigned)(K * 2) + (unsigned)C * 2u; }
                }
            }
            unsigned vS0[2], vS1[2];
#pragma unroll
            for (int i = 0; i < 2; ++i) { vS0[i] = (GATHER && last) ? vN[0][i] : vA[0][i]; vS1[i] = (GATHER && last) ? vN[1][i] : vA[1][i]; }
            PG8_LDB(B0, 0, 0); PG8_LDB(B1, 0, 1); PG8_SCHED; PG8_LDA(At, 0, 0); PG8_STAGE(PG8_SA(1, 1), a1, vA[1]);
            PG8_WAIT_V(8); PG8_WAIT_L(0); PG8_BAR; PG8_MMA(0, 0, At, B0); PG8_MMA(0, 1, At, B1); PG8_BAR; PG8_SCHED;
            PG8_LDA(At, 0, 1); PG8_STAGE(PG8_SB(0, 0), b2, voffB); PG8_STAGE(PG8_SB(0, 1), b2 + hstep, voffB); PG8_STAGE(PG8_SA(0, 0), a2, vS0);
            PG8_WAIT_V(8); PG8_WAIT_L(0); PG8_BAR; PG8_MMA(1, 0, At, B0); PG8_MMA(1, 1, At, B1); PG8_BAR; PG8_SCHED;
            PG8_LDB(B0, 1, 0); PG8_LDB(B1, 1, 1); PG8_SCHED; PG8_LDA(At, 1, 0); PG8_STAGE(PG8_SA(0, 1), a2, vS1);
            PG8_WAIT_V(8); PG8_WAIT_L(0); PG8_BAR; PG8_MMA(0, 0, At, B0); PG8_MMA(0, 1, At, B1); PG8_BAR; PG8_SCHED;
            PG8_LDA(At, 1, 1); PG8_STAGE(PG8_SB(1, 0), b3, voffB); PG8_STAGE(PG8_SB(1, 1), b3 + hstep, voffB); PG8_STAGE(PG8_SA(1, 0), a3, vS0);
            PG8_WAIT_V(8); PG8_WAIT_L(0); PG8_BAR; PG8_MMA(1, 0, At, B0); PG8_MMA(1, 1, At, B1); PG8_BAR; PG8_SCHED;
        }
        if constexpr (ALIGN_EPI) { if (wr == 0) PG8_BAR; }
        if constexpr (FP8 || I8) asm volatile("s_nop 15\n\ts_nop 15" ::: "memory");
        E(acc, cur, wr, wc, fr, fq, (const LAS float*)(lds + STAB_OFF) + (ui & 1) * 256);
        if (!has_next) break;
#pragma unroll
        for (int a = 0; a < 2; ++a)
#pragma unroll
            for (int b = 0; b < 2; ++b)
#pragma unroll
                for (int m = 0; m < 4; ++m)
#pragma unroll
                    for (int n = 0; n < 2; ++n) acc[a][b][m][n] = (f32x4){0.f, 0.f, 0.f, 0.f};
        cur = nxt; cA = nA; cB = nB; ++ui;
        if constexpr (GATHER) {
#pragma unroll
            for (int h = 0; h < 2; ++h)
#pragma unroll
                for (int i = 0; i < 2; ++i) vA[h][i] = vN[h][i];
        }
        if constexpr (ALIGN_EPI) { if (wr == 1) PG8_BAR; }
    }
    PG8_WAIT_V(0);
    if constexpr (!ALIGN_EPI) { if (wr == 0) PG8_BAR; }
    PG8_BAR;
#undef PG8_SA
#undef PG8_SB
#undef PG8_STAGE
#undef PG8_LDA
#undef PG8_LDB
#undef PG8_MMA
#undef PG8_WAIT_V
#undef PG8_WAIT_L
#undef PG8_BAR
#undef PG8_SCHED
}
}

namespace attn_body {
using bf16 = __hip_bfloat16;
using s16x4 = __attribute__((ext_vector_type(4))) short;
constexpr int D = 64, PITCH = NQKV, OPITCH = DM;
constexpr int NW = 8, QBLK = 32, KVBLK = 64;
__device__ __forceinline__ int crow(int r, int hi) { return (r & 3) + 8 * (r >> 2) + 4 * hi; }
#define SBAR() __builtin_amdgcn_sched_barrier(0)
__device__ __forceinline__ void bmask(f32x16& p0, f32x16& p1, int kb, int qrel, int hi) {
    const float NEG = -INFINITY; const int d0 = kb + 4 * hi - qrel;
#pragma unroll
    for (int r = 0; r < 16; ++r) { const int d = d0 + (r & 3) + 8 * (r >> 2); if (d < -128 || d > 128) p0[r] = NEG; if (d + 32 < -128 || d + 32 > 128) p1[r] = NEG; }
}
constexpr int NSLOT = 3, SLOTB = 8192;
constexpr int LDS_K = 0, LDS_V = NSLOT * SLOTB, LDS_WS = 2 * NSLOT * SLOTB, LDS_OST = LDS_WS + NW * 64 * 4, LDS_BYTES_A = LDS_OST + NW * 4096;
constexpr float C2 = 0.125f * 1.4426950408889634f;
__device__ __forceinline__ void glds16(const void* gsrc, unsigned lds_dst) { unsigned keep;
    asm volatile("s_mov_b32 %0, m0\n\ts_mov_b32 m0, %2\n\ts_nop 0\n\tglobal_load_lds_dwordx4 %1, off\n\ts_mov_b32 m0, %0" : "=&s"(keep) : "v"(gsrc), "s"(lds_dst) : "memory"); }
__device__ __forceinline__ float max3f(float a, float b, float c) { float r; asm("v_max3_f32 %0, %1, %2, %3" : "=v"(r) : "v"(a), "v"(b), "v"(c)); return r; }
__device__ __forceinline__ float max2f(float a, float b) { float r; asm("v_max_f32_e32 %0, %1, %2" : "=v"(r) : "v"(a), "v"(b)); return r; }
__device__ __forceinline__ float fadd_s(float a, float b) { float r; asm("v_add_f32_e32 %0, %1, %2" : "=v"(r) : "v"(a), "v"(b)); return r; }
__device__ __forceinline__ float fsub_s(float a, float b) { float r; asm("v_sub_f32_e32 %0, %1, %2" : "=v"(r) : "v"(a), "v"(b)); return r; }
__device__ __forceinline__ unsigned cvtpk_s(float lo, float hi) { f32x2 v = {lo, hi}; bf16x2_t b = __builtin_convertvector(v, bf16x2_t); return __builtin_bit_cast(unsigned, b); }
#define WAIT_BAR(N) asm volatile("s_waitcnt vmcnt(" #N ") lgkmcnt(0)\n\ts_barrier" ::: "memory")
__device__ __forceinline__ void qkt(f32x16& p0, f32x16& p1, const char* Kslot, const bf16x8* qr, const f32x16& negm, int r32, int hi) {
    const char* kb = Kslot + hi * 1024 + r32 * 16;
#pragma unroll
    for (int d0 = 0; d0 < 4; ++d0) {
        const bf16x8 b0 = *reinterpret_cast<const bf16x8*>(kb + d0 * 2048);
        const bf16x8 b1 = *reinterpret_cast<const bf16x8*>(kb + d0 * 2048 + 512);
        if (d0 == 0) { p0 = __builtin_amdgcn_mfma_f32_32x32x16_bf16(b0, qr[0], negm, 0, 0, 0); p1 = __builtin_amdgcn_mfma_f32_32x32x16_bf16(b1, qr[0], negm, 0, 0, 0); }
        else { p0 = __builtin_amdgcn_mfma_f32_32x32x16_bf16(b0, qr[d0], p0, 0, 0, 0); p1 = __builtin_amdgcn_mfma_f32_32x32x16_bf16(b1, qr[d0], p1, 0, 0, 0); } }
}
typedef __attribute__((address_space(3))) const char* lds_cptr;
typedef short v4i16_t __attribute__((ext_vector_type(4)));
__device__ __forceinline__ void kload8(bf16x8* kf, lds_cptr kp) {
    kf[0] = *(const __attribute__((address_space(3))) bf16x8*)(kp);        kf[1] = *(const __attribute__((address_space(3))) bf16x8*)(kp + 512);
    kf[2] = *(const __attribute__((address_space(3))) bf16x8*)(kp + 2048); kf[3] = *(const __attribute__((address_space(3))) bf16x8*)(kp + 2560);
    kf[4] = *(const __attribute__((address_space(3))) bf16x8*)(kp + 4096); kf[5] = *(const __attribute__((address_space(3))) bf16x8*)(kp + 4608);
    kf[6] = *(const __attribute__((address_space(3))) bf16x8*)(kp + 6144); kf[7] = *(const __attribute__((address_space(3))) bf16x8*)(kp + 6656);
}
__device__ __forceinline__ void kload2(bf16x8* kf, lds_cptr kp, int j) { kf[2 * j] = *(const __attribute__((address_space(3))) bf16x8*)(kp + j * 2048); kf[2 * j + 1] = *(const __attribute__((address_space(3))) bf16x8*)(kp + j * 2048 + 512); }
__device__ __forceinline__ s16x4 vtr(lds_cptr p) { return __builtin_bit_cast(s16x4, __builtin_amdgcn_ds_read_tr16_b64_v4i16((__attribute__((address_space(3))) v4i16_t*)p)); }
__device__ __forceinline__ float rowmax(const f32x16& p0, const f32x16& p1) {
    float a = max3f(p0[0], p0[1], p1[0]), b = max3f(p0[2], p0[3], p1[1]); a = max3f(a, p1[2], p1[3]);
#pragma unroll
    for (int r = 4; r < 16; r += 4) { a = max3f(a, p0[r], p0[r + 1]); b = max3f(b, p0[r + 2], p0[r + 3]); a = max3f(a, p1[r], p1[r + 1]); b = max3f(b, p1[r + 2], p1[r + 3]); }
    const float m = max2f(a, b);
    auto rr = __builtin_amdgcn_permlane32_swap(__float_as_uint(m), __float_as_uint(m), false, false);
    return max2f(__uint_as_float(rr[0]), __uint_as_float(rr[1]));
}
__device__ __forceinline__ void pv(f32x16* o, int vb, bf16x8 pa0, bf16x8 pa1, bf16x8 pa2, bf16x8 pa3) {
#pragma unroll
    for (int d0 = 0; d0 < 2; ++d0) { s16x4 lo[4], hi[4];
#pragma unroll
        for (int ks = 0; ks < 4; ++ks) {
            asm volatile("ds_read_b64_tr_b16 %0,%1 offset:%c2" : "=&v"(lo[ks]) : "v"(vb), "i"(d0 * 4096 + ks * 1024) : "memory");
            asm volatile("ds_read_b64_tr_b16 %0,%1 offset:%c2" : "=&v"(hi[ks]) : "v"(vb), "i"(d0 * 4096 + ks * 1024 + 512) : "memory"); }
        asm volatile("s_waitcnt lgkmcnt(0)" ::: "memory"); SBAR();
#define PK(k) (bf16x8){lo[k][0], lo[k][1], lo[k][2], lo[k][3], hi[k][0], hi[k][1], hi[k][2], hi[k][3]}
        o[d0] = __builtin_amdgcn_mfma_f32_32x32x16_bf16(pa0, PK(0), o[d0], 0, 0, 0);
        o[d0] = __builtin_amdgcn_mfma_f32_32x32x16_bf16(pa1, PK(1), o[d0], 0, 0, 0);
        o[d0] = __builtin_amdgcn_mfma_f32_32x32x16_bf16(pa2, PK(2), o[d0], 0, 0, 0);
        o[d0] = __builtin_amdgcn_mfma_f32_32x32x16_bf16(pa3, PK(3), o[d0], 0, 0, 0);
#undef PK
    }
}
#define ATTN_STORE16(p, v) (*(u32x4*)(p) = (v))
template <int THRL> __device__ __forceinline__ int attn_unit(int b, int hk, int n, int pr, const bf16* QKV, bf16* O, const float* sinkp, char* shm, int sb, bool pre, bool has_next, int nb2, int nhk2, int nn2, int npr2, bf16x8 (&qr)[4]) {
    int tid_ = threadIdx.x; asm volatile("" : "+v"(tid_));
    const int tid = tid_, lane = tid & 63, r32 = lane & 31, hi = lane >> 5; const int wid = __builtin_amdgcn_readfirstlane(tid >> 6);
    const int head = 4 * hk + 2 * pr + (wid >> 2);
    const long rowblk = (long)b * SEQ + n * 128;
    const long ctxrow = (long)NLAT + b * LCTX;
    const int nlo = n > 0 ? 2 : 0, nhi = n < (SEQ / 128 - 1) ? 2 : 0;
    const int NT = 6 + nlo + nhi;
    const bf16* Qw = QKV + (rowblk + (wid & 3) * QBLK) * PITCH + head * D;
    const bf16* Kc = QKV + 1024 + hk * D; const bf16* Vc = QKV + 1280 + hk * D;
    const unsigned lds0 = (unsigned)(uintptr_t)shm;
    float* wsf = (float*)(shm + LDS_WS) + wid * 64;
    const long klane = (long)lane * PITCH + wid * 8;
    const long vlane = (long)(16 * (wid & 3) + (lane >> 2)) * PITCH + (wid >> 2) * 32 + (lane & 3) * 8;
    const unsigned kdst = lds0 + LDS_K + wid * 1024, vdst = lds0 + LDS_V + wid * 1024;
#define TROW(t) (((t) < 2) ? (rowblk + 64 * (t)) : ((t) < 6) ? (ctxrow + 64 * ((t) - 2)) : (rowblk + ((((t) - 6) < nlo) ? (-128 + 64 * ((t) - 6)) : (128 + 64 * ((t) - 6 - nlo)))))
#define TKB(t) (((t) < 6) ? 0 : ((((t) - 6) < nlo) ? (-128 + 64 * ((t) - 6)) : (128 + 64 * ((t) - 6 - nlo))))
#define DMA_K(t, slot) glds16(Kc + TROW(t) * PITCH + klane, (unsigned)__builtin_amdgcn_readfirstlane(kdst + (slot)))
#define DMA_V(t, slot) glds16(Vc + TROW(t) * PITCH + vlane, (unsigned)__builtin_amdgcn_readfirstlane(vdst + (slot)))
    const int vb0 = (int)(lds0 + LDS_V) + ((lane >> 4) & 1) * 32 + (lane & 3) * 8 + (4 * hi + ((lane & 15) >> 2)) * 64;
    const char* Kbase = shm + LDS_K; bf16x8 kf[8];
    const lds_cptr shm3 = (lds_cptr)shm; const lds_cptr kp0 = shm3 + LDS_K + hi * 1024 + r32 * 16; const lds_cptr vp0 = shm3 + LDS_V + ((lane >> 4) & 1) * 32 + (lane & 3) * 8 + (4 * hi + ((lane & 15) >> 2)) * 64;
#define NXS(x) (((x) == (NSLOT - 1) * SLOTB) ? 0 : (x) + SLOTB)
    const int S0 = sb, S1 = NXS(S0), S2 = NXS(S1);
    if (!pre) { DMA_K(0, S0); DMA_V(0, S0); DMA_K(1, S1); }
    if (!pre) {
#pragma unroll
        for (int d0 = 0; d0 < 4; ++d0) qr[d0] = *reinterpret_cast<const bf16x8*>(&Qw[(long)r32 * PITCH + d0 * 16 + hi * 8]); }
    float mhat = 0.f, l_reg = 0.f; f32x16 o[2]; o[0] = f32x16{}; o[1] = f32x16{}; f32x16 negm = f32x16{}; asm volatile("" : "+v"(negm));
    const int qrel = (wid & 3) * QBLK + r32;
#define CMASK(P0, P1, t) do { int jb_ = (t) - (NT - 4); if (jb_ >= 0) bmask(P0, P1, TKB(t), qrel, hi); } while (0)
    bool resc = false;
#define START(P0, P1) do { const float rm = rowmax(P0, P1); resc = false; \
    { const float dl = rm; mhat = fadd_s(mhat, dl); \
      _Pragma("unroll") for (int r = 0; r < 16; ++r) { P0[r] = fsub_s(P0[r], dl); P1[r] = fsub_s(P1[r], dl); } \
      _Pragma("unroll") for (int r = 0; r < 16; ++r) negm[r] = -mhat; asm volatile("" : "+v"(negm)); } \
    _Pragma("unroll") for (int r = 0; r < 16; ++r) P0[r] = __builtin_amdgcn_exp2f(P0[r]); } while (0)
#define RESC() do { if (resc) { asm volatile("s_waitcnt lgkmcnt(0)" ::: "memory"); \
      _Pragma("unroll") for (int d_ = 0; d_ < 2; ++d_) _Pragma("unroll") for (int r = 0; r < 16; ++r) o[d_][r] *= wsf[crow(r, hi)]; } } while (0)
    f32x16 pA0, pA1, pB0, pB1;
    int sl_prev = S0, sl_cur = S0, sl_next = S1;
#define ROT() do { sl_prev = sl_cur; sl_cur = sl_next; sl_next = (sl_next == (NSLOT - 1) * SLOTB) ? 0 : sl_next + SLOTB; } while (0)
    if (!pre) { DMA_K(2, S2); }
    WAIT_BAR(3);
    qkt(pA0, pA1, Kbase + S0, qr, negm, r32, hi); asm volatile("s_nop 15\n\ts_nop 7" : "+v"(pA0), "+v"(pA1));
    START(pA0, pA1);
    _Pragma("unroll") for (int r = 0; r < 16; ++r) pA1[r] = __builtin_amdgcn_exp2f(pA1[r]);
    WAIT_BAR(0);
    DMA_K(3, S0); DMA_V(1, S1);
    ROT();
    kload8(kf, kp0 + sl_cur);
    WAIT_BAR(2);
    s16x4 vlo[8], vhi[8]; u32x4 pw0, pw1, pw2, pw3;
#define PKW(P, B) cvtpk_s(P[B], P[B + 1])
#define PAF(k) __builtin_bit_cast(bf16x8, pw##k)
#define VFR(i) (bf16x8){vlo[i][0], vlo[i][1], vlo[i][2], vlo[i][3], vhi[i][0], vhi[i][1], vhi[i][2], vhi[i][3]}
#define PIN(x) asm volatile("" : "+v"(x))
#define MX3(a, b, c) __builtin_fmaxf(__builtin_fmaxf((a), (b)), (c))
#define GAPA(MF, A0, A1, A2, A3, W0, W1, PW) do { MF; sacc += A0; sacc += A1; sacc += A2; sacc += A3; PIN(sacc); W0; W1; PIN(PW); SBAR(); } while (0)
#define EX(v) __builtin_amdgcn_exp2f(v)
#define GAPB(MF, X, B) do { MF; X[B] = EX(X[B]); X[B + 1] = EX(X[B + 1]); X[B + 2] = EX(X[B + 2]); X[B + 3] = EX(X[B + 3]); PIN(X); SBAR(); } while (0)
#define VRD(i) do { vlo[i] = vtr(vp_ + (((i) >> 2) * 4096 + ((i) & 3) * 1024)); vhi[i] = vtr(vp_ + (((i) >> 2) * 4096 + ((i) & 3) * 1024 + 512)); } while (0)
#define KRD(G, j) do { if (G) { kload2(kf, kp0 + sl_next, j); SBAR(); } } while (0)
#define STEP(C0, C1, P0, P1, t, GK, GV, GL) do { SBAR(); \
    const lds_cptr vp_ = vp0 + sl_prev; \
    VRD(0); SBAR(); float sacc = (P0[0] + P0[1]); \
    GAPA(C0 = __builtin_amdgcn_mfma_f32_32x32x16_bf16(kf[0], qr[0], negm, 0, 0, 0), P0[2], P0[3], P0[4], P0[5],     pw0[0] = PKW(P0, 0), pw0[1] = PKW(P0, 2), pw0); \
    VRD(4); SBAR(); GAPA(C1 = __builtin_amdgcn_mfma_f32_32x32x16_bf16(kf[1], qr[0], negm, 0, 0, 0), P0[6], P0[7], P0[8], P0[9],     pw0[2] = PKW(P0, 4), pw0[3] = PKW(P0, 6), pw0); \
    VRD(1); SBAR(); GAPA(C0 = __builtin_amdgcn_mfma_f32_32x32x16_bf16(kf[2], qr[1], C0, 0, 0, 0),   P0[10], P0[11], P0[12], P0[13], pw1[0] = PKW(P0, 8), pw1[1] = PKW(P0, 10), pw1); \
    VRD(5); SBAR(); GAPA(C1 = __builtin_amdgcn_mfma_f32_32x32x16_bf16(kf[3], qr[1], C1, 0, 0, 0),   P0[14], P0[15], P1[0], P1[1],   pw1[2] = PKW(P0, 12), pw1[3] = PKW(P0, 14), pw1); \
    VRD(2); SBAR(); GAPA(C0 = __builtin_amdgcn_mfma_f32_32x32x16_bf16(kf[4], qr[2], C0, 0, 0, 0),   P1[2], P1[3], P1[4], P1[5],     pw2[0] = PKW(P1, 0), pw2[1] = PKW(P1, 2), pw2); \
    VRD(6); SBAR(); GAPA(C1 = __builtin_amdgcn_mfma_f32_32x32x16_bf16(kf[5], qr[2], C1, 0, 0, 0),   P1[6], P1[7], P1[8], P1[9],     pw2[2] = PKW(P1, 4), pw2[3] = PKW(P1, 6), pw2); \
    VRD(3); SBAR(); GAPA(C0 = __builtin_amdgcn_mfma_f32_32x32x16_bf16(kf[6], qr[3], C0, 0, 0, 0),   P1[10], P1[11], P1[12], P1[13], pw3[0] = PKW(P1, 8), pw3[1] = PKW(P1, 10), pw3); \
    VRD(7); SBAR(); GAPA(C1 = __builtin_amdgcn_mfma_f32_32x32x16_bf16(kf[7], qr[3], C1, 0, 0, 0),   P1[14], P1[15], 0.f, 0.f,       pw3[2] = PKW(P1, 12), pw3[3] = PKW(P1, 14), pw3); \
    l_reg += sacc; \
    if (GK) { DMA_K((t) + 3, sl_cur); } if (GV) { DMA_V((t) + 1, sl_next); } \
    CMASK(C0, C1, t); \
    { float a = MX3(C0[0], C0[1], C1[0]), b = MX3(C0[2], C0[3], C1[1]); a = MX3(a, C1[2], C1[3]); \
      _Pragma("unroll") for (int r = 4; r < 16; r += 4) { a = MX3(a, C0[r], C0[r + 1]); b = MX3(b, C0[r + 2], C0[r + 3]); a = MX3(a, C1[r], C1[r + 1]); b = MX3(b, C1[r + 2], C1[r + 3]); } \
      float rm = __builtin_fmaxf(a, b); { auto rr = __builtin_amdgcn_permlane32_swap(__float_as_uint(rm), __float_as_uint(rm), false, false); rm = __builtin_fmaxf(__uint_as_float(rr[0]), __uint_as_float(rr[1])); } \
      resc = false; \
      if (__builtin_expect(__any(rm > (float)THRL), 0)) { const float dl = __builtin_fmaxf(rm, 0.f); mhat += dl; \
        _Pragma("unroll") for (int r = 0; r < 16; ++r) { C0[r] -= dl; C1[r] -= dl; } \
        _Pragma("unroll") for (int r = 0; r < 16; ++r) negm[r] = -mhat; asm volatile("" : "+v"(negm)); \
        const float f = __builtin_amdgcn_exp2f(-dl); l_reg *= f; if (hi == 0) wsf[r32] = f; resc = true; } } \
    SBAR(); \
    GAPB(o[0] = __builtin_amdgcn_mfma_f32_32x32x16_bf16(PAF(0), VFR(0), o[0], 0, 0, 0), C0, 0); \
    GAPB(o[1] = __builtin_amdgcn_mfma_f32_32x32x16_bf16(PAF(0), VFR(4), o[1], 0, 0, 0), C0, 4); \
    KRD(GL, 0); GAPB(o[0] = __builtin_amdgcn_mfma_f32_32x32x16_bf16(PAF(1), VFR(1), o[0], 0, 0, 0), C0, 8); \
    KRD(GL, 1); GAPB(o[1] = __builtin_amdgcn_mfma_f32_32x32x16_bf16(PAF(1), VFR(5), o[1], 0, 0, 0), C0, 12); \
    KRD(GL, 2); GAPB(o[0] = __builtin_amdgcn_mfma_f32_32x32x16_bf16(PAF(2), VFR(2), o[0], 0, 0, 0), C1, 0); \
    KRD(GL, 3); GAPB(o[1] = __builtin_amdgcn_mfma_f32_32x32x16_bf16(PAF(2), VFR(6), o[1], 0, 0, 0), C1, 4); \
    GAPB(o[0] = __builtin_amdgcn_mfma_f32_32x32x16_bf16(PAF(3), VFR(3), o[0], 0, 0, 0), C1, 8); \
    GAPB(o[1] = __builtin_amdgcn_mfma_f32_32x32x16_bf16(PAF(3), VFR(7), o[1], 0, 0, 0), C1, 12); \
    } while (0)
    int t = 1;
#undef CMASK
#define CMASK(P0, P1, t) do { } while (0)
    for (; t + 5 < NT; t += 2) {
        STEP(pB0, pB1, pA0, pA1, t, true, true, true);     WAIT_BAR(2); RESC(); ROT();
        STEP(pA0, pA1, pB0, pB1, t + 1, true, true, true); WAIT_BAR(2); RESC(); ROT();
    }
#undef CMASK
#define CMASK(P0, P1, t) do { int jb_ = (t) - (NT - 4); if (jb_ >= 0) bmask(P0, P1, TKB(t), qrel, hi); } while (0)
#define ENDW(tt) do { if ((tt) + 3 < NT) { WAIT_BAR(2); } else if ((tt) + 2 < NT) { WAIT_BAR(1); } else { WAIT_BAR(0); } } while (0)
    for (; t + 1 < NT; t += 2) {
        STEP(pB0, pB1, pA0, pA1, t, (t + 3 < NT), (t + 1 < NT), (t + 1 < NT));     ENDW(t);     RESC(); ROT();
        STEP(pA0, pA1, pB0, pB1, t + 1, (t + 4 < NT), (t + 2 < NT), (t + 2 < NT)); ENDW(t + 1); RESC(); ROT();
    }
    if (has_next) {
        const long rowblkN = (long)nb2 * SEQ + nn2 * 128, ctxrowN = (long)NLAT + nb2 * LCTX; const bf16* KcN = QKV + 1024 + nhk2 * D; const bf16* VcN = QKV + 1280 + nhk2 * D;
        const int T0 = sl_next, T1 = NXS(T0), T2 = NXS(T1);
        glds16(KcN + rowblkN * PITCH + klane, (unsigned)__builtin_amdgcn_readfirstlane(kdst + T0));
        glds16(VcN + rowblkN * PITCH + vlane, (unsigned)__builtin_amdgcn_readfirstlane(vdst + T0));
        glds16(KcN + (rowblkN + 64) * PITCH + klane, (unsigned)__builtin_amdgcn_readfirstlane(kdst + T1));
        glds16(KcN + ctxrowN * PITCH + klane, (unsigned)__builtin_amdgcn_readfirstlane(kdst + T2));
    }
    STEP(pB0, pB1, pA0, pA1, NT - 1, false, false, false); RESC();
    if (has_next) {
        const bf16* QwN = QKV + ((long)nb2 * SEQ + nn2 * 128 + (wid & 3) * QBLK) * PITCH + (4 * nhk2 + 2 * npr2 + (wid >> 2)) * D;
#pragma unroll
        for (int d0 = 0; d0 < 4; ++d0) qr[d0] = *reinterpret_cast<const bf16x8*>(&QwN[(long)r32 * PITCH + d0 * 16 + hi * 8]); }
    { float sacc = pB0[0] + pB0[1]; _Pragma("unroll") for (int r = 2; r < 16; ++r) sacc += pB0[r]; _Pragma("unroll") for (int r = 0; r < 16; ++r) sacc += pB1[r]; l_reg += sacc;
      pw0 = (u32x4){PKW(pB0, 0), PKW(pB0, 2), PKW(pB0, 4), PKW(pB0, 6)}; pw1 = (u32x4){PKW(pB0, 8), PKW(pB0, 10), PKW(pB0, 12), PKW(pB0, 14)}; pw2 = (u32x4){PKW(pB1, 0), PKW(pB1, 2), PKW(pB1, 4), PKW(pB1, 6)}; pw3 = (u32x4){PKW(pB1, 8), PKW(pB1, 10), PKW(pB1, 12), PKW(pB1, 14)};
      SBAR(); pv(o, vb0 + sl_cur, PAF(0), PAF(1), PAF(2), PAF(3)); }
#undef PKW
#undef PAF
#undef VFR
#undef PIN
#undef MX3
#undef GAPA
#undef GAPB
#undef EX
#undef VRD
#undef KRD
#undef STEP
#undef ENDW
    { auto rr = __builtin_amdgcn_permlane32_swap(__float_as_uint(l_reg), __float_as_uint(l_reg), false, false); l_reg = __uint_as_float(rr[0]) + __uint_as_float(rr[1]); }
    l_reg += __builtin_amdgcn_exp2f(sinkp[head] * 1.4426950408889634f - mhat);
    if (hi == 0) wsf[32 + r32] = l_reg; asm volatile("s_waitcnt lgkmcnt(0)" ::: "memory");
    float rli[16];
#pragma unroll
    for (int r = 0; r < 16; ++r) rli[r] = __builtin_amdgcn_rcpf(wsf[32 + crow(r, hi)]);
    bf16* Ow = O + (rowblk + (wid & 3) * QBLK) * OPITCH + head * D;
    { bf16* stg = (bf16*)(shm + LDS_OST) + wid * 2048;
#pragma unroll
      for (int r = 0; r < 16; ++r) { const int orow = crow(r, hi);
#pragma unroll
        for (int d0 = 0; d0 < 2; ++d0) stg[orow * 64 + d0 * 32 + r32] = __float2bfloat16(o[d0][r] * rli[r]); }
      asm volatile("s_waitcnt lgkmcnt(0)" ::: "memory");
#pragma unroll
      for (int i = 0; i < 4; ++i) { const int row = i * 8 + (lane >> 3), ch = lane & 7; const u32x4 v = *(const u32x4*)(stg + row * 64 + ch * 8); ATTN_STORE16(Ow + (long)row * OPITCH + ch * 8, v); } }
    asm volatile("s_waitcnt lgkmcnt(0)\n\ts_barrier" ::: "memory");
    return sl_next;
#undef NXS
#undef DMA_K
#undef DMA_V
#undef TROW
#undef TKB
#undef CMASK
#undef START
#undef RESC
#undef ROT
}
#undef SBAR
#undef WAIT_BAR
}

#define XB_TMO      128
#define XB_XCNT(j)  (256  + 64 * (j))
#define XB_XSUB(j)  (1280 + 64 * (j))
#define XB_XGEN(j)  (2304 + 64 * (j))
#define XB_TOP      3328
#define XB_TOPGEN   3392
#define XCD_BAR_WORDS 3456
#define XB_SPIN_CAP (1u << 18)
__device__ __forceinline__ unsigned xb_ld(unsigned* p)              { return __hip_atomic_load(p, __ATOMIC_RELAXED, __HIP_MEMORY_SCOPE_AGENT); }
__device__ __forceinline__ unsigned xb_add(unsigned* p, unsigned v) { return __hip_atomic_fetch_add(p, v, __ATOMIC_RELAXED, __HIP_MEMORY_SCOPE_AGENT); }
__device__ __forceinline__ unsigned xb_xcc_id() { return (unsigned)__builtin_amdgcn_s_getreg((3 << 11) | 20) & 0xFu; }
#define XB_SPIN(cond, bar) do { unsigned _sp = 0; while (cond) { __builtin_amdgcn_s_sleep(1); \
    if ((++_sp & 255u) == 0u) { if (xb_ld(&(bar)[XB_TMO])) break; if (_sp > XB_SPIN_CAP) { atomicAdd(&(bar)[XB_TMO], 1u); break; } } } } while (0)
struct XcdBarrier { unsigned* bar; unsigned x; volatile LAS unsigned* st; };
__device__ __forceinline__ XcdBarrier xcd_barrier_post(unsigned* bar, volatile LAS unsigned* st) {
    XcdBarrier b; b.bar = bar; b.x = xb_xcc_id(); b.st = st;
    if (threadIdx.x == 0) (void)xb_add(&bar[XB_XCNT(b.x)], 1u);
    return b;
}
__device__ __forceinline__ void xcd_barrier_complete(unsigned* bar, unsigned x, unsigned& nloc, unsigned& nx) {
    const unsigned G = gridDim.x * gridDim.y * gridDim.z;
    unsigned sum, cnt, mine, sp = 0u;
    for (;;) {
        sum = 0u; cnt = 0u; mine = 0u;
#pragma unroll
        for (unsigned j = 0; j < 16; ++j) { const unsigned c = xb_ld(&bar[XB_XCNT(j)]); sum += c; cnt += (c > 0u) ? 1u : 0u; mine = (j == x) ? c : mine; }
        if (sum == G) break;
        __builtin_amdgcn_s_sleep(1);
        if ((++sp & 255u) == 0u) { if (xb_ld(&bar[XB_TMO])) break; if (sp > XB_SPIN_CAP) { atomicAdd(&bar[XB_TMO], 1u); break; } }
    }
    nloc = mine > 0u ? mine : 1u; nx = cnt > 0u ? cnt : 1u;
}
__device__ __forceinline__ void xcd_barrier(const XcdBarrier& b) {
    asm volatile("s_waitcnt vmcnt(0)" ::: "memory");
    __syncthreads();
    if (threadIdx.x == 0) {
        unsigned* bar = b.bar;
        __builtin_amdgcn_s_waitcnt(0);
        unsigned nloc = b.st[0], nx = b.st[1];
        if (nloc == 0u) { xcd_barrier_complete(bar, b.x, nloc, nx); b.st[0] = nloc; b.st[1] = nx; }
        const unsigned old = xb_add(&bar[XB_XSUB(b.x)], 1u);
        const unsigned gen = old / nloc;
        if (old + 1u == (gen + 1u) * nloc) {
            __builtin_amdgcn_fence(__ATOMIC_RELEASE, "agent");
            asm volatile("s_waitcnt vmcnt(0)" ::: "memory");
            const unsigned og = xb_add(&bar[XB_TOP], 1u);
            const unsigned tg = og / nx;
            if (og + 1u == (tg + 1u) * nx) xb_add(&bar[XB_TOPGEN], 1u);
            else XB_SPIN(xb_ld(&bar[XB_TOPGEN]) == tg, bar);
            __builtin_amdgcn_fence(__ATOMIC_ACQUIRE, "agent");
            xb_add(&bar[XB_XGEN(b.x)], 1u);
            asm volatile("s_waitcnt vmcnt(0)" ::: "memory");
        } else {
            XB_SPIN(xb_ld(&bar[XB_XGEN(b.x)]) == gen, bar);
            __builtin_amdgcn_fence(__ATOMIC_ACQUIRE, "agent");
            asm volatile("s_waitcnt vmcnt(0)" ::: "memory");
        }
    }
    __syncthreads();
}

#define LDS_WAIT() asm volatile("s_waitcnt lgkmcnt(0)" ::: "memory")
__device__ __forceinline__ void transpose_item(const float* W, int K, int N, bf16_t* WT, int k0, int n0, int drow0, LAS float* scr, int lane) {
    float t[32];
#pragma unroll
    for (int i = 0; i < 32; ++i) t[i] = __builtin_nontemporal_load(W + (size_t)(k0 + 2 * i + (lane >> 5)) * N + n0 + (lane & 31));
#pragma unroll
    for (int i = 0; i < 32; ++i) scr[(2 * i + (lane >> 5)) * 33 + (lane & 31)] = t[i];
    LDS_WAIT(); asm volatile("" ::: "memory");
    const int c = lane & 7;
#pragma unroll
    for (int j = 0; j < 4; ++j) { const int n = (lane >> 3) + 8 * j; const LAS float* s = scr + (8 * c) * 33 + n;
        u32x4 o; o.x = pkbf(s[0 * 33], s[1 * 33]); o.y = pkbf(s[2 * 33], s[3 * 33]); o.z = pkbf(s[4 * 33], s[5 * 33]); o.w = pkbf(s[6 * 33], s[7 * 33]);
        *(GAS u32x4*)(WT + (size_t)(drow0 + n) * K + k0 + 8 * c) = o; }
    LDS_WAIT(); asm volatile("" ::: "memory");
}
__device__ __forceinline__ void transpose_item_f8(const float* W, int K, int N, unsigned char* WT, int k0, int n0, int drow0, float scale, LAS float* scr, int lane) {
    float t[32];
#pragma unroll
    for (int i = 0; i < 32; ++i) t[i] = __builtin_nontemporal_load(W + (size_t)(k0 + 2 * i + (lane >> 5)) * N + n0 + (lane & 31));
#pragma unroll
    for (int i = 0; i < 32; ++i) scr[(2 * i + (lane >> 5)) * 33 + (lane & 31)] = t[i];
    LDS_WAIT(); asm volatile("" ::: "memory");
    const int n = lane >> 1, hf = lane & 1; const LAS float* sp = scr + (32 * hf) * 33 + n;
    u32x4 o0, o1;
    o0.x = pk4f8(sp[0 * 33] * scale, sp[1 * 33] * scale, sp[2 * 33] * scale, sp[3 * 33] * scale);     o0.y = pk4f8(sp[4 * 33] * scale, sp[5 * 33] * scale, sp[6 * 33] * scale, sp[7 * 33] * scale);
    o0.z = pk4f8(sp[8 * 33] * scale, sp[9 * 33] * scale, sp[10 * 33] * scale, sp[11 * 33] * scale);   o0.w = pk4f8(sp[12 * 33] * scale, sp[13 * 33] * scale, sp[14 * 33] * scale, sp[15 * 33] * scale);
    o1.x = pk4f8(sp[16 * 33] * scale, sp[17 * 33] * scale, sp[18 * 33] * scale, sp[19 * 33] * scale); o1.y = pk4f8(sp[20 * 33] * scale, sp[21 * 33] * scale, sp[22 * 33] * scale, sp[23 * 33] * scale);
    o1.z = pk4f8(sp[24 * 33] * scale, sp[25 * 33] * scale, sp[26 * 33] * scale, sp[27 * 33] * scale); o1.w = pk4f8(sp[28 * 33] * scale, sp[29 * 33] * scale, sp[30 * 33] * scale, sp[31 * 33] * scale);
    GAS u32x4* dst = (GAS u32x4*)(WT + (size_t)(drow0 + n) * K + k0 + 32 * hf);
    dst[0] = o0; dst[1] = o1;
    LDS_WAIT(); asm volatile("" ::: "memory");
}
__device__ __forceinline__ unsigned pk4i8(float a, float b, float c, float d) {
    const int ia = (int)__builtin_rintf(a), ib = (int)__builtin_rintf(b), ic = (int)__builtin_rintf(c), id = (int)__builtin_rintf(d);
    return (unsigned)(ia & 255) | ((unsigned)(ib & 255) << 8) | ((unsigned)(ic & 255) << 16) | ((unsigned)(id & 255) << 24); }
__device__ __forceinline__ void transpose_item_i8(const float* W, int K, int N, unsigned char* WT, int k0, int n0, int drow0, float scale, LAS float* scr, int lane) {
    float t[32];
#pragma unroll
    for (int i = 0; i < 32; ++i) t[i] = W[(size_t)(k0 + 2 * i + (lane >> 5)) * N + n0 + (lane & 31)];
#pragma unroll
    for (int i = 0; i < 32; ++i) scr[(2 * i + (lane >> 5)) * 33 + (lane & 31)] = t[i];
    LDS_WAIT(); asm volatile("" ::: "memory");
    const int n = lane >> 1, hf = lane & 1; const LAS float* sp = scr + (32 * hf) * 33 + n;
    u32x4 o0, o1;
    o0.x = pk4i8(sp[0 * 33] * scale, sp[1 * 33] * scale, sp[2 * 33] * scale, sp[3 * 33] * scale);     o0.y = pk4i8(sp[4 * 33] * scale, sp[5 * 33] * scale, sp[6 * 33] * scale, sp[7 * 33] * scale);
    o0.z = pk4i8(sp[8 * 33] * scale, sp[9 * 33] * scale, sp[10 * 33] * scale, sp[11 * 33] * scale);   o0.w = pk4i8(sp[12 * 33] * scale, sp[13 * 33] * scale, sp[14 * 33] * scale, sp[15 * 33] * scale);
    o1.x = pk4i8(sp[16 * 33] * scale, sp[17 * 33] * scale, sp[18 * 33] * scale, sp[19 * 33] * scale); o1.y = pk4i8(sp[20 * 33] * scale, sp[21 * 33] * scale, sp[22 * 33] * scale, sp[23 * 33] * scale);
    o1.z = pk4i8(sp[24 * 33] * scale, sp[25 * 33] * scale, sp[26 * 33] * scale, sp[27 * 33] * scale); o1.w = pk4i8(sp[28 * 33] * scale, sp[29 * 33] * scale, sp[30 * 33] * scale, sp[31 * 33] * scale);
    GAS u32x4* dst = (GAS u32x4*)(WT + (size_t)(drow0 + n) * K + k0 + 32 * hf);
    dst[0] = o0; dst[1] = o1;
    LDS_WAIT(); asm volatile("" ::: "memory");
}
__device__ __forceinline__ void sincos_d(double x, double& s, double& c) {
    const double TWO_PI = 6.283185307179586476925;
    const double k = __builtin_rint(x / TWO_PI); const double r = x - k * TWO_PI;
    const double r2 = r * r; double ts = r, tc = 1.0; s = r; c = 1.0;
    for (int i = 1; i <= 16; ++i) { tc *= -r2 / (double)((2 * i - 1) * (2 * i)); ts *= -r2 / (double)((2 * i) * (2 * i + 1)); c += tc; s += ts; }
}

constexpr int CI_F = 16 * 112, CI_FD = 56 * 32, MOE_ITEMS = 8 * (2 * CI_F + CI_FD);
constexpr int MOE_TAIL_A = 12000, MOE_TAIL_B = 7000, MOE_TAIL_C = 12000, MOE_TAIL_TOTAL = MOE_TAIL_A + MOE_TAIL_B + MOE_TAIL_C;
__device__ __forceinline__ void moe_convert_item(int r, const float* wg, const float* wu, const float* wd, unsigned char* mgu, unsigned char* md, LAS float* scr, int lane) {
    const int e = r / (2 * CI_F + CI_FD); int q = r % (2 * CI_F + CI_FD);
    if (q < 2 * CI_F) { const int up = q / CI_F; q %= CI_F; const int kb = q / 112, nb = q % 112, n0 = 32 * nb;
        transpose_item_f8((up ? wu : wg) + (size_t)e * 1024 * DFF, 1024, DFF, mgu + (size_t)e * 7168 * 1024, 64 * kb, n0, 256 * (n0 >> 7) + 128 * up + (n0 & 127), MOE_SGU, scr, lane); }
    else { q -= 2 * CI_F; const int kb = q / 32, nb = q % 32; transpose_item_f8(wd + (size_t)e * DFF * 1024, DFF, 1024, md + (size_t)e * 1024 * DFF, 64 * kb, 32 * nb, 32 * nb, MOE_SD, scr, lane); }
}
__device__ __forceinline__ void moe_convert_tail(int nunits, int G, int bx, int first, int count, const float* wg, const float* wu, const float* wd, unsigned char* mgu, unsigned char* md, LAS unsigned char* lds) {
    const int busy = nunits % G; if (busy == 0 || bx < busy) return;
    int tid_ = threadIdx.x; asm volatile("" : "+v"(tid_)); const int lane = tid_ & 63, wave = __builtin_amdgcn_readfirstlane(tid_ >> 6);
    LAS float* scr = (LAS float*)(lds + wave * 16384);
    const int nw = (G - busy) * 8, w = (bx - busy) * 8 + wave;
    for (int it = w; it < count; it += nw) moe_convert_item(first + it, wg, wu, wd, mgu, md, scr, lane);
}

struct Args { const float* in[24]; float* out; unsigned char* ws; int ph_lo, ph_hi, li, pad; };
constexpr int NPH = 18;

__device__ __forceinline__ void norm_store(const f32x4 (&v)[4], float ssum, const float* g, const float* mrow, int shc, int scc, bf16_t* XNo, size_t m, int lane, float* rsc) {
    const float rstd = 1.0f / __builtin_sqrtf(ssum * (1.0f / DM) + EPS);
    f32x4 y[4];
#pragma unroll
    for (int j = 0; j < 4; ++j) { const f32x4 gv = *(const f32x4*)(g + 4 * lane + 256 * j), sc = *(const f32x4*)(mrow + scc * 1024 + 4 * lane + 256 * j), sh = *(const f32x4*)(mrow + shc * 1024 + 4 * lane + 256 * j);
        y[j] = (v[j] * rstd) * gv * (sc + 1.0f) + sh; }
    if (rsc == nullptr) {
#pragma unroll
        for (int j = 0; j < 4; ++j) { u32x2 w; w.x = pkbf(y[j].x, y[j].y); w.y = pkbf(y[j].z, y[j].w); *((GAS u32x2*)(XNo + m * DM) + lane + 64 * j) = w; }
    } else {
        float mx = 0.f;
#pragma unroll
        for (int j = 0; j < 4; ++j) mx = __builtin_fmaxf(__builtin_fmaxf(mx, __builtin_fmaxf(__builtin_fabsf(y[j].x), __builtin_fabsf(y[j].y))), __builtin_fmaxf(__builtin_fabsf(y[j].z), __builtin_fabsf(y[j].w)));
#pragma unroll
        for (int o = 1; o < 64; o <<= 1) mx = __builtin_fmaxf(mx, __shfl_xor(mx, o));
        mx = __builtin_fmaxf(mx, 1e-20f); const float qs = 127.0f / mx;
#pragma unroll
        for (int j = 0; j < 4; ++j) *((GAS unsigned*)((unsigned char*)XNo + m * DM) + lane + 64 * j) = pk4i8(y[j].x * qs, y[j].y * qs, y[j].z * qs, y[j].w * qs);
        if (lane == 0) rsc[m] = mx * (1.0f / 127.0f);
    }
}
template <bool SRC_BF16> __device__ __forceinline__ void norm_rows(const void* srcLv, const float* srcC, int nrows, const float* g, const float* mod, int shc, int scc, bf16_t* XNo, int gw, int NGW, int lane,
                                          const float* part, int nS, const float* gatec, float* zout, float* rsc = nullptr) {
    if (nrows > NLAT) {
        for (int rc = gw; rc < NCTXR; rc += NGW) {
            const GAS f32x4* xr = (const GAS f32x4*)(srcC + (size_t)rc * DM) + lane;
            f32x4 v[4];
#pragma unroll
            for (int j = 0; j < 4; ++j) v[j] = xr[64 * j];
            if (part != nullptr) {
                f32x4 a[4];
#pragma unroll
                for (int j = 0; j < 4; ++j) a[j] = (f32x4){0.f, 0.f, 0.f, 0.f};
                for (int s0 = 0; s0 < nS; s0 += 7) {
                    f32x4 t[7][4];
#pragma unroll
                    for (int q = 0; q < 7; ++q) { const int s2 = (s0 + q < nS) ? s0 + q : s0; const GAS f32x4* pr = (const GAS f32x4*)(part + ((size_t)s2 * NCTXR + rc) * DM) + lane;
#pragma unroll
                        for (int j = 0; j < 4; ++j) t[q][j] = pr[64 * j]; }
#pragma unroll
                    for (int q = 0; q < 7; ++q) if (s0 + q < nS) {
#pragma unroll
                        for (int j = 0; j < 4; ++j) a[j] += t[q][j]; }
                }
#pragma unroll
                for (int j = 0; j < 4; ++j) v[j] += *(const f32x4*)(gatec + 4 * lane + 256 * j) * a[j];
                if (zout != nullptr) { GAS f32x4* zr = (GAS f32x4*)(zout + (size_t)rc * DM) + lane;
#pragma unroll
                    for (int j = 0; j < 4; ++j) zr[64 * j] = v[j]; }
            }
            float ss = 0.f;
#pragma unroll
            for (int j = 0; j < 4; ++j) ss += (v[j].x * v[j].x + v[j].y * v[j].y) + (v[j].z * v[j].z + v[j].w * v[j].w);
            norm_store(v, wave_sum(ss), g, mod + (size_t)4 * 6144, shc, scc, XNo, (size_t)NLAT + rc, lane, rsc);
        }
    }
    const bool bal = (NGW == 2048) && (nrows > NLAT);
    for (int k = 0;; ++k) {
        int grp;
        if (bal) { if (k < 3) grp = gw + 2048 * k; else if (gw >= 1024 && k < 5) grp = 6144 + 2 * (gw - 1024) + (k - 3); else break; }
        else { grp = gw + k * NGW; if (grp >= NLAT / 4) break; }
        const int m0 = grp * 4;
        const int mb = m0 >> 13;
        f32x4 v[4][4];
        if constexpr (SRC_BF16) { const GAS u32x2* xr = (const GAS u32x2*)((const bf16_t*)srcLv + (size_t)m0 * DM) + lane;
#pragma unroll
            for (int r = 0; r < 4; ++r)
#pragma unroll
                for (int j = 0; j < 4; ++j) { const u32x2 w = xr[r * 256 + 64 * j]; v[r][j] = (f32x4){__uint_as_float(w.x << 16), __uint_as_float(w.x & 0xffff0000u), __uint_as_float(w.y << 16), __uint_as_float(w.y & 0xffff0000u)}; } }
        else { const GAS f32x4* xr = (const GAS f32x4*)((const float*)srcLv + (size_t)m0 * DM) + lane;
#pragma unroll
            for (int r = 0; r < 4; ++r)
#pragma unroll
                for (int j = 0; j < 4; ++j) v[r][j] = xr[r * 256 + 64 * j]; }
        float ss[4];
#pragma unroll
        for (int r = 0; r < 4; ++r) { ss[r] = 0.f;
#pragma unroll
            for (int j = 0; j < 4; ++j) ss[r] += (v[r][j].x * v[r][j].x + v[r][j].y * v[r][j].y) + (v[r][j].z * v[r][j].z + v[r][j].w * v[r][j].w); }
#pragma unroll
        for (int o = 1; o < 64; o <<= 1) {
#pragma unroll
            for (int r = 0; r < 4; ++r) ss[r] += __shfl_xor(ss[r], o); }
#pragma unroll
        for (int r = 0; r < 4; ++r) norm_store(v[r], ss[r], g, mod + (size_t)mb * 6144, shc, scc, XNo, (size_t)(m0 + r), lane, rsc);
    }
}

__global__ void __launch_bounds__(512, 2) fwd(Args args) {
    extern __shared__ __attribute__((aligned(16))) unsigned char lds_raw[];
    LAS unsigned char* lds = (LAS unsigned char*)lds_raw;
    volatile LAS unsigned* MISC = (volatile LAS unsigned*)(lds + MISC_OFF);
    LAS int* gtab = (LAS int*)(lds + GTAB_OFF);
    const int G = gridDim.x; const int bx = blockIdx.x; const int vcu = (G % 8 == 0) ? (bx % 8) * (G / 8) + bx / 8 : bx;
    const int NGW = G * 8;
#define PHASE_IDS() int tid_ = threadIdx.x; asm volatile("" : "+v"(tid_)); const int tid = tid_, lane = tid & 63, wave = __builtin_amdgcn_readfirstlane(tid >> 6), gw = vcu * 8 + wave; (void)lane; (void)gw
    unsigned char* ws = args.ws;
    gu32* ctl = (gu32*)(ws + WS_CTL);
#define MOD ((float*)(ws + WS_MOD))
#define ROPE ((float*)(ws + WS_ROPE))
#define STATS ((float*)(ws + WS_STATS))
#define RSC ((float*)(ws + WS_RSC))
#define LIST ((int*)(ws + WS_LIST))
#define TINFO ((int*)(ws + WS_TINFO))
#define WSB ((bf16_t*)(ws + WS_WS))
#define WIN ((unsigned char*)(ws + WS_WIN))
#define WAO ((bf16_t*)(ws + WS_WAO))
#define WQKV ((unsigned char*)(ws + WS_WQKV))
#define WBO ((bf16_t*)(ws + WS_WBO))
#define WGU ((unsigned char*)(ws + WS_WGU))
#define WD ((bf16_t*)(ws + WS_WD))
#define MGU ((unsigned char*)(ws + WS_MGU))
#define MD ((unsigned char*)(ws + WS_MD))
#define XN8 ((unsigned char*)(ws + WS_XN))
#define XN ((bf16_t*)(ws + WS_XN))
#define ZB ((float*)(ws + WS_ZB))
#define UVT ((bf16_t*)(ws + WS_UVT))
#define A2 ((bf16_t*)(ws + WS_A2))
#define HB ((bf16_t*)(ws + WS_H))
#define QKV ((bf16_t*)(ws + WS_QKV))
#define OB ((bf16_t*)(ws + WS_O))
#define YB ((bf16_t*)(ws + WS_Y))
#define HC ((unsigned char*)(ws + WS_HC))
#define YP ((bf16_t*)(ws + WS_YP))
#define PART1 ((float*)(ws + WS_PART1))
#define PART2 ((float*)(ws + WS_PART2))
#define I_X (args.in[0])
#define I_C (args.in[1])
#define I_CTX (args.in[2])
#define I_CCTX (args.in[3])
#define I_ADAW (args.in[4])
#define I_ADAB (args.in[5])
#define I_NORMG (args.in[6])
#define I_FINALG (args.in[7])
#define HL ((bf16_t*)(ws + WS_HLB))

    { PHASE_IDS(); for (int u = tid; u < (LDS_BYTES - MISC_OFF) / 4; u += 512) ((LAS unsigned*)(lds + MISC_OFF))[u] = 0u; }
    __syncthreads();
    const int lo = args.ph_lo, hi_ph = args.ph_hi;
    const bool one_launch = (hi_ph - lo) > 1;
    XcdBarrier bar; bar.bar = (unsigned*)(ctl + CW_BAR) + args.li * XCD_BAR_WORDS; bar.x = 0; bar.st = nullptr;
    if (one_launch) bar = xcd_barrier_post((unsigned*)(ctl + CW_BAR) + args.li * XCD_BAR_WORDS, MISC + 8);
#ifndef PHMASK
#define PHMASK 0xFFFFFFFFu
#endif
#define IN(k) (((PHMASK >> (k)) & 1) && lo <= (k) && (k) < hi_ph)
#define BOTH(k) (IN(k) && IN((k) + 1))
#define GRID_BAR() xcd_barrier(bar)
#if defined(PROBE_LO)
    unsigned long long tpA = __builtin_amdgcn_s_memrealtime(), tpB = 0;
#define PROBE_MARK(k) do { if ((k) == PROBE_LO - 1) tpA = __builtin_amdgcn_s_memrealtime(); if ((k) == PROBE_HI) tpB = __builtin_amdgcn_s_memrealtime(); } while (0)
#else
#define PROBE_MARK(k) do { } while (0)
#endif

    if (IN(0)) {
        PHASE_IDS();
        {
            LAS float* sv = (LAS float*)lds;
            LAS float* red = (LAS float*)(lds + 5 * 1024 * 4);
            if (bx < 192) {
                for (int idx = tid; idx < 5 * 1024; idx += 512) { const int r = idx >> 10, k = idx & 1023; const float cv = r < 4 ? I_C[r * 1024 + k] : I_CCTX[k]; sv[idx] = cv / (1.0f + __expf(-cv)); }
                __syncthreads();
                for (int item = bx; item < 192; item += G) {
                    const int i = item / 96, n0 = (item % 96) * 64, nn = tid & 63, kq = tid >> 6;
                    float a0 = 0.f, a1 = 0.f, a2 = 0.f, a3 = 0.f, a4 = 0.f;
                    const float* wp = I_ADAW + ((size_t)i * 1024 + kq * 128) * 6144 + n0 + nn;
#pragma unroll 8
                    for (int k = 0; k < 128; ++k) { const float w = wp[(size_t)k * 6144]; const int kk = kq * 128 + k;
                        a0 += sv[kk] * w; a1 += sv[1024 + kk] * w; a2 += sv[2048 + kk] * w; a3 += sv[3072 + kk] * w; a4 += sv[4096 + kk] * w; }
                    red[(kq * 5 + 0) * 64 + nn] = a0; red[(kq * 5 + 1) * 64 + nn] = a1; red[(kq * 5 + 2) * 64 + nn] = a2; red[(kq * 5 + 3) * 64 + nn] = a3; red[(kq * 5 + 4) * 64 + nn] = a4;
                    __syncthreads();
                    if (tid < 320) { const int r = tid >> 6; float s = I_ADAB[i * 6144 + n0 + nn];
#pragma unroll
                        for (int q = 0; q < 8; ++q) s += red[(q * 5 + r) * 64 + nn];
                        MOD[((size_t)i * 5 + r) * 6144 + n0 + nn] = s; }
                    __syncthreads();
                }
            }
            __syncthreads();
        }
        {
            LAS float* scr = (LAS float*)(lds + wave * 16384);
            constexpr int I_IN = 16 * 64, I_AO = 16 * 32, I_QKV = 16 * 48, I_BO = 16 * 32, I_F = 16 * 112, I_FD = 56 * 32;
            constexpr int I_DENSE = I_IN + I_AO + I_QKV + I_BO + 2 * I_F + I_FD, I_MOE = MOE_ITEMS, I_WS = 128, I_ROPE = 32;
            constexpr int NITEMS = I_DENSE + I_MOE + I_WS + I_ROPE;
            for (int it = gw; it < NITEMS; it += NGW) {
                int r = it;
                if (r < I_IN) { const int kb = r / 64, nb = r % 64; const float* W = args.in[8]; float mx = 0.f;
#pragma unroll
                    for (int i = 0; i < 32; ++i) mx = __builtin_fmaxf(mx, __builtin_fabsf(W[(size_t)(64 * kb + 2 * i + (lane >> 5)) * 2048 + 32 * nb + (lane & 31)]));
#pragma unroll
                    for (int o = 1; o < 64; o <<= 1) mx = __builtin_fmaxf(mx, __shfl_xor(mx, o));
                    if (lane == 0) __hip_atomic_fetch_max((unsigned*)(ctl + CW_WAMAX + 192), __float_as_uint(mx), __ATOMIC_RELAXED, __HIP_MEMORY_SCOPE_AGENT);
                    continue; } r -= I_IN;
                if (r < I_AO) { const int kb = r / 32, nb = r % 32; transpose_item(args.in[13], 1024, 1024, WAO, 64 * kb, 32 * nb, 32 * nb, scr, lane); continue; } r -= I_AO;
                if (r < I_QKV) { const int kb = r / 48, nb = r % 48; const float* W = args.in[14]; float mx = 0.f;
#pragma unroll
                    for (int i = 0; i < 32; ++i) mx = __builtin_fmaxf(mx, __builtin_fabsf(W[(size_t)(64 * kb + 2 * i + (lane >> 5)) * NQKV + 32 * nb + (lane & 31)]));
#pragma unroll
                    for (int o = 1; o < 64; o <<= 1) mx = __builtin_fmaxf(mx, __shfl_xor(mx, o));
                    if (lane == 0) __hip_atomic_fetch_max((unsigned*)(ctl + CW_WAMAX + 128), __float_as_uint(mx), __ATOMIC_RELAXED, __HIP_MEMORY_SCOPE_AGENT);
                    continue; } r -= I_QKV;
                if (r < I_BO) { const int kb = r / 32, nb = r % 32; transpose_item(args.in[16], 1024, 1024, WBO, 64 * kb, 32 * nb, 32 * nb, scr, lane); continue; } r -= I_BO;
                if (r < 2 * I_F) { const int up = r / I_F; const int q = r % I_F; const int kb = q / 112, nb = q % 112;
                    const float* W = args.in[17 + up]; float mx = 0.f;
#pragma unroll
                    for (int i = 0; i < 32; ++i) mx = __builtin_fmaxf(mx, __builtin_fabsf(W[(size_t)(64 * kb + 2 * i + (lane >> 5)) * DFF + 32 * nb + (lane & 31)]));
#pragma unroll
                    for (int o = 1; o < 64; o <<= 1) mx = __builtin_fmaxf(mx, __shfl_xor(mx, o));
                    if (lane == 0) __hip_atomic_fetch_max((unsigned*)(ctl + CW_WAMAX + 64 * up), __float_as_uint(mx), __ATOMIC_RELAXED, __HIP_MEMORY_SCOPE_AGENT);
                    continue; } r -= 2 * I_F;
                if (r < I_FD) { const int kb = r / 32, nb = r % 32; transpose_item(args.in[19], DFF, 1024, WD, 64 * kb, 32 * nb, 32 * nb, scr, lane); continue; } r -= I_FD;
                if (r < I_MOE) { if (r >= MOE_TAIL_TOTAL) moe_convert_item(r, args.in[21], args.in[22], args.in[23], MGU, MD, scr, lane); continue; } r -= I_MOE;
                if (r < I_WS) { const float* src = args.in[11] + (size_t)r * 2048;
#pragma unroll
                    for (int j = 0; j < 8; ++j) { const f32x4 v = *(const f32x4*)(src + j * 256 + lane * 4); u32x2 w; w.x = pkbf(v.x, v.y); w.y = pkbf(v.z, v.w); *(u32x2*)(WSB + (size_t)r * 2048 + j * 256 + lane * 4) = w; }
                    continue; } r -= I_WS;
                {
                    const int ent = r * 64 + lane; const int pos = ent >> 4, i = ent & 15;
                    double inv = 1.0; for (int q = 0; q < i; ++q) inv *= 0.56234132519034908;
                    const float ang = (float)pos * (float)inv; double s, c; sincos_d((double)ang, s, c);
                    ROPE[ent] = (float)c; ROPE[2048 + ent] = (float)s;
                }
            }
        }
        if (BOTH(0)) GRID_BAR(); PROBE_MARK(0);
    }
    if (IN(1)) { PHASE_IDS();
        {
            LAS float* scr = (LAS float*)(lds + wave * 16384);
            const float ag = __uint_as_float(__hip_atomic_load((unsigned*)(ctl + CW_WAMAX), __ATOMIC_RELAXED, __HIP_MEMORY_SCOPE_AGENT)), au = __uint_as_float(__hip_atomic_load((unsigned*)(ctl + CW_WAMAX + 64), __ATOMIC_RELAXED, __HIP_MEMORY_SCOPE_AGENT));
            if (gw == 0 && lane == 0) { RSC[MALL] = ag * (1.0f / 127.0f); RSC[MALL + 1] = au * (1.0f / 127.0f); }
            const float ai_ = __uint_as_float(__hip_atomic_load((unsigned*)(ctl + CW_WAMAX + 192), __ATOMIC_RELAXED, __HIP_MEMORY_SCOPE_AGENT));
            if (gw == 0 && lane == 0) RSC[MALL + 3] = ai_ * (1.0f / 127.0f);
            for (int it = gw; it < 16 * 64; it += NGW) { const int kb = it / 64, nb = it % 64; transpose_item_i8(args.in[8], 1024, 2048, WIN, 64 * kb, 32 * nb, 32 * nb, 127.0f / ai_, scr, lane); }
            const float aq = __uint_as_float(__hip_atomic_load((unsigned*)(ctl + CW_WAMAX + 128), __ATOMIC_RELAXED, __HIP_MEMORY_SCOPE_AGENT));
            if (gw == 0 && lane == 0) RSC[MALL + 2] = aq * (1.0f / 127.0f);
            for (int it = gw; it < 16 * 48; it += NGW) { const int kb = it / 48, nb = it % 48; transpose_item_i8(args.in[14], 1024, NQKV, WQKV, 64 * kb, 32 * nb, 32 * nb, 127.0f / aq, scr, lane); }
            for (int it = gw; it < 2 * 16 * 112; it += NGW) { const int up = it / (16 * 112), q = it % (16 * 112), kb = q / 112, nb = q % 112, n0 = 32 * nb;
                transpose_item_i8(args.in[17 + up], 1024, DFF, WGU, 64 * kb, n0, 256 * (n0 >> 7) + 128 * up + (n0 & 127), 127.0f / (up ? au : ag), scr, lane); }
        }
        norm_rows<false>(I_X, I_CTX, MALL, I_NORMG + 0 * 1024, MOD, 0, 1, XN, gw, NGW, lane, nullptr, 0, nullptr, nullptr, RSC); if (BOTH(1)) GRID_BAR(); PROBE_MARK(1); }
    if (IN(2)) {
        pg8::DenseSched S{(const char*)WIN, (const char*)XN8, 8, NPA, G, bx, (size_t)256 * 1024};
        pg8::EpiGeluT E{UVT, STATS, RSC, RSC + MALL + 3};
        pg8::gemm_phase<pg8::EpiGeluT, pg8::DenseSched, true, false, false, true>(lds, gtab, 512, 8, S, E);
        moe_convert_tail(8 * NPA, G, bx, 0, MOE_TAIL_A, args.in[21], args.in[22], args.in[23], MGU, MD, lds);
        if (BOTH(2)) GRID_BAR(); PROBE_MARK(2);
    }
    if (IN(3)) {
        PHASE_IDS();
        const float* vg = args.in[9]; const float* vb = args.in[10]; const float* bs = args.in[12];
        LAS unsigned char* buf = lds + wave * 16384;
        LAS float* mu_l = (LAS float*)(lds + RING_BYTES + 4096 + wave * 1024); LAS float* rs_l = mu_l + 128;
        const int r32 = lane & 31, h = lane >> 5;
        for (int unit = gw; unit < (MALL / 128) * 32; unit += NGW) {
            const int ph = unit & 1, g = (unit >> 1) & 15, ch = unit >> 5, q0 = ch * 128;
#pragma unroll
            for (int tt = 0; tt < 2; ++tt) { const int tok = q0 + lane * 2 + tt; const f32x4* sp = (const f32x4*)(STATS + (size_t)tok * 16);
                const f32x4 a = sp[0], b = sp[1], c = sp[2], d = sp[3];
                const float sum = (a.x + a.z) + (b.x + b.z) + (c.x + c.z) + (d.x + d.z), sq = (a.y + a.w) + (b.y + b.w) + (c.y + c.w) + (d.y + d.w);
                const float mean = sum * (1.0f / 1024.0f), var = sq * (1.0f / 1024.0f) - mean * mean;
                mu_l[lane * 2 + tt] = mean; rs_l[lane * 2 + tt] = 1.0f / __builtin_sqrtf(var + EPS); }
            {
                u32x4 t[16]; const int rw = lane >> 4, ck = lane & 15;
                const bf16_t* vp = UVT + (size_t)(1024 + 64 * g + rw) * MALL + q0 + ck * 8;
#pragma unroll
                for (int i = 0; i < 16; ++i) { t[i] = *(const u32x4*)vp; vp += (size_t)4 * MALL; asm volatile("" : "+v"(vp)); }
#pragma unroll
                for (int i = 0; i < 16; ++i) { const int row = 4 * i + rw; *(LAS u32x4*)(buf + row * 256 + ((ck ^ (row & 15)) << 4)) = t[i]; }
            }
            bf16x8 af[2][8];
#pragma unroll
            for (int ct = 0; ct < 2; ++ct) { const int row = 32 * ct + r32; const float vgc = vg[64 * g + row], vbc = vb[64 * g + row];
#pragma unroll
                for (int s2 = 0; s2 < 8; ++s2) { const int qs = 16 * s2 + 8 * h, ck = 2 * s2 + h;
                    const f32x4 m0 = *(const LAS f32x4*)(mu_l + qs), m1 = *(const LAS f32x4*)(mu_l + qs + 4), r0 = *(const LAS f32x4*)(rs_l + qs), r1 = *(const LAS f32x4*)(rs_l + qs + 4);
                    const bf16x8 raw = *(const LAS bf16x8*)(buf + row * 256 + ((ck ^ (row & 15)) << 4));
                    float y[8];
#pragma unroll
                    for (int j = 0; j < 4; ++j) { y[j] = (bf2f((unsigned short)raw[j]) - m0[j]) * r0[j] * vgc + vbc; y[4 + j] = (bf2f((unsigned short)raw[4 + j]) - m1[j]) * r1[j] * vgc + vbc; }
                    u32x4 w; w.x = pkbf(y[0], y[1]); w.y = pkbf(y[2], y[3]); w.z = pkbf(y[4], y[5]); w.w = pkbf(y[6], y[7]); af[ct][s2] = __builtin_bit_cast(bf16x8, w); } }
            {
                u32x4 t[8]; const int rw = lane >> 3, ck = lane & 7;
                const bf16_t* up = UVT + (size_t)(64 * g + rw) * MALL + q0 + 64 * ph + ck * 8;
#pragma unroll
                for (int i = 0; i < 8; ++i) { t[i] = *(const u32x4*)up; up += (size_t)8 * MALL; asm volatile("" : "+v"(up)); }
#pragma unroll
                for (int i = 0; i < 8; ++i) { const int row = 8 * i + rw; *(LAS u32x4*)(buf + row * 128 + ((ck ^ (row & 7)) << 4)) = t[i]; }
            }
#pragma unroll
            for (int ptl = 0; ptl < 2; ++ptl) {
                const int pl = 32 * ptl + r32, p = 64 * ph + pl; const float bsv = bs[g * 128 + p];
                bf16x8 bfr[8];
#pragma unroll
                for (int s2 = 0; s2 < 8; ++s2) bfr[s2] = *(const bf16x8*)(WSB + (size_t)(g * 128 + p) * 128 + 16 * s2 + 8 * h);
                f32x16 acc[2]; acc[0] = f32x16{}; acc[1] = f32x16{};
#pragma unroll
                for (int s2 = 0; s2 < 8; ++s2)
#pragma unroll
                    for (int ct = 0; ct < 2; ++ct) acc[ct] = __builtin_amdgcn_mfma_f32_32x32x16_bf16(af[ct][s2], bfr[s2], acc[ct], 0, 0, 0);
#pragma unroll
                for (int ct = 0; ct < 2; ++ct)
#pragma unroll
                    for (int rr = 0; rr < 4; ++rr) { const int c = 32 * ct + 8 * rr + 4 * h; float o[4];
#pragma unroll
                        for (int e = 0; e < 4; ++e) { const int cc = c + e; const float uu = bf2f(*(const LAS unsigned short*)(buf + cc * 128 + (((pl >> 3) ^ (cc & 7)) << 4) + (pl & 7) * 2)); o[e] = uu * (acc[ct][4 * rr + e] + bsv); }
                        u32x2 w; w.x = pkbf(o[0], o[1]); w.y = pkbf(o[2], o[3]);
                        *(LAS u32x2*)(buf + 8192 + pl * 128 + (((c >> 3) ^ (pl & 7)) << 4) + (c & 7) * 2) = w; }
            }
            {
                const int rw = lane >> 3, ck = lane & 7;
#pragma unroll
                for (int i = 0; i < 8; ++i) { const int row = 8 * i + rw; const u32x4 v = *(const LAS u32x4*)(buf + 8192 + row * 128 + ((ck ^ (row & 7)) << 4));
                    *(u32x4*)(A2 + (size_t)(q0 + 64 * ph + row) * DM + 64 * g + ck * 8) = v; }
            }
        }
        if (BOTH(3)) GRID_BAR(); PROBE_MARK(3);
    }
    if (IN(4)) {
        { pg8::DenseSched S{(const char*)A2, (const char*)WAO, NPL, 4, G, bx, (size_t)256 * 1024 * 2};
          pg8::EpiResid<true> E{I_X, nullptr, HL, MOD + 2 * 1024};
          pg8::gemm_phase<pg8::EpiResid<true>, pg8::DenseSched, true, false>(lds, gtab, 1024, 16, S, E); }
        { pg8::SplitSched S{(const char*)(A2 + (size_t)NLAT * DM), (const char*)WAO, 4, 4, P3_NS, G, bx, NPL, (size_t)256 * 1024 * 2, (size_t)(1024 / P3_NS) * 2};
          pg8::EpiPartF32 E{PART1, (size_t)NCTXR * DM};
          pg8::gemm_phase<pg8::EpiPartF32, pg8::SplitSched, true, false>(lds, gtab, 1024, 1024 / P3_NS / 64, S, E); }
        if (BOTH(4)) GRID_BAR(); PROBE_MARK(4);
    }
    if (IN(5)) { PHASE_IDS(); norm_rows<true>(HL, I_CTX, MALL, I_NORMG + 1 * 1024, MOD, 3, 4, XN, gw, NGW, lane, PART1, P3_NS, MOD + 4 * 6144 + 2 * 1024, ZB, RSC); if (BOTH(5)) GRID_BAR(); PROBE_MARK(5); }
    if (IN(6)) {
        pg8::DenseSched S{(const char*)XN8, (const char*)WGU, NPA, 28, G, bx, (size_t)256 * 1024};
        pg8::EpiSwiGLUI8 E{HB, RSC, RSC + MALL};
        pg8::gemm_phase<pg8::EpiSwiGLUI8, pg8::DenseSched, true, false, false, true>(lds, gtab, 512, 8, S, E);
        moe_convert_tail(NPA * 28, G, bx, MOE_TAIL_A, MOE_TAIL_B, args.in[21], args.in[22], args.in[23], MGU, MD, lds);
        if (BOTH(6)) GRID_BAR(); PROBE_MARK(6);
    }
    if (IN(7)) {
        { pg8::DenseSched S{(const char*)HB, (const char*)WD, NPL, 4, G, bx, (size_t)256 * DFF * 2};
          pg8::EpiResid<false> E{nullptr, HL, HL, MOD + 5 * 1024};
          pg8::gemm_phase<pg8::EpiResid<false>, pg8::DenseSched, true, false>(lds, gtab, DFF, 56, S, E); }
        { pg8::SplitSched S{(const char*)(HB + (size_t)NLAT * DFF), (const char*)WD, 4, 4, P5_NS, G, bx, NPL, (size_t)256 * DFF * 2, (size_t)(DFF / P5_NS) * 2};
          pg8::EpiPartF32 E{PART2, (size_t)NCTXR * DM};
          pg8::gemm_phase<pg8::EpiPartF32, pg8::SplitSched, true, false>(lds, gtab, DFF, DFF / P5_NS / 64, S, E); }
        if (BOTH(7)) GRID_BAR(); PROBE_MARK(7);
    }
    if (IN(8)) { PHASE_IDS(); norm_rows<true>(HL, ZB, MALL, I_NORMG + 2 * 1024, MOD + 5 * 6144, 0, 1, XN, gw, NGW, lane, PART2, P5_NS, MOD + 4 * 6144 + 5 * 1024, nullptr, RSC); if (BOTH(8)) GRID_BAR(); PROBE_MARK(8); }
    if (IN(9)) {
        pg8::DenseSched S{(const char*)XN8, (const char*)WQKV, NPA, 6, G, bx, (size_t)256 * 1024};
        pg8::EpiQKV E{QKV, ROPE, ROPE + 2048, attn_body::C2, RSC, RSC + MALL + 2};
        pg8::gemm_phase<pg8::EpiQKV, pg8::DenseSched, true, false, false, true>(lds, gtab, 512, 8, S, E);
        moe_convert_tail(NPA * 6, G, bx, MOE_TAIL_A + MOE_TAIL_B, MOE_TAIL_C, args.in[21], args.in[22], args.in[23], MGU, MD, lds);
        if (BOTH(9)) GRID_BAR(); PROBE_MARK(9);
    }
    if (IN(10)) {
        static_assert(attn_body::LDS_BYTES_A <= RING_BYTES, "attention LDS");
        const float* sinkp = args.in[15];
        int sb = 0; bool pre = false; bf16x8 qfr[4];
#pragma unroll
        for (int d0 = 0; d0 < 4; ++d0) qfr[d0] = bf16x8{};
        for (int i = 0;; ++i) { const int uid = i * G + vcu; if (uid >= NB * 64 * 4 * 2) break;
            const int pr = uid & 1, hk = (uid >> 1) & 3, n = (uid >> 3) & 63, b = uid >> 9;
            const int uid2 = uid + G; const bool has_next = uid2 < NB * 64 * 4 * 2;
            sb = attn_body::attn_unit<8>(b, hk, n, pr, (const attn_body::bf16*)QKV, (attn_body::bf16*)OB, sinkp, (char*)lds_raw, sb, pre, has_next, uid2 >> 9, (uid2 >> 1) & 3, (uid2 >> 3) & 63, uid2 & 1, qfr);
            pre = has_next; }
        if (BOTH(10)) GRID_BAR(); PROBE_MARK(10);
    }
    if (IN(11)) {
        pg8::DenseSched S{(const char*)OB, (const char*)WBO, NPL, 4, G, bx, (size_t)256 * 1024 * 2};
        pg8::EpiResid<false> E{nullptr, HL, HL, MOD + 5 * 6144 + 2 * 1024};
        pg8::gemm_phase<pg8::EpiResid<false>, pg8::DenseSched, true, false>(lds, gtab, 1024, 16, S, E);
        if (BOTH(11)) GRID_BAR(); PROBE_MARK(11);
    }
    if (IN(12)) {
        PHASE_IDS();
        const float* g = I_NORMG + 3 * 1024; const float* mod = MOD + 5 * 6144; const float* wrt = args.in[20];
        LAS int* l_e = (LAS int*)lds;
        LAS float* l_w = (LAS float*)(lds + 1024);
        LAS int* l_cnt = (LAS int*)(lds + 2048);
        LAS int* l_base = (LAS int*)(lds + 2048 + 64);
        for (int blk = bx; blk < NLAT / 128; blk += G) {
            if (tid < 8) l_cnt[tid] = 0;
            __syncthreads();
            const int mb = (blk * 128) >> 13; const float* mrow = mod + (size_t)mb * 6144;
            for (int i4 = 0; i4 < 8; ++i4) {
                const int tl0 = wave * 16 + i4 * 2, m0 = blk * 128 + tl0;
                const GAS u32x2* xr = (const GAS u32x2*)(HL + (size_t)m0 * DM) + lane;
                f32x4 v[2][4]; float ss[2];
#pragma unroll
                for (int r = 0; r < 2; ++r)
#pragma unroll
                    for (int j = 0; j < 4; ++j) { const u32x2 w = xr[r * 256 + 64 * j]; v[r][j] = (f32x4){__uint_as_float(w.x << 16), __uint_as_float(w.x & 0xffff0000u), __uint_as_float(w.y << 16), __uint_as_float(w.y & 0xffff0000u)}; }
#pragma unroll
                for (int r = 0; r < 2; ++r) { ss[r] = 0.f;
#pragma unroll
                    for (int j = 0; j < 4; ++j) ss[r] += (v[r][j].x * v[r][j].x + v[r][j].y * v[r][j].y) + (v[r][j].z * v[r][j].z + v[r][j].w * v[r][j].w); }
#pragma unroll
                for (int o = 1; o < 64; o <<= 1) {
#pragma unroll
                    for (int r = 0; r < 2; ++r) ss[r] += __shfl_xor(ss[r], o); }
                float lg[2][8];
#pragma unroll
                for (int r = 0; r < 2; ++r)
#pragma unroll
                    for (int e = 0; e < 8; ++e) lg[r][e] = 0.f;
#pragma unroll
                for (int j = 0; j < 4; ++j) { const int col = 4 * lane + 256 * j; const f32x4 gv = *(const f32x4*)(g + col), sc = *(const f32x4*)(mrow + 4 * 1024 + col), sh = *(const f32x4*)(mrow + 3 * 1024 + col);
                    const f32x4 gm = gv * (sc + 1.0f);
                    f32x4 y[2];
#pragma unroll
                    for (int r = 0; r < 2; ++r) { const float rstd = 1.0f / __builtin_sqrtf(ss[r] * (1.0f / DM) + EPS); y[r] = (v[r][j] * rstd) * gm + sh;
                        *((GAS unsigned*)(XN8 + (size_t)(m0 + r) * DM) + lane + 64 * j) = pk4f8(y[r].x, y[r].y, y[r].z, y[r].w); }
#pragma unroll
                    for (int cc = 0; cc < 4; ++cc) { const f32x4 w0 = *(const f32x4*)(wrt + (size_t)(col + cc) * 8), w1 = *(const f32x4*)(wrt + (size_t)(col + cc) * 8 + 4);
#pragma unroll
                        for (int r = 0; r < 2; ++r) { const float yv = y[r][cc];
                            lg[r][0] += yv * w0.x; lg[r][1] += yv * w0.y; lg[r][2] += yv * w0.z; lg[r][3] += yv * w0.w; lg[r][4] += yv * w1.x; lg[r][5] += yv * w1.y; lg[r][6] += yv * w1.z; lg[r][7] += yv * w1.w; } } }
#pragma unroll
                for (int o = 1; o < 64; o <<= 1) {
#pragma unroll
                    for (int r = 0; r < 2; ++r)
#pragma unroll
                        for (int e = 0; e < 8; ++e) lg[r][e] += __shfl_xor(lg[r][e], o); }
#pragma unroll
                for (int r = 0; r < 2; ++r) {
                    int ea = 0; float va = lg[r][0];
#pragma unroll
                    for (int e = 1; e < 8; ++e) if (lg[r][e] > va) { va = lg[r][e]; ea = e; }
                    int eb = -1; float vb2 = -INFINITY;
#pragma unroll
                    for (int e = 0; e < 8; ++e) if (e != ea && lg[r][e] > vb2) { vb2 = lg[r][e]; eb = e; }
                    const float wb = 1.0f / (1.0f + __expf(va - vb2)), wa = 1.0f - wb;
                    if (lane == 0) { const int tl = tl0 + r; l_e[tl * 2] = ea; l_e[tl * 2 + 1] = eb; l_w[tl * 2] = wa; l_w[tl * 2 + 1] = wb; } }
            }
            __syncthreads();
            int ea = 0, eb = 0, pa = 0, pb = 0;
            if (tid < 128) { ea = l_e[tid * 2]; eb = l_e[tid * 2 + 1]; pa = atomicAdd((int*)&l_cnt[ea], 1); pb = atomicAdd((int*)&l_cnt[eb], 1); }
            __syncthreads();
            if (tid < 8) l_base[tid] = (int)__hip_atomic_fetch_add((unsigned*)(ctl + CW_CNT + 64 * tid), (unsigned)l_cnt[tid], __ATOMIC_RELAXED, __HIP_MEMORY_SCOPE_AGENT);
            __syncthreads();
            if (tid < 128) { const int m = blk * 128 + tid; pa += l_base[ea]; pb += l_base[eb];
                LIST[(size_t)ea * NLAT + pa] = m; LIST[(size_t)eb * NLAT + pb] = m;
                int* ti = TINFO + (size_t)m * 8; ti[0] = ea; ti[1] = pa; ti[2] = eb; ti[3] = pb; ti[4] = __float_as_int(l_w[tid * 2]); ti[5] = __float_as_int(l_w[tid * 2 + 1]); }
            __syncthreads();
        }
        if (BOTH(12)) GRID_BAR(); PROBE_MARK(12);
    }
    if (hi_ph > 13 && lo < 17) {
        PHASE_IDS();
        LAS int* mtab = (LAS int*)(lds + MOE_OFF);
        if (tid == 0) { int run = 0, R = 0;
            for (int e = 0; e < 8; ++e) { const int ce = (int)__hip_atomic_load((unsigned*)(ctl + CW_CNT + 64 * e), __ATOMIC_RELAXED, __HIP_MEMORY_SCOPE_AGENT); mtab[e] = run; mtab[16 + e] = ce; run += ce >> 8; if (ce & 255) { mtab[24 + R] = e; ++R; } }
            mtab[8] = run; mtab[32] = R; }
        __syncthreads();
        const int nfull = __builtin_amdgcn_readfirstlane(mtab[8]);
        for (int c = 0; c < MOE_NCH; ++c) {
            const int gp0 = c * MOE_CH, gp1 = nfull < (c + 1) * MOE_CH ? nfull : (c + 1) * MOE_CH;
            if (IN(13 + 2 * c)) {
                { pg8::MoeSched S; S.A = (const char*)XN8; S.B = (const char*)MGU; S.list = LIST; S.tab = mtab; S.mode = 0; S.nS = 1; S.kbytes = 0; S.omoff = 0;
                  S.gp0 = gp0; S.gp1 = gp1; S.nN = 28; S.G = G; S.c = bx; S.bexp = (size_t)7168 * 1024; S.btile = (size_t)256 * 1024; S.astep = 0; S.gather = true;
                  pg8::EpiSwiGLU8 E{HC, 1.0f / MOE_SGU};
                  pg8::gemm_phase<pg8::EpiSwiGLU8, pg8::MoeSched, true, true, true>(lds, gtab, 512, 8, S, E); }
                if (c == 0) { pg8::MoeSched S; S.A = (const char*)XN8; S.B = (const char*)MGU; S.list = LIST; S.tab = mtab; S.mode = 1; S.nS = 1; S.kbytes = 0; S.omoff = MOE_CH;
                  S.gp0 = 0; S.gp1 = 0; S.nN = 28; S.G = G; S.c = bx; S.bexp = (size_t)7168 * 1024; S.btile = (size_t)256 * 1024; S.astep = 0; S.gather = true;
                  pg8::EpiSwiGLU8 E{HC, 1.0f / MOE_SGU};
                  pg8::gemm_phase<pg8::EpiSwiGLU8, pg8::MoeSched, true, true, true>(lds, gtab, 512, 8, S, E); }
                if (BOTH(13 + 2 * c)) GRID_BAR(); PROBE_MARK(13 + 2 * c);
            }
            if (IN(14 + 2 * c)) {
                { pg8::MoeSched S; S.A = (const char*)HC; S.B = (const char*)MD; S.list = LIST; S.tab = mtab; S.mode = 0; S.nS = 1; S.kbytes = 0; S.omoff = 0;
                  S.gp0 = gp0; S.gp1 = gp1; S.nN = 4; S.G = G; S.c = bx; S.bexp = (size_t)1024 * DFF; S.btile = (size_t)256 * DFF; S.astep = (size_t)256 * DFF; S.gather = false;
                  pg8::EpiBf16Plain E{YB, DM, 1.0f / MOE_SD};
                  pg8::gemm_phase<pg8::EpiBf16Plain, pg8::MoeSched, true, false, true>(lds, gtab, DFF / 2, 28, S, E); }
                if (c == 0) { pg8::MoeSched S; S.A = (const char*)(HC + (size_t)MOE_CH * 256 * DFF); S.B = (const char*)MD; S.list = LIST; S.tab = mtab; S.mode = 2; S.nS = MOE_RS; S.kbytes = (size_t)(DFF / MOE_RS); S.omoff = 0;
                  S.gp0 = 0; S.gp1 = 0; S.nN = 4; S.G = G; S.c = bx; S.bexp = (size_t)1024 * DFF; S.btile = (size_t)256 * DFF; S.astep = (size_t)256 * DFF; S.gather = false;
                  pg8::EpiPartBf16 E{YP, (size_t)8 * 256 * DM, 1.0f / MOE_SD};
                  pg8::gemm_phase<pg8::EpiPartBf16, pg8::MoeSched, true, false, true>(lds, gtab, DFF / 2, DFF / MOE_RS / 128, S, E); }
                if (BOTH(14 + 2 * c)) GRID_BAR(); PROBE_MARK(14 + 2 * c);
            }
        }
    }
    if (IN(17)) {
        PHASE_IDS();
        LAS int* l_pb = (LAS int*)(lds + wave * 128);
        if (lane == 0) { int run = 0, R = 0;
            for (int e = 0; e < 8; ++e) { const int ce = (int)__hip_atomic_load((unsigned*)(ctl + CW_CNT + 64 * e), __ATOMIC_RELAXED, __HIP_MEMORY_SCOPE_AGENT); l_pb[e] = run; l_pb[8 + e] = ce >> 8; l_pb[16 + e] = R; run += ce >> 8; if (ce & 255) ++R; } }
        const float* g2 = MOD + 5 * 6144 + 5 * 1024;
        for (int m0 = gw * 2; m0 < NLAT; m0 += NGW * 2) {
            const int mb = m0 >> 13;
            f32x4 hv[2][4], ya[2][4], yb[2][4]; float wa[2], wb[2];
#pragma unroll
            for (int r = 0; r < 2; ++r) {
                const int m = m0 + r; const int* ti = TINFO + (size_t)m * 8;
                const int ea = ti[0], pa = ti[1], eb = ti[2], pb = ti[3]; wa[r] = __int_as_float(ti[4]); wb[r] = __int_as_float(ti[5]);
                const bool ma = (pa >> 8) < l_pb[8 + ea], mbm = (pb >> 8) < l_pb[8 + eb];
                const size_t sa = ma ? (size_t)(l_pb[ea] + (pa >> 8)) * 256 + (pa & 255) : (size_t)l_pb[16 + ea] * 256 + (pa & 255);
                const size_t sb = mbm ? (size_t)(l_pb[eb] + (pb >> 8)) * 256 + (pb & 255) : (size_t)l_pb[16 + eb] * 256 + (pb & 255);
                const GAS u32x2* xr = (const GAS u32x2*)(HL + (size_t)m * DM) + lane;
#pragma unroll
                for (int j = 0; j < 4; ++j) { const u32x2 w = xr[64 * j]; hv[r][j] = (f32x4){__uint_as_float(w.x << 16), __uint_as_float(w.x & 0xffff0000u), __uint_as_float(w.y << 16), __uint_as_float(w.y & 0xffff0000u)}; }
                { const GAS u32x2* yr = (const GAS u32x2*)((ma ? YB : YP) + sa * DM) + lane;
#pragma unroll
                  for (int j = 0; j < 4; ++j) { const u32x2 a = yr[64 * j]; ya[r][j] = (f32x4){__uint_as_float(a.x << 16), __uint_as_float(a.x & 0xffff0000u), __uint_as_float(a.y << 16), __uint_as_float(a.y & 0xffff0000u)}; }
                  if (!ma) for (int s2 = 1; s2 < MOE_RS; ++s2) { const GAS u32x2* y2 = (const GAS u32x2*)(YP + ((size_t)s2 * 8 * 256 + sa) * DM) + lane;
#pragma unroll
                      for (int j = 0; j < 4; ++j) { const u32x2 a = y2[64 * j]; ya[r][j] += (f32x4){__uint_as_float(a.x << 16), __uint_as_float(a.x & 0xffff0000u), __uint_as_float(a.y << 16), __uint_as_float(a.y & 0xffff0000u)}; } } }
                { const GAS u32x2* yr = (const GAS u32x2*)((mbm ? YB : YP) + sb * DM) + lane;
#pragma unroll
                  for (int j = 0; j < 4; ++j) { const u32x2 a = yr[64 * j]; yb[r][j] = (f32x4){__uint_as_float(a.x << 16), __uint_as_float(a.x & 0xffff0000u), __uint_as_float(a.y << 16), __uint_as_float(a.y & 0xffff0000u)}; }
                  if (!mbm) for (int s2 = 1; s2 < MOE_RS; ++s2) { const GAS u32x2* y2 = (const GAS u32x2*)(YP + ((size_t)s2 * 8 * 256 + sb) * DM) + lane;
#pragma unroll
                      for (int j = 0; j < 4; ++j) { const u32x2 a = y2[64 * j]; yb[r][j] += (f32x4){__uint_as_float(a.x << 16), __uint_as_float(a.x & 0xffff0000u), __uint_as_float(a.y << 16), __uint_as_float(a.y & 0xffff0000u)}; } } }
            }
            float ss[2];
#pragma unroll
            for (int r = 0; r < 2; ++r) { ss[r] = 0.f;
#pragma unroll
                for (int j = 0; j < 4; ++j) { const f32x4 gv = *(const f32x4*)(g2 + (size_t)mb * 6144 + 4 * lane + 256 * j);
                    hv[r][j] = hv[r][j] + gv * (ya[r][j] * wa[r] + yb[r][j] * wb[r]); ss[r] += (hv[r][j].x * hv[r][j].x + hv[r][j].y * hv[r][j].y) + (hv[r][j].z * hv[r][j].z + hv[r][j].w * hv[r][j].w); } }
#pragma unroll
            for (int o = 1; o < 64; o <<= 1) {
#pragma unroll
                for (int r = 0; r < 2; ++r) ss[r] += __shfl_xor(ss[r], o); }
#pragma unroll
            for (int r = 0; r < 2; ++r) { const float rstd = 1.0f / __builtin_sqrtf(ss[r] * (1.0f / DM) + EPS);
                GAS f32x4* orow = (GAS f32x4*)(args.out + (size_t)(m0 + r) * DM) + lane;
#pragma unroll
                for (int j = 0; j < 4; ++j) { const f32x4 fg = *(const f32x4*)(I_FINALG + 4 * lane + 256 * j); __builtin_nontemporal_store((hv[r][j] * rstd) * fg, orow + 64 * j); } }
        }
    }
    PROBE_MARK(17);
#if defined(PROBE_LO)
    { PHASE_IDS(); const float T = (float)(tpB - tpA) * 0.01f; const float cval = __builtin_sqrtf(T / (float)(PROBE_UNIT));
      for (int m = gw; m < NLAT; m += NGW) { GAS f32x4* orow = (GAS f32x4*)(args.out + (size_t)m * DM) + lane;
#pragma unroll
        for (int j = 0; j < 4; ++j) orow[64 * j] = (f32x4){cval, cval, cval, cval}; } }
#endif
#undef IN
#undef BOTH
#undef GRID_BAR
}

#ifndef MK_ONE_LAUNCH
#define MK_ONE_LAUNCH 1
#endif
extern "C" void kernel_launch(void* const* d_in, const int* in_sizes, int n_in, void* d_out, int out_size, void* d_ws, size_t ws_size, hipStream_t stream) {
    static int grid = 0;
    if (grid == 0) {
        if (n_in != 24 || out_size != NLAT * DM || ws_size < WS_END) { fprintf(stderr, "kernel_launch: unexpected problem (n_in %d, out %d, ws %zu < %zu)\n", n_in, out_size, ws_size, (size_t)WS_END); grid = -1; return; }
        int dev = 0, cus = 0, per_cu = 0;
        if (hipGetDevice(&dev) != hipSuccess || hipDeviceGetAttribute(&cus, hipDeviceAttributeMultiprocessorCount, dev) != hipSuccess) { grid = -1; return; }
        if (hipFuncSetAttribute((const void*)fwd, hipFuncAttributeMaxDynamicSharedMemorySize, LDS_BYTES) != hipSuccess) { fprintf(stderr, "kernel_launch: hipFuncSetAttribute failed\n"); grid = -1; return; }
        if (hipOccupancyMaxActiveBlocksPerMultiprocessor(&per_cu, (const void*)fwd, 512, LDS_BYTES) != hipSuccess || per_cu < 1) fprintf(stderr, "kernel_launch: occupancy query says %d\n", per_cu);
        (void)hipGetLastError();
        grid = cus;
    }
    if (grid < 0) return;
    if (hipMemsetAsync((char*)d_ws + WS_CTL, 0, CTL_ZERO_BYTES, stream) != hipSuccess) return;
    Args a{};
    for (int i = 0; i < 24; ++i) a.in[i] = (const float*)d_in[i];
    a.out = (float*)d_out; a.ws = (unsigned char*)d_ws;
#if defined(SPLITAT)
    a.ph_lo = 0; a.ph_hi = SPLITAT; a.li = 0;
    hipLaunchKernelGGL(fwd, dim3(grid), dim3(512), LDS_BYTES, stream, a);
    a.ph_lo = SPLITAT; a.ph_hi = NPH; a.li = 1;
    hipLaunchKernelGGL(fwd, dim3(grid), dim3(512), LDS_BYTES, stream, a);
#elif defined(DUPK)
    a.ph_lo = 0; a.ph_hi = DUPK + 1; a.li = 0;
    hipLaunchKernelGGL(fwd, dim3(grid), dim3(512), LDS_BYTES, stream, a);
#ifdef DUPN
    for (int rep = 0; rep < DUPN; ++rep) { a.ph_lo = DUPK; a.ph_hi = DUPK + 1; a.li = 2; hipLaunchKernelGGL(fwd, dim3(grid), dim3(512), LDS_BYTES, stream, a); }
#endif
    a.ph_lo = DUPK; a.ph_hi = NPH; a.li = 1;
    hipLaunchKernelGGL(fwd, dim3(grid), dim3(512), LDS_BYTES, stream, a);
#elif MK_ONE_LAUNCH
    a.ph_lo = 0; a.ph_hi = NPH;
    hipLaunchKernelGGL(fwd, dim3(grid), dim3(512), LDS_BYTES, stream, a);
#else
    for (int p = 0; p < NPH; ++p) { a.ph_lo = p; a.ph_hi = p + 1; hipLaunchKernelGGL(fwd, dim3(grid), dim3(512), LDS_BYTES, stream, a); }
#endif
}
```

```cpp
#include <hip/hip_runtime.h>
#include <hip/hip_bf16.h>
#include <cstdio>
#include <cstdint>
#include <cmath>

constexpr int DM = 1024, NB = 4, SEQ = 8192, LCTX = 256, NLAT = NB * SEQ, NCTXR = NB * LCTX, MALL = NLAT + NCTXR;
constexpr int DFF = 3584, NEXP = 8, NQKV = 1536;
constexpr int NPL = NLAT / 256, NPA = MALL / 256;
constexpr float EPS = 1e-6f;
constexpr int MOE_CH = 128, MOE_NCH = 2;
constexpr float MOE_SGU = 32.0f, MOE_SD = 64.0f;
constexpr int MOE_RS = 7, P3_NS = 8, P5_NS = 14;

#define LAS __attribute__((address_space(3)))
#define GAS __attribute__((address_space(1)))
typedef unsigned short bf16_t;
typedef short bf16x8 __attribute__((ext_vector_type(8)));
typedef float f32x4 __attribute__((ext_vector_type(4)));
typedef float f32x2 __attribute__((ext_vector_type(2)));
typedef float f32x16 __attribute__((ext_vector_type(16)));
typedef unsigned u32x4 __attribute__((ext_vector_type(4)));
typedef unsigned u32x2 __attribute__((ext_vector_type(2)));
typedef __bf16 bf16x2_t __attribute__((ext_vector_type(2)));
typedef GAS unsigned gu32;

__device__ __forceinline__ unsigned pkbf(float lo, float hi) { f32x2 v = {lo, hi}; bf16x2_t b = __builtin_convertvector(v, bf16x2_t); return __builtin_bit_cast(unsigned, b); }
__device__ __forceinline__ unsigned pk4f8(float a, float b, float c, float d) { unsigned w = 0; w = __builtin_amdgcn_cvt_pk_fp8_f32(a, b, w, false); w = __builtin_amdgcn_cvt_pk_fp8_f32(c, d, w, true); return w; }
__device__ __forceinline__ float bf2f(unsigned short h) { return __builtin_bit_cast(float, (unsigned)h << 16); }
__device__ __forceinline__ float wave_sum(float v) {
#pragma unroll
    for (int o = 1; o < 64; o <<= 1) v += __shfl_xor(v, o);
    return v;
}
__device__ __forceinline__ float gelu_tanh(float x) {
    const float t = x * (1.0f + 0.044715f * x * x);
    const float e = __builtin_amdgcn_exp2f(-2.302208198f * t);
    return x * __builtin_amdgcn_rcpf(1.0f + e);
}
__device__ __forceinline__ float silu_f(float x) { return x * __builtin_amdgcn_rcpf(1.0f + __builtin_amdgcn_exp2f(-1.4426950409f * x)); }

constexpr size_t MiB = 1u << 20;
constexpr size_t WS_CTL = 0, CTL_ZERO_BYTES = 1 * MiB;
constexpr size_t WS_MOD = 1 * MiB;
constexpr size_t WS_ROPE = 1 * MiB + 256 * 1024;
constexpr size_t WS_STATS = 2 * MiB;
constexpr size_t WS_RSC = 4 * MiB + 512 * 1024;
constexpr size_t WS_LIST = 5 * MiB;
constexpr size_t WS_TINFO = 6 * MiB;
constexpr size_t WS_WS = 7 * MiB;
constexpr size_t WS_WIN = 8 * MiB, WS_WAO = 12 * MiB, WS_WQKV = 14 * MiB, WS_WBO = 17 * MiB, WS_WGU = 19 * MiB, WS_WD = 33 * MiB;
constexpr size_t WS_MGU = 40 * MiB, WS_MD = 96 * MiB;
constexpr size_t WS_HLB = 124 * MiB;
constexpr size_t WS_XN = 208 * MiB;
constexpr size_t WS_ZB = 274 * MiB;
constexpr size_t WS_R = 278 * MiB;
constexpr size_t WS_UVT = WS_R, WS_A2 = WS_R + 132 * MiB, WS_PART1 = WS_R + 198 * MiB, WS_H = WS_R, WS_PART2 = WS_R + 231 * MiB;
constexpr size_t WS_QKV = WS_R, WS_O = WS_R + 99 * MiB;
constexpr size_t WS_Y = WS_R, WS_YP = WS_R + 128 * MiB, WS_HC = WS_R + 156 * MiB;
constexpr size_t WS_END = WS_R + 287 * MiB;
static_assert(WS_UVT + (size_t)2048 * MALL * 2 <= WS_A2 && WS_A2 + (size_t)MALL * DM * 2 <= WS_PART1 && WS_PART1 + (size_t)P3_NS * NCTXR * DM * 4 <= WS_END, "layer-0 mixer map");
static_assert(WS_H + (size_t)MALL * DFF * 2 <= WS_PART2 && WS_PART2 + (size_t)P5_NS * NCTXR * DM * 4 <= WS_END && WS_QKV + (size_t)MALL * NQKV * 2 <= WS_O && WS_O + (size_t)NLAT * DM * 2 <= WS_END, "region map");
static_assert(WS_Y + (size_t)256 * 256 * DM * 2 <= WS_YP && WS_YP + (size_t)MOE_RS * 8 * 256 * DM * 2 <= WS_HC && WS_HC + (size_t)(MOE_CH + 8) * 256 * DFF <= WS_END, "MoE map");
static_assert(WS_MD + (size_t)8 * DM * DFF <= WS_HLB && WS_HLB + (size_t)NLAT * DM * 2 <= WS_XN && WS_XN + (size_t)MALL * DM * 2 <= WS_ZB && WS_MD + (size_t)8 * DM * DFF <= WS_XN && WS_MGU + (size_t)8 * 7168 * DM <= WS_MD, "weights map");
constexpr int CW_TMO = 0, CW_CODE = 1;
constexpr int CW_CNT = 64;
constexpr int CW_WAMAX = 1024;
constexpr int CW_BAR = 4096;

constexpr int RING_BYTES = 131072;
constexpr int GTAB_OFF = RING_BYTES;
constexpr int MOE_OFF = RING_BYTES + 1024;
constexpr int MISC_OFF = RING_BYTES + 2048;
constexpr int STAB_OFF = RING_BYTES + 3072;
constexpr int LDS_BYTES = 147456;

namespace pg8 {
constexpr int BM = 256, BK = 64, HALF = 128, HTB = HALF * BK * 2, STAGE_BYTES = 8 * HTB, NXCD = 8, WGM = 8;
__host__ __device__ __forceinline__ int lds_byte(int r, int c) { const int st = (r >> 4) * 2 + (c >> 5), rr = r & 15, cc = c & 31, ob = rr * 64 + cc * 2; return st * 1024 + (ob ^ (((ob >> 9) & 1) << 5)); }
__host__ __device__ __forceinline__ void stage_rc(int b, int& R, int& C) { const int st = b / 1024, sb = b % 1024, swz = sb ^ (((sb >> 9) & 1) << 5); R = (st >> 1) * 16 + swz / 64; C = (st & 1) * 32 + (swz % 64) / 2; }
__host__ __device__ __forceinline__ int perm32(int rho) { const int n = rho >> 4, i = rho & 15; return 8 * (i >> 2) + 4 * n + (i & 3); }

struct Unit { const char* a; const char* b; const int* gl; int pm, pn, om, nv, ks; };

__device__ __forceinline__ bool tile_order(int i, int G, int c, int nM, int nN, int& pm, int& pn) {
    const int nwg = nM * nN; const long L = (long)i * G + c; if (L >= nwg) return false;
    int wgid = (int)L; { const int q = nwg / NXCD, r = nwg % NXCD, xcd = wgid % NXCD, off = wgid / NXCD; wgid = (xcd < r ? xcd * (q + 1) : r * (q + 1) + (xcd - r) * q) + off; }
    const int nig = WGM * nN, gid = wgid / nig, fm = gid * WGM, gsz = (nM - fm) < WGM ? (nM - fm) : WGM;
    pm = fm + ((wgid % nig) % gsz); pn = (wgid % nig) / gsz; return true;
}
struct DenseSched {
    const char* A; const char* B; int nM, nN, G, c; size_t tstep;
    __device__ __forceinline__ bool next(int i, Unit& u) const {
        int pm, pn; if (!tile_order(i, G, c, nM, nN, pm, pn)) return false;
        u.a = A + (size_t)pm * tstep; u.b = B + (size_t)pn * tstep; u.gl = nullptr; u.pm = pm; u.pn = pn; u.om = pm; u.nv = 256; u.ks = 0; return true;
    }
};
typedef int v8i_t __attribute__((ext_vector_type(8)));
typedef int v4i_t __attribute__((ext_vector_type(4)));
__device__ __forceinline__ v8i_t cat8(bf16x8 lo, bf16x8 hi) { const v4i_t a = __builtin_bit_cast(v4i_t, lo), b = __builtin_bit_cast(v4i_t, hi); return __builtin_shufflevector(a, b, 0, 1, 2, 3, 4, 5, 6, 7); }
struct SplitSched {
    const char* A; const char* B; int nM, nN, nS, G, c, pm0; size_t tstep, kbytes;
    __device__ __forceinline__ bool next(int i, Unit& u) const {
        const int L = i * G + c; if (L >= nM * nN * nS) return false;
        const int ks = L % nS, t = L / nS, pn = t % nN, pm = t / nN;
        u.a = A + (size_t)pm * tstep + (size_t)ks * kbytes; u.b = B + (size_t)pn * tstep + (size_t)ks * kbytes; u.gl = nullptr; u.pm = pm0 + pm; u.pn = pn; u.om = pm; u.nv = 256; u.ks = ks; return true;
    }
};
struct MoeSched {
    const char* A; const char* B; const int* list; const LAS int* tab; int gp0, gp1, nN, nS, G, c, mode, omoff; size_t bexp, btile, astep, kbytes; bool gather;
    __device__ __forceinline__ bool next(int i, Unit& u) const {
        int pm, pn, ks = 0;
        if (mode == 0) { if (gp1 <= gp0) return false; if (!tile_order(i, G, c, gp1 - gp0, nN, pm, pn)) return false; }
        else { const int R = __builtin_amdgcn_readfirstlane(tab[32]); const int L = i * G + c; if (L >= R * nN * nS) return false; ks = L % nS; const int t = L / nS; pn = t % nN; pm = t / nN; }
        int e = 0, lp, nv;
        if (mode == 0) { const int gp = gp0 + pm;
#pragma unroll
            for (int k = 1; k < 8; ++k) e += (gp >= __builtin_amdgcn_readfirstlane(tab[k])) ? 1 : 0;
            lp = gp - __builtin_amdgcn_readfirstlane(tab[e]); nv = 256; u.pm = gp; }
        else { e = __builtin_amdgcn_readfirstlane(tab[24 + pm]); const int ce = __builtin_amdgcn_readfirstlane(tab[16 + e]); lp = ce >> 8; nv = ce & 255; u.pm = pm; }
        u.b = B + (size_t)e * bexp + (size_t)pn * btile + (size_t)ks * kbytes; u.pn = pn; u.nv = nv; u.ks = ks; u.om = pm;
        if (gather) { u.a = A; u.gl = list + (size_t)e * NLAT + 256 * lp; u.om = pm + omoff; }
        else { u.a = A + (size_t)pm * astep + (size_t)ks * kbytes; u.gl = nullptr; if (mode == 0) u.om = gp0 + pm; }
        return true;
    }
};

struct EpiGeluT {
    static constexpr bool PERM = true, ROWSCALE = true;
    __device__ __forceinline__ const float* scale_src(const Unit& u) const { return cscale + u.pn * BM; }
    bf16_t* O; float* stats; const float* cscale; const float* wsc;
    __device__ __forceinline__ void operator()(const f32x4 (&acc)[2][2][4][2], const Unit& u, int wr, int wc, int fr, int fq, const LAS float* tab) const {
        const int row0 = u.pm * BM + wr * 64 + fr, col0 = u.pn * BM + wc * 32 + 8 * fq;
        const bool isv = u.pm >= 4; const float wq = wsc[0];
        f32x4 csv[2][2];
#pragma unroll
        for (int bj = 0; bj < 2; ++bj)
#pragma unroll
            for (int n = 0; n < 2; ++n) csv[bj][n] = *(const LAS f32x4*)(tab + wc * 32 + 8 * fq + bj * HALF + 4 * n) * wq;
        float s1[2][2][4], s2[2][2][4];
#pragma unroll
        for (int bj = 0; bj < 2; ++bj)
#pragma unroll
            for (int n = 0; n < 2; ++n)
#pragma unroll
                for (int e = 0; e < 4; ++e) { s1[bj][n][e] = 0.f; s2[bj][n][e] = 0.f; }
#pragma unroll
        for (int ai = 0; ai < 2; ++ai)
#pragma unroll
            for (int m = 0; m < 4; ++m) { bf16_t* rowp = O + (size_t)(row0 + ai * HALF + m * 16) * MALL + col0;
#pragma unroll
                for (int bj = 0; bj < 2; ++bj) { const v4i_t i0 = __builtin_bit_cast(v4i_t, acc[ai][bj][m][0]), i1 = __builtin_bit_cast(v4i_t, acc[ai][bj][m][1]);
                    f32x4 v0 = (f32x4){(float)i0[0], (float)i0[1], (float)i0[2], (float)i0[3]} * csv[bj][0], v1 = (f32x4){(float)i1[0], (float)i1[1], (float)i1[2], (float)i1[3]} * csv[bj][1];
#pragma unroll
                    for (int e = 0; e < 4; ++e) { v0[e] = gelu_tanh(v0[e]); v1[e] = gelu_tanh(v1[e]); s1[bj][0][e] += v0[e]; s2[bj][0][e] += v0[e] * v0[e]; s1[bj][1][e] += v1[e]; s2[bj][1][e] += v1[e] * v1[e]; }
                    u32x4 w; w.x = pkbf(v0[0], v0[1]); w.y = pkbf(v0[2], v0[3]); w.z = pkbf(v1[0], v1[1]); w.w = pkbf(v1[2], v1[3]);
                    *(u32x4*)(rowp + bj * HALF) = w; } }
        if (isv) {
            const int slot = (u.pm - 4) * 2 + wr;
#pragma unroll
            for (int bj = 0; bj < 2; ++bj)
#pragma unroll
                for (int n = 0; n < 2; ++n)
#pragma unroll
                    for (int e = 0; e < 4; ++e) { float a = s1[bj][n][e], b = s2[bj][n][e];
#pragma unroll
                        for (int o = 1; o < 16; o <<= 1) { a += __shfl_xor(a, o); b += __shfl_xor(b, o); }
                        if (fr == 0) { const int tok = col0 + bj * HALF + 4 * n + e; *(f32x2*)(stats + (size_t)tok * 16 + slot * 2) = (f32x2){a, b}; } }
        }
    }
};
template <bool BASE_F32> struct EpiResid {
    static constexpr bool PERM = true, ROWSCALE = false;
    const float* basef; const bf16_t* baseb; bf16_t* out; const float* gate; float s;
    __device__ __forceinline__ void operator()(const f32x4 (&acc)[2][2][4][2], const Unit& u, int wr, int wc, int fr, int fq, const LAS float* tab) const {
        const int mb = u.pm >> 5; const int col0 = u.pn * BM + wc * 32 + 8 * fq;
        f32x4 gv[2][2];
#pragma unroll
        for (int bj = 0; bj < 2; ++bj)
#pragma unroll
            for (int n = 0; n < 2; ++n) gv[bj][n] = *(const f32x4*)(gate + (size_t)mb * 6144 + col0 + bj * HALF + n * 4) * s;
#pragma unroll
        for (int ai = 0; ai < 2; ++ai)
#pragma unroll
            for (int m = 0; m < 4; ++m) { const size_t off = (size_t)(u.pm * BM + wr * 64 + fr + ai * HALF + m * 16) * DM + col0;
#pragma unroll
                for (int bj = 0; bj < 2; ++bj) { f32x4 b0, b1;
                    if constexpr (BASE_F32) { b0 = *(const f32x4*)(basef + off + bj * HALF); b1 = *(const f32x4*)(basef + off + bj * HALF + 4); }
                    else { const u32x4 w = *(const u32x4*)(baseb + off + bj * HALF);
                        b0 = (f32x4){__uint_as_float(w.x << 16), __uint_as_float(w.x & 0xffff0000u), __uint_as_float(w.y << 16), __uint_as_float(w.y & 0xffff0000u)};
                        b1 = (f32x4){__uint_as_float(w.z << 16), __uint_as_float(w.z & 0xffff0000u), __uint_as_float(w.w << 16), __uint_as_float(w.w & 0xffff0000u)}; }
                    const f32x4 o0 = b0 + gv[bj][0] * acc[ai][bj][m][0], o1 = b1 + gv[bj][1] * acc[ai][bj][m][1];
                    u32x4 w; w.x = pkbf(o0[0], o0[1]); w.y = pkbf(o0[2], o0[3]); w.z = pkbf(o1[0], o1[1]); w.w = pkbf(o1[2], o1[3]);
                    *(u32x4*)(out + off + bj * HALF) = w; } }
    }
};
struct EpiSwiGLU {
    static constexpr bool PERM = true, ROWSCALE = false;
    bf16_t* O;
    __device__ __forceinline__ void operator()(const f32x4 (&acc)[2][2][4][2], const Unit& u, int wr, int wc, int fr, int fq, const LAS float* tab) const {
        bf16_t* base = O + (size_t)(u.om * BM + wr * 64 + fr) * DFF + u.pn * 128 + wc * 32 + 8 * fq;
#pragma unroll
        for (int ai = 0; ai < 2; ++ai)
#pragma unroll
            for (int m = 0; m < 4; ++m) { const f32x4 g0 = acc[ai][0][m][0], g1 = acc[ai][0][m][1], u0 = acc[ai][1][m][0], u1 = acc[ai][1][m][1];
                float o[8];
#pragma unroll
                for (int e = 0; e < 4; ++e) { o[e] = silu_f(g0[e]) * u0[e]; o[4 + e] = silu_f(g1[e]) * u1[e]; }
                u32x4 w; w.x = pkbf(o[0], o[1]); w.y = pkbf(o[2], o[3]); w.z = pkbf(o[4], o[5]); w.w = pkbf(o[6], o[7]);
                *(u32x4*)(base + (size_t)(ai * HALF + m * 16) * DFF) = w; }
    }
};
struct EpiQKV {
    static constexpr bool PERM = false, ROWSCALE = true;
    __device__ __forceinline__ const float* scale_src(const Unit& u) const { return rscale + u.pm * BM; }
    bf16_t* O; const float* cosT; const float* sinT; float qscale; const float* rscale; const float* wsc;
    __device__ __forceinline__ void operator()(const f32x4 (&acc)[2][2][4][2], const Unit& u, int wr, int wc, int fr, int fq, const LAS float* tab) const {
        const bool lat = u.pm < NPL; const bool dorope = lat && u.pn < 5; const float sc = (u.pn < 4 ? qscale : 1.0f) * wsc[0];
        const int col0 = u.pn * BM + wc * 32 + 4 * fq;
#pragma unroll
        for (int ai = 0; ai < 2; ++ai)
#pragma unroll
            for (int m = 0; m < 4; ++m) { const int grow = u.pm * BM + ai * HALF + wr * 64 + m * 16 + fr; const int s = grow & (SEQ - 1); const int pos = (wc & 1) ? (s & 63) : (s >> 6);
                f32x4 cs = (f32x4){1.f, 1.f, 1.f, 1.f}, sn = (f32x4){0.f, 0.f, 0.f, 0.f};
                if (dorope) { cs = *(const f32x4*)(cosT + pos * 16 + 4 * fq); sn = *(const f32x4*)(sinT + pos * 16 + 4 * fq); }
                bf16_t* rowp = O + (size_t)grow * NQKV + col0;
                const float rsx = tab[ai * HALF + wr * 64 + m * 16 + fr] * sc;
#pragma unroll
                for (int bj = 0; bj < 2; ++bj) { const v4i_t i1 = __builtin_bit_cast(v4i_t, acc[ai][bj][m][0]), i2 = __builtin_bit_cast(v4i_t, acc[ai][bj][m][1]);
                    const f32x4 x1 = (f32x4){(float)i1[0], (float)i1[1], (float)i1[2], (float)i1[3]}, x2 = (f32x4){(float)i2[0], (float)i2[1], (float)i2[2], (float)i2[3]};
                    const f32x4 o1 = (x1 * cs - x2 * sn) * rsx, o2 = (x1 * sn + x2 * cs) * rsx;
                    u32x2 w1, w2; w1.x = pkbf(o1[0], o1[1]); w1.y = pkbf(o1[2], o1[3]); w2.x = pkbf(o2[0], o2[1]); w2.y = pkbf(o2[2], o2[3]);
                    *(u32x2*)(rowp + bj * HALF) = w1; *(u32x2*)(rowp + bj * HALF + 16) = w2; } }
    }
};
struct EpiSwiGLUI8 {
    static constexpr bool PERM = true, ROWSCALE = true;
    __device__ __forceinline__ const float* scale_src(const Unit& u) const { return rscale + u.pm * BM; }
    bf16_t* O; const float* rscale; const float* ws;
    __device__ __forceinline__ void operator()(const f32x4 (&acc)[2][2][4][2], const Unit& u, int wr, int wc, int fr, int fq, const LAS float* tab) const {
        bf16_t* base = O + (size_t)(u.om * BM + wr * 64 + fr) * DFF + u.pn * 128 + wc * 32 + 8 * fq;
        const float wsg = ws[0], wsu = ws[1];
#pragma unroll
        for (int ai = 0; ai < 2; ++ai)
#pragma unroll
            for (int m = 0; m < 4; ++m) { const float rs = tab[wr * 64 + fr + ai * HALF + m * 16]; const float sg = rs * wsg, su = rs * wsu;
                const v4i_t g0 = __builtin_bit_cast(v4i_t, acc[ai][0][m][0]), g1 = __builtin_bit_cast(v4i_t, acc[ai][0][m][1]), u0 = __builtin_bit_cast(v4i_t, acc[ai][1][m][0]), u1 = __builtin_bit_cast(v4i_t, acc[ai][1][m][1]);
                float o[8];
#pragma unroll
                for (int e = 0; e < 4; ++e) { o[e] = silu_f((float)g0[e] * sg) * ((float)u0[e] * su); o[4 + e] = silu_f((float)g1[e] * sg) * ((float)u1[e] * su); }
                u32x4 w; w.x = pkbf(o[0], o[1]); w.y = pkbf(o[2], o[3]); w.z = pkbf(o[4], o[5]); w.w = pkbf(o[6], o[7]);
                *(u32x4*)(base + (size_t)(ai * HALF + m * 16) * DFF) = w; }
    }
};
struct EpiSwiGLU8 {
    static constexpr bool PERM = true, ROWSCALE = false;
    unsigned char* O; float s;
    __device__ __forceinline__ void operator()(const f32x4 (&acc)[2][2][4][2], const Unit& u, int wr, int wc, int fr, int fq, const LAS float* tab) const {
        unsigned char* base = O + (size_t)(u.om * BM + wr * 64 + fr) * DFF + u.pn * 128 + wc * 32 + 8 * fq;
#pragma unroll
        for (int ai = 0; ai < 2; ++ai)
#pragma unroll
            for (int m = 0; m < 4; ++m) { const f32x4 g0 = acc[ai][0][m][0] * s, g1 = acc[ai][0][m][1] * s, u0 = acc[ai][1][m][0] * s, u1 = acc[ai][1][m][1] * s;
                float o[8];
#pragma unroll
                for (int e = 0; e < 4; ++e) { o[e] = silu_f(g0[e]) * u0[e]; o[4 + e] = silu_f(g1[e]) * u1[e]; }
                u32x2 w; w.x = pk4f8(o[0], o[1], o[2], o[3]); w.y = pk4f8(o[4], o[5], o[6], o[7]);
                *(u32x2*)(base + (size_t)(ai * HALF + m * 16) * DFF) = w; }
    }
};
struct EpiBf16Plain {
    static constexpr bool PERM = true, ROWSCALE = false;
    bf16_t* O; int ldc; float s;
    __device__ __forceinline__ void operator()(const f32x4 (&acc)[2][2][4][2], const Unit& u, int wr, int wc, int fr, int fq, const LAS float* tab) const {
        bf16_t* base = O + (size_t)(u.om * BM + wr * 64 + fr) * ldc + u.pn * BM + wc * 32 + 8 * fq;
#pragma unroll
        for (int ai = 0; ai < 2; ++ai)
#pragma unroll
            for (int m = 0; m < 4; ++m)
#pragma unroll
                for (int bj = 0; bj < 2; ++bj) { const f32x4 v0 = acc[ai][bj][m][0] * s, v1 = acc[ai][bj][m][1] * s;
                    u32x4 w; w.x = pkbf(v0[0], v0[1]); w.y = pkbf(v0[2], v0[3]); w.z = pkbf(v1[0], v1[1]); w.w = pkbf(v1[2], v1[3]);
                    *(u32x4*)(base + (size_t)(ai * HALF + m * 16) * ldc + bj * HALF) = w; }
    }
};

struct EpiPartF32 {
    static constexpr bool PERM = true, ROWSCALE = false;
    float* P; size_t sstride;
    __device__ __forceinline__ void operator()(const f32x4 (&acc)[2][2][4][2], const Unit& u, int wr, int wc, int fr, int fq, const LAS float* tab) const {
        float* base = P + (size_t)u.ks * sstride + (size_t)(u.om * BM + wr * 64 + fr) * DM + u.pn * BM + wc * 32 + 8 * fq;
#pragma unroll
        for (int ai = 0; ai < 2; ++ai)
#pragma unroll
            for (int m = 0; m < 4; ++m)
#pragma unroll
                for (int bj = 0; bj < 2; ++bj)
#pragma unroll
                    for (int n = 0; n < 2; ++n) *(f32x4*)(base + (size_t)(ai * HALF + m * 16) * DM + bj * HALF + n * 4) = acc[ai][bj][m][n];
    }
};
struct EpiPartBf16 {
    static constexpr bool PERM = true, ROWSCALE = false;
    bf16_t* P; size_t sstride; float s;
    __device__ __forceinline__ void operator()(const f32x4 (&acc)[2][2][4][2], const Unit& u, int wr, int wc, int fr, int fq, const LAS float* tab) const {
        bf16_t* base = P + (size_t)u.ks * sstride + (size_t)(u.om * BM + wr * 64 + fr) * DM + u.pn * BM + wc * 32 + 8 * fq;
#pragma unroll
        for (int ai = 0; ai < 2; ++ai)
#pragma unroll
            for (int m = 0; m < 4; ++m)
#pragma unroll
                for (int bj = 0; bj < 2; ++bj) { const f32x4 v0 = acc[ai][bj][m][0] * s, v1 = acc[ai][bj][m][1] * s;
                    u32x4 w; w.x = pkbf(v0[0], v0[1]); w.y = pkbf(v0[2], v0[3]); w.z = pkbf(v1[0], v1[1]); w.w = pkbf(v1[2], v1[3]);
                    *(u32x4*)(base + (size_t)(ai * HALF + m * 16) * DM + bj * HALF) = w; }
    }
};

template <class Epi, class Sched, bool ALIGN_EPI, bool GATHER, bool FP8 = false, bool I8 = false>
__device__ __forceinline__ void gemm_phase(LAS unsigned char* lds, LAS int* gtab, const int K  , const int nt_in  , const Sched& S, const Epi& E) {
    int nt = nt_in; asm volatile("" : "+s"(nt));
    int tid_ = threadIdx.x; asm volatile("" : "+v"(tid_));
    const int tid = tid_, wid = __builtin_amdgcn_readfirstlane(tid >> 6), lane = tid & 63, wr = wid >> 2, wc = wid & 3, fr = lane & 15, fq = lane >> 4;
    const size_t kstep = (size_t)(BK * 2);
    const size_t hstep = (size_t)HALF * K * 2;
    unsigned voffB[2];
#pragma unroll
    for (int i = 0; i < 2; ++i) { int R, C; stage_rc(tid * 16 + i * 8192, R, C); const int Rb = Epi::PERM ? ((R & ~31) + perm32(R & 31)) : R;
        voffB[i] = (unsigned)(Rb * K + C) * 2u; }
    unsigned vA[2][2], vN[2][2];
    const unsigned ldsw = (unsigned)wid * 1024u;
    const int aoff = lds_byte(wr * 64 + fr, fq * 8), boff = lds_byte(wc * 32 + fr, fq * 8);
    const LAS unsigned char* aB = lds + aoff; const LAS unsigned char* bB = lds + 65536 + boff;
    asm volatile("" : "+v"(aB), "+v"(bB));
#define PG8_SA(b, h) (((b) * 2 + (h)) * HTB)
#define PG8_SB(b, h) ((4 + (b) * 2 + (h)) * HTB)
#define PG8_STAGE(bufoff, gbase, voff) do { _Pragma("unroll") for (int _i = 0; _i < 2; ++_i) \
        __builtin_amdgcn_global_load_lds((const unsigned*)((const char*)(gbase) + (voff)[_i]), (LAS unsigned*)(lds + (bufoff) + ldsw + _i * 8192), 16, 0, 0); } while (0)
#define PG8_LDA(dst, b, h) do { _Pragma("unroll") for (int m = 0; m < 4; ++m) { if constexpr (FP8) dst##8[m] = cat8(*(const LAS bf16x8*)(aB + PG8_SA(b, h) + m * 2048), *(const LAS bf16x8*)(aB + PG8_SA(b, h) + m * 2048 + 1024)); \
        else { _Pragma("unroll") for (int k = 0; k < 2; ++k) dst[m][k] = *(const LAS bf16x8*)(aB + PG8_SA(b, h) + m * 2048 + k * 1024); } } } while (0)
#define PG8_LDB(dst, b, h) do { _Pragma("unroll") for (int n = 0; n < 2; ++n) { if constexpr (FP8) dst##8[n] = cat8(*(const LAS bf16x8*)(bB + (PG8_SB(b, h) - 65536) + n * 2048), *(const LAS bf16x8*)(bB + (PG8_SB(b, h) - 65536) + n * 2048 + 1024)); \
        else { _Pragma("unroll") for (int k = 0; k < 2; ++k) dst[n][k] = *(const LAS bf16x8*)(bB + (PG8_SB(b, h) - 65536) + n * 2048 + k * 1024); } } } while (0)
#define PG8_MMA(ai, bj, At, Bt) do { __builtin_amdgcn_s_setprio(1); \
    if constexpr (FP8) { _Pragma("unroll") for (int m = 0; m < 4; ++m) _Pragma("unroll") for (int n = 0; n < 2; ++n) \
        asm volatile("v_mfma_f32_16x16x128_f8f6f4 %0, %1, %2, %0" : "+v"(acc[ai][bj][m][n]) : "v"(Bt##8[n]), "v"(At##8[m])); } \
    else if constexpr (I8) { _Pragma("unroll") for (int m = 0; m < 4; ++m) _Pragma("unroll") for (int n = 0; n < 2; ++n) _Pragma("unroll") for (int k = 0; k < 2; ++k) \
        asm volatile("v_mfma_i32_16x16x64_i8 %0, %1, %2, %0" : "+v"(acc[ai][bj][m][n]) : "v"(Bt[n][k]), "v"(At[m][k])); } \
    else { _Pragma("unroll") for (int m = 0; m < 4; ++m) _Pragma("unroll") for (int n = 0; n < 2; ++n) _Pragma("unroll") for (int k = 0; k < 2; ++k) \
        acc[ai][bj][m][n] = __builtin_amdgcn_mfma_f32_16x16x32_bf16(Bt[n][k], At[m][k], acc[ai][bj][m][n], 0, 0, 0); } \
    __builtin_amdgcn_s_setprio(0); } while (0)
#define PG8_WAIT_V(n) asm volatile("s_waitcnt vmcnt(" #n ")" ::: "memory")
#define PG8_WAIT_L(n) asm volatile("s_waitcnt lgkmcnt(" #n ")" ::: "memory")
#define PG8_BAR __builtin_amdgcn_s_barrier()
#define PG8_SCHED __builtin_amdgcn_sched_barrier(0)
    Unit cur, nxt; int ui = 0;
    if (!S.next(0, cur)) return;
    f32x4 acc[2][2][4][2];
#pragma unroll
    for (int a = 0; a < 2; ++a)
#pragma unroll
        for (int b = 0; b < 2; ++b)
#pragma unroll
            for (int m = 0; m < 4; ++m)
#pragma unroll
                for (int n = 0; n < 2; ++n) acc[a][b][m][n] = (f32x4){0.f, 0.f, 0.f, 0.f};
    bf16x8 At[4][2], B0[2][2], B1[2][2]; v8i_t At8[4], B08[2], B18[2];
    if constexpr (GATHER) {
#pragma unroll
        for (int h = 0; h < 2; ++h)
#pragma unroll
            for (int i = 0; i < 2; ++i) { int R, C; stage_rc(tid * 16 + i * 8192, R, C); const int row = h * HALF + R; const int tok = cur.gl[row < cur.nv ? row : 0]; vA[h][i] = (unsigned)tok * (unsigned)(K * 2) + (unsigned)C * 2u; }
    } else {
#pragma unroll
        for (int h = 0; h < 2; ++h)
#pragma unroll
            for (int i = 0; i < 2; ++i) { int R, C; stage_rc(tid * 16 + i * 8192, R, C); vA[h][i] = (unsigned)(R * K + C) * 2u + (unsigned)(h * hstep); }
    }
#pragma unroll
    for (int h = 0; h < 2; ++h)
#pragma unroll
        for (int i = 0; i < 2; ++i) vN[h][i] = vA[h][i];
    const char* cA = cur.a; const char* cB = cur.b;
    PG8_STAGE(PG8_SB(0, 0), cB, voffB); PG8_STAGE(PG8_SB(0, 1), cB + hstep, voffB); PG8_STAGE(PG8_SA(0, 0), cA, vA[0]); PG8_STAGE(PG8_SA(0, 1), cA, vA[1]);
    if (wr == 1) PG8_BAR;
    PG8_WAIT_V(2); PG8_BAR;
    PG8_STAGE(PG8_SB(1, 0), cB + kstep, voffB); PG8_STAGE(PG8_SA(1, 0), cA + kstep, vA[0]); PG8_STAGE(PG8_SB(1, 1), cB + hstep + kstep, voffB);
    PG8_WAIT_V(6); PG8_BAR;
    for (;;) {
        const bool has_next = S.next(ui + 1, nxt);
        if constexpr (Epi::ROWSCALE) {
            if (wid < 4) __builtin_amdgcn_global_load_lds((const unsigned*)(E.scale_src(cur) + wid * 64 + lane), (LAS unsigned*)(lds + STAB_OFF + (ui & 1) * 1024 + wid * 256), 4, 0, 0);
        }
        const char* nA = has_next ? nxt.a : cA; const char* nB = has_next ? nxt.b : cB;
        if constexpr (GATHER) {
            if (has_next && wid < 4) __builtin_amdgcn_global_load_lds((const unsigned*)(nxt.gl + wid * 64 + lane), (LAS unsigned*)(gtab + wid * 64), 4, 0, 0);
        }
        for (int t = 0; t < nt; t += 2) {
            const bool last = (t == nt - 2);
            const char* a1 = cA + (size_t)(t + 1) * kstep;
            const char* a2 = last ? nA : cA + (size_t)(t + 2) * kstep; const char* b2 = last ? nB : cB + (size_t)(t + 2) * kstep;
            const char* a3 = a2 + kstep; const char* b3 = b2 + kstep;
            if constexpr (GATHER) {
                if (last && has_next) {
                    int t2 = tid; asm volatile("" : "+v"(t2));
#pragma unroll
                    for (int h = 0; h < 2; ++h)
#pragma unroll
                        for (int i = 0; i < 2; ++i) { int R, C; stage_rc(t2 * 16 + i * 8192, R, C); const int row = h * HALF + R; const int tok = gtab[row < nxt.nv ? row : 0]; vN[h][i] = (unsigned)tok * (unsigned)(K * 2) + (unsigned)C * 2u; }
                }
            }
            unsigned vS0[2], vS1[2];
#pragma unroll
            for (int i = 0; i < 2; ++i) { vS0[i] = (GATHER && last) ? vN[0][i] : vA[0][i]; vS1[i] = (GATHER && last) ? vN[1][i] : vA[1][i]; }
            PG8_LDB(B0, 0, 0); PG8_LDB(B1, 0, 1); PG8_SCHED; PG8_LDA(At, 0, 0); PG8_STAGE(PG8_SA(1, 1), a1, vA[1]);
            PG8_WAIT_V(8); PG8_WAIT_L(0); PG8_BAR; PG8_MMA(0, 0, At, B0); PG8_MMA(0, 1, At, B1); PG8_BAR; PG8_SCHED;
            PG8_LDA(At, 0, 1); PG8_STAGE(PG8_SB(0, 0), b2, voffB); PG8_STAGE(PG8_SB(0, 1), b2 + hstep, voffB); PG8_STAGE(PG8_SA(0, 0), a2, vS0);
            PG8_WAIT_V(8); PG8_WAIT_L(0); PG8_BAR; PG8_MMA(1, 0, At, B0); PG8_MMA(1, 1, At, B1); PG8_BAR; PG8_SCHED;
            PG8_LDB(B0, 1, 0); PG8_LDB(B1, 1, 1); PG8_SCHED; PG8_LDA(At, 1, 0); PG8_STAGE(PG8_SA(0, 1), a2, vS1);
            PG8_WAIT_V(8); PG8_WAIT_L(0); PG8_BAR; PG8_MMA(0, 0, At, B0); PG8_MMA(0, 1, At, B1); PG8_BAR; PG8_SCHED;
            PG8_LDA(At, 1, 1); PG8_STAGE(PG8_SB(1, 0), b3, voffB); PG8_STAGE(PG8_SB(1, 1), b3 + hstep, voffB); PG8_STAGE(PG8_SA(1, 0), a3, vS0);
            PG8_WAIT_V(8); PG8_WAIT_L(0); PG8_BAR; PG8_MMA(1, 0, At, B0); PG8_MMA(1, 1, At, B1); PG8_BAR; PG8_SCHED;
        }
        if constexpr (ALIGN_EPI) { if (wr == 0) PG8_BAR; }
        if constexpr (FP8 || I8) asm volatile("s_nop 15\n\ts_nop 15" ::: "memory");
        E(acc, cur, wr, wc, fr, fq, (const LAS float*)(lds + STAB_OFF) + (ui & 1) * 256);
        if (!has_next) break;
#pragma unroll
        for (int a = 0; a < 2; ++a)
#pragma unroll
            for (int b = 0; b < 2; ++b)
#pragma unroll
                for (int m = 0; m < 4; ++m)
#pragma unroll
                    for (int n = 0; n < 2; ++n) acc[a][b][m][n] = (f32x4){0.f, 0.f, 0.f, 0.f};
        cur = nxt; cA = nA; cB = nB; ++ui;
        if constexpr (GATHER) {
#pragma unroll
            for (int h = 0; h < 2; ++h)
#pragma unroll
                for (int i = 0; i < 2; ++i) vA[h][i] = vN[h][i];
        }
        if constexpr (ALIGN_EPI) { if (wr == 1) PG8_BAR; }
    }
    PG8_WAIT_V(0);
    if constexpr (!ALIGN_EPI) { if (wr == 0) PG8_BAR; }
    PG8_BAR;
#undef PG8_SA
#undef PG8_SB
#undef PG8_STAGE
#undef PG8_LDA
#undef PG8_LDB
#undef PG8_MMA
#undef PG8_WAIT_V
#undef PG8_WAIT_L
#undef PG8_BAR
#undef PG8_SCHED
}
}

namespace attn_body {
using bf16 = __hip_bfloat16;
using s16x4 = __attribute__((ext_vector_type(4))) short;
constexpr int D = 64, PITCH = NQKV, OPITCH = DM;
constexpr int NW = 8, QBLK = 32, KVBLK = 64;
__device__ __forceinline__ int crow(int r, int hi) { return (r & 3) + 8 * (r >> 2) + 4 * hi; }
#define SBAR() __builtin_amdgcn_sched_barrier(0)
__device__ __forceinline__ void bmask(f32x16& p0, f32x16& p1, int kb, int qrel, int hi) {
    const float NEG = -INFINITY; const int d0 = kb + 4 * hi - qrel;
#pragma unroll
    for (int r = 0; r < 16; ++r) { const int d = d0 + (r & 3) + 8 * (r >> 2); if (d < -128 || d > 128) p0[r] = NEG; if (d + 32 < -128 || d + 32 > 128) p1[r] = NEG; }
}
constexpr int NSLOT = 3, SLOTB = 8192;
constexpr int LDS_K = 0, LDS_V = NSLOT * SLOTB, LDS_WS = 2 * NSLOT * SLOTB, LDS_OST = LDS_WS + NW * 64 * 4, LDS_BYTES_A = LDS_OST + NW * 4096;
constexpr float C2 = 0.125f * 1.4426950408889634f;
__device__ __forceinline__ void glds16(const void* gsrc, unsigned lds_dst) { unsigned keep;
    asm volatile("s_mov_b32 %0, m0\n\ts_mov_b32 m0, %2\n\ts_nop 0\n\tglobal_load_lds_dwordx4 %1, off\n\ts_mov_b32 m0, %0" : "=&s"(keep) : "v"(gsrc), "s"(lds_dst) : "memory"); }
__device__ __forceinline__ float max3f(float a, float b, float c) { float r; asm("v_max3_f32 %0, %1, %2, %3" : "=v"(r) : "v"(a), "v"(b), "v"(c)); return r; }
__device__ __forceinline__ float max2f(float a, float b) { float r; asm("v_max_f32_e32 %0, %1, %2" : "=v"(r) : "v"(a), "v"(b)); return r; }
__device__ __forceinline__ float fadd_s(float a, float b) { float r; asm("v_add_f32_e32 %0, %1, %2" : "=v"(r) : "v"(a), "v"(b)); return r; }
__device__ __forceinline__ float fsub_s(float a, float b) { float r; asm("v_sub_f32_e32 %0, %1, %2" : "=v"(r) : "v"(a), "v"(b)); return r; }
__device__ __forceinline__ unsigned cvtpk_s(float lo, float hi) { f32x2 v = {lo, hi}; bf16x2_t b = __builtin_convertvector(v, bf16x2_t); return __builtin_bit_cast(unsigned, b); }
#define WAIT_BAR(N) asm volatile("s_waitcnt vmcnt(" #N ") lgkmcnt(0)\n\ts_barrier" ::: "memory")
__device__ __forceinline__ void qkt(f32x16& p0, f32x16& p1, const char* Kslot, const bf16x8* qr, const f32x16& negm, int r32, int hi) {
    const char* kb = Kslot + hi * 1024 + r32 * 16;
#pragma unroll
    for (int d0 = 0; d0 < 4; ++d0) {
        const bf16x8 b0 = *reinterpret_cast<const bf16x8*>(kb + d0 * 2048);
        const bf16x8 b1 = *reinterpret_cast<const bf16x8*>(kb + d0 * 2048 + 512);
        if (d0 == 0) { p0 = __builtin_amdgcn_mfma_f32_32x32x16_bf16(b0, qr[0], negm, 0, 0, 0); p1 = __builtin_amdgcn_mfma_f32_32x32x16_bf16(b1, qr[0], negm, 0, 0, 0); }
        else { p0 = __builtin_amdgcn_mfma_f32_32x32x16_bf16(b0, qr[d0], p0, 0, 0, 0); p1 = __builtin_amdgcn_mfma_f32_32x32x16_bf16(b1, qr[d0], p1, 0, 0, 0); } }
}
typedef __attribute__((address_space(3))) const char* lds_cptr;
typedef short v4i16_t __attribute__((ext_vector_type(4)));
__device__ __forceinline__ void kload8(bf16x8* kf, lds_cptr kp) {
    kf[0] = *(const __attribute__((address_space(3))) bf16x8*)(kp);        kf[1] = *(const __attribute__((address_space(3))) bf16x8*)(kp + 512);
    kf[2] = *(const __attribute__((address_space(3))) bf16x8*)(kp + 2048); kf[3] = *(const __attribute__((address_space(3))) bf16x8*)(kp + 2560);
    kf[4] = *(const __attribute__((address_space(3))) bf16x8*)(kp + 4096); kf[5] = *(const __attribute__((address_space(3))) bf16x8*)(kp + 4608);
    kf[6] = *(const __attribute__((address_space(3))) bf16x8*)(kp + 6144); kf[7] = *(const __attribute__((address_space(3))) bf16x8*)(kp + 6656);
}
__device__ __forceinline__ void kload2(bf16x8* kf, lds_cptr kp, int j) { kf[2 * j] = *(const __attribute__((address_space(3))) bf16x8*)(kp + j * 2048); kf[2 * j + 1] = *(const __attribute__((address_space(3))) bf16x8*)(kp + j * 2048 + 512); }
__device__ __forceinline__ s16x4 vtr(lds_cptr p) { return __builtin_bit_cast(s16x4, __builtin_amdgcn_ds_read_tr16_b64_v4i16((__attribute__((address_space(3))) v4i16_t*)p)); }
__device__ __forceinline__ float rowmax(const f32x16& p0, const f32x16& p1) {
    float a = max3f(p0[0], p0[1], p1[0]), b = max3f(p0[2], p0[3], p1[1]); a = max3f(a, p1[2], p1[3]);
#pragma unroll
    for (int r = 4; r < 16; r += 4) { a = max3f(a, p0[r], p0[r + 1]); b = max3f(b, p0[r + 2], p0[r + 3]); a = max3f(a, p1[r], p1[r + 1]); b = max3f(b, p1[r + 2], p1[r + 3]); }
    const float m = max2f(a, b);
    auto rr = __builtin_amdgcn_permlane32_swap(__float_as_uint(m), __float_as_uint(m), false, false);
    return max2f(__uint_as_float(rr[0]), __uint_as_float(rr[1]));
}
__device__ __forceinline__ void pv(f32x16* o, int vb, bf16x8 pa0, bf16x8 pa1, bf16x8 pa2, bf16x8 pa3) {
#pragma unroll
    for (int d0 = 0; d0 < 2; ++d0) { s16x4 lo[4], hi[4];
#pragma unroll
        for (int ks = 0; ks < 4; ++ks) {
            asm volatile("ds_read_b64_tr_b16 %0,%1 offset:%c2" : "=&v"(lo[ks]) : "v"(vb), "i"(d0 * 4096 + ks * 1024) : "memory");
            asm volatile("ds_read_b64_tr_b16 %0,%1 offset:%c2" : "=&v"(hi[ks]) : "v"(vb), "i"(d0 * 4096 + ks * 1024 + 512) : "memory"); }
        asm volatile("s_waitcnt lgkmcnt(0)" ::: "memory"); SBAR();
#define PK(k) (bf16x8){lo[k][0], lo[k][1], lo[k][2], lo[k][3], hi[k][0], hi[k][1], hi[k][2], hi[k][3]}
        o[d0] = __builtin_amdgcn_mfma_f32_32x32x16_bf16(pa0, PK(0), o[d0], 0, 0, 0);
        o[d0] = __builtin_amdgcn_mfma_f32_32x32x16_bf16(pa1, PK(1), o[d0], 0, 0, 0);
        o[d0] = __builtin_amdgcn_mfma_f32_32x32x16_bf16(pa2, PK(2), o[d0], 0, 0, 0);
        o[d0] = __builtin_amdgcn_mfma_f32_32x32x16_bf16(pa3, PK(3), o[d0], 0, 0, 0);
#undef PK
    }
}
#define ATTN_STORE16(p, v) (*(u32x4*)(p) = (v))
template <int THRL> __device__ __forceinline__ int attn_unit(int b, int hk, int n, int pr, const bf16* QKV, unsigned char* O, const float* sinkp, char* shm, int sb, bool pre, bool has_next, int nb2, int nhk2, int nn2, int npr2, bf16x8 (&qr)[4]) {
    int tid_ = threadIdx.x; asm volatile("" : "+v"(tid_));
    const int tid = tid_, lane = tid & 63, r32 = lane & 31, hi = lane >> 5; const int wid = __builtin_amdgcn_readfirstlane(tid >> 6);
    const int head = 4 * hk + 2 * pr + (wid >> 2);
    const long rowblk = (long)b * SEQ + n * 128;
    const long ctxrow = (long)NLAT + b * LCTX;
    const int nlo = n > 0 ? 2 : 0, nhi = n < (SEQ / 128 - 1) ? 2 : 0;
    const int NT = 6 + nlo + nhi;
    const bf16* Qw = QKV + (rowblk + (wid & 3) * QBLK) * PITCH + head * D;
    const bf16* Kc = QKV + 1024 + hk * D; const bf16* Vc = QKV + 1280 + hk * D;
    const unsigned lds0 = (unsigned)(uintptr_t)shm;
    float* wsf = (float*)(shm + LDS_WS) + wid * 64;
    const long klane = (long)lane * PITCH + wid * 8;
    const long vlane = (long)(16 * (wid & 3) + (lane >> 2)) * PITCH + (wid >> 2) * 32 + (lane & 3) * 8;
    const unsigned kdst = lds0 + LDS_K + wid * 1024, vdst = lds0 + LDS_V + wid * 1024;
#define TROW(t) (((t) < 2) ? (rowblk + 64 * (t)) : ((t) < 6) ? (ctxrow + 64 * ((t) - 2)) : (rowblk + ((((t) - 6) < nlo) ? (-128 + 64 * ((t) - 6)) : (128 + 64 * ((t) - 6 - nlo)))))
#define TKB(t) (((t) < 6) ? 0 : ((((t) - 6) < nlo) ? (-128 + 64 * ((t) - 6)) : (128 + 64 * ((t) - 6 - nlo))))
#define DMA_K(t, slot) glds16(Kc + TROW(t) * PITCH + klane, (unsigned)__builtin_amdgcn_readfirstlane(kdst + (slot)))
#define DMA_V(t, slot) glds16(Vc + TROW(t) * PITCH + vlane, (unsigned)__builtin_amdgcn_readfirstlane(vdst + (slot)))
    const int vb0 = (int)(lds0 + LDS_V) + ((lane >> 4) & 1) * 32 + (lane & 3) * 8 + (4 * hi + ((lane & 15) >> 2)) * 64;
    const char* Kbase = shm + LDS_K; bf16x8 kf[8];
    const lds_cptr shm3 = (lds_cptr)shm; const lds_cptr kp0 = shm3 + LDS_K + hi * 1024 + r32 * 16; const lds_cptr vp0 = shm3 + LDS_V + ((lane >> 4) & 1) * 32 + (lane & 3) * 8 + (4 * hi + ((lane & 15) >> 2)) * 64;
#define NXS(x) (((x) == (NSLOT - 1) * SLOTB) ? 0 : (x) + SLOTB)
    const int S0 = sb, S1 = NXS(S0), S2 = NXS(S1);
    if (!pre) { DMA_K(0, S0); DMA_V(0, S0); DMA_K(1, S1); }
    if (!pre) {
#pragma unroll
        for (int d0 = 0; d0 < 4; ++d0) qr[d0] = *reinterpret_cast<const bf16x8*>(&Qw[(long)r32 * PITCH + d0 * 16 + hi * 8]); }
    float mhat = 0.f, l_reg = 0.f; f32x16 o[2]; o[0] = f32x16{}; o[1] = f32x16{}; f32x16 negm = f32x16{}; asm volatile("" : "+v"(negm));
    const int qrel = (wid & 3) * QBLK + r32;
#define CMASK(P0, P1, t) do { int jb_ = (t) - (NT - 4); if (jb_ >= 0) bmask(P0, P1, TKB(t), qrel, hi); } while (0)
    bool resc = false;
#define START(P0, P1) do { const float rm = rowmax(P0, P1); resc = false; \
    { const float dl = rm; mhat = fadd_s(mhat, dl); \
      _Pragma("unroll") for (int r = 0; r < 16; ++r) { P0[r] = fsub_s(P0[r], dl); P1[r] = fsub_s(P1[r], dl); } \
      _Pragma("unroll") for (int r = 0; r < 16; ++r) negm[r] = -mhat; asm volatile("" : "+v"(negm)); } \
    _Pragma("unroll") for (int r = 0; r < 16; ++r) P0[r] = __builtin_amdgcn_exp2f(P0[r]); } while (0)
#define RESC() do { if (resc) { asm volatile("s_waitcnt lgkmcnt(0)" ::: "memory"); \
      _Pragma("unroll") for (int d_ = 0; d_ < 2; ++d_) _Pragma("unroll") for (int r = 0; r < 16; ++r) o[d_][r] *= wsf[crow(r, hi)]; } } while (0)
    f32x16 pA0, pA1, pB0, pB1;
    int sl_prev = S0, sl_cur = S0, sl_next = S1;
#define ROT() do { sl_prev = sl_cur; sl_cur = sl_next; sl_next = (sl_next == (NSLOT - 1) * SLOTB) ? 0 : sl_next + SLOTB; } while (0)
    if (!pre) { DMA_K(2, S2); }
    WAIT_BAR(3);
    qkt(pA0, pA1, Kbase + S0, qr, negm, r32, hi); asm volatile("s_nop 15\n\ts_nop 7" : "+v"(pA0), "+v"(pA1));
    START(pA0, pA1);
    _Pragma("unroll") for (int r = 0; r < 16; ++r) pA1[r] = __builtin_amdgcn_exp2f(pA1[r]);
    WAIT_BAR(0);
    DMA_K(3, S0); DMA_V(1, S1);
    ROT();
    kload8(kf, kp0 + sl_cur);
    WAIT_BAR(2);
    s16x4 vlo[8], vhi[8]; u32x4 pw0, pw1, pw2, pw3;
#define PKW(P, B) cvtpk_s(P[B], P[B + 1])
#define PAF(k) __builtin_bit_cast(bf16x8, pw##k)
#define VFR(i) (bf16x8){vlo[i][0], vlo[i][1], vlo[i][2], vlo[i][3], vhi[i][0], vhi[i][1], vhi[i][2], vhi[i][3]}
#define PIN(x) asm volatile("" : "+v"(x))
#define MX3(a, b, c) __builtin_fmaxf(__builtin_fmaxf((a), (b)), (c))
#define GAPA(MF, A0, A1, A2, A3, W0, W1, PW) do { MF; sacc += A0; sacc += A1; sacc += A2; sacc += A3; PIN(sacc); W0; W1; PIN(PW); SBAR(); } while (0)
#define EX(v) __builtin_amdgcn_exp2f(v)
#define GAPB(MF, X, B) do { MF; X[B] = EX(X[B]); X[B + 1] = EX(X[B + 1]); X[B + 2] = EX(X[B + 2]); X[B + 3] = EX(X[B + 3]); PIN(X); SBAR(); } while (0)
#define VRD(i) do { vlo[i] = vtr(vp_ + (((i) >> 2) * 4096 + ((i) & 3) * 1024)); vhi[i] = vtr(vp_ + (((i) >> 2) * 4096 + ((i) & 3) * 1024 + 512)); } while (0)
#define KRD(G, j) do { if (G) { kload2(kf, kp0 + sl_next, j); SBAR(); } } while (0)
#define STEP(C0, C1, P0, P1, t, GK, GV, GL) do { SBAR(); \
    const lds_cptr vp_ = vp0 + sl_prev; \
    VRD(0); SBAR(); float sacc = (P0[0] + P0[1]); \
    GAPA(C0 = __builtin_amdgcn_mfma_f32_32x32x16_bf16(kf[0], qr[0], negm, 0, 0, 0), P0[2], P0[3], P0[4], P0[5],     pw0[0] = PKW(P0, 0), pw0[1] = PKW(P0, 2), pw0); \
    VRD(4); SBAR(); GAPA(C1 = __builtin_amdgcn_mfma_f32_32x32x16_bf16(kf[1], qr[0], negm, 0, 0, 0), P0[6], P0[7], P0[8], P0[9],     pw0[2] = PKW(P0, 4), pw0[3] = PKW(P0, 6), pw0); \
    VRD(1); SBAR(); GAPA(C0 = __builtin_amdgcn_mfma_f32_32x32x16_bf16(kf[2], qr[1], C0, 0, 0, 0),   P0[10], P0[11], P0[12], P0[13], pw1[0] = PKW(P0, 8), pw1[1] = PKW(P0, 10), pw1); \
    VRD(5); SBAR(); GAPA(C1 = __builtin_amdgcn_mfma_f32_32x32x16_bf16(kf[3], qr[1], C1, 0, 0, 0),   P0[14], P0[15], P1[0], P1[1],   pw1[2] = PKW(P0, 12), pw1[3] = PKW(P0, 14), pw1); \
    VRD(2); SBAR(); GAPA(C0 = __builtin_amdgcn_mfma_f32_32x32x16_bf16(kf[4], qr[2], C0, 0, 0, 0),   P1[2], P1[3], P1[4], P1[5],     pw2[0] = PKW(P1, 0), pw2[1] = PKW(P1, 2), pw2); \
    VRD(6); SBAR(); GAPA(C1 = __builtin_amdgcn_mfma_f32_32x32x16_bf16(kf[5], qr[2], C1, 0, 0, 0),   P1[6], P1[7], P1[8], P1[9],     pw2[2] = PKW(P1, 4), pw2[3] = PKW(P1, 6), pw2); \
    VRD(3); SBAR(); GAPA(C0 = __builtin_amdgcn_mfma_f32_32x32x16_bf16(kf[6], qr[3], C0, 0, 0, 0),   P1[10], P1[11], P1[12], P1[13], pw3[0] = PKW(P1, 8), pw3[1] = PKW(P1, 10), pw3); \
    VRD(7); SBAR(); GAPA(C1 = __builtin_amdgcn_mfma_f32_32x32x16_bf16(kf[7], qr[3], C1, 0, 0, 0),   P1[14], P1[15], 0.f, 0.f,       pw3[2] = PKW(P1, 12), pw3[3] = PKW(P1, 14), pw3); \
    l_reg += sacc; \
    if (GK) { DMA_K((t) + 3, sl_cur); } if (GV) { DMA_V((t) + 1, sl_next); } \
    CMASK(C0, C1, t); \
    { float a = MX3(C0[0], C0[1], C1[0]), b = MX3(C0[2], C0[3], C1[1]); a = MX3(a, C1[2], C1[3]); \
      _Pragma("unroll") for (int r = 4; r < 16; r += 4) { a = MX3(a, C0[r], C0[r + 1]); b = MX3(b, C0[r + 2], C0[r + 3]); a = MX3(a, C1[r], C1[r + 1]); b = MX3(b, C1[r + 2], C1[r + 3]); } \
      float rm = __builtin_fmaxf(a, b); { auto rr = __builtin_amdgcn_permlane32_swap(__float_as_uint(rm), __float_as_uint(rm), false, false); rm = __builtin_fmaxf(__uint_as_float(rr[0]), __uint_as_float(rr[1])); } \
      resc = false; \
      if (__builtin_expect(__any(rm > (float)THRL), 0)) { const float dl = __builtin_fmaxf(rm, 0.f); mhat += dl; \
        _Pragma("unroll") for (int r = 0; r < 16; ++r) { C0[r] -= dl; C1[r] -= dl; } \
        _Pragma("unroll") for (int r = 0; r < 16; ++r) negm[r] = -mhat; asm volatile("" : "+v"(negm)); \
        const float f = __builtin_amdgcn_exp2f(-dl); l_reg *= f; if (hi == 0) wsf[r32] = f; resc = true; } } \
    SBAR(); \
    GAPB(o[0] = __builtin_amdgcn_mfma_f32_32x32x16_bf16(PAF(0), VFR(0), o[0], 0, 0, 0), C0, 0); \
    GAPB(o[1] = __builtin_amdgcn_mfma_f32_32x32x16_bf16(PAF(0), VFR(4), o[1], 0, 0, 0), C0, 4); \
    KRD(GL, 0); GAPB(o[0] = __builtin_amdgcn_mfma_f32_32x32x16_bf16(PAF(1), VFR(1), o[0], 0, 0, 0), C0, 8); \
    KRD(GL, 1); GAPB(o[1] = __builtin_amdgcn_mfma_f32_32x32x16_bf16(PAF(1), VFR(5), o[1], 0, 0, 0), C0, 12); \
    KRD(GL, 2); GAPB(o[0] = __builtin_amdgcn_mfma_f32_32x32x16_bf16(PAF(2), VFR(2), o[0], 0, 0, 0), C1, 0); \
    KRD(GL, 3); GAPB(o[1] = __builtin_amdgcn_mfma_f32_32x32x16_bf16(PAF(2), VFR(6), o[1], 0, 0, 0), C1, 4); \
    GAPB(o[0] = __builtin_amdgcn_mfma_f32_32x32x16_bf16(PAF(3), VFR(3), o[0], 0, 0, 0), C1, 8); \
    GAPB(o[1] = __builtin_amdgcn_mfma_f32_32x32x16_bf16(PAF(3), VFR(7), o[1], 0, 0, 0), C1, 12); \
    } while (0)
    int t = 1;
#undef CMASK
#define CMASK(P0, P1, t) do { } while (0)
    for (; t + 5 < NT; t += 2) {
        STEP(pB0, pB1, pA0, pA1, t, true, true, true);     WAIT_BAR(2); RESC(); ROT();
        STEP(pA0, pA1, pB0, pB1, t + 1, true, true, true); WAIT_BAR(2); RESC(); ROT();
    }
#undef CMASK
#define CMASK(P0, P1, t) do { int jb_ = (t) - (NT - 4); if (jb_ >= 0) bmask(P0, P1, TKB(t), qrel, hi); } while (0)
#define ENDW(tt) do { if ((tt) + 3 < NT) { WAIT_BAR(2); } else if ((tt) + 2 < NT) { WAIT_BAR(1); } else { WAIT_BAR(0); } } while (0)
    for (; t + 1 < NT; t += 2) {
        STEP(pB0, pB1, pA0, pA1, t, (t + 3 < NT), (t + 1 < NT), (t + 1 < NT));     ENDW(t);     RESC(); ROT();
        STEP(pA0, pA1, pB0, pB1, t + 1, (t + 4 < NT), (t + 2 < NT), (t + 2 < NT)); ENDW(t + 1); RESC(); ROT();
    }
    if (has_next) {
        const long rowblkN = (long)nb2 * SEQ + nn2 * 128, ctxrowN = (long)NLAT + nb2 * LCTX; const bf16* KcN = QKV + 1024 + nhk2 * D; const bf16* VcN = QKV + 1280 + nhk2 * D;
        const int T0 = sl_next, T1 = NXS(T0), T2 = NXS(T1);
        glds16(KcN + rowblkN * PITCH + klane, (unsigned)__builtin_amdgcn_readfirstlane(kdst + T0));
        glds16(VcN + rowblkN * PITCH + vlane, (unsigned)__builtin_amdgcn_readfirstlane(vdst + T0));
        glds16(KcN + (rowblkN + 64) * PITCH + klane, (unsigned)__builtin_amdgcn_readfirstlane(kdst + T1));
        glds16(KcN + ctxrowN * PITCH + klane, (unsigned)__builtin_amdgcn_readfirstlane(kdst + T2));
    }
    STEP(pB0, pB1, pA0, pA1, NT - 1, false, false, false); RESC();
    if (has_next) {
        const bf16* QwN = QKV + ((long)nb2 * SEQ + nn2 * 128 + (wid & 3) * QBLK) * PITCH + (4 * nhk2 + 2 * npr2 + (wid >> 2)) * D;
#pragma unroll
        for (int d0 = 0; d0 < 4; ++d0) qr[d0] = *reinterpret_cast<const bf16x8*>(&QwN[(long)r32 * PITCH + d0 * 16 + hi * 8]); }
    { float sacc = pB0[0] + pB0[1]; _Pragma("unroll") for (int r = 2; r < 16; ++r) sacc += pB0[r]; _Pragma("unroll") for (int r = 0; r < 16; ++r) sacc += pB1[r]; l_reg += sacc;
      pw0 = (u32x4){PKW(pB0, 0), PKW(pB0, 2), PKW(pB0, 4), PKW(pB0, 6)}; pw1 = (u32x4){PKW(pB0, 8), PKW(pB0, 10), PKW(pB0, 12), PKW(pB0, 14)}; pw2 = (u32x4){PKW(pB1, 0), PKW(pB1, 2), PKW(pB1, 4), PKW(pB1, 6)}; pw3 = (u32x4){PKW(pB1, 8), PKW(pB1, 10), PKW(pB1, 12), PKW(pB1, 14)};
      SBAR(); pv(o, vb0 + sl_cur, PAF(0), PAF(1), PAF(2), PAF(3)); }
#undef PKW
#undef PAF
#undef VFR
#undef PIN
#undef MX3
#undef GAPA
#undef GAPB
#undef EX
#undef VRD
#undef KRD
#undef STEP
#undef ENDW
    { auto rr = __builtin_amdgcn_permlane32_swap(__float_as_uint(l_reg), __float_as_uint(l_reg), false, false); l_reg = __uint_as_float(rr[0]) + __uint_as_float(rr[1]); }
    l_reg += __builtin_amdgcn_exp2f(sinkp[head] * 1.4426950408889634f - mhat);
    if (hi == 0) wsf[32 + r32] = l_reg; asm volatile("s_waitcnt lgkmcnt(0)" ::: "memory");
    float rli[16];
#pragma unroll
    for (int r = 0; r < 16; ++r) rli[r] = __builtin_amdgcn_rcpf(wsf[32 + crow(r, hi)]);
    unsigned char* Ow = O + (rowblk + (wid & 3) * QBLK) * OPITCH + head * D;
    { bf16* stg = (bf16*)(shm + LDS_OST) + wid * 2048;
#pragma unroll
      for (int r = 0; r < 16; ++r) { const int orow = crow(r, hi);
#pragma unroll
        for (int d0 = 0; d0 < 2; ++d0) stg[orow * 64 + d0 * 32 + r32] = __float2bfloat16(o[d0][r] * rli[r]); }
      asm volatile("s_waitcnt lgkmcnt(0)" ::: "memory");
#pragma unroll
      for (int i = 0; i < 4; ++i) { const int row = i * 8 + (lane >> 3), ch = lane & 7; const u32x4 v = *(const u32x4*)(stg + row * 64 + ch * 8);
        u32x2 w; w.x = pk4f8(__uint_as_float(v.x << 16), __uint_as_float(v.x & 0xffff0000u), __uint_as_float(v.y << 16), __uint_as_float(v.y & 0xffff0000u));
        w.y = pk4f8(__uint_as_float(v.z << 16), __uint_as_float(v.z & 0xffff0000u), __uint_as_float(v.w << 16), __uint_as_float(v.w & 0xffff0000u));
        *(u32x2*)(Ow + (long)row * OPITCH + ch * 8) = w; } }
    asm volatile("s_waitcnt lgkmcnt(0)\n\ts_barrier" ::: "memory");
    return sl_next;
#undef NXS
#undef DMA_K
#undef DMA_V
#undef TROW
#undef TKB
#undef CMASK
#undef START
#undef RESC
#undef ROT
}
#undef SBAR
#undef WAIT_BAR
}

#define XB_TMO      128
#define XB_XCNT(j)  (256  + 64 * (j))
#define XB_XSUB(j)  (1280 + 64 * (j))
#define XB_XGEN(j)  (2304 + 64 * (j))
#define XB_TOP      3328
#define XB_TOPGEN   3392
#define XCD_BAR_WORDS 3456
#define XB_SPIN_CAP (1u << 18)
__device__ __forceinline__ unsigned xb_ld(unsigned* p)              { return __hip_atomic_load(p, __ATOMIC_RELAXED, __HIP_MEMORY_SCOPE_AGENT); }
__device__ __forceinline__ unsigned xb_add(unsigned* p, unsigned v) { return __hip_atomic_fetch_add(p, v, __ATOMIC_RELAXED, __HIP_MEMORY_SCOPE_AGENT); }
__device__ __forceinline__ unsigned xb_xcc_id() { return (unsigned)__builtin_amdgcn_s_getreg((3 << 11) | 20) & 0xFu; }
#define XB_SPIN(cond, bar) do { unsigned _sp = 0; while (cond) { __builtin_amdgcn_s_sleep(1); \
    if ((++_sp & 255u) == 0u) { if (xb_ld(&(bar)[XB_TMO])) break; if (_sp > XB_SPIN_CAP) { atomicAdd(&(bar)[XB_TMO], 1u); break; } } } } while (0)
struct XcdBarrier { unsigned* bar; unsigned x; volatile LAS unsigned* st; };
__device__ __forceinline__ XcdBarrier xcd_barrier_post(unsigned* bar, volatile LAS unsigned* st) {
    XcdBarrier b; b.bar = bar; b.x = xb_xcc_id(); b.st = st;
    if (threadIdx.x == 0) (void)xb_add(&bar[XB_XCNT(b.x)], 1u);
    return b;
}
__device__ __forceinline__ void xcd_barrier_complete(unsigned* bar, unsigned x, unsigned& nloc, unsigned& nx) {
    const unsigned G = gridDim.x * gridDim.y * gridDim.z;
    unsigned sum, cnt, mine, sp = 0u;
    for (;;) {
        sum = 0u; cnt = 0u; mine = 0u;
#pragma unroll
        for (unsigned j = 0; j < 16; ++j) { const unsigned c = xb_ld(&bar[XB_XCNT(j)]); sum += c; cnt += (c > 0u) ? 1u : 0u; mine = (j == x) ? c : mine; }
        if (sum == G) break;
        __builtin_amdgcn_s_sleep(1);
        if ((++sp & 255u) == 0u) { if (xb_ld(&bar[XB_TMO])) break; if (sp > XB_SPIN_CAP) { atomicAdd(&bar[XB_TMO], 1u); break; } }
    }
    nloc = mine > 0u ? mine : 1u; nx = cnt > 0u ? cnt : 1u;
}
__device__ __forceinline__ void xcd_barrier(const XcdBarrier& b) {
    asm volatile("s_waitcnt vmcnt(0)" ::: "memory");
    __syncthreads();
    if (threadIdx.x == 0) {
        unsigned* bar = b.bar;
        __builtin_amdgcn_s_waitcnt(0);
        unsigned nloc = b.st[0], nx = b.st[1];
        if (nloc == 0u) { xcd_barrier_complete(bar, b.x, nloc, nx); b.st[0] = nloc; b.st[1] = nx; }
        const unsigned old = xb_add(&bar[XB_XSUB(b.x)], 1u);
        const unsigned gen = old / nloc;
        if (old + 1u == (gen + 1u) * nloc) {
            __builtin_amdgcn_fence(__ATOMIC_RELEASE, "agent");
            asm volatile("s_waitcnt vmcnt(0)" ::: "memory");
            const unsigned og = xb_add(&bar[XB_TOP], 1u);
            const unsigned tg = og / nx;
            if (og + 1u == (tg + 1u) * nx) xb_add(&bar[XB_TOPGEN], 1u);
            else XB_SPIN(xb_ld(&bar[XB_TOPGEN]) == tg, bar);
            __builtin_amdgcn_fence(__ATOMIC_ACQUIRE, "agent");
            xb_add(&bar[XB_XGEN(b.x)], 1u);
            asm volatile("s_waitcnt vmcnt(0)" ::: "memory");
        } else {
            XB_SPIN(xb_ld(&bar[XB_XGEN(b.x)]) == gen, bar);
            __builtin_amdgcn_fence(__ATOMIC_ACQUIRE, "agent");
            asm volatile("s_waitcnt vmcnt(0)" ::: "memory");
        }
    }
    __syncthreads();
}

#define LDS_WAIT() asm volatile("s_waitcnt lgkmcnt(0)" ::: "memory")
__device__ __forceinline__ void transpose_item(const float* W, int K, int N, bf16_t* WT, int k0, int n0, int drow0, LAS float* scr, int lane) {
    float t[32];
#pragma unroll
    for (int i = 0; i < 32; ++i) t[i] = __builtin_nontemporal_load(W + (size_t)(k0 + 2 * i + (lane >> 5)) * N + n0 + (lane & 31));
#pragma unroll
    for (int i = 0; i < 32; ++i) scr[(2 * i + (lane >> 5)) * 33 + (lane & 31)] = t[i];
    LDS_WAIT(); asm volatile("" ::: "memory");
    const int c = lane & 7;
#pragma unroll
    for (int j = 0; j < 4; ++j) { const int n = (lane >> 3) + 8 * j; const LAS float* s = scr + (8 * c) * 33 + n;
        u32x4 o; o.x = pkbf(s[0 * 33], s[1 * 33]); o.y = pkbf(s[2 * 33], s[3 * 33]); o.z = pkbf(s[4 * 33], s[5 * 33]); o.w = pkbf(s[6 * 33], s[7 * 33]);
        *(GAS u32x4*)(WT + (size_t)(drow0 + n) * K + k0 + 8 * c) = o; }
    LDS_WAIT(); asm volatile("" ::: "memory");
}
__device__ __forceinline__ void transpose_item_f8(const float* W, int K, int N, unsigned char* WT, int k0, int n0, int drow0, float scale, LAS float* scr, int lane) {
    float t[32];
#pragma unroll
    for (int i = 0; i < 32; ++i) t[i] = __builtin_nontemporal_load(W + (size_t)(k0 + 2 * i + (lane >> 5)) * N + n0 + (lane & 31));
#pragma unroll
    for (int i = 0; i < 32; ++i) scr[(2 * i + (lane >> 5)) * 33 + (lane & 31)] = t[i];
    LDS_WAIT(); asm volatile("" ::: "memory");
    const int n = lane >> 1, hf = lane & 1; const LAS float* sp = scr + (32 * hf) * 33 + n;
    u32x4 o0, o1;
    o0.x = pk4f8(sp[0 * 33] * scale, sp[1 * 33] * scale, sp[2 * 33] * scale, sp[3 * 33] * scale);     o0.y = pk4f8(sp[4 * 33] * scale, sp[5 * 33] * scale, sp[6 * 33] * scale, sp[7 * 33] * scale);
    o0.z = pk4f8(sp[8 * 33] * scale, sp[9 * 33] * scale, sp[10 * 33] * scale, sp[11 * 33] * scale);   o0.w = pk4f8(sp[12 * 33] * scale, sp[13 * 33] * scale, sp[14 * 33] * scale, sp[15 * 33] * scale);
    o1.x = pk4f8(sp[16 * 33] * scale, sp[17 * 33] * scale, sp[18 * 33] * scale, sp[19 * 33] * scale); o1.y = pk4f8(sp[20 * 33] * scale, sp[21 * 33] * scale, sp[22 * 33] * scale, sp[23 * 33] * scale);
    o1.z = pk4f8(sp[24 * 33] * scale, sp[25 * 33] * scale, sp[26 * 33] * scale, sp[27 * 33] * scale); o1.w = pk4f8(sp[28 * 33] * scale, sp[29 * 33] * scale, sp[30 * 33] * scale, sp[31 * 33] * scale);
    GAS u32x4* dst = (GAS u32x4*)(WT + (size_t)(drow0 + n) * K + k0 + 32 * hf);
    dst[0] = o0; dst[1] = o1;
    LDS_WAIT(); asm volatile("" ::: "memory");
}
__device__ __forceinline__ unsigned pk4i8(float a, float b, float c, float d) {
    const int ia = (int)__builtin_rintf(a), ib = (int)__builtin_rintf(b), ic = (int)__builtin_rintf(c), id = (int)__builtin_rintf(d);
    return (unsigned)(ia & 255) | ((unsigned)(ib & 255) << 8) | ((unsigned)(ic & 255) << 16) | ((unsigned)(id & 255) << 24); }
__device__ __forceinline__ void transpose_item_i8(const float* W, int K, int N, unsigned char* WT, int k0, int n0, int drow0, float scale, LAS float* scr, int lane) {
    float t[32];
#pragma unroll
    for (int i = 0; i < 32; ++i) t[i] = W[(size_t)(k0 + 2 * i + (lane >> 5)) * N + n0 + (lane & 31)];
#pragma unroll
    for (int i = 0; i < 32; ++i) scr[(2 * i + (lane >> 5)) * 33 + (lane & 31)] = t[i];
    LDS_WAIT(); asm volatile("" ::: "memory");
    const int n = lane >> 1, hf = lane & 1; const LAS float* sp = scr + (32 * hf) * 33 + n;
    u32x4 o0, o1;
    o0.x = pk4i8(sp[0 * 33] * scale, sp[1 * 33] * scale, sp[2 * 33] * scale, sp[3 * 33] * scale);     o0.y = pk4i8(sp[4 * 33] * scale, sp[5 * 33] * scale, sp[6 * 33] * scale, sp[7 * 33] * scale);
    o0.z = pk4i8(sp[8 * 33] * scale, sp[9 * 33] * scale, sp[10 * 33] * scale, sp[11 * 33] * scale);   o0.w = pk4i8(sp[12 * 33] * scale, sp[13 * 33] * scale, sp[14 * 33] * scale, sp[15 * 33] * scale);
    o1.x = pk4i8(sp[16 * 33] * scale, sp[17 * 33] * scale, sp[18 * 33] * scale, sp[19 * 33] * scale); o1.y = pk4i8(sp[20 * 33] * scale, sp[21 * 33] * scale, sp[22 * 33] * scale, sp[23 * 33] * scale);
    o1.z = pk4i8(sp[24 * 33] * scale, sp[25 * 33] * scale, sp[26 * 33] * scale, sp[27 * 33] * scale); o1.w = pk4i8(sp[28 * 33] * scale, sp[29 * 33] * scale, sp[30 * 33] * scale, sp[31 * 33] * scale);
    GAS u32x4* dst = (GAS u32x4*)(WT + (size_t)(drow0 + n) * K + k0 + 32 * hf);
    dst[0] = o0; dst[1] = o1;
    LDS_WAIT(); asm volatile("" ::: "memory");
}
__device__ __forceinline__ void sincos_d(double x, double& s, double& c) {
    const double TWO_PI = 6.283185307179586476925;
    const double k = __builtin_rint(x / TWO_PI); const double r = x - k * TWO_PI;
    const double r2 = r * r; double ts = r, tc = 1.0; s = r; c = 1.0;
    for (int i = 1; i <= 16; ++i) { tc *= -r2 / (double)((2 * i - 1) * (2 * i)); ts *= -r2 / (double)((2 * i) * (2 * i + 1)); c += tc; s += ts; }
}

constexpr int CI_F = 16 * 112, CI_FD = 56 * 32, MOE_ITEMS = 8 * (2 * CI_F + CI_FD);
constexpr int MOE_TAIL_A = 12000, MOE_TAIL_B = 7000, MOE_TAIL_C = 12000, MOE_TAIL_TOTAL = MOE_TAIL_A + MOE_TAIL_B + MOE_TAIL_C;
__device__ __forceinline__ void moe_convert_item(int r, const float* wg, const float* wu, const float* wd, unsigned char* mgu, unsigned char* md, LAS float* scr, int lane) {
    const int e = r / (2 * CI_F + CI_FD); int q = r % (2 * CI_F + CI_FD);
    if (q < 2 * CI_F) { const int up = q / CI_F; q %= CI_F; const int kb = q / 112, nb = q % 112, n0 = 32 * nb;
        transpose_item_f8((up ? wu : wg) + (size_t)e * 1024 * DFF, 1024, DFF, mgu + (size_t)e * 7168 * 1024, 64 * kb, n0, 256 * (n0 >> 7) + 128 * up + (n0 & 127), MOE_SGU, scr, lane); }
    else { q -= 2 * CI_F; const int kb = q / 32, nb = q % 32; transpose_item_f8(wd + (size_t)e * DFF * 1024, DFF, 1024, md + (size_t)e * 1024 * DFF, 64 * kb, 32 * nb, 32 * nb, MOE_SD, scr, lane); }
}
__device__ __forceinline__ void moe_convert_tail(int nunits, int G, int bx, int first, int count, const float* wg, const float* wu, const float* wd, unsigned char* mgu, unsigned char* md, LAS unsigned char* lds) {
    const int busy = nunits % G; if (busy == 0 || bx < busy) return;
    int tid_ = threadIdx.x; asm volatile("" : "+v"(tid_)); const int lane = tid_ & 63, wave = __builtin_amdgcn_readfirstlane(tid_ >> 6);
    LAS float* scr = (LAS float*)(lds + wave * 16384);
    const int nw = (G - busy) * 8, w = (bx - busy) * 8 + wave;
    for (int it = w; it < count; it += nw) moe_convert_item(first + it, wg, wu, wd, mgu, md, scr, lane);
}

struct Args { const float* in[24]; float* out; unsigned char* ws; int ph_lo, ph_hi, li, pad; };
constexpr int NPH = 18;

__device__ __forceinline__ void norm_store(const f32x4 (&v)[4], float ssum, const float* g, const float* mrow, int shc, int scc, bf16_t* XNo, size_t m, int lane, float* rsc) {
    const float rstd = 1.0f / __builtin_sqrtf(ssum * (1.0f / DM) + EPS);
    f32x4 y[4];
#pragma unroll
    for (int j = 0; j < 4; ++j) { const f32x4 gv = *(const f32x4*)(g + 4 * lane + 256 * j), sc = *(const f32x4*)(mrow + scc * 1024 + 4 * lane + 256 * j), sh = *(const f32x4*)(mrow + shc * 1024 + 4 * lane + 256 * j);
        y[j] = (v[j] * rstd) * gv * (sc + 1.0f) + sh; }
    if (rsc == nullptr) {
#pragma unroll
        for (int j = 0; j < 4; ++j) { u32x2 w; w.x = pkbf(y[j].x, y[j].y); w.y = pkbf(y[j].z, y[j].w); *((GAS u32x2*)(XNo + m * DM) + lane + 64 * j) = w; }
    } else {
        float mx = 0.f;
#pragma unroll
        for (int j = 0; j < 4; ++j) mx = __builtin_fmaxf(__builtin_fmaxf(mx, __builtin_fmaxf(__builtin_fabsf(y[j].x), __builtin_fabsf(y[j].y))), __builtin_fmaxf(__builtin_fabsf(y[j].z), __builtin_fabsf(y[j].w)));
#pragma unroll
        for (int o = 1; o < 64; o <<= 1) mx = __builtin_fmaxf(mx, __shfl_xor(mx, o));
        mx = __builtin_fmaxf(mx, 1e-20f); const float qs = 127.0f / mx;
#pragma unroll
        for (int j = 0; j < 4; ++j) *((GAS unsigned*)((unsigned char*)XNo + m * DM) + lane + 64 * j) = pk4i8(y[j].x * qs, y[j].y * qs, y[j].z * qs, y[j].w * qs);
        if (lane == 0) rsc[m] = mx * (1.0f / 127.0f);
    }
}
template <bool SRC_BF16> __device__ __forceinline__ void norm_rows(const void* srcLv, const float* srcC, int nrows, const float* g, const float* mod, int shc, int scc, bf16_t* XNo, int gw, int NGW, int lane,
                                          const float* part, int nS, const float* gatec, float* zout, float* rsc = nullptr) {
    if (nrows > NLAT) {
        for (int rc = gw; rc < NCTXR; rc += NGW) {
            const GAS f32x4* xr = (const GAS f32x4*)(srcC + (size_t)rc * DM) + lane;
            f32x4 v[4];
#pragma unroll
            for (int j = 0; j < 4; ++j) v[j] = xr[64 * j];
            if (part != nullptr) {
                f32x4 a[4];
#pragma unroll
                for (int j = 0; j < 4; ++j) a[j] = (f32x4){0.f, 0.f, 0.f, 0.f};
                for (int s0 = 0; s0 < nS; s0 += 7) {
                    f32x4 t[7][4];
#pragma unroll
                    for (int q = 0; q < 7; ++q) { const int s2 = (s0 + q < nS) ? s0 + q : s0; const GAS f32x4* pr = (const GAS f32x4*)(part + ((size_t)s2 * NCTXR + rc) * DM) + lane;
#pragma unroll
                        for (int j = 0; j < 4; ++j) t[q][j] = pr[64 * j]; }
#pragma unroll
                    for (int q = 0; q < 7; ++q) if (s0 + q < nS) {
#pragma unroll
                        for (int j = 0; j < 4; ++j) a[j] += t[q][j]; }
                }
#pragma unroll
                for (int j = 0; j < 4; ++j) v[j] += *(const f32x4*)(gatec + 4 * lane + 256 * j) * a[j];
                if (zout != nullptr) { GAS f32x4* zr = (GAS f32x4*)(zout + (size_t)rc * DM) + lane;
#pragma unroll
                    for (int j = 0; j < 4; ++j) zr[64 * j] = v[j]; }
            }
            float ss = 0.f;
#pragma unroll
            for (int j = 0; j < 4; ++j) ss += (v[j].x * v[j].x + v[j].y * v[j].y) + (v[j].z * v[j].z + v[j].w * v[j].w);
            norm_store(v, wave_sum(ss), g, mod + (size_t)4 * 6144, shc, scc, XNo, (size_t)NLAT + rc, lane, rsc);
        }
    }
    const bool bal = (NGW == 2048) && (nrows > NLAT);
    for (int k = 0;; ++k) {
        int grp;
        if (bal) { if (k < 3) grp = gw + 2048 * k; else if (gw >= 1024 && k < 5) grp = 6144 + 2 * (gw - 1024) + (k - 3); else break; }
        else { grp = gw + k * NGW; if (grp >= NLAT / 4) break; }
        const int m0 = grp * 4;
        const int mb = m0 >> 13;
        f32x4 v[4][4];
        if constexpr (SRC_BF16) { const GAS u32x2* xr = (const GAS u32x2*)((const bf16_t*)srcLv + (size_t)m0 * DM) + lane;
#pragma unroll
            for (int r = 0; r < 4; ++r)
#pragma unroll
                for (int j = 0; j < 4; ++j) { const u32x2 w = xr[r * 256 + 64 * j]; v[r][j] = (f32x4){__uint_as_float(w.x << 16), __uint_as_float(w.x & 0xffff0000u), __uint_as_float(w.y << 16), __uint_as_float(w.y & 0xffff0000u)}; } }
        else { const GAS f32x4* xr = (const GAS f32x4*)((const float*)srcLv + (size_t)m0 * DM) + lane;
#pragma unroll
            for (int r = 0; r < 4; ++r)
#pragma unroll
                for (int j = 0; j < 4; ++j) v[r][j] = xr[r * 256 + 64 * j]; }
        float ss[4];
#pragma unroll
        for (int r = 0; r < 4; ++r) { ss[r] = 0.f;
#pragma unroll
            for (int j = 0; j < 4; ++j) ss[r] += (v[r][j].x * v[r][j].x + v[r][j].y * v[r][j].y) + (v[r][j].z * v[r][j].z + v[r][j].w * v[r][j].w); }
#pragma unroll
        for (int o = 1; o < 64; o <<= 1) {
#pragma unroll
            for (int r = 0; r < 4; ++r) ss[r] += __shfl_xor(ss[r], o); }
#pragma unroll
        for (int r = 0; r < 4; ++r) norm_store(v[r], ss[r], g, mod + (size_t)mb * 6144, shc, scc, XNo, (size_t)(m0 + r), lane, rsc);
    }
}

__global__ void __launch_bounds__(512, 2) fwd(Args args) {
    extern __shared__ __attribute__((aligned(16))) unsigned char lds_raw[];
    LAS unsigned char* lds = (LAS unsigned char*)lds_raw;
    volatile LAS unsigned* MISC = (volatile LAS unsigned*)(lds + MISC_OFF);
    LAS int* gtab = (LAS int*)(lds + GTAB_OFF);
    const int G = gridDim.x; const int bx = blockIdx.x; const int vcu = (G % 8 == 0) ? (bx % 8) * (G / 8) + bx / 8 : bx;
    const int NGW = G * 8;
#define PHASE_IDS() int tid_ = threadIdx.x; asm volatile("" : "+v"(tid_)); const int tid = tid_, lane = tid & 63, wave = __builtin_amdgcn_readfirstlane(tid >> 6), gw = vcu * 8 + wave; (void)lane; (void)gw
    unsigned char* ws = args.ws;
    gu32* ctl = (gu32*)(ws + WS_CTL);
#define MOD ((float*)(ws + WS_MOD))
#define ROPE ((float*)(ws + WS_ROPE))
#define STATS ((float*)(ws + WS_STATS))
#define RSC ((float*)(ws + WS_RSC))
#define LIST ((int*)(ws + WS_LIST))
#define TINFO ((int*)(ws + WS_TINFO))
#define WSB ((bf16_t*)(ws + WS_WS))
#define WIN ((unsigned char*)(ws + WS_WIN))
#define WAO ((bf16_t*)(ws + WS_WAO))
#define WQKV ((unsigned char*)(ws + WS_WQKV))
#define WBO ((unsigned char*)(ws + WS_WBO))
#define WGU ((unsigned char*)(ws + WS_WGU))
#define WD ((bf16_t*)(ws + WS_WD))
#define MGU ((unsigned char*)(ws + WS_MGU))
#define MD ((unsigned char*)(ws + WS_MD))
#define XN8 ((unsigned char*)(ws + WS_XN))
#define XN ((bf16_t*)(ws + WS_XN))
#define ZB ((float*)(ws + WS_ZB))
#define UVT ((bf16_t*)(ws + WS_UVT))
#define A2 ((bf16_t*)(ws + WS_A2))
#define HB ((bf16_t*)(ws + WS_H))
#define QKV ((bf16_t*)(ws + WS_QKV))
#define OB ((unsigned char*)(ws + WS_O))
#define YB ((bf16_t*)(ws + WS_Y))
#define HC ((unsigned char*)(ws + WS_HC))
#define YP ((bf16_t*)(ws + WS_YP))
#define PART1 ((float*)(ws + WS_PART1))
#define PART2 ((float*)(ws + WS_PART2))
#define I_X (args.in[0])
#define I_C (args.in[1])
#define I_CTX (args.in[2])
#define I_CCTX (args.in[3])
#define I_ADAW (args.in[4])
#define I_ADAB (args.in[5])
#define I_NORMG (args.in[6])
#define I_FINALG (args.in[7])
#define HL ((bf16_t*)(ws + WS_HLB))

    { PHASE_IDS(); for (int u = tid; u < (LDS_BYTES - MISC_OFF) / 4; u += 512) ((LAS unsigned*)(lds + MISC_OFF))[u] = 0u; }
    __syncthreads();
    const int lo = args.ph_lo, hi_ph = args.ph_hi;
    const bool one_launch = (hi_ph - lo) > 1;
    XcdBarrier bar; bar.bar = (unsigned*)(ctl + CW_BAR) + args.li * XCD_BAR_WORDS; bar.x = 0; bar.st = nullptr;
    if (one_launch) bar = xcd_barrier_post((unsigned*)(ctl + CW_BAR) + args.li * XCD_BAR_WORDS, MISC + 8);
#ifndef PHMASK
#define PHMASK 0xFFFFFFFFu
#endif
#define IN(k) (((PHMASK >> (k)) & 1) && lo <= (k) && (k) < hi_ph)
#define BOTH(k) (IN(k) && IN((k) + 1))
#define GRID_BAR() xcd_barrier(bar)
#if defined(PROBE_LO)
    unsigned long long tpA = __builtin_amdgcn_s_memrealtime(), tpB = 0;
#define PROBE_MARK(k) do { if ((k) == PROBE_LO - 1) tpA = __builtin_amdgcn_s_memrealtime(); if ((k) == PROBE_HI) tpB = __builtin_amdgcn_s_memrealtime(); } while (0)
#else
#define PROBE_MARK(k) do { } while (0)
#endif

    if (IN(0)) {
        PHASE_IDS();
        {
            LAS float* sv = (LAS float*)lds;
            LAS float* red = (LAS float*)(lds + 5 * 1024 * 4);
            if (bx < 192) {
                for (int idx = tid; idx < 5 * 1024; idx += 512) { const int r = idx >> 10, k = idx & 1023; const float cv = r < 4 ? I_C[r * 1024 + k] : I_CCTX[k]; sv[idx] = cv / (1.0f + __expf(-cv)); }
                __syncthreads();
                for (int item = bx; item < 192; item += G) {
                    const int i = item / 96, n0 = (item % 96) * 64, nn = tid & 63, kq = tid >> 6;
                    float a0 = 0.f, a1 = 0.f, a2 = 0.f, a3 = 0.f, a4 = 0.f;
                    const float* wp = I_ADAW + ((size_t)i * 1024 + kq * 128) * 6144 + n0 + nn;
#pragma unroll 8
                    for (int k = 0; k < 128; ++k) { const float w = wp[(size_t)k * 6144]; const int kk = kq * 128 + k;
                        a0 += sv[kk] * w; a1 += sv[1024 + kk] * w; a2 += sv[2048 + kk] * w; a3 += sv[3072 + kk] * w; a4 += sv[4096 + kk] * w; }
                    red[(kq * 5 + 0) * 64 + nn] = a0; red[(kq * 5 + 1) * 64 + nn] = a1; red[(kq * 5 + 2) * 64 + nn] = a2; red[(kq * 5 + 3) * 64 + nn] = a3; red[(kq * 5 + 4) * 64 + nn] = a4;
                    __syncthreads();
                    if (tid < 320) { const int r = tid >> 6; float s = I_ADAB[i * 6144 + n0 + nn];
#pragma unroll
                        for (int q = 0; q < 8; ++q) s += red[(q * 5 + r) * 64 + nn];
                        MOD[((size_t)i * 5 + r) * 6144 + n0 + nn] = s; }
                    __syncthreads();
                }
            }
            __syncthreads();
        }
        {
            LAS float* scr = (LAS float*)(lds + wave * 16384);
            constexpr int I_IN = 16 * 64, I_AO = 16 * 32, I_QKV = 16 * 48, I_BO = 16 * 32, I_F = 16 * 112, I_FD = 56 * 32;
            constexpr int I_DENSE = I_IN + I_AO + I_QKV + I_BO + 2 * I_F + I_FD, I_MOE = MOE_ITEMS, I_WS = 128, I_ROPE = 32;
            constexpr int NITEMS = I_DENSE + I_MOE + I_WS + I_ROPE;
            for (int it = gw; it < NITEMS; it += NGW) {
                int r = it;
                if (r < I_IN) { const int kb = r / 64, nb = r % 64; const float* W = args.in[8]; float mx = 0.f;
#pragma unroll
                    for (int i = 0; i < 32; ++i) mx = __builtin_fmaxf(mx, __builtin_fabsf(W[(size_t)(64 * kb + 2 * i + (lane >> 5)) * 2048 + 32 * nb + (lane & 31)]));
#pragma unroll
                    for (int o = 1; o < 64; o <<= 1) mx = __builtin_fmaxf(mx, __shfl_xor(mx, o));
                    if (lane == 0) __hip_atomic_fetch_max((unsigned*)(ctl + CW_WAMAX + 192), __float_as_uint(mx), __ATOMIC_RELAXED, __HIP_MEMORY_SCOPE_AGENT);
                    continue; } r -= I_IN;
                if (r < I_AO) { const int kb = r / 32, nb = r % 32; transpose_item(args.in[13], 1024, 1024, WAO, 64 * kb, 32 * nb, 32 * nb, scr, lane); continue; } r -= I_AO;
                if (r < I_QKV) { const int kb = r / 48, nb = r % 48; const float* W = args.in[14]; float mx = 0.f;
#pragma unroll
                    for (int i = 0; i < 32; ++i) mx = __builtin_fmaxf(mx, __builtin_fabsf(W[(size_t)(64 * kb + 2 * i + (lane >> 5)) * NQKV + 32 * nb + (lane & 31)]));
#pragma unroll
                    for (int o = 1; o < 64; o <<= 1) mx = __builtin_fmaxf(mx, __shfl_xor(mx, o));
                    if (lane == 0) __hip_atomic_fetch_max((unsigned*)(ctl + CW_WAMAX + 128), __float_as_uint(mx), __ATOMIC_RELAXED, __HIP_MEMORY_SCOPE_AGENT);
                    continue; } r -= I_QKV;
                if (r < I_BO) { const int kb = r / 32, nb = r % 32; transpose_item_f8(args.in[16], 1024, 1024, WBO, 64 * kb, 32 * nb, 32 * nb, MOE_SGU, scr, lane); continue; } r -= I_BO;
                if (r < 2 * I_F) { const int up = r / I_F; const int q = r % I_F; const int kb = q / 112, nb = q % 112;
                    const float* W = args.in[17 + up]; float mx = 0.f;
#pragma unroll
                    for (int i = 0; i < 32; ++i) mx = __builtin_fmaxf(mx, __builtin_fabsf(W[(size_t)(64 * kb + 2 * i + (lane >> 5)) * DFF + 32 * nb + (lane & 31)]));
#pragma unroll
                    for (int o = 1; o < 64; o <<= 1) mx = __builtin_fmaxf(mx, __shfl_xor(mx, o));
                    if (lane == 0) __hip_atomic_fetch_max((unsigned*)(ctl + CW_WAMAX + 64 * up), __float_as_uint(mx), __ATOMIC_RELAXED, __HIP_MEMORY_SCOPE_AGENT);
                    continue; } r -= 2 * I_F;
                if (r < I_FD) { const int kb = r / 32, nb = r % 32; transpose_item(args.in[19], DFF, 1024, WD, 64 * kb, 32 * nb, 32 * nb, scr, lane); continue; } r -= I_FD;
                if (r < I_MOE) { if (r >= MOE_TAIL_TOTAL) moe_convert_item(r, args.in[21], args.in[22], args.in[23], MGU, MD, scr, lane); continue; } r -= I_MOE;
                if (r < I_WS) { const float* src = args.in[11] + (size_t)r * 2048;
#pragma unroll
                    for (int j = 0; j < 8; ++j) { const f32x4 v = *(const f32x4*)(src + j * 256 + lane * 4); u32x2 w; w.x = pkbf(v.x, v.y); w.y = pkbf(v.z, v.w); *(u32x2*)(WSB + (size_t)r * 2048 + j * 256 + lane * 4) = w; }
                    continue; } r -= I_WS;
                {
                    const int ent = r * 64 + lane; const int pos = ent >> 4, i = ent & 15;
                    double inv = 1.0; for (int q = 0; q < i; ++q) inv *= 0.56234132519034908;
                    const float ang = (float)pos * (float)inv; double s, c; sincos_d((double)ang, s, c);
                    ROPE[ent] = (float)c; ROPE[2048 + ent] = (float)s;
                }
            }
        }
        if (BOTH(0)) GRID_BAR(); PROBE_MARK(0);
    }
    if (IN(1)) { PHASE_IDS();
        {
            LAS float* scr = (LAS float*)(lds + wave * 16384);
            const float ag = __uint_as_float(__hip_atomic_load((unsigned*)(ctl + CW_WAMAX), __ATOMIC_RELAXED, __HIP_MEMORY_SCOPE_AGENT)), au = __uint_as_float(__hip_atomic_load((unsigned*)(ctl + CW_WAMAX + 64), __ATOMIC_RELAXED, __HIP_MEMORY_SCOPE_AGENT));
            if (gw == 0 && lane == 0) { RSC[MALL] = ag * (1.0f / 127.0f); RSC[MALL + 1] = au * (1.0f / 127.0f); }
            const float ai_ = __uint_as_float(__hip_atomic_load((unsigned*)(ctl + CW_WAMAX + 192), __ATOMIC_RELAXED, __HIP_MEMORY_SCOPE_AGENT));
            if (gw == 0 && lane == 0) RSC[MALL + 3] = ai_ * (1.0f / 127.0f);
            for (int it = gw; it < 16 * 64; it += NGW) { const int kb = it / 64, nb = it % 64; transpose_item_i8(args.in[8], 1024, 2048, WIN, 64 * kb, 32 * nb, 32 * nb, 127.0f / ai_, scr, lane); }
            const float aq = __uint_as_float(__hip_atomic_load((unsigned*)(ctl + CW_WAMAX + 128), __ATOMIC_RELAXED, __HIP_MEMORY_SCOPE_AGENT));
            if (gw == 0 && lane == 0) RSC[MALL + 2] = aq * (1.0f / 127.0f);
            for (int it = gw; it < 16 * 48; it += NGW) { const int kb = it / 48, nb = it % 48; transpose_item_i8(args.in[14], 1024, NQKV, WQKV, 64 * kb, 32 * nb, 32 * nb, 127.0f / aq, scr, lane); }
            for (int it = gw; it < 2 * 16 * 112; it += NGW) { const int up = it / (16 * 112), q = it % (16 * 112), kb = q / 112, nb = q % 112, n0 = 32 * nb;
                transpose_item_i8(args.in[17 + up], 1024, DFF, WGU, 64 * kb, n0, 256 * (n0 >> 7) + 128 * up + (n0 & 127), 127.0f / (up ? au : ag), scr, lane); }
        }
        norm_rows<false>(I_X, I_CTX, MALL, I_NORMG + 0 * 1024, MOD, 0, 1, XN, gw, NGW, lane, nullptr, 0, nullptr, nullptr, RSC); if (BOTH(1)) GRID_BAR(); PROBE_MARK(1); }
    if (IN(2)) {
        pg8::DenseSched S{(const char*)WIN, (const char*)XN8, 8, NPA, G, bx, (size_t)256 * 1024};
        pg8::EpiGeluT E{UVT, STATS, RSC, RSC + MALL + 3};
        pg8::gemm_phase<pg8::EpiGeluT, pg8::DenseSched, true, false, false, true>(lds, gtab, 512, 8, S, E);
        moe_convert_tail(8 * NPA, G, bx, 0, MOE_TAIL_A, args.in[21], args.in[22], args.in[23], MGU, MD, lds);
        if (BOTH(2)) GRID_BAR(); PROBE_MARK(2);
    }
    if (IN(3)) {
        PHASE_IDS();
        const float* vg = args.in[9]; const float* vb = args.in[10]; const float* bs = args.in[12];
        LAS unsigned char* buf = lds + wave * 16384;
        LAS float* mu_l = (LAS float*)(lds + RING_BYTES + 4096 + wave * 1024); LAS float* rs_l = mu_l + 128;
        const int r32 = lane & 31, h = lane >> 5;
        for (int unit = gw; unit < (MALL / 128) * 32; unit += NGW) {
            const int ph = unit & 1, g = (unit >> 1) & 15, ch = unit >> 5, q0 = ch * 128;
#pragma unroll
            for (int tt = 0; tt < 2; ++tt) { const int tok = q0 + lane * 2 + tt; const f32x4* sp = (const f32x4*)(STATS + (size_t)tok * 16);
                const f32x4 a = sp[0], b = sp[1], c = sp[2], d = sp[3];
                const float sum = (a.x + a.z) + (b.x + b.z) + (c.x + c.z) + (d.x + d.z), sq = (a.y + a.w) + (b.y + b.w) + (c.y + c.w) + (d.y + d.w);
                const float mean = sum * (1.0f / 1024.0f), var = sq * (1.0f / 1024.0f) - mean * mean;
                mu_l[lane * 2 + tt] = mean; rs_l[lane * 2 + tt] = 1.0f / __builtin_sqrtf(var + EPS); }
            {
                u32x4 t[16]; const int rw = lane >> 4, ck = lane & 15;
                const bf16_t* vp = UVT + (size_t)(1024 + 64 * g + rw) * MALL + q0 + ck * 8;
#pragma unroll
                for (int i = 0; i < 16; ++i) { t[i] = *(const u32x4*)vp; vp += (size_t)4 * MALL; asm volatile("" : "+v"(vp)); }
#pragma unroll
                for (int i = 0; i < 16; ++i) { const int row = 4 * i + rw; *(LAS u32x4*)(buf + row * 256 + ((ck ^ (row & 15)) << 4)) = t[i]; }
            }
            bf16x8 af[2][8];
#pragma unroll
            for (int ct = 0; ct < 2; ++ct) { const int row = 32 * ct + r32; const float vgc = vg[64 * g + row], vbc = vb[64 * g + row];
#pragma unroll
                for (int s2 = 0; s2 < 8; ++s2) { const int qs = 16 * s2 + 8 * h, ck = 2 * s2 + h;
                    const f32x4 m0 = *(const LAS f32x4*)(mu_l + qs), m1 = *(const LAS f32x4*)(mu_l + qs + 4), r0 = *(const LAS f32x4*)(rs_l + qs), r1 = *(const LAS f32x4*)(rs_l + qs + 4);
                    const bf16x8 raw = *(const LAS bf16x8*)(buf + row * 256 + ((ck ^ (row & 15)) << 4));
                    float y[8];
#pragma unroll
                    for (int j = 0; j < 4; ++j) { y[j] = (bf2f((unsigned short)raw[j]) - m0[j]) * r0[j] * vgc + vbc; y[4 + j] = (bf2f((unsigned short)raw[4 + j]) - m1[j]) * r1[j] * vgc + vbc; }
                    u32x4 w; w.x = pkbf(y[0], y[1]); w.y = pkbf(y[2], y[3]); w.z = pkbf(y[4], y[5]); w.w = pkbf(y[6], y[7]); af[ct][s2] = __builtin_bit_cast(bf16x8, w); } }
            {
                u32x4 t[8]; const int rw = lane >> 3, ck = lane & 7;
                const bf16_t* up = UVT + (size_t)(64 * g + rw) * MALL + q0 + 64 * ph + ck * 8;
#pragma unroll
                for (int i = 0; i < 8; ++i) { t[i] = *(const u32x4*)up; up += (size_t)8 * MALL; asm volatile("" : "+v"(up)); }
#pragma unroll
                for (int i = 0; i < 8; ++i) { const int row = 8 * i + rw; *(LAS u32x4*)(buf + row * 128 + ((ck ^ (row & 7)) << 4)) = t[i]; }
            }
#pragma unroll
            for (int ptl = 0; ptl < 2; ++ptl) {
                const int pl = 32 * ptl + r32, p = 64 * ph + pl; const float bsv = bs[g * 128 + p];
                bf16x8 bfr[8];
#pragma unroll
                for (int s2 = 0; s2 < 8; ++s2) bfr[s2] = *(const bf16x8*)(WSB + (size_t)(g * 128 + p) * 128 + 16 * s2 + 8 * h);
                f32x16 acc[2]; acc[0] = f32x16{}; acc[1] = f32x16{};
#pragma unroll
                for (int s2 = 0; s2 < 8; ++s2)
#pragma unroll
                    for (int ct = 0; ct < 2; ++ct) acc[ct] = __builtin_amdgcn_mfma_f32_32x32x16_bf16(af[ct][s2], bfr[s2], acc[ct], 0, 0, 0);
#pragma unroll
                for (int ct = 0; ct < 2; ++ct)
#pragma unroll
                    for (int rr = 0; rr < 4; ++rr) { const int c = 32 * ct + 8 * rr + 4 * h; float o[4];
#pragma unroll
                        for (int e = 0; e < 4; ++e) { const int cc = c + e; const float uu = bf2f(*(const LAS unsigned short*)(buf + cc * 128 + (((pl >> 3) ^ (cc & 7)) << 4) + (pl & 7) * 2)); o[e] = uu * (acc[ct][4 * rr + e] + bsv); }
                        u32x2 w; w.x = pkbf(o[0], o[1]); w.y = pkbf(o[2], o[3]);
                        *(LAS u32x2*)(buf + 8192 + pl * 128 + (((c >> 3) ^ (pl & 7)) << 4) + (c & 7) * 2) = w; }
            }
            {
                const int rw = lane >> 3, ck = lane & 7;
#pragma unroll
                for (int i = 0; i < 8; ++i) { const int row = 8 * i + rw; const u32x4 v = *(const LAS u32x4*)(buf + 8192 + row * 128 + ((ck ^ (row & 7)) << 4));
                    *(u32x4*)(A2 + (size_t)(q0 + 64 * ph + row) * DM + 64 * g + ck * 8) = v; }
            }
        }
        if (BOTH(3)) GRID_BAR(); PROBE_MARK(3);
    }
    if (IN(4)) {
        { pg8::DenseSched S{(const char*)A2, (const char*)WAO, NPL, 4, G, bx, (size_t)256 * 1024 * 2};
          pg8::EpiResid<true> E{I_X, nullptr, HL, MOD + 2 * 1024, 1.0f};
          pg8::gemm_phase<pg8::EpiResid<true>, pg8::DenseSched, true, false>(lds, gtab, 1024, 16, S, E); }
        { pg8::SplitSched S{(const char*)(A2 + (size_t)NLAT * DM), (const char*)WAO, 4, 4, P3_NS, G, bx, NPL, (size_t)256 * 1024 * 2, (size_t)(1024 / P3_NS) * 2};
          pg8::EpiPartF32 E{PART1, (size_t)NCTXR * DM};
          pg8::gemm_phase<pg8::EpiPartF32, pg8::SplitSched, true, false>(lds, gtab, 1024, 1024 / P3_NS / 64, S, E); }
        if (BOTH(4)) GRID_BAR(); PROBE_MARK(4);
    }
    if (IN(5)) { PHASE_IDS(); norm_rows<true>(HL, I_CTX, MALL, I_NORMG + 1 * 1024, MOD, 3, 4, XN, gw, NGW, lane, PART1, P3_NS, MOD + 4 * 6144 + 2 * 1024, ZB, RSC); if (BOTH(5)) GRID_BAR(); PROBE_MARK(5); }
    if (IN(6)) {
        pg8::DenseSched S{(const char*)XN8, (const char*)WGU, NPA, 28, G, bx, (size_t)256 * 1024};
        pg8::EpiSwiGLUI8 E{HB, RSC, RSC + MALL};
        pg8::gemm_phase<pg8::EpiSwiGLUI8, pg8::DenseSched, true, false, false, true>(lds, gtab, 512, 8, S, E);
        moe_convert_tail(NPA * 28, G, bx, MOE_TAIL_A, MOE_TAIL_B, args.in[21], args.in[22], args.in[23], MGU, MD, lds);
        if (BOTH(6)) GRID_BAR(); PROBE_MARK(6);
    }
    if (IN(7)) {
        { pg8::DenseSched S{(const char*)HB, (const char*)WD, NPL, 4, G, bx, (size_t)256 * DFF * 2};
          pg8::EpiResid<false> E{nullptr, HL, HL, MOD + 5 * 1024, 1.0f};
          pg8::gemm_phase<pg8::EpiResid<false>, pg8::DenseSched, true, false>(lds, gtab, DFF, 56, S, E); }
        { pg8::SplitSched S{(const char*)(HB + (size_t)NLAT * DFF), (const char*)WD, 4, 4, P5_NS, G, bx, NPL, (size_t)256 * DFF * 2, (size_t)(DFF / P5_NS) * 2};
          pg8::EpiPartF32 E{PART2, (size_t)NCTXR * DM};
          pg8::gemm_phase<pg8::EpiPartF32, pg8::SplitSched, true, false>(lds, gtab, DFF, DFF / P5_NS / 64, S, E); }
        if (BOTH(7)) GRID_BAR(); PROBE_MARK(7);
    }
    if (IN(8)) { PHASE_IDS(); norm_rows<true>(HL, ZB, MALL, I_NORMG + 2 * 1024, MOD + 5 * 6144, 0, 1, XN, gw, NGW, lane, PART2, P5_NS, MOD + 4 * 6144 + 5 * 1024, nullptr, RSC); if (BOTH(8)) GRID_BAR(); PROBE_MARK(8); }
    if (IN(9)) {
        pg8::DenseSched S{(const char*)XN8, (const char*)WQKV, NPA, 6, G, bx, (size_t)256 * 1024};
        pg8::EpiQKV E{QKV, ROPE, ROPE + 2048, attn_body::C2, RSC, RSC + MALL + 2};
        pg8::gemm_phase<pg8::EpiQKV, pg8::DenseSched, true, false, false, true>(lds, gtab, 512, 8, S, E);
        moe_convert_tail(NPA * 6, G, bx, MOE_TAIL_A + MOE_TAIL_B, MOE_TAIL_C, args.in[21], args.in[22], args.in[23], MGU, MD, lds);
        if (BOTH(9)) GRID_BAR(); PROBE_MARK(9);
    }
    if (IN(10)) {
        static_assert(attn_body::LDS_BYTES_A <= RING_BYTES, "attention LDS");
        const float* sinkp = args.in[15];
        int sb = 0; bool pre = false; bf16x8 qfr[4];
#pragma unroll
        for (int d0 = 0; d0 < 4; ++d0) qfr[d0] = bf16x8{};
        for (int i = 0;; ++i) { const int uid = i * G + vcu; if (uid >= NB * 64 * 4 * 2) break;
            const int pr = uid & 1, hk = (uid >> 1) & 3, n = (uid >> 3) & 63, b = uid >> 9;
            const int uid2 = uid + G; const bool has_next = uid2 < NB * 64 * 4 * 2;
            sb = attn_body::attn_unit<8>(b, hk, n, pr, (const attn_body::bf16*)QKV, OB, sinkp, (char*)lds_raw, sb, pre, has_next, uid2 >> 9, (uid2 >> 1) & 3, (uid2 >> 3) & 63, uid2 & 1, qfr);
            pre = has_next; }
        if (BOTH(10)) GRID_BAR(); PROBE_MARK(10);
    }
    if (IN(11)) {
        pg8::DenseSched S{(const char*)OB, (const char*)WBO, NPL, 4, G, bx, (size_t)256 * 1024};
        pg8::EpiResid<false> E{nullptr, HL, HL, MOD + 5 * 6144 + 2 * 1024, 1.0f / MOE_SGU};
        pg8::gemm_phase<pg8::EpiResid<false>, pg8::DenseSched, true, false, true>(lds, gtab, 512, 8, S, E);
        if (BOTH(11)) GRID_BAR(); PROBE_MARK(11);
    }
    if (IN(12)) {
        PHASE_IDS();
        const float* g = I_NORMG + 3 * 1024; const float* mod = MOD + 5 * 6144; const float* wrt = args.in[20];
        LAS int* l_e = (LAS int*)lds;
        LAS float* l_w = (LAS float*)(lds + 1024);
        LAS int* l_cnt = (LAS int*)(lds + 2048);
        LAS int* l_base = (LAS int*)(lds + 2048 + 64);
        for (int blk = bx; blk < NLAT / 128; blk += G) {
            if (tid < 8) l_cnt[tid] = 0;
            __syncthreads();
            const int mb = (blk * 128) >> 13; const float* mrow = mod + (size_t)mb * 6144;
            for (int i4 = 0; i4 < 8; ++i4) {
                const int tl0 = wave * 16 + i4 * 2, m0 = blk * 128 + tl0;
                const GAS u32x2* xr = (const GAS u32x2*)(HL + (size_t)m0 * DM) + lane;
                f32x4 v[2][4]; float ss[2];
#pragma unroll
                for (int r = 0; r < 2; ++r)
#pragma unroll
                    for (int j = 0; j < 4; ++j) { const u32x2 w = xr[r * 256 + 64 * j]; v[r][j] = (f32x4){__uint_as_float(w.x << 16), __uint_as_float(w.x & 0xffff0000u), __uint_as_float(w.y << 16), __uint_as_float(w.y & 0xffff0000u)}; }
#pragma unroll
                for (int r = 0; r < 2; ++r) { ss[r] = 0.f;
#pragma unroll
                    for (int j = 0; j < 4; ++j) ss[r] += (v[r][j].x * v[r][j].x + v[r][j].y * v[r][j].y) + (v[r][j].z * v[r][j].z + v[r][j].w * v[r][j].w); }
#pragma unroll
                for (int o = 1; o < 64; o <<= 1) {
#pragma unroll
                    for (int r = 0; r < 2; ++r) ss[r] += __shfl_xor(ss[r], o); }
                float lg[2][8];
#pragma unroll
                for (int r = 0; r < 2; ++r)
#pragma unroll
                    for (int e = 0; e < 8; ++e) lg[r][e] = 0.f;
#pragma unroll
                for (int j = 0; j < 4; ++j) { const int col = 4 * lane + 256 * j; const f32x4 gv = *(const f32x4*)(g + col), sc = *(const f32x4*)(mrow + 4 * 1024 + col), sh = *(const f32x4*)(mrow + 3 * 1024 + col);
                    const f32x4 gm = gv * (sc + 1.0f);
                    f32x4 y[2];
#pragma unroll
                    for (int r = 0; r < 2; ++r) { const float rstd = 1.0f / __builtin_sqrtf(ss[r] * (1.0f / DM) + EPS); y[r] = (v[r][j] * rstd) * gm + sh;
                        *((GAS unsigned*)(XN8 + (size_t)(m0 + r) * DM) + lane + 64 * j) = pk4f8(y[r].x, y[r].y, y[r].z, y[r].w); }
#pragma unroll
                    for (int cc = 0; cc < 4; ++cc) { const f32x4 w0 = *(const f32x4*)(wrt + (size_t)(col + cc) * 8), w1 = *(const f32x4*)(wrt + (size_t)(col + cc) * 8 + 4);
#pragma unroll
                        for (int r = 0; r < 2; ++r) { const float yv = y[r][cc];
                            lg[r][0] += yv * w0.x; lg[r][1] += yv * w0.y; lg[r][2] += yv * w0.z; lg[r][3] += yv * w0.w; lg[r][4] += yv * w1.x; lg[r][5] += yv * w1.y; lg[r][6] += yv * w1.z; lg[r][7] += yv * w1.w; } } }
#pragma unroll
                for (int o = 1; o < 64; o <<= 1) {
#pragma unroll
                    for (int r = 0; r < 2; ++r)
#pragma unroll
                        for (int e = 0; e < 8; ++e) lg[r][e] += __shfl_xor(lg[r][e], o); }
#pragma unroll
                for (int r = 0; r < 2; ++r) {
                    int ea = 0; float va = lg[r][0];
#pragma unroll
                    for (int e = 1; e < 8; ++e) if (lg[r][e] > va) { va = lg[r][e]; ea = e; }
                    int eb = -1; float vb2 = -INFINITY;
#pragma unroll
                    for (int e = 0; e < 8; ++e) if (e != ea && lg[r][e] > vb2) { vb2 = lg[r][e]; eb = e; }
                    const float wb = 1.0f / (1.0f + __expf(va - vb2)), wa = 1.0f - wb;
                    if (lane == 0) { const int tl = tl0 + r; l_e[tl * 2] = ea; l_e[tl * 2 + 1] = eb; l_w[tl * 2] = wa; l_w[tl * 2 + 1] = wb; } }
            }
            __syncthreads();
            int ea = 0, eb = 0, pa = 0, pb = 0;
            if (tid < 128) { ea = l_e[tid * 2]; eb = l_e[tid * 2 + 1]; pa = atomicAdd((int*)&l_cnt[ea], 1); pb = atomicAdd((int*)&l_cnt[eb], 1); }
            __syncthreads();
            if (tid < 8) l_base[tid] = (int)__hip_atomic_fetch_add((unsigned*)(ctl + CW_CNT + 64 * tid), (unsigned)l_cnt[tid], __ATOMIC_RELAXED, __HIP_MEMORY_SCOPE_AGENT);
            __syncthreads();
            if (tid < 128) { const int m = blk * 128 + tid; pa += l_base[ea]; pb += l_base[eb];
                LIST[(size_t)ea * NLAT + pa] = m; LIST[(size_t)eb * NLAT + pb] = m;
                int* ti = TINFO + (size_t)m * 8; ti[0] = ea; ti[1] = pa; ti[2] = eb; ti[3] = pb; ti[4] = __float_as_int(l_w[tid * 2]); ti[5] = __float_as_int(l_w[tid * 2 + 1]); }
            __syncthreads();
        }
        if (BOTH(12)) GRID_BAR(); PROBE_MARK(12);
    }
    if (hi_ph > 13 && lo < 17) {
        PHASE_IDS();
        LAS int* mtab = (LAS int*)(lds + MOE_OFF);
        if (tid == 0) { int run = 0, R = 0;
            for (int e = 0; e < 8; ++e) { const int ce = (int)__hip_atomic_load((unsigned*)(ctl + CW_CNT + 64 * e), __ATOMIC_RELAXED, __HIP_MEMORY_SCOPE_AGENT); mtab[e] = run; mtab[16 + e] = ce; run += ce >> 8; if (ce & 255) { mtab[24 + R] = e; ++R; } }
            mtab[8] = run; mtab[32] = R; }
        __syncthreads();
        const int nfull = __builtin_amdgcn_readfirstlane(mtab[8]);
        for (int c = 0; c < MOE_NCH; ++c) {
            const int gp0 = c * MOE_CH, gp1 = nfull < (c + 1) * MOE_CH ? nfull : (c + 1) * MOE_CH;
            if (IN(13 + 2 * c)) {
                { pg8::MoeSched S; S.A = (const char*)XN8; S.B = (const char*)MGU; S.list = LIST; S.tab = mtab; S.mode = 0; S.nS = 1; S.kbytes = 0; S.omoff = 0;
                  S.gp0 = gp0; S.gp1 = gp1; S.nN = 28; S.G = G; S.c = bx; S.bexp = (size_t)7168 * 1024; S.btile = (size_t)256 * 1024; S.astep = 0; S.gather = true;
                  pg8::EpiSwiGLU8 E{HC, 1.0f / MOE_SGU};
                  pg8::gemm_phase<pg8::EpiSwiGLU8, pg8::MoeSched, true, true, true>(lds, gtab, 512, 8, S, E); }
                if (c == 0) { pg8::MoeSched S; S.A = (const char*)XN8; S.B = (const char*)MGU; S.list = LIST; S.tab = mtab; S.mode = 1; S.nS = 1; S.kbytes = 0; S.omoff = MOE_CH;
                  S.gp0 = 0; S.gp1 = 0; S.nN = 28; S.G = G; S.c = bx; S.bexp = (size_t)7168 * 1024; S.btile = (size_t)256 * 1024; S.astep = 0; S.gather = true;
                  pg8::EpiSwiGLU8 E{HC, 1.0f / MOE_SGU};
                  pg8::gemm_phase<pg8::EpiSwiGLU8, pg8::MoeSched, true, true, true>(lds, gtab, 512, 8, S, E); }
                if (BOTH(13 + 2 * c)) GRID_BAR(); PROBE_MARK(13 + 2 * c);
            }
            if (IN(14 + 2 * c)) {
                { pg8::MoeSched S; S.A = (const char*)HC; S.B = (const char*)MD; S.list = LIST; S.tab = mtab; S.mode = 0; S.nS = 1; S.kbytes = 0; S.omoff = 0;
                  S.gp0 = gp0; S.gp1 = gp1; S.nN = 4; S.G = G; S.c = bx; S.bexp = (size_t)1024 * DFF; S.btile = (size_t)256 * DFF; S.astep = (size_t)256 * DFF; S.gather = false;
                  pg8::EpiBf16Plain E{YB, DM, 1.0f / MOE_SD};
                  pg8::gemm_phase<pg8::EpiBf16Plain, pg8::MoeSched, true, false, true>(lds, gtab, DFF / 2, 28, S, E); }
                if (c == 0) { pg8::MoeSched S; S.A = (const char*)(HC + (size_t)MOE_CH * 256 * DFF); S.B = (const char*)MD; S.list = LIST; S.tab = mtab; S.mode = 2; S.nS = MOE_RS; S.kbytes = (size_t)(DFF / MOE_RS); S.omoff = 0;
                  S.gp0 = 0; S.gp1 = 0; S.nN = 4; S.G = G; S.c = bx; S.bexp = (size_t)1024 * DFF; S.btile = (size_t)256 * DFF; S.astep = (size_t)256 * DFF; S.gather = false;
                  pg8::EpiPartBf16 E{YP, (size_t)8 * 256 * DM, 1.0f / MOE_SD};
                  pg8::gemm_phase<pg8::EpiPartBf16, pg8::MoeSched, true, false, true>(lds, gtab, DFF / 2, DFF / MOE_RS / 128, S, E); }
                if (BOTH(14 + 2 * c)) GRID_BAR(); PROBE_MARK(14 + 2 * c);
            }
        }
    }
    if (IN(17)) {
        PHASE_IDS();
        LAS int* l_pb = (LAS int*)(lds + wave * 128);
        if (lane == 0) { int run = 0, R = 0;
            for (int e = 0; e < 8; ++e) { const int ce = (int)__hip_atomic_load((unsigned*)(ctl + CW_CNT + 64 * e), __ATOMIC_RELAXED, __HIP_MEMORY_SCOPE_AGENT); l_pb[e] = run; l_pb[8 + e] = ce >> 8; l_pb[16 + e] = R; run += ce >> 8; if (ce & 255) ++R; } }
        const float* g2 = MOD + 5 * 6144 + 5 * 1024;
        for (int m0 = gw * 2; m0 < NLAT; m0 += NGW * 2) {
            const int mb = m0 >> 13;
            f32x4 hv[2][4], ya[2][4], yb[2][4]; float wa[2], wb[2];
#pragma unroll
            for (int r = 0; r < 2; ++r) {
                const int m = m0 + r; const int* ti = TINFO + (size_t)m * 8;
                const int ea = ti[0], pa = ti[1], eb = ti[2], pb = ti[3]; wa[r] = __int_as_float(ti[4]); wb[r] = __int_as_float(ti[5]);
                const bool ma = (pa >> 8) < l_pb[8 + ea], mbm = (pb >> 8) < l_pb[8 + eb];
                const size_t sa = ma ? (size_t)(l_pb[ea] + (pa >> 8)) * 256 + (pa & 255) : (size_t)l_pb[16 + ea] * 256 + (pa & 255);
                const size_t sb = mbm ? (size_t)(l_pb[eb] + (pb >> 8)) * 256 + (pb & 255) : (size_t)l_pb[16 + eb] * 256 + (pb & 255);
                const GAS u32x2* xr = (const GAS u32x2*)(HL + (size_t)m * DM) + lane;
#pragma unroll
                for (int j = 0; j < 4; ++j) { const u32x2 w = xr[64 * j]; hv[r][j] = (f32x4){__uint_as_float(w.x << 16), __uint_as_float(w.x & 0xffff0000u), __uint_as_float(w.y << 16), __uint_as_float(w.y & 0xffff0000u)}; }
                { const GAS u32x2* yr = (const GAS u32x2*)((ma ? YB : YP) + sa * DM) + lane;
#pragma unroll
                  for (int j = 0; j < 4; ++j) { const u32x2 a = yr[64 * j]; ya[r][j] = (f32x4){__uint_as_float(a.x << 16), __uint_as_float(a.x & 0xffff0000u), __uint_as_float(a.y << 16), __uint_as_float(a.y & 0xffff0000u)}; }
                  if (!ma) for (int s2 = 1; s2 < MOE_RS; ++s2) { const GAS u32x2* y2 = (const GAS u32x2*)(YP + ((size_t)s2 * 8 * 256 + sa) * DM) + lane;
#pragma unroll
                      for (int j = 0; j < 4; ++j) { const u32x2 a = y2[64 * j]; ya[r][j] += (f32x4){__uint_as_float(a.x << 16), __uint_as_float(a.x & 0xffff0000u), __uint_as_float(a.y << 16), __uint_as_float(a.y & 0xffff0000u)}; } } }
                { const GAS u32x2* yr = (const GAS u32x2*)((mbm ? YB : YP) + sb * DM) + lane;
#pragma unroll
                  for (int j = 0; j < 4; ++j) { const u32x2 a = yr[64 * j]; yb[r][j] = (f32x4){__uint_as_float(a.x << 16), __uint_as_float(a.x & 0xffff0000u), __uint_as_float(a.y << 16), __uint_as_float(a.y & 0xffff0000u)}; }
                  if (!mbm) for (int s2 = 1; s2 < MOE_RS; ++s2) { const GAS u32x2* y2 = (const GAS u32x2*)(YP + ((size_t)s2 * 8 * 256 + sb) * DM) + lane;
#pragma unroll
                      for (int j = 0; j < 4; ++j) { const u32x2 a = y2[64 * j]; yb[r][j] += (f32x4){__uint_as_float(a.x << 16), __uint_as_float(a.x & 0xffff0000u), __uint_as_float(a.y << 16), __uint_as_float(a.y & 0xffff0000u)}; } } }
            }
            float ss[2];
#pragma unroll
            for (int r = 0; r < 2; ++r) { ss[r] = 0.f;
#pragma unroll
                for (int j = 0; j < 4; ++j) { const f32x4 gv = *(const f32x4*)(g2 + (size_t)mb * 6144 + 4 * lane + 256 * j);
                    hv[r][j] = hv[r][j] + gv * (ya[r][j] * wa[r] + yb[r][j] * wb[r]); ss[r] += (hv[r][j].x * hv[r][j].x + hv[r][j].y * hv[r][j].y) + (hv[r][j].z * hv[r][j].z + hv[r][j].w * hv[r][j].w); } }
#pragma unroll
            for (int o = 1; o < 64; o <<= 1) {
#pragma unroll
                for (int r = 0; r < 2; ++r) ss[r] += __shfl_xor(ss[r], o); }
#pragma unroll
            for (int r = 0; r < 2; ++r) { const float rstd = 1.0f / __builtin_sqrtf(ss[r] * (1.0f / DM) + EPS);
                GAS f32x4* orow = (GAS f32x4*)(args.out + (size_t)(m0 + r) * DM) + lane;
#pragma unroll
                for (int j = 0; j < 4; ++j) { const f32x4 fg = *(const f32x4*)(I_FINALG + 4 * lane + 256 * j); __builtin_nontemporal_store((hv[r][j] * rstd) * fg, orow + 64 * j); } }
        }
    }
    PROBE_MARK(17);
#if defined(PROBE_LO)
    { PHASE_IDS(); const float T = (float)(tpB - tpA) * 0.01f; const float cval = __builtin_sqrtf(T / (float)(PROBE_UNIT));
      for (int m = gw; m < NLAT; m += NGW) { GAS f32x4* orow = (GAS f32x4*)(args.out + (size_t)m * DM) + lane;
#pragma unroll
        for (int j = 0; j < 4; ++j) orow[64 * j] = (f32x4){cval, cval, cval, cval}; } }
#endif
#undef IN
#undef BOTH
#undef GRID_BAR
}

#ifndef MK_ONE_LAUNCH
#define MK_ONE_LAUNCH 1
#endif
extern "C" void kernel_launch(void* const* d_in, const int* in_sizes, int n_in, void* d_out, int out_size, void* d_ws, size_t ws_size, hipStream_t stream) {
    static int grid = 0;
    if (grid == 0) {
        if (n_in != 24 || out_size != NLAT * DM || ws_size < WS_END) { fprintf(stderr, "kernel_launch: unexpected problem (n_in %d, out %d, ws %zu < %zu)\n", n_in, out_size, ws_size, (size_t)WS_END); grid = -1; return; }
        int dev = 0, cus = 0, per_cu = 0;
        if (hipGetDevice(&dev) != hipSuccess || hipDeviceGetAttribute(&cus, hipDeviceAttributeMultiprocessorCount, dev) != hipSuccess) { grid = -1; return; }
        if (hipFuncSetAttribute((const void*)fwd, hipFuncAttributeMaxDynamicSharedMemorySize, LDS_BYTES) != hipSuccess) { fprintf(stderr, "kernel_launch: hipFuncSetAttribute failed\n"); grid = -1; return; }
        if (hipOccupancyMaxActiveBlocksPerMultiprocessor(&per_cu, (const void*)fwd, 512, LDS_BYTES) != hipSuccess || per_cu < 1) fprintf(stderr, "kernel_launch: occupancy query says %d\n", per_cu);
        (void)hipGetLastError();
        grid = cus;
    }
    if (grid < 0) return;
    if (hipMemsetAsync((char*)d_ws + WS_CTL, 0, CTL_ZERO_BYTES, stream) != hipSuccess) return;
    Args a{};
    for (int i = 0; i < 24; ++i) a.in[i] = (const float*)d_in[i];
    a.out = (float*)d_out; a.ws = (unsigned char*)d_ws;
#if defined(SPLITAT)
    a.ph_lo = 0; a.ph_hi = SPLITAT; a.li = 0;
    hipLaunchKernelGGL(fwd, dim3(grid), dim3(512), LDS_BYTES, stream, a);
    a.ph_lo = SPLITAT; a.ph_hi = NPH; a.li = 1;
    hipLaunchKernelGGL(fwd, dim3(grid), dim3(512), LDS_BYTES, stream, a);
#elif defined(DUPK)
    a.ph_lo = 0; a.ph_hi = DUPK + 1; a.li = 0;
    hipLaunchKernelGGL(fwd, dim3(grid), dim3(512), LDS_BYTES, stream, a);
#ifdef DUPN
    for (int rep = 0; rep < DUPN; ++rep) { a.ph_lo = DUPK; a.ph_hi = DUPK + 1; a.li = 2; hipLaunchKernelGGL(fwd, dim3(grid), dim3(512), LDS_BYTES, stream, a); }
#endif
    a.ph_lo = DUPK; a.ph_hi = NPH; a.li = 1;
    hipLaunchKernelGGL(fwd, dim3(grid), dim3(512), LDS_BYTES, stream, a);
#elif MK_ONE_LAUNCH
    a.ph_lo = 0; a.ph_hi = NPH;
    hipLaunchKernelGGL(fwd, dim3(grid), dim3(512), LDS_BYTES, stream, a);
#else
    for (int p = 0; p < NPH; ++p) { a.ph_lo = p; a.ph_hi = p + 1; hipLaunchKernelGGL(fwd, dim3(grid), dim3(512), LDS_BYTES, stream, a); }
#endif
}
```

```cpp
#include <hip/hip_runtime.h>
#include <hip/hip_bf16.h>
#include <cstdio>
#include <cstdint>
#include <cmath>

constexpr int DM = 1024, NB = 4, SEQ = 8192, LCTX = 256, NLAT = NB * SEQ, NCTXR = NB * LCTX, MALL = NLAT + NCTXR;
constexpr int DFF = 3584, NEXP = 8, NQKV = 1536;
constexpr int NPL = NLAT / 256, NPA = MALL / 256;
constexpr float EPS = 1e-6f;
constexpr int MOE_CH = 128, MOE_NCH = 2;
constexpr float MOE_SGU = 32.0f, MOE_SD = 64.0f;
constexpr int MOE_RS = 7, P3_NS = 8, P5_NS = 14;

#define LAS __attribute__((address_space(3)))
#define GAS __attribute__((address_space(1)))
typedef unsigned short bf16_t;
typedef short bf16x8 __attribute__((ext_vector_type(8)));
typedef float f32x4 __attribute__((ext_vector_type(4)));
typedef float f32x2 __attribute__((ext_vector_type(2)));
typedef float f32x16 __attribute__((ext_vector_type(16)));
typedef unsigned u32x4 __attribute__((ext_vector_type(4)));
typedef unsigned u32x2 __attribute__((ext_vector_type(2)));
typedef __bf16 bf16x2_t __attribute__((ext_vector_type(2)));
typedef GAS unsigned gu32;

__device__ __forceinline__ unsigned pkbf(float lo, float hi) { f32x2 v = {lo, hi}; bf16x2_t b = __builtin_convertvector(v, bf16x2_t); return __builtin_bit_cast(unsigned, b); }
__device__ __forceinline__ unsigned pk4f8(float a, float b, float c, float d) { unsigned w = 0; w = __builtin_amdgcn_cvt_pk_fp8_f32(a, b, w, false); w = __builtin_amdgcn_cvt_pk_fp8_f32(c, d, w, true); return w; }
typedef float f32x16v __attribute__((ext_vector_type(16)));
typedef unsigned u32x6 __attribute__((ext_vector_type(6)));
__device__ __forceinline__ void mxfp6_block(const float (&x)[32], u32x4& c0, u32x4& c1) {
    float mx = 0.f;
#pragma unroll
    for (int i = 0; i < 32; ++i) mx = __builtin_fmaxf(mx, __builtin_fabsf(x[i]));
    int eb = (int)((__float_as_uint(mx) >> 23) & 255u) - 2; eb = eb < 1 ? 1 : eb;
    const float sc = __uint_as_float((unsigned)eb << 23);
    f32x16v a, b;
#pragma unroll
    for (int i = 0; i < 16; ++i) { a[i] = x[i]; b[i] = x[16 + i]; }
    const u32x6 p = __builtin_amdgcn_cvt_scalef32_2xpk16_fp6_f32(a, b, sc);
    c0 = (u32x4){p[0], p[1], p[2], p[3]}; c1 = (u32x4){p[4], p[5], (unsigned)eb, 0u};
}
__device__ __forceinline__ float bf2f(unsigned short h) { return __builtin_bit_cast(float, (unsigned)h << 16); }
__device__ __forceinline__ float wave_sum(float v) {
#pragma unroll
    for (int o = 1; o < 64; o <<= 1) v += __shfl_xor(v, o);
    return v;
}
__device__ __forceinline__ float gelu_tanh(float x) {
    const float t = x * (1.0f + 0.044715f * x * x);
    const float e = __builtin_amdgcn_exp2f(-2.302208198f * t);
    return x * __builtin_amdgcn_rcpf(1.0f + e);
}
__device__ __forceinline__ float silu_f(float x) { return x * __builtin_amdgcn_rcpf(1.0f + __builtin_amdgcn_exp2f(-1.4426950409f * x)); }

constexpr size_t MiB = 1u << 20;
constexpr size_t WS_CTL = 0, CTL_ZERO_BYTES = 1 * MiB;
constexpr size_t WS_MOD = 1 * MiB;
constexpr size_t WS_ROPE = 1 * MiB + 256 * 1024;
constexpr size_t WS_STATS = 2 * MiB;
constexpr size_t WS_RSC = 4 * MiB + 512 * 1024;
constexpr size_t WS_LIST = 5 * MiB;
constexpr size_t WS_TINFO = 6 * MiB;
constexpr size_t WS_WS = 7 * MiB;
constexpr size_t WS_WIN = 8 * MiB, WS_WAO = 12 * MiB, WS_WQKV = 14 * MiB, WS_WBO = 17 * MiB, WS_WGU = 19 * MiB, WS_WD = 33 * MiB;
constexpr size_t WS_MGU = 40 * MiB, WS_MD = 96 * MiB;
constexpr size_t WS_HLB = 124 * MiB;
constexpr size_t WS_XN = 208 * MiB;
constexpr size_t WS_ZB = 274 * MiB;
constexpr size_t WS_R = 278 * MiB;
constexpr size_t WS_UVT = WS_R, WS_A2 = WS_R + 132 * MiB, WS_PART1 = WS_R + 198 * MiB, WS_H = WS_R, WS_PART2 = WS_R + 231 * MiB;
constexpr size_t WS_QKV = WS_R, WS_O = WS_R + 99 * MiB;
constexpr size_t WS_Y = WS_R, WS_YP = WS_R + 128 * MiB, WS_HC = WS_R + 156 * MiB;
constexpr size_t WS_END = WS_R + 287 * MiB;
static_assert(WS_UVT + (size_t)2048 * MALL * 2 <= WS_A2 && WS_A2 + (size_t)MALL * DM * 2 <= WS_PART1 && WS_PART1 + (size_t)P3_NS * NCTXR * DM * 4 <= WS_END, "layer-0 mixer map");
static_assert(WS_H + (size_t)MALL * DFF * 2 <= WS_PART2 && WS_PART2 + (size_t)P5_NS * NCTXR * DM * 4 <= WS_END && WS_QKV + (size_t)MALL * NQKV * 2 <= WS_O && WS_O + (size_t)NLAT * DM * 2 <= WS_END, "region map");
static_assert(WS_Y + (size_t)256 * 256 * DM * 2 <= WS_YP && WS_YP + (size_t)MOE_RS * 8 * 256 * DM * 2 <= WS_HC && WS_HC + (size_t)(MOE_CH + 8) * 256 * DFF <= WS_END, "MoE map");
static_assert(WS_MD + (size_t)8 * DM * DFF <= WS_HLB && WS_HLB + (size_t)NLAT * DM * 2 <= WS_XN && WS_XN + (size_t)MALL * DM * 2 <= WS_ZB && WS_MD + (size_t)8 * DM * DFF <= WS_XN && WS_MGU + (size_t)8 * 7168 * DM <= WS_MD, "weights map");
constexpr int CW_TMO = 0, CW_CODE = 1;
constexpr int CW_CNT = 64;
constexpr int CW_WAMAX = 1024;
constexpr int CW_BAR = 4096;

constexpr int RING_BYTES = 131072;
constexpr int GTAB_OFF = RING_BYTES;
constexpr int MOE_OFF = RING_BYTES + 1024;
constexpr int MISC_OFF = RING_BYTES + 2048;
constexpr int STAB_OFF = RING_BYTES + 3072;
constexpr int LDS_BYTES = 147456;

namespace pg8 {
constexpr int BM = 256, BK = 64, HALF = 128, HTB = HALF * BK * 2, STAGE_BYTES = 8 * HTB, NXCD = 8, WGM = 8;
__host__ __device__ __forceinline__ int lds_byte(int r, int c) { const int st = (r >> 4) * 2 + (c >> 5), rr = r & 15, cc = c & 31, ob = rr * 64 + cc * 2; return st * 1024 + (ob ^ (((ob >> 9) & 1) << 5)); }
__host__ __device__ __forceinline__ void stage_rc(int b, int& R, int& C) { const int st = b / 1024, sb = b % 1024, swz = sb ^ (((sb >> 9) & 1) << 5); R = (st >> 1) * 16 + swz / 64; C = (st & 1) * 32 + (swz % 64) / 2; }
__host__ __device__ __forceinline__ int perm32(int rho) { const int n = rho >> 4, i = rho & 15; return 8 * (i >> 2) + 4 * n + (i & 3); }

struct Unit { const char* a; const char* b; const int* gl; int pm, pn, om, nv, ks; };

__device__ __forceinline__ bool tile_order(int i, int G, int c, int nM, int nN, int& pm, int& pn) {
    const int nwg = nM * nN; const long L = (long)i * G + c; if (L >= nwg) return false;
    int wgid = (int)L; { const int q = nwg / NXCD, r = nwg % NXCD, xcd = wgid % NXCD, off = wgid / NXCD; wgid = (xcd < r ? xcd * (q + 1) : r * (q + 1) + (xcd - r) * q) + off; }
    const int nig = WGM * nN, gid = wgid / nig, fm = gid * WGM, gsz = (nM - fm) < WGM ? (nM - fm) : WGM;
    pm = fm + ((wgid % nig) % gsz); pn = (wgid % nig) / gsz; return true;
}
struct DenseSched {
    const char* A; const char* B; int nM, nN, G, c; size_t tstep;
    __device__ __forceinline__ bool next(int i, Unit& u) const {
        int pm, pn; if (!tile_order(i, G, c, nM, nN, pm, pn)) return false;
        u.a = A + (size_t)pm * tstep; u.b = B + (size_t)pn * tstep; u.gl = nullptr; u.pm = pm; u.pn = pn; u.om = pm; u.nv = 256; u.ks = 0; return true;
    }
};
typedef int v8i_t __attribute__((ext_vector_type(8)));
typedef int v4i_t __attribute__((ext_vector_type(4)));
__device__ __forceinline__ v8i_t cat8(bf16x8 lo, bf16x8 hi) { const v4i_t a = __builtin_bit_cast(v4i_t, lo), b = __builtin_bit_cast(v4i_t, hi); return __builtin_shufflevector(a, b, 0, 1, 2, 3, 4, 5, 6, 7); }
struct SplitSched {
    const char* A; const char* B; int nM, nN, nS, G, c, pm0; size_t tstep, kbytes;
    __device__ __forceinline__ bool next(int i, Unit& u) const {
        const int L = i * G + c; if (L >= nM * nN * nS) return false;
        const int ks = L % nS, t = L / nS, pn = t % nN, pm = t / nN;
        u.a = A + (size_t)pm * tstep + (size_t)ks * kbytes; u.b = B + (size_t)pn * tstep + (size_t)ks * kbytes; u.gl = nullptr; u.pm = pm0 + pm; u.pn = pn; u.om = pm; u.nv = 256; u.ks = ks; return true;
    }
};
struct MoeSched {
    const char* A; const char* B; const int* list; const LAS int* tab; int gp0, gp1, nN, nS, G, c, mode, omoff; size_t bexp, btile, astep, kbytes; bool gather;
    __device__ __forceinline__ bool next(int i, Unit& u) const {
        int pm, pn, ks = 0;
        if (mode == 0) { if (gp1 <= gp0) return false; if (!tile_order(i, G, c, gp1 - gp0, nN, pm, pn)) return false; }
        else { const int R = __builtin_amdgcn_readfirstlane(tab[32]); const int L = i * G + c; if (L >= R * nN * nS) return false; ks = L % nS; const int t = L / nS; pn = t % nN; pm = t / nN; }
        int e = 0, lp, nv;
        if (mode == 0) { const int gp = gp0 + pm;
#pragma unroll
            for (int k = 1; k < 8; ++k) e += (gp >= __builtin_amdgcn_readfirstlane(tab[k])) ? 1 : 0;
            lp = gp - __builtin_amdgcn_readfirstlane(tab[e]); nv = 256; u.pm = gp; }
        else { e = __builtin_amdgcn_readfirstlane(tab[24 + pm]); const int ce = __builtin_amdgcn_readfirstlane(tab[16 + e]); lp = ce >> 8; nv = ce & 255; u.pm = pm; }
        u.b = B + (size_t)e * bexp + (size_t)pn * btile + (size_t)ks * kbytes; u.pn = pn; u.nv = nv; u.ks = ks; u.om = pm;
        if (gather) { u.a = A; u.gl = list + (size_t)e * NLAT + 256 * lp; u.om = pm + omoff; }
        else { u.a = A + (size_t)pm * astep + (size_t)ks * kbytes; u.gl = nullptr; if (mode == 0) u.om = gp0 + pm; }
        return true;
    }
};

struct EpiGeluT {
    static constexpr bool PERM = true, ROWSCALE = true;
    __device__ __forceinline__ const float* scale_src(const Unit& u) const { return cscale + u.pn * BM; }
    bf16_t* O; float* stats; const float* cscale; const float* wsc;
    __device__ __forceinline__ void operator()(const f32x4 (&acc)[2][2][4][2], const Unit& u, int wr, int wc, int fr, int fq, const LAS float* tab) const {
        const int row0 = u.pm * BM + wr * 64 + fr, col0 = u.pn * BM + wc * 32 + 8 * fq;
        const bool isv = u.pm >= 4; const float wq = wsc[0];
        f32x4 csv[2][2];
#pragma unroll
        for (int bj = 0; bj < 2; ++bj)
#pragma unroll
            for (int n = 0; n < 2; ++n) csv[bj][n] = *(const LAS f32x4*)(tab + wc * 32 + 8 * fq + bj * HALF + 4 * n) * wq;
        float s1[2][2][4], s2[2][2][4];
#pragma unroll
        for (int bj = 0; bj < 2; ++bj)
#pragma unroll
            for (int n = 0; n < 2; ++n)
#pragma unroll
                for (int e = 0; e < 4; ++e) { s1[bj][n][e] = 0.f; s2[bj][n][e] = 0.f; }
#pragma unroll
        for (int ai = 0; ai < 2; ++ai)
#pragma unroll
            for (int m = 0; m < 4; ++m) { bf16_t* rowp = O + (size_t)(row0 + ai * HALF + m * 16) * MALL + col0;
#pragma unroll
                for (int bj = 0; bj < 2; ++bj) { const v4i_t i0 = __builtin_bit_cast(v4i_t, acc[ai][bj][m][0]), i1 = __builtin_bit_cast(v4i_t, acc[ai][bj][m][1]);
                    f32x4 v0 = (f32x4){(float)i0[0], (float)i0[1], (float)i0[2], (float)i0[3]} * csv[bj][0], v1 = (f32x4){(float)i1[0], (float)i1[1], (float)i1[2], (float)i1[3]} * csv[bj][1];
#pragma unroll
                    for (int e = 0; e < 4; ++e) { v0[e] = gelu_tanh(v0[e]); v1[e] = gelu_tanh(v1[e]); s1[bj][0][e] += v0[e]; s2[bj][0][e] += v0[e] * v0[e]; s1[bj][1][e] += v1[e]; s2[bj][1][e] += v1[e] * v1[e]; }
                    u32x4 w; w.x = pkbf(v0[0], v0[1]); w.y = pkbf(v0[2], v0[3]); w.z = pkbf(v1[0], v1[1]); w.w = pkbf(v1[2], v1[3]);
                    *(u32x4*)(rowp + bj * HALF) = w; } }
        if (isv) {
            const int slot = (u.pm - 4) * 2 + wr;
#pragma unroll
            for (int bj = 0; bj < 2; ++bj)
#pragma unroll
                for (int n = 0; n < 2; ++n)
#pragma unroll
                    for (int e = 0; e < 4; ++e) { float a = s1[bj][n][e], b = s2[bj][n][e];
#pragma unroll
                        for (int o = 1; o < 16; o <<= 1) { a += __shfl_xor(a, o); b += __shfl_xor(b, o); }
                        if (fr == 0) { const int tok = col0 + bj * HALF + 4 * n + e; *(f32x2*)(stats + (size_t)tok * 16 + slot * 2) = (f32x2){a, b}; } }
        }
    }
};
template <bool BASE_F32> struct EpiResid {
    static constexpr bool PERM = true, ROWSCALE = false;
    const float* basef; const bf16_t* baseb; bf16_t* out; const float* gate; float s;
    __device__ __forceinline__ void operator()(const f32x4 (&acc)[2][2][4][2], const Unit& u, int wr, int wc, int fr, int fq, const LAS float* tab) const {
        const int mb = u.pm >> 5; const int col0 = u.pn * BM + wc * 32 + 8 * fq;
        f32x4 gv[2][2];
#pragma unroll
        for (int bj = 0; bj < 2; ++bj)
#pragma unroll
            for (int n = 0; n < 2; ++n) gv[bj][n] = *(const f32x4*)(gate + (size_t)mb * 6144 + col0 + bj * HALF + n * 4) * s;
#pragma unroll
        for (int ai = 0; ai < 2; ++ai)
#pragma unroll
            for (int m = 0; m < 4; ++m) { const size_t off = (size_t)(u.pm * BM + wr * 64 + fr + ai * HALF + m * 16) * DM + col0;
#pragma unroll
                for (int bj = 0; bj < 2; ++bj) { f32x4 b0, b1;
                    if constexpr (BASE_F32) { b0 = *(const f32x4*)(basef + off + bj * HALF); b1 = *(const f32x4*)(basef + off + bj * HALF + 4); }
                    else { const u32x4 w = *(const u32x4*)(baseb + off + bj * HALF);
                        b0 = (f32x4){__uint_as_float(w.x << 16), __uint_as_float(w.x & 0xffff0000u), __uint_as_float(w.y << 16), __uint_as_float(w.y & 0xffff0000u)};
                        b1 = (f32x4){__uint_as_float(w.z << 16), __uint_as_float(w.z & 0xffff0000u), __uint_as_float(w.w << 16), __uint_as_float(w.w & 0xffff0000u)}; }
                    const f32x4 o0 = b0 + gv[bj][0] * acc[ai][bj][m][0], o1 = b1 + gv[bj][1] * acc[ai][bj][m][1];
                    u32x4 w; w.x = pkbf(o0[0], o0[1]); w.y = pkbf(o0[2], o0[3]); w.z = pkbf(o1[0], o1[1]); w.w = pkbf(o1[2], o1[3]);
                    *(u32x4*)(out + off + bj * HALF) = w; } }
    }
};
struct EpiSwiGLU {
    static constexpr bool PERM = true, ROWSCALE = false;
    bf16_t* O;
    __device__ __forceinline__ void operator()(const f32x4 (&acc)[2][2][4][2], const Unit& u, int wr, int wc, int fr, int fq, const LAS float* tab) const {
        bf16_t* base = O + (size_t)(u.om * BM + wr * 64 + fr) * DFF + u.pn * 128 + wc * 32 + 8 * fq;
#pragma unroll
        for (int ai = 0; ai < 2; ++ai)
#pragma unroll
            for (int m = 0; m < 4; ++m) { const f32x4 g0 = acc[ai][0][m][0], g1 = acc[ai][0][m][1], u0 = acc[ai][1][m][0], u1 = acc[ai][1][m][1];
                float o[8];
#pragma unroll
                for (int e = 0; e < 4; ++e) { o[e] = silu_f(g0[e]) * u0[e]; o[4 + e] = silu_f(g1[e]) * u1[e]; }
                u32x4 w; w.x = pkbf(o[0], o[1]); w.y = pkbf(o[2], o[3]); w.z = pkbf(o[4], o[5]); w.w = pkbf(o[6], o[7]);
                *(u32x4*)(base + (size_t)(ai * HALF + m * 16) * DFF) = w; }
    }
};
struct EpiQKV {
    static constexpr bool PERM = false, ROWSCALE = true;
    __device__ __forceinline__ const float* scale_src(const Unit& u) const { return rscale + u.pm * BM; }
    bf16_t* O; const float* cosT; const float* sinT; float qscale; const float* rscale; const float* wsc;
    __device__ __forceinline__ void operator()(const f32x4 (&acc)[2][2][4][2], const Unit& u, int wr, int wc, int fr, int fq, const LAS float* tab) const {
        const bool lat = u.pm < NPL; const bool dorope = lat && u.pn < 5; const float sc = (u.pn < 4 ? qscale : 1.0f) * wsc[0];
        const int col0 = u.pn * BM + wc * 32 + 4 * fq;
#pragma unroll
        for (int ai = 0; ai < 2; ++ai)
#pragma unroll
            for (int m = 0; m < 4; ++m) { const int grow = u.pm * BM + ai * HALF + wr * 64 + m * 16 + fr; const int s = grow & (SEQ - 1); const int pos = (wc & 1) ? (s & 63) : (s >> 6);
                f32x4 cs = (f32x4){1.f, 1.f, 1.f, 1.f}, sn = (f32x4){0.f, 0.f, 0.f, 0.f};
                if (dorope) { cs = *(const f32x4*)(cosT + pos * 16 + 4 * fq); sn = *(const f32x4*)(sinT + pos * 16 + 4 * fq); }
                bf16_t* rowp = O + (size_t)grow * NQKV + col0;
                const float rsx = tab[ai * HALF + wr * 64 + m * 16 + fr] * sc;
#pragma unroll
                for (int bj = 0; bj < 2; ++bj) { const v4i_t i1 = __builtin_bit_cast(v4i_t, acc[ai][bj][m][0]), i2 = __builtin_bit_cast(v4i_t, acc[ai][bj][m][1]);
                    const f32x4 x1 = (f32x4){(float)i1[0], (float)i1[1], (float)i1[2], (float)i1[3]}, x2 = (f32x4){(float)i2[0], (float)i2[1], (float)i2[2], (float)i2[3]};
                    const f32x4 o1 = (x1 * cs - x2 * sn) * rsx, o2 = (x1 * sn + x2 * cs) * rsx;
                    u32x2 w1, w2; w1.x = pkbf(o1[0], o1[1]); w1.y = pkbf(o1[2], o1[3]); w2.x = pkbf(o2[0], o2[1]); w2.y = pkbf(o2[2], o2[3]);
                    *(u32x2*)(rowp + bj * HALF) = w1; *(u32x2*)(rowp + bj * HALF + 16) = w2; } }
    }
};
struct EpiSwiGLUI8 {
    static constexpr bool PERM = true, ROWSCALE = true;
    __device__ __forceinline__ const float* scale_src(const Unit& u) const { return rscale + u.pm * BM; }
    bf16_t* O; const float* rscale; const float* ws;
    __device__ __forceinline__ void operator()(const f32x4 (&acc)[2][2][4][2], const Unit& u, int wr, int wc, int fr, int fq, const LAS float* tab) const {
        bf16_t* base = O + (size_t)(u.om * BM + wr * 64 + fr) * DFF + u.pn * 128 + wc * 32 + 8 * fq;
        const float wsg = ws[0], wsu = ws[1];
#pragma unroll
        for (int ai = 0; ai < 2; ++ai)
#pragma unroll
            for (int m = 0; m < 4; ++m) { const float rs = tab[wr * 64 + fr + ai * HALF + m * 16]; const float sg = rs * wsg, su = rs * wsu;
                const v4i_t g0 = __builtin_bit_cast(v4i_t, acc[ai][0][m][0]), g1 = __builtin_bit_cast(v4i_t, acc[ai][0][m][1]), u0 = __builtin_bit_cast(v4i_t, acc[ai][1][m][0]), u1 = __builtin_bit_cast(v4i_t, acc[ai][1][m][1]);
                float o[8];
#pragma unroll
                for (int e = 0; e < 4; ++e) { o[e] = silu_f((float)g0[e] * sg) * ((float)u0[e] * su); o[4 + e] = silu_f((float)g1[e] * sg) * ((float)u1[e] * su); }
                u32x4 w; w.x = pkbf(o[0], o[1]); w.y = pkbf(o[2], o[3]); w.z = pkbf(o[4], o[5]); w.w = pkbf(o[6], o[7]);
                *(u32x4*)(base + (size_t)(ai * HALF + m * 16) * DFF) = w; }
    }
};
struct EpiSwiGLU8 {
    static constexpr bool PERM = true, ROWSCALE = false;
    unsigned char* O; float s;
    __device__ __forceinline__ void operator()(const f32x4 (&acc)[2][2][4][2], const Unit& u, int wr, int wc, int fr, int fq, const LAS float* tab) const {
        unsigned char* base = O + (size_t)(u.om * BM + wr * 64 + fr) * DFF + u.pn * 128 + wc * 32 + 8 * fq;
#pragma unroll
        for (int ai = 0; ai < 2; ++ai)
#pragma unroll
            for (int m = 0; m < 4; ++m) { const f32x4 g0 = acc[ai][0][m][0] * s, g1 = acc[ai][0][m][1] * s, u0 = acc[ai][1][m][0] * s, u1 = acc[ai][1][m][1] * s;
                float o[8];
#pragma unroll
                for (int e = 0; e < 4; ++e) { o[e] = silu_f(g0[e]) * u0[e]; o[4 + e] = silu_f(g1[e]) * u1[e]; }
                u32x2 w; w.x = pk4f8(o[0], o[1], o[2], o[3]); w.y = pk4f8(o[4], o[5], o[6], o[7]);
                *(u32x2*)(base + (size_t)(ai * HALF + m * 16) * DFF) = w; }
    }
};
struct EpiBf16Plain {
    static constexpr bool PERM = true, ROWSCALE = false;
    bf16_t* O; int ldc; float s;
    __device__ __forceinline__ void operator()(const f32x4 (&acc)[2][2][4][2], const Unit& u, int wr, int wc, int fr, int fq, const LAS float* tab) const {
        bf16_t* base = O + (size_t)(u.om * BM + wr * 64 + fr) * ldc + u.pn * BM + wc * 32 + 8 * fq;
#pragma unroll
        for (int ai = 0; ai < 2; ++ai)
#pragma unroll
            for (int m = 0; m < 4; ++m)
#pragma unroll
                for (int bj = 0; bj < 2; ++bj) { const f32x4 v0 = acc[ai][bj][m][0] * s, v1 = acc[ai][bj][m][1] * s;
                    u32x4 w; w.x = pkbf(v0[0], v0[1]); w.y = pkbf(v0[2], v0[3]); w.z = pkbf(v1[0], v1[1]); w.w = pkbf(v1[2], v1[3]);
                    *(u32x4*)(base + (size_t)(ai * HALF + m * 16) * ldc + bj * HALF) = w; }
    }
};

struct EpiPartF32 {
    static constexpr bool PERM = true, ROWSCALE = false;
    float* P; size_t sstride;
    __device__ __forceinline__ void operator()(const f32x4 (&acc)[2][2][4][2], const Unit& u, int wr, int wc, int fr, int fq, const LAS float* tab) const {
        float* base = P + (size_t)u.ks * sstride + (size_t)(u.om * BM + wr * 64 + fr) * DM + u.pn * BM + wc * 32 + 8 * fq;
#pragma unroll
        for (int ai = 0; ai < 2; ++ai)
#pragma unroll
            for (int m = 0; m < 4; ++m)
#pragma unroll
                for (int bj = 0; bj < 2; ++bj)
#pragma unroll
                    for (int n = 0; n < 2; ++n) *(f32x4*)(base + (size_t)(ai * HALF + m * 16) * DM + bj * HALF + n * 4) = acc[ai][bj][m][n];
    }
};
struct EpiPartBf16 {
    static constexpr bool PERM = true, ROWSCALE = false;
    bf16_t* P; size_t sstride; float s;
    __device__ __forceinline__ void operator()(const f32x4 (&acc)[2][2][4][2], const Unit& u, int wr, int wc, int fr, int fq, const LAS float* tab) const {
        bf16_t* base = P + (size_t)u.ks * sstride + (size_t)(u.om * BM + wr * 64 + fr) * DM + u.pn * BM + wc * 32 + 8 * fq;
#pragma unroll
        for (int ai = 0; ai < 2; ++ai)
#pragma unroll
            for (int m = 0; m < 4; ++m)
#pragma unroll
                for (int bj = 0; bj < 2; ++bj) { const f32x4 v0 = acc[ai][bj][m][0] * s, v1 = acc[ai][bj][m][1] * s;
                    u32x4 w; w.x = pkbf(v0[0], v0[1]); w.y = pkbf(v0[2], v0[3]); w.z = pkbf(v1[0], v1[1]); w.w = pkbf(v1[2], v1[3]);
                    *(u32x4*)(base + (size_t)(ai * HALF + m * 16) * DM + bj * HALF) = w; }
    }
};

template <class Epi, class Sched, bool ALIGN_EPI, bool GATHER, bool FP8 = false, bool I8 = false, bool FP6 = false>
__device__ __forceinline__ void gemm_phase(LAS unsigned char* lds, LAS int* gtab, const int K  , const int nt_in  , const Sched& S, const Epi& E) {
    int nt = nt_in; asm volatile("" : "+s"(nt));
    int tid_ = threadIdx.x; asm volatile("" : "+v"(tid_));
    const int tid = tid_, wid = __builtin_amdgcn_readfirstlane(tid >> 6), lane = tid & 63, wr = wid >> 2, wc = wid & 3, fr = lane & 15, fq = lane >> 4;
    const size_t kstep = (size_t)(BK * 2);
    const size_t hstep = (size_t)HALF * K * 2;
    unsigned voffB[2];
#pragma unroll
    for (int i = 0; i < 2; ++i) { int R, C; stage_rc(tid * 16 + i * 8192, R, C); const int Rb = Epi::PERM ? ((R & ~31) + perm32(R & 31)) : R;
        voffB[i] = (unsigned)(Rb * K + C) * 2u; }
    unsigned vA[2][2], vN[2][2];
    const unsigned ldsw = (unsigned)wid * 1024u;
    const int aoff = lds_byte(wr * 64 + fr, fq * 8), boff = lds_byte(wc * 32 + fr, fq * 8);
    const LAS unsigned char* aB = lds + aoff; const LAS unsigned char* bB = lds + 65536 + boff;
    asm volatile("" : "+v"(aB), "+v"(bB));
#define PG8_SA(b, h) (((b) * 2 + (h)) * HTB)
#define PG8_SB(b, h) ((4 + (b) * 2 + (h)) * HTB)
#define PG8_STAGE(bufoff, gbase, voff) do { _Pragma("unroll") for (int _i = 0; _i < 2; ++_i) \
        __builtin_amdgcn_global_load_lds((const unsigned*)((const char*)(gbase) + (voff)[_i]), (LAS unsigned*)(lds + (bufoff) + ldsw + _i * 8192), 16, 0, 0); } while (0)
#define PG8_LDA(dst, b, h) do { _Pragma("unroll") for (int m = 0; m < 4; ++m) { if constexpr (FP8 || FP6) dst##8[m] = cat8(*(const LAS bf16x8*)(aB + PG8_SA(b, h) + m * 2048), *(const LAS bf16x8*)(aB + PG8_SA(b, h) + m * 2048 + 1024)); \
        else { _Pragma("unroll") for (int k = 0; k < 2; ++k) dst[m][k] = *(const LAS bf16x8*)(aB + PG8_SA(b, h) + m * 2048 + k * 1024); } } } while (0)
#define PG8_LDB(dst, b, h) do { _Pragma("unroll") for (int n = 0; n < 2; ++n) { if constexpr (FP8 || FP6) dst##8[n] = cat8(*(const LAS bf16x8*)(bB + (PG8_SB(b, h) - 65536) + n * 2048), *(const LAS bf16x8*)(bB + (PG8_SB(b, h) - 65536) + n * 2048 + 1024)); \
        else { _Pragma("unroll") for (int k = 0; k < 2; ++k) dst[n][k] = *(const LAS bf16x8*)(bB + (PG8_SB(b, h) - 65536) + n * 2048 + k * 1024); } } } while (0)
#define PG8_MMA(ai, bj, At, Bt) do { __builtin_amdgcn_s_setprio(1); \
    if constexpr (FP6) { _Pragma("unroll") for (int m = 0; m < 4; ++m) _Pragma("unroll") for (int n = 0; n < 2; ++n) \
        asm volatile("s_nop 1\n\tv_mfma_scale_f32_16x16x128_f8f6f4 %0, %1, %2, %0, %3, %4 op_sel_hi:[0,0,0] cbsz:2 blgp:2" : "+v"(acc[ai][bj][m][n]) \
                     : "v"(__builtin_shufflevector(Bt##8[n], Bt##8[n], 0, 1, 2, 3, 4, 5)), "v"(__builtin_shufflevector(At##8[m], At##8[m], 0, 1, 2, 3, 4, 5)), "v"(Bt##8[n][6]), "v"(At##8[m][6])); } \
    else if constexpr (FP8) { _Pragma("unroll") for (int m = 0; m < 4; ++m) _Pragma("unroll") for (int n = 0; n < 2; ++n) \
        asm volatile("v_mfma_f32_16x16x128_f8f6f4 %0, %1, %2, %0" : "+v"(acc[ai][bj][m][n]) : "v"(Bt##8[n]), "v"(At##8[m])); } \
    else if constexpr (I8) { _Pragma("unroll") for (int m = 0; m < 4; ++m) _Pragma("unroll") for (int n = 0; n < 2; ++n) _Pragma("unroll") for (int k = 0; k < 2; ++k) \
        asm volatile("v_mfma_i32_16x16x64_i8 %0, %1, %2, %0" : "+v"(acc[ai][bj][m][n]) : "v"(Bt[n][k]), "v"(At[m][k])); } \
    else { _Pragma("unroll") for (int m = 0; m < 4; ++m) _Pragma("unroll") for (int n = 0; n < 2; ++n) _Pragma("unroll") for (int k = 0; k < 2; ++k) \
        acc[ai][bj][m][n] = __builtin_amdgcn_mfma_f32_16x16x32_bf16(Bt[n][k], At[m][k], acc[ai][bj][m][n], 0, 0, 0); } \
    __builtin_amdgcn_s_setprio(0); } while (0)
#define PG8_WAIT_V(n) asm volatile("s_waitcnt vmcnt(" #n ")" ::: "memory")
#define PG8_WAIT_L(n) asm volatile("s_waitcnt lgkmcnt(" #n ")" ::: "memory")
#define PG8_BAR __builtin_amdgcn_s_barrier()
#define PG8_SCHED __builtin_amdgcn_sched_barrier(0)
    Unit cur, nxt; int ui = 0;
    if (!S.next(0, cur)) return;
    f32x4 acc[2][2][4][2];
#pragma unroll
    for (int a = 0; a < 2; ++a)
#pragma unroll
        for (int b = 0; b < 2; ++b)
#pragma unroll
            for (int m = 0; m < 4; ++m)
#pragma unroll
                for (int n = 0; n < 2; ++n) acc[a][b][m][n] = (f32x4){0.f, 0.f, 0.f, 0.f};
    bf16x8 At[4][2], B0[2][2], B1[2][2]; v8i_t At8[4], B08[2], B18[2];
    if constexpr (GATHER) {
#pragma unroll
        for (int h = 0; h < 2; ++h)
#pragma unroll
            for (int i = 0; i < 2; ++i) { int R, C; stage_rc(tid * 16 + i * 8192, R, C); const int row = h * HALF + R; const int tok = cur.gl[row < cur.nv ? row : 0]; vA[h][i] = (unsigned)tok * (unsigned)(K * 2) + (unsigned)C * 2u; }
    } else {
#pragma unroll
        for (int h = 0; h < 2; ++h)
#pragma unroll
            for (int i = 0; i < 2; ++i) { int R, C; stage_rc(tid * 16 + i * 8192, R, C); vA[h][i] = (unsigned)(R * K + C) * 2u + (unsigned)(h * hstep); }
    }
#pragma unroll
    for (int h = 0; h < 2; ++h)
#pragma unroll
        for (int i = 0; i < 2; ++i) vN[h][i] = vA[h][i];
    const char* cA = cur.a; const char* cB = cur.b;
    PG8_STAGE(PG8_SB(0, 0), cB, voffB); PG8_STAGE(PG8_SB(0, 1), cB + hstep, voffB); PG8_STAGE(PG8_SA(0, 0), cA, vA[0]); PG8_STAGE(PG8_SA(0, 1), cA, vA[1]);
    if (wr == 1) PG8_BAR;
    PG8_WAIT_V(2); PG8_BAR;
    PG8_STAGE(PG8_SB(1, 0), cB + kstep, voffB); PG8_STAGE(PG8_SA(1, 0), cA + kstep, vA[0]); PG8_STAGE(PG8_SB(1, 1), cB + hstep + kstep, voffB);
    PG8_WAIT_V(6); PG8_BAR;
    for (;;) {
        const bool has_next = S.next(ui + 1, nxt);
        if constexpr (Epi::ROWSCALE) {
            if (wid < 4) __builtin_amdgcn_global_load_lds((const unsigned*)(E.scale_src(cur) + wid * 64 + lane), (LAS unsigned*)(lds + STAB_OFF + (ui & 1) * 1024 + wid * 256), 4, 0, 0);
        }
        const char* nA = has_next ? nxt.a : cA; const char* nB = has_next ? nxt.b : cB;
        if constexpr (GATHER) {
            if (has_next && wid < 4) __builtin_amdgcn_global_load_lds((const unsigned*)(nxt.gl + wid * 64 + lane), (LAS unsigned*)(gtab + wid * 64), 4, 0, 0);
        }
        for (int t = 0; t < nt; t += 2) {
            const bool last = (t == nt - 2);
            const char* a1 = cA + (size_t)(t + 1) * kstep;
            const char* a2 = last ? nA : cA + (size_t)(t + 2) * kstep; const char* b2 = last ? nB : cB + (size_t)(t + 2) * kstep;
            const char* a3 = a2 + kstep; const char* b3 = b2 + kstep;
            if constexpr (GATHER) {
                if (last && has_next) {
                    int t2 = tid; asm volatile("" : "+v"(t2));
#pragma unroll
                    for (int h = 0; h < 2; ++h)
#pragma unroll
                        for (int i = 0; i < 2; ++i) { int R, C; stage_rc(t2 * 16 + i * 8192, R, C); const int row = h * HALF + R; const int tok = gtab[row < nxt.nv ? row : 0]; vN[h][i] = (unsigned)tok * (unsigned)(K * 2) + (unsigned)C * 2u; }
                }
            }
            unsigned vS0[2], vS1[2];
#pragma unroll
            for (int i = 0; i < 2; ++i) { vS0[i] = (GATHER && last) ? vN[0][i] : vA[0][i]; vS1[i] = (GATHER && last) ? vN[1][i] : vA[1][i]; }
            PG8_LDB(B0, 0, 0); PG8_LDB(B1, 0, 1); PG8_SCHED; PG8_LDA(At, 0, 0); PG8_STAGE(PG8_SA(1, 1), a1, vA[1]);
            PG8_WAIT_V(8); PG8_WAIT_L(0); PG8_BAR; PG8_MMA(0, 0, At, B0); PG8_MMA(0, 1, At, B1); PG8_BAR; PG8_SCHED;
            PG8_LDA(At, 0, 1); PG8_STAGE(PG8_SB(0, 0), b2, voffB); PG8_STAGE(PG8_SB(0, 1), b2 + hstep, voffB); PG8_STAGE(PG8_SA(0, 0), a2, vS0);
            PG8_WAIT_V(8); PG8_WAIT_L(0); PG8_BAR; PG8_MMA(1, 0, At, B0); PG8_MMA(1, 1, At, B1); PG8_BAR; PG8_SCHED;
            PG8_LDB(B0, 1, 0); PG8_LDB(B1, 1, 1); PG8_SCHED; PG8_LDA(At, 1, 0); PG8_STAGE(PG8_SA(0, 1), a2, vS1);
            PG8_WAIT_V(8); PG8_WAIT_L(0); PG8_BAR; PG8_MMA(0, 0, At, B0); PG8_MMA(0, 1, At, B1); PG8_BAR; PG8_SCHED;
            PG8_LDA(At, 1, 1); PG8_STAGE(PG8_SB(1, 0), b3, voffB); PG8_STAGE(PG8_SB(1, 1), b3 + hstep, voffB); PG8_STAGE(PG8_SA(1, 0), a3, vS0);
            PG8_WAIT_V(8); PG8_WAIT_L(0); PG8_BAR; PG8_MMA(1, 0, At, B0); PG8_MMA(1, 1, At, B1); PG8_BAR; PG8_SCHED;
        }
        if constexpr (ALIGN_EPI) { if (wr == 0) PG8_BAR; }
        if constexpr (FP8 || I8 || FP6) asm volatile("s_nop 15\n\ts_nop 15" ::: "memory");
        E(acc, cur, wr, wc, fr, fq, (const LAS float*)(lds + STAB_OFF) + (ui & 1) * 256);
        if (!has_next) break;
#pragma unroll
        for (int a = 0; a < 2; ++a)
#pragma unroll
            for (int b = 0; b < 2; ++b)
#pragma unroll
                for (int m = 0; m < 4; ++m)
#pragma unroll
                    for (int n = 0; n < 2; ++n) acc[a][b][m][n] = (f32x4){0.f, 0.f, 0.f, 0.f};
        cur = nxt; cA = nA; cB = nB; ++ui;
        if constexpr (GATHER) {
#pragma unroll
            for (int h = 0; h < 2; ++h)
#pragma unroll
                for (int i = 0; i < 2; ++i) vA[h][i] = vN[h][i];
        }
        if constexpr (ALIGN_EPI) { if (wr == 1) PG8_BAR; }
    }
    PG8_WAIT_V(0);
    if constexpr (!ALIGN_EPI) { if (wr == 0) PG8_BAR; }
    PG8_BAR;
#undef PG8_SA
#undef PG8_SB
#undef PG8_STAGE
#undef PG8_LDA
#undef PG8_LDB
#undef PG8_MMA
#undef PG8_WAIT_V
#undef PG8_WAIT_L
#undef PG8_BAR
#undef PG8_SCHED
}
}

namespace attn_body {
using bf16 = __hip_bfloat16;
using s16x4 = __attribute__((ext_vector_type(4))) short;
constexpr int D = 64, PITCH = NQKV, OPITCH = DM;
constexpr int NW = 8, QBLK = 32, KVBLK = 64;
__device__ __forceinline__ int crow(int r, int hi) { return (r & 3) + 8 * (r >> 2) + 4 * hi; }
#define SBAR() __builtin_amdgcn_sched_barrier(0)
__device__ __forceinline__ void bmask(f32x16& p0, f32x16& p1, int kb, int qrel, int hi) {
    const float NEG = -INFINITY; const int d0 = kb + 4 * hi - qrel;
#pragma unroll
    for (int r = 0; r < 16; ++r) { const int d = d0 + (r & 3) + 8 * (r >> 2); if (d < -128 || d > 128) p0[r] = NEG; if (d + 32 < -128 || d + 32 > 128) p1[r] = NEG; }
}
constexpr int NSLOT = 3, SLOTB = 8192;
constexpr int LDS_K = 0, LDS_V = NSLOT * SLOTB, LDS_WS = 2 * NSLOT * SLOTB, LDS_OST = LDS_WS + NW * 64 * 4, LDS_BYTES_A = LDS_OST + NW * 4096;
constexpr float C2 = 0.125f * 1.4426950408889634f;
__device__ __forceinline__ void glds16(const void* gsrc, unsigned lds_dst) { unsigned keep;
    asm volatile("s_mov_b32 %0, m0\n\ts_mov_b32 m0, %2\n\ts_nop 0\n\tglobal_load_lds_dwordx4 %1, off\n\ts_mov_b32 m0, %0" : "=&s"(keep) : "v"(gsrc), "s"(lds_dst) : "memory"); }
__device__ __forceinline__ float max3f(float a, float b, float c) { float r; asm("v_max3_f32 %0, %1, %2, %3" : "=v"(r) : "v"(a), "v"(b), "v"(c)); return r; }
__device__ __forceinline__ float max2f(float a, float b) { float r; asm("v_max_f32_e32 %0, %1, %2" : "=v"(r) : "v"(a), "v"(b)); return r; }
__device__ __forceinline__ float fadd_s(float a, float b) { float r; asm("v_add_f32_e32 %0, %1, %2" : "=v"(r) : "v"(a), "v"(b)); return r; }
__device__ __forceinline__ float fsub_s(float a, float b) { float r; asm("v_sub_f32_e32 %0, %1, %2" : "=v"(r) : "v"(a), "v"(b)); return r; }
__device__ __forceinline__ unsigned cvtpk_s(float lo, float hi) { f32x2 v = {lo, hi}; bf16x2_t b = __builtin_convertvector(v, bf16x2_t); return __builtin_bit_cast(unsigned, b); }
#define WAIT_BAR(N) asm volatile("s_waitcnt vmcnt(" #N ") lgkmcnt(0)\n\ts_barrier" ::: "memory")
__device__ __forceinline__ void qkt(f32x16& p0, f32x16& p1, const char* Kslot, const bf16x8* qr, const f32x16& negm, int r32, int hi) {
    const char* kb = Kslot + hi * 1024 + r32 * 16;
#pragma unroll
    for (int d0 = 0; d0 < 4; ++d0) {
        const bf16x8 b0 = *reinterpret_cast<const bf16x8*>(kb + d0 * 2048);
        const bf16x8 b1 = *reinterpret_cast<const bf16x8*>(kb + d0 * 2048 + 512);
        if (d0 == 0) { p0 = __builtin_amdgcn_mfma_f32_32x32x16_bf16(b0, qr[0], negm, 0, 0, 0); p1 = __builtin_amdgcn_mfma_f32_32x32x16_bf16(b1, qr[0], negm, 0, 0, 0); }
        else { p0 = __builtin_amdgcn_mfma_f32_32x32x16_bf16(b0, qr[d0], p0, 0, 0, 0); p1 = __builtin_amdgcn_mfma_f32_32x32x16_bf16(b1, qr[d0], p1, 0, 0, 0); } }
}
typedef __attribute__((address_space(3))) const char* lds_cptr;
typedef short v4i16_t __attribute__((ext_vector_type(4)));
__device__ __forceinline__ void kload8(bf16x8* kf, lds_cptr kp) {
    kf[0] = *(const __attribute__((address_space(3))) bf16x8*)(kp);        kf[1] = *(const __attribute__((address_space(3))) bf16x8*)(kp + 512);
    kf[2] = *(const __attribute__((address_space(3))) bf16x8*)(kp + 2048); kf[3] = *(const __attribute__((address_space(3))) bf16x8*)(kp + 2560);
    kf[4] = *(const __attribute__((address_space(3))) bf16x8*)(kp + 4096); kf[5] = *(const __attribute__((address_space(3))) bf16x8*)(kp + 4608);
    kf[6] = *(const __attribute__((address_space(3))) bf16x8*)(kp + 6144); kf[7] = *(const __attribute__((address_space(3))) bf16x8*)(kp + 6656);
}
__device__ __forceinline__ void kload2(bf16x8* kf, lds_cptr kp, int j) { kf[2 * j] = *(const __attribute__((address_space(3))) bf16x8*)(kp + j * 2048); kf[2 * j + 1] = *(const __attribute__((address_space(3))) bf16x8*)(kp + j * 2048 + 512); }
__device__ __forceinline__ s16x4 vtr(lds_cptr p) { return __builtin_bit_cast(s16x4, __builtin_amdgcn_ds_read_tr16_b64_v4i16((__attribute__((address_space(3))) v4i16_t*)p)); }
__device__ __forceinline__ float rowmax(const f32x16& p0, const f32x16& p1) {
    float a = max3f(p0[0], p0[1], p1[0]), b = max3f(p0[2], p0[3], p1[1]); a = max3f(a, p1[2], p1[3]);
#pragma unroll
    for (int r = 4; r < 16; r += 4) { a = max3f(a, p0[r], p0[r + 1]); b = max3f(b, p0[r + 2], p0[r + 3]); a = max3f(a, p1[r], p1[r + 1]); b = max3f(b, p1[r + 2], p1[r + 3]); }
    const float m = max2f(a, b);
    auto rr = __builtin_amdgcn_permlane32_swap(__float_as_uint(m), __float_as_uint(m), false, false);
    return max2f(__uint_as_float(rr[0]), __uint_as_float(rr[1]));
}
__device__ __forceinline__ void pv(f32x16* o, int vb, bf16x8 pa0, bf16x8 pa1, bf16x8 pa2, bf16x8 pa3) {
#pragma unroll
    for (int d0 = 0; d0 < 2; ++d0) { s16x4 lo[4], hi[4];
#pragma unroll
        for (int ks = 0; ks < 4; ++ks) {
            asm volatile("ds_read_b64_tr_b16 %0,%1 offset:%c2" : "=&v"(lo[ks]) : "v"(vb), "i"(d0 * 4096 + ks * 1024) : "memory");
            asm volatile("ds_read_b64_tr_b16 %0,%1 offset:%c2" : "=&v"(hi[ks]) : "v"(vb), "i"(d0 * 4096 + ks * 1024 + 512) : "memory"); }
        asm volatile("s_waitcnt lgkmcnt(0)" ::: "memory"); SBAR();
#define PK(k) (bf16x8){lo[k][0], lo[k][1], lo[k][2], lo[k][3], hi[k][0], hi[k][1], hi[k][2], hi[k][3]}
        o[d0] = __builtin_amdgcn_mfma_f32_32x32x16_bf16(pa0, PK(0), o[d0], 0, 0, 0);
        o[d0] = __builtin_amdgcn_mfma_f32_32x32x16_bf16(pa1, PK(1), o[d0], 0, 0, 0);
        o[d0] = __builtin_amdgcn_mfma_f32_32x32x16_bf16(pa2, PK(2), o[d0], 0, 0, 0);
        o[d0] = __builtin_amdgcn_mfma_f32_32x32x16_bf16(pa3, PK(3), o[d0], 0, 0, 0);
#undef PK
    }
}
#define ATTN_STORE16(p, v) (*(u32x4*)(p) = (v))
template <int THRL> __device__ __forceinline__ int attn_unit(int b, int hk, int n, int pr, const bf16* QKV, unsigned char* O, const float* sinkp, char* shm, int sb, bool pre, bool has_next, int nb2, int nhk2, int nn2, int npr2, bf16x8 (&qr)[4]) {
    int tid_ = threadIdx.x; asm volatile("" : "+v"(tid_));
    const int tid = tid_, lane = tid & 63, r32 = lane & 31, hi = lane >> 5; const int wid = __builtin_amdgcn_readfirstlane(tid >> 6);
    const int head = 4 * hk + 2 * pr + (wid >> 2);
    const long rowblk = (long)b * SEQ + n * 128;
    const long ctxrow = (long)NLAT + b * LCTX;
    const int nlo = n > 0 ? 2 : 0, nhi = n < (SEQ / 128 - 1) ? 2 : 0;
    const int NT = 6 + nlo + nhi;
    const bf16* Qw = QKV + (rowblk + (wid & 3) * QBLK) * PITCH + head * D;
    const bf16* Kc = QKV + 1024 + hk * D; const bf16* Vc = QKV + 1280 + hk * D;
    const unsigned lds0 = (unsigned)(uintptr_t)shm;
    float* wsf = (float*)(shm + LDS_WS) + wid * 64;
    const long klane = (long)lane * PITCH + wid * 8;
    const long vlane = (long)(16 * (wid & 3) + (lane >> 2)) * PITCH + (wid >> 2) * 32 + (lane & 3) * 8;
    const unsigned kdst = lds0 + LDS_K + wid * 1024, vdst = lds0 + LDS_V + wid * 1024;
#define TROW(t) (((t) < 2) ? (rowblk + 64 * (t)) : ((t) < 6) ? (ctxrow + 64 * ((t) - 2)) : (rowblk + ((((t) - 6) < nlo) ? (-128 + 64 * ((t) - 6)) : (128 + 64 * ((t) - 6 - nlo)))))
#define TKB(t) (((t) < 6) ? 0 : ((((t) - 6) < nlo) ? (-128 + 64 * ((t) - 6)) : (128 + 64 * ((t) - 6 - nlo))))
#define DMA_K(t, slot) glds16(Kc + TROW(t) * PITCH + klane, (unsigned)__builtin_amdgcn_readfirstlane(kdst + (slot)))
#define DMA_V(t, slot) glds16(Vc + TROW(t) * PITCH + vlane, (unsigned)__builtin_amdgcn_readfirstlane(vdst + (slot)))
    const int vb0 = (int)(lds0 + LDS_V) + ((lane >> 4) & 1) * 32 + (lane & 3) * 8 + (4 * hi + ((lane & 15) >> 2)) * 64;
    const char* Kbase = shm + LDS_K; bf16x8 kf[8];
    const lds_cptr shm3 = (lds_cptr)shm; const lds_cptr kp0 = shm3 + LDS_K + hi * 1024 + r32 * 16; const lds_cptr vp0 = shm3 + LDS_V + ((lane >> 4) & 1) * 32 + (lane & 3) * 8 + (4 * hi + ((lane & 15) >> 2)) * 64;
#define NXS(x) (((x) == (NSLOT - 1) * SLOTB) ? 0 : (x) + SLOTB)
    const int S0 = sb, S1 = NXS(S0), S2 = NXS(S1);
    if (!pre) { DMA_K(0, S0); DMA_V(0, S0); DMA_K(1, S1); }
    if (!pre) {
#pragma unroll
        for (int d0 = 0; d0 < 4; ++d0) qr[d0] = *reinterpret_cast<const bf16x8*>(&Qw[(long)r32 * PITCH + d0 * 16 + hi * 8]); }
    float mhat = 0.f, l_reg = 0.f; f32x16 o[2]; o[0] = f32x16{}; o[1] = f32x16{}; f32x16 negm = f32x16{}; asm volatile("" : "+v"(negm));
    const int qrel = (wid & 3) * QBLK + r32;
#define CMASK(P0, P1, t) do { int jb_ = (t) - (NT - 4); if (jb_ >= 0) bmask(P0, P1, TKB(t), qrel, hi); } while (0)
    bool resc = false;
#define START(P0, P1) do { const float rm = rowmax(P0, P1); resc = false; \
    { const float dl = rm; mhat = fadd_s(mhat, dl); \
      _Pragma("unroll") for (int r = 0; r < 16; ++r) { P0[r] = fsub_s(P0[r], dl); P1[r] = fsub_s(P1[r], dl); } \
      _Pragma("unroll") for (int r = 0; r < 16; ++r) negm[r] = -mhat; asm volatile("" : "+v"(negm)); } \
    _Pragma("unroll") for (int r = 0; r < 16; ++r) P0[r] = __builtin_amdgcn_exp2f(P0[r]); } while (0)
#define RESC() do { if (resc) { asm volatile("s_waitcnt lgkmcnt(0)" ::: "memory"); \
      _Pragma("unroll") for (int d_ = 0; d_ < 2; ++d_) _Pragma("unroll") for (int r = 0; r < 16; ++r) o[d_][r] *= wsf[crow(r, hi)]; } } while (0)
    f32x16 pA0, pA1, pB0, pB1;
    int sl_prev = S0, sl_cur = S0, sl_next = S1;
#define ROT() do { sl_prev = sl_cur; sl_cur = sl_next; sl_next = (sl_next == (NSLOT - 1) * SLOTB) ? 0 : sl_next + SLOTB; } while (0)
    if (!pre) { DMA_K(2, S2); }
    WAIT_BAR(3);
    qkt(pA0, pA1, Kbase + S0, qr, negm, r32, hi); asm volatile("s_nop 15\n\ts_nop 7" : "+v"(pA0), "+v"(pA1));
    START(pA0, pA1);
    _Pragma("unroll") for (int r = 0; r < 16; ++r) pA1[r] = __builtin_amdgcn_exp2f(pA1[r]);
    WAIT_BAR(0);
    DMA_K(3, S0); DMA_V(1, S1);
    ROT();
    kload8(kf, kp0 + sl_cur);
    WAIT_BAR(2);
    s16x4 vlo[8], vhi[8]; u32x4 pw0, pw1, pw2, pw3;
#define PKW(P, B) cvtpk_s(P[B], P[B + 1])
#define PAF(k) __builtin_bit_cast(bf16x8, pw##k)
#define VFR(i) (bf16x8){vlo[i][0], vlo[i][1], vlo[i][2], vlo[i][3], vhi[i][0], vhi[i][1], vhi[i][2], vhi[i][3]}
#define PIN(x) asm volatile("" : "+v"(x))
#define MX3(a, b, c) __builtin_fmaxf(__builtin_fmaxf((a), (b)), (c))
#define GAPA(MF, A0, A1, A2, A3, W0, W1, PW) do { MF; sacc += A0; sacc += A1; sacc += A2; sacc += A3; PIN(sacc); W0; W1; PIN(PW); SBAR(); } while (0)
#define EX(v) __builtin_amdgcn_exp2f(v)
#define GAPB(MF, X, B) do { MF; X[B] = EX(X[B]); X[B + 1] = EX(X[B + 1]); X[B + 2] = EX(X[B + 2]); X[B + 3] = EX(X[B + 3]); PIN(X); SBAR(); } while (0)
#define VRD(i) do { vlo[i] = vtr(vp_ + (((i) >> 2) * 4096 + ((i) & 3) * 1024)); vhi[i] = vtr(vp_ + (((i) >> 2) * 4096 + ((i) & 3) * 1024 + 512)); } while (0)
#define KRD(G, j) do { if (G) { kload2(kf, kp0 + sl_next, j); SBAR(); } } while (0)
#define STEP(C0, C1, P0, P1, t, GK, GV, GL) do { SBAR(); \
    const lds_cptr vp_ = vp0 + sl_prev; \
    VRD(0); SBAR(); float sacc = (P0[0] + P0[1]); \
    GAPA(C0 = __builtin_amdgcn_mfma_f32_32x32x16_bf16(kf[0], qr[0], negm, 0, 0, 0), P0[2], P0[3], P0[4], P0[5],     pw0[0] = PKW(P0, 0), pw0[1] = PKW(P0, 2), pw0); \
    VRD(4); SBAR(); GAPA(C1 = __builtin_amdgcn_mfma_f32_32x32x16_bf16(kf[1], qr[0], negm, 0, 0, 0), P0[6], P0[7], P0[8], P0[9],     pw0[2] = PKW(P0, 4), pw0[3] = PKW(P0, 6), pw0); \
    VRD(1); SBAR(); GAPA(C0 = __builtin_amdgcn_mfma_f32_32x32x16_bf16(kf[2], qr[1], C0, 0, 0, 0),   P0[10], P0[11], P0[12], P0[13], pw1[0] = PKW(P0, 8), pw1[1] = PKW(P0, 10), pw1); \
    VRD(5); SBAR(); GAPA(C1 = __builtin_amdgcn_mfma_f32_32x32x16_bf16(kf[3], qr[1], C1, 0, 0, 0),   P0[14], P0[15], P1[0], P1[1],   pw1[2] = PKW(P0, 12), pw1[3] = PKW(P0, 14), pw1); \
    VRD(2); SBAR(); GAPA(C0 = __builtin_amdgcn_mfma_f32_32x32x16_bf16(kf[4], qr[2], C0, 0, 0, 0),   P1[2], P1[3], P1[4], P1[5],     pw2[0] = PKW(P1, 0), pw2[1] = PKW(P1, 2), pw2); \
    VRD(6); SBAR(); GAPA(C1 = __builtin_amdgcn_mfma_f32_32x32x16_bf16(kf[5], qr[2], C1, 0, 0, 0),   P1[6], P1[7], P1[8], P1[9],     pw2[2] = PKW(P1, 4), pw2[3] = PKW(P1, 6), pw2); \
    VRD(3); SBAR(); GAPA(C0 = __builtin_amdgcn_mfma_f32_32x32x16_bf16(kf[6], qr[3], C0, 0, 0, 0),   P1[10], P1[11], P1[12], P1[13], pw3[0] = PKW(P1, 8), pw3[1] = PKW(P1, 10), pw3); \
    VRD(7); SBAR(); GAPA(C1 = __builtin_amdgcn_mfma_f32_32x32x16_bf16(kf[7], qr[3], C1, 0, 0, 0),   P1[14], P1[15], 0.f, 0.f,       pw3[2] = PKW(P1, 12), pw3[3] = PKW(P1, 14), pw3); \
    l_reg += sacc; \
    if (GK) { DMA_K((t) + 3, sl_cur); } if (GV) { DMA_V((t) + 1, sl_next); } \
    CMASK(C0, C1, t); \
    { float a = MX3(C0[0], C0[1], C1[0]), b = MX3(C0[2], C0[3], C1[1]); a = MX3(a, C1[2], C1[3]); \
      _Pragma("unroll") for (int r = 4; r < 16; r += 4) { a = MX3(a, C0[r], C0[r + 1]); b = MX3(b, C0[r + 2], C0[r + 3]); a = MX3(a, C1[r], C1[r + 1]); b = MX3(b, C1[r + 2], C1[r + 3]); } \
      float rm = __builtin_fmaxf(a, b); { auto rr = __builtin_amdgcn_permlane32_swap(__float_as_uint(rm), __float_as_uint(rm), false, false); rm = __builtin_fmaxf(__uint_as_float(rr[0]), __uint_as_float(rr[1])); } \
      resc = false; \
      if (__builtin_expect(__any(rm > (float)THRL), 0)) { const float dl = __builtin_fmaxf(rm, 0.f); mhat += dl; \
        _Pragma("unroll") for (int r = 0; r < 16; ++r) { C0[r] -= dl; C1[r] -= dl; } \
        _Pragma("unroll") for (int r = 0; r < 16; ++r) negm[r] = -mhat; asm volatile("" : "+v"(negm)); \
        const float f = __builtin_amdgcn_exp2f(-dl); l_reg *= f; if (hi == 0) wsf[r32] = f; resc = true; } } \
    SBAR(); \
    GAPB(o[0] = __builtin_amdgcn_mfma_f32_32x32x16_bf16(PAF(0), VFR(0), o[0], 0, 0, 0), C0, 0); \
    GAPB(o[1] = __builtin_amdgcn_mfma_f32_32x32x16_bf16(PAF(0), VFR(4), o[1], 0, 0, 0), C0, 4); \
    KRD(GL, 0); GAPB(o[0] = __builtin_amdgcn_mfma_f32_32x32x16_bf16(PAF(1), VFR(1), o[0], 0, 0, 0), C0, 8); \
    KRD(GL, 1); GAPB(o[1] = __builtin_amdgcn_mfma_f32_32x32x16_bf16(PAF(1), VFR(5), o[1], 0, 0, 0), C0, 12); \
    KRD(GL, 2); GAPB(o[0] = __builtin_amdgcn_mfma_f32_32x32x16_bf16(PAF(2), VFR(2), o[0], 0, 0, 0), C1, 0); \
    KRD(GL, 3); GAPB(o[1] = __builtin_amdgcn_mfma_f32_32x32x16_bf16(PAF(2), VFR(6), o[1], 0, 0, 0), C1, 4); \
    GAPB(o[0] = __builtin_amdgcn_mfma_f32_32x32x16_bf16(PAF(3), VFR(3), o[0], 0, 0, 0), C1, 8); \
    GAPB(o[1] = __builtin_amdgcn_mfma_f32_32x32x16_bf16(PAF(3), VFR(7), o[1], 0, 0, 0), C1, 12); \
    } while (0)
    int t = 1;
#undef CMASK
#define CMASK(P0, P1, t) do { } while (0)
    for (; t + 5 < NT; t += 2) {
        STEP(pB0, pB1, pA0, pA1, t, true, true, true);     WAIT_BAR(2); RESC(); ROT();
        STEP(pA0, pA1, pB0, pB1, t + 1, true, true, true); WAIT_BAR(2); RESC(); ROT();
    }
#undef CMASK
#define CMASK(P0, P1, t) do { int jb_ = (t) - (NT - 4); if (jb_ >= 0) bmask(P0, P1, TKB(t), qrel, hi); } while (0)
#define ENDW(tt) do { if ((tt) + 3 < NT) { WAIT_BAR(2); } else if ((tt) + 2 < NT) { WAIT_BAR(1); } else { WAIT_BAR(0); } } while (0)
    for (; t + 1 < NT; t += 2) {
        STEP(pB0, pB1, pA0, pA1, t, (t + 3 < NT), (t + 1 < NT), (t + 1 < NT));     ENDW(t);     RESC(); ROT();
        STEP(pA0, pA1, pB0, pB1, t + 1, (t + 4 < NT), (t + 2 < NT), (t + 2 < NT)); ENDW(t + 1); RESC(); ROT();
    }
    if (has_next) {
        const long rowblkN = (long)nb2 * SEQ + nn2 * 128, ctxrowN = (long)NLAT + nb2 * LCTX; const bf16* KcN = QKV + 1024 + nhk2 * D; const bf16* VcN = QKV + 1280 + nhk2 * D;
        const int T0 = sl_next, T1 = NXS(T0), T2 = NXS(T1);
        glds16(KcN + rowblkN * PITCH + klane, (unsigned)__builtin_amdgcn_readfirstlane(kdst + T0));
        glds16(VcN + rowblkN * PITCH + vlane, (unsigned)__builtin_amdgcn_readfirstlane(vdst + T0));
        glds16(KcN + (rowblkN + 64) * PITCH + klane, (unsigned)__builtin_amdgcn_readfirstlane(kdst + T1));
        glds16(KcN + ctxrowN * PITCH + klane, (unsigned)__builtin_amdgcn_readfirstlane(kdst + T2));
    }
    STEP(pB0, pB1, pA0, pA1, NT - 1, false, false, false); RESC();
    if (has_next) {
        const bf16* QwN = QKV + ((long)nb2 * SEQ + nn2 * 128 + (wid & 3) * QBLK) * PITCH + (4 * nhk2 + 2 * npr2 + (wid >> 2)) * D;
#pragma unroll
        for (int d0 = 0; d0 < 4; ++d0) qr[d0] = *reinterpret_cast<const bf16x8*>(&QwN[(long)r32 * PITCH + d0 * 16 + hi * 8]); }
    { float sacc = pB0[0] + pB0[1]; _Pragma("unroll") for (int r = 2; r < 16; ++r) sacc += pB0[r]; _Pragma("unroll") for (int r = 0; r < 16; ++r) sacc += pB1[r]; l_reg += sacc;
      pw0 = (u32x4){PKW(pB0, 0), PKW(pB0, 2), PKW(pB0, 4), PKW(pB0, 6)}; pw1 = (u32x4){PKW(pB0, 8), PKW(pB0, 10), PKW(pB0, 12), PKW(pB0, 14)}; pw2 = (u32x4){PKW(pB1, 0), PKW(pB1, 2), PKW(pB1, 4), PKW(pB1, 6)}; pw3 = (u32x4){PKW(pB1, 8), PKW(pB1, 10), PKW(pB1, 12), PKW(pB1, 14)};
      SBAR(); pv(o, vb0 + sl_cur, PAF(0), PAF(1), PAF(2), PAF(3)); }
#undef PKW
#undef PAF
#undef VFR
#undef PIN
#undef MX3
#undef GAPA
#undef GAPB
#undef EX
#undef VRD
#undef KRD
#undef STEP
#undef ENDW
    { auto rr = __builtin_amdgcn_permlane32_swap(__float_as_uint(l_reg), __float_as_uint(l_reg), false, false); l_reg = __uint_as_float(rr[0]) + __uint_as_float(rr[1]); }
    l_reg += __builtin_amdgcn_exp2f(sinkp[head] * 1.4426950408889634f - mhat);
    if (hi == 0) wsf[32 + r32] = l_reg; asm volatile("s_waitcnt lgkmcnt(0)" ::: "memory");
    float rli[16];
#pragma unroll
    for (int r = 0; r < 16; ++r) rli[r] = __builtin_amdgcn_rcpf(wsf[32 + crow(r, hi)]);
    unsigned char* Ow = O + (rowblk + (wid & 3) * QBLK) * OPITCH + head * D;
    { bf16* stg = (bf16*)(shm + LDS_OST) + wid * 2048;
#pragma unroll
      for (int r = 0; r < 16; ++r) { const int orow = crow(r, hi);
#pragma unroll
        for (int d0 = 0; d0 < 2; ++d0) stg[orow * 64 + d0 * 32 + r32] = __float2bfloat16(o[d0][r] * rli[r]); }
      asm volatile("s_waitcnt lgkmcnt(0)" ::: "memory");
#pragma unroll
      for (int i = 0; i < 4; ++i) { const int row = i * 8 + (lane >> 3), ch = lane & 7; const u32x4 v = *(const u32x4*)(stg + row * 64 + ch * 8);
        u32x2 w; w.x = pk4f8(__uint_as_float(v.x << 16), __uint_as_float(v.x & 0xffff0000u), __uint_as_float(v.y << 16), __uint_as_float(v.y & 0xffff0000u));
        w.y = pk4f8(__uint_as_float(v.z << 16), __uint_as_float(v.z & 0xffff0000u), __uint_as_float(v.w << 16), __uint_as_float(v.w & 0xffff0000u));
        *(u32x2*)(Ow + (long)row * OPITCH + ch * 8) = w; } }
    asm volatile("s_waitcnt lgkmcnt(0)\n\ts_barrier" ::: "memory");
    return sl_next;
#undef NXS
#undef DMA_K
#undef DMA_V
#undef TROW
#undef TKB
#undef CMASK
#undef START
#undef RESC
#undef ROT
}
#undef SBAR
#undef WAIT_BAR
}

#define XB_TMO      128
#define XB_XCNT(j)  (256  + 64 * (j))
#define XB_XSUB(j)  (1280 + 64 * (j))
#define XB_XGEN(j)  (2304 + 64 * (j))
#define XB_TOP      3328
#define XB_TOPGEN   3392
#define XCD_BAR_WORDS 3456
#define XB_SPIN_CAP (1u << 18)
__device__ __forceinline__ unsigned xb_ld(unsigned* p)              { return __hip_atomic_load(p, __ATOMIC_RELAXED, __HIP_MEMORY_SCOPE_AGENT); }
__device__ __forceinline__ unsigned xb_add(unsigned* p, unsigned v) { return __hip_atomic_fetch_add(p, v, __ATOMIC_RELAXED, __HIP_MEMORY_SCOPE_AGENT); }
__device__ __forceinline__ unsigned xb_xcc_id() { return (unsigned)__builtin_amdgcn_s_getreg((3 << 11) | 20) & 0xFu; }
#define XB_SPIN(cond, bar) do { unsigned _sp = 0; while (cond) { __builtin_amdgcn_s_sleep(1); \
    if ((++_sp & 255u) == 0u) { if (xb_ld(&(bar)[XB_TMO])) break; if (_sp > XB_SPIN_CAP) { atomicAdd(&(bar)[XB_TMO], 1u); break; } } } } while (0)
struct XcdBarrier { unsigned* bar; unsigned x; volatile LAS unsigned* st; };
__device__ __forceinline__ XcdBarrier xcd_barrier_post(unsigned* bar, volatile LAS unsigned* st) {
    XcdBarrier b; b.bar = bar; b.x = xb_xcc_id(); b.st = st;
    if (threadIdx.x == 0) (void)xb_add(&bar[XB_XCNT(b.x)], 1u);
    return b;
}
__device__ __forceinline__ void xcd_barrier_complete(unsigned* bar, unsigned x, unsigned& nloc, unsigned& nx) {
    const unsigned G = gridDim.x * gridDim.y * gridDim.z;
    unsigned sum, cnt, mine, sp = 0u;
    for (;;) {
        sum = 0u; cnt = 0u; mine = 0u;
#pragma unroll
        for (unsigned j = 0; j < 16; ++j) { const unsigned c = xb_ld(&bar[XB_XCNT(j)]); sum += c; cnt += (c > 0u) ? 1u : 0u; mine = (j == x) ? c : mine; }
        if (sum == G) break;
        __builtin_amdgcn_s_sleep(1);
        if ((++sp & 255u) == 0u) { if (xb_ld(&bar[XB_TMO])) break; if (sp > XB_SPIN_CAP) { atomicAdd(&bar[XB_TMO], 1u); break; } }
    }
    nloc = mine > 0u ? mine : 1u; nx = cnt > 0u ? cnt : 1u;
}
__device__ __forceinline__ void xcd_barrier(const XcdBarrier& b) {
    asm volatile("s_waitcnt vmcnt(0)" ::: "memory");
    __syncthreads();
    if (threadIdx.x == 0) {
        unsigned* bar = b.bar;
        __builtin_amdgcn_s_waitcnt(0);
        unsigned nloc = b.st[0], nx = b.st[1];
        if (nloc == 0u) { xcd_barrier_complete(bar, b.x, nloc, nx); b.st[0] = nloc; b.st[1] = nx; }
        const unsigned old = xb_add(&bar[XB_XSUB(b.x)], 1u);
        const unsigned gen = old / nloc;
        if (old + 1u == (gen + 1u) * nloc) {
            __builtin_amdgcn_fence(__ATOMIC_RELEASE, "agent");
            asm volatile("s_waitcnt vmcnt(0)" ::: "memory");
            const unsigned og = xb_add(&bar[XB_TOP], 1u);
            const unsigned tg = og / nx;
            if (og + 1u == (tg + 1u) * nx) xb_add(&bar[XB_TOPGEN], 1u);
            else XB_SPIN(xb_ld(&bar[XB_TOPGEN]) == tg, bar);
            __builtin_amdgcn_fence(__ATOMIC_ACQUIRE, "agent");
            xb_add(&bar[XB_XGEN(b.x)], 1u);
            asm volatile("s_waitcnt vmcnt(0)" ::: "memory");
        } else {
            XB_SPIN(xb_ld(&bar[XB_XGEN(b.x)]) == gen, bar);
            __builtin_amdgcn_fence(__ATOMIC_ACQUIRE, "agent");
            asm volatile("s_waitcnt vmcnt(0)" ::: "memory");
        }
    }
    __syncthreads();
}

#define LDS_WAIT() asm volatile("s_waitcnt lgkmcnt(0)" ::: "memory")
__device__ __forceinline__ void transpose_item(const float* W, int K, int N, bf16_t* WT, int k0, int n0, int drow0, LAS float* scr, int lane) {
    float t[32];
#pragma unroll
    for (int i = 0; i < 32; ++i) t[i] = __builtin_nontemporal_load(W + (size_t)(k0 + 2 * i + (lane >> 5)) * N + n0 + (lane & 31));
#pragma unroll
    for (int i = 0; i < 32; ++i) scr[(2 * i + (lane >> 5)) * 33 + (lane & 31)] = t[i];
    LDS_WAIT(); asm volatile("" ::: "memory");
    const int c = lane & 7;
#pragma unroll
    for (int j = 0; j < 4; ++j) { const int n = (lane >> 3) + 8 * j; const LAS float* s = scr + (8 * c) * 33 + n;
        u32x4 o; o.x = pkbf(s[0 * 33], s[1 * 33]); o.y = pkbf(s[2 * 33], s[3 * 33]); o.z = pkbf(s[4 * 33], s[5 * 33]); o.w = pkbf(s[6 * 33], s[7 * 33]);
        *(GAS u32x4*)(WT + (size_t)(drow0 + n) * K + k0 + 8 * c) = o; }
    LDS_WAIT(); asm volatile("" ::: "memory");
}
__device__ __forceinline__ void transpose_item_f8(const float* W, int K, int N, unsigned char* WT, int k0, int n0, int drow0, float scale, LAS float* scr, int lane) {
    float t[32];
#pragma unroll
    for (int i = 0; i < 32; ++i) t[i] = __builtin_nontemporal_load(W + (size_t)(k0 + 2 * i + (lane >> 5)) * N + n0 + (lane & 31));
#pragma unroll
    for (int i = 0; i < 32; ++i) scr[(2 * i + (lane >> 5)) * 33 + (lane & 31)] = t[i];
    LDS_WAIT(); asm volatile("" ::: "memory");
    const int n = lane >> 1, hf = lane & 1; const LAS float* sp = scr + (32 * hf) * 33 + n;
    u32x4 o0, o1;
    o0.x = pk4f8(sp[0 * 33] * scale, sp[1 * 33] * scale, sp[2 * 33] * scale, sp[3 * 33] * scale);     o0.y = pk4f8(sp[4 * 33] * scale, sp[5 * 33] * scale, sp[6 * 33] * scale, sp[7 * 33] * scale);
    o0.z = pk4f8(sp[8 * 33] * scale, sp[9 * 33] * scale, sp[10 * 33] * scale, sp[11 * 33] * scale);   o0.w = pk4f8(sp[12 * 33] * scale, sp[13 * 33] * scale, sp[14 * 33] * scale, sp[15 * 33] * scale);
    o1.x = pk4f8(sp[16 * 33] * scale, sp[17 * 33] * scale, sp[18 * 33] * scale, sp[19 * 33] * scale); o1.y = pk4f8(sp[20 * 33] * scale, sp[21 * 33] * scale, sp[22 * 33] * scale, sp[23 * 33] * scale);
    o1.z = pk4f8(sp[24 * 33] * scale, sp[25 * 33] * scale, sp[26 * 33] * scale, sp[27 * 33] * scale); o1.w = pk4f8(sp[28 * 33] * scale, sp[29 * 33] * scale, sp[30 * 33] * scale, sp[31 * 33] * scale);
    GAS u32x4* dst = (GAS u32x4*)(WT + (size_t)(drow0 + n) * K + k0 + 32 * hf);
    dst[0] = o0; dst[1] = o1;
    LDS_WAIT(); asm volatile("" ::: "memory");
}
__device__ __forceinline__ void transpose_item_f6(const float* W, int K, int N, unsigned char* WT, int k0, int n0, int drow0, LAS float* scr, int lane) {
    float t[32];
#pragma unroll
    for (int i = 0; i < 32; ++i) t[i] = __builtin_nontemporal_load(W + (size_t)(k0 + 2 * i + (lane >> 5)) * N + n0 + (lane & 31));
#pragma unroll
    for (int i = 0; i < 32; ++i) scr[(2 * i + (lane >> 5)) * 33 + (lane & 31)] = t[i];
    LDS_WAIT(); asm volatile("" ::: "memory");
    const int n = lane >> 1, hf = lane & 1; const LAS float* sp = scr + (32 * hf) * 33 + n;
    float x[32];
#pragma unroll
    for (int i = 0; i < 32; ++i) x[i] = sp[i * 33];
    u32x4 c0, c1; mxfp6_block(x, c0, c1);
    const int kb32 = (k0 >> 5) + hf; unsigned char* dst = WT + (size_t)(drow0 + n) * K + (kb32 >> 2) * 128 + (kb32 & 3) * 16;
    *(GAS u32x4*)dst = c0; *(GAS u32x4*)(dst + 64) = c1;
    LDS_WAIT(); asm volatile("" ::: "memory");
}
__device__ __forceinline__ unsigned pk4i8(float a, float b, float c, float d) {
    const int ia = (int)__builtin_rintf(a), ib = (int)__builtin_rintf(b), ic = (int)__builtin_rintf(c), id = (int)__builtin_rintf(d);
    return (unsigned)(ia & 255) | ((unsigned)(ib & 255) << 8) | ((unsigned)(ic & 255) << 16) | ((unsigned)(id & 255) << 24); }
__device__ __forceinline__ void transpose_item_i8(const float* W, int K, int N, unsigned char* WT, int k0, int n0, int drow0, float scale, LAS float* scr, int lane) {
    float t[32];
#pragma unroll
    for (int i = 0; i < 32; ++i) t[i] = W[(size_t)(k0 + 2 * i + (lane >> 5)) * N + n0 + (lane & 31)];
#pragma unroll
    for (int i = 0; i < 32; ++i) scr[(2 * i + (lane >> 5)) * 33 + (lane & 31)] = t[i];
    LDS_WAIT(); asm volatile("" ::: "memory");
    const int n = lane >> 1, hf = lane & 1; const LAS float* sp = scr + (32 * hf) * 33 + n;
    u32x4 o0, o1;
    o0.x = pk4i8(sp[0 * 33] * scale, sp[1 * 33] * scale, sp[2 * 33] * scale, sp[3 * 33] * scale);     o0.y = pk4i8(sp[4 * 33] * scale, sp[5 * 33] * scale, sp[6 * 33] * scale, sp[7 * 33] * scale);
    o0.z = pk4i8(sp[8 * 33] * scale, sp[9 * 33] * scale, sp[10 * 33] * scale, sp[11 * 33] * scale);   o0.w = pk4i8(sp[12 * 33] * scale, sp[13 * 33] * scale, sp[14 * 33] * scale, sp[15 * 33] * scale);
    o1.x = pk4i8(sp[16 * 33] * scale, sp[17 * 33] * scale, sp[18 * 33] * scale, sp[19 * 33] * scale); o1.y = pk4i8(sp[20 * 33] * scale, sp[21 * 33] * scale, sp[22 * 33] * scale, sp[23 * 33] * scale);
    o1.z = pk4i8(sp[24 * 33] * scale, sp[25 * 33] * scale, sp[26 * 33] * scale, sp[27 * 33] * scale); o1.w = pk4i8(sp[28 * 33] * scale, sp[29 * 33] * scale, sp[30 * 33] * scale, sp[31 * 33] * scale);
    GAS u32x4* dst = (GAS u32x4*)(WT + (size_t)(drow0 + n) * K + k0 + 32 * hf);
    dst[0] = o0; dst[1] = o1;
    LDS_WAIT(); asm volatile("" ::: "memory");
}
__device__ __forceinline__ void sincos_d(double x, double& s, double& c) {
    const double TWO_PI = 6.283185307179586476925;
    const double k = __builtin_rint(x / TWO_PI); const double r = x - k * TWO_PI;
    const double r2 = r * r; double ts = r, tc = 1.0; s = r; c = 1.0;
    for (int i = 1; i <= 16; ++i) { tc *= -r2 / (double)((2 * i - 1) * (2 * i)); ts *= -r2 / (double)((2 * i) * (2 * i + 1)); c += tc; s += ts; }
}

constexpr int CI_F = 16 * 112, CI_FD = 56 * 32, MOE_ITEMS = 8 * (2 * CI_F + CI_FD);
constexpr int MOE_TAIL_A = 12000, MOE_TAIL_B = 7000, MOE_TAIL_C = 12000, MOE_TAIL_TOTAL = MOE_TAIL_A + MOE_TAIL_B + MOE_TAIL_C;
__device__ __forceinline__ void moe_convert_item(int r, const float* wg, const float* wu, const float* wd, unsigned char* mgu, unsigned char* md, LAS float* scr, int lane) {
    const int e = r / (2 * CI_F + CI_FD); int q = r % (2 * CI_F + CI_FD);
    if (q < 2 * CI_F) { const int up = q / CI_F; q %= CI_F; const int kb = q / 112, nb = q % 112, n0 = 32 * nb;
        transpose_item_f6((up ? wu : wg) + (size_t)e * 1024 * DFF, 1024, DFF, mgu + (size_t)e * 7168 * 1024, 64 * kb, n0, 256 * (n0 >> 7) + 128 * up + (n0 & 127), scr, lane); }
    else { q -= 2 * CI_F; const int kb = q / 32, nb = q % 32; transpose_item_f8(wd + (size_t)e * DFF * 1024, DFF, 1024, md + (size_t)e * 1024 * DFF, 64 * kb, 32 * nb, 32 * nb, MOE_SD, scr, lane); }
}
__device__ __forceinline__ void moe_convert_tail(int nunits, int G, int bx, int first, int count, const float* wg, const float* wu, const float* wd, unsigned char* mgu, unsigned char* md, LAS unsigned char* lds) {
    const int busy = nunits % G; if (busy == 0 || bx < busy) return;
    int tid_ = threadIdx.x; asm volatile("" : "+v"(tid_)); const int lane = tid_ & 63, wave = __builtin_amdgcn_readfirstlane(tid_ >> 6);
    LAS float* scr = (LAS float*)(lds + wave * 16384);
    const int nw = (G - busy) * 8, w = (bx - busy) * 8 + wave;
    for (int it = w; it < count; it += nw) moe_convert_item(first + it, wg, wu, wd, mgu, md, scr, lane);
}

struct Args { const float* in[24]; float* out; unsigned char* ws; int ph_lo, ph_hi, li, pad; };
constexpr int NPH = 18;

__device__ __forceinline__ void norm_store(const f32x4 (&v)[4], float ssum, const float* g, const float* mrow, int shc, int scc, bf16_t* XNo, size_t m, int lane, float* rsc) {
    const float rstd = 1.0f / __builtin_sqrtf(ssum * (1.0f / DM) + EPS);
    f32x4 y[4];
#pragma unroll
    for (int j = 0; j < 4; ++j) { const f32x4 gv = *(const f32x4*)(g + 4 * lane + 256 * j), sc = *(const f32x4*)(mrow + scc * 1024 + 4 * lane + 256 * j), sh = *(const f32x4*)(mrow + shc * 1024 + 4 * lane + 256 * j);
        y[j] = (v[j] * rstd) * gv * (sc + 1.0f) + sh; }
    if (rsc == nullptr) {
#pragma unroll
        for (int j = 0; j < 4; ++j) { u32x2 w; w.x = pkbf(y[j].x, y[j].y); w.y = pkbf(y[j].z, y[j].w); *((GAS u32x2*)(XNo + m * DM) + lane + 64 * j) = w; }
    } else {
        float mx = 0.f;
#pragma unroll
        for (int j = 0; j < 4; ++j) mx = __builtin_fmaxf(__builtin_fmaxf(mx, __builtin_fmaxf(__builtin_fabsf(y[j].x), __builtin_fabsf(y[j].y))), __builtin_fmaxf(__builtin_fabsf(y[j].z), __builtin_fabsf(y[j].w)));
#pragma unroll
        for (int o = 1; o < 64; o <<= 1) mx = __builtin_fmaxf(mx, __shfl_xor(mx, o));
        mx = __builtin_fmaxf(mx, 1e-20f); const float qs = 127.0f / mx;
#pragma unroll
        for (int j = 0; j < 4; ++j) *((GAS unsigned*)((unsigned char*)XNo + m * DM) + lane + 64 * j) = pk4i8(y[j].x * qs, y[j].y * qs, y[j].z * qs, y[j].w * qs);
        if (lane == 0) rsc[m] = mx * (1.0f / 127.0f);
    }
}
template <bool SRC_BF16> __device__ __forceinline__ void norm_rows(const void* srcLv, const float* srcC, int nrows, const float* g, const float* mod, int shc, int scc, bf16_t* XNo, int gw, int NGW, int lane,
                                          const float* part, int nS, const float* gatec, float* zout, float* rsc = nullptr) {
    if (nrows > NLAT) {
        for (int rc = gw; rc < NCTXR; rc += NGW) {
            const GAS f32x4* xr = (const GAS f32x4*)(srcC + (size_t)rc * DM) + lane;
            f32x4 v[4];
#pragma unroll
            for (int j = 0; j < 4; ++j) v[j] = xr[64 * j];
            if (part != nullptr) {
                f32x4 a[4];
#pragma unroll
                for (int j = 0; j < 4; ++j) a[j] = (f32x4){0.f, 0.f, 0.f, 0.f};
                for (int s0 = 0; s0 < nS; s0 += 7) {
                    f32x4 t[7][4];
#pragma unroll
                    for (int q = 0; q < 7; ++q) { const int s2 = (s0 + q < nS) ? s0 + q : s0; const GAS f32x4* pr = (const GAS f32x4*)(part + ((size_t)s2 * NCTXR + rc) * DM) + lane;
#pragma unroll
                        for (int j = 0; j < 4; ++j) t[q][j] = pr[64 * j]; }
#pragma unroll
                    for (int q = 0; q < 7; ++q) if (s0 + q < nS) {
#pragma unroll
                        for (int j = 0; j < 4; ++j) a[j] += t[q][j]; }
                }
#pragma unroll
                for (int j = 0; j < 4; ++j) v[j] += *(const f32x4*)(gatec + 4 * lane + 256 * j) * a[j];
                if (zout != nullptr) { GAS f32x4* zr = (GAS f32x4*)(zout + (size_t)rc * DM) + lane;
#pragma unroll
                    for (int j = 0; j < 4; ++j) zr[64 * j] = v[j]; }
            }
            float ss = 0.f;
#pragma unroll
            for (int j = 0; j < 4; ++j) ss += (v[j].x * v[j].x + v[j].y * v[j].y) + (v[j].z * v[j].z + v[j].w * v[j].w);
            norm_store(v, wave_sum(ss), g, mod + (size_t)4 * 6144, shc, scc, XNo, (size_t)NLAT + rc, lane, rsc);
        }
    }
    const bool bal = (NGW == 2048) && (nrows > NLAT);
    for (int k = 0;; ++k) {
        int grp;
        if (bal) { if (k < 3) grp = gw + 2048 * k; else if (gw >= 1024 && k < 5) grp = 6144 + 2 * (gw - 1024) + (k - 3); else break; }
        else { grp = gw + k * NGW; if (grp >= NLAT / 4) break; }
        const int m0 = grp * 4;
        const int mb = m0 >> 13;
        f32x4 v[4][4];
        if constexpr (SRC_BF16) { const GAS u32x2* xr = (const GAS u32x2*)((const bf16_t*)srcLv + (size_t)m0 * DM) + lane;
#pragma unroll
            for (int r = 0; r < 4; ++r)
#pragma unroll
                for (int j = 0; j < 4; ++j) { const u32x2 w = xr[r * 256 + 64 * j]; v[r][j] = (f32x4){__uint_as_float(w.x << 16), __uint_as_float(w.x & 0xffff0000u), __uint_as_float(w.y << 16), __uint_as_float(w.y & 0xffff0000u)}; } }
        else { const GAS f32x4* xr = (const GAS f32x4*)((const float*)srcLv + (size_t)m0 * DM) + lane;
#pragma unroll
            for (int r = 0; r < 4; ++r)
#pragma unroll
                for (int j = 0; j < 4; ++j) v[r][j] = xr[r * 256 + 64 * j]; }
        float ss[4];
#pragma unroll
        for (int r = 0; r < 4; ++r) { ss[r] = 0.f;
#pragma unroll
            for (int j = 0; j < 4; ++j) ss[r] += (v[r][j].x * v[r][j].x + v[r][j].y * v[r][j].y) + (v[r][j].z * v[r][j].z + v[r][j].w * v[r][j].w); }
#pragma unroll
        for (int o = 1; o < 64; o <<= 1) {
#pragma unroll
            for (int r = 0; r < 4; ++r) ss[r] += __shfl_xor(ss[r], o); }
#pragma unroll
        for (int r = 0; r < 4; ++r) norm_store(v[r], ss[r], g, mod + (size_t)mb * 6144, shc, scc, XNo, (size_t)(m0 + r), lane, rsc);
    }
}

__global__ void __launch_bounds__(512, 2) fwd(Args args) {
    extern __shared__ __attribute__((aligned(16))) unsigned char lds_raw[];
    LAS unsigned char* lds = (LAS unsigned char*)lds_raw;
    volatile LAS unsigned* MISC = (volatile LAS unsigned*)(lds + MISC_OFF);
    LAS int* gtab = (LAS int*)(lds + GTAB_OFF);
    const int G = gridDim.x; const int bx = blockIdx.x; const int vcu = (G % 8 == 0) ? (bx % 8) * (G / 8) + bx / 8 : bx;
    const int NGW = G * 8;
#define PHASE_IDS() int tid_ = threadIdx.x; asm volatile("" : "+v"(tid_)); const int tid = tid_, lane = tid & 63, wave = __builtin_amdgcn_readfirstlane(tid >> 6), gw = vcu * 8 + wave; (void)lane; (void)gw
    unsigned char* ws = args.ws;
    gu32* ctl = (gu32*)(ws + WS_CTL);
#define MOD ((float*)(ws + WS_MOD))
#define ROPE ((float*)(ws + WS_ROPE))
#define STATS ((float*)(ws + WS_STATS))
#define RSC ((float*)(ws + WS_RSC))
#define LIST ((int*)(ws + WS_LIST))
#define TINFO ((int*)(ws + WS_TINFO))
#define WSB ((bf16_t*)(ws + WS_WS))
#define WIN ((unsigned char*)(ws + WS_WIN))
#define WAO ((bf16_t*)(ws + WS_WAO))
#define WQKV ((unsigned char*)(ws + WS_WQKV))
#define WBO ((unsigned char*)(ws + WS_WBO))
#define WGU ((unsigned char*)(ws + WS_WGU))
#define WD ((bf16_t*)(ws + WS_WD))
#define MGU ((unsigned char*)(ws + WS_MGU))
#define MD ((unsigned char*)(ws + WS_MD))
#define XN8 ((unsigned char*)(ws + WS_XN))
#define XN ((bf16_t*)(ws + WS_XN))
#define ZB ((float*)(ws + WS_ZB))
#define UVT ((bf16_t*)(ws + WS_UVT))
#define A2 ((bf16_t*)(ws + WS_A2))
#define HB ((bf16_t*)(ws + WS_H))
#define QKV ((bf16_t*)(ws + WS_QKV))
#define OB ((unsigned char*)(ws + WS_O))
#define YB ((bf16_t*)(ws + WS_Y))
#define HC ((unsigned char*)(ws + WS_HC))
#define YP ((bf16_t*)(ws + WS_YP))
#define PART1 ((float*)(ws + WS_PART1))
#define PART2 ((float*)(ws + WS_PART2))
#define I_X (args.in[0])
#define I_C (args.in[1])
#define I_CTX (args.in[2])
#define I_CCTX (args.in[3])
#define I_ADAW (args.in[4])
#define I_ADAB (args.in[5])
#define I_NORMG (args.in[6])
#define I_FINALG (args.in[7])
#define HL ((bf16_t*)(ws + WS_HLB))

    { PHASE_IDS(); for (int u = tid; u < (LDS_BYTES - MISC_OFF) / 4; u += 512) ((LAS unsigned*)(lds + MISC_OFF))[u] = 0u; }
    __syncthreads();
    const int lo = args.ph_lo, hi_ph = args.ph_hi;
    const bool one_launch = (hi_ph - lo) > 1;
    XcdBarrier bar; bar.bar = (unsigned*)(ctl + CW_BAR) + args.li * XCD_BAR_WORDS; bar.x = 0; bar.st = nullptr;
    if (one_launch) bar = xcd_barrier_post((unsigned*)(ctl + CW_BAR) + args.li * XCD_BAR_WORDS, MISC + 8);
#ifndef PHMASK
#define PHMASK 0xFFFFFFFFu
#endif
#define IN(k) (((PHMASK >> (k)) & 1) && lo <= (k) && (k) < hi_ph)
#define BOTH(k) (IN(k) && IN((k) + 1))
#define GRID_BAR() xcd_barrier(bar)
#if defined(PROBE_LO)
    unsigned long long tpA = __builtin_amdgcn_s_memrealtime(), tpB = 0;
#define PROBE_MARK(k) do { if ((k) == PROBE_LO - 1) tpA = __builtin_amdgcn_s_memrealtime(); if ((k) == PROBE_HI) tpB = __builtin_amdgcn_s_memrealtime(); } while (0)
#else
#define PROBE_MARK(k) do { } while (0)
#endif

    if (IN(0)) {
        PHASE_IDS();
        {
            LAS float* sv = (LAS float*)lds;
            LAS float* red = (LAS float*)(lds + 5 * 1024 * 4);
            if (bx < 192) {
                for (int idx = tid; idx < 5 * 1024; idx += 512) { const int r = idx >> 10, k = idx & 1023; const float cv = r < 4 ? I_C[r * 1024 + k] : I_CCTX[k]; sv[idx] = cv / (1.0f + __expf(-cv)); }
                __syncthreads();
                for (int item = bx; item < 192; item += G) {
                    const int i = item / 96, n0 = (item % 96) * 64, nn = tid & 63, kq = tid >> 6;
                    float a0 = 0.f, a1 = 0.f, a2 = 0.f, a3 = 0.f, a4 = 0.f;
                    const float* wp = I_ADAW + ((size_t)i * 1024 + kq * 128) * 6144 + n0 + nn;
#pragma unroll 8
                    for (int k = 0; k < 128; ++k) { const float w = wp[(size_t)k * 6144]; const int kk = kq * 128 + k;
                        a0 += sv[kk] * w; a1 += sv[1024 + kk] * w; a2 += sv[2048 + kk] * w; a3 += sv[3072 + kk] * w; a4 += sv[4096 + kk] * w; }
                    red[(kq * 5 + 0) * 64 + nn] = a0; red[(kq * 5 + 1) * 64 + nn] = a1; red[(kq * 5 + 2) * 64 + nn] = a2; red[(kq * 5 + 3) * 64 + nn] = a3; red[(kq * 5 + 4) * 64 + nn] = a4;
                    __syncthreads();
                    if (tid < 320) { const int r = tid >> 6; float s = I_ADAB[i * 6144 + n0 + nn];
#pragma unroll
                        for (int q = 0; q < 8; ++q) s += red[(q * 5 + r) * 64 + nn];
                        MOD[((size_t)i * 5 + r) * 6144 + n0 + nn] = s; }
                    __syncthreads();
                }
            }
            __syncthreads();
        }
        {
            LAS float* scr = (LAS float*)(lds + wave * 16384);
            constexpr int I_IN = 16 * 64, I_AO = 16 * 32, I_QKV = 16 * 48, I_BO = 16 * 32, I_F = 16 * 112, I_FD = 56 * 32;
            constexpr int I_DENSE = I_IN + I_AO + I_QKV + I_BO + 2 * I_F + I_FD, I_MOE = MOE_ITEMS, I_WS = 128, I_ROPE = 32;
            constexpr int NITEMS = I_DENSE + I_MOE + I_WS + I_ROPE;
            for (int it = gw; it < NITEMS; it += NGW) {
                int r = it;
                if (r < I_IN) { const int kb = r / 64, nb = r % 64; const float* W = args.in[8]; float mx = 0.f;
#pragma unroll
                    for (int i = 0; i < 32; ++i) mx = __builtin_fmaxf(mx, __builtin_fabsf(W[(size_t)(64 * kb + 2 * i + (lane >> 5)) * 2048 + 32 * nb + (lane & 31)]));
#pragma unroll
                    for (int o = 1; o < 64; o <<= 1) mx = __builtin_fmaxf(mx, __shfl_xor(mx, o));
                    if (lane == 0) __hip_atomic_fetch_max((unsigned*)(ctl + CW_WAMAX + 192), __float_as_uint(mx), __ATOMIC_RELAXED, __HIP_MEMORY_SCOPE_AGENT);
                    continue; } r -= I_IN;
                if (r < I_AO) { const int kb = r / 32, nb = r % 32; transpose_item(args.in[13], 1024, 1024, WAO, 64 * kb, 32 * nb, 32 * nb, scr, lane); continue; } r -= I_AO;
                if (r < I_QKV) { const int kb = r / 48, nb = r % 48; const float* W = args.in[14]; float mx = 0.f;
#pragma unroll
                    for (int i = 0; i < 32; ++i) mx = __builtin_fmaxf(mx, __builtin_fabsf(W[(size_t)(64 * kb + 2 * i + (lane >> 5)) * NQKV + 32 * nb + (lane & 31)]));
#pragma unroll
                    for (int o = 1; o < 64; o <<= 1) mx = __builtin_fmaxf(mx, __shfl_xor(mx, o));
                    if (lane == 0) __hip_atomic_fetch_max((unsigned*)(ctl + CW_WAMAX + 128), __float_as_uint(mx), __ATOMIC_RELAXED, __HIP_MEMORY_SCOPE_AGENT);
                    continue; } r -= I_QKV;
                if (r < I_BO) { const int kb = r / 32, nb = r % 32; transpose_item_f8(args.in[16], 1024, 1024, WBO, 64 * kb, 32 * nb, 32 * nb, MOE_SGU, scr, lane); continue; } r -= I_BO;
                if (r < 2 * I_F) { const int up = r / I_F; const int q = r % I_F; const int kb = q / 112, nb = q % 112;
                    const float* W = args.in[17 + up]; float mx = 0.f;
#pragma unroll
                    for (int i = 0; i < 32; ++i) mx = __builtin_fmaxf(mx, __builtin_fabsf(W[(size_t)(64 * kb + 2 * i + (lane >> 5)) * DFF + 32 * nb + (lane & 31)]));
#pragma unroll
                    for (int o = 1; o < 64; o <<= 1) mx = __builtin_fmaxf(mx, __shfl_xor(mx, o));
                    if (lane == 0) __hip_atomic_fetch_max((unsigned*)(ctl + CW_WAMAX + 64 * up), __float_as_uint(mx), __ATOMIC_RELAXED, __HIP_MEMORY_SCOPE_AGENT);
                    continue; } r -= 2 * I_F;
                if (r < I_FD) { const int kb = r / 32, nb = r % 32; transpose_item(args.in[19], DFF, 1024, WD, 64 * kb, 32 * nb, 32 * nb, scr, lane); continue; } r -= I_FD;
                if (r < I_MOE) { if (r >= MOE_TAIL_TOTAL) moe_convert_item(r, args.in[21], args.in[22], args.in[23], MGU, MD, scr, lane); continue; } r -= I_MOE;
                if (r < I_WS) { const float* src = args.in[11] + (size_t)r * 2048;
#pragma unroll
                    for (int j = 0; j < 8; ++j) { const f32x4 v = *(const f32x4*)(src + j * 256 + lane * 4); u32x2 w; w.x = pkbf(v.x, v.y); w.y = pkbf(v.z, v.w); *(u32x2*)(WSB + (size_t)r * 2048 + j * 256 + lane * 4) = w; }
                    continue; } r -= I_WS;
                {
                    const int ent = r * 64 + lane; const int pos = ent >> 4, i = ent & 15;
                    double inv = 1.0; for (int q = 0; q < i; ++q) inv *= 0.56234132519034908;
                    const float ang = (float)pos * (float)inv; double s, c; sincos_d((double)ang, s, c);
                    ROPE[ent] = (float)c; ROPE[2048 + ent] = (float)s;
                }
            }
        }
        if (BOTH(0)) GRID_BAR(); PROBE_MARK(0);
    }
    if (IN(1)) { PHASE_IDS();
        {
            LAS float* scr = (LAS float*)(lds + wave * 16384);
            const float ag = __uint_as_float(__hip_atomic_load((unsigned*)(ctl + CW_WAMAX), __ATOMIC_RELAXED, __HIP_MEMORY_SCOPE_AGENT)), au = __uint_as_float(__hip_atomic_load((unsigned*)(ctl + CW_WAMAX + 64), __ATOMIC_RELAXED, __HIP_MEMORY_SCOPE_AGENT));
            if (gw == 0 && lane == 0) { RSC[MALL] = ag * (1.0f / 127.0f); RSC[MALL + 1] = au * (1.0f / 127.0f); }
            const float ai_ = __uint_as_float(__hip_atomic_load((unsigned*)(ctl + CW_WAMAX + 192), __ATOMIC_RELAXED, __HIP_MEMORY_SCOPE_AGENT));
            if (gw == 0 && lane == 0) RSC[MALL + 3] = ai_ * (1.0f / 127.0f);
            for (int it = gw; it < 16 * 64; it += NGW) { const int kb = it / 64, nb = it % 64; transpose_item_i8(args.in[8], 1024, 2048, WIN, 64 * kb, 32 * nb, 32 * nb, 127.0f / ai_, scr, lane); }
            const float aq = __uint_as_float(__hip_atomic_load((unsigned*)(ctl + CW_WAMAX + 128), __ATOMIC_RELAXED, __HIP_MEMORY_SCOPE_AGENT));
            if (gw == 0 && lane == 0) RSC[MALL + 2] = aq * (1.0f / 127.0f);
            for (int it = gw; it < 16 * 48; it += NGW) { const int kb = it / 48, nb = it % 48; transpose_item_i8(args.in[14], 1024, NQKV, WQKV, 64 * kb, 32 * nb, 32 * nb, 127.0f / aq, scr, lane); }
            for (int it = gw; it < 2 * 16 * 112; it += NGW) { const int up = it / (16 * 112), q = it % (16 * 112), kb = q / 112, nb = q % 112, n0 = 32 * nb;
                transpose_item_i8(args.in[17 + up], 1024, DFF, WGU, 64 * kb, n0, 256 * (n0 >> 7) + 128 * up + (n0 & 127), 127.0f / (up ? au : ag), scr, lane); }
        }
        norm_rows<false>(I_X, I_CTX, MALL, I_NORMG + 0 * 1024, MOD, 0, 1, XN, gw, NGW, lane, nullptr, 0, nullptr, nullptr, RSC); if (BOTH(1)) GRID_BAR(); PROBE_MARK(1); }
    if (IN(2)) {
        pg8::DenseSched S{(const char*)WIN, (const char*)XN8, 8, NPA, G, bx, (size_t)256 * 1024};
        pg8::EpiGeluT E{UVT, STATS, RSC, RSC + MALL + 3};
        pg8::gemm_phase<pg8::EpiGeluT, pg8::DenseSched, true, false, false, true>(lds, gtab, 512, 8, S, E);
        moe_convert_tail(8 * NPA, G, bx, 0, MOE_TAIL_A, args.in[21], args.in[22], args.in[23], MGU, MD, lds);
        if (BOTH(2)) GRID_BAR(); PROBE_MARK(2);
    }
    if (IN(3)) {
        PHASE_IDS();
        const float* vg = args.in[9]; const float* vb = args.in[10]; const float* bs = args.in[12];
        LAS unsigned char* buf = lds + wave * 16384;
        LAS float* mu_l = (LAS float*)(lds + RING_BYTES + 4096 + wave * 1024); LAS float* rs_l = mu_l + 128;
        const int r32 = lane & 31, h = lane >> 5;
        for (int unit = gw; unit < (MALL / 128) * 32; unit += NGW) {
            const int ph = unit & 1, g = (unit >> 1) & 15, ch = unit >> 5, q0 = ch * 128;
#pragma unroll
            for (int tt = 0; tt < 2; ++tt) { const int tok = q0 + lane * 2 + tt; const f32x4* sp = (const f32x4*)(STATS + (size_t)tok * 16);
                const f32x4 a = sp[0], b = sp[1], c = sp[2], d = sp[3];
                const float sum = (a.x + a.z) + (b.x + b.z) + (c.x + c.z) + (d.x + d.z), sq = (a.y + a.w) + (b.y + b.w) + (c.y + c.w) + (d.y + d.w);
                const float mean = sum * (1.0f / 1024.0f), var = sq * (1.0f / 1024.0f) - mean * mean;
                mu_l[lane * 2 + tt] = mean; rs_l[lane * 2 + tt] = 1.0f / __builtin_sqrtf(var + EPS); }
            {
                u32x4 t[16]; const int rw = lane >> 4, ck = lane & 15;
                const bf16_t* vp = UVT + (size_t)(1024 + 64 * g + rw) * MALL + q0 + ck * 8;
#pragma unroll
                for (int i = 0; i < 16; ++i) { t[i] = *(const u32x4*)vp; vp += (size_t)4 * MALL; asm volatile("" : "+v"(vp)); }
#pragma unroll
                for (int i = 0; i < 16; ++i) { const int row = 4 * i + rw; *(LAS u32x4*)(buf + row * 256 + ((ck ^ (row & 15)) << 4)) = t[i]; }
            }
            bf16x8 af[2][8];
#pragma unroll
            for (int ct = 0; ct < 2; ++ct) { const int row = 32 * ct + r32; const float vgc = vg[64 * g + row], vbc = vb[64 * g + row];
#pragma unroll
                for (int s2 = 0; s2 < 8; ++s2) { const int qs = 16 * s2 + 8 * h, ck = 2 * s2 + h;
                    const f32x4 m0 = *(const LAS f32x4*)(mu_l + qs), m1 = *(const LAS f32x4*)(mu_l + qs + 4), r0 = *(const LAS f32x4*)(rs_l + qs), r1 = *(const LAS f32x4*)(rs_l + qs + 4);
                    const bf16x8 raw = *(const LAS bf16x8*)(buf + row * 256 + ((ck ^ (row & 15)) << 4));
                    float y[8];
#pragma unroll
                    for (int j = 0; j < 4; ++j) { y[j] = (bf2f((unsigned short)raw[j]) - m0[j]) * r0[j] * vgc + vbc; y[4 + j] = (bf2f((unsigned short)raw[4 + j]) - m1[j]) * r1[j] * vgc + vbc; }
                    u32x4 w; w.x = pkbf(y[0], y[1]); w.y = pkbf(y[2], y[3]); w.z = pkbf(y[4], y[5]); w.w = pkbf(y[6], y[7]); af[ct][s2] = __builtin_bit_cast(bf16x8, w); } }
            {
                u32x4 t[8]; const int rw = lane >> 3, ck = lane & 7;
                const bf16_t* up = UVT + (size_t)(64 * g + rw) * MALL + q0 + 64 * ph + ck * 8;
#pragma unroll
                for (int i = 0; i < 8; ++i) { t[i] = *(const u32x4*)up; up += (size_t)8 * MALL; asm volatile("" : "+v"(up)); }
#pragma unroll
                for (int i = 0; i < 8; ++i) { const int row = 8 * i + rw; *(LAS u32x4*)(buf + row * 128 + ((ck ^ (row & 7)) << 4)) = t[i]; }
            }
#pragma unroll
            for (int ptl = 0; ptl < 2; ++ptl) {
                const int pl = 32 * ptl + r32, p = 64 * ph + pl; const float bsv = bs[g * 128 + p];
                bf16x8 bfr[8];
#pragma unroll
                for (int s2 = 0; s2 < 8; ++s2) bfr[s2] = *(const bf16x8*)(WSB + (size_t)(g * 128 + p) * 128 + 16 * s2 + 8 * h);
                f32x16 acc[2]; acc[0] = f32x16{}; acc[1] = f32x16{};
#pragma unroll
                for (int s2 = 0; s2 < 8; ++s2)
#pragma unroll
                    for (int ct = 0; ct < 2; ++ct) acc[ct] = __builtin_amdgcn_mfma_f32_32x32x16_bf16(af[ct][s2], bfr[s2], acc[ct], 0, 0, 0);
#pragma unroll
                for (int ct = 0; ct < 2; ++ct)
#pragma unroll
                    for (int rr = 0; rr < 4; ++rr) { const int c = 32 * ct + 8 * rr + 4 * h; float o[4];
#pragma unroll
                        for (int e = 0; e < 4; ++e) { const int cc = c + e; const float uu = bf2f(*(const LAS unsigned short*)(buf + cc * 128 + (((pl >> 3) ^ (cc & 7)) << 4) + (pl & 7) * 2)); o[e] = uu * (acc[ct][4 * rr + e] + bsv); }
                        u32x2 w; w.x = pkbf(o[0], o[1]); w.y = pkbf(o[2], o[3]);
                        *(LAS u32x2*)(buf + 8192 + pl * 128 + (((c >> 3) ^ (pl & 7)) << 4) + (c & 7) * 2) = w; }
            }
            {
                const int rw = lane >> 3, ck = lane & 7;
#pragma unroll
                for (int i = 0; i < 8; ++i) { const int row = 8 * i + rw; const u32x4 v = *(const LAS u32x4*)(buf + 8192 + row * 128 + ((ck ^ (row & 7)) << 4));
                    *(u32x4*)(A2 + (size_t)(q0 + 64 * ph + row) * DM + 64 * g + ck * 8) = v; }
            }
        }
        if (BOTH(3)) GRID_BAR(); PROBE_MARK(3);
    }
    if (IN(4)) {
        { pg8::DenseSched S{(const char*)A2, (const char*)WAO, NPL, 4, G, bx, (size_t)256 * 1024 * 2};
          pg8::EpiResid<true> E{I_X, nullptr, HL, MOD + 2 * 1024, 1.0f};
          pg8::gemm_phase<pg8::EpiResid<true>, pg8::DenseSched, true, false>(lds, gtab, 1024, 16, S, E); }
        { pg8::SplitSched S{(const char*)(A2 + (size_t)NLAT * DM), (const char*)WAO, 4, 4, P3_NS, G, bx, NPL, (size_t)256 * 1024 * 2, (size_t)(1024 / P3_NS) * 2};
          pg8::EpiPartF32 E{PART1, (size_t)NCTXR * DM};
          pg8::gemm_phase<pg8::EpiPartF32, pg8::SplitSched, true, false>(lds, gtab, 1024, 1024 / P3_NS / 64, S, E); }
        if (BOTH(4)) GRID_BAR(); PROBE_MARK(4);
    }
    if (IN(5)) { PHASE_IDS(); norm_rows<true>(HL, I_CTX, MALL, I_NORMG + 1 * 1024, MOD, 3, 4, XN, gw, NGW, lane, PART1, P3_NS, MOD + 4 * 6144 + 2 * 1024, ZB, RSC); if (BOTH(5)) GRID_BAR(); PROBE_MARK(5); }
    if (IN(6)) {
        pg8::DenseSched S{(const char*)XN8, (const char*)WGU, NPA, 28, G, bx, (size_t)256 * 1024};
        pg8::EpiSwiGLUI8 E{HB, RSC, RSC + MALL};
        pg8::gemm_phase<pg8::EpiSwiGLUI8, pg8::DenseSched, true, false, false, true>(lds, gtab, 512, 8, S, E);
        moe_convert_tail(NPA * 28, G, bx, MOE_TAIL_A, MOE_TAIL_B, args.in[21], args.in[22], args.in[23], MGU, MD, lds);
        if (BOTH(6)) GRID_BAR(); PROBE_MARK(6);
    }
    if (IN(7)) {
        { pg8::DenseSched S{(const char*)HB, (const char*)WD, NPL, 4, G, bx, (size_t)256 * DFF * 2};
          pg8::EpiResid<false> E{nullptr, HL, HL, MOD + 5 * 1024, 1.0f};
          pg8::gemm_phase<pg8::EpiResid<false>, pg8::DenseSched, true, false>(lds, gtab, DFF, 56, S, E); }
        { pg8::SplitSched S{(const char*)(HB + (size_t)NLAT * DFF), (const char*)WD, 4, 4, P5_NS, G, bx, NPL, (size_t)256 * DFF * 2, (size_t)(DFF / P5_NS) * 2};
          pg8::EpiPartF32 E{PART2, (size_t)NCTXR * DM};
          pg8::gemm_phase<pg8::EpiPartF32, pg8::SplitSched, true, false>(lds, gtab, DFF, DFF / P5_NS / 64, S, E); }
        if (BOTH(7)) GRID_BAR(); PROBE_MARK(7);
    }
    if (IN(8)) { PHASE_IDS(); norm_rows<true>(HL, ZB, MALL, I_NORMG + 2 * 1024, MOD + 5 * 6144, 0, 1, XN, gw, NGW, lane, PART2, P5_NS, MOD + 4 * 6144 + 5 * 1024, nullptr, RSC); if (BOTH(8)) GRID_BAR(); PROBE_MARK(8); }
    if (IN(9)) {
        pg8::DenseSched S{(const char*)XN8, (const char*)WQKV, NPA, 6, G, bx, (size_t)256 * 1024};
        pg8::EpiQKV E{QKV, ROPE, ROPE + 2048, attn_body::C2, RSC, RSC + MALL + 2};
        pg8::gemm_phase<pg8::EpiQKV, pg8::DenseSched, true, false, false, true>(lds, gtab, 512, 8, S, E);
        moe_convert_tail(NPA * 6, G, bx, MOE_TAIL_A + MOE_TAIL_B, MOE_TAIL_C, args.in[21], args.in[22], args.in[23], MGU, MD, lds);
        if (BOTH(9)) GRID_BAR(); PROBE_MARK(9);
    }
    if (IN(10)) {
        static_assert(attn_body::LDS_BYTES_A <= RING_BYTES, "attention LDS");
        const float* sinkp = args.in[15];
        int sb = 0; bool pre = false; bf16x8 qfr[4];
#pragma unroll
        for (int d0 = 0; d0 < 4; ++d0) qfr[d0] = bf16x8{};
        for (int i = 0;; ++i) { const int uid = i * G + vcu; if (uid >= NB * 64 * 4 * 2) break;
            const int pr = uid & 1, hk = (uid >> 1) & 3, n = (uid >> 3) & 63, b = uid >> 9;
            const int uid2 = uid + G; const bool has_next = uid2 < NB * 64 * 4 * 2;
            sb = attn_body::attn_unit<8>(b, hk, n, pr, (const attn_body::bf16*)QKV, OB, sinkp, (char*)lds_raw, sb, pre, has_next, uid2 >> 9, (uid2 >> 1) & 3, (uid2 >> 3) & 63, uid2 & 1, qfr);
            pre = has_next; }
        if (BOTH(10)) GRID_BAR(); PROBE_MARK(10);
    }
    if (IN(11)) {
        pg8::DenseSched S{(const char*)OB, (const char*)WBO, NPL, 4, G, bx, (size_t)256 * 1024};
        pg8::EpiResid<false> E{nullptr, HL, HL, MOD + 5 * 6144 + 2 * 1024, 1.0f / MOE_SGU};
        pg8::gemm_phase<pg8::EpiResid<false>, pg8::DenseSched, true, false, true>(lds, gtab, 512, 8, S, E);
        if (BOTH(11)) GRID_BAR(); PROBE_MARK(11);
    }
    if (IN(12)) {
        PHASE_IDS();
        const float* g = I_NORMG + 3 * 1024; const float* mod = MOD + 5 * 6144; const float* wrt = args.in[20];
        LAS int* l_e = (LAS int*)lds;
        LAS float* l_w = (LAS float*)(lds + 1024);
        LAS int* l_cnt = (LAS int*)(lds + 2048);
        LAS int* l_base = (LAS int*)(lds + 2048 + 64);
        LAS unsigned char* rowb = lds + 8192 + wave * 9216;
        for (int blk = bx; blk < NLAT / 128; blk += G) {
            if (tid < 8) l_cnt[tid] = 0;
            __syncthreads();
            const int mb = (blk * 128) >> 13; const float* mrow = mod + (size_t)mb * 6144;
            for (int i4 = 0; i4 < 8; ++i4) {
                const int tl0 = wave * 16 + i4 * 2, m0 = blk * 128 + tl0;
                const GAS u32x2* xr = (const GAS u32x2*)(HL + (size_t)m0 * DM) + lane;
                f32x4 v[2][4]; float ss[2];
#pragma unroll
                for (int r = 0; r < 2; ++r)
#pragma unroll
                    for (int j = 0; j < 4; ++j) { const u32x2 w = xr[r * 256 + 64 * j]; v[r][j] = (f32x4){__uint_as_float(w.x << 16), __uint_as_float(w.x & 0xffff0000u), __uint_as_float(w.y << 16), __uint_as_float(w.y & 0xffff0000u)}; }
#pragma unroll
                for (int r = 0; r < 2; ++r) { ss[r] = 0.f;
#pragma unroll
                    for (int j = 0; j < 4; ++j) ss[r] += (v[r][j].x * v[r][j].x + v[r][j].y * v[r][j].y) + (v[r][j].z * v[r][j].z + v[r][j].w * v[r][j].w); }
#pragma unroll
                for (int o = 1; o < 64; o <<= 1) {
#pragma unroll
                    for (int r = 0; r < 2; ++r) ss[r] += __shfl_xor(ss[r], o); }
                float lg[2][8];
#pragma unroll
                for (int r = 0; r < 2; ++r)
#pragma unroll
                    for (int e = 0; e < 8; ++e) lg[r][e] = 0.f;
#pragma unroll
                for (int j = 0; j < 4; ++j) { const int col = 4 * lane + 256 * j; const f32x4 gv = *(const f32x4*)(g + col), sc = *(const f32x4*)(mrow + 4 * 1024 + col), sh = *(const f32x4*)(mrow + 3 * 1024 + col);
                    const f32x4 gm = gv * (sc + 1.0f);
                    f32x4 y[2];
#pragma unroll
                    for (int r = 0; r < 2; ++r) { const float rstd = 1.0f / __builtin_sqrtf(ss[r] * (1.0f / DM) + EPS); y[r] = (v[r][j] * rstd) * gm + sh;
                        *(LAS f32x4*)(rowb + r * 4608 + (8 * j + (lane >> 3)) * 144 + (lane & 7) * 16) = y[r]; }
#pragma unroll
                    for (int cc = 0; cc < 4; ++cc) { const f32x4 w0 = *(const f32x4*)(wrt + (size_t)(col + cc) * 8), w1 = *(const f32x4*)(wrt + (size_t)(col + cc) * 8 + 4);
#pragma unroll
                        for (int r = 0; r < 2; ++r) { const float yv = y[r][cc];
                            lg[r][0] += yv * w0.x; lg[r][1] += yv * w0.y; lg[r][2] += yv * w0.z; lg[r][3] += yv * w0.w; lg[r][4] += yv * w1.x; lg[r][5] += yv * w1.y; lg[r][6] += yv * w1.z; lg[r][7] += yv * w1.w; } } }
                {
                    const int rr = lane >> 5, bb = lane & 31; const LAS f32x4* bp = (const LAS f32x4*)(rowb + rr * 4608 + bb * 144);
                    float xb[32];
#pragma unroll
                    for (int q = 0; q < 8; ++q) { const f32x4 v4 = bp[q]; xb[4 * q] = v4.x; xb[4 * q + 1] = v4.y; xb[4 * q + 2] = v4.z; xb[4 * q + 3] = v4.w; }
                    u32x4 c0, c1; mxfp6_block(xb, c0, c1);
                    unsigned char* dst = XN8 + (size_t)(m0 + rr) * DM + (bb >> 2) * 128 + (bb & 3) * 16;
                    *(GAS u32x4*)dst = c0; *(GAS u32x4*)(dst + 64) = c1;
                }
#pragma unroll
                for (int o = 1; o < 64; o <<= 1) {
#pragma unroll
                    for (int r = 0; r < 2; ++r)
#pragma unroll
                        for (int e = 0; e < 8; ++e) lg[r][e] += __shfl_xor(lg[r][e], o); }
#pragma unroll
                for (int r = 0; r < 2; ++r) {
                    int ea = 0; float va = lg[r][0];
#pragma unroll
                    for (int e = 1; e < 8; ++e) if (lg[r][e] > va) { va = lg[r][e]; ea = e; }
                    int eb = -1; float vb2 = -INFINITY;
#pragma unroll
                    for (int e = 0; e < 8; ++e) if (e != ea && lg[r][e] > vb2) { vb2 = lg[r][e]; eb = e; }
                    const float wb = 1.0f / (1.0f + __expf(va - vb2)), wa = 1.0f - wb;
                    if (lane == 0) { const int tl = tl0 + r; l_e[tl * 2] = ea; l_e[tl * 2 + 1] = eb; l_w[tl * 2] = wa; l_w[tl * 2 + 1] = wb; } }
            }
            __syncthreads();
            int ea = 0, eb = 0, pa = 0, pb = 0;
            if (tid < 128) { ea = l_e[tid * 2]; eb = l_e[tid * 2 + 1]; pa = atomicAdd((int*)&l_cnt[ea], 1); pb = atomicAdd((int*)&l_cnt[eb], 1); }
            __syncthreads();
            if (tid < 8) l_base[tid] = (int)__hip_atomic_fetch_add((unsigned*)(ctl + CW_CNT + 64 * tid), (unsigned)l_cnt[tid], __ATOMIC_RELAXED, __HIP_MEMORY_SCOPE_AGENT);
            __syncthreads();
            if (tid < 128) { const int m = blk * 128 + tid; pa += l_base[ea]; pb += l_base[eb];
                LIST[(size_t)ea * NLAT + pa] = m; LIST[(size_t)eb * NLAT + pb] = m;
                int* ti = TINFO + (size_t)m * 8; ti[0] = ea; ti[1] = pa; ti[2] = eb; ti[3] = pb; ti[4] = __float_as_int(l_w[tid * 2]); ti[5] = __float_as_int(l_w[tid * 2 + 1]); }
            __syncthreads();
        }
        if (BOTH(12)) GRID_BAR(); PROBE_MARK(12);
    }
    if (hi_ph > 13 && lo < 17) {
        PHASE_IDS();
        LAS int* mtab = (LAS int*)(lds + MOE_OFF);
        if (tid == 0) { int run = 0, R = 0;
            for (int e = 0; e < 8; ++e) { const int ce = (int)__hip_atomic_load((unsigned*)(ctl + CW_CNT + 64 * e), __ATOMIC_RELAXED, __HIP_MEMORY_SCOPE_AGENT); mtab[e] = run; mtab[16 + e] = ce; run += ce >> 8; if (ce & 255) { mtab[24 + R] = e; ++R; } }
            mtab[8] = run; mtab[32] = R; }
        __syncthreads();
        const int nfull = __builtin_amdgcn_readfirstlane(mtab[8]);
        for (int c = 0; c < MOE_NCH; ++c) {
            const int gp0 = c * MOE_CH, gp1 = nfull < (c + 1) * MOE_CH ? nfull : (c + 1) * MOE_CH;
            if (IN(13 + 2 * c)) {
                { pg8::MoeSched S; S.A = (const char*)XN8; S.B = (const char*)MGU; S.list = LIST; S.tab = mtab; S.mode = 0; S.nS = 1; S.kbytes = 0; S.omoff = 0;
                  S.gp0 = gp0; S.gp1 = gp1; S.nN = 28; S.G = G; S.c = bx; S.bexp = (size_t)7168 * 1024; S.btile = (size_t)256 * 1024; S.astep = 0; S.gather = true;
                  pg8::EpiSwiGLU8 E{HC, 1.0f};
                  pg8::gemm_phase<pg8::EpiSwiGLU8, pg8::MoeSched, true, true, false, false, true>(lds, gtab, 512, 8, S, E); }
                if (c == 0) { pg8::MoeSched S; S.A = (const char*)XN8; S.B = (const char*)MGU; S.list = LIST; S.tab = mtab; S.mode = 1; S.nS = 1; S.kbytes = 0; S.omoff = MOE_CH;
                  S.gp0 = 0; S.gp1 = 0; S.nN = 28; S.G = G; S.c = bx; S.bexp = (size_t)7168 * 1024; S.btile = (size_t)256 * 1024; S.astep = 0; S.gather = true;
                  pg8::EpiSwiGLU8 E{HC, 1.0f};
                  pg8::gemm_phase<pg8::EpiSwiGLU8, pg8::MoeSched, true, true, false, false, true>(lds, gtab, 512, 8, S, E); }
                if (BOTH(13 + 2 * c)) GRID_BAR(); PROBE_MARK(13 + 2 * c);
            }
            if (IN(14 + 2 * c)) {
                { pg8::MoeSched S; S.A = (const char*)HC; S.B = (const char*)MD; S.list = LIST; S.tab = mtab; S.mode = 0; S.nS = 1; S.kbytes = 0; S.omoff = 0;
                  S.gp0 = gp0; S.gp1 = gp1; S.nN = 4; S.G = G; S.c = bx; S.bexp = (size_t)1024 * DFF; S.btile = (size_t)256 * DFF; S.astep = (size_t)256 * DFF; S.gather = false;
                  pg8::EpiBf16Plain E{YB, DM, 1.0f / MOE_SD};
                  pg8::gemm_phase<pg8::EpiBf16Plain, pg8::MoeSched, true, false, true>(lds, gtab, DFF / 2, 28, S, E); }
                if (c == 0) { pg8::MoeSched S; S.A = (const char*)(HC + (size_t)MOE_CH * 256 * DFF); S.B = (const char*)MD; S.list = LIST; S.tab = mtab; S.mode = 2; S.nS = MOE_RS; S.kbytes = (size_t)(DFF / MOE_RS); S.omoff = 0;
                  S.gp0 = 0; S.gp1 = 0; S.nN = 4; S.G = G; S.c = bx; S.bexp = (size_t)1024 * DFF; S.btile = (size_t)256 * DFF; S.astep = (size_t)256 * DFF; S.gather = false;
                  pg8::EpiPartBf16 E{YP, (size_t)8 * 256 * DM, 1.0f / MOE_SD};
                  pg8::gemm_phase<pg8::EpiPartBf16, pg8::MoeSched, true, false, true>(lds, gtab, DFF / 2, DFF / MOE_RS / 128, S, E); }
                if (BOTH(14 + 2 * c)) GRID_BAR(); PROBE_MARK(14 + 2 * c);
            }
        }
    }
    if (IN(17)) {
        PHASE_IDS();
        LAS int* l_pb = (LAS int*)(lds + wave * 128);
        if (lane == 0) { int run = 0, R = 0;
            for (int e = 0; e < 8; ++e) { const int ce = (int)__hip_atomic_load((unsigned*)(ctl + CW_CNT + 64 * e), __ATOMIC_RELAXED, __HIP_MEMORY_SCOPE_AGENT); l_pb[e] = run; l_pb[8 + e] = ce >> 8; l_pb[16 + e] = R; run += ce >> 8; if (ce & 255) ++R; } }
        const float* g2 = MOD + 5 * 6144 + 5 * 1024;
        for (int m0 = gw * 2; m0 < NLAT; m0 += NGW * 2) {
            const int mb = m0 >> 13;
            f32x4 hv[2][4], ya[2][4], yb[2][4]; float wa[2], wb[2];
#pragma unroll
            for (int r = 0; r < 2; ++r) {
                const int m = m0 + r; const int* ti = TINFO + (size_t)m * 8;
                const int ea = ti[0], pa = ti[1], eb = ti[2], pb = ti[3]; wa[r] = __int_as_float(ti[4]); wb[r] = __int_as_float(ti[5]);
                const bool ma = (pa >> 8) < l_pb[8 + ea], mbm = (pb >> 8) < l_pb[8 + eb];
                const size_t sa = ma ? (size_t)(l_pb[ea] + (pa >> 8)) * 256 + (pa & 255) : (size_t)l_pb[16 + ea] * 256 + (pa & 255);
                const size_t sb = mbm ? (size_t)(l_pb[eb] + (pb >> 8)) * 256 + (pb & 255) : (size_t)l_pb[16 + eb] * 256 + (pb & 255);
                const GAS u32x2* xr = (const GAS u32x2*)(HL + (size_t)m * DM) + lane;
#pragma unroll
                for (int j = 0; j < 4; ++j) { const u32x2 w = xr[64 * j]; hv[r][j] = (f32x4){__uint_as_float(w.x << 16), __uint_as_float(w.x & 0xffff0000u), __uint_as_float(w.y << 16), __uint_as_float(w.y & 0xffff0000u)}; }
                { const GAS u32x2* yr = (const GAS u32x2*)((ma ? YB : YP) + sa * DM) + lane;
#pragma unroll
                  for (int j = 0; j < 4; ++j) { const u32x2 a = yr[64 * j]; ya[r][j] = (f32x4){__uint_as_float(a.x << 16), __uint_as_float(a.x & 0xffff0000u), __uint_as_float(a.y << 16), __uint_as_float(a.y & 0xffff0000u)}; }
                  if (!ma) for (int s2 = 1; s2 < MOE_RS; ++s2) { const GAS u32x2* y2 = (const GAS u32x2*)(YP + ((size_t)s2 * 8 * 256 + sa) * DM) + lane;
#pragma unroll
                      for (int j = 0; j < 4; ++j) { const u32x2 a = y2[64 * j]; ya[r][j] += (f32x4){__uint_as_float(a.x << 16), __uint_as_float(a.x & 0xffff0000u), __uint_as_float(a.y << 16), __uint_as_float(a.y & 0xffff0000u)}; } } }
                { const GAS u32x2* yr = (const GAS u32x2*)((mbm ? YB : YP) + sb * DM) + lane;
#pragma unroll
                  for (int j = 0; j < 4; ++j) { const u32x2 a = yr[64 * j]; yb[r][j] = (f32x4){__uint_as_float(a.x << 16), __uint_as_float(a.x & 0xffff0000u), __uint_as_float(a.y << 16), __uint_as_float(a.y & 0xffff0000u)}; }
                  if (!mbm) for (int s2 = 1; s2 < MOE_RS; ++s2) { const GAS u32x2* y2 = (const GAS u32x2*)(YP + ((size_t)s2 * 8 * 256 + sb) * DM) + lane;
#pragma unroll
                      for (int j = 0; j < 4; ++j) { const u32x2 a = y2[64 * j]; yb[r][j] += (f32x4){__uint_as_float(a.x << 16), __uint_as_float(a.x & 0xffff0000u), __uint_as_float(a.y << 16), __uint_as_float(a.y & 0xffff0000u)}; } } }
            }
            float ss[2];
#pragma unroll
            for (int r = 0; r < 2; ++r) { ss[r] = 0.f;
#pragma unroll
                for (int j = 0; j < 4; ++j) { const f32x4 gv = *(const f32x4*)(g2 + (size_t)mb * 6144 + 4 * lane + 256 * j);
                    hv[r][j] = hv[r][j] + gv * (ya[r][j] * wa[r] + yb[r][j] * wb[r]); ss[r] += (hv[r][j].x * hv[r][j].x + hv[r][j].y * hv[r][j].y) + (hv[r][j].z * hv[r][j].z + hv[r][j].w * hv[r][j].w); } }
#pragma unroll
            for (int o = 1; o < 64; o <<= 1) {
#pragma unroll
                for (int r = 0; r < 2; ++r) ss[r] += __shfl_xor(ss[r], o); }
#pragma unroll
            for (int r = 0; r < 2; ++r) { const float rstd = 1.0f / __builtin_sqrtf(ss[r] * (1.0f / DM) + EPS);
                GAS f32x4* orow = (GAS f32x4*)(args.out + (size_t)(m0 + r) * DM) + lane;
#pragma unroll
                for (int j = 0; j < 4; ++j) { const f32x4 fg = *(const f32x4*)(I_FINALG + 4 * lane + 256 * j); __builtin_nontemporal_store((hv[r][j] * rstd) * fg, orow + 64 * j); } }
        }
    }
    PROBE_MARK(17);
#if defined(PROBE_LO)
    { PHASE_IDS(); const float T = (float)(tpB - tpA) * 0.01f; const float cval = __builtin_sqrtf(T / (float)(PROBE_UNIT));
      for (int m = gw; m < NLAT; m += NGW) { GAS f32x4* orow = (GAS f32x4*)(args.out + (size_t)m * DM) + lane;
#pragma unroll
        for (int j = 0; j < 4; ++j) orow[64 * j] = (f32x4){cval, cval, cval, cval}; } }
#endif
#undef IN
#undef BOTH
#undef GRID_BAR
}

#ifndef MK_ONE_LAUNCH
#define MK_ONE_LAUNCH 1
#endif
extern "C" void kernel_launch(void* const* d_in, const int* in_sizes, int n_in, void* d_out, int out_size, void* d_ws, size_t ws_size, hipStream_t stream) {
    static int grid = 0;
    if (grid == 0) {
        if (n_in != 24 || out_size != NLAT * DM || ws_size < WS_END) { fprintf(stderr, "kernel_launch: unexpected problem (n_in %d, out %d, ws %zu < %zu)\n", n_in, out_size, ws_size, (size_t)WS_END); grid = -1; return; }
        int dev = 0, cus = 0, per_cu = 0;
        if (hipGetDevice(&dev) != hipSuccess || hipDeviceGetAttribute(&cus, hipDeviceAttributeMultiprocessorCount, dev) != hipSuccess) { grid = -1; return; }
        if (hipFuncSetAttribute((const void*)fwd, hipFuncAttributeMaxDynamicSharedMemorySize, LDS_BYTES) != hipSuccess) { fprintf(stderr, "kernel_launch: hipFuncSetAttribute failed\n"); grid = -1; return; }
        if (hipOccupancyMaxActiveBlocksPerMultiprocessor(&per_cu, (const void*)fwd, 512, LDS_BYTES) != hipSuccess || per_cu < 1) fprintf(stderr, "kernel_launch: occupancy query says %d\n", per_cu);
        (void)hipGetLastError();
        grid = cus;
    }
    if (grid < 0) return;
    if (hipMemsetAsync((char*)d_ws + WS_CTL, 0, CTL_ZERO_BYTES, stream) != hipSuccess) return;
    Args a{};
    for (int i = 0; i < 24; ++i) a.in[i] = (const float*)d_in[i];
    a.out = (float*)d_out; a.ws = (unsigned char*)d_ws;
#if defined(SPLITAT)
    a.ph_lo = 0; a.ph_hi = SPLITAT; a.li = 0;
    hipLaunchKernelGGL(fwd, dim3(grid), dim3(512), LDS_BYTES, stream, a);
    a.ph_lo = SPLITAT; a.ph_hi = NPH; a.li = 1;
    hipLaunchKernelGGL(fwd, dim3(grid), dim3(512), LDS_BYTES, stream, a);
#elif defined(DUPK)
    a.ph_lo = 0; a.ph_hi = DUPK + 1; a.li = 0;
    hipLaunchKernelGGL(fwd, dim3(grid), dim3(512), LDS_BYTES, stream, a);
#ifdef DUPN
    for (int rep = 0; rep < DUPN; ++rep) { a.ph_lo = DUPK; a.ph_hi = DUPK + 1; a.li = 2; hipLaunchKernelGGL(fwd, dim3(grid), dim3(512), LDS_BYTES, stream, a); }
#endif
    a.ph_lo = DUPK; a.ph_hi = NPH; a.li = 1;
    hipLaunchKernelGGL(fwd, dim3(grid), dim3(512), LDS_BYTES, stream, a);
#elif MK_ONE_LAUNCH
    a.ph_lo = 0; a.ph_hi = NPH;
    hipLaunchKernelGGL(fwd, dim3(grid), dim3(512), LDS_BYTES, stream, a);
#else
    for (int p = 0; p < NPH; ++p) { a.ph_lo = p; a.ph_hi = p + 1; hipLaunchKernelGGL(fwd, dim3(grid), dim3(512), LDS_BYTES, stream, a); }
#endif
}
```

```cpp
#include <hip/hip_runtime.h>
#include <hip/hip_bf16.h>
#include <cstdio>
#include <cstdint>
#include <cmath>

constexpr int DM = 1024, NB = 4, SEQ = 8192, LCTX = 256, NLAT = NB * SEQ, NCTXR = NB * LCTX, MALL = NLAT + NCTXR;
constexpr int DFF = 3584, NEXP = 8, NQKV = 1536;
constexpr int NPL = NLAT / 256, NPA = MALL / 256;
constexpr float EPS = 1e-6f;
constexpr int MOE_CH = 128, MOE_NCH = 2;
constexpr float MOE_SGU = 32.0f, MOE_SD = 64.0f;
constexpr int MOE_RS = 7, P3_NS = 8, P5_NS = 14;

#define LAS __attribute__((address_space(3)))
#define GAS __attribute__((address_space(1)))
typedef unsigned short bf16_t;
typedef short bf16x8 __attribute__((ext_vector_type(8)));
typedef float f32x4 __attribute__((ext_vector_type(4)));
typedef float f32x2 __attribute__((ext_vector_type(2)));
typedef float f32x16 __attribute__((ext_vector_type(16)));
typedef unsigned u32x4 __attribute__((ext_vector_type(4)));
typedef unsigned u32x2 __attribute__((ext_vector_type(2)));
typedef __bf16 bf16x2_t __attribute__((ext_vector_type(2)));
typedef GAS unsigned gu32;

__device__ __forceinline__ unsigned pkbf(float lo, float hi) { f32x2 v = {lo, hi}; bf16x2_t b = __builtin_convertvector(v, bf16x2_t); return __builtin_bit_cast(unsigned, b); }
__device__ __forceinline__ unsigned pk4f8(float a, float b, float c, float d) { unsigned w = 0; w = __builtin_amdgcn_cvt_pk_fp8_f32(a, b, w, false); w = __builtin_amdgcn_cvt_pk_fp8_f32(c, d, w, true); return w; }
typedef float f32x16v __attribute__((ext_vector_type(16)));
typedef unsigned u32x6 __attribute__((ext_vector_type(6)));
__device__ __forceinline__ void mxfp6_block(const float (&x)[32], u32x4& c0, u32x4& c1) {
    float mx = 0.f;
#pragma unroll
    for (int i = 0; i < 32; ++i) mx = __builtin_fmaxf(mx, __builtin_fabsf(x[i]));
    int eb = (int)((__float_as_uint(mx) >> 23) & 255u) - 2; eb = eb < 1 ? 1 : eb;
    const float sc = __uint_as_float((unsigned)eb << 23);
    f32x16v a, b;
#pragma unroll
    for (int i = 0; i < 16; ++i) { a[i] = x[i]; b[i] = x[16 + i]; }
    const u32x6 p = __builtin_amdgcn_cvt_scalef32_2xpk16_fp6_f32(a, b, sc);
    c0 = (u32x4){p[0], p[1], p[2], p[3]}; c1 = (u32x4){p[4], p[5], (unsigned)eb, 0u};
}
__device__ __forceinline__ float bf2f(unsigned short h) { return __builtin_bit_cast(float, (unsigned)h << 16); }
__device__ __forceinline__ float wave_sum(float v) {
#pragma unroll
    for (int o = 1; o < 64; o <<= 1) v += __shfl_xor(v, o);
    return v;
}
__device__ __forceinline__ float gelu_tanh(float x) {
    const float t = x * (1.0f + 0.044715f * x * x);
    const float e = __builtin_amdgcn_exp2f(-2.302208198f * t);
    return x * __builtin_amdgcn_rcpf(1.0f + e);
}
__device__ __forceinline__ f32x2 gelu_tanh_pk(f32x2 x) {
    f32x2 xc; xc.x = __builtin_fminf(__builtin_fmaxf(x.x, -4.0f), 4.0f); xc.y = __builtin_fminf(__builtin_fmaxf(x.y, -4.0f), 4.0f);
    const f32x2 t = xc * xc;
    f32x2 a = t * (-1.722785075e-09f) + 1.318496625e-07f;
    a = a * t + (-4.396793778e-06f); a = a * t + 8.516542868e-05f; a = a * t + (-1.085376085e-03f); a = a * t + 9.819232370e-03f; a = a * t + (-6.640538584e-02f); a = a * t + 3.988107710e-01f;
    return x * (a * xc + 0.5f);
}
__device__ __forceinline__ float silu_f(float x) { return x * __builtin_amdgcn_rcpf(1.0f + __builtin_amdgcn_exp2f(-1.4426950409f * x)); }

constexpr size_t MiB = 1u << 20;
constexpr size_t WS_CTL = 0, CTL_ZERO_BYTES = 1 * MiB;
constexpr size_t WS_MOD = 1 * MiB;
constexpr size_t WS_ROPE = 1 * MiB + 256 * 1024;
constexpr size_t WS_STATS = 2 * MiB;
constexpr size_t WS_RSC = 4 * MiB + 512 * 1024;
constexpr size_t WS_LIST = 5 * MiB;
constexpr size_t WS_TINFO = 6 * MiB;
constexpr size_t WS_WS = 7 * MiB;
constexpr size_t WS_WIN = 8 * MiB, WS_WAO = 12 * MiB, WS_WQKV = 14 * MiB, WS_WBO = 17 * MiB, WS_WGU = 19 * MiB, WS_WD = 33 * MiB;
constexpr size_t WS_MGU = 40 * MiB, WS_MD = 96 * MiB;
constexpr size_t WS_HLB = 124 * MiB;
constexpr size_t WS_XN = 208 * MiB;
constexpr size_t WS_ZB = 274 * MiB;
constexpr size_t WS_R = 278 * MiB;
constexpr size_t WS_UVT = WS_R, WS_A2 = WS_R + 132 * MiB, WS_PART1 = WS_R + 198 * MiB, WS_H = WS_R, WS_PART2 = WS_R + 231 * MiB;
constexpr size_t WS_QKV = WS_R, WS_O = WS_R + 99 * MiB;
constexpr size_t WS_Y = WS_R, WS_YP = WS_R + 128 * MiB, WS_HC = WS_R + 156 * MiB;
constexpr size_t WS_END = WS_R + 287 * MiB;
static_assert(WS_UVT + (size_t)2048 * MALL * 2 <= WS_A2 && WS_A2 + (size_t)MALL * DM * 2 <= WS_PART1 && WS_PART1 + (size_t)P3_NS * NCTXR * DM * 4 <= WS_END, "layer-0 mixer map");
static_assert(WS_H + (size_t)MALL * DFF * 2 <= WS_PART2 && WS_PART2 + (size_t)P5_NS * NCTXR * DM * 4 <= WS_END && WS_QKV + (size_t)MALL * NQKV * 2 <= WS_O && WS_O + (size_t)NLAT * DM * 2 <= WS_END, "region map");
static_assert(WS_Y + (size_t)256 * 256 * DM * 2 <= WS_YP && WS_YP + (size_t)MOE_RS * 8 * 256 * DM * 2 <= WS_HC && WS_HC + (size_t)(MOE_CH + 8) * 256 * DFF <= WS_END, "MoE map");
static_assert(WS_MD + (size_t)8 * DM * DFF <= WS_HLB && WS_HLB + (size_t)NLAT * DM * 2 <= WS_XN && WS_XN + (size_t)MALL * DM * 2 <= WS_ZB && WS_MD + (size_t)8 * DM * DFF <= WS_XN && WS_MGU + (size_t)8 * 7168 * DM <= WS_MD, "weights map");
constexpr int CW_TMO = 0, CW_CODE = 1;
constexpr int CW_CNT = 64;
constexpr int CW_WAMAX = 1024;
constexpr int CW_BAR = 4096;

constexpr int RING_BYTES = 131072;
constexpr int GTAB_OFF = RING_BYTES;
constexpr int MOE_OFF = RING_BYTES + 1024;
constexpr int MISC_OFF = RING_BYTES + 2048;
constexpr int STAB_OFF = RING_BYTES + 3072, STAB_STRIDE = 1536;
constexpr int ROPC_OFF = RING_BYTES + 6144;
constexpr int LDS_BYTES = 147456;

namespace pg8 {
constexpr int BM = 256, BK = 64, HALF = 128, HTB = HALF * BK * 2, STAGE_BYTES = 8 * HTB, NXCD = 8, WGM = 8;
__host__ __device__ __forceinline__ int lds_byte(int r, int c) { const int st = (r >> 4) * 2 + (c >> 5), rr = r & 15, cc = c & 31, ob = rr * 64 + cc * 2; return st * 1024 + (ob ^ (((ob >> 9) & 1) << 5)); }
__host__ __device__ __forceinline__ void stage_rc(int b, int& R, int& C) { const int st = b / 1024, sb = b % 1024, swz = sb ^ (((sb >> 9) & 1) << 5); R = (st >> 1) * 16 + swz / 64; C = (st & 1) * 32 + (swz % 64) / 2; }
__host__ __device__ __forceinline__ int perm32(int rho) { const int n = rho >> 4, i = rho & 15; return 8 * (i >> 2) + 4 * n + (i & 3); }

struct Unit { const char* a; const char* b; const int* gl; int pm, pn, om, nv, ks; };

__device__ __forceinline__ bool tile_order(int i, int G, int c, int nM, int nN, int& pm, int& pn) {
    const int nwg = nM * nN; const long L = (long)i * G + c; if (L >= nwg) return false;
    int wgid = (int)L; { const int q = nwg / NXCD, r = nwg % NXCD, xcd = wgid % NXCD, off = wgid / NXCD; wgid = (xcd < r ? xcd * (q + 1) : r * (q + 1) + (xcd - r) * q) + off; }
    const int nig = WGM * nN, gid = wgid / nig, fm = gid * WGM, gsz = (nM - fm) < WGM ? (nM - fm) : WGM;
    pm = fm + ((wgid % nig) % gsz); pn = (wgid % nig) / gsz; return true;
}
struct DenseSched {
    const char* A; const char* B; int nM, nN, G, c; size_t tstep;
    __device__ __forceinline__ bool next(int i, Unit& u) const {
        int pm, pn; if (!tile_order(i, G, c, nM, nN, pm, pn)) return false;
        u.a = A + (size_t)pm * tstep; u.b = B + (size_t)pn * tstep; u.gl = nullptr; u.pm = pm; u.pn = pn; u.om = pm; u.nv = 256; u.ks = 0; return true;
    }
};
typedef int v8i_t __attribute__((ext_vector_type(8)));
typedef int v4i_t __attribute__((ext_vector_type(4)));
__device__ __forceinline__ v8i_t cat8(bf16x8 lo, bf16x8 hi) { const v4i_t a = __builtin_bit_cast(v4i_t, lo), b = __builtin_bit_cast(v4i_t, hi); return __builtin_shufflevector(a, b, 0, 1, 2, 3, 4, 5, 6, 7); }
struct SplitSched {
    const char* A; const char* B; int nM, nN, nS, G, c, pm0; size_t tstep, kbytes;
    __device__ __forceinline__ bool next(int i, Unit& u) const {
        const int L = i * G + c; if (L >= nM * nN * nS) return false;
        const int ks = L % nS, t = L / nS, pn = t % nN, pm = t / nN;
        u.a = A + (size_t)pm * tstep + (size_t)ks * kbytes; u.b = B + (size_t)pn * tstep + (size_t)ks * kbytes; u.gl = nullptr; u.pm = pm0 + pm; u.pn = pn; u.om = pm; u.nv = 256; u.ks = ks; return true;
    }
};
struct MoeSched {
    const char* A; const char* B; const int* list; const LAS int* tab; int gp0, gp1, nN, nS, G, c, mode, omoff; size_t bexp, btile, astep, kbytes; bool gather;
    __device__ __forceinline__ bool next(int i, Unit& u) const {
        int pm, pn, ks = 0;
        if (mode == 0) { if (gp1 <= gp0) return false; if (!tile_order(i, G, c, gp1 - gp0, nN, pm, pn)) return false; }
        else { const int R = __builtin_amdgcn_readfirstlane(tab[32]); const int L = i * G + c; if (L >= R * nN * nS) return false; ks = L % nS; const int t = L / nS; pn = t % nN; pm = t / nN; }
        int e = 0, lp, nv;
        if (mode == 0) { const int gp = gp0 + pm;
#pragma unroll
            for (int k = 1; k < 8; ++k) e += (gp >= __builtin_amdgcn_readfirstlane(tab[k])) ? 1 : 0;
            lp = gp - __builtin_amdgcn_readfirstlane(tab[e]); nv = 256; u.pm = gp; }
        else { e = __builtin_amdgcn_readfirstlane(tab[24 + pm]); const int ce = __builtin_amdgcn_readfirstlane(tab[16 + e]); lp = ce >> 8; nv = ce & 255; u.pm = pm; }
        u.b = B + (size_t)e * bexp + (size_t)pn * btile + (size_t)ks * kbytes; u.pn = pn; u.nv = nv; u.ks = ks; u.om = pm;
        if (gather) { u.a = A; u.gl = list + (size_t)e * NLAT + 256 * lp; u.om = pm + omoff; }
        else { u.a = A + (size_t)pm * astep + (size_t)ks * kbytes; u.gl = nullptr; if (mode == 0) u.om = gp0 + pm; }
        return true;
    }
};

struct EpiGeluT {
    static constexpr bool PERM = true, ROWSCALE = true, AUXTAB = false;
    __device__ __forceinline__ const float* scale_src(const Unit& u) const { return cscale + u.pn * BM; }
    bf16_t* O; float* stats; const float* cscale; const float* wsc;
    __device__ __forceinline__ void operator()(const f32x4 (&acc)[2][2][4][2], const Unit& u, int wr, int wc, int fr, int fq, const LAS float* tab) const {
        const int row0 = u.pm * BM + wr * 64 + fr, col0 = u.pn * BM + wc * 32 + 8 * fq;
        const bool isv = u.pm >= 4; const float wq = wsc[0];
        f32x4 csv[2][2];
#pragma unroll
        for (int bj = 0; bj < 2; ++bj)
#pragma unroll
            for (int n = 0; n < 2; ++n) csv[bj][n] = *(const LAS f32x4*)(tab + wc * 32 + 8 * fq + bj * HALF + 4 * n) * wq;
        float s1[2][2][4], s2[2][2][4];
#pragma unroll
        for (int bj = 0; bj < 2; ++bj)
#pragma unroll
            for (int n = 0; n < 2; ++n)
#pragma unroll
                for (int e = 0; e < 4; ++e) { s1[bj][n][e] = 0.f; s2[bj][n][e] = 0.f; }
#pragma unroll
        for (int ai = 0; ai < 2; ++ai)
#pragma unroll
            for (int m = 0; m < 4; ++m) { bf16_t* rowp = O + (size_t)(row0 + ai * HALF + m * 16) * MALL + col0;
#pragma unroll
                for (int bj = 0; bj < 2; ++bj) { const v4i_t i0 = __builtin_bit_cast(v4i_t, acc[ai][bj][m][0]), i1 = __builtin_bit_cast(v4i_t, acc[ai][bj][m][1]);
                    f32x4 v0 = (f32x4){(float)i0[0], (float)i0[1], (float)i0[2], (float)i0[3]} * csv[bj][0], v1 = (f32x4){(float)i1[0], (float)i1[1], (float)i1[2], (float)i1[3]} * csv[bj][1];
                    { const f32x2 a0 = gelu_tanh_pk((f32x2){v0[0], v0[1]}), a1 = gelu_tanh_pk((f32x2){v0[2], v0[3]}), b0 = gelu_tanh_pk((f32x2){v1[0], v1[1]}), b1 = gelu_tanh_pk((f32x2){v1[2], v1[3]});
                      v0 = (f32x4){a0.x, a0.y, a1.x, a1.y}; v1 = (f32x4){b0.x, b0.y, b1.x, b1.y}; }
#pragma unroll
                    for (int e = 0; e < 4; ++e) { s1[bj][0][e] += v0[e]; s2[bj][0][e] += v0[e] * v0[e]; s1[bj][1][e] += v1[e]; s2[bj][1][e] += v1[e] * v1[e]; }
                    u32x4 w; w.x = pkbf(v0[0], v0[1]); w.y = pkbf(v0[2], v0[3]); w.z = pkbf(v1[0], v1[1]); w.w = pkbf(v1[2], v1[3]);
                    *(u32x4*)(rowp + bj * HALF) = w; } }
        if (isv) {
            const int slot = (u.pm - 4) * 2 + wr;
#pragma unroll
            for (int bj = 0; bj < 2; ++bj)
#pragma unroll
                for (int n = 0; n < 2; ++n)
#pragma unroll
                    for (int e = 0; e < 4; ++e) { float a = s1[bj][n][e], b = s2[bj][n][e];
#pragma unroll
                        for (int o = 1; o < 16; o <<= 1) { a += __shfl_xor(a, o); b += __shfl_xor(b, o); }
                        if (fr == 0) { const int tok = col0 + bj * HALF + 4 * n + e; *(f32x2*)(stats + (size_t)tok * 16 + slot * 2) = (f32x2){a, b}; } }
        }
    }
};
template <bool BASE_F32> struct EpiResid {
    static constexpr bool PERM = true, ROWSCALE = false, AUXTAB = false;
    const float* basef; const bf16_t* baseb; bf16_t* out; const float* gate; float s;
    __device__ __forceinline__ void operator()(const f32x4 (&acc)[2][2][4][2], const Unit& u, int wr, int wc, int fr, int fq, const LAS float* tab) const {
        const int mb = u.pm >> 5; const int col0 = u.pn * BM + wc * 32 + 8 * fq;
        f32x4 gv[2][2];
#pragma unroll
        for (int bj = 0; bj < 2; ++bj)
#pragma unroll
            for (int n = 0; n < 2; ++n) gv[bj][n] = *(const f32x4*)(gate + (size_t)mb * 6144 + col0 + bj * HALF + n * 4) * s;
#pragma unroll
        for (int ai = 0; ai < 2; ++ai)
#pragma unroll
            for (int m = 0; m < 4; ++m) { const size_t off = (size_t)(u.pm * BM + wr * 64 + fr + ai * HALF + m * 16) * DM + col0;
#pragma unroll
                for (int bj = 0; bj < 2; ++bj) { f32x4 b0, b1;
                    if constexpr (BASE_F32) { b0 = *(const f32x4*)(basef + off + bj * HALF); b1 = *(const f32x4*)(basef + off + bj * HALF + 4); }
                    else { const u32x4 w = *(const u32x4*)(baseb + off + bj * HALF);
                        b0 = (f32x4){__uint_as_float(w.x << 16), __uint_as_float(w.x & 0xffff0000u), __uint_as_float(w.y << 16), __uint_as_float(w.y & 0xffff0000u)};
                        b1 = (f32x4){__uint_as_float(w.z << 16), __uint_as_float(w.z & 0xffff0000u), __uint_as_float(w.w << 16), __uint_as_float(w.w & 0xffff0000u)}; }
                    const f32x4 o0 = b0 + gv[bj][0] * acc[ai][bj][m][0], o1 = b1 + gv[bj][1] * acc[ai][bj][m][1];
                    u32x4 w; w.x = pkbf(o0[0], o0[1]); w.y = pkbf(o0[2], o0[3]); w.z = pkbf(o1[0], o1[1]); w.w = pkbf(o1[2], o1[3]);
                    *(u32x4*)(out + off + bj * HALF) = w; } }
    }
};
struct EpiSwiGLU {
    static constexpr bool PERM = true, ROWSCALE = false, AUXTAB = false;
    bf16_t* O;
    __device__ __forceinline__ void operator()(const f32x4 (&acc)[2][2][4][2], const Unit& u, int wr, int wc, int fr, int fq, const LAS float* tab) const {
        bf16_t* base = O + (size_t)(u.om * BM + wr * 64 + fr) * DFF + u.pn * 128 + wc * 32 + 8 * fq;
#pragma unroll
        for (int ai = 0; ai < 2; ++ai)
#pragma unroll
            for (int m = 0; m < 4; ++m) { const f32x4 g0 = acc[ai][0][m][0], g1 = acc[ai][0][m][1], u0 = acc[ai][1][m][0], u1 = acc[ai][1][m][1];
                float o[8];
#pragma unroll
                for (int e = 0; e < 4; ++e) { o[e] = silu_f(g0[e]) * u0[e]; o[4 + e] = silu_f(g1[e]) * u1[e]; }
                u32x4 w; w.x = pkbf(o[0], o[1]); w.y = pkbf(o[2], o[3]); w.z = pkbf(o[4], o[5]); w.w = pkbf(o[6], o[7]);
                *(u32x4*)(base + (size_t)(ai * HALF + m * 16) * DFF) = w; }
    }
};
struct EpiQKV {
    static constexpr bool PERM = false, ROWSCALE = true, AUXTAB = true;
    __device__ __forceinline__ const float* scale_src(const Unit& u) const { return rscale + u.pm * BM; }
    __device__ __forceinline__ const float* aux_src(const Unit& u, int w) const { return cosT + w * 2048 + (u.pm & 31) * 64; }
    bf16_t* O; const float* cosT; float qscale; const float* rscale; const float* wsc; const LAS float* colt;
    __device__ __forceinline__ void operator()(const f32x4 (&acc)[2][2][4][2], const Unit& u, int wr, int wc, int fr, int fq, const LAS float* tab) const {
        const bool lat = u.pm < NPL; const bool dorope = lat && u.pn < 5; const float sc = (u.pn < 4 ? qscale : 1.0f) * wsc[0];
        const bool isv = u.pn == 5;
#pragma unroll
        for (int ai = 0; ai < 2; ++ai)
#pragma unroll
            for (int m = 0; m < 4; ++m) { const int r = ai * HALF + wr * 64 + m * 16 + fr; const int grow = u.pm * BM + r;
                f32x4 cs = (f32x4){1.f, 1.f, 1.f, 1.f}, sn = (f32x4){0.f, 0.f, 0.f, 0.f};
                if (dorope) { if (wc & 1) { cs = *(const LAS f32x4*)(colt + (r & 63) * 16 + 4 * fq); sn = *(const LAS f32x4*)(colt + 1024 + (r & 63) * 16 + 4 * fq); }
                              else { cs = *(const LAS f32x4*)(tab + 256 + (r >> 6) * 16 + 4 * fq); sn = *(const LAS f32x4*)(tab + 320 + (r >> 6) * 16 + 4 * fq); } }
                bf16_t* rowp = O + (size_t)grow * NQKV + u.pn * BM + wc * 32;
                const float rsx = tab[r] * sc;
#pragma unroll
                for (int bj = 0; bj < 2; ++bj) { const v4i_t i1 = __builtin_bit_cast(v4i_t, acc[ai][bj][m][0]), i2 = __builtin_bit_cast(v4i_t, acc[ai][bj][m][1]);
                    const f32x4 x1 = (f32x4){(float)i1[0], (float)i1[1], (float)i1[2], (float)i1[3]}, x2 = (f32x4){(float)i2[0], (float)i2[1], (float)i2[2], (float)i2[3]};
                    const f32x4 o1 = (x1 * cs - x2 * sn) * rsx, o2 = (x1 * sn + x2 * cs) * rsx;
                    u32x4 w; w.x = pkbf(o1[0], o1[1]); w.y = pkbf(o1[2], o1[3]); w.z = pkbf(o2[0], o2[1]); w.w = pkbf(o2[2], o2[3]);
                    if (isv) { *(u32x2*)(rowp + bj * HALF + 4 * fq) = (u32x2){w.x, w.y}; *(u32x2*)(rowp + bj * HALF + 4 * fq + 16) = (u32x2){w.z, w.w}; }
                    else *(u32x4*)(rowp + bj * HALF + 8 * fq) = w; } }
    }
};
struct EpiSwiGLUI8 {
    static constexpr bool PERM = true, ROWSCALE = true, AUXTAB = false;
    __device__ __forceinline__ const float* scale_src(const Unit& u) const { return rscale + u.pm * BM; }
    bf16_t* O; const float* rscale; const float* ws;
    __device__ __forceinline__ void operator()(const f32x4 (&acc)[2][2][4][2], const Unit& u, int wr, int wc, int fr, int fq, const LAS float* tab) const {
        bf16_t* base = O + (size_t)(u.om * BM + wr * 64 + fr) * DFF + u.pn * 128 + wc * 32 + 8 * fq;
        const float wsg = ws[0], wsu = ws[1];
#pragma unroll
        for (int ai = 0; ai < 2; ++ai)
#pragma unroll
            for (int m = 0; m < 4; ++m) { const float rs = tab[wr * 64 + fr + ai * HALF + m * 16]; const float sg = rs * wsg, su = rs * wsu;
                const v4i_t g0 = __builtin_bit_cast(v4i_t, acc[ai][0][m][0]), g1 = __builtin_bit_cast(v4i_t, acc[ai][0][m][1]), u0 = __builtin_bit_cast(v4i_t, acc[ai][1][m][0]), u1 = __builtin_bit_cast(v4i_t, acc[ai][1][m][1]);
                float o[8];
#pragma unroll
                for (int e = 0; e < 4; ++e) { o[e] = silu_f((float)g0[e] * sg) * ((float)u0[e] * su); o[4 + e] = silu_f((float)g1[e] * sg) * ((float)u1[e] * su); }
                u32x4 w; w.x = pkbf(o[0], o[1]); w.y = pkbf(o[2], o[3]); w.z = pkbf(o[4], o[5]); w.w = pkbf(o[6], o[7]);
                *(u32x4*)(base + (size_t)(ai * HALF + m * 16) * DFF) = w; }
    }
};
struct EpiSwiGLU8 {
    static constexpr bool PERM = true, ROWSCALE = false, AUXTAB = false;
    unsigned char* O; float s;
    __device__ __forceinline__ void operator()(const f32x4 (&acc)[2][2][4][2], const Unit& u, int wr, int wc, int fr, int fq, const LAS float* tab) const {
        unsigned char* base = O + (size_t)(u.om * BM + wr * 64 + fr) * DFF + u.pn * 128 + wc * 32 + 8 * fq;
#pragma unroll
        for (int ai = 0; ai < 2; ++ai)
#pragma unroll
            for (int m = 0; m < 4; ++m) { const f32x4 g0 = acc[ai][0][m][0] * s, g1 = acc[ai][0][m][1] * s, u0 = acc[ai][1][m][0] * s, u1 = acc[ai][1][m][1] * s;
                float o[8];
#pragma unroll
                for (int e = 0; e < 4; ++e) { o[e] = silu_f(g0[e]) * u0[e]; o[4 + e] = silu_f(g1[e]) * u1[e]; }
                u32x2 w; w.x = pk4f8(o[0], o[1], o[2], o[3]); w.y = pk4f8(o[4], o[5], o[6], o[7]);
                *(u32x2*)(base + (size_t)(ai * HALF + m * 16) * DFF) = w; }
    }
};
struct EpiBf16Plain {
    static constexpr bool PERM = true, ROWSCALE = false, AUXTAB = false;
    bf16_t* O; int ldc; float s;
    __device__ __forceinline__ void operator()(const f32x4 (&acc)[2][2][4][2], const Unit& u, int wr, int wc, int fr, int fq, const LAS float* tab) const {
        bf16_t* base = O + (size_t)(u.om * BM + wr * 64 + fr) * ldc + u.pn * BM + wc * 32 + 8 * fq;
#pragma unroll
        for (int ai = 0; ai < 2; ++ai)
#pragma unroll
            for (int m = 0; m < 4; ++m)
#pragma unroll
                for (int bj = 0; bj < 2; ++bj) { const f32x4 v0 = acc[ai][bj][m][0] * s, v1 = acc[ai][bj][m][1] * s;
                    u32x4 w; w.x = pkbf(v0[0], v0[1]); w.y = pkbf(v0[2], v0[3]); w.z = pkbf(v1[0], v1[1]); w.w = pkbf(v1[2], v1[3]);
                    *(u32x4*)(base + (size_t)(ai * HALF + m * 16) * ldc + bj * HALF) = w; }
    }
};

struct EpiPartF32 {
    static constexpr bool PERM = true, ROWSCALE = false, AUXTAB = false;
    float* P; size_t sstride;
    __device__ __forceinline__ void operator()(const f32x4 (&acc)[2][2][4][2], const Unit& u, int wr, int wc, int fr, int fq, const LAS float* tab) const {
        float* base = P + (size_t)u.ks * sstride + (size_t)(u.om * BM + wr * 64 + fr) * DM + u.pn * BM + wc * 32 + 8 * fq;
#pragma unroll
        for (int ai = 0; ai < 2; ++ai)
#pragma unroll
            for (int m = 0; m < 4; ++m)
#pragma unroll
                for (int bj = 0; bj < 2; ++bj)
#pragma unroll
                    for (int n = 0; n < 2; ++n) *(f32x4*)(base + (size_t)(ai * HALF + m * 16) * DM + bj * HALF + n * 4) = acc[ai][bj][m][n];
    }
};
struct EpiPartBf16 {
    static constexpr bool PERM = true, ROWSCALE = false, AUXTAB = false;
    bf16_t* P; size_t sstride; float s;
    __device__ __forceinline__ void operator()(const f32x4 (&acc)[2][2][4][2], const Unit& u, int wr, int wc, int fr, int fq, const LAS float* tab) const {
        bf16_t* base = P + (size_t)u.ks * sstride + (size_t)(u.om * BM + wr * 64 + fr) * DM + u.pn * BM + wc * 32 + 8 * fq;
#pragma unroll
        for (int ai = 0; ai < 2; ++ai)
#pragma unroll
            for (int m = 0; m < 4; ++m)
#pragma unroll
                for (int bj = 0; bj < 2; ++bj) { const f32x4 v0 = acc[ai][bj][m][0] * s, v1 = acc[ai][bj][m][1] * s;
                    u32x4 w; w.x = pkbf(v0[0], v0[1]); w.y = pkbf(v0[2], v0[3]); w.z = pkbf(v1[0], v1[1]); w.w = pkbf(v1[2], v1[3]);
                    *(u32x4*)(base + (size_t)(ai * HALF + m * 16) * DM + bj * HALF) = w; }
    }
};

template <class Epi, class Sched, bool ALIGN_EPI, bool GATHER, bool FP8 = false, bool I8 = false, bool FP6 = false>
__device__ __forceinline__ void gemm_phase(LAS unsigned char* lds, LAS int* gtab, const int K  , const int nt_in  , const Sched& S, const Epi& E) {
    int nt = nt_in; asm volatile("" : "+s"(nt));
    int tid_ = threadIdx.x; asm volatile("" : "+v"(tid_));
    const int tid = tid_, wid = __builtin_amdgcn_readfirstlane(tid >> 6), lane = tid & 63, wr = wid >> 2, wc = wid & 3, fr = lane & 15, fq = lane >> 4;
    const size_t kstep = (size_t)(BK * 2);
    const size_t hstep = (size_t)HALF * K * 2;
    unsigned voffB[2];
#pragma unroll
    for (int i = 0; i < 2; ++i) { int R, C; stage_rc(tid * 16 + i * 8192, R, C); const int Rb = Epi::PERM ? ((R & ~31) + perm32(R & 31)) : R;
        voffB[i] = (unsigned)(Rb * K + C) * 2u; }
    unsigned vA[2][2], vN[2][2];
    const unsigned ldsw = (unsigned)wid * 1024u;
    const int aoff = lds_byte(wr * 64 + fr, fq * 8), boff = lds_byte(wc * 32 + fr, fq * 8);
    const LAS unsigned char* aB = lds + aoff; const LAS unsigned char* bB = lds + 65536 + boff;
    asm volatile("" : "+v"(aB), "+v"(bB));
#define PG8_SA(b, h) (((b) * 2 + (h)) * HTB)
#define PG8_SB(b, h) ((4 + (b) * 2 + (h)) * HTB)
#define PG8_STAGE(bufoff, gbase, voff) do { _Pragma("unroll") for (int _i = 0; _i < 2; ++_i) \
        __builtin_amdgcn_global_load_lds((const unsigned*)((const char*)(gbase) + (voff)[_i]), (LAS unsigned*)(lds + (bufoff) + ldsw + _i * 8192), 16, 0, 0); } while (0)
#define PG8_LDA(dst, b, h) do { _Pragma("unroll") for (int m = 0; m < 4; ++m) { if constexpr (FP8 || FP6) dst##8[m] = cat8(*(const LAS bf16x8*)(aB + PG8_SA(b, h) + m * 2048), *(const LAS bf16x8*)(aB + PG8_SA(b, h) + m * 2048 + 1024)); \
        else { _Pragma("unroll") for (int k = 0; k < 2; ++k) dst[m][k] = *(const LAS bf16x8*)(aB + PG8_SA(b, h) + m * 2048 + k * 1024); } } } while (0)
#define PG8_LDB(dst, b, h) do { _Pragma("unroll") for (int n = 0; n < 2; ++n) { if constexpr (FP8 || FP6) dst##8[n] = cat8(*(const LAS bf16x8*)(bB + (PG8_SB(b, h) - 65536) + n * 2048), *(const LAS bf16x8*)(bB + (PG8_SB(b, h) - 65536) + n * 2048 + 1024)); \
        else { _Pragma("unroll") for (int k = 0; k < 2; ++k) dst[n][k] = *(const LAS bf16x8*)(bB + (PG8_SB(b, h) - 65536) + n * 2048 + k * 1024); } } } while (0)
#define PG8_MMA(ai, bj, At, Bt) do { __builtin_amdgcn_s_setprio(1); \
    if constexpr (FP6) { _Pragma("unroll") for (int m = 0; m < 4; ++m) _Pragma("unroll") for (int n = 0; n < 2; ++n) \
        asm volatile("s_nop 1\n\tv_mfma_scale_f32_16x16x128_f8f6f4 %0, %1, %2, %0, %3, %4 op_sel_hi:[0,0,0] cbsz:2 blgp:2" : "+v"(acc[ai][bj][m][n]) \
                     : "v"(__builtin_shufflevector(Bt##8[n], Bt##8[n], 0, 1, 2, 3, 4, 5)), "v"(__builtin_shufflevector(At##8[m], At##8[m], 0, 1, 2, 3, 4, 5)), "v"(Bt##8[n][6]), "v"(At##8[m][6])); } \
    else if constexpr (FP8) { _Pragma("unroll") for (int m = 0; m < 4; ++m) _Pragma("unroll") for (int n = 0; n < 2; ++n) \
        asm volatile("v_mfma_f32_16x16x128_f8f6f4 %0, %1, %2, %0" : "+v"(acc[ai][bj][m][n]) : "v"(Bt##8[n]), "v"(At##8[m])); } \
    else if constexpr (I8) { _Pragma("unroll") for (int m = 0; m < 4; ++m) _Pragma("unroll") for (int n = 0; n < 2; ++n) _Pragma("unroll") for (int k = 0; k < 2; ++k) \
        asm volatile("v_mfma_i32_16x16x64_i8 %0, %1, %2, %0" : "+v"(acc[ai][bj][m][n]) : "v"(Bt[n][k]), "v"(At[m][k])); } \
    else { _Pragma("unroll") for (int m = 0; m < 4; ++m) _Pragma("unroll") for (int n = 0; n < 2; ++n) _Pragma("unroll") for (int k = 0; k < 2; ++k) \
        acc[ai][bj][m][n] = __builtin_amdgcn_mfma_f32_16x16x32_bf16(Bt[n][k], At[m][k], acc[ai][bj][m][n], 0, 0, 0); } \
    __builtin_amdgcn_s_setprio(0); } while (0)
#define PG8_WAIT_V(n) asm volatile("s_waitcnt vmcnt(" #n ")" ::: "memory")
#define PG8_WAIT_L(n) asm volatile("s_waitcnt lgkmcnt(" #n ")" ::: "memory")
#define PG8_BAR __builtin_amdgcn_s_barrier()
#define PG8_SCHED __builtin_amdgcn_sched_barrier(0)
    Unit cur, nxt; int ui = 0;
    if (!S.next(0, cur)) return;
    f32x4 acc[2][2][4][2];
#pragma unroll
    for (int a = 0; a < 2; ++a)
#pragma unroll
        for (int b = 0; b < 2; ++b)
#pragma unroll
            for (int m = 0; m < 4; ++m)
#pragma unroll
                for (int n = 0; n < 2; ++n) acc[a][b][m][n] = (f32x4){0.f, 0.f, 0.f, 0.f};
    bf16x8 At[4][2], B0[2][2], B1[2][2]; v8i_t At8[4], B08[2], B18[2];
    if constexpr (GATHER) {
#pragma unroll
        for (int h = 0; h < 2; ++h)
#pragma unroll
            for (int i = 0; i < 2; ++i) { int R, C; stage_rc(tid * 16 + i * 8192, R, C); const int row = h * HALF + R; const int tok = cur.gl[row < cur.nv ? row : 0]; vA[h][i] = (unsigned)tok * (unsigned)(K * 2) + (unsigned)C * 2u; }
    } else {
#pragma unroll
        for (int h = 0; h < 2; ++h)
#pragma unroll
            for (int i = 0; i < 2; ++i) { int R, C; stage_rc(tid * 16 + i * 8192, R, C); vA[h][i] = (unsigned)(R * K + C) * 2u + (unsigned)(h * hstep); }
    }
#pragma unroll
    for (int h = 0; h < 2; ++h)
#pragma unroll
        for (int i = 0; i < 2; ++i) vN[h][i] = vA[h][i];
    const char* cA = cur.a; const char* cB = cur.b;
    PG8_STAGE(PG8_SB(0, 0), cB, voffB); PG8_STAGE(PG8_SB(0, 1), cB + hstep, voffB); PG8_STAGE(PG8_SA(0, 0), cA, vA[0]); PG8_STAGE(PG8_SA(0, 1), cA, vA[1]);
    if (wr == 1) PG8_BAR;
    PG8_WAIT_V(2); PG8_BAR;
    PG8_STAGE(PG8_SB(1, 0), cB + kstep, voffB); PG8_STAGE(PG8_SA(1, 0), cA + kstep, vA[0]); PG8_STAGE(PG8_SB(1, 1), cB + hstep + kstep, voffB);
    PG8_WAIT_V(6); PG8_BAR;
    for (;;) {
        const bool has_next = S.next(ui + 1, nxt);
        if constexpr (Epi::ROWSCALE) {
            if (wid < 4) __builtin_amdgcn_global_load_lds((const unsigned*)(E.scale_src(cur) + wid * 64 + lane), (LAS unsigned*)(lds + STAB_OFF + (ui & 1) * STAB_STRIDE + wid * 256), 4, 0, 0);
            if constexpr (Epi::AUXTAB) { if (wid < 2) __builtin_amdgcn_global_load_lds((const unsigned*)(E.aux_src(cur, wid) + lane), (LAS unsigned*)(lds + STAB_OFF + (ui & 1) * STAB_STRIDE + 1024 + wid * 256), 4, 0, 0); }
        }
        const char* nA = has_next ? nxt.a : cA; const char* nB = has_next ? nxt.b : cB;
        if constexpr (GATHER) {
            if (has_next && wid < 4) __builtin_amdgcn_global_load_lds((const unsigned*)(nxt.gl + wid * 64 + lane), (LAS unsigned*)(gtab + wid * 64), 4, 0, 0);
        }
        for (int t = 0; t < nt; t += 2) {
            const bool last = (t == nt - 2);
            const char* a1 = cA + (size_t)(t + 1) * kstep;
            const char* a2 = last ? nA : cA + (size_t)(t + 2) * kstep; const char* b2 = last ? nB : cB + (size_t)(t + 2) * kstep;
            const char* a3 = a2 + kstep; const char* b3 = b2 + kstep;
            if constexpr (GATHER) {
                if (last && has_next) {
                    int t2 = tid; asm volatile("" : "+v"(t2));
#pragma unroll
                    for (int h = 0; h < 2; ++h)
#pragma unroll
                        for (int i = 0; i < 2; ++i) { int R, C; stage_rc(t2 * 16 + i * 8192, R, C); const int row = h * HALF + R; const int tok = gtab[row < nxt.nv ? row : 0]; vN[h][i] = (unsigned)tok * (unsigned)(K * 2) + (unsigned)C * 2u; }
                }
            }
            unsigned vS0[2], vS1[2];
#pragma unroll
            for (int i = 0; i < 2; ++i) { vS0[i] = (GATHER && last) ? vN[0][i] : vA[0][i]; vS1[i] = (GATHER && last) ? vN[1][i] : vA[1][i]; }
            PG8_LDB(B0, 0, 0); PG8_LDB(B1, 0, 1); PG8_SCHED; PG8_LDA(At, 0, 0); PG8_STAGE(PG8_SA(1, 1), a1, vA[1]);
            PG8_WAIT_V(8); PG8_WAIT_L(0); PG8_BAR; PG8_MMA(0, 0, At, B0); PG8_MMA(0, 1, At, B1); PG8_BAR; PG8_SCHED;
            PG8_LDA(At, 0, 1); PG8_STAGE(PG8_SB(0, 0), b2, voffB); PG8_STAGE(PG8_SB(0, 1), b2 + hstep, voffB); PG8_STAGE(PG8_SA(0, 0), a2, vS0);
            PG8_WAIT_V(8); PG8_WAIT_L(0); PG8_BAR; PG8_MMA(1, 0, At, B0); PG8_MMA(1, 1, At, B1); PG8_BAR; PG8_SCHED;
            PG8_LDB(B0, 1, 0); PG8_LDB(B1, 1, 1); PG8_SCHED; PG8_LDA(At, 1, 0); PG8_STAGE(PG8_SA(0, 1), a2, vS1);
            PG8_WAIT_V(8); PG8_WAIT_L(0); PG8_BAR; PG8_MMA(0, 0, At, B0); PG8_MMA(0, 1, At, B1); PG8_BAR; PG8_SCHED;
            PG8_LDA(At, 1, 1); PG8_STAGE(PG8_SB(1, 0), b3, voffB); PG8_STAGE(PG8_SB(1, 1), b3 + hstep, voffB); PG8_STAGE(PG8_SA(1, 0), a3, vS0);
            PG8_WAIT_V(8); PG8_WAIT_L(0); PG8_BAR; PG8_MMA(1, 0, At, B0); PG8_MMA(1, 1, At, B1); PG8_BAR; PG8_SCHED;
        }
        if constexpr (ALIGN_EPI) { if (wr == 0) PG8_BAR; }
        if constexpr (FP8 || I8 || FP6) asm volatile("s_nop 15\n\ts_nop 15" ::: "memory");
        E(acc, cur, wr, wc, fr, fq, (const LAS float*)(lds + STAB_OFF + (ui & 1) * STAB_STRIDE));
        if (!has_next) break;
#pragma unroll
        for (int a = 0; a < 2; ++a)
#pragma unroll
            for (int b = 0; b < 2; ++b)
#pragma unroll
                for (int m = 0; m < 4; ++m)
#pragma unroll
                    for (int n = 0; n < 2; ++n) acc[a][b][m][n] = (f32x4){0.f, 0.f, 0.f, 0.f};
        cur = nxt; cA = nA; cB = nB; ++ui;
        if constexpr (GATHER) {
#pragma unroll
            for (int h = 0; h < 2; ++h)
#pragma unroll
                for (int i = 0; i < 2; ++i) vA[h][i] = vN[h][i];
        }
        if constexpr (ALIGN_EPI) { if (wr == 1) PG8_BAR; }
    }
    PG8_WAIT_V(0);
    if constexpr (!ALIGN_EPI) { if (wr == 0) PG8_BAR; }
    PG8_BAR;
#undef PG8_SA
#undef PG8_SB
#undef PG8_STAGE
#undef PG8_LDA
#undef PG8_LDB
#undef PG8_MMA
#undef PG8_WAIT_V
#undef PG8_WAIT_L
#undef PG8_BAR
#undef PG8_SCHED
}
}

namespace attn_body {
using bf16 = __hip_bfloat16;
using s16x4 = __attribute__((ext_vector_type(4))) short;
constexpr int D = 64, PITCH = NQKV, OPITCH = DM;
constexpr int NW = 8, QBLK = 32, KVBLK = 64;
__device__ __forceinline__ int crow(int r, int hi) { return (r & 3) + 8 * (r >> 2) + 4 * hi; }
#define SBAR() __builtin_amdgcn_sched_barrier(0)
__device__ __forceinline__ void bmask(f32x16& p0, f32x16& p1, int kb, int qrel, int hi) {
    const float NEG = -INFINITY; const int d0 = kb + 4 * hi - qrel;
#pragma unroll
    for (int r = 0; r < 16; ++r) { const int d = d0 + (r & 3) + 8 * (r >> 2); if (d < -128 || d > 128) p0[r] = NEG; if (d + 32 < -128 || d + 32 > 128) p1[r] = NEG; }
}
constexpr int NSLOT = 3, SLOTB = 8192;
constexpr int LDS_K = 0, LDS_V = NSLOT * SLOTB, LDS_WS = 2 * NSLOT * SLOTB, LDS_OST = LDS_WS + NW * 64 * 4, LDS_BYTES_A = LDS_OST + NW * 4096;
constexpr float C2 = 0.125f * 1.4426950408889634f;
__device__ __forceinline__ void glds16(const void* gsrc, unsigned lds_dst) { unsigned keep;
    asm volatile("s_mov_b32 %0, m0\n\ts_mov_b32 m0, %2\n\ts_nop 0\n\tglobal_load_lds_dwordx4 %1, off\n\ts_mov_b32 m0, %0" : "=&s"(keep) : "v"(gsrc), "s"(lds_dst) : "memory"); }
__device__ __forceinline__ float max3f(float a, float b, float c) { float r; asm("v_max3_f32 %0, %1, %2, %3" : "=v"(r) : "v"(a), "v"(b), "v"(c)); return r; }
__device__ __forceinline__ float max2f(float a, float b) { float r; asm("v_max_f32_e32 %0, %1, %2" : "=v"(r) : "v"(a), "v"(b)); return r; }
__device__ __forceinline__ float fadd_s(float a, float b) { float r; asm("v_add_f32_e32 %0, %1, %2" : "=v"(r) : "v"(a), "v"(b)); return r; }
__device__ __forceinline__ float fsub_s(float a, float b) { float r; asm("v_sub_f32_e32 %0, %1, %2" : "=v"(r) : "v"(a), "v"(b)); return r; }
__device__ __forceinline__ unsigned cvtpk_s(float lo, float hi) { f32x2 v = {lo, hi}; bf16x2_t b = __builtin_convertvector(v, bf16x2_t); return __builtin_bit_cast(unsigned, b); }
#define WAIT_BAR(N) asm volatile("s_waitcnt vmcnt(" #N ") lgkmcnt(0)\n\ts_barrier" ::: "memory")
__device__ __forceinline__ void qkt(f32x16& p0, f32x16& p1, const char* Kslot, const bf16x8* qr, const f32x16& negm, int r32, int hi) {
    const char* kb = Kslot + hi * 1024 + r32 * 16;
#pragma unroll
    for (int d0 = 0; d0 < 4; ++d0) {
        const bf16x8 b0 = *reinterpret_cast<const bf16x8*>(kb + d0 * 2048);
        const bf16x8 b1 = *reinterpret_cast<const bf16x8*>(kb + d0 * 2048 + 512);
        if (d0 == 0) { p0 = __builtin_amdgcn_mfma_f32_32x32x16_bf16(b0, qr[0], negm, 0, 0, 0); p1 = __builtin_amdgcn_mfma_f32_32x32x16_bf16(b1, qr[0], negm, 0, 0, 0); }
        else { p0 = __builtin_amdgcn_mfma_f32_32x32x16_bf16(b0, qr[d0], p0, 0, 0, 0); p1 = __builtin_amdgcn_mfma_f32_32x32x16_bf16(b1, qr[d0], p1, 0, 0, 0); } }
}
typedef __attribute__((address_space(3))) const char* lds_cptr;
typedef short v4i16_t __attribute__((ext_vector_type(4)));
__device__ __forceinline__ void kload8(bf16x8* kf, lds_cptr kp) {
    kf[0] = *(const __attribute__((address_space(3))) bf16x8*)(kp);        kf[1] = *(const __attribute__((address_space(3))) bf16x8*)(kp + 512);
    kf[2] = *(const __attribute__((address_space(3))) bf16x8*)(kp + 2048); kf[3] = *(const __attribute__((address_space(3))) bf16x8*)(kp + 2560);
    kf[4] = *(const __attribute__((address_space(3))) bf16x8*)(kp + 4096); kf[5] = *(const __attribute__((address_space(3))) bf16x8*)(kp + 4608);
    kf[6] = *(const __attribute__((address_space(3))) bf16x8*)(kp + 6144); kf[7] = *(const __attribute__((address_space(3))) bf16x8*)(kp + 6656);
}
__device__ __forceinline__ void kload2(bf16x8* kf, lds_cptr kp, int j) { kf[2 * j] = *(const __attribute__((address_space(3))) bf16x8*)(kp + j * 2048); kf[2 * j + 1] = *(const __attribute__((address_space(3))) bf16x8*)(kp + j * 2048 + 512); }
__device__ __forceinline__ s16x4 vtr(lds_cptr p) { return __builtin_bit_cast(s16x4, __builtin_amdgcn_ds_read_tr16_b64_v4i16((__attribute__((address_space(3))) v4i16_t*)p)); }
__device__ __forceinline__ float rowmax(const f32x16& p0, const f32x16& p1) {
    float a = max3f(p0[0], p0[1], p1[0]), b = max3f(p0[2], p0[3], p1[1]); a = max3f(a, p1[2], p1[3]);
#pragma unroll
    for (int r = 4; r < 16; r += 4) { a = max3f(a, p0[r], p0[r + 1]); b = max3f(b, p0[r + 2], p0[r + 3]); a = max3f(a, p1[r], p1[r + 1]); b = max3f(b, p1[r + 2], p1[r + 3]); }
    const float m = max2f(a, b);
    auto rr = __builtin_amdgcn_permlane32_swap(__float_as_uint(m), __float_as_uint(m), false, false);
    return max2f(__uint_as_float(rr[0]), __uint_as_float(rr[1]));
}
__device__ __forceinline__ void pv(f32x16* o, int vb, bf16x8 pa0, bf16x8 pa1, bf16x8 pa2, bf16x8 pa3) {
#pragma unroll
    for (int d0 = 0; d0 < 2; ++d0) { s16x4 lo[4], hi[4];
#pragma unroll
        for (int ks = 0; ks < 4; ++ks) {
            asm volatile("ds_read_b64_tr_b16 %0,%1 offset:%c2" : "=&v"(lo[ks]) : "v"(vb), "i"(d0 * 4096 + ks * 1024) : "memory");
            asm volatile("ds_read_b64_tr_b16 %0,%1 offset:%c2" : "=&v"(hi[ks]) : "v"(vb), "i"(d0 * 4096 + ks * 1024 + 512) : "memory"); }
        asm volatile("s_waitcnt lgkmcnt(0)" ::: "memory"); SBAR();
#define PK(k) (bf16x8){lo[k][0], lo[k][1], lo[k][2], lo[k][3], hi[k][0], hi[k][1], hi[k][2], hi[k][3]}
        o[d0] = __builtin_amdgcn_mfma_f32_32x32x16_bf16(pa0, PK(0), o[d0], 0, 0, 0);
        o[d0] = __builtin_amdgcn_mfma_f32_32x32x16_bf16(pa1, PK(1), o[d0], 0, 0, 0);
        o[d0] = __builtin_amdgcn_mfma_f32_32x32x16_bf16(pa2, PK(2), o[d0], 0, 0, 0);
        o[d0] = __builtin_amdgcn_mfma_f32_32x32x16_bf16(pa3, PK(3), o[d0], 0, 0, 0);
#undef PK
    }
}
#define ATTN_STORE16(p, v) (*(u32x4*)(p) = (v))
template <int THRL> __device__ __forceinline__ int attn_unit(int b, int hk, int n, int pr, const bf16* QKV, unsigned char* O, const float* sinkp, char* shm, int sb, bool pre, bool has_next, int nb2, int nhk2, int nn2, int npr2, bf16x8 (&qr)[4]) {
    int tid_ = threadIdx.x; asm volatile("" : "+v"(tid_));
    const int tid = tid_, lane = tid & 63, r32 = lane & 31, hi = lane >> 5; const int wid = __builtin_amdgcn_readfirstlane(tid >> 6);
    const int head = 4 * hk + 2 * pr + (wid >> 2);
    const long rowblk = (long)b * SEQ + n * 128;
    const long ctxrow = (long)NLAT + b * LCTX;
    const int nlo = n > 0 ? 2 : 0, nhi = n < (SEQ / 128 - 1) ? 2 : 0;
    const int NT = 6 + nlo + nhi;
    const bf16* Qw = QKV + (rowblk + (wid & 3) * QBLK) * PITCH + head * D;
    const bf16* Kc = QKV + 1024 + hk * D; const bf16* Vc = QKV + 1280 + hk * D;
    const unsigned lds0 = (unsigned)(uintptr_t)shm;
    float* wsf = (float*)(shm + LDS_WS) + wid * 64;
    const long klane = (long)lane * PITCH + wid * 8;
    const long vlane = (long)(16 * (wid & 3) + (lane >> 2)) * PITCH + (wid >> 2) * 32 + (lane & 3) * 8;
    const unsigned kdst = lds0 + LDS_K + wid * 1024, vdst = lds0 + LDS_V + wid * 1024;
#define TROW(t) (((t) < 2) ? (rowblk + 64 * (t)) : ((t) < 6) ? (ctxrow + 64 * ((t) - 2)) : (rowblk + ((((t) - 6) < nlo) ? (-128 + 64 * ((t) - 6)) : (128 + 64 * ((t) - 6 - nlo)))))
#define TKB(t) (((t) < 6) ? 0 : ((((t) - 6) < nlo) ? (-128 + 64 * ((t) - 6)) : (128 + 64 * ((t) - 6 - nlo))))
#define DMA_K(t, slot) glds16(Kc + TROW(t) * PITCH + klane, (unsigned)__builtin_amdgcn_readfirstlane(kdst + (slot)))
#define DMA_V(t, slot) glds16(Vc + TROW(t) * PITCH + vlane, (unsigned)__builtin_amdgcn_readfirstlane(vdst + (slot)))
    const int vb0 = (int)(lds0 + LDS_V) + ((lane >> 4) & 1) * 32 + (lane & 3) * 8 + (4 * hi + ((lane & 15) >> 2)) * 64;
    const char* Kbase = shm + LDS_K; bf16x8 kf[8];
    const lds_cptr shm3 = (lds_cptr)shm; const lds_cptr kp0 = shm3 + LDS_K + hi * 1024 + r32 * 16; const lds_cptr vp0 = shm3 + LDS_V + ((lane >> 4) & 1) * 32 + (lane & 3) * 8 + (4 * hi + ((lane & 15) >> 2)) * 64;
#define NXS(x) (((x) == (NSLOT - 1) * SLOTB) ? 0 : (x) + SLOTB)
    const int S0 = sb, S1 = NXS(S0), S2 = NXS(S1);
    if (!pre) { DMA_K(0, S0); DMA_V(0, S0); DMA_K(1, S1); }
    if (!pre) {
#pragma unroll
        for (int d0 = 0; d0 < 4; ++d0) qr[d0] = *reinterpret_cast<const bf16x8*>(&Qw[(long)r32 * PITCH + d0 * 16 + hi * 8]); }
    float mhat = 0.f, l_reg = 0.f; f32x16 o[2]; o[0] = f32x16{}; o[1] = f32x16{}; f32x16 negm = f32x16{}; asm volatile("" : "+v"(negm));
    const int qrel = (wid & 3) * QBLK + r32;
#define CMASK(P0, P1, t) do { int jb_ = (t) - (NT - 4); if (jb_ >= 0) bmask(P0, P1, TKB(t), qrel, hi); } while (0)
    bool resc = false;
#define START(P0, P1) do { const float rm = rowmax(P0, P1); resc = false; \
    { const float dl = rm; mhat = fadd_s(mhat, dl); \
      _Pragma("unroll") for (int r = 0; r < 16; ++r) { P0[r] = fsub_s(P0[r], dl); P1[r] = fsub_s(P1[r], dl); } \
      _Pragma("unroll") for (int r = 0; r < 16; ++r) negm[r] = -mhat; asm volatile("" : "+v"(negm)); } \
    _Pragma("unroll") for (int r = 0; r < 16; ++r) P0[r] = __builtin_amdgcn_exp2f(P0[r]); } while (0)
#define RESC() do { if (resc) { asm volatile("s_waitcnt lgkmcnt(0)" ::: "memory"); \
      _Pragma("unroll") for (int d_ = 0; d_ < 2; ++d_) _Pragma("unroll") for (int r = 0; r < 16; ++r) o[d_][r] *= wsf[crow(r, hi)]; } } while (0)
    f32x16 pA0, pA1, pB0, pB1;
    int sl_prev = S0, sl_cur = S0, sl_next = S1;
#define ROT() do { sl_prev = sl_cur; sl_cur = sl_next; sl_next = (sl_next == (NSLOT - 1) * SLOTB) ? 0 : sl_next + SLOTB; } while (0)
    if (!pre) { DMA_K(2, S2); }
    WAIT_BAR(3);
    qkt(pA0, pA1, Kbase + S0, qr, negm, r32, hi); asm volatile("s_nop 15\n\ts_nop 7" : "+v"(pA0), "+v"(pA1));
    START(pA0, pA1);
    _Pragma("unroll") for (int r = 0; r < 16; ++r) pA1[r] = __builtin_amdgcn_exp2f(pA1[r]);
    WAIT_BAR(0);
    DMA_K(3, S0); DMA_V(1, S1);
    ROT();
    kload8(kf, kp0 + sl_cur);
    WAIT_BAR(2);
    s16x4 vlo[8], vhi[8]; u32x4 pw0, pw1, pw2, pw3;
#define PKW(P, B) cvtpk_s(P[B], P[B + 1])
#define PAF(k) __builtin_bit_cast(bf16x8, pw##k)
#define VFR(i) (bf16x8){vlo[i][0], vlo[i][1], vlo[i][2], vlo[i][3], vhi[i][0], vhi[i][1], vhi[i][2], vhi[i][3]}
#define PIN(x) asm volatile("" : "+v"(x))
#define MX3(a, b, c) __builtin_fmaxf(__builtin_fmaxf((a), (b)), (c))
#define GAPA(MF, A0, A1, A2, A3, W0, W1, PW) do { MF; sacc += A0; sacc += A1; sacc += A2; sacc += A3; PIN(sacc); W0; W1; PIN(PW); SBAR(); } while (0)
#define EX(v) __builtin_amdgcn_exp2f(v)
#define GAPB(MF, X, B) do { MF; X[B] = EX(X[B]); X[B + 1] = EX(X[B + 1]); X[B + 2] = EX(X[B + 2]); X[B + 3] = EX(X[B + 3]); PIN(X); SBAR(); } while (0)
#define VRD(i) do { vlo[i] = vtr(vp_ + (((i) >> 2) * 4096 + ((i) & 3) * 1024)); vhi[i] = vtr(vp_ + (((i) >> 2) * 4096 + ((i) & 3) * 1024 + 512)); } while (0)
#define KRD(G, j) do { if (G) { kload2(kf, kp0 + sl_next, j); SBAR(); } } while (0)
#define STEP(C0, C1, P0, P1, t, GK, GV, GL) do { SBAR(); \
    const lds_cptr vp_ = vp0 + sl_prev; \
    VRD(0); SBAR(); float sacc = (P0[0] + P0[1]); \
    GAPA(C0 = __builtin_amdgcn_mfma_f32_32x32x16_bf16(kf[0], qr[0], negm, 0, 0, 0), P0[2], P0[3], P0[4], P0[5],     pw0[0] = PKW(P0, 0), pw0[1] = PKW(P0, 2), pw0); \
    VRD(4); SBAR(); GAPA(C1 = __builtin_amdgcn_mfma_f32_32x32x16_bf16(kf[1], qr[0], negm, 0, 0, 0), P0[6], P0[7], P0[8], P0[9],     pw0[2] = PKW(P0, 4), pw0[3] = PKW(P0, 6), pw0); \
    VRD(1); SBAR(); GAPA(C0 = __builtin_amdgcn_mfma_f32_32x32x16_bf16(kf[2], qr[1], C0, 0, 0, 0),   P0[10], P0[11], P0[12], P0[13], pw1[0] = PKW(P0, 8), pw1[1] = PKW(P0, 10), pw1); \
    VRD(5); SBAR(); GAPA(C1 = __builtin_amdgcn_mfma_f32_32x32x16_bf16(kf[3], qr[1], C1, 0, 0, 0),   P0[14], P0[15], P1[0], P1[1],   pw1[2] = PKW(P0, 12), pw1[3] = PKW(P0, 14), pw1); \
    VRD(2); SBAR(); GAPA(C0 = __builtin_amdgcn_mfma_f32_32x32x16_bf16(kf[4], qr[2], C0, 0, 0, 0),   P1[2], P1[3], P1[4], P1[5],     pw2[0] = PKW(P1, 0), pw2[1] = PKW(P1, 2), pw2); \
    VRD(6); SBAR(); GAPA(C1 = __builtin_amdgcn_mfma_f32_32x32x16_bf16(kf[5], qr[2], C1, 0, 0, 0),   P1[6], P1[7], P1[8], P1[9],     pw2[2] = PKW(P1, 4), pw2[3] = PKW(P1, 6), pw2); \
    VRD(3); SBAR(); GAPA(C0 = __builtin_amdgcn_mfma_f32_32x32x16_bf16(kf[6], qr[3], C0, 0, 0, 0),   P1[10], P1[11], P1[12], P1[13], pw3[0] = PKW(P1, 8), pw3[1] = PKW(P1, 10), pw3); \
    VRD(7); SBAR(); GAPA(C1 = __builtin_amdgcn_mfma_f32_32x32x16_bf16(kf[7], qr[3], C1, 0, 0, 0),   P1[14], P1[15], 0.f, 0.f,       pw3[2] = PKW(P1, 12), pw3[3] = PKW(P1, 14), pw3); \
    l_reg += sacc; \
    if (GK) { DMA_K((t) + 3, sl_cur); } if (GV) { DMA_V((t) + 1, sl_next); } \
    CMASK(C0, C1, t); \
    { float a = MX3(C0[0], C0[1], C1[0]), b = MX3(C0[2], C0[3], C1[1]); a = MX3(a, C1[2], C1[3]); \
      _Pragma("unroll") for (int r = 4; r < 16; r += 4) { a = MX3(a, C0[r], C0[r + 1]); b = MX3(b, C0[r + 2], C0[r + 3]); a = MX3(a, C1[r], C1[r + 1]); b = MX3(b, C1[r + 2], C1[r + 3]); } \
      float rm = __builtin_fmaxf(a, b); { auto rr = __builtin_amdgcn_permlane32_swap(__float_as_uint(rm), __float_as_uint(rm), false, false); rm = __builtin_fmaxf(__uint_as_float(rr[0]), __uint_as_float(rr[1])); } \
      resc = false; \
      if (__builtin_expect(__any(rm > (float)THRL), 0)) { const float dl = __builtin_fmaxf(rm, 0.f); mhat += dl; \
        _Pragma("unroll") for (int r = 0; r < 16; ++r) { C0[r] -= dl; C1[r] -= dl; } \
        _Pragma("unroll") for (int r = 0; r < 16; ++r) negm[r] = -mhat; asm volatile("" : "+v"(negm)); \
        const float f = __builtin_amdgcn_exp2f(-dl); l_reg *= f; if (hi == 0) wsf[r32] = f; resc = true; } } \
    SBAR(); \
    GAPB(o[0] = __builtin_amdgcn_mfma_f32_32x32x16_bf16(PAF(0), VFR(0), o[0], 0, 0, 0), C0, 0); \
    GAPB(o[1] = __builtin_amdgcn_mfma_f32_32x32x16_bf16(PAF(0), VFR(4), o[1], 0, 0, 0), C0, 4); \
    KRD(GL, 0); GAPB(o[0] = __builtin_amdgcn_mfma_f32_32x32x16_bf16(PAF(1), VFR(1), o[0], 0, 0, 0), C0, 8); \
    KRD(GL, 1); GAPB(o[1] = __builtin_amdgcn_mfma_f32_32x32x16_bf16(PAF(1), VFR(5), o[1], 0, 0, 0), C0, 12); \
    KRD(GL, 2); GAPB(o[0] = __builtin_amdgcn_mfma_f32_32x32x16_bf16(PAF(2), VFR(2), o[0], 0, 0, 0), C1, 0); \
    KRD(GL, 3); GAPB(o[1] = __builtin_amdgcn_mfma_f32_32x32x16_bf16(PAF(2), VFR(6), o[1], 0, 0, 0), C1, 4); \
    GAPB(o[0] = __builtin_amdgcn_mfma_f32_32x32x16_bf16(PAF(3), VFR(3), o[0], 0, 0, 0), C1, 8); \
    GAPB(o[1] = __builtin_amdgcn_mfma_f32_32x32x16_bf16(PAF(3), VFR(7), o[1], 0, 0, 0), C1, 12); \
    } while (0)
    int t = 1;
#undef CMASK
#define CMASK(P0, P1, t) do { } while (0)
    for (; t + 5 < NT; t += 2) {
        STEP(pB0, pB1, pA0, pA1, t, true, true, true);     WAIT_BAR(2); RESC(); ROT();
        STEP(pA0, pA1, pB0, pB1, t + 1, true, true, true); WAIT_BAR(2); RESC(); ROT();
    }
#undef CMASK
#define CMASK(P0, P1, t) do { int jb_ = (t) - (NT - 4); if (jb_ >= 0) bmask(P0, P1, TKB(t), qrel, hi); } while (0)
#define ENDW(tt) do { if ((tt) + 3 < NT) { WAIT_BAR(2); } else if ((tt) + 2 < NT) { WAIT_BAR(1); } else { WAIT_BAR(0); } } while (0)
    for (; t + 1 < NT; t += 2) {
        STEP(pB0, pB1, pA0, pA1, t, (t + 3 < NT), (t + 1 < NT), (t + 1 < NT));     ENDW(t);     RESC(); ROT();
        STEP(pA0, pA1, pB0, pB1, t + 1, (t + 4 < NT), (t + 2 < NT), (t + 2 < NT)); ENDW(t + 1); RESC(); ROT();
    }
    if (has_next) {
        const long rowblkN = (long)nb2 * SEQ + nn2 * 128, ctxrowN = (long)NLAT + nb2 * LCTX; const bf16* KcN = QKV + 1024 + nhk2 * D; const bf16* VcN = QKV + 1280 + nhk2 * D;
        const int T0 = sl_next, T1 = NXS(T0), T2 = NXS(T1);
        glds16(KcN + rowblkN * PITCH + klane, (unsigned)__builtin_amdgcn_readfirstlane(kdst + T0));
        glds16(VcN + rowblkN * PITCH + vlane, (unsigned)__builtin_amdgcn_readfirstlane(vdst + T0));
        glds16(KcN + (rowblkN + 64) * PITCH + klane, (unsigned)__builtin_amdgcn_readfirstlane(kdst + T1));
        glds16(KcN + ctxrowN * PITCH + klane, (unsigned)__builtin_amdgcn_readfirstlane(kdst + T2));
    }
    STEP(pB0, pB1, pA0, pA1, NT - 1, false, false, false); RESC();
    if (has_next) {
        const bf16* QwN = QKV + ((long)nb2 * SEQ + nn2 * 128 + (wid & 3) * QBLK) * PITCH + (4 * nhk2 + 2 * npr2 + (wid >> 2)) * D;
#pragma unroll
        for (int d0 = 0; d0 < 4; ++d0) qr[d0] = *reinterpret_cast<const bf16x8*>(&QwN[(long)r32 * PITCH + d0 * 16 + hi * 8]); }
    { float sacc = pB0[0] + pB0[1]; _Pragma("unroll") for (int r = 2; r < 16; ++r) sacc += pB0[r]; _Pragma("unroll") for (int r = 0; r < 16; ++r) sacc += pB1[r]; l_reg += sacc;
      pw0 = (u32x4){PKW(pB0, 0), PKW(pB0, 2), PKW(pB0, 4), PKW(pB0, 6)}; pw1 = (u32x4){PKW(pB0, 8), PKW(pB0, 10), PKW(pB0, 12), PKW(pB0, 14)}; pw2 = (u32x4){PKW(pB1, 0), PKW(pB1, 2), PKW(pB1, 4), PKW(pB1, 6)}; pw3 = (u32x4){PKW(pB1, 8), PKW(pB1, 10), PKW(pB1, 12), PKW(pB1, 14)};
      SBAR(); pv(o, vb0 + sl_cur, PAF(0), PAF(1), PAF(2), PAF(3)); }
#undef PKW
#undef PAF
#undef VFR
#undef PIN
#undef MX3
#undef GAPA
#undef GAPB
#undef EX
#undef VRD
#undef KRD
#undef STEP
#undef ENDW
    { auto rr = __builtin_amdgcn_permlane32_swap(__float_as_uint(l_reg), __float_as_uint(l_reg), false, false); l_reg = __uint_as_float(rr[0]) + __uint_as_float(rr[1]); }
    l_reg += __builtin_amdgcn_exp2f(sinkp[head] * 1.4426950408889634f - mhat);
    if (hi == 0) wsf[32 + r32] = l_reg; asm volatile("s_waitcnt lgkmcnt(0)" ::: "memory");
    float rli[16];
#pragma unroll
    for (int r = 0; r < 16; ++r) rli[r] = __builtin_amdgcn_rcpf(wsf[32 + crow(r, hi)]);
    unsigned char* Ow = O + (rowblk + (wid & 3) * QBLK) * OPITCH + head * D;
    { bf16* stg = (bf16*)(shm + LDS_OST) + wid * 2048;
#pragma unroll
      for (int r = 0; r < 16; ++r) { const int orow = crow(r, hi);
#pragma unroll
        for (int d0 = 0; d0 < 2; ++d0) stg[orow * 64 + d0 * 32 + r32] = __float2bfloat16(o[d0][r] * rli[r]); }
      asm volatile("s_waitcnt lgkmcnt(0)" ::: "memory");
#pragma unroll
      for (int i = 0; i < 4; ++i) { const int row = i * 8 + (lane >> 3), ch = lane & 7; const u32x4 v = *(const u32x4*)(stg + row * 64 + ch * 8);
        u32x2 w; w.x = pk4f8(__uint_as_float(v.x << 16), __uint_as_float(v.x & 0xffff0000u), __uint_as_float(v.y << 16), __uint_as_float(v.y & 0xffff0000u));
        w.y = pk4f8(__uint_as_float(v.z << 16), __uint_as_float(v.z & 0xffff0000u), __uint_as_float(v.w << 16), __uint_as_float(v.w & 0xffff0000u));
        *(u32x2*)(Ow + (long)row * OPITCH + ch * 8) = w; } }
    asm volatile("s_waitcnt lgkmcnt(0)\n\ts_barrier" ::: "memory");
    return sl_next;
#undef NXS
#undef DMA_K
#undef DMA_V
#undef TROW
#undef TKB
#undef CMASK
#undef START
#undef RESC
#undef ROT
}
#undef SBAR
#undef WAIT_BAR
}

#define XB_TMO      128
#define XB_XCNT(j)  (256  + 64 * (j))
#define XB_XSUB(j)  (1280 + 64 * (j))
#define XB_XGEN(j)  (2304 + 64 * (j))
#define XB_TOP      3328
#define XB_TOPGEN   3392
#define XCD_BAR_WORDS 3456
#define XB_SPIN_CAP (1u << 18)
__device__ __forceinline__ unsigned xb_ld(unsigned* p)              { return __hip_atomic_load(p, __ATOMIC_RELAXED, __HIP_MEMORY_SCOPE_AGENT); }
__device__ __forceinline__ unsigned xb_add(unsigned* p, unsigned v) { return __hip_atomic_fetch_add(p, v, __ATOMIC_RELAXED, __HIP_MEMORY_SCOPE_AGENT); }
__device__ __forceinline__ unsigned xb_xcc_id() { return (unsigned)__builtin_amdgcn_s_getreg((3 << 11) | 20) & 0xFu; }
#define XB_SPIN(cond, bar) do { unsigned _sp = 0; while (cond) { __builtin_amdgcn_s_sleep(1); \
    if ((++_sp & 255u) == 0u) { if (xb_ld(&(bar)[XB_TMO])) break; if (_sp > XB_SPIN_CAP) { atomicAdd(&(bar)[XB_TMO], 1u); break; } } } } while (0)
struct XcdBarrier { unsigned* bar; unsigned x; volatile LAS unsigned* st; };
__device__ __forceinline__ XcdBarrier xcd_barrier_post(unsigned* bar, volatile LAS unsigned* st) {
    XcdBarrier b; b.bar = bar; b.x = xb_xcc_id(); b.st = st;
    if (threadIdx.x == 0) (void)xb_add(&bar[XB_XCNT(b.x)], 1u);
    return b;
}
__device__ __forceinline__ void xcd_barrier_complete(unsigned* bar, unsigned x, unsigned& nloc, unsigned& nx) {
    const unsigned G = gridDim.x * gridDim.y * gridDim.z;
    unsigned sum, cnt, mine, sp = 0u;
    for (;;) {
        sum = 0u; cnt = 0u; mine = 0u;
#pragma unroll
        for (unsigned j = 0; j < 16; ++j) { const unsigned c = xb_ld(&bar[XB_XCNT(j)]); sum += c; cnt += (c > 0u) ? 1u : 0u; mine = (j == x) ? c : mine; }
        if (sum == G) break;
        __builtin_amdgcn_s_sleep(1);
        if ((++sp & 255u) == 0u) { if (xb_ld(&bar[XB_TMO])) break; if (sp > XB_SPIN_CAP) { atomicAdd(&bar[XB_TMO], 1u); break; } }
    }
    nloc = mine > 0u ? mine : 1u; nx = cnt > 0u ? cnt : 1u;
}
__device__ __forceinline__ void xcd_barrier(const XcdBarrier& b) {
    asm volatile("s_waitcnt vmcnt(0)" ::: "memory");
    __syncthreads();
    if (threadIdx.x == 0) {
        unsigned* bar = b.bar;
        __builtin_amdgcn_s_waitcnt(0);
        unsigned nloc = b.st[0], nx = b.st[1];
        if (nloc == 0u) { xcd_barrier_complete(bar, b.x, nloc, nx); b.st[0] = nloc; b.st[1] = nx; }
        const unsigned old = xb_add(&bar[XB_XSUB(b.x)], 1u);
        const unsigned gen = old / nloc;
        if (old + 1u == (gen + 1u) * nloc) {
            __builtin_amdgcn_fence(__ATOMIC_RELEASE, "agent");
            asm volatile("s_waitcnt vmcnt(0)" ::: "memory");
            const unsigned og = xb_add(&bar[XB_TOP], 1u);
            const unsigned tg = og / nx;
            if (og + 1u == (tg + 1u) * nx) xb_add(&bar[XB_TOPGEN], 1u);
            else XB_SPIN(xb_ld(&bar[XB_TOPGEN]) == tg, bar);
            __builtin_amdgcn_fence(__ATOMIC_ACQUIRE, "agent");
            xb_add(&bar[XB_XGEN(b.x)], 1u);
            asm volatile("s_waitcnt vmcnt(0)" ::: "memory");
        } else {
            XB_SPIN(xb_ld(&bar[XB_XGEN(b.x)]) == gen, bar);
            __builtin_amdgcn_fence(__ATOMIC_ACQUIRE, "agent");
            asm volatile("s_waitcnt vmcnt(0)" ::: "memory");
        }
    }
    __syncthreads();
}

#define LDS_WAIT() asm volatile("s_waitcnt lgkmcnt(0)" ::: "memory")
__device__ __forceinline__ void transpose_item(const float* W, int K, int N, bf16_t* WT, int k0, int n0, int drow0, LAS float* scr, int lane) {
    float t[32];
#pragma unroll
    for (int i = 0; i < 32; ++i) t[i] = __builtin_nontemporal_load(W + (size_t)(k0 + 2 * i + (lane >> 5)) * N + n0 + (lane & 31));
#pragma unroll
    for (int i = 0; i < 32; ++i) scr[(2 * i + (lane >> 5)) * 33 + (lane & 31)] = t[i];
    LDS_WAIT(); asm volatile("" ::: "memory");
    const int c = lane & 7;
#pragma unroll
    for (int j = 0; j < 4; ++j) { const int n = (lane >> 3) + 8 * j; const LAS float* s = scr + (8 * c) * 33 + n;
        u32x4 o; o.x = pkbf(s[0 * 33], s[1 * 33]); o.y = pkbf(s[2 * 33], s[3 * 33]); o.z = pkbf(s[4 * 33], s[5 * 33]); o.w = pkbf(s[6 * 33], s[7 * 33]);
        *(GAS u32x4*)(WT + (size_t)(drow0 + n) * K + k0 + 8 * c) = o; }
    LDS_WAIT(); asm volatile("" ::: "memory");
}
__device__ __forceinline__ void transpose_item_f8(const float* W, int K, int N, unsigned char* WT, int k0, int n0, int drow0, float scale, LAS float* scr, int lane) {
    float t[32];
#pragma unroll
    for (int i = 0; i < 32; ++i) t[i] = __builtin_nontemporal_load(W + (size_t)(k0 + 2 * i + (lane >> 5)) * N + n0 + (lane & 31));
#pragma unroll
    for (int i = 0; i < 32; ++i) scr[(2 * i + (lane >> 5)) * 33 + (lane & 31)] = t[i];
    LDS_WAIT(); asm volatile("" ::: "memory");
    const int n = lane >> 1, hf = lane & 1; const LAS float* sp = scr + (32 * hf) * 33 + n;
    u32x4 o0, o1;
    o0.x = pk4f8(sp[0 * 33] * scale, sp[1 * 33] * scale, sp[2 * 33] * scale, sp[3 * 33] * scale);     o0.y = pk4f8(sp[4 * 33] * scale, sp[5 * 33] * scale, sp[6 * 33] * scale, sp[7 * 33] * scale);
    o0.z = pk4f8(sp[8 * 33] * scale, sp[9 * 33] * scale, sp[10 * 33] * scale, sp[11 * 33] * scale);   o0.w = pk4f8(sp[12 * 33] * scale, sp[13 * 33] * scale, sp[14 * 33] * scale, sp[15 * 33] * scale);
    o1.x = pk4f8(sp[16 * 33] * scale, sp[17 * 33] * scale, sp[18 * 33] * scale, sp[19 * 33] * scale); o1.y = pk4f8(sp[20 * 33] * scale, sp[21 * 33] * scale, sp[22 * 33] * scale, sp[23 * 33] * scale);
    o1.z = pk4f8(sp[24 * 33] * scale, sp[25 * 33] * scale, sp[26 * 33] * scale, sp[27 * 33] * scale); o1.w = pk4f8(sp[28 * 33] * scale, sp[29 * 33] * scale, sp[30 * 33] * scale, sp[31 * 33] * scale);
    GAS u32x4* dst = (GAS u32x4*)(WT + (size_t)(drow0 + n) * K + k0 + 32 * hf);
    dst[0] = o0; dst[1] = o1;
    LDS_WAIT(); asm volatile("" ::: "memory");
}
__device__ __forceinline__ void transpose_item_f6(const float* W, int K, int N, unsigned char* WT, int k0, int n0, int drow0, LAS float* scr, int lane) {
    float t[32];
#pragma unroll
    for (int i = 0; i < 32; ++i) t[i] = __builtin_nontemporal_load(W + (size_t)(k0 + 2 * i + (lane >> 5)) * N + n0 + (lane & 31));
#pragma unroll
    for (int i = 0; i < 32; ++i) scr[(2 * i + (lane >> 5)) * 33 + (lane & 31)] = t[i];
    LDS_WAIT(); asm volatile("" ::: "memory");
    const int n = lane >> 1, hf = lane & 1; const LAS float* sp = scr + (32 * hf) * 33 + n;
    float x[32];
#pragma unroll
    for (int i = 0; i < 32; ++i) x[i] = sp[i * 33];
    u32x4 c0, c1; mxfp6_block(x, c0, c1);
    const int kb32 = (k0 >> 5) + hf; unsigned char* dst = WT + (size_t)(drow0 + n) * K + (kb32 >> 2) * 128 + (kb32 & 3) * 16;
    *(GAS u32x4*)dst = c0; *(GAS u32x4*)(dst + 64) = c1;
    LDS_WAIT(); asm volatile("" ::: "memory");
}
__device__ __forceinline__ unsigned pk4i8(float a, float b, float c, float d) {
    const int ia = (int)__builtin_rintf(a), ib = (int)__builtin_rintf(b), ic = (int)__builtin_rintf(c), id = (int)__builtin_rintf(d);
    return (unsigned)(ia & 255) | ((unsigned)(ib & 255) << 8) | ((unsigned)(ic & 255) << 16) | ((unsigned)(id & 255) << 24); }
__device__ __forceinline__ void transpose_item_i8(const float* W, int K, int N, unsigned char* WT, int k0, int n0, int drow0, float scale, LAS float* scr, int lane) {
    float t[32];
#pragma unroll
    for (int i = 0; i < 32; ++i) t[i] = W[(size_t)(k0 + 2 * i + (lane >> 5)) * N + n0 + (lane & 31)];
#pragma unroll
    for (int i = 0; i < 32; ++i) scr[(2 * i + (lane >> 5)) * 33 + (lane & 31)] = t[i];
    LDS_WAIT(); asm volatile("" ::: "memory");
    const int n = lane >> 1, hf = lane & 1; const LAS float* sp = scr + (32 * hf) * 33 + n;
    u32x4 o0, o1;
    o0.x = pk4i8(sp[0 * 33] * scale, sp[1 * 33] * scale, sp[2 * 33] * scale, sp[3 * 33] * scale);     o0.y = pk4i8(sp[4 * 33] * scale, sp[5 * 33] * scale, sp[6 * 33] * scale, sp[7 * 33] * scale);
    o0.z = pk4i8(sp[8 * 33] * scale, sp[9 * 33] * scale, sp[10 * 33] * scale, sp[11 * 33] * scale);   o0.w = pk4i8(sp[12 * 33] * scale, sp[13 * 33] * scale, sp[14 * 33] * scale, sp[15 * 33] * scale);
    o1.x = pk4i8(sp[16 * 33] * scale, sp[17 * 33] * scale, sp[18 * 33] * scale, sp[19 * 33] * scale); o1.y = pk4i8(sp[20 * 33] * scale, sp[21 * 33] * scale, sp[22 * 33] * scale, sp[23 * 33] * scale);
    o1.z = pk4i8(sp[24 * 33] * scale, sp[25 * 33] * scale, sp[26 * 33] * scale, sp[27 * 33] * scale); o1.w = pk4i8(sp[28 * 33] * scale, sp[29 * 33] * scale, sp[30 * 33] * scale, sp[31 * 33] * scale);
    GAS u32x4* dst = (GAS u32x4*)(WT + (size_t)(drow0 + n) * K + k0 + 32 * hf);
    dst[0] = o0; dst[1] = o1;
    LDS_WAIT(); asm volatile("" ::: "memory");
}
__device__ __forceinline__ void sincos_d(double x, double& s, double& c) {
    const double TWO_PI = 6.283185307179586476925;
    const double k = __builtin_rint(x / TWO_PI); const double r = x - k * TWO_PI;
    const double r2 = r * r; double ts = r, tc = 1.0; s = r; c = 1.0;
    for (int i = 1; i <= 16; ++i) { tc *= -r2 / (double)((2 * i - 1) * (2 * i)); ts *= -r2 / (double)((2 * i) * (2 * i + 1)); c += tc; s += ts; }
}

constexpr int CI_F = 16 * 112, CI_FD = 56 * 32, MOE_ITEMS = 8 * (2 * CI_F + CI_FD);
constexpr int MOE_TAIL_A = 12000, MOE_TAIL_B = 7000, MOE_TAIL_C = 12000, MOE_TAIL_TOTAL = MOE_TAIL_A + MOE_TAIL_B + MOE_TAIL_C;
__device__ __forceinline__ void moe_convert_item(int r, const float* wg, const float* wu, const float* wd, unsigned char* mgu, unsigned char* md, LAS float* scr, int lane) {
    const int e = r / (2 * CI_F + CI_FD); int q = r % (2 * CI_F + CI_FD);
    if (q < 2 * CI_F) { const int up = q / CI_F; q %= CI_F; const int kb = q / 112, nb = q % 112, n0 = 32 * nb;
        transpose_item_f6((up ? wu : wg) + (size_t)e * 1024 * DFF, 1024, DFF, mgu + (size_t)e * 7168 * 1024, 64 * kb, n0, 256 * (n0 >> 7) + 128 * up + (n0 & 127), scr, lane); }
    else { q -= 2 * CI_F; const int kb = q / 32, nb = q % 32; transpose_item_f8(wd + (size_t)e * DFF * 1024, DFF, 1024, md + (size_t)e * 1024 * DFF, 64 * kb, 32 * nb, 32 * nb, MOE_SD, scr, lane); }
}
__device__ __forceinline__ void moe_convert_tail(int nunits, int G, int bx, int first, int count, const float* wg, const float* wu, const float* wd, unsigned char* mgu, unsigned char* md, LAS unsigned char* lds) {
    const int busy = nunits % G; if (busy == 0 || bx < busy) return;
    int tid_ = threadIdx.x; asm volatile("" : "+v"(tid_)); const int lane = tid_ & 63, wave = __builtin_amdgcn_readfirstlane(tid_ >> 6);
    LAS float* scr = (LAS float*)(lds + wave * 16384);
    const int nw = (G - busy) * 8, w = (bx - busy) * 8 + wave;
    for (int it = w; it < count; it += nw) moe_convert_item(first + it, wg, wu, wd, mgu, md, scr, lane);
}

struct Args { const float* in[24]; float* out; unsigned char* ws; int ph_lo, ph_hi, li, pad; };
constexpr int NPH = 18;

__device__ __forceinline__ void norm_store(const f32x4 (&v)[4], float ssum, const float* g, const float* mrow, int shc, int scc, bf16_t* XNo, size_t m, int lane, float* rsc) {
    const float rstd = 1.0f / __builtin_sqrtf(ssum * (1.0f / DM) + EPS);
    f32x4 y[4];
#pragma unroll
    for (int j = 0; j < 4; ++j) { const f32x4 gv = *(const f32x4*)(g + 4 * lane + 256 * j), sc = *(const f32x4*)(mrow + scc * 1024 + 4 * lane + 256 * j), sh = *(const f32x4*)(mrow + shc * 1024 + 4 * lane + 256 * j);
        y[j] = (v[j] * rstd) * gv * (sc + 1.0f) + sh; }
    if (rsc == nullptr) {
#pragma unroll
        for (int j = 0; j < 4; ++j) { u32x2 w; w.x = pkbf(y[j].x, y[j].y); w.y = pkbf(y[j].z, y[j].w); *((GAS u32x2*)(XNo + m * DM) + lane + 64 * j) = w; }
    } else {
        float mx = 0.f;
#pragma unroll
        for (int j = 0; j < 4; ++j) mx = __builtin_fmaxf(__builtin_fmaxf(mx, __builtin_fmaxf(__builtin_fabsf(y[j].x), __builtin_fabsf(y[j].y))), __builtin_fmaxf(__builtin_fabsf(y[j].z), __builtin_fabsf(y[j].w)));
#pragma unroll
        for (int o = 1; o < 64; o <<= 1) mx = __builtin_fmaxf(mx, __shfl_xor(mx, o));
        mx = __builtin_fmaxf(mx, 1e-20f); const float qs = 127.0f / mx;
#pragma unroll
        for (int j = 0; j < 4; ++j) *((GAS unsigned*)((unsigned char*)XNo + m * DM) + lane + 64 * j) = pk4i8(y[j].x * qs, y[j].y * qs, y[j].z * qs, y[j].w * qs);
        if (lane == 0) rsc[m] = mx * (1.0f / 127.0f);
    }
}
template <bool SRC_BF16> __device__ __forceinline__ void norm_rows(const void* srcLv, const float* srcC, int nrows, const float* g, const float* mod, int shc, int scc, bf16_t* XNo, int gw, int NGW, int lane,
                                          const float* part, int nS, const float* gatec, float* zout, float* rsc = nullptr) {
    if (nrows > NLAT) {
        for (int rc = gw; rc < NCTXR; rc += NGW) {
            const GAS f32x4* xr = (const GAS f32x4*)(srcC + (size_t)rc * DM) + lane;
            f32x4 v[4];
#pragma unroll
            for (int j = 0; j < 4; ++j) v[j] = xr[64 * j];
            if (part != nullptr) {
                f32x4 a[4];
#pragma unroll
                for (int j = 0; j < 4; ++j) a[j] = (f32x4){0.f, 0.f, 0.f, 0.f};
                for (int s0 = 0; s0 < nS; s0 += 7) {
                    f32x4 t[7][4];
#pragma unroll
                    for (int q = 0; q < 7; ++q) { const int s2 = (s0 + q < nS) ? s0 + q : s0; const GAS f32x4* pr = (const GAS f32x4*)(part + ((size_t)s2 * NCTXR + rc) * DM) + lane;
#pragma unroll
                        for (int j = 0; j < 4; ++j) t[q][j] = pr[64 * j]; }
#pragma unroll
                    for (int q = 0; q < 7; ++q) if (s0 + q < nS) {
#pragma unroll
                        for (int j = 0; j < 4; ++j) a[j] += t[q][j]; }
                }
#pragma unroll
                for (int j = 0; j < 4; ++j) v[j] += *(const f32x4*)(gatec + 4 * lane + 256 * j) * a[j];
                if (zout != nullptr) { GAS f32x4* zr = (GAS f32x4*)(zout + (size_t)rc * DM) + lane;
#pragma unroll
                    for (int j = 0; j < 4; ++j) zr[64 * j] = v[j]; }
            }
            float ss = 0.f;
#pragma unroll
            for (int j = 0; j < 4; ++j) ss += (v[j].x * v[j].x + v[j].y * v[j].y) + (v[j].z * v[j].z + v[j].w * v[j].w);
            norm_store(v, wave_sum(ss), g, mod + (size_t)4 * 6144, shc, scc, XNo, (size_t)NLAT + rc, lane, rsc);
        }
    }
    const bool bal = (NGW == 2048) && (nrows > NLAT);
    for (int k = 0;; ++k) {
        int grp;
        if (bal) { if (k < 3) grp = gw + 2048 * k; else if (gw >= 1024 && k < 5) grp = 6144 + 2 * (gw - 1024) + (k - 3); else break; }
        else { grp = gw + k * NGW; if (grp >= NLAT / 4) break; }
        const int m0 = grp * 4;
        const int mb = m0 >> 13;
        f32x4 v[4][4];
        if constexpr (SRC_BF16) { const GAS u32x2* xr = (const GAS u32x2*)((const bf16_t*)srcLv + (size_t)m0 * DM) + lane;
#pragma unroll
            for (int r = 0; r < 4; ++r)
#pragma unroll
                for (int j = 0; j < 4; ++j) { const u32x2 w = xr[r * 256 + 64 * j]; v[r][j] = (f32x4){__uint_as_float(w.x << 16), __uint_as_float(w.x & 0xffff0000u), __uint_as_float(w.y << 16), __uint_as_float(w.y & 0xffff0000u)}; } }
        else { const GAS f32x4* xr = (const GAS f32x4*)((const float*)srcLv + (size_t)m0 * DM) + lane;
#pragma unroll
            for (int r = 0; r < 4; ++r)
#pragma unroll
                for (int j = 0; j < 4; ++j) v[r][j] = xr[r * 256 + 64 * j]; }
        float ss[4];
#pragma unroll
        for (int r = 0; r < 4; ++r) { ss[r] = 0.f;
#pragma unroll
            for (int j = 0; j < 4; ++j) ss[r] += (v[r][j].x * v[r][j].x + v[r][j].y * v[r][j].y) + (v[r][j].z * v[r][j].z + v[r][j].w * v[r][j].w); }
#pragma unroll
        for (int o = 1; o < 64; o <<= 1) {
#pragma unroll
            for (int r = 0; r < 4; ++r) ss[r] += __shfl_xor(ss[r], o); }
#pragma unroll
        for (int r = 0; r < 4; ++r) norm_store(v[r], ss[r], g, mod + (size_t)mb * 6144, shc, scc, XNo, (size_t)(m0 + r), lane, rsc);
    }
}

__global__ void __launch_bounds__(512, 2) fwd(Args args) {
    extern __shared__ __attribute__((aligned(16))) unsigned char lds_raw[];
    LAS unsigned char* lds = (LAS unsigned char*)lds_raw;
    volatile LAS unsigned* MISC = (volatile LAS unsigned*)(lds + MISC_OFF);
    LAS int* gtab = (LAS int*)(lds + GTAB_OFF);
    const int G = gridDim.x; const int bx = blockIdx.x; const int vcu = (G % 8 == 0) ? (bx % 8) * (G / 8) + bx / 8 : bx;
    const int NGW = G * 8;
#define PHASE_IDS() int tid_ = threadIdx.x; asm volatile("" : "+v"(tid_)); const int tid = tid_, lane = tid & 63, wave = __builtin_amdgcn_readfirstlane(tid >> 6), gw = vcu * 8 + wave; (void)lane; (void)gw
    unsigned char* ws = args.ws;
    gu32* ctl = (gu32*)(ws + WS_CTL);
#define MOD ((float*)(ws + WS_MOD))
#define ROPE ((float*)(ws + WS_ROPE))
#define STATS ((float*)(ws + WS_STATS))
#define RSC ((float*)(ws + WS_RSC))
#define LIST ((int*)(ws + WS_LIST))
#define TINFO ((int*)(ws + WS_TINFO))
#define WSB ((bf16_t*)(ws + WS_WS))
#define WIN ((unsigned char*)(ws + WS_WIN))
#define WAO ((bf16_t*)(ws + WS_WAO))
#define WQKV ((unsigned char*)(ws + WS_WQKV))
#define WBO ((unsigned char*)(ws + WS_WBO))
#define WGU ((unsigned char*)(ws + WS_WGU))
#define WD ((bf16_t*)(ws + WS_WD))
#define MGU ((unsigned char*)(ws + WS_MGU))
#define MD ((unsigned char*)(ws + WS_MD))
#define XN8 ((unsigned char*)(ws + WS_XN))
#define XN ((bf16_t*)(ws + WS_XN))
#define ZB ((float*)(ws + WS_ZB))
#define UVT ((bf16_t*)(ws + WS_UVT))
#define A2 ((bf16_t*)(ws + WS_A2))
#define HB ((bf16_t*)(ws + WS_H))
#define QKV ((bf16_t*)(ws + WS_QKV))
#define OB ((unsigned char*)(ws + WS_O))
#define YB ((bf16_t*)(ws + WS_Y))
#define HC ((unsigned char*)(ws + WS_HC))
#define YP ((bf16_t*)(ws + WS_YP))
#define PART1 ((float*)(ws + WS_PART1))
#define PART2 ((float*)(ws + WS_PART2))
#define I_X (args.in[0])
#define I_C (args.in[1])
#define I_CTX (args.in[2])
#define I_CCTX (args.in[3])
#define I_ADAW (args.in[4])
#define I_ADAB (args.in[5])
#define I_NORMG (args.in[6])
#define I_FINALG (args.in[7])
#define HL ((bf16_t*)(ws + WS_HLB))

    { PHASE_IDS(); for (int u = tid; u < (LDS_BYTES - MISC_OFF) / 4; u += 512) ((LAS unsigned*)(lds + MISC_OFF))[u] = 0u; }
    __syncthreads();
    const int lo = args.ph_lo, hi_ph = args.ph_hi;
    const bool one_launch = (hi_ph - lo) > 1;
    XcdBarrier bar; bar.bar = (unsigned*)(ctl + CW_BAR) + args.li * XCD_BAR_WORDS; bar.x = 0; bar.st = nullptr;
    if (one_launch) bar = xcd_barrier_post((unsigned*)(ctl + CW_BAR) + args.li * XCD_BAR_WORDS, MISC + 8);
#ifndef PHMASK
#define PHMASK 0xFFFFFFFFu
#endif
#define IN(k) (((PHMASK >> (k)) & 1) && lo <= (k) && (k) < hi_ph)
#define BOTH(k) (IN(k) && IN((k) + 1))
#define GRID_BAR() xcd_barrier(bar)
#if defined(PROBE_LO)
    unsigned long long tpA = __builtin_amdgcn_s_memrealtime(), tpB = 0;
#define PROBE_MARK(k) do { if ((k) == PROBE_LO - 1) tpA = __builtin_amdgcn_s_memrealtime(); if ((k) == PROBE_HI) tpB = __builtin_amdgcn_s_memrealtime(); } while (0)
#else
#define PROBE_MARK(k) do { } while (0)
#endif

    if (IN(0)) {
        PHASE_IDS();
        {
            LAS float* sv = (LAS float*)lds;
            LAS float* red = (LAS float*)(lds + 5 * 1024 * 4);
            if (bx < 192) {
                for (int idx = tid; idx < 5 * 1024; idx += 512) { const int r = idx >> 10, k = idx & 1023; const float cv = r < 4 ? I_C[r * 1024 + k] : I_CCTX[k]; sv[idx] = cv / (1.0f + __expf(-cv)); }
                __syncthreads();
                for (int item = bx; item < 192; item += G) {
                    const int i = item / 96, n0 = (item % 96) * 64, nn = tid & 63, kq = tid >> 6;
                    float a0 = 0.f, a1 = 0.f, a2 = 0.f, a3 = 0.f, a4 = 0.f;
                    const float* wp = I_ADAW + ((size_t)i * 1024 + kq * 128) * 6144 + n0 + nn;
#pragma unroll 8
                    for (int k = 0; k < 128; ++k) { const float w = wp[(size_t)k * 6144]; const int kk = kq * 128 + k;
                        a0 += sv[kk] * w; a1 += sv[1024 + kk] * w; a2 += sv[2048 + kk] * w; a3 += sv[3072 + kk] * w; a4 += sv[4096 + kk] * w; }
                    red[(kq * 5 + 0) * 64 + nn] = a0; red[(kq * 5 + 1) * 64 + nn] = a1; red[(kq * 5 + 2) * 64 + nn] = a2; red[(kq * 5 + 3) * 64 + nn] = a3; red[(kq * 5 + 4) * 64 + nn] = a4;
                    __syncthreads();
                    if (tid < 320) { const int r = tid >> 6; float s = I_ADAB[i * 6144 + n0 + nn];
#pragma unroll
                        for (int q = 0; q < 8; ++q) s += red[(q * 5 + r) * 64 + nn];
                        MOD[((size_t)i * 5 + r) * 6144 + n0 + nn] = s; }
                    __syncthreads();
                }
            }
            __syncthreads();
        }
        {
            LAS float* scr = (LAS float*)(lds + wave * 16384);
            constexpr int I_IN = 16 * 64, I_AO = 16 * 32, I_QKV = 16 * 48, I_BO = 16 * 32, I_F = 16 * 112, I_FD = 56 * 32;
            constexpr int I_DENSE = I_IN + I_AO + I_QKV + I_BO + 2 * I_F + I_FD, I_MOE = MOE_ITEMS, I_WS = 128, I_ROPE = 32;
            constexpr int NITEMS = I_DENSE + I_MOE + I_WS + I_ROPE;
            for (int it = gw; it < NITEMS; it += NGW) {
                int r = it;
                if (r < I_IN) { const int kb = r / 64, nb = r % 64; const float* W = args.in[8]; float mx = 0.f;
#pragma unroll
                    for (int i = 0; i < 32; ++i) mx = __builtin_fmaxf(mx, __builtin_fabsf(W[(size_t)(64 * kb + 2 * i + (lane >> 5)) * 2048 + 32 * nb + (lane & 31)]));
#pragma unroll
                    for (int o = 1; o < 64; o <<= 1) mx = __builtin_fmaxf(mx, __shfl_xor(mx, o));
                    if (lane == 0) __hip_atomic_fetch_max((unsigned*)(ctl + CW_WAMAX + 192), __float_as_uint(mx), __ATOMIC_RELAXED, __HIP_MEMORY_SCOPE_AGENT);
                    continue; } r -= I_IN;
                if (r < I_AO) { const int kb = r / 32, nb = r % 32; transpose_item(args.in[13], 1024, 1024, WAO, 64 * kb, 32 * nb, 32 * nb, scr, lane); continue; } r -= I_AO;
                if (r < I_QKV) { const int kb = r / 48, nb = r % 48; const float* W = args.in[14]; float mx = 0.f;
#pragma unroll
                    for (int i = 0; i < 32; ++i) mx = __builtin_fmaxf(mx, __builtin_fabsf(W[(size_t)(64 * kb + 2 * i + (lane >> 5)) * NQKV + 32 * nb + (lane & 31)]));
#pragma unroll
                    for (int o = 1; o < 64; o <<= 1) mx = __builtin_fmaxf(mx, __shfl_xor(mx, o));
                    if (lane == 0) __hip_atomic_fetch_max((unsigned*)(ctl + CW_WAMAX + 128), __float_as_uint(mx), __ATOMIC_RELAXED, __HIP_MEMORY_SCOPE_AGENT);
                    continue; } r -= I_QKV;
                if (r < I_BO) { const int kb = r / 32, nb = r % 32; transpose_item_f8(args.in[16], 1024, 1024, WBO, 64 * kb, 32 * nb, 32 * nb, MOE_SGU, scr, lane); continue; } r -= I_BO;
                if (r < 2 * I_F) { const int up = r / I_F; const int q = r % I_F; const int kb = q / 112, nb = q % 112;
                    const float* W = args.in[17 + up]; float mx = 0.f;
#pragma unroll
                    for (int i = 0; i < 32; ++i) mx = __builtin_fmaxf(mx, __builtin_fabsf(W[(size_t)(64 * kb + 2 * i + (lane >> 5)) * DFF + 32 * nb + (lane & 31)]));
#pragma unroll
                    for (int o = 1; o < 64; o <<= 1) mx = __builtin_fmaxf(mx, __shfl_xor(mx, o));
                    if (lane == 0) __hip_atomic_fetch_max((unsigned*)(ctl + CW_WAMAX + 64 * up), __float_as_uint(mx), __ATOMIC_RELAXED, __HIP_MEMORY_SCOPE_AGENT);
                    continue; } r -= 2 * I_F;
                if (r < I_FD) { const int kb = r / 32, nb = r % 32; transpose_item(args.in[19], DFF, 1024, WD, 64 * kb, 32 * nb, 32 * nb, scr, lane); continue; } r -= I_FD;
                if (r < I_MOE) { if (r >= MOE_TAIL_TOTAL) moe_convert_item(r, args.in[21], args.in[22], args.in[23], MGU, MD, scr, lane); continue; } r -= I_MOE;
                if (r < I_WS) { const float* src = args.in[11] + (size_t)r * 2048;
#pragma unroll
                    for (int j = 0; j < 8; ++j) { const f32x4 v = *(const f32x4*)(src + j * 256 + lane * 4); u32x2 w; w.x = pkbf(v.x, v.y); w.y = pkbf(v.z, v.w); *(u32x2*)(WSB + (size_t)r * 2048 + j * 256 + lane * 4) = w; }
                    continue; } r -= I_WS;
                {
                    const int ent = r * 64 + lane; const int pos = ent >> 4, i = ent & 15;
                    double inv = 1.0; for (int q = 0; q < i; ++q) inv *= 0.56234132519034908;
                    const float ang = (float)pos * (float)inv; double s, c; sincos_d((double)ang, s, c);
                    ROPE[ent] = (float)c; ROPE[2048 + ent] = (float)s;
                }
            }
        }
        if (BOTH(0)) GRID_BAR(); PROBE_MARK(0);
    }
    if (IN(1)) { PHASE_IDS();
        {
            LAS float* scr = (LAS float*)(lds + wave * 16384);
            const float ag = __uint_as_float(__hip_atomic_load((unsigned*)(ctl + CW_WAMAX), __ATOMIC_RELAXED, __HIP_MEMORY_SCOPE_AGENT)), au = __uint_as_float(__hip_atomic_load((unsigned*)(ctl + CW_WAMAX + 64), __ATOMIC_RELAXED, __HIP_MEMORY_SCOPE_AGENT));
            if (gw == 0 && lane == 0) { RSC[MALL] = ag * (1.0f / 127.0f); RSC[MALL + 1] = au * (1.0f / 127.0f); }
            const float ai_ = __uint_as_float(__hip_atomic_load((unsigned*)(ctl + CW_WAMAX + 192), __ATOMIC_RELAXED, __HIP_MEMORY_SCOPE_AGENT));
            if (gw == 0 && lane == 0) RSC[MALL + 3] = ai_ * (1.0f / 127.0f);
            for (int it = gw; it < 16 * 64; it += NGW) { const int kb = it / 64, nb = it % 64; transpose_item_i8(args.in[8], 1024, 2048, WIN, 64 * kb, 32 * nb, 32 * nb, 127.0f / ai_, scr, lane); }
            const float aq = __uint_as_float(__hip_atomic_load((unsigned*)(ctl + CW_WAMAX + 128), __ATOMIC_RELAXED, __HIP_MEMORY_SCOPE_AGENT));
            if (gw == 0 && lane == 0) RSC[MALL + 2] = aq * (1.0f / 127.0f);
            for (int it = gw; it < 16 * 48; it += NGW) { const int kb = it / 48, nb = it % 48; transpose_item_i8(args.in[14], 1024, NQKV, WQKV, 64 * kb, 32 * nb, 32 * nb, 127.0f / aq, scr, lane); }
            for (int it = gw; it < 2 * 16 * 112; it += NGW) { const int up = it / (16 * 112), q = it % (16 * 112), kb = q / 112, nb = q % 112, n0 = 32 * nb;
                transpose_item_i8(args.in[17 + up], 1024, DFF, WGU, 64 * kb, n0, 256 * (n0 >> 7) + 128 * up + (n0 & 127), 127.0f / (up ? au : ag), scr, lane); }
        }
        norm_rows<false>(I_X, I_CTX, MALL, I_NORMG + 0 * 1024, MOD, 0, 1, XN, gw, NGW, lane, nullptr, 0, nullptr, nullptr, RSC); if (BOTH(1)) GRID_BAR(); PROBE_MARK(1); }
    if (IN(2)) {
        pg8::DenseSched S{(const char*)WIN, (const char*)XN8, 8, NPA, G, bx, (size_t)256 * 1024};
        pg8::EpiGeluT E{UVT, STATS, RSC, RSC + MALL + 3};
        pg8::gemm_phase<pg8::EpiGeluT, pg8::DenseSched, true, false, false, true>(lds, gtab, 512, 8, S, E);
        moe_convert_tail(8 * NPA, G, bx, 0, MOE_TAIL_A, args.in[21], args.in[22], args.in[23], MGU, MD, lds);
        if (BOTH(2)) GRID_BAR(); PROBE_MARK(2);
    }
    if (IN(3)) {
        PHASE_IDS();
        const float* vg = args.in[9]; const float* vb = args.in[10]; const float* bs = args.in[12];
        LAS unsigned char* buf = lds + wave * 16384;
        LAS float* mu_l = (LAS float*)(lds + RING_BYTES + 4096 + wave * 1024); LAS float* rs_l = mu_l + 128;
        const int r32 = lane & 31, h = lane >> 5;
        for (int unit = gw; unit < (MALL / 128) * 32; unit += NGW) {
            const int ph = unit & 1, g = (unit >> 1) & 15, ch = unit >> 5, q0 = ch * 128;
#pragma unroll
            for (int tt = 0; tt < 2; ++tt) { const int tok = q0 + lane * 2 + tt; const f32x4* sp = (const f32x4*)(STATS + (size_t)tok * 16);
                const f32x4 a = sp[0], b = sp[1], c = sp[2], d = sp[3];
                const float sum = (a.x + a.z) + (b.x + b.z) + (c.x + c.z) + (d.x + d.z), sq = (a.y + a.w) + (b.y + b.w) + (c.y + c.w) + (d.y + d.w);
                const float mean = sum * (1.0f / 1024.0f), var = sq * (1.0f / 1024.0f) - mean * mean;
                mu_l[lane * 2 + tt] = mean; rs_l[lane * 2 + tt] = 1.0f / __builtin_sqrtf(var + EPS); }
            {
                u32x4 t[16]; const int rw = lane >> 4, ck = lane & 15;
                const bf16_t* vp = UVT + (size_t)(1024 + 64 * g + rw) * MALL + q0 + ck * 8;
#pragma unroll
                for (int i = 0; i < 16; ++i) { t[i] = *(const u32x4*)vp; vp += (size_t)4 * MALL; asm volatile("" : "+v"(vp)); }
#pragma unroll
                for (int i = 0; i < 16; ++i) { const int row = 4 * i + rw; *(LAS u32x4*)(buf + row * 256 + ((ck ^ (row & 15)) << 4)) = t[i]; }
            }
            bf16x8 af[2][8];
#pragma unroll
            for (int ct = 0; ct < 2; ++ct) { const int row = 32 * ct + r32; const float vgc = vg[64 * g + row], vbc = vb[64 * g + row];
#pragma unroll
                for (int s2 = 0; s2 < 8; ++s2) { const int qs = 16 * s2 + 8 * h, ck = 2 * s2 + h;
                    const f32x4 m0 = *(const LAS f32x4*)(mu_l + qs), m1 = *(const LAS f32x4*)(mu_l + qs + 4), r0 = *(const LAS f32x4*)(rs_l + qs), r1 = *(const LAS f32x4*)(rs_l + qs + 4);
                    const bf16x8 raw = *(const LAS bf16x8*)(buf + row * 256 + ((ck ^ (row & 15)) << 4));
                    float y[8];
#pragma unroll
                    for (int j = 0; j < 4; ++j) { y[j] = (bf2f((unsigned short)raw[j]) - m0[j]) * r0[j] * vgc + vbc; y[4 + j] = (bf2f((unsigned short)raw[4 + j]) - m1[j]) * r1[j] * vgc + vbc; }
                    u32x4 w; w.x = pkbf(y[0], y[1]); w.y = pkbf(y[2], y[3]); w.z = pkbf(y[4], y[5]); w.w = pkbf(y[6], y[7]); af[ct][s2] = __builtin_bit_cast(bf16x8, w); } }
            {
                u32x4 t[8]; const int rw = lane >> 3, ck = lane & 7;
                const bf16_t* up = UVT + (size_t)(64 * g + rw) * MALL + q0 + 64 * ph + ck * 8;
#pragma unroll
                for (int i = 0; i < 8; ++i) { t[i] = *(const u32x4*)up; up += (size_t)8 * MALL; asm volatile("" : "+v"(up)); }
#pragma unroll
                for (int i = 0; i < 8; ++i) { const int row = 8 * i + rw; *(LAS u32x4*)(buf + row * 128 + ((ck ^ (row & 7)) << 4)) = t[i]; }
            }
#pragma unroll
            for (int ptl = 0; ptl < 2; ++ptl) {
                const int pl = 32 * ptl + r32, p = 64 * ph + pl; const float bsv = bs[g * 128 + p];
                bf16x8 bfr[8];
#pragma unroll
                for (int s2 = 0; s2 < 8; ++s2) bfr[s2] = *(const bf16x8*)(WSB + (size_t)(g * 128 + p) * 128 + 16 * s2 + 8 * h);
                f32x16 acc[2]; acc[0] = f32x16{}; acc[1] = f32x16{};
#pragma unroll
                for (int s2 = 0; s2 < 8; ++s2)
#pragma unroll
                    for (int ct = 0; ct < 2; ++ct) acc[ct] = __builtin_amdgcn_mfma_f32_32x32x16_bf16(af[ct][s2], bfr[s2], acc[ct], 0, 0, 0);
#pragma unroll
                for (int ct = 0; ct < 2; ++ct)
#pragma unroll
                    for (int rr = 0; rr < 4; ++rr) { const int c = 32 * ct + 8 * rr + 4 * h; float o[4];
#pragma unroll
                        for (int e = 0; e < 4; ++e) { const int cc = c + e; const float uu = bf2f(*(const LAS unsigned short*)(buf + cc * 128 + (((pl >> 3) ^ (cc & 7)) << 4) + (pl & 7) * 2)); o[e] = uu * (acc[ct][4 * rr + e] + bsv); }
                        u32x2 w; w.x = pkbf(o[0], o[1]); w.y = pkbf(o[2], o[3]);
                        *(LAS u32x2*)(buf + 8192 + pl * 128 + (((c >> 3) ^ (pl & 7)) << 4) + (c & 7) * 2) = w; }
            }
            {
                const int rw = lane >> 3, ck = lane & 7;
#pragma unroll
                for (int i = 0; i < 8; ++i) { const int row = 8 * i + rw; const u32x4 v = *(const LAS u32x4*)(buf + 8192 + row * 128 + ((ck ^ (row & 7)) << 4));
                    *(u32x4*)(A2 + (size_t)(q0 + 64 * ph + row) * DM + 64 * g + ck * 8) = v; }
            }
        }
        if (BOTH(3)) GRID_BAR(); PROBE_MARK(3);
    }
    if (IN(4)) {
        { pg8::DenseSched S{(const char*)A2, (const char*)WAO, NPL, 4, G, bx, (size_t)256 * 1024 * 2};
          pg8::EpiResid<true> E{I_X, nullptr, HL, MOD + 2 * 1024, 1.0f};
          pg8::gemm_phase<pg8::EpiResid<true>, pg8::DenseSched, true, false>(lds, gtab, 1024, 16, S, E); }
        { pg8::SplitSched S{(const char*)(A2 + (size_t)NLAT * DM), (const char*)WAO, 4, 4, P3_NS, G, bx, NPL, (size_t)256 * 1024 * 2, (size_t)(1024 / P3_NS) * 2};
          pg8::EpiPartF32 E{PART1, (size_t)NCTXR * DM};
          pg8::gemm_phase<pg8::EpiPartF32, pg8::SplitSched, true, false>(lds, gtab, 1024, 1024 / P3_NS / 64, S, E); }
        if (BOTH(4)) GRID_BAR(); PROBE_MARK(4);
    }
    if (IN(5)) { PHASE_IDS(); norm_rows<true>(HL, I_CTX, MALL, I_NORMG + 1 * 1024, MOD, 3, 4, XN, gw, NGW, lane, PART1, P3_NS, MOD + 4 * 6144 + 2 * 1024, ZB, RSC); if (BOTH(5)) GRID_BAR(); PROBE_MARK(5); }
    if (IN(6)) {
        pg8::DenseSched S{(const char*)XN8, (const char*)WGU, NPA, 28, G, bx, (size_t)256 * 1024};
        pg8::EpiSwiGLUI8 E{HB, RSC, RSC + MALL};
        pg8::gemm_phase<pg8::EpiSwiGLUI8, pg8::DenseSched, true, false, false, true>(lds, gtab, 512, 8, S, E);
        moe_convert_tail(NPA * 28, G, bx, MOE_TAIL_A, MOE_TAIL_B, args.in[21], args.in[22], args.in[23], MGU, MD, lds);
        if (BOTH(6)) GRID_BAR(); PROBE_MARK(6);
    }
    if (IN(7)) {
        { pg8::DenseSched S{(const char*)HB, (const char*)WD, NPL, 4, G, bx, (size_t)256 * DFF * 2};
          pg8::EpiResid<false> E{nullptr, HL, HL, MOD + 5 * 1024, 1.0f};
          pg8::gemm_phase<pg8::EpiResid<false>, pg8::DenseSched, true, false>(lds, gtab, DFF, 56, S, E); }
        { pg8::SplitSched S{(const char*)(HB + (size_t)NLAT * DFF), (const char*)WD, 4, 4, P5_NS, G, bx, NPL, (size_t)256 * DFF * 2, (size_t)(DFF / P5_NS) * 2};
          pg8::EpiPartF32 E{PART2, (size_t)NCTXR * DM};
          pg8::gemm_phase<pg8::EpiPartF32, pg8::SplitSched, true, false>(lds, gtab, DFF, DFF / P5_NS / 64, S, E); }
        if (BOTH(7)) GRID_BAR(); PROBE_MARK(7);
    }
    if (IN(8)) { PHASE_IDS(); norm_rows<true>(HL, ZB, MALL, I_NORMG + 2 * 1024, MOD + 5 * 6144, 0, 1, XN, gw, NGW, lane, PART2, P5_NS, MOD + 4 * 6144 + 5 * 1024, nullptr, RSC); if (BOTH(8)) GRID_BAR(); PROBE_MARK(8); }
    if (IN(9)) {
        { PHASE_IDS(); LAS float* colt = (LAS float*)(lds + ROPC_OFF);
          *(LAS f32x4*)(colt + 4 * tid) = *(const f32x4*)(ROPE + (tid < 256 ? 0 : 2048 - 1024) + 4 * tid); __syncthreads(); }
        pg8::DenseSched S{(const char*)XN8, (const char*)WQKV, NPA, 6, G, bx, (size_t)256 * 1024};
        pg8::EpiQKV E{QKV, ROPE, attn_body::C2, RSC, RSC + MALL + 2, (const LAS float*)(lds + ROPC_OFF)};
        pg8::gemm_phase<pg8::EpiQKV, pg8::DenseSched, true, false, false, true>(lds, gtab, 512, 8, S, E);
        moe_convert_tail(NPA * 6, G, bx, MOE_TAIL_A + MOE_TAIL_B, MOE_TAIL_C, args.in[21], args.in[22], args.in[23], MGU, MD, lds);
        if (BOTH(9)) GRID_BAR(); PROBE_MARK(9);
    }
    if (IN(10)) {
        static_assert(attn_body::LDS_BYTES_A <= RING_BYTES, "attention LDS");
        const float* sinkp = args.in[15];
        int sb = 0; bool pre = false; bf16x8 qfr[4];
#pragma unroll
        for (int d0 = 0; d0 < 4; ++d0) qfr[d0] = bf16x8{};
        for (int i = 0;; ++i) { const int uid = i * G + vcu; if (uid >= NB * 64 * 4 * 2) break;
            const int pr = uid & 1, hk = (uid >> 1) & 3, n = (uid >> 3) & 63, b = uid >> 9;
            const int uid2 = uid + G; const bool has_next = uid2 < NB * 64 * 4 * 2;
            sb = attn_body::attn_unit<8>(b, hk, n, pr, (const attn_body::bf16*)QKV, OB, sinkp, (char*)lds_raw, sb, pre, has_next, uid2 >> 9, (uid2 >> 1) & 3, (uid2 >> 3) & 63, uid2 & 1, qfr);
            pre = has_next; }
        if (BOTH(10)) GRID_BAR(); PROBE_MARK(10);
    }
    if (IN(11)) {
        pg8::DenseSched S{(const char*)OB, (const char*)WBO, NPL, 4, G, bx, (size_t)256 * 1024};
        pg8::EpiResid<false> E{nullptr, HL, HL, MOD + 5 * 6144 + 2 * 1024, 1.0f / MOE_SGU};
        pg8::gemm_phase<pg8::EpiResid<false>, pg8::DenseSched, true, false, true>(lds, gtab, 512, 8, S, E);
        if (BOTH(11)) GRID_BAR(); PROBE_MARK(11);
    }
    if (IN(12)) {
        PHASE_IDS();
        const float* g = I_NORMG + 3 * 1024; const float* mod = MOD + 5 * 6144; const float* wrt = args.in[20];
        LAS int* l_e = (LAS int*)lds;
        LAS float* l_w = (LAS float*)(lds + 1024);
        LAS int* l_cnt = (LAS int*)(lds + 2048);
        LAS int* l_base = (LAS int*)(lds + 2048 + 64);
        LAS unsigned char* rowb = lds + 8192 + wave * 9216;
        for (int blk = bx; blk < NLAT / 128; blk += G) {
            if (tid < 8) l_cnt[tid] = 0;
            __syncthreads();
            const int mb = (blk * 128) >> 13; const float* mrow = mod + (size_t)mb * 6144;
            for (int i4 = 0; i4 < 8; ++i4) {
                const int tl0 = wave * 16 + i4 * 2, m0 = blk * 128 + tl0;
                const GAS u32x2* xr = (const GAS u32x2*)(HL + (size_t)m0 * DM) + lane;
                f32x4 v[2][4]; float ss[2];
#pragma unroll
                for (int r = 0; r < 2; ++r)
#pragma unroll
                    for (int j = 0; j < 4; ++j) { const u32x2 w = xr[r * 256 + 64 * j]; v[r][j] = (f32x4){__uint_as_float(w.x << 16), __uint_as_float(w.x & 0xffff0000u), __uint_as_float(w.y << 16), __uint_as_float(w.y & 0xffff0000u)}; }
#pragma unroll
                for (int r = 0; r < 2; ++r) { ss[r] = 0.f;
#pragma unroll
                    for (int j = 0; j < 4; ++j) ss[r] += (v[r][j].x * v[r][j].x + v[r][j].y * v[r][j].y) + (v[r][j].z * v[r][j].z + v[r][j].w * v[r][j].w); }
#pragma unroll
                for (int o = 1; o < 64; o <<= 1) {
#pragma unroll
                    for (int r = 0; r < 2; ++r) ss[r] += __shfl_xor(ss[r], o); }
                float lg[2][8];
#pragma unroll
                for (int r = 0; r < 2; ++r)
#pragma unroll
                    for (int e = 0; e < 8; ++e) lg[r][e] = 0.f;
#pragma unroll
                for (int j = 0; j < 4; ++j) { const int col = 4 * lane + 256 * j; const f32x4 gv = *(const f32x4*)(g + col), sc = *(const f32x4*)(mrow + 4 * 1024 + col), sh = *(const f32x4*)(mrow + 3 * 1024 + col);
                    const f32x4 gm = gv * (sc + 1.0f);
                    f32x4 y[2];
#pragma unroll
                    for (int r = 0; r < 2; ++r) { const float rstd = 1.0f / __builtin_sqrtf(ss[r] * (1.0f / DM) + EPS); y[r] = (v[r][j] * rstd) * gm + sh;
                        *(LAS f32x4*)(rowb + r * 4608 + (8 * j + (lane >> 3)) * 144 + (lane & 7) * 16) = y[r]; }
#pragma unroll
                    for (int cc = 0; cc < 4; ++cc) { const f32x4 w0 = *(const f32x4*)(wrt + (size_t)(col + cc) * 8), w1 = *(const f32x4*)(wrt + (size_t)(col + cc) * 8 + 4);
#pragma unroll
                        for (int r = 0; r < 2; ++r) { const float yv = y[r][cc];
                            lg[r][0] += yv * w0.x; lg[r][1] += yv * w0.y; lg[r][2] += yv * w0.z; lg[r][3] += yv * w0.w; lg[r][4] += yv * w1.x; lg[r][5] += yv * w1.y; lg[r][6] += yv * w1.z; lg[r][7] += yv * w1.w; } } }
                {
                    const int rr = lane >> 5, bb = lane & 31; const LAS f32x4* bp = (const LAS f32x4*)(rowb + rr * 4608 + bb * 144);
                    float xb[32];
#pragma unroll
                    for (int q = 0; q < 8; ++q) { const f32x4 v4 = bp[q]; xb[4 * q] = v4.x; xb[4 * q + 1] = v4.y; xb[4 * q + 2] = v4.z; xb[4 * q + 3] = v4.w; }
                    u32x4 c0, c1; mxfp6_block(xb, c0, c1);
                    unsigned char* dst = XN8 + (size_t)(m0 + rr) * DM + (bb >> 2) * 128 + (bb & 3) * 16;
                    *(GAS u32x4*)dst = c0; *(GAS u32x4*)(dst + 64) = c1;
                }
#pragma unroll
                for (int o = 1; o < 64; o <<= 1) {
#pragma unroll
                    for (int r = 0; r < 2; ++r)
#pragma unroll
                        for (int e = 0; e < 8; ++e) lg[r][e] += __shfl_xor(lg[r][e], o); }
#pragma unroll
                for (int r = 0; r < 2; ++r) {
                    int ea = 0; float va = lg[r][0];
#pragma unroll
                    for (int e = 1; e < 8; ++e) if (lg[r][e] > va) { va = lg[r][e]; ea = e; }
                    int eb = -1; float vb2 = -INFINITY;
#pragma unroll
                    for (int e = 0; e < 8; ++e) if (e != ea && lg[r][e] > vb2) { vb2 = lg[r][e]; eb = e; }
                    const float wb = 1.0f / (1.0f + __expf(va - vb2)), wa = 1.0f - wb;
                    if (lane == 0) { const int tl = tl0 + r; l_e[tl * 2] = ea; l_e[tl * 2 + 1] = eb; l_w[tl * 2] = wa; l_w[tl * 2 + 1] = wb; } }
            }
            __syncthreads();
            int ea = 0, eb = 0, pa = 0, pb = 0;
            if (tid < 128) { ea = l_e[tid * 2]; eb = l_e[tid * 2 + 1]; pa = atomicAdd((int*)&l_cnt[ea], 1); pb = atomicAdd((int*)&l_cnt[eb], 1); }
            __syncthreads();
            if (tid < 8) l_base[tid] = (int)__hip_atomic_fetch_add((unsigned*)(ctl + CW_CNT + 64 * tid), (unsigned)l_cnt[tid], __ATOMIC_RELAXED, __HIP_MEMORY_SCOPE_AGENT);
            __syncthreads();
            if (tid < 128) { const int m = blk * 128 + tid; pa += l_base[ea]; pb += l_base[eb];
                LIST[(size_t)ea * NLAT + pa] = m; LIST[(size_t)eb * NLAT + pb] = m;
                int* ti = TINFO + (size_t)m * 8; ti[0] = ea; ti[1] = pa; ti[2] = eb; ti[3] = pb; ti[4] = __float_as_int(l_w[tid * 2]); ti[5] = __float_as_int(l_w[tid * 2 + 1]); }
            __syncthreads();
        }
        if (BOTH(12)) GRID_BAR(); PROBE_MARK(12);
    }
    if (hi_ph > 13 && lo < 17) {
        PHASE_IDS();
        LAS int* mtab = (LAS int*)(lds + MOE_OFF);
        if (tid == 0) { int run = 0, R = 0;
            for (int e = 0; e < 8; ++e) { const int ce = (int)__hip_atomic_load((unsigned*)(ctl + CW_CNT + 64 * e), __ATOMIC_RELAXED, __HIP_MEMORY_SCOPE_AGENT); mtab[e] = run; mtab[16 + e] = ce; run += ce >> 8; if (ce & 255) { mtab[24 + R] = e; ++R; } }
            mtab[8] = run; mtab[32] = R; }
        __syncthreads();
        const int nfull = __builtin_amdgcn_readfirstlane(mtab[8]);
        for (int c = 0; c < MOE_NCH; ++c) {
            const int gp0 = c * MOE_CH, gp1 = nfull < (c + 1) * MOE_CH ? nfull : (c + 1) * MOE_CH;
            if (IN(13 + 2 * c)) {
                { pg8::MoeSched S; S.A = (const char*)XN8; S.B = (const char*)MGU; S.list = LIST; S.tab = mtab; S.mode = 0; S.nS = 1; S.kbytes = 0; S.omoff = 0;
                  S.gp0 = gp0; S.gp1 = gp1; S.nN = 28; S.G = G; S.c = bx; S.bexp = (size_t)7168 * 1024; S.btile = (size_t)256 * 1024; S.astep = 0; S.gather = true;
                  pg8::EpiSwiGLU8 E{HC, 1.0f};
                  pg8::gemm_phase<pg8::EpiSwiGLU8, pg8::MoeSched, true, true, false, false, true>(lds, gtab, 512, 8, S, E); }
                if (c == 0) { pg8::MoeSched S; S.A = (const char*)XN8; S.B = (const char*)MGU; S.list = LIST; S.tab = mtab; S.mode = 1; S.nS = 1; S.kbytes = 0; S.omoff = MOE_CH;
                  S.gp0 = 0; S.gp1 = 0; S.nN = 28; S.G = G; S.c = bx; S.bexp = (size_t)7168 * 1024; S.btile = (size_t)256 * 1024; S.astep = 0; S.gather = true;
                  pg8::EpiSwiGLU8 E{HC, 1.0f};
                  pg8::gemm_phase<pg8::EpiSwiGLU8, pg8::MoeSched, true, true, false, false, true>(lds, gtab, 512, 8, S, E); }
                if (BOTH(13 + 2 * c)) GRID_BAR(); PROBE_MARK(13 + 2 * c);
            }
            if (IN(14 + 2 * c)) {
                { pg8::MoeSched S; S.A = (const char*)HC; S.B = (const char*)MD; S.list = LIST; S.tab = mtab; S.mode = 0; S.nS = 1; S.kbytes = 0; S.omoff = 0;
                  S.gp0 = gp0; S.gp1 = gp1; S.nN = 4; S.G = G; S.c = bx; S.bexp = (size_t)1024 * DFF; S.btile = (size_t)256 * DFF; S.astep = (size_t)256 * DFF; S.gather = false;
                  pg8::EpiBf16Plain E{YB, DM, 1.0f / MOE_SD};
                  pg8::gemm_phase<pg8::EpiBf16Plain, pg8::MoeSched, true, false, true>(lds, gtab, DFF / 2, 28, S, E); }
                if (c == 0) { pg8::MoeSched S; S.A = (const char*)(HC + (size_t)MOE_CH * 256 * DFF); S.B = (const char*)MD; S.list = LIST; S.tab = mtab; S.mode = 2; S.nS = MOE_RS; S.kbytes = (size_t)(DFF / MOE_RS); S.omoff = 0;
                  S.gp0 = 0; S.gp1 = 0; S.nN = 4; S.G = G; S.c = bx; S.bexp = (size_t)1024 * DFF; S.btile = (size_t)256 * DFF; S.astep = (size_t)256 * DFF; S.gather = false;
                  pg8::EpiPartBf16 E{YP, (size_t)8 * 256 * DM, 1.0f / MOE_SD};
                  pg8::gemm_phase<pg8::EpiPartBf16, pg8::MoeSched, true, false, true>(lds, gtab, DFF / 2, DFF / MOE_RS / 128, S, E); }
                if (BOTH(14 + 2 * c)) GRID_BAR(); PROBE_MARK(14 + 2 * c);
            }
        }
    }
    if (IN(17)) {
        PHASE_IDS();
        LAS int* l_pb = (LAS int*)(lds + wave * 128);
        if (lane == 0) { int run = 0, R = 0;
            for (int e = 0; e < 8; ++e) { const int ce = (int)__hip_atomic_load((unsigned*)(ctl + CW_CNT + 64 * e), __ATOMIC_RELAXED, __HIP_MEMORY_SCOPE_AGENT); l_pb[e] = run; l_pb[8 + e] = ce >> 8; l_pb[16 + e] = R; run += ce >> 8; if (ce & 255) ++R; } }
        const float* g2 = MOD + 5 * 6144 + 5 * 1024;
        for (int m0 = gw * 2; m0 < NLAT; m0 += NGW * 2) {
            const int mb = m0 >> 13;
            f32x4 hv[2][4], ya[2][4], yb[2][4]; float wa[2], wb[2];
#pragma unroll
            for (int r = 0; r < 2; ++r) {
                const int m = m0 + r; const int* ti = TINFO + (size_t)m * 8;
                const int ea = ti[0], pa = ti[1], eb = ti[2], pb = ti[3]; wa[r] = __int_as_float(ti[4]); wb[r] = __int_as_float(ti[5]);
                const bool ma = (pa >> 8) < l_pb[8 + ea], mbm = (pb >> 8) < l_pb[8 + eb];
                const size_t sa = ma ? (size_t)(l_pb[ea] + (pa >> 8)) * 256 + (pa & 255) : (size_t)l_pb[16 + ea] * 256 + (pa & 255);
                const size_t sb = mbm ? (size_t)(l_pb[eb] + (pb >> 8)) * 256 + (pb & 255) : (size_t)l_pb[16 + eb] * 256 + (pb & 255);
                const GAS u32x2* xr = (const GAS u32x2*)(HL + (size_t)m * DM) + lane;
#pragma unroll
                for (int j = 0; j < 4; ++j) { const u32x2 w = xr[64 * j]; hv[r][j] = (f32x4){__uint_as_float(w.x << 16), __uint_as_float(w.x & 0xffff0000u), __uint_as_float(w.y << 16), __uint_as_float(w.y & 0xffff0000u)}; }
                { const GAS u32x2* yr = (const GAS u32x2*)((ma ? YB : YP) + sa * DM) + lane;
#pragma unroll
                  for (int j = 0; j < 4; ++j) { const u32x2 a = yr[64 * j]; ya[r][j] = (f32x4){__uint_as_float(a.x << 16), __uint_as_float(a.x & 0xffff0000u), __uint_as_float(a.y << 16), __uint_as_float(a.y & 0xffff0000u)}; }
                  if (!ma) for (int s2 = 1; s2 < MOE_RS; ++s2) { const GAS u32x2* y2 = (const GAS u32x2*)(YP + ((size_t)s2 * 8 * 256 + sa) * DM) + lane;
#pragma unroll
                      for (int j = 0; j < 4; ++j) { const u32x2 a = y2[64 * j]; ya[r][j] += (f32x4){__uint_as_float(a.x << 16), __uint_as_float(a.x & 0xffff0000u), __uint_as_float(a.y << 16), __uint_as_float(a.y & 0xffff0000u)}; } } }
                { const GAS u32x2* yr = (const GAS u32x2*)((mbm ? YB : YP) + sb * DM) + lane;
#pragma unroll
                  for (int j = 0; j < 4; ++j) { const u32x2 a = yr[64 * j]; yb[r][j] = (f32x4){__uint_as_float(a.x << 16), __uint_as_float(a.x & 0xffff0000u), __uint_as_float(a.y << 16), __uint_as_float(a.y & 0xffff0000u)}; }
                  if (!mbm) for (int s2 = 1; s2 < MOE_RS; ++s2) { const GAS u32x2* y2 = (const GAS u32x2*)(YP + ((size_t)s2 * 8 * 256 + sb) * DM) + lane;
#pragma unroll
                      for (int j = 0; j < 4; ++j) { const u32x2 a = y2[64 * j]; yb[r][j] += (f32x4){__uint_as_float(a.x << 16), __uint_as_float(a.x & 0xffff0000u), __uint_as_float(a.y << 16), __uint_as_float(a.y & 0xffff0000u)}; } } }
            }
            float ss[2];
#pragma unroll
            for (int r = 0; r < 2; ++r) { ss[r] = 0.f;
#pragma unroll
                for (int j = 0; j < 4; ++j) { const f32x4 gv = *(const f32x4*)(g2 + (size_t)mb * 6144 + 4 * lane + 256 * j);
                    hv[r][j] = hv[r][j] + gv * (ya[r][j] * wa[r] + yb[r][j] * wb[r]); ss[r] += (hv[r][j].x * hv[r][j].x + hv[r][j].y * hv[r][j].y) + (hv[r][j].z * hv[r][j].z + hv[r][j].w * hv[r][j].w); } }
#pragma unroll
            for (int o = 1; o < 64; o <<= 1) {
#pragma unroll
                for (int r = 0; r < 2; ++r) ss[r] += __shfl_xor(ss[r], o); }
#pragma unroll
            for (int r = 0; r < 2; ++r) { const float rstd = 1.0f / __builtin_sqrtf(ss[r] * (1.0f / DM) + EPS);
                GAS f32x4* orow = (GAS f32x4*)(args.out + (size_t)(m0 + r) * DM) + lane;
#pragma unroll
                for (int j = 0; j < 4; ++j) { const f32x4 fg = *(const f32x4*)(I_FINALG + 4 * lane + 256 * j); __builtin_nontemporal_store((hv[r][j] * rstd) * fg, orow + 64 * j); } }
        }
    }
    PROBE_MARK(17);
#if defined(PROBE_LO)
    { PHASE_IDS(); const float T = (float)(tpB - tpA) * 0.01f; const float cval = __builtin_sqrtf(T / (float)(PROBE_UNIT));
      for (int m = gw; m < NLAT; m += NGW) { GAS f32x4* orow = (GAS f32x4*)(args.out + (size_t)m * DM) + lane;
#pragma unroll
        for (int j = 0; j < 4; ++j) orow[64 * j] = (f32x4){cval, cval, cval, cval}; } }
#endif
#undef IN
#undef BOTH
#undef GRID_BAR
}

#ifndef MK_ONE_LAUNCH
#define MK_ONE_LAUNCH 1
#endif
extern "C" void kernel_launch(void* const* d_in, const int* in_sizes, int n_in, void* d_out, int out_size, void* d_ws, size_t ws_size, hipStream_t stream) {
    static int grid = 0;
    if (grid == 0) {
        if (n_in != 24 || out_size != NLAT * DM || ws_size < WS_END) { fprintf(stderr, "kernel_launch: unexpected problem (n_in %d, out %d, ws %zu < %zu)\n", n_in, out_size, ws_size, (size_t)WS_END); grid = -1; return; }
        int dev = 0, cus = 0, per_cu = 0;
        if (hipGetDevice(&dev) != hipSuccess || hipDeviceGetAttribute(&cus, hipDeviceAttributeMultiprocessorCount, dev) != hipSuccess) { grid = -1; return; }
        if (hipFuncSetAttribute((const void*)fwd, hipFuncAttributeMaxDynamicSharedMemorySize, LDS_BYTES) != hipSuccess) { fprintf(stderr, "kernel_launch: hipFuncSetAttribute failed\n"); grid = -1; return; }
        if (hipOccupancyMaxActiveBlocksPerMultiprocessor(&per_cu, (const void*)fwd, 512, LDS_BYTES) != hipSuccess || per_cu < 1) fprintf(stderr, "kernel_launch: occupancy query says %d\n", per_cu);
        (void)hipGetLastError();
        grid = cus;
    }
    if (grid < 0) return;
    if (hipMemsetAsync((char*)d_ws + WS_CTL, 0, CTL_ZERO_BYTES, stream) != hipSuccess) return;
    Args a{};
    for (int i = 0; i < 24; ++i) a.in[i] = (const float*)d_in[i];
    a.out = (float*)d_out; a.ws = (unsigned char*)d_ws;
#if defined(SPLITAT)
    a.ph_lo = 0; a.ph_hi = SPLITAT; a.li = 0;
    hipLaunchKernelGGL(fwd, dim3(grid), dim3(512), LDS_BYTES, stream, a);
    a.ph_lo = SPLITAT; a.ph_hi = NPH; a.li = 1;
    hipLaunchKernelGGL(fwd, dim3(grid), dim3(512), LDS_BYTES, stream, a);
#elif defined(DUPK)
    a.ph_lo = 0; a.ph_hi = DUPK + 1; a.li = 0;
    hipLaunchKernelGGL(fwd, dim3(grid), dim3(512), LDS_BYTES, stream, a);
#ifdef DUPN
    for (int rep = 0; rep < DUPN; ++rep) { a.ph_lo = DUPK; a.ph_hi = DUPK + 1; a.li = 2; hipLaunchKernelGGL(fwd, dim3(grid), dim3(512), LDS_BYTES, stream, a); }
#endif
    a.ph_lo = DUPK; a.ph_hi = NPH; a.li = 1;
    hipLaunchKernelGGL(fwd, dim3(grid), dim3(512), LDS_BYTES, stream, a);
#elif MK_ONE_LAUNCH
    a.ph_lo = 0; a.ph_hi = NPH;
    hipLaunchKernelGGL(fwd, dim3(grid), dim3(512), LDS_BYTES, stream, a);
#else
    for (int p = 0; p < NPH; ++p) { a.ph_lo = p; a.ph_hi = p + 1; hipLaunchKernelGGL(fwd, dim3(grid), dim3(512), LDS_BYTES, stream, a); }
#endif
}
```

```cpp
#include <hip/hip_runtime.h>
#include <hip/hip_bf16.h>
#include <cstdio>
#include <cstdint>
#include <cmath>

constexpr int DM = 1024, NB = 4, SEQ = 8192, LCTX = 256, NLAT = NB * SEQ, NCTXR = NB * LCTX, MALL = NLAT + NCTXR;
constexpr int DFF = 3584, NEXP = 8, NQKV = 1536;
constexpr int NPL = NLAT / 256, NPA = MALL / 256;
constexpr float EPS = 1e-6f;
constexpr int MOE_CH = 128, MOE_NCH = 2;
constexpr float MOE_SGU = 32.0f, MOE_SD = 64.0f;
constexpr int MOE_RS = 7, P3_NS = 8, P5_NS = 14;

#define LAS __attribute__((address_space(3)))
#define GAS __attribute__((address_space(1)))
typedef unsigned short bf16_t;
typedef short bf16x8 __attribute__((ext_vector_type(8)));
typedef float f32x4 __attribute__((ext_vector_type(4)));
typedef float f32x2 __attribute__((ext_vector_type(2)));
typedef float f32x16 __attribute__((ext_vector_type(16)));
typedef unsigned u32x4 __attribute__((ext_vector_type(4)));
typedef unsigned u32x2 __attribute__((ext_vector_type(2)));
typedef __bf16 bf16x2_t __attribute__((ext_vector_type(2)));
typedef GAS unsigned gu32;

__device__ __forceinline__ unsigned pkbf(float lo, float hi) { f32x2 v = {lo, hi}; bf16x2_t b = __builtin_convertvector(v, bf16x2_t); return __builtin_bit_cast(unsigned, b); }
__device__ __forceinline__ unsigned pk4f8(float a, float b, float c, float d) { unsigned w = 0; w = __builtin_amdgcn_cvt_pk_fp8_f32(a, b, w, false); w = __builtin_amdgcn_cvt_pk_fp8_f32(c, d, w, true); return w; }
typedef float f32x16v __attribute__((ext_vector_type(16)));
typedef unsigned u32x6 __attribute__((ext_vector_type(6)));
__device__ __forceinline__ void mxfp6_block(const float (&x)[32], u32x4& c0, u32x4& c1) {
    float mx = 0.f;
#pragma unroll
    for (int i = 0; i < 32; ++i) mx = __builtin_fmaxf(mx, __builtin_fabsf(x[i]));
    int eb = (int)((__float_as_uint(mx) >> 23) & 255u) - 2; eb = eb < 1 ? 1 : eb;
    const float sc = __uint_as_float((unsigned)eb << 23);
    f32x16v a, b;
#pragma unroll
    for (int i = 0; i < 16; ++i) { a[i] = x[i]; b[i] = x[16 + i]; }
    const u32x6 p = __builtin_amdgcn_cvt_scalef32_2xpk16_fp6_f32(a, b, sc);
    c0 = (u32x4){p[0], p[1], p[2], p[3]}; c1 = (u32x4){p[4], p[5], (unsigned)eb, 0u};
}
__device__ __forceinline__ float bf2f(unsigned short h) { return __builtin_bit_cast(float, (unsigned)h << 16); }
__device__ __forceinline__ float wave_sum(float v) {
#pragma unroll
    for (int o = 1; o < 64; o <<= 1) v += __shfl_xor(v, o);
    return v;
}
__device__ __forceinline__ float gelu_tanh(float x) {
    const float t = x * (1.0f + 0.044715f * x * x);
    const float e = __builtin_amdgcn_exp2f(-2.302208198f * t);
    return x * __builtin_amdgcn_rcpf(1.0f + e);
}
__device__ __forceinline__ f32x2 gelu_tanh_pk(f32x2 x) {
    f32x2 xc; xc.x = __builtin_fminf(__builtin_fmaxf(x.x, -4.0f), 4.0f); xc.y = __builtin_fminf(__builtin_fmaxf(x.y, -4.0f), 4.0f);
    const f32x2 t = xc * xc;
    f32x2 a = t * (-1.722785075e-09f) + 1.318496625e-07f;
    a = a * t + (-4.396793778e-06f); a = a * t + 8.516542868e-05f; a = a * t + (-1.085376085e-03f); a = a * t + 9.819232370e-03f; a = a * t + (-6.640538584e-02f); a = a * t + 3.988107710e-01f;
    return x * (a * xc + 0.5f);
}
__device__ __forceinline__ float silu_f(float x) { return x * __builtin_amdgcn_rcpf(1.0f + __builtin_amdgcn_exp2f(-1.4426950409f * x)); }

constexpr size_t MiB = 1u << 20;
constexpr size_t WS_CTL = 0, CTL_ZERO_BYTES = 1 * MiB;
constexpr size_t WS_MOD = 1 * MiB;
constexpr size_t WS_ROPE = 1 * MiB + 256 * 1024;
constexpr size_t WS_STATS = 2 * MiB;
constexpr size_t WS_RSC = 4 * MiB + 512 * 1024;
constexpr size_t WS_LIST = 5 * MiB;
constexpr size_t WS_TINFO = 6 * MiB;
constexpr size_t WS_WS = 7 * MiB;
constexpr size_t WS_WIN = 8 * MiB, WS_WAO = 12 * MiB, WS_WQKV = 14 * MiB, WS_WBO = 17 * MiB, WS_WGU = 19 * MiB, WS_WD = 33 * MiB;
constexpr size_t WS_MGU = 40 * MiB, WS_MD = 96 * MiB;
constexpr size_t WS_HLB = 124 * MiB;
constexpr size_t WS_XN = 208 * MiB;
constexpr size_t WS_ZB = 274 * MiB;
constexpr size_t WS_R = 278 * MiB;
constexpr size_t WS_UVT = WS_R, WS_A2 = WS_R + 132 * MiB, WS_PART1 = WS_R + 198 * MiB, WS_H = WS_R, WS_PART2 = WS_R + 231 * MiB;
constexpr size_t WS_QKV = WS_R, WS_O = WS_R + 99 * MiB;
constexpr size_t WS_Y = WS_R, WS_YP = WS_R + 128 * MiB, WS_HC = WS_R + 156 * MiB;
constexpr size_t WS_END = WS_R + 287 * MiB;
static_assert(WS_UVT + (size_t)2048 * MALL * 2 <= WS_A2 && WS_A2 + (size_t)MALL * DM * 2 <= WS_PART1 && WS_PART1 + (size_t)P3_NS * NCTXR * DM * 4 <= WS_END, "layer-0 mixer map");
static_assert(WS_H + (size_t)MALL * DFF * 2 <= WS_PART2 && WS_PART2 + (size_t)P5_NS * NCTXR * DM * 4 <= WS_END && WS_QKV + (size_t)MALL * NQKV * 2 <= WS_O && WS_O + (size_t)NLAT * DM * 2 <= WS_END, "region map");
static_assert(WS_Y + (size_t)256 * 256 * DM * 2 <= WS_YP && WS_YP + (size_t)MOE_RS * 8 * 256 * DM * 2 <= WS_HC && WS_HC + (size_t)(MOE_CH + 8) * 256 * DFF <= WS_END, "MoE map");
static_assert(WS_MD + (size_t)8 * DM * DFF <= WS_HLB && WS_HLB + (size_t)NLAT * DM * 2 <= WS_XN && WS_XN + (size_t)MALL * DM * 2 <= WS_ZB && WS_MD + (size_t)8 * DM * DFF <= WS_XN && WS_MGU + (size_t)8 * 7168 * DM <= WS_MD, "weights map");
constexpr int CW_TMO = 0, CW_CODE = 1;
constexpr int CW_CNT = 64;
constexpr int CW_WAMAX = 1024;
constexpr int CW_BAR = 4096;

constexpr int RING_BYTES = 131072;
constexpr int GTAB_OFF = RING_BYTES;
constexpr int MOE_OFF = RING_BYTES + 1024;
constexpr int MISC_OFF = RING_BYTES + 2048;
constexpr int STAB_OFF = RING_BYTES + 3072, STAB_STRIDE = 1536;
constexpr int ROPC_OFF = RING_BYTES + 6144;
constexpr int LDS_BYTES = 147456;

namespace pg8 {
constexpr int BM = 256, BK = 64, HALF = 128, HTB = HALF * BK * 2, STAGE_BYTES = 8 * HTB, NXCD = 8, WGM = 8;
__host__ __device__ __forceinline__ int lds_byte(int r, int c) { const int st = (r >> 4) * 2 + (c >> 5), rr = r & 15, cc = c & 31, ob = rr * 64 + cc * 2; return st * 1024 + (ob ^ (((ob >> 9) & 1) << 5)); }
__host__ __device__ __forceinline__ void stage_rc(int b, int& R, int& C) { const int st = b / 1024, sb = b % 1024, swz = sb ^ (((sb >> 9) & 1) << 5); R = (st >> 1) * 16 + swz / 64; C = (st & 1) * 32 + (swz % 64) / 2; }
__host__ __device__ __forceinline__ int perm32(int rho) { const int n = rho >> 4, i = rho & 15; return 8 * (i >> 2) + 4 * n + (i & 3); }

struct Unit { const char* a; const char* b; const int* gl; int pm, pn, om, nv, ks; };

__device__ __forceinline__ bool tile_order(int i, int G, int c, int nM, int nN, int& pm, int& pn) {
    const int nwg = nM * nN; const long L = (long)i * G + c; if (L >= nwg) return false;
    int wgid = (int)L; { const int q = nwg / NXCD, r = nwg % NXCD, xcd = wgid % NXCD, off = wgid / NXCD; wgid = (xcd < r ? xcd * (q + 1) : r * (q + 1) + (xcd - r) * q) + off; }
    const int nig = WGM * nN, gid = wgid / nig, fm = gid * WGM, gsz = (nM - fm) < WGM ? (nM - fm) : WGM;
    pm = fm + ((wgid % nig) % gsz); pn = (wgid % nig) / gsz; return true;
}
struct DenseSched {
    const char* A; const char* B; int nM, nN, G, c; size_t tstep;
    __device__ __forceinline__ bool next(int i, Unit& u) const {
        int pm, pn; if (!tile_order(i, G, c, nM, nN, pm, pn)) return false;
        u.a = A + (size_t)pm * tstep; u.b = B + (size_t)pn * tstep; u.gl = nullptr; u.pm = pm; u.pn = pn; u.om = pm; u.nv = 256; u.ks = 0; return true;
    }
};
typedef int v8i_t __attribute__((ext_vector_type(8)));
typedef int v4i_t __attribute__((ext_vector_type(4)));
__device__ __forceinline__ v8i_t cat8(bf16x8 lo, bf16x8 hi) { const v4i_t a = __builtin_bit_cast(v4i_t, lo), b = __builtin_bit_cast(v4i_t, hi); return __builtin_shufflevector(a, b, 0, 1, 2, 3, 4, 5, 6, 7); }
struct SplitSched {
    const char* A; const char* B; int nM, nN, nS, G, c, pm0; size_t tstep, kbytes;
    __device__ __forceinline__ bool next(int i, Unit& u) const {
        const int L = i * G + c; if (L >= nM * nN * nS) return false;
        const int ks = L % nS, t = L / nS, pn = t % nN, pm = t / nN;
        u.a = A + (size_t)pm * tstep + (size_t)ks * kbytes; u.b = B + (size_t)pn * tstep + (size_t)ks * kbytes; u.gl = nullptr; u.pm = pm0 + pm; u.pn = pn; u.om = pm; u.nv = 256; u.ks = ks; return true;
    }
};
struct MoeSched {
    const char* A; const char* B; const int* list; const LAS int* tab; int gp0, gp1, nN, nS, G, c, mode, omoff; size_t bexp, btile, astep, kbytes; bool gather;
    __device__ __forceinline__ bool next(int i, Unit& u) const {
        int pm, pn, ks = 0;
        if (mode == 0) { if (gp1 <= gp0) return false; if (!tile_order(i, G, c, gp1 - gp0, nN, pm, pn)) return false; }
        else { const int R = __builtin_amdgcn_readfirstlane(tab[32]); const int L = i * G + c; if (L >= R * nN * nS) return false; ks = L % nS; const int t = L / nS; pn = t % nN; pm = t / nN; }
        int e = 0, lp, nv;
        if (mode == 0) { const int gp = gp0 + pm;
#pragma unroll
            for (int k = 1; k < 8; ++k) e += (gp >= __builtin_amdgcn_readfirstlane(tab[k])) ? 1 : 0;
            lp = gp - __builtin_amdgcn_readfirstlane(tab[e]); nv = 256; u.pm = gp; }
        else { e = __builtin_amdgcn_readfirstlane(tab[24 + pm]); const int ce = __builtin_amdgcn_readfirstlane(tab[16 + e]); lp = ce >> 8; nv = ce & 255; u.pm = pm; }
        u.b = B + (size_t)e * bexp + (size_t)pn * btile + (size_t)ks * kbytes; u.pn = pn; u.nv = nv; u.ks = ks; u.om = pm;
        if (gather) { u.a = A; u.gl = list + (size_t)e * NLAT + 256 * lp; u.om = pm + omoff; }
        else { u.a = A + (size_t)pm * astep + (size_t)ks * kbytes; u.gl = nullptr; if (mode == 0) u.om = gp0 + pm; }
        return true;
    }
};

struct EpiGeluT {
    static constexpr bool PERM = true, ROWSCALE = true, AUXTAB = false;
    __device__ __forceinline__ const float* scale_src(const Unit& u) const { return cscale + u.pn * BM; }
    bf16_t* O; float* stats; const float* cscale; const float* wsc;
    __device__ __forceinline__ void operator()(const f32x4 (&acc)[2][2][4][2], const Unit& u, int wr, int wc, int fr, int fq, const LAS float* tab) const {
        const int row0 = u.pm * BM + wr * 64 + fr, col0 = u.pn * BM + wc * 32 + 8 * fq;
        const bool isv = u.pm >= 4; const float wq = wsc[0];
        f32x4 csv[2][2];
#pragma unroll
        for (int bj = 0; bj < 2; ++bj)
#pragma unroll
            for (int n = 0; n < 2; ++n) csv[bj][n] = *(const LAS f32x4*)(tab + wc * 32 + 8 * fq + bj * HALF + 4 * n) * wq;
        float s1[2][2][4], s2[2][2][4];
#pragma unroll
        for (int bj = 0; bj < 2; ++bj)
#pragma unroll
            for (int n = 0; n < 2; ++n)
#pragma unroll
                for (int e = 0; e < 4; ++e) { s1[bj][n][e] = 0.f; s2[bj][n][e] = 0.f; }
#pragma unroll
        for (int ai = 0; ai < 2; ++ai)
#pragma unroll
            for (int m = 0; m < 4; ++m) { bf16_t* rowp = O + (size_t)(row0 + ai * HALF + m * 16) * MALL + col0;
#pragma unroll
                for (int bj = 0; bj < 2; ++bj) { const v4i_t i0 = __builtin_bit_cast(v4i_t, acc[ai][bj][m][0]), i1 = __builtin_bit_cast(v4i_t, acc[ai][bj][m][1]);
                    f32x4 v0 = (f32x4){(float)i0[0], (float)i0[1], (float)i0[2], (float)i0[3]} * csv[bj][0], v1 = (f32x4){(float)i1[0], (float)i1[1], (float)i1[2], (float)i1[3]} * csv[bj][1];
                    { const f32x2 a0 = gelu_tanh_pk((f32x2){v0[0], v0[1]}), a1 = gelu_tanh_pk((f32x2){v0[2], v0[3]}), b0 = gelu_tanh_pk((f32x2){v1[0], v1[1]}), b1 = gelu_tanh_pk((f32x2){v1[2], v1[3]});
                      v0 = (f32x4){a0.x, a0.y, a1.x, a1.y}; v1 = (f32x4){b0.x, b0.y, b1.x, b1.y}; }
#pragma unroll
                    for (int e = 0; e < 4; ++e) { s1[bj][0][e] += v0[e]; s2[bj][0][e] += v0[e] * v0[e]; s1[bj][1][e] += v1[e]; s2[bj][1][e] += v1[e] * v1[e]; }
                    u32x4 w; w.x = pkbf(v0[0], v0[1]); w.y = pkbf(v0[2], v0[3]); w.z = pkbf(v1[0], v1[1]); w.w = pkbf(v1[2], v1[3]);
                    *(u32x4*)(rowp + bj * HALF) = w; } }
        if (isv) {
            const int slot = (u.pm - 4) * 2 + wr;
#pragma unroll
            for (int bj = 0; bj < 2; ++bj)
#pragma unroll
                for (int n = 0; n < 2; ++n)
#pragma unroll
                    for (int e = 0; e < 4; ++e) { float a = s1[bj][n][e], b = s2[bj][n][e];
#pragma unroll
                        for (int o = 1; o < 16; o <<= 1) { a += __shfl_xor(a, o); b += __shfl_xor(b, o); }
                        if (fr == 0) { const int tok = col0 + bj * HALF + 4 * n + e; *(f32x2*)(stats + (size_t)tok * 16 + slot * 2) = (f32x2){a, b}; } }
        }
    }
};
template <bool BASE_F32> struct EpiResid {
    static constexpr bool PERM = true, ROWSCALE = false, AUXTAB = false;
    const float* basef; const bf16_t* baseb; bf16_t* out; const float* gate; float s;
    __device__ __forceinline__ void operator()(const f32x4 (&acc)[2][2][4][2], const Unit& u, int wr, int wc, int fr, int fq, const LAS float* tab) const {
        const int mb = u.pm >> 5; const int col0 = u.pn * BM + wc * 32 + 8 * fq;
        f32x4 gv[2][2];
#pragma unroll
        for (int bj = 0; bj < 2; ++bj)
#pragma unroll
            for (int n = 0; n < 2; ++n) gv[bj][n] = *(const f32x4*)(gate + (size_t)mb * 6144 + col0 + bj * HALF + n * 4) * s;
#pragma unroll
        for (int ai = 0; ai < 2; ++ai)
#pragma unroll
            for (int m = 0; m < 4; ++m) { const size_t off = (size_t)(u.pm * BM + wr * 64 + fr + ai * HALF + m * 16) * DM + col0;
#pragma unroll
                for (int bj = 0; bj < 2; ++bj) { f32x4 b0, b1;
                    if constexpr (BASE_F32) { b0 = *(const f32x4*)(basef + off + bj * HALF); b1 = *(const f32x4*)(basef + off + bj * HALF + 4); }
                    else { const u32x4 w = *(const u32x4*)(baseb + off + bj * HALF);
                        b0 = (f32x4){__uint_as_float(w.x << 16), __uint_as_float(w.x & 0xffff0000u), __uint_as_float(w.y << 16), __uint_as_float(w.y & 0xffff0000u)};
                        b1 = (f32x4){__uint_as_float(w.z << 16), __uint_as_float(w.z & 0xffff0000u), __uint_as_float(w.w << 16), __uint_as_float(w.w & 0xffff0000u)}; }
                    const f32x4 o0 = b0 + gv[bj][0] * acc[ai][bj][m][0], o1 = b1 + gv[bj][1] * acc[ai][bj][m][1];
                    u32x4 w; w.x = pkbf(o0[0], o0[1]); w.y = pkbf(o0[2], o0[3]); w.z = pkbf(o1[0], o1[1]); w.w = pkbf(o1[2], o1[3]);
                    *(u32x4*)(out + off + bj * HALF) = w; } }
    }
};
struct EpiSwiGLU {
    static constexpr bool PERM = true, ROWSCALE = false, AUXTAB = false;
    bf16_t* O;
    __device__ __forceinline__ void operator()(const f32x4 (&acc)[2][2][4][2], const Unit& u, int wr, int wc, int fr, int fq, const LAS float* tab) const {
        bf16_t* base = O + (size_t)(u.om * BM + wr * 64 + fr) * DFF + u.pn * 128 + wc * 32 + 8 * fq;
#pragma unroll
        for (int ai = 0; ai < 2; ++ai)
#pragma unroll
            for (int m = 0; m < 4; ++m) { const f32x4 g0 = acc[ai][0][m][0], g1 = acc[ai][0][m][1], u0 = acc[ai][1][m][0], u1 = acc[ai][1][m][1];
                float o[8];
#pragma unroll
                for (int e = 0; e < 4; ++e) { o[e] = silu_f(g0[e]) * u0[e]; o[4 + e] = silu_f(g1[e]) * u1[e]; }
                u32x4 w; w.x = pkbf(o[0], o[1]); w.y = pkbf(o[2], o[3]); w.z = pkbf(o[4], o[5]); w.w = pkbf(o[6], o[7]);
                *(u32x4*)(base + (size_t)(ai * HALF + m * 16) * DFF) = w; }
    }
};
struct EpiQKV {
    static constexpr bool PERM = false, ROWSCALE = true, AUXTAB = true;
    __device__ __forceinline__ const float* scale_src(const Unit& u) const { return rscale + u.pm * BM; }
    __device__ __forceinline__ const float* aux_src(const Unit& u, int w) const { return cosT + w * 2048 + (u.pm & 31) * 64; }
    bf16_t* O; const float* cosT; float qscale; const float* rscale; const float* wsc; const LAS float* colt;
    __device__ __forceinline__ void operator()(const f32x4 (&acc)[2][2][4][2], const Unit& u, int wr, int wc, int fr, int fq, const LAS float* tab) const {
        const bool lat = u.pm < NPL; const bool dorope = lat && u.pn < 5; const float sc = (u.pn < 4 ? qscale : 1.0f) * wsc[0];
        const bool isv = u.pn == 5;
#pragma unroll
        for (int ai = 0; ai < 2; ++ai)
#pragma unroll
            for (int m = 0; m < 4; ++m) { const int r = ai * HALF + wr * 64 + m * 16 + fr; const int grow = u.pm * BM + r;
                f32x4 cs = (f32x4){1.f, 1.f, 1.f, 1.f}, sn = (f32x4){0.f, 0.f, 0.f, 0.f};
                if (dorope) { if (wc & 1) { cs = *(const LAS f32x4*)(colt + (r & 63) * 16 + 4 * fq); sn = *(const LAS f32x4*)(colt + 1024 + (r & 63) * 16 + 4 * fq); }
                              else { cs = *(const LAS f32x4*)(tab + 256 + (r >> 6) * 16 + 4 * fq); sn = *(const LAS f32x4*)(tab + 320 + (r >> 6) * 16 + 4 * fq); } }
                bf16_t* rowp = O + (size_t)grow * NQKV + u.pn * BM + wc * 32;
                const float rsx = tab[r] * sc;
#pragma unroll
                for (int bj = 0; bj < 2; ++bj) { const v4i_t i1 = __builtin_bit_cast(v4i_t, acc[ai][bj][m][0]), i2 = __builtin_bit_cast(v4i_t, acc[ai][bj][m][1]);
                    const f32x4 x1 = (f32x4){(float)i1[0], (float)i1[1], (float)i1[2], (float)i1[3]}, x2 = (f32x4){(float)i2[0], (float)i2[1], (float)i2[2], (float)i2[3]};
                    const f32x4 o1 = (x1 * cs - x2 * sn) * rsx, o2 = (x1 * sn + x2 * cs) * rsx;
                    u32x4 w; w.x = pkbf(o1[0], o1[1]); w.y = pkbf(o1[2], o1[3]); w.z = pkbf(o2[0], o2[1]); w.w = pkbf(o2[2], o2[3]);
                    if (isv) { *(u32x2*)(rowp + bj * HALF + 4 * fq) = (u32x2){w.x, w.y}; *(u32x2*)(rowp + bj * HALF + 4 * fq + 16) = (u32x2){w.z, w.w}; }
                    else *(u32x4*)(rowp + bj * HALF + 8 * fq) = w; } }
    }
};
struct EpiSwiGLUI8 {
    static constexpr bool PERM = true, ROWSCALE = true, AUXTAB = false;
    __device__ __forceinline__ const float* scale_src(const Unit& u) const { return rscale + u.pm * BM; }
    bf16_t* O; const float* rscale; const float* ws;
    __device__ __forceinline__ void operator()(const f32x4 (&acc)[2][2][4][2], const Unit& u, int wr, int wc, int fr, int fq, const LAS float* tab) const {
        bf16_t* base = O + (size_t)(u.om * BM + wr * 64 + fr) * DFF + u.pn * 128 + wc * 32 + 8 * fq;
        const float wsg = ws[0], wsu = ws[1];
#pragma unroll
        for (int ai = 0; ai < 2; ++ai)
#pragma unroll
            for (int m = 0; m < 4; ++m) { const float rs = tab[wr * 64 + fr + ai * HALF + m * 16]; const float sg = rs * wsg, su = rs * wsu;
                const v4i_t g0 = __builtin_bit_cast(v4i_t, acc[ai][0][m][0]), g1 = __builtin_bit_cast(v4i_t, acc[ai][0][m][1]), u0 = __builtin_bit_cast(v4i_t, acc[ai][1][m][0]), u1 = __builtin_bit_cast(v4i_t, acc[ai][1][m][1]);
                float o[8];
#pragma unroll
                for (int e = 0; e < 4; ++e) { o[e] = silu_f((float)g0[e] * sg) * ((float)u0[e] * su); o[4 + e] = silu_f((float)g1[e] * sg) * ((float)u1[e] * su); }
                u32x4 w; w.x = pkbf(o[0], o[1]); w.y = pkbf(o[2], o[3]); w.z = pkbf(o[4], o[5]); w.w = pkbf(o[6], o[7]);
                *(u32x4*)(base + (size_t)(ai * HALF + m * 16) * DFF) = w; }
    }
};
struct EpiSwiGLU8 {
    static constexpr bool PERM = true, ROWSCALE = false, AUXTAB = false;
    unsigned char* O; float s;
    __device__ __forceinline__ void operator()(const f32x4 (&acc)[2][2][4][2], const Unit& u, int wr, int wc, int fr, int fq, const LAS float* tab) const {
        unsigned char* base = O + (size_t)(u.om * BM + wr * 64 + fr) * DFF + u.pn * 128 + wc * 32 + 8 * fq;
#pragma unroll
        for (int ai = 0; ai < 2; ++ai)
#pragma unroll
            for (int m = 0; m < 4; ++m) { const f32x4 g0 = acc[ai][0][m][0] * s, g1 = acc[ai][0][m][1] * s, u0 = acc[ai][1][m][0] * s, u1 = acc[ai][1][m][1] * s;
                float o[8];
#pragma unroll
                for (int e = 0; e < 4; ++e) { o[e] = silu_f(g0[e]) * u0[e]; o[4 + e] = silu_f(g1[e]) * u1[e]; }
                u32x2 w; w.x = pk4f8(o[0], o[1], o[2], o[3]); w.y = pk4f8(o[4], o[5], o[6], o[7]);
                *(u32x2*)(base + (size_t)(ai * HALF + m * 16) * DFF) = w; }
    }
};
struct EpiSwiGLU6 {
    static constexpr bool PERM = true, ROWSCALE = false, AUXTAB = false;
    unsigned char* O;
    __device__ __forceinline__ void operator()(const f32x4 (&acc)[2][2][4][2], const Unit& u, int wr, int wc, int fr, int fq, const LAS float* tab) const {
        unsigned char* base = O + (size_t)(u.om * BM + wr * 64 + 16 * fq + fr) * DFF + u.pn * 128 + wc * 16;
#pragma unroll
        for (int ai = 0; ai < 2; ++ai) {
            unsigned v[4][8];
#pragma unroll
            for (int m = 0; m < 4; ++m) { const f32x4 g0 = acc[ai][0][m][0], g1 = acc[ai][0][m][1], u0 = acc[ai][1][m][0], u1 = acc[ai][1][m][1];
#pragma unroll
                for (int e = 0; e < 4; ++e) { v[m][e] = __float_as_uint(silu_f(g0[e]) * u0[e]); v[m][4 + e] = __float_as_uint(silu_f(g1[e]) * u1[e]); } }
#pragma unroll
            for (int ml = 0; ml < 2; ++ml)
#pragma unroll
                for (int e = 0; e < 8; ++e) { const u32x2 r = __builtin_amdgcn_permlane32_swap(v[ml][e], v[ml + 2][e], false, false); v[ml][e] = r[0]; v[ml + 2][e] = r[1]; }
#pragma unroll
            for (int part = 0; part < 2; ++part)
#pragma unroll
                for (int e = 0; e < 8; ++e) { const u32x2 r = __builtin_amdgcn_permlane16_swap(v[2 * part][e], v[2 * part + 1][e], false, false); v[2 * part][e] = r[0]; v[2 * part + 1][e] = r[1]; }
            float x[32];
#pragma unroll
            for (int j = 0; j < 4; ++j)
#pragma unroll
                for (int e = 0; e < 8; ++e) x[8 * j + e] = __uint_as_float(v[j][e]);
            u32x4 c0, c1; mxfp6_block(x, c0, c1);
            unsigned char* dst = base + (size_t)(ai * HALF) * DFF;
            *(u32x4*)dst = c0; *(u32x4*)(dst + 64) = c1; }
    }
};
struct EpiBf16Plain {
    static constexpr bool PERM = true, ROWSCALE = false, AUXTAB = false;
    bf16_t* O; int ldc; float s;
    __device__ __forceinline__ void operator()(const f32x4 (&acc)[2][2][4][2], const Unit& u, int wr, int wc, int fr, int fq, const LAS float* tab) const {
        bf16_t* base = O + (size_t)(u.om * BM + wr * 64 + fr) * ldc + u.pn * BM + wc * 32 + 8 * fq;
#pragma unroll
        for (int ai = 0; ai < 2; ++ai)
#pragma unroll
            for (int m = 0; m < 4; ++m)
#pragma unroll
                for (int bj = 0; bj < 2; ++bj) { const f32x4 v0 = acc[ai][bj][m][0] * s, v1 = acc[ai][bj][m][1] * s;
                    u32x4 w; w.x = pkbf(v0[0], v0[1]); w.y = pkbf(v0[2], v0[3]); w.z = pkbf(v1[0], v1[1]); w.w = pkbf(v1[2], v1[3]);
                    *(u32x4*)(base + (size_t)(ai * HALF + m * 16) * ldc + bj * HALF) = w; }
    }
};

struct EpiPartF32 {
    static constexpr bool PERM = true, ROWSCALE = false, AUXTAB = false;
    float* P; size_t sstride;
    __device__ __forceinline__ void operator()(const f32x4 (&acc)[2][2][4][2], const Unit& u, int wr, int wc, int fr, int fq, const LAS float* tab) const {
        float* base = P + (size_t)u.ks * sstride + (size_t)(u.om * BM + wr * 64 + fr) * DM + u.pn * BM + wc * 32 + 8 * fq;
#pragma unroll
        for (int ai = 0; ai < 2; ++ai)
#pragma unroll
            for (int m = 0; m < 4; ++m)
#pragma unroll
                for (int bj = 0; bj < 2; ++bj)
#pragma unroll
                    for (int n = 0; n < 2; ++n) *(f32x4*)(base + (size_t)(ai * HALF + m * 16) * DM + bj * HALF + n * 4) = acc[ai][bj][m][n];
    }
};
struct EpiPartBf16 {
    static constexpr bool PERM = true, ROWSCALE = false, AUXTAB = false;
    bf16_t* P; size_t sstride; float s;
    __device__ __forceinline__ void operator()(const f32x4 (&acc)[2][2][4][2], const Unit& u, int wr, int wc, int fr, int fq, const LAS float* tab) const {
        bf16_t* base = P + (size_t)u.ks * sstride + (size_t)(u.om * BM + wr * 64 + fr) * DM + u.pn * BM + wc * 32 + 8 * fq;
#pragma unroll
        for (int ai = 0; ai < 2; ++ai)
#pragma unroll
            for (int m = 0; m < 4; ++m)
#pragma unroll
                for (int bj = 0; bj < 2; ++bj) { const f32x4 v0 = acc[ai][bj][m][0] * s, v1 = acc[ai][bj][m][1] * s;
                    u32x4 w; w.x = pkbf(v0[0], v0[1]); w.y = pkbf(v0[2], v0[3]); w.z = pkbf(v1[0], v1[1]); w.w = pkbf(v1[2], v1[3]);
                    *(u32x4*)(base + (size_t)(ai * HALF + m * 16) * DM + bj * HALF) = w; }
    }
};

template <class Epi, class Sched, bool ALIGN_EPI, bool GATHER, bool FP8 = false, bool I8 = false, bool FP6 = false>
__device__ __forceinline__ void gemm_phase(LAS unsigned char* lds, LAS int* gtab, const int K  , const int nt_in  , const Sched& S, const Epi& E) {
    int nt = nt_in; asm volatile("" : "+s"(nt));
    int tid_ = threadIdx.x; asm volatile("" : "+v"(tid_));
    const int tid = tid_, wid = __builtin_amdgcn_readfirstlane(tid >> 6), lane = tid & 63, wr = wid >> 2, wc = wid & 3, fr = lane & 15, fq = lane >> 4;
    const size_t kstep = (size_t)(BK * 2);
    const size_t hstep = (size_t)HALF * K * 2;
    unsigned voffB[2];
#pragma unroll
    for (int i = 0; i < 2; ++i) { int R, C; stage_rc(tid * 16 + i * 8192, R, C); const int Rb = Epi::PERM ? ((R & ~31) + perm32(R & 31)) : R;
        voffB[i] = (unsigned)(Rb * K + C) * 2u; }
    unsigned vA[2][2], vN[2][2];
    const unsigned ldsw = (unsigned)wid * 1024u;
    const int aoff = lds_byte(wr * 64 + fr, fq * 8), boff = lds_byte(wc * 32 + fr, fq * 8);
    const LAS unsigned char* aB = lds + aoff; const LAS unsigned char* bB = lds + 65536 + boff;
    asm volatile("" : "+v"(aB), "+v"(bB));
#define PG8_SA(b, h) (((b) * 2 + (h)) * HTB)
#define PG8_SB(b, h) ((4 + (b) * 2 + (h)) * HTB)
#define PG8_STAGE(bufoff, gbase, voff) do { _Pragma("unroll") for (int _i = 0; _i < 2; ++_i) \
        __builtin_amdgcn_global_load_lds((const unsigned*)((const char*)(gbase) + (voff)[_i]), (LAS unsigned*)(lds + (bufoff) + ldsw + _i * 8192), 16, 0, 0); } while (0)
#define PG8_LDA(dst, b, h) do { _Pragma("unroll") for (int m = 0; m < 4; ++m) { if constexpr (FP8 || FP6) dst##8[m] = cat8(*(const LAS bf16x8*)(aB + PG8_SA(b, h) + m * 2048), *(const LAS bf16x8*)(aB + PG8_SA(b, h) + m * 2048 + 1024)); \
        else { _Pragma("unroll") for (int k = 0; k < 2; ++k) dst[m][k] = *(const LAS bf16x8*)(aB + PG8_SA(b, h) + m * 2048 + k * 1024); } } } while (0)
#define PG8_LDB(dst, b, h) do { _Pragma("unroll") for (int n = 0; n < 2; ++n) { if constexpr (FP8 || FP6) dst##8[n] = cat8(*(const LAS bf16x8*)(bB + (PG8_SB(b, h) - 65536) + n * 2048), *(const LAS bf16x8*)(bB + (PG8_SB(b, h) - 65536) + n * 2048 + 1024)); \
        else { _Pragma("unroll") for (int k = 0; k < 2; ++k) dst[n][k] = *(const LAS bf16x8*)(bB + (PG8_SB(b, h) - 65536) + n * 2048 + k * 1024); } } } while (0)
#define PG8_MMA(ai, bj, At, Bt) do { __builtin_amdgcn_s_setprio(1); \
    if constexpr (FP6) { _Pragma("unroll") for (int m = 0; m < 4; ++m) _Pragma("unroll") for (int n = 0; n < 2; ++n) \
        asm volatile("s_nop 1\n\tv_mfma_scale_f32_16x16x128_f8f6f4 %0, %1, %2, %0, %3, %4 op_sel_hi:[0,0,0] cbsz:2 blgp:2" : "+v"(acc[ai][bj][m][n]) \
                     : "v"(__builtin_shufflevector(Bt##8[n], Bt##8[n], 0, 1, 2, 3, 4, 5)), "v"(__builtin_shufflevector(At##8[m], At##8[m], 0, 1, 2, 3, 4, 5)), "v"(Bt##8[n][6]), "v"(At##8[m][6])); } \
    else if constexpr (FP8) { _Pragma("unroll") for (int m = 0; m < 4; ++m) _Pragma("unroll") for (int n = 0; n < 2; ++n) \
        asm volatile("v_mfma_f32_16x16x128_f8f6f4 %0, %1, %2, %0" : "+v"(acc[ai][bj][m][n]) : "v"(Bt##8[n]), "v"(At##8[m])); } \
    else if constexpr (I8) { _Pragma("unroll") for (int m = 0; m < 4; ++m) _Pragma("unroll") for (int n = 0; n < 2; ++n) _Pragma("unroll") for (int k = 0; k < 2; ++k) \
        asm volatile("v_mfma_i32_16x16x64_i8 %0, %1, %2, %0" : "+v"(acc[ai][bj][m][n]) : "v"(Bt[n][k]), "v"(At[m][k])); } \
    else { _Pragma("unroll") for (int m = 0; m < 4; ++m) _Pragma("unroll") for (int n = 0; n < 2; ++n) _Pragma("unroll") for (int k = 0; k < 2; ++k) \
        acc[ai][bj][m][n] = __builtin_amdgcn_mfma_f32_16x16x32_bf16(Bt[n][k], At[m][k], acc[ai][bj][m][n], 0, 0, 0); } \
    __builtin_amdgcn_s_setprio(0); } while (0)
#define PG8_WAIT_V(n) asm volatile("s_waitcnt vmcnt(" #n ")" ::: "memory")
#define PG8_WAIT_L(n) asm volatile("s_waitcnt lgkmcnt(" #n ")" ::: "memory")
#define PG8_BAR __builtin_amdgcn_s_barrier()
#define PG8_SCHED __builtin_amdgcn_sched_barrier(0)
    Unit cur, nxt; int ui = 0;
    if (!S.next(0, cur)) return;
    f32x4 acc[2][2][4][2];
#pragma unroll
    for (int a = 0; a < 2; ++a)
#pragma unroll
        for (int b = 0; b < 2; ++b)
#pragma unroll
            for (int m = 0; m < 4; ++m)
#pragma unroll
                for (int n = 0; n < 2; ++n) acc[a][b][m][n] = (f32x4){0.f, 0.f, 0.f, 0.f};
    bf16x8 At[4][2], B0[2][2], B1[2][2]; v8i_t At8[4], B08[2], B18[2];
    if constexpr (GATHER) {
#pragma unroll
        for (int h = 0; h < 2; ++h)
#pragma unroll
            for (int i = 0; i < 2; ++i) { int R, C; stage_rc(tid * 16 + i * 8192, R, C); const int row = h * HALF + R; const int tok = cur.gl[row < cur.nv ? row : 0]; vA[h][i] = (unsigned)tok * (unsigned)(K * 2) + (unsigned)C * 2u; }
    } else {
#pragma unroll
        for (int h = 0; h < 2; ++h)
#pragma unroll
            for (int i = 0; i < 2; ++i) { int R, C; stage_rc(tid * 16 + i * 8192, R, C); vA[h][i] = (unsigned)(R * K + C) * 2u + (unsigned)(h * hstep); }
    }
#pragma unroll
    for (int h = 0; h < 2; ++h)
#pragma unroll
        for (int i = 0; i < 2; ++i) vN[h][i] = vA[h][i];
    const char* cA = cur.a; const char* cB = cur.b;
    PG8_STAGE(PG8_SB(0, 0), cB, voffB); PG8_STAGE(PG8_SB(0, 1), cB + hstep, voffB); PG8_STAGE(PG8_SA(0, 0), cA, vA[0]); PG8_STAGE(PG8_SA(0, 1), cA, vA[1]);
    if (wr == 1) PG8_BAR;
    PG8_WAIT_V(2); PG8_BAR;
    PG8_STAGE(PG8_SB(1, 0), cB + kstep, voffB); PG8_STAGE(PG8_SA(1, 0), cA + kstep, vA[0]); PG8_STAGE(PG8_SB(1, 1), cB + hstep + kstep, voffB);
    PG8_WAIT_V(6); PG8_BAR;
    for (;;) {
        const bool has_next = S.next(ui + 1, nxt);
        if constexpr (Epi::ROWSCALE) {
            if (wid < 4) __builtin_amdgcn_global_load_lds((const unsigned*)(E.scale_src(cur) + wid * 64 + lane), (LAS unsigned*)(lds + STAB_OFF + (ui & 1) * STAB_STRIDE + wid * 256), 4, 0, 0);
            if constexpr (Epi::AUXTAB) { if (wid < 2) __builtin_amdgcn_global_load_lds((const unsigned*)(E.aux_src(cur, wid) + lane), (LAS unsigned*)(lds + STAB_OFF + (ui & 1) * STAB_STRIDE + 1024 + wid * 256), 4, 0, 0); }
        }
        const char* nA = has_next ? nxt.a : cA; const char* nB = has_next ? nxt.b : cB;
        if constexpr (GATHER) {
            if (has_next && wid < 4) __builtin_amdgcn_global_load_lds((const unsigned*)(nxt.gl + wid * 64 + lane), (LAS unsigned*)(gtab + wid * 64), 4, 0, 0);
        }
        for (int t = 0; t < nt; t += 2) {
            const bool last = (t == nt - 2);
            const char* a1 = cA + (size_t)(t + 1) * kstep;
            const char* a2 = last ? nA : cA + (size_t)(t + 2) * kstep; const char* b2 = last ? nB : cB + (size_t)(t + 2) * kstep;
            const char* a3 = a2 + kstep; const char* b3 = b2 + kstep;
            if constexpr (GATHER) {
                if (last && has_next) {
                    int t2 = tid; asm volatile("" : "+v"(t2));
#pragma unroll
                    for (int h = 0; h < 2; ++h)
#pragma unroll
                        for (int i = 0; i < 2; ++i) { int R, C; stage_rc(t2 * 16 + i * 8192, R, C); const int row = h * HALF + R; const int tok = gtab[row < nxt.nv ? row : 0]; vN[h][i] = (unsigned)tok * (unsigned)(K * 2) + (unsigned)C * 2u; }
                }
            }
            unsigned vS0[2], vS1[2];
#pragma unroll
            for (int i = 0; i < 2; ++i) { vS0[i] = (GATHER && last) ? vN[0][i] : vA[0][i]; vS1[i] = (GATHER && last) ? vN[1][i] : vA[1][i]; }
            PG8_LDB(B0, 0, 0); PG8_LDB(B1, 0, 1); PG8_SCHED; PG8_LDA(At, 0, 0); PG8_STAGE(PG8_SA(1, 1), a1, vA[1]);
            PG8_WAIT_V(8); PG8_WAIT_L(0); PG8_BAR; PG8_MMA(0, 0, At, B0); PG8_MMA(0, 1, At, B1); PG8_BAR; PG8_SCHED;
            PG8_LDA(At, 0, 1); PG8_STAGE(PG8_SB(0, 0), b2, voffB); PG8_STAGE(PG8_SB(0, 1), b2 + hstep, voffB); PG8_STAGE(PG8_SA(0, 0), a2, vS0);
            PG8_WAIT_V(8); PG8_WAIT_L(0); PG8_BAR; PG8_MMA(1, 0, At, B0); PG8_MMA(1, 1, At, B1); PG8_BAR; PG8_SCHED;
            PG8_LDB(B0, 1, 0); PG8_LDB(B1, 1, 1); PG8_SCHED; PG8_LDA(At, 1, 0); PG8_STAGE(PG8_SA(0, 1), a2, vS1);
            PG8_WAIT_V(8); PG8_WAIT_L(0); PG8_BAR; PG8_MMA(0, 0, At, B0); PG8_MMA(0, 1, At, B1); PG8_BAR; PG8_SCHED;
            PG8_LDA(At, 1, 1); PG8_STAGE(PG8_SB(1, 0), b3, voffB); PG8_STAGE(PG8_SB(1, 1), b3 + hstep, voffB); PG8_STAGE(PG8_SA(1, 0), a3, vS0);
            PG8_WAIT_V(8); PG8_WAIT_L(0); PG8_BAR; PG8_MMA(1, 0, At, B0); PG8_MMA(1, 1, At, B1); PG8_BAR; PG8_SCHED;
        }
        if constexpr (ALIGN_EPI) { if (wr == 0) PG8_BAR; }
        if constexpr (FP8 || I8 || FP6) asm volatile("s_nop 15\n\ts_nop 15" ::: "memory");
        E(acc, cur, wr, wc, fr, fq, (const LAS float*)(lds + STAB_OFF + (ui & 1) * STAB_STRIDE));
        if (!has_next) break;
#pragma unroll
        for (int a = 0; a < 2; ++a)
#pragma unroll
            for (int b = 0; b < 2; ++b)
#pragma unroll
                for (int m = 0; m < 4; ++m)
#pragma unroll
                    for (int n = 0; n < 2; ++n) acc[a][b][m][n] = (f32x4){0.f, 0.f, 0.f, 0.f};
        cur = nxt; cA = nA; cB = nB; ++ui;
        if constexpr (GATHER) {
#pragma unroll
            for (int h = 0; h < 2; ++h)
#pragma unroll
                for (int i = 0; i < 2; ++i) vA[h][i] = vN[h][i];
        }
        if constexpr (ALIGN_EPI) { if (wr == 1) PG8_BAR; }
    }
    PG8_WAIT_V(0);
    if constexpr (!ALIGN_EPI) { if (wr == 0) PG8_BAR; }
    PG8_BAR;
#undef PG8_SA
#undef PG8_SB
#undef PG8_STAGE
#undef PG8_LDA
#undef PG8_LDB
#undef PG8_MMA
#undef PG8_WAIT_V
#undef PG8_WAIT_L
#undef PG8_BAR
#undef PG8_SCHED
}
}

namespace attn_body {
using bf16 = __hip_bfloat16;
using s16x4 = __attribute__((ext_vector_type(4))) short;
constexpr int D = 64, PITCH = NQKV, OPITCH = DM;
constexpr int NW = 8, QBLK = 32, KVBLK = 64;
__device__ __forceinline__ int crow(int r, int hi) { return (r & 3) + 8 * (r >> 2) + 4 * hi; }
#define SBAR() __builtin_amdgcn_sched_barrier(0)
__device__ __forceinline__ void bmask(f32x16& p0, f32x16& p1, int kb, int qrel, int hi) {
    const float NEG = -INFINITY; const int d0 = kb + 4 * hi - qrel;
#pragma unroll
    for (int r = 0; r < 16; ++r) { const int d = d0 + (r & 3) + 8 * (r >> 2); if (d < -128 || d > 128) p0[r] = NEG; if (d + 32 < -128 || d + 32 > 128) p1[r] = NEG; }
}
constexpr int NSLOT = 3, SLOTB = 8192;
constexpr int LDS_K = 0, LDS_V = NSLOT * SLOTB, LDS_WS = 2 * NSLOT * SLOTB, LDS_OST = LDS_WS + NW * 64 * 4, LDS_BYTES_A = LDS_OST + NW * 4096;
constexpr float C2 = 0.125f * 1.4426950408889634f;
__device__ __forceinline__ void glds16(const void* gsrc, unsigned lds_dst) { unsigned keep;
    asm volatile("s_mov_b32 %0, m0\n\ts_mov_b32 m0, %2\n\ts_nop 0\n\tglobal_load_lds_dwordx4 %1, off\n\ts_mov_b32 m0, %0" : "=&s"(keep) : "v"(gsrc), "s"(lds_dst) : "memory"); }
__device__ __forceinline__ float max3f(float a, float b, float c) { float r; asm("v_max3_f32 %0, %1, %2, %3" : "=v"(r) : "v"(a), "v"(b), "v"(c)); return r; }
__device__ __forceinline__ float max2f(float a, float b) { float r; asm("v_max_f32_e32 %0, %1, %2" : "=v"(r) : "v"(a), "v"(b)); return r; }
__device__ __forceinline__ float fadd_s(float a, float b) { float r; asm("v_add_f32_e32 %0, %1, %2" : "=v"(r) : "v"(a), "v"(b)); return r; }
__device__ __forceinline__ float fsub_s(float a, float b) { float r; asm("v_sub_f32_e32 %0, %1, %2" : "=v"(r) : "v"(a), "v"(b)); return r; }
__device__ __forceinline__ unsigned cvtpk_s(float lo, float hi) { f32x2 v = {lo, hi}; bf16x2_t b = __builtin_convertvector(v, bf16x2_t); return __builtin_bit_cast(unsigned, b); }
#define WAIT_BAR(N) asm volatile("s_waitcnt vmcnt(" #N ") lgkmcnt(0)\n\ts_barrier" ::: "memory")
__device__ __forceinline__ void qkt(f32x16& p0, f32x16& p1, const char* Kslot, const bf16x8* qr, const f32x16& negm, int r32, int hi) {
    const char* kb = Kslot + hi * 1024 + r32 * 16;
#pragma unroll
    for (int d0 = 0; d0 < 4; ++d0) {
        const bf16x8 b0 = *reinterpret_cast<const bf16x8*>(kb + d0 * 2048);
        const bf16x8 b1 = *reinterpret_cast<const bf16x8*>(kb + d0 * 2048 + 512);
        if (d0 == 0) { p0 = __builtin_amdgcn_mfma_f32_32x32x16_bf16(b0, qr[0], negm, 0, 0, 0); p1 = __builtin_amdgcn_mfma_f32_32x32x16_bf16(b1, qr[0], negm, 0, 0, 0); }
        else { p0 = __builtin_amdgcn_mfma_f32_32x32x16_bf16(b0, qr[d0], p0, 0, 0, 0); p1 = __builtin_amdgcn_mfma_f32_32x32x16_bf16(b1, qr[d0], p1, 0, 0, 0); } }
}
typedef __attribute__((address_space(3))) const char* lds_cptr;
typedef short v4i16_t __attribute__((ext_vector_type(4)));
__device__ __forceinline__ void kload8(bf16x8* kf, lds_cptr kp) {
    kf[0] = *(const __attribute__((address_space(3))) bf16x8*)(kp);        kf[1] = *(const __attribute__((address_space(3))) bf16x8*)(kp + 512);
    kf[2] = *(const __attribute__((address_space(3))) bf16x8*)(kp + 2048); kf[3] = *(const __attribute__((address_space(3))) bf16x8*)(kp + 2560);
    kf[4] = *(const __attribute__((address_space(3))) bf16x8*)(kp + 4096); kf[5] = *(const __attribute__((address_space(3))) bf16x8*)(kp + 4608);
    kf[6] = *(const __attribute__((address_space(3))) bf16x8*)(kp + 6144); kf[7] = *(const __attribute__((address_space(3))) bf16x8*)(kp + 6656);
}
__device__ __forceinline__ void kload2(bf16x8* kf, lds_cptr kp, int j) { kf[2 * j] = *(const __attribute__((address_space(3))) bf16x8*)(kp + j * 2048); kf[2 * j + 1] = *(const __attribute__((address_space(3))) bf16x8*)(kp + j * 2048 + 512); }
__device__ __forceinline__ s16x4 vtr(lds_cptr p) { return __builtin_bit_cast(s16x4, __builtin_amdgcn_ds_read_tr16_b64_v4i16((__attribute__((address_space(3))) v4i16_t*)p)); }
__device__ __forceinline__ float rowmax(const f32x16& p0, const f32x16& p1) {
    float a = max3f(p0[0], p0[1], p1[0]), b = max3f(p0[2], p0[3], p1[1]); a = max3f(a, p1[2], p1[3]);
#pragma unroll
    for (int r = 4; r < 16; r += 4) { a = max3f(a, p0[r], p0[r + 1]); b = max3f(b, p0[r + 2], p0[r + 3]); a = max3f(a, p1[r], p1[r + 1]); b = max3f(b, p1[r + 2], p1[r + 3]); }
    const float m = max2f(a, b);
    auto rr = __builtin_amdgcn_permlane32_swap(__float_as_uint(m), __float_as_uint(m), false, false);
    return max2f(__uint_as_float(rr[0]), __uint_as_float(rr[1]));
}
__device__ __forceinline__ void pv(f32x16* o, int vb, bf16x8 pa0, bf16x8 pa1, bf16x8 pa2, bf16x8 pa3) {
#pragma unroll
    for (int d0 = 0; d0 < 2; ++d0) { s16x4 lo[4], hi[4];
#pragma unroll
        for (int ks = 0; ks < 4; ++ks) {
            asm volatile("ds_read_b64_tr_b16 %0,%1 offset:%c2" : "=&v"(lo[ks]) : "v"(vb), "i"(d0 * 4096 + ks * 1024) : "memory");
            asm volatile("ds_read_b64_tr_b16 %0,%1 offset:%c2" : "=&v"(hi[ks]) : "v"(vb), "i"(d0 * 4096 + ks * 1024 + 512) : "memory"); }
        asm volatile("s_waitcnt lgkmcnt(0)" ::: "memory"); SBAR();
#define PK(k) (bf16x8){lo[k][0], lo[k][1], lo[k][2], lo[k][3], hi[k][0], hi[k][1], hi[k][2], hi[k][3]}
        o[d0] = __builtin_amdgcn_mfma_f32_32x32x16_bf16(pa0, PK(0), o[d0], 0, 0, 0);
        o[d0] = __builtin_amdgcn_mfma_f32_32x32x16_bf16(pa1, PK(1), o[d0], 0, 0, 0);
        o[d0] = __builtin_amdgcn_mfma_f32_32x32x16_bf16(pa2, PK(2), o[d0], 0, 0, 0);
        o[d0] = __builtin_amdgcn_mfma_f32_32x32x16_bf16(pa3, PK(3), o[d0], 0, 0, 0);
#undef PK
    }
}
#define ATTN_STORE16(p, v) (*(u32x4*)(p) = (v))
template <int THRL> __device__ __forceinline__ int attn_unit(int b, int hk, int n, int pr, const bf16* QKV, unsigned char* O, const float* sinkp, char* shm, int sb, bool pre, bool has_next, int nb2, int nhk2, int nn2, int npr2, bf16x8 (&qr)[4]) {
    int tid_ = threadIdx.x; asm volatile("" : "+v"(tid_));
    const int tid = tid_, lane = tid & 63, r32 = lane & 31, hi = lane >> 5; const int wid = __builtin_amdgcn_readfirstlane(tid >> 6);
    const int head = 4 * hk + 2 * pr + (wid >> 2);
    const long rowblk = (long)b * SEQ + n * 128;
    const long ctxrow = (long)NLAT + b * LCTX;
    const int nlo = n > 0 ? 2 : 0, nhi = n < (SEQ / 128 - 1) ? 2 : 0;
    const int NT = 6 + nlo + nhi;
    const bf16* Qw = QKV + (rowblk + (wid & 3) * QBLK) * PITCH + head * D;
    const bf16* Kc = QKV + 1024 + hk * D; const bf16* Vc = QKV + 1280 + hk * D;
    const unsigned lds0 = (unsigned)(uintptr_t)shm;
    float* wsf = (float*)(shm + LDS_WS) + wid * 64;
    const long klane = (long)lane * PITCH + wid * 8;
    const long vlane = (long)(16 * (wid & 3) + (lane >> 2)) * PITCH + (wid >> 2) * 32 + (lane & 3) * 8;
    const unsigned kdst = lds0 + LDS_K + wid * 1024, vdst = lds0 + LDS_V + wid * 1024;
#define TROW(t) (((t) < 2) ? (rowblk + 64 * (t)) : ((t) < 6) ? (ctxrow + 64 * ((t) - 2)) : (rowblk + ((((t) - 6) < nlo) ? (-128 + 64 * ((t) - 6)) : (128 + 64 * ((t) - 6 - nlo)))))
#define TKB(t) (((t) < 6) ? 0 : ((((t) - 6) < nlo) ? (-128 + 64 * ((t) - 6)) : (128 + 64 * ((t) - 6 - nlo))))
#define DMA_K(t, slot) glds16(Kc + TROW(t) * PITCH + klane, (unsigned)__builtin_amdgcn_readfirstlane(kdst + (slot)))
#define DMA_V(t, slot) glds16(Vc + TROW(t) * PITCH + vlane, (unsigned)__builtin_amdgcn_readfirstlane(vdst + (slot)))
    const int vb0 = (int)(lds0 + LDS_V) + ((lane >> 4) & 1) * 32 + (lane & 3) * 8 + (4 * hi + ((lane & 15) >> 2)) * 64;
    const char* Kbase = shm + LDS_K; bf16x8 kf[8];
    const lds_cptr shm3 = (lds_cptr)shm; const lds_cptr kp0 = shm3 + LDS_K + hi * 1024 + r32 * 16; const lds_cptr vp0 = shm3 + LDS_V + ((lane >> 4) & 1) * 32 + (lane & 3) * 8 + (4 * hi + ((lane & 15) >> 2)) * 64;
#define NXS(x) (((x) == (NSLOT - 1) * SLOTB) ? 0 : (x) + SLOTB)
    const int S0 = sb, S1 = NXS(S0), S2 = NXS(S1);
    if (!pre) { DMA_K(0, S0); DMA_V(0, S0); DMA_K(1, S1); }
    if (!pre) {
#pragma unroll
        for (int d0 = 0; d0 < 4; ++d0) qr[d0] = *reinterpret_cast<const bf16x8*>(&Qw[(long)r32 * PITCH + d0 * 16 + hi * 8]); }
    float mhat = 0.f, l_reg = 0.f; f32x16 o[2]; o[0] = f32x16{}; o[1] = f32x16{}; f32x16 negm = f32x16{}; asm volatile("" : "+v"(negm));
    const int qrel = (wid & 3) * QBLK + r32;
#define CMASK(P0, P1, t) do { int jb_ = (t) - (NT - 4); if (jb_ >= 0) bmask(P0, P1, TKB(t), qrel, hi); } while (0)
    bool resc = false;
#define START(P0, P1) do { const float rm = rowmax(P0, P1); resc = false; \
    { const float dl = rm; mhat = fadd_s(mhat, dl); \
      _Pragma("unroll") for (int r = 0; r < 16; ++r) { P0[r] = fsub_s(P0[r], dl); P1[r] = fsub_s(P1[r], dl); } \
      _Pragma("unroll") for (int r = 0; r < 16; ++r) negm[r] = -mhat; asm volatile("" : "+v"(negm)); } \
    _Pragma("unroll") for (int r = 0; r < 16; ++r) P0[r] = __builtin_amdgcn_exp2f(P0[r]); } while (0)
#define RESC() do { if (resc) { asm volatile("s_waitcnt lgkmcnt(0)" ::: "memory"); \
      _Pragma("unroll") for (int d_ = 0; d_ < 2; ++d_) _Pragma("unroll") for (int r = 0; r < 16; ++r) o[d_][r] *= wsf[crow(r, hi)]; } } while (0)
    f32x16 pA0, pA1, pB0, pB1;
    int sl_prev = S0, sl_cur = S0, sl_next = S1;
#define ROT() do { sl_prev = sl_cur; sl_cur = sl_next; sl_next = (sl_next == (NSLOT - 1) * SLOTB) ? 0 : sl_next + SLOTB; } while (0)
    if (!pre) { DMA_K(2, S2); }
    WAIT_BAR(3);
    qkt(pA0, pA1, Kbase + S0, qr, negm, r32, hi); asm volatile("s_nop 15\n\ts_nop 7" : "+v"(pA0), "+v"(pA1));
    START(pA0, pA1);
    _Pragma("unroll") for (int r = 0; r < 16; ++r) pA1[r] = __builtin_amdgcn_exp2f(pA1[r]);
    WAIT_BAR(0);
    DMA_K(3, S0); DMA_V(1, S1);
    ROT();
    kload8(kf, kp0 + sl_cur);
    WAIT_BAR(2);
    s16x4 vlo[8], vhi[8]; u32x4 pw0, pw1, pw2, pw3;
#define PKW(P, B) cvtpk_s(P[B], P[B + 1])
#define PAF(k) __builtin_bit_cast(bf16x8, pw##k)
#define VFR(i) (bf16x8){vlo[i][0], vlo[i][1], vlo[i][2], vlo[i][3], vhi[i][0], vhi[i][1], vhi[i][2], vhi[i][3]}
#define PIN(x) asm volatile("" : "+v"(x))
#define MX3(a, b, c) __builtin_fmaxf(__builtin_fmaxf((a), (b)), (c))
#define GAPA(MF, A0, A1, A2, A3, W0, W1, PW) do { MF; sacc += A0; sacc += A1; sacc += A2; sacc += A3; PIN(sacc); W0; W1; PIN(PW); SBAR(); } while (0)
#define EX(v) __builtin_amdgcn_exp2f(v)
#define GAPB(MF, X, B) do { MF; X[B] = EX(X[B]); X[B + 1] = EX(X[B + 1]); X[B + 2] = EX(X[B + 2]); X[B + 3] = EX(X[B + 3]); PIN(X); SBAR(); } while (0)
#define VRD(i) do { vlo[i] = vtr(vp_ + (((i) >> 2) * 4096 + ((i) & 3) * 1024)); vhi[i] = vtr(vp_ + (((i) >> 2) * 4096 + ((i) & 3) * 1024 + 512)); } while (0)
#define KRD(G, j) do { if (G) { kload2(kf, kp0 + sl_next, j); SBAR(); } } while (0)
#define STEP(C0, C1, P0, P1, t, GK, GV, GL) do { SBAR(); \
    const lds_cptr vp_ = vp0 + sl_prev; \
    VRD(0); SBAR(); float sacc = (P0[0] + P0[1]); \
    GAPA(C0 = __builtin_amdgcn_mfma_f32_32x32x16_bf16(kf[0], qr[0], negm, 0, 0, 0), P0[2], P0[3], P0[4], P0[5],     pw0[0] = PKW(P0, 0), pw0[1] = PKW(P0, 2), pw0); \
    VRD(4); SBAR(); GAPA(C1 = __builtin_amdgcn_mfma_f32_32x32x16_bf16(kf[1], qr[0], negm, 0, 0, 0), P0[6], P0[7], P0[8], P0[9],     pw0[2] = PKW(P0, 4), pw0[3] = PKW(P0, 6), pw0); \
    VRD(1); SBAR(); GAPA(C0 = __builtin_amdgcn_mfma_f32_32x32x16_bf16(kf[2], qr[1], C0, 0, 0, 0),   P0[10], P0[11], P0[12], P0[13], pw1[0] = PKW(P0, 8), pw1[1] = PKW(P0, 10), pw1); \
    VRD(5); SBAR(); GAPA(C1 = __builtin_amdgcn_mfma_f32_32x32x16_bf16(kf[3], qr[1], C1, 0, 0, 0),   P0[14], P0[15], P1[0], P1[1],   pw1[2] = PKW(P0, 12), pw1[3] = PKW(P0, 14), pw1); \
    VRD(2); SBAR(); GAPA(C0 = __builtin_amdgcn_mfma_f32_32x32x16_bf16(kf[4], qr[2], C0, 0, 0, 0),   P1[2], P1[3], P1[4], P1[5],     pw2[0] = PKW(P1, 0), pw2[1] = PKW(P1, 2), pw2); \
    VRD(6); SBAR(); GAPA(C1 = __builtin_amdgcn_mfma_f32_32x32x16_bf16(kf[5], qr[2], C1, 0, 0, 0),   P1[6], P1[7], P1[8], P1[9],     pw2[2] = PKW(P1, 4), pw2[3] = PKW(P1, 6), pw2); \
    VRD(3); SBAR(); GAPA(C0 = __builtin_amdgcn_mfma_f32_32x32x16_bf16(kf[6], qr[3], C0, 0, 0, 0),   P1[10], P1[11], P1[12], P1[13], pw3[0] = PKW(P1, 8), pw3[1] = PKW(P1, 10), pw3); \
    VRD(7); SBAR(); GAPA(C1 = __builtin_amdgcn_mfma_f32_32x32x16_bf16(kf[7], qr[3], C1, 0, 0, 0),   P1[14], P1[15], 0.f, 0.f,       pw3[2] = PKW(P1, 12), pw3[3] = PKW(P1, 14), pw3); \
    l_reg += sacc; \
    if (GK) { DMA_K((t) + 3, sl_cur); } if (GV) { DMA_V((t) + 1, sl_next); } \
    CMASK(C0, C1, t); \
    { float a = MX3(C0[0], C0[1], C1[0]), b = MX3(C0[2], C0[3], C1[1]); a = MX3(a, C1[2], C1[3]); \
      _Pragma("unroll") for (int r = 4; r < 16; r += 4) { a = MX3(a, C0[r], C0[r + 1]); b = MX3(b, C0[r + 2], C0[r + 3]); a = MX3(a, C1[r], C1[r + 1]); b = MX3(b, C1[r + 2], C1[r + 3]); } \
      float rm = __builtin_fmaxf(a, b); { auto rr = __builtin_amdgcn_permlane32_swap(__float_as_uint(rm), __float_as_uint(rm), false, false); rm = __builtin_fmaxf(__uint_as_float(rr[0]), __uint_as_float(rr[1])); } \
      resc = false; \
      if (__builtin_expect(__any(rm > (float)THRL), 0)) { const float dl = __builtin_fmaxf(rm, 0.f); mhat += dl; \
        _Pragma("unroll") for (int r = 0; r < 16; ++r) { C0[r] -= dl; C1[r] -= dl; } \
        _Pragma("unroll") for (int r = 0; r < 16; ++r) negm[r] = -mhat; asm volatile("" : "+v"(negm)); \
        const float f = __builtin_amdgcn_exp2f(-dl); l_reg *= f; if (hi == 0) wsf[r32] = f; resc = true; } } \
    SBAR(); \
    GAPB(o[0] = __builtin_amdgcn_mfma_f32_32x32x16_bf16(PAF(0), VFR(0), o[0], 0, 0, 0), C0, 0); \
    GAPB(o[1] = __builtin_amdgcn_mfma_f32_32x32x16_bf16(PAF(0), VFR(4), o[1], 0, 0, 0), C0, 4); \
    KRD(GL, 0); GAPB(o[0] = __builtin_amdgcn_mfma_f32_32x32x16_bf16(PAF(1), VFR(1), o[0], 0, 0, 0), C0, 8); \
    KRD(GL, 1); GAPB(o[1] = __builtin_amdgcn_mfma_f32_32x32x16_bf16(PAF(1), VFR(5), o[1], 0, 0, 0), C0, 12); \
    KRD(GL, 2); GAPB(o[0] = __builtin_amdgcn_mfma_f32_32x32x16_bf16(PAF(2), VFR(2), o[0], 0, 0, 0), C1, 0); \
    KRD(GL, 3); GAPB(o[1] = __builtin_amdgcn_mfma_f32_32x32x16_bf16(PAF(2), VFR(6), o[1], 0, 0, 0), C1, 4); \
    GAPB(o[0] = __builtin_amdgcn_mfma_f32_32x32x16_bf16(PAF(3), VFR(3), o[0], 0, 0, 0), C1, 8); \
    GAPB(o[1] = __builtin_amdgcn_mfma_f32_32x32x16_bf16(PAF(3), VFR(7), o[1], 0, 0, 0), C1, 12); \
    } while (0)
    int t = 1;
#undef CMASK
#define CMASK(P0, P1, t) do { } while (0)
    for (; t + 5 < NT; t += 2) {
        STEP(pB0, pB1, pA0, pA1, t, true, true, true);     WAIT_BAR(2); RESC(); ROT();
        STEP(pA0, pA1, pB0, pB1, t + 1, true, true, true); WAIT_BAR(2); RESC(); ROT();
    }
#undef CMASK
#define CMASK(P0, P1, t) do { int jb_ = (t) - (NT - 4); if (jb_ >= 0) bmask(P0, P1, TKB(t), qrel, hi); } while (0)
#define ENDW(tt) do { if ((tt) + 3 < NT) { WAIT_BAR(2); } else if ((tt) + 2 < NT) { WAIT_BAR(1); } else { WAIT_BAR(0); } } while (0)
    for (; t + 1 < NT; t += 2) {
        STEP(pB0, pB1, pA0, pA1, t, (t + 3 < NT), (t + 1 < NT), (t + 1 < NT));     ENDW(t);     RESC(); ROT();
        STEP(pA0, pA1, pB0, pB1, t + 1, (t + 4 < NT), (t + 2 < NT), (t + 2 < NT)); ENDW(t + 1); RESC(); ROT();
    }
    if (has_next) {
        const long rowblkN = (long)nb2 * SEQ + nn2 * 128, ctxrowN = (long)NLAT + nb2 * LCTX; const bf16* KcN = QKV + 1024 + nhk2 * D; const bf16* VcN = QKV + 1280 + nhk2 * D;
        const int T0 = sl_next, T1 = NXS(T0), T2 = NXS(T1);
        glds16(KcN + rowblkN * PITCH + klane, (unsigned)__builtin_amdgcn_readfirstlane(kdst + T0));
        glds16(VcN + rowblkN * PITCH + vlane, (unsigned)__builtin_amdgcn_readfirstlane(vdst + T0));
        glds16(KcN + (rowblkN + 64) * PITCH + klane, (unsigned)__builtin_amdgcn_readfirstlane(kdst + T1));
        glds16(KcN + ctxrowN * PITCH + klane, (unsigned)__builtin_amdgcn_readfirstlane(kdst + T2));
    }
    STEP(pB0, pB1, pA0, pA1, NT - 1, false, false, false); RESC();
    if (has_next) {
        const bf16* QwN = QKV + ((long)nb2 * SEQ + nn2 * 128 + (wid & 3) * QBLK) * PITCH + (4 * nhk2 + 2 * npr2 + (wid >> 2)) * D;
#pragma unroll
        for (int d0 = 0; d0 < 4; ++d0) qr[d0] = *reinterpret_cast<const bf16x8*>(&QwN[(long)r32 * PITCH + d0 * 16 + hi * 8]); }
    { float sacc = pB0[0] + pB0[1]; _Pragma("unroll") for (int r = 2; r < 16; ++r) sacc += pB0[r]; _Pragma("unroll") for (int r = 0; r < 16; ++r) sacc += pB1[r]; l_reg += sacc;
      pw0 = (u32x4){PKW(pB0, 0), PKW(pB0, 2), PKW(pB0, 4), PKW(pB0, 6)}; pw1 = (u32x4){PKW(pB0, 8), PKW(pB0, 10), PKW(pB0, 12), PKW(pB0, 14)}; pw2 = (u32x4){PKW(pB1, 0), PKW(pB1, 2), PKW(pB1, 4), PKW(pB1, 6)}; pw3 = (u32x4){PKW(pB1, 8), PKW(pB1, 10), PKW(pB1, 12), PKW(pB1, 14)};
      SBAR(); pv(o, vb0 + sl_cur, PAF(0), PAF(1), PAF(2), PAF(3)); }
#undef PKW
#undef PAF
#undef VFR
#undef PIN
#undef MX3
#undef GAPA
#undef GAPB
#undef EX
#undef VRD
#undef KRD
#undef STEP
#undef ENDW
    { auto rr = __builtin_amdgcn_permlane32_swap(__float_as_uint(l_reg), __float_as_uint(l_reg), false, false); l_reg = __uint_as_float(rr[0]) + __uint_as_float(rr[1]); }
    l_reg += __builtin_amdgcn_exp2f(sinkp[head] * 1.4426950408889634f - mhat);
    if (hi == 0) wsf[32 + r32] = l_reg; asm volatile("s_waitcnt lgkmcnt(0)" ::: "memory");
    float rli[16];
#pragma unroll
    for (int r = 0; r < 16; ++r) rli[r] = __builtin_amdgcn_rcpf(wsf[32 + crow(r, hi)]);
    unsigned char* Ow = O + (rowblk + (wid & 3) * QBLK) * OPITCH + head * D;
    { bf16* stg = (bf16*)(shm + LDS_OST) + wid * 2048;
#pragma unroll
      for (int r = 0; r < 16; ++r) { const int orow = crow(r, hi);
#pragma unroll
        for (int d0 = 0; d0 < 2; ++d0) stg[orow * 64 + d0 * 32 + r32] = __float2bfloat16(o[d0][r] * rli[r]); }
      asm volatile("s_waitcnt lgkmcnt(0)" ::: "memory");
#pragma unroll
      for (int i = 0; i < 4; ++i) { const int row = i * 8 + (lane >> 3), ch = lane & 7; const u32x4 v = *(const u32x4*)(stg + row * 64 + ch * 8);
        u32x2 w; w.x = pk4f8(__uint_as_float(v.x << 16), __uint_as_float(v.x & 0xffff0000u), __uint_as_float(v.y << 16), __uint_as_float(v.y & 0xffff0000u));
        w.y = pk4f8(__uint_as_float(v.z << 16), __uint_as_float(v.z & 0xffff0000u), __uint_as_float(v.w << 16), __uint_as_float(v.w & 0xffff0000u));
        *(u32x2*)(Ow + (long)row * OPITCH + ch * 8) = w; } }
    asm volatile("s_waitcnt lgkmcnt(0)\n\ts_barrier" ::: "memory");
    return sl_next;
#undef NXS
#undef DMA_K
#undef DMA_V
#undef TROW
#undef TKB
#undef CMASK
#undef START
#undef RESC
#undef ROT
}
#undef SBAR
#undef WAIT_BAR
}

#define XB_TMO      128
#define XB_XCNT(j)  (256  + 64 * (j))
#define XB_XSUB(j)  (1280 + 64 * (j))
#define XB_XGEN(j)  (2304 + 64 * (j))
#define XB_TOP      3328
#define XB_TOPGEN   3392
#define XCD_BAR_WORDS 3456
#define XB_SPIN_CAP (1u << 18)
__device__ __forceinline__ unsigned xb_ld(unsigned* p)              { return __hip_atomic_load(p, __ATOMIC_RELAXED, __HIP_MEMORY_SCOPE_AGENT); }
__device__ __forceinline__ unsigned xb_add(unsigned* p, unsigned v) { return __hip_atomic_fetch_add(p, v, __ATOMIC_RELAXED, __HIP_MEMORY_SCOPE_AGENT); }
__device__ __forceinline__ unsigned xb_xcc_id() { return (unsigned)__builtin_amdgcn_s_getreg((3 << 11) | 20) & 0xFu; }
#define XB_SPIN(cond, bar) do { unsigned _sp = 0; while (cond) { __builtin_amdgcn_s_sleep(1); \
    if ((++_sp & 255u) == 0u) { if (xb_ld(&(bar)[XB_TMO])) break; if (_sp > XB_SPIN_CAP) { atomicAdd(&(bar)[XB_TMO], 1u); break; } } } } while (0)
struct XcdBarrier { unsigned* bar; unsigned x; volatile LAS unsigned* st; };
__device__ __forceinline__ XcdBarrier xcd_barrier_post(unsigned* bar, volatile LAS unsigned* st) {
    XcdBarrier b; b.bar = bar; b.x = xb_xcc_id(); b.st = st;
    if (threadIdx.x == 0) (void)xb_add(&bar[XB_XCNT(b.x)], 1u);
    return b;
}
__device__ __forceinline__ void xcd_barrier_complete(unsigned* bar, unsigned x, unsigned& nloc, unsigned& nx) {
    const unsigned G = gridDim.x * gridDim.y * gridDim.z;
    unsigned sum, cnt, mine, sp = 0u;
    for (;;) {
        sum = 0u; cnt = 0u; mine = 0u;
#pragma unroll
        for (unsigned j = 0; j < 16; ++j) { const unsigned c = xb_ld(&bar[XB_XCNT(j)]); sum += c; cnt += (c > 0u) ? 1u : 0u; mine = (j == x) ? c : mine; }
        if (sum == G) break;
        __builtin_amdgcn_s_sleep(1);
        if ((++sp & 255u) == 0u) { if (xb_ld(&bar[XB_TMO])) break; if (sp > XB_SPIN_CAP) { atomicAdd(&bar[XB_TMO], 1u); break; } }
    }
    nloc = mine > 0u ? mine : 1u; nx = cnt > 0u ? cnt : 1u;
}
__device__ __forceinline__ void xcd_barrier(const XcdBarrier& b) {
    asm volatile("s_waitcnt vmcnt(0)" ::: "memory");
    __syncthreads();
    if (threadIdx.x == 0) {
        unsigned* bar = b.bar;
        __builtin_amdgcn_s_waitcnt(0);
        unsigned nloc = b.st[0], nx = b.st[1];
        if (nloc == 0u) { xcd_barrier_complete(bar, b.x, nloc, nx); b.st[0] = nloc; b.st[1] = nx; }
        const unsigned old = xb_add(&bar[XB_XSUB(b.x)], 1u);
        const unsigned gen = old / nloc;
        if (old + 1u == (gen + 1u) * nloc) {
            __builtin_amdgcn_fence(__ATOMIC_RELEASE, "agent");
            asm volatile("s_waitcnt vmcnt(0)" ::: "memory");
            const unsigned og = xb_add(&bar[XB_TOP], 1u);
            const unsigned tg = og / nx;
            if (og + 1u == (tg + 1u) * nx) xb_add(&bar[XB_TOPGEN], 1u);
            else XB_SPIN(xb_ld(&bar[XB_TOPGEN]) == tg, bar);
            __builtin_amdgcn_fence(__ATOMIC_ACQUIRE, "agent");
            xb_add(&bar[XB_XGEN(b.x)], 1u);
            asm volatile("s_waitcnt vmcnt(0)" ::: "memory");
        } else {
            XB_SPIN(xb_ld(&bar[XB_XGEN(b.x)]) == gen, bar);
            __builtin_amdgcn_fence(__ATOMIC_ACQUIRE, "agent");
            asm volatile("s_waitcnt vmcnt(0)" ::: "memory");
        }
    }
    __syncthreads();
}

#define LDS_WAIT() asm volatile("s_waitcnt lgkmcnt(0)" ::: "memory")
__device__ __forceinline__ void transpose_item(const float* W, int K, int N, bf16_t* WT, int k0, int n0, int drow0, LAS float* scr, int lane) {
    float t[32];
#pragma unroll
    for (int i = 0; i < 32; ++i) t[i] = __builtin_nontemporal_load(W + (size_t)(k0 + 2 * i + (lane >> 5)) * N + n0 + (lane & 31));
#pragma unroll
    for (int i = 0; i < 32; ++i) scr[(2 * i + (lane >> 5)) * 33 + (lane & 31)] = t[i];
    LDS_WAIT(); asm volatile("" ::: "memory");
    const int c = lane & 7;
#pragma unroll
    for (int j = 0; j < 4; ++j) { const int n = (lane >> 3) + 8 * j; const LAS float* s = scr + (8 * c) * 33 + n;
        u32x4 o; o.x = pkbf(s[0 * 33], s[1 * 33]); o.y = pkbf(s[2 * 33], s[3 * 33]); o.z = pkbf(s[4 * 33], s[5 * 33]); o.w = pkbf(s[6 * 33], s[7 * 33]);
        *(GAS u32x4*)(WT + (size_t)(drow0 + n) * K + k0 + 8 * c) = o; }
    LDS_WAIT(); asm volatile("" ::: "memory");
}
__device__ __forceinline__ void transpose_item_f8(const float* W, int K, int N, unsigned char* WT, int k0, int n0, int drow0, float scale, LAS float* scr, int lane) {
    float t[32];
#pragma unroll
    for (int i = 0; i < 32; ++i) t[i] = __builtin_nontemporal_load(W + (size_t)(k0 + 2 * i + (lane >> 5)) * N + n0 + (lane & 31));
#pragma unroll
    for (int i = 0; i < 32; ++i) scr[(2 * i + (lane >> 5)) * 33 + (lane & 31)] = t[i];
    LDS_WAIT(); asm volatile("" ::: "memory");
    const int n = lane >> 1, hf = lane & 1; const LAS float* sp = scr + (32 * hf) * 33 + n;
    u32x4 o0, o1;
    o0.x = pk4f8(sp[0 * 33] * scale, sp[1 * 33] * scale, sp[2 * 33] * scale, sp[3 * 33] * scale);     o0.y = pk4f8(sp[4 * 33] * scale, sp[5 * 33] * scale, sp[6 * 33] * scale, sp[7 * 33] * scale);
    o0.z = pk4f8(sp[8 * 33] * scale, sp[9 * 33] * scale, sp[10 * 33] * scale, sp[11 * 33] * scale);   o0.w = pk4f8(sp[12 * 33] * scale, sp[13 * 33] * scale, sp[14 * 33] * scale, sp[15 * 33] * scale);
    o1.x = pk4f8(sp[16 * 33] * scale, sp[17 * 33] * scale, sp[18 * 33] * scale, sp[19 * 33] * scale); o1.y = pk4f8(sp[20 * 33] * scale, sp[21 * 33] * scale, sp[22 * 33] * scale, sp[23 * 33] * scale);
    o1.z = pk4f8(sp[24 * 33] * scale, sp[25 * 33] * scale, sp[26 * 33] * scale, sp[27 * 33] * scale); o1.w = pk4f8(sp[28 * 33] * scale, sp[29 * 33] * scale, sp[30 * 33] * scale, sp[31 * 33] * scale);
    GAS u32x4* dst = (GAS u32x4*)(WT + (size_t)(drow0 + n) * K + k0 + 32 * hf);
    dst[0] = o0; dst[1] = o1;
    LDS_WAIT(); asm volatile("" ::: "memory");
}
__device__ __forceinline__ void transpose_item_f6(const float* W, int K, int N, unsigned char* WT, int k0, int n0, int drow0, LAS float* scr, int lane) {
    float t[32];
#pragma unroll
    for (int i = 0; i < 32; ++i) t[i] = __builtin_nontemporal_load(W + (size_t)(k0 + 2 * i + (lane >> 5)) * N + n0 + (lane & 31));
#pragma unroll
    for (int i = 0; i < 32; ++i) scr[(2 * i + (lane >> 5)) * 33 + (lane & 31)] = t[i];
    LDS_WAIT(); asm volatile("" ::: "memory");
    const int n = lane >> 1, hf = lane & 1; const LAS float* sp = scr + (32 * hf) * 33 + n;
    float x[32];
#pragma unroll
    for (int i = 0; i < 32; ++i) x[i] = sp[i * 33];
    u32x4 c0, c1; mxfp6_block(x, c0, c1);
    const int kb32 = (k0 >> 5) + hf; unsigned char* dst = WT + (size_t)(drow0 + n) * K + (kb32 >> 2) * 128 + (kb32 & 3) * 16;
    *(GAS u32x4*)dst = c0; *(GAS u32x4*)(dst + 64) = c1;
    LDS_WAIT(); asm volatile("" ::: "memory");
}
__device__ __forceinline__ unsigned pk4i8(float a, float b, float c, float d) {
    const int ia = (int)__builtin_rintf(a), ib = (int)__builtin_rintf(b), ic = (int)__builtin_rintf(c), id = (int)__builtin_rintf(d);
    return (unsigned)(ia & 255) | ((unsigned)(ib & 255) << 8) | ((unsigned)(ic & 255) << 16) | ((unsigned)(id & 255) << 24); }
__device__ __forceinline__ void transpose_item_i8(const float* W, int K, int N, unsigned char* WT, int k0, int n0, int drow0, float scale, LAS float* scr, int lane) {
    float t[32];
#pragma unroll
    for (int i = 0; i < 32; ++i) t[i] = W[(size_t)(k0 + 2 * i + (lane >> 5)) * N + n0 + (lane & 31)];
#pragma unroll
    for (int i = 0; i < 32; ++i) scr[(2 * i + (lane >> 5)) * 33 + (lane & 31)] = t[i];
    LDS_WAIT(); asm volatile("" ::: "memory");
    const int n = lane >> 1, hf = lane & 1; const LAS float* sp = scr + (32 * hf) * 33 + n;
    u32x4 o0, o1;
    o0.x = pk4i8(sp[0 * 33] * scale, sp[1 * 33] * scale, sp[2 * 33] * scale, sp[3 * 33] * scale);     o0.y = pk4i8(sp[4 * 33] * scale, sp[5 * 33] * scale, sp[6 * 33] * scale, sp[7 * 33] * scale);
    o0.z = pk4i8(sp[8 * 33] * scale, sp[9 * 33] * scale, sp[10 * 33] * scale, sp[11 * 33] * scale);   o0.w = pk4i8(sp[12 * 33] * scale, sp[13 * 33] * scale, sp[14 * 33] * scale, sp[15 * 33] * scale);
    o1.x = pk4i8(sp[16 * 33] * scale, sp[17 * 33] * scale, sp[18 * 33] * scale, sp[19 * 33] * scale); o1.y = pk4i8(sp[20 * 33] * scale, sp[21 * 33] * scale, sp[22 * 33] * scale, sp[23 * 33] * scale);
    o1.z = pk4i8(sp[24 * 33] * scale, sp[25 * 33] * scale, sp[26 * 33] * scale, sp[27 * 33] * scale); o1.w = pk4i8(sp[28 * 33] * scale, sp[29 * 33] * scale, sp[30 * 33] * scale, sp[31 * 33] * scale);
    GAS u32x4* dst = (GAS u32x4*)(WT + (size_t)(drow0 + n) * K + k0 + 32 * hf);
    dst[0] = o0; dst[1] = o1;
    LDS_WAIT(); asm volatile("" ::: "memory");
}
__device__ __forceinline__ void sincos_d(double x, double& s, double& c) {
    const double TWO_PI = 6.283185307179586476925;
    const double k = __builtin_rint(x / TWO_PI); const double r = x - k * TWO_PI;
    const double r2 = r * r; double ts = r, tc = 1.0; s = r; c = 1.0;
    for (int i = 1; i <= 16; ++i) { tc *= -r2 / (double)((2 * i - 1) * (2 * i)); ts *= -r2 / (double)((2 * i) * (2 * i + 1)); c += tc; s += ts; }
}

constexpr int CI_F = 16 * 112, CI_FD = 56 * 32, MOE_ITEMS = 8 * (2 * CI_F + CI_FD);
constexpr int MOE_TAIL_A = 12000, MOE_TAIL_B = 7000, MOE_TAIL_C = 12000, MOE_TAIL_TOTAL = MOE_TAIL_A + MOE_TAIL_B + MOE_TAIL_C;
__device__ __forceinline__ void moe_convert_item(int r, const float* wg, const float* wu, const float* wd, unsigned char* mgu, unsigned char* md, LAS float* scr, int lane) {
    const int e = r / (2 * CI_F + CI_FD); int q = r % (2 * CI_F + CI_FD);
    if (q < 2 * CI_F) { const int up = q / CI_F; q %= CI_F; const int kb = q / 112, nb = q % 112, n0 = 32 * nb;
        transpose_item_f6((up ? wu : wg) + (size_t)e * 1024 * DFF, 1024, DFF, mgu + (size_t)e * 7168 * 1024, 64 * kb, n0, 256 * (n0 >> 7) + 128 * up + (n0 & 127), scr, lane); }
    else { q -= 2 * CI_F; const int kb = q / 32, nb = q % 32; transpose_item_f6(wd + (size_t)e * DFF * 1024, DFF, 1024, md + (size_t)e * 1024 * DFF, 64 * kb, 32 * nb, 32 * nb, scr, lane); }
}
__device__ __forceinline__ void moe_convert_tail(int nunits, int G, int bx, int first, int count, const float* wg, const float* wu, const float* wd, unsigned char* mgu, unsigned char* md, LAS unsigned char* lds) {
    const int busy = nunits % G; if (busy == 0 || bx < busy) return;
    int tid_ = threadIdx.x; asm volatile("" : "+v"(tid_)); const int lane = tid_ & 63, wave = __builtin_amdgcn_readfirstlane(tid_ >> 6);
    LAS float* scr = (LAS float*)(lds + wave * 16384);
    const int nw = (G - busy) * 8, w = (bx - busy) * 8 + wave;
    for (int it = w; it < count; it += nw) moe_convert_item(first + it, wg, wu, wd, mgu, md, scr, lane);
}

struct Args { const float* in[24]; float* out; unsigned char* ws; int ph_lo, ph_hi, li, pad; };
constexpr int NPH = 18;

__device__ __forceinline__ void norm_store(const f32x4 (&v)[4], float ssum, const float* g, const float* mrow, int shc, int scc, bf16_t* XNo, size_t m, int lane, float* rsc) {
    const float rstd = 1.0f / __builtin_sqrtf(ssum * (1.0f / DM) + EPS);
    f32x4 y[4];
#pragma unroll
    for (int j = 0; j < 4; ++j) { const f32x4 gv = *(const f32x4*)(g + 4 * lane + 256 * j), sc = *(const f32x4*)(mrow + scc * 1024 + 4 * lane + 256 * j), sh = *(const f32x4*)(mrow + shc * 1024 + 4 * lane + 256 * j);
        y[j] = (v[j] * rstd) * gv * (sc + 1.0f) + sh; }
    if (rsc == nullptr) {
#pragma unroll
        for (int j = 0; j < 4; ++j) { u32x2 w; w.x = pkbf(y[j].x, y[j].y); w.y = pkbf(y[j].z, y[j].w); *((GAS u32x2*)(XNo + m * DM) + lane + 64 * j) = w; }
    } else {
        float mx = 0.f;
#pragma unroll
        for (int j = 0; j < 4; ++j) mx = __builtin_fmaxf(__builtin_fmaxf(mx, __builtin_fmaxf(__builtin_fabsf(y[j].x), __builtin_fabsf(y[j].y))), __builtin_fmaxf(__builtin_fabsf(y[j].z), __builtin_fabsf(y[j].w)));
#pragma unroll
        for (int o = 1; o < 64; o <<= 1) mx = __builtin_fmaxf(mx, __shfl_xor(mx, o));
        mx = __builtin_fmaxf(mx, 1e-20f); const float qs = 127.0f / mx;
#pragma unroll
        for (int j = 0; j < 4; ++j) *((GAS unsigned*)((unsigned char*)XNo + m * DM) + lane + 64 * j) = pk4i8(y[j].x * qs, y[j].y * qs, y[j].z * qs, y[j].w * qs);
        if (lane == 0) rsc[m] = mx * (1.0f / 127.0f);
    }
}
template <bool SRC_BF16> __device__ __forceinline__ void norm_rows(const void* srcLv, const float* srcC, int nrows, const float* g, const float* mod, int shc, int scc, bf16_t* XNo, int gw, int NGW, int lane,
                                          const float* part, int nS, const float* gatec, float* zout, float* rsc = nullptr) {
    if (nrows > NLAT) {
        for (int rc = gw; rc < NCTXR; rc += NGW) {
            const GAS f32x4* xr = (const GAS f32x4*)(srcC + (size_t)rc * DM) + lane;
            f32x4 v[4];
#pragma unroll
            for (int j = 0; j < 4; ++j) v[j] = xr[64 * j];
            if (part != nullptr) {
                f32x4 a[4];
#pragma unroll
                for (int j = 0; j < 4; ++j) a[j] = (f32x4){0.f, 0.f, 0.f, 0.f};
                for (int s0 = 0; s0 < nS; s0 += 7) {
                    f32x4 t[7][4];
#pragma unroll
                    for (int q = 0; q < 7; ++q) { const int s2 = (s0 + q < nS) ? s0 + q : s0; const GAS f32x4* pr = (const GAS f32x4*)(part + ((size_t)s2 * NCTXR + rc) * DM) + lane;
#pragma unroll
                        for (int j = 0; j < 4; ++j) t[q][j] = pr[64 * j]; }
#pragma unroll
                    for (int q = 0; q < 7; ++q) if (s0 + q < nS) {
#pragma unroll
                        for (int j = 0; j < 4; ++j) a[j] += t[q][j]; }
                }
#pragma unroll
                for (int j = 0; j < 4; ++j) v[j] += *(const f32x4*)(gatec + 4 * lane + 256 * j) * a[j];
                if (zout != nullptr) { GAS f32x4* zr = (GAS f32x4*)(zout + (size_t)rc * DM) + lane;
#pragma unroll
                    for (int j = 0; j < 4; ++j) zr[64 * j] = v[j]; }
            }
            float ss = 0.f;
#pragma unroll
            for (int j = 0; j < 4; ++j) ss += (v[j].x * v[j].x + v[j].y * v[j].y) + (v[j].z * v[j].z + v[j].w * v[j].w);
            norm_store(v, wave_sum(ss), g, mod + (size_t)4 * 6144, shc, scc, XNo, (size_t)NLAT + rc, lane, rsc);
        }
    }
    const bool bal = (NGW == 2048) && (nrows > NLAT);
    for (int k = 0;; ++k) {
        int grp;
        if (bal) { if (k < 3) grp = gw + 2048 * k; else if (gw >= 1024 && k < 5) grp = 6144 + 2 * (gw - 1024) + (k - 3); else break; }
        else { grp = gw + k * NGW; if (grp >= NLAT / 4) break; }
        const int m0 = grp * 4;
        const int mb = m0 >> 13;
        f32x4 v[4][4];
        if constexpr (SRC_BF16) { const GAS u32x2* xr = (const GAS u32x2*)((const bf16_t*)srcLv + (size_t)m0 * DM) + lane;
#pragma unroll
            for (int r = 0; r < 4; ++r)
#pragma unroll
                for (int j = 0; j < 4; ++j) { const u32x2 w = xr[r * 256 + 64 * j]; v[r][j] = (f32x4){__uint_as_float(w.x << 16), __uint_as_float(w.x & 0xffff0000u), __uint_as_float(w.y << 16), __uint_as_float(w.y & 0xffff0000u)}; } }
        else { const GAS f32x4* xr = (const GAS f32x4*)((const float*)srcLv + (size_t)m0 * DM) + lane;
#pragma unroll
            for (int r = 0; r < 4; ++r)
#pragma unroll
                for (int j = 0; j < 4; ++j) v[r][j] = xr[r * 256 + 64 * j]; }
        float ss[4];
#pragma unroll
        for (int r = 0; r < 4; ++r) { ss[r] = 0.f;
#pragma unroll
            for (int j = 0; j < 4; ++j) ss[r] += (v[r][j].x * v[r][j].x + v[r][j].y * v[r][j].y) + (v[r][j].z * v[r][j].z + v[r][j].w * v[r][j].w); }
#pragma unroll
        for (int o = 1; o < 64; o <<= 1) {
#pragma unroll
            for (int r = 0; r < 4; ++r) ss[r] += __shfl_xor(ss[r], o); }
#pragma unroll
        for (int r = 0; r < 4; ++r) norm_store(v[r], ss[r], g, mod + (size_t)mb * 6144, shc, scc, XNo, (size_t)(m0 + r), lane, rsc);
    }
}

__global__ void __launch_bounds__(512, 2) fwd(Args args) {
    extern __shared__ __attribute__((aligned(16))) unsigned char lds_raw[];
    LAS unsigned char* lds = (LAS unsigned char*)lds_raw;
    volatile LAS unsigned* MISC = (volatile LAS unsigned*)(lds + MISC_OFF);
    LAS int* gtab = (LAS int*)(lds + GTAB_OFF);
    const int G = gridDim.x; const int bx = blockIdx.x; const int vcu = (G % 8 == 0) ? (bx % 8) * (G / 8) + bx / 8 : bx;
    const int NGW = G * 8;
#define PHASE_IDS() int tid_ = threadIdx.x; asm volatile("" : "+v"(tid_)); const int tid = tid_, lane = tid & 63, wave = __builtin_amdgcn_readfirstlane(tid >> 6), gw = vcu * 8 + wave; (void)lane; (void)gw
    unsigned char* ws = args.ws;
    gu32* ctl = (gu32*)(ws + WS_CTL);
#define MOD ((float*)(ws + WS_MOD))
#define ROPE ((float*)(ws + WS_ROPE))
#define STATS ((float*)(ws + WS_STATS))
#define RSC ((float*)(ws + WS_RSC))
#define LIST ((int*)(ws + WS_LIST))
#define TINFO ((int*)(ws + WS_TINFO))
#define WSB ((bf16_t*)(ws + WS_WS))
#define WIN ((unsigned char*)(ws + WS_WIN))
#define WAO ((bf16_t*)(ws + WS_WAO))
#define WQKV ((unsigned char*)(ws + WS_WQKV))
#define WBO ((unsigned char*)(ws + WS_WBO))
#define WGU ((unsigned char*)(ws + WS_WGU))
#define WD ((bf16_t*)(ws + WS_WD))
#define MGU ((unsigned char*)(ws + WS_MGU))
#define MD ((unsigned char*)(ws + WS_MD))
#define XN8 ((unsigned char*)(ws + WS_XN))
#define XN ((bf16_t*)(ws + WS_XN))
#define ZB ((float*)(ws + WS_ZB))
#define UVT ((bf16_t*)(ws + WS_UVT))
#define A2 ((bf16_t*)(ws + WS_A2))
#define HB ((bf16_t*)(ws + WS_H))
#define QKV ((bf16_t*)(ws + WS_QKV))
#define OB ((unsigned char*)(ws + WS_O))
#define YB ((bf16_t*)(ws + WS_Y))
#define HC ((unsigned char*)(ws + WS_HC))
#define YP ((bf16_t*)(ws + WS_YP))
#define PART1 ((float*)(ws + WS_PART1))
#define PART2 ((float*)(ws + WS_PART2))
#define I_X (args.in[0])
#define I_C (args.in[1])
#define I_CTX (args.in[2])
#define I_CCTX (args.in[3])
#define I_ADAW (args.in[4])
#define I_ADAB (args.in[5])
#define I_NORMG (args.in[6])
#define I_FINALG (args.in[7])
#define HL ((bf16_t*)(ws + WS_HLB))

    { PHASE_IDS(); for (int u = tid; u < (LDS_BYTES - MISC_OFF) / 4; u += 512) ((LAS unsigned*)(lds + MISC_OFF))[u] = 0u; }
    __syncthreads();
    const int lo = args.ph_lo, hi_ph = args.ph_hi;
    const bool one_launch = (hi_ph - lo) > 1;
    XcdBarrier bar; bar.bar = (unsigned*)(ctl + CW_BAR) + args.li * XCD_BAR_WORDS; bar.x = 0; bar.st = nullptr;
    if (one_launch) bar = xcd_barrier_post((unsigned*)(ctl + CW_BAR) + args.li * XCD_BAR_WORDS, MISC + 8);
#ifndef PHMASK
#define PHMASK 0xFFFFFFFFu
#endif
#define IN(k) (((PHMASK >> (k)) & 1) && lo <= (k) && (k) < hi_ph)
#define BOTH(k) (IN(k) && IN((k) + 1))
#define GRID_BAR() xcd_barrier(bar)
#if defined(PROBE_LO)
    unsigned long long tpA = __builtin_amdgcn_s_memrealtime(), tpB = 0;
#define PROBE_MARK(k) do { if ((k) == PROBE_LO - 1) tpA = __builtin_amdgcn_s_memrealtime(); if ((k) == PROBE_HI) tpB = __builtin_amdgcn_s_memrealtime(); } while (0)
#else
#define PROBE_MARK(k) do { } while (0)
#endif

    if (IN(0)) {
        PHASE_IDS();
        {
            LAS float* sv = (LAS float*)lds;
            LAS float* red = (LAS float*)(lds + 5 * 1024 * 4);
            if (bx < 192) {
                for (int idx = tid; idx < 5 * 1024; idx += 512) { const int r = idx >> 10, k = idx & 1023; const float cv = r < 4 ? I_C[r * 1024 + k] : I_CCTX[k]; sv[idx] = cv / (1.0f + __expf(-cv)); }
                __syncthreads();
                for (int item = bx; item < 192; item += G) {
                    const int i = item / 96, n0 = (item % 96) * 64, nn = tid & 63, kq = tid >> 6;
                    float a0 = 0.f, a1 = 0.f, a2 = 0.f, a3 = 0.f, a4 = 0.f;
                    const float* wp = I_ADAW + ((size_t)i * 1024 + kq * 128) * 6144 + n0 + nn;
#pragma unroll 8
                    for (int k = 0; k < 128; ++k) { const float w = wp[(size_t)k * 6144]; const int kk = kq * 128 + k;
                        a0 += sv[kk] * w; a1 += sv[1024 + kk] * w; a2 += sv[2048 + kk] * w; a3 += sv[3072 + kk] * w; a4 += sv[4096 + kk] * w; }
                    red[(kq * 5 + 0) * 64 + nn] = a0; red[(kq * 5 + 1) * 64 + nn] = a1; red[(kq * 5 + 2) * 64 + nn] = a2; red[(kq * 5 + 3) * 64 + nn] = a3; red[(kq * 5 + 4) * 64 + nn] = a4;
                    __syncthreads();
                    if (tid < 320) { const int r = tid >> 6; float s = I_ADAB[i * 6144 + n0 + nn];
#pragma unroll
                        for (int q = 0; q < 8; ++q) s += red[(q * 5 + r) * 64 + nn];
                        MOD[((size_t)i * 5 + r) * 6144 + n0 + nn] = s; }
                    __syncthreads();
                }
            }
            __syncthreads();
        }
        {
            LAS float* scr = (LAS float*)(lds + wave * 16384);
            constexpr int I_IN = 16 * 64, I_AO = 16 * 32, I_QKV = 16 * 48, I_BO = 16 * 32, I_F = 16 * 112, I_FD = 56 * 32;
            constexpr int I_DENSE = I_IN + I_AO + I_QKV + I_BO + 2 * I_F + I_FD, I_MOE = MOE_ITEMS, I_WS = 128, I_ROPE = 32;
            constexpr int NITEMS = I_DENSE + I_MOE + I_WS + I_ROPE;
            for (int it = gw; it < NITEMS; it += NGW) {
                int r = it;
                if (r < I_IN) { const int kb = r / 64, nb = r % 64; const float* W = args.in[8]; float mx = 0.f;
#pragma unroll
                    for (int i = 0; i < 32; ++i) mx = __builtin_fmaxf(mx, __builtin_fabsf(W[(size_t)(64 * kb + 2 * i + (lane >> 5)) * 2048 + 32 * nb + (lane & 31)]));
#pragma unroll
                    for (int o = 1; o < 64; o <<= 1) mx = __builtin_fmaxf(mx, __shfl_xor(mx, o));
                    if (lane == 0) __hip_atomic_fetch_max((unsigned*)(ctl + CW_WAMAX + 192), __float_as_uint(mx), __ATOMIC_RELAXED, __HIP_MEMORY_SCOPE_AGENT);
                    continue; } r -= I_IN;
                if (r < I_AO) { const int kb = r / 32, nb = r % 32; transpose_item(args.in[13], 1024, 1024, WAO, 64 * kb, 32 * nb, 32 * nb, scr, lane); continue; } r -= I_AO;
                if (r < I_QKV) { const int kb = r / 48, nb = r % 48; const float* W = args.in[14]; float mx = 0.f;
#pragma unroll
                    for (int i = 0; i < 32; ++i) mx = __builtin_fmaxf(mx, __builtin_fabsf(W[(size_t)(64 * kb + 2 * i + (lane >> 5)) * NQKV + 32 * nb + (lane & 31)]));
#pragma unroll
                    for (int o = 1; o < 64; o <<= 1) mx = __builtin_fmaxf(mx, __shfl_xor(mx, o));
                    if (lane == 0) __hip_atomic_fetch_max((unsigned*)(ctl + CW_WAMAX + 128), __float_as_uint(mx), __ATOMIC_RELAXED, __HIP_MEMORY_SCOPE_AGENT);
                    continue; } r -= I_QKV;
                if (r < I_BO) { const int kb = r / 32, nb = r % 32; transpose_item_f8(args.in[16], 1024, 1024, WBO, 64 * kb, 32 * nb, 32 * nb, MOE_SGU, scr, lane); continue; } r -= I_BO;
                if (r < 2 * I_F) { const int up = r / I_F; const int q = r % I_F; const int kb = q / 112, nb = q % 112;
                    const float* W = args.in[17 + up]; float mx = 0.f;
#pragma unroll
                    for (int i = 0; i < 32; ++i) mx = __builtin_fmaxf(mx, __builtin_fabsf(W[(size_t)(64 * kb + 2 * i + (lane >> 5)) * DFF + 32 * nb + (lane & 31)]));
#pragma unroll
                    for (int o = 1; o < 64; o <<= 1) mx = __builtin_fmaxf(mx, __shfl_xor(mx, o));
                    if (lane == 0) __hip_atomic_fetch_max((unsigned*)(ctl + CW_WAMAX + 64 * up), __float_as_uint(mx), __ATOMIC_RELAXED, __HIP_MEMORY_SCOPE_AGENT);
                    continue; } r -= 2 * I_F;
                if (r < I_FD) { const int kb = r / 32, nb = r % 32; transpose_item(args.in[19], DFF, 1024, WD, 64 * kb, 32 * nb, 32 * nb, scr, lane); continue; } r -= I_FD;
                if (r < I_MOE) { if (r >= MOE_TAIL_TOTAL) moe_convert_item(r, args.in[21], args.in[22], args.in[23], MGU, MD, scr, lane); continue; } r -= I_MOE;
                if (r < I_WS) { const float* src = args.in[11] + (size_t)r * 2048;
#pragma unroll
                    for (int j = 0; j < 8; ++j) { const f32x4 v = *(const f32x4*)(src + j * 256 + lane * 4); u32x2 w; w.x = pkbf(v.x, v.y); w.y = pkbf(v.z, v.w); *(u32x2*)(WSB + (size_t)r * 2048 + j * 256 + lane * 4) = w; }
                    continue; } r -= I_WS;
                {
                    const int ent = r * 64 + lane; const int pos = ent >> 4, i = ent & 15;
                    double inv = 1.0; for (int q = 0; q < i; ++q) inv *= 0.56234132519034908;
                    const float ang = (float)pos * (float)inv; double s, c; sincos_d((double)ang, s, c);
                    ROPE[ent] = (float)c; ROPE[2048 + ent] = (float)s;
                }
            }
        }
        if (BOTH(0)) GRID_BAR(); PROBE_MARK(0);
    }
    if (IN(1)) { PHASE_IDS();
        {
            LAS float* scr = (LAS float*)(lds + wave * 16384);
            const float ag = __uint_as_float(__hip_atomic_load((unsigned*)(ctl + CW_WAMAX), __ATOMIC_RELAXED, __HIP_MEMORY_SCOPE_AGENT)), au = __uint_as_float(__hip_atomic_load((unsigned*)(ctl + CW_WAMAX + 64), __ATOMIC_RELAXED, __HIP_MEMORY_SCOPE_AGENT));
            if (gw == 0 && lane == 0) { RSC[MALL] = ag * (1.0f / 127.0f); RSC[MALL + 1] = au * (1.0f / 127.0f); }
            const float ai_ = __uint_as_float(__hip_atomic_load((unsigned*)(ctl + CW_WAMAX + 192), __ATOMIC_RELAXED, __HIP_MEMORY_SCOPE_AGENT));
            if (gw == 0 && lane == 0) RSC[MALL + 3] = ai_ * (1.0f / 127.0f);
            for (int it = gw; it < 16 * 64; it += NGW) { const int kb = it / 64, nb = it % 64; transpose_item_i8(args.in[8], 1024, 2048, WIN, 64 * kb, 32 * nb, 32 * nb, 127.0f / ai_, scr, lane); }
            const float aq = __uint_as_float(__hip_atomic_load((unsigned*)(ctl + CW_WAMAX + 128), __ATOMIC_RELAXED, __HIP_MEMORY_SCOPE_AGENT));
            if (gw == 0 && lane == 0) RSC[MALL + 2] = aq * (1.0f / 127.0f);
            for (int it = gw; it < 16 * 48; it += NGW) { const int kb = it / 48, nb = it % 48; transpose_item_i8(args.in[14], 1024, NQKV, WQKV, 64 * kb, 32 * nb, 32 * nb, 127.0f / aq, scr, lane); }
            for (int it = gw; it < 2 * 16 * 112; it += NGW) { const int up = it / (16 * 112), q = it % (16 * 112), kb = q / 112, nb = q % 112, n0 = 32 * nb;
                transpose_item_i8(args.in[17 + up], 1024, DFF, WGU, 64 * kb, n0, 256 * (n0 >> 7) + 128 * up + (n0 & 127), 127.0f / (up ? au : ag), scr, lane); }
        }
        norm_rows<false>(I_X, I_CTX, MALL, I_NORMG + 0 * 1024, MOD, 0, 1, XN, gw, NGW, lane, nullptr, 0, nullptr, nullptr, RSC); if (BOTH(1)) GRID_BAR(); PROBE_MARK(1); }
    if (IN(2)) {
        pg8::DenseSched S{(const char*)WIN, (const char*)XN8, 8, NPA, G, bx, (size_t)256 * 1024};
        pg8::EpiGeluT E{UVT, STATS, RSC, RSC + MALL + 3};
        pg8::gemm_phase<pg8::EpiGeluT, pg8::DenseSched, true, false, false, true>(lds, gtab, 512, 8, S, E);
        moe_convert_tail(8 * NPA, G, bx, 0, MOE_TAIL_A, args.in[21], args.in[22], args.in[23], MGU, MD, lds);
        if (BOTH(2)) GRID_BAR(); PROBE_MARK(2);
    }
    if (IN(3)) {
        PHASE_IDS();
        const float* vg = args.in[9]; const float* vb = args.in[10]; const float* bs = args.in[12];
        LAS unsigned char* buf = lds + wave * 16384;
        LAS float* mu_l = (LAS float*)(lds + RING_BYTES + 4096 + wave * 1024); LAS float* rs_l = mu_l + 128;
        const int r32 = lane & 31, h = lane >> 5;
        for (int unit = gw; unit < (MALL / 128) * 32; unit += NGW) {
            const int ph = unit & 1, g = (unit >> 1) & 15, ch = unit >> 5, q0 = ch * 128;
#pragma unroll
            for (int tt = 0; tt < 2; ++tt) { const int tok = q0 + lane * 2 + tt; const f32x4* sp = (const f32x4*)(STATS + (size_t)tok * 16);
                const f32x4 a = sp[0], b = sp[1], c = sp[2], d = sp[3];
                const float sum = (a.x + a.z) + (b.x + b.z) + (c.x + c.z) + (d.x + d.z), sq = (a.y + a.w) + (b.y + b.w) + (c.y + c.w) + (d.y + d.w);
                const float mean = sum * (1.0f / 1024.0f), var = sq * (1.0f / 1024.0f) - mean * mean;
                mu_l[lane * 2 + tt] = mean; rs_l[lane * 2 + tt] = 1.0f / __builtin_sqrtf(var + EPS); }
            {
                u32x4 t[16]; const int rw = lane >> 4, ck = lane & 15;
                const bf16_t* vp = UVT + (size_t)(1024 + 64 * g + rw) * MALL + q0 + ck * 8;
#pragma unroll
                for (int i = 0; i < 16; ++i) { t[i] = *(const u32x4*)vp; vp += (size_t)4 * MALL; asm volatile("" : "+v"(vp)); }
#pragma unroll
                for (int i = 0; i < 16; ++i) { const int row = 4 * i + rw; *(LAS u32x4*)(buf + row * 256 + ((ck ^ (row & 15)) << 4)) = t[i]; }
            }
            bf16x8 af[2][8];
#pragma unroll
            for (int ct = 0; ct < 2; ++ct) { const int row = 32 * ct + r32; const float vgc = vg[64 * g + row], vbc = vb[64 * g + row];
#pragma unroll
                for (int s2 = 0; s2 < 8; ++s2) { const int qs = 16 * s2 + 8 * h, ck = 2 * s2 + h;
                    const f32x4 m0 = *(const LAS f32x4*)(mu_l + qs), m1 = *(const LAS f32x4*)(mu_l + qs + 4), r0 = *(const LAS f32x4*)(rs_l + qs), r1 = *(const LAS f32x4*)(rs_l + qs + 4);
                    const bf16x8 raw = *(const LAS bf16x8*)(buf + row * 256 + ((ck ^ (row & 15)) << 4));
                    float y[8];
#pragma unroll
                    for (int j = 0; j < 4; ++j) { y[j] = (bf2f((unsigned short)raw[j]) - m0[j]) * r0[j] * vgc + vbc; y[4 + j] = (bf2f((unsigned short)raw[4 + j]) - m1[j]) * r1[j] * vgc + vbc; }
                    u32x4 w; w.x = pkbf(y[0], y[1]); w.y = pkbf(y[2], y[3]); w.z = pkbf(y[4], y[5]); w.w = pkbf(y[6], y[7]); af[ct][s2] = __builtin_bit_cast(bf16x8, w); } }
            {
                u32x4 t[8]; const int rw = lane >> 3, ck = lane & 7;
                const bf16_t* up = UVT + (size_t)(64 * g + rw) * MALL + q0 + 64 * ph + ck * 8;
#pragma unroll
                for (int i = 0; i < 8; ++i) { t[i] = *(const u32x4*)up; up += (size_t)8 * MALL; asm volatile("" : "+v"(up)); }
#pragma unroll
                for (int i = 0; i < 8; ++i) { const int row = 8 * i + rw; *(LAS u32x4*)(buf + row * 128 + ((ck ^ (row & 7)) << 4)) = t[i]; }
            }
#pragma unroll
            for (int ptl = 0; ptl < 2; ++ptl) {
                const int pl = 32 * ptl + r32, p = 64 * ph + pl; const float bsv = bs[g * 128 + p];
                bf16x8 bfr[8];
#pragma unroll
                for (int s2 = 0; s2 < 8; ++s2) bfr[s2] = *(const bf16x8*)(WSB + (size_t)(g * 128 + p) * 128 + 16 * s2 + 8 * h);
                f32x16 acc[2]; acc[0] = f32x16{}; acc[1] = f32x16{};
#pragma unroll
                for (int s2 = 0; s2 < 8; ++s2)
#pragma unroll
                    for (int ct = 0; ct < 2; ++ct) acc[ct] = __builtin_amdgcn_mfma_f32_32x32x16_bf16(af[ct][s2], bfr[s2], acc[ct], 0, 0, 0);
#pragma unroll
                for (int ct = 0; ct < 2; ++ct)
#pragma unroll
                    for (int rr = 0; rr < 4; ++rr) { const int c = 32 * ct + 8 * rr + 4 * h; float o[4];
#pragma unroll
                        for (int e = 0; e < 4; ++e) { const int cc = c + e; const float uu = bf2f(*(const LAS unsigned short*)(buf + cc * 128 + (((pl >> 3) ^ (cc & 7)) << 4) + (pl & 7) * 2)); o[e] = uu * (acc[ct][4 * rr + e] + bsv); }
                        u32x2 w; w.x = pkbf(o[0], o[1]); w.y = pkbf(o[2], o[3]);
                        *(LAS u32x2*)(buf + 8192 + pl * 128 + (((c >> 3) ^ (pl & 7)) << 4) + (c & 7) * 2) = w; }
            }
            {
                const int rw = lane >> 3, ck = lane & 7;
#pragma unroll
                for (int i = 0; i < 8; ++i) { const int row = 8 * i + rw; const u32x4 v = *(const LAS u32x4*)(buf + 8192 + row * 128 + ((ck ^ (row & 7)) << 4));
                    *(u32x4*)(A2 + (size_t)(q0 + 64 * ph + row) * DM + 64 * g + ck * 8) = v; }
            }
        }
        if (BOTH(3)) GRID_BAR(); PROBE_MARK(3);
    }
    if (IN(4)) {
        { pg8::DenseSched S{(const char*)A2, (const char*)WAO, NPL, 4, G, bx, (size_t)256 * 1024 * 2};
          pg8::EpiResid<true> E{I_X, nullptr, HL, MOD + 2 * 1024, 1.0f};
          pg8::gemm_phase<pg8::EpiResid<true>, pg8::DenseSched, true, false>(lds, gtab, 1024, 16, S, E); }
        { pg8::SplitSched S{(const char*)(A2 + (size_t)NLAT * DM), (const char*)WAO, 4, 4, P3_NS, G, bx, NPL, (size_t)256 * 1024 * 2, (size_t)(1024 / P3_NS) * 2};
          pg8::EpiPartF32 E{PART1, (size_t)NCTXR * DM};
          pg8::gemm_phase<pg8::EpiPartF32, pg8::SplitSched, true, false>(lds, gtab, 1024, 1024 / P3_NS / 64, S, E); }
        if (BOTH(4)) GRID_BAR(); PROBE_MARK(4);
    }
    if (IN(5)) { PHASE_IDS(); norm_rows<true>(HL, I_CTX, MALL, I_NORMG + 1 * 1024, MOD, 3, 4, XN, gw, NGW, lane, PART1, P3_NS, MOD + 4 * 6144 + 2 * 1024, ZB, RSC); if (BOTH(5)) GRID_BAR(); PROBE_MARK(5); }
    if (IN(6)) {
        pg8::DenseSched S{(const char*)XN8, (const char*)WGU, NPA, 28, G, bx, (size_t)256 * 1024};
        pg8::EpiSwiGLUI8 E{HB, RSC, RSC + MALL};
        pg8::gemm_phase<pg8::EpiSwiGLUI8, pg8::DenseSched, true, false, false, true>(lds, gtab, 512, 8, S, E);
        moe_convert_tail(NPA * 28, G, bx, MOE_TAIL_A, MOE_TAIL_B, args.in[21], args.in[22], args.in[23], MGU, MD, lds);
        if (BOTH(6)) GRID_BAR(); PROBE_MARK(6);
    }
    if (IN(7)) {
        { pg8::DenseSched S{(const char*)HB, (const char*)WD, NPL, 4, G, bx, (size_t)256 * DFF * 2};
          pg8::EpiResid<false> E{nullptr, HL, HL, MOD + 5 * 1024, 1.0f};
          pg8::gemm_phase<pg8::EpiResid<false>, pg8::DenseSched, true, false>(lds, gtab, DFF, 56, S, E); }
        { pg8::SplitSched S{(const char*)(HB + (size_t)NLAT * DFF), (const char*)WD, 4, 4, P5_NS, G, bx, NPL, (size_t)256 * DFF * 2, (size_t)(DFF / P5_NS) * 2};
          pg8::EpiPartF32 E{PART2, (size_t)NCTXR * DM};
          pg8::gemm_phase<pg8::EpiPartF32, pg8::SplitSched, true, false>(lds, gtab, DFF, DFF / P5_NS / 64, S, E); }
        if (BOTH(7)) GRID_BAR(); PROBE_MARK(7);
    }
    if (IN(8)) { PHASE_IDS(); norm_rows<true>(HL, ZB, MALL, I_NORMG + 2 * 1024, MOD + 5 * 6144, 0, 1, XN, gw, NGW, lane, PART2, P5_NS, MOD + 4 * 6144 + 5 * 1024, nullptr, RSC); if (BOTH(8)) GRID_BAR(); PROBE_MARK(8); }
    if (IN(9)) {
        { PHASE_IDS(); LAS float* colt = (LAS float*)(lds + ROPC_OFF);
          *(LAS f32x4*)(colt + 4 * tid) = *(const f32x4*)(ROPE + (tid < 256 ? 0 : 2048 - 1024) + 4 * tid); __syncthreads(); }
        pg8::DenseSched S{(const char*)XN8, (const char*)WQKV, NPA, 6, G, bx, (size_t)256 * 1024};
        pg8::EpiQKV E{QKV, ROPE, attn_body::C2, RSC, RSC + MALL + 2, (const LAS float*)(lds + ROPC_OFF)};
        pg8::gemm_phase<pg8::EpiQKV, pg8::DenseSched, true, false, false, true>(lds, gtab, 512, 8, S, E);
        moe_convert_tail(NPA * 6, G, bx, MOE_TAIL_A + MOE_TAIL_B, MOE_TAIL_C, args.in[21], args.in[22], args.in[23], MGU, MD, lds);
        if (BOTH(9)) GRID_BAR(); PROBE_MARK(9);
    }
    if (IN(10)) {
        static_assert(attn_body::LDS_BYTES_A <= RING_BYTES, "attention LDS");
        const float* sinkp = args.in[15];
        int sb = 0; bool pre = false; bf16x8 qfr[4];
#pragma unroll
        for (int d0 = 0; d0 < 4; ++d0) qfr[d0] = bf16x8{};
        for (int i = 0;; ++i) { const int uid = i * G + vcu; if (uid >= NB * 64 * 4 * 2) break;
            const int pr = uid & 1, hk = (uid >> 1) & 3, n = (uid >> 3) & 63, b = uid >> 9;
            const int uid2 = uid + G; const bool has_next = uid2 < NB * 64 * 4 * 2;
            sb = attn_body::attn_unit<8>(b, hk, n, pr, (const attn_body::bf16*)QKV, OB, sinkp, (char*)lds_raw, sb, pre, has_next, uid2 >> 9, (uid2 >> 1) & 3, (uid2 >> 3) & 63, uid2 & 1, qfr);
            pre = has_next; }
        if (BOTH(10)) GRID_BAR(); PROBE_MARK(10);
    }
    if (IN(11)) {
        pg8::DenseSched S{(const char*)OB, (const char*)WBO, NPL, 4, G, bx, (size_t)256 * 1024};
        pg8::EpiResid<false> E{nullptr, HL, HL, MOD + 5 * 6144 + 2 * 1024, 1.0f / MOE_SGU};
        pg8::gemm_phase<pg8::EpiResid<false>, pg8::DenseSched, true, false, true>(lds, gtab, 512, 8, S, E);
        if (BOTH(11)) GRID_BAR(); PROBE_MARK(11);
    }
    if (IN(12)) {
        PHASE_IDS();
        const float* g = I_NORMG + 3 * 1024; const float* mod = MOD + 5 * 6144; const float* wrt = args.in[20];
        LAS int* l_e = (LAS int*)lds;
        LAS float* l_w = (LAS float*)(lds + 1024);
        LAS int* l_cnt = (LAS int*)(lds + 2048);
        LAS int* l_base = (LAS int*)(lds + 2048 + 64);
        LAS unsigned char* rowb = lds + 8192 + wave * 9216;
        for (int blk = bx; blk < NLAT / 128; blk += G) {
            if (tid < 8) l_cnt[tid] = 0;
            __syncthreads();
            const int mb = (blk * 128) >> 13; const float* mrow = mod + (size_t)mb * 6144;
            for (int i4 = 0; i4 < 8; ++i4) {
                const int tl0 = wave * 16 + i4 * 2, m0 = blk * 128 + tl0;
                const GAS u32x2* xr = (const GAS u32x2*)(HL + (size_t)m0 * DM) + lane;
                f32x4 v[2][4]; float ss[2];
#pragma unroll
                for (int r = 0; r < 2; ++r)
#pragma unroll
                    for (int j = 0; j < 4; ++j) { const u32x2 w = xr[r * 256 + 64 * j]; v[r][j] = (f32x4){__uint_as_float(w.x << 16), __uint_as_float(w.x & 0xffff0000u), __uint_as_float(w.y << 16), __uint_as_float(w.y & 0xffff0000u)}; }
#pragma unroll
                for (int r = 0; r < 2; ++r) { ss[r] = 0.f;
#pragma unroll
                    for (int j = 0; j < 4; ++j) ss[r] += (v[r][j].x * v[r][j].x + v[r][j].y * v[r][j].y) + (v[r][j].z * v[r][j].z + v[r][j].w * v[r][j].w); }
#pragma unroll
                for (int o = 1; o < 64; o <<= 1) {
#pragma unroll
                    for (int r = 0; r < 2; ++r) ss[r] += __shfl_xor(ss[r], o); }
                float lg[2][8];
#pragma unroll
                for (int r = 0; r < 2; ++r)
#pragma unroll
                    for (int e = 0; e < 8; ++e) lg[r][e] = 0.f;
#pragma unroll
                for (int j = 0; j < 4; ++j) { const int col = 4 * lane + 256 * j; const f32x4 gv = *(const f32x4*)(g + col), sc = *(const f32x4*)(mrow + 4 * 1024 + col), sh = *(const f32x4*)(mrow + 3 * 1024 + col);
                    const f32x4 gm = gv * (sc + 1.0f);
                    f32x4 y[2];
#pragma unroll
                    for (int r = 0; r < 2; ++r) { const float rstd = 1.0f / __builtin_sqrtf(ss[r] * (1.0f / DM) + EPS); y[r] = (v[r][j] * rstd) * gm + sh;
                        *(LAS f32x4*)(rowb + r * 4608 + (8 * j + (lane >> 3)) * 144 + (lane & 7) * 16) = y[r]; }
#pragma unroll
                    for (int cc = 0; cc < 4; ++cc) { const f32x4 w0 = *(const f32x4*)(wrt + (size_t)(col + cc) * 8), w1 = *(const f32x4*)(wrt + (size_t)(col + cc) * 8 + 4);
#pragma unroll
                        for (int r = 0; r < 2; ++r) { const float yv = y[r][cc];
                            lg[r][0] += yv * w0.x; lg[r][1] += yv * w0.y; lg[r][2] += yv * w0.z; lg[r][3] += yv * w0.w; lg[r][4] += yv * w1.x; lg[r][5] += yv * w1.y; lg[r][6] += yv * w1.z; lg[r][7] += yv * w1.w; } } }
                {
                    const int rr = lane >> 5, bb = lane & 31; const LAS f32x4* bp = (const LAS f32x4*)(rowb + rr * 4608 + bb * 144);
                    float xb[32];
#pragma unroll
                    for (int q = 0; q < 8; ++q) { const f32x4 v4 = bp[q]; xb[4 * q] = v4.x; xb[4 * q + 1] = v4.y; xb[4 * q + 2] = v4.z; xb[4 * q + 3] = v4.w; }
                    u32x4 c0, c1; mxfp6_block(xb, c0, c1);
                    unsigned char* dst = XN8 + (size_t)(m0 + rr) * DM + (bb >> 2) * 128 + (bb & 3) * 16;
                    *(GAS u32x4*)dst = c0; *(GAS u32x4*)(dst + 64) = c1;
                }
#pragma unroll
                for (int o = 1; o < 64; o <<= 1) {
#pragma unroll
                    for (int r = 0; r < 2; ++r)
#pragma unroll
                        for (int e = 0; e < 8; ++e) lg[r][e] += __shfl_xor(lg[r][e], o); }
#pragma unroll
                for (int r = 0; r < 2; ++r) {
                    int ea = 0; float va = lg[r][0];
#pragma unroll
                    for (int e = 1; e < 8; ++e) if (lg[r][e] > va) { va = lg[r][e]; ea = e; }
                    int eb = -1; float vb2 = -INFINITY;
#pragma unroll
                    for (int e = 0; e < 8; ++e) if (e != ea && lg[r][e] > vb2) { vb2 = lg[r][e]; eb = e; }
                    const float wb = 1.0f / (1.0f + __expf(va - vb2)), wa = 1.0f - wb;
                    if (lane == 0) { const int tl = tl0 + r; l_e[tl * 2] = ea; l_e[tl * 2 + 1] = eb; l_w[tl * 2] = wa; l_w[tl * 2 + 1] = wb; } }
            }
            __syncthreads();
            int ea = 0, eb = 0, pa = 0, pb = 0;
            if (tid < 128) { ea = l_e[tid * 2]; eb = l_e[tid * 2 + 1]; pa = atomicAdd((int*)&l_cnt[ea], 1); pb = atomicAdd((int*)&l_cnt[eb], 1); }
            __syncthreads();
            if (tid < 8) l_base[tid] = (int)__hip_atomic_fetch_add((unsigned*)(ctl + CW_CNT + 64 * tid), (unsigned)l_cnt[tid], __ATOMIC_RELAXED, __HIP_MEMORY_SCOPE_AGENT);
            __syncthreads();
            if (tid < 128) { const int m = blk * 128 + tid; pa += l_base[ea]; pb += l_base[eb];
                LIST[(size_t)ea * NLAT + pa] = m; LIST[(size_t)eb * NLAT + pb] = m;
                int* ti = TINFO + (size_t)m * 8; ti[0] = ea; ti[1] = pa; ti[2] = eb; ti[3] = pb; ti[4] = __float_as_int(l_w[tid * 2]); ti[5] = __float_as_int(l_w[tid * 2 + 1]); }
            __syncthreads();
        }
        if (BOTH(12)) GRID_BAR(); PROBE_MARK(12);
    }
    if (hi_ph > 13 && lo < 17) {
        PHASE_IDS();
        LAS int* mtab = (LAS int*)(lds + MOE_OFF);
        if (tid == 0) { int run = 0, R = 0;
            for (int e = 0; e < 8; ++e) { const int ce = (int)__hip_atomic_load((unsigned*)(ctl + CW_CNT + 64 * e), __ATOMIC_RELAXED, __HIP_MEMORY_SCOPE_AGENT); mtab[e] = run; mtab[16 + e] = ce; run += ce >> 8; if (ce & 255) { mtab[24 + R] = e; ++R; } }
            mtab[8] = run; mtab[32] = R; }
        __syncthreads();
        const int nfull = __builtin_amdgcn_readfirstlane(mtab[8]);
        for (int c = 0; c < MOE_NCH; ++c) {
            const int gp0 = c * MOE_CH, gp1 = nfull < (c + 1) * MOE_CH ? nfull : (c + 1) * MOE_CH;
            if (IN(13 + 2 * c)) {
                { pg8::MoeSched S; S.A = (const char*)XN8; S.B = (const char*)MGU; S.list = LIST; S.tab = mtab; S.mode = 0; S.nS = 1; S.kbytes = 0; S.omoff = 0;
                  S.gp0 = gp0; S.gp1 = gp1; S.nN = 28; S.G = G; S.c = bx; S.bexp = (size_t)7168 * 1024; S.btile = (size_t)256 * 1024; S.astep = 0; S.gather = true;
                  pg8::EpiSwiGLU6 E{HC};
                  pg8::gemm_phase<pg8::EpiSwiGLU6, pg8::MoeSched, true, true, false, false, true>(lds, gtab, 512, 8, S, E); }
                if (c == 0) { pg8::MoeSched S; S.A = (const char*)XN8; S.B = (const char*)MGU; S.list = LIST; S.tab = mtab; S.mode = 1; S.nS = 1; S.kbytes = 0; S.omoff = MOE_CH;
                  S.gp0 = 0; S.gp1 = 0; S.nN = 28; S.G = G; S.c = bx; S.bexp = (size_t)7168 * 1024; S.btile = (size_t)256 * 1024; S.astep = 0; S.gather = true;
                  pg8::EpiSwiGLU6 E{HC};
                  pg8::gemm_phase<pg8::EpiSwiGLU6, pg8::MoeSched, true, true, false, false, true>(lds, gtab, 512, 8, S, E); }
                if (BOTH(13 + 2 * c)) GRID_BAR(); PROBE_MARK(13 + 2 * c);
            }
            if (IN(14 + 2 * c)) {
                { pg8::MoeSched S; S.A = (const char*)HC; S.B = (const char*)MD; S.list = LIST; S.tab = mtab; S.mode = 0; S.nS = 1; S.kbytes = 0; S.omoff = 0;
                  S.gp0 = gp0; S.gp1 = gp1; S.nN = 4; S.G = G; S.c = bx; S.bexp = (size_t)1024 * DFF; S.btile = (size_t)256 * DFF; S.astep = (size_t)256 * DFF; S.gather = false;
                  pg8::EpiBf16Plain E{YB, DM, 1.0f};
                  pg8::gemm_phase<pg8::EpiBf16Plain, pg8::MoeSched, true, false, false, false, true>(lds, gtab, DFF / 2, 28, S, E); }
                if (c == 0) { pg8::MoeSched S; S.A = (const char*)(HC + (size_t)MOE_CH * 256 * DFF); S.B = (const char*)MD; S.list = LIST; S.tab = mtab; S.mode = 2; S.nS = MOE_RS; S.kbytes = (size_t)(DFF / MOE_RS); S.omoff = 0;
                  S.gp0 = 0; S.gp1 = 0; S.nN = 4; S.G = G; S.c = bx; S.bexp = (size_t)1024 * DFF; S.btile = (size_t)256 * DFF; S.astep = (size_t)256 * DFF; S.gather = false;
                  pg8::EpiPartBf16 E{YP, (size_t)8 * 256 * DM, 1.0f};
                  pg8::gemm_phase<pg8::EpiPartBf16, pg8::MoeSched, true, false, false, false, true>(lds, gtab, DFF / 2, DFF / MOE_RS / 128, S, E); }
                if (BOTH(14 + 2 * c)) GRID_BAR(); PROBE_MARK(14 + 2 * c);
            }
        }
    }
    if (IN(17)) {
        PHASE_IDS();
        LAS int* l_pb = (LAS int*)(lds + wave * 128);
        if (lane == 0) { int run = 0, R = 0;
            for (int e = 0; e < 8; ++e) { const int ce = (int)__hip_atomic_load((unsigned*)(ctl + CW_CNT + 64 * e), __ATOMIC_RELAXED, __HIP_MEMORY_SCOPE_AGENT); l_pb[e] = run; l_pb[8 + e] = ce >> 8; l_pb[16 + e] = R; run += ce >> 8; if (ce & 255) ++R; } }
        const float* g2 = MOD + 5 * 6144 + 5 * 1024;
        for (int m0 = gw * 2; m0 < NLAT; m0 += NGW * 2) {
            const int mb = m0 >> 13;
            f32x4 hv[2][4], ya[2][4], yb[2][4]; float wa[2], wb[2];
#pragma unroll
            for (int r = 0; r < 2; ++r) {
                const int m = m0 + r; const int* ti = TINFO + (size_t)m * 8;
                const int ea = ti[0], pa = ti[1], eb = ti[2], pb = ti[3]; wa[r] = __int_as_float(ti[4]); wb[r] = __int_as_float(ti[5]);
                const bool ma = (pa >> 8) < l_pb[8 + ea], mbm = (pb >> 8) < l_pb[8 + eb];
                const size_t sa = ma ? (size_t)(l_pb[ea] + (pa >> 8)) * 256 + (pa & 255) : (size_t)l_pb[16 + ea] * 256 + (pa & 255);
                const size_t sb = mbm ? (size_t)(l_pb[eb] + (pb >> 8)) * 256 + (pb & 255) : (size_t)l_pb[16 + eb] * 256 + (pb & 255);
                const GAS u32x2* xr = (const GAS u32x2*)(HL + (size_t)m * DM) + lane;
#pragma unroll
                for (int j = 0; j < 4; ++j) { const u32x2 w = xr[64 * j]; hv[r][j] = (f32x4){__uint_as_float(w.x << 16), __uint_as_float(w.x & 0xffff0000u), __uint_as_float(w.y << 16), __uint_as_float(w.y & 0xffff0000u)}; }
                { const GAS u32x2* yr = (const GAS u32x2*)((ma ? YB : YP) + sa * DM) + lane;
#pragma unroll
                  for (int j = 0; j < 4; ++j) { const u32x2 a = yr[64 * j]; ya[r][j] = (f32x4){__uint_as_float(a.x << 16), __uint_as_float(a.x & 0xffff0000u), __uint_as_float(a.y << 16), __uint_as_float(a.y & 0xffff0000u)}; }
                  if (!ma) for (int s2 = 1; s2 < MOE_RS; ++s2) { const GAS u32x2* y2 = (const GAS u32x2*)(YP + ((size_t)s2 * 8 * 256 + sa) * DM) + lane;
#pragma unroll
                      for (int j = 0; j < 4; ++j) { const u32x2 a = y2[64 * j]; ya[r][j] += (f32x4){__uint_as_float(a.x << 16), __uint_as_float(a.x & 0xffff0000u), __uint_as_float(a.y << 16), __uint_as_float(a.y & 0xffff0000u)}; } } }
                { const GAS u32x2* yr = (const GAS u32x2*)((mbm ? YB : YP) + sb * DM) + lane;
#pragma unroll
                  for (int j = 0; j < 4; ++j) { const u32x2 a = yr[64 * j]; yb[r][j] = (f32x4){__uint_as_float(a.x << 16), __uint_as_float(a.x & 0xffff0000u), __uint_as_float(a.y << 16), __uint_as_float(a.y & 0xffff0000u)}; }
                  if (!mbm) for (int s2 = 1; s2 < MOE_RS; ++s2) { const GAS u32x2* y2 = (const GAS u32x2*)(YP + ((size_t)s2 * 8 * 256 + sb) * DM) + lane;
#pragma unroll
                      for (int j = 0; j < 4; ++j) { const u32x2 a = y2[64 * j]; yb[r][j] += (f32x4){__uint_as_float(a.x << 16), __uint_as_float(a.x & 0xffff0000u), __uint_as_float(a.y << 16), __uint_as_float(a.y & 0xffff0000u)}; } } }
            }
            float ss[2];
#pragma unroll
            for (int r = 0; r < 2; ++r) { ss[r] = 0.f;
#pragma unroll
                for (int j = 0; j < 4; ++j) { const f32x4 gv = *(const f32x4*)(g2 + (size_t)mb * 6144 + 4 * lane + 256 * j);
                    hv[r][j] = hv[r][j] + gv * (ya[r][j] * wa[r] + yb[r][j] * wb[r]); ss[r] += (hv[r][j].x * hv[r][j].x + hv[r][j].y * hv[r][j].y) + (hv[r][j].z * hv[r][j].z + hv[r][j].w * hv[r][j].w); } }
#pragma unroll
            for (int o = 1; o < 64; o <<= 1) {
#pragma unroll
                for (int r = 0; r < 2; ++r) ss[r] += __shfl_xor(ss[r], o); }
#pragma unroll
            for (int r = 0; r < 2; ++r) { const float rstd = 1.0f / __builtin_sqrtf(ss[r] * (1.0f / DM) + EPS);
                GAS f32x4* orow = (GAS f32x4*)(args.out + (size_t)(m0 + r) * DM) + lane;
#pragma unroll
                for (int j = 0; j < 4; ++j) { const f32x4 fg = *(const f32x4*)(I_FINALG + 4 * lane + 256 * j); __builtin_nontemporal_store((hv[r][j] * rstd) * fg, orow + 64 * j); } }
        }
    }
    PROBE_MARK(17);
#if defined(PROBE_LO)
    { PHASE_IDS(); const float T = (float)(tpB - tpA) * 0.01f; const float cval = __builtin_sqrtf(T / (float)(PROBE_UNIT));
      for (int m = gw; m < NLAT; m += NGW) { GAS f32x4* orow = (GAS f32x4*)(args.out + (size_t)m * DM) + lane;
#pragma unroll
        for (int j = 0; j < 4; ++j) orow[64 * j] = (f32x4){cval, cval, cval, cval}; } }
#endif
#undef IN
#undef BOTH
#undef GRID_BAR
}

#ifndef MK_ONE_LAUNCH
#define MK_ONE_LAUNCH 1
#endif
extern "C" void kernel_launch(void* const* d_in, const int* in_sizes, int n_in, void* d_out, int out_size, void* d_ws, size_t ws_size, hipStream_t stream) {
    static int grid = 0;
    if (grid == 0) {
        if (n_in != 24 || out_size != NLAT * DM || ws_size < WS_END) { fprintf(stderr, "kernel_launch: unexpected problem (n_in %d, out %d, ws %zu < %zu)\n", n_in, out_size, ws_size, (size_t)WS_END); grid = -1; return; }
        int dev = 0, cus = 0, per_cu = 0;
        if (hipGetDevice(&dev) != hipSuccess || hipDeviceGetAttribute(&cus, hipDeviceAttributeMultiprocessorCount, dev) != hipSuccess) { grid = -1; return; }
        if (hipFuncSetAttribute((const void*)fwd, hipFuncAttributeMaxDynamicSharedMemorySize, LDS_BYTES) != hipSuccess) { fprintf(stderr, "kernel_launch: hipFuncSetAttribute failed\n"); grid = -1; return; }
        if (hipOccupancyMaxActiveBlocksPerMultiprocessor(&per_cu, (const void*)fwd, 512, LDS_BYTES) != hipSuccess || per_cu < 1) fprintf(stderr, "kernel_launch: occupancy query says %d\n", per_cu);
        (void)hipGetLastError();
        grid = cus;
    }
    if (grid < 0) return;
    if (hipMemsetAsync((char*)d_ws + WS_CTL, 0, CTL_ZERO_BYTES, stream) != hipSuccess) return;
    Args a{};
    for (int i = 0; i < 24; ++i) a.in[i] = (const float*)d_in[i];
    a.out = (float*)d_out; a.ws = (unsigned char*)d_ws;
#if defined(SPLITAT)
    a.ph_lo = 0; a.ph_hi = SPLITAT; a.li = 0;
    hipLaunchKernelGGL(fwd, dim3(grid), dim3(512), LDS_BYTES, stream, a);
    a.ph_lo = SPLITAT; a.ph_hi = NPH; a.li = 1;
    hipLaunchKernelGGL(fwd, dim3(grid), dim3(512), LDS_BYTES, stream, a);
#elif defined(DUPK)
    a.ph_lo = 0; a.ph_hi = DUPK + 1; a.li = 0;
    hipLaunchKernelGGL(fwd, dim3(grid), dim3(512), LDS_BYTES, stream, a);
#ifdef DUPN
    for (int rep = 0; rep < DUPN; ++rep) { a.ph_lo = DUPK; a.ph_hi = DUPK + 1; a.li = 2; hipLaunchKernelGGL(fwd, dim3(grid), dim3(512), LDS_BYTES, stream, a); }
#endif
    a.ph_lo = DUPK; a.ph_hi = NPH; a.li = 1;
    hipLaunchKernelGGL(fwd, dim3(grid), dim3(512), LDS_BYTES, stream, a);
#elif MK_ONE_LAUNCH
    a.ph_lo = 0; a.ph_hi = NPH;
    hipLaunchKernelGGL(fwd, dim3(grid), dim3(512), LDS_BYTES, stream, a);
#else
    for (int p = 0; p < NPH; ++p) { a.ph_lo = p; a.ph_hi = p + 1; hipLaunchKernelGGL(fwd, dim3(grid), dim3(512), LDS_BYTES, stream, a); }
#endif
}
```

```cpp
#include <hip/hip_runtime.h>
#include <hip/hip_bf16.h>
#include <cstdio>
#include <cstdint>
#include <cmath>

__device__ __forceinline__ int tid_of(int wave_s) { int l; asm volatile("v_mbcnt_lo_u32_b32 %0, -1, 0\n\tv_mbcnt_hi_u32_b32 %0, -1, %0" : "=v"(l)); return wave_s * 64 + l; }
constexpr int DM = 1024, NB = 4, SEQ = 8192, LCTX = 256, NLAT = NB * SEQ, NCTXR = NB * LCTX, MALL = NLAT + NCTXR;
constexpr int DFF = 3584, NEXP = 8, NQKV = 1536;
constexpr int NPL = NLAT / 256, NPA = MALL / 256;
constexpr float EPS = 1e-6f;
constexpr int MOE_CH = 128, MOE_NCH = 2;
constexpr float MOE_SGU = 32.0f, MOE_SD = 64.0f;
constexpr int MOE_RS = 7, P3_NS = 8, P5_NS = 14;

#define LAS __attribute__((address_space(3)))
#define GAS __attribute__((address_space(1)))
typedef unsigned short bf16_t;
typedef short bf16x8 __attribute__((ext_vector_type(8)));
typedef float f32x4 __attribute__((ext_vector_type(4)));
typedef float f32x2 __attribute__((ext_vector_type(2)));
typedef float f32x16 __attribute__((ext_vector_type(16)));
typedef unsigned u32x4 __attribute__((ext_vector_type(4)));
typedef unsigned u32x2 __attribute__((ext_vector_type(2)));
typedef __bf16 bf16x2_t __attribute__((ext_vector_type(2)));
typedef GAS unsigned gu32;

__device__ __forceinline__ unsigned pkbf(float lo, float hi) { f32x2 v = {lo, hi}; bf16x2_t b = __builtin_convertvector(v, bf16x2_t); return __builtin_bit_cast(unsigned, b); }
__device__ __forceinline__ unsigned pk4f8(float a, float b, float c, float d) { unsigned w = 0; w = __builtin_amdgcn_cvt_pk_fp8_f32(a, b, w, false); w = __builtin_amdgcn_cvt_pk_fp8_f32(c, d, w, true); return w; }
typedef float f32x16v __attribute__((ext_vector_type(16)));
typedef unsigned u32x6 __attribute__((ext_vector_type(6)));
__device__ __forceinline__ void mxfp6_block(const float (&x)[32], u32x4& c0, u32x4& c1) {
    float mx = 0.f;
#pragma unroll
    for (int i = 0; i < 32; ++i) mx = __builtin_fmaxf(mx, __builtin_fabsf(x[i]));
    int eb = (int)((__float_as_uint(mx) >> 23) & 255u) - 2; eb = eb < 1 ? 1 : eb;
    const float sc = __uint_as_float((unsigned)eb << 23);
    f32x16v a, b;
#pragma unroll
    for (int i = 0; i < 16; ++i) { a[i] = x[i]; b[i] = x[16 + i]; }
    const u32x6 p = __builtin_amdgcn_cvt_scalef32_2xpk16_fp6_f32(a, b, sc);
    c0 = (u32x4){p[0], p[1], p[2], p[3]}; c1 = (u32x4){p[4], p[5], (unsigned)eb, 0u};
}
__device__ __forceinline__ float bf2f(unsigned short h) { return __builtin_bit_cast(float, (unsigned)h << 16); }
template <int CTRL> __device__ __forceinline__ float dpp_mov(float v) { return __int_as_float(__builtin_amdgcn_update_dpp(0, __float_as_int(v), CTRL, 0xf, 0xf, true)); }
__device__ __forceinline__ float wave_allsum(float x) {
    x += dpp_mov<0xB1>(x); x += dpp_mov<0x4E>(x); x += dpp_mov<0x141>(x); x += dpp_mov<0x140>(x);
    { const u32x2 r = __builtin_amdgcn_permlane16_swap(__float_as_uint(x), __float_as_uint(x), false, false); x = __uint_as_float(r[0]) + __uint_as_float(r[1]); }
    { const u32x2 r = __builtin_amdgcn_permlane32_swap(__float_as_uint(x), __float_as_uint(x), false, false); x = __uint_as_float(r[0]) + __uint_as_float(r[1]); }
    return x; }
__device__ __forceinline__ float wave_allmax(float x) {
    x = __builtin_fmaxf(x, dpp_mov<0xB1>(x)); x = __builtin_fmaxf(x, dpp_mov<0x4E>(x)); x = __builtin_fmaxf(x, dpp_mov<0x141>(x)); x = __builtin_fmaxf(x, dpp_mov<0x140>(x));
    { const u32x2 r = __builtin_amdgcn_permlane16_swap(__float_as_uint(x), __float_as_uint(x), false, false); x = __builtin_fmaxf(__uint_as_float(r[0]), __uint_as_float(r[1])); }
    { const u32x2 r = __builtin_amdgcn_permlane32_swap(__float_as_uint(x), __float_as_uint(x), false, false); x = __builtin_fmaxf(__uint_as_float(r[0]), __uint_as_float(r[1])); }
    return x; }
__device__ __forceinline__ float wave_sum(float v) { return wave_allsum(v); }
__device__ __forceinline__ float gelu_tanh(float x) {
    const float t = x * (1.0f + 0.044715f * x * x);
    const float e = __builtin_amdgcn_exp2f(-2.302208198f * t);
    return x * __builtin_amdgcn_rcpf(1.0f + e);
}
__device__ __forceinline__ f32x2 gelu_tanh_pk(f32x2 x) {
    f32x2 xc; xc.x = __builtin_fminf(__builtin_fmaxf(x.x, -4.0f), 4.0f); xc.y = __builtin_fminf(__builtin_fmaxf(x.y, -4.0f), 4.0f);
    const f32x2 t = xc * xc;
    f32x2 a = t * (-1.722785075e-09f) + 1.318496625e-07f;
    a = a * t + (-4.396793778e-06f); a = a * t + 8.516542868e-05f; a = a * t + (-1.085376085e-03f); a = a * t + 9.819232370e-03f; a = a * t + (-6.640538584e-02f); a = a * t + 3.988107710e-01f;
    return x * (a * xc + 0.5f);
}
#define GELU4_STEP(c) do { a0 = a0 * t0 + (c); a1 = a1 * t1 + (c); a2 = a2 * t2 + (c); a3 = a3 * t3 + (c); __builtin_amdgcn_sched_barrier(0); } while (0)
__device__ __forceinline__ void gelu_tanh_pk4(f32x2& p0, f32x2& p1, f32x2& p2, f32x2& p3) {
    f32x2 c0, c1, c2, c3;
    c0.x = __builtin_fminf(__builtin_fmaxf(p0.x, -4.0f), 4.0f); c0.y = __builtin_fminf(__builtin_fmaxf(p0.y, -4.0f), 4.0f); c1.x = __builtin_fminf(__builtin_fmaxf(p1.x, -4.0f), 4.0f); c1.y = __builtin_fminf(__builtin_fmaxf(p1.y, -4.0f), 4.0f);
    c2.x = __builtin_fminf(__builtin_fmaxf(p2.x, -4.0f), 4.0f); c2.y = __builtin_fminf(__builtin_fmaxf(p2.y, -4.0f), 4.0f); c3.x = __builtin_fminf(__builtin_fmaxf(p3.x, -4.0f), 4.0f); c3.y = __builtin_fminf(__builtin_fmaxf(p3.y, -4.0f), 4.0f);
    const f32x2 t0 = c0 * c0, t1 = c1 * c1, t2 = c2 * c2, t3 = c3 * c3;
    __builtin_amdgcn_sched_barrier(0);
    f32x2 a0 = t0 * (-1.722785075e-09f) + 1.318496625e-07f, a1 = t1 * (-1.722785075e-09f) + 1.318496625e-07f, a2 = t2 * (-1.722785075e-09f) + 1.318496625e-07f, a3 = t3 * (-1.722785075e-09f) + 1.318496625e-07f;
    __builtin_amdgcn_sched_barrier(0);
    GELU4_STEP(-4.396793778e-06f); GELU4_STEP(8.516542868e-05f); GELU4_STEP(-1.085376085e-03f); GELU4_STEP(9.819232370e-03f); GELU4_STEP(-6.640538584e-02f); GELU4_STEP(3.988107710e-01f);
    a0 = a0 * c0 + 0.5f; a1 = a1 * c1 + 0.5f; a2 = a2 * c2 + 0.5f; a3 = a3 * c3 + 0.5f;
    __builtin_amdgcn_sched_barrier(0);
    p0 = p0 * a0; p1 = p1 * a1; p2 = p2 * a2; p3 = p3 * a3;
    __builtin_amdgcn_sched_barrier(0);
}
#undef GELU4_STEP
__device__ __forceinline__ f32x2 swiglu_pk(f32x2 g, f32x2 u) {
    const f32x2 t = g * (f32x2){-1.4426950409f, -1.4426950409f};
    f32x2 d; d.x = __builtin_amdgcn_exp2f(t.x); d.y = __builtin_amdgcn_exp2f(t.y);
    d = d + (f32x2){1.0f, 1.0f};
    f32x2 r; r.x = __builtin_amdgcn_rcpf(d.x); r.y = __builtin_amdgcn_rcpf(d.y);
    return (g * u) * r;
}
__device__ __forceinline__ float silu_f(float x) { return x * __builtin_amdgcn_rcpf(1.0f + __builtin_amdgcn_exp2f(-1.4426950409f * x)); }

constexpr size_t MiB = 1u << 20;
constexpr size_t WS_CTL = 0, CTL_ZERO_BYTES = 1 * MiB;
constexpr size_t WS_MOD = 1 * MiB;
constexpr size_t WS_ROPE = 1 * MiB + 256 * 1024;
constexpr size_t WS_STATS = 2 * MiB;
constexpr size_t WS_RSC = 4 * MiB + 512 * 1024;
constexpr size_t WS_LIST = 5 * MiB;
constexpr size_t WS_TINFO = 6 * MiB;
constexpr size_t WS_WS = 7 * MiB;
constexpr size_t WS_WIN = 8 * MiB, WS_WAO = 12 * MiB, WS_WQKV = 14 * MiB, WS_WBO = 17 * MiB, WS_WGU = 19 * MiB, WS_WD = 33 * MiB;
constexpr size_t WS_MGU = 40 * MiB, WS_MD = 96 * MiB;
constexpr size_t WS_HLB = 124 * MiB;
constexpr size_t WS_XN = 208 * MiB;
constexpr size_t WS_ZB = 274 * MiB;
constexpr size_t WS_R = 278 * MiB;
constexpr size_t WS_UVT = WS_R, WS_A2 = WS_R + 132 * MiB, WS_PART1 = WS_R + 198 * MiB, WS_H = WS_R, WS_PART2 = WS_R + 231 * MiB;
constexpr size_t WS_QKV = WS_R, WS_O = WS_R + 99 * MiB;
constexpr size_t WS_Y = WS_R, WS_YP = WS_R + 128 * MiB, WS_HC = WS_R + 156 * MiB;
constexpr size_t WS_END = WS_R + 287 * MiB;
static_assert(WS_UVT + (size_t)2048 * MALL * 2 <= WS_A2 && WS_A2 + (size_t)MALL * DM * 2 <= WS_PART1 && WS_PART1 + (size_t)P3_NS * NCTXR * DM * 4 <= WS_END, "layer-0 mixer map");
static_assert(WS_H + (size_t)MALL * DFF * 2 <= WS_PART2 && WS_PART2 + (size_t)P5_NS * NCTXR * DM * 4 <= WS_END && WS_QKV + (size_t)MALL * NQKV * 2 <= WS_O && WS_O + (size_t)NLAT * DM * 2 <= WS_END, "region map");
static_assert(WS_Y + (size_t)256 * 256 * DM * 2 <= WS_YP && WS_YP + (size_t)MOE_RS * 8 * 256 * DM * 2 <= WS_HC && WS_HC + (size_t)(MOE_CH + 8) * 256 * DFF <= WS_END, "MoE map");
static_assert(WS_MD + (size_t)8 * DM * DFF <= WS_HLB && WS_HLB + (size_t)NLAT * DM * 2 <= WS_XN && WS_XN + (size_t)MALL * DM * 2 <= WS_ZB && WS_MD + (size_t)8 * DM * DFF <= WS_XN && WS_MGU + (size_t)8 * 7168 * DM <= WS_MD, "weights map");
constexpr int CW_TMO = 0, CW_CODE = 1;
constexpr int CW_CNT = 64;
constexpr int CW_WAMAX = 1024;
constexpr int CW_BAR = 4096;

constexpr int RING_BYTES = 131072;
constexpr int GTAB_OFF = RING_BYTES;
constexpr int MOE_OFF = RING_BYTES + 1024;
constexpr int MISC_OFF = RING_BYTES + 2048;
constexpr int STAB_OFF = RING_BYTES + 3072, STAB_STRIDE = 1536;
constexpr int ROPC_OFF = RING_BYTES + 6144;
constexpr int LDS_BYTES = 147456;

namespace pg8 {
constexpr int BM = 256, BK = 64, HALF = 128, HTB = HALF * BK * 2, STAGE_BYTES = 8 * HTB, NXCD = 8, WGM = 4;
__host__ __device__ __forceinline__ int lds_byte(int r, int c) { const int st = (r >> 4) * 2 + (c >> 5), rr = r & 15, cc = c & 31, ob = rr * 64 + cc * 2; return st * 1024 + (ob ^ (((ob >> 9) & 1) << 5)); }
__host__ __device__ __forceinline__ void stage_rc(int b, int& R, int& C) { const int st = b / 1024, sb = b % 1024, swz = sb ^ (((sb >> 9) & 1) << 5); R = (st >> 1) * 16 + swz / 64; C = (st & 1) * 32 + (swz % 64) / 2; }
__host__ __device__ __forceinline__ int perm32(int rho) { const int n = rho >> 4, i = rho & 15; return 8 * (i >> 2) + 4 * n + (i & 3); }

struct Unit { const char* a; const char* b; const int* gl; int pm, pn, om, nv, ks; };

__device__ __forceinline__ bool tile_order(int i, int G, int c, int nM, int nN, int& pm, int& pn) {
    const int nwg = nM * nN; const long L = (long)i * G + c; if (L >= nwg) return false;
    int wgid = (int)L; { const int q = nwg / NXCD, r = nwg % NXCD, xcd = wgid % NXCD, off = wgid / NXCD; wgid = (xcd < r ? xcd * (q + 1) : r * (q + 1) + (xcd - r) * q) + off; }
    const int nig = WGM * nN, gid = wgid / nig, fm = gid * WGM, gsz = (nM - fm) < WGM ? (nM - fm) : WGM;
    pm = fm + ((wgid % nig) % gsz); pn = (wgid % nig) / gsz; return true;
}
struct DenseSched {
    const char* A; const char* B; int nM, nN, G, c; size_t tstep;
    __device__ __forceinline__ bool next(int i, Unit& u) const {
        int pm, pn; if (!tile_order(i, G, c, nM, nN, pm, pn)) return false;
        u.a = A + (size_t)pm * tstep; u.b = B + (size_t)pn * tstep; u.gl = nullptr; u.pm = pm; u.pn = pn; u.om = pm; u.nv = 256; u.ks = 0; return true;
    }
};
typedef int v8i_t __attribute__((ext_vector_type(8)));
typedef int v4i_t __attribute__((ext_vector_type(4)));
__device__ __forceinline__ v8i_t cat8(bf16x8 lo, bf16x8 hi) { const v4i_t a = __builtin_bit_cast(v4i_t, lo), b = __builtin_bit_cast(v4i_t, hi); return __builtin_shufflevector(a, b, 0, 1, 2, 3, 4, 5, 6, 7); }
struct SplitSched {
    const char* A; const char* B; int nM, nN, nS, G, c, pm0; size_t tstep, kbytes;
    __device__ __forceinline__ bool next(int i, Unit& u) const {
        const int L = i * G + c; if (L >= nM * nN * nS) return false;
        const int ks = L % nS, t = L / nS, pn = t % nN, pm = t / nN;
        u.a = A + (size_t)pm * tstep + (size_t)ks * kbytes; u.b = B + (size_t)pn * tstep + (size_t)ks * kbytes; u.gl = nullptr; u.pm = pm0 + pm; u.pn = pn; u.om = pm; u.nv = 256; u.ks = ks; return true;
    }
};
struct MoeSched {
    const char* A; const char* B; const int* list; const LAS int* tab; int gp0, gp1, nN, nS, G, c, mode, omoff; size_t bexp, btile, astep, kbytes; bool gather;
    __device__ __forceinline__ bool next(int i, Unit& u) const {
        int pm, pn, ks = 0;
        if (mode == 0) { if (gp1 <= gp0) return false; if (!tile_order(i, G, c, gp1 - gp0, nN, pm, pn)) return false; }
        else { const int R = __builtin_amdgcn_readfirstlane(tab[32]); const int L = i * G + c; if (L >= R * nN * nS) return false; ks = L % nS; const int t = L / nS; pn = t % nN; pm = t / nN; }
        int e = 0, lp, nv;
        if (mode == 0) { const int gp = gp0 + pm;
#pragma unroll
            for (int k = 1; k < 8; ++k) e += (gp >= __builtin_amdgcn_readfirstlane(tab[k])) ? 1 : 0;
            e = __builtin_amdgcn_readfirstlane(e);
            lp = gp - __builtin_amdgcn_readfirstlane(tab[e]); nv = 256; u.pm = gp; }
        else { e = __builtin_amdgcn_readfirstlane(tab[24 + pm]); const int ce = __builtin_amdgcn_readfirstlane(tab[16 + e]); lp = ce >> 8; nv = ce & 255; u.pm = pm; }
        u.b = B + (size_t)e * bexp + (size_t)pn * btile + (size_t)ks * kbytes; u.pn = pn; u.nv = nv; u.ks = ks; u.om = pm;
        if (gather) { u.a = A; u.gl = list + (size_t)e * NLAT + 256 * lp; u.om = pm + omoff; }
        else { u.a = A + (size_t)pm * astep + (size_t)ks * kbytes; u.gl = nullptr; if (mode == 0) u.om = gp0 + pm; }
        return true;
    }
};

struct EpiGeluT {
    static constexpr bool PERM = true, ROWSCALE = true, AUXTAB = false;
    __device__ __forceinline__ const float* scale_src(const Unit& u) const { return cscale + u.pn * BM; }
    bf16_t* O; float* stats; const float* cscale; float wq;
    __device__ __forceinline__ void operator()(const f32x4 (&acc)[2][2][4][2], const Unit& u, int wr, int wc, int fr, int fq, const LAS float* tab) const {
        const int row0 = u.pm * BM + wr * 64 + fr, col0 = u.pn * BM + wc * 32 + 8 * fq;
        const bool isv = u.pm >= 4;
        f32x4 csv[2][2];
#pragma unroll
        for (int bj = 0; bj < 2; ++bj)
#pragma unroll
            for (int n = 0; n < 2; ++n) csv[bj][n] = *(const LAS f32x4*)(tab + wc * 32 + 8 * fq + bj * HALF + 4 * n) * wq;
        float s1[2][2][4], s2[2][2][4];
#pragma unroll
        for (int bj = 0; bj < 2; ++bj)
#pragma unroll
            for (int n = 0; n < 2; ++n)
#pragma unroll
                for (int e = 0; e < 4; ++e) { s1[bj][n][e] = 0.f; s2[bj][n][e] = 0.f; }
#pragma unroll
        for (int ai = 0; ai < 2; ++ai)
#pragma unroll
            for (int m = 0; m < 4; ++m) { bf16_t* rowp = O + (size_t)(row0 + ai * HALF + m * 16) * MALL + col0;
#pragma unroll
                for (int bj = 0; bj < 2; ++bj) { const v4i_t i0 = __builtin_bit_cast(v4i_t, acc[ai][bj][m][0]), i1 = __builtin_bit_cast(v4i_t, acc[ai][bj][m][1]);
                    f32x4 v0 = (f32x4){(float)i0[0], (float)i0[1], (float)i0[2], (float)i0[3]} * csv[bj][0], v1 = (f32x4){(float)i1[0], (float)i1[1], (float)i1[2], (float)i1[3]} * csv[bj][1];
                    { f32x2 a0 = {v0[0], v0[1]}, a1 = {v0[2], v0[3]}, b0 = {v1[0], v1[1]}, b1 = {v1[2], v1[3]}; gelu_tanh_pk4(a0, a1, b0, b1);
                      v0 = (f32x4){a0.x, a0.y, a1.x, a1.y}; v1 = (f32x4){b0.x, b0.y, b1.x, b1.y}; }
#pragma unroll
                    for (int e = 0; e < 4; ++e) { s1[bj][0][e] += v0[e]; s2[bj][0][e] += v0[e] * v0[e]; s1[bj][1][e] += v1[e]; s2[bj][1][e] += v1[e] * v1[e]; }
                    u32x4 w; w.x = pkbf(v0[0], v0[1]); w.y = pkbf(v0[2], v0[3]); w.z = pkbf(v1[0], v1[1]); w.w = pkbf(v1[2], v1[3]);
                    *(u32x4*)(rowp + bj * HALF) = w; } }
        if (isv) {
            const int slot = (u.pm - 4) * 2 + wr;
#pragma unroll
            for (int bj = 0; bj < 2; ++bj)
#pragma unroll
                for (int n = 0; n < 2; ++n)
#pragma unroll
                    for (int e = 0; e < 4; ++e) { float a = s1[bj][n][e], b = s2[bj][n][e];
                        a += dpp_mov<0xB1>(a); b += dpp_mov<0xB1>(b); a += dpp_mov<0x4E>(a); b += dpp_mov<0x4E>(b); a += dpp_mov<0x141>(a); b += dpp_mov<0x141>(b); a += dpp_mov<0x140>(a); b += dpp_mov<0x140>(b);
                        if (fr == 0) { const int tok = col0 + bj * HALF + 4 * n + e; *(f32x2*)(stats + (size_t)tok * 16 + slot * 2) = (f32x2){a, b}; } }
        }
    }
};
template <bool BASE_F32> struct EpiResid {
    static constexpr bool PERM = true, ROWSCALE = false, AUXTAB = false;
    const float* basef; const bf16_t* baseb; bf16_t* out; const float* gate; float s;
    __device__ __forceinline__ void operator()(const f32x4 (&acc)[2][2][4][2], const Unit& u, int wr, int wc, int fr, int fq, const LAS float* tab) const {
        const int mb = u.pm >> 5; const int col0 = u.pn * BM + wc * 32 + 8 * fq;
        f32x4 gv[2][2];
#pragma unroll
        for (int bj = 0; bj < 2; ++bj)
#pragma unroll
            for (int n = 0; n < 2; ++n) gv[bj][n] = *(const f32x4*)(gate + (size_t)mb * 6144 + col0 + bj * HALF + n * 4) * s;
#pragma unroll
        for (int ai = 0; ai < 2; ++ai)
#pragma unroll
            for (int m = 0; m < 4; ++m) { const size_t off = (size_t)(u.pm * BM + wr * 64 + fr + ai * HALF + m * 16) * DM + col0;
#pragma unroll
                for (int bj = 0; bj < 2; ++bj) { f32x4 b0, b1;
                    if constexpr (BASE_F32) { b0 = __builtin_nontemporal_load((const f32x4*)(basef + off + bj * HALF)); b1 = __builtin_nontemporal_load((const f32x4*)(basef + off + bj * HALF + 4)); }
                    else { const u32x4 w = *(const u32x4*)(baseb + off + bj * HALF);
                        b0 = (f32x4){__uint_as_float(w.x << 16), __uint_as_float(w.x & 0xffff0000u), __uint_as_float(w.y << 16), __uint_as_float(w.y & 0xffff0000u)};
                        b1 = (f32x4){__uint_as_float(w.z << 16), __uint_as_float(w.z & 0xffff0000u), __uint_as_float(w.w << 16), __uint_as_float(w.w & 0xffff0000u)}; }
                    const f32x4 o0 = b0 + gv[bj][0] * acc[ai][bj][m][0], o1 = b1 + gv[bj][1] * acc[ai][bj][m][1];
                    u32x4 w; w.x = pkbf(o0[0], o0[1]); w.y = pkbf(o0[2], o0[3]); w.z = pkbf(o1[0], o1[1]); w.w = pkbf(o1[2], o1[3]);
                    *(u32x4*)(out + off + bj * HALF) = w; } }
    }
};
struct EpiSwiGLU {
    static constexpr bool PERM = true, ROWSCALE = false, AUXTAB = false;
    bf16_t* O;
    __device__ __forceinline__ void operator()(const f32x4 (&acc)[2][2][4][2], const Unit& u, int wr, int wc, int fr, int fq, const LAS float* tab) const {
        bf16_t* base = O + (size_t)(u.om * BM + wr * 64 + fr) * DFF + u.pn * 128 + wc * 32 + 8 * fq;
#pragma unroll
        for (int ai = 0; ai < 2; ++ai)
#pragma unroll
            for (int m = 0; m < 4; ++m) { const f32x4 g0 = acc[ai][0][m][0], g1 = acc[ai][0][m][1], u0 = acc[ai][1][m][0], u1 = acc[ai][1][m][1];
                float o[8];
#pragma unroll
                for (int e = 0; e < 4; ++e) { o[e] = silu_f(g0[e]) * u0[e]; o[4 + e] = silu_f(g1[e]) * u1[e]; }
                u32x4 w; w.x = pkbf(o[0], o[1]); w.y = pkbf(o[2], o[3]); w.z = pkbf(o[4], o[5]); w.w = pkbf(o[6], o[7]);
                *(u32x4*)(base + (size_t)(ai * HALF + m * 16) * DFF) = w; }
    }
};
struct EpiQKV {
    static constexpr bool PERM = false, ROWSCALE = true, AUXTAB = true;
    __device__ __forceinline__ const float* scale_src(const Unit& u) const { return rscale + u.pm * BM; }
    __device__ __forceinline__ const float* aux_src(const Unit& u, int w) const { return cosT + w * 2048 + (u.pm & 31) * 64; }
    bf16_t* O; const float* cosT; float qscale; const float* rscale; float wq; const LAS float* colt;
    __device__ __forceinline__ void operator()(const f32x4 (&acc)[2][2][4][2], const Unit& u, int wr, int wc, int fr, int fq, const LAS float* tab) const {
        const bool lat = u.pm < NPL; const bool dorope = lat && u.pn < 5; const float sc = (u.pn < 4 ? qscale : 1.0f) * wq;
        const bool isv = u.pn == 5;
#pragma unroll
        for (int ai = 0; ai < 2; ++ai)
#pragma unroll
            for (int m = 0; m < 4; ++m) { const int r = ai * HALF + wr * 64 + m * 16 + fr; const int grow = u.pm * BM + r;
                f32x4 cs = (f32x4){1.f, 1.f, 1.f, 1.f}, sn = (f32x4){0.f, 0.f, 0.f, 0.f};
                if (dorope) { if (wc & 1) { cs = *(const LAS f32x4*)(colt + (r & 63) * 16 + 4 * fq); sn = *(const LAS f32x4*)(colt + 1024 + (r & 63) * 16 + 4 * fq); }
                              else { cs = *(const LAS f32x4*)(tab + 256 + (r >> 6) * 16 + 4 * fq); sn = *(const LAS f32x4*)(tab + 320 + (r >> 6) * 16 + 4 * fq); } }
                bf16_t* rowp = O + (size_t)grow * NQKV + u.pn * BM + wc * 32;
                const float rsx = tab[r] * sc;
#pragma unroll
                for (int bj = 0; bj < 2; ++bj) { const v4i_t i1 = __builtin_bit_cast(v4i_t, acc[ai][bj][m][0]), i2 = __builtin_bit_cast(v4i_t, acc[ai][bj][m][1]);
                    const f32x4 x1 = (f32x4){(float)i1[0], (float)i1[1], (float)i1[2], (float)i1[3]}, x2 = (f32x4){(float)i2[0], (float)i2[1], (float)i2[2], (float)i2[3]};
                    const f32x4 o1 = (x1 * cs - x2 * sn) * rsx, o2 = (x1 * sn + x2 * cs) * rsx;
                    u32x4 w; w.x = pkbf(o1[0], o1[1]); w.y = pkbf(o1[2], o1[3]); w.z = pkbf(o2[0], o2[1]); w.w = pkbf(o2[2], o2[3]);
                    if (isv) { *(u32x2*)(rowp + bj * HALF + 4 * fq) = (u32x2){w.x, w.y}; *(u32x2*)(rowp + bj * HALF + 4 * fq + 16) = (u32x2){w.z, w.w}; }
                    else *(u32x4*)(rowp + bj * HALF + 8 * fq) = w; } }
    }
};
struct EpiSwiGLUI8 {
    static constexpr bool PERM = true, ROWSCALE = true, AUXTAB = false;
    __device__ __forceinline__ const float* scale_src(const Unit& u) const { return rscale + u.pm * BM; }
    bf16_t* O; const float* rscale; float wsg, wsu;
    __device__ __forceinline__ void operator()(const f32x4 (&acc)[2][2][4][2], const Unit& u, int wr, int wc, int fr, int fq, const LAS float* tab) const {
        bf16_t* base = O + (size_t)(u.om * BM + wr * 64 + fr) * DFF + u.pn * 128 + wc * 32 + 8 * fq;
#pragma unroll
        for (int ai = 0; ai < 2; ++ai)
#pragma unroll
            for (int m = 0; m < 4; ++m) { const float rs = tab[wr * 64 + fr + ai * HALF + m * 16]; const float sg = rs * wsg, su = rs * wsu;
                const v4i_t g0 = __builtin_bit_cast(v4i_t, acc[ai][0][m][0]), g1 = __builtin_bit_cast(v4i_t, acc[ai][0][m][1]), u0 = __builtin_bit_cast(v4i_t, acc[ai][1][m][0]), u1 = __builtin_bit_cast(v4i_t, acc[ai][1][m][1]);
                float o[8];
#pragma unroll
                for (int e = 0; e < 4; e += 2) { const f32x2 sg2 = {sg, sg}, su2 = {su, su};
                    const f32x2 a = swiglu_pk((f32x2){(float)g0[e], (float)g0[e + 1]} * sg2, (f32x2){(float)u0[e], (float)u0[e + 1]} * su2), b = swiglu_pk((f32x2){(float)g1[e], (float)g1[e + 1]} * sg2, (f32x2){(float)u1[e], (float)u1[e + 1]} * su2);
                    o[e] = a.x; o[e + 1] = a.y; o[4 + e] = b.x; o[5 + e] = b.y; }
                u32x4 w; w.x = pkbf(o[0], o[1]); w.y = pkbf(o[2], o[3]); w.z = pkbf(o[4], o[5]); w.w = pkbf(o[6], o[7]);
                *(u32x4*)(base + (size_t)(ai * HALF + m * 16) * DFF) = w; }
    }
};
struct EpiSwiGLU8 {
    static constexpr bool PERM = true, ROWSCALE = false, AUXTAB = false;
    unsigned char* O; float s;
    __device__ __forceinline__ void operator()(const f32x4 (&acc)[2][2][4][2], const Unit& u, int wr, int wc, int fr, int fq, const LAS float* tab) const {
        unsigned char* base = O + (size_t)(u.om * BM + wr * 64 + fr) * DFF + u.pn * 128 + wc * 32 + 8 * fq;
#pragma unroll
        for (int ai = 0; ai < 2; ++ai)
#pragma unroll
            for (int m = 0; m < 4; ++m) { const f32x4 g0 = acc[ai][0][m][0] * s, g1 = acc[ai][0][m][1] * s, u0 = acc[ai][1][m][0] * s, u1 = acc[ai][1][m][1] * s;
                float o[8];
#pragma unroll
                for (int e = 0; e < 4; ++e) { o[e] = silu_f(g0[e]) * u0[e]; o[4 + e] = silu_f(g1[e]) * u1[e]; }
                u32x2 w; w.x = pk4f8(o[0], o[1], o[2], o[3]); w.y = pk4f8(o[4], o[5], o[6], o[7]);
                *(u32x2*)(base + (size_t)(ai * HALF + m * 16) * DFF) = w; }
    }
};
struct EpiSwiGLU6 {
    static constexpr bool PERM = true, ROWSCALE = false, AUXTAB = false;
    unsigned char* O;
    __device__ __forceinline__ void operator()(const f32x4 (&acc)[2][2][4][2], const Unit& u, int wr, int wc, int fr, int fq, const LAS float* tab) const {
        unsigned char* base = O + (size_t)(u.om * BM + wr * 64 + 16 * fq + fr) * DFF + u.pn * 128 + wc * 16;
#pragma unroll
        for (int ai = 0; ai < 2; ++ai) {
            unsigned v[4][8];
#pragma unroll
            for (int m = 0; m < 4; ++m) { const f32x4 g0 = acc[ai][0][m][0], g1 = acc[ai][0][m][1], u0 = acc[ai][1][m][0], u1 = acc[ai][1][m][1];
#pragma unroll
                for (int e = 0; e < 4; e += 2) { const f32x2 a = swiglu_pk((f32x2){g0[e], g0[e + 1]}, (f32x2){u0[e], u0[e + 1]}), b = swiglu_pk((f32x2){g1[e], g1[e + 1]}, (f32x2){u1[e], u1[e + 1]});
                    v[m][e] = __float_as_uint(a.x); v[m][e + 1] = __float_as_uint(a.y); v[m][4 + e] = __float_as_uint(b.x); v[m][5 + e] = __float_as_uint(b.y); } }
#pragma unroll
            for (int ml = 0; ml < 2; ++ml)
#pragma unroll
                for (int e = 0; e < 8; ++e) { const u32x2 r = __builtin_amdgcn_permlane32_swap(v[ml][e], v[ml + 2][e], false, false); v[ml][e] = r[0]; v[ml + 2][e] = r[1]; }
#pragma unroll
            for (int part = 0; part < 2; ++part)
#pragma unroll
                for (int e = 0; e < 8; ++e) { const u32x2 r = __builtin_amdgcn_permlane16_swap(v[2 * part][e], v[2 * part + 1][e], false, false); v[2 * part][e] = r[0]; v[2 * part + 1][e] = r[1]; }
            float x[32];
#pragma unroll
            for (int j = 0; j < 4; ++j)
#pragma unroll
                for (int e = 0; e < 8; ++e) x[8 * j + e] = __uint_as_float(v[j][e]);
            u32x4 c0, c1; mxfp6_block(x, c0, c1);
            unsigned char* dst = base + (size_t)(ai * HALF) * DFF;
            *(u32x4*)dst = c0; *(u32x4*)(dst + 64) = c1; }
    }
};
struct EpiBf16Plain {
    static constexpr bool PERM = true, ROWSCALE = false, AUXTAB = false;
    bf16_t* O; int ldc; float s;
    __device__ __forceinline__ void operator()(const f32x4 (&acc)[2][2][4][2], const Unit& u, int wr, int wc, int fr, int fq, const LAS float* tab) const {
        bf16_t* base = O + (size_t)(u.om * BM + wr * 64 + fr) * ldc + u.pn * BM + wc * 32 + 8 * fq;
#pragma unroll
        for (int ai = 0; ai < 2; ++ai)
#pragma unroll
            for (int m = 0; m < 4; ++m)
#pragma unroll
                for (int bj = 0; bj < 2; ++bj) { const f32x4 v0 = acc[ai][bj][m][0] * s, v1 = acc[ai][bj][m][1] * s;
                    u32x4 w; w.x = pkbf(v0[0], v0[1]); w.y = pkbf(v0[2], v0[3]); w.z = pkbf(v1[0], v1[1]); w.w = pkbf(v1[2], v1[3]);
                    *(u32x4*)(base + (size_t)(ai * HALF + m * 16) * ldc + bj * HALF) = w; }
    }
};

struct EpiPartF32 {
    static constexpr bool PERM = true, ROWSCALE = false, AUXTAB = false;
    float* P; size_t sstride;
    __device__ __forceinline__ void operator()(const f32x4 (&acc)[2][2][4][2], const Unit& u, int wr, int wc, int fr, int fq, const LAS float* tab) const {
        float* base = P + (size_t)u.ks * sstride + (size_t)(u.om * BM + wr * 64 + fr) * DM + u.pn * BM + wc * 32 + 8 * fq;
#pragma unroll
        for (int ai = 0; ai < 2; ++ai)
#pragma unroll
            for (int m = 0; m < 4; ++m)
#pragma unroll
                for (int bj = 0; bj < 2; ++bj)
#pragma unroll
                    for (int n = 0; n < 2; ++n) *(f32x4*)(base + (size_t)(ai * HALF + m * 16) * DM + bj * HALF + n * 4) = acc[ai][bj][m][n];
    }
};
struct EpiPartBf16 {
    static constexpr bool PERM = true, ROWSCALE = false, AUXTAB = false;
    bf16_t* P; size_t sstride; float s;
    __device__ __forceinline__ void operator()(const f32x4 (&acc)[2][2][4][2], const Unit& u, int wr, int wc, int fr, int fq, const LAS float* tab) const {
        bf16_t* base = P + (size_t)u.ks * sstride + (size_t)(u.om * BM + wr * 64 + fr) * DM + u.pn * BM + wc * 32 + 8 * fq;
#pragma unroll
        for (int ai = 0; ai < 2; ++ai)
#pragma unroll
            for (int m = 0; m < 4; ++m)
#pragma unroll
                for (int bj = 0; bj < 2; ++bj) { const f32x4 v0 = acc[ai][bj][m][0] * s, v1 = acc[ai][bj][m][1] * s;
                    u32x4 w; w.x = pkbf(v0[0], v0[1]); w.y = pkbf(v0[2], v0[3]); w.z = pkbf(v1[0], v1[1]); w.w = pkbf(v1[2], v1[3]);
                    *(u32x4*)(base + (size_t)(ai * HALF + m * 16) * DM + bj * HALF) = w; }
    }
};

template <class Epi, class Sched, bool ALIGN_EPI, bool GATHER, bool FP8 = false, bool I8 = false, bool FP6 = false>
__device__ __forceinline__ void gemm_phase(int wave_s_, LAS unsigned char* lds, LAS int* gtab, const int K  , const int nt_in  , const Sched& S, const Epi& E) {
    int nt = nt_in; asm volatile("" : "+s"(nt));
    int tid_ = tid_of(wave_s_); asm volatile("" : "+v"(tid_));
    const int tid = tid_, wid = __builtin_amdgcn_readfirstlane(tid >> 6), lane = tid & 63, wr = wid >> 2, wc = wid & 3, fr = lane & 15, fq = lane >> 4;
    const size_t kstep = (size_t)(BK * 2);
    const size_t hstep = (size_t)HALF * K * 2;
    unsigned voffB[2];
#pragma unroll
    for (int i = 0; i < 2; ++i) { int R, C; stage_rc(tid * 16 + i * 8192, R, C); const int Rb = Epi::PERM ? ((R & ~31) + perm32(R & 31)) : R;
        voffB[i] = (unsigned)(Rb * K + C) * 2u; }
    unsigned vA[2][2], vN[2][2];
    const unsigned ldsw = (unsigned)wid * 1024u;
    const int aoff = lds_byte(wr * 64 + fr, fq * 8), boff = lds_byte(wc * 32 + fr, fq * 8);
    const LAS unsigned char* aB = lds + aoff; const LAS unsigned char* bB = lds + 65536 + boff;
    asm volatile("" : "+v"(aB), "+v"(bB));
#define PG8_SA(b, h) (((b) * 2 + (h)) * HTB)
#define PG8_SB(b, h) ((4 + (b) * 2 + (h)) * HTB)
#define PG8_STAGE(bufoff, gbase, voff) do { _Pragma("unroll") for (int _i = 0; _i < 2; ++_i) \
        __builtin_amdgcn_global_load_lds((const unsigned*)((const char*)(gbase) + (voff)[_i]), (LAS unsigned*)(lds + (bufoff) + ldsw + _i * 8192), 16, 0, 0); } while (0)
#define PG8_LDA(dst, b, h) do { _Pragma("unroll") for (int m = 0; m < 4; ++m) { if constexpr (FP8 || FP6) dst##8[m] = cat8(*(const LAS bf16x8*)(aB + PG8_SA(b, h) + m * 2048), *(const LAS bf16x8*)(aB + PG8_SA(b, h) + m * 2048 + 1024)); \
        else { _Pragma("unroll") for (int k = 0; k < 2; ++k) dst[m][k] = *(const LAS bf16x8*)(aB + PG8_SA(b, h) + m * 2048 + k * 1024); } } } while (0)
#define PG8_LDB(dst, b, h) do { _Pragma("unroll") for (int n = 0; n < 2; ++n) { if constexpr (FP8 || FP6) dst##8[n] = cat8(*(const LAS bf16x8*)(bB + (PG8_SB(b, h) - 65536) + n * 2048), *(const LAS bf16x8*)(bB + (PG8_SB(b, h) - 65536) + n * 2048 + 1024)); \
        else { _Pragma("unroll") for (int k = 0; k < 2; ++k) dst[n][k] = *(const LAS bf16x8*)(bB + (PG8_SB(b, h) - 65536) + n * 2048 + k * 1024); } } } while (0)
#define PG8_MMA(ai, bj, At, Bt) do { __builtin_amdgcn_s_setprio(1); \
    if constexpr (FP6) { _Pragma("unroll") for (int m = 0; m < 4; ++m) _Pragma("unroll") for (int n = 0; n < 2; ++n) \
        asm volatile("s_nop 1\n\tv_mfma_scale_f32_16x16x128_f8f6f4 %0, %1, %2, %0, %3, %4 op_sel_hi:[0,0,0] cbsz:2 blgp:2" : "+v"(acc[ai][bj][m][n]) \
                     : "v"(__builtin_shufflevector(Bt##8[n], Bt##8[n], 0, 1, 2, 3, 4, 5)), "v"(__builtin_shufflevector(At##8[m], At##8[m], 0, 1, 2, 3, 4, 5)), "v"(Bt##8[n][6]), "v"(At##8[m][6])); } \
    else if constexpr (FP8) { _Pragma("unroll") for (int m = 0; m < 4; ++m) _Pragma("unroll") for (int n = 0; n < 2; ++n) \
        asm volatile("v_mfma_f32_16x16x128_f8f6f4 %0, %1, %2, %0" : "+v"(acc[ai][bj][m][n]) : "v"(Bt##8[n]), "v"(At##8[m])); } \
    else if constexpr (I8) { _Pragma("unroll") for (int m = 0; m < 4; ++m) _Pragma("unroll") for (int n = 0; n < 2; ++n) _Pragma("unroll") for (int k = 0; k < 2; ++k) \
        asm volatile("v_mfma_i32_16x16x64_i8 %0, %1, %2, %0" : "+v"(acc[ai][bj][m][n]) : "v"(Bt[n][k]), "v"(At[m][k])); } \
    else { _Pragma("unroll") for (int m = 0; m < 4; ++m) _Pragma("unroll") for (int n = 0; n < 2; ++n) _Pragma("unroll") for (int k = 0; k < 2; ++k) \
        acc[ai][bj][m][n] = __builtin_amdgcn_mfma_f32_16x16x32_bf16(Bt[n][k], At[m][k], acc[ai][bj][m][n], 0, 0, 0); } \
    __builtin_amdgcn_s_setprio(0); } while (0)
#define PG8_WAIT_V(n) asm volatile("s_waitcnt vmcnt(" #n ")" ::: "memory")
#define PG8_WAIT_L(n) asm volatile("s_waitcnt lgkmcnt(" #n ")" ::: "memory")
#define PG8_BAR __builtin_amdgcn_s_barrier()
#define PG8_SCHED __builtin_amdgcn_sched_barrier(0)
    Unit cur, nxt; int ui = 0;
    if (!S.next(0, cur)) return;
    f32x4 acc[2][2][4][2];
#pragma unroll
    for (int a = 0; a < 2; ++a)
#pragma unroll
        for (int b = 0; b < 2; ++b)
#pragma unroll
            for (int m = 0; m < 4; ++m)
#pragma unroll
                for (int n = 0; n < 2; ++n) acc[a][b][m][n] = (f32x4){0.f, 0.f, 0.f, 0.f};
    bf16x8 At[4][2], B0[2][2], B1[2][2]; v8i_t At8[4], B08[2], B18[2];
    if constexpr (GATHER) {
#pragma unroll
        for (int h = 0; h < 2; ++h)
#pragma unroll
            for (int i = 0; i < 2; ++i) { int R, C; stage_rc(tid * 16 + i * 8192, R, C); const int row = h * HALF + R; const int tok = cur.gl[row < cur.nv ? row : 0]; vA[h][i] = (unsigned)tok * (unsigned)(K * 2) + (unsigned)C * 2u; }
    } else {
#pragma unroll
        for (int h = 0; h < 2; ++h)
#pragma unroll
            for (int i = 0; i < 2; ++i) { int R, C; stage_rc(tid * 16 + i * 8192, R, C); vA[h][i] = (unsigned)(R * K + C) * 2u + (unsigned)(h * hstep); }
    }
#pragma unroll
    for (int h = 0; h < 2; ++h)
#pragma unroll
        for (int i = 0; i < 2; ++i) vN[h][i] = vA[h][i];
    const char* cA = cur.a; const char* cB = cur.b;
    bool has_next = S.next(1, nxt);
    if constexpr (Epi::ROWSCALE) {
        if (wid < 4) __builtin_amdgcn_global_load_lds((const unsigned*)(E.scale_src(cur) + wid * 64 + lane), (LAS unsigned*)(lds + STAB_OFF + wid * 256), 4, 0, 0);
        if constexpr (Epi::AUXTAB) { if (wid < 2) __builtin_amdgcn_global_load_lds((const unsigned*)(E.aux_src(cur, wid) + lane), (LAS unsigned*)(lds + STAB_OFF + 1024 + wid * 256), 4, 0, 0); }
    }
    if constexpr (GATHER) { if (has_next && wid < 4) __builtin_amdgcn_global_load_lds((const unsigned*)(nxt.gl + wid * 64 + lane), (LAS unsigned*)(gtab + wid * 64), 4, 0, 0); }
    PG8_STAGE(PG8_SB(0, 0), cB, voffB); PG8_STAGE(PG8_SB(0, 1), cB + hstep, voffB); PG8_STAGE(PG8_SA(0, 0), cA, vA[0]); PG8_STAGE(PG8_SA(0, 1), cA, vA[1]);
    if (wr == 1) PG8_BAR;
    PG8_WAIT_V(2); PG8_BAR;
    PG8_STAGE(PG8_SB(1, 0), cB + kstep, voffB); PG8_STAGE(PG8_SA(1, 0), cA + kstep, vA[0]); PG8_STAGE(PG8_SB(1, 1), cB + hstep + kstep, voffB);
    PG8_WAIT_V(6); PG8_BAR;
    Unit nx2;
    for (;;) {
        const char* nA = has_next ? nxt.a : cA; const char* nB = has_next ? nxt.b : cB;
        for (int t = 0; t < nt; t += 2) {
            const bool last = (t == nt - 2);
            const char* a1 = cA + (size_t)(t + 1) * kstep;
            const char* a2 = last ? nA : cA + (size_t)(t + 2) * kstep; const char* b2 = last ? nB : cB + (size_t)(t + 2) * kstep;
            const char* a3 = a2 + kstep; const char* b3 = b2 + kstep;
            if constexpr (GATHER) {
                if (last && has_next) {
                    int t2 = tid; asm volatile("" : "+v"(t2));
#pragma unroll
                    for (int h = 0; h < 2; ++h)
#pragma unroll
                        for (int i = 0; i < 2; ++i) { int R, C; stage_rc(t2 * 16 + i * 8192, R, C); const int row = h * HALF + R; const int tok = gtab[row < nxt.nv ? row : 0]; vN[h][i] = (unsigned)tok * (unsigned)(K * 2) + (unsigned)C * 2u; }
                }
            }
            unsigned vS0[2], vS1[2];
#pragma unroll
            for (int i = 0; i < 2; ++i) { vS0[i] = (GATHER && last) ? vN[0][i] : vA[0][i]; vS1[i] = (GATHER && last) ? vN[1][i] : vA[1][i]; }
            PG8_LDB(B0, 0, 0); PG8_LDB(B1, 0, 1); PG8_SCHED; PG8_LDA(At, 0, 0); PG8_STAGE(PG8_SA(1, 1), a1, vA[1]);
            PG8_WAIT_V(8); PG8_WAIT_L(0); PG8_BAR; PG8_MMA(0, 0, At, B0); PG8_MMA(0, 1, At, B1); PG8_BAR; PG8_SCHED;
            PG8_LDA(At, 0, 1); PG8_STAGE(PG8_SB(0, 0), b2, voffB); PG8_STAGE(PG8_SB(0, 1), b2 + hstep, voffB); PG8_STAGE(PG8_SA(0, 0), a2, vS0);
            PG8_WAIT_V(8); PG8_WAIT_L(0); PG8_BAR; PG8_MMA(1, 0, At, B0); PG8_MMA(1, 1, At, B1); PG8_BAR; PG8_SCHED;
            PG8_LDB(B0, 1, 0); PG8_LDB(B1, 1, 1); PG8_SCHED; PG8_LDA(At, 1, 0); PG8_STAGE(PG8_SA(0, 1), a2, vS1);
            PG8_WAIT_V(8); PG8_WAIT_L(0); PG8_BAR; PG8_MMA(0, 0, At, B0); PG8_MMA(0, 1, At, B1); PG8_BAR; PG8_SCHED;
            PG8_LDA(At, 1, 1); PG8_STAGE(PG8_SB(1, 0), b3, voffB); PG8_STAGE(PG8_SB(1, 1), b3 + hstep, voffB); PG8_STAGE(PG8_SA(1, 0), a3, vS0);
            PG8_WAIT_V(8); PG8_WAIT_L(0); PG8_BAR; PG8_MMA(1, 0, At, B0); PG8_MMA(1, 1, At, B1); PG8_BAR; PG8_SCHED;
        }
        if constexpr (ALIGN_EPI) { if (wr == 0) PG8_BAR; }
        const bool has_nx2 = has_next && S.next(ui + 2, nx2);
        if constexpr (Epi::ROWSCALE) {
            if (has_next && wid < 4) __builtin_amdgcn_global_load_lds((const unsigned*)(E.scale_src(nxt) + wid * 64 + lane), (LAS unsigned*)(lds + STAB_OFF + ((ui + 1) & 1) * STAB_STRIDE + wid * 256), 4, 0, 0);
            if constexpr (Epi::AUXTAB) { if (has_next && wid < 2) __builtin_amdgcn_global_load_lds((const unsigned*)(E.aux_src(nxt, wid) + lane), (LAS unsigned*)(lds + STAB_OFF + ((ui + 1) & 1) * STAB_STRIDE + 1024 + wid * 256), 4, 0, 0); }
        }
        if constexpr (GATHER) {
            if (has_nx2 && wid < 4) __builtin_amdgcn_global_load_lds((const unsigned*)(nx2.gl + wid * 64 + lane), (LAS unsigned*)(gtab + wid * 64), 4, 0, 0);
        }
        if constexpr (FP8 || I8 || FP6) asm volatile("s_nop 15\n\ts_nop 15" ::: "memory");
        E(acc, cur, wr, wc, fr, fq, (const LAS float*)(lds + STAB_OFF + (ui & 1) * STAB_STRIDE));
        if (!has_next) break;
        { f32x2 z2 = (f32x2){0.f, 0.f}; asm volatile("" : "+v"(z2));
#pragma unroll
        for (int a = 0; a < 2; ++a)
#pragma unroll
            for (int b = 0; b < 2; ++b)
#pragma unroll
                for (int m = 0; m < 4; ++m)
#pragma unroll
                    for (int n = 0; n < 2; ++n) { const int ix = ((a * 2 + b) * 4 + m) * 2 + n; const f32x2 lo = z2 * __uint_as_float(2 * ix + 1), hi = z2 * __uint_as_float(2 * ix + 2); acc[a][b][m][n] = __builtin_shufflevector(lo, hi, 0, 1, 2, 3); } }
        cur = nxt; nxt = nx2; has_next = has_nx2; cA = nA; cB = nB; ++ui;
        if constexpr (GATHER) {
#pragma unroll
            for (int h = 0; h < 2; ++h)
#pragma unroll
                for (int i = 0; i < 2; ++i) vA[h][i] = vN[h][i];
        }
        if constexpr (ALIGN_EPI) { if (wr == 1) PG8_BAR; }
    }
    PG8_WAIT_V(0);
    if constexpr (!ALIGN_EPI) { if (wr == 0) PG8_BAR; }
    PG8_BAR;
#undef PG8_SA
#undef PG8_SB
#undef PG8_STAGE
#undef PG8_LDA
#undef PG8_LDB
#undef PG8_MMA
#undef PG8_WAIT_V
#undef PG8_WAIT_L
#undef PG8_BAR
#undef PG8_SCHED
}
}

namespace attn_body {
using bf16 = __hip_bfloat16;
using s16x4 = __attribute__((ext_vector_type(4))) short;
constexpr int D = 64, PITCH = NQKV, OPITCH = DM;
constexpr int NW = 8, QBLK = 32, KVBLK = 64;
__device__ __forceinline__ int crow(int r, int hi) { return (r & 3) + 8 * (r >> 2) + 4 * hi; }
#define SBAR() __builtin_amdgcn_sched_barrier(0)
__device__ __forceinline__ void bmask(f32x16& p0, f32x16& p1, int kb, int qrel, int hi) {
    const float NEG = -INFINITY; const int d0 = kb + 4 * hi - qrel;
#pragma unroll
    for (int r = 0; r < 16; ++r) { const int d = d0 + (r & 3) + 8 * (r >> 2); if (d < -128 || d > 128) p0[r] = NEG; if (d + 32 < -128 || d + 32 > 128) p1[r] = NEG; }
}
constexpr int NSLOT = 3, SLOTB = 8192;
constexpr int LDS_K = 0, LDS_V = NSLOT * SLOTB, LDS_WS = 2 * NSLOT * SLOTB, LDS_OST = LDS_WS + NW * 64 * 4, LDS_BYTES_A = LDS_OST + NW * 4096;
constexpr float C2 = 0.125f * 1.4426950408889634f;
__device__ __forceinline__ void glds16(const void* gsrc, unsigned lds_dst) { unsigned keep;
    asm volatile("s_mov_b32 %0, m0\n\ts_mov_b32 m0, %2\n\ts_nop 0\n\tglobal_load_lds_dwordx4 %1, off\n\ts_mov_b32 m0, %0" : "=&s"(keep) : "v"(gsrc), "s"(lds_dst) : "memory"); }
__device__ __forceinline__ float max3f(float a, float b, float c) { float r; asm("v_max3_f32 %0, %1, %2, %3" : "=v"(r) : "v"(a), "v"(b), "v"(c)); return r; }
__device__ __forceinline__ float max2f(float a, float b) { float r; asm("v_max_f32_e32 %0, %1, %2" : "=v"(r) : "v"(a), "v"(b)); return r; }
__device__ __forceinline__ float fadd_s(float a, float b) { float r; asm("v_add_f32_e32 %0, %1, %2" : "=v"(r) : "v"(a), "v"(b)); return r; }
__device__ __forceinline__ float fsub_s(float a, float b) { float r; asm("v_sub_f32_e32 %0, %1, %2" : "=v"(r) : "v"(a), "v"(b)); return r; }
__device__ __forceinline__ unsigned cvtpk_s(float lo, float hi) { f32x2 v = {lo, hi}; bf16x2_t b = __builtin_convertvector(v, bf16x2_t); return __builtin_bit_cast(unsigned, b); }
#define WAIT_BAR(N) asm volatile("s_waitcnt vmcnt(" #N ") lgkmcnt(0)\n\ts_barrier" ::: "memory")
__device__ __forceinline__ void qkt(f32x16& p0, f32x16& p1, const char* Kslot, const bf16x8* qr, const f32x16& negm, int r32, int hi) {
    const char* kb = Kslot + hi * 1024 + r32 * 16;
#pragma unroll
    for (int d0 = 0; d0 < 4; ++d0) {
        const bf16x8 b0 = *reinterpret_cast<const bf16x8*>(kb + d0 * 2048);
        const bf16x8 b1 = *reinterpret_cast<const bf16x8*>(kb + d0 * 2048 + 512);
        if (d0 == 0) { p0 = __builtin_amdgcn_mfma_f32_32x32x16_bf16(b0, qr[0], negm, 0, 0, 0); p1 = __builtin_amdgcn_mfma_f32_32x32x16_bf16(b1, qr[0], negm, 0, 0, 0); }
        else { p0 = __builtin_amdgcn_mfma_f32_32x32x16_bf16(b0, qr[d0], p0, 0, 0, 0); p1 = __builtin_amdgcn_mfma_f32_32x32x16_bf16(b1, qr[d0], p1, 0, 0, 0); } }
}
typedef __attribute__((address_space(3))) const char* lds_cptr;
typedef short v4i16_t __attribute__((ext_vector_type(4)));
__device__ __forceinline__ void kload8(bf16x8* kf, lds_cptr kp) {
    kf[0] = *(const __attribute__((address_space(3))) bf16x8*)(kp);        kf[1] = *(const __attribute__((address_space(3))) bf16x8*)(kp + 512);
    kf[2] = *(const __attribute__((address_space(3))) bf16x8*)(kp + 2048); kf[3] = *(const __attribute__((address_space(3))) bf16x8*)(kp + 2560);
    kf[4] = *(const __attribute__((address_space(3))) bf16x8*)(kp + 4096); kf[5] = *(const __attribute__((address_space(3))) bf16x8*)(kp + 4608);
    kf[6] = *(const __attribute__((address_space(3))) bf16x8*)(kp + 6144); kf[7] = *(const __attribute__((address_space(3))) bf16x8*)(kp + 6656);
}
__device__ __forceinline__ void kload2(bf16x8* kf, lds_cptr kp, int j) { kf[2 * j] = *(const __attribute__((address_space(3))) bf16x8*)(kp + j * 2048); kf[2 * j + 1] = *(const __attribute__((address_space(3))) bf16x8*)(kp + j * 2048 + 512); }
__device__ __forceinline__ s16x4 vtr(lds_cptr p) { return __builtin_bit_cast(s16x4, __builtin_amdgcn_ds_read_tr16_b64_v4i16((__attribute__((address_space(3))) v4i16_t*)p)); }
__device__ __forceinline__ float rowmax(const f32x16& p0, const f32x16& p1) {
    float a = max3f(p0[0], p0[1], p1[0]), b = max3f(p0[2], p0[3], p1[1]); a = max3f(a, p1[2], p1[3]);
#pragma unroll
    for (int r = 4; r < 16; r += 4) { a = max3f(a, p0[r], p0[r + 1]); b = max3f(b, p0[r + 2], p0[r + 3]); a = max3f(a, p1[r], p1[r + 1]); b = max3f(b, p1[r + 2], p1[r + 3]); }
    const float m = max2f(a, b);
    auto rr = __builtin_amdgcn_permlane32_swap(__float_as_uint(m), __float_as_uint(m), false, false);
    return max2f(__uint_as_float(rr[0]), __uint_as_float(rr[1]));
}
__device__ __forceinline__ void pv(f32x16* o, int vb, bf16x8 pa0, bf16x8 pa1, bf16x8 pa2, bf16x8 pa3) {
#pragma unroll
    for (int d0 = 0; d0 < 2; ++d0) { s16x4 lo[4], hi[4];
#pragma unroll
        for (int ks = 0; ks < 4; ++ks) {
            asm volatile("ds_read_b64_tr_b16 %0,%1 offset:%c2" : "=&v"(lo[ks]) : "v"(vb), "i"(d0 * 4096 + ks * 1024) : "memory");
            asm volatile("ds_read_b64_tr_b16 %0,%1 offset:%c2" : "=&v"(hi[ks]) : "v"(vb), "i"(d0 * 4096 + ks * 1024 + 512) : "memory"); }
        asm volatile("s_waitcnt lgkmcnt(0)" ::: "memory"); SBAR();
#define PK(k) (bf16x8){lo[k][0], lo[k][1], lo[k][2], lo[k][3], hi[k][0], hi[k][1], hi[k][2], hi[k][3]}
        o[d0] = __builtin_amdgcn_mfma_f32_32x32x16_bf16(pa0, PK(0), o[d0], 0, 0, 0);
        o[d0] = __builtin_amdgcn_mfma_f32_32x32x16_bf16(pa1, PK(1), o[d0], 0, 0, 0);
        o[d0] = __builtin_amdgcn_mfma_f32_32x32x16_bf16(pa2, PK(2), o[d0], 0, 0, 0);
        o[d0] = __builtin_amdgcn_mfma_f32_32x32x16_bf16(pa3, PK(3), o[d0], 0, 0, 0);
#undef PK
    }
}
#define ATTN_STORE16(p, v) (*(u32x4*)(p) = (v))
template <int THRL> __device__ __forceinline__ int attn_unit(int wave_s_, int b, int hk, int n, int pr, const bf16* QKV, unsigned char* O, const float* sinkp, char* shm, int sb, bool pre, bool has_next, int nb2, int nhk2, int nn2, int npr2, bf16x8 (&qr)[4]) {
    int tid_ = tid_of(wave_s_); asm volatile("" : "+v"(tid_));
    const int tid = tid_, lane = tid & 63, r32 = lane & 31, hi = lane >> 5; const int wid = __builtin_amdgcn_readfirstlane(tid >> 6);
    const int head = 4 * hk + 2 * pr + (wid >> 2);
    const long rowblk = (long)b * SEQ + n * 128;
    const long ctxrow = (long)NLAT + b * LCTX;
    const int nlo = n > 0 ? 2 : 0, nhi = n < (SEQ / 128 - 1) ? 2 : 0;
    const int NT = 6 + nlo + nhi;
    const bf16* Qw = QKV + (rowblk + (wid & 3) * QBLK) * PITCH + head * D;
    const bf16* Kc = QKV + 1024 + hk * D; const bf16* Vc = QKV + 1280 + hk * D;
    const unsigned lds0 = (unsigned)(uintptr_t)shm;
    float* wsf = (float*)(shm + LDS_WS) + wid * 64;
    const long klane = (long)lane * PITCH + wid * 8;
    const long vlane = (long)(16 * (wid & 3) + (lane >> 2)) * PITCH + (wid >> 2) * 32 + (lane & 3) * 8;
    const unsigned kdst = lds0 + LDS_K + wid * 1024, vdst = lds0 + LDS_V + wid * 1024;
#define TROW(t) (((t) < 2) ? (rowblk + 64 * (t)) : ((t) < 6) ? (ctxrow + 64 * ((t) - 2)) : (rowblk + ((((t) - 6) < nlo) ? (-128 + 64 * ((t) - 6)) : (128 + 64 * ((t) - 6 - nlo)))))
#define TKB(t) (((t) < 6) ? 0 : ((((t) - 6) < nlo) ? (-128 + 64 * ((t) - 6)) : (128 + 64 * ((t) - 6 - nlo))))
#define DMA_K(t, slot) glds16(Kc + TROW(t) * PITCH + klane, (unsigned)__builtin_amdgcn_readfirstlane(kdst + (slot)))
#define DMA_V(t, slot) glds16(Vc + TROW(t) * PITCH + vlane, (unsigned)__builtin_amdgcn_readfirstlane(vdst + (slot)))
    const int vb0 = (int)(lds0 + LDS_V) + ((lane >> 4) & 1) * 32 + (lane & 3) * 8 + (4 * hi + ((lane & 15) >> 2)) * 64;
    const char* Kbase = shm + LDS_K; bf16x8 kf[8];
    const lds_cptr shm3 = (lds_cptr)shm; const lds_cptr kp0 = shm3 + LDS_K + hi * 1024 + r32 * 16; const lds_cptr vp0 = shm3 + LDS_V + ((lane >> 4) & 1) * 32 + (lane & 3) * 8 + (4 * hi + ((lane & 15) >> 2)) * 64;
#define NXS(x) (((x) == (NSLOT - 1) * SLOTB) ? 0 : (x) + SLOTB)
    const int S0 = sb, S1 = NXS(S0), S2 = NXS(S1);
    if (!pre) { DMA_K(0, S0); DMA_V(0, S0); DMA_K(1, S1); }
    if (!pre) {
#pragma unroll
        for (int d0 = 0; d0 < 4; ++d0) qr[d0] = *reinterpret_cast<const bf16x8*>(&Qw[(long)r32 * PITCH + d0 * 16 + hi * 8]); }
    float mhat = 0.f, l_reg = 0.f; f32x16 o[2]; o[0] = f32x16{}; o[1] = f32x16{}; f32x16 negm = f32x16{}; asm volatile("" : "+v"(negm));
    const int qrel = (wid & 3) * QBLK + r32;
#define CMASK(P0, P1, t) do { int jb_ = (t) - (NT - 4); if (jb_ >= 0) bmask(P0, P1, TKB(t), qrel, hi); } while (0)
    bool resc = false;
#define START(P0, P1) do { const float rm = rowmax(P0, P1); resc = false; \
    { const float dl = rm; mhat = fadd_s(mhat, dl); \
      _Pragma("unroll") for (int r = 0; r < 16; ++r) { P0[r] = fsub_s(P0[r], dl); P1[r] = fsub_s(P1[r], dl); } \
      _Pragma("unroll") for (int r = 0; r < 16; ++r) negm[r] = -mhat; asm volatile("" : "+v"(negm)); } \
    _Pragma("unroll") for (int r = 0; r < 16; ++r) P0[r] = __builtin_amdgcn_exp2f(P0[r]); } while (0)
#define RESC() do { if (resc) { asm volatile("s_waitcnt lgkmcnt(0)" ::: "memory"); \
      _Pragma("unroll") for (int d_ = 0; d_ < 2; ++d_) _Pragma("unroll") for (int r = 0; r < 16; ++r) o[d_][r] *= wsf[crow(r, hi)]; } } while (0)
    f32x16 pA0, pA1, pB0, pB1;
    int sl_prev = S0, sl_cur = S0, sl_next = S1;
#define ROT() do { sl_prev = sl_cur; sl_cur = sl_next; sl_next = (sl_next == (NSLOT - 1) * SLOTB) ? 0 : sl_next + SLOTB; } while (0)
    if (!pre) { DMA_K(2, S2); }
    WAIT_BAR(3);
    qkt(pA0, pA1, Kbase + S0, qr, negm, r32, hi); asm volatile("s_nop 15\n\ts_nop 7" : "+v"(pA0), "+v"(pA1));
    START(pA0, pA1);
    _Pragma("unroll") for (int r = 0; r < 16; ++r) pA1[r] = __builtin_amdgcn_exp2f(pA1[r]);
    WAIT_BAR(0);
    DMA_K(3, S0); DMA_V(1, S1);
    ROT();
    kload8(kf, kp0 + sl_cur);
    WAIT_BAR(2);
    s16x4 vlo[8], vhi[8]; u32x4 pw0, pw1, pw2, pw3;
#define PKW(P, B) cvtpk_s(P[B], P[B + 1])
#define PAF(k) __builtin_bit_cast(bf16x8, pw##k)
#define VFR(i) (bf16x8){vlo[i][0], vlo[i][1], vlo[i][2], vlo[i][3], vhi[i][0], vhi[i][1], vhi[i][2], vhi[i][3]}
#define PIN(x) asm volatile("" : "+v"(x))
#define MX3(a, b, c) __builtin_fmaxf(__builtin_fmaxf((a), (b)), (c))
#define GAPA(MF, A0, A1, A2, A3, W0, W1, PW) do { MF; sacc += A0; sacc += A1; sacc += A2; sacc += A3; PIN(sacc); W0; W1; PIN(PW); SBAR(); } while (0)
#define EX(v) __builtin_amdgcn_exp2f(v)
#define GAPB(MF, X, B) do { MF; X[B] = EX(X[B]); X[B + 1] = EX(X[B + 1]); X[B + 2] = EX(X[B + 2]); X[B + 3] = EX(X[B + 3]); PIN(X); SBAR(); } while (0)
#define VRD(i) do { vlo[i] = vtr(vp_ + (((i) >> 2) * 4096 + ((i) & 3) * 1024)); vhi[i] = vtr(vp_ + (((i) >> 2) * 4096 + ((i) & 3) * 1024 + 512)); } while (0)
#define KRD(G, j) do { if (G) { kload2(kf, kp0 + sl_next, j); SBAR(); } } while (0)
#define STEP(C0, C1, P0, P1, t, GK, GV, GL) do { SBAR(); \
    const lds_cptr vp_ = vp0 + sl_prev; \
    VRD(0); SBAR(); float sacc = (P0[0] + P0[1]); \
    GAPA(C0 = __builtin_amdgcn_mfma_f32_32x32x16_bf16(kf[0], qr[0], negm, 0, 0, 0), P0[2], P0[3], P0[4], P0[5],     pw0[0] = PKW(P0, 0), pw0[1] = PKW(P0, 2), pw0); \
    VRD(4); SBAR(); GAPA(C1 = __builtin_amdgcn_mfma_f32_32x32x16_bf16(kf[1], qr[0], negm, 0, 0, 0), P0[6], P0[7], P0[8], P0[9],     pw0[2] = PKW(P0, 4), pw0[3] = PKW(P0, 6), pw0); \
    VRD(1); SBAR(); GAPA(C0 = __builtin_amdgcn_mfma_f32_32x32x16_bf16(kf[2], qr[1], C0, 0, 0, 0),   P0[10], P0[11], P0[12], P0[13], pw1[0] = PKW(P0, 8), pw1[1] = PKW(P0, 10), pw1); \
    VRD(5); SBAR(); GAPA(C1 = __builtin_amdgcn_mfma_f32_32x32x16_bf16(kf[3], qr[1], C1, 0, 0, 0),   P0[14], P0[15], P1[0], P1[1],   pw1[2] = PKW(P0, 12), pw1[3] = PKW(P0, 14), pw1); \
    VRD(2); SBAR(); GAPA(C0 = __builtin_amdgcn_mfma_f32_32x32x16_bf16(kf[4], qr[2], C0, 0, 0, 0),   P1[2], P1[3], P1[4], P1[5],     pw2[0] = PKW(P1, 0), pw2[1] = PKW(P1, 2), pw2); \
    VRD(6); SBAR(); GAPA(C1 = __builtin_amdgcn_mfma_f32_32x32x16_bf16(kf[5], qr[2], C1, 0, 0, 0),   P1[6], P1[7], P1[8], P1[9],     pw2[2] = PKW(P1, 4), pw2[3] = PKW(P1, 6), pw2); \
    VRD(3); SBAR(); GAPA(C0 = __builtin_amdgcn_mfma_f32_32x32x16_bf16(kf[6], qr[3], C0, 0, 0, 0),   P1[10], P1[11], P1[12], P1[13], pw3[0] = PKW(P1, 8), pw3[1] = PKW(P1, 10), pw3); \
    VRD(7); SBAR(); GAPA(C1 = __builtin_amdgcn_mfma_f32_32x32x16_bf16(kf[7], qr[3], C1, 0, 0, 0),   P1[14], P1[15], 0.f, 0.f,       pw3[2] = PKW(P1, 12), pw3[3] = PKW(P1, 14), pw3); \
    l_reg += sacc; \
    if (GK) { DMA_K((t) + 3, sl_cur); } if (GV) { DMA_V((t) + 1, sl_next); } \
    CMASK(C0, C1, t); \
    { float a = MX3(C0[0], C0[1], C1[0]), b = MX3(C0[2], C0[3], C1[1]); a = MX3(a, C1[2], C1[3]); \
      _Pragma("unroll") for (int r = 4; r < 16; r += 4) { a = MX3(a, C0[r], C0[r + 1]); b = MX3(b, C0[r + 2], C0[r + 3]); a = MX3(a, C1[r], C1[r + 1]); b = MX3(b, C1[r + 2], C1[r + 3]); } \
      float rm = __builtin_fmaxf(a, b); { auto rr = __builtin_amdgcn_permlane32_swap(__float_as_uint(rm), __float_as_uint(rm), false, false); rm = __builtin_fmaxf(__uint_as_float(rr[0]), __uint_as_float(rr[1])); } \
      resc = false; \
      if (__builtin_expect(__any(rm > (float)THRL), 0)) { const float dl = __builtin_fmaxf(rm, 0.f); mhat += dl; \
        _Pragma("unroll") for (int r = 0; r < 16; ++r) { C0[r] -= dl; C1[r] -= dl; } \
        _Pragma("unroll") for (int r = 0; r < 16; ++r) negm[r] = -mhat; asm volatile("" : "+v"(negm)); \
        const float f = __builtin_amdgcn_exp2f(-dl); l_reg *= f; if (hi == 0) wsf[r32] = f; resc = true; } } \
    SBAR(); \
    GAPB(o[0] = __builtin_amdgcn_mfma_f32_32x32x16_bf16(PAF(0), VFR(0), o[0], 0, 0, 0), C0, 0); \
    GAPB(o[1] = __builtin_amdgcn_mfma_f32_32x32x16_bf16(PAF(0), VFR(4), o[1], 0, 0, 0), C0, 4); \
    KRD(GL, 0); GAPB(o[0] = __builtin_amdgcn_mfma_f32_32x32x16_bf16(PAF(1), VFR(1), o[0], 0, 0, 0), C0, 8); \
    KRD(GL, 1); GAPB(o[1] = __builtin_amdgcn_mfma_f32_32x32x16_bf16(PAF(1), VFR(5), o[1], 0, 0, 0), C0, 12); \
    KRD(GL, 2); GAPB(o[0] = __builtin_amdgcn_mfma_f32_32x32x16_bf16(PAF(2), VFR(2), o[0], 0, 0, 0), C1, 0); \
    KRD(GL, 3); GAPB(o[1] = __builtin_amdgcn_mfma_f32_32x32x16_bf16(PAF(2), VFR(6), o[1], 0, 0, 0), C1, 4); \
    GAPB(o[0] = __builtin_amdgcn_mfma_f32_32x32x16_bf16(PAF(3), VFR(3), o[0], 0, 0, 0), C1, 8); \
    GAPB(o[1] = __builtin_amdgcn_mfma_f32_32x32x16_bf16(PAF(3), VFR(7), o[1], 0, 0, 0), C1, 12); \
    } while (0)
    int t = 1;
#undef CMASK
#define CMASK(P0, P1, t) do { } while (0)
    for (; t + 5 < NT; t += 2) {
        STEP(pB0, pB1, pA0, pA1, t, true, true, true);     WAIT_BAR(2); RESC(); ROT();
        STEP(pA0, pA1, pB0, pB1, t + 1, true, true, true); WAIT_BAR(2); RESC(); ROT();
    }
#undef CMASK
#define CMASK(P0, P1, t) do { int jb_ = (t) - (NT - 4); if (jb_ >= 0) bmask(P0, P1, TKB(t), qrel, hi); } while (0)
#define ENDW(tt) do { if ((tt) + 3 < NT) { WAIT_BAR(2); } else if ((tt) + 2 < NT) { WAIT_BAR(1); } else { WAIT_BAR(0); } } while (0)
    for (; t + 1 < NT; t += 2) {
        STEP(pB0, pB1, pA0, pA1, t, (t + 3 < NT), (t + 1 < NT), (t + 1 < NT));     ENDW(t);     RESC(); ROT();
        STEP(pA0, pA1, pB0, pB1, t + 1, (t + 4 < NT), (t + 2 < NT), (t + 2 < NT)); ENDW(t + 1); RESC(); ROT();
    }
    if (has_next) {
        const long rowblkN = (long)nb2 * SEQ + nn2 * 128, ctxrowN = (long)NLAT + nb2 * LCTX; const bf16* KcN = QKV + 1024 + nhk2 * D; const bf16* VcN = QKV + 1280 + nhk2 * D;
        const int T0 = sl_next, T1 = NXS(T0), T2 = NXS(T1);
        glds16(KcN + rowblkN * PITCH + klane, (unsigned)__builtin_amdgcn_readfirstlane(kdst + T0));
        glds16(VcN + rowblkN * PITCH + vlane, (unsigned)__builtin_amdgcn_readfirstlane(vdst + T0));
        glds16(KcN + (rowblkN + 64) * PITCH + klane, (unsigned)__builtin_amdgcn_readfirstlane(kdst + T1));
        glds16(KcN + ctxrowN * PITCH + klane, (unsigned)__builtin_amdgcn_readfirstlane(kdst + T2));
    }
    STEP(pB0, pB1, pA0, pA1, NT - 1, false, false, false); RESC();
    if (has_next) {
        const bf16* QwN = QKV + ((long)nb2 * SEQ + nn2 * 128 + (wid & 3) * QBLK) * PITCH + (4 * nhk2 + 2 * npr2 + (wid >> 2)) * D;
#pragma unroll
        for (int d0 = 0; d0 < 4; ++d0) qr[d0] = *reinterpret_cast<const bf16x8*>(&QwN[(long)r32 * PITCH + d0 * 16 + hi * 8]); }
    { float sacc = pB0[0] + pB0[1]; _Pragma("unroll") for (int r = 2; r < 16; ++r) sacc += pB0[r]; _Pragma("unroll") for (int r = 0; r < 16; ++r) sacc += pB1[r]; l_reg += sacc;
      pw0 = (u32x4){PKW(pB0, 0), PKW(pB0, 2), PKW(pB0, 4), PKW(pB0, 6)}; pw1 = (u32x4){PKW(pB0, 8), PKW(pB0, 10), PKW(pB0, 12), PKW(pB0, 14)}; pw2 = (u32x4){PKW(pB1, 0), PKW(pB1, 2), PKW(pB1, 4), PKW(pB1, 6)}; pw3 = (u32x4){PKW(pB1, 8), PKW(pB1, 10), PKW(pB1, 12), PKW(pB1, 14)};
      SBAR(); pv(o, vb0 + sl_cur, PAF(0), PAF(1), PAF(2), PAF(3)); }
#undef PKW
#undef PAF
#undef VFR
#undef PIN
#undef MX3
#undef GAPA
#undef GAPB
#undef EX
#undef VRD
#undef KRD
#undef STEP
#undef ENDW
    { auto rr = __builtin_amdgcn_permlane32_swap(__float_as_uint(l_reg), __float_as_uint(l_reg), false, false); l_reg = __uint_as_float(rr[0]) + __uint_as_float(rr[1]); }
    l_reg += __builtin_amdgcn_exp2f(sinkp[head] * 1.4426950408889634f - mhat);
    if (hi == 0) wsf[32 + r32] = l_reg; asm volatile("s_waitcnt lgkmcnt(0)" ::: "memory");
    float rli[16];
#pragma unroll
    for (int r = 0; r < 16; ++r) rli[r] = __builtin_amdgcn_rcpf(wsf[32 + crow(r, hi)]);
    unsigned char* Ow = O + (rowblk + (wid & 3) * QBLK) * OPITCH + head * D;
    { bf16* stg = (bf16*)(shm + LDS_OST) + wid * 2048;
#pragma unroll
      for (int r = 0; r < 16; ++r) { const int orow = crow(r, hi);
#pragma unroll
        for (int d0 = 0; d0 < 2; ++d0) stg[orow * 64 + d0 * 32 + r32] = __float2bfloat16(o[d0][r] * rli[r]); }
      asm volatile("s_waitcnt lgkmcnt(0)" ::: "memory");
#pragma unroll
      for (int i = 0; i < 4; ++i) { const int row = i * 8 + (lane >> 3), ch = lane & 7; const u32x4 v = *(const u32x4*)(stg + row * 64 + ch * 8);
        u32x2 w; w.x = pk4f8(__uint_as_float(v.x << 16), __uint_as_float(v.x & 0xffff0000u), __uint_as_float(v.y << 16), __uint_as_float(v.y & 0xffff0000u));
        w.y = pk4f8(__uint_as_float(v.z << 16), __uint_as_float(v.z & 0xffff0000u), __uint_as_float(v.w << 16), __uint_as_float(v.w & 0xffff0000u));
        *(u32x2*)(Ow + (long)row * OPITCH + ch * 8) = w; } }
    asm volatile("s_waitcnt lgkmcnt(0)\n\ts_barrier" ::: "memory");
    return sl_next;
#undef NXS
#undef DMA_K
#undef DMA_V
#undef TROW
#undef TKB
#undef CMASK
#undef START
#undef RESC
#undef ROT
}
#undef SBAR
#undef WAIT_BAR
}

#define XB_TMO      128
#define XB_XCNT(j)  (256  + 64 * (j))
#define XB_XSUB(j)  (1280 + 64 * (j))
#define XB_XGEN(j)  (2304 + 64 * (j))
#define XB_TOP      3328
#define XB_TOPGEN   3392
#define XCD_BAR_WORDS 3456
#define XB_SPIN_CAP (1u << 18)
__device__ __forceinline__ unsigned xb_ld(unsigned* p)              { return __hip_atomic_load(p, __ATOMIC_RELAXED, __HIP_MEMORY_SCOPE_AGENT); }
__device__ __forceinline__ unsigned xb_add(unsigned* p, unsigned v) { return __hip_atomic_fetch_add(p, v, __ATOMIC_RELAXED, __HIP_MEMORY_SCOPE_AGENT); }
__device__ __forceinline__ unsigned xb_xcc_id() { return (unsigned)__builtin_amdgcn_s_getreg((3 << 11) | 20) & 0xFu; }
#define XB_SPIN(cond, bar) do { unsigned _sp = 0; while (cond) { __builtin_amdgcn_s_sleep(1); \
    if ((++_sp & 255u) == 0u) { if (xb_ld(&(bar)[XB_TMO])) break; if (_sp > XB_SPIN_CAP) { atomicAdd(&(bar)[XB_TMO], 1u); break; } } } } while (0)
struct XcdBarrier { unsigned* bar; unsigned x; volatile LAS unsigned* st; };
__device__ __forceinline__ XcdBarrier xcd_barrier_post(unsigned* bar, volatile LAS unsigned* st, int wave_s_) {
    XcdBarrier b; b.bar = bar; b.x = xb_xcc_id(); b.st = st;
    if (tid_of(wave_s_) == 0) (void)xb_add(&bar[XB_XCNT(b.x)], 1u);
    return b;
}
__device__ __forceinline__ void xcd_barrier_complete(unsigned* bar, unsigned x, unsigned& nloc, unsigned& nx) {
    const unsigned G = gridDim.x * gridDim.y * gridDim.z;
    unsigned sum, cnt, mine, sp = 0u;
    for (;;) {
        sum = 0u; cnt = 0u; mine = 0u;
#pragma unroll
        for (unsigned j = 0; j < 16; ++j) { const unsigned c = xb_ld(&bar[XB_XCNT(j)]); sum += c; cnt += (c > 0u) ? 1u : 0u; mine = (j == x) ? c : mine; }
        if (sum == G) break;
        __builtin_amdgcn_s_sleep(1);
        if ((++sp & 255u) == 0u) { if (xb_ld(&bar[XB_TMO])) break; if (sp > XB_SPIN_CAP) { atomicAdd(&bar[XB_TMO], 1u); break; } }
    }
    nloc = mine > 0u ? mine : 1u; nx = cnt > 0u ? cnt : 1u;
}
__device__ __forceinline__ void xcd_barrier(const XcdBarrier& b, int wave_s_) {
    asm volatile("s_waitcnt vmcnt(0)" ::: "memory");
    __syncthreads();
    if (tid_of(wave_s_) == 0) {
        unsigned* bar = b.bar;
        __builtin_amdgcn_s_waitcnt(0);
        unsigned nloc = b.st[0], nx = b.st[1];
        if (nloc == 0u) { xcd_barrier_complete(bar, b.x, nloc, nx); b.st[0] = nloc; b.st[1] = nx; }
        const unsigned old = xb_add(&bar[XB_XSUB(b.x)], 1u);
        const unsigned gen = old / nloc;
        if (old + 1u == (gen + 1u) * nloc) {
            __builtin_amdgcn_fence(__ATOMIC_RELEASE, "agent");
            asm volatile("s_waitcnt vmcnt(0)" ::: "memory");
            const unsigned og = xb_add(&bar[XB_TOP], 1u);
            const unsigned tg = og / nx;
            if (og + 1u == (tg + 1u) * nx) xb_add(&bar[XB_TOPGEN], 1u);
            else XB_SPIN(xb_ld(&bar[XB_TOPGEN]) == tg, bar);
            xb_add(&bar[XB_XGEN(b.x)], 1u);
            __builtin_amdgcn_fence(__ATOMIC_ACQUIRE, "agent");
            asm volatile("s_waitcnt vmcnt(0)" ::: "memory");
        } else {
            XB_SPIN(xb_ld(&bar[XB_XGEN(b.x)]) == gen, bar);
            __builtin_amdgcn_fence(__ATOMIC_ACQUIRE, "agent");
            asm volatile("s_waitcnt vmcnt(0)" ::: "memory");
        }
    }
    __syncthreads();
}

#define LDS_WAIT() asm volatile("s_waitcnt lgkmcnt(0)" ::: "memory")
__device__ __forceinline__ void transpose_item(const float* W, int K, int N, bf16_t* WT, int k0, int n0, int drow0, LAS float* scr, int lane) {
    float t[32];
#pragma unroll
    for (int i = 0; i < 32; ++i) t[i] = __builtin_nontemporal_load(W + (size_t)(k0 + 2 * i + (lane >> 5)) * N + n0 + (lane & 31));
#pragma unroll
    for (int i = 0; i < 32; ++i) scr[(2 * i + (lane >> 5)) * 33 + (lane & 31)] = t[i];
    LDS_WAIT(); asm volatile("" ::: "memory");
    const int c = lane & 7;
#pragma unroll
    for (int j = 0; j < 4; ++j) { const int n = (lane >> 3) + 8 * j; const LAS float* s = scr + (8 * c) * 33 + n;
        u32x4 o; o.x = pkbf(s[0 * 33], s[1 * 33]); o.y = pkbf(s[2 * 33], s[3 * 33]); o.z = pkbf(s[4 * 33], s[5 * 33]); o.w = pkbf(s[6 * 33], s[7 * 33]);
        *(GAS u32x4*)(WT + (size_t)(drow0 + n) * K + k0 + 8 * c) = o; }
    LDS_WAIT(); asm volatile("" ::: "memory");
}
__device__ __forceinline__ void transpose_item_f8(const float* W, int K, int N, unsigned char* WT, int k0, int n0, int drow0, float scale, LAS float* scr, int lane) {
    float t[32];
#pragma unroll
    for (int i = 0; i < 32; ++i) t[i] = __builtin_nontemporal_load(W + (size_t)(k0 + 2 * i + (lane >> 5)) * N + n0 + (lane & 31));
#pragma unroll
    for (int i = 0; i < 32; ++i) scr[(2 * i + (lane >> 5)) * 33 + (lane & 31)] = t[i];
    LDS_WAIT(); asm volatile("" ::: "memory");
    const int n = lane >> 1, hf = lane & 1; const LAS float* sp = scr + (32 * hf) * 33 + n;
    u32x4 o0, o1;
    o0.x = pk4f8(sp[0 * 33] * scale, sp[1 * 33] * scale, sp[2 * 33] * scale, sp[3 * 33] * scale);     o0.y = pk4f8(sp[4 * 33] * scale, sp[5 * 33] * scale, sp[6 * 33] * scale, sp[7 * 33] * scale);
    o0.z = pk4f8(sp[8 * 33] * scale, sp[9 * 33] * scale, sp[10 * 33] * scale, sp[11 * 33] * scale);   o0.w = pk4f8(sp[12 * 33] * scale, sp[13 * 33] * scale, sp[14 * 33] * scale, sp[15 * 33] * scale);
    o1.x = pk4f8(sp[16 * 33] * scale, sp[17 * 33] * scale, sp[18 * 33] * scale, sp[19 * 33] * scale); o1.y = pk4f8(sp[20 * 33] * scale, sp[21 * 33] * scale, sp[22 * 33] * scale, sp[23 * 33] * scale);
    o1.z = pk4f8(sp[24 * 33] * scale, sp[25 * 33] * scale, sp[26 * 33] * scale, sp[27 * 33] * scale); o1.w = pk4f8(sp[28 * 33] * scale, sp[29 * 33] * scale, sp[30 * 33] * scale, sp[31 * 33] * scale);
    GAS u32x4* dst = (GAS u32x4*)(WT + (size_t)(drow0 + n) * K + k0 + 32 * hf);
    dst[0] = o0; dst[1] = o1;
    LDS_WAIT(); asm volatile("" ::: "memory");
}
__device__ __forceinline__ void transpose_item_f6(const float* W, int K, int N, unsigned char* WT, int k0, int n0, int drow0, LAS float* scr, int lane) {
    float t[32];
#pragma unroll
    for (int i = 0; i < 32; ++i) t[i] = __builtin_nontemporal_load(W + (size_t)(k0 + 2 * i + (lane >> 5)) * N + n0 + (lane & 31));
#pragma unroll
    for (int i = 0; i < 32; ++i) scr[(2 * i + (lane >> 5)) * 33 + (lane & 31)] = t[i];
    LDS_WAIT(); asm volatile("" ::: "memory");
    const int n = lane >> 1, hf = lane & 1; const LAS float* sp = scr + (32 * hf) * 33 + n;
    float x[32];
#pragma unroll
    for (int i = 0; i < 32; ++i) x[i] = sp[i * 33];
    u32x4 c0, c1; mxfp6_block(x, c0, c1);
    const int kb32 = (k0 >> 5) + hf; unsigned char* dst = WT + (size_t)(drow0 + n) * K + (kb32 >> 2) * 128 + (kb32 & 3) * 16;
    *(GAS u32x4*)dst = c0; *(GAS u32x4*)(dst + 64) = c1;
    LDS_WAIT(); asm volatile("" ::: "memory");
}
__device__ __forceinline__ unsigned pk4i8(float a, float b, float c, float d) {
    const int ia = (int)__builtin_rintf(a), ib = (int)__builtin_rintf(b), ic = (int)__builtin_rintf(c), id = (int)__builtin_rintf(d);
    return (unsigned)(ia & 255) | ((unsigned)(ib & 255) << 8) | ((unsigned)(ic & 255) << 16) | ((unsigned)(id & 255) << 24); }
__device__ __forceinline__ void transpose_item_i8(const float* W, int K, int N, unsigned char* WT, int k0, int n0, int drow0, float scale, LAS float* scr, int lane) {
    float t[32];
#pragma unroll
    for (int i = 0; i < 32; ++i) t[i] = W[(size_t)(k0 + 2 * i + (lane >> 5)) * N + n0 + (lane & 31)];
#pragma unroll
    for (int i = 0; i < 32; ++i) scr[(2 * i + (lane >> 5)) * 33 + (lane & 31)] = t[i];
    LDS_WAIT(); asm volatile("" ::: "memory");
    const int n = lane >> 1, hf = lane & 1; const LAS float* sp = scr + (32 * hf) * 33 + n;
    u32x4 o0, o1;
    o0.x = pk4i8(sp[0 * 33] * scale, sp[1 * 33] * scale, sp[2 * 33] * scale, sp[3 * 33] * scale);     o0.y = pk4i8(sp[4 * 33] * scale, sp[5 * 33] * scale, sp[6 * 33] * scale, sp[7 * 33] * scale);
    o0.z = pk4i8(sp[8 * 33] * scale, sp[9 * 33] * scale, sp[10 * 33] * scale, sp[11 * 33] * scale);   o0.w = pk4i8(sp[12 * 33] * scale, sp[13 * 33] * scale, sp[14 * 33] * scale, sp[15 * 33] * scale);
    o1.x = pk4i8(sp[16 * 33] * scale, sp[17 * 33] * scale, sp[18 * 33] * scale, sp[19 * 33] * scale); o1.y = pk4i8(sp[20 * 33] * scale, sp[21 * 33] * scale, sp[22 * 33] * scale, sp[23 * 33] * scale);
    o1.z = pk4i8(sp[24 * 33] * scale, sp[25 * 33] * scale, sp[26 * 33] * scale, sp[27 * 33] * scale); o1.w = pk4i8(sp[28 * 33] * scale, sp[29 * 33] * scale, sp[30 * 33] * scale, sp[31 * 33] * scale);
    GAS u32x4* dst = (GAS u32x4*)(WT + (size_t)(drow0 + n) * K + k0 + 32 * hf);
    dst[0] = o0; dst[1] = o1;
    LDS_WAIT(); asm volatile("" ::: "memory");
}
__device__ __forceinline__ void i8_item_load(float (&t)[32], const float* src, int N, int lane) {
#pragma unroll
    for (int i = 0; i < 32; ++i) t[i] = src[(size_t)(2 * i + (lane >> 5)) * N + (lane & 31)];
}
__device__ __forceinline__ void i8_item_finish(const float (&t)[32], unsigned char* dst, int K, float scale, LAS float* scr, int lane) {
#pragma unroll
    for (int i = 0; i < 32; ++i) scr[(2 * i + (lane >> 5)) * 33 + (lane & 31)] = t[i];
    LDS_WAIT(); asm volatile("" ::: "memory");
    const int n = lane >> 1, hf = lane & 1; const LAS float* sp = scr + (32 * hf) * 33 + n;
    u32x4 o0, o1;
    o0.x = pk4i8(sp[0 * 33] * scale, sp[1 * 33] * scale, sp[2 * 33] * scale, sp[3 * 33] * scale);     o0.y = pk4i8(sp[4 * 33] * scale, sp[5 * 33] * scale, sp[6 * 33] * scale, sp[7 * 33] * scale);
    o0.z = pk4i8(sp[8 * 33] * scale, sp[9 * 33] * scale, sp[10 * 33] * scale, sp[11 * 33] * scale);   o0.w = pk4i8(sp[12 * 33] * scale, sp[13 * 33] * scale, sp[14 * 33] * scale, sp[15 * 33] * scale);
    o1.x = pk4i8(sp[16 * 33] * scale, sp[17 * 33] * scale, sp[18 * 33] * scale, sp[19 * 33] * scale); o1.y = pk4i8(sp[20 * 33] * scale, sp[21 * 33] * scale, sp[22 * 33] * scale, sp[23 * 33] * scale);
    o1.z = pk4i8(sp[24 * 33] * scale, sp[25 * 33] * scale, sp[26 * 33] * scale, sp[27 * 33] * scale); o1.w = pk4i8(sp[28 * 33] * scale, sp[29 * 33] * scale, sp[30 * 33] * scale, sp[31 * 33] * scale);
    GAS u32x4* d = (GAS u32x4*)(dst + (size_t)n * K + 32 * hf);
    d[0] = o0; d[1] = o1;
    LDS_WAIT(); asm volatile("" ::: "memory");
}
__device__ __forceinline__ void q8_decode(int it, const float* w_in, const float* w_qkv, const float* w_g, const float* w_u, unsigned char* WINq, unsigned char* WQKVq, unsigned char* WGUq,
                                          float a_in, float a_qkv, float a_g, float a_u, const float*& src, int& N, unsigned char*& dst, float& sc) {
    if (it < 16 * 64) { const int kb = it / 64, nb = it % 64; N = 2048; src = w_in + (size_t)(64 * kb) * N + 32 * nb; dst = WINq + (size_t)(32 * nb) * 1024 + 64 * kb; sc = 127.0f / a_in; return; }
    it -= 16 * 64;
    if (it < 16 * 48) { const int kb = it / 48, nb = it % 48; N = NQKV; src = w_qkv + (size_t)(64 * kb) * N + 32 * nb; dst = WQKVq + (size_t)(32 * nb) * 1024 + 64 * kb; sc = 127.0f / a_qkv; return; }
    it -= 16 * 48;
    const int up = it / (16 * 112), q = it % (16 * 112), kb = q / 112, nb = q % 112, n0 = 32 * nb; N = DFF;
    src = (up ? w_u : w_g) + (size_t)(64 * kb) * N + n0; dst = WGUq + (size_t)(256 * (n0 >> 7) + 128 * up + (n0 & 127)) * 1024 + 64 * kb; sc = 127.0f / (up ? a_u : a_g);
}
__device__ __forceinline__ void sincos_d(double x, double& s, double& c) {
    const double TWO_PI = 6.283185307179586476925;
    const double k = __builtin_rint(x / TWO_PI); const double r = x - k * TWO_PI;
    const double r2 = r * r; double ts = r, tc = 1.0; s = r; c = 1.0;
    for (int i = 1; i <= 16; ++i) { tc *= -r2 / (double)((2 * i - 1) * (2 * i)); ts *= -r2 / (double)((2 * i) * (2 * i + 1)); c += tc; s += ts; }
}

constexpr int CI_F = 16 * 112, CI_FD = 56 * 32, MOE_ITEMS = 8 * (2 * CI_F + CI_FD);
constexpr int MOE_TAIL_A = 12000, MOE_TAIL_B = 7000, MOE_TAIL_C = 12000, MOE_TAIL_TOTAL = MOE_TAIL_A + MOE_TAIL_B + MOE_TAIL_C;
__device__ __forceinline__ void moe_convert_item(int r, const float* wg, const float* wu, const float* wd, unsigned char* mgu, unsigned char* md, LAS float* scr, int lane) {
    const int e = r / (2 * CI_F + CI_FD); int q = r % (2 * CI_F + CI_FD);
    if (q < 2 * CI_F) { const int up = q / CI_F; q %= CI_F; const int kb = q / 112, nb = q % 112, n0 = 32 * nb;
        transpose_item_f6((up ? wu : wg) + (size_t)e * 1024 * DFF, 1024, DFF, mgu + (size_t)e * 7168 * 1024, 64 * kb, n0, 256 * (n0 >> 7) + 128 * up + (n0 & 127), scr, lane); }
    else { q -= 2 * CI_F; const int kb = q / 32, nb = q % 32; transpose_item_f6(wd + (size_t)e * DFF * 1024, DFF, 1024, md + (size_t)e * 1024 * DFF, 64 * kb, 32 * nb, 32 * nb, scr, lane); }
}
__device__ __forceinline__ void moe_item_decode(int r, const float* wg, const float* wu, const float* wd, unsigned char* mgu, unsigned char* md, const float*& src, int& N, unsigned char*& dst, int& K) {
    const int e = r / (2 * CI_F + CI_FD); int q = r % (2 * CI_F + CI_FD);
    const float* W; unsigned char* WT; int k0, n0, drow0;
    if (q < 2 * CI_F) { const int up = q / CI_F; q %= CI_F; const int kb = q / 112, nb = q % 112; n0 = 32 * nb; k0 = 64 * kb;
        W = (up ? wu : wg) + (size_t)e * 1024 * DFF; K = 1024; N = DFF; WT = mgu + (size_t)e * 7168 * 1024; drow0 = 256 * (n0 >> 7) + 128 * up + (n0 & 127); }
    else { q -= 2 * CI_F; const int kb = q / 32, nb = q % 32; n0 = 32 * nb; k0 = 64 * kb; W = wd + (size_t)e * DFF * 1024; K = DFF; N = 1024; WT = md + (size_t)e * 1024 * DFF; drow0 = n0; }
    src = W + (size_t)k0 * N + n0; dst = WT + (size_t)drow0 * K + (k0 >> 7) * 128 + ((k0 >> 5) & 3) * 16;
}
__device__ __forceinline__ void moe_item_load(float (&t)[32], const float* src, int N, int lane) {
#pragma unroll
    for (int i = 0; i < 32; ++i) t[i] = __builtin_nontemporal_load(src + (size_t)(2 * i + (lane >> 5)) * N + (lane & 31));
}
__device__ __forceinline__ void moe_item_finish(const float (&t)[32], unsigned char* dst, int K, LAS float* scr, int lane) {
#pragma unroll
    for (int i = 0; i < 32; ++i) scr[(2 * i + (lane >> 5)) * 33 + (lane & 31)] = t[i];
    LDS_WAIT(); asm volatile("" ::: "memory");
    const int n = lane >> 1, hf = lane & 1; const LAS float* sp = scr + (32 * hf) * 33 + n;
    float x[32];
#pragma unroll
    for (int i = 0; i < 32; ++i) x[i] = sp[i * 33];
    u32x4 c0, c1; mxfp6_block(x, c0, c1);
    unsigned char* d = dst + (size_t)n * K + hf * 16;
    *(GAS u32x4*)d = c0; *(GAS u32x4*)(d + 64) = c1;
    LDS_WAIT(); asm volatile("" ::: "memory");
}
__device__ __forceinline__ void moe_convert_tail(int nunits, int G, int bx, int first, int count, const float* wg, const float* wu, const float* wd, unsigned char* mgu, unsigned char* md, LAS unsigned char* lds, int wave_s_) {
    const int busy = nunits % G; if (busy == 0 || bx < busy) return;
    int tid_ = tid_of(wave_s_); asm volatile("" : "+v"(tid_)); const int lane = tid_ & 63, wave = __builtin_amdgcn_readfirstlane(tid_ >> 6);
    LAS float* scr = (LAS float*)(lds + wave * 16384);
    const int nw = (G - busy) * 8, w = (bx - busy) * 8 + wave;
    int it = w; if (it >= count) return;
    float tA[32], tB[32]; const float* sA; const float* sB; unsigned char* dA; unsigned char* dB; int NA, NB2, KA, KB;
    moe_item_decode(first + it, wg, wu, wd, mgu, md, sA, NA, dA, KA); moe_item_load(tA, sA, NA, lane);
    for (;;) {
        const int itB = it + nw; const bool hasB = itB < count;
        if (hasB) { moe_item_decode(first + itB, wg, wu, wd, mgu, md, sB, NB2, dB, KB); moe_item_load(tB, sB, NB2, lane); }
        moe_item_finish(tA, dA, KA, scr, lane);
        if (!hasB) break;
        it = itB + nw; const bool hasA = it < count;
        if (hasA) { moe_item_decode(first + it, wg, wu, wd, mgu, md, sA, NA, dA, KA); moe_item_load(tA, sA, NA, lane); }
        moe_item_finish(tB, dB, KB, scr, lane);
        if (!hasA) break;
    }
}

struct Args { const float* in[24]; float* out; unsigned char* ws; int ph_lo, ph_hi, li, pad; };
constexpr int NPH = 18;

__device__ __forceinline__ void norm_store(const f32x4 (&v)[4], float ssum, const float* g, const float* mrow, int shc, int scc, bf16_t* XNo, size_t m, int lane, float* rsc) {
    const float rstd = 1.0f / __builtin_sqrtf(ssum * (1.0f / DM) + EPS);
    f32x4 y[4];
#pragma unroll
    for (int j = 0; j < 4; ++j) { const f32x4 gv = *(const f32x4*)(g + 4 * lane + 256 * j), sc = *(const f32x4*)(mrow + scc * 1024 + 4 * lane + 256 * j), sh = *(const f32x4*)(mrow + shc * 1024 + 4 * lane + 256 * j);
        y[j] = (v[j] * rstd) * gv * (sc + 1.0f) + sh; }
    if (rsc == nullptr) {
#pragma unroll
        for (int j = 0; j < 4; ++j) { u32x2 w; w.x = pkbf(y[j].x, y[j].y); w.y = pkbf(y[j].z, y[j].w); *((GAS u32x2*)(XNo + m * DM) + lane + 64 * j) = w; }
    } else {
        float mx = 0.f;
#pragma unroll
        for (int j = 0; j < 4; ++j) mx = __builtin_fmaxf(__builtin_fmaxf(mx, __builtin_fmaxf(__builtin_fabsf(y[j].x), __builtin_fabsf(y[j].y))), __builtin_fmaxf(__builtin_fabsf(y[j].z), __builtin_fabsf(y[j].w)));
        mx = wave_allmax(mx);
        mx = __builtin_fmaxf(mx, 1e-20f); const float qs = 127.0f / mx;
#pragma unroll
        for (int j = 0; j < 4; ++j) *((GAS unsigned*)((unsigned char*)XNo + m * DM) + lane + 64 * j) = pk4i8(y[j].x * qs, y[j].y * qs, y[j].z * qs, y[j].w * qs);
        if (lane == 0) rsc[m] = mx * (1.0f / 127.0f);
    }
}
template <bool SRC_BF16> __device__ __forceinline__ void norm_rows(const void* srcLv, const float* srcC, int nrows, const float* g, const float* mod, int shc, int scc, bf16_t* XNo, int gw, int NGW, int lane,
                                          const bf16_t* part, int nS, const float* gatec, float* zout, float* rsc, int g1) {
    const bool bal = (NGW == 2048) && (nrows > NLAT);
    const int wv = gw & 7, cu = gw >> 3;
    if (nrows > NLAT) {
        for (int rc = bal ? (wv < 4 ? cu * 4 + wv : NCTXR) : gw; rc < NCTXR; rc += bal ? NCTXR : NGW) {
            const GAS f32x4* xr = (const GAS f32x4*)(srcC + (size_t)rc * DM) + lane;
            f32x4 v[4];
#pragma unroll
            for (int j = 0; j < 4; ++j) v[j] = xr[64 * j];
            if (part != nullptr) {
                f32x4 a[4];
#pragma unroll
                for (int j = 0; j < 4; ++j) a[j] = (f32x4){0.f, 0.f, 0.f, 0.f};
                for (int s0 = 0; s0 < nS; s0 += 7) {
                    u32x2 t[7][4];
#pragma unroll
                    for (int q = 0; q < 7; ++q) { const int s2 = (s0 + q < nS) ? s0 + q : s0; const GAS u32x2* pr = (const GAS u32x2*)(part + ((size_t)s2 * NCTXR + rc) * DM) + lane;
#pragma unroll
                        for (int j = 0; j < 4; ++j) t[q][j] = pr[64 * j]; }
#pragma unroll
                    for (int q = 0; q < 7; ++q) if (s0 + q < nS) {
#pragma unroll
                        for (int j = 0; j < 4; ++j) a[j] += (f32x4){__uint_as_float(t[q][j].x << 16), __uint_as_float(t[q][j].x & 0xffff0000u), __uint_as_float(t[q][j].y << 16), __uint_as_float(t[q][j].y & 0xffff0000u)}; }
                }
#pragma unroll
                for (int j = 0; j < 4; ++j) v[j] += *(const f32x4*)(gatec + 4 * lane + 256 * j) * a[j];
                if (zout != nullptr) { GAS f32x4* zr = (GAS f32x4*)(zout + (size_t)rc * DM) + lane;
#pragma unroll
                    for (int j = 0; j < 4; ++j) zr[64 * j] = v[j]; }
            }
            float ss = 0.f;
#pragma unroll
            for (int j = 0; j < 4; ++j) ss += (v[j].x * v[j].x + v[j].y * v[j].y) + (v[j].z * v[j].z + v[j].w * v[j].w);
            norm_store(v, wave_sum(ss), g, mod + (size_t)4 * 6144, shc, scc, XNo, (size_t)NLAT + rc, lane, rsc);
        }
    }
    for (int k = 0;; ++k) {
        int grp;
        if (bal) { if (wv < 4) { if (k >= g1) break; grp = (cu * 4 + wv) * g1 + k; } else { if (k >= 8 - g1) break; grp = 1024 * g1 + (cu * 4 + wv - 4) * (8 - g1) + k; } }
        else { grp = gw + k * NGW; if (grp >= NLAT / 4) break; }
        const int m0 = grp * 4;
        const int mb = m0 >> 13;
        f32x4 v[4][4];
        if constexpr (SRC_BF16) { const GAS u32x2* xr = (const GAS u32x2*)((const bf16_t*)srcLv + (size_t)m0 * DM) + lane;
#pragma unroll
            for (int r = 0; r < 4; ++r)
#pragma unroll
                for (int j = 0; j < 4; ++j) { const u32x2 w = xr[r * 256 + 64 * j]; v[r][j] = (f32x4){__uint_as_float(w.x << 16), __uint_as_float(w.x & 0xffff0000u), __uint_as_float(w.y << 16), __uint_as_float(w.y & 0xffff0000u)}; } }
        else { const GAS f32x4* xr = (const GAS f32x4*)((const float*)srcLv + (size_t)m0 * DM) + lane;
#pragma unroll
            for (int r = 0; r < 4; ++r)
#pragma unroll
                for (int j = 0; j < 4; ++j) v[r][j] = xr[r * 256 + 64 * j]; }
        float ss[4];
#pragma unroll
        for (int r = 0; r < 4; ++r) { ss[r] = 0.f;
#pragma unroll
            for (int j = 0; j < 4; ++j) ss[r] += (v[r][j].x * v[r][j].x + v[r][j].y * v[r][j].y) + (v[r][j].z * v[r][j].z + v[r][j].w * v[r][j].w); }
#pragma unroll
        for (int r = 0; r < 4; ++r) ss[r] = wave_allsum(ss[r]);
#pragma unroll
        for (int r = 0; r < 4; ++r) norm_store(v[r], ss[r], g, mod + (size_t)mb * 6144, shc, scc, XNo, (size_t)(m0 + r), lane, rsc);
    }
}

__global__ void __launch_bounds__(512, 2) fwd(Args args) {
    extern __shared__ __attribute__((aligned(16))) unsigned char lds_raw[];
    LAS unsigned char* lds = (LAS unsigned char*)lds_raw;
    volatile LAS unsigned* MISC = (volatile LAS unsigned*)(lds + MISC_OFF);
    LAS int* gtab = (LAS int*)(lds + GTAB_OFF);
    const int wave_s_ = __builtin_amdgcn_readfirstlane((int)threadIdx.x >> 6);
    const int G = gridDim.x; const int bx = blockIdx.x; const int vcu = (G % 8 == 0) ? (bx % 8) * (G / 8) + bx / 8 : bx;
    const int NGW = G * 8;
#define PHASE_IDS() int tid_ = tid_of(wave_s_); asm volatile("" : "+v"(tid_)); const int tid = tid_, lane = tid & 63, wave = __builtin_amdgcn_readfirstlane(tid >> 6), gw = vcu * 8 + wave; (void)lane; (void)gw
    unsigned char* ws = args.ws;
    gu32* ctl = (gu32*)(ws + WS_CTL);
#define MOD ((float*)(ws + WS_MOD))
#define ROPE ((float*)(ws + WS_ROPE))
#define STATS ((float*)(ws + WS_STATS))
#define RSC ((float*)(ws + WS_RSC))
#define LIST ((int*)(ws + WS_LIST))
#define TINFO ((int*)(ws + WS_TINFO))
#define WSB ((bf16_t*)(ws + WS_WS))
#define WIN ((unsigned char*)(ws + WS_WIN))
#define WAO ((bf16_t*)(ws + WS_WAO))
#define WQKV ((unsigned char*)(ws + WS_WQKV))
#define WBO ((unsigned char*)(ws + WS_WBO))
#define WGU ((unsigned char*)(ws + WS_WGU))
#define WD ((bf16_t*)(ws + WS_WD))
#define MGU ((unsigned char*)(ws + WS_MGU))
#define MD ((unsigned char*)(ws + WS_MD))
#define XN8 ((unsigned char*)(ws + WS_XN))
#define XN ((bf16_t*)(ws + WS_XN))
#define ZB ((float*)(ws + WS_ZB))
#define UVT ((bf16_t*)(ws + WS_UVT))
#define A2 ((bf16_t*)(ws + WS_A2))
#define HB ((bf16_t*)(ws + WS_H))
#define QKV ((bf16_t*)(ws + WS_QKV))
#define OB ((unsigned char*)(ws + WS_O))
#define YB ((bf16_t*)(ws + WS_Y))
#define HC ((unsigned char*)(ws + WS_HC))
#define YP ((bf16_t*)(ws + WS_YP))
#define PART1 ((float*)(ws + WS_PART1))
#define PART2 ((float*)(ws + WS_PART2))
#define I_X (args.in[0])
#define I_C (args.in[1])
#define I_CTX (args.in[2])
#define I_CCTX (args.in[3])
#define I_ADAW (args.in[4])
#define I_ADAB (args.in[5])
#define I_NORMG (args.in[6])
#define I_FINALG (args.in[7])
#define HL ((bf16_t*)(ws + WS_HLB))

    { PHASE_IDS(); for (int u = tid; u < (LDS_BYTES - MISC_OFF) / 4; u += 512) ((LAS unsigned*)(lds + MISC_OFF))[u] = 0u; }
    __syncthreads();
    const int lo = args.ph_lo, hi_ph = args.ph_hi;
    const bool one_launch = (hi_ph - lo) > 1;
    XcdBarrier bar; bar.bar = (unsigned*)(ctl + CW_BAR) + args.li * XCD_BAR_WORDS; bar.x = 0; bar.st = nullptr;
    if (one_launch) bar = xcd_barrier_post((unsigned*)(ctl + CW_BAR) + args.li * XCD_BAR_WORDS, MISC + 8, wave_s_);
#ifndef PHMASK
#define PHMASK 0xFFFFFFFFu
#endif
#define IN(k) (((PHMASK >> (k)) & 1) && lo <= (k) && (k) < hi_ph)
#define BOTH(k) (IN(k) && IN((k) + 1))
#define GRID_BAR() xcd_barrier(bar, wave_s_)
#if defined(PROBE_LO)
    unsigned long long tpA = __builtin_amdgcn_s_memrealtime(), tpB = 0;
#define PROBE_MARK(k) do { if ((k) == PROBE_LO - 1) tpA = __builtin_amdgcn_s_memrealtime(); if ((k) == PROBE_HI) tpB = __builtin_amdgcn_s_memrealtime(); } while (0)
#else
#define PROBE_MARK(k) do { } while (0)
#endif

    if (IN(0)) {
        PHASE_IDS();
        {
            LAS float* sv = (LAS float*)lds;
            LAS float* red = (LAS float*)(lds + 5 * 1024 * 4);
            if (bx < 192) {
                for (int idx = tid; idx < 5 * 1024; idx += 512) { const int r = idx >> 10, k = idx & 1023; const float cv = r < 4 ? I_C[r * 1024 + k] : I_CCTX[k]; sv[idx] = cv / (1.0f + __expf(-cv)); }
                __syncthreads();
                for (int item = bx; item < 192; item += G) {
                    const int i = item / 96, n0 = (item % 96) * 64, nn = tid & 63, kq = tid >> 6;
                    float a0 = 0.f, a1 = 0.f, a2 = 0.f, a3 = 0.f, a4 = 0.f;
                    const float* wp = I_ADAW + ((size_t)i * 1024 + kq * 128) * 6144 + n0 + nn;
#pragma unroll 8
                    for (int k = 0; k < 128; ++k) { const float w = wp[(size_t)k * 6144]; const int kk = kq * 128 + k;
                        a0 += sv[kk] * w; a1 += sv[1024 + kk] * w; a2 += sv[2048 + kk] * w; a3 += sv[3072 + kk] * w; a4 += sv[4096 + kk] * w; }
                    red[(kq * 5 + 0) * 64 + nn] = a0; red[(kq * 5 + 1) * 64 + nn] = a1; red[(kq * 5 + 2) * 64 + nn] = a2; red[(kq * 5 + 3) * 64 + nn] = a3; red[(kq * 5 + 4) * 64 + nn] = a4;
                    __syncthreads();
                    if (tid < 320) { const int r = tid >> 6; float s = I_ADAB[i * 6144 + n0 + nn];
#pragma unroll
                        for (int q = 0; q < 8; ++q) s += red[(q * 5 + r) * 64 + nn];
                        MOD[((size_t)i * 5 + r) * 6144 + n0 + nn] = s; }
                    __syncthreads();
                }
            }
            __syncthreads();
        }
        {
            LAS float* scr = (LAS float*)(lds + wave * 16384);
            constexpr int I_IN = 16 * 64, I_AO = 16 * 32, I_QKV = 16 * 48, I_BO = 16 * 32, I_F = 16 * 112, I_FD = 56 * 32;
            constexpr int I_DENSE = I_IN + I_AO + I_QKV + I_BO + 2 * I_F + I_FD, I_MOE = MOE_ITEMS, I_WS = 128, I_ROPE = 32;
            constexpr int NITEMS = I_DENSE + I_MOE + I_WS + I_ROPE;
            for (int it = gw; it < NITEMS; it += NGW) {
                int r = it;
                if (r < I_IN) { const int kb = r / 64, nb = r % 64; const float* W = args.in[8]; float mx = 0.f;
#pragma unroll
                    for (int i = 0; i < 32; ++i) mx = __builtin_fmaxf(mx, __builtin_fabsf(W[(size_t)(64 * kb + 2 * i + (lane >> 5)) * 2048 + 32 * nb + (lane & 31)]));
                    mx = wave_allmax(mx);
                    if (lane == 0) __hip_atomic_fetch_max((unsigned*)(ctl + CW_WAMAX + 192), __float_as_uint(mx), __ATOMIC_RELAXED, __HIP_MEMORY_SCOPE_AGENT);
                    continue; } r -= I_IN;
                if (r < I_AO) { const int kb = r / 32, nb = r % 32; transpose_item(args.in[13], 1024, 1024, WAO, 64 * kb, 32 * nb, 32 * nb, scr, lane); continue; } r -= I_AO;
                if (r < I_QKV) { const int kb = r / 48, nb = r % 48; const float* W = args.in[14]; float mx = 0.f;
#pragma unroll
                    for (int i = 0; i < 32; ++i) mx = __builtin_fmaxf(mx, __builtin_fabsf(W[(size_t)(64 * kb + 2 * i + (lane >> 5)) * NQKV + 32 * nb + (lane & 31)]));
                    mx = wave_allmax(mx);
                    if (lane == 0) __hip_atomic_fetch_max((unsigned*)(ctl + CW_WAMAX + 128), __float_as_uint(mx), __ATOMIC_RELAXED, __HIP_MEMORY_SCOPE_AGENT);
                    continue; } r -= I_QKV;
                if (r < I_BO) { const int kb = r / 32, nb = r % 32; transpose_item_f8(args.in[16], 1024, 1024, WBO, 64 * kb, 32 * nb, 32 * nb, MOE_SGU, scr, lane); continue; } r -= I_BO;
                if (r < 2 * I_F) { const int up = r / I_F; const int q = r % I_F; const int kb = q / 112, nb = q % 112;
                    const float* W = args.in[17 + up]; float mx = 0.f;
#pragma unroll
                    for (int i = 0; i < 32; ++i) mx = __builtin_fmaxf(mx, __builtin_fabsf(W[(size_t)(64 * kb + 2 * i + (lane >> 5)) * DFF + 32 * nb + (lane & 31)]));
                    mx = wave_allmax(mx);
                    if (lane == 0) __hip_atomic_fetch_max((unsigned*)(ctl + CW_WAMAX + 64 * up), __float_as_uint(mx), __ATOMIC_RELAXED, __HIP_MEMORY_SCOPE_AGENT);
                    continue; } r -= 2 * I_F;
                if (r < I_FD) { const int kb = r / 32, nb = r % 32; transpose_item(args.in[19], DFF, 1024, WD, 64 * kb, 32 * nb, 32 * nb, scr, lane); continue; } r -= I_FD;
                if (r < I_MOE) { if (r >= MOE_TAIL_TOTAL) moe_convert_item(r, args.in[21], args.in[22], args.in[23], MGU, MD, scr, lane); continue; } r -= I_MOE;
                if (r < I_WS) { const float* src = args.in[11] + (size_t)r * 2048;
#pragma unroll
                    for (int j = 0; j < 8; ++j) { const f32x4 v = *(const f32x4*)(src + j * 256 + lane * 4); u32x2 w; w.x = pkbf(v.x, v.y); w.y = pkbf(v.z, v.w); *(u32x2*)(WSB + (size_t)r * 2048 + j * 256 + lane * 4) = w; }
                    continue; } r -= I_WS;
                {
                    const int ent = r * 64 + lane; const int pos = ent >> 4, i = ent & 15;
                    double inv = 1.0; for (int q = 0; q < i; ++q) inv *= 0.56234132519034908;
                    const float ang = (float)pos * (float)inv; double s, c; sincos_d((double)ang, s, c);
                    ROPE[ent] = (float)c; ROPE[2048 + ent] = (float)s;
                }
            }
        }
        if (BOTH(0)) GRID_BAR(); PROBE_MARK(0);
    }
    if (IN(1)) { PHASE_IDS();
        {
            LAS float* scr = (LAS float*)(lds + wave * 16384);
            unsigned am_ = 0u; if (lane < 4) am_ = __hip_atomic_load((unsigned*)(ctl + CW_WAMAX + 64 * lane), __ATOMIC_RELAXED, __HIP_MEMORY_SCOPE_AGENT);
            const float ag = __uint_as_float((unsigned)__builtin_amdgcn_readlane((int)am_, 0)), au = __uint_as_float((unsigned)__builtin_amdgcn_readlane((int)am_, 1));
            if (gw == 0 && lane == 0) { RSC[MALL] = ag * (1.0f / 127.0f); RSC[MALL + 1] = au * (1.0f / 127.0f); }
            const float ai_ = __uint_as_float((unsigned)__builtin_amdgcn_readlane((int)am_, 3));
            if (gw == 0 && lane == 0) RSC[MALL + 3] = ai_ * (1.0f / 127.0f);
            const float aq = __uint_as_float((unsigned)__builtin_amdgcn_readlane((int)am_, 2));
            if (gw == 0 && lane == 0) RSC[MALL + 2] = aq * (1.0f / 127.0f);
            constexpr int Q_IN = 16 * 64, Q_QKV = 16 * 48, Q_GU = 2 * 16 * 112, Q_ALL = Q_IN + Q_QKV + Q_GU;
            if (gw < Q_ALL) {
                float tA[32], tB[32]; const float* sA; const float* sB; unsigned char* dA; unsigned char* dB; int NA, NB2; float cA, cB;
                int it = gw; q8_decode(it, args.in[8], args.in[14], args.in[17], args.in[18], (unsigned char*)WIN, (unsigned char*)WQKV, (unsigned char*)WGU, ai_, aq, ag, au, sA, NA, dA, cA); i8_item_load(tA, sA, NA, lane);
                for (;;) {
                    const int itB = it + NGW; const bool hasB = itB < Q_ALL;
                    if (hasB) { q8_decode(itB, args.in[8], args.in[14], args.in[17], args.in[18], (unsigned char*)WIN, (unsigned char*)WQKV, (unsigned char*)WGU, ai_, aq, ag, au, sB, NB2, dB, cB); i8_item_load(tB, sB, NB2, lane); }
                    i8_item_finish(tA, dA, 1024, cA, scr, lane);
                    if (!hasB) break;
                    it = itB + NGW; const bool hasA = it < Q_ALL;
                    if (hasA) { q8_decode(it, args.in[8], args.in[14], args.in[17], args.in[18], (unsigned char*)WIN, (unsigned char*)WQKV, (unsigned char*)WGU, ai_, aq, ag, au, sA, NA, dA, cA); i8_item_load(tA, sA, NA, lane); }
                    i8_item_finish(tB, dB, 1024, cB, scr, lane);
                    if (!hasA) break;
                }
            }
        }
        norm_rows<false>(I_X, I_CTX, MALL, I_NORMG + 0 * 1024, MOD, 0, 1, XN, gw, NGW, lane, nullptr, 0, nullptr, nullptr, RSC, 4); if (BOTH(1)) GRID_BAR(); PROBE_MARK(1); }
    if (IN(2)) {
        pg8::DenseSched S{(const char*)WIN, (const char*)XN8, 8, NPA, G, bx, (size_t)256 * 1024};
        const float wq_in = __int_as_float(__builtin_amdgcn_readfirstlane(__float_as_int(RSC[MALL + 3])));
        pg8::EpiGeluT E{UVT, STATS, RSC, wq_in};
        pg8::gemm_phase<pg8::EpiGeluT, pg8::DenseSched, true, false, false, true>(wave_s_, lds, gtab, 512, 8, S, E);
        moe_convert_tail(8 * NPA, G, bx, 0, MOE_TAIL_A, args.in[21], args.in[22], args.in[23], MGU, MD, lds, wave_s_);
        if (BOTH(2)) GRID_BAR(); PROBE_MARK(2);
    }
    if (IN(3)) {
        PHASE_IDS();
        const float* vg = args.in[9]; const float* vb = args.in[10]; const float* bs = args.in[12];
        LAS unsigned char* buf = lds + wave * 16384;
        LAS float* mu_l = (LAS float*)(lds + RING_BYTES + 4096 + wave * 1024); LAS float* rs_l = mu_l + 128;
        const int r32 = lane & 31, h = lane >> 5;
        constexpr int NCG = (MALL / 128) * 16;
        const int nfullr = NCG / NGW;
        const int nover = 2 * (NCG - nfullr * NGW);
        for (int k = 0; k <= nfullr; ++k) {
            int cg, phb, phe;
            if (k < nfullr) { cg = gw + k * NGW; phb = 0; phe = 2; }
            else if (nover <= (NGW >> 3)) { const int hu = gw >> 3; if ((gw & 7) != 0 || hu >= nover) break;
                cg = nfullr * NGW + (hu >> 1); phb = hu & 1; phe = phb + 1; }
            else { cg = nfullr * NGW + gw; if (cg >= NCG) break; phb = 0; phe = 2; }
            const int g = cg & 15, ch = cg >> 4, q0 = ch * 128;
#pragma unroll
            for (int tt = 0; tt < 2; ++tt) { const int tok = q0 + lane * 2 + tt; const f32x4* sp = (const f32x4*)(STATS + (size_t)tok * 16);
                const f32x4 a = sp[0], b = sp[1], c = sp[2], d = sp[3];
                const float sum = (a.x + a.z) + (b.x + b.z) + (c.x + c.z) + (d.x + d.z), sq = (a.y + a.w) + (b.y + b.w) + (c.y + c.w) + (d.y + d.w);
                const float mean = sum * (1.0f / 1024.0f), var = sq * (1.0f / 1024.0f) - mean * mean;
                mu_l[lane * 2 + tt] = mean; rs_l[lane * 2 + tt] = 1.0f / __builtin_sqrtf(var + EPS); }
            {
                u32x4 t[16]; const int rw = lane >> 4, ck = lane & 15;
                const bf16_t* vp = UVT + (size_t)(1024 + 64 * g + rw) * MALL + q0 + ck * 8;
#pragma unroll
                for (int i = 0; i < 16; ++i) { t[i] = *(const u32x4*)vp; vp += (size_t)4 * MALL; asm volatile("" : "+v"(vp)); }
#pragma unroll
                for (int i = 0; i < 16; ++i) { const int row = 4 * i + rw; *(LAS u32x4*)(buf + row * 256 + ((ck ^ (row & 15)) << 4)) = t[i]; }
            }
            bf16x8 af[2][8];
#pragma unroll
            for (int ct = 0; ct < 2; ++ct) { const int row = 32 * ct + r32; const float vgc = vg[64 * g + row], vbc = vb[64 * g + row];
#pragma unroll
                for (int s2 = 0; s2 < 8; ++s2) { const int qs = 16 * s2 + 8 * h, ck = 2 * s2 + h;
                    const f32x4 m0 = *(const LAS f32x4*)(mu_l + qs), m1 = *(const LAS f32x4*)(mu_l + qs + 4), r0 = *(const LAS f32x4*)(rs_l + qs), r1 = *(const LAS f32x4*)(rs_l + qs + 4);
                    const bf16x8 raw = *(const LAS bf16x8*)(buf + row * 256 + ((ck ^ (row & 15)) << 4));
                    float y[8];
#pragma unroll
                    for (int j = 0; j < 4; ++j) { y[j] = (bf2f((unsigned short)raw[j]) - m0[j]) * r0[j] * vgc + vbc; y[4 + j] = (bf2f((unsigned short)raw[4 + j]) - m1[j]) * r1[j] * vgc + vbc; }
                    u32x4 w; w.x = pkbf(y[0], y[1]); w.y = pkbf(y[2], y[3]); w.z = pkbf(y[4], y[5]); w.w = pkbf(y[6], y[7]); af[ct][s2] = __builtin_bit_cast(bf16x8, w); } }
            for (int ph = phb; ph < phe; ++ph) {
            {
                u32x4 t[8]; const int rw = lane >> 3, ck = lane & 7;
                const bf16_t* up = UVT + (size_t)(64 * g + rw) * MALL + q0 + 64 * ph + ck * 8;
#pragma unroll
                for (int i = 0; i < 8; ++i) { t[i] = *(const u32x4*)up; up += (size_t)8 * MALL; asm volatile("" : "+v"(up)); }
#pragma unroll
                for (int i = 0; i < 8; ++i) { const int row = 8 * i + rw; *(LAS u32x4*)(buf + row * 128 + ((ck ^ (row & 7)) << 4)) = t[i]; }
            }
#pragma unroll
            for (int ptl = 0; ptl < 2; ++ptl) {
                const int pl = 32 * ptl + r32, p = 64 * ph + pl; const float bsv = bs[g * 128 + p];
                bf16x8 bfr[8];
#pragma unroll
                for (int s2 = 0; s2 < 8; ++s2) bfr[s2] = *(const bf16x8*)(WSB + (size_t)(g * 128 + p) * 128 + 16 * s2 + 8 * h);
                f32x16 acc[2]; acc[0] = f32x16{}; acc[1] = f32x16{};
#pragma unroll
                for (int s2 = 0; s2 < 8; ++s2)
#pragma unroll
                    for (int ct = 0; ct < 2; ++ct) acc[ct] = __builtin_amdgcn_mfma_f32_32x32x16_bf16(af[ct][s2], bfr[s2], acc[ct], 0, 0, 0);
#pragma unroll
                for (int ct = 0; ct < 2; ++ct)
#pragma unroll
                    for (int rr = 0; rr < 4; ++rr) { const int c = 32 * ct + 8 * rr + 4 * h; float o[4];
#pragma unroll
                        for (int e = 0; e < 4; ++e) { const int cc = c + e; const float uu = bf2f(*(const LAS unsigned short*)(buf + cc * 128 + (((pl >> 3) ^ (cc & 7)) << 4) + (pl & 7) * 2)); o[e] = uu * (acc[ct][4 * rr + e] + bsv); }
                        u32x2 w; w.x = pkbf(o[0], o[1]); w.y = pkbf(o[2], o[3]);
                        *(LAS u32x2*)(buf + 8192 + pl * 128 + (((c >> 3) ^ (pl & 7)) << 4) + (c & 7) * 2) = w; }
            }
            {
                const int rw = lane >> 3, ck = lane & 7;
#pragma unroll
                for (int i = 0; i < 8; ++i) { const int row = 8 * i + rw; const u32x4 v = *(const LAS u32x4*)(buf + 8192 + row * 128 + ((ck ^ (row & 7)) << 4));
                    *(u32x4*)(A2 + (size_t)(q0 + 64 * ph + row) * DM + 64 * g + ck * 8) = v; }
            }
            }
        }
        if (BOTH(3)) GRID_BAR(); PROBE_MARK(3);
    }
    if (IN(4)) {
        { pg8::DenseSched S{(const char*)A2, (const char*)WAO, NPL, 4, G, bx, (size_t)256 * 1024 * 2};
          pg8::EpiResid<true> E{I_X, nullptr, HL, MOD + 2 * 1024, 1.0f};
          pg8::gemm_phase<pg8::EpiResid<true>, pg8::DenseSched, true, false>(wave_s_, lds, gtab, 1024, 16, S, E); }
        { pg8::SplitSched S{(const char*)(A2 + (size_t)NLAT * DM), (const char*)WAO, 4, 4, P3_NS, G, bx, NPL, (size_t)256 * 1024 * 2, (size_t)(1024 / P3_NS) * 2};
          pg8::EpiPartBf16 E{(bf16_t*)PART1, (size_t)NCTXR * DM, 1.0f};
          pg8::gemm_phase<pg8::EpiPartBf16, pg8::SplitSched, true, false>(wave_s_, lds, gtab, 1024, 1024 / P3_NS / 64, S, E); }
        if (BOTH(4)) GRID_BAR(); PROBE_MARK(4);
    }
    if (IN(5)) { PHASE_IDS(); norm_rows<true>(HL, I_CTX, MALL, I_NORMG + 1 * 1024, MOD, 3, 4, XN, gw, NGW, lane, (const bf16_t*)PART1, P3_NS, MOD + 4 * 6144 + 2 * 1024, ZB, RSC, 3); if (BOTH(5)) GRID_BAR(); PROBE_MARK(5); }
    if (IN(6)) {
        pg8::DenseSched S{(const char*)XN8, (const char*)WGU, NPA, 28, G, bx, (size_t)256 * 1024};
        const float wq_g = __int_as_float(__builtin_amdgcn_readfirstlane(__float_as_int(RSC[MALL]))), wq_u = __int_as_float(__builtin_amdgcn_readfirstlane(__float_as_int(RSC[MALL + 1])));
        pg8::EpiSwiGLUI8 E{HB, RSC, wq_g, wq_u};
        pg8::gemm_phase<pg8::EpiSwiGLUI8, pg8::DenseSched, true, false, false, true>(wave_s_, lds, gtab, 512, 8, S, E);
        moe_convert_tail(NPA * 28, G, bx, MOE_TAIL_A, MOE_TAIL_B, args.in[21], args.in[22], args.in[23], MGU, MD, lds, wave_s_);
        if (BOTH(6)) GRID_BAR(); PROBE_MARK(6);
    }
    if (IN(7)) {
        { pg8::DenseSched S{(const char*)HB, (const char*)WD, NPL, 4, G, bx, (size_t)256 * DFF * 2};
          pg8::EpiResid<false> E{nullptr, HL, HL, MOD + 5 * 1024, 1.0f};
          pg8::gemm_phase<pg8::EpiResid<false>, pg8::DenseSched, true, false>(wave_s_, lds, gtab, DFF, 56, S, E); }
        { pg8::SplitSched S{(const char*)(HB + (size_t)NLAT * DFF), (const char*)WD, 4, 4, P5_NS, G, bx, NPL, (size_t)256 * DFF * 2, (size_t)(DFF / P5_NS) * 2};
          pg8::EpiPartBf16 E{(bf16_t*)PART2, (size_t)NCTXR * DM, 1.0f};
          pg8::gemm_phase<pg8::EpiPartBf16, pg8::SplitSched, true, false>(wave_s_, lds, gtab, DFF, DFF / P5_NS / 64, S, E); }
        if (BOTH(7)) GRID_BAR(); PROBE_MARK(7);
    }
    if (IN(8)) { PHASE_IDS(); norm_rows<true>(HL, ZB, MALL, I_NORMG + 2 * 1024, MOD + 5 * 6144, 0, 1, XN, gw, NGW, lane, (const bf16_t*)PART2, P5_NS, MOD + 4 * 6144 + 5 * 1024, nullptr, RSC, 2); if (BOTH(8)) GRID_BAR(); PROBE_MARK(8); }
    if (IN(9)) {
        { PHASE_IDS(); LAS float* colt = (LAS float*)(lds + ROPC_OFF);
          *(LAS f32x4*)(colt + 4 * tid) = *(const f32x4*)(ROPE + (tid < 256 ? 0 : 2048 - 1024) + 4 * tid); __syncthreads(); }
        pg8::DenseSched S{(const char*)XN8, (const char*)WQKV, NPA, 6, G, bx, (size_t)256 * 1024};
        const float wq_qkv = __int_as_float(__builtin_amdgcn_readfirstlane(__float_as_int(RSC[MALL + 2])));
        pg8::EpiQKV E{QKV, ROPE, attn_body::C2, RSC, wq_qkv, (const LAS float*)(lds + ROPC_OFF)};
        pg8::gemm_phase<pg8::EpiQKV, pg8::DenseSched, true, false, false, true>(wave_s_, lds, gtab, 512, 8, S, E);
        moe_convert_tail(NPA * 6, G, bx, MOE_TAIL_A + MOE_TAIL_B, MOE_TAIL_C, args.in[21], args.in[22], args.in[23], MGU, MD, lds, wave_s_);
        if (BOTH(9)) GRID_BAR(); PROBE_MARK(9);
    }
    if (IN(10)) {
        static_assert(attn_body::LDS_BYTES_A <= RING_BYTES, "attention LDS");
        const float* sinkp = args.in[15];
        int sb = 0; bool pre = false; bf16x8 qfr[4];
#pragma unroll
        for (int d0 = 0; d0 < 4; ++d0) qfr[d0] = bf16x8{};
        for (int i = 0;; ++i) { const int uid = i * G + vcu; if (uid >= NB * 64 * 4 * 2) break;
            const int pr = uid & 1, hk = (uid >> 1) & 3, n = (uid >> 3) & 63, b = uid >> 9;
            const int uid2 = uid + G; const bool has_next = uid2 < NB * 64 * 4 * 2;
            sb = attn_body::attn_unit<8>(wave_s_, b, hk, n, pr, (const attn_body::bf16*)QKV, OB, sinkp, (char*)lds_raw, sb, pre, has_next, uid2 >> 9, (uid2 >> 1) & 3, (uid2 >> 3) & 63, uid2 & 1, qfr);
            pre = has_next; }
        if (BOTH(10)) GRID_BAR(); PROBE_MARK(10);
    }
    if (IN(11)) {
        pg8::DenseSched S{(const char*)OB, (const char*)WBO, NPL, 4, G, bx, (size_t)256 * 1024};
        pg8::EpiResid<false> E{nullptr, HL, HL, MOD + 5 * 6144 + 2 * 1024, 1.0f / MOE_SGU};
        pg8::gemm_phase<pg8::EpiResid<false>, pg8::DenseSched, true, false, true>(wave_s_, lds, gtab, 512, 8, S, E);
        if (BOTH(11)) GRID_BAR(); PROBE_MARK(11);
    }
    if (IN(12)) {
        PHASE_IDS();
        const float* g = I_NORMG + 3 * 1024; const float* mod = MOD + 5 * 6144; const float* wrt = args.in[20];
        LAS int* l_e = (LAS int*)lds;
        LAS float* l_w = (LAS float*)(lds + 1024);
        LAS int* l_cnt = (LAS int*)(lds + 2048);
        LAS int* l_base = (LAS int*)(lds + 2048 + 64);
        LAS unsigned char* rowb = lds + 8192 + wave * 9216;
        LAS f32x4* wrl = (LAS f32x4*)(lds + 90112);
        for (int u = tid; u < 2048; u += 512) { const int ln = u & 63, hf = (u >> 6) & 1, cc = (u >> 7) & 3, j = u >> 9; wrl[u] = *(const f32x4*)(wrt + (size_t)(4 * ln + 256 * j + cc) * 8 + 4 * hf); }
        __syncthreads();
        for (int blk = bx; blk < NLAT / 128; blk += G) {
            if (tid < 8) l_cnt[tid] = 0;
            __syncthreads();
            const int mb = (blk * 128) >> 13; const float* mrow = mod + (size_t)mb * 6144;
            u32x2 nx[2][4];
            { const GAS u32x2* xr = (const GAS u32x2*)(HL + (size_t)(blk * 128 + wave * 16) * DM) + lane;
#pragma unroll
              for (int r = 0; r < 2; ++r)
#pragma unroll
                for (int j = 0; j < 4; ++j) nx[r][j] = xr[r * 256 + 64 * j]; }
            for (int i4 = 0; i4 < 8; ++i4) {
                const int tl0 = wave * 16 + i4 * 2, m0 = blk * 128 + tl0;
                f32x4 v[2][4]; float ss[2];
#pragma unroll
                for (int r = 0; r < 2; ++r)
#pragma unroll
                    for (int j = 0; j < 4; ++j) { const u32x2 w = nx[r][j]; v[r][j] = (f32x4){__uint_as_float(w.x << 16), __uint_as_float(w.x & 0xffff0000u), __uint_as_float(w.y << 16), __uint_as_float(w.y & 0xffff0000u)}; }
                if (i4 < 7) { const GAS u32x2* xr = (const GAS u32x2*)(HL + (size_t)(m0 + 2) * DM) + lane;
#pragma unroll
                    for (int r = 0; r < 2; ++r)
#pragma unroll
                        for (int j = 0; j < 4; ++j) nx[r][j] = xr[r * 256 + 64 * j]; }
#pragma unroll
                for (int r = 0; r < 2; ++r) { ss[r] = 0.f;
#pragma unroll
                    for (int j = 0; j < 4; ++j) ss[r] += (v[r][j].x * v[r][j].x + v[r][j].y * v[r][j].y) + (v[r][j].z * v[r][j].z + v[r][j].w * v[r][j].w); }
#pragma unroll
                for (int r = 0; r < 2; ++r) ss[r] = wave_allsum(ss[r]);
                float lg[2][8];
#pragma unroll
                for (int r = 0; r < 2; ++r)
#pragma unroll
                    for (int e = 0; e < 8; ++e) lg[r][e] = 0.f;
#pragma unroll
                for (int j = 0; j < 4; ++j) { const int col = 4 * lane + 256 * j; const f32x4 gv = *(const f32x4*)(g + col), sc = *(const f32x4*)(mrow + 4 * 1024 + col), sh = *(const f32x4*)(mrow + 3 * 1024 + col);
                    const f32x4 gm = gv * (sc + 1.0f);
                    f32x4 y[2];
#pragma unroll
                    for (int r = 0; r < 2; ++r) { const float rstd = 1.0f / __builtin_sqrtf(ss[r] * (1.0f / DM) + EPS); y[r] = (v[r][j] * rstd) * gm + sh;
                        *(LAS f32x4*)(rowb + r * 4608 + (8 * j + (lane >> 3)) * 144 + (lane & 7) * 16) = y[r]; }
#pragma unroll
                    for (int cc = 0; cc < 4; ++cc) { const f32x4 w0 = wrl[((j * 4 + cc) * 2 + 0) * 64 + lane], w1 = wrl[((j * 4 + cc) * 2 + 1) * 64 + lane];
#pragma unroll
                        for (int r = 0; r < 2; ++r) { const float yv = y[r][cc];
                            lg[r][0] += yv * w0.x; lg[r][1] += yv * w0.y; lg[r][2] += yv * w0.z; lg[r][3] += yv * w0.w; lg[r][4] += yv * w1.x; lg[r][5] += yv * w1.y; lg[r][6] += yv * w1.z; lg[r][7] += yv * w1.w; } } }
                {
                    const int rr = lane >> 5, bb = lane & 31; const LAS f32x4* bp = (const LAS f32x4*)(rowb + rr * 4608 + bb * 144);
                    float xb[32];
#pragma unroll
                    for (int q = 0; q < 8; ++q) { const f32x4 v4 = bp[q]; xb[4 * q] = v4.x; xb[4 * q + 1] = v4.y; xb[4 * q + 2] = v4.z; xb[4 * q + 3] = v4.w; }
                    u32x4 c0, c1; mxfp6_block(xb, c0, c1);
                    unsigned char* dst = XN8 + (size_t)(m0 + rr) * DM + (bb >> 2) * 128 + (bb & 3) * 16;
                    *(GAS u32x4*)dst = c0; *(GAS u32x4*)(dst + 64) = c1;
                }
#pragma unroll
                for (int r = 0; r < 2; ++r)
#pragma unroll
                    for (int e = 0; e < 8; ++e) lg[r][e] = wave_allsum(lg[r][e]);
#pragma unroll
                for (int r = 0; r < 2; ++r) {
                    int ea = 0; float va = lg[r][0];
#pragma unroll
                    for (int e = 1; e < 8; ++e) if (lg[r][e] > va) { va = lg[r][e]; ea = e; }
                    int eb = -1; float vb2 = -INFINITY;
#pragma unroll
                    for (int e = 0; e < 8; ++e) if (e != ea && lg[r][e] > vb2) { vb2 = lg[r][e]; eb = e; }
                    const float wb = 1.0f / (1.0f + __expf(va - vb2)), wa = 1.0f - wb;
                    if (lane == 0) { const int tl = tl0 + r; l_e[tl * 2] = ea; l_e[tl * 2 + 1] = eb; l_w[tl * 2] = wa; l_w[tl * 2 + 1] = wb; } }
            }
            __syncthreads();
            int ea = 0, eb = 0, pa = 0, pb = 0;
            if (tid < 128) { ea = l_e[tid * 2]; eb = l_e[tid * 2 + 1]; pa = atomicAdd((int*)&l_cnt[ea], 1); pb = atomicAdd((int*)&l_cnt[eb], 1); }
            __syncthreads();
            if (tid < 8) l_base[tid] = (int)__hip_atomic_fetch_add((unsigned*)(ctl + CW_CNT + 64 * tid), (unsigned)l_cnt[tid], __ATOMIC_RELAXED, __HIP_MEMORY_SCOPE_AGENT);
            __syncthreads();
            if (tid < 128) { const int m = blk * 128 + tid; pa += l_base[ea]; pb += l_base[eb];
                LIST[(size_t)ea * NLAT + pa] = m; LIST[(size_t)eb * NLAT + pb] = m;
                int* ti = TINFO + (size_t)m * 8; ti[0] = ea; ti[1] = pa; ti[2] = eb; ti[3] = pb; ti[4] = __float_as_int(l_w[tid * 2]); ti[5] = __float_as_int(l_w[tid * 2 + 1]); }
            __syncthreads();
        }
        if (BOTH(12)) GRID_BAR(); PROBE_MARK(12);
    }
    if (hi_ph > 13 && lo < 17) {
        PHASE_IDS();
        LAS int* mtab = (LAS int*)(lds + MOE_OFF);
        if (tid < 64) {
            int cl = 0; if (lane < 8) cl = (int)__hip_atomic_load((unsigned*)(ctl + CW_CNT + 64 * lane), __ATOMIC_RELAXED, __HIP_MEMORY_SCOPE_AGENT);
            int run = 0, R = 0;
#pragma unroll
            for (int e = 0; e < 8; ++e) { const int ce = __builtin_amdgcn_readlane(cl, e); if (tid == 0) { mtab[e] = run; mtab[16 + e] = ce; if (ce & 255) mtab[24 + R] = e; } run += ce >> 8; if (ce & 255) ++R; }
            if (tid == 0) { mtab[8] = run; mtab[32] = R; } }
        __syncthreads();
        const int nfull = __builtin_amdgcn_readfirstlane(mtab[8]);
        for (int c = 0; c < MOE_NCH; ++c) {
            const int gp0 = c * MOE_CH, gp1 = nfull < (c + 1) * MOE_CH ? nfull : (c + 1) * MOE_CH;
            if (IN(13 + 2 * c)) {
                { pg8::MoeSched S; S.A = (const char*)XN8; S.B = (const char*)MGU; S.list = LIST; S.tab = mtab; S.mode = 0; S.nS = 1; S.kbytes = 0; S.omoff = 0;
                  S.gp0 = gp0; S.gp1 = gp1; S.nN = 28; S.G = G; S.c = bx; S.bexp = (size_t)7168 * 1024; S.btile = (size_t)256 * 1024; S.astep = 0; S.gather = true;
                  pg8::EpiSwiGLU6 E{HC};
                  pg8::gemm_phase<pg8::EpiSwiGLU6, pg8::MoeSched, true, true, false, false, true>(wave_s_, lds, gtab, 512, 8, S, E); }
                if (c == 0) { pg8::MoeSched S; S.A = (const char*)XN8; S.B = (const char*)MGU; S.list = LIST; S.tab = mtab; S.mode = 1; S.nS = 1; S.kbytes = 0; S.omoff = MOE_CH;
                  S.gp0 = 0; S.gp1 = 0; S.nN = 28; S.G = G; S.c = bx; S.bexp = (size_t)7168 * 1024; S.btile = (size_t)256 * 1024; S.astep = 0; S.gather = true;
                  pg8::EpiSwiGLU6 E{HC};
                  pg8::gemm_phase<pg8::EpiSwiGLU6, pg8::MoeSched, true, true, false, false, true>(wave_s_, lds, gtab, 512, 8, S, E); }
                if (BOTH(13 + 2 * c)) GRID_BAR(); PROBE_MARK(13 + 2 * c);
            }
            if (IN(14 + 2 * c)) {
                { pg8::MoeSched S; S.A = (const char*)HC; S.B = (const char*)MD; S.list = LIST; S.tab = mtab; S.mode = 0; S.nS = 1; S.kbytes = 0; S.omoff = 0;
                  S.gp0 = gp0; S.gp1 = gp1; S.nN = 4; S.G = G; S.c = bx; S.bexp = (size_t)1024 * DFF; S.btile = (size_t)256 * DFF; S.astep = (size_t)256 * DFF; S.gather = false;
                  pg8::EpiBf16Plain E{YB, DM, 1.0f};
                  pg8::gemm_phase<pg8::EpiBf16Plain, pg8::MoeSched, true, false, false, false, true>(wave_s_, lds, gtab, DFF / 2, 28, S, E); }
                if (c == 0) { pg8::MoeSched S; S.A = (const char*)(HC + (size_t)MOE_CH * 256 * DFF); S.B = (const char*)MD; S.list = LIST; S.tab = mtab; S.mode = 2; S.nS = MOE_RS; S.kbytes = (size_t)(DFF / MOE_RS); S.omoff = 0;
                  S.gp0 = 0; S.gp1 = 0; S.nN = 4; S.G = G; S.c = bx; S.bexp = (size_t)1024 * DFF; S.btile = (size_t)256 * DFF; S.astep = (size_t)256 * DFF; S.gather = false;
                  pg8::EpiPartBf16 E{YP, (size_t)8 * 256 * DM, 1.0f};
                  pg8::gemm_phase<pg8::EpiPartBf16, pg8::MoeSched, true, false, false, false, true>(wave_s_, lds, gtab, DFF / 2, DFF / MOE_RS / 128, S, E); }
                if (BOTH(14 + 2 * c)) GRID_BAR(); PROBE_MARK(14 + 2 * c);
            }
        }
    }
    if (IN(17)) {
        PHASE_IDS();
        LAS int* l_pb = (LAS int*)(lds + wave * 128);
        {
            int cl = 0; if (lane < 8) cl = (int)__hip_atomic_load((unsigned*)(ctl + CW_CNT + 64 * lane), __ATOMIC_RELAXED, __HIP_MEMORY_SCOPE_AGENT);
            int run = 0, R = 0;
#pragma unroll
            for (int e = 0; e < 8; ++e) { const int ce = __builtin_amdgcn_readlane(cl, e); if (lane == 0) { l_pb[e] = run; l_pb[8 + e] = ce >> 8; l_pb[16 + e] = R; } run += ce >> 8; if (ce & 255) ++R; } }
        const float* g2 = MOD + 5 * 6144 + 5 * 1024;
        for (int m0 = gw * 2; m0 < NLAT; m0 += NGW * 2) {
            const int mb = m0 >> 13;
            f32x4 hv[2][4], ya[2][4], yb[2][4]; float wa[2], wb[2];
#pragma unroll
            for (int r = 0; r < 2; ++r) {
                const int m = m0 + r; const int* ti = TINFO + (size_t)m * 8;
                const int ea = ti[0], pa = ti[1], eb = ti[2], pb = ti[3]; wa[r] = __int_as_float(ti[4]); wb[r] = __int_as_float(ti[5]);
                const bool ma = (pa >> 8) < l_pb[8 + ea], mbm = (pb >> 8) < l_pb[8 + eb];
                const size_t sa = ma ? (size_t)(l_pb[ea] + (pa >> 8)) * 256 + (pa & 255) : (size_t)l_pb[16 + ea] * 256 + (pa & 255);
                const size_t sb = mbm ? (size_t)(l_pb[eb] + (pb >> 8)) * 256 + (pb & 255) : (size_t)l_pb[16 + eb] * 256 + (pb & 255);
                const GAS u32x2* xr = (const GAS u32x2*)(HL + (size_t)m * DM) + lane;
#pragma unroll
                for (int j = 0; j < 4; ++j) { const u32x2 w = xr[64 * j]; hv[r][j] = (f32x4){__uint_as_float(w.x << 16), __uint_as_float(w.x & 0xffff0000u), __uint_as_float(w.y << 16), __uint_as_float(w.y & 0xffff0000u)}; }
                { const GAS u32x2* yr = (const GAS u32x2*)((ma ? YB : YP) + sa * DM) + lane;
#pragma unroll
                  for (int j = 0; j < 4; ++j) { const u32x2 a = yr[64 * j]; ya[r][j] = (f32x4){__uint_as_float(a.x << 16), __uint_as_float(a.x & 0xffff0000u), __uint_as_float(a.y << 16), __uint_as_float(a.y & 0xffff0000u)}; }
                  if (!ma) for (int s2 = 1; s2 < MOE_RS; ++s2) { const GAS u32x2* y2 = (const GAS u32x2*)(YP + ((size_t)s2 * 8 * 256 + sa) * DM) + lane;
#pragma unroll
                      for (int j = 0; j < 4; ++j) { const u32x2 a = y2[64 * j]; ya[r][j] += (f32x4){__uint_as_float(a.x << 16), __uint_as_float(a.x & 0xffff0000u), __uint_as_float(a.y << 16), __uint_as_float(a.y & 0xffff0000u)}; } } }
                { const GAS u32x2* yr = (const GAS u32x2*)((mbm ? YB : YP) + sb * DM) + lane;
#pragma unroll
                  for (int j = 0; j < 4; ++j) { const u32x2 a = yr[64 * j]; yb[r][j] = (f32x4){__uint_as_float(a.x << 16), __uint_as_float(a.x & 0xffff0000u), __uint_as_float(a.y << 16), __uint_as_float(a.y & 0xffff0000u)}; }
                  if (!mbm) for (int s2 = 1; s2 < MOE_RS; ++s2) { const GAS u32x2* y2 = (const GAS u32x2*)(YP + ((size_t)s2 * 8 * 256 + sb) * DM) + lane;
#pragma unroll
                      for (int j = 0; j < 4; ++j) { const u32x2 a = y2[64 * j]; yb[r][j] += (f32x4){__uint_as_float(a.x << 16), __uint_as_float(a.x & 0xffff0000u), __uint_as_float(a.y << 16), __uint_as_float(a.y & 0xffff0000u)}; } } }
            }
            float ss[2];
#pragma unroll
            for (int r = 0; r < 2; ++r) { ss[r] = 0.f;
#pragma unroll
                for (int j = 0; j < 4; ++j) { const f32x4 gv = *(const f32x4*)(g2 + (size_t)mb * 6144 + 4 * lane + 256 * j);
                    hv[r][j] = hv[r][j] + gv * (ya[r][j] * wa[r] + yb[r][j] * wb[r]); ss[r] += (hv[r][j].x * hv[r][j].x + hv[r][j].y * hv[r][j].y) + (hv[r][j].z * hv[r][j].z + hv[r][j].w * hv[r][j].w); } }
#pragma unroll
            for (int r = 0; r < 2; ++r) ss[r] = wave_allsum(ss[r]);
#pragma unroll
            for (int r = 0; r < 2; ++r) { const float rstd = 1.0f / __builtin_sqrtf(ss[r] * (1.0f / DM) + EPS);
                GAS f32x4* orow = (GAS f32x4*)(args.out + (size_t)(m0 + r) * DM) + lane;
#pragma unroll
                for (int j = 0; j < 4; ++j) { const f32x4 fg = *(const f32x4*)(I_FINALG + 4 * lane + 256 * j); __builtin_nontemporal_store((hv[r][j] * rstd) * fg, orow + 64 * j); } }
        }
    }
    PROBE_MARK(17);
#if defined(PROBE_LO)
    { PHASE_IDS(); const float T = (float)(tpB - tpA) * 0.01f; const float cval = __builtin_sqrtf(T / (float)(PROBE_UNIT));
      for (int m = gw; m < NLAT; m += NGW) { GAS f32x4* orow = (GAS f32x4*)(args.out + (size_t)m * DM) + lane;
#pragma unroll
        for (int j = 0; j < 4; ++j) orow[64 * j] = (f32x4){cval, cval, cval, cval}; } }
#endif
#undef IN
#undef BOTH
#undef GRID_BAR
}

#ifndef MK_ONE_LAUNCH
#define MK_ONE_LAUNCH 1
#endif
extern "C" void kernel_launch(void* const* d_in, const int* in_sizes, int n_in, void* d_out, int out_size, void* d_ws, size_t ws_size, hipStream_t stream) {
    static int grid = 0;
    if (grid == 0) {
        if (n_in != 24 || out_size != NLAT * DM || ws_size < WS_END) { fprintf(stderr, "kernel_launch: unexpected problem (n_in %d, out %d, ws %zu < %zu)\n", n_in, out_size, ws_size, (size_t)WS_END); grid = -1; return; }
        int dev = 0, cus = 0, per_cu = 0;
        if (hipGetDevice(&dev) != hipSuccess || hipDeviceGetAttribute(&cus, hipDeviceAttributeMultiprocessorCount, dev) != hipSuccess) { grid = -1; return; }
        if (hipFuncSetAttribute((const void*)fwd, hipFuncAttributeMaxDynamicSharedMemorySize, LDS_BYTES) != hipSuccess) { fprintf(stderr, "kernel_launch: hipFuncSetAttribute failed\n"); grid = -1; return; }
        if (hipOccupancyMaxActiveBlocksPerMultiprocessor(&per_cu, (const void*)fwd, 512, LDS_BYTES) != hipSuccess || per_cu < 1) fprintf(stderr, "kernel_launch: occupancy query says %d\n", per_cu);
        (void)hipGetLastError();
        grid = cus;
    }
    if (grid < 0) return;
#if defined(DUPK) || defined(SPLITAT)
    const size_t ctl_zero = CTL_ZERO_BYTES;
#else
    const size_t ctl_zero = 64 * 1024;
#endif
    static_assert((CW_BAR + XCD_BAR_WORDS) * 4 <= 64 * 1024, "control words of launch 0 must fit the zeroed prefix");
    if (hipMemsetAsync((char*)d_ws + WS_CTL, 0, ctl_zero, stream) != hipSuccess) return;
    Args a{};
    for (int i = 0; i < 24; ++i) a.in[i] = (const float*)d_in[i];
    a.out = (float*)d_out; a.ws = (unsigned char*)d_ws;
#if defined(SPLITAT)
    a.ph_lo = 0; a.ph_hi = SPLITAT; a.li = 0;
    hipLaunchKernelGGL(fwd, dim3(grid), dim3(512), LDS_BYTES, stream, a);
    a.ph_lo = SPLITAT; a.ph_hi = NPH; a.li = 1;
    hipLaunchKernelGGL(fwd, dim3(grid), dim3(512), LDS_BYTES, stream, a);
#elif defined(DUPK)
    a.ph_lo = 0; a.ph_hi = DUPK + 1; a.li = 0;
    hipLaunchKernelGGL(fwd, dim3(grid), dim3(512), LDS_BYTES, stream, a);
#ifdef DUPN
    for (int rep = 0; rep < DUPN; ++rep) { a.ph_lo = DUPK; a.ph_hi = DUPK + 1; a.li = 2; hipLaunchKernelGGL(fwd, dim3(grid), dim3(512), LDS_BYTES, stream, a); }
#endif
    a.ph_lo = DUPK; a.ph_hi = NPH; a.li = 1;
    hipLaunchKernelGGL(fwd, dim3(grid), dim3(512), LDS_BYTES, stream, a);
#elif MK_ONE_LAUNCH
    a.ph_lo = 0; a.ph_hi = NPH;
    hipLaunchKernelGGL(fwd, dim3(grid), dim3(512), LDS_BYTES, stream, a);
#else
    for (int p = 0; p < NPH; ++p) { a.ph_lo = p; a.ph_hi = p + 1; hipLaunchKernelGGL(fwd, dim3(grid), dim3(512), LDS_BYTES, stream, a); }
#endif
}
```
